# Optimizing an MI355X kernel written in HIP

```python
import jax, jax.numpy as jnp
from jax import lax
import numpy as np

D_MODEL = 1024
BATCH = 4
SEQ = 8192
DEPTH = 1

MEM_LEN = 256
DN_ALPHA = (2 * DEPTH) ** 0.25
DN_BETA = (8 * DEPTH) ** -0.25
LN_EPS = 1e-5
NEG = -1e30
FORCE = 1e9

RET_HEADS = 4
RET_DIM = D_MODEL // 2 // RET_HEADS
RET_CHUNK = 128
RET_ROPE_BASE = 10000.0

NSA_HEADS = 8
NSA_KV_GROUPS = 2
NSA_HPG = NSA_HEADS // NSA_KV_GROUPS
NSA_DIM = D_MODEL // 2 // NSA_HEADS
CMP_LEN = 32
CMP_STRIDE = 16
CMP_HIDDEN = 256
SEL_LEN = 64
SEL_TOPK = 16
WIN = 512
Q_BLOCK = 128
ROPE_THETA = 500000.0
ROPE_DIMS = NSA_DIM // 4

RET_WIDTH = RET_HEADS * RET_DIM
NSA_WIDTH = NSA_HEADS * NSA_DIM
MIX_WIDTH = RET_WIDTH + NSA_WIDTH
KV_WIDTH = NSA_KV_GROUPS * NSA_DIM
IN_SIZES = [RET_WIDTH] * 4 + [NSA_WIDTH] + [KV_WIDTH] * 6 + [3 * NSA_HEADS]
IN_COLS = sum(IN_SIZES)

XATT_HEADS = 4
XATT_DIM = D_MODEL // XATT_HEADS

N_EXPERTS = 64
TOP_K = 8
N_GROUPS = 8
TOPK_GROUPS = 4
EXPERT_FF = 256
SHARED_FF = 256
ROUTED_SCALE = 2.5
MOE_BLOCK = 128

kernel_name = 'hymba_retnet_nsa_deepnorm_moe'


def layer_norm(x, g, b):
    xf = x.astype(jnp.float32)
    mu = xf.mean(-1, keepdims=True)
    var = jnp.square(xf - mu).mean(-1, keepdims=True)
    return ((xf - mu) * lax.rsqrt(var + LN_EPS) * g + b).astype(x.dtype)


def rotary(x, pos, n_rot, base):
    half = n_rot // 2
    inv = base ** (-jnp.arange(half, dtype=jnp.float32) / half)
    ang = pos.astype(jnp.float32)[..., None] * inv
    cos = jnp.cos(ang)[:, :, None, :]
    sin = jnp.sin(ang)[:, :, None, :]
    x1 = x[..., :half].astype(jnp.float32)
    x2 = x[..., half:n_rot].astype(jnp.float32)
    out = jnp.concatenate([x1 * cos - x2 * sin, x2 * cos + x1 * sin,
                           x[..., n_rot:].astype(jnp.float32)], axis=-1)
    return out.astype(x.dtype)


def retention(q, k, v, pos):
    B, T, H, dh = q.shape
    C = RET_CHUNK
    nc = T // C
    q = rotary(q, pos, dh, RET_ROPE_BASE)
    k = rotary(k, pos, dh, RET_ROPE_BASE) * (dh ** -0.5)

    def chunks(a):
        return a.reshape(B, nc, C, H, dh).transpose(0, 3, 1, 2, 4)

    qc, kc, vc = chunks(q), chunks(k), chunks(v)
    log_g = jnp.log(1.0 - 2.0 ** (-5.0 - jnp.arange(H, dtype=jnp.float32)))
    idx = jnp.arange(C, dtype=jnp.float32)
    rel = idx[:, None] - idx[None, :]
    dmask = jnp.where(rel >= 0, jnp.exp(log_g[:, None, None] * jnp.maximum(rel, 0.0)), 0.0)
    scores = jnp.einsum('bhncd,bhnmd->bhncm', qc, kc) * dmask[:, None]
    inner = jnp.einsum('bhncm,bhnme->bhnce', scores, vc)
    zeta = jnp.exp(log_g[:, None] * (C - 1.0 - idx))
    xi = jnp.exp(log_g[:, None] * (idx + 1.0))
    chunk_decay = jnp.exp(log_g * C)[:, None, None]
    kv = jnp.einsum('bhncd,bhnce->nbhde', kc * zeta[:, None, :, None], vc).astype(jnp.float32)

    def step(state, kv_n):
        return state * chunk_decay + kv_n, state

    _, prev = lax.scan(step, jnp.zeros(kv.shape[1:], jnp.float32), kv)
    cross = jnp.einsum('bhncd,nbhde->bhnce', qc, prev) * xi[:, None, :, None]
    o = (inner + cross).astype(jnp.float32).transpose(0, 2, 3, 1, 4).reshape(B, T, H, dh)
    mu = o.mean(-1, keepdims=True)
    var = jnp.square(o - mu).mean(-1, keepdims=True)
    o = (o - mu) * lax.rsqrt(var + LN_EPS)
    return o.reshape(B, T, H * dh)


def native_sparse_attention(q, kc, vc, ks, vs, kw, vw, gates, pos,
                            cmp_pe_k, cmp_pe_v, cmp_w1_k, cmp_w2_k, cmp_w1_v, cmp_w2_v):
    B, T, H, dh = q.shape
    G, hpg = NSA_KV_GROUPS, NSA_HPG
    scale = dh ** -0.5
    q_rot = rotary(q, pos, ROPE_DIMS, ROPE_THETA)
    ks = rotary(ks, pos, ROPE_DIMS, ROPE_THETA)
    kw = rotary(kw, pos, ROPE_DIMS, ROPE_THETA)

    n_cmp = (T - CMP_LEN) // CMP_STRIDE + 1
    blk = jnp.arange(n_cmp)[:, None] * CMP_STRIDE + jnp.arange(CMP_LEN)[None, :]

    def compress(a, pe, w1, w2):
        ab = a[:, blk] + pe[None, None, :, None, :]
        ab = ab.transpose(0, 1, 3, 2, 4).reshape(B, n_cmp, G, CMP_LEN * dh)
        return jax.nn.silu(ab @ w1) @ w2

    k_cmp = compress(kc, cmp_pe_k, cmp_w1_k, cmp_w2_k)
    v_cmp = compress(vc, cmp_pe_v, cmp_w1_v, cmp_w2_v)
    cmp_start = jnp.arange(n_cmp) * CMP_STRIDE
    cmp_last = cmp_start + CMP_LEN - 1

    n_sel = T // SEL_LEN
    n_top = min(SEL_TOPK, n_sel)
    ks_b = ks.reshape(B, n_sel, SEL_LEN, G, dh).transpose(0, 3, 1, 2, 4)
    vs_b = vs.reshape(B, n_sel, SEL_LEN, G, dh).transpose(0, 3, 1, 2, 4)
    sel_start = jnp.arange(n_sel) * SEL_LEN
    overlap = ((cmp_start[:, None] < sel_start[None, :] + SEL_LEN)
               & (cmp_start[:, None] + CMP_LEN > sel_start[None, :])).astype(jnp.float32)
    gather = jax.vmap(jax.vmap(lambda tab, ix: tab[ix]))

    kw_p = jnp.pad(kw, ((0, 0), (WIN, 0), (0, 0), (0, 0)))
    vw_p = jnp.pad(vw, ((0, 0), (WIN, 0), (0, 0), (0, 0)))

    nqb = T // Q_BLOCK

    def to_blocks(a):
        return a.reshape((B, nqb, Q_BLOCK) + a.shape[2:]).swapaxes(0, 1)

    q_g = q.reshape(B, T, G, hpg, dh)
    qr_g = q_rot.reshape(B, T, G, hpg, dh)
    g_g = jax.nn.sigmoid(gates).reshape(B, T, G, hpg, 3)
    j_sel = jnp.arange(n_sel)

    def block_fn(args):
        i, qb, qrb, gb = args
        t = i * Q_BLOCK + jnp.arange(Q_BLOCK)
        s_c = jnp.einsum('bqghd,bcgd->bghqc', qb, k_cmp).astype(jnp.float32) * scale
        valid_c = cmp_last[None, :] <= t[:, None]
        p_c = jnp.where(valid_c, jax.nn.softmax(jnp.where(valid_c, s_c, NEG), axis=-1), 0.0)
        o_c = jnp.einsum('bghqc,bcgd->bqghd', p_c, v_cmp)
        imp = jnp.einsum('bghqc,cs->bgqs', p_c, overlap)
        cur = t // SEL_LEN
        forced = (j_sel[None] == 0) | (j_sel[None] == cur[:, None]) | (j_sel[None] == cur[:, None] - 1)
        imp = jnp.where(forced, FORCE, imp)
        imp = jnp.where(j_sel[None] <= cur[:, None], imp, NEG)
        _, sel = lax.top_k(imp, n_top)
        k_sel = gather(ks_b, sel)
        v_sel = gather(vs_b, sel)
        kpos = sel[..., None] * SEL_LEN + jnp.arange(SEL_LEN)
        m_s = (kpos <= t[:, None, None])[:, :, None]
        s_s = jnp.einsum('bqghd,bgqnld->bghqnl', qrb, k_sel).astype(jnp.float32) * scale
        s_s = jnp.where(m_s, s_s, NEG)
        p_s = jax.nn.softmax(s_s.reshape(B, G, hpg, Q_BLOCK, n_top * SEL_LEN), axis=-1)
        p_s = p_s.reshape(B, G, hpg, Q_BLOCK, n_top, SEL_LEN)
        o_s = jnp.einsum('bghqnl,bgqnld->bqghd', p_s, v_sel)
        start = i * Q_BLOCK
        k_win = lax.dynamic_slice_in_dim(kw_p, start, WIN + Q_BLOCK, axis=1)
        v_win = lax.dynamic_slice_in_dim(vw_p, start, WIN + Q_BLOCK, axis=1)
        wpos = start - WIN + jnp.arange(WIN + Q_BLOCK)
        diff = t[:, None] - wpos[None, :]
        m_w = (wpos[None, :] >= 0) & (diff >= 0) & (diff < WIN)
        s_w = jnp.einsum('bqghd,bkgd->bghqk', qrb, k_win).astype(jnp.float32) * scale
        p_w = jax.nn.softmax(jnp.where(m_w, s_w, NEG), axis=-1)
        o_w = jnp.einsum('bghqk,bkgd->bqghd', p_w, v_win)
        o = gb[..., 0:1] * o_c + gb[..., 1:2] * o_s + gb[..., 2:3] * o_w
        return o.reshape(B, Q_BLOCK, H * dh)

    out = lax.map(block_fn, (jnp.arange(nqb), to_blocks(q_g), to_blocks(qr_g), to_blocks(g_g)))
    return out.swapaxes(0, 1).reshape(B, T, H * dh)


def memory_cross_attention(x, mem, w_xq, w_xkv, w_xo):
    B, T, D = x.shape
    q = (x @ w_xq).reshape(B, T, XATT_HEADS, XATT_DIM)
    k, v = jnp.split(mem @ w_xkv, 2, axis=-1)
    k = k.reshape(B, -1, XATT_HEADS, XATT_DIM)
    v = v.reshape(B, -1, XATT_HEADS, XATT_DIM)
    s = jnp.einsum('bthd,bmhd->bhtm', q, k).astype(jnp.float32) * (XATT_DIM ** -0.5)
    p = jax.nn.softmax(s, axis=-1)
    o = jnp.einsum('bhtm,bmhd->bthd', p, v).reshape(B, T, D)
    return o @ w_xo


def moe(x, w_router, router_bias, w_gate, w_up, w_down, ws_gate, ws_up, ws_down):
    B, T, D = x.shape
    xf = x.reshape(-1, D)
    N = xf.shape[0]
    E = N_EXPERTS
    scores = jax.nn.sigmoid((xf @ w_router).astype(jnp.float32))
    biased = scores + router_bias.astype(jnp.float32)
    group_score = lax.top_k(biased.reshape(N, N_GROUPS, E // N_GROUPS), 2)[0].sum(-1)
    kth = lax.top_k(group_score, TOPK_GROUPS)[0][:, -1:]
    expert_ok = jnp.repeat(group_score >= kth, E // N_GROUPS, axis=1)
    _, top_e = lax.top_k(jnp.where(expert_ok, biased, NEG), TOP_K)
    w = jnp.take_along_axis(scores, top_e, axis=-1)
    w = w / w.sum(-1, keepdims=True) * ROUTED_SCALE
    flat_e = top_e.reshape(-1)
    flat_tok = jnp.repeat(jnp.arange(N, dtype=jnp.int32), TOP_K)
    flat_w = w.reshape(-1)
    order = jnp.argsort(flat_e)
    e_sorted = flat_e[order]
    counts = jnp.bincount(flat_e, length=E)
    starts = jnp.cumsum(counts) - counts
    padded = (counts + MOE_BLOCK - 1) // MOE_BLOCK * MOE_BLOCK
    pad_ends = jnp.cumsum(padded)
    pad_starts = pad_ends - padded
    dest = pad_starts[e_sorted] + (jnp.arange(N * TOP_K) - starts[e_sorted])
    cap = N * TOP_K + E * MOE_BLOCK
    n_blocks = cap // MOE_BLOCK
    slot_tok = jnp.zeros((cap,), jnp.int32).at[dest].set(flat_tok[order])
    slot_w = jnp.zeros((cap,), jnp.float32).at[dest].set(flat_w[order])
    block_e = jnp.minimum(jnp.searchsorted(pad_ends, jnp.arange(n_blocks) * MOE_BLOCK, side='right'), E - 1)

    def body(acc, blk):
        tok, wt, e = blk
        h = xf[tok]
        y = (jax.nn.silu(h @ w_gate[e]) * (h @ w_up[e])) @ w_down[e]
        return acc.at[tok].add(y.astype(jnp.float32) * wt[:, None]), None

    routed, _ = lax.scan(body, jnp.zeros((N, D), jnp.float32),
                         (slot_tok.reshape(n_blocks, MOE_BLOCK), slot_w.reshape(n_blocks, MOE_BLOCK), block_e))
    shared = (jax.nn.silu(xf @ ws_gate) * (xf @ ws_up)) @ ws_down
    return (routed + shared).reshape(B, T, D)


def hybrid_layer(x, mem, positions, w_in, cmp_pe_k, cmp_pe_v, cmp_w1_k, cmp_w2_k, cmp_w1_v, cmp_w2_v,
                 w_out, ln1_g, ln1_b, w_xq, w_xkv, w_xo, ln2_g, ln2_b, w_router, router_bias,
                 w_gate, w_up, w_down, ws_gate, ws_up, ws_down, ln3_g, ln3_b):
    B, T, _ = x.shape
    h = x @ w_in
    (rq, rk, rv, rg, nq, nkc, nvc, nks, nvs, nkw, nvw, ngate) = jnp.split(
        h, list(np.cumsum(IN_SIZES)[:-1]), axis=-1)
    o_ret = retention(rq.reshape(B, T, RET_HEADS, RET_DIM), rk.reshape(B, T, RET_HEADS, RET_DIM),
                      rv.reshape(B, T, RET_HEADS, RET_DIM), positions)
    o_ret = jax.nn.silu(rg) * o_ret
    kvs = lambda a: a.reshape(B, T, NSA_KV_GROUPS, NSA_DIM)
    o_nsa = native_sparse_attention(nq.reshape(B, T, NSA_HEADS, NSA_DIM), kvs(nkc), kvs(nvc), kvs(nks),
                                    kvs(nvs), kvs(nkw), kvs(nvw), ngate, positions,
                                    cmp_pe_k, cmp_pe_v, cmp_w1_k, cmp_w2_k, cmp_w1_v, cmp_w2_v)
    mix = jnp.concatenate([o_ret.astype(x.dtype), o_nsa.astype(x.dtype)], axis=-1) @ w_out
    x = layer_norm(DN_ALPHA * x + mix, ln1_g, ln1_b)
    x = layer_norm(DN_ALPHA * x + memory_cross_attention(x, mem, w_xq, w_xkv, w_xo), ln2_g, ln2_b)
    y = moe(x, w_router, router_bias, w_gate, w_up, w_down, ws_gate, ws_up, ws_down)
    x = layer_norm(DN_ALPHA * x + y.astype(x.dtype), ln3_g, ln3_b)
    return x


def setup_inputs(seed: int = 0) -> dict:
    key = jax.random.key(seed)
    ks = jax.random.split(key, 32)
    L, D = DEPTH, D_MODEL
    nrm = lambda k, shape, s: jax.random.normal(k, shape, jnp.float32) * s
    return {
        'x': nrm(ks[0], (BATCH, SEQ, D), 1.0),
        'mem': nrm(ks[1], (BATCH, MEM_LEN, D), 1.0),
        'positions': (jnp.arange(SEQ, dtype=jnp.int32)[None, :]
                      + jax.random.randint(ks[2], (BATCH, 1), 0, 1024, dtype=jnp.int32)),
        'w_in': nrm(ks[3], (L, D, IN_COLS), D ** -0.5),
        'cmp_pe_k': nrm(ks[4], (L, CMP_LEN, NSA_DIM), 0.1),
        'cmp_pe_v': nrm(ks[5], (L, CMP_LEN, NSA_DIM), 0.1),
        'cmp_w1_k': nrm(ks[6], (L, CMP_LEN * NSA_DIM, CMP_HIDDEN), (CMP_LEN * NSA_DIM) ** -0.5),
        'cmp_w2_k': nrm(ks[7], (L, CMP_HIDDEN, NSA_DIM), CMP_HIDDEN ** -0.5),
        'cmp_w1_v': nrm(ks[8], (L, CMP_LEN * NSA_DIM, CMP_HIDDEN), (CMP_LEN * NSA_DIM) ** -0.5),
        'cmp_w2_v': nrm(ks[9], (L, CMP_HIDDEN, NSA_DIM), CMP_HIDDEN ** -0.5),
        'w_out': nrm(ks[10], (L, MIX_WIDTH, D), DN_BETA * MIX_WIDTH ** -0.5),
        'ln1_g': 1.0 + nrm(ks[11], (L, D), 0.02),
        'ln1_b': nrm(ks[12], (L, D), 0.02),
        'w_xq': nrm(ks[13], (L, D, D), D ** -0.5),
        'w_xkv': nrm(ks[14], (L, D, 2 * D), D ** -0.5),
        'w_xo': nrm(ks[15], (L, D, D), DN_BETA * D ** -0.5),
        'ln2_g': 1.0 + nrm(ks[16], (L, D), 0.02),
        'ln2_b': nrm(ks[17], (L, D), 0.02),
        'w_router': nrm(ks[18], (L, D, N_EXPERTS), D ** -0.5),
        'router_bias': nrm(ks[19], (L, N_EXPERTS), 0.01),
        'w_gate': nrm(ks[20], (L, N_EXPERTS, D, EXPERT_FF), D ** -0.5),
        'w_up': nrm(ks[21], (L, N_EXPERTS, D, EXPERT_FF), D ** -0.5),
        'w_down': nrm(ks[22], (L, N_EXPERTS, EXPERT_FF, D), DN_BETA * EXPERT_FF ** -0.5),
        'ws_gate': nrm(ks[23], (L, D, SHARED_FF), D ** -0.5),
        'ws_up': nrm(ks[24], (L, D, SHARED_FF), D ** -0.5),
        'ws_down': nrm(ks[25], (L, SHARED_FF, D), DN_BETA * SHARED_FF ** -0.5),
        'ln3_g': 1.0 + nrm(ks[26], (L, D), 0.02),
        'ln3_b': nrm(ks[27], (L, D), 0.02),
    }


def reference(x, mem, positions, w_in, cmp_pe_k, cmp_pe_v, cmp_w1_k, cmp_w2_k, cmp_w1_v, cmp_w2_v,
              w_out, ln1_g, ln1_b, w_xq, w_xkv, w_xo, ln2_g, ln2_b, w_router, router_bias,
              w_gate, w_up, w_down, ws_gate, ws_up, ws_down, ln3_g, ln3_b):
    for l in range(DEPTH):
        x = hybrid_layer(x, mem, positions, w_in[l], cmp_pe_k[l], cmp_pe_v[l], cmp_w1_k[l], cmp_w2_k[l],
                         cmp_w1_v[l], cmp_w2_v[l], w_out[l], ln1_g[l], ln1_b[l], w_xq[l], w_xkv[l],
                         w_xo[l], ln2_g[l], ln2_b[l], w_router[l], router_bias[l], w_gate[l], w_up[l],
                         w_down[l], ws_gate[l], ws_up[l], ws_down[l], ln3_g[l], ln3_b[l])
    return x
```

```cpp
#include <hip/hip_runtime.h>
#include <cstdio>
#include <cstdint>
#include <cmath>

typedef _Float16 h16;
typedef _Float16 h16x8 __attribute__((ext_vector_type(8)));
typedef _Float16 h16x2 __attribute__((ext_vector_type(2)));
typedef float f32x2 __attribute__((ext_vector_type(2)));
typedef float f32x4 __attribute__((ext_vector_type(4)));
typedef unsigned u32x4 __attribute__((ext_vector_type(4)));
typedef unsigned u32x2 __attribute__((ext_vector_type(2)));

constexpr int NB = 4, T = 8192, D = 1024, M = NB * T;
constexpr int INC = 3352, INP = 3584;
constexpr int C_RQ = 0, C_RK = 512, C_RV = 1024, C_RG = 1536, C_NQ = 2048, C_NKC = 2560, C_NVC = 2688, C_NKS = 2816, C_NVS = 2944, C_NKW = 3072, C_NVW = 3200, C_NG = 3328;
constexpr int MEML = 256;
constexpr int NE = 64, EFF = 256;
constexpr float LN_EPS = 1e-5f;
constexpr float DN_ALPHA = 1.189207115002721f;
constexpr float NEGF = -1e30f;

constexpr size_t MiB = 1u << 20;
constexpr size_t WS_WIN = 1 * MiB, WS_WOUT = 8 * MiB, WS_WXQ = 10 * MiB, WS_WXO = 12 * MiB, WS_WXKV = 14 * MiB, WS_MEMH = 18 * MiB, WS_KVM = 20 * MiB;
constexpr size_t WS_KCMP = 24 * MiB, WS_VCMP = 25 * MiB, WS_TOPE = 26 * MiB, WS_TOPW = 27 * MiB;
constexpr size_t WS_XH = 32 * MiB, WS_MIX = 32 * MiB, WS_OX = 32 * MiB;
constexpr size_t WS_H = 96 * MiB, WS_NQR = 320 * MiB, WS_KVB = 352 * MiB, WS_PREV = 416 * MiB;
constexpr size_t WS_PRE = 96 * MiB, WS_X1 = 224 * MiB, WS_X1H = 352 * MiB, WS_QX = 416 * MiB, WS_X2 = 352 * MiB;
constexpr size_t WS_NEED = 480 * MiB;

namespace pg8 {
#define PG8_LAS __attribute__((address_space(3)))
typedef short s16x8 __attribute__((ext_vector_type(8)));
constexpr int BM = 256, BK = 64, HALF = 128, HTB = HALF * BK * 2, STAGE_BYTES = 8 * HTB, NXCD = 8, WGM = 8;
__host__ __device__ __forceinline__ int lds_byte(int r, int c) { const int st = (r >> 4) * 2 + (c >> 5), rr = r & 15, cc = c & 31, ob = rr * 64 + cc * 2; return st * 1024 + (ob ^ (((ob >> 9) & 1) << 5)); }
__host__ __device__ __forceinline__ void stage_rc(int b, int& R, int& C) { const int st = b / 1024, sb = b % 1024, swz = sb ^ (((sb >> 9) & 1) << 5); R = (st >> 1) * 16 + swz / 64; C = (st & 1) * 32 + (swz % 64) / 2; }
__host__ __device__ __forceinline__ int perm32(int rho) { const int n = rho >> 4, i = rho & 15; return 8 * (i >> 2) + 4 * n + (i & 3); }
struct Unit { int pm, pn; };
struct Gemm { const h16* A; const h16* Bt; int M, N, K; };
struct StaticOrder {
    int nM, nN, nwg, G, c;
    __host__ __device__ void init(int M_, int N_, int G_, int c_) { nM = M_ / BM; nN = N_ / BM; nwg = nM * nN; G = G_; c = c_; }
    __host__ __device__ bool next(int i, Unit& u) const {
        const long L = (long)i * G + c; if (L >= nwg) return false;
        int wgid = (int)L; { const int q = nwg / NXCD, r = nwg % NXCD, xcd = wgid % NXCD, off = wgid / NXCD; wgid = (xcd < r ? xcd * (q + 1) : r * (q + 1) + (xcd - r) * q) + off; }
        const int nig = WGM * nN, gid = wgid / nig, fm = gid * WGM, gsz = (nM - fm) < WGM ? (nM - fm) : WGM;
        u.pm = fm + ((wgid % nig) % gsz); u.pn = (wgid % nig) / gsz; return true;
    }
    __device__ __forceinline__ void a_ready(const Unit&) const {}
    __device__ __forceinline__ void done(const Unit&) const {}
};
__device__ __forceinline__ unsigned cvt_pk_f16(float lo, float hi) { f32x2 v = {lo, hi}; h16x2 h = __builtin_convertvector(v, h16x2); return __builtin_bit_cast(unsigned, h); }

struct EpiF16 {
    static constexpr bool PERM = true, AFTER_DRAIN = false;
    h16* O; int ldc;
    __device__ __forceinline__ void operator()(const f32x4 (&acc)[2][2][4][2], const Unit& u, int wr, int wc, int fr, int fq) const {
        const int row0 = u.pm * BM + wr * 64 + fr; const int col0 = u.pn * BM + wc * 32 + 8 * fq;
#pragma unroll
        for (int ai = 0; ai < 2; ++ai)
#pragma unroll
            for (int m = 0; m < 4; ++m) { h16* rowp = O + (size_t)(row0 + ai * HALF + m * 16) * ldc + col0;
#pragma unroll
                for (int bj = 0; bj < 2; ++bj) { const f32x4 v0 = acc[ai][bj][m][0], v1 = acc[ai][bj][m][1];
                    u32x4 w; w.x = cvt_pk_f16(v0[0], v0[1]); w.y = cvt_pk_f16(v0[2], v0[3]); w.z = cvt_pk_f16(v1[0], v1[1]); w.w = cvt_pk_f16(v1[2], v1[3]);
                    *(u32x4*)(rowp + bj * HALF) = w; } }
    }
};
struct EpiResF32 {
    static constexpr bool PERM = false, AFTER_DRAIN = false;
    float* C; const float* R; int ldc; float alpha;
    __device__ __forceinline__ void operator()(const f32x4 (&acc)[2][2][4][2], const Unit& u, int wr, int wc, int fr, int fq) const {
        const int row0 = u.pm * BM + wr * 64 + fr, col0 = u.pn * BM + wc * 32 + 4 * fq;
#pragma unroll
        for (int ai = 0; ai < 2; ++ai)
#pragma unroll
            for (int m = 0; m < 4; ++m) { const size_t off = (size_t)(row0 + ai * HALF + m * 16) * ldc + col0;
#pragma unroll
                for (int bj = 0; bj < 2; ++bj)
#pragma unroll
                    for (int n = 0; n < 2; ++n) { const f32x4 r = *(const f32x4*)(R + off + bj * HALF + n * 16); *(f32x4*)(C + off + bj * HALF + n * 16) = r * alpha + acc[ai][bj][m][n]; } }
    }
};

template <class Epi, class Sched, bool ALIGN_EPI = false, bool SP2 = false>
__device__ __forceinline__ void gemm_phase(PG8_LAS unsigned char* lds, const Gemm g, const Sched& S, const Epi& E) {
    const int tid = threadIdx.x, wid = __builtin_amdgcn_readfirstlane(tid >> 6), lane = tid & 63, wr = wid >> 2, wc = wid & 3, fr = lane & 15, fq = lane >> 4;
    const int K = g.K, nt = K / BK;
    unsigned voffA[2], voffB[2];
#pragma unroll
    for (int i = 0; i < 2; ++i) { int R, C; stage_rc(tid * 16 + i * 8192, R, C); const int Rb = Epi::PERM ? ((R & ~31) + perm32(R & 31)) : R;
        voffA[i] = (unsigned)(R * K + C) * 2u; voffB[i] = (unsigned)(Rb * K + C) * 2u; }
    const size_t kstep = (size_t)(BK * 2);
    const size_t hstep = (size_t)HALF * K * 2;
    const size_t tstep = 2 * hstep;
    const unsigned ldsw = (unsigned)wid * 1024u;
    const int aoff = lds_byte(wr * 64 + fr, fq * 8), boff = lds_byte(wc * 32 + fr, fq * 8);
#define PG8_SA(b, h) (((b) * 2 + (h)) * HTB)
#define PG8_SB(b, h) ((4 + (b) * 2 + (h)) * HTB)
#define PG8_STAGE(bufoff, gbase, voff) do { _Pragma("unroll") for (int _i = 0; _i < 2; ++_i) \
        __builtin_amdgcn_global_load_lds((const unsigned*)((const char*)(gbase) + (voff)[_i]), (PG8_LAS unsigned*)(lds + (bufoff) + ldsw + _i * 8192), 16, 0, 0); } while (0)
#define PG8_LDA(dst, b, h) do { _Pragma("unroll") for (int m = 0; m < 4; ++m) _Pragma("unroll") for (int k = 0; k < 2; ++k) dst[m][k] = *(const PG8_LAS s16x8*)(lds + PG8_SA(b, h) + aoff + m * 2048 + k * 1024); } while (0)
#define PG8_LDB(dst, b, h) do { _Pragma("unroll") for (int n = 0; n < 2; ++n) _Pragma("unroll") for (int k = 0; k < 2; ++k) dst[n][k] = *(const PG8_LAS s16x8*)(lds + PG8_SB(b, h) + boff + n * 2048 + k * 1024); } while (0)
#define PG8_MMA(ai, bj, At, Bt) do { __builtin_amdgcn_s_setprio(1); _Pragma("unroll") for (int m = 0; m < 4; ++m) _Pragma("unroll") for (int n = 0; n < 2; ++n) _Pragma("unroll") for (int k = 0; k < 2; ++k) \
        acc[ai][bj][m][n] = __builtin_amdgcn_mfma_f32_16x16x32_f16(__builtin_bit_cast(h16x8, Bt[n][k]), __builtin_bit_cast(h16x8, At[m][k]), acc[ai][bj][m][n], 0, 0, 0); __builtin_amdgcn_s_setprio(0); } while (0)
#define PG8_WAIT_V(n) asm volatile("s_waitcnt vmcnt(" #n ")" ::: "memory")
#define PG8_WAIT_L(n) asm volatile("s_waitcnt lgkmcnt(" #n ")" ::: "memory")
#define PG8_BAR __builtin_amdgcn_s_barrier()
#define PG8_SCHED __builtin_amdgcn_sched_barrier(0)
    Unit cur, nxt; int ui = 0;
    if (!S.next(0, cur)) return;
    f32x4 acc[2][2][4][2];
#pragma unroll
    for (int a = 0; a < 2; ++a)
#pragma unroll
        for (int b = 0; b < 2; ++b)
#pragma unroll
            for (int m = 0; m < 4; ++m)
#pragma unroll
                for (int n = 0; n < 2; ++n) acc[a][b][m][n] = (f32x4){0.f, 0.f, 0.f, 0.f};
    s16x8 At[4][2], B0[2][2], B1[2][2];
    const char* cA = (const char*)g.A + (size_t)cur.pm * tstep; const char* cB = (const char*)g.Bt + (size_t)cur.pn * tstep;
    S.a_ready(cur);
    if constexpr (SP2) {
        PG8_STAGE(PG8_SB(0, 0), cB, voffB); PG8_STAGE(PG8_SB(0, 1), cB + hstep, voffB); PG8_STAGE(PG8_SA(0, 0), cA, voffA); PG8_STAGE(PG8_SA(0, 1), cA + hstep, voffA);
        if (wr == 1) PG8_BAR;
        PG8_WAIT_V(2); PG8_BAR;
        PG8_STAGE(PG8_SB(1, 0), cB + kstep, voffB); PG8_STAGE(PG8_SA(1, 0), cA + kstep, voffA); PG8_STAGE(PG8_SB(1, 1), cB + hstep + kstep, voffB);
        PG8_WAIT_V(6); PG8_BAR;
    } else {
        PG8_STAGE(PG8_SB(0, 0), cB, voffB); PG8_STAGE(PG8_SA(0, 0), cA, voffA); PG8_STAGE(PG8_SB(0, 1), cB + hstep, voffB); PG8_STAGE(PG8_SA(0, 1), cA + hstep, voffA);
        if (wr == 1) PG8_BAR;
        PG8_WAIT_V(4); PG8_BAR;
        PG8_STAGE(PG8_SB(1, 0), cB + kstep, voffB); PG8_STAGE(PG8_SA(1, 0), cA + kstep, voffA); PG8_STAGE(PG8_SB(1, 1), cB + hstep + kstep, voffB);
        PG8_WAIT_V(6); PG8_BAR;
    }
    for (;;) {
        const bool has_next = S.next(ui + 1, nxt);
        const char* nA = has_next ? (const char*)g.A + (size_t)nxt.pm * tstep : cA; const char* nB = has_next ? (const char*)g.Bt + (size_t)nxt.pn * tstep : cB;
        for (int t = 0; t < nt; t += 2) {
            const bool last = (t == nt - 2);
            const char* a1 = cA + (size_t)(t + 1) * kstep;
            const char* a2 = last ? nA : cA + (size_t)(t + 2) * kstep; const char* b2 = last ? nB : cB + (size_t)(t + 2) * kstep;
            const char* a3 = a2 + kstep; const char* b3 = b2 + kstep;
            if (last && has_next) S.a_ready(nxt);
            if constexpr (SP2) {
            PG8_LDB(B0, 0, 0); PG8_LDB(B1, 0, 1); PG8_SCHED; PG8_LDA(At, 0, 0); PG8_STAGE(PG8_SA(1, 1), a1 + hstep, voffA);
            PG8_WAIT_V(8); PG8_WAIT_L(0); PG8_BAR; PG8_MMA(0, 0, At, B0); PG8_MMA(0, 1, At, B1); PG8_BAR; PG8_SCHED;
            PG8_LDA(At, 0, 1); PG8_STAGE(PG8_SB(0, 0), b2, voffB); PG8_STAGE(PG8_SB(0, 1), b2 + hstep, voffB); PG8_STAGE(PG8_SA(0, 0), a2, voffA);
            PG8_WAIT_V(8); PG8_WAIT_L(0); PG8_BAR; PG8_MMA(1, 0, At, B0); PG8_MMA(1, 1, At, B1); PG8_BAR; PG8_SCHED;
            PG8_LDB(B0, 1, 0); PG8_LDB(B1, 1, 1); PG8_SCHED; PG8_LDA(At, 1, 0); PG8_STAGE(PG8_SA(0, 1), a2 + hstep, voffA);
            PG8_WAIT_V(8); PG8_WAIT_L(0); PG8_BAR; PG8_MMA(0, 0, At, B0); PG8_MMA(0, 1, At, B1); PG8_BAR; PG8_SCHED;
            PG8_LDA(At, 1, 1); PG8_STAGE(PG8_SB(1, 0), b3, voffB); PG8_STAGE(PG8_SB(1, 1), b3 + hstep, voffB); PG8_STAGE(PG8_SA(1, 0), a3, voffA);
            PG8_WAIT_V(8); PG8_WAIT_L(0); PG8_BAR; PG8_MMA(1, 0, At, B0); PG8_MMA(1, 1, At, B1); PG8_BAR; PG8_SCHED;
            } else {
            PG8_LDB(B0, 0, 0); PG8_SCHED; PG8_LDA(At, 0, 0); PG8_STAGE(PG8_SA(1, 1), a1 + hstep, voffA);
            PG8_WAIT_L(8); PG8_BAR; PG8_WAIT_L(0); PG8_MMA(0, 0, At, B0); PG8_BAR; PG8_SCHED;
            PG8_LDB(B1, 0, 1); PG8_STAGE(PG8_SB(0, 0), b2, voffB);
            PG8_BAR; PG8_WAIT_L(0); PG8_MMA(0, 1, At, B1); PG8_BAR;
            PG8_LDA(At, 0, 1); PG8_STAGE(PG8_SA(0, 0), a2, voffA);
            PG8_BAR; PG8_WAIT_L(0); PG8_MMA(1, 0, At, B0); PG8_BAR; PG8_SCHED;
            PG8_STAGE(PG8_SB(0, 1), b2 + hstep, voffB);
            PG8_WAIT_V(6); PG8_BAR; PG8_MMA(1, 1, At, B1); PG8_BAR;
            PG8_LDB(B0, 1, 0); PG8_SCHED; PG8_LDA(At, 1, 0); PG8_STAGE(PG8_SA(0, 1), a2 + hstep, voffA);
            PG8_WAIT_L(8); PG8_BAR; PG8_WAIT_L(0); PG8_MMA(0, 0, At, B0); PG8_BAR; PG8_SCHED;
            PG8_LDB(B1, 1, 1); PG8_STAGE(PG8_SB(1, 0), b3, voffB);
            PG8_BAR; PG8_WAIT_L(0); PG8_MMA(0, 1, At, B1); PG8_BAR;
            PG8_LDA(At, 1, 1); PG8_STAGE(PG8_SA(1, 0), a3, voffA);
            PG8_BAR; PG8_WAIT_L(0); PG8_MMA(1, 0, At, B0); PG8_BAR; PG8_SCHED;
            PG8_STAGE(PG8_SB(1, 1), b3 + hstep, voffB);
            PG8_WAIT_V(6); PG8_BAR; PG8_MMA(1, 1, At, B1); PG8_BAR;
            }
        }
        if constexpr (ALIGN_EPI) { if (wr == 0) PG8_BAR; }
        if constexpr (!Epi::AFTER_DRAIN) { E(acc, cur, wr, wc, fr, fq); S.done(cur); }
        if (!has_next) break;
#pragma unroll
        for (int a = 0; a < 2; ++a)
#pragma unroll
            for (int b = 0; b < 2; ++b)
#pragma unroll
                for (int m = 0; m < 4; ++m)
#pragma unroll
                    for (int n = 0; n < 2; ++n) acc[a][b][m][n] = (f32x4){0.f, 0.f, 0.f, 0.f};
        cur = nxt; cA = nA; cB = nB; ++ui;
        if constexpr (ALIGN_EPI) { if (wr == 1) PG8_BAR; }
    }
    PG8_WAIT_V(0);
    if constexpr (!ALIGN_EPI) { if (wr == 0) PG8_BAR; }
    PG8_BAR;
#undef PG8_SA
#undef PG8_SB
#undef PG8_STAGE
#undef PG8_LDA
#undef PG8_LDB
#undef PG8_MMA
#undef PG8_WAIT_V
#undef PG8_WAIT_L
#undef PG8_BAR
#undef PG8_SCHED
}
}

constexpr int GEMM_LDS = 131072;
__global__ void __launch_bounds__(512, 2) k_gemm_f16(const h16* A, const h16* Bt, h16* O, int Mr, int N, int K) {
    extern __shared__ __attribute__((aligned(16))) unsigned char lds[];
    pg8::Gemm g{A, Bt, Mr, N, K}; pg8::StaticOrder S; S.init(Mr, N, (int)gridDim.x, (int)blockIdx.x);
    pg8::EpiF16 E{O, N};
    pg8::gemm_phase<pg8::EpiF16, pg8::StaticOrder, true, true>((PG8_LAS unsigned char*)lds, g, S, E);
}
__global__ void __launch_bounds__(512, 2) k_gemm_res(const h16* A, const h16* Bt, float* C, const float* R, int Mr, int N, int K, float alpha) {
    extern __shared__ __attribute__((aligned(16))) unsigned char lds[];
    pg8::Gemm g{A, Bt, Mr, N, K}; pg8::StaticOrder S; S.init(Mr, N, (int)gridDim.x, (int)blockIdx.x);
    pg8::EpiResF32 E{C, R, N, alpha};
    pg8::gemm_phase<pg8::EpiResF32, pg8::StaticOrder, true, true>((PG8_LAS unsigned char*)lds, g, S, E);
}

__device__ __forceinline__ float wave_sum(float v) {
#pragma unroll
    for (int o = 1; o < 64; o <<= 1) v += __shfl_xor(v, o);
    return v;
}
__device__ __forceinline__ float wave_max(float v) {
#pragma unroll
    for (int o = 1; o < 64; o <<= 1) v = fmaxf(v, __shfl_xor(v, o));
    return v;
}
__device__ __forceinline__ float siluf(float v) { return v / (1.f + __expf(-v)); }
__device__ __forceinline__ float sigmf(float v) { return 1.f / (1.f + __expf(-v)); }

__global__ void __launch_bounds__(256) k_transpose(const float* __restrict__ W, int K, int N, h16* __restrict__ WT, int Npad) {
    __shared__ float tile[32][33];
    const int n0 = blockIdx.x * 32, k0 = blockIdx.y * 32, tx = threadIdx.x & 31, ty = threadIdx.x >> 5;
    for (int i = ty; i < 32; i += 8) { const int k = k0 + i, n = n0 + tx; tile[i][tx] = (n < N) ? W[(size_t)k * N + n] : 0.f; }
    __syncthreads();
    for (int i = ty; i < 32; i += 8) { const int n = n0 + i, k = k0 + tx; if (n < Npad) WT[(size_t)n * K + k] = (h16)tile[tx][i]; }
}
__global__ void __launch_bounds__(256) k_cvt(const float* __restrict__ x, h16* __restrict__ o, size_t n4) {
    for (size_t i = (size_t)blockIdx.x * 256 + threadIdx.x; i < n4; i += (size_t)gridDim.x * 256) {
        const f32x4 v = ((const f32x4*)x)[i]; u32x2 w; w.x = pg8::cvt_pk_f16(v[0], v[1]); w.y = pg8::cvt_pk_f16(v[2], v[3]); ((u32x2*)o)[i] = w; }
}

__global__ void __launch_bounds__(256) k_rope(h16* __restrict__ h, h16* __restrict__ nqr, const int* __restrict__ positions) {
    const int m = blockIdx.x, j = threadIdx.x;
    h16* hr = h + (size_t)m * INP;
    const float pos = (float)positions[m];
    {
        const int hd = j >> 6, jj = j & 63;
        const float inv = (float)pow(10000.0, -(double)jj / 64.0);
        const float ang = pos * inv; double sd, cd; sincos((double)ang, &sd, &cd); const float c = (float)cd, s = (float)sd;
        const int o1 = hd * 128 + jj, o2 = o1 + 64;
        const float q1 = (float)hr[C_RQ + o1], q2 = (float)hr[C_RQ + o2];
        hr[C_RQ + o1] = (h16)(q1 * c - q2 * s); hr[C_RQ + o2] = (h16)(q2 * c + q1 * s);
        const float k1 = (float)hr[C_RK + o1], k2 = (float)hr[C_RK + o2]; const float sc = 0.08838834764831845f;
        hr[C_RK + o1] = (h16)((k1 * c - k2 * s) * sc); hr[C_RK + o2] = (h16)((k2 * c + k1 * s) * sc);
    }
    if (j < 64 + 16 + 16) {
        const int jj = j & 7;
        const float inv = (float)pow(500000.0, -(double)jj / 8.0);
        const float ang = pos * inv; double sd, cd; sincos((double)ang, &sd, &cd); const float c = (float)cd, s = (float)sd;
        if (j < 64) { const int hd = j >> 3; const int o1 = hd * 64 + jj, o2 = o1 + 8;
            const float q1 = (float)hr[C_NQ + o1], q2 = (float)hr[C_NQ + o2];
            nqr[(size_t)m * 512 + o1] = (h16)(q1 * c - q2 * s); nqr[(size_t)m * 512 + o2] = (h16)(q2 * c + q1 * s);
        } else { const int jx = j - 64; const int which = jx >> 4, g = (jx >> 3) & 1; const int base = (which ? C_NKW : C_NKS) + g * 64 + jj;
            const float k1 = (float)hr[base], k2 = (float)hr[base + 8];
            hr[base] = (h16)(k1 * c - k2 * s); hr[base + 8] = (h16)(k2 * c + k1 * s); }
    }
    for (int i = j; i < 8 * 48; i += 256) { const int hd = i / 48, d = 16 + i % 48; nqr[(size_t)m * 512 + hd * 64 + d] = hr[C_NQ + hd * 64 + d]; }
}

__global__ void __launch_bounds__(256) k_cmp(const h16* __restrict__ h, const float* __restrict__ pe_k, const float* __restrict__ pe_v, const float* __restrict__ w1k, const float* __restrict__ w2k,
                                            const float* __restrict__ w1v, const float* __restrict__ w2v, float* __restrict__ kcmp, float* __restrict__ vcmp) {
    __shared__ float a[2048]; __shared__ float hid[256];
    int id = blockIdx.x; const int g = id & 1; id >>= 1; const int c = id % 511; id /= 511; const int b = id & 3; const int kv = id >> 2;
    const float* pe = kv ? pe_v : pe_k; const float* w1 = kv ? w1v : w1k; const float* w2 = kv ? w2v : w2k; float* out = kv ? vcmp : kcmp;
    const int colb = (kv ? C_NVC : C_NKC) + g * 64;
    for (int i = threadIdx.x; i < 2048; i += 256) { const int l = i >> 6, d = i & 63; a[i] = (float)h[(size_t)(b * T + 16 * c + l) * INP + colb + d] + pe[l * 64 + d]; }
    __syncthreads();
    { const int j = threadIdx.x; float acc = 0.f;
        for (int k = 0; k < 2048; ++k) acc += a[k] * w1[(size_t)k * 256 + j];
        hid[j] = siluf(acc); }
    __syncthreads();
    if (threadIdx.x < 64) { const int e = threadIdx.x; float acc = 0.f;
        for (int j = 0; j < 256; ++j) acc += hid[j] * w2[j * 64 + e];
        out[((size_t)(b * 512 + c) * 2 + g) * 64 + e] = acc; }
}

__global__ void __launch_bounds__(256) k_ret_kv(const h16* __restrict__ h, float* __restrict__ kvb, float lg0, float lg1, float lg2, float lg3) {
    const int id = blockIdx.x, n = id & 63, hd = (id >> 6) & 3, b = id >> 8;
    const float lg = hd == 0 ? lg0 : hd == 1 ? lg1 : hd == 2 ? lg2 : lg3;
    const int d = threadIdx.x >> 1, e0 = (threadIdx.x & 1) * 64;
    float acc[64];
#pragma unroll
    for (int i = 0; i < 64; ++i) acc[i] = 0.f;
    const h16* base = h + (size_t)(b * T + n * 128) * INP;
    for (int j = 0; j < 128; ++j) {
        const float kd = (float)base[(size_t)j * INP + C_RK + hd * 128 + d] * __expf(lg * (float)(127 - j));
        const h16x8* vp = (const h16x8*)(base + (size_t)j * INP + C_RV + hd * 128 + e0);
#pragma unroll
        for (int i8 = 0; i8 < 8; ++i8) { const h16x8 v = vp[i8];
#pragma unroll
            for (int i = 0; i < 8; ++i) acc[i8 * 8 + i] += kd * (float)v[i]; }
    }
    float* o = kvb + ((size_t)id * 128 + d) * 128 + e0;
#pragma unroll
    for (int i = 0; i < 64; ++i) o[i] = acc[i];
}
__global__ void __launch_bounds__(256) k_ret_scan(const float* __restrict__ kvb, float* __restrict__ prev, float lg0, float lg1, float lg2, float lg3) {
    const int gid = blockIdx.x * 256 + threadIdx.x; const int de = gid & 16383, bh = gid >> 14; const int hd = bh & 3;
    const float lg = hd == 0 ? lg0 : hd == 1 ? lg1 : hd == 2 ? lg2 : lg3; const float cd = __expf(lg * 128.f);
    float st = 0.f;
    for (int n = 0; n < 64; ++n) { const size_t o = ((size_t)(bh * 64 + n) << 14) + de; prev[o] = st; st = st * cd + kvb[o]; }
}
__global__ void __launch_bounds__(128) k_ret_out(const h16* __restrict__ h, const float* __restrict__ prev, h16* __restrict__ mix, float lg0, float lg1, float lg2, float lg3) {
    __shared__ float q[128]; __shared__ float s[128]; __shared__ float red[4];
    int id = blockIdx.x; const int i = id & 127; id >>= 7; const int n = id & 63, hd = (id >> 6) & 3, b = id >> 8;
    const float lg = hd == 0 ? lg0 : hd == 1 ? lg1 : hd == 2 ? lg2 : lg3;
    const int tid = threadIdx.x; const size_t m = (size_t)b * T + n * 128 + i;
    q[tid] = (float)h[m * INP + C_RQ + hd * 128 + tid];
    __syncthreads();
    { const int j = tid; float acc = 0.f;
        if (j <= i) { const h16x8* kp = (const h16x8*)(h + ((size_t)b * T + n * 128 + j) * INP + C_RK + hd * 128);
#pragma unroll
            for (int d8 = 0; d8 < 16; ++d8) { const h16x8 kv = kp[d8];
#pragma unroll
                for (int x = 0; x < 8; ++x) acc += q[d8 * 8 + x] * (float)kv[x]; }
            acc *= __expf(lg * (float)(i - j)); }
        s[j] = acc; }
    __syncthreads();
    const int e = tid; float inner = 0.f, cross = 0.f;
    { const h16* vb = h + ((size_t)b * T + n * 128) * INP + C_RV + hd * 128 + e;
        for (int j = 0; j <= i; ++j) inner += s[j] * (float)vb[(size_t)j * INP];
        const float* pp = prev + ((size_t)((b * 4 + hd) * 64 + n) << 14) + e;
        for (int d = 0; d < 128; ++d) cross += q[d] * pp[d * 128];
        cross *= __expf(lg * (float)(i + 1)); }
    const float o = inner + cross;
    float sm = wave_sum(o); if ((tid & 63) == 0) red[tid >> 6] = sm; __syncthreads();
    const float mu = (red[0] + red[1]) * (1.f / 128.f); const float dv = o - mu;
    float sq = wave_sum(dv * dv); if ((tid & 63) == 0) red[2 + (tid >> 6)] = sq; __syncthreads();
    const float var = (red[2] + red[3]) * (1.f / 128.f);
    const float on = dv * rsqrtf(var + LN_EPS);
    const float gt = (float)h[m * INP + C_RG + hd * 128 + e];
    mix[m * D + hd * 128 + e] = (h16)(siluf(gt) * on);
}

__global__ void __launch_bounds__(256) k_nsa(const h16* __restrict__ h, const h16* __restrict__ nqr, const float* __restrict__ kcmp, const float* __restrict__ vcmp, h16* __restrict__ mix) {
    __shared__ float q[4][64], qr[4][64]; __shared__ float sc[4][1024]; __shared__ float impv[128]; __shared__ int sel[16];
    int id = blockIdx.x; const int g = id & 1; id >>= 1; const int t = id & (T - 1); const int b = id >> 13;
    const int tid = threadIdx.x, w = tid >> 6, lane = tid & 63, hh = g * 4 + w; const size_t m = (size_t)b * T + t;
    q[w][lane] = (float)h[m * INP + C_NQ + hh * 64 + lane]; qr[w][lane] = (float)nqr[m * 512 + hh * 64 + lane];
    if (tid < 16) sel[tid] = 0;
    __syncthreads();
    const int ncv = (t >= 31) ? ((t - 31) >> 4) + 1 : 0;
    float mx = -INFINITY;
    for (int c = lane; c < 512; c += 64) { float s = -INFINITY;
        if (c < ncv) { const float* kp = kcmp + ((size_t)(b * 512 + c) * 2 + g) * 64; float a = 0.f;
#pragma unroll 16
            for (int d = 0; d < 64; ++d) a += q[w][d] * kp[d];
            s = a * 0.125f; }
        sc[w][c] = s; mx = fmaxf(mx, s); }
    mx = wave_max(mx);
    float sm = 0.f;
    for (int c = lane; c < 512; c += 64) { const float p = (c < ncv) ? __expf(sc[w][c] - mx) : 0.f; sc[w][c] = p; sm += p; }
    sm = wave_sum(sm); const float isum = ncv > 0 ? 1.f / sm : 0.f;
    for (int c = lane; c < 512; c += 64) sc[w][c] *= isum;
    float o_c = 0.f;
    { const float* vp = vcmp + ((size_t)(b * 512) * 2 + g) * 64 + lane;
        for (int c = 0; c < ncv; ++c) o_c += sc[w][c] * vp[(size_t)c * 128]; }
    __syncthreads();
    const int cur = t >> 6;
    if (tid < 128) { const int s = tid; float v = 0.f;
        const int c0 = max(4 * s - 1, 0), c1 = min(4 * s + 3, 510);
        for (int c = c0; c <= c1; ++c) v += sc[0][c] + sc[1][c] + sc[2][c] + sc[3][c];
        if (s == 0 || s == cur || s == cur - 1) v = 1e9f;
        if (s > cur) v = NEGF;
        impv[s] = v; }
    __syncthreads();
    if (tid < 128) { const int s = tid; const float v = impv[s]; int rank = 0;
        for (int s2 = 0; s2 < 128; ++s2) { const float v2 = impv[s2]; rank += (v2 > v || (v2 == v && s2 < s)) ? 1 : 0; }
        if (rank < 16) sel[rank] = s; }
    __syncthreads();
    mx = -INFINITY;
    for (int i = 0; i < 16; ++i) { const int key = sel[i] * 64 + lane; float s = -INFINITY;
        if (key <= t) { const h16x8* kp = (const h16x8*)(h + ((size_t)b * T + key) * INP + C_NKS + g * 64); float a = 0.f;
#pragma unroll
            for (int d8 = 0; d8 < 8; ++d8) { const h16x8 kv = kp[d8];
#pragma unroll
                for (int x = 0; x < 8; ++x) a += qr[w][d8 * 8 + x] * (float)kv[x]; }
            s = a * 0.125f; }
        sc[w][i * 64 + lane] = s; mx = fmaxf(mx, s); }
    mx = wave_max(mx); sm = 0.f;
    for (int i = 0; i < 16; ++i) { const float s = sc[w][i * 64 + lane]; const float p = (s == -INFINITY) ? 0.f : __expf(s - mx); sc[w][i * 64 + lane] = p; sm += p; }
    sm = wave_sum(sm);
    float o_s = 0.f;
    for (int i = 0; i < 16; ++i) { const int kb = sel[i] * 64; const h16* vp = h + ((size_t)b * T + kb) * INP + C_NVS + g * 64 + lane;
        if (kb <= t) { const int nk = min(64, t - kb + 1);
            for (int kk = 0; kk < nk; ++kk) o_s += sc[w][i * 64 + kk] * (float)vp[(size_t)kk * INP]; } }
    o_s /= sm;
    mx = -INFINITY;
    for (int i = 0; i < 8; ++i) { const int key = t - 511 + i * 64 + lane; float s = -INFINITY;
        if (key >= 0) { const h16x8* kp = (const h16x8*)(h + ((size_t)b * T + key) * INP + C_NKW + g * 64); float a = 0.f;
#pragma unroll
            for (int d8 = 0; d8 < 8; ++d8) { const h16x8 kv = kp[d8];
#pragma unroll
                for (int x = 0; x < 8; ++x) a += qr[w][d8 * 8 + x] * (float)kv[x]; }
            s = a * 0.125f; }
        sc[w][i * 64 + lane] = s; mx = fmaxf(mx, s); }
    mx = wave_max(mx); sm = 0.f;
    for (int i = 0; i < 8; ++i) { const float s = sc[w][i * 64 + lane]; const float p = (s == -INFINITY) ? 0.f : __expf(s - mx); sc[w][i * 64 + lane] = p; sm += p; }
    sm = wave_sum(sm);
    float o_w = 0.f;
    { const int k0 = max(0, t - 511); const h16* vp = h + ((size_t)b * T) * INP + C_NVW + g * 64 + lane;
        for (int key = k0; key <= t; ++key) o_w += sc[w][key - (t - 511)] * (float)vp[(size_t)key * INP]; }
    o_w /= sm;
    const float g0 = sigmf((float)h[m * INP + C_NG + hh * 3 + 0]), g1 = sigmf((float)h[m * INP + C_NG + hh * 3 + 1]), g2 = sigmf((float)h[m * INP + C_NG + hh * 3 + 2]);
    mix[m * D + 512 + hh * 64 + lane] = (h16)(g0 * o_c + g1 * o_s + g2 * o_w);
}

__global__ void __launch_bounds__(256) k_ln(const float* __restrict__ in, const float* __restrict__ gam, const float* __restrict__ bet, float* __restrict__ o32, h16* __restrict__ o16) {
    const int lane = threadIdx.x & 63; const int row = blockIdx.x * 4 + (threadIdx.x >> 6);
    const f32x4* xr = (const f32x4*)(in + (size_t)row * D) + lane;
    f32x4 v[4]; float s = 0.f;
#pragma unroll
    for (int j = 0; j < 4; ++j) { v[j] = xr[64 * j]; s += (v[j][0] + v[j][1]) + (v[j][2] + v[j][3]); }
    const float mean = wave_sum(s) * (1.f / D); float s2 = 0.f;
#pragma unroll
    for (int j = 0; j < 4; ++j) { v[j] = v[j] - mean; s2 += (v[j][0] * v[j][0] + v[j][1] * v[j][1]) + (v[j][2] * v[j][2] + v[j][3] * v[j][3]); }
    const float rstd = rsqrtf(wave_sum(s2) * (1.f / D) + LN_EPS);
#pragma unroll
    for (int j = 0; j < 4; ++j) { const f32x4 gg = ((const f32x4*)gam)[lane + 64 * j], bb = ((const f32x4*)bet)[lane + 64 * j]; const f32x4 o = v[j] * rstd * gg + bb;
        ((f32x4*)(o32 + (size_t)row * D))[lane + 64 * j] = o;
        if (o16) { u32x2 w; w.x = pg8::cvt_pk_f16(o[0], o[1]); w.y = pg8::cvt_pk_f16(o[2], o[3]); ((u32x2*)(o16 + (size_t)row * D))[lane + 64 * j] = w; } }
}

__global__ void __launch_bounds__(256) k_xattn(const h16* __restrict__ qx, const h16* __restrict__ kvm, h16* __restrict__ ox) {
    __shared__ float q[1024]; __shared__ float p[4][256];
    const int m = blockIdx.x, b = m >> 13, tid = threadIdx.x;
    for (int i = tid; i < 1024; i += 256) q[i] = (float)qx[(size_t)m * D + i];
    __syncthreads();
    { const h16x8* kp = (const h16x8*)(kvm + (size_t)(b * MEML + tid) * 2048);
        for (int hh = 0; hh < 4; ++hh) { float a = 0.f;
            for (int d8 = 0; d8 < 32; ++d8) { const h16x8 kv = kp[hh * 32 + d8];
#pragma unroll
                for (int x = 0; x < 8; ++x) a += q[hh * 256 + d8 * 8 + x] * (float)kv[x]; }
            p[hh][tid] = a * 0.0625f; } }
    __syncthreads();
    { const int w = tid >> 6, lane = tid & 63; float v[4]; float mx = -INFINITY;
#pragma unroll
        for (int i = 0; i < 4; ++i) { v[i] = p[w][lane + 64 * i]; mx = fmaxf(mx, v[i]); }
        mx = wave_max(mx); float sm = 0.f;
#pragma unroll
        for (int i = 0; i < 4; ++i) { v[i] = __expf(v[i] - mx); sm += v[i]; }
        sm = wave_sum(sm); const float is = 1.f / sm;
#pragma unroll
        for (int i = 0; i < 4; ++i) p[w][lane + 64 * i] = v[i] * is; }
    __syncthreads();
    { const h16* vp = kvm + (size_t)(b * MEML) * 2048 + 1024 + tid;
        for (int hh = 0; hh < 4; ++hh) { float a = 0.f;
            for (int mm = 0; mm < 256; ++mm) a += p[hh][mm] * (float)vp[(size_t)mm * 2048 + hh * 256];
            ox[(size_t)m * D + hh * 256 + tid] = (h16)a; } }
}

__global__ void __launch_bounds__(256) k_router(const float* __restrict__ x2, const float* __restrict__ wr, const float* __restrict__ rbias, int* __restrict__ tope, float* __restrict__ topw) {
    const int lane = threadIdx.x & 63; const int m = blockIdx.x * 4 + (threadIdx.x >> 6);
    const float* xr = x2 + (size_t)m * D; float acc = 0.f;
    for (int k = 0; k < D; k += 4) { const f32x4 xv = *(const f32x4*)(xr + k);
        acc += xv[0] * wr[(k + 0) * 64 + lane]; acc += xv[1] * wr[(k + 1) * 64 + lane]; acc += xv[2] * wr[(k + 2) * 64 + lane]; acc += xv[3] * wr[(k + 3) * 64 + lane]; }
    const float score = 1.f / (1.f + expf(-acc)); const float biased = score + rbias[lane];
    float m1 = biased; m1 = fmaxf(m1, __shfl_xor(m1, 1)); m1 = fmaxf(m1, __shfl_xor(m1, 2)); m1 = fmaxf(m1, __shfl_xor(m1, 4));
    int am = (biased == m1) ? lane : 999; am = min(am, __shfl_xor(am, 1)); am = min(am, __shfl_xor(am, 2)); am = min(am, __shfl_xor(am, 4));
    float m2 = (lane == am) ? -INFINITY : biased; m2 = fmaxf(m2, __shfl_xor(m2, 1)); m2 = fmaxf(m2, __shfl_xor(m2, 2)); m2 = fmaxf(m2, __shfl_xor(m2, 4));
    const float gs = m1 + m2;
    int cnt = 0;
#pragma unroll
    for (int gq = 0; gq < 8; ++gq) { const float o = __shfl(gs, gq * 8); cnt += (o > gs) ? 1 : 0; }
    const float masked = (cnt <= 3) ? biased : NEGF;
    int rank = 0;
    for (int e2 = 0; e2 < 64; ++e2) { const float o = __shfl(masked, e2); rank += (o > masked || (o == masked && e2 < lane)) ? 1 : 0; }
    const bool selq = rank < 8;
    const float wsum = wave_sum(selq ? score : 0.f);
    if (selq) { tope[(size_t)m * 8 + rank] = lane; topw[(size_t)m * 8 + rank] = score / wsum * 2.5f; }
}

__global__ void __launch_bounds__(256) k_moe(const float* __restrict__ x2, const int* __restrict__ tope, const float* __restrict__ topw, const float* __restrict__ wg, const float* __restrict__ wu, const float* __restrict__ wd,
                                            const float* __restrict__ sg, const float* __restrict__ su, const float* __restrict__ sd, const float* __restrict__ gam, const float* __restrict__ bet, float* __restrict__ out) {
    __shared__ float xs[1024]; __shared__ float hd[256]; __shared__ float red[8];
    const int m = blockIdx.x, tid = threadIdx.x;
    for (int i = tid; i < 1024; i += 256) xs[i] = x2[(size_t)m * D + i];
    __syncthreads();
    float acc[4] = {0.f, 0.f, 0.f, 0.f};
    for (int kx = 0; kx < 9; ++kx) {
        const float* G; const float* U; const float* Dn; float wt;
        if (kx < 8) { const int e = tope[(size_t)m * 8 + kx]; wt = topw[(size_t)m * 8 + kx]; G = wg + (size_t)e * D * EFF; U = wu + (size_t)e * D * EFF; Dn = wd + (size_t)e * EFF * D; }
        else { wt = 1.f; G = sg; U = su; Dn = sd; }
        float a = 0.f, u = 0.f;
        for (int k = 0; k < D; ++k) { const float xv = xs[k]; a += xv * G[(size_t)k * EFF + tid]; u += xv * U[(size_t)k * EFF + tid]; }
        hd[tid] = siluf(a) * u * wt;
        __syncthreads();
        for (int j = 0; j < EFF; ++j) { const float hv = hd[j]; const float* dr = Dn + (size_t)j * D + tid;
            acc[0] += hv * dr[0]; acc[1] += hv * dr[256]; acc[2] += hv * dr[512]; acc[3] += hv * dr[768]; }
        __syncthreads();
    }
    float v[4]; float s = 0.f;
#pragma unroll
    for (int i = 0; i < 4; ++i) { v[i] = DN_ALPHA * xs[tid + 256 * i] + acc[i]; s += v[i]; }
    s = wave_sum(s); if ((tid & 63) == 0) red[tid >> 6] = s; __syncthreads();
    const float mean = (red[0] + red[1] + red[2] + red[3]) * (1.f / D); float s2 = 0.f;
#pragma unroll
    for (int i = 0; i < 4; ++i) { v[i] -= mean; s2 += v[i] * v[i]; }
    s2 = wave_sum(s2); if ((tid & 63) == 0) red[4 + (tid >> 6)] = s2; __syncthreads();
    const float rstd = rsqrtf((red[4] + red[5] + red[6] + red[7]) * (1.f / D) + LN_EPS);
#pragma unroll
    for (int i = 0; i < 4; ++i) out[(size_t)m * D + tid + 256 * i] = v[i] * rstd * gam[tid + 256 * i] + bet[tid + 256 * i];
}

extern "C" void kernel_launch(void* const* d_in, const int* in_sizes, int n_in, void* d_out, int out_size, void* d_ws, size_t ws_size, hipStream_t stream) {
    static int ready = 0;
    if (ready == 0) {
        if (n_in != 28 || in_sizes[0] != M * D || out_size != M * D || ws_size < WS_NEED) { fprintf(stderr, "kernel_launch: unexpected shapes (n_in %d, in0 %d, out %d, ws %zu)\n", n_in, n_in > 0 ? in_sizes[0] : -1, out_size, ws_size); ready = -1; return; }
        if (hipFuncSetAttribute((const void*)k_gemm_f16, hipFuncAttributeMaxDynamicSharedMemorySize, GEMM_LDS) != hipSuccess || hipFuncSetAttribute((const void*)k_gemm_res, hipFuncAttributeMaxDynamicSharedMemorySize, GEMM_LDS) != hipSuccess) {
            fprintf(stderr, "kernel_launch: hipFuncSetAttribute failed\n"); ready = -1; return; }
        ready = 1;
    }
    if (ready < 0) return;
    const float* x = (const float*)d_in[0]; const float* mem = (const float*)d_in[1]; const int* positions = (const int*)d_in[2];
    const float* w_in = (const float*)d_in[3]; const float* pe_k = (const float*)d_in[4]; const float* pe_v = (const float*)d_in[5];
    const float* w1k = (const float*)d_in[6]; const float* w2k = (const float*)d_in[7]; const float* w1v = (const float*)d_in[8]; const float* w2v = (const float*)d_in[9];
    const float* w_out = (const float*)d_in[10]; const float* ln1g = (const float*)d_in[11]; const float* ln1b = (const float*)d_in[12];
    const float* w_xq = (const float*)d_in[13]; const float* w_xkv = (const float*)d_in[14]; const float* w_xo = (const float*)d_in[15];
    const float* ln2g = (const float*)d_in[16]; const float* ln2b = (const float*)d_in[17]; const float* w_router = (const float*)d_in[18]; const float* rbias = (const float*)d_in[19];
    const float* w_gate = (const float*)d_in[20]; const float* w_up = (const float*)d_in[21]; const float* w_down = (const float*)d_in[22];
    const float* ws_gate = (const float*)d_in[23]; const float* ws_up = (const float*)d_in[24]; const float* ws_down = (const float*)d_in[25];
    const float* ln3g = (const float*)d_in[26]; const float* ln3b = (const float*)d_in[27];
    unsigned char* ws = (unsigned char*)d_ws; float* out = (float*)d_out;
    h16* WinT = (h16*)(ws + WS_WIN); h16* WoutT = (h16*)(ws + WS_WOUT); h16* WxqT = (h16*)(ws + WS_WXQ); h16* WxoT = (h16*)(ws + WS_WXO); h16* WxkvT = (h16*)(ws + WS_WXKV);
    h16* memh = (h16*)(ws + WS_MEMH); h16* kvm = (h16*)(ws + WS_KVM); float* kcmp = (float*)(ws + WS_KCMP); float* vcmp = (float*)(ws + WS_VCMP);
    int* tope = (int*)(ws + WS_TOPE); float* topw = (float*)(ws + WS_TOPW);
    h16* xh = (h16*)(ws + WS_XH); h16* mix = (h16*)(ws + WS_MIX); h16* ox = (h16*)(ws + WS_OX); h16* hb = (h16*)(ws + WS_H); h16* nqr = (h16*)(ws + WS_NQR);
    float* kvb = (float*)(ws + WS_KVB); float* prev = (float*)(ws + WS_PREV); float* pre = (float*)(ws + WS_PRE); float* x1 = (float*)(ws + WS_X1); h16* x1h = (h16*)(ws + WS_X1H);
    h16* qx = (h16*)(ws + WS_QX); float* x2 = (float*)(ws + WS_X2);
    const float lg0 = (float)std::log(1.0 - std::pow(2.0, -5.0)), lg1 = (float)std::log(1.0 - std::pow(2.0, -6.0)), lg2 = (float)std::log(1.0 - std::pow(2.0, -7.0)), lg3 = (float)std::log(1.0 - std::pow(2.0, -8.0));
    const int G = 256;
    hipLaunchKernelGGL(k_transpose, dim3(INP / 32, D / 32), dim3(256), 0, stream, w_in, D, INC, WinT, INP);
    hipLaunchKernelGGL(k_transpose, dim3(D / 32, D / 32), dim3(256), 0, stream, w_out, D, D, WoutT, D);
    hipLaunchKernelGGL(k_transpose, dim3(D / 32, D / 32), dim3(256), 0, stream, w_xq, D, D, WxqT, D);
    hipLaunchKernelGGL(k_transpose, dim3(D / 32, D / 32), dim3(256), 0, stream, w_xo, D, D, WxoT, D);
    hipLaunchKernelGGL(k_transpose, dim3(2 * D / 32, D / 32), dim3(256), 0, stream, w_xkv, D, 2 * D, WxkvT, 2 * D);
    hipLaunchKernelGGL(k_cvt, dim3(2048), dim3(256), 0, stream, x, xh, (size_t)M * D / 4);
    hipLaunchKernelGGL(k_cvt, dim3(256), dim3(256), 0, stream, mem, memh, (size_t)NB * MEML * D / 4);
    hipLaunchKernelGGL(k_gemm_f16, dim3(G), dim3(512), GEMM_LDS, stream, (const h16*)xh, (const h16*)WinT, hb, M, INP, D);
    hipLaunchKernelGGL(k_gemm_f16, dim3(G), dim3(512), GEMM_LDS, stream, (const h16*)memh, (const h16*)WxkvT, kvm, NB * MEML, 2 * D, D);
    hipLaunchKernelGGL(k_rope, dim3(M), dim3(256), 0, stream, hb, nqr, positions);
    hipLaunchKernelGGL(k_cmp, dim3(2 * NB * 511 * 2), dim3(256), 0, stream, (const h16*)hb, pe_k, pe_v, w1k, w2k, w1v, w2v, kcmp, vcmp);
    hipLaunchKernelGGL(k_ret_kv, dim3(NB * 4 * 64), dim3(256), 0, stream, (const h16*)hb, kvb, lg0, lg1, lg2, lg3);
    hipLaunchKernelGGL(k_ret_scan, dim3(16 * 16384 / 256), dim3(256), 0, stream, (const float*)kvb, prev, lg0, lg1, lg2, lg3);
    hipLaunchKernelGGL(k_ret_out, dim3(NB * 4 * 64 * 128), dim3(128), 0, stream, (const h16*)hb, (const float*)prev, mix, lg0, lg1, lg2, lg3);
    hipLaunchKernelGGL(k_nsa, dim3(NB * T * 2), dim3(256), 0, stream, (const h16*)hb, (const h16*)nqr, (const float*)kcmp, (const float*)vcmp, mix);
    hipLaunchKernelGGL(k_gemm_res, dim3(G), dim3(512), GEMM_LDS, stream, (const h16*)mix, (const h16*)WoutT, pre, x, M, D, D, DN_ALPHA);
    hipLaunchKernelGGL(k_ln, dim3(M / 4), dim3(256), 0, stream, (const float*)pre, ln1g, ln1b, x1, x1h);
    hipLaunchKernelGGL(k_gemm_f16, dim3(G), dim3(512), GEMM_LDS, stream, (const h16*)x1h, (const h16*)WxqT, qx, M, D, D);
    hipLaunchKernelGGL(k_xattn, dim3(M), dim3(256), 0, stream, (const h16*)qx, (const h16*)kvm, ox);
    hipLaunchKernelGGL(k_gemm_res, dim3(G), dim3(512), GEMM_LDS, stream, (const h16*)ox, (const h16*)WxoT, pre, (const float*)x1, M, D, D, DN_ALPHA);
    hipLaunchKernelGGL(k_ln, dim3(M / 4), dim3(256), 0, stream, (const float*)pre, ln2g, ln2b, x2, (h16*)nullptr);
    hipLaunchKernelGGL(k_router, dim3(M / 4), dim3(256), 0, stream, (const float*)x2, w_router, rbias, tope, topw);
    hipLaunchKernelGGL(k_moe, dim3(M), dim3(256), 0, stream, (const float*)x2, (const int*)tope, (const float*)topw, w_gate, w_up, w_down, ws_gate, ws_up, ws_down, ln3g, ln3b, out);
}
```

```cpp
#include <hip/hip_runtime.h>
#include <cstdio>
#include <cstdint>
#include <cmath>

typedef _Float16 h16;
typedef _Float16 h16x8 __attribute__((ext_vector_type(8)));
typedef _Float16 h16x2 __attribute__((ext_vector_type(2)));
typedef float f32x2 __attribute__((ext_vector_type(2)));
typedef float f32x4 __attribute__((ext_vector_type(4)));
typedef unsigned u32x4 __attribute__((ext_vector_type(4)));
typedef unsigned u32x2 __attribute__((ext_vector_type(2)));

constexpr int NB = 4, T = 8192, D = 1024, M = NB * T;
constexpr int INC = 3352, INP = 3584;
constexpr int C_RQ = 0, C_RK = 512, C_RV = 1024, C_RG = 1536, C_NQ = 2048, C_NKC = 2560, C_NVC = 2688, C_NKS = 2816, C_NVS = 2944, C_NKW = 3072, C_NVW = 3200, C_NG = 3328;
constexpr int MEML = 256;
constexpr int NE = 64, EFF = 256;
constexpr float LN_EPS = 1e-5f;
constexpr float DN_ALPHA = 1.189207115002721f;
constexpr float NEGF = -1e30f;

constexpr size_t MiB = 1u << 20;
constexpr size_t WS_WIN = 1 * MiB, WS_WOUT = 8 * MiB, WS_WXQ = 10 * MiB, WS_WXO = 12 * MiB, WS_WXKV = 14 * MiB, WS_MEMH = 18 * MiB, WS_KVM = 20 * MiB;
constexpr size_t WS_KCMP = 24 * MiB, WS_VCMP = 25 * MiB, WS_TOPE = 26 * MiB, WS_TOPW = 27 * MiB;
constexpr size_t WS_XH = 32 * MiB, WS_MIX = 32 * MiB, WS_OX = 32 * MiB;
constexpr size_t WS_H = 96 * MiB, WS_NQR = 320 * MiB, WS_KVB = 352 * MiB, WS_PREV = 416 * MiB;
constexpr size_t WS_PRE = 96 * MiB, WS_X1 = 224 * MiB, WS_X1H = 352 * MiB, WS_QX = 416 * MiB, WS_X2 = 352 * MiB;
constexpr size_t WS_NEED = 480 * MiB;

namespace pg8 {
#define PG8_LAS __attribute__((address_space(3)))
typedef short s16x8 __attribute__((ext_vector_type(8)));
constexpr int BM = 256, BK = 64, HALF = 128, HTB = HALF * BK * 2, STAGE_BYTES = 8 * HTB, NXCD = 8, WGM = 8;
__host__ __device__ __forceinline__ int lds_byte(int r, int c) { const int st = (r >> 4) * 2 + (c >> 5), rr = r & 15, cc = c & 31, ob = rr * 64 + cc * 2; return st * 1024 + (ob ^ (((ob >> 9) & 1) << 5)); }
__host__ __device__ __forceinline__ void stage_rc(int b, int& R, int& C) { const int st = b / 1024, sb = b % 1024, swz = sb ^ (((sb >> 9) & 1) << 5); R = (st >> 1) * 16 + swz / 64; C = (st & 1) * 32 + (swz % 64) / 2; }
__host__ __device__ __forceinline__ int perm32(int rho) { const int n = rho >> 4, i = rho & 15; return 8 * (i >> 2) + 4 * n + (i & 3); }
struct Unit { int pm, pn; };
struct Gemm { const h16* A; const h16* Bt; int M, N, K; };
struct StaticOrder {
    int nM, nN, nwg, G, c;
    __host__ __device__ void init(int M_, int N_, int G_, int c_) { nM = M_ / BM; nN = N_ / BM; nwg = nM * nN; G = G_; c = c_; }
    __host__ __device__ bool next(int i, Unit& u) const {
        const long L = (long)i * G + c; if (L >= nwg) return false;
        int wgid = (int)L; { const int q = nwg / NXCD, r = nwg % NXCD, xcd = wgid % NXCD, off = wgid / NXCD; wgid = (xcd < r ? xcd * (q + 1) : r * (q + 1) + (xcd - r) * q) + off; }
        const int nig = WGM * nN, gid = wgid / nig, fm = gid * WGM, gsz = (nM - fm) < WGM ? (nM - fm) : WGM;
        u.pm = fm + ((wgid % nig) % gsz); u.pn = (wgid % nig) / gsz; return true;
    }
    __device__ __forceinline__ void a_ready(const Unit&) const {}
    __device__ __forceinline__ void done(const Unit&) const {}
};
__device__ __forceinline__ unsigned cvt_pk_f16(float lo, float hi) { f32x2 v = {lo, hi}; h16x2 h = __builtin_convertvector(v, h16x2); return __builtin_bit_cast(unsigned, h); }

struct EpiF16 {
    static constexpr bool PERM = true, AFTER_DRAIN = false;
    h16* O; int ldc;
    __device__ __forceinline__ void operator()(const f32x4 (&acc)[2][2][4][2], const Unit& u, int wr, int wc, int fr, int fq) const {
        const int row0 = u.pm * BM + wr * 64 + fr; const int col0 = u.pn * BM + wc * 32 + 8 * fq;
#pragma unroll
        for (int ai = 0; ai < 2; ++ai)
#pragma unroll
            for (int m = 0; m < 4; ++m) { h16* rowp = O + (size_t)(row0 + ai * HALF + m * 16) * ldc + col0;
#pragma unroll
                for (int bj = 0; bj < 2; ++bj) { const f32x4 v0 = acc[ai][bj][m][0], v1 = acc[ai][bj][m][1];
                    u32x4 w; w.x = cvt_pk_f16(v0[0], v0[1]); w.y = cvt_pk_f16(v0[2], v0[3]); w.z = cvt_pk_f16(v1[0], v1[1]); w.w = cvt_pk_f16(v1[2], v1[3]);
                    *(u32x4*)(rowp + bj * HALF) = w; } }
    }
};
struct EpiResF32 {
    static constexpr bool PERM = false, AFTER_DRAIN = false;
    float* C; const float* R; int ldc; float alpha;
    __device__ __forceinline__ void operator()(const f32x4 (&acc)[2][2][4][2], const Unit& u, int wr, int wc, int fr, int fq) const {
        const int row0 = u.pm * BM + wr * 64 + fr, col0 = u.pn * BM + wc * 32 + 4 * fq;
#pragma unroll
        for (int ai = 0; ai < 2; ++ai)
#pragma unroll
            for (int m = 0; m < 4; ++m) { const size_t off = (size_t)(row0 + ai * HALF + m * 16) * ldc + col0;
#pragma unroll
                for (int bj = 0; bj < 2; ++bj)
#pragma unroll
                    for (int n = 0; n < 2; ++n) { const f32x4 r = *(const f32x4*)(R + off + bj * HALF + n * 16); *(f32x4*)(C + off + bj * HALF + n * 16) = r * alpha + acc[ai][bj][m][n]; } }
    }
};

template <class Epi, class Sched, bool ALIGN_EPI = false, bool SP2 = false>
__device__ __forceinline__ void gemm_phase(PG8_LAS unsigned char* lds, const Gemm g, const Sched& S, const Epi& E) {
    const int tid = threadIdx.x, wid = __builtin_amdgcn_readfirstlane(tid >> 6), lane = tid & 63, wr = wid >> 2, wc = wid & 3, fr = lane & 15, fq = lane >> 4;
    const int K = g.K, nt = K / BK;
    unsigned voffA[2], voffB[2];
#pragma unroll
    for (int i = 0; i < 2; ++i) { int R, C; stage_rc(tid * 16 + i * 8192, R, C); const int Rb = Epi::PERM ? ((R & ~31) + perm32(R & 31)) : R;
        voffA[i] = (unsigned)(R * K + C) * 2u; voffB[i] = (unsigned)(Rb * K + C) * 2u; }
    const size_t kstep = (size_t)(BK * 2);
    const size_t hstep = (size_t)HALF * K * 2;
    const size_t tstep = 2 * hstep;
    const unsigned ldsw = (unsigned)wid * 1024u;
    const int aoff = lds_byte(wr * 64 + fr, fq * 8), boff = lds_byte(wc * 32 + fr, fq * 8);
#define PG8_SA(b, h) (((b) * 2 + (h)) * HTB)
#define PG8_SB(b, h) ((4 + (b) * 2 + (h)) * HTB)
#define PG8_STAGE(bufoff, gbase, voff) do { _Pragma("unroll") for (int _i = 0; _i < 2; ++_i) \
        __builtin_amdgcn_global_load_lds((const unsigned*)((const char*)(gbase) + (voff)[_i]), (PG8_LAS unsigned*)(lds + (bufoff) + ldsw + _i * 8192), 16, 0, 0); } while (0)
#define PG8_LDA(dst, b, h) do { _Pragma("unroll") for (int m = 0; m < 4; ++m) _Pragma("unroll") for (int k = 0; k < 2; ++k) dst[m][k] = *(const PG8_LAS s16x8*)(lds + PG8_SA(b, h) + aoff + m * 2048 + k * 1024); } while (0)
#define PG8_LDB(dst, b, h) do { _Pragma("unroll") for (int n = 0; n < 2; ++n) _Pragma("unroll") for (int k = 0; k < 2; ++k) dst[n][k] = *(const PG8_LAS s16x8*)(lds + PG8_SB(b, h) + boff + n * 2048 + k * 1024); } while (0)
#define PG8_MMA(ai, bj, At, Bt) do { __builtin_amdgcn_s_setprio(1); _Pragma("unroll") for (int m = 0; m < 4; ++m) _Pragma("unroll") for (int n = 0; n < 2; ++n) _Pragma("unroll") for (int k = 0; k < 2; ++k) \
        acc[ai][bj][m][n] = __builtin_amdgcn_mfma_f32_16x16x32_f16(__builtin_bit_cast(h16x8, Bt[n][k]), __builtin_bit_cast(h16x8, At[m][k]), acc[ai][bj][m][n], 0, 0, 0); __builtin_amdgcn_s_setprio(0); } while (0)
#define PG8_WAIT_V(n) asm volatile("s_waitcnt vmcnt(" #n ")" ::: "memory")
#define PG8_WAIT_L(n) asm volatile("s_waitcnt lgkmcnt(" #n ")" ::: "memory")
#define PG8_BAR __builtin_amdgcn_s_barrier()
#define PG8_SCHED __builtin_amdgcn_sched_barrier(0)
    Unit cur, nxt; int ui = 0;
    if (!S.next(0, cur)) return;
    f32x4 acc[2][2][4][2];
#pragma unroll
    for (int a = 0; a < 2; ++a)
#pragma unroll
        for (int b = 0; b < 2; ++b)
#pragma unroll
            for (int m = 0; m < 4; ++m)
#pragma unroll
                for (int n = 0; n < 2; ++n) acc[a][b][m][n] = (f32x4){0.f, 0.f, 0.f, 0.f};
    s16x8 At[4][2], B0[2][2], B1[2][2];
    const char* cA = (const char*)g.A + (size_t)cur.pm * tstep; const char* cB = (const char*)g.Bt + (size_t)cur.pn * tstep;
    S.a_ready(cur);
    if constexpr (SP2) {
        PG8_STAGE(PG8_SB(0, 0), cB, voffB); PG8_STAGE(PG8_SB(0, 1), cB + hstep, voffB); PG8_STAGE(PG8_SA(0, 0), cA, voffA); PG8_STAGE(PG8_SA(0, 1), cA + hstep, voffA);
        if (wr == 1) PG8_BAR;
        PG8_WAIT_V(2); PG8_BAR;
        PG8_STAGE(PG8_SB(1, 0), cB + kstep, voffB); PG8_STAGE(PG8_SA(1, 0), cA + kstep, voffA); PG8_STAGE(PG8_SB(1, 1), cB + hstep + kstep, voffB);
        PG8_WAIT_V(6); PG8_BAR;
    } else {
        PG8_STAGE(PG8_SB(0, 0), cB, voffB); PG8_STAGE(PG8_SA(0, 0), cA, voffA); PG8_STAGE(PG8_SB(0, 1), cB + hstep, voffB); PG8_STAGE(PG8_SA(0, 1), cA + hstep, voffA);
        if (wr == 1) PG8_BAR;
        PG8_WAIT_V(4); PG8_BAR;
        PG8_STAGE(PG8_SB(1, 0), cB + kstep, voffB); PG8_STAGE(PG8_SA(1, 0), cA + kstep, voffA); PG8_STAGE(PG8_SB(1, 1), cB + hstep + kstep, voffB);
        PG8_WAIT_V(6); PG8_BAR;
    }
    for (;;) {
        const bool has_next = S.next(ui + 1, nxt);
        const char* nA = has_next ? (const char*)g.A + (size_t)nxt.pm * tstep : cA; const char* nB = has_next ? (const char*)g.Bt + (size_t)nxt.pn * tstep : cB;
        for (int t = 0; t < nt; t += 2) {
            const bool last = (t == nt - 2);
            const char* a1 = cA + (size_t)(t + 1) * kstep;
            const char* a2 = last ? nA : cA + (size_t)(t + 2) * kstep; const char* b2 = last ? nB : cB + (size_t)(t + 2) * kstep;
            const char* a3 = a2 + kstep; const char* b3 = b2 + kstep;
            if (last && has_next) S.a_ready(nxt);
            if constexpr (SP2) {
            PG8_LDB(B0, 0, 0); PG8_LDB(B1, 0, 1); PG8_SCHED; PG8_LDA(At, 0, 0); PG8_STAGE(PG8_SA(1, 1), a1 + hstep, voffA);
            PG8_WAIT_V(8); PG8_WAIT_L(0); PG8_BAR; PG8_MMA(0, 0, At, B0); PG8_MMA(0, 1, At, B1); PG8_BAR; PG8_SCHED;
            PG8_LDA(At, 0, 1); PG8_STAGE(PG8_SB(0, 0), b2, voffB); PG8_STAGE(PG8_SB(0, 1), b2 + hstep, voffB); PG8_STAGE(PG8_SA(0, 0), a2, voffA);
            PG8_WAIT_V(8); PG8_WAIT_L(0); PG8_BAR; PG8_MMA(1, 0, At, B0); PG8_MMA(1, 1, At, B1); PG8_BAR; PG8_SCHED;
            PG8_LDB(B0, 1, 0); PG8_LDB(B1, 1, 1); PG8_SCHED; PG8_LDA(At, 1, 0); PG8_STAGE(PG8_SA(0, 1), a2 + hstep, voffA);
            PG8_WAIT_V(8); PG8_WAIT_L(0); PG8_BAR; PG8_MMA(0, 0, At, B0); PG8_MMA(0, 1, At, B1); PG8_BAR; PG8_SCHED;
            PG8_LDA(At, 1, 1); PG8_STAGE(PG8_SB(1, 0), b3, voffB); PG8_STAGE(PG8_SB(1, 1), b3 + hstep, voffB); PG8_STAGE(PG8_SA(1, 0), a3, voffA);
            PG8_WAIT_V(8); PG8_WAIT_L(0); PG8_BAR; PG8_MMA(1, 0, At, B0); PG8_MMA(1, 1, At, B1); PG8_BAR; PG8_SCHED;
            } else {
            PG8_LDB(B0, 0, 0); PG8_SCHED; PG8_LDA(At, 0, 0); PG8_STAGE(PG8_SA(1, 1), a1 + hstep, voffA);
            PG8_WAIT_L(8); PG8_BAR; PG8_WAIT_L(0); PG8_MMA(0, 0, At, B0); PG8_BAR; PG8_SCHED;
            PG8_LDB(B1, 0, 1); PG8_STAGE(PG8_SB(0, 0), b2, voffB);
            PG8_BAR; PG8_WAIT_L(0); PG8_MMA(0, 1, At, B1); PG8_BAR;
            PG8_LDA(At, 0, 1); PG8_STAGE(PG8_SA(0, 0), a2, voffA);
            PG8_BAR; PG8_WAIT_L(0); PG8_MMA(1, 0, At, B0); PG8_BAR; PG8_SCHED;
            PG8_STAGE(PG8_SB(0, 1), b2 + hstep, voffB);
            PG8_WAIT_V(6); PG8_BAR; PG8_MMA(1, 1, At, B1); PG8_BAR;
            PG8_LDB(B0, 1, 0); PG8_SCHED; PG8_LDA(At, 1, 0); PG8_STAGE(PG8_SA(0, 1), a2 + hstep, voffA);
            PG8_WAIT_L(8); PG8_BAR; PG8_WAIT_L(0); PG8_MMA(0, 0, At, B0); PG8_BAR; PG8_SCHED;
            PG8_LDB(B1, 1, 1); PG8_STAGE(PG8_SB(1, 0), b3, voffB);
            PG8_BAR; PG8_WAIT_L(0); PG8_MMA(0, 1, At, B1); PG8_BAR;
            PG8_LDA(At, 1, 1); PG8_STAGE(PG8_SA(1, 0), a3, voffA);
            PG8_BAR; PG8_WAIT_L(0); PG8_MMA(1, 0, At, B0); PG8_BAR; PG8_SCHED;
            PG8_STAGE(PG8_SB(1, 1), b3 + hstep, voffB);
            PG8_WAIT_V(6); PG8_BAR; PG8_MMA(1, 1, At, B1); PG8_BAR;
            }
        }
        if constexpr (ALIGN_EPI) { if (wr == 0) PG8_BAR; }
        if constexpr (!Epi::AFTER_DRAIN) { E(acc, cur, wr, wc, fr, fq); S.done(cur); }
        if (!has_next) break;
#pragma unroll
        for (int a = 0; a < 2; ++a)
#pragma unroll
            for (int b = 0; b < 2; ++b)
#pragma unroll
                for (int m = 0; m < 4; ++m)
#pragma unroll
                    for (int n = 0; n < 2; ++n) acc[a][b][m][n] = (f32x4){0.f, 0.f, 0.f, 0.f};
        cur = nxt; cA = nA; cB = nB; ++ui;
        if constexpr (ALIGN_EPI) { if (wr == 1) PG8_BAR; }
    }
    PG8_WAIT_V(0);
    if constexpr (!ALIGN_EPI) { if (wr == 0) PG8_BAR; }
    PG8_BAR;
#undef PG8_SA
#undef PG8_SB
#undef PG8_STAGE
#undef PG8_LDA
#undef PG8_LDB
#undef PG8_MMA
#undef PG8_WAIT_V
#undef PG8_WAIT_L
#undef PG8_BAR
#undef PG8_SCHED
}
}


#include <hip/hip_cooperative_groups.h>
namespace cg = cooperative_groups;
constexpr int NTHR = 512;
constexpr int LDS_BYTES = 147456;
#define LAS __attribute__((address_space(3)))

struct Params {
    const float *x, *mem; const int* positions;
    const float *w_in, *pe_k, *pe_v, *w1k, *w2k, *w1v, *w2v, *w_out, *ln1g, *ln1b, *w_xq, *w_xkv, *w_xo, *ln2g, *ln2b, *w_router, *rbias, *w_gate, *w_up, *w_down, *ws_gate, *ws_up, *ws_down, *ln3g, *ln3b;
    float* out; unsigned char* ws;
    float lg[4];
    int ph_lo, ph_hi;
};

__device__ __forceinline__ float wave_sum(float v) {
#pragma unroll
    for (int o = 1; o < 64; o <<= 1) v += __shfl_xor(v, o);
    return v;
}
__device__ __forceinline__ float wave_max(float v) {
#pragma unroll
    for (int o = 1; o < 64; o <<= 1) v = fmaxf(v, __shfl_xor(v, o));
    return v;
}
__device__ __forceinline__ float siluf(float v) { return v / (1.f + __expf(-v)); }
__device__ __forceinline__ float sigmf(float v) { return 1.f / (1.f + __expf(-v)); }

__device__ __forceinline__ void b_transpose_tile(const float* __restrict__ W, int K, int N, h16* __restrict__ WT, int Npad, int tile, float* tl, int lt) {
    const int ntn = Npad / 32; const int n0 = (tile % ntn) * 32, k0 = (tile / ntn) * 32, tx = lt & 31, ty = lt >> 5;
    for (int i = ty; i < 32; i += 8) { const int k = k0 + i, n = n0 + tx; tl[i * 33 + tx] = (n < N) ? W[(size_t)k * N + n] : 0.f; }
    __syncthreads();
    for (int i = ty; i < 32; i += 8) { const int n = n0 + i, k = k0 + tx; WT[(size_t)n * K + k] = (h16)tl[tx * 33 + i]; }
    __syncthreads();
}
__device__ __forceinline__ void b_cvt(const float* __restrict__ x, h16* __restrict__ o, size_t n4) {
    for (size_t i = (size_t)blockIdx.x * NTHR + threadIdx.x; i < n4; i += (size_t)gridDim.x * NTHR) {
        const f32x4 v = ((const f32x4*)x)[i]; u32x2 w; w.x = pg8::cvt_pk_f16(v[0], v[1]); w.y = pg8::cvt_pk_f16(v[2], v[3]); ((u32x2*)o)[i] = w; }
}

__device__ __forceinline__ void b_rope(h16* __restrict__ h, h16* __restrict__ nqr, const int* __restrict__ positions, int m, int j) {
    h16* hr = h + (size_t)m * INP;
    const float pos = (float)positions[m];
    {   const int hd = j >> 6, jj = j & 63;
        const float inv = (float)pow(10000.0, -(double)jj / 64.0);
        const float ang = pos * inv; double sd, cd; sincos((double)ang, &sd, &cd); const float c = (float)cd, s = (float)sd;
        const int o1 = hd * 128 + jj, o2 = o1 + 64;
        const float q1 = (float)hr[C_RQ + o1], q2 = (float)hr[C_RQ + o2];
        hr[C_RQ + o1] = (h16)(q1 * c - q2 * s); hr[C_RQ + o2] = (h16)(q2 * c + q1 * s);
        const float k1 = (float)hr[C_RK + o1], k2 = (float)hr[C_RK + o2]; const float sc = 0.08838834764831845f;
        hr[C_RK + o1] = (h16)((k1 * c - k2 * s) * sc); hr[C_RK + o2] = (h16)((k2 * c + k1 * s) * sc);
    }
    if (j < 64 + 16 + 16) {
        const int jj = j & 7;
        const float inv = (float)pow(500000.0, -(double)jj / 8.0);
        const float ang = pos * inv; double sd, cd; sincos((double)ang, &sd, &cd); const float c = (float)cd, s = (float)sd;
        if (j < 64) { const int hd = j >> 3; const int o1 = hd * 64 + jj, o2 = o1 + 8;
            const float q1 = (float)hr[C_NQ + o1], q2 = (float)hr[C_NQ + o2];
            nqr[(size_t)m * 512 + o1] = (h16)(q1 * c - q2 * s); nqr[(size_t)m * 512 + o2] = (h16)(q2 * c + q1 * s);
        } else { const int jx = j - 64; const int which = jx >> 4, g = (jx >> 3) & 1; const int base = (which ? C_NKW : C_NKS) + g * 64 + jj;
            const float k1 = (float)hr[base], k2 = (float)hr[base + 8];
            hr[base] = (h16)(k1 * c - k2 * s); hr[base + 8] = (h16)(k2 * c + k1 * s); }
    }
    for (int i = j; i < 8 * 48; i += 256) { const int hd = i / 48, d = 16 + i % 48; nqr[(size_t)m * 512 + hd * 64 + d] = hr[C_NQ + hd * 64 + d]; }
}

__device__ __forceinline__ void b_cmp(const Params& p, const h16* __restrict__ h, float* __restrict__ kcmp, float* __restrict__ vcmp, int item, float* sl, int lt) {
    float* a = sl; float* hid = sl + 2048;
    int id = item; const int g = id & 1; id >>= 1; const int c = id % 511; id /= 511; const int b = id & 3; const int kv = id >> 2;
    const float* pe = kv ? p.pe_v : p.pe_k; const float* w1 = kv ? p.w1v : p.w1k; const float* w2 = kv ? p.w2v : p.w2k; float* out = kv ? vcmp : kcmp;
    const int colb = (kv ? C_NVC : C_NKC) + g * 64;
    for (int i = lt; i < 2048; i += 256) { const int l = i >> 6, d = i & 63; a[i] = (float)h[(size_t)(b * T + 16 * c + l) * INP + colb + d] + pe[l * 64 + d]; }
    __syncthreads();
    { const int j = lt; float acc = 0.f;
        for (int k = 0; k < 2048; ++k) acc += a[k] * w1[(size_t)k * 256 + j];
        hid[j] = siluf(acc); }
    __syncthreads();
    if (lt < 64) { const int e = lt; float acc = 0.f;
        for (int j = 0; j < 256; ++j) acc += hid[j] * w2[j * 64 + e];
        out[((size_t)(b * 512 + c) * 2 + g) * 64 + e] = acc; }
    __syncthreads();
}

__device__ __forceinline__ void b_ret_kv(const Params& p, const h16* __restrict__ h, float* __restrict__ kvb, int id, int lt) {
    const int n = id & 63, hd = (id >> 6) & 3, b = id >> 8;
    const float lg = p.lg[hd];
    const int d = lt >> 1, e0 = (lt & 1) * 64;
    float acc[64];
#pragma unroll
    for (int i = 0; i < 64; ++i) acc[i] = 0.f;
    const h16* base = h + (size_t)(b * T + n * 128) * INP;
    for (int j = 0; j < 128; ++j) {
        const float kd = (float)base[(size_t)j * INP + C_RK + hd * 128 + d] * __expf(lg * (float)(127 - j));
        const h16x8* vp = (const h16x8*)(base + (size_t)j * INP + C_RV + hd * 128 + e0);
#pragma unroll
        for (int i8 = 0; i8 < 8; ++i8) { const h16x8 v = vp[i8];
#pragma unroll
            for (int i = 0; i < 8; ++i) acc[i8 * 8 + i] += kd * (float)v[i]; }
    }
    float* o = kvb + ((size_t)id * 128 + d) * 128 + e0;
#pragma unroll
    for (int i = 0; i < 64; ++i) o[i] = acc[i];
}
__device__ __forceinline__ void b_ret_scan(const Params& p, const float* __restrict__ kvb, float* __restrict__ prev) {
    for (int gid = blockIdx.x * NTHR + threadIdx.x; gid < 16 * 16384; gid += gridDim.x * NTHR) {
        const int de = gid & 16383, bh = gid >> 14; const float cd = __expf(p.lg[bh & 3] * 128.f);
        float st = 0.f;
        for (int n = 0; n < 64; ++n) { const size_t o = ((size_t)(bh * 64 + n) << 14) + de; prev[o] = st; st = st * cd + kvb[o]; }
    }
}
__device__ __forceinline__ void b_ret_out(const Params& p, const h16* __restrict__ h, const float* __restrict__ prev, h16* __restrict__ mix, int item, float* sl, int tid) {
    float* q = sl; float* s = sl + 128; float* red = sl + 256;
    int id = item; const int i = id & 127; id >>= 7; const int n = id & 63, hd = (id >> 6) & 3, b = id >> 8;
    const float lg = p.lg[hd];
    const size_t m = (size_t)b * T + n * 128 + i;
    q[tid] = (float)h[m * INP + C_RQ + hd * 128 + tid];
    __syncthreads();
    { const int j = tid; float acc = 0.f;
        if (j <= i) { const h16x8* kp = (const h16x8*)(h + ((size_t)b * T + n * 128 + j) * INP + C_RK + hd * 128);
#pragma unroll
            for (int d8 = 0; d8 < 16; ++d8) { const h16x8 kv = kp[d8];
#pragma unroll
                for (int x = 0; x < 8; ++x) acc += q[d8 * 8 + x] * (float)kv[x]; }
            acc *= __expf(lg * (float)(i - j)); }
        s[j] = acc; }
    __syncthreads();
    const int e = tid; float inner = 0.f, cross = 0.f;
    { const h16* vb = h + ((size_t)b * T + n * 128) * INP + C_RV + hd * 128 + e;
        for (int j = 0; j <= i; ++j) inner += s[j] * (float)vb[(size_t)j * INP];
        const float* pp = prev + ((size_t)((b * 4 + hd) * 64 + n) << 14) + e;
        for (int d = 0; d < 128; ++d) cross += q[d] * pp[d * 128];
        cross *= __expf(lg * (float)(i + 1)); }
    const float o = inner + cross;
    float sm = wave_sum(o); if ((tid & 63) == 0) red[tid >> 6] = sm; __syncthreads();
    const float mu = (red[0] + red[1]) * (1.f / 128.f); const float dv = o - mu;
    float sq = wave_sum(dv * dv); if ((tid & 63) == 0) red[2 + (tid >> 6)] = sq; __syncthreads();
    const float var = (red[2] + red[3]) * (1.f / 128.f);
    const float on = dv * rsqrtf(var + LN_EPS);
    const float gt = (float)h[m * INP + C_RG + hd * 128 + e];
    mix[m * D + hd * 128 + e] = (h16)(siluf(gt) * on);
    __syncthreads();
}

__device__ __forceinline__ void b_nsa(const h16* __restrict__ h, const h16* __restrict__ nqr, const float* __restrict__ kcmp, const float* __restrict__ vcmp, h16* __restrict__ mix, int item, float* sl, int tid) {
    float (*q)[64] = (float (*)[64])sl; float (*qr)[64] = (float (*)[64])(sl + 256); float (*sc)[1024] = (float (*)[1024])(sl + 512); float* impv = sl + 512 + 4096; int* sel = (int*)(sl + 512 + 4096 + 128);
    int id = item; const int g = id & 1; id >>= 1; const int t = id & (T - 1); const int b = id >> 13;
    const int w = tid >> 6, lane = tid & 63, hh = g * 4 + w; const size_t m = (size_t)b * T + t;
    q[w][lane] = (float)h[m * INP + C_NQ + hh * 64 + lane]; qr[w][lane] = (float)nqr[m * 512 + hh * 64 + lane];
    if (tid < 16) sel[tid] = 0;
    __syncthreads();
    const int ncv = (t >= 31) ? ((t - 31) >> 4) + 1 : 0;
    float mx = -INFINITY;
    for (int c = lane; c < 512; c += 64) { float s = -INFINITY;
        if (c < ncv) { const float* kp = kcmp + ((size_t)(b * 512 + c) * 2 + g) * 64; float a = 0.f;
#pragma unroll 16
            for (int d = 0; d < 64; ++d) a += q[w][d] * kp[d];
            s = a * 0.125f; }
        sc[w][c] = s; mx = fmaxf(mx, s); }
    mx = wave_max(mx);
    float sm = 0.f;
    for (int c = lane; c < 512; c += 64) { const float pp = (c < ncv) ? __expf(sc[w][c] - mx) : 0.f; sc[w][c] = pp; sm += pp; }
    sm = wave_sum(sm); const float isum = ncv > 0 ? 1.f / sm : 0.f;
    for (int c = lane; c < 512; c += 64) sc[w][c] *= isum;
    float o_c = 0.f;
    { const float* vp = vcmp + ((size_t)(b * 512) * 2 + g) * 64 + lane;
        for (int c = 0; c < ncv; ++c) o_c += sc[w][c] * vp[(size_t)c * 128]; }
    __syncthreads();
    const int cur = t >> 6;
    if (tid < 128) { const int s = tid; float v = 0.f;
        const int c0 = max(4 * s - 1, 0), c1 = min(4 * s + 3, 510);
        for (int c = c0; c <= c1; ++c) v += sc[0][c] + sc[1][c] + sc[2][c] + sc[3][c];
        if (s == 0 || s == cur || s == cur - 1) v = 1e9f;
        if (s > cur) v = NEGF;
        impv[s] = v; }
    __syncthreads();
    if (tid < 128) { const int s = tid; const float v = impv[s]; int rank = 0;
        for (int s2 = 0; s2 < 128; ++s2) { const float v2 = impv[s2]; rank += (v2 > v || (v2 == v && s2 < s)) ? 1 : 0; }
        if (rank < 16) sel[rank] = s; }
    __syncthreads();
    mx = -INFINITY;
    for (int i = 0; i < 16; ++i) { const int key = sel[i] * 64 + lane; float s = -INFINITY;
        if (key <= t) { const h16x8* kp = (const h16x8*)(h + ((size_t)b * T + key) * INP + C_NKS + g * 64); float a = 0.f;
#pragma unroll
            for (int d8 = 0; d8 < 8; ++d8) { const h16x8 kv = kp[d8];
#pragma unroll
                for (int x = 0; x < 8; ++x) a += qr[w][d8 * 8 + x] * (float)kv[x]; }
            s = a * 0.125f; }
        sc[w][i * 64 + lane] = s; mx = fmaxf(mx, s); }
    mx = wave_max(mx); sm = 0.f;
    for (int i = 0; i < 16; ++i) { const float s = sc[w][i * 64 + lane]; const float pp = (s == -INFINITY) ? 0.f : __expf(s - mx); sc[w][i * 64 + lane] = pp; sm += pp; }
    sm = wave_sum(sm);
    float o_s = 0.f;
    for (int i = 0; i < 16; ++i) { const int kb = sel[i] * 64; const h16* vp = h + ((size_t)b * T + kb) * INP + C_NVS + g * 64 + lane;
        if (kb <= t) { const int nk = min(64, t - kb + 1);
            for (int kk = 0; kk < nk; ++kk) o_s += sc[w][i * 64 + kk] * (float)vp[(size_t)kk * INP]; } }
    o_s /= sm;
    mx = -INFINITY;
    for (int i = 0; i < 8; ++i) { const int key = t - 511 + i * 64 + lane; float s = -INFINITY;
        if (key >= 0) { const h16x8* kp = (const h16x8*)(h + ((size_t)b * T + key) * INP + C_NKW + g * 64); float a = 0.f;
#pragma unroll
            for (int d8 = 0; d8 < 8; ++d8) { const h16x8 kv = kp[d8];
#pragma unroll
                for (int x = 0; x < 8; ++x) a += qr[w][d8 * 8 + x] * (float)kv[x]; }
            s = a * 0.125f; }
        sc[w][i * 64 + lane] = s; mx = fmaxf(mx, s); }
    mx = wave_max(mx); sm = 0.f;
    for (int i = 0; i < 8; ++i) { const float s = sc[w][i * 64 + lane]; const float pp = (s == -INFINITY) ? 0.f : __expf(s - mx); sc[w][i * 64 + lane] = pp; sm += pp; }
    sm = wave_sum(sm);
    float o_w = 0.f;
    { const int k0 = max(0, t - 511); const h16* vp = h + ((size_t)b * T) * INP + C_NVW + g * 64 + lane;
        for (int key = k0; key <= t; ++key) o_w += sc[w][key - (t - 511)] * (float)vp[(size_t)key * INP]; }
    o_w /= sm;
    const float g0 = sigmf((float)h[m * INP + C_NG + hh * 3 + 0]), g1 = sigmf((float)h[m * INP + C_NG + hh * 3 + 1]), g2 = sigmf((float)h[m * INP + C_NG + hh * 3 + 2]);
    mix[m * D + 512 + hh * 64 + lane] = (h16)(g0 * o_c + g1 * o_s + g2 * o_w);
    __syncthreads();
}

__device__ __forceinline__ void b_ln(const float* __restrict__ in, const float* __restrict__ gam, const float* __restrict__ bet, float* __restrict__ o32, h16* __restrict__ o16) {
    const int lane = threadIdx.x & 63;
    for (int row = blockIdx.x * 8 + (threadIdx.x >> 6); row < M; row += gridDim.x * 8) {
        const f32x4* xr = (const f32x4*)(in + (size_t)row * D) + lane;
        f32x4 v[4]; float s = 0.f;
#pragma unroll
        for (int j = 0; j < 4; ++j) { v[j] = xr[64 * j]; s += (v[j][0] + v[j][1]) + (v[j][2] + v[j][3]); }
        const float mean = wave_sum(s) * (1.f / D); float s2 = 0.f;
#pragma unroll
        for (int j = 0; j < 4; ++j) { v[j] = v[j] - mean; s2 += (v[j][0] * v[j][0] + v[j][1] * v[j][1]) + (v[j][2] * v[j][2] + v[j][3] * v[j][3]); }
        const float rstd = rsqrtf(wave_sum(s2) * (1.f / D) + LN_EPS);
#pragma unroll
        for (int j = 0; j < 4; ++j) { const f32x4 gg = ((const f32x4*)gam)[lane + 64 * j], bb = ((const f32x4*)bet)[lane + 64 * j]; const f32x4 o = v[j] * rstd * gg + bb;
            ((f32x4*)(o32 + (size_t)row * D))[lane + 64 * j] = o;
            if (o16) { u32x2 w; w.x = pg8::cvt_pk_f16(o[0], o[1]); w.y = pg8::cvt_pk_f16(o[2], o[3]); ((u32x2*)(o16 + (size_t)row * D))[lane + 64 * j] = w; } }
    }
}

__device__ __forceinline__ void b_xattn(const h16* __restrict__ qx, const h16* __restrict__ kvm, h16* __restrict__ ox, int m, float* sl, int tid) {
    float* q = sl; float (*pr)[256] = (float (*)[256])(sl + 1024);
    const int b = m >> 13;
    for (int i = tid; i < 1024; i += 256) q[i] = (float)qx[(size_t)m * D + i];
    __syncthreads();
    { const h16x8* kp = (const h16x8*)(kvm + (size_t)(b * MEML + tid) * 2048);
        for (int hh = 0; hh < 4; ++hh) { float a = 0.f;
            for (int d8 = 0; d8 < 32; ++d8) { const h16x8 kv = kp[hh * 32 + d8];
#pragma unroll
                for (int x = 0; x < 8; ++x) a += q[hh * 256 + d8 * 8 + x] * (float)kv[x]; }
            pr[hh][tid] = a * 0.0625f; } }
    __syncthreads();
    { const int w = tid >> 6, lane = tid & 63; float v[4]; float mx = -INFINITY;
#pragma unroll
        for (int i = 0; i < 4; ++i) { v[i] = pr[w][lane + 64 * i]; mx = fmaxf(mx, v[i]); }
        mx = wave_max(mx); float sm = 0.f;
#pragma unroll
        for (int i = 0; i < 4; ++i) { v[i] = __expf(v[i] - mx); sm += v[i]; }
        sm = wave_sum(sm); const float is = 1.f / sm;
#pragma unroll
        for (int i = 0; i < 4; ++i) pr[w][lane + 64 * i] = v[i] * is; }
    __syncthreads();
    { const h16* vp = kvm + (size_t)(b * MEML) * 2048 + 1024 + tid;
        for (int hh = 0; hh < 4; ++hh) { float a = 0.f;
            for (int mm = 0; mm < 256; ++mm) a += pr[hh][mm] * (float)vp[(size_t)mm * 2048 + hh * 256];
            ox[(size_t)m * D + hh * 256 + tid] = (h16)a; } }
    __syncthreads();
}

__device__ __forceinline__ void b_router(const Params& p, const float* __restrict__ x2, int* __restrict__ tope, float* __restrict__ topw) {
    const int lane = threadIdx.x & 63; const float* wr = p.w_router;
    for (int m = blockIdx.x * 8 + (threadIdx.x >> 6); m < M; m += gridDim.x * 8) {
        const float* xr = x2 + (size_t)m * D; float acc = 0.f;
        for (int k = 0; k < D; k += 4) { const f32x4 xv = *(const f32x4*)(xr + k);
            acc += xv[0] * wr[(k + 0) * 64 + lane]; acc += xv[1] * wr[(k + 1) * 64 + lane]; acc += xv[2] * wr[(k + 2) * 64 + lane]; acc += xv[3] * wr[(k + 3) * 64 + lane]; }
        const float score = 1.f / (1.f + expf(-acc)); const float biased = score + p.rbias[lane];
        float m1 = biased; m1 = fmaxf(m1, __shfl_xor(m1, 1)); m1 = fmaxf(m1, __shfl_xor(m1, 2)); m1 = fmaxf(m1, __shfl_xor(m1, 4));
        int am = (biased == m1) ? lane : 999; am = min(am, __shfl_xor(am, 1)); am = min(am, __shfl_xor(am, 2)); am = min(am, __shfl_xor(am, 4));
        float m2 = (lane == am) ? -INFINITY : biased; m2 = fmaxf(m2, __shfl_xor(m2, 1)); m2 = fmaxf(m2, __shfl_xor(m2, 2)); m2 = fmaxf(m2, __shfl_xor(m2, 4));
        const float gs = m1 + m2;
        int cnt = 0;
#pragma unroll
        for (int gq = 0; gq < 8; ++gq) { const float o = __shfl(gs, gq * 8); cnt += (o > gs) ? 1 : 0; }
        const float masked = (cnt <= 3) ? biased : NEGF;
        int rank = 0;
        for (int e2 = 0; e2 < 64; ++e2) { const float o = __shfl(masked, e2); rank += (o > masked || (o == masked && e2 < lane)) ? 1 : 0; }
        const bool selq = rank < 8;
        const float wsum = wave_sum(selq ? score : 0.f);
        if (selq) { tope[(size_t)m * 8 + rank] = lane; topw[(size_t)m * 8 + rank] = score / wsum * 2.5f; }
    }
}

__device__ __forceinline__ void b_moe(const Params& p, const float* __restrict__ x2, const int* __restrict__ tope, const float* __restrict__ topw, float* __restrict__ out, int m, float* sl, int tid) {
    float* xs = sl; float* hd = sl + 1024; float* red = sl + 1280;
    for (int i = tid; i < 1024; i += 256) xs[i] = x2[(size_t)m * D + i];
    __syncthreads();
    float acc[4] = {0.f, 0.f, 0.f, 0.f};
    for (int kx = 0; kx < 9; ++kx) {
        const float* G; const float* U; const float* Dn; float wt;
        if (kx < 8) { const int e = tope[(size_t)m * 8 + kx]; wt = topw[(size_t)m * 8 + kx]; G = p.w_gate + (size_t)e * D * EFF; U = p.w_up + (size_t)e * D * EFF; Dn = p.w_down + (size_t)e * EFF * D; }
        else { wt = 1.f; G = p.ws_gate; U = p.ws_up; Dn = p.ws_down; }
        float a = 0.f, u = 0.f;
        for (int k = 0; k < D; ++k) { const float xv = xs[k]; a += xv * G[(size_t)k * EFF + tid]; u += xv * U[(size_t)k * EFF + tid]; }
        hd[tid] = siluf(a) * u * wt;
        __syncthreads();
        for (int j = 0; j < EFF; ++j) { const float hv = hd[j]; const float* dr = Dn + (size_t)j * D + tid;
            acc[0] += hv * dr[0]; acc[1] += hv * dr[256]; acc[2] += hv * dr[512]; acc[3] += hv * dr[768]; }
        __syncthreads();
    }
    float v[4]; float s = 0.f;
#pragma unroll
    for (int i = 0; i < 4; ++i) { v[i] = DN_ALPHA * xs[tid + 256 * i] + acc[i]; s += v[i]; }
    s = wave_sum(s); if ((tid & 63) == 0) red[tid >> 6] = s; __syncthreads();
    const float mean = (red[0] + red[1] + red[2] + red[3]) * (1.f / D); float s2 = 0.f;
#pragma unroll
    for (int i = 0; i < 4; ++i) { v[i] -= mean; s2 += v[i] * v[i]; }
    s2 = wave_sum(s2); if ((tid & 63) == 0) red[4 + (tid >> 6)] = s2; __syncthreads();
    const float rstd = rsqrtf((red[4] + red[5] + red[6] + red[7]) * (1.f / D) + LN_EPS);
#pragma unroll
    for (int i = 0; i < 4; ++i) out[(size_t)m * D + tid + 256 * i] = v[i] * rstd * p.ln3g[tid + 256 * i] + p.ln3b[tid + 256 * i];
    __syncthreads();
}

constexpr int N_PHASES = 14;
__global__ void __launch_bounds__(NTHR, 2) mega_fwd(Params p) {
    extern __shared__ __attribute__((aligned(16))) unsigned char lds[];
    cg::grid_group grid = cg::this_grid();
    const int tid = threadIdx.x; const int G = (int)gridDim.x, bid = (int)blockIdx.x;
    unsigned char* ws = p.ws;
    h16* WinT = (h16*)(ws + WS_WIN); h16* WoutT = (h16*)(ws + WS_WOUT); h16* WxqT = (h16*)(ws + WS_WXQ); h16* WxoT = (h16*)(ws + WS_WXO); h16* WxkvT = (h16*)(ws + WS_WXKV);
    h16* memh = (h16*)(ws + WS_MEMH); h16* kvm = (h16*)(ws + WS_KVM); float* kcmp = (float*)(ws + WS_KCMP); float* vcmp = (float*)(ws + WS_VCMP);
    int* tope = (int*)(ws + WS_TOPE); float* topw = (float*)(ws + WS_TOPW);
    h16* xh = (h16*)(ws + WS_XH); h16* mix = (h16*)(ws + WS_MIX); h16* ox = (h16*)(ws + WS_OX); h16* hb = (h16*)(ws + WS_H); h16* nqr = (h16*)(ws + WS_NQR);
    float* kvb = (float*)(ws + WS_KVB); float* prev = (float*)(ws + WS_PREV); float* pre = (float*)(ws + WS_PRE); float* x1 = (float*)(ws + WS_X1); h16* x1h = (h16*)(ws + WS_X1H);
    h16* qx = (h16*)(ws + WS_QX); float* x2 = (float*)(ws + WS_X2);
    float* fl = (float*)lds;
    const int lo = p.ph_lo, hi = p.ph_hi;
#define IN(k) (lo <= (k) && (k) < hi)
#define SEAM(k) do { if (IN(k) && IN((k) + 1)) grid.sync(); } while (0)

    if (IN(0)) {
        const int sub = tid >> 8, lt = tid & 255; float* tl = fl + sub * 1088;
        constexpr int T0 = (INP / 32) * (D / 32), T1 = (D / 32) * (D / 32), T4 = (2 * D / 32) * (D / 32), TT = T0 + 3 * T1 + T4;
        for (int b0 = bid * 2; b0 < TT; b0 += G * 2) { int it = b0 + sub;
            if (it < T0) { b_transpose_tile(p.w_in, D, INC, WinT, INP, it, tl, lt); continue; } it -= T0;
            if (it < T1) { b_transpose_tile(p.w_out, D, D, WoutT, D, it, tl, lt); continue; } it -= T1;
            if (it < T1) { b_transpose_tile(p.w_xq, D, D, WxqT, D, it, tl, lt); continue; } it -= T1;
            if (it < T1) { b_transpose_tile(p.w_xo, D, D, WxoT, D, it, tl, lt); continue; } it -= T1;
            b_transpose_tile(p.w_xkv, D, 2 * D, WxkvT, 2 * D, it, tl, lt); }
        b_cvt(p.x, xh, (size_t)M * D / 4);
        b_cvt(p.mem, memh, (size_t)NB * MEML * D / 4);
    }
    SEAM(0);
    if (IN(1)) {
        { pg8::Gemm g{xh, WinT, M, INP, D}; pg8::StaticOrder S; S.init(M, INP, G, bid); pg8::EpiF16 E{hb, INP};
          pg8::gemm_phase<pg8::EpiF16, pg8::StaticOrder, true, true>((PG8_LAS unsigned char*)lds, g, S, E); }
        { pg8::Gemm g{memh, WxkvT, NB * MEML, 2 * D, D}; pg8::StaticOrder S; S.init(NB * MEML, 2 * D, G, bid); pg8::EpiF16 E{kvm, 2 * D};
          pg8::gemm_phase<pg8::EpiF16, pg8::StaticOrder, true, true>((PG8_LAS unsigned char*)lds, g, S, E); }
    }
    SEAM(1);
    if (IN(2)) { const int sub = tid >> 8, lt = tid & 255;
        for (int b0 = bid * 2; b0 < M; b0 += G * 2) b_rope(hb, nqr, p.positions, b0 + sub, lt); }
    SEAM(2);
    if (IN(3)) { const int sub = tid >> 8, lt = tid & 255;
        for (int b0 = bid * 2; b0 < 2 * NB * 511 * 2; b0 += G * 2) b_cmp(p, hb, kcmp, vcmp, b0 + sub, fl + sub * 2304, lt);
        for (int b0 = bid * 2; b0 < NB * 4 * 64; b0 += G * 2) b_ret_kv(p, hb, kvb, b0 + sub, lt); }
    SEAM(3);
    if (IN(4)) b_ret_scan(p, kvb, prev);
    SEAM(4);
    if (IN(5)) {
        { const int sub = tid >> 7, lt = tid & 127;
          for (int b0 = bid * 4; b0 < NB * 4 * 64 * 128; b0 += G * 4) b_ret_out(p, hb, prev, mix, b0 + sub, fl + sub * 260, lt); }
        { const int sub = tid >> 8, lt = tid & 255;
          for (int b0 = bid * 2; b0 < NB * T * 2; b0 += G * 2) b_nsa(hb, nqr, kcmp, vcmp, mix, b0 + sub, fl + sub * 4768, lt); }
    }
    SEAM(5);
    if (IN(6)) { pg8::Gemm g{mix, WoutT, M, D, D}; pg8::StaticOrder S; S.init(M, D, G, bid); pg8::EpiResF32 E{pre, p.x, D, DN_ALPHA};
        pg8::gemm_phase<pg8::EpiResF32, pg8::StaticOrder, true, true>((PG8_LAS unsigned char*)lds, g, S, E); }
    SEAM(6);
    if (IN(7)) b_ln(pre, p.ln1g, p.ln1b, x1, x1h);
    SEAM(7);
    if (IN(8)) { pg8::Gemm g{x1h, WxqT, M, D, D}; pg8::StaticOrder S; S.init(M, D, G, bid); pg8::EpiF16 E{qx, D};
        pg8::gemm_phase<pg8::EpiF16, pg8::StaticOrder, true, true>((PG8_LAS unsigned char*)lds, g, S, E); }
    SEAM(8);
    if (IN(9)) { const int sub = tid >> 8, lt = tid & 255;
        for (int b0 = bid * 2; b0 < M; b0 += G * 2) b_xattn(qx, kvm, ox, b0 + sub, fl + sub * 2048, lt); }
    SEAM(9);
    if (IN(10)) { pg8::Gemm g{ox, WxoT, M, D, D}; pg8::StaticOrder S; S.init(M, D, G, bid); pg8::EpiResF32 E{pre, x1, D, DN_ALPHA};
        pg8::gemm_phase<pg8::EpiResF32, pg8::StaticOrder, true, true>((PG8_LAS unsigned char*)lds, g, S, E); }
    SEAM(10);
    if (IN(11)) b_ln(pre, p.ln2g, p.ln2b, x2, (h16*)nullptr);
    SEAM(11);
    if (IN(12)) b_router(p, x2, tope, topw);
    SEAM(12);
    if (IN(13)) { const int sub = tid >> 8, lt = tid & 255;
        for (int b0 = bid * 2; b0 < M; b0 += G * 2) b_moe(p, x2, tope, topw, p.out, b0 + sub, fl + sub * 1288, lt); }
#undef IN
#undef SEAM
}

#ifndef MK_PER_PHASE
#define MK_PER_PHASE 0
#endif
extern "C" void kernel_launch(void* const* d_in, const int* in_sizes, int n_in, void* d_out, int out_size, void* d_ws, size_t ws_size, hipStream_t stream) {
    static int grid = 0;
    if (grid == 0) {
        if (n_in != 28 || in_sizes[0] != M * D || out_size != M * D || ws_size < WS_NEED) { fprintf(stderr, "kernel_launch: unexpected shapes (n_in %d, in0 %d, out %d, ws %zu)\n", n_in, n_in > 0 ? in_sizes[0] : -1, out_size, ws_size); grid = -1; return; }
        if (hipFuncSetAttribute((const void*)mega_fwd, hipFuncAttributeMaxDynamicSharedMemorySize, LDS_BYTES) != hipSuccess) { fprintf(stderr, "kernel_launch: hipFuncSetAttribute failed\n"); grid = -1; return; }
        int dev = 0, cus = 0, per_cu = 0;
        hipGetDevice(&dev); hipDeviceGetAttribute(&cus, hipDeviceAttributeMultiprocessorCount, dev);
        if (hipOccupancyMaxActiveBlocksPerMultiprocessor(&per_cu, (const void*)mega_fwd, NTHR, LDS_BYTES) != hipSuccess || per_cu < 1) { fprintf(stderr, "kernel_launch: occupancy query failed (%d)\n", per_cu); grid = -1; return; }
        grid = cus;
    }
    if (grid < 0) return;
    Params p{};
    p.x = (const float*)d_in[0]; p.mem = (const float*)d_in[1]; p.positions = (const int*)d_in[2];
    p.w_in = (const float*)d_in[3]; p.pe_k = (const float*)d_in[4]; p.pe_v = (const float*)d_in[5];
    p.w1k = (const float*)d_in[6]; p.w2k = (const float*)d_in[7]; p.w1v = (const float*)d_in[8]; p.w2v = (const float*)d_in[9];
    p.w_out = (const float*)d_in[10]; p.ln1g = (const float*)d_in[11]; p.ln1b = (const float*)d_in[12];
    p.w_xq = (const float*)d_in[13]; p.w_xkv = (const float*)d_in[14]; p.w_xo = (const float*)d_in[15];
    p.ln2g = (const float*)d_in[16]; p.ln2b = (const float*)d_in[17]; p.w_router = (const float*)d_in[18]; p.rbias = (const float*)d_in[19];
    p.w_gate = (const float*)d_in[20]; p.w_up = (const float*)d_in[21]; p.w_down = (const float*)d_in[22];
    p.ws_gate = (const float*)d_in[23]; p.ws_up = (const float*)d_in[24]; p.ws_down = (const float*)d_in[25];
    p.ln3g = (const float*)d_in[26]; p.ln3b = (const float*)d_in[27];
    p.out = (float*)d_out; p.ws = (unsigned char*)d_ws;
    for (int i = 0; i < 4; ++i) p.lg[i] = (float)std::log(1.0 - std::pow(2.0, -5.0 - (double)i));
#if MK_PER_PHASE
    for (int ph = 0; ph < N_PHASES; ++ph) { p.ph_lo = ph; p.ph_hi = ph + 1; hipLaunchKernelGGL(mega_fwd, dim3(grid), dim3(NTHR), LDS_BYTES, stream, p); }
#else
    p.ph_lo = 0; p.ph_hi = N_PHASES;
    void* args[] = {&p};
    hipError_t e = hipLaunchCooperativeKernel((const void*)mega_fwd, dim3(grid), dim3(NTHR), args, LDS_BYTES, stream);
    if (e != hipSuccess) fprintf(stderr, "kernel_launch: cooperative launch failed: %s (grid %d)\n", hipGetErrorString(e), grid);
#endif
}
```

```cpp
#include <hip/hip_runtime.h>
#include <cstdio>
#include <cstdint>
#include <cmath>

typedef _Float16 h16;
typedef _Float16 h16x8 __attribute__((ext_vector_type(8)));
typedef _Float16 h16x2 __attribute__((ext_vector_type(2)));
typedef float f32x2 __attribute__((ext_vector_type(2)));
typedef float f32x4 __attribute__((ext_vector_type(4)));
typedef unsigned u32x4 __attribute__((ext_vector_type(4)));
typedef unsigned u32x2 __attribute__((ext_vector_type(2)));

constexpr int NB = 4, T = 8192, D = 1024, M = NB * T;
constexpr int INC = 3352, INP = 3584;
constexpr int C_RQ = 0, C_RK = 512, C_RV = 1024, C_RG = 1536, C_NQ = 2048, C_NKC = 2560, C_NVC = 2688, C_NKS = 2816, C_NVS = 2944, C_NKW = 3072, C_NVW = 3200, C_NG = 3328;
constexpr int MEML = 256;
constexpr int NE = 64, EFF = 256;
constexpr float LN_EPS = 1e-5f;
constexpr float DN_ALPHA = 1.189207115002721f;
constexpr float NEGF = -1e30f;

constexpr size_t MiB = 1u << 20;
constexpr size_t WS_WIN = 1 * MiB, WS_WOUT = 8 * MiB, WS_WXQ = 10 * MiB, WS_WXO = 12 * MiB, WS_WXKV = 14 * MiB, WS_MEMH = 18 * MiB, WS_KVM = 20 * MiB;
constexpr size_t WS_KCMP = 24 * MiB, WS_VCMP = 25 * MiB, WS_TOPE = 26 * MiB, WS_TOPW = 27 * MiB;
constexpr size_t WS_XH = 32 * MiB, WS_MIX = 32 * MiB, WS_OX = 32 * MiB;
constexpr size_t WS_H = 96 * MiB, WS_NQR = 320 * MiB, WS_KVB = 352 * MiB, WS_PREV = 416 * MiB;
constexpr size_t WS_PRE = 96 * MiB, WS_X1 = 224 * MiB, WS_X1H = 352 * MiB, WS_QX = 416 * MiB, WS_X2 = 130 * MiB;
constexpr size_t WS_X2H = 32 * MiB, WS_WDT = 96 * MiB, WS_HM = 130 * MiB, WS_WGUT = 306 * MiB, WS_Y = 306 * MiB;
constexpr size_t WS_ROWOFF = 1 * MiB, WS_ROWMETA = 3 * MiB;
constexpr size_t WS_NEED = 480 * MiB;
constexpr int NQ = 4, QT = M / NQ, NVE = NQ * 65, CAP_TILES = 1412, CAP = CAP_TILES * 256;
constexpr int CTL_CNT = 0, CTL_CUR = 512, CTL_PST = 1024, CTL_TQS = 1536, CTL_TVE = 2048;

namespace pg8 {
#define PG8_LAS __attribute__((address_space(3)))
typedef short s16x8 __attribute__((ext_vector_type(8)));
constexpr int BM = 256, BK = 64, HALF = 128, HTB = HALF * BK * 2, STAGE_BYTES = 8 * HTB, NXCD = 8, WGM = 8;
__host__ __device__ __forceinline__ int lds_byte(int r, int c) { const int st = (r >> 4) * 2 + (c >> 5), rr = r & 15, cc = c & 31, ob = rr * 64 + cc * 2; return st * 1024 + (ob ^ (((ob >> 9) & 1) << 5)); }
__host__ __device__ __forceinline__ void stage_rc(int b, int& R, int& C) { const int st = b / 1024, sb = b % 1024, swz = sb ^ (((sb >> 9) & 1) << 5); R = (st >> 1) * 16 + swz / 64; C = (st & 1) * 32 + (swz % 64) / 2; }
__host__ __device__ __forceinline__ int perm32(int rho) { const int n = rho >> 4, i = rho & 15; return 8 * (i >> 2) + 4 * n + (i & 3); }
struct Unit { int pm, pn; const char* A; const char* B; const unsigned* gat; };
struct Gemm { const h16* A; const h16* Bt; int M, N, K; };
struct StaticOrder {
    int nM, nN, nwg, G, c; const char* A; const char* B; size_t tstep;
    __device__ void init(const Gemm& g, int G_, int c_) { nM = g.M / BM; nN = g.N / BM; nwg = nM * nN; G = G_; c = c_; A = (const char*)g.A; B = (const char*)g.Bt; tstep = (size_t)BM * g.K * 2; }
    __device__ bool next(int i, Unit& u) const {
        const long L = (long)i * G + c; if (L >= nwg) return false;
        int wgid = (int)L; { const int q = nwg / NXCD, r = nwg % NXCD, xcd = wgid % NXCD, off = wgid / NXCD; wgid = (xcd < r ? xcd * (q + 1) : r * (q + 1) + (xcd - r) * q) + off; }
        const int nig = WGM * nN, gid = wgid / nig, fm = gid * WGM, gsz = (nM - fm) < WGM ? (nM - fm) : WGM;
        u.pm = fm + ((wgid % nig) % gsz); u.pn = (wgid % nig) / gsz; u.A = A + (size_t)u.pm * tstep; u.B = B + (size_t)u.pn * tstep; u.gat = nullptr; return true;
    }
};
__device__ __forceinline__ unsigned cvt_pk_f16(float lo, float hi) { f32x2 v = {lo, hi}; h16x2 h = __builtin_convertvector(v, h16x2); return __builtin_bit_cast(unsigned, h); }

struct EpiF16 {
    static constexpr bool PERM = true;
    h16* O; int ldc;
    __device__ __forceinline__ void operator()(const f32x4 (&acc)[2][2][4][2], const Unit& u, int wr, int wc, int fr, int fq) const {
        const int row0 = u.pm * BM + wr * 64 + fr; const int col0 = u.pn * BM + wc * 32 + 8 * fq;
#pragma unroll
        for (int ai = 0; ai < 2; ++ai)
#pragma unroll
            for (int m = 0; m < 4; ++m) { h16* rowp = O + (size_t)(row0 + ai * HALF + m * 16) * ldc + col0;
#pragma unroll
                for (int bj = 0; bj < 2; ++bj) { const f32x4 v0 = acc[ai][bj][m][0], v1 = acc[ai][bj][m][1];
                    u32x4 w; w.x = cvt_pk_f16(v0[0], v0[1]); w.y = cvt_pk_f16(v0[2], v0[3]); w.z = cvt_pk_f16(v1[0], v1[1]); w.w = cvt_pk_f16(v1[2], v1[3]);
                    *(u32x4*)(rowp + bj * HALF) = w; } }
    }
};
struct EpiResF32 {
    static constexpr bool PERM = false;
    float* C; const float* R; int ldc; float alpha;
    __device__ __forceinline__ void operator()(const f32x4 (&acc)[2][2][4][2], const Unit& u, int wr, int wc, int fr, int fq) const {
        const int row0 = u.pm * BM + wr * 64 + fr, col0 = u.pn * BM + wc * 32 + 4 * fq;
#pragma unroll
        for (int ai = 0; ai < 2; ++ai)
#pragma unroll
            for (int m = 0; m < 4; ++m) { const size_t off = (size_t)(row0 + ai * HALF + m * 16) * ldc + col0;
#pragma unroll
                for (int bj = 0; bj < 2; ++bj)
#pragma unroll
                    for (int n = 0; n < 2; ++n) { const f32x4 r = *(const f32x4*)(R + off + bj * HALF + n * 16); *(f32x4*)(C + off + bj * HALF + n * 16) = r * alpha + acc[ai][bj][m][n]; } }
    }
};
struct EpiGateUp {
    static constexpr bool PERM = true;
    h16* H;
    __device__ __forceinline__ void operator()(const f32x4 (&acc)[2][2][4][2], const Unit& u, int wr, int wc, int fr, int fq) const {
        const int row0 = u.pm * BM + wr * 64 + fr; const int col0 = u.pn * 128 + wc * 16 + 4 * fq;
#pragma unroll
        for (int ai = 0; ai < 2; ++ai)
#pragma unroll
            for (int m = 0; m < 4; ++m) { h16* rowp = H + (size_t)(row0 + ai * HALF + m * 16) * 256 + col0;
#pragma unroll
                for (int bj = 0; bj < 2; ++bj) { const f32x4 v0 = acc[ai][bj][m][0], v1 = acc[ai][bj][m][1];
                    const float h0 = v0[0] / (1.f + __expf(-v0[0])) * v0[1], h1 = v0[2] / (1.f + __expf(-v0[2])) * v0[3];
                    const float h2 = v1[0] / (1.f + __expf(-v1[0])) * v1[1], h3 = v1[2] / (1.f + __expf(-v1[2])) * v1[3];
                    u32x2 w; w.x = cvt_pk_f16(h0, h1); w.y = cvt_pk_f16(h2, h3);
                    *(u32x2*)(rowp + bj * 64) = w; } }
    }
};
struct EpiDown {
    static constexpr bool PERM = true;
    h16* Y; const u32x2* rowmeta;
    __device__ __forceinline__ void operator()(const f32x4 (&acc)[2][2][4][2], const Unit& u, int wr, int wc, int fr, int fq) const {
        const int row0 = u.pm * BM + wr * 64 + fr; const int col0 = u.pn * BM + wc * 32 + 8 * fq;
#pragma unroll
        for (int ai = 0; ai < 2; ++ai)
#pragma unroll
            for (int m = 0; m < 4; ++m) { const u32x2 md = rowmeta[row0 + ai * HALF + m * 16]; const int slot = (int)md.x; const float w8 = __uint_as_float(md.y);
                if (slot >= 0) { h16* rowp = Y + (size_t)slot * 1024 + col0;
#pragma unroll
                    for (int bj = 0; bj < 2; ++bj) { const f32x4 v0 = acc[ai][bj][m][0] * w8, v1 = acc[ai][bj][m][1] * w8;
                        u32x4 w; w.x = cvt_pk_f16(v0[0], v0[1]); w.y = cvt_pk_f16(v0[2], v0[3]); w.z = cvt_pk_f16(v1[0], v1[1]); w.w = cvt_pk_f16(v1[2], v1[3]);
                        *(u32x4*)(rowp + bj * HALF) = w; } }
                asm volatile("" ::: "memory"); }
    }
};

template <class Epi, class Sched>
__device__ __forceinline__ void gemm_phase(PG8_LAS unsigned char* lds, const int K, const Sched& S, const Epi& E) {
    const int tid = threadIdx.x, wid = __builtin_amdgcn_readfirstlane(tid >> 6), lane = tid & 63, wr = wid >> 2, wc = wid & 3, fr = lane & 15, fq = lane >> 4;
    const int nt = K / BK;
    int R0, C0; stage_rc(tid * 16, R0, C0);
    const unsigned cb2 = (unsigned)C0 * 2u;
    unsigned voffB[2];
#pragma unroll
    for (int i = 0; i < 2; ++i) { const int R = R0 + 64 * i; const int Rb = Epi::PERM ? ((R & ~31) + perm32(R & 31)) : R; voffB[i] = (unsigned)(Rb * K) * 2u + cb2; }
    const size_t kstep = (size_t)(BK * 2);
    const size_t hstep = (size_t)HALF * K * 2;
    const unsigned ldsw = (unsigned)wid * 1024u;
    const int aoff = lds_byte(wr * 64 + fr, fq * 8), boff = lds_byte(wc * 32 + fr, fq * 8);
#define PG8_MKVA(u, va) do { _Pragma("unroll") for (int _h = 0; _h < 2; ++_h) _Pragma("unroll") for (int _i = 0; _i < 2; ++_i) { const int _r = _h * HALF + R0 + 64 * _i; \
        (va)[_h][_i] = ((u).gat ? (u).gat[_r] : (unsigned)(_r * K) * 2u) + cb2; } } while (0)
#define PG8_SA(b, h) (((b) * 2 + (h)) * HTB)
#define PG8_SB(b, h) ((4 + (b) * 2 + (h)) * HTB)
#define PG8_STAGE(bufoff, gbase, voff) do { _Pragma("unroll") for (int _i = 0; _i < 2; ++_i) \
        __builtin_amdgcn_global_load_lds((const unsigned*)((const char*)(gbase) + (voff)[_i]), (PG8_LAS unsigned*)(lds + (bufoff) + ldsw + _i * 8192), 16, 0, 0); } while (0)
#define PG8_LDA(dst, b, h) do { _Pragma("unroll") for (int m = 0; m < 4; ++m) _Pragma("unroll") for (int k = 0; k < 2; ++k) dst[m][k] = *(const PG8_LAS s16x8*)(lds + PG8_SA(b, h) + aoff + m * 2048 + k * 1024); } while (0)
#define PG8_LDB(dst, b, h) do { _Pragma("unroll") for (int n = 0; n < 2; ++n) _Pragma("unroll") for (int k = 0; k < 2; ++k) dst[n][k] = *(const PG8_LAS s16x8*)(lds + PG8_SB(b, h) + boff + n * 2048 + k * 1024); } while (0)
#define PG8_MMA(ai, bj, At, Bt) do { __builtin_amdgcn_s_setprio(1); _Pragma("unroll") for (int m = 0; m < 4; ++m) _Pragma("unroll") for (int n = 0; n < 2; ++n) _Pragma("unroll") for (int k = 0; k < 2; ++k) \
        acc[ai][bj][m][n] = __builtin_amdgcn_mfma_f32_16x16x32_f16(__builtin_bit_cast(h16x8, Bt[n][k]), __builtin_bit_cast(h16x8, At[m][k]), acc[ai][bj][m][n], 0, 0, 0); __builtin_amdgcn_s_setprio(0); } while (0)
#define PG8_WAIT_V(n) asm volatile("s_waitcnt vmcnt(" #n ")" ::: "memory")
#define PG8_WAIT_L(n) asm volatile("s_waitcnt lgkmcnt(" #n ")" ::: "memory")
#define PG8_BAR __builtin_amdgcn_s_barrier()
#define PG8_SCHED __builtin_amdgcn_sched_barrier(0)
    Unit cur, nxt; int ui = 0;
    if (!S.next(0, cur)) return;
    unsigned va[2][2];
    PG8_MKVA(cur, va);
    f32x4 acc[2][2][4][2];
#pragma unroll
    for (int a = 0; a < 2; ++a)
#pragma unroll
        for (int b = 0; b < 2; ++b)
#pragma unroll
            for (int m = 0; m < 4; ++m)
#pragma unroll
                for (int n = 0; n < 2; ++n) acc[a][b][m][n] = (f32x4){0.f, 0.f, 0.f, 0.f};
    s16x8 At[4][2], B0[2][2], B1[2][2];
    const char* cA = cur.A; const char* cB = cur.B;
    {
        PG8_STAGE(PG8_SB(0, 0), cB, voffB); PG8_STAGE(PG8_SB(0, 1), cB + hstep, voffB); PG8_STAGE(PG8_SA(0, 0), cA, va[0]); PG8_STAGE(PG8_SA(0, 1), cA, va[1]);
        if (wr == 1) PG8_BAR;
        PG8_WAIT_V(2); PG8_BAR;
        PG8_STAGE(PG8_SB(1, 0), cB + kstep, voffB); PG8_STAGE(PG8_SA(1, 0), cA + kstep, va[0]); PG8_STAGE(PG8_SB(1, 1), cB + hstep + kstep, voffB);
        PG8_WAIT_V(6); PG8_BAR;
    }
    for (;;) {
        const bool has_next = S.next(ui + 1, nxt);
        const char* nA = has_next ? nxt.A : cA; const char* nB = has_next ? nxt.B : cB;
#pragma unroll 1
        for (int t = 0; t < nt; t += 2) {
            const bool last = (t == nt - 2);
            const char* a1 = cA + (size_t)(t + 1) * kstep;
            const char* a2 = last ? nA : cA + (size_t)(t + 2) * kstep; const char* b2 = last ? nB : cB + (size_t)(t + 2) * kstep;
            const char* a3 = a2 + kstep; const char* b3 = b2 + kstep;
            PG8_LDB(B0, 0, 0); PG8_LDB(B1, 0, 1); PG8_SCHED; PG8_LDA(At, 0, 0); PG8_STAGE(PG8_SA(1, 1), a1, va[1]);
            if (last && has_next) { PG8_MKVA(nxt, va); }
            PG8_WAIT_V(8); PG8_WAIT_L(0); PG8_BAR; PG8_MMA(0, 0, At, B0); PG8_MMA(0, 1, At, B1); PG8_BAR; PG8_SCHED;
            PG8_LDA(At, 0, 1); PG8_STAGE(PG8_SB(0, 0), b2, voffB); PG8_STAGE(PG8_SB(0, 1), b2 + hstep, voffB); PG8_STAGE(PG8_SA(0, 0), a2, va[0]);
            PG8_WAIT_V(8); PG8_WAIT_L(0); PG8_BAR; PG8_MMA(1, 0, At, B0); PG8_MMA(1, 1, At, B1); PG8_BAR; PG8_SCHED;
            PG8_LDB(B0, 1, 0); PG8_LDB(B1, 1, 1); PG8_SCHED; PG8_LDA(At, 1, 0); PG8_STAGE(PG8_SA(0, 1), a2, va[1]);
            PG8_WAIT_V(8); PG8_WAIT_L(0); PG8_BAR; PG8_MMA(0, 0, At, B0); PG8_MMA(0, 1, At, B1); PG8_BAR; PG8_SCHED;
            PG8_LDA(At, 1, 1); PG8_STAGE(PG8_SB(1, 0), b3, voffB); PG8_STAGE(PG8_SB(1, 1), b3 + hstep, voffB); PG8_STAGE(PG8_SA(1, 0), a3, va[0]);
            PG8_WAIT_V(8); PG8_WAIT_L(0); PG8_BAR; PG8_MMA(1, 0, At, B0); PG8_MMA(1, 1, At, B1); PG8_BAR; PG8_SCHED;
        }
        if (wr == 0) PG8_BAR;
        E(acc, cur, wr, wc, fr, fq);
        if (!has_next) break;
#pragma unroll
        for (int a = 0; a < 2; ++a)
#pragma unroll
            for (int b = 0; b < 2; ++b)
#pragma unroll
                for (int m = 0; m < 4; ++m)
#pragma unroll
                    for (int n = 0; n < 2; ++n) acc[a][b][m][n] = (f32x4){0.f, 0.f, 0.f, 0.f};
        cur = nxt; cA = nA; cB = nB; ++ui;
        if (wr == 1) PG8_BAR;
    }
    PG8_WAIT_V(0);
    PG8_BAR;
#undef PG8_MKVA
#undef PG8_SA
#undef PG8_SB
#undef PG8_STAGE
#undef PG8_LDA
#undef PG8_LDB
#undef PG8_MMA
#undef PG8_WAIT_V
#undef PG8_WAIT_L
#undef PG8_BAR
#undef PG8_SCHED
}
}


#include <hip/hip_cooperative_groups.h>
namespace cg = cooperative_groups;
constexpr int NTHR = 512;
constexpr int LDS_BYTES = 147456;
#define LAS __attribute__((address_space(3)))

struct Params {
    const float *x, *mem; const int* positions;
    const float *w_in, *pe_k, *pe_v, *w1k, *w2k, *w1v, *w2v, *w_out, *ln1g, *ln1b, *w_xq, *w_xkv, *w_xo, *ln2g, *ln2b, *w_router, *rbias, *w_gate, *w_up, *w_down, *ws_gate, *ws_up, *ws_down, *ln3g, *ln3b;
    float* out; unsigned char* ws;
    float lg[4];
    int ph_lo, ph_hi;
};

__device__ __forceinline__ float wave_sum(float v) {
#pragma unroll
    for (int o = 1; o < 64; o <<= 1) v += __shfl_xor(v, o);
    return v;
}
__device__ __forceinline__ float wave_max(float v) {
#pragma unroll
    for (int o = 1; o < 64; o <<= 1) v = fmaxf(v, __shfl_xor(v, o));
    return v;
}
__device__ __forceinline__ float siluf(float v) { return v / (1.f + __expf(-v)); }
__device__ __forceinline__ float sigmf(float v) { return 1.f / (1.f + __expf(-v)); }

__device__ __forceinline__ void b_transpose_tile(const float* __restrict__ W, int K, int N, h16* __restrict__ WT, int Npad, int tile, float* tl, int lt, int rs = 1, int ro = 0) {
    const int ntn = Npad / 32; const int n0 = (tile % ntn) * 32, k0 = (tile / ntn) * 32, tx = lt & 31, ty = lt >> 5;
    for (int i = ty; i < 32; i += 8) { const int k = k0 + i, n = n0 + tx; tl[i * 33 + tx] = (n < N) ? W[(size_t)k * N + n] : 0.f; }
    __syncthreads();
    for (int i = ty; i < 32; i += 8) { const int n = n0 + i, k = k0 + tx; WT[(size_t)(n * rs + ro) * K + k] = (h16)tl[tx * 33 + i]; }
    __syncthreads();
}
__device__ __forceinline__ void b_cvt(const float* __restrict__ x, h16* __restrict__ o, size_t n4) {
    for (size_t i = (size_t)blockIdx.x * NTHR + threadIdx.x; i < n4; i += (size_t)gridDim.x * NTHR) {
        const f32x4 v = ((const f32x4*)x)[i]; u32x2 w; w.x = pg8::cvt_pk_f16(v[0], v[1]); w.y = pg8::cvt_pk_f16(v[2], v[3]); ((u32x2*)o)[i] = w; }
}

__device__ __forceinline__ void b_rope(h16* __restrict__ h, h16* __restrict__ nqr, const int* __restrict__ positions, int m, int j) {
    h16* hr = h + (size_t)m * INP;
    const float pos = (float)positions[m];
    {   const int hd = j >> 6, jj = j & 63;
        const float inv = (float)pow(10000.0, -(double)jj / 64.0);
        const float ang = pos * inv; double sd, cd; sincos((double)ang, &sd, &cd); const float c = (float)cd, s = (float)sd;
        const int o1 = hd * 128 + jj, o2 = o1 + 64;
        const float q1 = (float)hr[C_RQ + o1], q2 = (float)hr[C_RQ + o2];
        hr[C_RQ + o1] = (h16)(q1 * c - q2 * s); hr[C_RQ + o2] = (h16)(q2 * c + q1 * s);
        const float k1 = (float)hr[C_RK + o1], k2 = (float)hr[C_RK + o2]; const float sc = 0.08838834764831845f;
        hr[C_RK + o1] = (h16)((k1 * c - k2 * s) * sc); hr[C_RK + o2] = (h16)((k2 * c + k1 * s) * sc);
    }
    if (j < 64 + 16 + 16) {
        const int jj = j & 7;
        const float inv = (float)pow(500000.0, -(double)jj / 8.0);
        const float ang = pos * inv; double sd, cd; sincos((double)ang, &sd, &cd); const float c = (float)cd, s = (float)sd;
        if (j < 64) { const int hd = j >> 3; const int o1 = hd * 64 + jj, o2 = o1 + 8;
            const float q1 = (float)hr[C_NQ + o1], q2 = (float)hr[C_NQ + o2];
            nqr[(size_t)m * 512 + o1] = (h16)(q1 * c - q2 * s); nqr[(size_t)m * 512 + o2] = (h16)(q2 * c + q1 * s);
        } else { const int jx = j - 64; const int which = jx >> 4, g = (jx >> 3) & 1; const int base = (which ? C_NKW : C_NKS) + g * 64 + jj;
            const float k1 = (float)hr[base], k2 = (float)hr[base + 8];
            hr[base] = (h16)(k1 * c - k2 * s); hr[base + 8] = (h16)(k2 * c + k1 * s); }
    }
    for (int i = j; i < 8 * 48; i += 256) { const int hd = i / 48, d = 16 + i % 48; nqr[(size_t)m * 512 + hd * 64 + d] = hr[C_NQ + hd * 64 + d]; }
}

__device__ __forceinline__ void b_cmp(const Params& p, const h16* __restrict__ h, float* __restrict__ kcmp, float* __restrict__ vcmp, int item, float* sl, int lt) {
    float* a = sl; float* hid = sl + 2048;
    int id = item; const int g = id & 1; id >>= 1; const int c = id % 511; id /= 511; const int b = id & 3; const int kv = id >> 2;
    const float* pe = kv ? p.pe_v : p.pe_k; const float* w1 = kv ? p.w1v : p.w1k; const float* w2 = kv ? p.w2v : p.w2k; float* out = kv ? vcmp : kcmp;
    const int colb = (kv ? C_NVC : C_NKC) + g * 64;
    for (int i = lt; i < 2048; i += 256) { const int l = i >> 6, d = i & 63; a[i] = (float)h[(size_t)(b * T + 16 * c + l) * INP + colb + d] + pe[l * 64 + d]; }
    __syncthreads();
    { const int j = lt; float acc = 0.f;
        for (int k = 0; k < 2048; ++k) acc += a[k] * w1[(size_t)k * 256 + j];
        hid[j] = siluf(acc); }
    __syncthreads();
    if (lt < 64) { const int e = lt; float acc = 0.f;
        for (int j = 0; j < 256; ++j) acc += hid[j] * w2[j * 64 + e];
        out[((size_t)(b * 512 + c) * 2 + g) * 64 + e] = acc; }
    __syncthreads();
}

__device__ __forceinline__ void b_ret_kv(const Params& p, const h16* __restrict__ h, float* __restrict__ kvb, int id, int lt) {
    const int n = id & 63, hd = (id >> 6) & 3, b = id >> 8;
    const float lg = p.lg[hd];
    const int d = lt >> 1, e0 = (lt & 1) * 64;
    float acc[64];
#pragma unroll
    for (int i = 0; i < 64; ++i) acc[i] = 0.f;
    const h16* base = h + (size_t)(b * T + n * 128) * INP;
    for (int j = 0; j < 128; ++j) {
        const float kd = (float)base[(size_t)j * INP + C_RK + hd * 128 + d] * __expf(lg * (float)(127 - j));
        const h16x8* vp = (const h16x8*)(base + (size_t)j * INP + C_RV + hd * 128 + e0);
#pragma unroll
        for (int i8 = 0; i8 < 8; ++i8) { const h16x8 v = vp[i8];
#pragma unroll
            for (int i = 0; i < 8; ++i) acc[i8 * 8 + i] += kd * (float)v[i]; }
    }
    float* o = kvb + ((size_t)id * 128 + d) * 128 + e0;
#pragma unroll
    for (int i = 0; i < 64; ++i) o[i] = acc[i];
}
__device__ __forceinline__ void b_ret_scan(const Params& p, const float* __restrict__ kvb, float* __restrict__ prev) {
    for (int gid = blockIdx.x * NTHR + threadIdx.x; gid < 16 * 16384; gid += gridDim.x * NTHR) {
        const int de = gid & 16383, bh = gid >> 14; const float cd = __expf(p.lg[bh & 3] * 128.f);
        float st = 0.f;
        for (int n = 0; n < 64; ++n) { const size_t o = ((size_t)(bh * 64 + n) << 14) + de; prev[o] = st; st = st * cd + kvb[o]; }
    }
}
__device__ __forceinline__ void b_ret_out(const Params& p, const h16* __restrict__ h, const float* __restrict__ prev, h16* __restrict__ mix, int item, float* sl, int tid) {
    float* q = sl; float* s = sl + 128; float* red = sl + 256;
    int id = item; const int i = id & 127; id >>= 7; const int n = id & 63, hd = (id >> 6) & 3, b = id >> 8;
    const float lg = p.lg[hd];
    const size_t m = (size_t)b * T + n * 128 + i;
    q[tid] = (float)h[m * INP + C_RQ + hd * 128 + tid];
    __syncthreads();
    { const int j = tid; float acc = 0.f;
        if (j <= i) { const h16x8* kp = (const h16x8*)(h + ((size_t)b * T + n * 128 + j) * INP + C_RK + hd * 128);
#pragma unroll
            for (int d8 = 0; d8 < 16; ++d8) { const h16x8 kv = kp[d8];
#pragma unroll
                for (int x = 0; x < 8; ++x) acc += q[d8 * 8 + x] * (float)kv[x]; }
            acc *= __expf(lg * (float)(i - j)); }
        s[j] = acc; }
    __syncthreads();
    const int e = tid; float inner = 0.f, cross = 0.f;
    { const h16* vb = h + ((size_t)b * T + n * 128) * INP + C_RV + hd * 128 + e;
        for (int j = 0; j <= i; ++j) inner += s[j] * (float)vb[(size_t)j * INP];
        const float* pp = prev + ((size_t)((b * 4 + hd) * 64 + n) << 14) + e;
        for (int d = 0; d < 128; ++d) cross += q[d] * pp[d * 128];
        cross *= __expf(lg * (float)(i + 1)); }
    const float o = inner + cross;
    float sm = wave_sum(o); if ((tid & 63) == 0) red[tid >> 6] = sm; __syncthreads();
    const float mu = (red[0] + red[1]) * (1.f / 128.f); const float dv = o - mu;
    float sq = wave_sum(dv * dv); if ((tid & 63) == 0) red[2 + (tid >> 6)] = sq; __syncthreads();
    const float var = (red[2] + red[3]) * (1.f / 128.f);
    const float on = dv * rsqrtf(var + LN_EPS);
    const float gt = (float)h[m * INP + C_RG + hd * 128 + e];
    mix[m * D + hd * 128 + e] = (h16)(siluf(gt) * on);
    __syncthreads();
}

__device__ __forceinline__ void b_nsa(const h16* __restrict__ h, const h16* __restrict__ nqr, const float* __restrict__ kcmp, const float* __restrict__ vcmp, h16* __restrict__ mix, int item, float* sl, int tid) {
    float (*q)[64] = (float (*)[64])sl; float (*qr)[64] = (float (*)[64])(sl + 256); float (*sc)[1024] = (float (*)[1024])(sl + 512); float* impv = sl + 512 + 4096; int* sel = (int*)(sl + 512 + 4096 + 128);
    int id = item; const int g = id & 1; id >>= 1; const int t = id & (T - 1); const int b = id >> 13;
    const int w = tid >> 6, lane = tid & 63, hh = g * 4 + w; const size_t m = (size_t)b * T + t;
    q[w][lane] = (float)h[m * INP + C_NQ + hh * 64 + lane]; qr[w][lane] = (float)nqr[m * 512 + hh * 64 + lane];
    if (tid < 16) sel[tid] = 0;
    __syncthreads();
    const int ncv = (t >= 31) ? ((t - 31) >> 4) + 1 : 0;
    float mx = -INFINITY;
    for (int c = lane; c < 512; c += 64) { float s = -INFINITY;
        if (c < ncv) { const float* kp = kcmp + ((size_t)(b * 512 + c) * 2 + g) * 64; float a = 0.f;
#pragma unroll 16
            for (int d = 0; d < 64; ++d) a += q[w][d] * kp[d];
            s = a * 0.125f; }
        sc[w][c] = s; mx = fmaxf(mx, s); }
    mx = wave_max(mx);
    float sm = 0.f;
    for (int c = lane; c < 512; c += 64) { const float pp = (c < ncv) ? __expf(sc[w][c] - mx) : 0.f; sc[w][c] = pp; sm += pp; }
    sm = wave_sum(sm); const float isum = ncv > 0 ? 1.f / sm : 0.f;
    for (int c = lane; c < 512; c += 64) sc[w][c] *= isum;
    float o_c = 0.f;
    { const float* vp = vcmp + ((size_t)(b * 512) * 2 + g) * 64 + lane;
        for (int c = 0; c < ncv; ++c) o_c += sc[w][c] * vp[(size_t)c * 128]; }
    __syncthreads();
    const int cur = t >> 6;
    if (tid < 128) { const int s = tid; float v = 0.f;
        const int c0 = max(4 * s - 1, 0), c1 = min(4 * s + 3, 510);
        for (int c = c0; c <= c1; ++c) v += sc[0][c] + sc[1][c] + sc[2][c] + sc[3][c];
        if (s == 0 || s == cur || s == cur - 1) v = 1e9f;
        if (s > cur) v = NEGF;
        impv[s] = v; }
    __syncthreads();
    if (tid < 128) { const int s = tid; const float v = impv[s]; int rank = 0;
        for (int s2 = 0; s2 < 128; ++s2) { const float v2 = impv[s2]; rank += (v2 > v || (v2 == v && s2 < s)) ? 1 : 0; }
        if (rank < 16) sel[rank] = s; }
    __syncthreads();
    mx = -INFINITY;
    for (int i = 0; i < 16; ++i) { const int key = sel[i] * 64 + lane; float s = -INFINITY;
        if (key <= t) { const h16x8* kp = (const h16x8*)(h + ((size_t)b * T + key) * INP + C_NKS + g * 64); float a = 0.f;
#pragma unroll
            for (int d8 = 0; d8 < 8; ++d8) { const h16x8 kv = kp[d8];
#pragma unroll
                for (int x = 0; x < 8; ++x) a += qr[w][d8 * 8 + x] * (float)kv[x]; }
            s = a * 0.125f; }
        sc[w][i * 64 + lane] = s; mx = fmaxf(mx, s); }
    mx = wave_max(mx); sm = 0.f;
    for (int i = 0; i < 16; ++i) { const float s = sc[w][i * 64 + lane]; const float pp = (s == -INFINITY) ? 0.f : __expf(s - mx); sc[w][i * 64 + lane] = pp; sm += pp; }
    sm = wave_sum(sm);
    float o_s = 0.f;
    for (int i = 0; i < 16; ++i) { const int kb = sel[i] * 64; const h16* vp = h + ((size_t)b * T + kb) * INP + C_NVS + g * 64 + lane;
        if (kb <= t) { const int nk = min(64, t - kb + 1);
            for (int kk = 0; kk < nk; ++kk) o_s += sc[w][i * 64 + kk] * (float)vp[(size_t)kk * INP]; } }
    o_s /= sm;
    mx = -INFINITY;
    for (int i = 0; i < 8; ++i) { const int key = t - 511 + i * 64 + lane; float s = -INFINITY;
        if (key >= 0) { const h16x8* kp = (const h16x8*)(h + ((size_t)b * T + key) * INP + C_NKW + g * 64); float a = 0.f;
#pragma unroll
            for (int d8 = 0; d8 < 8; ++d8) { const h16x8 kv = kp[d8];
#pragma unroll
                for (int x = 0; x < 8; ++x) a += qr[w][d8 * 8 + x] * (float)kv[x]; }
            s = a * 0.125f; }
        sc[w][i * 64 + lane] = s; mx = fmaxf(mx, s); }
    mx = wave_max(mx); sm = 0.f;
    for (int i = 0; i < 8; ++i) { const float s = sc[w][i * 64 + lane]; const float pp = (s == -INFINITY) ? 0.f : __expf(s - mx); sc[w][i * 64 + lane] = pp; sm += pp; }
    sm = wave_sum(sm);
    float o_w = 0.f;
    { const int k0 = max(0, t - 511); const h16* vp = h + ((size_t)b * T) * INP + C_NVW + g * 64 + lane;
        for (int key = k0; key <= t; ++key) o_w += sc[w][key - (t - 511)] * (float)vp[(size_t)key * INP]; }
    o_w /= sm;
    const float g0 = sigmf((float)h[m * INP + C_NG + hh * 3 + 0]), g1 = sigmf((float)h[m * INP + C_NG + hh * 3 + 1]), g2 = sigmf((float)h[m * INP + C_NG + hh * 3 + 2]);
    mix[m * D + 512 + hh * 64 + lane] = (h16)(g0 * o_c + g1 * o_s + g2 * o_w);
    __syncthreads();
}

__device__ __forceinline__ void b_ln(const float* __restrict__ in, const float* __restrict__ gam, const float* __restrict__ bet, float* __restrict__ o32, h16* __restrict__ o16) {
    const int lane = threadIdx.x & 63;
    for (int row = blockIdx.x * 8 + (threadIdx.x >> 6); row < M; row += gridDim.x * 8) {
        const f32x4* xr = (const f32x4*)(in + (size_t)row * D) + lane;
        f32x4 v[4]; float s = 0.f;
#pragma unroll
        for (int j = 0; j < 4; ++j) { v[j] = xr[64 * j]; s += (v[j][0] + v[j][1]) + (v[j][2] + v[j][3]); }
        const float mean = wave_sum(s) * (1.f / D); float s2 = 0.f;
#pragma unroll
        for (int j = 0; j < 4; ++j) { v[j] = v[j] - mean; s2 += (v[j][0] * v[j][0] + v[j][1] * v[j][1]) + (v[j][2] * v[j][2] + v[j][3] * v[j][3]); }
        const float rstd = rsqrtf(wave_sum(s2) * (1.f / D) + LN_EPS);
#pragma unroll
        for (int j = 0; j < 4; ++j) { const f32x4 gg = ((const f32x4*)gam)[lane + 64 * j], bb = ((const f32x4*)bet)[lane + 64 * j]; const f32x4 o = v[j] * rstd * gg + bb;
            ((f32x4*)(o32 + (size_t)row * D))[lane + 64 * j] = o;
            if (o16) { u32x2 w; w.x = pg8::cvt_pk_f16(o[0], o[1]); w.y = pg8::cvt_pk_f16(o[2], o[3]); ((u32x2*)(o16 + (size_t)row * D))[lane + 64 * j] = w; } }
    }
}

__device__ __forceinline__ void b_xattn(const h16* __restrict__ qx, const h16* __restrict__ kvm, h16* __restrict__ ox, int m, float* sl, int tid) {
    float* q = sl; float (*pr)[256] = (float (*)[256])(sl + 1024);
    const int b = m >> 13;
    for (int i = tid; i < 1024; i += 256) q[i] = (float)qx[(size_t)m * D + i];
    __syncthreads();
    { const h16x8* kp = (const h16x8*)(kvm + (size_t)(b * MEML + tid) * 2048);
        for (int hh = 0; hh < 4; ++hh) { float a = 0.f;
            for (int d8 = 0; d8 < 32; ++d8) { const h16x8 kv = kp[hh * 32 + d8];
#pragma unroll
                for (int x = 0; x < 8; ++x) a += q[hh * 256 + d8 * 8 + x] * (float)kv[x]; }
            pr[hh][tid] = a * 0.0625f; } }
    __syncthreads();
    { const int w = tid >> 6, lane = tid & 63; float v[4]; float mx = -INFINITY;
#pragma unroll
        for (int i = 0; i < 4; ++i) { v[i] = pr[w][lane + 64 * i]; mx = fmaxf(mx, v[i]); }
        mx = wave_max(mx); float sm = 0.f;
#pragma unroll
        for (int i = 0; i < 4; ++i) { v[i] = __expf(v[i] - mx); sm += v[i]; }
        sm = wave_sum(sm); const float is = 1.f / sm;
#pragma unroll
        for (int i = 0; i < 4; ++i) pr[w][lane + 64 * i] = v[i] * is; }
    __syncthreads();
    { const h16* vp = kvm + (size_t)(b * MEML) * 2048 + 1024 + tid;
        for (int hh = 0; hh < 4; ++hh) { float a = 0.f;
            for (int mm = 0; mm < 256; ++mm) a += pr[hh][mm] * (float)vp[(size_t)mm * 2048 + hh * 256];
            ox[(size_t)m * D + hh * 256 + tid] = (h16)a; } }
    __syncthreads();
}

__device__ __forceinline__ void b_router(const Params& p, const float* __restrict__ x2, int* __restrict__ tope, float* __restrict__ topw, int* __restrict__ hist) {
    const int lane = threadIdx.x & 63; const float* wr = p.w_router;
    for (int m = blockIdx.x * 8 + (threadIdx.x >> 6); m < M; m += gridDim.x * 8) {
        const float* xr = x2 + (size_t)m * D; float acc = 0.f;
        for (int k = 0; k < D; k += 4) { const f32x4 xv = *(const f32x4*)(xr + k);
            acc += xv[0] * wr[(k + 0) * 64 + lane]; acc += xv[1] * wr[(k + 1) * 64 + lane]; acc += xv[2] * wr[(k + 2) * 64 + lane]; acc += xv[3] * wr[(k + 3) * 64 + lane]; }
        const float score = 1.f / (1.f + expf(-acc)); const float biased = score + p.rbias[lane];
        float m1 = biased; m1 = fmaxf(m1, __shfl_xor(m1, 1)); m1 = fmaxf(m1, __shfl_xor(m1, 2)); m1 = fmaxf(m1, __shfl_xor(m1, 4));
        int am = (biased == m1) ? lane : 999; am = min(am, __shfl_xor(am, 1)); am = min(am, __shfl_xor(am, 2)); am = min(am, __shfl_xor(am, 4));
        float m2 = (lane == am) ? -INFINITY : biased; m2 = fmaxf(m2, __shfl_xor(m2, 1)); m2 = fmaxf(m2, __shfl_xor(m2, 2)); m2 = fmaxf(m2, __shfl_xor(m2, 4));
        const float gs = m1 + m2;
        int cnt = 0;
#pragma unroll
        for (int gq = 0; gq < 8; ++gq) { const float o = __shfl(gs, gq * 8); cnt += (o > gs) ? 1 : 0; }
        const float masked = (cnt <= 3) ? biased : NEGF;
        int rank = 0;
        for (int e2 = 0; e2 < 64; ++e2) { const float o = __shfl(masked, e2); rank += (o > masked || (o == masked && e2 < lane)) ? 1 : 0; }
        const bool selq = rank < 8;
        const float wsum = wave_sum(selq ? score : 0.f);
        if (selq) { tope[(size_t)m * 8 + rank] = lane; topw[(size_t)m * 8 + rank] = score / wsum * 2.5f; atomicAdd(hist + (m >> 13) * 65 + lane, 1); }
    }
}

__device__ __forceinline__ void b_moe(const Params& p, const float* __restrict__ x2, const int* __restrict__ tope, const float* __restrict__ topw, float* __restrict__ out, int m, float* sl, int tid) {
    float* xs = sl; float* hd = sl + 1024; float* red = sl + 1280;
    for (int i = tid; i < 1024; i += 256) xs[i] = x2[(size_t)m * D + i];
    __syncthreads();
    float acc[4] = {0.f, 0.f, 0.f, 0.f};
    for (int kx = 0; kx < 9; ++kx) {
        const float* G; const float* U; const float* Dn; float wt;
        if (kx < 8) { const int e = tope[(size_t)m * 8 + kx]; wt = topw[(size_t)m * 8 + kx]; G = p.w_gate + (size_t)e * D * EFF; U = p.w_up + (size_t)e * D * EFF; Dn = p.w_down + (size_t)e * EFF * D; }
        else { wt = 1.f; G = p.ws_gate; U = p.ws_up; Dn = p.ws_down; }
        float a = 0.f, u = 0.f;
        for (int k = 0; k < D; ++k) { const float xv = xs[k]; a += xv * G[(size_t)k * EFF + tid]; u += xv * U[(size_t)k * EFF + tid]; }
        hd[tid] = siluf(a) * u * wt;
        __syncthreads();
        for (int j = 0; j < EFF; ++j) { const float hv = hd[j]; const float* dr = Dn + (size_t)j * D + tid;
            acc[0] += hv * dr[0]; acc[1] += hv * dr[256]; acc[2] += hv * dr[512]; acc[3] += hv * dr[768]; }
        __syncthreads();
    }
    float v[4]; float s = 0.f;
#pragma unroll
    for (int i = 0; i < 4; ++i) { v[i] = DN_ALPHA * xs[tid + 256 * i] + acc[i]; s += v[i]; }
    s = wave_sum(s); if ((tid & 63) == 0) red[tid >> 6] = s; __syncthreads();
    const float mean = (red[0] + red[1] + red[2] + red[3]) * (1.f / D); float s2 = 0.f;
#pragma unroll
    for (int i = 0; i < 4; ++i) { v[i] -= mean; s2 += v[i] * v[i]; }
    s2 = wave_sum(s2); if ((tid & 63) == 0) red[4 + (tid >> 6)] = s2; __syncthreads();
    const float rstd = rsqrtf((red[4] + red[5] + red[6] + red[7]) * (1.f / D) + LN_EPS);
#pragma unroll
    for (int i = 0; i < 4; ++i) out[(size_t)m * D + tid + 256 * i] = v[i] * rstd * p.ln3g[tid + 256 * i] + p.ln3b[tid + 256 * i];
    __syncthreads();
}

struct G1Sched {
    const int* ctl; const char* x2h; const unsigned* rowoff; const char* WguT; int G, c;
    __device__ bool next(int i, pg8::Unit& u) const {
        const int ntile = ctl[CTL_TQS + NQ]; const long L = (long)i * G + c; if (L >= 2L * ntile) return false;
        const int tile = (int)(L >> 1), pn = (int)(L & 1); const int e = ctl[CTL_TVE + tile] % 65;
        u.pm = tile; u.pn = pn; u.A = x2h; u.gat = rowoff + (size_t)tile * 256; u.B = WguT + ((size_t)e * 512 + pn * 256) * (D * 2); return true; }
};
struct G2Sched {
    const int* ctl; const char* H; const char* WdT; int q, G, c;
    __device__ bool next(int i, pg8::Unit& u) const {
        const int t0 = ctl[CTL_TQS + q], t1 = ctl[CTL_TQS + q + 1]; const long L = (long)i * G + c; if (L >= 4L * (t1 - t0)) return false;
        const int tile = t0 + (int)(L >> 2), pn = (int)(L & 3); const int e = ctl[CTL_TVE + tile] % 65;
        u.pm = tile; u.pn = pn; u.A = H + (size_t)tile * 256 * (EFF * 2); u.gat = nullptr; u.B = WdT + ((size_t)e * D + pn * 256) * (EFF * 2); return true; }
};
__device__ __forceinline__ void b_scatter(int* __restrict__ ctl, const int* __restrict__ tope, const float* __restrict__ topw, unsigned* __restrict__ rowoff, u32x2* __restrict__ rowmeta, int* sl) {
    int* pst = sl;
    if (threadIdx.x == 0) { int acc = 0; for (int v = 0; v < NVE; ++v) { pst[v] = acc; acc += (ctl[CTL_CNT + v] + 255) & ~255; } pst[NVE] = acc; }
    __syncthreads();
    if (blockIdx.x == 0) {
        for (int v = threadIdx.x; v <= NVE; v += NTHR) ctl[CTL_PST + v] = pst[v];
        if (threadIdx.x <= NQ) ctl[CTL_TQS + threadIdx.x] = pst[threadIdx.x * 65] >> 8;
        for (int v = threadIdx.x; v < NVE; v += NTHR) for (int tl = pst[v] >> 8; tl < (pst[v + 1] >> 8); ++tl) ctl[CTL_TVE + tl] = v;
    }
    for (int idx = blockIdx.x * NTHR + threadIdx.x; idx < M * 9; idx += gridDim.x * NTHR) {
        int m, k, pos; float w;
        if (idx < M * 8) { m = idx >> 3; k = idx & 7; const int ve = (m >> 13) * 65 + tope[idx]; w = topw[idx]; pos = pst[ve] + atomicAdd(ctl + CTL_CUR + ve, 1); }
        else { m = idx - M * 8; k = 8; w = 1.f; pos = pst[(m >> 13) * 65 + 64] + (m & (QT - 1)); }
        rowoff[pos] = (unsigned)m * (D * 2); rowmeta[pos] = (u32x2){(unsigned)((m & (QT - 1)) * 9 + k), __float_as_uint(w)};
    }
    __syncthreads();
}
__device__ __forceinline__ void b_combine(const Params& p, const h16* __restrict__ x2h, const h16* __restrict__ Y, int q) {
    const int lane = threadIdx.x & 63;
    for (int r = blockIdx.x * 8 + (threadIdx.x >> 6); r < QT; r += gridDim.x * 8) {
        const int m = q * QT + r;
        float v[16];
        { const h16x8 a = ((const h16x8*)(x2h + (size_t)m * D))[lane], b = ((const h16x8*)(x2h + (size_t)m * D))[lane + 64];
#pragma unroll
          for (int i = 0; i < 8; ++i) { v[i] = DN_ALPHA * (float)a[i]; v[8 + i] = DN_ALPHA * (float)b[i]; } }
#pragma unroll
        for (int k = 0; k < 9; ++k) { const h16x8* yr = (const h16x8*)(Y + ((size_t)r * 9 + k) * D); const h16x8 a = yr[lane], b = yr[lane + 64];
#pragma unroll
            for (int i = 0; i < 8; ++i) { v[i] += (float)a[i]; v[8 + i] += (float)b[i]; } }
        float s = 0.f;
#pragma unroll
        for (int i = 0; i < 16; ++i) s += v[i];
        const float mean = wave_sum(s) * (1.f / D); float s2 = 0.f;
#pragma unroll
        for (int i = 0; i < 16; ++i) { v[i] -= mean; s2 += v[i] * v[i]; }
        const float rstd = rsqrtf(wave_sum(s2) * (1.f / D) + LN_EPS);
#pragma unroll
        for (int hlf = 0; hlf < 2; ++hlf) { const int c0 = (lane + 64 * hlf) * 8;
            const f32x4 g0 = *(const f32x4*)(p.ln3g + c0), g1 = *(const f32x4*)(p.ln3g + c0 + 4), b0 = *(const f32x4*)(p.ln3b + c0), b1 = *(const f32x4*)(p.ln3b + c0 + 4);
            f32x4 o0, o1;
#pragma unroll
            for (int i = 0; i < 4; ++i) { o0[i] = v[8 * hlf + i] * rstd * g0[i] + b0[i]; o1[i] = v[8 * hlf + 4 + i] * rstd * g1[i] + b1[i]; }
            *(f32x4*)(p.out + (size_t)m * D + c0) = o0; *(f32x4*)(p.out + (size_t)m * D + c0 + 4) = o1; }
    }
}

constexpr int N_PHASES = 23;
__global__ void __launch_bounds__(NTHR, 2) mega_fwd(Params p) {
    extern __shared__ __attribute__((aligned(16))) unsigned char lds[];
    cg::grid_group grid = cg::this_grid();
    const int tid = threadIdx.x; const int G = (int)gridDim.x, bid = (int)blockIdx.x;
    unsigned char* ws = p.ws;
    h16* WinT = (h16*)(ws + WS_WIN); h16* WoutT = (h16*)(ws + WS_WOUT); h16* WxqT = (h16*)(ws + WS_WXQ); h16* WxoT = (h16*)(ws + WS_WXO); h16* WxkvT = (h16*)(ws + WS_WXKV);
    h16* memh = (h16*)(ws + WS_MEMH); h16* kvm = (h16*)(ws + WS_KVM); float* kcmp = (float*)(ws + WS_KCMP); float* vcmp = (float*)(ws + WS_VCMP);
    int* tope = (int*)(ws + WS_TOPE); float* topw = (float*)(ws + WS_TOPW);
    h16* xh = (h16*)(ws + WS_XH); h16* mix = (h16*)(ws + WS_MIX); h16* ox = (h16*)(ws + WS_OX); h16* hb = (h16*)(ws + WS_H); h16* nqr = (h16*)(ws + WS_NQR);
    float* kvb = (float*)(ws + WS_KVB); float* prev = (float*)(ws + WS_PREV); float* pre = p.out; float* x1 = (float*)(ws + WS_X1); h16* x1h = (h16*)(ws + WS_X1H);
    h16* qx = (h16*)(ws + WS_QX); float* x2 = (float*)(ws + WS_X2); h16* x2h = (h16*)(ws + WS_X2H);
    int* ctl = (int*)ws; unsigned* rowoff = (unsigned*)(ws + WS_ROWOFF); u32x2* rowmeta = (u32x2*)(ws + WS_ROWMETA);
    h16* WguT = (h16*)(ws + WS_WGUT); h16* WdT = (h16*)(ws + WS_WDT); h16* Hm = (h16*)(ws + WS_HM); h16* Yq = (h16*)(ws + WS_Y);
    float* fl = (float*)lds;
    const int lo = p.ph_lo, hi = p.ph_hi;
#define IN(k) (lo <= (k) && (k) < hi)
#define SEAM(k) do { if (IN(k) && IN((k) + 1)) grid.sync(); } while (0)

    if (IN(0)) {
        const int sub = tid >> 8, lt = tid & 255; float* tl = fl + sub * 1088;
        constexpr int T0 = (INP / 32) * (D / 32), T1 = (D / 32) * (D / 32), T4 = (2 * D / 32) * (D / 32), TT = T0 + 3 * T1 + T4;
        for (int b0 = bid * 2; b0 < TT; b0 += G * 2) { int it = b0 + sub;
            if (it < T0) { b_transpose_tile(p.w_in, D, INC, WinT, INP, it, tl, lt); continue; } it -= T0;
            if (it < T1) { b_transpose_tile(p.w_out, D, D, WoutT, D, it, tl, lt); continue; } it -= T1;
            if (it < T1) { b_transpose_tile(p.w_xq, D, D, WxqT, D, it, tl, lt); continue; } it -= T1;
            if (it < T1) { b_transpose_tile(p.w_xo, D, D, WxoT, D, it, tl, lt); continue; } it -= T1;
            b_transpose_tile(p.w_xkv, D, 2 * D, WxkvT, 2 * D, it, tl, lt); }
        b_cvt(p.x, xh, (size_t)M * D / 4);
        b_cvt(p.mem, memh, (size_t)NB * MEML * D / 4);
        if (bid == 0) for (int i = tid; i < 1024; i += NTHR) ctl[i] = 0;
    }
    SEAM(0);
    if (IN(1)) {
        { pg8::Gemm g{xh, WinT, M, INP, D}; pg8::StaticOrder S; S.init(g, G, bid); pg8::EpiF16 E{hb, INP};
          pg8::gemm_phase<pg8::EpiF16, pg8::StaticOrder>((PG8_LAS unsigned char*)lds, g.K, S, E); }
        { pg8::Gemm g{memh, WxkvT, NB * MEML, 2 * D, D}; pg8::StaticOrder S; S.init(g, G, bid); pg8::EpiF16 E{kvm, 2 * D};
          pg8::gemm_phase<pg8::EpiF16, pg8::StaticOrder>((PG8_LAS unsigned char*)lds, g.K, S, E); }
    }
    SEAM(1);
    if (IN(2)) { const int sub = tid >> 8, lt = tid & 255;
        for (int b0 = bid * 2; b0 < M; b0 += G * 2) b_rope(hb, nqr, p.positions, b0 + sub, lt); }
    SEAM(2);
    if (IN(3)) { const int sub = tid >> 8, lt = tid & 255;
        for (int b0 = bid * 2; b0 < 2 * NB * 511 * 2; b0 += G * 2) b_cmp(p, hb, kcmp, vcmp, b0 + sub, fl + sub * 2304, lt);
        for (int b0 = bid * 2; b0 < NB * 4 * 64; b0 += G * 2) b_ret_kv(p, hb, kvb, b0 + sub, lt); }
    SEAM(3);
    if (IN(4)) b_ret_scan(p, kvb, prev);
    SEAM(4);
    if (IN(5)) {
        { const int sub = tid >> 7, lt = tid & 127;
          for (int b0 = bid * 4; b0 < NB * 4 * 64 * 128; b0 += G * 4) b_ret_out(p, hb, prev, mix, b0 + sub, fl + sub * 260, lt); }
        { const int sub = tid >> 8, lt = tid & 255;
          for (int b0 = bid * 2; b0 < NB * T * 2; b0 += G * 2) b_nsa(hb, nqr, kcmp, vcmp, mix, b0 + sub, fl + sub * 4768, lt); }
    }
    SEAM(5);
    if (IN(6)) { pg8::Gemm g{mix, WoutT, M, D, D}; pg8::StaticOrder S; S.init(g, G, bid); pg8::EpiResF32 E{pre, p.x, D, DN_ALPHA};
        pg8::gemm_phase<pg8::EpiResF32, pg8::StaticOrder>((PG8_LAS unsigned char*)lds, g.K, S, E); }
    SEAM(6);
    if (IN(7)) b_ln(pre, p.ln1g, p.ln1b, x1, x1h);
    SEAM(7);
    if (IN(8)) { pg8::Gemm g{x1h, WxqT, M, D, D}; pg8::StaticOrder S; S.init(g, G, bid); pg8::EpiF16 E{qx, D};
        pg8::gemm_phase<pg8::EpiF16, pg8::StaticOrder>((PG8_LAS unsigned char*)lds, g.K, S, E); }
    SEAM(8);
    if (IN(9)) { const int sub = tid >> 8, lt = tid & 255;
        for (int b0 = bid * 2; b0 < M; b0 += G * 2) b_xattn(qx, kvm, ox, b0 + sub, fl + sub * 2048, lt); }
    SEAM(9);
    if (IN(10)) { pg8::Gemm g{ox, WxoT, M, D, D}; pg8::StaticOrder S; S.init(g, G, bid); pg8::EpiResF32 E{pre, x1, D, DN_ALPHA};
        pg8::gemm_phase<pg8::EpiResF32, pg8::StaticOrder>((PG8_LAS unsigned char*)lds, g.K, S, E); }
    SEAM(10);
    if (IN(11)) b_ln(pre, p.ln2g, p.ln2b, x2, x2h);
    SEAM(11);
    if (IN(12)) {
        b_router(p, x2, tope, topw, ctl + CTL_CNT);
        if (bid == 0 && tid < NQ) ctl[CTL_CNT + tid * 65 + 64] = QT;
        for (int i = bid * NTHR + tid; i < CAP; i += G * NTHR) { rowoff[i] = 0u; rowmeta[i] = (u32x2){0xffffffffu, 0u}; }
        const int sub = tid >> 8, lt = tid & 255; float* tl = fl + sub * 1088;
        for (int b0 = bid * 2; b0 < 65 * 768; b0 += G * 2) { const int it = b0 + sub; const int e = it / 768, r = it % 768;
            const float* wg = e < 64 ? p.w_gate + (size_t)e * D * EFF : p.ws_gate; const float* wu = e < 64 ? p.w_up + (size_t)e * D * EFF : p.ws_up; const float* wd = e < 64 ? p.w_down + (size_t)e * EFF * D : p.ws_down;
            if (r < 256) b_transpose_tile(wg, D, EFF, WguT + (size_t)e * 512 * D, EFF, r, tl, lt, 2, 0);
            else if (r < 512) b_transpose_tile(wu, D, EFF, WguT + (size_t)e * 512 * D, EFF, r - 256, tl, lt, 2, 1);
            else b_transpose_tile(wd, EFF, D, WdT + (size_t)e * D * EFF, D, r - 512, tl, lt); }
    }
    SEAM(12);
    if (IN(13)) b_scatter(ctl, tope, topw, rowoff, rowmeta, (int*)lds);
    SEAM(13);
    if (IN(14)) { G1Sched S{ctl, (const char*)x2h, rowoff, (const char*)WguT, G, bid}; pg8::EpiGateUp E{Hm};
        pg8::gemm_phase<pg8::EpiGateUp, G1Sched>((PG8_LAS unsigned char*)lds, D, S, E); }
    SEAM(14);
#pragma unroll 1
    for (int q = 0; q < NQ; ++q) {
        if (IN(15 + 2 * q)) { G2Sched S{ctl, (const char*)Hm, (const char*)WdT, q, G, bid}; pg8::EpiDown E{Yq, rowmeta};
            pg8::gemm_phase<pg8::EpiDown, G2Sched>((PG8_LAS unsigned char*)lds, EFF, S, E); }
        SEAM(15 + 2 * q);
        if (IN(16 + 2 * q)) b_combine(p, x2h, Yq, q);
        if (q < NQ - 1) SEAM(16 + 2 * q);
    }
#undef IN
#undef SEAM
}

#ifndef MK_PER_PHASE
#define MK_PER_PHASE 0
#endif
extern "C" void kernel_launch(void* const* d_in, const int* in_sizes, int n_in, void* d_out, int out_size, void* d_ws, size_t ws_size, hipStream_t stream) {
    static int grid = 0;
    if (grid == 0) {
        if (n_in != 28 || in_sizes[0] != M * D || out_size != M * D || ws_size < WS_NEED) { fprintf(stderr, "kernel_launch: unexpected shapes (n_in %d, in0 %d, out %d, ws %zu)\n", n_in, n_in > 0 ? in_sizes[0] : -1, out_size, ws_size); grid = -1; return; }
        if (hipFuncSetAttribute((const void*)mega_fwd, hipFuncAttributeMaxDynamicSharedMemorySize, LDS_BYTES) != hipSuccess) { fprintf(stderr, "kernel_launch: hipFuncSetAttribute failed\n"); grid = -1; return; }
        int dev = 0, cus = 0, per_cu = 0;
        hipGetDevice(&dev); hipDeviceGetAttribute(&cus, hipDeviceAttributeMultiprocessorCount, dev);
        if (hipOccupancyMaxActiveBlocksPerMultiprocessor(&per_cu, (const void*)mega_fwd, NTHR, LDS_BYTES) != hipSuccess || per_cu < 1) { fprintf(stderr, "kernel_launch: occupancy query failed (%d)\n", per_cu); grid = -1; return; }
        grid = cus;
    }
    if (grid < 0) return;
    Params p{};
    p.x = (const float*)d_in[0]; p.mem = (const float*)d_in[1]; p.positions = (const int*)d_in[2];
    p.w_in = (const float*)d_in[3]; p.pe_k = (const float*)d_in[4]; p.pe_v = (const float*)d_in[5];
    p.w1k = (const float*)d_in[6]; p.w2k = (const float*)d_in[7]; p.w1v = (const float*)d_in[8]; p.w2v = (const float*)d_in[9];
    p.w_out = (const float*)d_in[10]; p.ln1g = (const float*)d_in[11]; p.ln1b = (const float*)d_in[12];
    p.w_xq = (const float*)d_in[13]; p.w_xkv = (const float*)d_in[14]; p.w_xo = (const float*)d_in[15];
    p.ln2g = (const float*)d_in[16]; p.ln2b = (const float*)d_in[17]; p.w_router = (const float*)d_in[18]; p.rbias = (const float*)d_in[19];
    p.w_gate = (const float*)d_in[20]; p.w_up = (const float*)d_in[21]; p.w_down = (const float*)d_in[22];
    p.ws_gate = (const float*)d_in[23]; p.ws_up = (const float*)d_in[24]; p.ws_down = (const float*)d_in[25];
    p.ln3g = (const float*)d_in[26]; p.ln3b = (const float*)d_in[27];
    p.out = (float*)d_out; p.ws = (unsigned char*)d_ws;
    for (int i = 0; i < 4; ++i) p.lg[i] = (float)std::log(1.0 - std::pow(2.0, -5.0 - (double)i));
#if MK_PER_PHASE
    for (int ph = 0; ph < N_PHASES; ++ph) { p.ph_lo = ph; p.ph_hi = ph + 1; hipLaunchKernelGGL(mega_fwd, dim3(grid), dim3(NTHR), LDS_BYTES, stream, p); }
#else
    p.ph_lo = 0; p.ph_hi = N_PHASES;
    void* args[] = {&p};
    hipError_t e = hipLaunchCooperativeKernel((const void*)mega_fwd, dim3(grid), dim3(NTHR), args, LDS_BYTES, stream);
    if (e != hipSuccess) fprintf(stderr, "kernel_launch: cooperative launch failed: %s (grid %d)\n", hipGetErrorString(e), grid);
#endif
}
```

```cpp
#include <hip/hip_runtime.h>
#include <cstdio>
#include <cstdint>
#include <cmath>

typedef _Float16 h16;
typedef _Float16 h16x8 __attribute__((ext_vector_type(8)));
typedef _Float16 h16x2 __attribute__((ext_vector_type(2)));
typedef float f32x2 __attribute__((ext_vector_type(2)));
typedef float f32x4 __attribute__((ext_vector_type(4)));
typedef unsigned u32x4 __attribute__((ext_vector_type(4)));
typedef unsigned u32x2 __attribute__((ext_vector_type(2)));

__device__ __forceinline__ int tidx() { int t = (int)threadIdx.x; asm volatile("" : "+v"(t)); return t; }

constexpr int NB = 4, T = 8192, D = 1024, M = NB * T;
constexpr int INC = 3352, INP = 3584;
constexpr int C_RQ = 0, C_RK = 512, C_RV = 1024, C_RG = 1536, C_NQ = 2048, C_NKC = 2560, C_NVC = 2688, C_NKS = 2816, C_NVS = 2944, C_NKW = 3072, C_NVW = 3200, C_NG = 3328;
constexpr int MEML = 256;
constexpr int NE = 64, EFF = 256;
constexpr float LN_EPS = 1e-5f;
constexpr float DN_ALPHA = 1.189207115002721f;
constexpr float NEGF = -1e30f;

constexpr size_t MiB = 1u << 20;
constexpr size_t WS_WIN = 1 * MiB, WS_WOUT = 8 * MiB, WS_WXQ = 10 * MiB, WS_WXO = 12 * MiB, WS_WXKV = 14 * MiB, WS_MEMH = 18 * MiB, WS_KVM = 20 * MiB;
constexpr size_t WS_KCMP = 24 * MiB, WS_VCMP = 25 * MiB, WS_TOPE = 26 * MiB, WS_TOPW = 27 * MiB;
constexpr size_t WS_XH = 32 * MiB, WS_MIX = 32 * MiB, WS_OX = 32 * MiB;
constexpr size_t WS_H = 96 * MiB, WS_NQR = 320 * MiB, WS_KVB = 352 * MiB, WS_PREV = 416 * MiB;
constexpr size_t WS_PRE = 96 * MiB, WS_X1 = 224 * MiB, WS_X1H = 352 * MiB, WS_QX = 416 * MiB, WS_X2 = 130 * MiB;
constexpr size_t WS_X2H = 32 * MiB, WS_WDT = 96 * MiB, WS_HM = 130 * MiB, WS_WGUT = 306 * MiB, WS_Y = 306 * MiB;
constexpr size_t WS_ROWOFF = 1 * MiB, WS_ROWMETA = 3 * MiB;
constexpr size_t WS_VST = 480 * MiB, WS_VWT = 488 * MiB;
constexpr size_t WS_NEED = 496 * MiB;
constexpr int NQ = 4, QT = M / NQ, NVE = NQ * 65, CAP_TILES = 1412, CAP = CAP_TILES * 256;
constexpr int CTL_CNT = 0, CTL_CUR = 512, CTL_PST = 1024, CTL_TQS = 1536, CTL_TVE = 2048;

namespace pg8 {
#define PG8_LAS __attribute__((address_space(3)))
typedef short s16x8 __attribute__((ext_vector_type(8)));
constexpr int BM = 256, BK = 64, HALF = 128, HTB = HALF * BK * 2, STAGE_BYTES = 8 * HTB, NXCD = 8, WGM = 8;
__host__ __device__ __forceinline__ int lds_byte(int r, int c) { const int st = (r >> 4) * 2 + (c >> 5), rr = r & 15, cc = c & 31, ob = rr * 64 + cc * 2; return st * 1024 + (ob ^ (((ob >> 9) & 1) << 5)); }
__host__ __device__ __forceinline__ void stage_rc(int b, int& R, int& C) { const int st = b / 1024, sb = b % 1024, swz = sb ^ (((sb >> 9) & 1) << 5); R = (st >> 1) * 16 + swz / 64; C = (st & 1) * 32 + (swz % 64) / 2; }
__host__ __device__ __forceinline__ int perm32(int rho) { const int n = rho >> 4, i = rho & 15; return 8 * (i >> 2) + 4 * n + (i & 3); }
struct Unit { int pm, pn; const char* A; const char* B; const unsigned* gat; };
struct Gemm { const h16* A; const h16* Bt; int M, N, K; };
struct StaticOrder {
    int nM, nN, nwg, G, c; const char* A; const char* B; size_t tstep;
    __device__ void init(const Gemm& g, int G_, int c_) { nM = g.M / BM; nN = g.N / BM; nwg = nM * nN; G = G_; c = c_; A = (const char*)g.A; B = (const char*)g.Bt; tstep = (size_t)BM * g.K * 2; }
    __device__ bool next(int i, Unit& u) const {
        const long L = (long)i * G + c; if (L >= nwg) return false;
        int wgid = (int)L; { const int q = nwg / NXCD, r = nwg % NXCD, xcd = wgid % NXCD, off = wgid / NXCD; wgid = (xcd < r ? xcd * (q + 1) : r * (q + 1) + (xcd - r) * q) + off; }
        const int nig = WGM * nN, gid = wgid / nig, fm = gid * WGM, gsz = (nM - fm) < WGM ? (nM - fm) : WGM;
        u.pm = fm + ((wgid % nig) % gsz); u.pn = (wgid % nig) / gsz; u.A = A + (size_t)u.pm * tstep; u.B = B + (size_t)u.pn * tstep; u.gat = nullptr; return true;
    }
};
__device__ __forceinline__ unsigned cvt_pk_f16(float lo, float hi) { f32x2 v = {lo, hi}; h16x2 h = __builtin_convertvector(v, h16x2); return __builtin_bit_cast(unsigned, h); }

struct EpiF16 {
    static constexpr bool PERM = true;
    h16* O; int ldc;
    __device__ __forceinline__ void operator()(const f32x4 (&acc)[2][2][4][2], const Unit& u, int wr, int wc, int fr, int fq) const {
        const int row0 = u.pm * BM + wr * 64 + fr; const int col0 = u.pn * BM + wc * 32 + 8 * fq;
#pragma unroll
        for (int ai = 0; ai < 2; ++ai)
#pragma unroll
            for (int m = 0; m < 4; ++m) { h16* rowp = O + (size_t)(row0 + ai * HALF + m * 16) * ldc + col0;
#pragma unroll
                for (int bj = 0; bj < 2; ++bj) { const f32x4 v0 = acc[ai][bj][m][0], v1 = acc[ai][bj][m][1];
                    u32x4 w; w.x = cvt_pk_f16(v0[0], v0[1]); w.y = cvt_pk_f16(v0[2], v0[3]); w.z = cvt_pk_f16(v1[0], v1[1]); w.w = cvt_pk_f16(v1[2], v1[3]);
                    *(u32x4*)(rowp + bj * HALF) = w; } }
    }
};
struct EpiResF32 {
    static constexpr bool PERM = false;
    float* C; const float* R; int ldc; float alpha;
    __device__ __forceinline__ void operator()(const f32x4 (&acc)[2][2][4][2], const Unit& u, int wr, int wc, int fr, int fq) const {
        const int row0 = u.pm * BM + wr * 64 + fr, col0 = u.pn * BM + wc * 32 + 4 * fq;
#pragma unroll
        for (int ai = 0; ai < 2; ++ai)
#pragma unroll
            for (int m = 0; m < 4; ++m) { const size_t off = (size_t)(row0 + ai * HALF + m * 16) * ldc + col0;
#pragma unroll
                for (int bj = 0; bj < 2; ++bj)
#pragma unroll
                    for (int n = 0; n < 2; ++n) { const f32x4 r = *(const f32x4*)(R + off + bj * HALF + n * 16); *(f32x4*)(C + off + bj * HALF + n * 16) = r * alpha + acc[ai][bj][m][n]; } }
    }
};
struct EpiGateUp {
    static constexpr bool PERM = true;
    h16* H;
    __device__ __forceinline__ void operator()(const f32x4 (&acc)[2][2][4][2], const Unit& u, int wr, int wc, int fr, int fq) const {
        const int row0 = u.pm * BM + wr * 64 + fr; const int col0 = u.pn * 128 + wc * 16 + 4 * fq;
#pragma unroll
        for (int ai = 0; ai < 2; ++ai)
#pragma unroll
            for (int m = 0; m < 4; ++m) { h16* rowp = H + (size_t)(row0 + ai * HALF + m * 16) * 256 + col0;
#pragma unroll
                for (int bj = 0; bj < 2; ++bj) { const f32x4 v0 = acc[ai][bj][m][0], v1 = acc[ai][bj][m][1];
                    const float h0 = v0[0] / (1.f + __expf(-v0[0])) * v0[1], h1 = v0[2] / (1.f + __expf(-v0[2])) * v0[3];
                    const float h2 = v1[0] / (1.f + __expf(-v1[0])) * v1[1], h3 = v1[2] / (1.f + __expf(-v1[2])) * v1[3];
                    u32x2 w; w.x = cvt_pk_f16(h0, h1); w.y = cvt_pk_f16(h2, h3);
                    *(u32x2*)(rowp + bj * 64) = w; } }
    }
};
struct EpiDown {
    static constexpr bool PERM = true;
    h16* Y; const u32x2* rowmeta;
    __device__ __forceinline__ void operator()(const f32x4 (&acc)[2][2][4][2], const Unit& u, int wr, int wc, int fr, int fq) const {
        const int row0 = u.pm * BM + wr * 64 + fr; const int col0 = u.pn * BM + wc * 32 + 8 * fq;
#pragma unroll
        for (int ai = 0; ai < 2; ++ai)
#pragma unroll
            for (int m = 0; m < 4; ++m) { const u32x2 md = rowmeta[row0 + ai * HALF + m * 16]; const int slot = (int)md.x; const float w8 = __uint_as_float(md.y);
                if (slot >= 0) { h16* rowp = Y + (size_t)slot * 1024 + col0;
#pragma unroll
                    for (int bj = 0; bj < 2; ++bj) { const f32x4 v0 = acc[ai][bj][m][0] * w8, v1 = acc[ai][bj][m][1] * w8;
                        u32x4 w; w.x = cvt_pk_f16(v0[0], v0[1]); w.y = cvt_pk_f16(v0[2], v0[3]); w.z = cvt_pk_f16(v1[0], v1[1]); w.w = cvt_pk_f16(v1[2], v1[3]);
                        *(u32x4*)(rowp + bj * HALF) = w; } }
                asm volatile("" ::: "memory"); }
    }
};

template <class Epi, class Sched>
__device__ __forceinline__ void gemm_phase(PG8_LAS unsigned char* lds, const int K, const Sched& S, const Epi& E) {
    const int tid = tidx(), wid = __builtin_amdgcn_readfirstlane(tid >> 6), lane = tid & 63, wr = wid >> 2, wc = wid & 3, fr = lane & 15, fq = lane >> 4;
    const int nt = K / BK;
    int R0, C0; stage_rc(tid * 16, R0, C0);
    const unsigned cb2 = (unsigned)C0 * 2u;
    unsigned voffB[2];
#pragma unroll
    for (int i = 0; i < 2; ++i) { const int R = R0 + 64 * i; const int Rb = Epi::PERM ? ((R & ~31) + perm32(R & 31)) : R; voffB[i] = (unsigned)(Rb * K) * 2u + cb2; }
    const size_t kstep = (size_t)(BK * 2);
    const size_t hstep = (size_t)HALF * K * 2;
    const unsigned ldsw = (unsigned)wid * 1024u;
    const int aoff = lds_byte(wr * 64 + fr, fq * 8), boff = lds_byte(wc * 32 + fr, fq * 8);
#define PG8_MKVA(u, va) do { _Pragma("unroll") for (int _h = 0; _h < 2; ++_h) _Pragma("unroll") for (int _i = 0; _i < 2; ++_i) { const int _r = _h * HALF + R0 + 64 * _i; \
        (va)[_h][_i] = ((u).gat ? (u).gat[_r] : (unsigned)(_r * K) * 2u) + cb2; } } while (0)
#define PG8_SA(b, h) (((b) * 2 + (h)) * HTB)
#define PG8_SB(b, h) ((4 + (b) * 2 + (h)) * HTB)
#define PG8_STAGE(bufoff, gbase, voff) do { _Pragma("unroll") for (int _i = 0; _i < 2; ++_i) \
        __builtin_amdgcn_global_load_lds((const unsigned*)((const char*)(gbase) + (voff)[_i]), (PG8_LAS unsigned*)(lds + (bufoff) + ldsw + _i * 8192), 16, 0, 0); } while (0)
#define PG8_LDA(dst, b, h) do { _Pragma("unroll") for (int m = 0; m < 4; ++m) _Pragma("unroll") for (int k = 0; k < 2; ++k) dst[m][k] = *(const PG8_LAS s16x8*)(lds + PG8_SA(b, h) + aoff + m * 2048 + k * 1024); } while (0)
#define PG8_LDB(dst, b, h) do { _Pragma("unroll") for (int n = 0; n < 2; ++n) _Pragma("unroll") for (int k = 0; k < 2; ++k) dst[n][k] = *(const PG8_LAS s16x8*)(lds + PG8_SB(b, h) + boff + n * 2048 + k * 1024); } while (0)
#define PG8_MMA(ai, bj, At, Bt) do { __builtin_amdgcn_s_setprio(1); _Pragma("unroll") for (int m = 0; m < 4; ++m) _Pragma("unroll") for (int n = 0; n < 2; ++n) _Pragma("unroll") for (int k = 0; k < 2; ++k) \
        acc[ai][bj][m][n] = __builtin_amdgcn_mfma_f32_16x16x32_f16(__builtin_bit_cast(h16x8, Bt[n][k]), __builtin_bit_cast(h16x8, At[m][k]), acc[ai][bj][m][n], 0, 0, 0); __builtin_amdgcn_s_setprio(0); } while (0)
#define PG8_WAIT_V(n) asm volatile("s_waitcnt vmcnt(" #n ")" ::: "memory")
#define PG8_WAIT_L(n) asm volatile("s_waitcnt lgkmcnt(" #n ")" ::: "memory")
#define PG8_BAR __builtin_amdgcn_s_barrier()
#define PG8_SCHED __builtin_amdgcn_sched_barrier(0)
    Unit cur, nxt; int ui = 0;
    if (!S.next(0, cur)) return;
    unsigned va[2][2];
    PG8_MKVA(cur, va);
    f32x4 acc[2][2][4][2];
#pragma unroll
    for (int a = 0; a < 2; ++a)
#pragma unroll
        for (int b = 0; b < 2; ++b)
#pragma unroll
            for (int m = 0; m < 4; ++m)
#pragma unroll
                for (int n = 0; n < 2; ++n) acc[a][b][m][n] = (f32x4){0.f, 0.f, 0.f, 0.f};
    s16x8 At[4][2], B0[2][2], B1[2][2];
    const char* cA = cur.A; const char* cB = cur.B;
    {
        PG8_STAGE(PG8_SB(0, 0), cB, voffB); PG8_STAGE(PG8_SB(0, 1), cB + hstep, voffB); PG8_STAGE(PG8_SA(0, 0), cA, va[0]); PG8_STAGE(PG8_SA(0, 1), cA, va[1]);
        if (wr == 1) PG8_BAR;
        PG8_WAIT_V(2); PG8_BAR;
        PG8_STAGE(PG8_SB(1, 0), cB + kstep, voffB); PG8_STAGE(PG8_SA(1, 0), cA + kstep, va[0]); PG8_STAGE(PG8_SB(1, 1), cB + hstep + kstep, voffB);
        PG8_WAIT_V(6); PG8_BAR;
    }
    for (;;) {
        const bool has_next = S.next(ui + 1, nxt);
        const char* nA = has_next ? nxt.A : cA; const char* nB = has_next ? nxt.B : cB;
#pragma unroll 1
        for (int t = 0; t < nt; t += 2) {
            const bool last = (t == nt - 2);
            const char* a1 = cA + (size_t)(t + 1) * kstep;
            const char* a2 = last ? nA : cA + (size_t)(t + 2) * kstep; const char* b2 = last ? nB : cB + (size_t)(t + 2) * kstep;
            const char* a3 = a2 + kstep; const char* b3 = b2 + kstep;
            PG8_LDB(B0, 0, 0); PG8_LDB(B1, 0, 1); PG8_SCHED; PG8_LDA(At, 0, 0); PG8_STAGE(PG8_SA(1, 1), a1, va[1]);
            if (last && has_next) { PG8_MKVA(nxt, va); }
            PG8_WAIT_V(8); PG8_WAIT_L(0); PG8_BAR; PG8_MMA(0, 0, At, B0); PG8_MMA(0, 1, At, B1); PG8_BAR; PG8_SCHED;
            PG8_LDA(At, 0, 1); PG8_STAGE(PG8_SB(0, 0), b2, voffB); PG8_STAGE(PG8_SB(0, 1), b2 + hstep, voffB); PG8_STAGE(PG8_SA(0, 0), a2, va[0]);
            PG8_WAIT_V(8); PG8_WAIT_L(0); PG8_BAR; PG8_MMA(1, 0, At, B0); PG8_MMA(1, 1, At, B1); PG8_BAR; PG8_SCHED;
            PG8_LDB(B0, 1, 0); PG8_LDB(B1, 1, 1); PG8_SCHED; PG8_LDA(At, 1, 0); PG8_STAGE(PG8_SA(0, 1), a2, va[1]);
            PG8_WAIT_V(8); PG8_WAIT_L(0); PG8_BAR; PG8_MMA(0, 0, At, B0); PG8_MMA(0, 1, At, B1); PG8_BAR; PG8_SCHED;
            PG8_LDA(At, 1, 1); PG8_STAGE(PG8_SB(1, 0), b3, voffB); PG8_STAGE(PG8_SB(1, 1), b3 + hstep, voffB); PG8_STAGE(PG8_SA(1, 0), a3, va[0]);
            PG8_WAIT_V(8); PG8_WAIT_L(0); PG8_BAR; PG8_MMA(1, 0, At, B0); PG8_MMA(1, 1, At, B1); PG8_BAR; PG8_SCHED;
        }
        if (wr == 0) PG8_BAR;
        E(acc, cur, wr, wc, fr, fq);
        if (!has_next) break;
#pragma unroll
        for (int a = 0; a < 2; ++a)
#pragma unroll
            for (int b = 0; b < 2; ++b)
#pragma unroll
                for (int m = 0; m < 4; ++m)
#pragma unroll
                    for (int n = 0; n < 2; ++n) acc[a][b][m][n] = (f32x4){0.f, 0.f, 0.f, 0.f};
        cur = nxt; cA = nA; cB = nB; ++ui;
        if (wr == 1) PG8_BAR;
    }
    PG8_WAIT_V(0);
    PG8_BAR;
#undef PG8_MKVA
#undef PG8_SA
#undef PG8_SB
#undef PG8_STAGE
#undef PG8_LDA
#undef PG8_LDB
#undef PG8_MMA
#undef PG8_WAIT_V
#undef PG8_WAIT_L
#undef PG8_BAR
#undef PG8_SCHED
}
}


#include <hip/hip_cooperative_groups.h>
namespace cg = cooperative_groups;
constexpr int NTHR = 512;
constexpr int LDS_BYTES = 147456;
#define LAS __attribute__((address_space(3)))

struct Params {
    const float *x, *mem; const int* positions;
    const float *w_in, *pe_k, *pe_v, *w1k, *w2k, *w1v, *w2v, *w_out, *ln1g, *ln1b, *w_xq, *w_xkv, *w_xo, *ln2g, *ln2b, *w_router, *rbias, *w_gate, *w_up, *w_down, *ws_gate, *ws_up, *ws_down, *ln3g, *ln3b;
    float* out; unsigned char* ws;
    float lg[4];
    int ph_lo, ph_hi;
};

__device__ __forceinline__ float wave_sum(float v) {
#pragma unroll
    for (int o = 1; o < 64; o <<= 1) v += __shfl_xor(v, o);
    return v;
}
__device__ __forceinline__ float wave_max(float v) {
#pragma unroll
    for (int o = 1; o < 64; o <<= 1) v = fmaxf(v, __shfl_xor(v, o));
    return v;
}
__device__ __forceinline__ float siluf(float v) { return v / (1.f + __expf(-v)); }
__device__ __forceinline__ float sigmf(float v) { return 1.f / (1.f + __expf(-v)); }

__device__ __forceinline__ void b_transpose_tile(const float* __restrict__ W, int K, int N, h16* __restrict__ WT, int Npad, int tile, float* tl, int lt, int rs = 1, int ro = 0) {
    const int ntn = Npad / 32; const int n0 = (tile % ntn) * 32, k0 = (tile / ntn) * 32, tx = lt & 31, ty = lt >> 5;
    for (int i = ty; i < 32; i += 8) { const int k = k0 + i, n = n0 + tx; tl[i * 33 + tx] = (n < N) ? W[(size_t)k * N + n] : 0.f; }
    __syncthreads();
    for (int i = ty; i < 32; i += 8) { const int n = n0 + i, k = k0 + tx; WT[(size_t)(n * rs + ro) * K + k] = (h16)tl[tx * 33 + i]; }
    __syncthreads();
}
__device__ __forceinline__ void b_cvt(const float* __restrict__ x, h16* __restrict__ o, size_t n4) {
    for (size_t i = (size_t)blockIdx.x * NTHR + tidx(); i < n4; i += (size_t)gridDim.x * NTHR) {
        const f32x4 v = ((const f32x4*)x)[i]; u32x2 w; w.x = pg8::cvt_pk_f16(v[0], v[1]); w.y = pg8::cvt_pk_f16(v[2], v[3]); ((u32x2*)o)[i] = w; }
}

__device__ __forceinline__ void b_rope(h16* __restrict__ h, h16* __restrict__ nqr, const int* __restrict__ positions, int m, int j) {
    h16* hr = h + (size_t)m * INP;
    const float pos = (float)positions[m];
    {   const int hd = j >> 6, jj = j & 63;
        const float inv = (float)pow(10000.0, -(double)jj / 64.0);
        const float ang = pos * inv; double sd, cd; sincos((double)ang, &sd, &cd); const float c = (float)cd, s = (float)sd;
        const int o1 = hd * 128 + jj, o2 = o1 + 64;
        const float q1 = (float)hr[C_RQ + o1], q2 = (float)hr[C_RQ + o2];
        hr[C_RQ + o1] = (h16)(q1 * c - q2 * s); hr[C_RQ + o2] = (h16)(q2 * c + q1 * s);
        const float k1 = (float)hr[C_RK + o1], k2 = (float)hr[C_RK + o2]; const float sc = 0.08838834764831845f;
        hr[C_RK + o1] = (h16)((k1 * c - k2 * s) * sc); hr[C_RK + o2] = (h16)((k2 * c + k1 * s) * sc);
    }
    if (j < 64 + 16 + 16) {
        const int jj = j & 7;
        const float inv = (float)pow(500000.0, -(double)jj / 8.0);
        const float ang = pos * inv; double sd, cd; sincos((double)ang, &sd, &cd); const float c = (float)cd, s = (float)sd;
        if (j < 64) { const int hd = j >> 3; const int o1 = hd * 64 + jj, o2 = o1 + 8;
            const float q1 = (float)hr[C_NQ + o1], q2 = (float)hr[C_NQ + o2];
            nqr[(size_t)m * 512 + o1] = (h16)(q1 * c - q2 * s); nqr[(size_t)m * 512 + o2] = (h16)(q2 * c + q1 * s);
        } else { const int jx = j - 64; const int which = jx >> 4, g = (jx >> 3) & 1; const int base = (which ? C_NKW : C_NKS) + g * 64 + jj;
            const float k1 = (float)hr[base], k2 = (float)hr[base + 8];
            hr[base] = (h16)(k1 * c - k2 * s); hr[base + 8] = (h16)(k2 * c + k1 * s); }
    }
    for (int i = j; i < 8 * 48; i += 256) { const int hd = i / 48, d = 16 + i % 48; nqr[(size_t)m * 512 + hd * 64 + d] = hr[C_NQ + hd * 64 + d]; }
}

__device__ __forceinline__ void b_cmp(const Params& p, const h16* __restrict__ h, h16* __restrict__ kcmp, h16* __restrict__ vcmpT, int item, float* sl, int lt) {
    float* a = sl; float* hid = sl + 2048;
    int id = item; const int g = id & 1; id >>= 1; const int c = id % 511; id /= 511; const int b = id & 3; const int kv = id >> 2;
    const float* pe = kv ? p.pe_v : p.pe_k; const float* w1 = kv ? p.w1v : p.w1k; const float* w2 = kv ? p.w2v : p.w2k;
    const int colb = (kv ? C_NVC : C_NKC) + g * 64;
    for (int i = lt; i < 2048; i += 256) { const int l = i >> 6, d = i & 63; a[i] = (float)h[(size_t)(b * T + 16 * c + l) * INP + colb + d] + pe[l * 64 + d]; }
    __syncthreads();
    { const int j = lt; float acc = 0.f;
        for (int k = 0; k < 2048; ++k) acc += a[k] * w1[(size_t)k * 256 + j];
        hid[j] = siluf(acc); }
    __syncthreads();
    if (lt < 64) { const int e = lt; float acc = 0.f;
        for (int j = 0; j < 256; ++j) acc += hid[j] * w2[j * 64 + e];
        if (kv == 0) { kcmp[((size_t)(b * 2 + g) * 512 + c) * 64 + e] = (h16)acc; if (c == 510) kcmp[((size_t)(b * 2 + g) * 512 + 511) * 64 + e] = (h16)0.f; }
        else { vcmpT[((size_t)(b * 2 + g) * 64 + e) * 512 + c] = (h16)acc; if (c == 510) vcmpT[((size_t)(b * 2 + g) * 64 + e) * 512 + 511] = (h16)0.f; } }
    __syncthreads();
}
__device__ __forceinline__ void b_vtrans(const h16* __restrict__ h, h16* __restrict__ vsT, h16* __restrict__ vwT, int item, h16* sl, int lt) {
    int id = item; const int tt = id & 127; id >>= 7; const int g = id & 1; id >>= 1; const int b = id & 3; const int which = id >> 2;
    const int col = (which ? C_NVW : C_NVS) + g * 64; h16* dst = (which ? vwT : vsT) + (size_t)((b * 2 + g) * 64) * T + tt * 64;
    for (int i = lt; i < 64 * 64; i += 256) { const int t = i >> 6, d = i & 63; sl[t * 66 + d] = h[(size_t)(b * T + tt * 64 + t) * INP + col + d]; }
    __syncthreads();
    for (int i = lt; i < 64 * 64; i += 256) { const int d = i >> 6, t = i & 63; dst[(size_t)d * T + t] = sl[t * 66 + d]; }
    __syncthreads();
}

__device__ __forceinline__ void b_ret_kv(const Params& p, const h16* __restrict__ h, float* __restrict__ kvb, int id, int lt) {
    const int n = id & 63, hd = (id >> 6) & 3, b = id >> 8;
    const float lg = p.lg[hd];
    const int d = lt >> 1, e0 = (lt & 1) * 64;
    float acc[64];
#pragma unroll
    for (int i = 0; i < 64; ++i) acc[i] = 0.f;
    const h16* base = h + (size_t)(b * T + n * 128) * INP;
    for (int j = 0; j < 128; ++j) {
        const float kd = (float)base[(size_t)j * INP + C_RK + hd * 128 + d] * __expf(lg * (float)(127 - j));
        const h16x8* vp = (const h16x8*)(base + (size_t)j * INP + C_RV + hd * 128 + e0);
#pragma unroll
        for (int i8 = 0; i8 < 8; ++i8) { const h16x8 v = vp[i8];
#pragma unroll
            for (int i = 0; i < 8; ++i) acc[i8 * 8 + i] += kd * (float)v[i]; }
    }
    float* o = kvb + ((size_t)id * 128 + d) * 128 + e0;
#pragma unroll
    for (int i = 0; i < 64; ++i) o[i] = acc[i];
}
__device__ __forceinline__ void b_ret_scan(const Params& p, const float* __restrict__ kvb, float* __restrict__ prev) {
    for (int gid = blockIdx.x * NTHR + tidx(); gid < 16 * 16384; gid += gridDim.x * NTHR) {
        const int de = gid & 16383, bh = gid >> 14; const float cd = __expf(p.lg[bh & 3] * 128.f);
        float st = 0.f;
        for (int n = 0; n < 64; ++n) { const size_t o = ((size_t)(bh * 64 + n) << 14) + de; prev[o] = st; st = st * cd + kvb[o]; }
    }
}
__device__ __forceinline__ void b_ret_out(const Params& p, const h16* __restrict__ h, const float* __restrict__ prev, h16* __restrict__ mix, int item, float* sl, int tid) {
    float* q = sl; float* s = sl + 128; float* red = sl + 256;
    int id = item; const int i = id & 127; id >>= 7; const int n = id & 63, hd = (id >> 6) & 3, b = id >> 8;
    const float lg = p.lg[hd];
    const size_t m = (size_t)b * T + n * 128 + i;
    q[tid] = (float)h[m * INP + C_RQ + hd * 128 + tid];
    __syncthreads();
    { const int j = tid; float acc = 0.f;
        if (j <= i) { const h16x8* kp = (const h16x8*)(h + ((size_t)b * T + n * 128 + j) * INP + C_RK + hd * 128);
#pragma unroll
            for (int d8 = 0; d8 < 16; ++d8) { const h16x8 kv = kp[d8];
#pragma unroll
                for (int x = 0; x < 8; ++x) acc += q[d8 * 8 + x] * (float)kv[x]; }
            acc *= __expf(lg * (float)(i - j)); }
        s[j] = acc; }
    __syncthreads();
    const int e = tid; float inner = 0.f, cross = 0.f;
    { const h16* vb = h + ((size_t)b * T + n * 128) * INP + C_RV + hd * 128 + e;
        for (int j = 0; j <= i; ++j) inner += s[j] * (float)vb[(size_t)j * INP];
        const float* pp = prev + ((size_t)((b * 4 + hd) * 64 + n) << 14) + e;
        for (int d = 0; d < 128; ++d) cross += q[d] * pp[d * 128];
        cross *= __expf(lg * (float)(i + 1)); }
    const float o = inner + cross;
    float sm = wave_sum(o); if ((tid & 63) == 0) red[tid >> 6] = sm; __syncthreads();
    const float mu = (red[0] + red[1]) * (1.f / 128.f); const float dv = o - mu;
    float sq = wave_sum(dv * dv); if ((tid & 63) == 0) red[2 + (tid >> 6)] = sq; __syncthreads();
    const float var = (red[2] + red[3]) * (1.f / 128.f);
    const float on = dv * rsqrtf(var + LN_EPS);
    const float gt = (float)h[m * INP + C_RG + hd * 128 + e];
    mix[m * D + hd * 128 + e] = (h16)(siluf(gt) * on);
    __syncthreads();
}

struct AttSt { float m, l; f32x4 o[4]; };
template <class MaskF>
__device__ __forceinline__ void att_scores(f32x4 (&s)[4], const h16* __restrict__ Kb, int pitchK, const h16x8 (&qf)[2], int i, int kg, MaskF valid) {
#pragma unroll
    for (int tl = 0; tl < 4; ++tl) { const int ko = 32 * (tl >> 1) + 8 * (i >> 2) + 4 * (tl & 1) + (i & 3); const h16* kp = Kb + (size_t)ko * pitchK + 8 * kg;
        const h16x8 a0 = *(const h16x8*)kp, a1 = *(const h16x8*)(kp + 32);
        f32x4 z = {0.f, 0.f, 0.f, 0.f}; z = __builtin_amdgcn_mfma_f32_16x16x32_f16(a0, qf[0], z, 0, 0, 0); s[tl] = __builtin_amdgcn_mfma_f32_16x16x32_f16(a1, qf[1], z, 0, 0, 0); }
#pragma unroll
    for (int tl = 0; tl < 4; ++tl)
#pragma unroll
        for (int r = 0; r < 4; ++r) { const int ko = 32 * (tl >> 1) + 8 * kg + 4 * (tl & 1) + r; s[tl][r] = valid(ko) ? s[tl][r] * 0.125f : -INFINITY; }
}
__device__ __forceinline__ void att_pv(f32x4 (&o)[4], const f32x4 (&pv)[4], const h16* __restrict__ VTb, int vstride, int i, int kg) {
    h16x8 pf[2];
#pragma unroll
    for (int s2 = 0; s2 < 2; ++s2)
#pragma unroll
        for (int j = 0; j < 8; ++j) pf[s2][j] = (h16)pv[2 * s2 + (j >> 2)][j & 3];
#pragma unroll
    for (int dt = 0; dt < 4; ++dt)
#pragma unroll
        for (int s2 = 0; s2 < 2; ++s2) { const h16x8 a = *(const h16x8*)(VTb + (size_t)(16 * dt + i) * vstride + 32 * s2 + 8 * kg);
            o[dt] = __builtin_amdgcn_mfma_f32_16x16x32_f16(a, pf[s2], o[dt], 0, 0, 0); }
}
template <class MaskF>
__device__ __forceinline__ void att_tile(AttSt& st, const h16* __restrict__ Kb, int pitchK, const h16* __restrict__ VTb, int vstride, const h16x8 (&qf)[2], int i, int kg, MaskF valid) {
    f32x4 s[4]; att_scores(s, Kb, pitchK, qf, i, kg, valid);
    float mx = -INFINITY;
#pragma unroll
    for (int tl = 0; tl < 4; ++tl)
#pragma unroll
        for (int r = 0; r < 4; ++r) mx = fmaxf(mx, s[tl][r]);
    mx = fmaxf(mx, __shfl_xor(mx, 16)); mx = fmaxf(mx, __shfl_xor(mx, 32));
    const float mn = fmaxf(st.m, mx); const float alpha = __expf(st.m - mn); st.m = mn;
    float ps = 0.f;
#pragma unroll
    for (int tl = 0; tl < 4; ++tl)
#pragma unroll
        for (int r = 0; r < 4; ++r) { const float pe = __expf(s[tl][r] - mn); s[tl][r] = pe; ps += pe; }
    st.l = st.l * alpha + ps;
#pragma unroll
    for (int dt = 0; dt < 4; ++dt) st.o[dt] = st.o[dt] * alpha;
    att_pv(st.o, s, VTb, vstride, i, kg);
}
__device__ __forceinline__ void nsa_wave_unit(const h16* __restrict__ h, const h16* __restrict__ nqr, const h16* __restrict__ kcmp, const h16* __restrict__ vcmpT, const h16* __restrict__ vsT, const h16* __restrict__ vwT,
                                              h16* __restrict__ mix, int b, int g, int t0, float* wl, int lane) {
    const int i = lane & 15, kg = lane >> 4, tt = i & 3, hh = i >> 2;
    const int trow = t0 + tt; const size_t mrow = (size_t)b * T + trow;
    h16x8 qf[2], qrf[2];
    { const h16* qp = h + mrow * INP + C_NQ + (g * 4 + hh) * 64 + 8 * kg; qf[0] = *(const h16x8*)qp; qf[1] = *(const h16x8*)(qp + 32);
      const h16* qrp = nqr + mrow * 512 + (g * 4 + hh) * 64 + 8 * kg; qrf[0] = *(const h16x8*)qrp; qrf[1] = *(const h16x8*)(qrp + 32); }
    float* impA = wl; float* impL = wl + 512; float* vals = wl + 1024;
    for (int x = lane; x < 1024; x += 64) wl[x] = 0.f;
    const int ncv_row = trow >= 31 ? ((trow - 31) >> 4) + 1 : 0;
    const int ncv_max = (t0 + 3 >= 31) ? ((t0 + 3 - 31) >> 4) + 1 : 0;
    const int nct = (ncv_max + 63) >> 6;
    const h16* Kc = kcmp + (size_t)(b * 2 + g) * 512 * 64; const h16* Vc = vcmpT + (size_t)(b * 2 + g) * 64 * 512;
    float m = -1e30f, l = 0.f;
    for (int ct = 0; ct < nct; ++ct) {
        f32x4 s[4]; att_scores(s, Kc + (size_t)ct * 64 * 64, 64, qf, i, kg, [&](int ko) { return ct * 64 + ko < ncv_row; });
        float mx = -INFINITY;
#pragma unroll
        for (int tl = 0; tl < 4; ++tl)
#pragma unroll
            for (int r = 0; r < 4; ++r) mx = fmaxf(mx, s[tl][r]);
        mx = fmaxf(mx, __shfl_xor(mx, 16)); mx = fmaxf(mx, __shfl_xor(mx, 32));
        const float mn = fmaxf(m, mx); float ps = 0.f;
#pragma unroll
        for (int tl = 0; tl < 4; ++tl)
#pragma unroll
            for (int r = 0; r < 4; ++r) ps += __expf(s[tl][r] - mn);
        l = l * __expf(m - mn) + ps; m = mn;
    }
    l += __shfl_xor(l, 16); l += __shfl_xor(l, 32);
    const float linv = l > 0.f ? 1.f / l : 0.f;
    f32x4 oc[4];
#pragma unroll
    for (int dt = 0; dt < 4; ++dt) oc[dt] = (f32x4){0.f, 0.f, 0.f, 0.f};
    for (int ct = 0; ct < nct; ++ct) {
        f32x4 s[4]; att_scores(s, Kc + (size_t)ct * 64 * 64, 64, qf, i, kg, [&](int ko) { return ct * 64 + ko < ncv_row; });
#pragma unroll
        for (int tl = 0; tl < 4; ++tl) {
#pragma unroll
            for (int r = 0; r < 4; ++r) s[tl][r] = __expf(s[tl][r] - m) * linv;
            float A = (s[tl][0] + s[tl][1]) + (s[tl][2] + s[tl][3]), L = s[tl][3];
            A += __shfl_xor(A, 4); A += __shfl_xor(A, 8); L += __shfl_xor(L, 4); L += __shfl_xor(L, 8);
            if (hh == 0) { const int u = ct * 16 + 8 * (tl >> 1) + 2 * kg + (tl & 1); impA[tt * 128 + u] = A; impL[tt * 128 + u] = L; }
        }
        att_pv(oc, s, Vc + ct * 64, 512, i, kg);
    }
    const int cur = t0 >> 6;
    unsigned long long mylo = 0ull, myhi = 0ull, anylo = 0ull, anyhi = 0ull;
    for (int tk = 0; tk < 4; ++tk) {
        float v0, v1;
        { const int s0 = lane, s1 = lane + 64;
          v0 = impA[tk * 128 + s0] + (s0 > 0 ? impL[tk * 128 + s0 - 1] : 0.f); v1 = impA[tk * 128 + s1] + impL[tk * 128 + s1 - 1];
          if (s0 == 0 || s0 == cur || s0 == cur - 1) v0 = 1e9f; if (s1 == cur || s1 == cur - 1) v1 = 1e9f;
          if (s0 > cur) v0 = NEGF; if (s1 > cur) v1 = NEGF; }
        vals[lane] = v0; vals[lane + 64] = v1;
        int r0 = 0, r1 = 0;
        for (int s2 = 0; s2 < 128; ++s2) { const float x = vals[s2]; r0 += (x > v0 || (x == v0 && s2 < lane)) ? 1 : 0; r1 += (x > v1 || (x == v1 && s2 < lane + 64)) ? 1 : 0; }
        const unsigned long long lo = __ballot(r0 < 16), hi = __ballot(r1 < 16);
        anylo |= lo; anyhi |= hi; if (tt == tk) { mylo = lo; myhi = hi; }
    }
    AttSt ss; ss.m = -1e30f; ss.l = 0.f;
#pragma unroll
    for (int dt = 0; dt < 4; ++dt) ss.o[dt] = (f32x4){0.f, 0.f, 0.f, 0.f};
    for (int s = 0; s <= cur; ++s) {
        const unsigned long long am = s < 64 ? anylo : anyhi; if (!((am >> (s & 63)) & 1ull)) continue;
        const bool mybit = (((s < 64 ? mylo : myhi) >> (s & 63)) & 1ull) != 0ull;
        att_tile(ss, h + ((size_t)b * T + 64 * s) * INP + C_NKS + g * 64, INP, vsT + (size_t)((b * 2 + g) * 64) * T + 64 * s, T, qrf, i, kg, [&](int ko) { return mybit && (64 * s + ko <= trow); });
    }
    AttSt sw; sw.m = -1e30f; sw.l = 0.f;
#pragma unroll
    for (int dt = 0; dt < 4; ++dt) sw.o[dt] = (f32x4){0.f, 0.f, 0.f, 0.f};
    for (int s = (t0 >= 511 ? (t0 - 511) >> 6 : 0); s <= cur; ++s)
        att_tile(sw, h + ((size_t)b * T + 64 * s) * INP + C_NKW + g * 64, INP, vwT + (size_t)((b * 2 + g) * 64) * T + 64 * s, T, qrf, i, kg, [&](int ko) { const int kp = 64 * s + ko; return kp <= trow && kp >= trow - 511; });
    float ls = ss.l; ls += __shfl_xor(ls, 16); ls += __shfl_xor(ls, 32); float lw = sw.l; lw += __shfl_xor(lw, 16); lw += __shfl_xor(lw, 32);
    const h16* gp = h + mrow * INP + C_NG + (g * 4 + hh) * 3;
    const float g0 = sigmf((float)gp[0]), g1 = sigmf((float)gp[1]) / ls, g2 = sigmf((float)gp[2]) / lw;
#pragma unroll
    for (int dt = 0; dt < 4; ++dt) { const f32x4 o = oc[dt] * g0 + ss.o[dt] * g1 + sw.o[dt] * g2;
        u32x2 w; w.x = pg8::cvt_pk_f16(o[0], o[1]); w.y = pg8::cvt_pk_f16(o[2], o[3]);
        *(u32x2*)(mix + mrow * D + 512 + (g * 4 + hh) * 64 + 16 * dt + 4 * kg) = w; }
}

__device__ __forceinline__ void b_ln(const float* __restrict__ in, const float* __restrict__ gam, const float* __restrict__ bet, float* __restrict__ o32, h16* __restrict__ o16) {
    const int lane = tidx() & 63;
    for (int row = blockIdx.x * 8 + (tidx() >> 6); row < M; row += gridDim.x * 8) {
        const f32x4* xr = (const f32x4*)(in + (size_t)row * D) + lane;
        f32x4 v[4]; float s = 0.f;
#pragma unroll
        for (int j = 0; j < 4; ++j) { v[j] = xr[64 * j]; s += (v[j][0] + v[j][1]) + (v[j][2] + v[j][3]); }
        const float mean = wave_sum(s) * (1.f / D); float s2 = 0.f;
#pragma unroll
        for (int j = 0; j < 4; ++j) { v[j] = v[j] - mean; s2 += (v[j][0] * v[j][0] + v[j][1] * v[j][1]) + (v[j][2] * v[j][2] + v[j][3] * v[j][3]); }
        const float rstd = rsqrtf(wave_sum(s2) * (1.f / D) + LN_EPS);
#pragma unroll
        for (int j = 0; j < 4; ++j) { const f32x4 gg = ((const f32x4*)gam)[lane + 64 * j], bb = ((const f32x4*)bet)[lane + 64 * j]; const f32x4 o = v[j] * rstd * gg + bb;
            ((f32x4*)(o32 + (size_t)row * D))[lane + 64 * j] = o;
            if (o16) { u32x2 w; w.x = pg8::cvt_pk_f16(o[0], o[1]); w.y = pg8::cvt_pk_f16(o[2], o[3]); ((u32x2*)(o16 + (size_t)row * D))[lane + 64 * j] = w; } }
    }
}

__device__ __forceinline__ void b_xattn(const h16* __restrict__ qx, const h16* __restrict__ kvm, h16* __restrict__ ox, int m, float* sl, int tid) {
    float* q = sl; float (*pr)[256] = (float (*)[256])(sl + 1024);
    const int b = m >> 13;
    for (int i = tid; i < 1024; i += 256) q[i] = (float)qx[(size_t)m * D + i];
    __syncthreads();
    { const h16x8* kp = (const h16x8*)(kvm + (size_t)(b * MEML + tid) * 2048);
        for (int hh = 0; hh < 4; ++hh) { float a = 0.f;
            for (int d8 = 0; d8 < 32; ++d8) { const h16x8 kv = kp[hh * 32 + d8];
#pragma unroll
                for (int x = 0; x < 8; ++x) a += q[hh * 256 + d8 * 8 + x] * (float)kv[x]; }
            pr[hh][tid] = a * 0.0625f; } }
    __syncthreads();
    { const int w = tid >> 6, lane = tid & 63; float v[4]; float mx = -INFINITY;
#pragma unroll
        for (int i = 0; i < 4; ++i) { v[i] = pr[w][lane + 64 * i]; mx = fmaxf(mx, v[i]); }
        mx = wave_max(mx); float sm = 0.f;
#pragma unroll
        for (int i = 0; i < 4; ++i) { v[i] = __expf(v[i] - mx); sm += v[i]; }
        sm = wave_sum(sm); const float is = 1.f / sm;
#pragma unroll
        for (int i = 0; i < 4; ++i) pr[w][lane + 64 * i] = v[i] * is; }
    __syncthreads();
    { const h16* vp = kvm + (size_t)(b * MEML) * 2048 + 1024 + tid;
        for (int hh = 0; hh < 4; ++hh) { float a = 0.f;
            for (int mm = 0; mm < 256; ++mm) a += pr[hh][mm] * (float)vp[(size_t)mm * 2048 + hh * 256];
            ox[(size_t)m * D + hh * 256 + tid] = (h16)a; } }
    __syncthreads();
}

__device__ __forceinline__ void b_router(const Params& p, const float* __restrict__ x2, int* __restrict__ tope, float* __restrict__ topw, int* __restrict__ hist) {
    const int lane = tidx() & 63; const float* wr = p.w_router;
    for (int m = blockIdx.x * 8 + (tidx() >> 6); m < M; m += gridDim.x * 8) {
        const float* xr = x2 + (size_t)m * D; float acc = 0.f;
        for (int k = 0; k < D; k += 4) { const f32x4 xv = *(const f32x4*)(xr + k);
            acc += xv[0] * wr[(k + 0) * 64 + lane]; acc += xv[1] * wr[(k + 1) * 64 + lane]; acc += xv[2] * wr[(k + 2) * 64 + lane]; acc += xv[3] * wr[(k + 3) * 64 + lane]; }
        const float score = 1.f / (1.f + expf(-acc)); const float biased = score + p.rbias[lane];
        float m1 = biased; m1 = fmaxf(m1, __shfl_xor(m1, 1)); m1 = fmaxf(m1, __shfl_xor(m1, 2)); m1 = fmaxf(m1, __shfl_xor(m1, 4));
        int am = (biased == m1) ? lane : 999; am = min(am, __shfl_xor(am, 1)); am = min(am, __shfl_xor(am, 2)); am = min(am, __shfl_xor(am, 4));
        float m2 = (lane == am) ? -INFINITY : biased; m2 = fmaxf(m2, __shfl_xor(m2, 1)); m2 = fmaxf(m2, __shfl_xor(m2, 2)); m2 = fmaxf(m2, __shfl_xor(m2, 4));
        const float gs = m1 + m2;
        int cnt = 0;
#pragma unroll
        for (int gq = 0; gq < 8; ++gq) { const float o = __shfl(gs, gq * 8); cnt += (o > gs) ? 1 : 0; }
        const float masked = (cnt <= 3) ? biased : NEGF;
        int rank = 0;
        for (int e2 = 0; e2 < 64; ++e2) { const float o = __shfl(masked, e2); rank += (o > masked || (o == masked && e2 < lane)) ? 1 : 0; }
        const bool selq = rank < 8;
        const float wsum = wave_sum(selq ? score : 0.f);
        if (selq) { tope[(size_t)m * 8 + rank] = lane; topw[(size_t)m * 8 + rank] = score / wsum * 2.5f; atomicAdd(hist + (m >> 13) * 65 + lane, 1); }
    }
}

__device__ __forceinline__ void b_moe(const Params& p, const float* __restrict__ x2, const int* __restrict__ tope, const float* __restrict__ topw, float* __restrict__ out, int m, float* sl, int tid) {
    float* xs = sl; float* hd = sl + 1024; float* red = sl + 1280;
    for (int i = tid; i < 1024; i += 256) xs[i] = x2[(size_t)m * D + i];
    __syncthreads();
    float acc[4] = {0.f, 0.f, 0.f, 0.f};
    for (int kx = 0; kx < 9; ++kx) {
        const float* G; const float* U; const float* Dn; float wt;
        if (kx < 8) { const int e = tope[(size_t)m * 8 + kx]; wt = topw[(size_t)m * 8 + kx]; G = p.w_gate + (size_t)e * D * EFF; U = p.w_up + (size_t)e * D * EFF; Dn = p.w_down + (size_t)e * EFF * D; }
        else { wt = 1.f; G = p.ws_gate; U = p.ws_up; Dn = p.ws_down; }
        float a = 0.f, u = 0.f;
        for (int k = 0; k < D; ++k) { const float xv = xs[k]; a += xv * G[(size_t)k * EFF + tid]; u += xv * U[(size_t)k * EFF + tid]; }
        hd[tid] = siluf(a) * u * wt;
        __syncthreads();
        for (int j = 0; j < EFF; ++j) { const float hv = hd[j]; const float* dr = Dn + (size_t)j * D + tid;
            acc[0] += hv * dr[0]; acc[1] += hv * dr[256]; acc[2] += hv * dr[512]; acc[3] += hv * dr[768]; }
        __syncthreads();
    }
    float v[4]; float s = 0.f;
#pragma unroll
    for (int i = 0; i < 4; ++i) { v[i] = DN_ALPHA * xs[tid + 256 * i] + acc[i]; s += v[i]; }
    s = wave_sum(s); if ((tid & 63) == 0) red[tid >> 6] = s; __syncthreads();
    const float mean = (red[0] + red[1] + red[2] + red[3]) * (1.f / D); float s2 = 0.f;
#pragma unroll
    for (int i = 0; i < 4; ++i) { v[i] -= mean; s2 += v[i] * v[i]; }
    s2 = wave_sum(s2); if ((tid & 63) == 0) red[4 + (tid >> 6)] = s2; __syncthreads();
    const float rstd = rsqrtf((red[4] + red[5] + red[6] + red[7]) * (1.f / D) + LN_EPS);
#pragma unroll
    for (int i = 0; i < 4; ++i) out[(size_t)m * D + tid + 256 * i] = v[i] * rstd * p.ln3g[tid + 256 * i] + p.ln3b[tid + 256 * i];
    __syncthreads();
}

struct G1Sched {
    const int* ctl; const char* x2h; const unsigned* rowoff; const char* WguT; int G, c;
    __device__ bool next(int i, pg8::Unit& u) const {
        const int ntile = ctl[CTL_TQS + NQ]; const long L = (long)i * G + c; if (L >= 2L * ntile) return false;
        const int tile = (int)(L >> 1), pn = (int)(L & 1); const int e = ctl[CTL_TVE + tile] % 65;
        u.pm = tile; u.pn = pn; u.A = x2h; u.gat = rowoff + (size_t)tile * 256; u.B = WguT + ((size_t)e * 512 + pn * 256) * (D * 2); return true; }
};
struct G2Sched {
    const int* ctl; const char* H; const char* WdT; int q, G, c;
    __device__ bool next(int i, pg8::Unit& u) const {
        const int t0 = ctl[CTL_TQS + q], t1 = ctl[CTL_TQS + q + 1]; const long L = (long)i * G + c; if (L >= 4L * (t1 - t0)) return false;
        const int tile = t0 + (int)(L >> 2), pn = (int)(L & 3); const int e = ctl[CTL_TVE + tile] % 65;
        u.pm = tile; u.pn = pn; u.A = H + (size_t)tile * 256 * (EFF * 2); u.gat = nullptr; u.B = WdT + ((size_t)e * D + pn * 256) * (EFF * 2); return true; }
};
__device__ __forceinline__ void b_scatter(int* __restrict__ ctl, const int* __restrict__ tope, const float* __restrict__ topw, unsigned* __restrict__ rowoff, u32x2* __restrict__ rowmeta, int* sl) {
    int* pst = sl;
    if (tidx() == 0) { int acc = 0; for (int v = 0; v < NVE; ++v) { pst[v] = acc; acc += (ctl[CTL_CNT + v] + 255) & ~255; } pst[NVE] = acc; }
    __syncthreads();
    if (blockIdx.x == 0) {
        for (int v = tidx(); v <= NVE; v += NTHR) ctl[CTL_PST + v] = pst[v];
        if (tidx() <= NQ) ctl[CTL_TQS + tidx()] = pst[tidx() * 65] >> 8;
        for (int v = tidx(); v < NVE; v += NTHR) for (int tl = pst[v] >> 8; tl < (pst[v + 1] >> 8); ++tl) ctl[CTL_TVE + tl] = v;
    }
    for (int idx = blockIdx.x * NTHR + tidx(); idx < M * 9; idx += gridDim.x * NTHR) {
        int m, k, pos; float w;
        if (idx < M * 8) { m = idx >> 3; k = idx & 7; const int ve = (m >> 13) * 65 + tope[idx]; w = topw[idx]; pos = pst[ve] + atomicAdd(ctl + CTL_CUR + ve, 1); }
        else { m = idx - M * 8; k = 8; w = 1.f; pos = pst[(m >> 13) * 65 + 64] + (m & (QT - 1)); }
        rowoff[pos] = (unsigned)m * (D * 2); rowmeta[pos] = (u32x2){(unsigned)((m & (QT - 1)) * 9 + k), __float_as_uint(w)};
    }
    __syncthreads();
}
__device__ __forceinline__ void b_combine(const Params& p, const h16* __restrict__ x2h, const h16* __restrict__ Y, int q) {
    const int lane = tidx() & 63;
    for (int r = blockIdx.x * 8 + (tidx() >> 6); r < QT; r += gridDim.x * 8) {
        const int m = q * QT + r;
        float v[16];
        { const h16x8 a = ((const h16x8*)(x2h + (size_t)m * D))[lane], b = ((const h16x8*)(x2h + (size_t)m * D))[lane + 64];
#pragma unroll
          for (int i = 0; i < 8; ++i) { v[i] = DN_ALPHA * (float)a[i]; v[8 + i] = DN_ALPHA * (float)b[i]; } }
#pragma unroll
        for (int k = 0; k < 9; ++k) { const h16x8* yr = (const h16x8*)(Y + ((size_t)r * 9 + k) * D); const h16x8 a = yr[lane], b = yr[lane + 64];
#pragma unroll
            for (int i = 0; i < 8; ++i) { v[i] += (float)a[i]; v[8 + i] += (float)b[i]; } }
        float s = 0.f;
#pragma unroll
        for (int i = 0; i < 16; ++i) s += v[i];
        const float mean = wave_sum(s) * (1.f / D); float s2 = 0.f;
#pragma unroll
        for (int i = 0; i < 16; ++i) { v[i] -= mean; s2 += v[i] * v[i]; }
        const float rstd = rsqrtf(wave_sum(s2) * (1.f / D) + LN_EPS);
#pragma unroll
        for (int hlf = 0; hlf < 2; ++hlf) { const int c0 = (lane + 64 * hlf) * 8;
            const f32x4 g0 = *(const f32x4*)(p.ln3g + c0), g1 = *(const f32x4*)(p.ln3g + c0 + 4), b0 = *(const f32x4*)(p.ln3b + c0), b1 = *(const f32x4*)(p.ln3b + c0 + 4);
            f32x4 o0, o1;
#pragma unroll
            for (int i = 0; i < 4; ++i) { o0[i] = v[8 * hlf + i] * rstd * g0[i] + b0[i]; o1[i] = v[8 * hlf + 4 + i] * rstd * g1[i] + b1[i]; }
            *(f32x4*)(p.out + (size_t)m * D + c0) = o0; *(f32x4*)(p.out + (size_t)m * D + c0 + 4) = o1; }
    }
}

constexpr int N_PHASES = 23;
__global__ void __launch_bounds__(NTHR, 2) mega_fwd(Params p) {
    extern __shared__ __attribute__((aligned(16))) unsigned char lds[];
    cg::grid_group grid = cg::this_grid();
    const int G = (int)gridDim.x, bid = (int)blockIdx.x;
#define tid tidx()
    unsigned char* ws = p.ws;
    h16* WinT = (h16*)(ws + WS_WIN); h16* WoutT = (h16*)(ws + WS_WOUT); h16* WxqT = (h16*)(ws + WS_WXQ); h16* WxoT = (h16*)(ws + WS_WXO); h16* WxkvT = (h16*)(ws + WS_WXKV);
    h16* memh = (h16*)(ws + WS_MEMH); h16* kvm = (h16*)(ws + WS_KVM); h16* kcmp = (h16*)(ws + WS_KCMP); h16* vcmpT = (h16*)(ws + WS_VCMP); h16* vsT = (h16*)(ws + WS_VST); h16* vwT = (h16*)(ws + WS_VWT);
    int* tope = (int*)(ws + WS_TOPE); float* topw = (float*)(ws + WS_TOPW);
    h16* xh = (h16*)(ws + WS_XH); h16* mix = (h16*)(ws + WS_MIX); h16* ox = (h16*)(ws + WS_OX); h16* hb = (h16*)(ws + WS_H); h16* nqr = (h16*)(ws + WS_NQR);
    float* kvb = (float*)(ws + WS_KVB); float* prev = (float*)(ws + WS_PREV); float* pre = p.out; float* x1 = (float*)(ws + WS_X1); h16* x1h = (h16*)(ws + WS_X1H);
    h16* qx = (h16*)(ws + WS_QX); float* x2 = (float*)(ws + WS_X2); h16* x2h = (h16*)(ws + WS_X2H);
    int* ctl = (int*)ws; unsigned* rowoff = (unsigned*)(ws + WS_ROWOFF); u32x2* rowmeta = (u32x2*)(ws + WS_ROWMETA);
    h16* WguT = (h16*)(ws + WS_WGUT); h16* WdT = (h16*)(ws + WS_WDT); h16* Hm = (h16*)(ws + WS_HM); h16* Yq = (h16*)(ws + WS_Y);
    float* fl = (float*)lds;
    const int lo = p.ph_lo, hi = p.ph_hi;
#define IN(k) (lo <= (k) && (k) < hi)
#define SEAM(k) do { if (IN(k) && IN((k) + 1)) grid.sync(); } while (0)

    if (IN(0)) {
        const int sub = tid >> 8, lt = tid & 255; float* tl = fl + sub * 1088;
        constexpr int T0 = (INP / 32) * (D / 32), T1 = (D / 32) * (D / 32), T4 = (2 * D / 32) * (D / 32), TT = T0 + 3 * T1 + T4;
        for (int b0 = bid * 2; b0 < TT; b0 += G * 2) { int it = b0 + sub;
            if (it < T0) { b_transpose_tile(p.w_in, D, INC, WinT, INP, it, tl, lt); continue; } it -= T0;
            if (it < T1) { b_transpose_tile(p.w_out, D, D, WoutT, D, it, tl, lt); continue; } it -= T1;
            if (it < T1) { b_transpose_tile(p.w_xq, D, D, WxqT, D, it, tl, lt); continue; } it -= T1;
            if (it < T1) { b_transpose_tile(p.w_xo, D, D, WxoT, D, it, tl, lt); continue; } it -= T1;
            b_transpose_tile(p.w_xkv, D, 2 * D, WxkvT, 2 * D, it, tl, lt); }
        b_cvt(p.x, xh, (size_t)M * D / 4);
        b_cvt(p.mem, memh, (size_t)NB * MEML * D / 4);
        if (bid == 0) for (int i = tid; i < 1024; i += NTHR) ctl[i] = 0;
    }
    SEAM(0);
    if (IN(1)) {
        { pg8::Gemm g{xh, WinT, M, INP, D}; pg8::StaticOrder S; S.init(g, G, bid); pg8::EpiF16 E{hb, INP};
          pg8::gemm_phase<pg8::EpiF16, pg8::StaticOrder>((PG8_LAS unsigned char*)lds, g.K, S, E); }
        { pg8::Gemm g{memh, WxkvT, NB * MEML, 2 * D, D}; pg8::StaticOrder S; S.init(g, G, bid); pg8::EpiF16 E{kvm, 2 * D};
          pg8::gemm_phase<pg8::EpiF16, pg8::StaticOrder>((PG8_LAS unsigned char*)lds, g.K, S, E); }
    }
    SEAM(1);
    if (IN(2)) { const int sub = tid >> 8, lt = tid & 255;
        for (int b0 = bid * 2; b0 < M; b0 += G * 2) b_rope(hb, nqr, p.positions, b0 + sub, lt);
        for (int b0 = bid * 2; b0 < 2 * NB * 2 * 128; b0 += G * 2) b_vtrans(hb, vsT, vwT, b0 + sub, (h16*)(fl + sub * 2304), lt); }
    SEAM(2);
    if (IN(3)) { const int sub = tid >> 8, lt = tid & 255;
        for (int b0 = bid * 2; b0 < 2 * NB * 511 * 2; b0 += G * 2) b_cmp(p, hb, kcmp, vcmpT, b0 + sub, fl + sub * 2304, lt);
        for (int b0 = bid * 2; b0 < NB * 4 * 64; b0 += G * 2) b_ret_kv(p, hb, kvb, b0 + sub, lt); }
    SEAM(3);
    if (IN(4)) b_ret_scan(p, kvb, prev);
    SEAM(4);
    if (IN(5)) {
        { const int sub = tid >> 7, lt = tid & 127;
          for (int b0 = bid * 4; b0 < NB * 4 * 64 * 128; b0 += G * 4) b_ret_out(p, hb, prev, mix, b0 + sub, fl + sub * 260, lt); }
        { const int wv = __builtin_amdgcn_readfirstlane(tid >> 6), lane = tid & 63; float* wl = fl + wv * 1152;
          for (int u = bid * 8 + wv; u < NB * 2 * (T / 4); u += G * 8) { const int tg = (T / 4 - 1) - (u >> 3), bg = u & 7;
              nsa_wave_unit(hb, nqr, kcmp, vcmpT, vsT, vwT, mix, bg >> 1, bg & 1, tg * 4, wl, lane); } }
    }
    SEAM(5);
    if (IN(6)) { pg8::Gemm g{mix, WoutT, M, D, D}; pg8::StaticOrder S; S.init(g, G, bid); pg8::EpiResF32 E{pre, p.x, D, DN_ALPHA};
        pg8::gemm_phase<pg8::EpiResF32, pg8::StaticOrder>((PG8_LAS unsigned char*)lds, g.K, S, E); }
    SEAM(6);
    if (IN(7)) b_ln(pre, p.ln1g, p.ln1b, x1, x1h);
    SEAM(7);
    if (IN(8)) { pg8::Gemm g{x1h, WxqT, M, D, D}; pg8::StaticOrder S; S.init(g, G, bid); pg8::EpiF16 E{qx, D};
        pg8::gemm_phase<pg8::EpiF16, pg8::StaticOrder>((PG8_LAS unsigned char*)lds, g.K, S, E); }
    SEAM(8);
    if (IN(9)) { const int sub = tid >> 8, lt = tid & 255;
        for (int b0 = bid * 2; b0 < M; b0 += G * 2) b_xattn(qx, kvm, ox, b0 + sub, fl + sub * 2048, lt); }
    SEAM(9);
    if (IN(10)) { pg8::Gemm g{ox, WxoT, M, D, D}; pg8::StaticOrder S; S.init(g, G, bid); pg8::EpiResF32 E{pre, x1, D, DN_ALPHA};
        pg8::gemm_phase<pg8::EpiResF32, pg8::StaticOrder>((PG8_LAS unsigned char*)lds, g.K, S, E); }
    SEAM(10);
    if (IN(11)) b_ln(pre, p.ln2g, p.ln2b, x2, x2h);
    SEAM(11);
    if (IN(12)) {
        b_router(p, x2, tope, topw, ctl + CTL_CNT);
        if (bid == 0 && tid < NQ) ctl[CTL_CNT + tid * 65 + 64] = QT;
        for (int i = bid * NTHR + tid; i < CAP; i += G * NTHR) { rowoff[i] = 0u; rowmeta[i] = (u32x2){0xffffffffu, 0u}; }
        const int sub = tid >> 8, lt = tid & 255; float* tl = fl + sub * 1088;
        for (int b0 = bid * 2; b0 < 65 * 768; b0 += G * 2) { const int it = b0 + sub; const int e = it / 768, r = it % 768;
            const float* wg = e < 64 ? p.w_gate + (size_t)e * D * EFF : p.ws_gate; const float* wu = e < 64 ? p.w_up + (size_t)e * D * EFF : p.ws_up; const float* wd = e < 64 ? p.w_down + (size_t)e * EFF * D : p.ws_down;
            if (r < 256) b_transpose_tile(wg, D, EFF, WguT + (size_t)e * 512 * D, EFF, r, tl, lt, 2, 0);
            else if (r < 512) b_transpose_tile(wu, D, EFF, WguT + (size_t)e * 512 * D, EFF, r - 256, tl, lt, 2, 1);
            else b_transpose_tile(wd, EFF, D, WdT + (size_t)e * D * EFF, D, r - 512, tl, lt); }
    }
    SEAM(12);
    if (IN(13)) b_scatter(ctl, tope, topw, rowoff, rowmeta, (int*)lds);
    SEAM(13);
    if (IN(14)) { G1Sched S{ctl, (const char*)x2h, rowoff, (const char*)WguT, G, bid}; pg8::EpiGateUp E{Hm};
        pg8::gemm_phase<pg8::EpiGateUp, G1Sched>((PG8_LAS unsigned char*)lds, D, S, E); }
    SEAM(14);
#pragma unroll 1
    for (int q = 0; q < NQ; ++q) {
        if (IN(15 + 2 * q)) { G2Sched S{ctl, (const char*)Hm, (const char*)WdT, q, G, bid}; pg8::EpiDown E{Yq, rowmeta};
            pg8::gemm_phase<pg8::EpiDown, G2Sched>((PG8_LAS unsigned char*)lds, EFF, S, E); }
        SEAM(15 + 2 * q);
        if (IN(16 + 2 * q)) b_combine(p, x2h, Yq, q);
        if (q < NQ - 1) SEAM(16 + 2 * q);
    }
#undef IN
#undef SEAM
#undef tid
}

#ifndef MK_PER_PHASE
#define MK_PER_PHASE 0
#endif
extern "C" void kernel_launch(void* const* d_in, const int* in_sizes, int n_in, void* d_out, int out_size, void* d_ws, size_t ws_size, hipStream_t stream) {
    static int grid = 0;
    if (grid == 0) {
        if (n_in != 28 || in_sizes[0] != M * D || out_size != M * D || ws_size < WS_NEED) { fprintf(stderr, "kernel_launch: unexpected shapes (n_in %d, in0 %d, out %d, ws %zu)\n", n_in, n_in > 0 ? in_sizes[0] : -1, out_size, ws_size); grid = -1; return; }
        if (hipFuncSetAttribute((const void*)mega_fwd, hipFuncAttributeMaxDynamicSharedMemorySize, LDS_BYTES) != hipSuccess) { fprintf(stderr, "kernel_launch: hipFuncSetAttribute failed\n"); grid = -1; return; }
        int dev = 0, cus = 0, per_cu = 0;
        hipGetDevice(&dev); hipDeviceGetAttribute(&cus, hipDeviceAttributeMultiprocessorCount, dev);
        if (hipOccupancyMaxActiveBlocksPerMultiprocessor(&per_cu, (const void*)mega_fwd, NTHR, LDS_BYTES) != hipSuccess || per_cu < 1) { fprintf(stderr, "kernel_launch: occupancy query failed (%d)\n", per_cu); grid = -1; return; }
        grid = cus;
    }
    if (grid < 0) return;
    Params p{};
    p.x = (const float*)d_in[0]; p.mem = (const float*)d_in[1]; p.positions = (const int*)d_in[2];
    p.w_in = (const float*)d_in[3]; p.pe_k = (const float*)d_in[4]; p.pe_v = (const float*)d_in[5];
    p.w1k = (const float*)d_in[6]; p.w2k = (const float*)d_in[7]; p.w1v = (const float*)d_in[8]; p.w2v = (const float*)d_in[9];
    p.w_out = (const float*)d_in[10]; p.ln1g = (const float*)d_in[11]; p.ln1b = (const float*)d_in[12];
    p.w_xq = (const float*)d_in[13]; p.w_xkv = (const float*)d_in[14]; p.w_xo = (const float*)d_in[15];
    p.ln2g = (const float*)d_in[16]; p.ln2b = (const float*)d_in[17]; p.w_router = (const float*)d_in[18]; p.rbias = (const float*)d_in[19];
    p.w_gate = (const float*)d_in[20]; p.w_up = (const float*)d_in[21]; p.w_down = (const float*)d_in[22];
    p.ws_gate = (const float*)d_in[23]; p.ws_up = (const float*)d_in[24]; p.ws_down = (const float*)d_in[25];
    p.ln3g = (const float*)d_in[26]; p.ln3b = (const float*)d_in[27];
    p.out = (float*)d_out; p.ws = (unsigned char*)d_ws;
    for (int i = 0; i < 4; ++i) p.lg[i] = (float)std::log(1.0 - std::pow(2.0, -5.0 - (double)i));
#if MK_PER_PHASE
    for (int ph = 0; ph < N_PHASES; ++ph) { p.ph_lo = ph; p.ph_hi = ph + 1; hipLaunchKernelGGL(mega_fwd, dim3(grid), dim3(NTHR), LDS_BYTES, stream, p); }
#else
    p.ph_lo = 0; p.ph_hi = N_PHASES;
    void* args[] = {&p};
    hipError_t e = hipLaunchCooperativeKernel((const void*)mega_fwd, dim3(grid), dim3(NTHR), args, LDS_BYTES, stream);
    if (e != hipSuccess) fprintf(stderr, "kernel_launch: cooperative launch failed: %s (grid %d)\n", hipGetErrorString(e), grid);
#endif
}
```

```cpp
#include <hip/hip_runtime.h>
#include <cstdio>
#include <cstdint>
#include <cmath>

typedef _Float16 h16;
typedef _Float16 h16x8 __attribute__((ext_vector_type(8)));
typedef _Float16 h16x2 __attribute__((ext_vector_type(2)));
typedef _Float16 h16x4 __attribute__((ext_vector_type(4)));
typedef float f32x2 __attribute__((ext_vector_type(2)));
typedef float f32x4 __attribute__((ext_vector_type(4)));
typedef unsigned u32x4 __attribute__((ext_vector_type(4)));
typedef unsigned u32x2 __attribute__((ext_vector_type(2)));

__device__ __forceinline__ int tidx() { int t = (int)threadIdx.x; asm volatile("" : "+v"(t)); return t; }

constexpr int NB = 4, T = 8192, D = 1024, M = NB * T;
constexpr int INC = 3352, INP = 3584;
constexpr int C_RQ = 0, C_RK = 512, C_RV = 1024, C_RG = 1536, C_NQ = 2048, C_NKC = 2560, C_NVC = 2688, C_NKS = 2816, C_NVS = 2944, C_NKW = 3072, C_NVW = 3200, C_NG = 3328;
constexpr int MEML = 256;
constexpr int NE = 64, EFF = 256;
constexpr float LN_EPS = 1e-5f;
constexpr float DN_ALPHA = 1.189207115002721f;
constexpr float NEGF = -1e30f;

constexpr size_t MiB = 1u << 20;
constexpr size_t WS_WIN = 1 * MiB, WS_WOUT = 8 * MiB, WS_WXQ = 10 * MiB, WS_WXO = 12 * MiB, WS_WXKV = 14 * MiB, WS_MEMH = 18 * MiB, WS_KVM = 20 * MiB;
constexpr size_t WS_KCMP = 24 * MiB, WS_VCMP = 25 * MiB, WS_TOPE = 26 * MiB, WS_TOPW = 27 * MiB;
constexpr size_t WS_XH = 32 * MiB, WS_MIX = 32 * MiB, WS_OX = 32 * MiB;
constexpr size_t WS_H = 96 * MiB, WS_NQR = 320 * MiB, WS_KVB = 352 * MiB, WS_PREV = 416 * MiB;
constexpr size_t WS_PRE = 96 * MiB, WS_X1 = 224 * MiB, WS_X1H = 352 * MiB, WS_QX = 416 * MiB, WS_X2 = 130 * MiB;
constexpr size_t WS_X2H = 32 * MiB, WS_WDT = 96 * MiB, WS_HM = 130 * MiB, WS_WGUT = 306 * MiB, WS_Y = 306 * MiB;
constexpr size_t WS_ROWOFF = 1 * MiB, WS_ROWMETA = 3 * MiB;
constexpr size_t WS_VST = 480 * MiB, WS_VWT = 488 * MiB, WS_COSR = 496 * MiB, WS_SINR = 504 * MiB, WS_COSN = 28 * MiB, WS_SINN = 29 * MiB, WS_KVMVT = 30 * MiB;
constexpr size_t WS_PREVT = 416 * MiB;
constexpr size_t DO_RQR = 0, DO_RKR = 32 * MiB, DO_RKZT = 64 * MiB, DO_RVT = 96 * MiB;
constexpr size_t WS_NEED = 512 * MiB;
constexpr int NQ = 4, QT = M / NQ, NVE = NQ * 65, CAP_TILES = 1412, CAP = CAP_TILES * 256;
constexpr int CTL_CNT = 0, CTL_CUR = 512, CTL_PST = 1024, CTL_TQS = 1536, CTL_TVE = 2048;

namespace pg8 {
#define PG8_LAS __attribute__((address_space(3)))
typedef short s16x8 __attribute__((ext_vector_type(8)));
constexpr int BM = 256, BK = 64, HALF = 128, HTB = HALF * BK * 2, STAGE_BYTES = 8 * HTB, NXCD = 8, WGM = 8;
__host__ __device__ __forceinline__ int lds_byte(int r, int c) { const int st = (r >> 4) * 2 + (c >> 5), rr = r & 15, cc = c & 31, ob = rr * 64 + cc * 2; return st * 1024 + (ob ^ (((ob >> 9) & 1) << 5)); }
__host__ __device__ __forceinline__ void stage_rc(int b, int& R, int& C) { const int st = b / 1024, sb = b % 1024, swz = sb ^ (((sb >> 9) & 1) << 5); R = (st >> 1) * 16 + swz / 64; C = (st & 1) * 32 + (swz % 64) / 2; }
__host__ __device__ __forceinline__ int perm32(int rho) { const int n = rho >> 4, i = rho & 15; return 8 * (i >> 2) + 4 * n + (i & 3); }
struct Unit { int pm, pn; const char* A; const char* B; const unsigned* gat; };
struct Gemm { const h16* A; const h16* Bt; int M, N, K; };
struct StaticOrder {
    int nM, nN, nwg, G, c; const char* A; const char* B; size_t tstep;
    __device__ void init(const Gemm& g, int G_, int c_) { nM = g.M / BM; nN = g.N / BM; nwg = nM * nN; G = G_; c = c_; A = (const char*)g.A; B = (const char*)g.Bt; tstep = (size_t)BM * g.K * 2; }
    __device__ bool next(int i, Unit& u) const {
        const long L = (long)i * G + c; if (L >= nwg) return false;
        int wgid = (int)L; { const int q = nwg / NXCD, r = nwg % NXCD, xcd = wgid % NXCD, off = wgid / NXCD; wgid = (xcd < r ? xcd * (q + 1) : r * (q + 1) + (xcd - r) * q) + off; }
        const int nig = WGM * nN, gid = wgid / nig, fm = gid * WGM, gsz = (nM - fm) < WGM ? (nM - fm) : WGM;
        u.pm = fm + ((wgid % nig) % gsz); u.pn = (wgid % nig) / gsz; u.A = A + (size_t)u.pm * tstep; u.B = B + (size_t)u.pn * tstep; u.gat = nullptr; return true;
    }
};
__device__ __forceinline__ unsigned cvt_pk_f16(float lo, float hi) { f32x2 v = {lo, hi}; h16x2 h = __builtin_convertvector(v, h16x2); return __builtin_bit_cast(unsigned, h); }

struct EpiF16 {
    static constexpr bool PERM = true;
    h16* O; int ldc;
    __device__ __forceinline__ void operator()(const f32x4 (&acc)[2][2][4][2], const Unit& u, int wr, int wc, int fr, int fq) const {
        const int row0 = u.pm * BM + wr * 64 + fr; const int col0 = u.pn * BM + wc * 32 + 8 * fq;
#pragma unroll
        for (int ai = 0; ai < 2; ++ai)
#pragma unroll
            for (int m = 0; m < 4; ++m) { h16* rowp = O + (size_t)(row0 + ai * HALF + m * 16) * ldc + col0;
#pragma unroll
                for (int bj = 0; bj < 2; ++bj) { const f32x4 v0 = acc[ai][bj][m][0], v1 = acc[ai][bj][m][1];
                    *(h16x8*)(rowp + bj * HALF) = __builtin_convertvector(__builtin_shufflevector(v0, v1, 0, 1, 2, 3, 4, 5, 6, 7), h16x8); } }
    }
};
struct EpiResF32 {
    static constexpr bool PERM = false;
    float* C; const float* R; int ldc; float alpha;
    __device__ __forceinline__ void operator()(const f32x4 (&acc)[2][2][4][2], const Unit& u, int wr, int wc, int fr, int fq) const {
        const int row0 = u.pm * BM + wr * 64 + fr, col0 = u.pn * BM + wc * 32 + 4 * fq;
#pragma unroll
        for (int ai = 0; ai < 2; ++ai)
#pragma unroll
            for (int m = 0; m < 4; ++m) { const size_t off = (size_t)(row0 + ai * HALF + m * 16) * ldc + col0;
#pragma unroll
                for (int bj = 0; bj < 2; ++bj)
#pragma unroll
                    for (int n = 0; n < 2; ++n) { const f32x4 r = *(const f32x4*)(R + off + bj * HALF + n * 16); *(f32x4*)(C + off + bj * HALF + n * 16) = r * alpha + acc[ai][bj][m][n]; } }
    }
};
struct EpiGateUp {
    static constexpr bool PERM = true;
    h16* H;
    __device__ __forceinline__ void operator()(const f32x4 (&acc)[2][2][4][2], const Unit& u, int wr, int wc, int fr, int fq) const {
        const int row0 = u.pm * BM + wr * 64 + fr; const int col0 = u.pn * 128 + wc * 16 + 4 * fq;
#pragma unroll
        for (int ai = 0; ai < 2; ++ai)
#pragma unroll
            for (int m = 0; m < 4; ++m) { h16* rowp = H + (size_t)(row0 + ai * HALF + m * 16) * 256 + col0;
#pragma unroll
                for (int bj = 0; bj < 2; ++bj) { const f32x4 v0 = acc[ai][bj][m][0], v1 = acc[ai][bj][m][1];
                    const float h0 = v0[0] / (1.f + __expf(-v0[0])) * v0[1], h1 = v0[2] / (1.f + __expf(-v0[2])) * v0[3];
                    const float h2 = v1[0] / (1.f + __expf(-v1[0])) * v1[1], h3 = v1[2] / (1.f + __expf(-v1[2])) * v1[3];
                    *(h16x4*)(rowp + bj * 64) = __builtin_convertvector((f32x4){h0, h1, h2, h3}, h16x4); } }
    }
};
struct EpiDown {
    static constexpr bool PERM = true;
    h16* Y; const u32x2* rowmeta;
    __device__ __forceinline__ void operator()(const f32x4 (&acc)[2][2][4][2], const Unit& u, int wr, int wc, int fr, int fq) const {
        const int row0 = u.pm * BM + wr * 64 + fr; const int col0 = u.pn * BM + wc * 32 + 8 * fq;
#pragma unroll
        for (int ai = 0; ai < 2; ++ai)
#pragma unroll
            for (int m = 0; m < 4; ++m) { const u32x2 md = rowmeta[row0 + ai * HALF + m * 16]; const int slot = (int)md.x; const float w8 = __uint_as_float(md.y);
                if (slot >= 0) { h16* rowp = Y + (size_t)slot * 1024 + col0;
#pragma unroll
                    for (int bj = 0; bj < 2; ++bj) { const f32x4 v0 = acc[ai][bj][m][0] * w8, v1 = acc[ai][bj][m][1] * w8;
                        *(h16x8*)(rowp + bj * HALF) = __builtin_convertvector(__builtin_shufflevector(v0, v1, 0, 1, 2, 3, 4, 5, 6, 7), h16x8); } }
                asm volatile("" ::: "memory"); }
    }
};

template <class Epi, class Sched>
__device__ __forceinline__ void gemm_phase(PG8_LAS unsigned char* lds, const int K, const Sched& S, const Epi& E) {
    const int tid = tidx(), wid = __builtin_amdgcn_readfirstlane(tid >> 6), lane = tid & 63, wr = wid >> 2, wc = wid & 3, fr = lane & 15, fq = lane >> 4;
    const int nt = K / BK;
    int R0, C0; stage_rc(tid * 16, R0, C0);
    const unsigned cb2 = (unsigned)C0 * 2u;
    unsigned voffB[2];
#pragma unroll
    for (int i = 0; i < 2; ++i) { const int R = R0 + 64 * i; const int Rb = Epi::PERM ? ((R & ~31) + perm32(R & 31)) : R; voffB[i] = (unsigned)(Rb * K) * 2u + cb2; }
    const size_t kstep = (size_t)(BK * 2);
    const size_t hstep = (size_t)HALF * K * 2;
    const unsigned ldsw = (unsigned)wid * 1024u;
    const int aoff = lds_byte(wr * 64 + fr, fq * 8), boff = lds_byte(wc * 32 + fr, fq * 8);
#define PG8_MKVA(u, va) do { _Pragma("unroll") for (int _h = 0; _h < 2; ++_h) _Pragma("unroll") for (int _i = 0; _i < 2; ++_i) { const int _r = _h * HALF + R0 + 64 * _i; \
        (va)[_h][_i] = ((u).gat ? (u).gat[_r] : (unsigned)(_r * K) * 2u) + cb2; } } while (0)
#define PG8_SA(b, h) (((b) * 2 + (h)) * HTB)
#define PG8_SB(b, h) ((4 + (b) * 2 + (h)) * HTB)
#define PG8_STAGE(bufoff, gbase, voff) do { _Pragma("unroll") for (int _i = 0; _i < 2; ++_i) \
        __builtin_amdgcn_global_load_lds((const unsigned*)((const char*)(gbase) + (voff)[_i]), (PG8_LAS unsigned*)(lds + (bufoff) + ldsw + _i * 8192), 16, 0, 0); } while (0)
#define PG8_LDA(dst, b, h) do { _Pragma("unroll") for (int m = 0; m < 4; ++m) _Pragma("unroll") for (int k = 0; k < 2; ++k) dst[m][k] = *(const PG8_LAS s16x8*)(lds + PG8_SA(b, h) + aoff + m * 2048 + k * 1024); } while (0)
#define PG8_LDB(dst, b, h) do { _Pragma("unroll") for (int n = 0; n < 2; ++n) _Pragma("unroll") for (int k = 0; k < 2; ++k) dst[n][k] = *(const PG8_LAS s16x8*)(lds + PG8_SB(b, h) + boff + n * 2048 + k * 1024); } while (0)
#define PG8_MMA(ai, bj, At, Bt) do { __builtin_amdgcn_s_setprio(1); _Pragma("unroll") for (int m = 0; m < 4; ++m) _Pragma("unroll") for (int n = 0; n < 2; ++n) _Pragma("unroll") for (int k = 0; k < 2; ++k) \
        acc[ai][bj][m][n] = __builtin_amdgcn_mfma_f32_16x16x32_f16(__builtin_bit_cast(h16x8, Bt[n][k]), __builtin_bit_cast(h16x8, At[m][k]), acc[ai][bj][m][n], 0, 0, 0); __builtin_amdgcn_s_setprio(0); } while (0)
#define PG8_WAIT_V(n) asm volatile("s_waitcnt vmcnt(" #n ")" ::: "memory")
#define PG8_WAIT_L(n) asm volatile("s_waitcnt lgkmcnt(" #n ")" ::: "memory")
#define PG8_BAR __builtin_amdgcn_s_barrier()
#define PG8_SCHED __builtin_amdgcn_sched_barrier(0)
    Unit cur, nxt; int ui = 0;
    if (!S.next(0, cur)) return;
    unsigned va[2][2];
    PG8_MKVA(cur, va);
    f32x4 acc[2][2][4][2];
#pragma unroll
    for (int a = 0; a < 2; ++a)
#pragma unroll
        for (int b = 0; b < 2; ++b)
#pragma unroll
            for (int m = 0; m < 4; ++m)
#pragma unroll
                for (int n = 0; n < 2; ++n) acc[a][b][m][n] = (f32x4){0.f, 0.f, 0.f, 0.f};
    s16x8 At[4][2], B0[2][2], B1[2][2];
    const char* cA = cur.A; const char* cB = cur.B;
    {
        PG8_STAGE(PG8_SB(0, 0), cB, voffB); PG8_STAGE(PG8_SB(0, 1), cB + hstep, voffB); PG8_STAGE(PG8_SA(0, 0), cA, va[0]); PG8_STAGE(PG8_SA(0, 1), cA, va[1]);
        if (wr == 1) PG8_BAR;
        PG8_WAIT_V(2); PG8_BAR;
        PG8_STAGE(PG8_SB(1, 0), cB + kstep, voffB); PG8_STAGE(PG8_SA(1, 0), cA + kstep, va[0]); PG8_STAGE(PG8_SB(1, 1), cB + hstep + kstep, voffB);
        PG8_WAIT_V(6); PG8_BAR;
    }
    for (;;) {
        const bool has_next = S.next(ui + 1, nxt);
        const char* nA = has_next ? nxt.A : cA; const char* nB = has_next ? nxt.B : cB;
#pragma unroll 1
        for (int t = 0; t < nt; t += 2) {
            const bool last = (t == nt - 2);
            const char* a1 = cA + (size_t)(t + 1) * kstep;
            const char* a2 = last ? nA : cA + (size_t)(t + 2) * kstep; const char* b2 = last ? nB : cB + (size_t)(t + 2) * kstep;
            const char* a3 = a2 + kstep; const char* b3 = b2 + kstep;
            PG8_LDB(B0, 0, 0); PG8_LDB(B1, 0, 1); PG8_SCHED; PG8_LDA(At, 0, 0); PG8_STAGE(PG8_SA(1, 1), a1, va[1]);
            if (last && has_next) { PG8_MKVA(nxt, va); }
            PG8_WAIT_V(8); PG8_WAIT_L(0); PG8_BAR; PG8_MMA(0, 0, At, B0); PG8_MMA(0, 1, At, B1); PG8_BAR; PG8_SCHED;
            PG8_LDA(At, 0, 1); PG8_STAGE(PG8_SB(0, 0), b2, voffB); PG8_STAGE(PG8_SB(0, 1), b2 + hstep, voffB); PG8_STAGE(PG8_SA(0, 0), a2, va[0]);
            PG8_WAIT_V(8); PG8_WAIT_L(0); PG8_BAR; PG8_MMA(1, 0, At, B0); PG8_MMA(1, 1, At, B1); PG8_BAR; PG8_SCHED;
            PG8_LDB(B0, 1, 0); PG8_LDB(B1, 1, 1); PG8_SCHED; PG8_LDA(At, 1, 0); PG8_STAGE(PG8_SA(0, 1), a2, va[1]);
            PG8_WAIT_V(8); PG8_WAIT_L(0); PG8_BAR; PG8_MMA(0, 0, At, B0); PG8_MMA(0, 1, At, B1); PG8_BAR; PG8_SCHED;
            PG8_LDA(At, 1, 1); PG8_STAGE(PG8_SB(1, 0), b3, voffB); PG8_STAGE(PG8_SB(1, 1), b3 + hstep, voffB); PG8_STAGE(PG8_SA(1, 0), a3, va[0]);
            PG8_WAIT_V(8); PG8_WAIT_L(0); PG8_BAR; PG8_MMA(1, 0, At, B0); PG8_MMA(1, 1, At, B1); PG8_BAR; PG8_SCHED;
        }
        if (wr == 0) PG8_BAR;
        E(acc, cur, wr, wc, fr, fq);
        if (!has_next) break;
#pragma unroll
        for (int a = 0; a < 2; ++a)
#pragma unroll
            for (int b = 0; b < 2; ++b)
#pragma unroll
                for (int m = 0; m < 4; ++m)
#pragma unroll
                    for (int n = 0; n < 2; ++n) acc[a][b][m][n] = (f32x4){0.f, 0.f, 0.f, 0.f};
        cur = nxt; cA = nA; cB = nB; ++ui;
        if (wr == 1) PG8_BAR;
    }
    PG8_WAIT_V(0);
    PG8_BAR;
#undef PG8_MKVA
#undef PG8_SA
#undef PG8_SB
#undef PG8_STAGE
#undef PG8_LDA
#undef PG8_LDB
#undef PG8_MMA
#undef PG8_WAIT_V
#undef PG8_WAIT_L
#undef PG8_BAR
#undef PG8_SCHED
}
}


#include <hip/hip_cooperative_groups.h>
namespace cg = cooperative_groups;
constexpr int NTHR = 512;
constexpr int LDS_BYTES = 147456;
#define LAS __attribute__((address_space(3)))

struct Params {
    const float *x, *mem; const int* positions;
    const float *w_in, *pe_k, *pe_v, *w1k, *w2k, *w1v, *w2v, *w_out, *ln1g, *ln1b, *w_xq, *w_xkv, *w_xo, *ln2g, *ln2b, *w_router, *rbias, *w_gate, *w_up, *w_down, *ws_gate, *ws_up, *ws_down, *ln3g, *ln3b;
    float* out; unsigned char* ws;
    float lg[4];
    int ph_lo, ph_hi;
};

__device__ __forceinline__ float wave_sum(float v) {
#pragma unroll
    for (int o = 1; o < 64; o <<= 1) v += __shfl_xor(v, o);
    return v;
}
__device__ __forceinline__ float wave_max(float v) {
#pragma unroll
    for (int o = 1; o < 64; o <<= 1) v = fmaxf(v, __shfl_xor(v, o));
    return v;
}
__device__ __forceinline__ float siluf(float v) { return v / (1.f + __expf(-v)); }
__device__ __forceinline__ float sigmf(float v) { return 1.f / (1.f + __expf(-v)); }

__device__ __forceinline__ void b_transpose_tile(const float* __restrict__ W, int K, int N, h16* __restrict__ WT, int Npad, int tile, float* tl, int lt, int rs = 1, int ro = 0) {
    const int ntn = Npad / 32; const int n0 = (tile % ntn) * 32, k0 = (tile / ntn) * 32, tx = lt & 31, ty = lt >> 5;
    for (int i = ty; i < 32; i += 8) { const int k = k0 + i, n = n0 + tx; tl[i * 33 + tx] = (n < N) ? W[(size_t)k * N + n] : 0.f; }
    __syncthreads();
    for (int i = ty; i < 32; i += 8) { const int n = n0 + i, k = k0 + tx; WT[(size_t)(n * rs + ro) * K + k] = (h16)tl[tx * 33 + i]; }
    __syncthreads();
}
__device__ __forceinline__ void b_cvt(const float* __restrict__ x, h16* __restrict__ o, size_t n4) {
    for (size_t i = (size_t)blockIdx.x * NTHR + tidx(); i < n4; i += (size_t)gridDim.x * NTHR) {
        const f32x4 v = ((const f32x4*)x)[i]; ((h16x4*)o)[i] = __builtin_convertvector(v, h16x4); }
}

__device__ __forceinline__ void b_tables(const int* __restrict__ positions, float* __restrict__ cosr, float* __restrict__ sinr, float* __restrict__ cosn, float* __restrict__ sinn) {
    for (int idx = blockIdx.x * NTHR + tidx(); idx < M * 72; idx += gridDim.x * NTHR) {
        const int m = idx / 72, j = idx % 72; const float pos = (float)positions[m];
        const float inv = j < 64 ? (float)pow(10000.0, -(double)j / 64.0) : (float)pow(500000.0, -(double)(j - 64) / 8.0);
        const float ang = pos * inv; double sd, cd; sincos((double)ang, &sd, &cd);
        if (j < 64) { cosr[(size_t)m * 64 + j] = (float)cd; sinr[(size_t)m * 64 + j] = (float)sd; } else { cosn[(size_t)m * 8 + j - 64] = (float)cd; sinn[(size_t)m * 8 + j - 64] = (float)sd; }
    }
}
__device__ __forceinline__ void b_rope(h16* __restrict__ h, h16* __restrict__ rqr, h16* __restrict__ rkr, h16* __restrict__ nqr, const float* __restrict__ cosr, const float* __restrict__ sinr,
                                       const float* __restrict__ cosn, const float* __restrict__ sinn, int m, int j) {
    h16* hr = h + (size_t)m * INP;
    {   const int hd = j >> 6, jj = j & 63; const float c = cosr[(size_t)m * 64 + jj], s = sinr[(size_t)m * 64 + jj];
        const int o1 = hd * 128 + jj, o2 = o1 + 64;
        const float q1 = (float)hr[C_RQ + o1], q2 = (float)hr[C_RQ + o2];
        rqr[(size_t)m * 512 + o1] = (h16)(q1 * c - q2 * s); rqr[(size_t)m * 512 + o2] = (h16)(q2 * c + q1 * s);
        const float k1 = (float)hr[C_RK + o1], k2 = (float)hr[C_RK + o2]; const float sc = 0.08838834764831845f;
        rkr[(size_t)m * 512 + o1] = (h16)((k1 * c - k2 * s) * sc); rkr[(size_t)m * 512 + o2] = (h16)((k2 * c + k1 * s) * sc);
    }
    if (j < 64 + 16 + 16) {
        const int jj = j & 7; const float c = cosn[(size_t)m * 8 + jj], s = sinn[(size_t)m * 8 + jj];
        if (j < 64) { const int hd = j >> 3; const int o1 = hd * 64 + jj, o2 = o1 + 8;
            const float q1 = (float)hr[C_NQ + o1], q2 = (float)hr[C_NQ + o2];
            nqr[(size_t)m * 512 + o1] = (h16)(q1 * c - q2 * s); nqr[(size_t)m * 512 + o2] = (h16)(q2 * c + q1 * s);
        } else { const int jx = j - 64; const int which = jx >> 4, g = (jx >> 3) & 1; const int base = (which ? C_NKW : C_NKS) + g * 64 + jj;
            const float k1 = (float)hr[base], k2 = (float)hr[base + 8];
            hr[base] = (h16)(k1 * c - k2 * s); hr[base + 8] = (h16)(k2 * c + k1 * s); }
    }
    for (int i = j; i < 8 * 48; i += 256) { const int hd = i / 48, d = 16 + i % 48; nqr[(size_t)m * 512 + hd * 64 + d] = hr[C_NQ + hd * 64 + d]; }
}
__device__ __forceinline__ void b_rtrans(const Params& p, const h16* __restrict__ h, h16* __restrict__ rvT, h16* __restrict__ rkzT, const float* __restrict__ cosr, const float* __restrict__ sinr, int item, h16* sl, int lt) {
    int id = item; const int tt = id & 127; id >>= 7; const int hd = id & 3; const int b = id >> 2; const int bh = b * 4 + hd; const float lg = p.lg[hd];
    for (int i = lt; i < 64 * 128; i += 256) { const int t = i >> 7, e = i & 127; sl[t * 130 + e] = h[(size_t)(b * T + tt * 64 + t) * INP + C_RV + hd * 128 + e]; }
    __syncthreads();
    for (int i = lt; i < 64 * 128; i += 256) { const int e = i >> 6, t = i & 63; rvT[(size_t)(bh * 128 + e) * T + tt * 64 + t] = sl[t * 130 + e]; }
    __syncthreads();
    for (int i = lt; i < 64 * 64; i += 256) { const int t = i >> 6, jj = i & 63; const size_t m = (size_t)b * T + tt * 64 + t;
        const float c = cosr[m * 64 + jj], s = sinr[m * 64 + jj]; const float k1 = (float)h[m * INP + C_RK + hd * 128 + jj], k2 = (float)h[m * INP + C_RK + hd * 128 + jj + 64];
        const float z = 0.08838834764831845f * __expf(lg * (float)(127 - ((tt * 64 + t) & 127)));
        sl[t * 130 + jj] = (h16)((k1 * c - k2 * s) * z); sl[t * 130 + jj + 64] = (h16)((k2 * c + k1 * s) * z); }
    __syncthreads();
    for (int i = lt; i < 64 * 128; i += 256) { const int d = i >> 6, t = i & 63; rkzT[(size_t)(bh * 128 + d) * T + tt * 64 + t] = sl[t * 130 + d]; }
    __syncthreads();
}
__device__ __forceinline__ void b_mvtrans(const h16* __restrict__ kvm, h16* __restrict__ kvmVT, int item, h16* sl, int lt) {
    int id = item; const int kt = id & 3; id >>= 2; const int dtl = id & 3; id >>= 2; const int hh = id & 3; const int b = id >> 2;
    for (int i = lt; i < 64 * 64; i += 256) { const int k = i >> 6, d = i & 63; sl[k * 66 + d] = kvm[(size_t)(b * MEML + kt * 64 + k) * 2048 + 1024 + hh * 256 + dtl * 64 + d]; }
    __syncthreads();
    for (int i = lt; i < 64 * 64; i += 256) { const int d = i >> 6, k = i & 63; kvmVT[(size_t)((b * 4 + hh) * 256 + dtl * 64 + d) * MEML + kt * 64 + k] = sl[k * 66 + d]; }
    __syncthreads();
}

__device__ __forceinline__ void b_cmp(const Params& p, const h16* __restrict__ h, h16* __restrict__ kcmp, h16* __restrict__ vcmpT, int item, float* sl, int lt) {
    float* a = sl; float* hid = sl + 2048;
    int id = item; const int g = id & 1; id >>= 1; const int c = id % 511; id /= 511; const int b = id & 3; const int kv = id >> 2;
    const float* pe = kv ? p.pe_v : p.pe_k; const float* w1 = kv ? p.w1v : p.w1k; const float* w2 = kv ? p.w2v : p.w2k;
    const int colb = (kv ? C_NVC : C_NKC) + g * 64;
    for (int i = lt; i < 2048; i += 256) { const int l = i >> 6, d = i & 63; a[i] = (float)h[(size_t)(b * T + 16 * c + l) * INP + colb + d] + pe[l * 64 + d]; }
    __syncthreads();
    { const int j = lt; float acc = 0.f;
        for (int k = 0; k < 2048; ++k) acc += a[k] * w1[(size_t)k * 256 + j];
        hid[j] = siluf(acc); }
    __syncthreads();
    if (lt < 64) { const int e = lt; float acc = 0.f;
        for (int j = 0; j < 256; ++j) acc += hid[j] * w2[j * 64 + e];
        if (kv == 0) { kcmp[((size_t)(b * 2 + g) * 512 + c) * 64 + e] = (h16)acc; if (c == 510) kcmp[((size_t)(b * 2 + g) * 512 + 511) * 64 + e] = (h16)0.f; }
        else { vcmpT[((size_t)(b * 2 + g) * 64 + e) * 512 + c] = (h16)acc; if (c == 510) vcmpT[((size_t)(b * 2 + g) * 64 + e) * 512 + 511] = (h16)0.f; } }
    __syncthreads();
}
__device__ __forceinline__ void b_vtrans(const h16* __restrict__ h, h16* __restrict__ vsT, h16* __restrict__ vwT, int item, h16* sl, int lt) {
    int id = item; const int tt = id & 127; id >>= 7; const int g = id & 1; id >>= 1; const int b = id & 3; const int which = id >> 2;
    const int col = (which ? C_NVW : C_NVS) + g * 64; h16* dst = (which ? vwT : vsT) + (size_t)((b * 2 + g) * 64) * T + tt * 64;
    for (int i = lt; i < 64 * 64; i += 256) { const int t = i >> 6, d = i & 63; sl[t * 66 + d] = h[(size_t)(b * T + tt * 64 + t) * INP + col + d]; }
    __syncthreads();
    for (int i = lt; i < 64 * 64; i += 256) { const int d = i >> 6, t = i & 63; dst[(size_t)d * T + t] = sl[t * 66 + d]; }
    __syncthreads();
}

__device__ __forceinline__ void ret_kv_unit(const h16* __restrict__ rkzT, const h16* __restrict__ rvT, float* __restrict__ kvT, int chunk, int w, int lane) {
    const int i = lane & 15, kg = lane >> 4; const int bh = chunk >> 6, n = chunk & 63;
    h16x8 a[4];
#pragma unroll
    for (int ks = 0; ks < 4; ++ks) a[ks] = *(const h16x8*)(rkzT + (size_t)(bh * 128 + 16 * w + i) * T + n * 128 + 32 * ks + 8 * kg);
#pragma unroll
    for (int et = 0; et < 8; ++et) { f32x4 acc = {0.f, 0.f, 0.f, 0.f};
#pragma unroll
        for (int ks = 0; ks < 4; ++ks) { const h16x8 bq = *(const h16x8*)(rvT + (size_t)(bh * 128 + 16 * et + i) * T + n * 128 + 32 * ks + 8 * kg); acc = __builtin_amdgcn_mfma_f32_16x16x32_f16(a[ks], bq, acc, 0, 0, 0); }
        *(f32x4*)(kvT + ((size_t)chunk * 128 + 16 * et + i) * 128 + 16 * w + 4 * kg) = acc; }
}
__device__ __forceinline__ void b_ret_scan(const Params& p, const float* __restrict__ kvT, h16* __restrict__ prevT) {
    for (int gid = blockIdx.x * NTHR + tidx(); gid < 16 * 16384; gid += gridDim.x * NTHR) {
        const int de = gid & 16383, bh = gid >> 14; const float cd = __expf(p.lg[bh & 3] * 128.f);
        float st = 0.f;
        for (int n = 0; n < 64; ++n) { const size_t o = ((size_t)(bh * 64 + n) << 14) + de; prevT[o] = (h16)st; st = st * cd + kvT[o]; }
    }
}
__device__ __forceinline__ void ret_out_unit(const Params& p, const h16* __restrict__ h, const h16* __restrict__ rqr, const h16* __restrict__ rkr, const h16* __restrict__ rvT, const h16* __restrict__ prevT,
                                             h16* __restrict__ mix, int chunk, int w, int lane) {
    const int i = lane & 15, kg = lane >> 4; const int bh = chunk >> 6, n = chunk & 63, b = bh >> 2, hd = bh & 3; const float lg = p.lg[hd];
    const int qi = 16 * w + i; const size_t m = (size_t)b * T + n * 128 + qi;
    h16x8 qf[4];
#pragma unroll
    for (int ks = 0; ks < 4; ++ks) qf[ks] = *(const h16x8*)(rqr + m * 512 + hd * 128 + 32 * ks + 8 * kg);
    f32x4 inner[8], cross[8];
#pragma unroll
    for (int et = 0; et < 8; ++et) { inner[et] = (f32x4){0.f, 0.f, 0.f, 0.f}; cross[et] = (f32x4){0.f, 0.f, 0.f, 0.f}; }
    for (int gq = 0; gq < 2; ++gq) {
        if (64 * gq > 16 * w + 15) break;
        f32x4 s[4];
#pragma unroll
        for (int tl = 0; tl < 4; ++tl) { const int ko = 32 * (tl >> 1) + 8 * (i >> 2) + 4 * (tl & 1) + (i & 3); const h16* kp = rkr + ((size_t)b * T + n * 128 + 64 * gq + ko) * 512 + hd * 128 + 8 * kg;
            f32x4 acc = {0.f, 0.f, 0.f, 0.f};
#pragma unroll
            for (int ks = 0; ks < 4; ++ks) acc = __builtin_amdgcn_mfma_f32_16x16x32_f16(*(const h16x8*)(kp + 32 * ks), qf[ks], acc, 0, 0, 0);
            s[tl] = acc; }
        h16x8 pf[2];
#pragma unroll
        for (int tl = 0; tl < 4; ++tl)
#pragma unroll
            for (int r = 0; r < 4; ++r) { const int j = 64 * gq + 32 * (tl >> 1) + 8 * kg + 4 * (tl & 1) + r; const float v = (j <= qi) ? s[tl][r] * __expf(lg * (float)(qi - j)) : 0.f; pf[tl >> 1][4 * (tl & 1) + r] = (h16)v; }
#pragma unroll
        for (int et = 0; et < 8; ++et)
#pragma unroll
            for (int s2 = 0; s2 < 2; ++s2) { const h16x8 a = *(const h16x8*)(rvT + (size_t)(bh * 128 + 16 * et + i) * T + n * 128 + 64 * gq + 32 * s2 + 8 * kg); inner[et] = __builtin_amdgcn_mfma_f32_16x16x32_f16(a, pf[s2], inner[et], 0, 0, 0); }
    }
#pragma unroll
    for (int et = 0; et < 8; ++et)
#pragma unroll
        for (int ks = 0; ks < 4; ++ks) { const h16x8 a = *(const h16x8*)(prevT + ((size_t)chunk * 128 + 16 * et + i) * 128 + 32 * ks + 8 * kg); cross[et] = __builtin_amdgcn_mfma_f32_16x16x32_f16(a, qf[ks], cross[et], 0, 0, 0); }
    const float xi = __expf(lg * (float)(qi + 1));
    float sm = 0.f;
#pragma unroll
    for (int et = 0; et < 8; ++et) { inner[et] = inner[et] + cross[et] * xi; sm += (inner[et][0] + inner[et][1]) + (inner[et][2] + inner[et][3]); }
    sm += __shfl_xor(sm, 16); sm += __shfl_xor(sm, 32);
    const float mu = sm * (1.f / 128.f); float sq = 0.f;
#pragma unroll
    for (int et = 0; et < 8; ++et) { inner[et] = inner[et] - mu; sq += (inner[et][0] * inner[et][0] + inner[et][1] * inner[et][1]) + (inner[et][2] * inner[et][2] + inner[et][3] * inner[et][3]); }
    sq += __shfl_xor(sq, 16); sq += __shfl_xor(sq, 32);
    const float rstd = rsqrtf(sq * (1.f / 128.f) + LN_EPS);
#pragma unroll
    for (int et = 0; et < 8; ++et) { const int e = 16 * et + 4 * kg; const h16x4 gv = *(const h16x4*)(h + m * INP + C_RG + hd * 128 + e);
        f32x4 o;
#pragma unroll
        for (int r = 0; r < 4; ++r) o[r] = siluf((float)gv[r]) * inner[et][r] * rstd;
        *(h16x4*)(mix + m * D + hd * 128 + e) = __builtin_convertvector(o, h16x4); }
}

struct AttSt { float m, l; f32x4 o[4]; };
template <class MaskF>
__device__ __forceinline__ void att_scores(f32x4 (&s)[4], const h16* __restrict__ Kb, int pitchK, const h16x8 (&qf)[2], int i, int kg, MaskF valid) {
#pragma unroll
    for (int tl = 0; tl < 4; ++tl) { const int ko = 32 * (tl >> 1) + 8 * (i >> 2) + 4 * (tl & 1) + (i & 3); const h16* kp = Kb + (size_t)ko * pitchK + 8 * kg;
        const h16x8 a0 = *(const h16x8*)kp, a1 = *(const h16x8*)(kp + 32);
        f32x4 z = {0.f, 0.f, 0.f, 0.f}; z = __builtin_amdgcn_mfma_f32_16x16x32_f16(a0, qf[0], z, 0, 0, 0); s[tl] = __builtin_amdgcn_mfma_f32_16x16x32_f16(a1, qf[1], z, 0, 0, 0); }
#pragma unroll
    for (int tl = 0; tl < 4; ++tl)
#pragma unroll
        for (int r = 0; r < 4; ++r) { const int ko = 32 * (tl >> 1) + 8 * kg + 4 * (tl & 1) + r; s[tl][r] = valid(ko) ? s[tl][r] * 0.125f : -INFINITY; }
}
__device__ __forceinline__ void att_pv(f32x4 (&o)[4], const f32x4 (&pv)[4], const h16* __restrict__ VTb, int vstride, int i, int kg) {
    h16x8 pf[2];
#pragma unroll
    for (int s2 = 0; s2 < 2; ++s2)
#pragma unroll
        for (int j = 0; j < 8; ++j) pf[s2][j] = (h16)pv[2 * s2 + (j >> 2)][j & 3];
#pragma unroll
    for (int dt = 0; dt < 4; ++dt)
#pragma unroll
        for (int s2 = 0; s2 < 2; ++s2) { const h16x8 a = *(const h16x8*)(VTb + (size_t)(16 * dt + i) * vstride + 32 * s2 + 8 * kg);
            o[dt] = __builtin_amdgcn_mfma_f32_16x16x32_f16(a, pf[s2], o[dt], 0, 0, 0); }
}
template <class MaskF>
__device__ __forceinline__ void att_tile(AttSt& st, const h16* __restrict__ Kb, int pitchK, const h16* __restrict__ VTb, int vstride, const h16x8 (&qf)[2], int i, int kg, MaskF valid) {
    f32x4 s[4]; att_scores(s, Kb, pitchK, qf, i, kg, valid);
    float mx = -INFINITY;
#pragma unroll
    for (int tl = 0; tl < 4; ++tl)
#pragma unroll
        for (int r = 0; r < 4; ++r) mx = fmaxf(mx, s[tl][r]);
    mx = fmaxf(mx, __shfl_xor(mx, 16)); mx = fmaxf(mx, __shfl_xor(mx, 32));
    const float mn = fmaxf(st.m, mx); const float alpha = __expf(st.m - mn); st.m = mn;
    float ps = 0.f;
#pragma unroll
    for (int tl = 0; tl < 4; ++tl)
#pragma unroll
        for (int r = 0; r < 4; ++r) { const float pe = __expf(s[tl][r] - mn); s[tl][r] = pe; ps += pe; }
    st.l = st.l * alpha + ps;
#pragma unroll
    for (int dt = 0; dt < 4; ++dt) st.o[dt] = st.o[dt] * alpha;
    att_pv(st.o, s, VTb, vstride, i, kg);
}
__device__ __forceinline__ void nsa_wave_unit(const h16* __restrict__ h, const h16* __restrict__ nqr, const h16* __restrict__ kcmp, const h16* __restrict__ vcmpT, const h16* __restrict__ vsT, const h16* __restrict__ vwT,
                                              h16* __restrict__ mix, int b, int g, int t0, float* wl, int lane) {
    const int i = lane & 15, kg = lane >> 4, tt = i & 3, hh = i >> 2;
    const int trow = t0 + tt; const size_t mrow = (size_t)b * T + trow;
    h16x8 qf[2], qrf[2];
    { const h16* qp = h + mrow * INP + C_NQ + (g * 4 + hh) * 64 + 8 * kg; qf[0] = *(const h16x8*)qp; qf[1] = *(const h16x8*)(qp + 32);
      const h16* qrp = nqr + mrow * 512 + (g * 4 + hh) * 64 + 8 * kg; qrf[0] = *(const h16x8*)qrp; qrf[1] = *(const h16x8*)(qrp + 32); }
    float* impA = wl; float* impL = wl + 512; float* vals = wl + 1024;
    for (int x = lane; x < 1024; x += 64) wl[x] = 0.f;
    const int ncv_row = trow >= 31 ? ((trow - 31) >> 4) + 1 : 0;
    const int ncv_max = (t0 + 3 >= 31) ? ((t0 + 3 - 31) >> 4) + 1 : 0;
    const int nct = (ncv_max + 63) >> 6;
    const h16* Kc = kcmp + (size_t)(b * 2 + g) * 512 * 64; const h16* Vc = vcmpT + (size_t)(b * 2 + g) * 64 * 512;
    float m = -1e30f, l = 0.f;
    for (int ct = 0; ct < nct; ++ct) {
        f32x4 s[4]; att_scores(s, Kc + (size_t)ct * 64 * 64, 64, qf, i, kg, [&](int ko) { return ct * 64 + ko < ncv_row; });
        float mx = -INFINITY;
#pragma unroll
        for (int tl = 0; tl < 4; ++tl)
#pragma unroll
            for (int r = 0; r < 4; ++r) mx = fmaxf(mx, s[tl][r]);
        mx = fmaxf(mx, __shfl_xor(mx, 16)); mx = fmaxf(mx, __shfl_xor(mx, 32));
        const float mn = fmaxf(m, mx); float ps = 0.f;
#pragma unroll
        for (int tl = 0; tl < 4; ++tl)
#pragma unroll
            for (int r = 0; r < 4; ++r) ps += __expf(s[tl][r] - mn);
        l = l * __expf(m - mn) + ps; m = mn;
    }
    l += __shfl_xor(l, 16); l += __shfl_xor(l, 32);
    const float linv = l > 0.f ? 1.f / l : 0.f;
    f32x4 oc[4];
#pragma unroll
    for (int dt = 0; dt < 4; ++dt) oc[dt] = (f32x4){0.f, 0.f, 0.f, 0.f};
    for (int ct = 0; ct < nct; ++ct) {
        f32x4 s[4]; att_scores(s, Kc + (size_t)ct * 64 * 64, 64, qf, i, kg, [&](int ko) { return ct * 64 + ko < ncv_row; });
#pragma unroll
        for (int tl = 0; tl < 4; ++tl) {
#pragma unroll
            for (int r = 0; r < 4; ++r) s[tl][r] = __expf(s[tl][r] - m) * linv;
            float A = (s[tl][0] + s[tl][1]) + (s[tl][2] + s[tl][3]), L = s[tl][3];
            A += __shfl_xor(A, 4); A += __shfl_xor(A, 8); L += __shfl_xor(L, 4); L += __shfl_xor(L, 8);
            if (hh == 0) { const int u = ct * 16 + 8 * (tl >> 1) + 2 * kg + (tl & 1); impA[tt * 128 + u] = A; impL[tt * 128 + u] = L; }
        }
        att_pv(oc, s, Vc + ct * 64, 512, i, kg);
    }
    const int cur = t0 >> 6;
    unsigned long long mylo = 0ull, myhi = 0ull, anylo = 0ull, anyhi = 0ull;
    for (int tk = 0; tk < 4; ++tk) {
        float v0, v1;
        { const int s0 = lane, s1 = lane + 64;
          v0 = impA[tk * 128 + s0] + (s0 > 0 ? impL[tk * 128 + s0 - 1] : 0.f); v1 = impA[tk * 128 + s1] + impL[tk * 128 + s1 - 1];
          if (s0 == 0 || s0 == cur || s0 == cur - 1) v0 = 1e9f; if (s1 == cur || s1 == cur - 1) v1 = 1e9f;
          if (s0 > cur) v0 = NEGF; if (s1 > cur) v1 = NEGF; }
        vals[lane] = v0; vals[lane + 64] = v1;
        int r0 = 0, r1 = 0;
        for (int s2 = 0; s2 < 128; ++s2) { const float x = vals[s2]; r0 += (x > v0 || (x == v0 && s2 < lane)) ? 1 : 0; r1 += (x > v1 || (x == v1 && s2 < lane + 64)) ? 1 : 0; }
        const unsigned long long lo = __ballot(r0 < 16), hi = __ballot(r1 < 16);
        anylo |= lo; anyhi |= hi; if (tt == tk) { mylo = lo; myhi = hi; }
    }
    AttSt ss; ss.m = -1e30f; ss.l = 0.f;
#pragma unroll
    for (int dt = 0; dt < 4; ++dt) ss.o[dt] = (f32x4){0.f, 0.f, 0.f, 0.f};
    for (int s = 0; s <= cur; ++s) {
        const unsigned long long am = s < 64 ? anylo : anyhi; if (!((am >> (s & 63)) & 1ull)) continue;
        const bool mybit = (((s < 64 ? mylo : myhi) >> (s & 63)) & 1ull) != 0ull;
        att_tile(ss, h + ((size_t)b * T + 64 * s) * INP + C_NKS + g * 64, INP, vsT + (size_t)((b * 2 + g) * 64) * T + 64 * s, T, qrf, i, kg, [&](int ko) { return mybit && (64 * s + ko <= trow); });
    }
    AttSt sw; sw.m = -1e30f; sw.l = 0.f;
#pragma unroll
    for (int dt = 0; dt < 4; ++dt) sw.o[dt] = (f32x4){0.f, 0.f, 0.f, 0.f};
    for (int s = (t0 >= 511 ? (t0 - 511) >> 6 : 0); s <= cur; ++s)
        att_tile(sw, h + ((size_t)b * T + 64 * s) * INP + C_NKW + g * 64, INP, vwT + (size_t)((b * 2 + g) * 64) * T + 64 * s, T, qrf, i, kg, [&](int ko) { const int kp = 64 * s + ko; return kp <= trow && kp >= trow - 511; });
    float ls = ss.l; ls += __shfl_xor(ls, 16); ls += __shfl_xor(ls, 32); float lw = sw.l; lw += __shfl_xor(lw, 16); lw += __shfl_xor(lw, 32);
    const h16* gp = h + mrow * INP + C_NG + (g * 4 + hh) * 3;
    const float g0 = sigmf((float)gp[0]), g1 = sigmf((float)gp[1]) / ls, g2 = sigmf((float)gp[2]) / lw;
#pragma unroll
    for (int dt = 0; dt < 4; ++dt) { const f32x4 o = oc[dt] * g0 + ss.o[dt] * g1 + sw.o[dt] * g2;
        *(h16x4*)(mix + mrow * D + 512 + (g * 4 + hh) * 64 + 16 * dt + 4 * kg) = __builtin_convertvector(o, h16x4); }
}

__device__ __forceinline__ void b_ln(const float* __restrict__ in, const float* __restrict__ gam, const float* __restrict__ bet, float* __restrict__ o32, h16* __restrict__ o16) {
    const int lane = tidx() & 63;
    for (int row = blockIdx.x * 8 + (tidx() >> 6); row < M; row += gridDim.x * 8) {
        const f32x4* xr = (const f32x4*)(in + (size_t)row * D) + lane;
        f32x4 v[4]; float s = 0.f;
#pragma unroll
        for (int j = 0; j < 4; ++j) { v[j] = xr[64 * j]; s += (v[j][0] + v[j][1]) + (v[j][2] + v[j][3]); }
        const float mean = wave_sum(s) * (1.f / D); float s2 = 0.f;
#pragma unroll
        for (int j = 0; j < 4; ++j) { v[j] = v[j] - mean; s2 += (v[j][0] * v[j][0] + v[j][1] * v[j][1]) + (v[j][2] * v[j][2] + v[j][3] * v[j][3]); }
        const float rstd = rsqrtf(wave_sum(s2) * (1.f / D) + LN_EPS);
#pragma unroll
        for (int j = 0; j < 4; ++j) { const f32x4 gg = ((const f32x4*)gam)[lane + 64 * j], bb = ((const f32x4*)bet)[lane + 64 * j]; const f32x4 o = v[j] * rstd * gg + bb;
            ((f32x4*)(o32 + (size_t)row * D))[lane + 64 * j] = o;
            if (o16) ((h16x4*)(o16 + (size_t)row * D))[lane + 64 * j] = __builtin_convertvector(o, h16x4); }
    }
}

__device__ __forceinline__ void xattn_unit(const h16* __restrict__ qx, const h16* __restrict__ kvm, const h16* __restrict__ kvmVT, h16* __restrict__ ox, int m0, int hh, int lane) {
    const int i = lane & 15, kg = lane >> 4; const int b = m0 >> 13; const size_t m = (size_t)m0 + i;
    h16x8 qf[8];
#pragma unroll
    for (int ks = 0; ks < 8; ++ks) qf[ks] = *(const h16x8*)(qx + m * D + hh * 256 + 32 * ks + 8 * kg);
    f32x4 o[16];
#pragma unroll
    for (int dt = 0; dt < 16; ++dt) o[dt] = (f32x4){0.f, 0.f, 0.f, 0.f};
    float mrun = -1e30f, l = 0.f;
    const h16* vb = kvmVT + (size_t)((b * 4 + hh) * 256) * MEML;
#pragma unroll 1
    for (int gq = 0; gq < 4; ++gq) {
        f32x4 s[4]; float mx = -INFINITY;
#pragma unroll
        for (int tl = 0; tl < 4; ++tl) { const int ko = 64 * gq + 32 * (tl >> 1) + 8 * (i >> 2) + 4 * (tl & 1) + (i & 3); const h16* kp = kvm + (size_t)(b * MEML + ko) * 2048 + hh * 256 + 8 * kg;
            f32x4 acc = {0.f, 0.f, 0.f, 0.f};
#pragma unroll
            for (int ks = 0; ks < 8; ++ks) acc = __builtin_amdgcn_mfma_f32_16x16x32_f16(*(const h16x8*)(kp + 32 * ks), qf[ks], acc, 0, 0, 0);
            s[tl] = acc * 0.0625f; mx = fmaxf(mx, fmaxf(fmaxf(s[tl][0], s[tl][1]), fmaxf(s[tl][2], s[tl][3]))); }
        mx = fmaxf(mx, __shfl_xor(mx, 16)); mx = fmaxf(mx, __shfl_xor(mx, 32));
        const float mn = fmaxf(mrun, mx); const float alpha = __expf(mrun - mn); mrun = mn;
        float ps = 0.f; h16x8 pf[2];
#pragma unroll
        for (int tl = 0; tl < 4; ++tl)
#pragma unroll
            for (int r = 0; r < 4; ++r) { const float pe = __expf(s[tl][r] - mn); ps += pe; pf[tl >> 1][4 * (tl & 1) + r] = (h16)pe; }
        l = l * alpha + ps;
#pragma unroll
        for (int dt = 0; dt < 16; ++dt) { f32x4 acc = o[dt] * alpha;
#pragma unroll
            for (int s2 = 0; s2 < 2; ++s2) acc = __builtin_amdgcn_mfma_f32_16x16x32_f16(*(const h16x8*)(vb + (size_t)(16 * dt + i) * MEML + 64 * gq + 32 * s2 + 8 * kg), pf[s2], acc, 0, 0, 0);
            o[dt] = acc; }
    }
    l += __shfl_xor(l, 16); l += __shfl_xor(l, 32); const float linv = 1.f / l;
#pragma unroll
    for (int dt = 0; dt < 16; ++dt) { const f32x4 acc = o[dt] * linv; *(h16x4*)(ox + m * D + hh * 256 + 16 * dt + 4 * kg) = __builtin_convertvector(acc, h16x4); }
}

__device__ __forceinline__ void b_router(const Params& p, const float* __restrict__ x2, int* __restrict__ tope, float* __restrict__ topw, int* __restrict__ hist) {
    const int lane = tidx() & 63; const float* wr = p.w_router;
    for (int m = blockIdx.x * 8 + (tidx() >> 6); m < M; m += gridDim.x * 8) {
        const float* xr = x2 + (size_t)m * D; float acc = 0.f;
        for (int k = 0; k < D; k += 4) { const f32x4 xv = *(const f32x4*)(xr + k);
            acc += xv[0] * wr[(k + 0) * 64 + lane]; acc += xv[1] * wr[(k + 1) * 64 + lane]; acc += xv[2] * wr[(k + 2) * 64 + lane]; acc += xv[3] * wr[(k + 3) * 64 + lane]; }
        const float score = 1.f / (1.f + expf(-acc)); const float biased = score + p.rbias[lane];
        float m1 = biased; m1 = fmaxf(m1, __shfl_xor(m1, 1)); m1 = fmaxf(m1, __shfl_xor(m1, 2)); m1 = fmaxf(m1, __shfl_xor(m1, 4));
        int am = (biased == m1) ? lane : 999; am = min(am, __shfl_xor(am, 1)); am = min(am, __shfl_xor(am, 2)); am = min(am, __shfl_xor(am, 4));
        float m2 = (lane == am) ? -INFINITY : biased; m2 = fmaxf(m2, __shfl_xor(m2, 1)); m2 = fmaxf(m2, __shfl_xor(m2, 2)); m2 = fmaxf(m2, __shfl_xor(m2, 4));
        const float gs = m1 + m2;
        int cnt = 0;
#pragma unroll
        for (int gq = 0; gq < 8; ++gq) { const float o = __shfl(gs, gq * 8); cnt += (o > gs) ? 1 : 0; }
        const float masked = (cnt <= 3) ? biased : NEGF;
        int rank = 0;
        for (int e2 = 0; e2 < 64; ++e2) { const float o = __shfl(masked, e2); rank += (o > masked || (o == masked && e2 < lane)) ? 1 : 0; }
        const bool selq = rank < 8;
        const float wsum = wave_sum(selq ? score : 0.f);
        if (selq) { tope[(size_t)m * 8 + rank] = lane; topw[(size_t)m * 8 + rank] = score / wsum * 2.5f; atomicAdd(hist + (m >> 13) * 65 + lane, 1); }
    }
}

__device__ __forceinline__ void b_moe(const Params& p, const float* __restrict__ x2, const int* __restrict__ tope, const float* __restrict__ topw, float* __restrict__ out, int m, float* sl, int tid) {
    float* xs = sl; float* hd = sl + 1024; float* red = sl + 1280;
    for (int i = tid; i < 1024; i += 256) xs[i] = x2[(size_t)m * D + i];
    __syncthreads();
    float acc[4] = {0.f, 0.f, 0.f, 0.f};
    for (int kx = 0; kx < 9; ++kx) {
        const float* G; const float* U; const float* Dn; float wt;
        if (kx < 8) { const int e = tope[(size_t)m * 8 + kx]; wt = topw[(size_t)m * 8 + kx]; G = p.w_gate + (size_t)e * D * EFF; U = p.w_up + (size_t)e * D * EFF; Dn = p.w_down + (size_t)e * EFF * D; }
        else { wt = 1.f; G = p.ws_gate; U = p.ws_up; Dn = p.ws_down; }
        float a = 0.f, u = 0.f;
        for (int k = 0; k < D; ++k) { const float xv = xs[k]; a += xv * G[(size_t)k * EFF + tid]; u += xv * U[(size_t)k * EFF + tid]; }
        hd[tid] = siluf(a) * u * wt;
        __syncthreads();
        for (int j = 0; j < EFF; ++j) { const float hv = hd[j]; const float* dr = Dn + (size_t)j * D + tid;
            acc[0] += hv * dr[0]; acc[1] += hv * dr[256]; acc[2] += hv * dr[512]; acc[3] += hv * dr[768]; }
        __syncthreads();
    }
    float v[4]; float s = 0.f;
#pragma unroll
    for (int i = 0; i < 4; ++i) { v[i] = DN_ALPHA * xs[tid + 256 * i] + acc[i]; s += v[i]; }
    s = wave_sum(s); if ((tid & 63) == 0) red[tid >> 6] = s; __syncthreads();
    const float mean = (red[0] + red[1] + red[2] + red[3]) * (1.f / D); float s2 = 0.f;
#pragma unroll
    for (int i = 0; i < 4; ++i) { v[i] -= mean; s2 += v[i] * v[i]; }
    s2 = wave_sum(s2); if ((tid & 63) == 0) red[4 + (tid >> 6)] = s2; __syncthreads();
    const float rstd = rsqrtf((red[4] + red[5] + red[6] + red[7]) * (1.f / D) + LN_EPS);
#pragma unroll
    for (int i = 0; i < 4; ++i) out[(size_t)m * D + tid + 256 * i] = v[i] * rstd * p.ln3g[tid + 256 * i] + p.ln3b[tid + 256 * i];
    __syncthreads();
}

struct G1Sched {
    const int* ctl; const char* x2h; const unsigned* rowoff; const char* WguT; int G, c;
    __device__ bool next(int i, pg8::Unit& u) const {
        const int ntile = ctl[CTL_TQS + NQ]; const long L = (long)i * G + c; if (L >= 2L * ntile) return false;
        const int tile = (int)(L >> 1), pn = (int)(L & 1); const int e = ctl[CTL_TVE + tile] % 65;
        u.pm = tile; u.pn = pn; u.A = x2h; u.gat = rowoff + (size_t)tile * 256; u.B = WguT + ((size_t)e * 512 + pn * 256) * (D * 2); return true; }
};
struct G2Sched {
    const int* ctl; const char* H; const char* WdT; int q, G, c;
    __device__ bool next(int i, pg8::Unit& u) const {
        const int t0 = ctl[CTL_TQS + q], t1 = ctl[CTL_TQS + q + 1]; const long L = (long)i * G + c; if (L >= 4L * (t1 - t0)) return false;
        const int tile = t0 + (int)(L >> 2), pn = (int)(L & 3); const int e = ctl[CTL_TVE + tile] % 65;
        u.pm = tile; u.pn = pn; u.A = H + (size_t)tile * 256 * (EFF * 2); u.gat = nullptr; u.B = WdT + ((size_t)e * D + pn * 256) * (EFF * 2); return true; }
};
__device__ __forceinline__ void b_scatter(int* __restrict__ ctl, const int* __restrict__ tope, const float* __restrict__ topw, unsigned* __restrict__ rowoff, u32x2* __restrict__ rowmeta, int* sl) {
    int* pst = sl;
    if (tidx() == 0) { int acc = 0; for (int v = 0; v < NVE; ++v) { pst[v] = acc; acc += (ctl[CTL_CNT + v] + 255) & ~255; } pst[NVE] = acc; }
    __syncthreads();
    if (blockIdx.x == 0) {
        for (int v = tidx(); v <= NVE; v += NTHR) ctl[CTL_PST + v] = pst[v];
        if (tidx() <= NQ) ctl[CTL_TQS + tidx()] = pst[tidx() * 65] >> 8;
        for (int v = tidx(); v < NVE; v += NTHR) for (int tl = pst[v] >> 8; tl < (pst[v + 1] >> 8); ++tl) ctl[CTL_TVE + tl] = v;
    }
    for (int idx = blockIdx.x * NTHR + tidx(); idx < M * 9; idx += gridDim.x * NTHR) {
        int m, k, pos; float w;
        if (idx < M * 8) { m = idx >> 3; k = idx & 7; const int ve = (m >> 13) * 65 + tope[idx]; w = topw[idx]; pos = pst[ve] + atomicAdd(ctl + CTL_CUR + ve, 1); }
        else { m = idx - M * 8; k = 8; w = 1.f; pos = pst[(m >> 13) * 65 + 64] + (m & (QT - 1)); }
        rowoff[pos] = (unsigned)m * (D * 2); rowmeta[pos] = (u32x2){(unsigned)((m & (QT - 1)) * 9 + k), __float_as_uint(w)};
    }
    __syncthreads();
}
__device__ __forceinline__ void b_combine(const Params& p, const h16* __restrict__ x2h, const h16* __restrict__ Y, int q) {
    const int lane = tidx() & 63;
    for (int r = blockIdx.x * 8 + (tidx() >> 6); r < QT; r += gridDim.x * 8) {
        const int m = q * QT + r;
        float v[16];
        { const h16x8 a = ((const h16x8*)(x2h + (size_t)m * D))[lane], b = ((const h16x8*)(x2h + (size_t)m * D))[lane + 64];
#pragma unroll
          for (int i = 0; i < 8; ++i) { v[i] = DN_ALPHA * (float)a[i]; v[8 + i] = DN_ALPHA * (float)b[i]; } }
#pragma unroll
        for (int k = 0; k < 9; ++k) { const h16x8* yr = (const h16x8*)(Y + ((size_t)r * 9 + k) * D); const h16x8 a = yr[lane], b = yr[lane + 64];
#pragma unroll
            for (int i = 0; i < 8; ++i) { v[i] += (float)a[i]; v[8 + i] += (float)b[i]; } }
        float s = 0.f;
#pragma unroll
        for (int i = 0; i < 16; ++i) s += v[i];
        const float mean = wave_sum(s) * (1.f / D); float s2 = 0.f;
#pragma unroll
        for (int i = 0; i < 16; ++i) { v[i] -= mean; s2 += v[i] * v[i]; }
        const float rstd = rsqrtf(wave_sum(s2) * (1.f / D) + LN_EPS);
#pragma unroll
        for (int hlf = 0; hlf < 2; ++hlf) { const int c0 = (lane + 64 * hlf) * 8;
            const f32x4 g0 = *(const f32x4*)(p.ln3g + c0), g1 = *(const f32x4*)(p.ln3g + c0 + 4), b0 = *(const f32x4*)(p.ln3b + c0), b1 = *(const f32x4*)(p.ln3b + c0 + 4);
            f32x4 o0, o1;
#pragma unroll
            for (int i = 0; i < 4; ++i) { o0[i] = v[8 * hlf + i] * rstd * g0[i] + b0[i]; o1[i] = v[8 * hlf + 4 + i] * rstd * g1[i] + b1[i]; }
            *(f32x4*)(p.out + (size_t)m * D + c0) = o0; *(f32x4*)(p.out + (size_t)m * D + c0 + 4) = o1; }
    }
}

constexpr int N_PHASES = 23;
__global__ void __launch_bounds__(NTHR, 2) mega_fwd(Params p) {
    extern __shared__ __attribute__((aligned(16))) unsigned char lds[];
    cg::grid_group grid = cg::this_grid();
    const int G = (int)gridDim.x, bid = (int)blockIdx.x;
#define tid tidx()
    unsigned char* ws = p.ws;
    h16* WinT = (h16*)(ws + WS_WIN); h16* WoutT = (h16*)(ws + WS_WOUT); h16* WxqT = (h16*)(ws + WS_WXQ); h16* WxoT = (h16*)(ws + WS_WXO); h16* WxkvT = (h16*)(ws + WS_WXKV);
    h16* memh = (h16*)(ws + WS_MEMH); h16* kvm = (h16*)(ws + WS_KVM); h16* kcmp = (h16*)(ws + WS_KCMP); h16* vcmpT = (h16*)(ws + WS_VCMP); h16* vsT = (h16*)(ws + WS_VST); h16* vwT = (h16*)(ws + WS_VWT);
    int* tope = (int*)(ws + WS_TOPE); float* topw = (float*)(ws + WS_TOPW);
    h16* xh = (h16*)(ws + WS_XH); h16* mix = (h16*)(ws + WS_MIX); h16* ox = (h16*)(ws + WS_OX); h16* hb = (h16*)(ws + WS_H); h16* nqr = (h16*)(ws + WS_NQR);
    float* kvb = (float*)(ws + WS_KVB); h16* prevT = (h16*)(ws + WS_PREVT);
    float* cosr = (float*)(ws + WS_COSR); float* sinr = (float*)(ws + WS_SINR); float* cosn = (float*)(ws + WS_COSN); float* sinn = (float*)(ws + WS_SINN); h16* kvmVT = (h16*)(ws + WS_KVMVT);
    h16* rqr = (h16*)((unsigned char*)p.out + DO_RQR); h16* rkr = (h16*)((unsigned char*)p.out + DO_RKR); h16* rkzT = (h16*)((unsigned char*)p.out + DO_RKZT); h16* rvT = (h16*)((unsigned char*)p.out + DO_RVT); float* pre = p.out; float* x1 = (float*)(ws + WS_X1); h16* x1h = (h16*)(ws + WS_X1H);
    h16* qx = (h16*)(ws + WS_QX); float* x2 = (float*)(ws + WS_X2); h16* x2h = (h16*)(ws + WS_X2H);
    int* ctl = (int*)ws; unsigned* rowoff = (unsigned*)(ws + WS_ROWOFF); u32x2* rowmeta = (u32x2*)(ws + WS_ROWMETA);
    h16* WguT = (h16*)(ws + WS_WGUT); h16* WdT = (h16*)(ws + WS_WDT); h16* Hm = (h16*)(ws + WS_HM); h16* Yq = (h16*)(ws + WS_Y);
    float* fl = (float*)lds;
    const int lo = p.ph_lo, hi = p.ph_hi;
#define IN(k) (lo <= (k) && (k) < hi)
#define SEAM(k) do { if (IN(k) && IN((k) + 1)) grid.sync(); } while (0)

    if (IN(0)) {
        const int sub = tid >> 8, lt = tid & 255; float* tl = fl + sub * 1088;
        constexpr int T0 = (INP / 32) * (D / 32), T1 = (D / 32) * (D / 32), T4 = (2 * D / 32) * (D / 32), TT = T0 + 3 * T1 + T4;
        for (int b0 = bid * 2; b0 < TT; b0 += G * 2) { int it = b0 + sub;
            if (it < T0) { b_transpose_tile(p.w_in, D, INC, WinT, INP, it, tl, lt); continue; } it -= T0;
            if (it < T1) { b_transpose_tile(p.w_out, D, D, WoutT, D, it, tl, lt); continue; } it -= T1;
            if (it < T1) { b_transpose_tile(p.w_xq, D, D, WxqT, D, it, tl, lt); continue; } it -= T1;
            if (it < T1) { b_transpose_tile(p.w_xo, D, D, WxoT, D, it, tl, lt); continue; } it -= T1;
            b_transpose_tile(p.w_xkv, D, 2 * D, WxkvT, 2 * D, it, tl, lt); }
        b_cvt(p.x, xh, (size_t)M * D / 4);
        b_cvt(p.mem, memh, (size_t)NB * MEML * D / 4);
        if (bid == 0) for (int i = tid; i < 1024; i += NTHR) ctl[i] = 0;
        b_tables(p.positions, cosr, sinr, cosn, sinn);
    }
    SEAM(0);
    if (IN(1)) {
        { pg8::Gemm g{xh, WinT, M, INP, D}; pg8::StaticOrder S; S.init(g, G, bid); pg8::EpiF16 E{hb, INP};
          pg8::gemm_phase<pg8::EpiF16, pg8::StaticOrder>((PG8_LAS unsigned char*)lds, g.K, S, E); }
        { pg8::Gemm g{memh, WxkvT, NB * MEML, 2 * D, D}; pg8::StaticOrder S; S.init(g, G, bid); pg8::EpiF16 E{kvm, 2 * D};
          pg8::gemm_phase<pg8::EpiF16, pg8::StaticOrder>((PG8_LAS unsigned char*)lds, g.K, S, E); }
    }
    SEAM(1);
    if (IN(2)) { const int sub = tid >> 8, lt = tid & 255;
        for (int b0 = bid * 2; b0 < M; b0 += G * 2) b_rope(hb, rqr, rkr, nqr, cosr, sinr, cosn, sinn, b0 + sub, lt);
        for (int b0 = bid * 2; b0 < 2 * NB * 2 * 128; b0 += G * 2) b_vtrans(hb, vsT, vwT, b0 + sub, (h16*)(fl + sub * 2304), lt);
        for (int b0 = bid * 2; b0 < NB * 4 * 128; b0 += G * 2) b_rtrans(p, hb, rvT, rkzT, cosr, sinr, b0 + sub, (h16*)(fl + sub * 4224), lt);
        for (int b0 = bid * 2; b0 < NB * 4 * 16; b0 += G * 2) b_mvtrans(kvm, kvmVT, b0 + sub, (h16*)(fl + sub * 2304), lt); }
    SEAM(2);
    if (IN(3)) { const int sub = tid >> 8, lt = tid & 255;
        for (int b0 = bid * 2; b0 < 2 * NB * 511 * 2; b0 += G * 2) b_cmp(p, hb, kcmp, vcmpT, b0 + sub, fl + sub * 2304, lt);
        const int wv = __builtin_amdgcn_readfirstlane(tid >> 6), lane = tid & 63;
        for (int ch = bid; ch < NB * 4 * 64; ch += G) ret_kv_unit(rkzT, rvT, kvb, ch, wv, lane); }
    SEAM(3);
    if (IN(4)) b_ret_scan(p, kvb, prevT);
    SEAM(4);
    if (IN(5)) {
        const int wv = __builtin_amdgcn_readfirstlane(tid >> 6), lane = tid & 63; float* wl = fl + wv * 1152;
        for (int u = bid * 8 + wv; u < NB * 2 * (T / 4); u += G * 8) { const int tg = (T / 4 - 1) - (u >> 3), bg = u & 7;
            nsa_wave_unit(hb, nqr, kcmp, vcmpT, vsT, vwT, mix, bg >> 1, bg & 1, tg * 4, wl, lane); }
        for (int ch = bid; ch < NB * 4 * 64; ch += G) ret_out_unit(p, hb, rqr, rkr, rvT, prevT, mix, ch, wv, lane);
    }
    SEAM(5);
    if (IN(6)) { pg8::Gemm g{mix, WoutT, M, D, D}; pg8::StaticOrder S; S.init(g, G, bid); pg8::EpiResF32 E{pre, p.x, D, DN_ALPHA};
        pg8::gemm_phase<pg8::EpiResF32, pg8::StaticOrder>((PG8_LAS unsigned char*)lds, g.K, S, E); }
    SEAM(6);
    if (IN(7)) b_ln(pre, p.ln1g, p.ln1b, x1, x1h);
    SEAM(7);
    if (IN(8)) { pg8::Gemm g{x1h, WxqT, M, D, D}; pg8::StaticOrder S; S.init(g, G, bid); pg8::EpiF16 E{qx, D};
        pg8::gemm_phase<pg8::EpiF16, pg8::StaticOrder>((PG8_LAS unsigned char*)lds, g.K, S, E); }
    SEAM(8);
    if (IN(9)) { const int wv = __builtin_amdgcn_readfirstlane(tid >> 6), lane = tid & 63;
        for (int u = bid; u < (M / 128) * 4; u += G) xattn_unit(qx, kvm, kvmVT, ox, (u >> 2) * 128 + wv * 16, u & 3, lane); }
    SEAM(9);
    if (IN(10)) { pg8::Gemm g{ox, WxoT, M, D, D}; pg8::StaticOrder S; S.init(g, G, bid); pg8::EpiResF32 E{pre, x1, D, DN_ALPHA};
        pg8::gemm_phase<pg8::EpiResF32, pg8::StaticOrder>((PG8_LAS unsigned char*)lds, g.K, S, E); }
    SEAM(10);
    if (IN(11)) b_ln(pre, p.ln2g, p.ln2b, x2, x2h);
    SEAM(11);
    if (IN(12)) {
        b_router(p, x2, tope, topw, ctl + CTL_CNT);
        if (bid == 0 && tid < NQ) ctl[CTL_CNT + tid * 65 + 64] = QT;
        for (int i = bid * NTHR + tid; i < CAP; i += G * NTHR) { rowoff[i] = 0u; rowmeta[i] = (u32x2){0xffffffffu, 0u}; }
        const int sub = tid >> 8, lt = tid & 255; float* tl = fl + sub * 1088;
        for (int b0 = bid * 2; b0 < 65 * 768; b0 += G * 2) { const int it = b0 + sub; const int e = it / 768, r = it % 768;
            const float* wg = e < 64 ? p.w_gate + (size_t)e * D * EFF : p.ws_gate; const float* wu = e < 64 ? p.w_up + (size_t)e * D * EFF : p.ws_up; const float* wd = e < 64 ? p.w_down + (size_t)e * EFF * D : p.ws_down;
            if (r < 256) b_transpose_tile(wg, D, EFF, WguT + (size_t)e * 512 * D, EFF, r, tl, lt, 2, 0);
            else if (r < 512) b_transpose_tile(wu, D, EFF, WguT + (size_t)e * 512 * D, EFF, r - 256, tl, lt, 2, 1);
            else b_transpose_tile(wd, EFF, D, WdT + (size_t)e * D * EFF, D, r - 512, tl, lt); }
    }
    SEAM(12);
    if (IN(13)) b_scatter(ctl, tope, topw, rowoff, rowmeta, (int*)lds);
    SEAM(13);
    if (IN(14)) { G1Sched S{ctl, (const char*)x2h, rowoff, (const char*)WguT, G, bid}; pg8::EpiGateUp E{Hm};
        pg8::gemm_phase<pg8::EpiGateUp, G1Sched>((PG8_LAS unsigned char*)lds, D, S, E); }
    SEAM(14);
#pragma unroll 1
    for (int q = 0; q < NQ; ++q) {
        if (IN(15 + 2 * q)) { G2Sched S{ctl, (const char*)Hm, (const char*)WdT, q, G, bid}; pg8::EpiDown E{Yq, rowmeta};
            pg8::gemm_phase<pg8::EpiDown, G2Sched>((PG8_LAS unsigned char*)lds, EFF, S, E); }
        SEAM(15 + 2 * q);
        if (IN(16 + 2 * q)) b_combine(p, x2h, Yq, q);
        if (q < NQ - 1) SEAM(16 + 2 * q);
    }
#undef IN
#undef SEAM
#undef tid
}

#ifndef MK_PER_PHASE
#define MK_PER_PHASE 0
#endif
extern "C" void kernel_launch(void* const* d_in, const int* in_sizes, int n_in, void* d_out, int out_size, void* d_ws, size_t ws_size, hipStream_t stream) {
    static int grid = 0;
    if (grid == 0) {
        if (n_in != 28 || in_sizes[0] != M * D || out_size != M * D || ws_size < WS_NEED) { fprintf(stderr, "kernel_launch: unexpected shapes (n_in %d, in0 %d, out %d, ws %zu)\n", n_in, n_in > 0 ? in_sizes[0] : -1, out_size, ws_size); grid = -1; return; }
        if (hipFuncSetAttribute((const void*)mega_fwd, hipFuncAttributeMaxDynamicSharedMemorySize, LDS_BYTES) != hipSuccess) { fprintf(stderr, "kernel_launch: hipFuncSetAttribute failed\n"); grid = -1; return; }
        int dev = 0, cus = 0, per_cu = 0;
        hipGetDevice(&dev); hipDeviceGetAttribute(&cus, hipDeviceAttributeMultiprocessorCount, dev);
        if (hipOccupancyMaxActiveBlocksPerMultiprocessor(&per_cu, (const void*)mega_fwd, NTHR, LDS_BYTES) != hipSuccess || per_cu < 1) { fprintf(stderr, "kernel_launch: occupancy query failed (%d)\n", per_cu); grid = -1; return; }
        grid = cus;
    }
    if (grid < 0) return;
    Params p{};
    p.x = (const float*)d_in[0]; p.mem = (const float*)d_in[1]; p.positions = (const int*)d_in[2];
    p.w_in = (const float*)d_in[3]; p.pe_k = (const float*)d_in[4]; p.pe_v = (const float*)d_in[5];
    p.w1k = (const float*)d_in[6]; p.w2k = (const float*)d_in[7]; p.w1v = (const float*)d_in[8]; p.w2v = (const float*)d_in[9];
    p.w_out = (const float*)d_in[10]; p.ln1g = (const float*)d_in[11]; p.ln1b = (const float*)d_in[12];
    p.w_xq = (const float*)d_in[13]; p.w_xkv = (const float*)d_in[14]; p.w_xo = (const float*)d_in[15];
    p.ln2g = (const float*)d_in[16]; p.ln2b = (const float*)d_in[17]; p.w_router = (const float*)d_in[18]; p.rbias = (const float*)d_in[19];
    p.w_gate = (const float*)d_in[20]; p.w_up = (const float*)d_in[21]; p.w_down = (const float*)d_in[22];
    p.ws_gate = (const float*)d_in[23]; p.ws_up = (const float*)d_in[24]; p.ws_down = (const float*)d_in[25];
    p.ln3g = (const float*)d_in[26]; p.ln3b = (const float*)d_in[27];
    p.out = (float*)d_out; p.ws = (unsigned char*)d_ws;
    for (int i = 0; i < 4; ++i) p.lg[i] = (float)std::log(1.0 - std::pow(2.0, -5.0 - (double)i));
#if MK_PER_PHASE
    for (int ph = 0; ph < N_PHASES; ++ph) { p.ph_lo = ph; p.ph_hi = ph + 1; hipLaunchKernelGGL(mega_fwd, dim3(grid), dim3(NTHR), LDS_BYTES, stream, p); }
#else
    p.ph_lo = 0; p.ph_hi = N_PHASES;
    void* args[] = {&p};
    hipError_t e = hipLaunchCooperativeKernel((const void*)mega_fwd, dim3(grid), dim3(NTHR), args, LDS_BYTES, stream);
    if (e != hipSuccess) fprintf(stderr, "kernel_launch: cooperative launch failed: %s (grid %d)\n", hipGetErrorString(e), grid);
#endif
}
```

```cpp
#include <hip/hip_runtime.h>
#include <cstdio>
#include <cstdint>
#include <cmath>

typedef _Float16 h16;
typedef _Float16 h16x8 __attribute__((ext_vector_type(8)));
typedef _Float16 h16x2 __attribute__((ext_vector_type(2)));
typedef _Float16 h16x4 __attribute__((ext_vector_type(4)));
typedef float f32x2 __attribute__((ext_vector_type(2)));
typedef float f32x4 __attribute__((ext_vector_type(4)));
typedef unsigned u32x4 __attribute__((ext_vector_type(4)));
typedef unsigned u32x2 __attribute__((ext_vector_type(2)));

__device__ __forceinline__ int tidx() { int t = (int)threadIdx.x; asm volatile("" : "+v"(t)); return t; }

constexpr int NB = 4, T = 8192, D = 1024, M = NB * T;
constexpr int INC = 3352, INP = 3584;
constexpr int C_RQ = 0, C_RK = 512, C_RV = 1024, C_RG = 1536, C_NQ = 2048, C_NKC = 2560, C_NVC = 2688, C_NKS = 2816, C_NVS = 2944, C_NKW = 3072, C_NVW = 3200, C_NG = 3328;
constexpr int MEML = 256;
constexpr int NE = 64, EFF = 256;
constexpr float LN_EPS = 1e-5f;
constexpr float DN_ALPHA = 1.189207115002721f;
constexpr float NEGF = -1e30f;

constexpr size_t MiB = 1u << 20;
constexpr size_t WS_WIN = 1 * MiB, WS_WOUT = 8 * MiB, WS_WXQ = 10 * MiB, WS_WXO = 12 * MiB, WS_WXKV = 14 * MiB, WS_MEMH = 18 * MiB, WS_KVM = 20 * MiB;
constexpr size_t WS_KCMP = 24 * MiB, WS_VCMP = 25 * MiB, WS_TOPE = 26 * MiB, WS_TOPW = 27 * MiB;
constexpr size_t WS_XH = 32 * MiB, WS_MIX = 32 * MiB, WS_OX = 32 * MiB;
constexpr size_t WS_H = 96 * MiB, WS_NQR = 320 * MiB, WS_KVB = 352 * MiB, WS_PREV = 416 * MiB;
constexpr size_t WS_PRE = 96 * MiB, WS_X1 = 224 * MiB, WS_X1H = 352 * MiB, WS_QX = 416 * MiB, WS_X2 = 130 * MiB;
constexpr size_t WS_X2H = 32 * MiB, WS_WDT = 96 * MiB, WS_HM = 130 * MiB, WS_WGUT = 306 * MiB, WS_Y = 306 * MiB;
constexpr size_t WS_ROWOFF = 1 * MiB, WS_ROWMETA = 3 * MiB;
constexpr size_t WS_VST = 480 * MiB, WS_VWT = 488 * MiB, WS_COSR = 496 * MiB, WS_SINR = 504 * MiB, WS_COSN = 28 * MiB, WS_SINN = 29 * MiB, WS_KVMVT = 30 * MiB;
constexpr size_t WS_PREVT = 416 * MiB;
constexpr size_t DO_RQR = 0, DO_RKR = 32 * MiB, DO_RKZT = 64 * MiB, DO_RVT = 96 * MiB;
constexpr size_t WS_NEED = 512 * MiB;
constexpr int NQ = 4, QT = M / NQ, NVE = NQ * 65, CAP_TILES = 1412, CAP = CAP_TILES * 256;
constexpr size_t WS_BAR = 65536;
constexpr int CTL_CNT = 0, CTL_CUR = 512, CTL_PST = 1024, CTL_TQS = 1536, CTL_TVE = 2048;

namespace pg8 {
#define PG8_LAS __attribute__((address_space(3)))
typedef short s16x8 __attribute__((ext_vector_type(8)));
constexpr int BM = 256, BK = 64, HALF = 128, HTB = HALF * BK * 2, STAGE_BYTES = 8 * HTB, NXCD = 8, WGM = 8;
__host__ __device__ __forceinline__ int lds_byte(int r, int c) { const int st = (r >> 4) * 2 + (c >> 5), rr = r & 15, cc = c & 31, ob = rr * 64 + cc * 2; return st * 1024 + (ob ^ (((ob >> 9) & 1) << 5)); }
__host__ __device__ __forceinline__ void stage_rc(int b, int& R, int& C) { const int st = b / 1024, sb = b % 1024, swz = sb ^ (((sb >> 9) & 1) << 5); R = (st >> 1) * 16 + swz / 64; C = (st & 1) * 32 + (swz % 64) / 2; }
__host__ __device__ __forceinline__ int perm32(int rho) { const int n = rho >> 4, i = rho & 15; return 8 * (i >> 2) + 4 * n + (i & 3); }
struct Unit { int pm, pn; const char* A; const char* B; const unsigned* gat; };
struct Gemm { const h16* A; const h16* Bt; int M, N, K; };
struct StaticOrder {
    int nM, nN, nwg, G, c; const char* A; const char* B; size_t tstep;
    __device__ void init(const Gemm& g, int G_, int c_) { nM = g.M / BM; nN = g.N / BM; nwg = nM * nN; G = G_; c = c_; A = (const char*)g.A; B = (const char*)g.Bt; tstep = (size_t)BM * g.K * 2; }
    __device__ bool next(int i, Unit& u) const {
        const long L = (long)i * G + c; if (L >= nwg) return false;
        int wgid = (int)L; { const int q = nwg / NXCD, r = nwg % NXCD, xcd = wgid % NXCD, off = wgid / NXCD; wgid = (xcd < r ? xcd * (q + 1) : r * (q + 1) + (xcd - r) * q) + off; }
        const int nig = WGM * nN, gid = wgid / nig, fm = gid * WGM, gsz = (nM - fm) < WGM ? (nM - fm) : WGM;
        u.pm = fm + ((wgid % nig) % gsz); u.pn = (wgid % nig) / gsz; u.A = A + (size_t)u.pm * tstep; u.B = B + (size_t)u.pn * tstep; u.gat = nullptr; return true;
    }
};
__device__ __forceinline__ unsigned cvt_pk_f16(float lo, float hi) { f32x2 v = {lo, hi}; h16x2 h = __builtin_convertvector(v, h16x2); return __builtin_bit_cast(unsigned, h); }

struct EpiF16 {
    static constexpr bool PERM = true;
    h16* O; int ldc;
    __device__ __forceinline__ void operator()(const f32x4 (&acc)[2][2][4][2], const Unit& u, int wr, int wc, int fr, int fq) const {
        const int row0 = u.pm * BM + wr * 64 + fr; const int col0 = u.pn * BM + wc * 32 + 8 * fq;
#pragma unroll
        for (int ai = 0; ai < 2; ++ai)
#pragma unroll
            for (int m = 0; m < 4; ++m) { h16* rowp = O + (size_t)(row0 + ai * HALF + m * 16) * ldc + col0;
#pragma unroll
                for (int bj = 0; bj < 2; ++bj) { const f32x4 v0 = acc[ai][bj][m][0], v1 = acc[ai][bj][m][1];
                    *(h16x8*)(rowp + bj * HALF) = __builtin_convertvector(__builtin_shufflevector(v0, v1, 0, 1, 2, 3, 4, 5, 6, 7), h16x8); } }
    }
};
struct EpiResF32 {
    static constexpr bool PERM = false;
    float* C; const float* R; int ldc; float alpha;
    __device__ __forceinline__ void operator()(const f32x4 (&acc)[2][2][4][2], const Unit& u, int wr, int wc, int fr, int fq) const {
        const int row0 = u.pm * BM + wr * 64 + fr, col0 = u.pn * BM + wc * 32 + 4 * fq;
#pragma unroll
        for (int ai = 0; ai < 2; ++ai)
#pragma unroll
            for (int m = 0; m < 4; ++m) { const size_t off = (size_t)(row0 + ai * HALF + m * 16) * ldc + col0;
#pragma unroll
                for (int bj = 0; bj < 2; ++bj)
#pragma unroll
                    for (int n = 0; n < 2; ++n) { const f32x4 r = *(const f32x4*)(R + off + bj * HALF + n * 16); *(f32x4*)(C + off + bj * HALF + n * 16) = r * alpha + acc[ai][bj][m][n]; } }
    }
};
struct EpiGateUp {
    static constexpr bool PERM = true;
    h16* H;
    __device__ __forceinline__ void operator()(const f32x4 (&acc)[2][2][4][2], const Unit& u, int wr, int wc, int fr, int fq) const {
        const int row0 = u.pm * BM + wr * 64 + fr; const int col0 = u.pn * 128 + wc * 16 + 4 * fq;
#pragma unroll
        for (int ai = 0; ai < 2; ++ai)
#pragma unroll
            for (int m = 0; m < 4; ++m) { h16* rowp = H + (size_t)(row0 + ai * HALF + m * 16) * 256 + col0;
#pragma unroll
                for (int bj = 0; bj < 2; ++bj) { const f32x4 v0 = acc[ai][bj][m][0], v1 = acc[ai][bj][m][1];
                    const float h0 = v0[0] / (1.f + __expf(-v0[0])) * v0[1], h1 = v0[2] / (1.f + __expf(-v0[2])) * v0[3];
                    const float h2 = v1[0] / (1.f + __expf(-v1[0])) * v1[1], h3 = v1[2] / (1.f + __expf(-v1[2])) * v1[3];
                    *(h16x4*)(rowp + bj * 64) = __builtin_convertvector((f32x4){h0, h1, h2, h3}, h16x4); } }
    }
};
struct EpiDown {
    static constexpr bool PERM = true;
    h16* Y; const u32x2* rowmeta;
    __device__ __forceinline__ void operator()(const f32x4 (&acc)[2][2][4][2], const Unit& u, int wr, int wc, int fr, int fq) const {
        const int row0 = u.pm * BM + wr * 64 + fr; const int col0 = u.pn * BM + wc * 32 + 8 * fq;
#pragma unroll
        for (int ai = 0; ai < 2; ++ai)
#pragma unroll
            for (int m = 0; m < 4; ++m) { const u32x2 md = rowmeta[row0 + ai * HALF + m * 16]; const int slot = (int)md.x; const float w8 = __uint_as_float(md.y);
                if (slot >= 0) { h16* rowp = Y + (size_t)slot * 1024 + col0;
#pragma unroll
                    for (int bj = 0; bj < 2; ++bj) { const f32x4 v0 = acc[ai][bj][m][0] * w8, v1 = acc[ai][bj][m][1] * w8;
                        *(h16x8*)(rowp + bj * HALF) = __builtin_convertvector(__builtin_shufflevector(v0, v1, 0, 1, 2, 3, 4, 5, 6, 7), h16x8); } }
                asm volatile("" ::: "memory"); }
    }
};

template <class Epi, class Sched>
__device__ __forceinline__ void gemm_phase(PG8_LAS unsigned char* lds, const int K, const Sched& S, const Epi& E) {
    const int tid = tidx(), wid = __builtin_amdgcn_readfirstlane(tid >> 6), lane = tid & 63, wr = wid >> 2, wc = wid & 3, fr = lane & 15, fq = lane >> 4;
    const int nt = K / BK;
    int R0, C0; stage_rc(tid * 16, R0, C0);
    const unsigned cb2 = (unsigned)C0 * 2u;
    unsigned voffB[2];
#pragma unroll
    for (int i = 0; i < 2; ++i) { const int R = R0 + 64 * i; const int Rb = Epi::PERM ? ((R & ~31) + perm32(R & 31)) : R; voffB[i] = (unsigned)(Rb * K) * 2u + cb2; }
    const size_t kstep = (size_t)(BK * 2);
    const size_t hstep = (size_t)HALF * K * 2;
    const unsigned ldsw = (unsigned)wid * 1024u;
    const int aoff = lds_byte(wr * 64 + fr, fq * 8), boff = lds_byte(wc * 32 + fr, fq * 8);
#define PG8_MKVA(u, va) do { _Pragma("unroll") for (int _h = 0; _h < 2; ++_h) _Pragma("unroll") for (int _i = 0; _i < 2; ++_i) { const int _r = _h * HALF + R0 + 64 * _i; \
        (va)[_h][_i] = ((u).gat ? (u).gat[_r] : (unsigned)(_r * K) * 2u) + cb2; } } while (0)
#define PG8_SA(b, h) (((b) * 2 + (h)) * HTB)
#define PG8_SB(b, h) ((4 + (b) * 2 + (h)) * HTB)
#define PG8_STAGE(bufoff, gbase, voff) do { _Pragma("unroll") for (int _i = 0; _i < 2; ++_i) \
        __builtin_amdgcn_global_load_lds((const unsigned*)((const char*)(gbase) + (voff)[_i]), (PG8_LAS unsigned*)(lds + (bufoff) + ldsw + _i * 8192), 16, 0, 0); } while (0)
#define PG8_LDA(dst, b, h) do { _Pragma("unroll") for (int m = 0; m < 4; ++m) _Pragma("unroll") for (int k = 0; k < 2; ++k) dst[m][k] = *(const PG8_LAS s16x8*)(lds + PG8_SA(b, h) + aoff + m * 2048 + k * 1024); } while (0)
#define PG8_LDB(dst, b, h) do { _Pragma("unroll") for (int n = 0; n < 2; ++n) _Pragma("unroll") for (int k = 0; k < 2; ++k) dst[n][k] = *(const PG8_LAS s16x8*)(lds + PG8_SB(b, h) + boff + n * 2048 + k * 1024); } while (0)
#define PG8_MMA(ai, bj, At, Bt) do { __builtin_amdgcn_s_setprio(1); _Pragma("unroll") for (int m = 0; m < 4; ++m) _Pragma("unroll") for (int n = 0; n < 2; ++n) _Pragma("unroll") for (int k = 0; k < 2; ++k) \
        acc[ai][bj][m][n] = __builtin_amdgcn_mfma_f32_16x16x32_f16(__builtin_bit_cast(h16x8, Bt[n][k]), __builtin_bit_cast(h16x8, At[m][k]), acc[ai][bj][m][n], 0, 0, 0); __builtin_amdgcn_s_setprio(0); } while (0)
#define PG8_WAIT_V(n) asm volatile("s_waitcnt vmcnt(" #n ")" ::: "memory")
#define PG8_WAIT_L(n) asm volatile("s_waitcnt lgkmcnt(" #n ")" ::: "memory")
#define PG8_BAR __builtin_amdgcn_s_barrier()
#define PG8_SCHED __builtin_amdgcn_sched_barrier(0)
    Unit cur, nxt; int ui = 0;
    if (!S.next(0, cur)) return;
    unsigned va[2][2];
    PG8_MKVA(cur, va);
    f32x4 acc[2][2][4][2];
#pragma unroll
    for (int a = 0; a < 2; ++a)
#pragma unroll
        for (int b = 0; b < 2; ++b)
#pragma unroll
            for (int m = 0; m < 4; ++m)
#pragma unroll
                for (int n = 0; n < 2; ++n) acc[a][b][m][n] = (f32x4){0.f, 0.f, 0.f, 0.f};
    s16x8 At[4][2], B0[2][2], B1[2][2];
    const char* cA = cur.A; const char* cB = cur.B;
    {
        PG8_STAGE(PG8_SB(0, 0), cB, voffB); PG8_STAGE(PG8_SB(0, 1), cB + hstep, voffB); PG8_STAGE(PG8_SA(0, 0), cA, va[0]); PG8_STAGE(PG8_SA(0, 1), cA, va[1]);
        if (wr == 1) PG8_BAR;
        PG8_WAIT_V(2); PG8_BAR;
        PG8_STAGE(PG8_SB(1, 0), cB + kstep, voffB); PG8_STAGE(PG8_SA(1, 0), cA + kstep, va[0]); PG8_STAGE(PG8_SB(1, 1), cB + hstep + kstep, voffB);
        PG8_WAIT_V(6); PG8_BAR;
    }
    for (;;) {
        const bool has_next = S.next(ui + 1, nxt);
        const char* nA = has_next ? nxt.A : cA; const char* nB = has_next ? nxt.B : cB;
#pragma unroll 1
        for (int t = 0; t < nt; t += 2) {
            const bool last = (t == nt - 2);
            const char* a1 = cA + (size_t)(t + 1) * kstep;
            const char* a2 = last ? nA : cA + (size_t)(t + 2) * kstep; const char* b2 = last ? nB : cB + (size_t)(t + 2) * kstep;
            const char* a3 = a2 + kstep; const char* b3 = b2 + kstep;
            PG8_LDB(B0, 0, 0); PG8_LDB(B1, 0, 1); PG8_SCHED; PG8_LDA(At, 0, 0); PG8_STAGE(PG8_SA(1, 1), a1, va[1]);
            if (last && has_next) { PG8_MKVA(nxt, va); }
            PG8_WAIT_V(8); PG8_WAIT_L(0); PG8_BAR; PG8_MMA(0, 0, At, B0); PG8_MMA(0, 1, At, B1); PG8_BAR; PG8_SCHED;
            PG8_LDA(At, 0, 1); PG8_STAGE(PG8_SB(0, 0), b2, voffB); PG8_STAGE(PG8_SB(0, 1), b2 + hstep, voffB); PG8_STAGE(PG8_SA(0, 0), a2, va[0]);
            PG8_WAIT_V(8); PG8_WAIT_L(0); PG8_BAR; PG8_MMA(1, 0, At, B0); PG8_MMA(1, 1, At, B1); PG8_BAR; PG8_SCHED;
            PG8_LDB(B0, 1, 0); PG8_LDB(B1, 1, 1); PG8_SCHED; PG8_LDA(At, 1, 0); PG8_STAGE(PG8_SA(0, 1), a2, va[1]);
            PG8_WAIT_V(8); PG8_WAIT_L(0); PG8_BAR; PG8_MMA(0, 0, At, B0); PG8_MMA(0, 1, At, B1); PG8_BAR; PG8_SCHED;
            PG8_LDA(At, 1, 1); PG8_STAGE(PG8_SB(1, 0), b3, voffB); PG8_STAGE(PG8_SB(1, 1), b3 + hstep, voffB); PG8_STAGE(PG8_SA(1, 0), a3, va[0]);
            PG8_WAIT_V(8); PG8_WAIT_L(0); PG8_BAR; PG8_MMA(1, 0, At, B0); PG8_MMA(1, 1, At, B1); PG8_BAR; PG8_SCHED;
        }
        if (wr == 0) PG8_BAR;
        E(acc, cur, wr, wc, fr, fq);
        if (!has_next) break;
#pragma unroll
        for (int a = 0; a < 2; ++a)
#pragma unroll
            for (int b = 0; b < 2; ++b)
#pragma unroll
                for (int m = 0; m < 4; ++m)
#pragma unroll
                    for (int n = 0; n < 2; ++n) acc[a][b][m][n] = (f32x4){0.f, 0.f, 0.f, 0.f};
        cur = nxt; cA = nA; cB = nB; ++ui;
        if (wr == 1) PG8_BAR;
    }
    PG8_WAIT_V(0);
    PG8_BAR;
#undef PG8_MKVA
#undef PG8_SA
#undef PG8_SB
#undef PG8_STAGE
#undef PG8_LDA
#undef PG8_LDB
#undef PG8_MMA
#undef PG8_WAIT_V
#undef PG8_WAIT_L
#undef PG8_BAR
#undef PG8_SCHED
}
}


#include <hip/hip_cooperative_groups.h>
namespace cg = cooperative_groups;
constexpr int NTHR = 512;
constexpr int LDS_BYTES = 147456;
#define LAS __attribute__((address_space(3)))

struct Params {
    const float *x, *mem; const int* positions;
    const float *w_in, *pe_k, *pe_v, *w1k, *w2k, *w1v, *w2v, *w_out, *ln1g, *ln1b, *w_xq, *w_xkv, *w_xo, *ln2g, *ln2b, *w_router, *rbias, *w_gate, *w_up, *w_down, *ws_gate, *ws_up, *ws_down, *ln3g, *ln3b;
    float* out; unsigned char* ws;
    float lg[4];
    int ph_lo, ph_hi;
};

__device__ __forceinline__ float wave_sum(float v) {
#pragma unroll
    for (int o = 1; o < 64; o <<= 1) v += __shfl_xor(v, o);
    return v;
}
__device__ __forceinline__ float wave_max(float v) {
#pragma unroll
    for (int o = 1; o < 64; o <<= 1) v = fmaxf(v, __shfl_xor(v, o));
    return v;
}
__device__ __forceinline__ float siluf(float v) { return v / (1.f + __expf(-v)); }
__device__ __forceinline__ float sigmf(float v) { return 1.f / (1.f + __expf(-v)); }

__device__ __forceinline__ void b_transpose_tile(const float* __restrict__ W, int K, int N, h16* __restrict__ WT, int Npad, int tile, float* tl, int lt, int rs = 1, int ro = 0) {
    const int ntn = Npad / 32; const int n0 = (tile % ntn) * 32, k0 = (tile / ntn) * 32, tx = lt & 31, ty = lt >> 5;
    for (int i = ty; i < 32; i += 8) { const int k = k0 + i, n = n0 + tx; tl[i * 33 + tx] = (n < N) ? W[(size_t)k * N + n] : 0.f; }
    __syncthreads();
    for (int i = ty; i < 32; i += 8) { const int n = n0 + i, k = k0 + tx; WT[(size_t)(n * rs + ro) * K + k] = (h16)tl[tx * 33 + i]; }
    __syncthreads();
}
__device__ __forceinline__ void b_cvt(const float* __restrict__ x, h16* __restrict__ o, size_t n4) {
    for (size_t i = (size_t)blockIdx.x * NTHR + tidx(); i < n4; i += (size_t)gridDim.x * NTHR) {
        const f32x4 v = ((const f32x4*)x)[i]; ((h16x4*)o)[i] = __builtin_convertvector(v, h16x4); }
}

__device__ __forceinline__ void b_tables(const int* __restrict__ positions, float* __restrict__ cosr, float* __restrict__ sinr, float* __restrict__ cosn, float* __restrict__ sinn) {
    for (int idx = blockIdx.x * NTHR + tidx(); idx < M * 72; idx += gridDim.x * NTHR) {
        const int m = idx / 72, j = idx % 72; const float pos = (float)positions[m];
        const float inv = j < 64 ? (float)pow(10000.0, -(double)j / 64.0) : (float)pow(500000.0, -(double)(j - 64) / 8.0);
        const float ang = pos * inv; double sd, cd; sincos((double)ang, &sd, &cd);
        if (j < 64) { cosr[(size_t)m * 64 + j] = (float)cd; sinr[(size_t)m * 64 + j] = (float)sd; } else { cosn[(size_t)m * 8 + j - 64] = (float)cd; sinn[(size_t)m * 8 + j - 64] = (float)sd; }
    }
}
__device__ __forceinline__ void b_rope(h16* __restrict__ h, h16* __restrict__ rqr, h16* __restrict__ rkr, h16* __restrict__ nqr, const float* __restrict__ cosr, const float* __restrict__ sinr,
                                       const float* __restrict__ cosn, const float* __restrict__ sinn, int m, int j) {
    h16* hr = h + (size_t)m * INP;
    {   const int hd = j >> 6, jj = j & 63; const float c = cosr[(size_t)m * 64 + jj], s = sinr[(size_t)m * 64 + jj];
        const int o1 = hd * 128 + jj, o2 = o1 + 64;
        const float q1 = (float)hr[C_RQ + o1], q2 = (float)hr[C_RQ + o2];
        rqr[(size_t)m * 512 + o1] = (h16)(q1 * c - q2 * s); rqr[(size_t)m * 512 + o2] = (h16)(q2 * c + q1 * s);
        const float k1 = (float)hr[C_RK + o1], k2 = (float)hr[C_RK + o2]; const float sc = 0.08838834764831845f;
        rkr[(size_t)m * 512 + o1] = (h16)((k1 * c - k2 * s) * sc); rkr[(size_t)m * 512 + o2] = (h16)((k2 * c + k1 * s) * sc);
    }
    if (j < 64 + 16 + 16) {
        const int jj = j & 7; const float c = cosn[(size_t)m * 8 + jj], s = sinn[(size_t)m * 8 + jj];
        if (j < 64) { const int hd = j >> 3; const int o1 = hd * 64 + jj, o2 = o1 + 8;
            const float q1 = (float)hr[C_NQ + o1], q2 = (float)hr[C_NQ + o2];
            nqr[(size_t)m * 512 + o1] = (h16)(q1 * c - q2 * s); nqr[(size_t)m * 512 + o2] = (h16)(q2 * c + q1 * s);
        } else { const int jx = j - 64; const int which = jx >> 4, g = (jx >> 3) & 1; const int base = (which ? C_NKW : C_NKS) + g * 64 + jj;
            const float k1 = (float)hr[base], k2 = (float)hr[base + 8];
            hr[base] = (h16)(k1 * c - k2 * s); hr[base + 8] = (h16)(k2 * c + k1 * s); }
    }
    for (int i = j; i < 8 * 48; i += 256) { const int hd = i / 48, d = 16 + i % 48; nqr[(size_t)m * 512 + hd * 64 + d] = hr[C_NQ + hd * 64 + d]; }
}
__device__ __forceinline__ void b_rtrans(const Params& p, const h16* __restrict__ h, h16* __restrict__ rvT, h16* __restrict__ rkzT, const float* __restrict__ cosr, const float* __restrict__ sinr, int item, h16* sl, int lt) {
    int id = item; const int tt = id & 127; id >>= 7; const int hd = id & 3; const int b = id >> 2; const int bh = b * 4 + hd; const float lg = p.lg[hd];
    for (int i = lt; i < 64 * 128; i += 256) { const int t = i >> 7, e = i & 127; sl[t * 130 + e] = h[(size_t)(b * T + tt * 64 + t) * INP + C_RV + hd * 128 + e]; }
    __syncthreads();
    for (int i = lt; i < 64 * 128; i += 256) { const int e = i >> 6, t = i & 63; rvT[(size_t)(bh * 128 + e) * T + tt * 64 + t] = sl[t * 130 + e]; }
    __syncthreads();
    for (int i = lt; i < 64 * 64; i += 256) { const int t = i >> 6, jj = i & 63; const size_t m = (size_t)b * T + tt * 64 + t;
        const float c = cosr[m * 64 + jj], s = sinr[m * 64 + jj]; const float k1 = (float)h[m * INP + C_RK + hd * 128 + jj], k2 = (float)h[m * INP + C_RK + hd * 128 + jj + 64];
        const float z = 0.08838834764831845f * __expf(lg * (float)(127 - ((tt * 64 + t) & 127)));
        sl[t * 130 + jj] = (h16)((k1 * c - k2 * s) * z); sl[t * 130 + jj + 64] = (h16)((k2 * c + k1 * s) * z); }
    __syncthreads();
    for (int i = lt; i < 64 * 128; i += 256) { const int d = i >> 6, t = i & 63; rkzT[(size_t)(bh * 128 + d) * T + tt * 64 + t] = sl[t * 130 + d]; }
    __syncthreads();
}
__device__ __forceinline__ void b_mvtrans(const h16* __restrict__ kvm, h16* __restrict__ kvmVT, int item, h16* sl, int lt) {
    int id = item; const int kt = id & 3; id >>= 2; const int dtl = id & 3; id >>= 2; const int hh = id & 3; const int b = id >> 2;
    for (int i = lt; i < 64 * 64; i += 256) { const int k = i >> 6, d = i & 63; sl[k * 66 + d] = kvm[(size_t)(b * MEML + kt * 64 + k) * 2048 + 1024 + hh * 256 + dtl * 64 + d]; }
    __syncthreads();
    for (int i = lt; i < 64 * 64; i += 256) { const int d = i >> 6, k = i & 63; kvmVT[(size_t)((b * 4 + hh) * 256 + dtl * 64 + d) * MEML + kt * 64 + k] = sl[k * 66 + d]; }
    __syncthreads();
}

__device__ __forceinline__ void b_cmp(const Params& p, const h16* __restrict__ h, h16* __restrict__ kcmp, h16* __restrict__ vcmpT, int item, float* sl, int lt) {
    float* a = sl; float* hid = sl + 2048;
    int id = item; const int g = id & 1; id >>= 1; const int c = id % 511; id /= 511; const int b = id & 3; const int kv = id >> 2;
    const float* pe = kv ? p.pe_v : p.pe_k; const float* w1 = kv ? p.w1v : p.w1k; const float* w2 = kv ? p.w2v : p.w2k;
    const int colb = (kv ? C_NVC : C_NKC) + g * 64;
    for (int i = lt; i < 2048; i += 256) { const int l = i >> 6, d = i & 63; a[i] = (float)h[(size_t)(b * T + 16 * c + l) * INP + colb + d] + pe[l * 64 + d]; }
    __syncthreads();
    { const int j = lt; float acc = 0.f;
        for (int k = 0; k < 2048; ++k) acc += a[k] * w1[(size_t)k * 256 + j];
        hid[j] = siluf(acc); }
    __syncthreads();
    if (lt < 64) { const int e = lt; float acc = 0.f;
        for (int j = 0; j < 256; ++j) acc += hid[j] * w2[j * 64 + e];
        if (kv == 0) { kcmp[((size_t)(b * 2 + g) * 512 + c) * 64 + e] = (h16)acc; if (c == 510) kcmp[((size_t)(b * 2 + g) * 512 + 511) * 64 + e] = (h16)0.f; }
        else { vcmpT[((size_t)(b * 2 + g) * 64 + e) * 512 + c] = (h16)acc; if (c == 510) vcmpT[((size_t)(b * 2 + g) * 64 + e) * 512 + 511] = (h16)0.f; } }
    __syncthreads();
}
__device__ __forceinline__ void b_vtrans(const h16* __restrict__ h, h16* __restrict__ vsT, h16* __restrict__ vwT, int item, h16* sl, int lt) {
    int id = item; const int tt = id & 127; id >>= 7; const int g = id & 1; id >>= 1; const int b = id & 3; const int which = id >> 2;
    const int col = (which ? C_NVW : C_NVS) + g * 64; h16* dst = (which ? vwT : vsT) + (size_t)((b * 2 + g) * 64) * T + tt * 64;
    for (int i = lt; i < 64 * 64; i += 256) { const int t = i >> 6, d = i & 63; sl[t * 66 + d] = h[(size_t)(b * T + tt * 64 + t) * INP + col + d]; }
    __syncthreads();
    for (int i = lt; i < 64 * 64; i += 256) { const int d = i >> 6, t = i & 63; dst[(size_t)d * T + t] = sl[t * 66 + d]; }
    __syncthreads();
}

__device__ __forceinline__ void ret_kv_unit(const h16* __restrict__ rkzT, const h16* __restrict__ rvT, float* __restrict__ kvT, int chunk, int w, int lane) {
    const int i = lane & 15, kg = lane >> 4; const int bh = chunk >> 6, n = chunk & 63;
    h16x8 a[4];
#pragma unroll
    for (int ks = 0; ks < 4; ++ks) a[ks] = *(const h16x8*)(rkzT + (size_t)(bh * 128 + 16 * w + i) * T + n * 128 + 32 * ks + 8 * kg);
#pragma unroll
    for (int et = 0; et < 8; ++et) { f32x4 acc = {0.f, 0.f, 0.f, 0.f};
#pragma unroll
        for (int ks = 0; ks < 4; ++ks) { const h16x8 bq = *(const h16x8*)(rvT + (size_t)(bh * 128 + 16 * et + i) * T + n * 128 + 32 * ks + 8 * kg); acc = __builtin_amdgcn_mfma_f32_16x16x32_f16(a[ks], bq, acc, 0, 0, 0); }
        *(f32x4*)(kvT + ((size_t)chunk * 128 + 16 * et + i) * 128 + 16 * w + 4 * kg) = acc; }
}
__device__ __forceinline__ void b_ret_scan(const Params& p, const float* __restrict__ kvT, h16* __restrict__ prevT) {
    for (int gid = blockIdx.x * NTHR + tidx(); gid < 16 * 16384; gid += gridDim.x * NTHR) {
        const int de = gid & 16383, bh = gid >> 14; const float cd = __expf(p.lg[bh & 3] * 128.f);
        float st = 0.f;
        for (int n = 0; n < 64; ++n) { const size_t o = ((size_t)(bh * 64 + n) << 14) + de; prevT[o] = (h16)st; st = st * cd + kvT[o]; }
    }
}
__device__ __forceinline__ void ret_out_unit(const Params& p, const h16* __restrict__ h, const h16* __restrict__ rqr, const h16* __restrict__ rkr, const h16* __restrict__ rvT, const h16* __restrict__ prevT,
                                             h16* __restrict__ mix, int chunk, int w, int lane) {
    const int i = lane & 15, kg = lane >> 4; const int bh = chunk >> 6, n = chunk & 63, b = bh >> 2, hd = bh & 3; const float lg = p.lg[hd];
    const int qi = 16 * w + i; const size_t m = (size_t)b * T + n * 128 + qi;
    h16x8 qf[4];
#pragma unroll
    for (int ks = 0; ks < 4; ++ks) qf[ks] = *(const h16x8*)(rqr + m * 512 + hd * 128 + 32 * ks + 8 * kg);
    f32x4 inner[8], cross[8];
#pragma unroll
    for (int et = 0; et < 8; ++et) { inner[et] = (f32x4){0.f, 0.f, 0.f, 0.f}; cross[et] = (f32x4){0.f, 0.f, 0.f, 0.f}; }
    for (int gq = 0; gq < 2; ++gq) {
        if (64 * gq > 16 * w + 15) break;
        f32x4 s[4];
#pragma unroll
        for (int tl = 0; tl < 4; ++tl) { const int ko = 32 * (tl >> 1) + 8 * (i >> 2) + 4 * (tl & 1) + (i & 3); const h16* kp = rkr + ((size_t)b * T + n * 128 + 64 * gq + ko) * 512 + hd * 128 + 8 * kg;
            f32x4 acc = {0.f, 0.f, 0.f, 0.f};
#pragma unroll
            for (int ks = 0; ks < 4; ++ks) acc = __builtin_amdgcn_mfma_f32_16x16x32_f16(*(const h16x8*)(kp + 32 * ks), qf[ks], acc, 0, 0, 0);
            s[tl] = acc; }
        h16x8 pf[2];
#pragma unroll
        for (int tl = 0; tl < 4; ++tl)
#pragma unroll
            for (int r = 0; r < 4; ++r) { const int j = 64 * gq + 32 * (tl >> 1) + 8 * kg + 4 * (tl & 1) + r; const float v = (j <= qi) ? s[tl][r] * __expf(lg * (float)(qi - j)) : 0.f; pf[tl >> 1][4 * (tl & 1) + r] = (h16)v; }
#pragma unroll
        for (int et = 0; et < 8; ++et)
#pragma unroll
            for (int s2 = 0; s2 < 2; ++s2) { const h16x8 a = *(const h16x8*)(rvT + (size_t)(bh * 128 + 16 * et + i) * T + n * 128 + 64 * gq + 32 * s2 + 8 * kg); inner[et] = __builtin_amdgcn_mfma_f32_16x16x32_f16(a, pf[s2], inner[et], 0, 0, 0); }
    }
#pragma unroll
    for (int et = 0; et < 8; ++et)
#pragma unroll
        for (int ks = 0; ks < 4; ++ks) { const h16x8 a = *(const h16x8*)(prevT + ((size_t)chunk * 128 + 16 * et + i) * 128 + 32 * ks + 8 * kg); cross[et] = __builtin_amdgcn_mfma_f32_16x16x32_f16(a, qf[ks], cross[et], 0, 0, 0); }
    const float xi = __expf(lg * (float)(qi + 1));
    float sm = 0.f;
#pragma unroll
    for (int et = 0; et < 8; ++et) { inner[et] = inner[et] + cross[et] * xi; sm += (inner[et][0] + inner[et][1]) + (inner[et][2] + inner[et][3]); }
    sm += __shfl_xor(sm, 16); sm += __shfl_xor(sm, 32);
    const float mu = sm * (1.f / 128.f); float sq = 0.f;
#pragma unroll
    for (int et = 0; et < 8; ++et) { inner[et] = inner[et] - mu; sq += (inner[et][0] * inner[et][0] + inner[et][1] * inner[et][1]) + (inner[et][2] * inner[et][2] + inner[et][3] * inner[et][3]); }
    sq += __shfl_xor(sq, 16); sq += __shfl_xor(sq, 32);
    const float rstd = rsqrtf(sq * (1.f / 128.f) + LN_EPS);
#pragma unroll
    for (int et = 0; et < 8; ++et) { const int e = 16 * et + 4 * kg; const h16x4 gv = *(const h16x4*)(h + m * INP + C_RG + hd * 128 + e);
        f32x4 o;
#pragma unroll
        for (int r = 0; r < 4; ++r) o[r] = siluf((float)gv[r]) * inner[et][r] * rstd;
        *(h16x4*)(mix + m * D + hd * 128 + e) = __builtin_convertvector(o, h16x4); }
}

struct AttSt { float m, l; f32x4 o[4]; };
template <class MaskF>
__device__ __forceinline__ void att_scores(f32x4 (&s)[4], const h16* __restrict__ Kb, int pitchK, const h16x8 (&qf)[2], int i, int kg, MaskF valid) {
#pragma unroll
    for (int tl = 0; tl < 4; ++tl) { const int ko = 32 * (tl >> 1) + 8 * (i >> 2) + 4 * (tl & 1) + (i & 3); const h16* kp = Kb + (size_t)ko * pitchK + 8 * kg;
        const h16x8 a0 = *(const h16x8*)kp, a1 = *(const h16x8*)(kp + 32);
        f32x4 z = {0.f, 0.f, 0.f, 0.f}; z = __builtin_amdgcn_mfma_f32_16x16x32_f16(a0, qf[0], z, 0, 0, 0); s[tl] = __builtin_amdgcn_mfma_f32_16x16x32_f16(a1, qf[1], z, 0, 0, 0); }
#pragma unroll
    for (int tl = 0; tl < 4; ++tl)
#pragma unroll
        for (int r = 0; r < 4; ++r) { const int ko = 32 * (tl >> 1) + 8 * kg + 4 * (tl & 1) + r; s[tl][r] = valid(ko) ? s[tl][r] * 0.125f : -INFINITY; }
}
__device__ __forceinline__ void att_pv(f32x4 (&o)[4], const f32x4 (&pv)[4], const h16* __restrict__ VTb, int vstride, int i, int kg) {
    h16x8 pf[2];
#pragma unroll
    for (int s2 = 0; s2 < 2; ++s2)
#pragma unroll
        for (int j = 0; j < 8; ++j) pf[s2][j] = (h16)pv[2 * s2 + (j >> 2)][j & 3];
#pragma unroll
    for (int dt = 0; dt < 4; ++dt)
#pragma unroll
        for (int s2 = 0; s2 < 2; ++s2) { const h16x8 a = *(const h16x8*)(VTb + (size_t)(16 * dt + i) * vstride + 32 * s2 + 8 * kg);
            o[dt] = __builtin_amdgcn_mfma_f32_16x16x32_f16(a, pf[s2], o[dt], 0, 0, 0); }
}
template <class MaskF>
__device__ __forceinline__ void att_tile(AttSt& st, const h16* __restrict__ Kb, int pitchK, const h16* __restrict__ VTb, int vstride, const h16x8 (&qf)[2], int i, int kg, MaskF valid) {
    f32x4 s[4]; att_scores(s, Kb, pitchK, qf, i, kg, valid);
    float mx = -INFINITY;
#pragma unroll
    for (int tl = 0; tl < 4; ++tl)
#pragma unroll
        for (int r = 0; r < 4; ++r) mx = fmaxf(mx, s[tl][r]);
    mx = fmaxf(mx, __shfl_xor(mx, 16)); mx = fmaxf(mx, __shfl_xor(mx, 32));
    const float mn = fmaxf(st.m, mx); const float alpha = __expf(st.m - mn); st.m = mn;
    float ps = 0.f;
#pragma unroll
    for (int tl = 0; tl < 4; ++tl)
#pragma unroll
        for (int r = 0; r < 4; ++r) { const float pe = __expf(s[tl][r] - mn); s[tl][r] = pe; ps += pe; }
    st.l = st.l * alpha + ps;
#pragma unroll
    for (int dt = 0; dt < 4; ++dt) st.o[dt] = st.o[dt] * alpha;
    att_pv(st.o, s, VTb, vstride, i, kg);
}
__device__ __forceinline__ void nsa_wave_unit(const h16* __restrict__ h, const h16* __restrict__ nqr, const h16* __restrict__ kcmp, const h16* __restrict__ vcmpT, const h16* __restrict__ vsT, const h16* __restrict__ vwT,
                                              h16* __restrict__ mix, int b, int g, int t0, float* wl, int lane) {
    const int i = lane & 15, kg = lane >> 4, tt = i & 3, hh = i >> 2;
    const int trow = t0 + tt; const size_t mrow = (size_t)b * T + trow;
    h16x8 qf[2], qrf[2];
    { const h16* qp = h + mrow * INP + C_NQ + (g * 4 + hh) * 64 + 8 * kg; qf[0] = *(const h16x8*)qp; qf[1] = *(const h16x8*)(qp + 32);
      const h16* qrp = nqr + mrow * 512 + (g * 4 + hh) * 64 + 8 * kg; qrf[0] = *(const h16x8*)qrp; qrf[1] = *(const h16x8*)(qrp + 32); }
    float* impA = wl; float* impL = wl + 512; float* vals = wl + 1024;
    for (int x = lane; x < 1024; x += 64) wl[x] = 0.f;
    const int ncv_row = trow >= 31 ? ((trow - 31) >> 4) + 1 : 0;
    const int ncv_max = (t0 + 3 >= 31) ? ((t0 + 3 - 31) >> 4) + 1 : 0;
    const int nct = (ncv_max + 63) >> 6;
    const h16* Kc = kcmp + (size_t)(b * 2 + g) * 512 * 64; const h16* Vc = vcmpT + (size_t)(b * 2 + g) * 64 * 512;
    float m = -1e30f, l = 0.f;
    for (int ct = 0; ct < nct; ++ct) {
        f32x4 s[4]; att_scores(s, Kc + (size_t)ct * 64 * 64, 64, qf, i, kg, [&](int ko) { return ct * 64 + ko < ncv_row; });
        float mx = -INFINITY;
#pragma unroll
        for (int tl = 0; tl < 4; ++tl)
#pragma unroll
            for (int r = 0; r < 4; ++r) mx = fmaxf(mx, s[tl][r]);
        mx = fmaxf(mx, __shfl_xor(mx, 16)); mx = fmaxf(mx, __shfl_xor(mx, 32));
        const float mn = fmaxf(m, mx); float ps = 0.f;
#pragma unroll
        for (int tl = 0; tl < 4; ++tl)
#pragma unroll
            for (int r = 0; r < 4; ++r) ps += __expf(s[tl][r] - mn);
        l = l * __expf(m - mn) + ps; m = mn;
    }
    l += __shfl_xor(l, 16); l += __shfl_xor(l, 32);
    const float linv = l > 0.f ? 1.f / l : 0.f;
    f32x4 oc[4];
#pragma unroll
    for (int dt = 0; dt < 4; ++dt) oc[dt] = (f32x4){0.f, 0.f, 0.f, 0.f};
    for (int ct = 0; ct < nct; ++ct) {
        f32x4 s[4]; att_scores(s, Kc + (size_t)ct * 64 * 64, 64, qf, i, kg, [&](int ko) { return ct * 64 + ko < ncv_row; });
#pragma unroll
        for (int tl = 0; tl < 4; ++tl) {
#pragma unroll
            for (int r = 0; r < 4; ++r) s[tl][r] = __expf(s[tl][r] - m) * linv;
            float A = (s[tl][0] + s[tl][1]) + (s[tl][2] + s[tl][3]), L = s[tl][3];
            A += __shfl_xor(A, 4); A += __shfl_xor(A, 8); L += __shfl_xor(L, 4); L += __shfl_xor(L, 8);
            if (hh == 0) { const int u = ct * 16 + 8 * (tl >> 1) + 2 * kg + (tl & 1); impA[tt * 128 + u] = A; impL[tt * 128 + u] = L; }
        }
        att_pv(oc, s, Vc + ct * 64, 512, i, kg);
    }
    const int cur = t0 >> 6;
    unsigned long long mylo = 0ull, myhi = 0ull, anylo = 0ull, anyhi = 0ull;
    for (int tk = 0; tk < 4; ++tk) {
        float v0, v1;
        { const int s0 = lane, s1 = lane + 64;
          v0 = impA[tk * 128 + s0] + (s0 > 0 ? impL[tk * 128 + s0 - 1] : 0.f); v1 = impA[tk * 128 + s1] + impL[tk * 128 + s1 - 1];
          if (s0 == 0 || s0 == cur || s0 == cur - 1) v0 = 1e9f; if (s1 == cur || s1 == cur - 1) v1 = 1e9f;
          if (s0 > cur) v0 = NEGF; if (s1 > cur) v1 = NEGF; }
        vals[lane] = v0; vals[lane + 64] = v1;
        int r0 = 0, r1 = 0;
        for (int s2 = 0; s2 < 128; ++s2) { const float x = vals[s2]; r0 += (x > v0 || (x == v0 && s2 < lane)) ? 1 : 0; r1 += (x > v1 || (x == v1 && s2 < lane + 64)) ? 1 : 0; }
        const unsigned long long lo = __ballot(r0 < 16), hi = __ballot(r1 < 16);
        anylo |= lo; anyhi |= hi; if (tt == tk) { mylo = lo; myhi = hi; }
    }
    AttSt ss; ss.m = -1e30f; ss.l = 0.f;
#pragma unroll
    for (int dt = 0; dt < 4; ++dt) ss.o[dt] = (f32x4){0.f, 0.f, 0.f, 0.f};
    for (int s = 0; s <= cur; ++s) {
        const unsigned long long am = s < 64 ? anylo : anyhi; if (!((am >> (s & 63)) & 1ull)) continue;
        const bool mybit = (((s < 64 ? mylo : myhi) >> (s & 63)) & 1ull) != 0ull;
        att_tile(ss, h + ((size_t)b * T + 64 * s) * INP + C_NKS + g * 64, INP, vsT + (size_t)((b * 2 + g) * 64) * T + 64 * s, T, qrf, i, kg, [&](int ko) { return mybit && (64 * s + ko <= trow); });
    }
    AttSt sw; sw.m = -1e30f; sw.l = 0.f;
#pragma unroll
    for (int dt = 0; dt < 4; ++dt) sw.o[dt] = (f32x4){0.f, 0.f, 0.f, 0.f};
    for (int s = (t0 >= 511 ? (t0 - 511) >> 6 : 0); s <= cur; ++s)
        att_tile(sw, h + ((size_t)b * T + 64 * s) * INP + C_NKW + g * 64, INP, vwT + (size_t)((b * 2 + g) * 64) * T + 64 * s, T, qrf, i, kg, [&](int ko) { const int kp = 64 * s + ko; return kp <= trow && kp >= trow - 511; });
    float ls = ss.l; ls += __shfl_xor(ls, 16); ls += __shfl_xor(ls, 32); float lw = sw.l; lw += __shfl_xor(lw, 16); lw += __shfl_xor(lw, 32);
    const h16* gp = h + mrow * INP + C_NG + (g * 4 + hh) * 3;
    const float g0 = sigmf((float)gp[0]), g1 = sigmf((float)gp[1]) / ls, g2 = sigmf((float)gp[2]) / lw;
#pragma unroll
    for (int dt = 0; dt < 4; ++dt) { const f32x4 o = oc[dt] * g0 + ss.o[dt] * g1 + sw.o[dt] * g2;
        *(h16x4*)(mix + mrow * D + 512 + (g * 4 + hh) * 64 + 16 * dt + 4 * kg) = __builtin_convertvector(o, h16x4); }
}

__device__ __forceinline__ void b_ln(const float* __restrict__ in, const float* __restrict__ gam, const float* __restrict__ bet, float* __restrict__ o32, h16* __restrict__ o16) {
    const int lane = tidx() & 63;
    for (int row = blockIdx.x * 8 + (tidx() >> 6); row < M; row += gridDim.x * 8) {
        const f32x4* xr = (const f32x4*)(in + (size_t)row * D) + lane;
        f32x4 v[4]; float s = 0.f;
#pragma unroll
        for (int j = 0; j < 4; ++j) { v[j] = xr[64 * j]; s += (v[j][0] + v[j][1]) + (v[j][2] + v[j][3]); }
        const float mean = wave_sum(s) * (1.f / D); float s2 = 0.f;
#pragma unroll
        for (int j = 0; j < 4; ++j) { v[j] = v[j] - mean; s2 += (v[j][0] * v[j][0] + v[j][1] * v[j][1]) + (v[j][2] * v[j][2] + v[j][3] * v[j][3]); }
        const float rstd = rsqrtf(wave_sum(s2) * (1.f / D) + LN_EPS);
#pragma unroll
        for (int j = 0; j < 4; ++j) { const f32x4 gg = ((const f32x4*)gam)[lane + 64 * j], bb = ((const f32x4*)bet)[lane + 64 * j]; const f32x4 o = v[j] * rstd * gg + bb;
            ((f32x4*)(o32 + (size_t)row * D))[lane + 64 * j] = o;
            if (o16) ((h16x4*)(o16 + (size_t)row * D))[lane + 64 * j] = __builtin_convertvector(o, h16x4); }
    }
}

__device__ __forceinline__ void xattn_unit(const h16* __restrict__ qx, const h16* __restrict__ kvm, const h16* __restrict__ kvmVT, h16* __restrict__ ox, int m0, int hh, int lane) {
    const int i = lane & 15, kg = lane >> 4; const int b = m0 >> 13; const size_t m = (size_t)m0 + i;
    h16x8 qf[8];
#pragma unroll
    for (int ks = 0; ks < 8; ++ks) qf[ks] = *(const h16x8*)(qx + m * D + hh * 256 + 32 * ks + 8 * kg);
    f32x4 o[16];
#pragma unroll
    for (int dt = 0; dt < 16; ++dt) o[dt] = (f32x4){0.f, 0.f, 0.f, 0.f};
    float mrun = -1e30f, l = 0.f;
    const h16* vb = kvmVT + (size_t)((b * 4 + hh) * 256) * MEML;
#pragma unroll 1
    for (int gq = 0; gq < 4; ++gq) {
        f32x4 s[4]; float mx = -INFINITY;
#pragma unroll
        for (int tl = 0; tl < 4; ++tl) { const int ko = 64 * gq + 32 * (tl >> 1) + 8 * (i >> 2) + 4 * (tl & 1) + (i & 3); const h16* kp = kvm + (size_t)(b * MEML + ko) * 2048 + hh * 256 + 8 * kg;
            f32x4 acc = {0.f, 0.f, 0.f, 0.f};
#pragma unroll
            for (int ks = 0; ks < 8; ++ks) acc = __builtin_amdgcn_mfma_f32_16x16x32_f16(*(const h16x8*)(kp + 32 * ks), qf[ks], acc, 0, 0, 0);
            s[tl] = acc * 0.0625f; mx = fmaxf(mx, fmaxf(fmaxf(s[tl][0], s[tl][1]), fmaxf(s[tl][2], s[tl][3]))); }
        mx = fmaxf(mx, __shfl_xor(mx, 16)); mx = fmaxf(mx, __shfl_xor(mx, 32));
        const float mn = fmaxf(mrun, mx); const float alpha = __expf(mrun - mn); mrun = mn;
        float ps = 0.f; h16x8 pf[2];
#pragma unroll
        for (int tl = 0; tl < 4; ++tl)
#pragma unroll
            for (int r = 0; r < 4; ++r) { const float pe = __expf(s[tl][r] - mn); ps += pe; pf[tl >> 1][4 * (tl & 1) + r] = (h16)pe; }
        l = l * alpha + ps;
#pragma unroll
        for (int dt = 0; dt < 16; ++dt) { f32x4 acc = o[dt] * alpha;
#pragma unroll
            for (int s2 = 0; s2 < 2; ++s2) acc = __builtin_amdgcn_mfma_f32_16x16x32_f16(*(const h16x8*)(vb + (size_t)(16 * dt + i) * MEML + 64 * gq + 32 * s2 + 8 * kg), pf[s2], acc, 0, 0, 0);
            o[dt] = acc; }
    }
    l += __shfl_xor(l, 16); l += __shfl_xor(l, 32); const float linv = 1.f / l;
#pragma unroll
    for (int dt = 0; dt < 16; ++dt) { const f32x4 acc = o[dt] * linv; *(h16x4*)(ox + m * D + hh * 256 + 16 * dt + 4 * kg) = __builtin_convertvector(acc, h16x4); }
}

__device__ __forceinline__ void b_router(const Params& p, const float* __restrict__ x2, int* __restrict__ tope, float* __restrict__ topw, int* __restrict__ hist) {
    const int lane = tidx() & 63; const float* wr = p.w_router;
    for (int m = blockIdx.x * 8 + (tidx() >> 6); m < M; m += gridDim.x * 8) {
        const float* xr = x2 + (size_t)m * D; float acc = 0.f;
        for (int k = 0; k < D; k += 4) { const f32x4 xv = *(const f32x4*)(xr + k);
            acc += xv[0] * wr[(k + 0) * 64 + lane]; acc += xv[1] * wr[(k + 1) * 64 + lane]; acc += xv[2] * wr[(k + 2) * 64 + lane]; acc += xv[3] * wr[(k + 3) * 64 + lane]; }
        const float score = 1.f / (1.f + expf(-acc)); const float biased = score + p.rbias[lane];
        float m1 = biased; m1 = fmaxf(m1, __shfl_xor(m1, 1)); m1 = fmaxf(m1, __shfl_xor(m1, 2)); m1 = fmaxf(m1, __shfl_xor(m1, 4));
        int am = (biased == m1) ? lane : 999; am = min(am, __shfl_xor(am, 1)); am = min(am, __shfl_xor(am, 2)); am = min(am, __shfl_xor(am, 4));
        float m2 = (lane == am) ? -INFINITY : biased; m2 = fmaxf(m2, __shfl_xor(m2, 1)); m2 = fmaxf(m2, __shfl_xor(m2, 2)); m2 = fmaxf(m2, __shfl_xor(m2, 4));
        const float gs = m1 + m2;
        int cnt = 0;
#pragma unroll
        for (int gq = 0; gq < 8; ++gq) { const float o = __shfl(gs, gq * 8); cnt += (o > gs) ? 1 : 0; }
        const float masked = (cnt <= 3) ? biased : NEGF;
        int rank = 0;
        for (int e2 = 0; e2 < 64; ++e2) { const float o = __shfl(masked, e2); rank += (o > masked || (o == masked && e2 < lane)) ? 1 : 0; }
        const bool selq = rank < 8;
        const float wsum = wave_sum(selq ? score : 0.f);
        if (selq) { tope[(size_t)m * 8 + rank] = lane; topw[(size_t)m * 8 + rank] = score / wsum * 2.5f; atomicAdd(hist + (m >> 13) * 65 + lane, 1); }
    }
}

__device__ __forceinline__ void b_moe(const Params& p, const float* __restrict__ x2, const int* __restrict__ tope, const float* __restrict__ topw, float* __restrict__ out, int m, float* sl, int tid) {
    float* xs = sl; float* hd = sl + 1024; float* red = sl + 1280;
    for (int i = tid; i < 1024; i += 256) xs[i] = x2[(size_t)m * D + i];
    __syncthreads();
    float acc[4] = {0.f, 0.f, 0.f, 0.f};
    for (int kx = 0; kx < 9; ++kx) {
        const float* G; const float* U; const float* Dn; float wt;
        if (kx < 8) { const int e = tope[(size_t)m * 8 + kx]; wt = topw[(size_t)m * 8 + kx]; G = p.w_gate + (size_t)e * D * EFF; U = p.w_up + (size_t)e * D * EFF; Dn = p.w_down + (size_t)e * EFF * D; }
        else { wt = 1.f; G = p.ws_gate; U = p.ws_up; Dn = p.ws_down; }
        float a = 0.f, u = 0.f;
        for (int k = 0; k < D; ++k) { const float xv = xs[k]; a += xv * G[(size_t)k * EFF + tid]; u += xv * U[(size_t)k * EFF + tid]; }
        hd[tid] = siluf(a) * u * wt;
        __syncthreads();
        for (int j = 0; j < EFF; ++j) { const float hv = hd[j]; const float* dr = Dn + (size_t)j * D + tid;
            acc[0] += hv * dr[0]; acc[1] += hv * dr[256]; acc[2] += hv * dr[512]; acc[3] += hv * dr[768]; }
        __syncthreads();
    }
    float v[4]; float s = 0.f;
#pragma unroll
    for (int i = 0; i < 4; ++i) { v[i] = DN_ALPHA * xs[tid + 256 * i] + acc[i]; s += v[i]; }
    s = wave_sum(s); if ((tid & 63) == 0) red[tid >> 6] = s; __syncthreads();
    const float mean = (red[0] + red[1] + red[2] + red[3]) * (1.f / D); float s2 = 0.f;
#pragma unroll
    for (int i = 0; i < 4; ++i) { v[i] -= mean; s2 += v[i] * v[i]; }
    s2 = wave_sum(s2); if ((tid & 63) == 0) red[4 + (tid >> 6)] = s2; __syncthreads();
    const float rstd = rsqrtf((red[4] + red[5] + red[6] + red[7]) * (1.f / D) + LN_EPS);
#pragma unroll
    for (int i = 0; i < 4; ++i) out[(size_t)m * D + tid + 256 * i] = v[i] * rstd * p.ln3g[tid + 256 * i] + p.ln3b[tid + 256 * i];
    __syncthreads();
}

struct G1Sched {
    const int* ctl; const char* x2h; const unsigned* rowoff; const char* WguT; int G, c;
    __device__ bool next(int i, pg8::Unit& u) const {
        const int ntile = ctl[CTL_TQS + NQ]; const long L = (long)i * G + c; if (L >= 2L * ntile) return false;
        const int tile = (int)(L >> 1), pn = (int)(L & 1); const int e = ctl[CTL_TVE + tile] % 65;
        u.pm = tile; u.pn = pn; u.A = x2h; u.gat = rowoff + (size_t)tile * 256; u.B = WguT + ((size_t)e * 512 + pn * 256) * (D * 2); return true; }
};
struct G2Sched {
    const int* ctl; const char* H; const char* WdT; int q, G, c;
    __device__ bool next(int i, pg8::Unit& u) const {
        const int t0 = ctl[CTL_TQS + q], t1 = ctl[CTL_TQS + q + 1]; const long L = (long)i * G + c; if (L >= 4L * (t1 - t0)) return false;
        const int tile = t0 + (int)(L >> 2), pn = (int)(L & 3); const int e = ctl[CTL_TVE + tile] % 65;
        u.pm = tile; u.pn = pn; u.A = H + (size_t)tile * 256 * (EFF * 2); u.gat = nullptr; u.B = WdT + ((size_t)e * D + pn * 256) * (EFF * 2); return true; }
};
__device__ __forceinline__ void b_scatter(int* __restrict__ ctl, const int* __restrict__ tope, const float* __restrict__ topw, unsigned* __restrict__ rowoff, u32x2* __restrict__ rowmeta, int* sl) {
    int* pst = sl;
    if (tidx() == 0) { int acc = 0; for (int v = 0; v < NVE; ++v) { pst[v] = acc; acc += (ctl[CTL_CNT + v] + 255) & ~255; } pst[NVE] = acc; }
    __syncthreads();
    if (blockIdx.x == 0) {
        for (int v = tidx(); v <= NVE; v += NTHR) ctl[CTL_PST + v] = pst[v];
        if (tidx() <= NQ) ctl[CTL_TQS + tidx()] = pst[tidx() * 65] >> 8;
        for (int v = tidx(); v < NVE; v += NTHR) for (int tl = pst[v] >> 8; tl < (pst[v + 1] >> 8); ++tl) ctl[CTL_TVE + tl] = v;
    }
    for (int idx = blockIdx.x * NTHR + tidx(); idx < M * 9; idx += gridDim.x * NTHR) {
        int m, k, pos; float w;
        if (idx < M * 8) { m = idx >> 3; k = idx & 7; const int ve = (m >> 13) * 65 + tope[idx]; w = topw[idx]; pos = pst[ve] + atomicAdd(ctl + CTL_CUR + ve, 1); }
        else { m = idx - M * 8; k = 8; w = 1.f; pos = pst[(m >> 13) * 65 + 64] + (m & (QT - 1)); }
        rowoff[pos] = (unsigned)m * (D * 2); rowmeta[pos] = (u32x2){(unsigned)((m & (QT - 1)) * 9 + k), __float_as_uint(w)};
    }
    __syncthreads();
}
__device__ __forceinline__ void b_combine(const Params& p, const h16* __restrict__ x2h, const h16* __restrict__ Y, int q) {
    const int lane = tidx() & 63;
    for (int r = blockIdx.x * 8 + (tidx() >> 6); r < QT; r += gridDim.x * 8) {
        const int m = q * QT + r;
        float v[16];
        { const h16x8 a = ((const h16x8*)(x2h + (size_t)m * D))[lane], b = ((const h16x8*)(x2h + (size_t)m * D))[lane + 64];
#pragma unroll
          for (int i = 0; i < 8; ++i) { v[i] = DN_ALPHA * (float)a[i]; v[8 + i] = DN_ALPHA * (float)b[i]; } }
#pragma unroll
        for (int k = 0; k < 9; ++k) { const h16x8* yr = (const h16x8*)(Y + ((size_t)r * 9 + k) * D); const h16x8 a = yr[lane], b = yr[lane + 64];
#pragma unroll
            for (int i = 0; i < 8; ++i) { v[i] += (float)a[i]; v[8 + i] += (float)b[i]; } }
        float s = 0.f;
#pragma unroll
        for (int i = 0; i < 16; ++i) s += v[i];
        const float mean = wave_sum(s) * (1.f / D); float s2 = 0.f;
#pragma unroll
        for (int i = 0; i < 16; ++i) { v[i] -= mean; s2 += v[i] * v[i]; }
        const float rstd = rsqrtf(wave_sum(s2) * (1.f / D) + LN_EPS);
#pragma unroll
        for (int hlf = 0; hlf < 2; ++hlf) { const int c0 = (lane + 64 * hlf) * 8;
            const f32x4 g0 = *(const f32x4*)(p.ln3g + c0), g1 = *(const f32x4*)(p.ln3g + c0 + 4), b0 = *(const f32x4*)(p.ln3b + c0), b1 = *(const f32x4*)(p.ln3b + c0 + 4);
            f32x4 o0, o1;
#pragma unroll
            for (int i = 0; i < 4; ++i) { o0[i] = v[8 * hlf + i] * rstd * g0[i] + b0[i]; o1[i] = v[8 * hlf + 4 + i] * rstd * g1[i] + b1[i]; }
            *(f32x4*)(p.out + (size_t)m * D + c0) = o0; *(f32x4*)(p.out + (size_t)m * D + c0 + 4) = o1; }
    }
}

#define XB_TMO      128
#define XB_XCNT(j)  (256  + 64 * (j))
#define XB_XSUB(j)  (1280 + 64 * (j))
#define XB_XGEN(j)  (2304 + 64 * (j))
#define XB_TOP      3328
#define XB_TOPGEN   3392
#define XCD_BAR_WORDS 3456
#define XB_SPIN_CAP (1u << 22)
__device__ __forceinline__ unsigned xb_ld(unsigned* p)              { return __hip_atomic_load(p, __ATOMIC_RELAXED, __HIP_MEMORY_SCOPE_AGENT); }
__device__ __forceinline__ unsigned xb_add(unsigned* p, unsigned v) { return __hip_atomic_fetch_add(p, v, __ATOMIC_RELAXED, __HIP_MEMORY_SCOPE_AGENT); }
__device__ __forceinline__ unsigned xb_xcc_id() { return (unsigned)__builtin_amdgcn_s_getreg((3 << 11) | 20) & 0xFu; }
#define XB_SPIN(cond, bar) do { unsigned _sp = 0; while (cond) { __builtin_amdgcn_s_sleep(1); \
    if ((++_sp & 255u) == 0u) { if (xb_ld(&(bar)[XB_TMO])) break; if (_sp > XB_SPIN_CAP) { atomicAdd(&(bar)[XB_TMO], 1u); break; } } } } while (0)
struct XcdBarrier { unsigned* bar; unsigned x; volatile LAS unsigned* st; };
__device__ __forceinline__ XcdBarrier xcd_barrier_post(unsigned* bar, volatile LAS unsigned* st) {
    XcdBarrier b; b.bar = bar; b.x = xb_xcc_id(); b.st = st;
    if (threadIdx.x == 0) (void)xb_add(&bar[XB_XCNT(b.x)], 1u);
    return b;
}
__device__ __forceinline__ void xcd_barrier_complete(unsigned* bar, unsigned x, unsigned& nloc, unsigned& nx) {
    const unsigned G = gridDim.x * gridDim.y * gridDim.z;
    unsigned sum, cnt, mine, sp = 0u;
    for (;;) {
        sum = 0u; cnt = 0u; mine = 0u;
#pragma unroll
        for (unsigned j = 0; j < 16; ++j) { const unsigned c = xb_ld(&bar[XB_XCNT(j)]); sum += c; cnt += (c > 0u) ? 1u : 0u; mine = (j == x) ? c : mine; }
        if (sum == G) break;
        __builtin_amdgcn_s_sleep(1);
        if ((++sp & 255u) == 0u) { if (xb_ld(&bar[XB_TMO])) break; if (sp > XB_SPIN_CAP) { atomicAdd(&bar[XB_TMO], 1u); break; } }
    }
    nloc = mine > 0u ? mine : 1u; nx = cnt > 0u ? cnt : 1u;
}
__device__ __forceinline__ void xcd_barrier(const XcdBarrier& b) {
    asm volatile("s_waitcnt vmcnt(0)" ::: "memory");
    __syncthreads();
    if (threadIdx.x == 0) {
        unsigned* bar = b.bar;
        __builtin_amdgcn_s_waitcnt(0);
        unsigned nloc = b.st[0], nx = b.st[1];
        if (nloc == 0u) { xcd_barrier_complete(bar, b.x, nloc, nx); b.st[0] = nloc; b.st[1] = nx; }
        const unsigned old = xb_add(&bar[XB_XSUB(b.x)], 1u);
        const unsigned gen = old / nloc;
        if (old + 1u == (gen + 1u) * nloc) {
            __builtin_amdgcn_fence(__ATOMIC_RELEASE, "agent");
            asm volatile("s_waitcnt vmcnt(0)" ::: "memory");
            const unsigned og = xb_add(&bar[XB_TOP], 1u);
            const unsigned tg = og / nx;
            if (og + 1u == (tg + 1u) * nx) xb_add(&bar[XB_TOPGEN], 1u);
            else XB_SPIN(xb_ld(&bar[XB_TOPGEN]) == tg, bar);
            __builtin_amdgcn_fence(__ATOMIC_ACQUIRE, "agent");
            xb_add(&bar[XB_XGEN(b.x)], 1u);
            asm volatile("s_waitcnt vmcnt(0)" ::: "memory");
        } else {
            XB_SPIN(xb_ld(&bar[XB_XGEN(b.x)]) == gen, bar);
            __builtin_amdgcn_fence(__ATOMIC_ACQUIRE, "agent");
            asm volatile("s_waitcnt vmcnt(0)" ::: "memory");
        }
    }
    __syncthreads();
}

constexpr int N_PHASES = 23;
#ifndef PROBE_DBL
#define PROBE_DBL -1
#endif
#define REPS(k) for (int _rep = 0; _rep < ((PROBE_DBL) == (k) ? 2 : 1); ++_rep)
__global__ void __launch_bounds__(NTHR, 2) mega_fwd(Params p) {
    extern __shared__ __attribute__((aligned(16))) unsigned char lds[];
    cg::grid_group grid = cg::this_grid();
    const int G = (int)gridDim.x, bid = (int)blockIdx.x;
#define tid tidx()
    unsigned char* ws = p.ws;
    h16* WinT = (h16*)(ws + WS_WIN); h16* WoutT = (h16*)(ws + WS_WOUT); h16* WxqT = (h16*)(ws + WS_WXQ); h16* WxoT = (h16*)(ws + WS_WXO); h16* WxkvT = (h16*)(ws + WS_WXKV);
    h16* memh = (h16*)(ws + WS_MEMH); h16* kvm = (h16*)(ws + WS_KVM); h16* kcmp = (h16*)(ws + WS_KCMP); h16* vcmpT = (h16*)(ws + WS_VCMP); h16* vsT = (h16*)(ws + WS_VST); h16* vwT = (h16*)(ws + WS_VWT);
    int* tope = (int*)(ws + WS_TOPE); float* topw = (float*)(ws + WS_TOPW);
    h16* xh = (h16*)(ws + WS_XH); h16* mix = (h16*)(ws + WS_MIX); h16* ox = (h16*)(ws + WS_OX); h16* hb = (h16*)(ws + WS_H); h16* nqr = (h16*)(ws + WS_NQR);
    float* kvb = (float*)(ws + WS_KVB); h16* prevT = (h16*)(ws + WS_PREVT);
    float* cosr = (float*)(ws + WS_COSR); float* sinr = (float*)(ws + WS_SINR); float* cosn = (float*)(ws + WS_COSN); float* sinn = (float*)(ws + WS_SINN); h16* kvmVT = (h16*)(ws + WS_KVMVT);
    h16* rqr = (h16*)((unsigned char*)p.out + DO_RQR); h16* rkr = (h16*)((unsigned char*)p.out + DO_RKR); h16* rkzT = (h16*)((unsigned char*)p.out + DO_RKZT); h16* rvT = (h16*)((unsigned char*)p.out + DO_RVT); float* pre = p.out; float* x1 = (float*)(ws + WS_X1); h16* x1h = (h16*)(ws + WS_X1H);
    h16* qx = (h16*)(ws + WS_QX); float* x2 = (float*)(ws + WS_X2); h16* x2h = (h16*)(ws + WS_X2H);
    int* ctl = (int*)ws; unsigned* rowoff = (unsigned*)(ws + WS_ROWOFF); u32x2* rowmeta = (u32x2*)(ws + WS_ROWMETA);
    h16* WguT = (h16*)(ws + WS_WGUT); h16* WdT = (h16*)(ws + WS_WDT); h16* Hm = (h16*)(ws + WS_HM); h16* Yq = (h16*)(ws + WS_Y);
    float* fl = (float*)lds;
    const int lo = p.ph_lo, hi = p.ph_hi;
#define IN(k) (lo <= (k) && (k) < hi)
    { volatile LAS unsigned* st = (volatile LAS unsigned*)((LAS unsigned char*)lds + 131072); if (threadIdx.x < 2) st[threadIdx.x] = 0u; }
    __syncthreads();
    XcdBarrier xbar = xcd_barrier_post((unsigned*)(ws + WS_BAR), (volatile LAS unsigned*)((LAS unsigned char*)lds + 131072));
#define SEAM(k) do { if (IN(k) && IN((k) + 1)) { if ((k) == 0) grid.sync(); else xcd_barrier(xbar); } } while (0)

    if (IN(0)) REPS(0) {
        const int sub = tid >> 8, lt = tid & 255; float* tl = fl + sub * 1088;
        constexpr int T0 = (INP / 32) * (D / 32), T1 = (D / 32) * (D / 32), T4 = (2 * D / 32) * (D / 32), TT = T0 + 3 * T1 + T4;
        for (int b0 = bid * 2; b0 < TT; b0 += G * 2) { int it = b0 + sub;
            if (it < T0) { b_transpose_tile(p.w_in, D, INC, WinT, INP, it, tl, lt); continue; } it -= T0;
            if (it < T1) { b_transpose_tile(p.w_out, D, D, WoutT, D, it, tl, lt); continue; } it -= T1;
            if (it < T1) { b_transpose_tile(p.w_xq, D, D, WxqT, D, it, tl, lt); continue; } it -= T1;
            if (it < T1) { b_transpose_tile(p.w_xo, D, D, WxoT, D, it, tl, lt); continue; } it -= T1;
            b_transpose_tile(p.w_xkv, D, 2 * D, WxkvT, 2 * D, it, tl, lt); }
        b_cvt(p.x, xh, (size_t)M * D / 4);
        b_cvt(p.mem, memh, (size_t)NB * MEML * D / 4);
        if (bid == 0) for (int i = tid; i < 1024; i += NTHR) ctl[i] = 0;
        b_tables(p.positions, cosr, sinr, cosn, sinn);
    }
    SEAM(0);
    if (IN(1)) {
        REPS(1) { pg8::Gemm g{xh, WinT, M, INP, D}; pg8::StaticOrder S; S.init(g, G, bid); pg8::EpiF16 E{hb, INP};
          pg8::gemm_phase<pg8::EpiF16, pg8::StaticOrder>((PG8_LAS unsigned char*)lds, g.K, S, E); }
        { pg8::Gemm g{memh, WxkvT, NB * MEML, 2 * D, D}; pg8::StaticOrder S; S.init(g, G, bid); pg8::EpiF16 E{kvm, 2 * D};
          pg8::gemm_phase<pg8::EpiF16, pg8::StaticOrder>((PG8_LAS unsigned char*)lds, g.K, S, E); }
    }
    SEAM(1);
    if (IN(2)) REPS(2) { const int sub = tid >> 8, lt = tid & 255;
        for (int b0 = bid * 2; b0 < M; b0 += G * 2) b_rope(hb, rqr, rkr, nqr, cosr, sinr, cosn, sinn, b0 + sub, lt);
        for (int b0 = bid * 2; b0 < 2 * NB * 2 * 128; b0 += G * 2) b_vtrans(hb, vsT, vwT, b0 + sub, (h16*)(fl + sub * 2304), lt);
        for (int b0 = bid * 2; b0 < NB * 4 * 128; b0 += G * 2) b_rtrans(p, hb, rvT, rkzT, cosr, sinr, b0 + sub, (h16*)(fl + sub * 4224), lt);
        for (int b0 = bid * 2; b0 < NB * 4 * 16; b0 += G * 2) b_mvtrans(kvm, kvmVT, b0 + sub, (h16*)(fl + sub * 2304), lt); }
    SEAM(2);
    if (IN(3)) { const int sub = tid >> 8, lt = tid & 255;
        REPS(30) for (int b0 = bid * 2; b0 < 2 * NB * 511 * 2; b0 += G * 2) b_cmp(p, hb, kcmp, vcmpT, b0 + sub, fl + sub * 2304, lt);
        const int wv = __builtin_amdgcn_readfirstlane(tid >> 6), lane = tid & 63;
        REPS(31) for (int ch = bid; ch < NB * 4 * 64; ch += G) ret_kv_unit(rkzT, rvT, kvb, ch, wv, lane); }
    SEAM(3);
    if (IN(4)) b_ret_scan(p, kvb, prevT);
    SEAM(4);
    if (IN(5)) {
        const int wv = __builtin_amdgcn_readfirstlane(tid >> 6), lane = tid & 63; float* wl = fl + wv * 1152;
        REPS(50) for (int u = bid * 8 + wv; u < NB * 2 * (T / 4); u += G * 8) { const int tg = (T / 4 - 1) - (u >> 3), bg = u & 7;
            nsa_wave_unit(hb, nqr, kcmp, vcmpT, vsT, vwT, mix, bg >> 1, bg & 1, tg * 4, wl, lane); }
        REPS(51) for (int ch = bid; ch < NB * 4 * 64; ch += G) ret_out_unit(p, hb, rqr, rkr, rvT, prevT, mix, ch, wv, lane);
    }
    SEAM(5);
    if (IN(6)) { pg8::Gemm g{mix, WoutT, M, D, D}; pg8::StaticOrder S; S.init(g, G, bid); pg8::EpiResF32 E{pre, p.x, D, DN_ALPHA};
        pg8::gemm_phase<pg8::EpiResF32, pg8::StaticOrder>((PG8_LAS unsigned char*)lds, g.K, S, E); }
    SEAM(6);
    if (IN(7)) b_ln(pre, p.ln1g, p.ln1b, x1, x1h);
    SEAM(7);
    if (IN(8)) { pg8::Gemm g{x1h, WxqT, M, D, D}; pg8::StaticOrder S; S.init(g, G, bid); pg8::EpiF16 E{qx, D};
        pg8::gemm_phase<pg8::EpiF16, pg8::StaticOrder>((PG8_LAS unsigned char*)lds, g.K, S, E); }
    SEAM(8);
    if (IN(9)) { const int wv = __builtin_amdgcn_readfirstlane(tid >> 6), lane = tid & 63;
        REPS(9) for (int u = bid; u < (M / 128) * 4; u += G) xattn_unit(qx, kvm, kvmVT, ox, (u >> 2) * 128 + wv * 16, u & 3, lane); }
    SEAM(9);
    if (IN(10)) { pg8::Gemm g{ox, WxoT, M, D, D}; pg8::StaticOrder S; S.init(g, G, bid); pg8::EpiResF32 E{pre, x1, D, DN_ALPHA};
        pg8::gemm_phase<pg8::EpiResF32, pg8::StaticOrder>((PG8_LAS unsigned char*)lds, g.K, S, E); }
    SEAM(10);
    if (IN(11)) b_ln(pre, p.ln2g, p.ln2b, x2, x2h);
    SEAM(11);
    if (IN(12)) {
        b_router(p, x2, tope, topw, ctl + CTL_CNT);
        if (bid == 0 && tid < NQ) ctl[CTL_CNT + tid * 65 + 64] = QT;
        for (int i = bid * NTHR + tid; i < CAP; i += G * NTHR) { rowoff[i] = 0u; rowmeta[i] = (u32x2){0xffffffffu, 0u}; }
        const int sub = tid >> 8, lt = tid & 255; float* tl = fl + sub * 1088;
        REPS(121) for (int b0 = bid * 2; b0 < 65 * 768; b0 += G * 2) { const int it = b0 + sub; const int e = it / 768, r = it % 768;
            const float* wg = e < 64 ? p.w_gate + (size_t)e * D * EFF : p.ws_gate; const float* wu = e < 64 ? p.w_up + (size_t)e * D * EFF : p.ws_up; const float* wd = e < 64 ? p.w_down + (size_t)e * EFF * D : p.ws_down;
            if (r < 256) b_transpose_tile(wg, D, EFF, WguT + (size_t)e * 512 * D, EFF, r, tl, lt, 2, 0);
            else if (r < 512) b_transpose_tile(wu, D, EFF, WguT + (size_t)e * 512 * D, EFF, r - 256, tl, lt, 2, 1);
            else b_transpose_tile(wd, EFF, D, WdT + (size_t)e * D * EFF, D, r - 512, tl, lt); }
    }
    SEAM(12);
    if (IN(13)) b_scatter(ctl, tope, topw, rowoff, rowmeta, (int*)lds);
    SEAM(13);
    if (IN(14)) REPS(14) { G1Sched S{ctl, (const char*)x2h, rowoff, (const char*)WguT, G, bid}; pg8::EpiGateUp E{Hm};
        pg8::gemm_phase<pg8::EpiGateUp, G1Sched>((PG8_LAS unsigned char*)lds, D, S, E); }
    SEAM(14);
#pragma unroll 1
    for (int q = 0; q < NQ; ++q) {
        if (IN(15 + 2 * q)) { G2Sched S{ctl, (const char*)Hm, (const char*)WdT, q, G, bid}; pg8::EpiDown E{Yq, rowmeta};
            pg8::gemm_phase<pg8::EpiDown, G2Sched>((PG8_LAS unsigned char*)lds, EFF, S, E); }
        SEAM(15 + 2 * q);
        if (IN(16 + 2 * q)) b_combine(p, x2h, Yq, q);
        if (q < NQ - 1) SEAM(16 + 2 * q);
    }
#undef IN
#undef SEAM
#undef tid
}

#ifndef MK_PER_PHASE
#define MK_PER_PHASE 0
#endif
extern "C" void kernel_launch(void* const* d_in, const int* in_sizes, int n_in, void* d_out, int out_size, void* d_ws, size_t ws_size, hipStream_t stream) {
    static int grid = 0;
    if (grid == 0) {
        if (n_in != 28 || in_sizes[0] != M * D || out_size != M * D || ws_size < WS_NEED) { fprintf(stderr, "kernel_launch: unexpected shapes (n_in %d, in0 %d, out %d, ws %zu)\n", n_in, n_in > 0 ? in_sizes[0] : -1, out_size, ws_size); grid = -1; return; }
        if (hipFuncSetAttribute((const void*)mega_fwd, hipFuncAttributeMaxDynamicSharedMemorySize, LDS_BYTES) != hipSuccess) { fprintf(stderr, "kernel_launch: hipFuncSetAttribute failed\n"); grid = -1; return; }
        int dev = 0, cus = 0, per_cu = 0;
        hipGetDevice(&dev); hipDeviceGetAttribute(&cus, hipDeviceAttributeMultiprocessorCount, dev);
        if (hipOccupancyMaxActiveBlocksPerMultiprocessor(&per_cu, (const void*)mega_fwd, NTHR, LDS_BYTES) != hipSuccess || per_cu < 1) { fprintf(stderr, "kernel_launch: occupancy query failed (%d)\n", per_cu); grid = -1; return; }
        grid = cus;
    }
    if (grid < 0) return;
    Params p{};
    p.x = (const float*)d_in[0]; p.mem = (const float*)d_in[1]; p.positions = (const int*)d_in[2];
    p.w_in = (const float*)d_in[3]; p.pe_k = (const float*)d_in[4]; p.pe_v = (const float*)d_in[5];
    p.w1k = (const float*)d_in[6]; p.w2k = (const float*)d_in[7]; p.w1v = (const float*)d_in[8]; p.w2v = (const float*)d_in[9];
    p.w_out = (const float*)d_in[10]; p.ln1g = (const float*)d_in[11]; p.ln1b = (const float*)d_in[12];
    p.w_xq = (const float*)d_in[13]; p.w_xkv = (const float*)d_in[14]; p.w_xo = (const float*)d_in[15];
    p.ln2g = (const float*)d_in[16]; p.ln2b = (const float*)d_in[17]; p.w_router = (const float*)d_in[18]; p.rbias = (const float*)d_in[19];
    p.w_gate = (const float*)d_in[20]; p.w_up = (const float*)d_in[21]; p.w_down = (const float*)d_in[22];
    p.ws_gate = (const float*)d_in[23]; p.ws_up = (const float*)d_in[24]; p.ws_down = (const float*)d_in[25];
    p.ln3g = (const float*)d_in[26]; p.ln3b = (const float*)d_in[27];
    p.out = (float*)d_out; p.ws = (unsigned char*)d_ws;
    for (int i = 0; i < 4; ++i) p.lg[i] = (float)std::log(1.0 - std::pow(2.0, -5.0 - (double)i));
#if MK_PER_PHASE
    for (int ph = 0; ph < N_PHASES; ++ph) { p.ph_lo = ph; p.ph_hi = ph + 1; hipLaunchKernelGGL(mega_fwd, dim3(grid), dim3(NTHR), LDS_BYTES, stream, p); }
#else
    p.ph_lo = 0; p.ph_hi = N_PHASES;
    if (hipMemsetAsync((char*)d_ws + WS_BAR, 0, XCD_BAR_WORDS * 4, stream) != hipSuccess) { fprintf(stderr, "kernel_launch: memset failed\n"); return; }
    void* args[] = {&p};
    hipError_t e = hipLaunchCooperativeKernel((const void*)mega_fwd, dim3(grid), dim3(NTHR), args, LDS_BYTES, stream);
    if (e != hipSuccess) fprintf(stderr, "kernel_launch: cooperative launch failed: %s (grid %d)\n", hipGetErrorString(e), grid);
#endif
}
```

```cpp
#include <hip/hip_runtime.h>
#include <cstdio>
#include <cstdint>
#include <cmath>

typedef _Float16 h16;
typedef _Float16 h16x8 __attribute__((ext_vector_type(8)));
typedef _Float16 h16x2 __attribute__((ext_vector_type(2)));
typedef _Float16 h16x4 __attribute__((ext_vector_type(4)));
typedef float f32x2 __attribute__((ext_vector_type(2)));
typedef float f32x4 __attribute__((ext_vector_type(4)));
typedef unsigned u32x4 __attribute__((ext_vector_type(4)));
typedef unsigned u32x2 __attribute__((ext_vector_type(2)));

__device__ __forceinline__ int tidx() { int t = (int)threadIdx.x; asm volatile("" : "+v"(t)); return t; }

#ifndef PROBE_DBL
#define PROBE_DBL -1
#endif
#define REPS(k) for (int _rep = 0; _rep < ((PROBE_DBL) == (k) ? 2 : 1); ++_rep)

constexpr int NB = 4, T = 8192, D = 1024, M = NB * T;
constexpr int INC = 3352, INP = 3584;
constexpr int C_RQ = 0, C_RK = 512, C_RV = 1024, C_RG = 1536, C_NQ = 2048, C_NKC = 2560, C_NVC = 2688, C_NKS = 2816, C_NVS = 2944, C_NKW = 3072, C_NVW = 3200, C_NG = 3328;
constexpr int MEML = 256;
constexpr int NE = 64, EFF = 256;
constexpr float LN_EPS = 1e-5f;
constexpr float DN_ALPHA = 1.189207115002721f;
constexpr float NEGF = -1e30f;

constexpr size_t MiB = 1u << 20;
constexpr size_t WS_WIN = 1 * MiB, WS_WOUT = 8 * MiB, WS_WXQ = 10 * MiB, WS_WXO = 12 * MiB, WS_WXKV = 14 * MiB, WS_MEMH = 18 * MiB, WS_KVM = 20 * MiB;
constexpr size_t WS_KCMP = 24 * MiB, WS_VCMP = 25 * MiB, WS_TOPE = 26 * MiB, WS_TOPW = 27 * MiB;
constexpr size_t WS_XH = 32 * MiB, WS_MIX = 32 * MiB, WS_OX = 32 * MiB;
constexpr size_t WS_H = 96 * MiB, WS_NQR = 320 * MiB, WS_KVB = 352 * MiB, WS_PREV = 416 * MiB;
constexpr size_t WS_PRE = 96 * MiB, WS_X1 = 224 * MiB, WS_X1H = 352 * MiB, WS_QX = 416 * MiB, WS_X2 = 130 * MiB;
constexpr size_t WS_X2H = 32 * MiB, WS_WDT = 96 * MiB, WS_HM = 130 * MiB, WS_WGUT = 306 * MiB, WS_Y = 306 * MiB;
constexpr size_t WS_ROWOFF = 1 * MiB, WS_ROWMETA = 3 * MiB;
constexpr size_t WS_VST = 480 * MiB, WS_VWT = 488 * MiB, WS_COSR = 496 * MiB, WS_SINR = 504 * MiB, WS_COSN = 28 * MiB, WS_SINN = 29 * MiB, WS_KVMVT = 30 * MiB;
constexpr size_t WS_PREVT = 416 * MiB, WS_KSR = 448 * MiB, WS_KWR = 456 * MiB, WS_KX = 26 * MiB;
constexpr size_t DO_RQR = 0, DO_RKR = 32 * MiB, DO_RKZT = 64 * MiB, DO_RVT = 96 * MiB;
constexpr size_t WS_NEED = 512 * MiB;
constexpr int NQ = 4, QT = M / NQ, NVE = NQ * 65, CAP_TILES = 1412, CAP = CAP_TILES * 256;
constexpr size_t WS_BAR = 65536;
constexpr int CTL_CNT = 0, CTL_CUR = 512, CTL_PST = 1024, CTL_TQS = 1536, CTL_TVE = 2048;

namespace pg8 {
#define PG8_LAS __attribute__((address_space(3)))
typedef short s16x8 __attribute__((ext_vector_type(8)));
constexpr int BM = 256, BK = 64, HALF = 128, HTB = HALF * BK * 2, STAGE_BYTES = 8 * HTB, NXCD = 8, WGM = 8;
__host__ __device__ __forceinline__ int lds_byte(int r, int c) { const int st = (r >> 4) * 2 + (c >> 5), rr = r & 15, cc = c & 31, ob = rr * 64 + cc * 2; return st * 1024 + (ob ^ (((ob >> 9) & 1) << 5)); }
__host__ __device__ __forceinline__ void stage_rc(int b, int& R, int& C) { const int st = b / 1024, sb = b % 1024, swz = sb ^ (((sb >> 9) & 1) << 5); R = (st >> 1) * 16 + swz / 64; C = (st & 1) * 32 + (swz % 64) / 2; }
__host__ __device__ __forceinline__ int perm32(int rho) { const int n = rho >> 4, i = rho & 15; return 8 * (i >> 2) + 4 * n + (i & 3); }
struct Unit { int pm, pn; const char* A; const char* B; const unsigned* gat; };
struct Gemm { const h16* A; const h16* Bt; int M, N, K; };
struct StaticOrder {
    int nM, nN, nwg, G, c; const char* A; const char* B; size_t tstep;
    __device__ void init(const Gemm& g, int G_, int c_) { nM = g.M / BM; nN = g.N / BM; nwg = nM * nN; G = G_; c = c_; A = (const char*)g.A; B = (const char*)g.Bt; tstep = (size_t)BM * g.K * 2; }
    __device__ bool next(int i, Unit& u) const {
        const long L = (long)i * G + c; if (L >= nwg) return false;
        int wgid = (int)L; { const int q = nwg / NXCD, r = nwg % NXCD, xcd = wgid % NXCD, off = wgid / NXCD; wgid = (xcd < r ? xcd * (q + 1) : r * (q + 1) + (xcd - r) * q) + off; }
        const int nig = WGM * nN, gid = wgid / nig, fm = gid * WGM, gsz = (nM - fm) < WGM ? (nM - fm) : WGM;
        u.pm = fm + ((wgid % nig) % gsz); u.pn = (wgid % nig) / gsz; u.A = A + (size_t)u.pm * tstep; u.B = B + (size_t)u.pn * tstep; u.gat = nullptr; return true;
    }
};
__device__ __forceinline__ unsigned cvt_pk_f16(float lo, float hi) { f32x2 v = {lo, hi}; h16x2 h = __builtin_convertvector(v, h16x2); return __builtin_bit_cast(unsigned, h); }

struct EpiF16 {
    static constexpr bool PERM = true;
    h16* O; int ldc;
    __device__ __forceinline__ void operator()(const f32x4 (&acc)[2][2][4][2], const Unit& u, int wr, int wc, int fr, int fq) const {
        const int row0 = u.pm * BM + wr * 64 + fr; const int col0 = u.pn * BM + wc * 32 + 8 * fq;
#pragma unroll
        for (int ai = 0; ai < 2; ++ai)
#pragma unroll
            for (int m = 0; m < 4; ++m) { h16* rowp = O + (size_t)(row0 + ai * HALF + m * 16) * ldc + col0;
#pragma unroll
                for (int bj = 0; bj < 2; ++bj) { const f32x4 v0 = acc[ai][bj][m][0], v1 = acc[ai][bj][m][1];
                    *(h16x8*)(rowp + bj * HALF) = __builtin_convertvector(__builtin_shufflevector(v0, v1, 0, 1, 2, 3, 4, 5, 6, 7), h16x8); } }
    }
};
struct EpiResF32 {
    static constexpr bool PERM = false;
    float* C; const float* R; int ldc; float alpha;
    __device__ __forceinline__ void operator()(const f32x4 (&acc)[2][2][4][2], const Unit& u, int wr, int wc, int fr, int fq) const {
        const int row0 = u.pm * BM + wr * 64 + fr, col0 = u.pn * BM + wc * 32 + 4 * fq;
#pragma unroll
        for (int ai = 0; ai < 2; ++ai)
#pragma unroll
            for (int m = 0; m < 4; ++m) { const size_t off = (size_t)(row0 + ai * HALF + m * 16) * ldc + col0;
#pragma unroll
                for (int bj = 0; bj < 2; ++bj)
#pragma unroll
                    for (int n = 0; n < 2; ++n) { const f32x4 r = *(const f32x4*)(R + off + bj * HALF + n * 16); *(f32x4*)(C + off + bj * HALF + n * 16) = r * alpha + acc[ai][bj][m][n]; } }
    }
};
struct EpiGateUp {
    static constexpr bool PERM = true;
    h16* H;
    __device__ __forceinline__ void operator()(const f32x4 (&acc)[2][2][4][2], const Unit& u, int wr, int wc, int fr, int fq) const {
        const int row0 = u.pm * BM + wr * 64 + fr; const int col0 = u.pn * 128 + wc * 16 + 4 * fq;
#pragma unroll
        for (int ai = 0; ai < 2; ++ai)
#pragma unroll
            for (int m = 0; m < 4; ++m) { h16* rowp = H + (size_t)(row0 + ai * HALF + m * 16) * 256 + col0;
#pragma unroll
                for (int bj = 0; bj < 2; ++bj) { const f32x4 v0 = acc[ai][bj][m][0], v1 = acc[ai][bj][m][1];
                    const float h0 = v0[0] / (1.f + __expf(-v0[0])) * v0[1], h1 = v0[2] / (1.f + __expf(-v0[2])) * v0[3];
                    const float h2 = v1[0] / (1.f + __expf(-v1[0])) * v1[1], h3 = v1[2] / (1.f + __expf(-v1[2])) * v1[3];
                    *(h16x4*)(rowp + bj * 64) = __builtin_convertvector((f32x4){h0, h1, h2, h3}, h16x4); } }
    }
};
struct EpiDown {
    static constexpr bool PERM = true;
    h16* Y; const u32x2* rowmeta;
    __device__ __forceinline__ void operator()(const f32x4 (&acc)[2][2][4][2], const Unit& u, int wr, int wc, int fr, int fq) const {
        const int row0 = u.pm * BM + wr * 64 + fr; const int col0 = u.pn * BM + wc * 32 + 8 * fq;
#pragma unroll
        for (int ai = 0; ai < 2; ++ai)
#pragma unroll
            for (int m = 0; m < 4; ++m) { const u32x2 md = rowmeta[row0 + ai * HALF + m * 16]; const int slot = (int)md.x; const float w8 = __uint_as_float(md.y);
                if (slot >= 0) { h16* rowp = Y + (size_t)slot * 1024 + col0;
#pragma unroll
                    for (int bj = 0; bj < 2; ++bj) { const f32x4 v0 = acc[ai][bj][m][0] * w8, v1 = acc[ai][bj][m][1] * w8;
                        *(h16x8*)(rowp + bj * HALF) = __builtin_convertvector(__builtin_shufflevector(v0, v1, 0, 1, 2, 3, 4, 5, 6, 7), h16x8); } }
                asm volatile("" ::: "memory"); }
    }
};

template <class Epi, class Sched>
__device__ __forceinline__ void gemm_phase(PG8_LAS unsigned char* lds, const int K, const Sched& S, const Epi& E) {
    const int tid = tidx(), wid = __builtin_amdgcn_readfirstlane(tid >> 6), lane = tid & 63, wr = wid >> 2, wc = wid & 3, fr = lane & 15, fq = lane >> 4;
    const int nt = K / BK;
    int R0, C0; stage_rc(tid * 16, R0, C0);
    const unsigned cb2 = (unsigned)C0 * 2u;
    unsigned voffB[2];
#pragma unroll
    for (int i = 0; i < 2; ++i) { const int R = R0 + 64 * i; const int Rb = Epi::PERM ? ((R & ~31) + perm32(R & 31)) : R; voffB[i] = (unsigned)(Rb * K) * 2u + cb2; }
    const size_t kstep = (size_t)(BK * 2);
    const size_t hstep = (size_t)HALF * K * 2;
    const unsigned ldsw = (unsigned)wid * 1024u;
    const int aoff = lds_byte(wr * 64 + fr, fq * 8), boff = lds_byte(wc * 32 + fr, fq * 8);
#define PG8_MKVA(u, va) do { _Pragma("unroll") for (int _h = 0; _h < 2; ++_h) _Pragma("unroll") for (int _i = 0; _i < 2; ++_i) { const int _r = _h * HALF + R0 + 64 * _i; \
        (va)[_h][_i] = ((u).gat ? (u).gat[_r] : (unsigned)(_r * K) * 2u) + cb2; } } while (0)
#define PG8_SA(b, h) (((b) * 2 + (h)) * HTB)
#define PG8_SB(b, h) ((4 + (b) * 2 + (h)) * HTB)
#define PG8_STAGE(bufoff, gbase, voff) do { _Pragma("unroll") for (int _i = 0; _i < 2; ++_i) \
        __builtin_amdgcn_global_load_lds((const unsigned*)((const char*)(gbase) + (voff)[_i]), (PG8_LAS unsigned*)(lds + (bufoff) + ldsw + _i * 8192), 16, 0, 0); } while (0)
#define PG8_LDA(dst, b, h) do { _Pragma("unroll") for (int m = 0; m < 4; ++m) _Pragma("unroll") for (int k = 0; k < 2; ++k) dst[m][k] = *(const PG8_LAS s16x8*)(lds + PG8_SA(b, h) + aoff + m * 2048 + k * 1024); } while (0)
#define PG8_LDB(dst, b, h) do { _Pragma("unroll") for (int n = 0; n < 2; ++n) _Pragma("unroll") for (int k = 0; k < 2; ++k) dst[n][k] = *(const PG8_LAS s16x8*)(lds + PG8_SB(b, h) + boff + n * 2048 + k * 1024); } while (0)
#define PG8_MMA(ai, bj, At, Bt) do { __builtin_amdgcn_s_setprio(1); _Pragma("unroll") for (int m = 0; m < 4; ++m) _Pragma("unroll") for (int n = 0; n < 2; ++n) _Pragma("unroll") for (int k = 0; k < 2; ++k) \
        acc[ai][bj][m][n] = __builtin_amdgcn_mfma_f32_16x16x32_f16(__builtin_bit_cast(h16x8, Bt[n][k]), __builtin_bit_cast(h16x8, At[m][k]), acc[ai][bj][m][n], 0, 0, 0); __builtin_amdgcn_s_setprio(0); } while (0)
#define PG8_WAIT_V(n) asm volatile("s_waitcnt vmcnt(" #n ")" ::: "memory")
#define PG8_WAIT_L(n) asm volatile("s_waitcnt lgkmcnt(" #n ")" ::: "memory")
#define PG8_BAR __builtin_amdgcn_s_barrier()
#define PG8_SCHED __builtin_amdgcn_sched_barrier(0)
    Unit cur, nxt; int ui = 0;
    if (!S.next(0, cur)) return;
    unsigned va[2][2];
    PG8_MKVA(cur, va);
    f32x4 acc[2][2][4][2];
#pragma unroll
    for (int a = 0; a < 2; ++a)
#pragma unroll
        for (int b = 0; b < 2; ++b)
#pragma unroll
            for (int m = 0; m < 4; ++m)
#pragma unroll
                for (int n = 0; n < 2; ++n) acc[a][b][m][n] = (f32x4){0.f, 0.f, 0.f, 0.f};
    s16x8 At[4][2], B0[2][2], B1[2][2];
    const char* cA = cur.A; const char* cB = cur.B;
    {
        PG8_STAGE(PG8_SB(0, 0), cB, voffB); PG8_STAGE(PG8_SB(0, 1), cB + hstep, voffB); PG8_STAGE(PG8_SA(0, 0), cA, va[0]); PG8_STAGE(PG8_SA(0, 1), cA, va[1]);
        if (wr == 1) PG8_BAR;
        PG8_WAIT_V(2); PG8_BAR;
        PG8_STAGE(PG8_SB(1, 0), cB + kstep, voffB); PG8_STAGE(PG8_SA(1, 0), cA + kstep, va[0]); PG8_STAGE(PG8_SB(1, 1), cB + hstep + kstep, voffB);
        PG8_WAIT_V(6); PG8_BAR;
    }
    for (;;) {
        const bool has_next = S.next(ui + 1, nxt);
        const char* nA = has_next ? nxt.A : cA; const char* nB = has_next ? nxt.B : cB;
#pragma unroll 1
        for (int t = 0; t < nt; t += 2) {
            const bool last = (t == nt - 2);
            const char* a1 = cA + (size_t)(t + 1) * kstep;
            const char* a2 = last ? nA : cA + (size_t)(t + 2) * kstep; const char* b2 = last ? nB : cB + (size_t)(t + 2) * kstep;
            const char* a3 = a2 + kstep; const char* b3 = b2 + kstep;
            PG8_LDB(B0, 0, 0); PG8_LDB(B1, 0, 1); PG8_SCHED; PG8_LDA(At, 0, 0); PG8_STAGE(PG8_SA(1, 1), a1, va[1]);
            if (last && has_next) { PG8_MKVA(nxt, va); }
            PG8_WAIT_V(8); PG8_WAIT_L(0); PG8_BAR; PG8_MMA(0, 0, At, B0); PG8_MMA(0, 1, At, B1); PG8_BAR; PG8_SCHED;
            PG8_LDA(At, 0, 1); PG8_STAGE(PG8_SB(0, 0), b2, voffB); PG8_STAGE(PG8_SB(0, 1), b2 + hstep, voffB); PG8_STAGE(PG8_SA(0, 0), a2, va[0]);
            PG8_WAIT_V(8); PG8_WAIT_L(0); PG8_BAR; PG8_MMA(1, 0, At, B0); PG8_MMA(1, 1, At, B1); PG8_BAR; PG8_SCHED;
            PG8_LDB(B0, 1, 0); PG8_LDB(B1, 1, 1); PG8_SCHED; PG8_LDA(At, 1, 0); PG8_STAGE(PG8_SA(0, 1), a2, va[1]);
            PG8_WAIT_V(8); PG8_WAIT_L(0); PG8_BAR; PG8_MMA(0, 0, At, B0); PG8_MMA(0, 1, At, B1); PG8_BAR; PG8_SCHED;
            PG8_LDA(At, 1, 1); PG8_STAGE(PG8_SB(1, 0), b3, voffB); PG8_STAGE(PG8_SB(1, 1), b3 + hstep, voffB); PG8_STAGE(PG8_SA(1, 0), a3, va[0]);
            PG8_WAIT_V(8); PG8_WAIT_L(0); PG8_BAR; PG8_MMA(1, 0, At, B0); PG8_MMA(1, 1, At, B1); PG8_BAR; PG8_SCHED;
        }
        if (wr == 0) PG8_BAR;
        E(acc, cur, wr, wc, fr, fq);
        if (!has_next) break;
#pragma unroll
        for (int a = 0; a < 2; ++a)
#pragma unroll
            for (int b = 0; b < 2; ++b)
#pragma unroll
                for (int m = 0; m < 4; ++m)
#pragma unroll
                    for (int n = 0; n < 2; ++n) acc[a][b][m][n] = (f32x4){0.f, 0.f, 0.f, 0.f};
        cur = nxt; cA = nA; cB = nB; ++ui;
        if (wr == 1) PG8_BAR;
    }
    PG8_WAIT_V(0);
    PG8_BAR;
#undef PG8_MKVA
#undef PG8_SA
#undef PG8_SB
#undef PG8_STAGE
#undef PG8_LDA
#undef PG8_LDB
#undef PG8_MMA
#undef PG8_WAIT_V
#undef PG8_WAIT_L
#undef PG8_BAR
#undef PG8_SCHED
}
}


#include <hip/hip_cooperative_groups.h>
namespace cg = cooperative_groups;
constexpr int NTHR = 512;
constexpr int LDS_BYTES = 147456;
#define LAS __attribute__((address_space(3)))

struct Params {
    const float *x, *mem; const int* positions;
    const float *w_in, *pe_k, *pe_v, *w1k, *w2k, *w1v, *w2v, *w_out, *ln1g, *ln1b, *w_xq, *w_xkv, *w_xo, *ln2g, *ln2b, *w_router, *rbias, *w_gate, *w_up, *w_down, *ws_gate, *ws_up, *ws_down, *ln3g, *ln3b;
    float* out; unsigned char* ws;
    float lg[4];
    int ph_lo, ph_hi;
};

__device__ __forceinline__ float wave_sum(float v) {
#pragma unroll
    for (int o = 1; o < 64; o <<= 1) v += __shfl_xor(v, o);
    return v;
}
__device__ __forceinline__ float wave_max(float v) {
#pragma unroll
    for (int o = 1; o < 64; o <<= 1) v = fmaxf(v, __shfl_xor(v, o));
    return v;
}
__device__ __forceinline__ float siluf(float v) { return v / (1.f + __expf(-v)); }
__device__ __forceinline__ float sigmf(float v) { return 1.f / (1.f + __expf(-v)); }

__device__ __forceinline__ void b_transpose_tile(const float* __restrict__ W, int K, int N, h16* __restrict__ WT, int Npad, int tile, float* tl, int lt, int rs = 1, int ro = 0) {
    const int ntn = Npad / 32; const int n0 = (tile % ntn) * 32, k0 = (tile / ntn) * 32, tx = lt & 31, ty = lt >> 5;
    for (int i = ty; i < 32; i += 8) { const int k = k0 + i, n = n0 + tx; tl[i * 33 + tx] = (n < N) ? W[(size_t)k * N + n] : 0.f; }
    __syncthreads();
    for (int i = ty; i < 32; i += 8) { const int n = n0 + i, k = k0 + tx; WT[(size_t)(n * rs + ro) * K + k] = (h16)tl[tx * 33 + i]; }
    __syncthreads();
}
__device__ __forceinline__ void b_cvt(const float* __restrict__ x, h16* __restrict__ o, size_t n4) {
    for (size_t i = (size_t)blockIdx.x * NTHR + tidx(); i < n4; i += (size_t)gridDim.x * NTHR) {
        const f32x4 v = ((const f32x4*)x)[i]; ((h16x4*)o)[i] = __builtin_convertvector(v, h16x4); }
}

__device__ __forceinline__ void b_tables(const int* __restrict__ positions, float* __restrict__ cosr, float* __restrict__ sinr, float* __restrict__ cosn, float* __restrict__ sinn) {
    for (int idx = blockIdx.x * NTHR + tidx(); idx < M * 72; idx += gridDim.x * NTHR) {
        const int m = idx / 72, j = idx % 72; const float pos = (float)positions[m];
        const float inv = j < 64 ? (float)pow(10000.0, -(double)j / 64.0) : (float)pow(500000.0, -(double)(j - 64) / 8.0);
        const float ang = pos * inv; double sd, cd; sincos((double)ang, &sd, &cd);
        if (j < 64) { cosr[(size_t)m * 64 + j] = (float)cd; sinr[(size_t)m * 64 + j] = (float)sd; } else { cosn[(size_t)m * 8 + j - 64] = (float)cd; sinn[(size_t)m * 8 + j - 64] = (float)sd; }
    }
}
__device__ __forceinline__ void b_rope(const h16* __restrict__ h, h16* __restrict__ rqr, h16* __restrict__ rkr, h16* __restrict__ nqr, h16* __restrict__ ksR, h16* __restrict__ kwR, const float* __restrict__ cosr, const float* __restrict__ sinr,
                                       const float* __restrict__ cosn, const float* __restrict__ sinn, int m, int j) {
    const h16* hr = h + (size_t)m * INP; const int bb = m >> 13, t = m & (T - 1);
    {   const int hd = j >> 6, jj = j & 63; const float c = cosr[(size_t)m * 64 + jj], s = sinr[(size_t)m * 64 + jj]; const size_t ro = ((size_t)(bb * 4 + hd) * T + t) * 128;
        const int o1 = hd * 128 + jj, o2 = o1 + 64;
        const float q1 = (float)hr[C_RQ + o1], q2 = (float)hr[C_RQ + o2];
        rqr[ro + jj] = (h16)(q1 * c - q2 * s); rqr[ro + jj + 64] = (h16)(q2 * c + q1 * s);
        const float k1 = (float)hr[C_RK + o1], k2 = (float)hr[C_RK + o2]; const float sc = 0.08838834764831845f;
        rkr[ro + jj] = (h16)((k1 * c - k2 * s) * sc); rkr[ro + jj + 64] = (h16)((k2 * c + k1 * s) * sc);
    }
    if (j < 64 + 16 + 16) {
        const int jj = j & 7; const float c = cosn[(size_t)m * 8 + jj], s = sinn[(size_t)m * 8 + jj];
        if (j < 64) { const int hd = j >> 3; const int o1 = hd * 64 + jj, o2 = o1 + 8;
            const float q1 = (float)hr[C_NQ + o1], q2 = (float)hr[C_NQ + o2];
            nqr[(size_t)m * 512 + o1] = (h16)(q1 * c - q2 * s); nqr[(size_t)m * 512 + o2] = (h16)(q2 * c + q1 * s);
        } else { const int jx = j - 64; const int which = jx >> 4, g = (jx >> 3) & 1; const int base = (which ? C_NKW : C_NKS) + g * 64 + jj;
            const float k1 = (float)hr[base], k2 = (float)hr[base + 8];
            h16* dst = (which ? kwR : ksR) + (((size_t)((bb * 2 + g) * 128 + (t >> 6)) * 64 + (t & 63)) * 64); dst[jj] = (h16)(k1 * c - k2 * s); dst[jj + 8] = (h16)(k2 * c + k1 * s); }
    }
    if (j >= 128 && j < 128 + 96) { const int jx = j - 128; const int which = jx / 48, r = jx % 48, g = r / 24, d = 16 + 2 * (r % 24);
        const int base = (which ? C_NKW : C_NKS) + g * 64 + d; h16* dst = (which ? kwR : ksR) + (((size_t)((bb * 2 + g) * 128 + (t >> 6)) * 64 + (t & 63)) * 64);
        dst[d] = hr[base]; dst[d + 1] = hr[base + 1]; }
    for (int i = j; i < 8 * 48; i += 256) { const int hd = i / 48, d = 16 + i % 48; nqr[(size_t)m * 512 + hd * 64 + d] = hr[C_NQ + hd * 64 + d]; }
}
__device__ __forceinline__ void b_rtrans(const Params& p, const h16* __restrict__ h, h16* __restrict__ rvT, h16* __restrict__ rkzT, const float* __restrict__ cosr, const float* __restrict__ sinr, int item, h16* sl, int lt) {
    int id = item; const int tt = id & 127; id >>= 7; const int hd = id & 3; const int b = id >> 2; const int bh = b * 4 + hd; const float lg = p.lg[hd];
    for (int i = lt; i < 64 * 128; i += 256) { const int t = i >> 7, e = i & 127; sl[t * 130 + e] = h[(size_t)(b * T + tt * 64 + t) * INP + C_RV + hd * 128 + e]; }
    __syncthreads();
    for (int i = lt; i < 64 * 128; i += 256) { const int e = i >> 6, t = i & 63; rvT[((size_t)(bh * 64 + (tt >> 1)) * 128 + e) * 128 + (tt & 1) * 64 + t] = sl[t * 130 + e]; }
    __syncthreads();
    for (int i = lt; i < 64 * 64; i += 256) { const int t = i >> 6, jj = i & 63; const size_t m = (size_t)b * T + tt * 64 + t;
        const float c = cosr[m * 64 + jj], s = sinr[m * 64 + jj]; const float k1 = (float)h[m * INP + C_RK + hd * 128 + jj], k2 = (float)h[m * INP + C_RK + hd * 128 + jj + 64];
        const float z = 0.08838834764831845f * __expf(lg * (float)(127 - ((tt * 64 + t) & 127)));
        sl[t * 130 + jj] = (h16)((k1 * c - k2 * s) * z); sl[t * 130 + jj + 64] = (h16)((k2 * c + k1 * s) * z); }
    __syncthreads();
    for (int i = lt; i < 64 * 128; i += 256) { const int d = i >> 6, t = i & 63; rkzT[((size_t)(bh * 64 + (tt >> 1)) * 128 + d) * 128 + (tt & 1) * 64 + t] = sl[t * 130 + d]; }
    __syncthreads();
}
__device__ __forceinline__ void b_mvtrans(const h16* __restrict__ kvm, h16* __restrict__ kvmVT, h16* __restrict__ kx, int item, h16* sl, int lt) {
    int id = item; const int kt = id & 3; id >>= 2; const int dtl = id & 3; id >>= 2; const int hh = id & 3; const int b = id >> 2;
    for (int i = lt; i < 64 * 64; i += 256) { const int k = i >> 6, d = i & 63; sl[k * 66 + d] = kvm[(size_t)(b * MEML + kt * 64 + k) * 2048 + 1024 + hh * 256 + dtl * 64 + d];
        kx[((size_t)(b * 4 + hh) * MEML + kt * 64 + k) * 256 + dtl * 64 + d] = kvm[(size_t)(b * MEML + kt * 64 + k) * 2048 + hh * 256 + dtl * 64 + d]; }
    __syncthreads();
    for (int i = lt; i < 64 * 64; i += 256) { const int d = i >> 6, k = i & 63; kvmVT[(size_t)((b * 4 + hh) * 256 + dtl * 64 + d) * MEML + kt * 64 + k] = sl[k * 66 + d]; }
    __syncthreads();
}

__device__ __forceinline__ void b_cmp(const Params& p, const h16* __restrict__ h, h16* __restrict__ kcmp, h16* __restrict__ vcmpT, int item, float* sl, int lt) {
    float* a = sl; float* hid = sl + 2048;
    int id = item; const int g = id & 1; id >>= 1; const int c = id % 511; id /= 511; const int b = id & 3; const int kv = id >> 2;
    const float* pe = kv ? p.pe_v : p.pe_k; const float* w1 = kv ? p.w1v : p.w1k; const float* w2 = kv ? p.w2v : p.w2k;
    const int colb = (kv ? C_NVC : C_NKC) + g * 64;
    for (int i = lt; i < 2048; i += 256) { const int l = i >> 6, d = i & 63; a[i] = (float)h[(size_t)(b * T + 16 * c + l) * INP + colb + d] + pe[l * 64 + d]; }
    __syncthreads();
    { const int j = lt; float acc = 0.f;
        for (int k = 0; k < 2048; ++k) acc += a[k] * w1[(size_t)k * 256 + j];
        hid[j] = siluf(acc); }
    __syncthreads();
    if (lt < 64) { const int e = lt; float acc = 0.f;
        for (int j = 0; j < 256; ++j) acc += hid[j] * w2[j * 64 + e];
        if (kv == 0) { kcmp[((size_t)(b * 2 + g) * 512 + c) * 64 + e] = (h16)acc; if (c == 510) kcmp[((size_t)(b * 2 + g) * 512 + 511) * 64 + e] = (h16)0.f; }
        else { vcmpT[(((size_t)(b * 2 + g) * 8 + (c >> 6)) * 64 + e) * 64 + (c & 63)] = (h16)acc; if (c == 510) vcmpT[(((size_t)(b * 2 + g) * 8 + 7) * 64 + e) * 64 + 63] = (h16)0.f; } }
    __syncthreads();
}
__device__ __forceinline__ void b_vtrans(const h16* __restrict__ h, h16* __restrict__ vsT, h16* __restrict__ vwT, int item, h16* sl, int lt) {
    int id = item; const int tt = id & 127; id >>= 7; const int g = id & 1; id >>= 1; const int b = id & 3; const int which = id >> 2;
    const int col = (which ? C_NVW : C_NVS) + g * 64; h16* dst = (which ? vwT : vsT) + (size_t)((b * 2 + g) * 128 + tt) * 4096;
    for (int i = lt; i < 64 * 64; i += 256) { const int t = i >> 6, d = i & 63; sl[t * 66 + d] = h[(size_t)(b * T + tt * 64 + t) * INP + col + d]; }
    __syncthreads();
    for (int i = lt; i < 64 * 64; i += 256) { const int d = i >> 6, t = i & 63; dst[d * 64 + t] = sl[t * 66 + d]; }
    __syncthreads();
}

__device__ __forceinline__ void ret_kv_unit(const h16* __restrict__ rkzT, const h16* __restrict__ rvT, float* __restrict__ kvT, int chunk, int w, int lane) {
    const int i = lane & 15, kg = lane >> 4; const int bh = chunk >> 6, n = chunk & 63;
    h16x8 a[4];
#pragma unroll
    for (int ks = 0; ks < 4; ++ks) a[ks] = *(const h16x8*)(rkzT + ((size_t)chunk * 128 + 16 * w + i) * 128 + 32 * ks + 8 * kg);
#pragma unroll
    for (int et = 0; et < 8; ++et) { f32x4 acc = {0.f, 0.f, 0.f, 0.f};
#pragma unroll
        for (int ks = 0; ks < 4; ++ks) { const h16x8 bq = *(const h16x8*)(rvT + ((size_t)chunk * 128 + 16 * et + i) * 128 + 32 * ks + 8 * kg); acc = __builtin_amdgcn_mfma_f32_16x16x32_f16(a[ks], bq, acc, 0, 0, 0); }
        *(f32x4*)(kvT + ((size_t)chunk * 128 + 16 * et + i) * 128 + 16 * w + 4 * kg) = acc; }
}
__device__ __forceinline__ void b_ret_scan(const Params& p, const float* __restrict__ kvT, h16* __restrict__ prevT) {
    for (int gid = blockIdx.x * NTHR + tidx(); gid < 16 * 16384; gid += gridDim.x * NTHR) {
        const int de = gid & 16383, bh = gid >> 14; const float cd = __expf(p.lg[bh & 3] * 128.f);
        float st = 0.f;
        for (int n = 0; n < 64; ++n) { const size_t o = ((size_t)(bh * 64 + n) << 14) + de; prevT[o] = (h16)st; st = st * cd + kvT[o]; }
    }
}
__device__ __forceinline__ void ret_out_unit(const Params& p, const h16* __restrict__ h, const h16* __restrict__ rqr, const h16* __restrict__ rkr, const h16* __restrict__ rvT, const h16* __restrict__ prevT,
                                             h16* __restrict__ mix, int chunk, int w, int lane) {
    const int i = lane & 15, kg = lane >> 4; const int bh = chunk >> 6, n = chunk & 63, b = bh >> 2, hd = bh & 3; const float lg = p.lg[hd];
    const int qi = 16 * w + i; const size_t m = (size_t)b * T + n * 128 + qi;
    h16x8 qf[4];
#pragma unroll
    for (int ks = 0; ks < 4; ++ks) qf[ks] = *(const h16x8*)(rqr + ((size_t)bh * T + n * 128 + qi) * 128 + 32 * ks + 8 * kg);
    f32x4 inner[8], cross[8];
#pragma unroll
    for (int et = 0; et < 8; ++et) { inner[et] = (f32x4){0.f, 0.f, 0.f, 0.f}; cross[et] = (f32x4){0.f, 0.f, 0.f, 0.f}; }
    for (int gq = 0; gq < 2; ++gq) {
        if (64 * gq > 16 * w + 15) break;
        f32x4 s[4];
#pragma unroll
        for (int tl = 0; tl < 4; ++tl) { const int ko = 32 * (tl >> 1) + 8 * (i >> 2) + 4 * (tl & 1) + (i & 3); const h16* kp = rkr + ((size_t)bh * T + n * 128 + 64 * gq + ko) * 128 + 8 * kg;
            f32x4 acc = {0.f, 0.f, 0.f, 0.f};
#pragma unroll
            for (int ks = 0; ks < 4; ++ks) acc = __builtin_amdgcn_mfma_f32_16x16x32_f16(*(const h16x8*)(kp + 32 * ks), qf[ks], acc, 0, 0, 0);
            s[tl] = acc; }
        h16x8 pf[2];
#pragma unroll
        for (int tl = 0; tl < 4; ++tl)
#pragma unroll
            for (int r = 0; r < 4; ++r) { const int j = 64 * gq + 32 * (tl >> 1) + 8 * kg + 4 * (tl & 1) + r; const float v = (j <= qi) ? s[tl][r] * __expf(lg * (float)(qi - j)) : 0.f; pf[tl >> 1][4 * (tl & 1) + r] = (h16)v; }
#pragma unroll
        for (int et = 0; et < 8; ++et)
#pragma unroll
            for (int s2 = 0; s2 < 2; ++s2) { const h16x8 a = *(const h16x8*)(rvT + ((size_t)chunk * 128 + 16 * et + i) * 128 + 64 * gq + 32 * s2 + 8 * kg); inner[et] = __builtin_amdgcn_mfma_f32_16x16x32_f16(a, pf[s2], inner[et], 0, 0, 0); }
    }
#pragma unroll
    for (int et = 0; et < 8; ++et)
#pragma unroll
        for (int ks = 0; ks < 4; ++ks) { const h16x8 a = *(const h16x8*)(prevT + ((size_t)chunk * 128 + 16 * et + i) * 128 + 32 * ks + 8 * kg); cross[et] = __builtin_amdgcn_mfma_f32_16x16x32_f16(a, qf[ks], cross[et], 0, 0, 0); }
    const float xi = __expf(lg * (float)(qi + 1));
    float sm = 0.f;
#pragma unroll
    for (int et = 0; et < 8; ++et) { inner[et] = inner[et] + cross[et] * xi; sm += (inner[et][0] + inner[et][1]) + (inner[et][2] + inner[et][3]); }
    sm += __shfl_xor(sm, 16); sm += __shfl_xor(sm, 32);
    const float mu = sm * (1.f / 128.f); float sq = 0.f;
#pragma unroll
    for (int et = 0; et < 8; ++et) { inner[et] = inner[et] - mu; sq += (inner[et][0] * inner[et][0] + inner[et][1] * inner[et][1]) + (inner[et][2] * inner[et][2] + inner[et][3] * inner[et][3]); }
    sq += __shfl_xor(sq, 16); sq += __shfl_xor(sq, 32);
    const float rstd = rsqrtf(sq * (1.f / 128.f) + LN_EPS);
#pragma unroll
    for (int et = 0; et < 8; ++et) { const int e = 16 * et + 4 * kg; const h16x4 gv = *(const h16x4*)(h + m * INP + C_RG + hd * 128 + e);
        f32x4 o;
#pragma unroll
        for (int r = 0; r < 4; ++r) o[r] = siluf((float)gv[r]) * inner[et][r] * rstd;
        *(h16x4*)(mix + m * D + hd * 128 + e) = __builtin_convertvector(o, h16x4); }
}

struct AttSt { float m, l; f32x4 o[4]; };
struct KFrag { h16x8 a[4][2]; };
struct VFrag { h16x8 a[4][2]; };
__device__ __forceinline__ void ldk(KFrag& k, const h16* __restrict__ Kb, int pitchK, int i, int kg) {
#pragma unroll
    for (int tl = 0; tl < 4; ++tl) { const int ko = 32 * (tl >> 1) + 8 * (i >> 2) + 4 * (tl & 1) + (i & 3); const h16* kp = Kb + (size_t)ko * pitchK + 8 * kg;
        k.a[tl][0] = *(const h16x8*)kp; k.a[tl][1] = *(const h16x8*)(kp + 32); }
}
__device__ __forceinline__ void ldv(VFrag& v, const h16* __restrict__ VTb, int vstride, int i, int kg) {
#pragma unroll
    for (int dt = 0; dt < 4; ++dt)
#pragma unroll
        for (int s2 = 0; s2 < 2; ++s2) v.a[dt][s2] = *(const h16x8*)(VTb + (size_t)(16 * dt + i) * vstride + 32 * s2 + 8 * kg);
}
template <class MaskF>
__device__ __forceinline__ void att_scores(f32x4 (&s)[4], const KFrag& k, const h16x8 (&qf)[2], int kg, MaskF valid) {
#pragma unroll
    for (int tl = 0; tl < 4; ++tl) { f32x4 z = {0.f, 0.f, 0.f, 0.f}; z = __builtin_amdgcn_mfma_f32_16x16x32_f16(k.a[tl][0], qf[0], z, 0, 0, 0); s[tl] = __builtin_amdgcn_mfma_f32_16x16x32_f16(k.a[tl][1], qf[1], z, 0, 0, 0); }
#pragma unroll
    for (int tl = 0; tl < 4; ++tl)
#pragma unroll
        for (int r = 0; r < 4; ++r) { const int ko = 32 * (tl >> 1) + 8 * kg + 4 * (tl & 1) + r; s[tl][r] = valid(ko) ? s[tl][r] * 0.125f : -INFINITY; }
}
__device__ __forceinline__ void att_pv(f32x4 (&o)[4], const f32x4 (&pv)[4], const VFrag& v) {
    h16x8 pf[2];
#pragma unroll
    for (int s2 = 0; s2 < 2; ++s2)
#pragma unroll
        for (int j = 0; j < 8; ++j) pf[s2][j] = (h16)pv[2 * s2 + (j >> 2)][j & 3];
#pragma unroll
    for (int dt = 0; dt < 4; ++dt)
#pragma unroll
        for (int s2 = 0; s2 < 2; ++s2) o[dt] = __builtin_amdgcn_mfma_f32_16x16x32_f16(v.a[dt][s2], pf[s2], o[dt], 0, 0, 0);
}
template <class MaskF>
__device__ __forceinline__ void att_tile(AttSt& st, const KFrag& k, const VFrag& v, const h16x8 (&qf)[2], int kg, MaskF valid) {
    f32x4 s[4]; att_scores(s, k, qf, kg, valid);
    float mx = -INFINITY;
#pragma unroll
    for (int tl = 0; tl < 4; ++tl)
#pragma unroll
        for (int r = 0; r < 4; ++r) mx = fmaxf(mx, s[tl][r]);
    mx = fmaxf(mx, __shfl_xor(mx, 16)); mx = fmaxf(mx, __shfl_xor(mx, 32));
    const float mn = fmaxf(st.m, mx); const float alpha = __expf(st.m - mn); st.m = mn;
    float ps = 0.f;
#pragma unroll
    for (int tl = 0; tl < 4; ++tl)
#pragma unroll
        for (int r = 0; r < 4; ++r) { const float pe = __expf(s[tl][r] - mn); s[tl][r] = pe; ps += pe; }
    st.l = st.l * alpha + ps;
#pragma unroll
    for (int dt = 0; dt < 4; ++dt) st.o[dt] = st.o[dt] * alpha;
    att_pv(st.o, s, v);
}
constexpr int NSA_NSLOT = 5, NSA_RING = 0, NSA_IMP = NSA_NSLOT * 16384, NSA_MSK = NSA_IMP + 32768, NSA_LIST = NSA_MSK + 256;
__device__ __forceinline__ void ldk_lds(KFrag& k, LAS const unsigned char* slot, int ko0, int ko1) {
#pragma unroll
    for (int tl = 0; tl < 4; ++tl) { const int o = (32 * (tl >> 1) + 4 * (tl & 1)) * 128; k.a[tl][0] = *(LAS const h16x8*)(slot + o + ko0); k.a[tl][1] = *(LAS const h16x8*)(slot + o + ko1); }
}
__device__ __forceinline__ void ldv_lds(VFrag& v, LAS const unsigned char* slot, int vo0, int vo1) {
#pragma unroll
    for (int dt = 0; dt < 4; ++dt) { v.a[dt][0] = *(LAS const h16x8*)(slot + 8192 + dt * 2048 + vo0); v.a[dt][1] = *(LAS const h16x8*)(slot + 8192 + dt * 2048 + vo1); }
}
#define NSA_WAITV(n) asm volatile("s_waitcnt vmcnt(" #n ")" ::: "memory")
#define NSA_BAR() do { asm volatile("s_waitcnt lgkmcnt(0)" ::: "memory"); __builtin_amdgcn_s_barrier(); asm volatile("" ::: "memory"); } while (0)
template <int LPT, class IssueF, class CompF>
__device__ __forceinline__ void nsa_stream(int n, LAS unsigned char* dmaw, LAS unsigned char* ring, IssueF issue, CompF comp) {
#pragma unroll
    for (int j = 0; j < NSA_NSLOT - 1; ++j) if (j < n) issue(j, (LAS unsigned*)(dmaw + j * 16384));
    int st = 0, si = (NSA_NSLOT - 1) * 16384;
    for (int t = 0; t < n; ++t) {
        const int ahead = n - 1 - t;
        if (ahead >= 3) { if (LPT == 2) NSA_WAITV(6); else NSA_WAITV(3); }
        else if (ahead == 2) { if (LPT == 2) NSA_WAITV(4); else NSA_WAITV(2); }
        else if (ahead == 1) { if (LPT == 2) NSA_WAITV(2); else NSA_WAITV(1); }
        else NSA_WAITV(0);
        NSA_BAR();
        if (t + NSA_NSLOT - 1 < n) issue(t + NSA_NSLOT - 1, (LAS unsigned*)(dmaw + si));
        comp(t, (LAS const unsigned char*)(ring + st));
        st = (st == (NSA_NSLOT - 1) * 16384) ? 0 : st + 16384; si = (si == (NSA_NSLOT - 1) * 16384) ? 0 : si + 16384; }
    NSA_BAR();
}
__device__ __forceinline__ void nsa_block_unit(const h16* __restrict__ h, const h16* __restrict__ nqr, const h16* __restrict__ kcmp, const h16* __restrict__ vcmpT, const h16* __restrict__ vsT, const h16* __restrict__ vwT,
                                               const h16* __restrict__ ksR, const h16* __restrict__ kwR, h16* __restrict__ mix, int b, int g, int T0, LAS unsigned char* lds, int wv, int lane) {
    const int i = lane & 15, kg = lane >> 4, tt = i & 3, hh = i >> 2;
    const int t0 = T0 + 4 * wv, trow = t0 + tt; const size_t mrow = (size_t)b * T + trow;
    const int q = wv * 64 + lane, qrow = q >> 3, qch = q & 7;
    const int ksrc = qrow * 128 + ((qch ^ (((qrow >> 1) & 1) | (((qrow >> 3) & 3) << 1))) << 4), vsrc = qrow * 128 + ((qch ^ ((qrow >> 1) & 7)) << 4);
    const int gki = ((i >> 1) & 1) | ((i >> 2) << 1), gvi = (i >> 1) & 7;
    const int ko0 = (8 * (i >> 2) + (i & 3)) * 128 + ((kg ^ gki) << 4), ko1 = (8 * (i >> 2) + (i & 3)) * 128 + (((kg + 4) ^ gki) << 4);
    const int vo0 = i * 128 + ((kg ^ gvi) << 4), vo1 = i * 128 + (((kg + 4) ^ gvi) << 4);
    LAS unsigned char* ring = lds + NSA_RING; LAS unsigned char* dmaw = ring + wv * 1024;
    LAS float* impA = (LAS float*)(lds + NSA_IMP + wv * 4096); LAS float* impL = impA + 512;
    h16x8 qf[2], qrf[2];
    { const h16* qp = h + mrow * INP + C_NQ + (g * 4 + hh) * 64 + 8 * kg; qf[0] = *(const h16x8*)qp; qf[1] = *(const h16x8*)(qp + 32);
      const h16* qrp = nqr + mrow * 512 + (g * 4 + hh) * 64 + 8 * kg; qrf[0] = *(const h16x8*)qrp; qrf[1] = *(const h16x8*)(qrp + 32); }
    const h16* gp = h + mrow * INP + C_NG + (g * 4 + hh) * 3; const float gt0 = (float)gp[0], gt1 = (float)gp[1], gt2 = (float)gp[2];
    for (int x = lane; x < 1024; x += 64) impA[x] = 0.f;
    NSA_WAITV(0);
#define GLDS16(gsrc, ldst) __builtin_amdgcn_global_load_lds((const unsigned*)(gsrc), (ldst), 16, 0, 0)
    const int ncv_row = trow >= 31 ? ((trow - 31) >> 4) + 1 : 0;
    const int ncv_blk = (T0 + 31 >= 31) ? ((T0 + 31 - 31) >> 4) + 1 : 0;
    const int nct = (ncv_blk + 63) >> 6;
    const unsigned char* Kc = (const unsigned char*)(kcmp + (size_t)(b * 2 + g) * 512 * 64); const unsigned char* Vc = (const unsigned char*)(vcmpT + (size_t)(b * 2 + g) * 8 * 4096);
    float m = -1e30f, l = 0.f;
    f32x4 oc[4];
#pragma unroll
    for (int dt = 0; dt < 4; ++dt) oc[dt] = (f32x4){0.f, 0.f, 0.f, 0.f};
    nsa_stream<1>(nct, dmaw, ring, [&](int j, LAS unsigned* dk) { GLDS16(Kc + (size_t)j * 8192 + ksrc, dk); }, [&](int j, LAS const unsigned char* slot) {
        KFrag kf; ldk_lds(kf, slot, ko0, ko1);
        f32x4 s[4]; att_scores(s, kf, qf, kg, [&](int ko) { return j * 64 + ko < ncv_row; });
        float mx = -INFINITY;
        _Pragma("unroll") for (int tl = 0; tl < 4; ++tl) _Pragma("unroll") for (int r = 0; r < 4; ++r) mx = fmaxf(mx, s[tl][r]);
        mx = fmaxf(mx, __shfl_xor(mx, 16)); mx = fmaxf(mx, __shfl_xor(mx, 32));
        const float mn = fmaxf(m, mx); float ps = 0.f;
        _Pragma("unroll") for (int tl = 0; tl < 4; ++tl) _Pragma("unroll") for (int r = 0; r < 4; ++r) ps += __expf(s[tl][r] - mn);
        l = l * __expf(m - mn) + ps; m = mn; });
    l += __shfl_xor(l, 16); l += __shfl_xor(l, 32);
    const float linv = l > 0.f ? 1.f / l : 0.f;
    nsa_stream<2>(nct, dmaw, ring, [&](int j, LAS unsigned* dk) { GLDS16(Kc + (size_t)j * 8192 + ksrc, dk); GLDS16(Vc + (size_t)j * 8192 + vsrc, (LAS unsigned*)((LAS unsigned char*)dk + 8192)); }, [&](int j, LAS const unsigned char* slot) {
        KFrag kf; ldk_lds(kf, slot, ko0, ko1); VFrag vf; ldv_lds(vf, slot, vo0, vo1);
        f32x4 s[4]; att_scores(s, kf, qf, kg, [&](int ko) { return j * 64 + ko < ncv_row; });
        _Pragma("unroll") for (int tl = 0; tl < 4; ++tl) {
            _Pragma("unroll") for (int r = 0; r < 4; ++r) s[tl][r] = __expf(s[tl][r] - m) * linv;
            float A = (s[tl][0] + s[tl][1]) + (s[tl][2] + s[tl][3]), L = s[tl][3];
            A += __shfl_xor(A, 4); A += __shfl_xor(A, 8); L += __shfl_xor(L, 4); L += __shfl_xor(L, 8);
            if (hh == 0) { const int u = j * 16 + 8 * (tl >> 1) + 2 * kg + (tl & 1); impA[tt * 128 + u] = A; impL[tt * 128 + u] = L; } }
        att_pv(oc, s, vf); });
    const int cur = T0 >> 6;
    AttSt sw; sw.m = -1e30f; sw.l = 0.f;
#pragma unroll
    for (int dt = 0; dt < 4; ++dt) sw.o[dt] = (f32x4){0.f, 0.f, 0.f, 0.f};
    {
        const unsigned char* Kw = (const unsigned char*)(kwR + (size_t)((b * 2 + g) * 128) * 4096); const unsigned char* Vw = (const unsigned char*)(vwT + (size_t)((b * 2 + g) * 128) * 4096);
        const int s0w = (T0 >= 511 ? (T0 - 511) >> 6 : 0);
        nsa_stream<2>(cur - s0w + 1, dmaw, ring, [&](int j, LAS unsigned* dk) { GLDS16(Kw + (size_t)(s0w + j) * 8192 + ksrc, dk); GLDS16(Vw + (size_t)(s0w + j) * 8192 + vsrc, (LAS unsigned*)((LAS unsigned char*)dk + 8192)); }, [&](int j, LAS const unsigned char* slot) {
            KFrag kf; ldk_lds(kf, slot, ko0, ko1); VFrag vf; ldv_lds(vf, slot, vo0, vo1); const int s = s0w + j;
            att_tile(sw, kf, vf, qrf, kg, [&](int ko) { const int kp = 64 * s + ko; return kp <= trow && kp >= trow - 511; }); });
    }
    unsigned long long mylo, myhi, anylo, anyhi;
    if (cur <= 15) { mylo = anylo = (1ull << (cur + 1)) - 1ull; myhi = anyhi = 0ull; }
    else {
        mylo = myhi = anylo = anyhi = 0ull;
        const unsigned long long flo = 1ull | (cur < 64 ? (1ull << cur) : 0ull) | (cur - 1 < 64 ? (1ull << (cur - 1)) : 0ull);
        const unsigned long long fhi = (cur >= 64 ? (1ull << (cur - 64)) : 0ull) | (cur - 1 >= 64 ? (1ull << (cur - 65)) : 0ull);
        const unsigned long long lmask = (1ull << lane) - 1ull;
        for (int tk = 0; tk < 4; ++tk) {
            const int s0 = lane, s1 = lane + 64;
            const float v0 = impA[tk * 128 + s0] + (s0 > 0 ? impL[tk * 128 + s0 - 1] : 0.f), v1 = impA[tk * 128 + s1] + impL[tk * 128 + s1 - 1];
            const unsigned b0 = (s0 >= 1 && s0 <= cur - 2) ? __float_as_uint(v0) + 1u : 0u, b1 = (s1 <= cur - 2) ? __float_as_uint(v1) + 1u : 0u;
            unsigned Tq = 0u;
            for (int bit = 30; bit >= 0; --bit) { const unsigned T2 = Tq | (1u << bit);
                const int c = __popcll(__ballot(b0 >= T2)) + __popcll(__ballot(b1 >= T2)); if (c >= 13) Tq = T2; }
            const unsigned long long gtlo = __ballot(b0 > Tq), gthi = __ballot(b1 > Tq), eqlo = __ballot(b0 == Tq), eqhi = __ballot(b1 == Tq);
            const int need = 13 - (__popcll(gtlo) + __popcll(gthi));
            const bool t0q = (b0 == Tq) && (__popcll(eqlo & lmask) < need), t1q = (b1 == Tq) && (__popcll(eqlo) + __popcll(eqhi & lmask) < need);
            const unsigned long long lo = gtlo | __ballot(t0q) | flo, hi = gthi | __ballot(t1q) | fhi;
            anylo |= lo; anyhi |= hi; if (tt == tk) { mylo = lo; myhi = hi; }
        }
    }
    LAS unsigned long long* msk = (LAS unsigned long long*)(lds + NSA_MSK); LAS unsigned char* lst = lds + NSA_LIST; LAS int* nlst = (LAS int*)(lds + NSA_LIST + 128);
    if (lane == 0) { msk[2 * wv] = anylo; msk[2 * wv + 1] = anyhi; }
    NSA_BAR();
    if (wv == 0) {
        unsigned long long ulo = 0ull, uhi = 0ull;
#pragma unroll
        for (int w2 = 0; w2 < 8; ++w2) { ulo |= msk[2 * w2]; uhi |= msk[2 * w2 + 1]; }
        const unsigned long long lmask = (1ull << lane) - 1ull; const int nlo = __popcll(ulo);
        if ((ulo >> lane) & 1ull) lst[__popcll(ulo & lmask)] = (unsigned char)lane;
        if ((uhi >> lane) & 1ull) lst[nlo + __popcll(uhi & lmask)] = (unsigned char)(64 + lane);
        if (lane == 0) nlst[0] = nlo + __popcll(uhi);
    }
    NSA_BAR();
    const int nsel = nlst[0];
    AttSt ss; ss.m = -1e30f; ss.l = 0.f;
#pragma unroll
    for (int dt = 0; dt < 4; ++dt) ss.o[dt] = (f32x4){0.f, 0.f, 0.f, 0.f};
    {
        const unsigned char* Ks = (const unsigned char*)(ksR + (size_t)((b * 2 + g) * 128) * 4096); const unsigned char* Vs = (const unsigned char*)(vsT + (size_t)((b * 2 + g) * 128) * 4096);
        nsa_stream<2>(nsel, dmaw, ring, [&](int j, LAS unsigned* dk) { const int sj = lst[j]; GLDS16(Ks + (size_t)sj * 8192 + ksrc, dk); GLDS16(Vs + (size_t)sj * 8192 + vsrc, (LAS unsigned*)((LAS unsigned char*)dk + 8192)); }, [&](int j, LAS const unsigned char* slot) {
            const int s = lst[j];
            if ((((s < 64 ? anylo : anyhi) >> (s & 63)) & 1ull) != 0ull) {
                KFrag kf; ldk_lds(kf, slot, ko0, ko1); VFrag vf; ldv_lds(vf, slot, vo0, vo1);
                const bool mybit = (((s < 64 ? mylo : myhi) >> (s & 63)) & 1ull) != 0ull;
                att_tile(ss, kf, vf, qrf, kg, [&](int ko) { return mybit && (64 * s + ko <= trow); }); } });
    }
    float ls = ss.l; ls += __shfl_xor(ls, 16); ls += __shfl_xor(ls, 32); float lw = sw.l; lw += __shfl_xor(lw, 16); lw += __shfl_xor(lw, 32);
    const float g0 = sigmf(gt0), g1 = sigmf(gt1) / ls, g2 = sigmf(gt2) / lw;
#pragma unroll
    for (int dt = 0; dt < 4; ++dt) { const f32x4 o = oc[dt] * g0 + ss.o[dt] * g1 + sw.o[dt] * g2;
        *(h16x4*)(mix + mrow * D + 512 + (g * 4 + hh) * 64 + 16 * dt + 4 * kg) = __builtin_convertvector(o, h16x4); }
#undef GLDS16
}

__device__ __forceinline__ void b_ln(const float* __restrict__ in, const float* __restrict__ gam, const float* __restrict__ bet, float* __restrict__ o32, h16* __restrict__ o16) {
    const int lane = tidx() & 63;
    for (int row = blockIdx.x * 8 + (tidx() >> 6); row < M; row += gridDim.x * 8) {
        const f32x4* xr = (const f32x4*)(in + (size_t)row * D) + lane;
        f32x4 v[4]; float s = 0.f;
#pragma unroll
        for (int j = 0; j < 4; ++j) { v[j] = xr[64 * j]; s += (v[j][0] + v[j][1]) + (v[j][2] + v[j][3]); }
        const float mean = wave_sum(s) * (1.f / D); float s2 = 0.f;
#pragma unroll
        for (int j = 0; j < 4; ++j) { v[j] = v[j] - mean; s2 += (v[j][0] * v[j][0] + v[j][1] * v[j][1]) + (v[j][2] * v[j][2] + v[j][3] * v[j][3]); }
        const float rstd = rsqrtf(wave_sum(s2) * (1.f / D) + LN_EPS);
#pragma unroll
        for (int j = 0; j < 4; ++j) { const f32x4 gg = ((const f32x4*)gam)[lane + 64 * j], bb = ((const f32x4*)bet)[lane + 64 * j]; const f32x4 o = v[j] * rstd * gg + bb;
            ((f32x4*)(o32 + (size_t)row * D))[lane + 64 * j] = o;
            if (o16) ((h16x4*)(o16 + (size_t)row * D))[lane + 64 * j] = __builtin_convertvector(o, h16x4); }
    }
}

__device__ __forceinline__ void xattn_unit(const h16* __restrict__ qx, const h16* __restrict__ kx, const h16* __restrict__ kvmVT, h16* __restrict__ ox, int m0, int hh, int lane) {
    const int i = lane & 15, kg = lane >> 4; const int b = m0 >> 13; const size_t m = (size_t)m0 + i;
    h16x8 qf[8];
#pragma unroll
    for (int ks = 0; ks < 8; ++ks) qf[ks] = *(const h16x8*)(qx + m * D + hh * 256 + 32 * ks + 8 * kg);
    f32x4 o[16];
#pragma unroll
    for (int dt = 0; dt < 16; ++dt) o[dt] = (f32x4){0.f, 0.f, 0.f, 0.f};
    float mrun = -1e30f, l = 0.f;
    const h16* vb = kvmVT + (size_t)((b * 4 + hh) * 256) * MEML;
#pragma unroll 1
    for (int gq = 0; gq < 4; ++gq) {
        f32x4 s[4]; float mx = -INFINITY;
#pragma unroll
        for (int tl = 0; tl < 4; ++tl) { const int ko = 64 * gq + 32 * (tl >> 1) + 8 * (i >> 2) + 4 * (tl & 1) + (i & 3); const h16* kp = kx + ((size_t)(b * 4 + hh) * MEML + ko) * 256 + 8 * kg;
            f32x4 acc = {0.f, 0.f, 0.f, 0.f};
#pragma unroll
            for (int ks = 0; ks < 8; ++ks) acc = __builtin_amdgcn_mfma_f32_16x16x32_f16(*(const h16x8*)(kp + 32 * ks), qf[ks], acc, 0, 0, 0);
            s[tl] = acc * 0.0625f; mx = fmaxf(mx, fmaxf(fmaxf(s[tl][0], s[tl][1]), fmaxf(s[tl][2], s[tl][3]))); }
        mx = fmaxf(mx, __shfl_xor(mx, 16)); mx = fmaxf(mx, __shfl_xor(mx, 32));
        const float mn = fmaxf(mrun, mx); const float alpha = __expf(mrun - mn); mrun = mn;
        float ps = 0.f; h16x8 pf[2];
#pragma unroll
        for (int tl = 0; tl < 4; ++tl)
#pragma unroll
            for (int r = 0; r < 4; ++r) { const float pe = __expf(s[tl][r] - mn); ps += pe; pf[tl >> 1][4 * (tl & 1) + r] = (h16)pe; }
        l = l * alpha + ps;
#pragma unroll
        for (int dt = 0; dt < 16; ++dt) { f32x4 acc = o[dt] * alpha;
#pragma unroll
            for (int s2 = 0; s2 < 2; ++s2) acc = __builtin_amdgcn_mfma_f32_16x16x32_f16(*(const h16x8*)(vb + (size_t)(16 * dt + i) * MEML + 64 * gq + 32 * s2 + 8 * kg), pf[s2], acc, 0, 0, 0);
            o[dt] = acc; }
    }
    l += __shfl_xor(l, 16); l += __shfl_xor(l, 32); const float linv = 1.f / l;
#pragma unroll
    for (int dt = 0; dt < 16; ++dt) { const f32x4 acc = o[dt] * linv; *(h16x4*)(ox + m * D + hh * 256 + 16 * dt + 4 * kg) = __builtin_convertvector(acc, h16x4); }
}

__device__ __forceinline__ void b_router(const Params& p, const float* __restrict__ x2, int* __restrict__ tope, float* __restrict__ topw, int* __restrict__ hist) {
    const int lane = tidx() & 63; const float* wr = p.w_router;
    for (int m = blockIdx.x * 8 + (tidx() >> 6); m < M; m += gridDim.x * 8) {
        const float* xr = x2 + (size_t)m * D; float acc = 0.f;
        for (int k = 0; k < D; k += 4) { const f32x4 xv = *(const f32x4*)(xr + k);
            acc += xv[0] * wr[(k + 0) * 64 + lane]; acc += xv[1] * wr[(k + 1) * 64 + lane]; acc += xv[2] * wr[(k + 2) * 64 + lane]; acc += xv[3] * wr[(k + 3) * 64 + lane]; }
        const float score = 1.f / (1.f + expf(-acc)); const float biased = score + p.rbias[lane];
        float m1 = biased; m1 = fmaxf(m1, __shfl_xor(m1, 1)); m1 = fmaxf(m1, __shfl_xor(m1, 2)); m1 = fmaxf(m1, __shfl_xor(m1, 4));
        int am = (biased == m1) ? lane : 999; am = min(am, __shfl_xor(am, 1)); am = min(am, __shfl_xor(am, 2)); am = min(am, __shfl_xor(am, 4));
        float m2 = (lane == am) ? -INFINITY : biased; m2 = fmaxf(m2, __shfl_xor(m2, 1)); m2 = fmaxf(m2, __shfl_xor(m2, 2)); m2 = fmaxf(m2, __shfl_xor(m2, 4));
        const float gs = m1 + m2;
        int cnt = 0;
#pragma unroll
        for (int gq = 0; gq < 8; ++gq) { const float o = __shfl(gs, gq * 8); cnt += (o > gs) ? 1 : 0; }
        const float masked = (cnt <= 3) ? biased : NEGF;
        int rank = 0;
        for (int e2 = 0; e2 < 64; ++e2) { const float o = __shfl(masked, e2); rank += (o > masked || (o == masked && e2 < lane)) ? 1 : 0; }
        const bool selq = rank < 8;
        const float wsum = wave_sum(selq ? score : 0.f);
        if (selq) { tope[(size_t)m * 8 + rank] = lane; topw[(size_t)m * 8 + rank] = score / wsum * 2.5f; atomicAdd(hist + (m >> 13) * 65 + lane, 1); }
    }
}

__device__ __forceinline__ void b_moe(const Params& p, const float* __restrict__ x2, const int* __restrict__ tope, const float* __restrict__ topw, float* __restrict__ out, int m, float* sl, int tid) {
    float* xs = sl; float* hd = sl + 1024; float* red = sl + 1280;
    for (int i = tid; i < 1024; i += 256) xs[i] = x2[(size_t)m * D + i];
    __syncthreads();
    float acc[4] = {0.f, 0.f, 0.f, 0.f};
    for (int kx = 0; kx < 9; ++kx) {
        const float* G; const float* U; const float* Dn; float wt;
        if (kx < 8) { const int e = tope[(size_t)m * 8 + kx]; wt = topw[(size_t)m * 8 + kx]; G = p.w_gate + (size_t)e * D * EFF; U = p.w_up + (size_t)e * D * EFF; Dn = p.w_down + (size_t)e * EFF * D; }
        else { wt = 1.f; G = p.ws_gate; U = p.ws_up; Dn = p.ws_down; }
        float a = 0.f, u = 0.f;
        for (int k = 0; k < D; ++k) { const float xv = xs[k]; a += xv * G[(size_t)k * EFF + tid]; u += xv * U[(size_t)k * EFF + tid]; }
        hd[tid] = siluf(a) * u * wt;
        __syncthreads();
        for (int j = 0; j < EFF; ++j) { const float hv = hd[j]; const float* dr = Dn + (size_t)j * D + tid;
            acc[0] += hv * dr[0]; acc[1] += hv * dr[256]; acc[2] += hv * dr[512]; acc[3] += hv * dr[768]; }
        __syncthreads();
    }
    float v[4]; float s = 0.f;
#pragma unroll
    for (int i = 0; i < 4; ++i) { v[i] = DN_ALPHA * xs[tid + 256 * i] + acc[i]; s += v[i]; }
    s = wave_sum(s); if ((tid & 63) == 0) red[tid >> 6] = s; __syncthreads();
    const float mean = (red[0] + red[1] + red[2] + red[3]) * (1.f / D); float s2 = 0.f;
#pragma unroll
    for (int i = 0; i < 4; ++i) { v[i] -= mean; s2 += v[i] * v[i]; }
    s2 = wave_sum(s2); if ((tid & 63) == 0) red[4 + (tid >> 6)] = s2; __syncthreads();
    const float rstd = rsqrtf((red[4] + red[5] + red[6] + red[7]) * (1.f / D) + LN_EPS);
#pragma unroll
    for (int i = 0; i < 4; ++i) out[(size_t)m * D + tid + 256 * i] = v[i] * rstd * p.ln3g[tid + 256 * i] + p.ln3b[tid + 256 * i];
    __syncthreads();
}

struct G1Sched {
    const int* ctl; const char* x2h; const unsigned* rowoff; const char* WguT; int G, c;
    __device__ bool next(int i, pg8::Unit& u) const {
        const int ntile = ctl[CTL_TQS + NQ]; const long L = (long)i * G + c; if (L >= 2L * ntile) return false;
        const int tile = (int)(L >> 1), pn = (int)(L & 1); const int e = ctl[CTL_TVE + tile] % 65;
        u.pm = tile; u.pn = pn; u.A = x2h; u.gat = rowoff + (size_t)tile * 256; u.B = WguT + ((size_t)e * 512 + pn * 256) * (D * 2); return true; }
};
struct G2Sched {
    const int* ctl; const char* H; const char* WdT; int q, G, c;
    __device__ bool next(int i, pg8::Unit& u) const {
        const int t0 = ctl[CTL_TQS + q], t1 = ctl[CTL_TQS + q + 1]; const long L = (long)i * G + c; if (L >= 4L * (t1 - t0)) return false;
        const int tile = t0 + (int)(L >> 2), pn = (int)(L & 3); const int e = ctl[CTL_TVE + tile] % 65;
        u.pm = tile; u.pn = pn; u.A = H + (size_t)tile * 256 * (EFF * 2); u.gat = nullptr; u.B = WdT + ((size_t)e * D + pn * 256) * (EFF * 2); return true; }
};
__device__ __forceinline__ void b_scatter(int* __restrict__ ctl, const int* __restrict__ tope, const float* __restrict__ topw, unsigned* __restrict__ rowoff, u32x2* __restrict__ rowmeta, int* sl) {
    int* pst = sl;
    if (tidx() == 0) { int acc = 0; for (int v = 0; v < NVE; ++v) { pst[v] = acc; acc += (ctl[CTL_CNT + v] + 255) & ~255; } pst[NVE] = acc; }
    __syncthreads();
    if (blockIdx.x == 0) {
        for (int v = tidx(); v <= NVE; v += NTHR) ctl[CTL_PST + v] = pst[v];
        if (tidx() <= NQ) ctl[CTL_TQS + tidx()] = pst[tidx() * 65] >> 8;
        for (int v = tidx(); v < NVE; v += NTHR) for (int tl = pst[v] >> 8; tl < (pst[v + 1] >> 8); ++tl) ctl[CTL_TVE + tl] = v;
    }
    for (int idx = blockIdx.x * NTHR + tidx(); idx < M * 9; idx += gridDim.x * NTHR) {
        int m, k, pos; float w;
        if (idx < M * 8) { m = idx >> 3; k = idx & 7; const int ve = (m >> 13) * 65 + tope[idx]; w = topw[idx]; pos = pst[ve] + atomicAdd(ctl + CTL_CUR + ve, 1); }
        else { m = idx - M * 8; k = 8; w = 1.f; pos = pst[(m >> 13) * 65 + 64] + (m & (QT - 1)); }
        rowoff[pos] = (unsigned)m * (D * 2); rowmeta[pos] = (u32x2){(unsigned)((m & (QT - 1)) * 9 + k), __float_as_uint(w)};
    }
    __syncthreads();
}
__device__ __forceinline__ void b_combine(const Params& p, const h16* __restrict__ x2h, const h16* __restrict__ Y, int q) {
    const int lane = tidx() & 63;
    for (int r = blockIdx.x * 8 + (tidx() >> 6); r < QT; r += gridDim.x * 8) {
        const int m = q * QT + r;
        float v[16];
        { const h16x8 a = ((const h16x8*)(x2h + (size_t)m * D))[lane], b = ((const h16x8*)(x2h + (size_t)m * D))[lane + 64];
#pragma unroll
          for (int i = 0; i < 8; ++i) { v[i] = DN_ALPHA * (float)a[i]; v[8 + i] = DN_ALPHA * (float)b[i]; } }
#pragma unroll
        for (int k = 0; k < 9; ++k) { const h16x8* yr = (const h16x8*)(Y + ((size_t)r * 9 + k) * D); const h16x8 a = yr[lane], b = yr[lane + 64];
#pragma unroll
            for (int i = 0; i < 8; ++i) { v[i] += (float)a[i]; v[8 + i] += (float)b[i]; } }
        float s = 0.f;
#pragma unroll
        for (int i = 0; i < 16; ++i) s += v[i];
        const float mean = wave_sum(s) * (1.f / D); float s2 = 0.f;
#pragma unroll
        for (int i = 0; i < 16; ++i) { v[i] -= mean; s2 += v[i] * v[i]; }
        const float rstd = rsqrtf(wave_sum(s2) * (1.f / D) + LN_EPS);
#pragma unroll
        for (int hlf = 0; hlf < 2; ++hlf) { const int c0 = (lane + 64 * hlf) * 8;
            const f32x4 g0 = *(const f32x4*)(p.ln3g + c0), g1 = *(const f32x4*)(p.ln3g + c0 + 4), b0 = *(const f32x4*)(p.ln3b + c0), b1 = *(const f32x4*)(p.ln3b + c0 + 4);
            f32x4 o0, o1;
#pragma unroll
            for (int i = 0; i < 4; ++i) { o0[i] = v[8 * hlf + i] * rstd * g0[i] + b0[i]; o1[i] = v[8 * hlf + 4 + i] * rstd * g1[i] + b1[i]; }
            *(f32x4*)(p.out + (size_t)m * D + c0) = o0; *(f32x4*)(p.out + (size_t)m * D + c0 + 4) = o1; }
    }
}

#define XB_TMO      128
#define XB_XCNT(j)  (256  + 64 * (j))
#define XB_XSUB(j)  (1280 + 64 * (j))
#define XB_XGEN(j)  (2304 + 64 * (j))
#define XB_TOP      3328
#define XB_TOPGEN   3392
#define XCD_BAR_WORDS 3456
#define XB_SPIN_CAP (1u << 22)
__device__ __forceinline__ unsigned xb_ld(unsigned* p)              { return __hip_atomic_load(p, __ATOMIC_RELAXED, __HIP_MEMORY_SCOPE_AGENT); }
__device__ __forceinline__ unsigned xb_add(unsigned* p, unsigned v) { return __hip_atomic_fetch_add(p, v, __ATOMIC_RELAXED, __HIP_MEMORY_SCOPE_AGENT); }
__device__ __forceinline__ unsigned xb_xcc_id() { return (unsigned)__builtin_amdgcn_s_getreg((3 << 11) | 20) & 0xFu; }
#define XB_SPIN(cond, bar) do { unsigned _sp = 0; while (cond) { __builtin_amdgcn_s_sleep(1); \
    if ((++_sp & 255u) == 0u) { if (xb_ld(&(bar)[XB_TMO])) break; if (_sp > XB_SPIN_CAP) { atomicAdd(&(bar)[XB_TMO], 1u); break; } } } } while (0)
struct XcdBarrier { unsigned* bar; unsigned x; volatile LAS unsigned* st; };
__device__ __forceinline__ XcdBarrier xcd_barrier_post(unsigned* bar, volatile LAS unsigned* st) {
    XcdBarrier b; b.bar = bar; b.x = xb_xcc_id(); b.st = st;
    if (threadIdx.x == 0) (void)xb_add(&bar[XB_XCNT(b.x)], 1u);
    return b;
}
__device__ __forceinline__ void xcd_barrier_complete(unsigned* bar, unsigned x, unsigned& nloc, unsigned& nx) {
    const unsigned G = gridDim.x * gridDim.y * gridDim.z;
    unsigned sum, cnt, mine, sp = 0u;
    for (;;) {
        sum = 0u; cnt = 0u; mine = 0u;
#pragma unroll
        for (unsigned j = 0; j < 16; ++j) { const unsigned c = xb_ld(&bar[XB_XCNT(j)]); sum += c; cnt += (c > 0u) ? 1u : 0u; mine = (j == x) ? c : mine; }
        if (sum == G) break;
        __builtin_amdgcn_s_sleep(1);
        if ((++sp & 255u) == 0u) { if (xb_ld(&bar[XB_TMO])) break; if (sp > XB_SPIN_CAP) { atomicAdd(&bar[XB_TMO], 1u); break; } }
    }
    nloc = mine > 0u ? mine : 1u; nx = cnt > 0u ? cnt : 1u;
}
__device__ __forceinline__ void xcd_barrier(const XcdBarrier& b) {
    asm volatile("s_waitcnt vmcnt(0)" ::: "memory");
    __syncthreads();
    if (threadIdx.x == 0) {
        unsigned* bar = b.bar;
        __builtin_amdgcn_s_waitcnt(0);
        unsigned nloc = b.st[0], nx = b.st[1];
        if (nloc == 0u) { xcd_barrier_complete(bar, b.x, nloc, nx); b.st[0] = nloc; b.st[1] = nx; }
        const unsigned old = xb_add(&bar[XB_XSUB(b.x)], 1u);
        const unsigned gen = old / nloc;
        if (old + 1u == (gen + 1u) * nloc) {
            __builtin_amdgcn_fence(__ATOMIC_RELEASE, "agent");
            asm volatile("s_waitcnt vmcnt(0)" ::: "memory");
            const unsigned og = xb_add(&bar[XB_TOP], 1u);
            const unsigned tg = og / nx;
            if (og + 1u == (tg + 1u) * nx) xb_add(&bar[XB_TOPGEN], 1u);
            else XB_SPIN(xb_ld(&bar[XB_TOPGEN]) == tg, bar);
            __builtin_amdgcn_fence(__ATOMIC_ACQUIRE, "agent");
            xb_add(&bar[XB_XGEN(b.x)], 1u);
            asm volatile("s_waitcnt vmcnt(0)" ::: "memory");
        } else {
            XB_SPIN(xb_ld(&bar[XB_XGEN(b.x)]) == gen, bar);
            __builtin_amdgcn_fence(__ATOMIC_ACQUIRE, "agent");
            asm volatile("s_waitcnt vmcnt(0)" ::: "memory");
        }
    }
    __syncthreads();
}

constexpr int N_PHASES = 23;

__global__ void __launch_bounds__(NTHR, 2) mega_fwd(Params p) {
    extern __shared__ __attribute__((aligned(16))) unsigned char lds[];
    cg::grid_group grid = cg::this_grid();
    const int G = (int)gridDim.x, bid = (int)blockIdx.x;
#define tid tidx()
    unsigned char* ws = p.ws;
    h16* WinT = (h16*)(ws + WS_WIN); h16* WoutT = (h16*)(ws + WS_WOUT); h16* WxqT = (h16*)(ws + WS_WXQ); h16* WxoT = (h16*)(ws + WS_WXO); h16* WxkvT = (h16*)(ws + WS_WXKV);
    h16* memh = (h16*)(ws + WS_MEMH); h16* kvm = (h16*)(ws + WS_KVM); h16* kcmp = (h16*)(ws + WS_KCMP); h16* vcmpT = (h16*)(ws + WS_VCMP); h16* vsT = (h16*)(ws + WS_VST); h16* vwT = (h16*)(ws + WS_VWT);
    int* tope = (int*)(ws + WS_TOPE); float* topw = (float*)(ws + WS_TOPW);
    h16* xh = (h16*)(ws + WS_XH); h16* mix = (h16*)(ws + WS_MIX); h16* ox = (h16*)(ws + WS_OX); h16* hb = (h16*)(ws + WS_H); h16* nqr = (h16*)(ws + WS_NQR);
    float* kvb = (float*)(ws + WS_KVB); h16* prevT = (h16*)(ws + WS_PREVT);
    float* cosr = (float*)(ws + WS_COSR); float* sinr = (float*)(ws + WS_SINR); float* cosn = (float*)(ws + WS_COSN); float* sinn = (float*)(ws + WS_SINN); h16* kvmVT = (h16*)(ws + WS_KVMVT); h16* ksR = (h16*)(ws + WS_KSR); h16* kwR = (h16*)(ws + WS_KWR); h16* kx = (h16*)(ws + WS_KX);
    h16* rqr = (h16*)((unsigned char*)p.out + DO_RQR); h16* rkr = (h16*)((unsigned char*)p.out + DO_RKR); h16* rkzT = (h16*)((unsigned char*)p.out + DO_RKZT); h16* rvT = (h16*)((unsigned char*)p.out + DO_RVT); float* pre = p.out; float* x1 = (float*)(ws + WS_X1); h16* x1h = (h16*)(ws + WS_X1H);
    h16* qx = (h16*)(ws + WS_QX); float* x2 = (float*)(ws + WS_X2); h16* x2h = (h16*)(ws + WS_X2H);
    int* ctl = (int*)ws; unsigned* rowoff = (unsigned*)(ws + WS_ROWOFF); u32x2* rowmeta = (u32x2*)(ws + WS_ROWMETA);
    h16* WguT = (h16*)(ws + WS_WGUT); h16* WdT = (h16*)(ws + WS_WDT); h16* Hm = (h16*)(ws + WS_HM); h16* Yq = (h16*)(ws + WS_Y);
    float* fl = (float*)lds;
    const int lo = p.ph_lo, hi = p.ph_hi;
#define IN(k) (lo <= (k) && (k) < hi)
    { volatile LAS unsigned* st = (volatile LAS unsigned*)((LAS unsigned char*)lds + 131072); if (threadIdx.x < 2) st[threadIdx.x] = 0u; }
    __syncthreads();
    XcdBarrier xbar = xcd_barrier_post((unsigned*)(ws + WS_BAR), (volatile LAS unsigned*)((LAS unsigned char*)lds + 131072));
#define SEAM(k) do { if (IN(k) && IN((k) + 1)) { if ((k) == 0) grid.sync(); else xcd_barrier(xbar); } } while (0)

    if (IN(0)) REPS(0) {
        const int sub = tid >> 8, lt = tid & 255; float* tl = fl + sub * 1088;
        constexpr int T0 = (INP / 32) * (D / 32), T1 = (D / 32) * (D / 32), T4 = (2 * D / 32) * (D / 32), TT = T0 + 3 * T1 + T4;
        for (int b0 = bid * 2; b0 < TT; b0 += G * 2) { int it = b0 + sub;
            if (it < T0) { b_transpose_tile(p.w_in, D, INC, WinT, INP, it, tl, lt); continue; } it -= T0;
            if (it < T1) { b_transpose_tile(p.w_out, D, D, WoutT, D, it, tl, lt); continue; } it -= T1;
            if (it < T1) { b_transpose_tile(p.w_xq, D, D, WxqT, D, it, tl, lt); continue; } it -= T1;
            if (it < T1) { b_transpose_tile(p.w_xo, D, D, WxoT, D, it, tl, lt); continue; } it -= T1;
            b_transpose_tile(p.w_xkv, D, 2 * D, WxkvT, 2 * D, it, tl, lt); }
        b_cvt(p.x, xh, (size_t)M * D / 4);
        b_cvt(p.mem, memh, (size_t)NB * MEML * D / 4);
        if (bid == 0) for (int i = tid; i < 1024; i += NTHR) ctl[i] = 0;
        b_tables(p.positions, cosr, sinr, cosn, sinn);
    }
    SEAM(0);
    if (IN(1)) {
        REPS(1) { pg8::Gemm g{xh, WinT, M, INP, D}; pg8::StaticOrder S; S.init(g, G, bid); pg8::EpiF16 E{hb, INP};
          pg8::gemm_phase<pg8::EpiF16, pg8::StaticOrder>((PG8_LAS unsigned char*)lds, g.K, S, E); }
        { pg8::Gemm g{memh, WxkvT, NB * MEML, 2 * D, D}; pg8::StaticOrder S; S.init(g, G, bid); pg8::EpiF16 E{kvm, 2 * D};
          pg8::gemm_phase<pg8::EpiF16, pg8::StaticOrder>((PG8_LAS unsigned char*)lds, g.K, S, E); }
    }
    SEAM(1);
    if (IN(2)) REPS(2) { const int sub = tid >> 8, lt = tid & 255;
        for (int b0 = bid * 2; b0 < M; b0 += G * 2) b_rope(hb, rqr, rkr, nqr, ksR, kwR, cosr, sinr, cosn, sinn, b0 + sub, lt);
        for (int b0 = bid * 2; b0 < 2 * NB * 2 * 128; b0 += G * 2) b_vtrans(hb, vsT, vwT, b0 + sub, (h16*)(fl + sub * 2304), lt);
        for (int b0 = bid * 2; b0 < NB * 4 * 128; b0 += G * 2) b_rtrans(p, hb, rvT, rkzT, cosr, sinr, b0 + sub, (h16*)(fl + sub * 4224), lt);
        for (int b0 = bid * 2; b0 < NB * 4 * 16; b0 += G * 2) b_mvtrans(kvm, kvmVT, kx, b0 + sub, (h16*)(fl + sub * 2304), lt); }
    SEAM(2);
    if (IN(3)) { const int sub = tid >> 8, lt = tid & 255;
        REPS(30) for (int b0 = bid * 2; b0 < 2 * NB * 511 * 2; b0 += G * 2) b_cmp(p, hb, kcmp, vcmpT, b0 + sub, fl + sub * 2304, lt);
        const int wv = __builtin_amdgcn_readfirstlane(tid >> 6), lane = tid & 63;
        REPS(31) for (int ch = bid; ch < NB * 4 * 64; ch += G) ret_kv_unit(rkzT, rvT, kvb, ch, wv, lane); }
    SEAM(3);
    if (IN(4)) b_ret_scan(p, kvb, prevT);
    SEAM(4);
    if (IN(5)) {
        const int wv = __builtin_amdgcn_readfirstlane(tid >> 6), lane = tid & 63;
        REPS(50) { const int bg = bid & 7;
            for (int k = bid >> 3; k < T / 32; k += (G >> 3)) nsa_block_unit(hb, nqr, kcmp, vcmpT, vsT, vwT, ksR, kwR, mix, bg >> 1, bg & 1, (T / 32 - 1 - k) * 32, (LAS unsigned char*)lds, wv, lane); }
        __syncthreads();
        REPS(51) for (int ch = bid; ch < NB * 4 * 64; ch += G) ret_out_unit(p, hb, rqr, rkr, rvT, prevT, mix, ch, wv, lane);
    }
    SEAM(5);
    if (IN(6)) { pg8::Gemm g{mix, WoutT, M, D, D}; pg8::StaticOrder S; S.init(g, G, bid); pg8::EpiResF32 E{pre, p.x, D, DN_ALPHA};
        pg8::gemm_phase<pg8::EpiResF32, pg8::StaticOrder>((PG8_LAS unsigned char*)lds, g.K, S, E); }
    SEAM(6);
    if (IN(7)) b_ln(pre, p.ln1g, p.ln1b, x1, x1h);
    SEAM(7);
    if (IN(8)) { pg8::Gemm g{x1h, WxqT, M, D, D}; pg8::StaticOrder S; S.init(g, G, bid); pg8::EpiF16 E{qx, D};
        pg8::gemm_phase<pg8::EpiF16, pg8::StaticOrder>((PG8_LAS unsigned char*)lds, g.K, S, E); }
    SEAM(8);
    if (IN(9)) { const int wv = __builtin_amdgcn_readfirstlane(tid >> 6), lane = tid & 63;
        REPS(9) for (int u = bid; u < (M / 128) * 4; u += G) xattn_unit(qx, kx, kvmVT, ox, (u >> 2) * 128 + wv * 16, u & 3, lane); }
    SEAM(9);
    if (IN(10)) { pg8::Gemm g{ox, WxoT, M, D, D}; pg8::StaticOrder S; S.init(g, G, bid); pg8::EpiResF32 E{pre, x1, D, DN_ALPHA};
        pg8::gemm_phase<pg8::EpiResF32, pg8::StaticOrder>((PG8_LAS unsigned char*)lds, g.K, S, E); }
    SEAM(10);
    if (IN(11)) b_ln(pre, p.ln2g, p.ln2b, x2, x2h);
    SEAM(11);
    if (IN(12)) {
        b_router(p, x2, tope, topw, ctl + CTL_CNT);
        if (bid == 0 && tid < NQ) ctl[CTL_CNT + tid * 65 + 64] = QT;
        for (int i = bid * NTHR + tid; i < CAP; i += G * NTHR) { rowoff[i] = 0u; rowmeta[i] = (u32x2){0xffffffffu, 0u}; }
        const int sub = tid >> 8, lt = tid & 255; float* tl = fl + sub * 1088;
        REPS(121) for (int b0 = bid * 2; b0 < 65 * 768; b0 += G * 2) { const int it = b0 + sub; const int e = it / 768, r = it % 768;
            const float* wg = e < 64 ? p.w_gate + (size_t)e * D * EFF : p.ws_gate; const float* wu = e < 64 ? p.w_up + (size_t)e * D * EFF : p.ws_up; const float* wd = e < 64 ? p.w_down + (size_t)e * EFF * D : p.ws_down;
            if (r < 256) b_transpose_tile(wg, D, EFF, WguT + (size_t)e * 512 * D, EFF, r, tl, lt, 2, 0);
            else if (r < 512) b_transpose_tile(wu, D, EFF, WguT + (size_t)e * 512 * D, EFF, r - 256, tl, lt, 2, 1);
            else b_transpose_tile(wd, EFF, D, WdT + (size_t)e * D * EFF, D, r - 512, tl, lt); }
    }
    SEAM(12);
    if (IN(13)) b_scatter(ctl, tope, topw, rowoff, rowmeta, (int*)lds);
    SEAM(13);
    if (IN(14)) REPS(14) { G1Sched S{ctl, (const char*)x2h, rowoff, (const char*)WguT, G, bid}; pg8::EpiGateUp E{Hm};
        pg8::gemm_phase<pg8::EpiGateUp, G1Sched>((PG8_LAS unsigned char*)lds, D, S, E); }
    SEAM(14);
#pragma unroll 1
    for (int q = 0; q < NQ; ++q) {
        if (IN(15 + 2 * q)) { G2Sched S{ctl, (const char*)Hm, (const char*)WdT, q, G, bid}; pg8::EpiDown E{Yq, rowmeta};
            pg8::gemm_phase<pg8::EpiDown, G2Sched>((PG8_LAS unsigned char*)lds, EFF, S, E); }
        SEAM(15 + 2 * q);
        if (IN(16 + 2 * q)) b_combine(p, x2h, Yq, q);
        if (q < NQ - 1) SEAM(16 + 2 * q);
    }
#undef IN
#undef SEAM
#undef tid
}

#ifndef MK_PER_PHASE
#define MK_PER_PHASE 0
#endif
extern "C" void kernel_launch(void* const* d_in, const int* in_sizes, int n_in, void* d_out, int out_size, void* d_ws, size_t ws_size, hipStream_t stream) {
    static int grid = 0;
    if (grid == 0) {
        if (n_in != 28 || in_sizes[0] != M * D || out_size != M * D || ws_size < WS_NEED) { fprintf(stderr, "kernel_launch: unexpected shapes (n_in %d, in0 %d, out %d, ws %zu)\n", n_in, n_in > 0 ? in_sizes[0] : -1, out_size, ws_size); grid = -1; return; }
        if (hipFuncSetAttribute((const void*)mega_fwd, hipFuncAttributeMaxDynamicSharedMemorySize, LDS_BYTES) != hipSuccess) { fprintf(stderr, "kernel_launch: hipFuncSetAttribute failed\n"); grid = -1; return; }
        int dev = 0, cus = 0, per_cu = 0;
        hipGetDevice(&dev); hipDeviceGetAttribute(&cus, hipDeviceAttributeMultiprocessorCount, dev);
        if (hipOccupancyMaxActiveBlocksPerMultiprocessor(&per_cu, (const void*)mega_fwd, NTHR, LDS_BYTES) != hipSuccess || per_cu < 1) { fprintf(stderr, "kernel_launch: occupancy query failed (%d)\n", per_cu); grid = -1; return; }
        grid = cus;
    }
    if (grid < 0) return;
    Params p{};
    p.x = (const float*)d_in[0]; p.mem = (const float*)d_in[1]; p.positions = (const int*)d_in[2];
    p.w_in = (const float*)d_in[3]; p.pe_k = (const float*)d_in[4]; p.pe_v = (const float*)d_in[5];
    p.w1k = (const float*)d_in[6]; p.w2k = (const float*)d_in[7]; p.w1v = (const float*)d_in[8]; p.w2v = (const float*)d_in[9];
    p.w_out = (const float*)d_in[10]; p.ln1g = (const float*)d_in[11]; p.ln1b = (const float*)d_in[12];
    p.w_xq = (const float*)d_in[13]; p.w_xkv = (const float*)d_in[14]; p.w_xo = (const float*)d_in[15];
    p.ln2g = (const float*)d_in[16]; p.ln2b = (const float*)d_in[17]; p.w_router = (const float*)d_in[18]; p.rbias = (const float*)d_in[19];
    p.w_gate = (const float*)d_in[20]; p.w_up = (const float*)d_in[21]; p.w_down = (const float*)d_in[22];
    p.ws_gate = (const float*)d_in[23]; p.ws_up = (const float*)d_in[24]; p.ws_down = (const float*)d_in[25];
    p.ln3g = (const float*)d_in[26]; p.ln3b = (const float*)d_in[27];
    p.out = (float*)d_out; p.ws = (unsigned char*)d_ws;
    for (int i = 0; i < 4; ++i) p.lg[i] = (float)std::log(1.0 - std::pow(2.0, -5.0 - (double)i));
#if MK_PER_PHASE
    for (int ph = 0; ph < N_PHASES; ++ph) { p.ph_lo = ph; p.ph_hi = ph + 1; hipLaunchKernelGGL(mega_fwd, dim3(grid), dim3(NTHR), LDS_BYTES, stream, p); }
#else
    p.ph_lo = 0; p.ph_hi = N_PHASES;
    if (hipMemsetAsync((char*)d_ws + WS_BAR, 0, XCD_BAR_WORDS * 4, stream) != hipSuccess) { fprintf(stderr, "kernel_launch: memset failed\n"); return; }
    void* args[] = {&p};
    hipError_t e = hipLaunchCooperativeKernel((const void*)mega_fwd, dim3(grid), dim3(NTHR), args, LDS_BYTES, stream);
    if (e != hipSuccess) fprintf(stderr, "kernel_launch: cooperative launch failed: %s (grid %d)\n", hipGetErrorString(e), grid);
#endif
}
```

```cpp
#include <hip/hip_runtime.h>
#include <cstdio>
#include <cstdint>
#include <cmath>

typedef _Float16 h16;
typedef _Float16 h16x8 __attribute__((ext_vector_type(8)));
typedef _Float16 h16x2 __attribute__((ext_vector_type(2)));
typedef _Float16 h16x4 __attribute__((ext_vector_type(4)));
typedef float f32x2 __attribute__((ext_vector_type(2)));
typedef float f32x4 __attribute__((ext_vector_type(4)));
typedef unsigned u32x4 __attribute__((ext_vector_type(4)));
typedef unsigned u32x2 __attribute__((ext_vector_type(2)));

__device__ __forceinline__ int tidx() { int t = (int)threadIdx.x; asm volatile("" : "+v"(t)); return t; }

#ifndef PROBE_DBL
#define PROBE_DBL -1
#endif
#define REPS(k) for (int _rep = 0; _rep < ((PROBE_DBL) == (k) ? 2 : 1); ++_rep)

constexpr int NB = 4, T = 8192, D = 1024, M = NB * T;
constexpr int INC = 3352, INP = 3584;
constexpr int C_RQ = 0, C_RK = 512, C_RV = 1024, C_RG = 1536, C_NQ = 2048, C_NKC = 2560, C_NVC = 2688, C_NKS = 2816, C_NVS = 2944, C_NKW = 3072, C_NVW = 3200, C_NG = 3328;
constexpr int MEML = 256;
constexpr int NE = 64, EFF = 256;
constexpr float LN_EPS = 1e-5f;
constexpr float DN_ALPHA = 1.189207115002721f;
constexpr float NEGF = -1e30f;

constexpr size_t MiB = 1u << 20;
constexpr size_t WS_WIN = 1 * MiB, WS_WOUT = 8 * MiB, WS_WXQ = 10 * MiB, WS_WXO = 12 * MiB, WS_WXKV = 14 * MiB, WS_MEMH = 18 * MiB, WS_KVM = 20 * MiB;
constexpr size_t WS_KCMP = 24 * MiB, WS_VCMP = 25 * MiB, WS_TOPE = 26 * MiB, WS_TOPW = 27 * MiB;
constexpr size_t WS_XH = 32 * MiB, WS_MIX = 32 * MiB, WS_OX = 32 * MiB;
constexpr size_t WS_H = 96 * MiB, WS_NQR = 320 * MiB, WS_KVB = 352 * MiB, WS_PREV = 416 * MiB;
constexpr size_t WS_PRE = 96 * MiB, WS_X1 = 224 * MiB, WS_X1H = 352 * MiB, WS_QX = 416 * MiB, WS_X2 = 130 * MiB;
constexpr size_t WS_X2H = 32 * MiB, WS_WDT = 96 * MiB, WS_HM = 130 * MiB, WS_WGUT = 306 * MiB, WS_Y = 306 * MiB;
constexpr size_t WS_ROWOFF = 1 * MiB, WS_ROWMETA = 3 * MiB;
constexpr size_t WS_VST = 480 * MiB, WS_VWT = 488 * MiB, WS_COSR = 496 * MiB, WS_SINR = 504 * MiB, WS_COSN = 28 * MiB, WS_SINN = 29 * MiB, WS_KVMVT = 30 * MiB;
constexpr size_t WS_WC1T = 464 * MiB, WS_HID = 466 * MiB, WS_CMPOFF = 131072, WS_PEB = 131072 + 16384;
constexpr size_t WS_PREVT = 416 * MiB, WS_KSR = 448 * MiB, WS_KWR = 456 * MiB, WS_KX = 26 * MiB;
constexpr size_t DO_RQR = 0, DO_RKR = 32 * MiB, DO_RKZT = 64 * MiB, DO_RVT = 96 * MiB;
constexpr size_t WS_NEED = 512 * MiB;
constexpr int NQ = 4, QT = M / NQ, NVE = NQ * 65, CAP_TILES = 1412, CAP = CAP_TILES * 256;
constexpr size_t WS_BAR = 65536;
constexpr int CTL_CNT = 0, CTL_CUR = 512, CTL_PST = 1024, CTL_TQS = 1536, CTL_TVE = 2048;

namespace pg8 {
#define PG8_LAS __attribute__((address_space(3)))
typedef short s16x8 __attribute__((ext_vector_type(8)));
constexpr int BM = 256, BK = 64, HALF = 128, HTB = HALF * BK * 2, STAGE_BYTES = 8 * HTB, NXCD = 8, WGM = 8;
__host__ __device__ __forceinline__ int lds_byte(int r, int c) { const int st = (r >> 4) * 2 + (c >> 5), rr = r & 15, cc = c & 31, ob = rr * 64 + cc * 2; return st * 1024 + (ob ^ (((ob >> 9) & 1) << 5)); }
__host__ __device__ __forceinline__ void stage_rc(int b, int& R, int& C) { const int st = b / 1024, sb = b % 1024, swz = sb ^ (((sb >> 9) & 1) << 5); R = (st >> 1) * 16 + swz / 64; C = (st & 1) * 32 + (swz % 64) / 2; }
__host__ __device__ __forceinline__ int perm32(int rho) { const int n = rho >> 4, i = rho & 15; return 8 * (i >> 2) + 4 * n + (i & 3); }
struct Unit { int pm, pn; const char* A; const char* B; const unsigned* gat; };
struct Gemm { const h16* A; const h16* Bt; int M, N, K; };
struct StaticOrder {
    int nM, nN, nwg, G, c; const char* A; const char* B; size_t tstep;
    __device__ void init(const Gemm& g, int G_, int c_) { nM = g.M / BM; nN = g.N / BM; nwg = nM * nN; G = G_; c = c_; A = (const char*)g.A; B = (const char*)g.Bt; tstep = (size_t)BM * g.K * 2; }
    __device__ bool next(int i, Unit& u) const {
        const long L = (long)i * G + c; if (L >= nwg) return false;
        int wgid = (int)L; { const int q = nwg / NXCD, r = nwg % NXCD, xcd = wgid % NXCD, off = wgid / NXCD; wgid = (xcd < r ? xcd * (q + 1) : r * (q + 1) + (xcd - r) * q) + off; }
        const int nig = WGM * nN, gid = wgid / nig, fm = gid * WGM, gsz = (nM - fm) < WGM ? (nM - fm) : WGM;
        u.pm = fm + ((wgid % nig) % gsz); u.pn = (wgid % nig) / gsz; u.A = A + (size_t)u.pm * tstep; u.B = B + (size_t)u.pn * tstep; u.gat = nullptr; return true;
    }
};
__device__ __forceinline__ unsigned cvt_pk_f16(float lo, float hi) { f32x2 v = {lo, hi}; h16x2 h = __builtin_convertvector(v, h16x2); return __builtin_bit_cast(unsigned, h); }

struct EpiF16 {
    static constexpr bool PERM = true;
    h16* O; int ldc;
    __device__ __forceinline__ void operator()(const f32x4 (&acc)[2][2][4][2], const Unit& u, int wr, int wc, int fr, int fq) const {
        const int row0 = u.pm * BM + wr * 64 + fr; const int col0 = u.pn * BM + wc * 32 + 8 * fq;
#pragma unroll
        for (int ai = 0; ai < 2; ++ai)
#pragma unroll
            for (int m = 0; m < 4; ++m) { h16* rowp = O + (size_t)(row0 + ai * HALF + m * 16) * ldc + col0;
#pragma unroll
                for (int bj = 0; bj < 2; ++bj) { const f32x4 v0 = acc[ai][bj][m][0], v1 = acc[ai][bj][m][1];
                    *(h16x8*)(rowp + bj * HALF) = __builtin_convertvector(__builtin_shufflevector(v0, v1, 0, 1, 2, 3, 4, 5, 6, 7), h16x8); } }
    }
};
struct EpiResF32 {
    static constexpr bool PERM = false;
    float* C; const float* R; int ldc; float alpha;
    __device__ __forceinline__ void operator()(const f32x4 (&acc)[2][2][4][2], const Unit& u, int wr, int wc, int fr, int fq) const {
        const int row0 = u.pm * BM + wr * 64 + fr, col0 = u.pn * BM + wc * 32 + 4 * fq;
#pragma unroll
        for (int ai = 0; ai < 2; ++ai)
#pragma unroll
            for (int m = 0; m < 4; ++m) { const size_t off = (size_t)(row0 + ai * HALF + m * 16) * ldc + col0;
#pragma unroll
                for (int bj = 0; bj < 2; ++bj)
#pragma unroll
                    for (int n = 0; n < 2; ++n) { const f32x4 r = *(const f32x4*)(R + off + bj * HALF + n * 16); *(f32x4*)(C + off + bj * HALF + n * 16) = r * alpha + acc[ai][bj][m][n]; } }
    }
};
struct EpiCmp1 {
    static constexpr bool PERM = true;
    h16* O; const float* peb;
    __device__ __forceinline__ void operator()(const f32x4 (&acc)[2][2][4][2], const Unit& u, int wr, int wc, int fr, int fq) const {
        const int row0 = u.pm * BM + wr * 64 + fr; const int col0 = wc * 32 + 8 * fq;
#pragma unroll
        for (int bj = 0; bj < 2; ++bj) { const f32x4 b0 = *(const f32x4*)(peb + col0 + bj * HALF), b1 = *(const f32x4*)(peb + col0 + bj * HALF + 4);
#pragma unroll
            for (int ai = 0; ai < 2; ++ai)
#pragma unroll
                for (int m = 0; m < 4; ++m) { f32x4 v0 = acc[ai][bj][m][0] + b0, v1 = acc[ai][bj][m][1] + b1;
#pragma unroll
                    for (int r = 0; r < 4; ++r) { v0[r] = v0[r] / (1.f + __expf(-v0[r])); v1[r] = v1[r] / (1.f + __expf(-v1[r])); }
                    *(h16x8*)(O + (size_t)(row0 + ai * HALF + m * 16) * 256 + col0 + bj * HALF) = __builtin_convertvector(__builtin_shufflevector(v0, v1, 0, 1, 2, 3, 4, 5, 6, 7), h16x8); } }
    }
};
struct EpiGateUp {
    static constexpr bool PERM = true;
    h16* H;
    __device__ __forceinline__ void operator()(const f32x4 (&acc)[2][2][4][2], const Unit& u, int wr, int wc, int fr, int fq) const {
        const int row0 = u.pm * BM + wr * 64 + fr; const int col0 = u.pn * 128 + wc * 16 + 4 * fq;
#pragma unroll
        for (int ai = 0; ai < 2; ++ai)
#pragma unroll
            for (int m = 0; m < 4; ++m) { h16* rowp = H + (size_t)(row0 + ai * HALF + m * 16) * 256 + col0;
#pragma unroll
                for (int bj = 0; bj < 2; ++bj) { const f32x4 v0 = acc[ai][bj][m][0], v1 = acc[ai][bj][m][1];
                    const float h0 = v0[0] / (1.f + __expf(-v0[0])) * v0[1], h1 = v0[2] / (1.f + __expf(-v0[2])) * v0[3];
                    const float h2 = v1[0] / (1.f + __expf(-v1[0])) * v1[1], h3 = v1[2] / (1.f + __expf(-v1[2])) * v1[3];
                    *(h16x4*)(rowp + bj * 64) = __builtin_convertvector((f32x4){h0, h1, h2, h3}, h16x4); } }
    }
};
struct EpiDown {
    static constexpr bool PERM = true;
    h16* Y; const u32x2* rowmeta;
    __device__ __forceinline__ void operator()(const f32x4 (&acc)[2][2][4][2], const Unit& u, int wr, int wc, int fr, int fq) const {
        const int row0 = u.pm * BM + wr * 64 + fr; const int col0 = u.pn * BM + wc * 32 + 8 * fq;
#pragma unroll
        for (int ai = 0; ai < 2; ++ai)
#pragma unroll
            for (int m = 0; m < 4; ++m) { const u32x2 md = rowmeta[row0 + ai * HALF + m * 16]; const int slot = (int)md.x; const float w8 = __uint_as_float(md.y);
                if (slot >= 0) { h16* rowp = Y + (size_t)slot * 1024 + col0;
#pragma unroll
                    for (int bj = 0; bj < 2; ++bj) { const f32x4 v0 = acc[ai][bj][m][0] * w8, v1 = acc[ai][bj][m][1] * w8;
                        *(h16x8*)(rowp + bj * HALF) = __builtin_convertvector(__builtin_shufflevector(v0, v1, 0, 1, 2, 3, 4, 5, 6, 7), h16x8); } }
                asm volatile("" ::: "memory"); }
    }
};

template <class Epi, class Sched>
__device__ __forceinline__ void gemm_phase(PG8_LAS unsigned char* lds, const int K, const Sched& S, const Epi& E, const size_t kstepA = (size_t)(BK * 2)) {
    const int tid = tidx(), wid = __builtin_amdgcn_readfirstlane(tid >> 6), lane = tid & 63, wr = wid >> 2, wc = wid & 3, fr = lane & 15, fq = lane >> 4;
    const int nt = K / BK;
    int R0, C0; stage_rc(tid * 16, R0, C0);
    const unsigned cb2 = (unsigned)C0 * 2u;
    unsigned voffB[2];
#pragma unroll
    for (int i = 0; i < 2; ++i) { const int R = R0 + 64 * i; const int Rb = Epi::PERM ? ((R & ~31) + perm32(R & 31)) : R; voffB[i] = (unsigned)(Rb * K) * 2u + cb2; }
    const size_t kstep = (size_t)(BK * 2);
    const size_t hstep = (size_t)HALF * K * 2;
    const unsigned ldsw = (unsigned)wid * 1024u;
    const int aoff = lds_byte(wr * 64 + fr, fq * 8), boff = lds_byte(wc * 32 + fr, fq * 8);
#define PG8_MKVA(u, va) do { _Pragma("unroll") for (int _h = 0; _h < 2; ++_h) _Pragma("unroll") for (int _i = 0; _i < 2; ++_i) { const int _r = _h * HALF + R0 + 64 * _i; \
        (va)[_h][_i] = ((u).gat ? (u).gat[_r] : (unsigned)(_r * K) * 2u) + cb2; } } while (0)
#define PG8_SA(b, h) (((b) * 2 + (h)) * HTB)
#define PG8_SB(b, h) ((4 + (b) * 2 + (h)) * HTB)
#define PG8_STAGE(bufoff, gbase, voff) do { _Pragma("unroll") for (int _i = 0; _i < 2; ++_i) \
        __builtin_amdgcn_global_load_lds((const unsigned*)((const char*)(gbase) + (voff)[_i]), (PG8_LAS unsigned*)(lds + (bufoff) + ldsw + _i * 8192), 16, 0, 0); } while (0)
#define PG8_LDA(dst, b, h) do { _Pragma("unroll") for (int m = 0; m < 4; ++m) _Pragma("unroll") for (int k = 0; k < 2; ++k) dst[m][k] = *(const PG8_LAS s16x8*)(lds + PG8_SA(b, h) + aoff + m * 2048 + k * 1024); } while (0)
#define PG8_LDB(dst, b, h) do { _Pragma("unroll") for (int n = 0; n < 2; ++n) _Pragma("unroll") for (int k = 0; k < 2; ++k) dst[n][k] = *(const PG8_LAS s16x8*)(lds + PG8_SB(b, h) + boff + n * 2048 + k * 1024); } while (0)
#define PG8_MMA(ai, bj, At, Bt) do { __builtin_amdgcn_s_setprio(1); _Pragma("unroll") for (int m = 0; m < 4; ++m) _Pragma("unroll") for (int n = 0; n < 2; ++n) _Pragma("unroll") for (int k = 0; k < 2; ++k) \
        acc[ai][bj][m][n] = __builtin_amdgcn_mfma_f32_16x16x32_f16(__builtin_bit_cast(h16x8, Bt[n][k]), __builtin_bit_cast(h16x8, At[m][k]), acc[ai][bj][m][n], 0, 0, 0); __builtin_amdgcn_s_setprio(0); } while (0)
#define PG8_WAIT_V(n) asm volatile("s_waitcnt vmcnt(" #n ")" ::: "memory")
#define PG8_WAIT_L(n) asm volatile("s_waitcnt lgkmcnt(" #n ")" ::: "memory")
#define PG8_BAR __builtin_amdgcn_s_barrier()
#define PG8_SCHED __builtin_amdgcn_sched_barrier(0)
    Unit cur, nxt; int ui = 0;
    if (!S.next(0, cur)) return;
    unsigned va[2][2];
    PG8_MKVA(cur, va);
    f32x4 acc[2][2][4][2];
#pragma unroll
    for (int a = 0; a < 2; ++a)
#pragma unroll
        for (int b = 0; b < 2; ++b)
#pragma unroll
            for (int m = 0; m < 4; ++m)
#pragma unroll
                for (int n = 0; n < 2; ++n) acc[a][b][m][n] = (f32x4){0.f, 0.f, 0.f, 0.f};
    s16x8 At[4][2], B0[2][2], B1[2][2];
    const char* cA = cur.A; const char* cB = cur.B;
    {
        PG8_STAGE(PG8_SB(0, 0), cB, voffB); PG8_STAGE(PG8_SB(0, 1), cB + hstep, voffB); PG8_STAGE(PG8_SA(0, 0), cA, va[0]); PG8_STAGE(PG8_SA(0, 1), cA, va[1]);
        if (wr == 1) PG8_BAR;
        PG8_WAIT_V(2); PG8_BAR;
        PG8_STAGE(PG8_SB(1, 0), cB + kstep, voffB); PG8_STAGE(PG8_SA(1, 0), cA + kstepA, va[0]); PG8_STAGE(PG8_SB(1, 1), cB + hstep + kstep, voffB);
        PG8_WAIT_V(6); PG8_BAR;
    }
    for (;;) {
        const bool has_next = S.next(ui + 1, nxt);
        const char* nA = has_next ? nxt.A : cA; const char* nB = has_next ? nxt.B : cB;
#pragma unroll 1
        for (int t = 0; t < nt; t += 2) {
            const bool last = (t == nt - 2);
            const char* a1 = cA + (size_t)(t + 1) * kstepA;
            const char* a2 = last ? nA : cA + (size_t)(t + 2) * kstepA; const char* b2 = last ? nB : cB + (size_t)(t + 2) * kstep;
            const char* a3 = a2 + kstepA; const char* b3 = b2 + kstep;
            PG8_LDB(B0, 0, 0); PG8_LDB(B1, 0, 1); PG8_SCHED; PG8_LDA(At, 0, 0); PG8_STAGE(PG8_SA(1, 1), a1, va[1]);
            if (last && has_next) { PG8_MKVA(nxt, va); }
            PG8_WAIT_V(8); PG8_WAIT_L(0); PG8_BAR; PG8_MMA(0, 0, At, B0); PG8_MMA(0, 1, At, B1); PG8_BAR; PG8_SCHED;
            PG8_LDA(At, 0, 1); PG8_STAGE(PG8_SB(0, 0), b2, voffB); PG8_STAGE(PG8_SB(0, 1), b2 + hstep, voffB); PG8_STAGE(PG8_SA(0, 0), a2, va[0]);
            PG8_WAIT_V(8); PG8_WAIT_L(0); PG8_BAR; PG8_MMA(1, 0, At, B0); PG8_MMA(1, 1, At, B1); PG8_BAR; PG8_SCHED;
            PG8_LDB(B0, 1, 0); PG8_LDB(B1, 1, 1); PG8_SCHED; PG8_LDA(At, 1, 0); PG8_STAGE(PG8_SA(0, 1), a2, va[1]);
            PG8_WAIT_V(8); PG8_WAIT_L(0); PG8_BAR; PG8_MMA(0, 0, At, B0); PG8_MMA(0, 1, At, B1); PG8_BAR; PG8_SCHED;
            PG8_LDA(At, 1, 1); PG8_STAGE(PG8_SB(1, 0), b3, voffB); PG8_STAGE(PG8_SB(1, 1), b3 + hstep, voffB); PG8_STAGE(PG8_SA(1, 0), a3, va[0]);
            PG8_WAIT_V(8); PG8_WAIT_L(0); PG8_BAR; PG8_MMA(1, 0, At, B0); PG8_MMA(1, 1, At, B1); PG8_BAR; PG8_SCHED;
        }
        if (wr == 0) PG8_BAR;
        E(acc, cur, wr, wc, fr, fq);
        if (!has_next) break;
#pragma unroll
        for (int a = 0; a < 2; ++a)
#pragma unroll
            for (int b = 0; b < 2; ++b)
#pragma unroll
                for (int m = 0; m < 4; ++m)
#pragma unroll
                    for (int n = 0; n < 2; ++n) acc[a][b][m][n] = (f32x4){0.f, 0.f, 0.f, 0.f};
        cur = nxt; cA = nA; cB = nB; ++ui;
        if (wr == 1) PG8_BAR;
    }
    PG8_WAIT_V(0);
    PG8_BAR;
#undef PG8_MKVA
#undef PG8_SA
#undef PG8_SB
#undef PG8_STAGE
#undef PG8_LDA
#undef PG8_LDB
#undef PG8_MMA
#undef PG8_WAIT_V
#undef PG8_WAIT_L
#undef PG8_BAR
#undef PG8_SCHED
}
}


#include <hip/hip_cooperative_groups.h>
namespace cg = cooperative_groups;
constexpr int NTHR = 512;
constexpr int LDS_BYTES = 147456;
#define LAS __attribute__((address_space(3)))

struct Params {
    const float *x, *mem; const int* positions;
    const float *w_in, *pe_k, *pe_v, *w1k, *w2k, *w1v, *w2v, *w_out, *ln1g, *ln1b, *w_xq, *w_xkv, *w_xo, *ln2g, *ln2b, *w_router, *rbias, *w_gate, *w_up, *w_down, *ws_gate, *ws_up, *ws_down, *ln3g, *ln3b;
    float* out; unsigned char* ws;
    float lg[4];
    int ph_lo, ph_hi;
};

__device__ __forceinline__ float wave_sum(float v) {
#pragma unroll
    for (int o = 1; o < 64; o <<= 1) v += __shfl_xor(v, o);
    return v;
}
__device__ __forceinline__ float wave_max(float v) {
#pragma unroll
    for (int o = 1; o < 64; o <<= 1) v = fmaxf(v, __shfl_xor(v, o));
    return v;
}
__device__ __forceinline__ float siluf(float v) { return v / (1.f + __expf(-v)); }
__device__ __forceinline__ float sigmf(float v) { return 1.f / (1.f + __expf(-v)); }

__device__ __forceinline__ void b_transpose_tile(const float* __restrict__ W, int K, int N, h16* __restrict__ WT, int Npad, int tile, float* tl, int lt, int rs = 1, int ro = 0) {
    const int ntn = Npad / 32; const int n0 = (tile % ntn) * 32, k0 = (tile / ntn) * 32, tx = lt & 31, ty = lt >> 5;
    for (int i = ty; i < 32; i += 8) { const int k = k0 + i, n = n0 + tx; tl[i * 33 + tx] = (n < N) ? W[(size_t)k * N + n] : 0.f; }
    __syncthreads();
    for (int i = ty; i < 32; i += 8) { const int n = n0 + i, k = k0 + tx; WT[(size_t)(n * rs + ro) * K + k] = (h16)tl[tx * 33 + i]; }
    __syncthreads();
}
__device__ __forceinline__ void b_cvt(const float* __restrict__ x, h16* __restrict__ o, size_t n4) {
    for (size_t i = (size_t)blockIdx.x * NTHR + tidx(); i < n4; i += (size_t)gridDim.x * NTHR) {
        const f32x4 v = ((const f32x4*)x)[i]; ((h16x4*)o)[i] = __builtin_convertvector(v, h16x4); }
}

__device__ __forceinline__ void b_tables(const int* __restrict__ positions, float* __restrict__ cosr, float* __restrict__ sinr, float* __restrict__ cosn, float* __restrict__ sinn) {
    for (int idx = blockIdx.x * NTHR + tidx(); idx < M * 72; idx += gridDim.x * NTHR) {
        const int m = idx / 72, j = idx % 72; const float pos = (float)positions[m];
        const float inv = j < 64 ? (float)pow(10000.0, -(double)j / 64.0) : (float)pow(500000.0, -(double)(j - 64) / 8.0);
        const float ang = pos * inv; double sd, cd; sincos((double)ang, &sd, &cd);
        if (j < 64) { cosr[(size_t)m * 64 + j] = (float)cd; sinr[(size_t)m * 64 + j] = (float)sd; } else { cosn[(size_t)m * 8 + j - 64] = (float)cd; sinn[(size_t)m * 8 + j - 64] = (float)sd; }
    }
}
__device__ __forceinline__ void b_rope(const h16* __restrict__ h, h16* __restrict__ rqr, h16* __restrict__ rkr, h16* __restrict__ nqr, h16* __restrict__ ksR, h16* __restrict__ kwR, const float* __restrict__ cosr, const float* __restrict__ sinr,
                                       const float* __restrict__ cosn, const float* __restrict__ sinn, int m, int j) {
    const h16* hr = h + (size_t)m * INP; const int bb = m >> 13, t = m & (T - 1);
    {   const int hd = j >> 6, jj = j & 63; const float c = cosr[(size_t)m * 64 + jj], s = sinr[(size_t)m * 64 + jj]; const size_t ro = ((size_t)(bb * 4 + hd) * T + t) * 128;
        const int o1 = hd * 128 + jj, o2 = o1 + 64;
        const float q1 = (float)hr[C_RQ + o1], q2 = (float)hr[C_RQ + o2];
        rqr[ro + jj] = (h16)(q1 * c - q2 * s); rqr[ro + jj + 64] = (h16)(q2 * c + q1 * s);
        const float k1 = (float)hr[C_RK + o1], k2 = (float)hr[C_RK + o2]; const float sc = 0.08838834764831845f;
        rkr[ro + jj] = (h16)((k1 * c - k2 * s) * sc); rkr[ro + jj + 64] = (h16)((k2 * c + k1 * s) * sc);
    }
    if (j < 64 + 16 + 16) {
        const int jj = j & 7; const float c = cosn[(size_t)m * 8 + jj], s = sinn[(size_t)m * 8 + jj];
        if (j < 64) { const int hd = j >> 3; const int o1 = hd * 64 + jj, o2 = o1 + 8;
            const float q1 = (float)hr[C_NQ + o1], q2 = (float)hr[C_NQ + o2];
            nqr[(size_t)m * 512 + o1] = (h16)(q1 * c - q2 * s); nqr[(size_t)m * 512 + o2] = (h16)(q2 * c + q1 * s);
        } else { const int jx = j - 64; const int which = jx >> 4, g = (jx >> 3) & 1; const int base = (which ? C_NKW : C_NKS) + g * 64 + jj;
            const float k1 = (float)hr[base], k2 = (float)hr[base + 8];
            h16* dst = (which ? kwR : ksR) + (((size_t)((bb * 2 + g) * 128 + (t >> 6)) * 64 + (t & 63)) * 64); dst[jj] = (h16)(k1 * c - k2 * s); dst[jj + 8] = (h16)(k2 * c + k1 * s); }
    }
    if (j >= 128 && j < 128 + 96) { const int jx = j - 128; const int which = jx / 48, r = jx % 48, g = r / 24, d = 16 + 2 * (r % 24);
        const int base = (which ? C_NKW : C_NKS) + g * 64 + d; h16* dst = (which ? kwR : ksR) + (((size_t)((bb * 2 + g) * 128 + (t >> 6)) * 64 + (t & 63)) * 64);
        dst[d] = hr[base]; dst[d + 1] = hr[base + 1]; }
    for (int i = j; i < 8 * 48; i += 256) { const int hd = i / 48, d = 16 + i % 48; nqr[(size_t)m * 512 + hd * 64 + d] = hr[C_NQ + hd * 64 + d]; }
}
__device__ __forceinline__ void b_rtrans(const Params& p, const h16* __restrict__ h, h16* __restrict__ rvT, h16* __restrict__ rkzT, const float* __restrict__ cosr, const float* __restrict__ sinr, int item, h16* sl, int lt) {
    int id = item; const int tt = id & 127; id >>= 7; const int hd = id & 3; const int b = id >> 2; const int bh = b * 4 + hd; const float lg = p.lg[hd];
    for (int i = lt; i < 64 * 128; i += 256) { const int t = i >> 7, e = i & 127; sl[t * 130 + e] = h[(size_t)(b * T + tt * 64 + t) * INP + C_RV + hd * 128 + e]; }
    __syncthreads();
    for (int i = lt; i < 64 * 128; i += 256) { const int e = i >> 6, t = i & 63; rvT[((size_t)(bh * 64 + (tt >> 1)) * 128 + e) * 128 + (tt & 1) * 64 + t] = sl[t * 130 + e]; }
    __syncthreads();
    for (int i = lt; i < 64 * 64; i += 256) { const int t = i >> 6, jj = i & 63; const size_t m = (size_t)b * T + tt * 64 + t;
        const float c = cosr[m * 64 + jj], s = sinr[m * 64 + jj]; const float k1 = (float)h[m * INP + C_RK + hd * 128 + jj], k2 = (float)h[m * INP + C_RK + hd * 128 + jj + 64];
        const float z = 0.08838834764831845f * __expf(lg * (float)(127 - ((tt * 64 + t) & 127)));
        sl[t * 130 + jj] = (h16)((k1 * c - k2 * s) * z); sl[t * 130 + jj + 64] = (h16)((k2 * c + k1 * s) * z); }
    __syncthreads();
    for (int i = lt; i < 64 * 128; i += 256) { const int d = i >> 6, t = i & 63; rkzT[((size_t)(bh * 64 + (tt >> 1)) * 128 + d) * 128 + (tt & 1) * 64 + t] = sl[t * 130 + d]; }
    __syncthreads();
}
__device__ __forceinline__ void b_mvtrans(const h16* __restrict__ kvm, h16* __restrict__ kvmVT, h16* __restrict__ kx, int item, h16* sl, int lt) {
    int id = item; const int kt = id & 3; id >>= 2; const int dtl = id & 3; id >>= 2; const int hh = id & 3; const int b = id >> 2;
    for (int i = lt; i < 64 * 64; i += 256) { const int k = i >> 6, d = i & 63; sl[k * 66 + d] = kvm[(size_t)(b * MEML + kt * 64 + k) * 2048 + 1024 + hh * 256 + dtl * 64 + d];
        kx[((size_t)(b * 4 + hh) * MEML + kt * 64 + k) * 256 + dtl * 64 + d] = kvm[(size_t)(b * MEML + kt * 64 + k) * 2048 + hh * 256 + dtl * 64 + d]; }
    __syncthreads();
    for (int i = lt; i < 64 * 64; i += 256) { const int d = i >> 6, k = i & 63; kvmVT[(size_t)((b * 4 + hh) * 256 + dtl * 64 + d) * MEML + kt * 64 + k] = sl[k * 66 + d]; }
    __syncthreads();
}

struct CmpSched {
    const char* hbase; const unsigned* cmpoff; const char* Wc1T; int c;
    __device__ bool next(int i, pg8::Unit& u) const {
        if (i > 0 || c >= 32) return false; const int kv = c >> 4, rt = c & 15;
        u.pm = kv * 16 + rt; u.pn = 0; u.A = hbase + (size_t)(kv ? C_NVC : C_NKC) * 2; u.gat = cmpoff + rt * 256; u.B = Wc1T + (size_t)kv * 256 * 2048 * 2; return true; }
};
__device__ __forceinline__ void b_cmp2(const Params& p, const h16* __restrict__ hid, h16* __restrict__ kcmp, h16* __restrict__ vcmpT) {
    const int lane = tidx() & 63;
    for (int r = blockIdx.x * 8 + (tidx() >> 6); r < 2 * 4096; r += gridDim.x * 8) {
        const int kv = r >> 12, rr = r & 4095, g = rr & 1, c = (rr >> 1) & 511, b = rr >> 10;
        const float* w2 = kv ? p.w2v : p.w2k; const h16* hr = hid + (size_t)r * 256; float acc = 0.f;
        for (int j = 0; j < 256; j += 8) { const h16x8 hv = *(const h16x8*)(hr + j);
#pragma unroll
            for (int x = 0; x < 8; ++x) acc += (float)hv[x] * w2[(j + x) * 64 + lane]; }
        if (c == 511) acc = 0.f;
        if (kv == 0) kcmp[((size_t)(b * 2 + g) * 512 + c) * 64 + lane] = (h16)acc;
        else vcmpT[(((size_t)(b * 2 + g) * 8 + (c >> 6)) * 64 + lane) * 64 + (c & 63)] = (h16)acc;
    }
}
__device__ __forceinline__ void b_vtrans(const h16* __restrict__ h, h16* __restrict__ vsT, h16* __restrict__ vwT, int item, h16* sl, int lt) {
    int id = item; const int tt = id & 127; id >>= 7; const int g = id & 1; id >>= 1; const int b = id & 3; const int which = id >> 2;
    const int col = (which ? C_NVW : C_NVS) + g * 64; h16* dst = (which ? vwT : vsT) + (size_t)((b * 2 + g) * 128 + tt) * 4096;
    for (int i = lt; i < 64 * 64; i += 256) { const int t = i >> 6, d = i & 63; sl[t * 66 + d] = h[(size_t)(b * T + tt * 64 + t) * INP + col + d]; }
    __syncthreads();
    for (int i = lt; i < 64 * 64; i += 256) { const int d = i >> 6, t = i & 63; dst[d * 64 + t] = sl[t * 66 + d]; }
    __syncthreads();
}

__device__ __forceinline__ void ret_kv_unit(const h16* __restrict__ rkzT, const h16* __restrict__ rvT, float* __restrict__ kvT, int chunk, int w, int lane) {
    const int i = lane & 15, kg = lane >> 4; const int bh = chunk >> 6, n = chunk & 63;
    h16x8 a[4];
#pragma unroll
    for (int ks = 0; ks < 4; ++ks) a[ks] = *(const h16x8*)(rkzT + ((size_t)chunk * 128 + 16 * w + i) * 128 + 32 * ks + 8 * kg);
#pragma unroll
    for (int et = 0; et < 8; ++et) { f32x4 acc = {0.f, 0.f, 0.f, 0.f};
#pragma unroll
        for (int ks = 0; ks < 4; ++ks) { const h16x8 bq = *(const h16x8*)(rvT + ((size_t)chunk * 128 + 16 * et + i) * 128 + 32 * ks + 8 * kg); acc = __builtin_amdgcn_mfma_f32_16x16x32_f16(a[ks], bq, acc, 0, 0, 0); }
        *(f32x4*)(kvT + ((size_t)chunk * 128 + 16 * et + i) * 128 + 16 * w + 4 * kg) = acc; }
}
__device__ __forceinline__ void b_ret_scan(const Params& p, const float* __restrict__ kvT, h16* __restrict__ prevT) {
    for (int gid = blockIdx.x * NTHR + tidx(); gid < 16 * 16384; gid += gridDim.x * NTHR) {
        const int de = gid & 16383, bh = gid >> 14; const float cd = __expf(p.lg[bh & 3] * 128.f);
        float st = 0.f;
        for (int n = 0; n < 64; ++n) { const size_t o = ((size_t)(bh * 64 + n) << 14) + de; prevT[o] = (h16)st; st = st * cd + kvT[o]; }
    }
}
__device__ __forceinline__ void ret_out_unit(const Params& p, const h16* __restrict__ h, const h16* __restrict__ rqr, const h16* __restrict__ rkr, const h16* __restrict__ rvT, const h16* __restrict__ prevT,
                                             h16* __restrict__ mix, int chunk, int w, int lane) {
    const int i = lane & 15, kg = lane >> 4; const int bh = chunk >> 6, n = chunk & 63, b = bh >> 2, hd = bh & 3; const float lg = p.lg[hd];
    const int qi = 16 * w + i; const size_t m = (size_t)b * T + n * 128 + qi;
    h16x8 qf[4];
#pragma unroll
    for (int ks = 0; ks < 4; ++ks) qf[ks] = *(const h16x8*)(rqr + ((size_t)bh * T + n * 128 + qi) * 128 + 32 * ks + 8 * kg);
    f32x4 inner[8], cross[8];
#pragma unroll
    for (int et = 0; et < 8; ++et) { inner[et] = (f32x4){0.f, 0.f, 0.f, 0.f}; cross[et] = (f32x4){0.f, 0.f, 0.f, 0.f}; }
    for (int gq = 0; gq < 2; ++gq) {
        if (64 * gq > 16 * w + 15) break;
        f32x4 s[4];
#pragma unroll
        for (int tl = 0; tl < 4; ++tl) { const int ko = 32 * (tl >> 1) + 8 * (i >> 2) + 4 * (tl & 1) + (i & 3); const h16* kp = rkr + ((size_t)bh * T + n * 128 + 64 * gq + ko) * 128 + 8 * kg;
            f32x4 acc = {0.f, 0.f, 0.f, 0.f};
#pragma unroll
            for (int ks = 0; ks < 4; ++ks) acc = __builtin_amdgcn_mfma_f32_16x16x32_f16(*(const h16x8*)(kp + 32 * ks), qf[ks], acc, 0, 0, 0);
            s[tl] = acc; }
        h16x8 pf[2];
#pragma unroll
        for (int tl = 0; tl < 4; ++tl)
#pragma unroll
            for (int r = 0; r < 4; ++r) { const int j = 64 * gq + 32 * (tl >> 1) + 8 * kg + 4 * (tl & 1) + r; const float v = (j <= qi) ? s[tl][r] * __expf(lg * (float)(qi - j)) : 0.f; pf[tl >> 1][4 * (tl & 1) + r] = (h16)v; }
#pragma unroll
        for (int et = 0; et < 8; ++et)
#pragma unroll
            for (int s2 = 0; s2 < 2; ++s2) { const h16x8 a = *(const h16x8*)(rvT + ((size_t)chunk * 128 + 16 * et + i) * 128 + 64 * gq + 32 * s2 + 8 * kg); inner[et] = __builtin_amdgcn_mfma_f32_16x16x32_f16(a, pf[s2], inner[et], 0, 0, 0); }
    }
#pragma unroll
    for (int et = 0; et < 8; ++et)
#pragma unroll
        for (int ks = 0; ks < 4; ++ks) { const h16x8 a = *(const h16x8*)(prevT + ((size_t)chunk * 128 + 16 * et + i) * 128 + 32 * ks + 8 * kg); cross[et] = __builtin_amdgcn_mfma_f32_16x16x32_f16(a, qf[ks], cross[et], 0, 0, 0); }
    const float xi = __expf(lg * (float)(qi + 1));
    float sm = 0.f;
#pragma unroll
    for (int et = 0; et < 8; ++et) { inner[et] = inner[et] + cross[et] * xi; sm += (inner[et][0] + inner[et][1]) + (inner[et][2] + inner[et][3]); }
    sm += __shfl_xor(sm, 16); sm += __shfl_xor(sm, 32);
    const float mu = sm * (1.f / 128.f); float sq = 0.f;
#pragma unroll
    for (int et = 0; et < 8; ++et) { inner[et] = inner[et] - mu; sq += (inner[et][0] * inner[et][0] + inner[et][1] * inner[et][1]) + (inner[et][2] * inner[et][2] + inner[et][3] * inner[et][3]); }
    sq += __shfl_xor(sq, 16); sq += __shfl_xor(sq, 32);
    const float rstd = rsqrtf(sq * (1.f / 128.f) + LN_EPS);
#pragma unroll
    for (int et = 0; et < 8; ++et) { const int e = 16 * et + 4 * kg; const h16x4 gv = *(const h16x4*)(h + m * INP + C_RG + hd * 128 + e);
        f32x4 o;
#pragma unroll
        for (int r = 0; r < 4; ++r) o[r] = siluf((float)gv[r]) * inner[et][r] * rstd;
        *(h16x4*)(mix + m * D + hd * 128 + e) = __builtin_convertvector(o, h16x4); }
}

struct AttSt { float m, l; f32x4 o[4]; };
struct KFrag { h16x8 a[4][2]; };
struct VFrag { h16x8 a[4][2]; };
__device__ __forceinline__ void ldk(KFrag& k, const h16* __restrict__ Kb, int pitchK, int i, int kg) {
#pragma unroll
    for (int tl = 0; tl < 4; ++tl) { const int ko = 32 * (tl >> 1) + 8 * (i >> 2) + 4 * (tl & 1) + (i & 3); const h16* kp = Kb + (size_t)ko * pitchK + 8 * kg;
        k.a[tl][0] = *(const h16x8*)kp; k.a[tl][1] = *(const h16x8*)(kp + 32); }
}
__device__ __forceinline__ void ldv(VFrag& v, const h16* __restrict__ VTb, int vstride, int i, int kg) {
#pragma unroll
    for (int dt = 0; dt < 4; ++dt)
#pragma unroll
        for (int s2 = 0; s2 < 2; ++s2) v.a[dt][s2] = *(const h16x8*)(VTb + (size_t)(16 * dt + i) * vstride + 32 * s2 + 8 * kg);
}
template <class MaskF>
__device__ __forceinline__ void att_scores(f32x4 (&s)[4], const KFrag& k, const h16x8 (&qf)[2], int kg, MaskF valid) {
#pragma unroll
    for (int tl = 0; tl < 4; ++tl) { f32x4 z = {0.f, 0.f, 0.f, 0.f}; z = __builtin_amdgcn_mfma_f32_16x16x32_f16(k.a[tl][0], qf[0], z, 0, 0, 0); s[tl] = __builtin_amdgcn_mfma_f32_16x16x32_f16(k.a[tl][1], qf[1], z, 0, 0, 0); }
#pragma unroll
    for (int tl = 0; tl < 4; ++tl)
#pragma unroll
        for (int r = 0; r < 4; ++r) { const int ko = 32 * (tl >> 1) + 8 * kg + 4 * (tl & 1) + r; s[tl][r] = valid(ko) ? s[tl][r] * 0.125f : -INFINITY; }
}
__device__ __forceinline__ void att_pv(f32x4 (&o)[4], const f32x4 (&pv)[4], const VFrag& v) {
    h16x8 pf[2];
#pragma unroll
    for (int s2 = 0; s2 < 2; ++s2)
#pragma unroll
        for (int j = 0; j < 8; ++j) pf[s2][j] = (h16)pv[2 * s2 + (j >> 2)][j & 3];
#pragma unroll
    for (int dt = 0; dt < 4; ++dt)
#pragma unroll
        for (int s2 = 0; s2 < 2; ++s2) o[dt] = __builtin_amdgcn_mfma_f32_16x16x32_f16(v.a[dt][s2], pf[s2], o[dt], 0, 0, 0);
}
template <class MaskF>
__device__ __forceinline__ void att_tile(AttSt& st, const KFrag& k, const VFrag& v, const h16x8 (&qf)[2], int kg, MaskF valid) {
    f32x4 s[4]; att_scores(s, k, qf, kg, valid);
    float mx = -INFINITY;
#pragma unroll
    for (int tl = 0; tl < 4; ++tl)
#pragma unroll
        for (int r = 0; r < 4; ++r) mx = fmaxf(mx, s[tl][r]);
    mx = fmaxf(mx, __shfl_xor(mx, 16)); mx = fmaxf(mx, __shfl_xor(mx, 32));
    const float mn = fmaxf(st.m, mx); const float alpha = __expf(st.m - mn); st.m = mn;
    float ps = 0.f;
#pragma unroll
    for (int tl = 0; tl < 4; ++tl)
#pragma unroll
        for (int r = 0; r < 4; ++r) { const float pe = __expf(s[tl][r] - mn); s[tl][r] = pe; ps += pe; }
    st.l = st.l * alpha + ps;
#pragma unroll
    for (int dt = 0; dt < 4; ++dt) st.o[dt] = st.o[dt] * alpha;
    att_pv(st.o, s, v);
}
constexpr int NSA_NSLOT = 5, NSA_RING = 0, NSA_IMP = NSA_NSLOT * 16384, NSA_MSK = NSA_IMP + 32768, NSA_LIST = NSA_MSK + 256;
__device__ __forceinline__ void ldk_lds(KFrag& k, LAS const unsigned char* slot, int ko0, int ko1) {
#pragma unroll
    for (int tl = 0; tl < 4; ++tl) { const int o = (32 * (tl >> 1) + 4 * (tl & 1)) * 128; k.a[tl][0] = *(LAS const h16x8*)(slot + o + ko0); k.a[tl][1] = *(LAS const h16x8*)(slot + o + ko1); }
}
__device__ __forceinline__ void ldv_lds(VFrag& v, LAS const unsigned char* slot, int vo0, int vo1) {
#pragma unroll
    for (int dt = 0; dt < 4; ++dt) { v.a[dt][0] = *(LAS const h16x8*)(slot + 8192 + dt * 2048 + vo0); v.a[dt][1] = *(LAS const h16x8*)(slot + 8192 + dt * 2048 + vo1); }
}
#define NSA_WAITV(n) asm volatile("s_waitcnt vmcnt(" #n ")" ::: "memory")
#define NSA_BAR() do { asm volatile("s_waitcnt lgkmcnt(0)" ::: "memory"); __builtin_amdgcn_s_barrier(); asm volatile("" ::: "memory"); } while (0)
template <int LPT, class IssueF, class CompF>
__device__ __forceinline__ void nsa_stream(int n, LAS unsigned char* dmaw, LAS unsigned char* ring, IssueF issue, CompF comp) {
#pragma unroll
    for (int j = 0; j < NSA_NSLOT - 1; ++j) if (j < n) issue(j, (LAS unsigned*)(dmaw + j * 16384));
    int st = 0, si = (NSA_NSLOT - 1) * 16384;
    for (int t = 0; t < n; ++t) {
        const int ahead = n - 1 - t;
        if (ahead >= 3) { if (LPT == 2) NSA_WAITV(6); else NSA_WAITV(3); }
        else if (ahead == 2) { if (LPT == 2) NSA_WAITV(4); else NSA_WAITV(2); }
        else if (ahead == 1) { if (LPT == 2) NSA_WAITV(2); else NSA_WAITV(1); }
        else NSA_WAITV(0);
        NSA_BAR();
        if (t + NSA_NSLOT - 1 < n) issue(t + NSA_NSLOT - 1, (LAS unsigned*)(dmaw + si));
        comp(t, (LAS const unsigned char*)(ring + st));
        st = (st == (NSA_NSLOT - 1) * 16384) ? 0 : st + 16384; si = (si == (NSA_NSLOT - 1) * 16384) ? 0 : si + 16384; }
    NSA_BAR();
}
__device__ __forceinline__ void nsa_block_unit(const h16* __restrict__ h, const h16* __restrict__ nqr, const h16* __restrict__ kcmp, const h16* __restrict__ vcmpT, const h16* __restrict__ vsT, const h16* __restrict__ vwT,
                                               const h16* __restrict__ ksR, const h16* __restrict__ kwR, h16* __restrict__ mix, int b, int g, int T0, LAS unsigned char* lds, int wv, int lane) {
    const int i = lane & 15, kg = lane >> 4, tt = i & 3, hh = i >> 2;
    const int t0 = T0 + 4 * wv, trow = t0 + tt; const size_t mrow = (size_t)b * T + trow;
    const int q = wv * 64 + lane, qrow = q >> 3, qch = q & 7;
    const int ksrc = qrow * 128 + ((qch ^ (((qrow >> 1) & 1) | (((qrow >> 3) & 3) << 1))) << 4), vsrc = qrow * 128 + ((qch ^ ((qrow >> 1) & 7)) << 4);
    const int gki = ((i >> 1) & 1) | ((i >> 2) << 1), gvi = (i >> 1) & 7;
    const int ko0 = (8 * (i >> 2) + (i & 3)) * 128 + ((kg ^ gki) << 4), ko1 = (8 * (i >> 2) + (i & 3)) * 128 + (((kg + 4) ^ gki) << 4);
    const int vo0 = i * 128 + ((kg ^ gvi) << 4), vo1 = i * 128 + (((kg + 4) ^ gvi) << 4);
    LAS unsigned char* ring = lds + NSA_RING; LAS unsigned char* dmaw = ring + wv * 1024;
    LAS float* impA = (LAS float*)(lds + NSA_IMP + wv * 4096); LAS float* impL = impA + 512;
    h16x8 qf[2], qrf[2];
    { const h16* qp = h + mrow * INP + C_NQ + (g * 4 + hh) * 64 + 8 * kg; qf[0] = *(const h16x8*)qp; qf[1] = *(const h16x8*)(qp + 32);
      const h16* qrp = nqr + mrow * 512 + (g * 4 + hh) * 64 + 8 * kg; qrf[0] = *(const h16x8*)qrp; qrf[1] = *(const h16x8*)(qrp + 32); }
    const h16* gp = h + mrow * INP + C_NG + (g * 4 + hh) * 3; const float gt0 = (float)gp[0], gt1 = (float)gp[1], gt2 = (float)gp[2];
    for (int x = lane; x < 1024; x += 64) impA[x] = 0.f;
    NSA_WAITV(0);
#define GLDS16(gsrc, ldst) __builtin_amdgcn_global_load_lds((const unsigned*)(gsrc), (ldst), 16, 0, 0)
    const int ncv_row = trow >= 31 ? ((trow - 31) >> 4) + 1 : 0;
    const int ncv_blk = (T0 + 31 >= 31) ? ((T0 + 31 - 31) >> 4) + 1 : 0;
    const int nct = (ncv_blk + 63) >> 6;
    const unsigned char* Kc = (const unsigned char*)(kcmp + (size_t)(b * 2 + g) * 512 * 64); const unsigned char* Vc = (const unsigned char*)(vcmpT + (size_t)(b * 2 + g) * 8 * 4096);
    float m = -1e30f, l = 0.f;
    f32x4 oc[4];
#pragma unroll
    for (int dt = 0; dt < 4; ++dt) oc[dt] = (f32x4){0.f, 0.f, 0.f, 0.f};
    nsa_stream<1>(nct, dmaw, ring, [&](int j, LAS unsigned* dk) { GLDS16(Kc + (size_t)j * 8192 + ksrc, dk); }, [&](int j, LAS const unsigned char* slot) {
        KFrag kf; ldk_lds(kf, slot, ko0, ko1);
        f32x4 s[4]; att_scores(s, kf, qf, kg, [&](int ko) { return j * 64 + ko < ncv_row; });
        float mx = -INFINITY;
        _Pragma("unroll") for (int tl = 0; tl < 4; ++tl) _Pragma("unroll") for (int r = 0; r < 4; ++r) mx = fmaxf(mx, s[tl][r]);
        mx = fmaxf(mx, __shfl_xor(mx, 16)); mx = fmaxf(mx, __shfl_xor(mx, 32));
        const float mn = fmaxf(m, mx); float ps = 0.f;
        _Pragma("unroll") for (int tl = 0; tl < 4; ++tl) _Pragma("unroll") for (int r = 0; r < 4; ++r) ps += __expf(s[tl][r] - mn);
        l = l * __expf(m - mn) + ps; m = mn; });
    l += __shfl_xor(l, 16); l += __shfl_xor(l, 32);
    const float linv = l > 0.f ? 1.f / l : 0.f;
    nsa_stream<2>(nct, dmaw, ring, [&](int j, LAS unsigned* dk) { GLDS16(Kc + (size_t)j * 8192 + ksrc, dk); GLDS16(Vc + (size_t)j * 8192 + vsrc, (LAS unsigned*)((LAS unsigned char*)dk + 8192)); }, [&](int j, LAS const unsigned char* slot) {
        KFrag kf; ldk_lds(kf, slot, ko0, ko1); VFrag vf; ldv_lds(vf, slot, vo0, vo1);
        f32x4 s[4]; att_scores(s, kf, qf, kg, [&](int ko) { return j * 64 + ko < ncv_row; });
        _Pragma("unroll") for (int tl = 0; tl < 4; ++tl) {
            _Pragma("unroll") for (int r = 0; r < 4; ++r) s[tl][r] = __expf(s[tl][r] - m) * linv;
            float A = (s[tl][0] + s[tl][1]) + (s[tl][2] + s[tl][3]), L = s[tl][3];
            A += __shfl_xor(A, 4); A += __shfl_xor(A, 8); L += __shfl_xor(L, 4); L += __shfl_xor(L, 8);
            if (hh == 0) { const int u = j * 16 + 8 * (tl >> 1) + 2 * kg + (tl & 1); impA[tt * 128 + u] = A; impL[tt * 128 + u] = L; } }
        att_pv(oc, s, vf); });
    const int cur = T0 >> 6;
    AttSt sw; sw.m = -1e30f; sw.l = 0.f;
#pragma unroll
    for (int dt = 0; dt < 4; ++dt) sw.o[dt] = (f32x4){0.f, 0.f, 0.f, 0.f};
    {
        const unsigned char* Kw = (const unsigned char*)(kwR + (size_t)((b * 2 + g) * 128) * 4096); const unsigned char* Vw = (const unsigned char*)(vwT + (size_t)((b * 2 + g) * 128) * 4096);
        const int s0w = (T0 >= 511 ? (T0 - 511) >> 6 : 0);
        nsa_stream<2>(cur - s0w + 1, dmaw, ring, [&](int j, LAS unsigned* dk) { GLDS16(Kw + (size_t)(s0w + j) * 8192 + ksrc, dk); GLDS16(Vw + (size_t)(s0w + j) * 8192 + vsrc, (LAS unsigned*)((LAS unsigned char*)dk + 8192)); }, [&](int j, LAS const unsigned char* slot) {
            KFrag kf; ldk_lds(kf, slot, ko0, ko1); VFrag vf; ldv_lds(vf, slot, vo0, vo1); const int s = s0w + j;
            att_tile(sw, kf, vf, qrf, kg, [&](int ko) { const int kp = 64 * s + ko; return kp <= trow && kp >= trow - 511; }); });
    }
    unsigned long long mylo, myhi, anylo, anyhi;
    if (cur <= 15) { mylo = anylo = (1ull << (cur + 1)) - 1ull; myhi = anyhi = 0ull; }
    else {
        mylo = myhi = anylo = anyhi = 0ull;
        const unsigned long long flo = 1ull | (cur < 64 ? (1ull << cur) : 0ull) | (cur - 1 < 64 ? (1ull << (cur - 1)) : 0ull);
        const unsigned long long fhi = (cur >= 64 ? (1ull << (cur - 64)) : 0ull) | (cur - 1 >= 64 ? (1ull << (cur - 65)) : 0ull);
        const unsigned long long lmask = (1ull << lane) - 1ull;
        for (int tk = 0; tk < 4; ++tk) {
            const int s0 = lane, s1 = lane + 64;
            const float v0 = impA[tk * 128 + s0] + (s0 > 0 ? impL[tk * 128 + s0 - 1] : 0.f), v1 = impA[tk * 128 + s1] + impL[tk * 128 + s1 - 1];
            const unsigned b0 = (s0 >= 1 && s0 <= cur - 2) ? __float_as_uint(v0) + 1u : 0u, b1 = (s1 <= cur - 2) ? __float_as_uint(v1) + 1u : 0u;
            unsigned Tq = 0u;
            for (int bit = 30; bit >= 0; --bit) { const unsigned T2 = Tq | (1u << bit);
                const int c = __popcll(__ballot(b0 >= T2)) + __popcll(__ballot(b1 >= T2)); if (c >= 13) Tq = T2; }
            const unsigned long long gtlo = __ballot(b0 > Tq), gthi = __ballot(b1 > Tq), eqlo = __ballot(b0 == Tq), eqhi = __ballot(b1 == Tq);
            const int need = 13 - (__popcll(gtlo) + __popcll(gthi));
            const bool t0q = (b0 == Tq) && (__popcll(eqlo & lmask) < need), t1q = (b1 == Tq) && (__popcll(eqlo) + __popcll(eqhi & lmask) < need);
            const unsigned long long lo = gtlo | __ballot(t0q) | flo, hi = gthi | __ballot(t1q) | fhi;
            anylo |= lo; anyhi |= hi; if (tt == tk) { mylo = lo; myhi = hi; }
        }
    }
    LAS unsigned long long* msk = (LAS unsigned long long*)(lds + NSA_MSK); LAS unsigned char* lst = lds + NSA_LIST; LAS int* nlst = (LAS int*)(lds + NSA_LIST + 128);
    if (lane == 0) { msk[2 * wv] = anylo; msk[2 * wv + 1] = anyhi; }
    NSA_BAR();
    if (wv == 0) {
        unsigned long long ulo = 0ull, uhi = 0ull;
#pragma unroll
        for (int w2 = 0; w2 < 8; ++w2) { ulo |= msk[2 * w2]; uhi |= msk[2 * w2 + 1]; }
        const unsigned long long lmask = (1ull << lane) - 1ull; const int nlo = __popcll(ulo);
        if ((ulo >> lane) & 1ull) lst[__popcll(ulo & lmask)] = (unsigned char)lane;
        if ((uhi >> lane) & 1ull) lst[nlo + __popcll(uhi & lmask)] = (unsigned char)(64 + lane);
        if (lane == 0) nlst[0] = nlo + __popcll(uhi);
    }
    NSA_BAR();
    const int nsel = nlst[0];
    AttSt ss; ss.m = -1e30f; ss.l = 0.f;
#pragma unroll
    for (int dt = 0; dt < 4; ++dt) ss.o[dt] = (f32x4){0.f, 0.f, 0.f, 0.f};
    {
        const unsigned char* Ks = (const unsigned char*)(ksR + (size_t)((b * 2 + g) * 128) * 4096); const unsigned char* Vs = (const unsigned char*)(vsT + (size_t)((b * 2 + g) * 128) * 4096);
        nsa_stream<2>(nsel, dmaw, ring, [&](int j, LAS unsigned* dk) { const int sj = lst[j]; GLDS16(Ks + (size_t)sj * 8192 + ksrc, dk); GLDS16(Vs + (size_t)sj * 8192 + vsrc, (LAS unsigned*)((LAS unsigned char*)dk + 8192)); }, [&](int j, LAS const unsigned char* slot) {
            const int s = lst[j];
            if ((((s < 64 ? anylo : anyhi) >> (s & 63)) & 1ull) != 0ull) {
                KFrag kf; ldk_lds(kf, slot, ko0, ko1); VFrag vf; ldv_lds(vf, slot, vo0, vo1);
                const bool mybit = (((s < 64 ? mylo : myhi) >> (s & 63)) & 1ull) != 0ull;
                att_tile(ss, kf, vf, qrf, kg, [&](int ko) { return mybit && (64 * s + ko <= trow); }); } });
    }
    float ls = ss.l; ls += __shfl_xor(ls, 16); ls += __shfl_xor(ls, 32); float lw = sw.l; lw += __shfl_xor(lw, 16); lw += __shfl_xor(lw, 32);
    const float g0 = sigmf(gt0), g1 = sigmf(gt1) / ls, g2 = sigmf(gt2) / lw;
#pragma unroll
    for (int dt = 0; dt < 4; ++dt) { const f32x4 o = oc[dt] * g0 + ss.o[dt] * g1 + sw.o[dt] * g2;
        *(h16x4*)(mix + mrow * D + 512 + (g * 4 + hh) * 64 + 16 * dt + 4 * kg) = __builtin_convertvector(o, h16x4); }
#undef GLDS16
}

__device__ __forceinline__ void b_ln(const float* __restrict__ in, const float* __restrict__ gam, const float* __restrict__ bet, float* __restrict__ o32, h16* __restrict__ o16) {
    const int lane = tidx() & 63;
    for (int row = blockIdx.x * 8 + (tidx() >> 6); row < M; row += gridDim.x * 8) {
        const f32x4* xr = (const f32x4*)(in + (size_t)row * D) + lane;
        f32x4 v[4]; float s = 0.f;
#pragma unroll
        for (int j = 0; j < 4; ++j) { v[j] = xr[64 * j]; s += (v[j][0] + v[j][1]) + (v[j][2] + v[j][3]); }
        const float mean = wave_sum(s) * (1.f / D); float s2 = 0.f;
#pragma unroll
        for (int j = 0; j < 4; ++j) { v[j] = v[j] - mean; s2 += (v[j][0] * v[j][0] + v[j][1] * v[j][1]) + (v[j][2] * v[j][2] + v[j][3] * v[j][3]); }
        const float rstd = rsqrtf(wave_sum(s2) * (1.f / D) + LN_EPS);
#pragma unroll
        for (int j = 0; j < 4; ++j) { const f32x4 gg = ((const f32x4*)gam)[lane + 64 * j], bb = ((const f32x4*)bet)[lane + 64 * j]; const f32x4 o = v[j] * rstd * gg + bb;
            ((f32x4*)(o32 + (size_t)row * D))[lane + 64 * j] = o;
            if (o16) ((h16x4*)(o16 + (size_t)row * D))[lane + 64 * j] = __builtin_convertvector(o, h16x4); }
    }
}

__device__ __forceinline__ void xattn_unit(const h16* __restrict__ qx, const h16* __restrict__ kx, const h16* __restrict__ kvmVT, h16* __restrict__ ox, int m0, int hh, int lane) {
    const int i = lane & 15, kg = lane >> 4; const int b = m0 >> 13; const size_t m = (size_t)m0 + i;
    h16x8 qf[8];
#pragma unroll
    for (int ks = 0; ks < 8; ++ks) qf[ks] = *(const h16x8*)(qx + m * D + hh * 256 + 32 * ks + 8 * kg);
    f32x4 o[16];
#pragma unroll
    for (int dt = 0; dt < 16; ++dt) o[dt] = (f32x4){0.f, 0.f, 0.f, 0.f};
    float mrun = -1e30f, l = 0.f;
    const h16* vb = kvmVT + (size_t)((b * 4 + hh) * 256) * MEML;
#pragma unroll 1
    for (int gq = 0; gq < 4; ++gq) {
        f32x4 s[4]; float mx = -INFINITY;
#pragma unroll
        for (int tl = 0; tl < 4; ++tl) { const int ko = 64 * gq + 32 * (tl >> 1) + 8 * (i >> 2) + 4 * (tl & 1) + (i & 3); const h16* kp = kx + ((size_t)(b * 4 + hh) * MEML + ko) * 256 + 8 * kg;
            f32x4 acc = {0.f, 0.f, 0.f, 0.f};
#pragma unroll
            for (int ks = 0; ks < 8; ++ks) acc = __builtin_amdgcn_mfma_f32_16x16x32_f16(*(const h16x8*)(kp + 32 * ks), qf[ks], acc, 0, 0, 0);
            s[tl] = acc * 0.0625f; mx = fmaxf(mx, fmaxf(fmaxf(s[tl][0], s[tl][1]), fmaxf(s[tl][2], s[tl][3]))); }
        mx = fmaxf(mx, __shfl_xor(mx, 16)); mx = fmaxf(mx, __shfl_xor(mx, 32));
        const float mn = fmaxf(mrun, mx); const float alpha = __expf(mrun - mn); mrun = mn;
        float ps = 0.f; h16x8 pf[2];
#pragma unroll
        for (int tl = 0; tl < 4; ++tl)
#pragma unroll
            for (int r = 0; r < 4; ++r) { const float pe = __expf(s[tl][r] - mn); ps += pe; pf[tl >> 1][4 * (tl & 1) + r] = (h16)pe; }
        l = l * alpha + ps;
#pragma unroll
        for (int dt = 0; dt < 16; ++dt) { f32x4 acc = o[dt] * alpha;
#pragma unroll
            for (int s2 = 0; s2 < 2; ++s2) acc = __builtin_amdgcn_mfma_f32_16x16x32_f16(*(const h16x8*)(vb + (size_t)(16 * dt + i) * MEML + 64 * gq + 32 * s2 + 8 * kg), pf[s2], acc, 0, 0, 0);
            o[dt] = acc; }
    }
    l += __shfl_xor(l, 16); l += __shfl_xor(l, 32); const float linv = 1.f / l;
#pragma unroll
    for (int dt = 0; dt < 16; ++dt) { const f32x4 acc = o[dt] * linv; *(h16x4*)(ox + m * D + hh * 256 + 16 * dt + 4 * kg) = __builtin_convertvector(acc, h16x4); }
}

__device__ __forceinline__ void b_router(const Params& p, const float* __restrict__ x2, int* __restrict__ tope, float* __restrict__ topw, int* __restrict__ hist) {
    const int lane = tidx() & 63; const float* wr = p.w_router;
    for (int m = blockIdx.x * 8 + (tidx() >> 6); m < M; m += gridDim.x * 8) {
        const float* xr = x2 + (size_t)m * D; float acc = 0.f;
        for (int k = 0; k < D; k += 4) { const f32x4 xv = *(const f32x4*)(xr + k);
            acc += xv[0] * wr[(k + 0) * 64 + lane]; acc += xv[1] * wr[(k + 1) * 64 + lane]; acc += xv[2] * wr[(k + 2) * 64 + lane]; acc += xv[3] * wr[(k + 3) * 64 + lane]; }
        const float score = 1.f / (1.f + expf(-acc)); const float biased = score + p.rbias[lane];
        float m1 = biased; m1 = fmaxf(m1, __shfl_xor(m1, 1)); m1 = fmaxf(m1, __shfl_xor(m1, 2)); m1 = fmaxf(m1, __shfl_xor(m1, 4));
        int am = (biased == m1) ? lane : 999; am = min(am, __shfl_xor(am, 1)); am = min(am, __shfl_xor(am, 2)); am = min(am, __shfl_xor(am, 4));
        float m2 = (lane == am) ? -INFINITY : biased; m2 = fmaxf(m2, __shfl_xor(m2, 1)); m2 = fmaxf(m2, __shfl_xor(m2, 2)); m2 = fmaxf(m2, __shfl_xor(m2, 4));
        const float gs = m1 + m2;
        int cnt = 0;
#pragma unroll
        for (int gq = 0; gq < 8; ++gq) { const float o = __shfl(gs, gq * 8); cnt += (o > gs) ? 1 : 0; }
        const float masked = (cnt <= 3) ? biased : NEGF;
        int rank = 0;
        for (int e2 = 0; e2 < 64; ++e2) { const float o = __shfl(masked, e2); rank += (o > masked || (o == masked && e2 < lane)) ? 1 : 0; }
        const bool selq = rank < 8;
        const float wsum = wave_sum(selq ? score : 0.f);
        if (selq) { tope[(size_t)m * 8 + rank] = lane; topw[(size_t)m * 8 + rank] = score / wsum * 2.5f; atomicAdd(hist + (m >> 13) * 65 + lane, 1); }
    }
}

__device__ __forceinline__ void b_moe(const Params& p, const float* __restrict__ x2, const int* __restrict__ tope, const float* __restrict__ topw, float* __restrict__ out, int m, float* sl, int tid) {
    float* xs = sl; float* hd = sl + 1024; float* red = sl + 1280;
    for (int i = tid; i < 1024; i += 256) xs[i] = x2[(size_t)m * D + i];
    __syncthreads();
    float acc[4] = {0.f, 0.f, 0.f, 0.f};
    for (int kx = 0; kx < 9; ++kx) {
        const float* G; const float* U; const float* Dn; float wt;
        if (kx < 8) { const int e = tope[(size_t)m * 8 + kx]; wt = topw[(size_t)m * 8 + kx]; G = p.w_gate + (size_t)e * D * EFF; U = p.w_up + (size_t)e * D * EFF; Dn = p.w_down + (size_t)e * EFF * D; }
        else { wt = 1.f; G = p.ws_gate; U = p.ws_up; Dn = p.ws_down; }
        float a = 0.f, u = 0.f;
        for (int k = 0; k < D; ++k) { const float xv = xs[k]; a += xv * G[(size_t)k * EFF + tid]; u += xv * U[(size_t)k * EFF + tid]; }
        hd[tid] = siluf(a) * u * wt;
        __syncthreads();
        for (int j = 0; j < EFF; ++j) { const float hv = hd[j]; const float* dr = Dn + (size_t)j * D + tid;
            acc[0] += hv * dr[0]; acc[1] += hv * dr[256]; acc[2] += hv * dr[512]; acc[3] += hv * dr[768]; }
        __syncthreads();
    }
    float v[4]; float s = 0.f;
#pragma unroll
    for (int i = 0; i < 4; ++i) { v[i] = DN_ALPHA * xs[tid + 256 * i] + acc[i]; s += v[i]; }
    s = wave_sum(s); if ((tid & 63) == 0) red[tid >> 6] = s; __syncthreads();
    const float mean = (red[0] + red[1] + red[2] + red[3]) * (1.f / D); float s2 = 0.f;
#pragma unroll
    for (int i = 0; i < 4; ++i) { v[i] -= mean; s2 += v[i] * v[i]; }
    s2 = wave_sum(s2); if ((tid & 63) == 0) red[4 + (tid >> 6)] = s2; __syncthreads();
    const float rstd = rsqrtf((red[4] + red[5] + red[6] + red[7]) * (1.f / D) + LN_EPS);
#pragma unroll
    for (int i = 0; i < 4; ++i) out[(size_t)m * D + tid + 256 * i] = v[i] * rstd * p.ln3g[tid + 256 * i] + p.ln3b[tid + 256 * i];
    __syncthreads();
}

struct G1Sched {
    const int* ctl; const char* x2h; const unsigned* rowoff; const char* WguT; int G, c;
    __device__ bool next(int i, pg8::Unit& u) const {
        const int ntile = ctl[CTL_TQS + NQ]; const long L = (long)i * G + c; if (L >= 2L * ntile) return false;
        const int tile = (int)(L >> 1), pn = (int)(L & 1); const int e = ctl[CTL_TVE + tile] % 65;
        u.pm = tile; u.pn = pn; u.A = x2h; u.gat = rowoff + (size_t)tile * 256; u.B = WguT + ((size_t)e * 512 + pn * 256) * (D * 2); return true; }
};
struct G2Sched {
    const int* ctl; const char* H; const char* WdT; int q, G, c;
    __device__ bool next(int i, pg8::Unit& u) const {
        const int t0 = ctl[CTL_TQS + q], t1 = ctl[CTL_TQS + q + 1]; const long L = (long)i * G + c; if (L >= 4L * (t1 - t0)) return false;
        const int tile = t0 + (int)(L >> 2), pn = (int)(L & 3); const int e = ctl[CTL_TVE + tile] % 65;
        u.pm = tile; u.pn = pn; u.A = H + (size_t)tile * 256 * (EFF * 2); u.gat = nullptr; u.B = WdT + ((size_t)e * D + pn * 256) * (EFF * 2); return true; }
};
__device__ __forceinline__ void b_scatter(int* __restrict__ ctl, const int* __restrict__ tope, const float* __restrict__ topw, unsigned* __restrict__ rowoff, u32x2* __restrict__ rowmeta, int* sl) {
    int* pst = sl;
    if (tidx() == 0) { int acc = 0; for (int v = 0; v < NVE; ++v) { pst[v] = acc; acc += (ctl[CTL_CNT + v] + 255) & ~255; } pst[NVE] = acc; }
    __syncthreads();
    if (blockIdx.x == 0) {
        for (int v = tidx(); v <= NVE; v += NTHR) ctl[CTL_PST + v] = pst[v];
        if (tidx() <= NQ) ctl[CTL_TQS + tidx()] = pst[tidx() * 65] >> 8;
        for (int v = tidx(); v < NVE; v += NTHR) for (int tl = pst[v] >> 8; tl < (pst[v + 1] >> 8); ++tl) ctl[CTL_TVE + tl] = v;
    }
    for (int idx = blockIdx.x * NTHR + tidx(); idx < M * 9; idx += gridDim.x * NTHR) {
        int m, k, pos; float w;
        if (idx < M * 8) { m = idx >> 3; k = idx & 7; const int ve = (m >> 13) * 65 + tope[idx]; w = topw[idx]; pos = pst[ve] + atomicAdd(ctl + CTL_CUR + ve, 1); }
        else { m = idx - M * 8; k = 8; w = 1.f; pos = pst[(m >> 13) * 65 + 64] + (m & (QT - 1)); }
        rowoff[pos] = (unsigned)m * (D * 2); rowmeta[pos] = (u32x2){(unsigned)((m & (QT - 1)) * 9 + k), __float_as_uint(w)};
    }
    __syncthreads();
}
__device__ __forceinline__ void b_combine(const Params& p, const h16* __restrict__ x2h, const h16* __restrict__ Y, int q) {
    const int lane = tidx() & 63;
    for (int r = blockIdx.x * 8 + (tidx() >> 6); r < QT; r += gridDim.x * 8) {
        const int m = q * QT + r;
        float v[16];
        { const h16x8 a = ((const h16x8*)(x2h + (size_t)m * D))[lane], b = ((const h16x8*)(x2h + (size_t)m * D))[lane + 64];
#pragma unroll
          for (int i = 0; i < 8; ++i) { v[i] = DN_ALPHA * (float)a[i]; v[8 + i] = DN_ALPHA * (float)b[i]; } }
#pragma unroll
        for (int k = 0; k < 9; ++k) { const h16x8* yr = (const h16x8*)(Y + ((size_t)r * 9 + k) * D); const h16x8 a = yr[lane], b = yr[lane + 64];
#pragma unroll
            for (int i = 0; i < 8; ++i) { v[i] += (float)a[i]; v[8 + i] += (float)b[i]; } }
        float s = 0.f;
#pragma unroll
        for (int i = 0; i < 16; ++i) s += v[i];
        const float mean = wave_sum(s) * (1.f / D); float s2 = 0.f;
#pragma unroll
        for (int i = 0; i < 16; ++i) { v[i] -= mean; s2 += v[i] * v[i]; }
        const float rstd = rsqrtf(wave_sum(s2) * (1.f / D) + LN_EPS);
#pragma unroll
        for (int hlf = 0; hlf < 2; ++hlf) { const int c0 = (lane + 64 * hlf) * 8;
            const f32x4 g0 = *(const f32x4*)(p.ln3g + c0), g1 = *(const f32x4*)(p.ln3g + c0 + 4), b0 = *(const f32x4*)(p.ln3b + c0), b1 = *(const f32x4*)(p.ln3b + c0 + 4);
            f32x4 o0, o1;
#pragma unroll
            for (int i = 0; i < 4; ++i) { o0[i] = v[8 * hlf + i] * rstd * g0[i] + b0[i]; o1[i] = v[8 * hlf + 4 + i] * rstd * g1[i] + b1[i]; }
            *(f32x4*)(p.out + (size_t)m * D + c0) = o0; *(f32x4*)(p.out + (size_t)m * D + c0 + 4) = o1; }
    }
}

#define XB_TMO      128
#define XB_XCNT(j)  (256  + 64 * (j))
#define XB_XSUB(j)  (1280 + 64 * (j))
#define XB_XGEN(j)  (2304 + 64 * (j))
#define XB_TOP      3328
#define XB_TOPGEN   3392
#define XCD_BAR_WORDS 3456
#define XB_SPIN_CAP (1u << 22)
__device__ __forceinline__ unsigned xb_ld(unsigned* p)              { return __hip_atomic_load(p, __ATOMIC_RELAXED, __HIP_MEMORY_SCOPE_AGENT); }
__device__ __forceinline__ unsigned xb_add(unsigned* p, unsigned v) { return __hip_atomic_fetch_add(p, v, __ATOMIC_RELAXED, __HIP_MEMORY_SCOPE_AGENT); }
__device__ __forceinline__ unsigned xb_xcc_id() { return (unsigned)__builtin_amdgcn_s_getreg((3 << 11) | 20) & 0xFu; }
#define XB_SPIN(cond, bar) do { unsigned _sp = 0; while (cond) { __builtin_amdgcn_s_sleep(1); \
    if ((++_sp & 255u) == 0u) { if (xb_ld(&(bar)[XB_TMO])) break; if (_sp > XB_SPIN_CAP) { atomicAdd(&(bar)[XB_TMO], 1u); break; } } } } while (0)
struct XcdBarrier { unsigned* bar; unsigned x; volatile LAS unsigned* st; };
__device__ __forceinline__ XcdBarrier xcd_barrier_post(unsigned* bar, volatile LAS unsigned* st) {
    XcdBarrier b; b.bar = bar; b.x = xb_xcc_id(); b.st = st;
    if (threadIdx.x == 0) (void)xb_add(&bar[XB_XCNT(b.x)], 1u);
    return b;
}
__device__ __forceinline__ void xcd_barrier_complete(unsigned* bar, unsigned x, unsigned& nloc, unsigned& nx) {
    const unsigned G = gridDim.x * gridDim.y * gridDim.z;
    unsigned sum, cnt, mine, sp = 0u;
    for (;;) {
        sum = 0u; cnt = 0u; mine = 0u;
#pragma unroll
        for (unsigned j = 0; j < 16; ++j) { const unsigned c = xb_ld(&bar[XB_XCNT(j)]); sum += c; cnt += (c > 0u) ? 1u : 0u; mine = (j == x) ? c : mine; }
        if (sum == G) break;
        __builtin_amdgcn_s_sleep(1);
        if ((++sp & 255u) == 0u) { if (xb_ld(&bar[XB_TMO])) break; if (sp > XB_SPIN_CAP) { atomicAdd(&bar[XB_TMO], 1u); break; } }
    }
    nloc = mine > 0u ? mine : 1u; nx = cnt > 0u ? cnt : 1u;
}
__device__ __forceinline__ void xcd_barrier(const XcdBarrier& b) {
    asm volatile("s_waitcnt vmcnt(0)" ::: "memory");
    __syncthreads();
    if (threadIdx.x == 0) {
        unsigned* bar = b.bar;
        __builtin_amdgcn_s_waitcnt(0);
        unsigned nloc = b.st[0], nx = b.st[1];
        if (nloc == 0u) { xcd_barrier_complete(bar, b.x, nloc, nx); b.st[0] = nloc; b.st[1] = nx; }
        const unsigned old = xb_add(&bar[XB_XSUB(b.x)], 1u);
        const unsigned gen = old / nloc;
        if (old + 1u == (gen + 1u) * nloc) {
            __builtin_amdgcn_fence(__ATOMIC_RELEASE, "agent");
            asm volatile("s_waitcnt vmcnt(0)" ::: "memory");
            const unsigned og = xb_add(&bar[XB_TOP], 1u);
            const unsigned tg = og / nx;
            if (og + 1u == (tg + 1u) * nx) xb_add(&bar[XB_TOPGEN], 1u);
            else XB_SPIN(xb_ld(&bar[XB_TOPGEN]) == tg, bar);
            __builtin_amdgcn_fence(__ATOMIC_ACQUIRE, "agent");
            xb_add(&bar[XB_XGEN(b.x)], 1u);
            asm volatile("s_waitcnt vmcnt(0)" ::: "memory");
        } else {
            XB_SPIN(xb_ld(&bar[XB_XGEN(b.x)]) == gen, bar);
            __builtin_amdgcn_fence(__ATOMIC_ACQUIRE, "agent");
            asm volatile("s_waitcnt vmcnt(0)" ::: "memory");
        }
    }
    __syncthreads();
}

constexpr int N_PHASES = 23;

__global__ void __launch_bounds__(NTHR, 2) mega_fwd(Params p) {
    extern __shared__ __attribute__((aligned(16))) unsigned char lds[];
    cg::grid_group grid = cg::this_grid();
    const int G = (int)gridDim.x, bid = (int)blockIdx.x;
#define tid tidx()
    unsigned char* ws = p.ws;
    h16* WinT = (h16*)(ws + WS_WIN); h16* WoutT = (h16*)(ws + WS_WOUT); h16* WxqT = (h16*)(ws + WS_WXQ); h16* WxoT = (h16*)(ws + WS_WXO); h16* WxkvT = (h16*)(ws + WS_WXKV);
    h16* memh = (h16*)(ws + WS_MEMH); h16* kvm = (h16*)(ws + WS_KVM); h16* kcmp = (h16*)(ws + WS_KCMP); h16* vcmpT = (h16*)(ws + WS_VCMP); h16* vsT = (h16*)(ws + WS_VST); h16* vwT = (h16*)(ws + WS_VWT);
    int* tope = (int*)(ws + WS_TOPE); float* topw = (float*)(ws + WS_TOPW);
    h16* xh = (h16*)(ws + WS_XH); h16* mix = (h16*)(ws + WS_MIX); h16* ox = (h16*)(ws + WS_OX); h16* hb = (h16*)(ws + WS_H); h16* nqr = (h16*)(ws + WS_NQR);
    float* kvb = (float*)(ws + WS_KVB); h16* prevT = (h16*)(ws + WS_PREVT);
    float* cosr = (float*)(ws + WS_COSR); float* sinr = (float*)(ws + WS_SINR); float* cosn = (float*)(ws + WS_COSN); float* sinn = (float*)(ws + WS_SINN); h16* kvmVT = (h16*)(ws + WS_KVMVT); h16* Wc1T = (h16*)(ws + WS_WC1T); h16* hid = (h16*)(ws + WS_HID); unsigned* cmpoff = (unsigned*)(ws + WS_CMPOFF); float* peb = (float*)(ws + WS_PEB); h16* ksR = (h16*)(ws + WS_KSR); h16* kwR = (h16*)(ws + WS_KWR); h16* kx = (h16*)(ws + WS_KX);
    h16* rqr = (h16*)((unsigned char*)p.out + DO_RQR); h16* rkr = (h16*)((unsigned char*)p.out + DO_RKR); h16* rkzT = (h16*)((unsigned char*)p.out + DO_RKZT); h16* rvT = (h16*)((unsigned char*)p.out + DO_RVT); float* pre = p.out; float* x1 = (float*)(ws + WS_X1); h16* x1h = (h16*)(ws + WS_X1H);
    h16* qx = (h16*)(ws + WS_QX); float* x2 = (float*)(ws + WS_X2); h16* x2h = (h16*)(ws + WS_X2H);
    int* ctl = (int*)ws; unsigned* rowoff = (unsigned*)(ws + WS_ROWOFF); u32x2* rowmeta = (u32x2*)(ws + WS_ROWMETA);
    h16* WguT = (h16*)(ws + WS_WGUT); h16* WdT = (h16*)(ws + WS_WDT); h16* Hm = (h16*)(ws + WS_HM); h16* Yq = (h16*)(ws + WS_Y);
    float* fl = (float*)lds;
    const int lo = p.ph_lo, hi = p.ph_hi;
#define IN(k) (lo <= (k) && (k) < hi)
    { volatile LAS unsigned* st = (volatile LAS unsigned*)((LAS unsigned char*)lds + 131072); if (threadIdx.x < 2) st[threadIdx.x] = 0u; }
    __syncthreads();
    XcdBarrier xbar = xcd_barrier_post((unsigned*)(ws + WS_BAR), (volatile LAS unsigned*)((LAS unsigned char*)lds + 131072));
#define SEAM(k) do { if (IN(k) && IN((k) + 1)) { if ((k) == 0) grid.sync(); else xcd_barrier(xbar); } } while (0)

    if (IN(0)) REPS(0) {
        const int sub = tid >> 8, lt = tid & 255; float* tl = fl + sub * 1088;
        constexpr int T0 = (INP / 32) * (D / 32), T1 = (D / 32) * (D / 32), T4 = (2 * D / 32) * (D / 32), T5 = (256 / 32) * (2048 / 32), TT = T0 + 3 * T1 + T4 + 2 * T5;
        for (int b0 = bid * 2; b0 < TT; b0 += G * 2) { int it = b0 + sub;
            if (it < T0) { b_transpose_tile(p.w_in, D, INC, WinT, INP, it, tl, lt); continue; } it -= T0;
            if (it < T1) { b_transpose_tile(p.w_out, D, D, WoutT, D, it, tl, lt); continue; } it -= T1;
            if (it < T1) { b_transpose_tile(p.w_xq, D, D, WxqT, D, it, tl, lt); continue; } it -= T1;
            if (it < T1) { b_transpose_tile(p.w_xo, D, D, WxoT, D, it, tl, lt); continue; } it -= T1;
            if (it < T4) { b_transpose_tile(p.w_xkv, D, 2 * D, WxkvT, 2 * D, it, tl, lt); continue; } it -= T4;
            if (it < T5) { b_transpose_tile(p.w1k, 2048, 256, Wc1T, 256, it, tl, lt); continue; } it -= T5;
            b_transpose_tile(p.w1v, 2048, 256, Wc1T + 256 * 2048, 256, it, tl, lt); }
        b_cvt(p.x, xh, (size_t)M * D / 4);
        b_cvt(p.mem, memh, (size_t)NB * MEML * D / 4);
        if (bid == 0) for (int i = tid; i < 1024; i += NTHR) ctl[i] = 0;
        b_tables(p.positions, cosr, sinr, cosn, sinn);
        for (int r = bid * NTHR + tid; r < 4096; r += G * NTHR) { const int g = r & 1, c = min((r >> 1) & 511, 510), b = r >> 10; cmpoff[r] = (unsigned)(((size_t)(b * T + 16 * c) * INP + g * 64) * 2); }
        { const int lane = tid & 63;
          for (int o = bid * 8 + (tid >> 6); o < 512; o += G * 8) { const int kv = o >> 8, j = o & 255; const float* pe = kv ? p.pe_v : p.pe_k; const float* w1 = kv ? p.w1v : p.w1k; float a = 0.f;
              for (int k = lane; k < 2048; k += 64) a += pe[k] * w1[(size_t)k * 256 + j];
              a = wave_sum(a); if (lane == 0) peb[o] = a; } }
    }
    SEAM(0);
    if (IN(1)) {
        REPS(1) { pg8::Gemm g{xh, WinT, M, INP, D}; pg8::StaticOrder S; S.init(g, G, bid); pg8::EpiF16 E{hb, INP};
          pg8::gemm_phase<pg8::EpiF16, pg8::StaticOrder>((PG8_LAS unsigned char*)lds, g.K, S, E); }
        { pg8::Gemm g{memh, WxkvT, NB * MEML, 2 * D, D}; pg8::StaticOrder S; S.init(g, G, bid); pg8::EpiF16 E{kvm, 2 * D};
          pg8::gemm_phase<pg8::EpiF16, pg8::StaticOrder>((PG8_LAS unsigned char*)lds, g.K, S, E); }
    }
    SEAM(1);
    if (IN(2)) REPS(2) {
        if (bid < 32) { CmpSched S{(const char*)hb, cmpoff, (const char*)Wc1T, bid}; pg8::EpiCmp1 E{hid, peb + (bid >> 4) * 256};
            pg8::gemm_phase<pg8::EpiCmp1, CmpSched>((PG8_LAS unsigned char*)lds, 2048, S, E, (size_t)INP * 2); }
        else { const int sub = tid >> 8, lt = tid & 255; const int b2 = bid - 32, G2 = G - 32;
        for (int b0 = b2 * 2; b0 < M; b0 += G2 * 2) b_rope(hb, rqr, rkr, nqr, ksR, kwR, cosr, sinr, cosn, sinn, b0 + sub, lt);
        for (int b0 = b2 * 2; b0 < 2 * NB * 2 * 128; b0 += G2 * 2) b_vtrans(hb, vsT, vwT, b0 + sub, (h16*)(fl + sub * 2304), lt);
        for (int b0 = b2 * 2; b0 < NB * 4 * 128; b0 += G2 * 2) b_rtrans(p, hb, rvT, rkzT, cosr, sinr, b0 + sub, (h16*)(fl + sub * 4224), lt);
        for (int b0 = b2 * 2; b0 < NB * 4 * 16; b0 += G2 * 2) b_mvtrans(kvm, kvmVT, kx, b0 + sub, (h16*)(fl + sub * 2304), lt); } }
    SEAM(2);
    if (IN(3)) {
        REPS(30) b_cmp2(p, hid, kcmp, vcmpT);
        const int wv = __builtin_amdgcn_readfirstlane(tid >> 6), lane = tid & 63;
        REPS(31) for (int ch = bid; ch < NB * 4 * 64; ch += G) ret_kv_unit(rkzT, rvT, kvb, ch, wv, lane); }
    SEAM(3);
    if (IN(4)) b_ret_scan(p, kvb, prevT);
    SEAM(4);
    if (IN(5)) {
        const int wv = __builtin_amdgcn_readfirstlane(tid >> 6), lane = tid & 63;
        REPS(50) { const int bg = bid & 7;
            for (int k = bid >> 3; k < T / 32; k += (G >> 3)) nsa_block_unit(hb, nqr, kcmp, vcmpT, vsT, vwT, ksR, kwR, mix, bg >> 1, bg & 1, (T / 32 - 1 - k) * 32, (LAS unsigned char*)lds, wv, lane); }
        __syncthreads();
        REPS(51) for (int ch = bid; ch < NB * 4 * 64; ch += G) ret_out_unit(p, hb, rqr, rkr, rvT, prevT, mix, ch, wv, lane);
    }
    SEAM(5);
    if (IN(6)) { pg8::Gemm g{mix, WoutT, M, D, D}; pg8::StaticOrder S; S.init(g, G, bid); pg8::EpiResF32 E{pre, p.x, D, DN_ALPHA};
        pg8::gemm_phase<pg8::EpiResF32, pg8::StaticOrder>((PG8_LAS unsigned char*)lds, g.K, S, E); }
    SEAM(6);
    if (IN(7)) b_ln(pre, p.ln1g, p.ln1b, x1, x1h);
    SEAM(7);
    if (IN(8)) { pg8::Gemm g{x1h, WxqT, M, D, D}; pg8::StaticOrder S; S.init(g, G, bid); pg8::EpiF16 E{qx, D};
        pg8::gemm_phase<pg8::EpiF16, pg8::StaticOrder>((PG8_LAS unsigned char*)lds, g.K, S, E); }
    SEAM(8);
    if (IN(9)) { const int wv = __builtin_amdgcn_readfirstlane(tid >> 6), lane = tid & 63;
        REPS(9) for (int u = bid; u < (M / 128) * 4; u += G) xattn_unit(qx, kx, kvmVT, ox, (u >> 2) * 128 + wv * 16, u & 3, lane); }
    SEAM(9);
    if (IN(10)) { pg8::Gemm g{ox, WxoT, M, D, D}; pg8::StaticOrder S; S.init(g, G, bid); pg8::EpiResF32 E{pre, x1, D, DN_ALPHA};
        pg8::gemm_phase<pg8::EpiResF32, pg8::StaticOrder>((PG8_LAS unsigned char*)lds, g.K, S, E); }
    SEAM(10);
    if (IN(11)) b_ln(pre, p.ln2g, p.ln2b, x2, x2h);
    SEAM(11);
    if (IN(12)) {
        b_router(p, x2, tope, topw, ctl + CTL_CNT);
        if (bid == 0 && tid < NQ) ctl[CTL_CNT + tid * 65 + 64] = QT;
        for (int i = bid * NTHR + tid; i < CAP; i += G * NTHR) { rowoff[i] = 0u; rowmeta[i] = (u32x2){0xffffffffu, 0u}; }
        const int sub = tid >> 8, lt = tid & 255; float* tl = fl + sub * 1088;
        REPS(121) for (int b0 = bid * 2; b0 < 65 * 768; b0 += G * 2) { const int it = b0 + sub; const int e = it / 768, r = it % 768;
            const float* wg = e < 64 ? p.w_gate + (size_t)e * D * EFF : p.ws_gate; const float* wu = e < 64 ? p.w_up + (size_t)e * D * EFF : p.ws_up; const float* wd = e < 64 ? p.w_down + (size_t)e * EFF * D : p.ws_down;
            if (r < 256) b_transpose_tile(wg, D, EFF, WguT + (size_t)e * 512 * D, EFF, r, tl, lt, 2, 0);
            else if (r < 512) b_transpose_tile(wu, D, EFF, WguT + (size_t)e * 512 * D, EFF, r - 256, tl, lt, 2, 1);
            else b_transpose_tile(wd, EFF, D, WdT + (size_t)e * D * EFF, D, r - 512, tl, lt); }
    }
    SEAM(12);
    if (IN(13)) b_scatter(ctl, tope, topw, rowoff, rowmeta, (int*)lds);
    SEAM(13);
    if (IN(14)) REPS(14) { G1Sched S{ctl, (const char*)x2h, rowoff, (const char*)WguT, G, bid}; pg8::EpiGateUp E{Hm};
        pg8::gemm_phase<pg8::EpiGateUp, G1Sched>((PG8_LAS unsigned char*)lds, D, S, E); }
    SEAM(14);
#pragma unroll 1
    for (int q = 0; q < NQ; ++q) {
        if (IN(15 + 2 * q)) { G2Sched S{ctl, (const char*)Hm, (const char*)WdT, q, G, bid}; pg8::EpiDown E{Yq, rowmeta};
            pg8::gemm_phase<pg8::EpiDown, G2Sched>((PG8_LAS unsigned char*)lds, EFF, S, E); }
        SEAM(15 + 2 * q);
        if (IN(16 + 2 * q)) b_combine(p, x2h, Yq, q);
        if (q < NQ - 1) SEAM(16 + 2 * q);
    }
#undef IN
#undef SEAM
#undef tid
}

#ifndef MK_PER_PHASE
#define MK_PER_PHASE 0
#endif
extern "C" void kernel_launch(void* const* d_in, const int* in_sizes, int n_in, void* d_out, int out_size, void* d_ws, size_t ws_size, hipStream_t stream) {
    static int grid = 0;
    if (grid == 0) {
        if (n_in != 28 || in_sizes[0] != M * D || out_size != M * D || ws_size < WS_NEED) { fprintf(stderr, "kernel_launch: unexpected shapes (n_in %d, in0 %d, out %d, ws %zu)\n", n_in, n_in > 0 ? in_sizes[0] : -1, out_size, ws_size); grid = -1; return; }
        if (hipFuncSetAttribute((const void*)mega_fwd, hipFuncAttributeMaxDynamicSharedMemorySize, LDS_BYTES) != hipSuccess) { fprintf(stderr, "kernel_launch: hipFuncSetAttribute failed\n"); grid = -1; return; }
        int dev = 0, cus = 0, per_cu = 0;
        hipGetDevice(&dev); hipDeviceGetAttribute(&cus, hipDeviceAttributeMultiprocessorCount, dev);
        if (hipOccupancyMaxActiveBlocksPerMultiprocessor(&per_cu, (const void*)mega_fwd, NTHR, LDS_BYTES) != hipSuccess || per_cu < 1) { fprintf(stderr, "kernel_launch: occupancy query failed (%d)\n", per_cu); grid = -1; return; }
        grid = cus;
    }
    if (grid < 0) return;
    Params p{};
    p.x = (const float*)d_in[0]; p.mem = (const float*)d_in[1]; p.positions = (const int*)d_in[2];
    p.w_in = (const float*)d_in[3]; p.pe_k = (const float*)d_in[4]; p.pe_v = (const float*)d_in[5];
    p.w1k = (const float*)d_in[6]; p.w2k = (const float*)d_in[7]; p.w1v = (const float*)d_in[8]; p.w2v = (const float*)d_in[9];
    p.w_out = (const float*)d_in[10]; p.ln1g = (const float*)d_in[11]; p.ln1b = (const float*)d_in[12];
    p.w_xq = (const float*)d_in[13]; p.w_xkv = (const float*)d_in[14]; p.w_xo = (const float*)d_in[15];
    p.ln2g = (const float*)d_in[16]; p.ln2b = (const float*)d_in[17]; p.w_router = (const float*)d_in[18]; p.rbias = (const float*)d_in[19];
    p.w_gate = (const float*)d_in[20]; p.w_up = (const float*)d_in[21]; p.w_down = (const float*)d_in[22];
    p.ws_gate = (const float*)d_in[23]; p.ws_up = (const float*)d_in[24]; p.ws_down = (const float*)d_in[25];
    p.ln3g = (const float*)d_in[26]; p.ln3b = (const float*)d_in[27];
    p.out = (float*)d_out; p.ws = (unsigned char*)d_ws;
    for (int i = 0; i < 4; ++i) p.lg[i] = (float)std::log(1.0 - std::pow(2.0, -5.0 - (double)i));
#if MK_PER_PHASE
    for (int ph = 0; ph < N_PHASES; ++ph) { p.ph_lo = ph; p.ph_hi = ph + 1; hipLaunchKernelGGL(mega_fwd, dim3(grid), dim3(NTHR), LDS_BYTES, stream, p); }
#else
    p.ph_lo = 0; p.ph_hi = N_PHASES;
    if (hipMemsetAsync((char*)d_ws + WS_BAR, 0, XCD_BAR_WORDS * 4, stream) != hipSuccess) { fprintf(stderr, "kernel_launch: memset failed\n"); return; }
    void* args[] = {&p};
    hipError_t e = hipLaunchCooperativeKernel((const void*)mega_fwd, dim3(grid), dim3(NTHR), args, LDS_BYTES, stream);
    if (e != hipSuccess) fprintf(stderr, "kernel_launch: cooperative launch failed: %s (grid %d)\n", hipGetErrorString(e), grid);
#endif
}
```

```cpp
#include <hip/hip_runtime.h>
#include <cstdio>
#include <cstdint>
#include <cmath>

typedef _Float16 h16;
typedef _Float16 h16x8 __attribute__((ext_vector_type(8)));
typedef _Float16 h16x2 __attribute__((ext_vector_type(2)));
typedef _Float16 h16x4 __attribute__((ext_vector_type(4)));
typedef float f32x2 __attribute__((ext_vector_type(2)));
typedef float f32x4 __attribute__((ext_vector_type(4)));
typedef unsigned u32x4 __attribute__((ext_vector_type(4)));
typedef unsigned u32x2 __attribute__((ext_vector_type(2)));

__device__ __forceinline__ int tidx() { int t = (int)threadIdx.x; asm volatile("" : "+v"(t)); return t; }

#ifndef PROBE_DBL
#define PROBE_DBL -1
#endif
#define REPS(k) for (int _rep = 0; _rep < ((PROBE_DBL) == (k) ? 2 : 1); ++_rep)

constexpr int NB = 4, T = 8192, D = 1024, M = NB * T;
constexpr int INC = 3352, INP = 3584;
constexpr int C_RQ = 0, C_RK = 512, C_RV = 1024, C_RG = 1536, C_NQ = 2048, C_NKC = 2560, C_NVC = 2688, C_NKS = 2816, C_NVS = 2944, C_NKW = 3072, C_NVW = 3200, C_NG = 3328;
constexpr int MEML = 256;
constexpr int NE = 64, EFF = 256;
constexpr float LN_EPS = 1e-5f;
constexpr float DN_ALPHA = 1.189207115002721f;
constexpr float NEGF = -1e30f;

constexpr size_t MiB = 1u << 20;
constexpr size_t WS_WIN = 1 * MiB, WS_WOUT = 8 * MiB, WS_WXQ = 10 * MiB, WS_WXO = 12 * MiB, WS_WXKV = 14 * MiB, WS_MEMH = 18 * MiB, WS_KVM = 20 * MiB;
constexpr size_t WS_KCMP = 24 * MiB, WS_VCMP = 25 * MiB, WS_TOPE = 26 * MiB, WS_TOPW = 27 * MiB;
constexpr size_t WS_XH = 32 * MiB, WS_MIX = 32 * MiB, WS_OX = 32 * MiB;
constexpr size_t WS_H = 96 * MiB, WS_NQR = 320 * MiB, WS_KVB = 352 * MiB, WS_PREV = 416 * MiB;
constexpr size_t WS_PRE = 96 * MiB, WS_X1 = 224 * MiB, WS_X1H = 352 * MiB, WS_QX = 416 * MiB, WS_X2 = 130 * MiB;
constexpr size_t WS_X2H = 32 * MiB, WS_WDT = 96 * MiB, WS_HM = 130 * MiB, WS_WGUT = 306 * MiB, WS_Y = 306 * MiB;
constexpr size_t WS_ROWOFF = 1 * MiB, WS_ROWMETA = 3 * MiB;
constexpr size_t WS_VST = 480 * MiB, WS_VWT = 488 * MiB, WS_COSR = 496 * MiB, WS_SINR = 504 * MiB, WS_COSN = 28 * MiB, WS_SINN = 29 * MiB, WS_KVMVT = 30 * MiB;
constexpr size_t WS_WRTH = 262144, WS_WRTL = 393216;
constexpr size_t WS_WC1T = 464 * MiB, WS_HID = 466 * MiB, WS_CMPOFF = 131072, WS_PEB = 131072 + 16384;
constexpr size_t WS_PREVT = 416 * MiB, WS_KSR = 448 * MiB, WS_KWR = 456 * MiB, WS_KX = 26 * MiB;
constexpr size_t DO_RQR = 0, DO_RKR = 32 * MiB, DO_RKZT = 64 * MiB, DO_RVT = 96 * MiB;
constexpr size_t WS_NEED = 512 * MiB;
constexpr int NQ = 4, QT = M / NQ, NVE = NQ * 65, CAP_TILES = 1412, CAP = CAP_TILES * 256;
constexpr size_t WS_BAR = 65536;
constexpr int CTL_CNT = 0, CTL_CUR = 512, CTL_PST = 1024, CTL_TQS = 1536, CTL_TVE = 2048;

namespace pg8 {
#define PG8_LAS __attribute__((address_space(3)))
typedef short s16x8 __attribute__((ext_vector_type(8)));
constexpr int BM = 256, BK = 64, HALF = 128, HTB = HALF * BK * 2, STAGE_BYTES = 8 * HTB, NXCD = 8, WGM = 8;
__host__ __device__ __forceinline__ int lds_byte(int r, int c) { const int st = (r >> 4) * 2 + (c >> 5), rr = r & 15, cc = c & 31, ob = rr * 64 + cc * 2; return st * 1024 + (ob ^ (((ob >> 9) & 1) << 5)); }
__host__ __device__ __forceinline__ void stage_rc(int b, int& R, int& C) { const int st = b / 1024, sb = b % 1024, swz = sb ^ (((sb >> 9) & 1) << 5); R = (st >> 1) * 16 + swz / 64; C = (st & 1) * 32 + (swz % 64) / 2; }
__host__ __device__ __forceinline__ int perm32(int rho) { const int n = rho >> 4, i = rho & 15; return 8 * (i >> 2) + 4 * n + (i & 3); }
struct Unit { int pm, pn; const char* A; const char* B; const unsigned* gat; };
struct Gemm { const h16* A; const h16* Bt; int M, N, K; };
struct StaticOrder {
    int nM, nN, nwg, G, c; const char* A; const char* B; size_t tstep;
    __device__ void init(const Gemm& g, int G_, int c_) { nM = g.M / BM; nN = g.N / BM; nwg = nM * nN; G = G_; c = c_; A = (const char*)g.A; B = (const char*)g.Bt; tstep = (size_t)BM * g.K * 2; }
    __device__ bool next(int i, Unit& u) const {
        const long L = (long)i * G + c; if (L >= nwg) return false;
        int wgid = (int)L; { const int q = nwg / NXCD, r = nwg % NXCD, xcd = wgid % NXCD, off = wgid / NXCD; wgid = (xcd < r ? xcd * (q + 1) : r * (q + 1) + (xcd - r) * q) + off; }
        const int nig = WGM * nN, gid = wgid / nig, fm = gid * WGM, gsz = (nM - fm) < WGM ? (nM - fm) : WGM;
        u.pm = fm + ((wgid % nig) % gsz); u.pn = (wgid % nig) / gsz; u.A = A + (size_t)u.pm * tstep; u.B = B + (size_t)u.pn * tstep; u.gat = nullptr; return true;
    }
};
__device__ __forceinline__ unsigned cvt_pk_f16(float lo, float hi) { f32x2 v = {lo, hi}; h16x2 h = __builtin_convertvector(v, h16x2); return __builtin_bit_cast(unsigned, h); }

struct EpiF16 {
    static constexpr bool PERM = true;
    h16* O; int ldc;
    __device__ __forceinline__ void operator()(const f32x4 (&acc)[2][2][4][2], const Unit& u, int wr, int wc, int fr, int fq) const {
        const int row0 = u.pm * BM + wr * 64 + fr; const int col0 = u.pn * BM + wc * 32 + 8 * fq;
#pragma unroll
        for (int ai = 0; ai < 2; ++ai)
#pragma unroll
            for (int m = 0; m < 4; ++m) { h16* rowp = O + (size_t)(row0 + ai * HALF + m * 16) * ldc + col0;
#pragma unroll
                for (int bj = 0; bj < 2; ++bj) { const f32x4 v0 = acc[ai][bj][m][0], v1 = acc[ai][bj][m][1];
                    *(h16x8*)(rowp + bj * HALF) = __builtin_convertvector(__builtin_shufflevector(v0, v1, 0, 1, 2, 3, 4, 5, 6, 7), h16x8); } }
    }
};
struct EpiResF32 {
    static constexpr bool PERM = false;
    float* C; const float* R; int ldc; float alpha;
    __device__ __forceinline__ void operator()(const f32x4 (&acc)[2][2][4][2], const Unit& u, int wr, int wc, int fr, int fq) const {
        const int row0 = u.pm * BM + wr * 64 + fr, col0 = u.pn * BM + wc * 32 + 4 * fq;
#pragma unroll
        for (int ai = 0; ai < 2; ++ai)
#pragma unroll
            for (int m = 0; m < 4; ++m) { const size_t off = (size_t)(row0 + ai * HALF + m * 16) * ldc + col0;
#pragma unroll
                for (int bj = 0; bj < 2; ++bj)
#pragma unroll
                    for (int n = 0; n < 2; ++n) { const f32x4 r = *(const f32x4*)(R + off + bj * HALF + n * 16); *(f32x4*)(C + off + bj * HALF + n * 16) = r * alpha + acc[ai][bj][m][n]; } }
    }
};
struct EpiCmp1 {
    static constexpr bool PERM = true;
    h16* O; const float* peb;
    __device__ __forceinline__ void operator()(const f32x4 (&acc)[2][2][4][2], const Unit& u, int wr, int wc, int fr, int fq) const {
        const int row0 = u.pm * BM + wr * 64 + fr; const int col0 = wc * 32 + 8 * fq;
#pragma unroll
        for (int bj = 0; bj < 2; ++bj) { const f32x4 b0 = *(const f32x4*)(peb + col0 + bj * HALF), b1 = *(const f32x4*)(peb + col0 + bj * HALF + 4);
#pragma unroll
            for (int ai = 0; ai < 2; ++ai)
#pragma unroll
                for (int m = 0; m < 4; ++m) { f32x4 v0 = acc[ai][bj][m][0] + b0, v1 = acc[ai][bj][m][1] + b1;
#pragma unroll
                    for (int r = 0; r < 4; ++r) { v0[r] = v0[r] / (1.f + __expf(-v0[r])); v1[r] = v1[r] / (1.f + __expf(-v1[r])); }
                    *(h16x8*)(O + (size_t)(row0 + ai * HALF + m * 16) * 256 + col0 + bj * HALF) = __builtin_convertvector(__builtin_shufflevector(v0, v1, 0, 1, 2, 3, 4, 5, 6, 7), h16x8); } }
    }
};
struct EpiGateUp {
    static constexpr bool PERM = true;
    h16* H;
    __device__ __forceinline__ void operator()(const f32x4 (&acc)[2][2][4][2], const Unit& u, int wr, int wc, int fr, int fq) const {
        const int row0 = u.pm * BM + wr * 64 + fr; const int col0 = u.pn * 128 + wc * 16 + 4 * fq;
#pragma unroll
        for (int ai = 0; ai < 2; ++ai)
#pragma unroll
            for (int m = 0; m < 4; ++m) { h16* rowp = H + (size_t)(row0 + ai * HALF + m * 16) * 256 + col0;
#pragma unroll
                for (int bj = 0; bj < 2; ++bj) { const f32x4 v0 = acc[ai][bj][m][0], v1 = acc[ai][bj][m][1];
                    const float h0 = v0[0] / (1.f + __expf(-v0[0])) * v0[1], h1 = v0[2] / (1.f + __expf(-v0[2])) * v0[3];
                    const float h2 = v1[0] / (1.f + __expf(-v1[0])) * v1[1], h3 = v1[2] / (1.f + __expf(-v1[2])) * v1[3];
                    *(h16x4*)(rowp + bj * 64) = __builtin_convertvector((f32x4){h0, h1, h2, h3}, h16x4); } }
    }
};
struct EpiDown {
    static constexpr bool PERM = true;
    h16* Y; const u32x2* rowmeta;
    __device__ __forceinline__ void operator()(const f32x4 (&acc)[2][2][4][2], const Unit& u, int wr, int wc, int fr, int fq) const {
        const int row0 = u.pm * BM + wr * 64 + fr; const int col0 = u.pn * BM + wc * 32 + 8 * fq;
#pragma unroll
        for (int ai = 0; ai < 2; ++ai)
#pragma unroll
            for (int m = 0; m < 4; ++m) { const u32x2 md = rowmeta[row0 + ai * HALF + m * 16]; const int slot = (int)md.x; const float w8 = __uint_as_float(md.y);
                if (slot >= 0) { h16* rowp = Y + (size_t)slot * 1024 + col0;
#pragma unroll
                    for (int bj = 0; bj < 2; ++bj) { const f32x4 v0 = acc[ai][bj][m][0] * w8, v1 = acc[ai][bj][m][1] * w8;
                        *(h16x8*)(rowp + bj * HALF) = __builtin_convertvector(__builtin_shufflevector(v0, v1, 0, 1, 2, 3, 4, 5, 6, 7), h16x8); } }
                asm volatile("" ::: "memory"); }
    }
};

template <class Epi, class Sched>
__device__ __forceinline__ void gemm_phase(PG8_LAS unsigned char* lds, const int K, const Sched& S, const Epi& E, const size_t kstepA = (size_t)(BK * 2)) {
    const int tid = tidx(), wid = __builtin_amdgcn_readfirstlane(tid >> 6), lane = tid & 63, wr = wid >> 2, wc = wid & 3, fr = lane & 15, fq = lane >> 4;
    const int nt = K / BK;
    int R0, C0; stage_rc(tid * 16, R0, C0);
    const unsigned cb2 = (unsigned)C0 * 2u;
    unsigned voffB[2];
#pragma unroll
    for (int i = 0; i < 2; ++i) { const int R = R0 + 64 * i; const int Rb = Epi::PERM ? ((R & ~31) + perm32(R & 31)) : R; voffB[i] = (unsigned)(Rb * K) * 2u + cb2; }
    const size_t kstep = (size_t)(BK * 2);
    const size_t hstep = (size_t)HALF * K * 2;
    const unsigned ldsw = (unsigned)wid * 1024u;
    const int aoff = lds_byte(wr * 64 + fr, fq * 8), boff = lds_byte(wc * 32 + fr, fq * 8);
#define PG8_MKVA(u, va) do { _Pragma("unroll") for (int _h = 0; _h < 2; ++_h) _Pragma("unroll") for (int _i = 0; _i < 2; ++_i) { const int _r = _h * HALF + R0 + 64 * _i; \
        (va)[_h][_i] = ((u).gat ? (u).gat[_r] : (unsigned)(_r * K) * 2u) + cb2; } } while (0)
#define PG8_SA(b, h) (((b) * 2 + (h)) * HTB)
#define PG8_SB(b, h) ((4 + (b) * 2 + (h)) * HTB)
#define PG8_STAGE(bufoff, gbase, voff) do { _Pragma("unroll") for (int _i = 0; _i < 2; ++_i) \
        __builtin_amdgcn_global_load_lds((const unsigned*)((const char*)(gbase) + (voff)[_i]), (PG8_LAS unsigned*)(lds + (bufoff) + ldsw + _i * 8192), 16, 0, 0); } while (0)
#define PG8_LDA(dst, b, h) do { _Pragma("unroll") for (int m = 0; m < 4; ++m) _Pragma("unroll") for (int k = 0; k < 2; ++k) dst[m][k] = *(const PG8_LAS s16x8*)(lds + PG8_SA(b, h) + aoff + m * 2048 + k * 1024); } while (0)
#define PG8_LDB(dst, b, h) do { _Pragma("unroll") for (int n = 0; n < 2; ++n) _Pragma("unroll") for (int k = 0; k < 2; ++k) dst[n][k] = *(const PG8_LAS s16x8*)(lds + PG8_SB(b, h) + boff + n * 2048 + k * 1024); } while (0)
#define PG8_MMA(ai, bj, At, Bt) do { __builtin_amdgcn_s_setprio(1); _Pragma("unroll") for (int m = 0; m < 4; ++m) _Pragma("unroll") for (int n = 0; n < 2; ++n) _Pragma("unroll") for (int k = 0; k < 2; ++k) \
        acc[ai][bj][m][n] = __builtin_amdgcn_mfma_f32_16x16x32_f16(__builtin_bit_cast(h16x8, Bt[n][k]), __builtin_bit_cast(h16x8, At[m][k]), acc[ai][bj][m][n], 0, 0, 0); __builtin_amdgcn_s_setprio(0); } while (0)
#define PG8_WAIT_V(n) asm volatile("s_waitcnt vmcnt(" #n ")" ::: "memory")
#define PG8_WAIT_L(n) asm volatile("s_waitcnt lgkmcnt(" #n ")" ::: "memory")
#define PG8_BAR __builtin_amdgcn_s_barrier()
#define PG8_SCHED __builtin_amdgcn_sched_barrier(0)
    Unit cur, nxt; int ui = 0;
    if (!S.next(0, cur)) return;
    unsigned va[2][2];
    PG8_MKVA(cur, va);
    f32x4 acc[2][2][4][2];
#pragma unroll
    for (int a = 0; a < 2; ++a)
#pragma unroll
        for (int b = 0; b < 2; ++b)
#pragma unroll
            for (int m = 0; m < 4; ++m)
#pragma unroll
                for (int n = 0; n < 2; ++n) acc[a][b][m][n] = (f32x4){0.f, 0.f, 0.f, 0.f};
    s16x8 At[4][2], B0[2][2], B1[2][2];
    const char* cA = cur.A; const char* cB = cur.B;
    {
        PG8_STAGE(PG8_SB(0, 0), cB, voffB); PG8_STAGE(PG8_SB(0, 1), cB + hstep, voffB); PG8_STAGE(PG8_SA(0, 0), cA, va[0]); PG8_STAGE(PG8_SA(0, 1), cA, va[1]);
        if (wr == 1) PG8_BAR;
        PG8_WAIT_V(2); PG8_BAR;
        PG8_STAGE(PG8_SB(1, 0), cB + kstep, voffB); PG8_STAGE(PG8_SA(1, 0), cA + kstepA, va[0]); PG8_STAGE(PG8_SB(1, 1), cB + hstep + kstep, voffB);
        PG8_WAIT_V(6); PG8_BAR;
    }
    for (;;) {
        const bool has_next = S.next(ui + 1, nxt);
        const char* nA = has_next ? nxt.A : cA; const char* nB = has_next ? nxt.B : cB;
#pragma unroll 1
        for (int t = 0; t < nt; t += 2) {
            const bool last = (t == nt - 2);
            const char* a1 = cA + (size_t)(t + 1) * kstepA;
            const char* a2 = last ? nA : cA + (size_t)(t + 2) * kstepA; const char* b2 = last ? nB : cB + (size_t)(t + 2) * kstep;
            const char* a3 = a2 + kstepA; const char* b3 = b2 + kstep;
            PG8_LDB(B0, 0, 0); PG8_LDB(B1, 0, 1); PG8_SCHED; PG8_LDA(At, 0, 0); PG8_STAGE(PG8_SA(1, 1), a1, va[1]);
            if (last && has_next) { PG8_MKVA(nxt, va); }
            PG8_WAIT_V(8); PG8_WAIT_L(0); PG8_BAR; PG8_MMA(0, 0, At, B0); PG8_MMA(0, 1, At, B1); PG8_BAR; PG8_SCHED;
            PG8_LDA(At, 0, 1); PG8_STAGE(PG8_SB(0, 0), b2, voffB); PG8_STAGE(PG8_SB(0, 1), b2 + hstep, voffB); PG8_STAGE(PG8_SA(0, 0), a2, va[0]);
            PG8_WAIT_V(8); PG8_WAIT_L(0); PG8_BAR; PG8_MMA(1, 0, At, B0); PG8_MMA(1, 1, At, B1); PG8_BAR; PG8_SCHED;
            PG8_LDB(B0, 1, 0); PG8_LDB(B1, 1, 1); PG8_SCHED; PG8_LDA(At, 1, 0); PG8_STAGE(PG8_SA(0, 1), a2, va[1]);
            PG8_WAIT_V(8); PG8_WAIT_L(0); PG8_BAR; PG8_MMA(0, 0, At, B0); PG8_MMA(0, 1, At, B1); PG8_BAR; PG8_SCHED;
            PG8_LDA(At, 1, 1); PG8_STAGE(PG8_SB(1, 0), b3, voffB); PG8_STAGE(PG8_SB(1, 1), b3 + hstep, voffB); PG8_STAGE(PG8_SA(1, 0), a3, va[0]);
            PG8_WAIT_V(8); PG8_WAIT_L(0); PG8_BAR; PG8_MMA(1, 0, At, B0); PG8_MMA(1, 1, At, B1); PG8_BAR; PG8_SCHED;
        }
        if (wr == 0) PG8_BAR;
        E(acc, cur, wr, wc, fr, fq);
        if (!has_next) break;
#pragma unroll
        for (int a = 0; a < 2; ++a)
#pragma unroll
            for (int b = 0; b < 2; ++b)
#pragma unroll
                for (int m = 0; m < 4; ++m)
#pragma unroll
                    for (int n = 0; n < 2; ++n) acc[a][b][m][n] = (f32x4){0.f, 0.f, 0.f, 0.f};
        cur = nxt; cA = nA; cB = nB; ++ui;
        if (wr == 1) PG8_BAR;
    }
    PG8_WAIT_V(0);
    PG8_BAR;
#undef PG8_MKVA
#undef PG8_SA
#undef PG8_SB
#undef PG8_STAGE
#undef PG8_LDA
#undef PG8_LDB
#undef PG8_MMA
#undef PG8_WAIT_V
#undef PG8_WAIT_L
#undef PG8_BAR
#undef PG8_SCHED
}
}


#include <hip/hip_cooperative_groups.h>
namespace cg = cooperative_groups;
constexpr int NTHR = 512;
constexpr int LDS_BYTES = 147456;
#define LAS __attribute__((address_space(3)))

struct Params {
    const float *x, *mem; const int* positions;
    const float *w_in, *pe_k, *pe_v, *w1k, *w2k, *w1v, *w2v, *w_out, *ln1g, *ln1b, *w_xq, *w_xkv, *w_xo, *ln2g, *ln2b, *w_router, *rbias, *w_gate, *w_up, *w_down, *ws_gate, *ws_up, *ws_down, *ln3g, *ln3b;
    float* out; unsigned char* ws;
    float lg[4];
    int ph_lo, ph_hi;
};

__device__ __forceinline__ float wave_sum(float v) {
#pragma unroll
    for (int o = 1; o < 64; o <<= 1) v += __shfl_xor(v, o);
    return v;
}
__device__ __forceinline__ float wave_max(float v) {
#pragma unroll
    for (int o = 1; o < 64; o <<= 1) v = fmaxf(v, __shfl_xor(v, o));
    return v;
}
__device__ __forceinline__ float siluf(float v) { return v / (1.f + __expf(-v)); }
__device__ __forceinline__ float sigmf(float v) { return 1.f / (1.f + __expf(-v)); }

__device__ __forceinline__ void b_transpose_tile(const float* __restrict__ W, int K, int N, h16* __restrict__ WT, int Npad, int tile, float* tl, int lt, int rs = 1, int ro = 0) {
    const int ntn = Npad / 32; const int n0 = (tile % ntn) * 32, k0 = (tile / ntn) * 32, tx = lt & 31, ty = lt >> 5;
    for (int i = ty; i < 32; i += 8) { const int k = k0 + i, n = n0 + tx; tl[i * 33 + tx] = (n < N) ? W[(size_t)k * N + n] : 0.f; }
    __syncthreads();
    for (int i = ty; i < 32; i += 8) { const int n = n0 + i, k = k0 + tx; WT[(size_t)(n * rs + ro) * K + k] = (h16)tl[tx * 33 + i]; }
    __syncthreads();
}
__device__ __forceinline__ void b_cvt(const float* __restrict__ x, h16* __restrict__ o, size_t n4) {
    for (size_t i = (size_t)blockIdx.x * NTHR + tidx(); i < n4; i += (size_t)gridDim.x * NTHR) {
        const f32x4 v = ((const f32x4*)x)[i]; ((h16x4*)o)[i] = __builtin_convertvector(v, h16x4); }
}

__device__ __forceinline__ void b_tables(const int* __restrict__ positions, float* __restrict__ cosr, float* __restrict__ sinr, float* __restrict__ cosn, float* __restrict__ sinn) {
    for (int idx = blockIdx.x * NTHR + tidx(); idx < M * 72; idx += gridDim.x * NTHR) {
        const int m = idx / 72, j = idx % 72; const float pos = (float)positions[m];
        const float inv = j < 64 ? (float)pow(10000.0, -(double)j / 64.0) : (float)pow(500000.0, -(double)(j - 64) / 8.0);
        const float ang = pos * inv; double sd, cd; sincos((double)ang, &sd, &cd);
        if (j < 64) { cosr[(size_t)m * 64 + j] = (float)cd; sinr[(size_t)m * 64 + j] = (float)sd; } else { cosn[(size_t)m * 8 + j - 64] = (float)cd; sinn[(size_t)m * 8 + j - 64] = (float)sd; }
    }
}
__device__ __forceinline__ void b_rope(const h16* __restrict__ h, h16* __restrict__ rqr, h16* __restrict__ rkr, h16* __restrict__ nqr, h16* __restrict__ ksR, h16* __restrict__ kwR, const float* __restrict__ cosr, const float* __restrict__ sinr,
                                       const float* __restrict__ cosn, const float* __restrict__ sinn, int m, int j) {
    const h16* hr = h + (size_t)m * INP; const int bb = m >> 13, t = m & (T - 1);
    {   const int hd = j >> 6, jj = j & 63; const float c = cosr[(size_t)m * 64 + jj], s = sinr[(size_t)m * 64 + jj]; const size_t ro = ((size_t)(bb * 4 + hd) * T + t) * 128;
        const int o1 = hd * 128 + jj, o2 = o1 + 64;
        const float q1 = (float)hr[C_RQ + o1], q2 = (float)hr[C_RQ + o2];
        rqr[ro + jj] = (h16)(q1 * c - q2 * s); rqr[ro + jj + 64] = (h16)(q2 * c + q1 * s);
        const float k1 = (float)hr[C_RK + o1], k2 = (float)hr[C_RK + o2]; const float sc = 0.08838834764831845f;
        rkr[ro + jj] = (h16)((k1 * c - k2 * s) * sc); rkr[ro + jj + 64] = (h16)((k2 * c + k1 * s) * sc);
    }
    if (j < 64 + 16 + 16) {
        const int jj = j & 7; const float c = cosn[(size_t)m * 8 + jj], s = sinn[(size_t)m * 8 + jj];
        if (j < 64) { const int hd = j >> 3; const int o1 = hd * 64 + jj, o2 = o1 + 8;
            const float q1 = (float)hr[C_NQ + o1], q2 = (float)hr[C_NQ + o2];
            nqr[(size_t)m * 512 + o1] = (h16)(q1 * c - q2 * s); nqr[(size_t)m * 512 + o2] = (h16)(q2 * c + q1 * s);
        } else { const int jx = j - 64; const int which = jx >> 4, g = (jx >> 3) & 1; const int base = (which ? C_NKW : C_NKS) + g * 64 + jj;
            const float k1 = (float)hr[base], k2 = (float)hr[base + 8];
            h16* dst = (which ? kwR : ksR) + (((size_t)((bb * 2 + g) * 128 + (t >> 6)) * 64 + (t & 63)) * 64); dst[jj] = (h16)(k1 * c - k2 * s); dst[jj + 8] = (h16)(k2 * c + k1 * s); }
    }
    if (j >= 128 && j < 128 + 96) { const int jx = j - 128; const int which = jx / 48, r = jx % 48, g = r / 24, d = 16 + 2 * (r % 24);
        const int base = (which ? C_NKW : C_NKS) + g * 64 + d; h16* dst = (which ? kwR : ksR) + (((size_t)((bb * 2 + g) * 128 + (t >> 6)) * 64 + (t & 63)) * 64);
        dst[d] = hr[base]; dst[d + 1] = hr[base + 1]; }
    for (int i = j; i < 8 * 48; i += 256) { const int hd = i / 48, d = 16 + i % 48; nqr[(size_t)m * 512 + hd * 64 + d] = hr[C_NQ + hd * 64 + d]; }
}
__device__ __forceinline__ void b_rtrans(const Params& p, const h16* __restrict__ h, h16* __restrict__ rvT, h16* __restrict__ rkzT, const float* __restrict__ cosr, const float* __restrict__ sinr, int item, h16* sl, int lt) {
    int id = item; const int tt = id & 127; id >>= 7; const int hd = id & 3; const int b = id >> 2; const int bh = b * 4 + hd; const float lg = p.lg[hd];
    for (int i = lt; i < 64 * 128; i += 256) { const int t = i >> 7, e = i & 127; sl[t * 130 + e] = h[(size_t)(b * T + tt * 64 + t) * INP + C_RV + hd * 128 + e]; }
    __syncthreads();
    for (int i = lt; i < 64 * 128; i += 256) { const int e = i >> 6, t = i & 63; rvT[((size_t)(bh * 64 + (tt >> 1)) * 128 + e) * 128 + (tt & 1) * 64 + t] = sl[t * 130 + e]; }
    __syncthreads();
    for (int i = lt; i < 64 * 64; i += 256) { const int t = i >> 6, jj = i & 63; const size_t m = (size_t)b * T + tt * 64 + t;
        const float c = cosr[m * 64 + jj], s = sinr[m * 64 + jj]; const float k1 = (float)h[m * INP + C_RK + hd * 128 + jj], k2 = (float)h[m * INP + C_RK + hd * 128 + jj + 64];
        const float z = 0.08838834764831845f * __expf(lg * (float)(127 - ((tt * 64 + t) & 127)));
        sl[t * 130 + jj] = (h16)((k1 * c - k2 * s) * z); sl[t * 130 + jj + 64] = (h16)((k2 * c + k1 * s) * z); }
    __syncthreads();
    for (int i = lt; i < 64 * 128; i += 256) { const int d = i >> 6, t = i & 63; rkzT[((size_t)(bh * 64 + (tt >> 1)) * 128 + d) * 128 + (tt & 1) * 64 + t] = sl[t * 130 + d]; }
    __syncthreads();
}
__device__ __forceinline__ void b_mvtrans(const h16* __restrict__ kvm, h16* __restrict__ kvmVT, h16* __restrict__ kx, int item, h16* sl, int lt) {
    int id = item; const int kt = id & 3; id >>= 2; const int dtl = id & 3; id >>= 2; const int hh = id & 3; const int b = id >> 2;
    for (int i = lt; i < 64 * 64; i += 256) { const int k = i >> 6, d = i & 63; sl[k * 66 + d] = kvm[(size_t)(b * MEML + kt * 64 + k) * 2048 + 1024 + hh * 256 + dtl * 64 + d];
        kx[((size_t)(b * 4 + hh) * MEML + kt * 64 + k) * 256 + dtl * 64 + d] = kvm[(size_t)(b * MEML + kt * 64 + k) * 2048 + hh * 256 + dtl * 64 + d]; }
    __syncthreads();
    for (int i = lt; i < 64 * 64; i += 256) { const int d = i >> 6, k = i & 63; kvmVT[(size_t)((b * 4 + hh) * 256 + dtl * 64 + d) * MEML + kt * 64 + k] = sl[k * 66 + d]; }
    __syncthreads();
}

struct CmpSched {
    const char* hbase; const unsigned* cmpoff; const char* Wc1T; int c;
    __device__ bool next(int i, pg8::Unit& u) const {
        if (i > 0 || c >= 32) return false; const int kv = c >> 4, rt = c & 15;
        u.pm = kv * 16 + rt; u.pn = 0; u.A = hbase + (size_t)(kv ? C_NVC : C_NKC) * 2; u.gat = cmpoff + rt * 256; u.B = Wc1T + (size_t)kv * 256 * 2048 * 2; return true; }
};
__device__ __forceinline__ void b_cmp2(const Params& p, const h16* __restrict__ hid, h16* __restrict__ kcmp, h16* __restrict__ vcmpT) {
    const int lane = tidx() & 63;
    for (int r = blockIdx.x * 8 + (tidx() >> 6); r < 2 * 4096; r += gridDim.x * 8) {
        const int kv = r >> 12, rr = r & 4095, g = rr & 1, c = (rr >> 1) & 511, b = rr >> 10;
        const float* w2 = kv ? p.w2v : p.w2k; const h16* hr = hid + (size_t)r * 256; float acc = 0.f;
        for (int j = 0; j < 256; j += 8) { const h16x8 hv = *(const h16x8*)(hr + j);
#pragma unroll
            for (int x = 0; x < 8; ++x) acc += (float)hv[x] * w2[(j + x) * 64 + lane]; }
        if (c == 511) acc = 0.f;
        if (kv == 0) kcmp[((size_t)(b * 2 + g) * 512 + c) * 64 + lane] = (h16)acc;
        else vcmpT[(((size_t)(b * 2 + g) * 8 + (c >> 6)) * 64 + lane) * 64 + (c & 63)] = (h16)acc;
    }
}
__device__ __forceinline__ void b_vtrans(const h16* __restrict__ h, h16* __restrict__ vsT, h16* __restrict__ vwT, int item, h16* sl, int lt) {
    int id = item; const int tt = id & 127; id >>= 7; const int g = id & 1; id >>= 1; const int b = id & 3; const int which = id >> 2;
    const int col = (which ? C_NVW : C_NVS) + g * 64; h16* dst = (which ? vwT : vsT) + (size_t)((b * 2 + g) * 128 + tt) * 4096;
    for (int i = lt; i < 64 * 64; i += 256) { const int t = i >> 6, d = i & 63; sl[t * 66 + d] = h[(size_t)(b * T + tt * 64 + t) * INP + col + d]; }
    __syncthreads();
    for (int i = lt; i < 64 * 64; i += 256) { const int d = i >> 6, t = i & 63; dst[d * 64 + t] = sl[t * 66 + d]; }
    __syncthreads();
}

__device__ __forceinline__ void ret_kv_unit(const h16* __restrict__ rkzT, const h16* __restrict__ rvT, float* __restrict__ kvT, int chunk, int w, int lane) {
    const int i = lane & 15, kg = lane >> 4; const int bh = chunk >> 6, n = chunk & 63;
    h16x8 a[4];
#pragma unroll
    for (int ks = 0; ks < 4; ++ks) a[ks] = *(const h16x8*)(rkzT + ((size_t)chunk * 128 + 16 * w + i) * 128 + 32 * ks + 8 * kg);
#pragma unroll
    for (int et = 0; et < 8; ++et) { f32x4 acc = {0.f, 0.f, 0.f, 0.f};
#pragma unroll
        for (int ks = 0; ks < 4; ++ks) { const h16x8 bq = *(const h16x8*)(rvT + ((size_t)chunk * 128 + 16 * et + i) * 128 + 32 * ks + 8 * kg); acc = __builtin_amdgcn_mfma_f32_16x16x32_f16(a[ks], bq, acc, 0, 0, 0); }
        *(f32x4*)(kvT + ((size_t)chunk * 128 + 16 * et + i) * 128 + 16 * w + 4 * kg) = acc; }
}
__device__ __forceinline__ void b_ret_scan(const Params& p, const float* __restrict__ kvT, h16* __restrict__ prevT) {
    for (int gid = blockIdx.x * NTHR + tidx(); gid < 16 * 16384; gid += gridDim.x * NTHR) {
        const int de = gid & 16383, bh = gid >> 14; const float cd = __expf(p.lg[bh & 3] * 128.f);
        float st = 0.f;
        for (int n = 0; n < 64; ++n) { const size_t o = ((size_t)(bh * 64 + n) << 14) + de; prevT[o] = (h16)st; st = st * cd + kvT[o]; }
    }
}
__device__ __forceinline__ void ret_out_unit(const Params& p, const h16* __restrict__ h, const h16* __restrict__ rqr, const h16* __restrict__ rkr, const h16* __restrict__ rvT, const h16* __restrict__ prevT,
                                             h16* __restrict__ mix, int chunk, int w, int lane) {
    const int i = lane & 15, kg = lane >> 4; const int bh = chunk >> 6, n = chunk & 63, b = bh >> 2, hd = bh & 3; const float lg = p.lg[hd];
    const int qi = 16 * w + i; const size_t m = (size_t)b * T + n * 128 + qi;
    h16x8 qf[4];
#pragma unroll
    for (int ks = 0; ks < 4; ++ks) qf[ks] = *(const h16x8*)(rqr + ((size_t)bh * T + n * 128 + qi) * 128 + 32 * ks + 8 * kg);
    f32x4 inner[8], cross[8];
#pragma unroll
    for (int et = 0; et < 8; ++et) { inner[et] = (f32x4){0.f, 0.f, 0.f, 0.f}; cross[et] = (f32x4){0.f, 0.f, 0.f, 0.f}; }
    for (int gq = 0; gq < 2; ++gq) {
        if (64 * gq > 16 * w + 15) break;
        f32x4 s[4];
#pragma unroll
        for (int tl = 0; tl < 4; ++tl) { const int ko = 32 * (tl >> 1) + 8 * (i >> 2) + 4 * (tl & 1) + (i & 3); const h16* kp = rkr + ((size_t)bh * T + n * 128 + 64 * gq + ko) * 128 + 8 * kg;
            f32x4 acc = {0.f, 0.f, 0.f, 0.f};
#pragma unroll
            for (int ks = 0; ks < 4; ++ks) acc = __builtin_amdgcn_mfma_f32_16x16x32_f16(*(const h16x8*)(kp + 32 * ks), qf[ks], acc, 0, 0, 0);
            s[tl] = acc; }
        h16x8 pf[2];
#pragma unroll
        for (int tl = 0; tl < 4; ++tl)
#pragma unroll
            for (int r = 0; r < 4; ++r) { const int j = 64 * gq + 32 * (tl >> 1) + 8 * kg + 4 * (tl & 1) + r; const float v = (j <= qi) ? s[tl][r] * __expf(lg * (float)(qi - j)) : 0.f; pf[tl >> 1][4 * (tl & 1) + r] = (h16)v; }
#pragma unroll
        for (int et = 0; et < 8; ++et)
#pragma unroll
            for (int s2 = 0; s2 < 2; ++s2) { const h16x8 a = *(const h16x8*)(rvT + ((size_t)chunk * 128 + 16 * et + i) * 128 + 64 * gq + 32 * s2 + 8 * kg); inner[et] = __builtin_amdgcn_mfma_f32_16x16x32_f16(a, pf[s2], inner[et], 0, 0, 0); }
    }
#pragma unroll
    for (int et = 0; et < 8; ++et)
#pragma unroll
        for (int ks = 0; ks < 4; ++ks) { const h16x8 a = *(const h16x8*)(prevT + ((size_t)chunk * 128 + 16 * et + i) * 128 + 32 * ks + 8 * kg); cross[et] = __builtin_amdgcn_mfma_f32_16x16x32_f16(a, qf[ks], cross[et], 0, 0, 0); }
    const float xi = __expf(lg * (float)(qi + 1));
    float sm = 0.f;
#pragma unroll
    for (int et = 0; et < 8; ++et) { inner[et] = inner[et] + cross[et] * xi; sm += (inner[et][0] + inner[et][1]) + (inner[et][2] + inner[et][3]); }
    sm += __shfl_xor(sm, 16); sm += __shfl_xor(sm, 32);
    const float mu = sm * (1.f / 128.f); float sq = 0.f;
#pragma unroll
    for (int et = 0; et < 8; ++et) { inner[et] = inner[et] - mu; sq += (inner[et][0] * inner[et][0] + inner[et][1] * inner[et][1]) + (inner[et][2] * inner[et][2] + inner[et][3] * inner[et][3]); }
    sq += __shfl_xor(sq, 16); sq += __shfl_xor(sq, 32);
    const float rstd = rsqrtf(sq * (1.f / 128.f) + LN_EPS);
#pragma unroll
    for (int et = 0; et < 8; ++et) { const int e = 16 * et + 4 * kg; const h16x4 gv = *(const h16x4*)(h + m * INP + C_RG + hd * 128 + e);
        f32x4 o;
#pragma unroll
        for (int r = 0; r < 4; ++r) o[r] = siluf((float)gv[r]) * inner[et][r] * rstd;
        *(h16x4*)(mix + m * D + hd * 128 + e) = __builtin_convertvector(o, h16x4); }
}

struct AttSt { float m, l; f32x4 o[4]; };
struct KFrag { h16x8 a[4][2]; };
struct VFrag { h16x8 a[4][2]; };
__device__ __forceinline__ void ldk(KFrag& k, const h16* __restrict__ Kb, int pitchK, int i, int kg) {
#pragma unroll
    for (int tl = 0; tl < 4; ++tl) { const int ko = 32 * (tl >> 1) + 8 * (i >> 2) + 4 * (tl & 1) + (i & 3); const h16* kp = Kb + (size_t)ko * pitchK + 8 * kg;
        k.a[tl][0] = *(const h16x8*)kp; k.a[tl][1] = *(const h16x8*)(kp + 32); }
}
__device__ __forceinline__ void ldv(VFrag& v, const h16* __restrict__ VTb, int vstride, int i, int kg) {
#pragma unroll
    for (int dt = 0; dt < 4; ++dt)
#pragma unroll
        for (int s2 = 0; s2 < 2; ++s2) v.a[dt][s2] = *(const h16x8*)(VTb + (size_t)(16 * dt + i) * vstride + 32 * s2 + 8 * kg);
}
template <class MaskF>
__device__ __forceinline__ void att_scores(f32x4 (&s)[4], const KFrag& k, const h16x8 (&qf)[2], int kg, MaskF valid) {
#pragma unroll
    for (int tl = 0; tl < 4; ++tl) { f32x4 z = {0.f, 0.f, 0.f, 0.f}; z = __builtin_amdgcn_mfma_f32_16x16x32_f16(k.a[tl][0], qf[0], z, 0, 0, 0); s[tl] = __builtin_amdgcn_mfma_f32_16x16x32_f16(k.a[tl][1], qf[1], z, 0, 0, 0); }
#pragma unroll
    for (int tl = 0; tl < 4; ++tl)
#pragma unroll
        for (int r = 0; r < 4; ++r) { const int ko = 32 * (tl >> 1) + 8 * kg + 4 * (tl & 1) + r; s[tl][r] = valid(ko) ? s[tl][r] * 0.125f : -INFINITY; }
}
__device__ __forceinline__ void att_pv(f32x4 (&o)[4], const f32x4 (&pv)[4], const VFrag& v) {
    h16x8 pf[2];
#pragma unroll
    for (int s2 = 0; s2 < 2; ++s2)
#pragma unroll
        for (int j = 0; j < 8; ++j) pf[s2][j] = (h16)pv[2 * s2 + (j >> 2)][j & 3];
#pragma unroll
    for (int dt = 0; dt < 4; ++dt)
#pragma unroll
        for (int s2 = 0; s2 < 2; ++s2) o[dt] = __builtin_amdgcn_mfma_f32_16x16x32_f16(v.a[dt][s2], pf[s2], o[dt], 0, 0, 0);
}
template <class MaskF>
__device__ __forceinline__ void att_tile(AttSt& st, const KFrag& k, const VFrag& v, const h16x8 (&qf)[2], int kg, MaskF valid) {
    f32x4 s[4]; att_scores(s, k, qf, kg, valid);
    float mx = -INFINITY;
#pragma unroll
    for (int tl = 0; tl < 4; ++tl)
#pragma unroll
        for (int r = 0; r < 4; ++r) mx = fmaxf(mx, s[tl][r]);
    mx = fmaxf(mx, __shfl_xor(mx, 16)); mx = fmaxf(mx, __shfl_xor(mx, 32));
    const float mn = fmaxf(st.m, mx); const float alpha = __expf(st.m - mn); st.m = mn;
    float ps = 0.f;
#pragma unroll
    for (int tl = 0; tl < 4; ++tl)
#pragma unroll
        for (int r = 0; r < 4; ++r) { const float pe = __expf(s[tl][r] - mn); s[tl][r] = pe; ps += pe; }
    st.l = st.l * alpha + ps;
#pragma unroll
    for (int dt = 0; dt < 4; ++dt) st.o[dt] = st.o[dt] * alpha;
    att_pv(st.o, s, v);
}
constexpr int NSA_NSLOT = 5, NSA_RING = 0, NSA_IMP = NSA_NSLOT * 16384, NSA_MSK = NSA_IMP + 32768, NSA_LIST = NSA_MSK + 256;
__device__ __forceinline__ void ldk_lds(KFrag& k, LAS const unsigned char* slot, int ko0, int ko1) {
#pragma unroll
    for (int tl = 0; tl < 4; ++tl) { const int o = (32 * (tl >> 1) + 4 * (tl & 1)) * 128; k.a[tl][0] = *(LAS const h16x8*)(slot + o + ko0); k.a[tl][1] = *(LAS const h16x8*)(slot + o + ko1); }
}
__device__ __forceinline__ void ldv_lds(VFrag& v, LAS const unsigned char* slot, int vo0, int vo1) {
#pragma unroll
    for (int dt = 0; dt < 4; ++dt) { v.a[dt][0] = *(LAS const h16x8*)(slot + 8192 + dt * 2048 + vo0); v.a[dt][1] = *(LAS const h16x8*)(slot + 8192 + dt * 2048 + vo1); }
}
#define NSA_WAITV(n) asm volatile("s_waitcnt vmcnt(" #n ")" ::: "memory")
#define NSA_BAR() do { asm volatile("s_waitcnt lgkmcnt(0)" ::: "memory"); __builtin_amdgcn_s_barrier(); asm volatile("" ::: "memory"); } while (0)
template <int LPT, class IssueF, class CompF>
__device__ __forceinline__ void nsa_stream(int n, LAS unsigned char* dmaw, LAS unsigned char* ring, IssueF issue, CompF comp) {
#pragma unroll
    for (int j = 0; j < NSA_NSLOT - 1; ++j) if (j < n) issue(j, (LAS unsigned*)(dmaw + j * 16384));
    int st = 0, si = (NSA_NSLOT - 1) * 16384;
    for (int t = 0; t < n; ++t) {
        const int ahead = n - 1 - t;
        if (ahead >= 3) { if (LPT == 2) NSA_WAITV(6); else NSA_WAITV(3); }
        else if (ahead == 2) { if (LPT == 2) NSA_WAITV(4); else NSA_WAITV(2); }
        else if (ahead == 1) { if (LPT == 2) NSA_WAITV(2); else NSA_WAITV(1); }
        else NSA_WAITV(0);
        NSA_BAR();
        if (t + NSA_NSLOT - 1 < n) issue(t + NSA_NSLOT - 1, (LAS unsigned*)(dmaw + si));
        comp(t, (LAS const unsigned char*)(ring + st));
        st = (st == (NSA_NSLOT - 1) * 16384) ? 0 : st + 16384; si = (si == (NSA_NSLOT - 1) * 16384) ? 0 : si + 16384; }
    NSA_BAR();
}
__device__ __forceinline__ void nsa_block_unit(const h16* __restrict__ h, const h16* __restrict__ nqr, const h16* __restrict__ kcmp, const h16* __restrict__ vcmpT, const h16* __restrict__ vsT, const h16* __restrict__ vwT,
                                               const h16* __restrict__ ksR, const h16* __restrict__ kwR, h16* __restrict__ mix, int b, int g, int T0, LAS unsigned char* lds, int wv, int lane) {
    const int i = lane & 15, kg = lane >> 4, tt = i & 3, hh = i >> 2;
    const int t0 = T0 + 4 * wv, trow = t0 + tt; const size_t mrow = (size_t)b * T + trow;
    const int q = wv * 64 + lane, qrow = q >> 3, qch = q & 7;
    const int ksrc = qrow * 128 + ((qch ^ (((qrow >> 1) & 1) | (((qrow >> 3) & 3) << 1))) << 4), vsrc = qrow * 128 + ((qch ^ ((qrow >> 1) & 7)) << 4);
    const int gki = ((i >> 1) & 1) | ((i >> 2) << 1), gvi = (i >> 1) & 7;
    const int ko0 = (8 * (i >> 2) + (i & 3)) * 128 + ((kg ^ gki) << 4), ko1 = (8 * (i >> 2) + (i & 3)) * 128 + (((kg + 4) ^ gki) << 4);
    const int vo0 = i * 128 + ((kg ^ gvi) << 4), vo1 = i * 128 + (((kg + 4) ^ gvi) << 4);
    LAS unsigned char* ring = lds + NSA_RING; LAS unsigned char* dmaw = ring + wv * 1024;
    LAS float* impA = (LAS float*)(lds + NSA_IMP + wv * 4096); LAS float* impL = impA + 512;
    h16x8 qf[2], qrf[2];
    { const h16* qp = h + mrow * INP + C_NQ + (g * 4 + hh) * 64 + 8 * kg; qf[0] = *(const h16x8*)qp; qf[1] = *(const h16x8*)(qp + 32);
      const h16* qrp = nqr + mrow * 512 + (g * 4 + hh) * 64 + 8 * kg; qrf[0] = *(const h16x8*)qrp; qrf[1] = *(const h16x8*)(qrp + 32); }
    const h16* gp = h + mrow * INP + C_NG + (g * 4 + hh) * 3; const float gt0 = (float)gp[0], gt1 = (float)gp[1], gt2 = (float)gp[2];
    for (int x = lane; x < 1024; x += 64) impA[x] = 0.f;
    NSA_WAITV(0);
#define GLDS16(gsrc, ldst) __builtin_amdgcn_global_load_lds((const unsigned*)(gsrc), (ldst), 16, 0, 0)
    const int ncv_row = trow >= 31 ? ((trow - 31) >> 4) + 1 : 0;
    const int ncv_blk = (T0 + 31 >= 31) ? ((T0 + 31 - 31) >> 4) + 1 : 0;
    const int nct = (ncv_blk + 63) >> 6;
    const unsigned char* Kc = (const unsigned char*)(kcmp + (size_t)(b * 2 + g) * 512 * 64); const unsigned char* Vc = (const unsigned char*)(vcmpT + (size_t)(b * 2 + g) * 8 * 4096);
    float m = -1e30f, l = 0.f;
    f32x4 oc[4];
#pragma unroll
    for (int dt = 0; dt < 4; ++dt) oc[dt] = (f32x4){0.f, 0.f, 0.f, 0.f};
    nsa_stream<1>(nct, dmaw, ring, [&](int j, LAS unsigned* dk) { GLDS16(Kc + (size_t)j * 8192 + ksrc, dk); }, [&](int j, LAS const unsigned char* slot) {
        KFrag kf; ldk_lds(kf, slot, ko0, ko1);
        f32x4 s[4]; att_scores(s, kf, qf, kg, [&](int ko) { return j * 64 + ko < ncv_row; });
        float mx = -INFINITY;
        _Pragma("unroll") for (int tl = 0; tl < 4; ++tl) _Pragma("unroll") for (int r = 0; r < 4; ++r) mx = fmaxf(mx, s[tl][r]);
        mx = fmaxf(mx, __shfl_xor(mx, 16)); mx = fmaxf(mx, __shfl_xor(mx, 32));
        const float mn = fmaxf(m, mx); float ps = 0.f;
        _Pragma("unroll") for (int tl = 0; tl < 4; ++tl) _Pragma("unroll") for (int r = 0; r < 4; ++r) ps += __expf(s[tl][r] - mn);
        l = l * __expf(m - mn) + ps; m = mn; });
    l += __shfl_xor(l, 16); l += __shfl_xor(l, 32);
    const float linv = l > 0.f ? 1.f / l : 0.f;
    nsa_stream<2>(nct, dmaw, ring, [&](int j, LAS unsigned* dk) { GLDS16(Kc + (size_t)j * 8192 + ksrc, dk); GLDS16(Vc + (size_t)j * 8192 + vsrc, (LAS unsigned*)((LAS unsigned char*)dk + 8192)); }, [&](int j, LAS const unsigned char* slot) {
        KFrag kf; ldk_lds(kf, slot, ko0, ko1); VFrag vf; ldv_lds(vf, slot, vo0, vo1);
        f32x4 s[4]; att_scores(s, kf, qf, kg, [&](int ko) { return j * 64 + ko < ncv_row; });
        _Pragma("unroll") for (int tl = 0; tl < 4; ++tl) {
            _Pragma("unroll") for (int r = 0; r < 4; ++r) s[tl][r] = __expf(s[tl][r] - m) * linv;
            float A = (s[tl][0] + s[tl][1]) + (s[tl][2] + s[tl][3]), L = s[tl][3];
            A += __shfl_xor(A, 4); A += __shfl_xor(A, 8); L += __shfl_xor(L, 4); L += __shfl_xor(L, 8);
            if (hh == 0) { const int u = j * 16 + 8 * (tl >> 1) + 2 * kg + (tl & 1); impA[tt * 128 + u] = A; impL[tt * 128 + u] = L; } }
        att_pv(oc, s, vf); });
    const int cur = T0 >> 6;
    AttSt sw; sw.m = -1e30f; sw.l = 0.f;
#pragma unroll
    for (int dt = 0; dt < 4; ++dt) sw.o[dt] = (f32x4){0.f, 0.f, 0.f, 0.f};
    {
        const unsigned char* Kw = (const unsigned char*)(kwR + (size_t)((b * 2 + g) * 128) * 4096); const unsigned char* Vw = (const unsigned char*)(vwT + (size_t)((b * 2 + g) * 128) * 4096);
        const int s0w = (T0 >= 511 ? (T0 - 511) >> 6 : 0);
        nsa_stream<2>(cur - s0w + 1, dmaw, ring, [&](int j, LAS unsigned* dk) { GLDS16(Kw + (size_t)(s0w + j) * 8192 + ksrc, dk); GLDS16(Vw + (size_t)(s0w + j) * 8192 + vsrc, (LAS unsigned*)((LAS unsigned char*)dk + 8192)); }, [&](int j, LAS const unsigned char* slot) {
            KFrag kf; ldk_lds(kf, slot, ko0, ko1); VFrag vf; ldv_lds(vf, slot, vo0, vo1); const int s = s0w + j;
            att_tile(sw, kf, vf, qrf, kg, [&](int ko) { const int kp = 64 * s + ko; return kp <= trow && kp >= trow - 511; }); });
    }
    unsigned long long mylo, myhi, anylo, anyhi;
    if (cur <= 15) { mylo = anylo = (1ull << (cur + 1)) - 1ull; myhi = anyhi = 0ull; }
    else {
        mylo = myhi = anylo = anyhi = 0ull;
        const unsigned long long flo = 1ull | (cur < 64 ? (1ull << cur) : 0ull) | (cur - 1 < 64 ? (1ull << (cur - 1)) : 0ull);
        const unsigned long long fhi = (cur >= 64 ? (1ull << (cur - 64)) : 0ull) | (cur - 1 >= 64 ? (1ull << (cur - 65)) : 0ull);
        const unsigned long long lmask = (1ull << lane) - 1ull;
        for (int tk = 0; tk < 4; ++tk) {
            const int s0 = lane, s1 = lane + 64;
            const float v0 = impA[tk * 128 + s0] + (s0 > 0 ? impL[tk * 128 + s0 - 1] : 0.f), v1 = impA[tk * 128 + s1] + impL[tk * 128 + s1 - 1];
            const unsigned b0 = (s0 >= 1 && s0 <= cur - 2) ? __float_as_uint(v0) + 1u : 0u, b1 = (s1 <= cur - 2) ? __float_as_uint(v1) + 1u : 0u;
            unsigned Tq = 0u;
            for (int bit = 30; bit >= 0; --bit) { const unsigned T2 = Tq | (1u << bit);
                const int c = __popcll(__ballot(b0 >= T2)) + __popcll(__ballot(b1 >= T2)); if (c >= 13) Tq = T2; }
            const unsigned long long gtlo = __ballot(b0 > Tq), gthi = __ballot(b1 > Tq), eqlo = __ballot(b0 == Tq), eqhi = __ballot(b1 == Tq);
            const int need = 13 - (__popcll(gtlo) + __popcll(gthi));
            const bool t0q = (b0 == Tq) && (__popcll(eqlo & lmask) < need), t1q = (b1 == Tq) && (__popcll(eqlo) + __popcll(eqhi & lmask) < need);
            const unsigned long long lo = gtlo | __ballot(t0q) | flo, hi = gthi | __ballot(t1q) | fhi;
            anylo |= lo; anyhi |= hi; if (tt == tk) { mylo = lo; myhi = hi; }
        }
    }
    LAS unsigned long long* msk = (LAS unsigned long long*)(lds + NSA_MSK); LAS unsigned char* lst = lds + NSA_LIST; LAS int* nlst = (LAS int*)(lds + NSA_LIST + 128);
    if (lane == 0) { msk[2 * wv] = anylo; msk[2 * wv + 1] = anyhi; }
    NSA_BAR();
    if (wv == 0) {
        unsigned long long ulo = 0ull, uhi = 0ull;
#pragma unroll
        for (int w2 = 0; w2 < 8; ++w2) { ulo |= msk[2 * w2]; uhi |= msk[2 * w2 + 1]; }
        const unsigned long long lmask = (1ull << lane) - 1ull; const int nlo = __popcll(ulo);
        if ((ulo >> lane) & 1ull) lst[__popcll(ulo & lmask)] = (unsigned char)lane;
        if ((uhi >> lane) & 1ull) lst[nlo + __popcll(uhi & lmask)] = (unsigned char)(64 + lane);
        if (lane == 0) nlst[0] = nlo + __popcll(uhi);
    }
    NSA_BAR();
    const int nsel = nlst[0];
    AttSt ss; ss.m = -1e30f; ss.l = 0.f;
#pragma unroll
    for (int dt = 0; dt < 4; ++dt) ss.o[dt] = (f32x4){0.f, 0.f, 0.f, 0.f};
    {
        const unsigned char* Ks = (const unsigned char*)(ksR + (size_t)((b * 2 + g) * 128) * 4096); const unsigned char* Vs = (const unsigned char*)(vsT + (size_t)((b * 2 + g) * 128) * 4096);
        nsa_stream<2>(nsel, dmaw, ring, [&](int j, LAS unsigned* dk) { const int sj = lst[j]; GLDS16(Ks + (size_t)sj * 8192 + ksrc, dk); GLDS16(Vs + (size_t)sj * 8192 + vsrc, (LAS unsigned*)((LAS unsigned char*)dk + 8192)); }, [&](int j, LAS const unsigned char* slot) {
            const int s = lst[j];
            if ((((s < 64 ? anylo : anyhi) >> (s & 63)) & 1ull) != 0ull) {
                KFrag kf; ldk_lds(kf, slot, ko0, ko1); VFrag vf; ldv_lds(vf, slot, vo0, vo1);
                const bool mybit = (((s < 64 ? mylo : myhi) >> (s & 63)) & 1ull) != 0ull;
                att_tile(ss, kf, vf, qrf, kg, [&](int ko) { return mybit && (64 * s + ko <= trow); }); } });
    }
    float ls = ss.l; ls += __shfl_xor(ls, 16); ls += __shfl_xor(ls, 32); float lw = sw.l; lw += __shfl_xor(lw, 16); lw += __shfl_xor(lw, 32);
    const float g0 = sigmf(gt0), g1 = sigmf(gt1) / ls, g2 = sigmf(gt2) / lw;
#pragma unroll
    for (int dt = 0; dt < 4; ++dt) { const f32x4 o = oc[dt] * g0 + ss.o[dt] * g1 + sw.o[dt] * g2;
        *(h16x4*)(mix + mrow * D + 512 + (g * 4 + hh) * 64 + 16 * dt + 4 * kg) = __builtin_convertvector(o, h16x4); }
#undef GLDS16
}

__device__ __forceinline__ void b_ln(const float* __restrict__ in, const float* __restrict__ gam, const float* __restrict__ bet, float* __restrict__ o32, h16* __restrict__ o16) {
    const int lane = tidx() & 63;
    for (int row = blockIdx.x * 8 + (tidx() >> 6); row < M; row += gridDim.x * 8) {
        const f32x4* xr = (const f32x4*)(in + (size_t)row * D) + lane;
        f32x4 v[4]; float s = 0.f;
#pragma unroll
        for (int j = 0; j < 4; ++j) { v[j] = xr[64 * j]; s += (v[j][0] + v[j][1]) + (v[j][2] + v[j][3]); }
        const float mean = wave_sum(s) * (1.f / D); float s2 = 0.f;
#pragma unroll
        for (int j = 0; j < 4; ++j) { v[j] = v[j] - mean; s2 += (v[j][0] * v[j][0] + v[j][1] * v[j][1]) + (v[j][2] * v[j][2] + v[j][3] * v[j][3]); }
        const float rstd = rsqrtf(wave_sum(s2) * (1.f / D) + LN_EPS);
#pragma unroll
        for (int j = 0; j < 4; ++j) { const f32x4 gg = ((const f32x4*)gam)[lane + 64 * j], bb = ((const f32x4*)bet)[lane + 64 * j]; const f32x4 o = v[j] * rstd * gg + bb;
            ((f32x4*)(o32 + (size_t)row * D))[lane + 64 * j] = o;
            if (o16) ((h16x4*)(o16 + (size_t)row * D))[lane + 64 * j] = __builtin_convertvector(o, h16x4); }
    }
}

__device__ __forceinline__ void xattn_unit(const h16* __restrict__ qx, const h16* __restrict__ kx, const h16* __restrict__ kvmVT, h16* __restrict__ ox, int m0, int hh, int lane) {
    const int i = lane & 15, kg = lane >> 4; const int b = m0 >> 13; const size_t m = (size_t)m0 + i;
    h16x8 qf[8];
#pragma unroll
    for (int ks = 0; ks < 8; ++ks) qf[ks] = *(const h16x8*)(qx + m * D + hh * 256 + 32 * ks + 8 * kg);
    f32x4 o[16];
#pragma unroll
    for (int dt = 0; dt < 16; ++dt) o[dt] = (f32x4){0.f, 0.f, 0.f, 0.f};
    float mrun = -1e30f, l = 0.f;
    const h16* vb = kvmVT + (size_t)((b * 4 + hh) * 256) * MEML;
#pragma unroll 1
    for (int gq = 0; gq < 4; ++gq) {
        f32x4 s[4]; float mx = -INFINITY;
#pragma unroll
        for (int tl = 0; tl < 4; ++tl) { const int ko = 64 * gq + 32 * (tl >> 1) + 8 * (i >> 2) + 4 * (tl & 1) + (i & 3); const h16* kp = kx + ((size_t)(b * 4 + hh) * MEML + ko) * 256 + 8 * kg;
            f32x4 acc = {0.f, 0.f, 0.f, 0.f};
#pragma unroll
            for (int ks = 0; ks < 8; ++ks) acc = __builtin_amdgcn_mfma_f32_16x16x32_f16(*(const h16x8*)(kp + 32 * ks), qf[ks], acc, 0, 0, 0);
            s[tl] = acc * 0.0625f; mx = fmaxf(mx, fmaxf(fmaxf(s[tl][0], s[tl][1]), fmaxf(s[tl][2], s[tl][3]))); }
        mx = fmaxf(mx, __shfl_xor(mx, 16)); mx = fmaxf(mx, __shfl_xor(mx, 32));
        const float mn = fmaxf(mrun, mx); const float alpha = __expf(mrun - mn); mrun = mn;
        float ps = 0.f; h16x8 pf[2];
#pragma unroll
        for (int tl = 0; tl < 4; ++tl)
#pragma unroll
            for (int r = 0; r < 4; ++r) { const float pe = __expf(s[tl][r] - mn); ps += pe; pf[tl >> 1][4 * (tl & 1) + r] = (h16)pe; }
        l = l * alpha + ps;
#pragma unroll
        for (int dt = 0; dt < 16; ++dt) { f32x4 acc = o[dt] * alpha;
#pragma unroll
            for (int s2 = 0; s2 < 2; ++s2) acc = __builtin_amdgcn_mfma_f32_16x16x32_f16(*(const h16x8*)(vb + (size_t)(16 * dt + i) * MEML + 64 * gq + 32 * s2 + 8 * kg), pf[s2], acc, 0, 0, 0);
            o[dt] = acc; }
    }
    l += __shfl_xor(l, 16); l += __shfl_xor(l, 32); const float linv = 1.f / l;
#pragma unroll
    for (int dt = 0; dt < 16; ++dt) { const f32x4 acc = o[dt] * linv; *(h16x4*)(ox + m * D + hh * 256 + 16 * dt + 4 * kg) = __builtin_convertvector(acc, h16x4); }
}

__device__ __forceinline__ void route_token(float logit, int m, int lane, const float* __restrict__ rbias, int* __restrict__ tope, float* __restrict__ topw, int* __restrict__ hist) {
    const float score = 1.f / (1.f + expf(-logit)); const float biased = score + rbias[lane];
    float m1 = biased; m1 = fmaxf(m1, __shfl_xor(m1, 1)); m1 = fmaxf(m1, __shfl_xor(m1, 2)); m1 = fmaxf(m1, __shfl_xor(m1, 4));
    int am = (biased == m1) ? lane : 999; am = min(am, __shfl_xor(am, 1)); am = min(am, __shfl_xor(am, 2)); am = min(am, __shfl_xor(am, 4));
    float m2 = (lane == am) ? -INFINITY : biased; m2 = fmaxf(m2, __shfl_xor(m2, 1)); m2 = fmaxf(m2, __shfl_xor(m2, 2)); m2 = fmaxf(m2, __shfl_xor(m2, 4));
    const float gs = m1 + m2;
    int cnt = 0;
#pragma unroll
    for (int gq = 0; gq < 8; ++gq) { const float o = __shfl(gs, gq * 8); cnt += (o > gs) ? 1 : 0; }
    const float masked = (cnt <= 3) ? biased : NEGF;
    int rank = 0;
    for (int e2 = 0; e2 < 64; ++e2) { const float o = __shfl(masked, e2); rank += (o > masked || (o == masked && e2 < lane)) ? 1 : 0; }
    const bool selq = rank < 8;
    const float wsum = wave_sum(selq ? score : 0.f);
    if (selq) { tope[(size_t)m * 8 + rank] = lane; topw[(size_t)m * 8 + rank] = score / wsum * 2.5f; atomicAdd(hist + (m >> 13) * 65 + lane, 1); }
}
__device__ __forceinline__ void router_unit(const Params& p, const float* __restrict__ x2, const h16* __restrict__ WrTh, const h16* __restrict__ WrTl, int* __restrict__ tope, float* __restrict__ topw, int* __restrict__ hist,
                                            int m0, LAS float* lg, int lane) {
    const int i = lane & 15, kg = lane >> 4;
    f32x4 am_[4], ac_[4];
#pragma unroll
    for (int et = 0; et < 4; ++et) { am_[et] = (f32x4){0.f, 0.f, 0.f, 0.f}; ac_[et] = (f32x4){0.f, 0.f, 0.f, 0.f}; }
    const float* xr = x2 + (size_t)(m0 + i) * D + 8 * kg;
#pragma unroll 2
    for (int ks = 0; ks < 32; ++ks) {
        const f32x4 x0 = *(const f32x4*)(xr + 32 * ks), x1 = *(const f32x4*)(xr + 32 * ks + 4);
        h16x8 xh, xl;
#pragma unroll
        for (int j = 0; j < 4; ++j) { xh[j] = (h16)x0[j]; xl[j] = (h16)((x0[j] - (float)xh[j]) * 2048.f); xh[4 + j] = (h16)x1[j]; xl[4 + j] = (h16)((x1[j] - (float)xh[4 + j]) * 2048.f); }
#pragma unroll
        for (int et = 0; et < 4; ++et) { const h16x8 wh = *(const h16x8*)(WrTh + (size_t)(16 * et + i) * D + 32 * ks + 8 * kg), wl = *(const h16x8*)(WrTl + (size_t)(16 * et + i) * D + 32 * ks + 8 * kg);
            am_[et] = __builtin_amdgcn_mfma_f32_16x16x32_f16(wh, xh, am_[et], 0, 0, 0);
            ac_[et] = __builtin_amdgcn_mfma_f32_16x16x32_f16(wh, xl, ac_[et], 0, 0, 0);
            ac_[et] = __builtin_amdgcn_mfma_f32_16x16x32_f16(wl, xh, ac_[et], 0, 0, 0); }
    }
#pragma unroll
    for (int et = 0; et < 4; ++et)
#pragma unroll
        for (int r = 0; r < 4; ++r) lg[i * 64 + 16 * et + 4 * kg + r] = am_[et][r] + ac_[et][r] * (1.f / 2048.f);
    for (int tk = 0; tk < 16; ++tk) route_token(lg[tk * 64 + lane], m0 + tk, lane, p.rbias, tope, topw, hist);
}

__device__ __forceinline__ void b_moe(const Params& p, const float* __restrict__ x2, const int* __restrict__ tope, const float* __restrict__ topw, float* __restrict__ out, int m, float* sl, int tid) {
    float* xs = sl; float* hd = sl + 1024; float* red = sl + 1280;
    for (int i = tid; i < 1024; i += 256) xs[i] = x2[(size_t)m * D + i];
    __syncthreads();
    float acc[4] = {0.f, 0.f, 0.f, 0.f};
    for (int kx = 0; kx < 9; ++kx) {
        const float* G; const float* U; const float* Dn; float wt;
        if (kx < 8) { const int e = tope[(size_t)m * 8 + kx]; wt = topw[(size_t)m * 8 + kx]; G = p.w_gate + (size_t)e * D * EFF; U = p.w_up + (size_t)e * D * EFF; Dn = p.w_down + (size_t)e * EFF * D; }
        else { wt = 1.f; G = p.ws_gate; U = p.ws_up; Dn = p.ws_down; }
        float a = 0.f, u = 0.f;
        for (int k = 0; k < D; ++k) { const float xv = xs[k]; a += xv * G[(size_t)k * EFF + tid]; u += xv * U[(size_t)k * EFF + tid]; }
        hd[tid] = siluf(a) * u * wt;
        __syncthreads();
        for (int j = 0; j < EFF; ++j) { const float hv = hd[j]; const float* dr = Dn + (size_t)j * D + tid;
            acc[0] += hv * dr[0]; acc[1] += hv * dr[256]; acc[2] += hv * dr[512]; acc[3] += hv * dr[768]; }
        __syncthreads();
    }
    float v[4]; float s = 0.f;
#pragma unroll
    for (int i = 0; i < 4; ++i) { v[i] = DN_ALPHA * xs[tid + 256 * i] + acc[i]; s += v[i]; }
    s = wave_sum(s); if ((tid & 63) == 0) red[tid >> 6] = s; __syncthreads();
    const float mean = (red[0] + red[1] + red[2] + red[3]) * (1.f / D); float s2 = 0.f;
#pragma unroll
    for (int i = 0; i < 4; ++i) { v[i] -= mean; s2 += v[i] * v[i]; }
    s2 = wave_sum(s2); if ((tid & 63) == 0) red[4 + (tid >> 6)] = s2; __syncthreads();
    const float rstd = rsqrtf((red[4] + red[5] + red[6] + red[7]) * (1.f / D) + LN_EPS);
#pragma unroll
    for (int i = 0; i < 4; ++i) out[(size_t)m * D + tid + 256 * i] = v[i] * rstd * p.ln3g[tid + 256 * i] + p.ln3b[tid + 256 * i];
    __syncthreads();
}

struct G1Sched {
    const int* ctl; const char* x2h; const unsigned* rowoff; const char* WguT; int G, c;
    __device__ bool next(int i, pg8::Unit& u) const {
        const int ntile = ctl[CTL_TQS + NQ]; const long L = (long)i * G + c; if (L >= 2L * ntile) return false;
        const int tile = (int)(L >> 1), pn = (int)(L & 1); const int e = ctl[CTL_TVE + tile] % 65;
        u.pm = tile; u.pn = pn; u.A = x2h; u.gat = rowoff + (size_t)tile * 256; u.B = WguT + ((size_t)e * 512 + pn * 256) * (D * 2); return true; }
};
struct G2Sched {
    const int* ctl; const char* H; const char* WdT; int q, G, c;
    __device__ bool next(int i, pg8::Unit& u) const {
        const int t0 = ctl[CTL_TQS + q], t1 = ctl[CTL_TQS + q + 1]; const long L = (long)i * G + c; if (L >= 4L * (t1 - t0)) return false;
        const int tile = t0 + (int)(L >> 2), pn = (int)(L & 3); const int e = ctl[CTL_TVE + tile] % 65;
        u.pm = tile; u.pn = pn; u.A = H + (size_t)tile * 256 * (EFF * 2); u.gat = nullptr; u.B = WdT + ((size_t)e * D + pn * 256) * (EFF * 2); return true; }
};
__device__ __forceinline__ void b_scatter(int* __restrict__ ctl, const int* __restrict__ tope, const float* __restrict__ topw, unsigned* __restrict__ rowoff, u32x2* __restrict__ rowmeta, int* sl) {
    int* pst = sl;
    if (tidx() == 0) { int acc = 0; for (int v = 0; v < NVE; ++v) { pst[v] = acc; acc += (ctl[CTL_CNT + v] + 255) & ~255; } pst[NVE] = acc; }
    __syncthreads();
    if (blockIdx.x == 0) {
        for (int v = tidx(); v <= NVE; v += NTHR) ctl[CTL_PST + v] = pst[v];
        if (tidx() <= NQ) ctl[CTL_TQS + tidx()] = pst[tidx() * 65] >> 8;
        for (int v = tidx(); v < NVE; v += NTHR) for (int tl = pst[v] >> 8; tl < (pst[v + 1] >> 8); ++tl) ctl[CTL_TVE + tl] = v;
    }
    for (int idx = blockIdx.x * NTHR + tidx(); idx < M * 9; idx += gridDim.x * NTHR) {
        int m, k, pos; float w;
        if (idx < M * 8) { m = idx >> 3; k = idx & 7; const int ve = (m >> 13) * 65 + tope[idx]; w = topw[idx]; pos = pst[ve] + atomicAdd(ctl + CTL_CUR + ve, 1); }
        else { m = idx - M * 8; k = 8; w = 1.f; pos = pst[(m >> 13) * 65 + 64] + (m & (QT - 1)); }
        rowoff[pos] = (unsigned)m * (D * 2); rowmeta[pos] = (u32x2){(unsigned)((m & (QT - 1)) * 9 + k), __float_as_uint(w)};
    }
    __syncthreads();
}
__device__ __forceinline__ void b_combine(const Params& p, const h16* __restrict__ x2h, const h16* __restrict__ Y, int q) {
    const int lane = tidx() & 63;
    for (int r = blockIdx.x * 8 + (tidx() >> 6); r < QT; r += gridDim.x * 8) {
        const int m = q * QT + r;
        float v[16];
        { const h16x8 a = ((const h16x8*)(x2h + (size_t)m * D))[lane], b = ((const h16x8*)(x2h + (size_t)m * D))[lane + 64];
#pragma unroll
          for (int i = 0; i < 8; ++i) { v[i] = DN_ALPHA * (float)a[i]; v[8 + i] = DN_ALPHA * (float)b[i]; } }
#pragma unroll
        for (int k = 0; k < 9; ++k) { const h16x8* yr = (const h16x8*)(Y + ((size_t)r * 9 + k) * D); const h16x8 a = yr[lane], b = yr[lane + 64];
#pragma unroll
            for (int i = 0; i < 8; ++i) { v[i] += (float)a[i]; v[8 + i] += (float)b[i]; } }
        float s = 0.f;
#pragma unroll
        for (int i = 0; i < 16; ++i) s += v[i];
        const float mean = wave_sum(s) * (1.f / D); float s2 = 0.f;
#pragma unroll
        for (int i = 0; i < 16; ++i) { v[i] -= mean; s2 += v[i] * v[i]; }
        const float rstd = rsqrtf(wave_sum(s2) * (1.f / D) + LN_EPS);
#pragma unroll
        for (int hlf = 0; hlf < 2; ++hlf) { const int c0 = (lane + 64 * hlf) * 8;
            const f32x4 g0 = *(const f32x4*)(p.ln3g + c0), g1 = *(const f32x4*)(p.ln3g + c0 + 4), b0 = *(const f32x4*)(p.ln3b + c0), b1 = *(const f32x4*)(p.ln3b + c0 + 4);
            f32x4 o0, o1;
#pragma unroll
            for (int i = 0; i < 4; ++i) { o0[i] = v[8 * hlf + i] * rstd * g0[i] + b0[i]; o1[i] = v[8 * hlf + 4 + i] * rstd * g1[i] + b1[i]; }
            *(f32x4*)(p.out + (size_t)m * D + c0) = o0; *(f32x4*)(p.out + (size_t)m * D + c0 + 4) = o1; }
    }
}

#define XB_TMO      128
#define XB_XCNT(j)  (256  + 64 * (j))
#define XB_XSUB(j)  (1280 + 64 * (j))
#define XB_XGEN(j)  (2304 + 64 * (j))
#define XB_TOP      3328
#define XB_TOPGEN   3392
#define XCD_BAR_WORDS 3456
#define XB_SPIN_CAP (1u << 22)
__device__ __forceinline__ unsigned xb_ld(unsigned* p)              { return __hip_atomic_load(p, __ATOMIC_RELAXED, __HIP_MEMORY_SCOPE_AGENT); }
__device__ __forceinline__ unsigned xb_add(unsigned* p, unsigned v) { return __hip_atomic_fetch_add(p, v, __ATOMIC_RELAXED, __HIP_MEMORY_SCOPE_AGENT); }
__device__ __forceinline__ unsigned xb_xcc_id() { return (unsigned)__builtin_amdgcn_s_getreg((3 << 11) | 20) & 0xFu; }
#define XB_SPIN(cond, bar) do { unsigned _sp = 0; while (cond) { __builtin_amdgcn_s_sleep(1); \
    if ((++_sp & 255u) == 0u) { if (xb_ld(&(bar)[XB_TMO])) break; if (_sp > XB_SPIN_CAP) { atomicAdd(&(bar)[XB_TMO], 1u); break; } } } } while (0)
struct XcdBarrier { unsigned* bar; unsigned x; volatile LAS unsigned* st; };
__device__ __forceinline__ XcdBarrier xcd_barrier_post(unsigned* bar, volatile LAS unsigned* st) {
    XcdBarrier b; b.bar = bar; b.x = xb_xcc_id(); b.st = st;
    if (threadIdx.x == 0) (void)xb_add(&bar[XB_XCNT(b.x)], 1u);
    return b;
}
__device__ __forceinline__ void xcd_barrier_complete(unsigned* bar, unsigned x, unsigned& nloc, unsigned& nx) {
    const unsigned G = gridDim.x * gridDim.y * gridDim.z;
    unsigned sum, cnt, mine, sp = 0u;
    for (;;) {
        sum = 0u; cnt = 0u; mine = 0u;
#pragma unroll
        for (unsigned j = 0; j < 16; ++j) { const unsigned c = xb_ld(&bar[XB_XCNT(j)]); sum += c; cnt += (c > 0u) ? 1u : 0u; mine = (j == x) ? c : mine; }
        if (sum == G) break;
        __builtin_amdgcn_s_sleep(1);
        if ((++sp & 255u) == 0u) { if (xb_ld(&bar[XB_TMO])) break; if (sp > XB_SPIN_CAP) { atomicAdd(&bar[XB_TMO], 1u); break; } }
    }
    nloc = mine > 0u ? mine : 1u; nx = cnt > 0u ? cnt : 1u;
}
__device__ __forceinline__ void xcd_barrier(const XcdBarrier& b) {
    asm volatile("s_waitcnt vmcnt(0)" ::: "memory");
    __syncthreads();
    if (threadIdx.x == 0) {
        unsigned* bar = b.bar;
        __builtin_amdgcn_s_waitcnt(0);
        unsigned nloc = b.st[0], nx = b.st[1];
        if (nloc == 0u) { xcd_barrier_complete(bar, b.x, nloc, nx); b.st[0] = nloc; b.st[1] = nx; }
        const unsigned old = xb_add(&bar[XB_XSUB(b.x)], 1u);
        const unsigned gen = old / nloc;
        if (old + 1u == (gen + 1u) * nloc) {
            __builtin_amdgcn_fence(__ATOMIC_RELEASE, "agent");
            asm volatile("s_waitcnt vmcnt(0)" ::: "memory");
            const unsigned og = xb_add(&bar[XB_TOP], 1u);
            const unsigned tg = og / nx;
            if (og + 1u == (tg + 1u) * nx) xb_add(&bar[XB_TOPGEN], 1u);
            else XB_SPIN(xb_ld(&bar[XB_TOPGEN]) == tg, bar);
            __builtin_amdgcn_fence(__ATOMIC_ACQUIRE, "agent");
            xb_add(&bar[XB_XGEN(b.x)], 1u);
            asm volatile("s_waitcnt vmcnt(0)" ::: "memory");
        } else {
            XB_SPIN(xb_ld(&bar[XB_XGEN(b.x)]) == gen, bar);
            __builtin_amdgcn_fence(__ATOMIC_ACQUIRE, "agent");
            asm volatile("s_waitcnt vmcnt(0)" ::: "memory");
        }
    }
    __syncthreads();
}

constexpr int N_PHASES = 23;

__global__ void __launch_bounds__(NTHR, 2) mega_fwd(Params p) {
    extern __shared__ __attribute__((aligned(16))) unsigned char lds[];
    cg::grid_group grid = cg::this_grid();
    const int G = (int)gridDim.x, bid = (int)blockIdx.x;
#define tid tidx()
    unsigned char* ws = p.ws;
    h16* WinT = (h16*)(ws + WS_WIN); h16* WoutT = (h16*)(ws + WS_WOUT); h16* WxqT = (h16*)(ws + WS_WXQ); h16* WxoT = (h16*)(ws + WS_WXO); h16* WxkvT = (h16*)(ws + WS_WXKV);
    h16* memh = (h16*)(ws + WS_MEMH); h16* kvm = (h16*)(ws + WS_KVM); h16* kcmp = (h16*)(ws + WS_KCMP); h16* vcmpT = (h16*)(ws + WS_VCMP); h16* vsT = (h16*)(ws + WS_VST); h16* vwT = (h16*)(ws + WS_VWT);
    int* tope = (int*)(ws + WS_TOPE); float* topw = (float*)(ws + WS_TOPW);
    h16* xh = (h16*)(ws + WS_XH); h16* mix = (h16*)(ws + WS_MIX); h16* ox = (h16*)(ws + WS_OX); h16* hb = (h16*)(ws + WS_H); h16* nqr = (h16*)(ws + WS_NQR);
    float* kvb = (float*)(ws + WS_KVB); h16* prevT = (h16*)(ws + WS_PREVT);
    float* cosr = (float*)(ws + WS_COSR); float* sinr = (float*)(ws + WS_SINR); float* cosn = (float*)(ws + WS_COSN); float* sinn = (float*)(ws + WS_SINN); h16* kvmVT = (h16*)(ws + WS_KVMVT); h16* WrTh = (h16*)(ws + WS_WRTH); h16* WrTl = (h16*)(ws + WS_WRTL); h16* Wc1T = (h16*)(ws + WS_WC1T); h16* hid = (h16*)(ws + WS_HID); unsigned* cmpoff = (unsigned*)(ws + WS_CMPOFF); float* peb = (float*)(ws + WS_PEB); h16* ksR = (h16*)(ws + WS_KSR); h16* kwR = (h16*)(ws + WS_KWR); h16* kx = (h16*)(ws + WS_KX);
    h16* rqr = (h16*)((unsigned char*)p.out + DO_RQR); h16* rkr = (h16*)((unsigned char*)p.out + DO_RKR); h16* rkzT = (h16*)((unsigned char*)p.out + DO_RKZT); h16* rvT = (h16*)((unsigned char*)p.out + DO_RVT); float* pre = p.out; float* x1 = (float*)(ws + WS_X1); h16* x1h = (h16*)(ws + WS_X1H);
    h16* qx = (h16*)(ws + WS_QX); float* x2 = (float*)(ws + WS_X2); h16* x2h = (h16*)(ws + WS_X2H);
    int* ctl = (int*)ws; unsigned* rowoff = (unsigned*)(ws + WS_ROWOFF); u32x2* rowmeta = (u32x2*)(ws + WS_ROWMETA);
    h16* WguT = (h16*)(ws + WS_WGUT); h16* WdT = (h16*)(ws + WS_WDT); h16* Hm = (h16*)(ws + WS_HM); h16* Yq = (h16*)(ws + WS_Y);
    float* fl = (float*)lds;
    const int lo = p.ph_lo, hi = p.ph_hi;
#define IN(k) (lo <= (k) && (k) < hi)
    { volatile LAS unsigned* st = (volatile LAS unsigned*)((LAS unsigned char*)lds + 131072); if (threadIdx.x < 2) st[threadIdx.x] = 0u; }
    __syncthreads();
    XcdBarrier xbar = xcd_barrier_post((unsigned*)(ws + WS_BAR), (volatile LAS unsigned*)((LAS unsigned char*)lds + 131072));
#define SEAM(k) do { if (IN(k) && IN((k) + 1)) { if ((k) == 0) grid.sync(); else xcd_barrier(xbar); } } while (0)

    if (IN(0)) REPS(0) {
        const int sub = tid >> 8, lt = tid & 255; float* tl = fl + sub * 1088;
        constexpr int T0 = (INP / 32) * (D / 32), T1 = (D / 32) * (D / 32), T4 = (2 * D / 32) * (D / 32), T5 = (256 / 32) * (2048 / 32), TT = T0 + 3 * T1 + T4 + 2 * T5;
        for (int b0 = bid * 2; b0 < TT; b0 += G * 2) { int it = b0 + sub;
            if (it < T0) { b_transpose_tile(p.w_in, D, INC, WinT, INP, it, tl, lt); continue; } it -= T0;
            if (it < T1) { b_transpose_tile(p.w_out, D, D, WoutT, D, it, tl, lt); continue; } it -= T1;
            if (it < T1) { b_transpose_tile(p.w_xq, D, D, WxqT, D, it, tl, lt); continue; } it -= T1;
            if (it < T1) { b_transpose_tile(p.w_xo, D, D, WxoT, D, it, tl, lt); continue; } it -= T1;
            if (it < T4) { b_transpose_tile(p.w_xkv, D, 2 * D, WxkvT, 2 * D, it, tl, lt); continue; } it -= T4;
            if (it < T5) { b_transpose_tile(p.w1k, 2048, 256, Wc1T, 256, it, tl, lt); continue; } it -= T5;
            b_transpose_tile(p.w1v, 2048, 256, Wc1T + 256 * 2048, 256, it, tl, lt); }
        b_cvt(p.x, xh, (size_t)M * D / 4);
        b_cvt(p.mem, memh, (size_t)NB * MEML * D / 4);
        if (bid == 0) for (int i = tid; i < 1024; i += NTHR) ctl[i] = 0;
        b_tables(p.positions, cosr, sinr, cosn, sinn);
        for (int idx = bid * NTHR + tid; idx < NE * D; idx += G * NTHR) { const int e = idx >> 10, k = idx & 1023; const float w = p.w_router[k * NE + e]; const h16 hi = (h16)w; WrTh[idx] = hi; WrTl[idx] = (h16)((w - (float)hi) * 2048.f); }
        for (int r = bid * NTHR + tid; r < 4096; r += G * NTHR) { const int g = r & 1, c = min((r >> 1) & 511, 510), b = r >> 10; cmpoff[r] = (unsigned)(((size_t)(b * T + 16 * c) * INP + g * 64) * 2); }
        { const int lane = tid & 63;
          for (int o = bid * 8 + (tid >> 6); o < 512; o += G * 8) { const int kv = o >> 8, j = o & 255; const float* pe = kv ? p.pe_v : p.pe_k; const float* w1 = kv ? p.w1v : p.w1k; float a = 0.f;
              for (int k = lane; k < 2048; k += 64) a += pe[k] * w1[(size_t)k * 256 + j];
              a = wave_sum(a); if (lane == 0) peb[o] = a; } }
    }
    SEAM(0);
    if (IN(1)) {
        REPS(1) { pg8::Gemm g{xh, WinT, M, INP, D}; pg8::StaticOrder S; S.init(g, G, bid); pg8::EpiF16 E{hb, INP};
          pg8::gemm_phase<pg8::EpiF16, pg8::StaticOrder>((PG8_LAS unsigned char*)lds, g.K, S, E); }
        { pg8::Gemm g{memh, WxkvT, NB * MEML, 2 * D, D}; pg8::StaticOrder S; S.init(g, G, bid); pg8::EpiF16 E{kvm, 2 * D};
          pg8::gemm_phase<pg8::EpiF16, pg8::StaticOrder>((PG8_LAS unsigned char*)lds, g.K, S, E); }
    }
    SEAM(1);
    if (IN(2)) REPS(2) {
        if (bid < 32) { CmpSched S{(const char*)hb, cmpoff, (const char*)Wc1T, bid}; pg8::EpiCmp1 E{hid, peb + (bid >> 4) * 256};
            pg8::gemm_phase<pg8::EpiCmp1, CmpSched>((PG8_LAS unsigned char*)lds, 2048, S, E, (size_t)INP * 2); }
        else { const int sub = tid >> 8, lt = tid & 255; const int b2 = bid - 32, G2 = G - 32;
        for (int b0 = b2 * 2; b0 < M; b0 += G2 * 2) b_rope(hb, rqr, rkr, nqr, ksR, kwR, cosr, sinr, cosn, sinn, b0 + sub, lt);
        for (int b0 = b2 * 2; b0 < 2 * NB * 2 * 128; b0 += G2 * 2) b_vtrans(hb, vsT, vwT, b0 + sub, (h16*)(fl + sub * 2304), lt);
        for (int b0 = b2 * 2; b0 < NB * 4 * 128; b0 += G2 * 2) b_rtrans(p, hb, rvT, rkzT, cosr, sinr, b0 + sub, (h16*)(fl + sub * 4224), lt);
        for (int b0 = b2 * 2; b0 < NB * 4 * 16; b0 += G2 * 2) b_mvtrans(kvm, kvmVT, kx, b0 + sub, (h16*)(fl + sub * 2304), lt); } }
    SEAM(2);
    if (IN(3)) {
        REPS(30) b_cmp2(p, hid, kcmp, vcmpT);
        const int wv = __builtin_amdgcn_readfirstlane(tid >> 6), lane = tid & 63;
        REPS(31) for (int ch = bid; ch < NB * 4 * 64; ch += G) ret_kv_unit(rkzT, rvT, kvb, ch, wv, lane); }
    SEAM(3);
    if (IN(4)) REPS(4) b_ret_scan(p, kvb, prevT);
    SEAM(4);
    if (IN(5)) {
        const int wv = __builtin_amdgcn_readfirstlane(tid >> 6), lane = tid & 63;
        REPS(50) { const int bg = bid & 7;
            for (int k = bid >> 3; k < T / 32; k += (G >> 3)) nsa_block_unit(hb, nqr, kcmp, vcmpT, vsT, vwT, ksR, kwR, mix, bg >> 1, bg & 1, (T / 32 - 1 - k) * 32, (LAS unsigned char*)lds, wv, lane); }
        __syncthreads();
        REPS(51) for (int ch = bid; ch < NB * 4 * 64; ch += G) ret_out_unit(p, hb, rqr, rkr, rvT, prevT, mix, ch, wv, lane);
    }
    SEAM(5);
    if (IN(6)) { pg8::Gemm g{mix, WoutT, M, D, D}; pg8::StaticOrder S; S.init(g, G, bid); pg8::EpiResF32 E{pre, p.x, D, DN_ALPHA};
        pg8::gemm_phase<pg8::EpiResF32, pg8::StaticOrder>((PG8_LAS unsigned char*)lds, g.K, S, E); }
    SEAM(6);
    if (IN(7)) REPS(7) b_ln(pre, p.ln1g, p.ln1b, x1, x1h);
    SEAM(7);
    if (IN(8)) { pg8::Gemm g{x1h, WxqT, M, D, D}; pg8::StaticOrder S; S.init(g, G, bid); pg8::EpiF16 E{qx, D};
        pg8::gemm_phase<pg8::EpiF16, pg8::StaticOrder>((PG8_LAS unsigned char*)lds, g.K, S, E); }
    SEAM(8);
    if (IN(9)) { const int wv = __builtin_amdgcn_readfirstlane(tid >> 6), lane = tid & 63;
        REPS(9) for (int u = bid; u < (M / 128) * 4; u += G) xattn_unit(qx, kx, kvmVT, ox, (u >> 2) * 128 + wv * 16, u & 3, lane); }
    SEAM(9);
    if (IN(10)) { pg8::Gemm g{ox, WxoT, M, D, D}; pg8::StaticOrder S; S.init(g, G, bid); pg8::EpiResF32 E{pre, x1, D, DN_ALPHA};
        pg8::gemm_phase<pg8::EpiResF32, pg8::StaticOrder>((PG8_LAS unsigned char*)lds, g.K, S, E); }
    SEAM(10);
    if (IN(11)) REPS(7) b_ln(pre, p.ln2g, p.ln2b, x2, x2h);
    SEAM(11);
    if (IN(12)) {
        { const int wv = __builtin_amdgcn_readfirstlane(tid >> 6), lane = tid & 63; LAS float* lg = (LAS float*)((LAS unsigned char*)lds + wv * 4096);
          for (int u = bid * 8 + wv; u < M / 16; u += G * 8) router_unit(p, x2, WrTh, WrTl, tope, topw, ctl + CTL_CNT, u * 16, lg, lane); }
        __syncthreads();
        if (bid == 0 && tid < NQ) ctl[CTL_CNT + tid * 65 + 64] = QT;
        for (int i = bid * NTHR + tid; i < CAP; i += G * NTHR) { rowoff[i] = 0u; rowmeta[i] = (u32x2){0xffffffffu, 0u}; }
        const int sub = tid >> 8, lt = tid & 255; float* tl = fl + sub * 1088;
        REPS(121) for (int b0 = bid * 2; b0 < 65 * 768; b0 += G * 2) { const int it = b0 + sub; const int e = it / 768, r = it % 768;
            const float* wg = e < 64 ? p.w_gate + (size_t)e * D * EFF : p.ws_gate; const float* wu = e < 64 ? p.w_up + (size_t)e * D * EFF : p.ws_up; const float* wd = e < 64 ? p.w_down + (size_t)e * EFF * D : p.ws_down;
            if (r < 256) b_transpose_tile(wg, D, EFF, WguT + (size_t)e * 512 * D, EFF, r, tl, lt, 2, 0);
            else if (r < 512) b_transpose_tile(wu, D, EFF, WguT + (size_t)e * 512 * D, EFF, r - 256, tl, lt, 2, 1);
            else b_transpose_tile(wd, EFF, D, WdT + (size_t)e * D * EFF, D, r - 512, tl, lt); }
    }
    SEAM(12);
    if (IN(13)) b_scatter(ctl, tope, topw, rowoff, rowmeta, (int*)lds);
    SEAM(13);
    if (IN(14)) REPS(14) { G1Sched S{ctl, (const char*)x2h, rowoff, (const char*)WguT, G, bid}; pg8::EpiGateUp E{Hm};
        pg8::gemm_phase<pg8::EpiGateUp, G1Sched>((PG8_LAS unsigned char*)lds, D, S, E); }
    SEAM(14);
#pragma unroll 1
    for (int q = 0; q < NQ; ++q) {
        if (IN(15 + 2 * q)) REPS(15) { G2Sched S{ctl, (const char*)Hm, (const char*)WdT, q, G, bid}; pg8::EpiDown E{Yq, rowmeta};
            pg8::gemm_phase<pg8::EpiDown, G2Sched>((PG8_LAS unsigned char*)lds, EFF, S, E); }
        SEAM(15 + 2 * q);
        if (IN(16 + 2 * q)) REPS(16) b_combine(p, x2h, Yq, q);
        if (q < NQ - 1) SEAM(16 + 2 * q);
    }
#undef IN
#undef SEAM
#undef tid
}

#ifndef MK_PER_PHASE
#define MK_PER_PHASE 0
#endif
extern "C" void kernel_launch(void* const* d_in, const int* in_sizes, int n_in, void* d_out, int out_size, void* d_ws, size_t ws_size, hipStream_t stream) {
    static int grid = 0;
    if (grid == 0) {
        if (n_in != 28 || in_sizes[0] != M * D || out_size != M * D || ws_size < WS_NEED) { fprintf(stderr, "kernel_launch: unexpected shapes (n_in %d, in0 %d, out %d, ws %zu)\n", n_in, n_in > 0 ? in_sizes[0] : -1, out_size, ws_size); grid = -1; return; }
        if (hipFuncSetAttribute((const void*)mega_fwd, hipFuncAttributeMaxDynamicSharedMemorySize, LDS_BYTES) != hipSuccess) { fprintf(stderr, "kernel_launch: hipFuncSetAttribute failed\n"); grid = -1; return; }
        int dev = 0, cus = 0, per_cu = 0;
        hipGetDevice(&dev); hipDeviceGetAttribute(&cus, hipDeviceAttributeMultiprocessorCount, dev);
        if (hipOccupancyMaxActiveBlocksPerMultiprocessor(&per_cu, (const void*)mega_fwd, NTHR, LDS_BYTES) != hipSuccess || per_cu < 1) { fprintf(stderr, "kernel_launch: occupancy query failed (%d)\n", per_cu); grid = -1; return; }
        grid = cus;
    }
    if (grid < 0) return;
    Params p{};
    p.x = (const float*)d_in[0]; p.mem = (const float*)d_in[1]; p.positions = (const int*)d_in[2];
    p.w_in = (const float*)d_in[3]; p.pe_k = (const float*)d_in[4]; p.pe_v = (const float*)d_in[5];
    p.w1k = (const float*)d_in[6]; p.w2k = (const float*)d_in[7]; p.w1v = (const float*)d_in[8]; p.w2v = (const float*)d_in[9];
    p.w_out = (const float*)d_in[10]; p.ln1g = (const float*)d_in[11]; p.ln1b = (const float*)d_in[12];
    p.w_xq = (const float*)d_in[13]; p.w_xkv = (const float*)d_in[14]; p.w_xo = (const float*)d_in[15];
    p.ln2g = (const float*)d_in[16]; p.ln2b = (const float*)d_in[17]; p.w_router = (const float*)d_in[18]; p.rbias = (const float*)d_in[19];
    p.w_gate = (const float*)d_in[20]; p.w_up = (const float*)d_in[21]; p.w_down = (const float*)d_in[22];
    p.ws_gate = (const float*)d_in[23]; p.ws_up = (const float*)d_in[24]; p.ws_down = (const float*)d_in[25];
    p.ln3g = (const float*)d_in[26]; p.ln3b = (const float*)d_in[27];
    p.out = (float*)d_out; p.ws = (unsigned char*)d_ws;
    for (int i = 0; i < 4; ++i) p.lg[i] = (float)std::log(1.0 - std::pow(2.0, -5.0 - (double)i));
#if MK_PER_PHASE
    for (int ph = 0; ph < N_PHASES; ++ph) { p.ph_lo = ph; p.ph_hi = ph + 1; hipLaunchKernelGGL(mega_fwd, dim3(grid), dim3(NTHR), LDS_BYTES, stream, p); }
#else
    p.ph_lo = 0; p.ph_hi = N_PHASES;
    if (hipMemsetAsync((char*)d_ws + WS_BAR, 0, XCD_BAR_WORDS * 4, stream) != hipSuccess) { fprintf(stderr, "kernel_launch: memset failed\n"); return; }
    void* args[] = {&p};
    hipError_t e = hipLaunchCooperativeKernel((const void*)mega_fwd, dim3(grid), dim3(NTHR), args, LDS_BYTES, stream);
    if (e != hipSuccess) fprintf(stderr, "kernel_launch: cooperative launch failed: %s (grid %d)\n", hipGetErrorString(e), grid);
#endif
}
```

```cpp
#include <hip/hip_runtime.h>
#include <cstdio>
#include <cstdint>
#include <cmath>

typedef _Float16 h16;
typedef _Float16 h16x8 __attribute__((ext_vector_type(8)));
typedef _Float16 h16x2 __attribute__((ext_vector_type(2)));
typedef _Float16 h16x4 __attribute__((ext_vector_type(4)));
typedef float f32x2 __attribute__((ext_vector_type(2)));
typedef float f32x4 __attribute__((ext_vector_type(4)));
typedef unsigned u32x4 __attribute__((ext_vector_type(4)));
typedef unsigned u32x2 __attribute__((ext_vector_type(2)));

__device__ __forceinline__ int tidx() { int t = (int)threadIdx.x; asm volatile("" : "+v"(t)); return t; }

#ifndef PROBE_DBL
#define PROBE_DBL -1
#endif
#define REPS(k) for (int _rep = 0; _rep < ((PROBE_DBL) == (k) ? 2 : 1); ++_rep)

constexpr int NB = 4, T = 8192, D = 1024, M = NB * T;
constexpr int INC = 3352, INP = 3584;
constexpr int C_RQ = 0, C_RK = 512, C_RV = 1024, C_RG = 1536, C_NQ = 2048, C_NKC = 2560, C_NVC = 2688, C_NKS = 2816, C_NVS = 2944, C_NKW = 3072, C_NVW = 3200, C_NG = 3328;
constexpr int MEML = 256;
constexpr int NE = 64, EFF = 256;
constexpr float LN_EPS = 1e-5f;
constexpr float DN_ALPHA = 1.189207115002721f;
constexpr float NEGF = -1e30f;

constexpr size_t MiB = 1u << 20;
constexpr size_t WS_WIN = 1 * MiB, WS_WOUT = 8 * MiB, WS_WXQ = 10 * MiB, WS_WXO = 12 * MiB, WS_WXKV = 14 * MiB, WS_MEMH = 18 * MiB, WS_KVM = 20 * MiB;
constexpr size_t WS_KCMP = 24 * MiB, WS_VCMP = 25 * MiB, WS_TOPE = 26 * MiB, WS_TOPW = 27 * MiB;
constexpr size_t WS_XH = 32 * MiB, WS_MIX = 32 * MiB, WS_OX = 32 * MiB;
constexpr size_t WS_H = 96 * MiB, WS_NQR = 320 * MiB, WS_KVB = 352 * MiB, WS_PREV = 416 * MiB;
constexpr size_t WS_PRE = 96 * MiB, WS_X1 = 224 * MiB, WS_X1H = 352 * MiB, WS_QX = 416 * MiB, WS_X2 = 130 * MiB;
constexpr size_t WS_X2H = 32 * MiB, WS_WDT = 96 * MiB, WS_HM = 130 * MiB, WS_WGUT = 306 * MiB, WS_Y = 306 * MiB;
constexpr size_t WS_ROWOFF = 1 * MiB, WS_ROWMETA = 3 * MiB;
constexpr size_t WS_VST = 480 * MiB, WS_VWT = 488 * MiB, WS_COSR = 496 * MiB, WS_SINR = 504 * MiB, WS_COSN = 28 * MiB, WS_SINN = 29 * MiB, WS_KVMVT = 30 * MiB;
constexpr size_t WS_WRTH = 262144, WS_WRTL = 393216;
constexpr size_t WS_WC1T = 464 * MiB, WS_HID = 466 * MiB, WS_CMPOFF = 131072, WS_PEB = 131072 + 16384;
constexpr size_t WS_PREVT = 416 * MiB, WS_KSR = 448 * MiB, WS_KWR = 456 * MiB, WS_KX = 26 * MiB;
constexpr size_t DO_RQR = 0, DO_RKR = 32 * MiB, DO_RKZT = 64 * MiB, DO_RVT = 96 * MiB;
constexpr size_t WS_NEED = 512 * MiB;
constexpr int NQ = 4, QT = M / NQ, NVE = NQ * 65, CAP_TILES = 1412, CAP = CAP_TILES * 256;
constexpr size_t WS_BAR = 65536;
constexpr int CTL_CNT = 0, CTL_CUR = 512, CTL_PST = 1024, CTL_TQS = 1536, CTL_TVE = 2048;

namespace pg8 {
#define PG8_LAS __attribute__((address_space(3)))
typedef short s16x8 __attribute__((ext_vector_type(8)));
constexpr int BM = 256, BK = 64, HALF = 128, HTB = HALF * BK * 2, STAGE_BYTES = 8 * HTB, NXCD = 8, WGM = 8;
__host__ __device__ __forceinline__ int lds_byte(int r, int c) { const int st = (r >> 4) * 2 + (c >> 5), rr = r & 15, cc = c & 31, ob = rr * 64 + cc * 2; return st * 1024 + (ob ^ (((ob >> 9) & 1) << 5)); }
__host__ __device__ __forceinline__ void stage_rc(int b, int& R, int& C) { const int st = b / 1024, sb = b % 1024, swz = sb ^ (((sb >> 9) & 1) << 5); R = (st >> 1) * 16 + swz / 64; C = (st & 1) * 32 + (swz % 64) / 2; }
__host__ __device__ __forceinline__ int perm32(int rho) { const int n = rho >> 4, i = rho & 15; return 8 * (i >> 2) + 4 * n + (i & 3); }
struct Unit { int pm, pn; const char* A; const char* B; const unsigned* gat; };
struct Gemm { const h16* A; const h16* Bt; int M, N, K; };
struct StaticOrder {
    int nM, nN, nwg, G, c; const char* A; const char* B; size_t tstep;
    __device__ void init(const Gemm& g, int G_, int c_) { nM = g.M / BM; nN = g.N / BM; nwg = nM * nN; G = G_; c = c_; A = (const char*)g.A; B = (const char*)g.Bt; tstep = (size_t)BM * g.K * 2; }
    __device__ bool next(int i, Unit& u) const {
        const long L = (long)i * G + c; if (L >= nwg) return false;
        int wgid = (int)L; { const int q = nwg / NXCD, r = nwg % NXCD, xcd = wgid % NXCD, off = wgid / NXCD; wgid = (xcd < r ? xcd * (q + 1) : r * (q + 1) + (xcd - r) * q) + off; }
        const int nig = WGM * nN, gid = wgid / nig, fm = gid * WGM, gsz = (nM - fm) < WGM ? (nM - fm) : WGM;
        u.pm = fm + ((wgid % nig) % gsz); u.pn = (wgid % nig) / gsz; u.A = A + (size_t)u.pm * tstep; u.B = B + (size_t)u.pn * tstep; u.gat = nullptr; return true;
    }
};
__device__ __forceinline__ unsigned cvt_pk_f16(float lo, float hi) { f32x2 v = {lo, hi}; h16x2 h = __builtin_convertvector(v, h16x2); return __builtin_bit_cast(unsigned, h); }

struct EpiF16 {
    static constexpr bool PERM = true;
    h16* O; int ldc;
    __device__ __forceinline__ void operator()(const f32x4 (&acc)[2][2][4][2], const Unit& u, int wr, int wc, int fr, int fq) const {
        const int row0 = u.pm * BM + wr * 64 + fr; const int col0 = u.pn * BM + wc * 32 + 8 * fq;
#pragma unroll
        for (int ai = 0; ai < 2; ++ai)
#pragma unroll
            for (int m = 0; m < 4; ++m) { h16* rowp = O + (size_t)(row0 + ai * HALF + m * 16) * ldc + col0;
#pragma unroll
                for (int bj = 0; bj < 2; ++bj) { const f32x4 v0 = acc[ai][bj][m][0], v1 = acc[ai][bj][m][1];
                    *(h16x8*)(rowp + bj * HALF) = __builtin_convertvector(__builtin_shufflevector(v0, v1, 0, 1, 2, 3, 4, 5, 6, 7), h16x8); } }
    }
};
struct EpiResF32 {
    static constexpr bool PERM = false;
    float* C; const float* R; int ldc; float alpha;
    __device__ __forceinline__ void operator()(const f32x4 (&acc)[2][2][4][2], const Unit& u, int wr, int wc, int fr, int fq) const {
        const int row0 = u.pm * BM + wr * 64 + fr, col0 = u.pn * BM + wc * 32 + 4 * fq;
#pragma unroll
        for (int ai = 0; ai < 2; ++ai)
#pragma unroll
            for (int m = 0; m < 4; ++m) { const size_t off = (size_t)(row0 + ai * HALF + m * 16) * ldc + col0;
#pragma unroll
                for (int bj = 0; bj < 2; ++bj)
#pragma unroll
                    for (int n = 0; n < 2; ++n) { const f32x4 r = *(const f32x4*)(R + off + bj * HALF + n * 16); *(f32x4*)(C + off + bj * HALF + n * 16) = r * alpha + acc[ai][bj][m][n]; } }
    }
};
struct EpiCmp1 {
    static constexpr bool PERM = true;
    h16* O; const float* peb;
    __device__ __forceinline__ void operator()(const f32x4 (&acc)[2][2][4][2], const Unit& u, int wr, int wc, int fr, int fq) const {
        const int row0 = u.pm * BM + wr * 64 + fr; const int col0 = wc * 32 + 8 * fq;
#pragma unroll
        for (int bj = 0; bj < 2; ++bj) { const f32x4 b0 = *(const f32x4*)(peb + col0 + bj * HALF), b1 = *(const f32x4*)(peb + col0 + bj * HALF + 4);
#pragma unroll
            for (int ai = 0; ai < 2; ++ai)
#pragma unroll
                for (int m = 0; m < 4; ++m) { f32x4 v0 = acc[ai][bj][m][0] + b0, v1 = acc[ai][bj][m][1] + b1;
#pragma unroll
                    for (int r = 0; r < 4; ++r) { v0[r] = v0[r] / (1.f + __expf(-v0[r])); v1[r] = v1[r] / (1.f + __expf(-v1[r])); }
                    *(h16x8*)(O + (size_t)(row0 + ai * HALF + m * 16) * 256 + col0 + bj * HALF) = __builtin_convertvector(__builtin_shufflevector(v0, v1, 0, 1, 2, 3, 4, 5, 6, 7), h16x8); } }
    }
};
struct EpiGateUp {
    static constexpr bool PERM = true;
    h16* H;
    __device__ __forceinline__ void operator()(const f32x4 (&acc)[2][2][4][2], const Unit& u, int wr, int wc, int fr, int fq) const {
        const int row0 = u.pm * BM + wr * 64 + fr; const int col0 = u.pn * 128 + wc * 16 + 4 * fq;
#pragma unroll
        for (int ai = 0; ai < 2; ++ai)
#pragma unroll
            for (int m = 0; m < 4; ++m) { h16* rowp = H + (size_t)(row0 + ai * HALF + m * 16) * 256 + col0;
#pragma unroll
                for (int bj = 0; bj < 2; ++bj) { const f32x4 v0 = acc[ai][bj][m][0], v1 = acc[ai][bj][m][1];
                    const float h0 = v0[0] / (1.f + __expf(-v0[0])) * v0[1], h1 = v0[2] / (1.f + __expf(-v0[2])) * v0[3];
                    const float h2 = v1[0] / (1.f + __expf(-v1[0])) * v1[1], h3 = v1[2] / (1.f + __expf(-v1[2])) * v1[3];
                    *(h16x4*)(rowp + bj * 64) = __builtin_convertvector((f32x4){h0, h1, h2, h3}, h16x4); } }
    }
};
struct EpiDown {
    static constexpr bool PERM = true;
    h16* Y; const u32x2* rowmeta;
    __device__ __forceinline__ void operator()(const f32x4 (&acc)[2][2][4][2], const Unit& u, int wr, int wc, int fr, int fq) const {
        const int row0 = u.pm * BM + wr * 64 + fr; const int col0 = u.pn * BM + wc * 32 + 8 * fq;
#pragma unroll
        for (int ai = 0; ai < 2; ++ai)
#pragma unroll
            for (int m = 0; m < 4; ++m) { const u32x2 md = rowmeta[row0 + ai * HALF + m * 16]; const int slot = (int)md.x; const float w8 = __uint_as_float(md.y);
                if (slot >= 0) { h16* rowp = Y + (size_t)slot * 1024 + col0;
#pragma unroll
                    for (int bj = 0; bj < 2; ++bj) { const f32x4 v0 = acc[ai][bj][m][0] * w8, v1 = acc[ai][bj][m][1] * w8;
                        *(h16x8*)(rowp + bj * HALF) = __builtin_convertvector(__builtin_shufflevector(v0, v1, 0, 1, 2, 3, 4, 5, 6, 7), h16x8); } }
                asm volatile("" ::: "memory"); }
    }
};

template <class Epi, class Sched>
__device__ __forceinline__ void gemm_phase(PG8_LAS unsigned char* lds, const int K, const Sched& S, const Epi& E, const size_t kstepA = (size_t)(BK * 2)) {
    const int tid = tidx(), wid = __builtin_amdgcn_readfirstlane(tid >> 6), lane = tid & 63, wr = wid >> 2, wc = wid & 3, fr = lane & 15, fq = lane >> 4;
    const int nt = K / BK;
    int R0, C0; stage_rc(tid * 16, R0, C0);
    const unsigned cb2 = (unsigned)C0 * 2u;
    unsigned voffB[2];
#pragma unroll
    for (int i = 0; i < 2; ++i) { const int R = R0 + 64 * i; const int Rb = Epi::PERM ? ((R & ~31) + perm32(R & 31)) : R; voffB[i] = (unsigned)(Rb * K) * 2u + cb2; }
    const size_t kstep = (size_t)(BK * 2);
    const size_t hstep = (size_t)HALF * K * 2;
    const unsigned ldsw = (unsigned)wid * 1024u;
    const int aoff = lds_byte(wr * 64 + fr, fq * 8), boff = lds_byte(wc * 32 + fr, fq * 8);
#define PG8_MKVA(u, va) do { _Pragma("unroll") for (int _h = 0; _h < 2; ++_h) _Pragma("unroll") for (int _i = 0; _i < 2; ++_i) { const int _r = _h * HALF + R0 + 64 * _i; \
        (va)[_h][_i] = ((u).gat ? (u).gat[_r] : (unsigned)(_r * K) * 2u) + cb2; } } while (0)
#define PG8_SA(b, h) (((b) * 2 + (h)) * HTB)
#define PG8_SB(b, h) ((4 + (b) * 2 + (h)) * HTB)
#define PG8_STAGE(bufoff, gbase, voff) do { _Pragma("unroll") for (int _i = 0; _i < 2; ++_i) \
        __builtin_amdgcn_global_load_lds((const unsigned*)((const char*)(gbase) + (voff)[_i]), (PG8_LAS unsigned*)(lds + (bufoff) + ldsw + _i * 8192), 16, 0, 0); } while (0)
#define PG8_LDA(dst, b, h) do { _Pragma("unroll") for (int m = 0; m < 4; ++m) _Pragma("unroll") for (int k = 0; k < 2; ++k) dst[m][k] = *(const PG8_LAS s16x8*)(lds + PG8_SA(b, h) + aoff + m * 2048 + k * 1024); } while (0)
#define PG8_LDB(dst, b, h) do { _Pragma("unroll") for (int n = 0; n < 2; ++n) _Pragma("unroll") for (int k = 0; k < 2; ++k) dst[n][k] = *(const PG8_LAS s16x8*)(lds + PG8_SB(b, h) + boff + n * 2048 + k * 1024); } while (0)
#define PG8_MMA(ai, bj, At, Bt) do { __builtin_amdgcn_s_setprio(1); _Pragma("unroll") for (int m = 0; m < 4; ++m) _Pragma("unroll") for (int n = 0; n < 2; ++n) _Pragma("unroll") for (int k = 0; k < 2; ++k) \
        acc[ai][bj][m][n] = __builtin_amdgcn_mfma_f32_16x16x32_f16(__builtin_bit_cast(h16x8, Bt[n][k]), __builtin_bit_cast(h16x8, At[m][k]), acc[ai][bj][m][n], 0, 0, 0); __builtin_amdgcn_s_setprio(0); } while (0)
#define PG8_WAIT_V(n) asm volatile("s_waitcnt vmcnt(" #n ")" ::: "memory")
#define PG8_WAIT_L(n) asm volatile("s_waitcnt lgkmcnt(" #n ")" ::: "memory")
#define PG8_BAR __builtin_amdgcn_s_barrier()
#define PG8_SCHED __builtin_amdgcn_sched_barrier(0)
    Unit cur, nxt; int ui = 0;
    if (!S.next(0, cur)) return;
    unsigned va[2][2];
    PG8_MKVA(cur, va);
    f32x4 acc[2][2][4][2];
#pragma unroll
    for (int a = 0; a < 2; ++a)
#pragma unroll
        for (int b = 0; b < 2; ++b)
#pragma unroll
            for (int m = 0; m < 4; ++m)
#pragma unroll
                for (int n = 0; n < 2; ++n) acc[a][b][m][n] = (f32x4){0.f, 0.f, 0.f, 0.f};
    s16x8 At[4][2], B0[2][2], B1[2][2];
    const char* cA = cur.A; const char* cB = cur.B;
    {
        PG8_STAGE(PG8_SB(0, 0), cB, voffB); PG8_STAGE(PG8_SB(0, 1), cB + hstep, voffB); PG8_STAGE(PG8_SA(0, 0), cA, va[0]); PG8_STAGE(PG8_SA(0, 1), cA, va[1]);
        if (wr == 1) PG8_BAR;
        PG8_WAIT_V(2); PG8_BAR;
        PG8_STAGE(PG8_SB(1, 0), cB + kstep, voffB); PG8_STAGE(PG8_SA(1, 0), cA + kstepA, va[0]); PG8_STAGE(PG8_SB(1, 1), cB + hstep + kstep, voffB);
        PG8_WAIT_V(6); PG8_BAR;
    }
    for (;;) {
        const bool has_next = S.next(ui + 1, nxt);
        const char* nA = has_next ? nxt.A : cA; const char* nB = has_next ? nxt.B : cB;
#pragma unroll 1
        for (int t = 0; t < nt; t += 2) {
            const bool last = (t == nt - 2);
            const char* a1 = cA + (size_t)(t + 1) * kstepA;
            const char* a2 = last ? nA : cA + (size_t)(t + 2) * kstepA; const char* b2 = last ? nB : cB + (size_t)(t + 2) * kstep;
            const char* a3 = a2 + kstepA; const char* b3 = b2 + kstep;
            PG8_LDB(B0, 0, 0); PG8_LDB(B1, 0, 1); PG8_SCHED; PG8_LDA(At, 0, 0); PG8_STAGE(PG8_SA(1, 1), a1, va[1]);
            if (last && has_next) { PG8_MKVA(nxt, va); }
            PG8_WAIT_V(8); PG8_WAIT_L(0); PG8_BAR; PG8_MMA(0, 0, At, B0); PG8_MMA(0, 1, At, B1); PG8_BAR; PG8_SCHED;
            PG8_LDA(At, 0, 1); PG8_STAGE(PG8_SB(0, 0), b2, voffB); PG8_STAGE(PG8_SB(0, 1), b2 + hstep, voffB); PG8_STAGE(PG8_SA(0, 0), a2, va[0]);
            PG8_WAIT_V(8); PG8_WAIT_L(0); PG8_BAR; PG8_MMA(1, 0, At, B0); PG8_MMA(1, 1, At, B1); PG8_BAR; PG8_SCHED;
            PG8_LDB(B0, 1, 0); PG8_LDB(B1, 1, 1); PG8_SCHED; PG8_LDA(At, 1, 0); PG8_STAGE(PG8_SA(0, 1), a2, va[1]);
            PG8_WAIT_V(8); PG8_WAIT_L(0); PG8_BAR; PG8_MMA(0, 0, At, B0); PG8_MMA(0, 1, At, B1); PG8_BAR; PG8_SCHED;
            PG8_LDA(At, 1, 1); PG8_STAGE(PG8_SB(1, 0), b3, voffB); PG8_STAGE(PG8_SB(1, 1), b3 + hstep, voffB); PG8_STAGE(PG8_SA(1, 0), a3, va[0]);
            PG8_WAIT_V(8); PG8_WAIT_L(0); PG8_BAR; PG8_MMA(1, 0, At, B0); PG8_MMA(1, 1, At, B1); PG8_BAR; PG8_SCHED;
        }
        if (wr == 0) PG8_BAR;
        E(acc, cur, wr, wc, fr, fq);
        if (!has_next) break;
#pragma unroll
        for (int a = 0; a < 2; ++a)
#pragma unroll
            for (int b = 0; b < 2; ++b)
#pragma unroll
                for (int m = 0; m < 4; ++m)
#pragma unroll
                    for (int n = 0; n < 2; ++n) acc[a][b][m][n] = (f32x4){0.f, 0.f, 0.f, 0.f};
        cur = nxt; cA = nA; cB = nB; ++ui;
        if (wr == 1) PG8_BAR;
    }
    PG8_WAIT_V(0);
    PG8_BAR;
#undef PG8_MKVA
#undef PG8_SA
#undef PG8_SB
#undef PG8_STAGE
#undef PG8_LDA
#undef PG8_LDB
#undef PG8_MMA
#undef PG8_WAIT_V
#undef PG8_WAIT_L
#undef PG8_BAR
#undef PG8_SCHED
}
}


#include <hip/hip_cooperative_groups.h>
namespace cg = cooperative_groups;
constexpr int NTHR = 512;
constexpr int LDS_BYTES = 147456;
#define LAS __attribute__((address_space(3)))

struct Params {
    const float *x, *mem; const int* positions;
    const float *w_in, *pe_k, *pe_v, *w1k, *w2k, *w1v, *w2v, *w_out, *ln1g, *ln1b, *w_xq, *w_xkv, *w_xo, *ln2g, *ln2b, *w_router, *rbias, *w_gate, *w_up, *w_down, *ws_gate, *ws_up, *ws_down, *ln3g, *ln3b;
    float* out; unsigned char* ws;
    float lg[4];
    int ph_lo, ph_hi;
};

__device__ __forceinline__ float wave_sum(float v) {
#pragma unroll
    for (int o = 1; o < 64; o <<= 1) v += __shfl_xor(v, o);
    return v;
}
__device__ __forceinline__ float wave_max(float v) {
#pragma unroll
    for (int o = 1; o < 64; o <<= 1) v = fmaxf(v, __shfl_xor(v, o));
    return v;
}
__device__ __forceinline__ float siluf(float v) { return v / (1.f + __expf(-v)); }
__device__ __forceinline__ float sigmf(float v) { return 1.f / (1.f + __expf(-v)); }

__device__ __forceinline__ void b_transpose_tile(const float* __restrict__ W, int K, int N, h16* __restrict__ WT, int Npad, int tile, float* tl, int lt, int rs = 1, int ro = 0) {
    const int ntn = Npad / 32; const int n0 = (tile % ntn) * 32, k0 = (tile / ntn) * 32, tx = lt & 31, ty = lt >> 5;
    for (int i = ty; i < 32; i += 8) { const int k = k0 + i, n = n0 + tx; tl[i * 33 + tx] = (n < N) ? W[(size_t)k * N + n] : 0.f; }
    __syncthreads();
    for (int i = ty; i < 32; i += 8) { const int n = n0 + i, k = k0 + tx; WT[(size_t)(n * rs + ro) * K + k] = (h16)tl[tx * 33 + i]; }
    __syncthreads();
}
__device__ __forceinline__ void w_transpose_item(const float* __restrict__ W, int K, int N, h16* __restrict__ WT, int item, LAS float* scr, int lane, int rs = 1, int ro = 0) {
    const int nblk = N / 32, kb = item / nblk, nb = item % nblk, k0 = 64 * kb, n0 = 32 * nb;
#pragma unroll 8
    for (int i = 0; i < 32; ++i) { const int kk = 2 * i + (lane >> 5); scr[kk * 33 + (lane & 31)] = W[(size_t)(k0 + kk) * N + n0 + (lane & 31)]; }
    asm volatile("s_waitcnt lgkmcnt(0)" ::: "memory");
    const int c = lane & 7;
#pragma unroll
    for (int j = 0; j < 4; ++j) { const int n = (lane >> 3) + 8 * j; LAS const float* s = scr + (8 * c) * 33 + n; h16x8 o;
#pragma unroll
        for (int x = 0; x < 8; ++x) o[x] = (h16)s[x * 33];
        *(h16x8*)(WT + (size_t)((n0 + n) * rs + ro) * K + k0 + 8 * c) = o; }
    asm volatile("s_waitcnt lgkmcnt(0)" ::: "memory");
}
__device__ __forceinline__ void b_cvt(const float* __restrict__ x, h16* __restrict__ o, size_t n4) {
    for (size_t i = (size_t)blockIdx.x * NTHR + tidx(); i < n4; i += (size_t)gridDim.x * NTHR) {
        const f32x4 v = ((const f32x4*)x)[i]; ((h16x4*)o)[i] = __builtin_convertvector(v, h16x4); }
}

__device__ __forceinline__ void b_tables(const int* __restrict__ positions, float* __restrict__ cosr, float* __restrict__ sinr, float* __restrict__ cosn, float* __restrict__ sinn) {
    for (int idx = blockIdx.x * NTHR + tidx(); idx < M * 72; idx += gridDim.x * NTHR) {
        const int m = idx / 72, j = idx % 72; const float pos = (float)positions[m];
        const float inv = j < 64 ? (float)pow(10000.0, -(double)j / 64.0) : (float)pow(500000.0, -(double)(j - 64) / 8.0);
        const float ang = pos * inv; double sd, cd; sincos((double)ang, &sd, &cd);
        if (j < 64) { cosr[(size_t)m * 64 + j] = (float)cd; sinr[(size_t)m * 64 + j] = (float)sd; } else { cosn[(size_t)m * 8 + j - 64] = (float)cd; sinn[(size_t)m * 8 + j - 64] = (float)sd; }
    }
}
__device__ __forceinline__ void b_rope(const h16* __restrict__ h, h16* __restrict__ rqr, h16* __restrict__ rkr, h16* __restrict__ nqr, h16* __restrict__ ksR, h16* __restrict__ kwR, const float* __restrict__ cosr, const float* __restrict__ sinr,
                                       const float* __restrict__ cosn, const float* __restrict__ sinn, int m, int j) {
    const h16* hr = h + (size_t)m * INP; const int bb = m >> 13, t = m & (T - 1);
    {   const int hd = j >> 6, jj = j & 63; const float c = cosr[(size_t)m * 64 + jj], s = sinr[(size_t)m * 64 + jj]; const size_t ro = ((size_t)(bb * 4 + hd) * T + t) * 128;
        const int o1 = hd * 128 + jj, o2 = o1 + 64;
        const float q1 = (float)hr[C_RQ + o1], q2 = (float)hr[C_RQ + o2];
        rqr[ro + jj] = (h16)(q1 * c - q2 * s); rqr[ro + jj + 64] = (h16)(q2 * c + q1 * s);
        const float k1 = (float)hr[C_RK + o1], k2 = (float)hr[C_RK + o2]; const float sc = 0.08838834764831845f;
        rkr[ro + jj] = (h16)((k1 * c - k2 * s) * sc); rkr[ro + jj + 64] = (h16)((k2 * c + k1 * s) * sc);
    }
    if (j < 64 + 16 + 16) {
        const int jj = j & 7; const float c = cosn[(size_t)m * 8 + jj], s = sinn[(size_t)m * 8 + jj];
        if (j < 64) { const int hd = j >> 3; const int o1 = hd * 64 + jj, o2 = o1 + 8;
            const float q1 = (float)hr[C_NQ + o1], q2 = (float)hr[C_NQ + o2];
            nqr[(size_t)m * 512 + o1] = (h16)(q1 * c - q2 * s); nqr[(size_t)m * 512 + o2] = (h16)(q2 * c + q1 * s);
        } else { const int jx = j - 64; const int which = jx >> 4, g = (jx >> 3) & 1; const int base = (which ? C_NKW : C_NKS) + g * 64 + jj;
            const float k1 = (float)hr[base], k2 = (float)hr[base + 8];
            h16* dst = (which ? kwR : ksR) + (((size_t)((bb * 2 + g) * 128 + (t >> 6)) * 64 + (t & 63)) * 64); dst[jj] = (h16)(k1 * c - k2 * s); dst[jj + 8] = (h16)(k2 * c + k1 * s); }
    }
    if (j >= 128 && j < 128 + 96) { const int jx = j - 128; const int which = jx / 48, r = jx % 48, g = r / 24, d = 16 + 2 * (r % 24);
        const int base = (which ? C_NKW : C_NKS) + g * 64 + d; h16* dst = (which ? kwR : ksR) + (((size_t)((bb * 2 + g) * 128 + (t >> 6)) * 64 + (t & 63)) * 64);
        dst[d] = hr[base]; dst[d + 1] = hr[base + 1]; }
    for (int i = j; i < 8 * 48; i += 256) { const int hd = i / 48, d = 16 + i % 48; nqr[(size_t)m * 512 + hd * 64 + d] = hr[C_NQ + hd * 64 + d]; }
}
__device__ __forceinline__ void b_rtrans(const Params& p, const h16* __restrict__ h, h16* __restrict__ rvT, h16* __restrict__ rkzT, const float* __restrict__ cosr, const float* __restrict__ sinr, int item, h16* sl, int lt) {
    int id = item; const int tt = id & 127; id >>= 7; const int hd = id & 3; const int b = id >> 2; const int bh = b * 4 + hd; const float lg = p.lg[hd];
    for (int i = lt; i < 64 * 128; i += 256) { const int t = i >> 7, e = i & 127; sl[t * 130 + e] = h[(size_t)(b * T + tt * 64 + t) * INP + C_RV + hd * 128 + e]; }
    __syncthreads();
    for (int i = lt; i < 64 * 128; i += 256) { const int e = i >> 6, t = i & 63; rvT[((size_t)(bh * 64 + (tt >> 1)) * 128 + e) * 128 + (tt & 1) * 64 + t] = sl[t * 130 + e]; }
    __syncthreads();
    for (int i = lt; i < 64 * 64; i += 256) { const int t = i >> 6, jj = i & 63; const size_t m = (size_t)b * T + tt * 64 + t;
        const float c = cosr[m * 64 + jj], s = sinr[m * 64 + jj]; const float k1 = (float)h[m * INP + C_RK + hd * 128 + jj], k2 = (float)h[m * INP + C_RK + hd * 128 + jj + 64];
        const float z = 0.08838834764831845f * __expf(lg * (float)(127 - ((tt * 64 + t) & 127)));
        sl[t * 130 + jj] = (h16)((k1 * c - k2 * s) * z); sl[t * 130 + jj + 64] = (h16)((k2 * c + k1 * s) * z); }
    __syncthreads();
    for (int i = lt; i < 64 * 128; i += 256) { const int d = i >> 6, t = i & 63; rkzT[((size_t)(bh * 64 + (tt >> 1)) * 128 + d) * 128 + (tt & 1) * 64 + t] = sl[t * 130 + d]; }
    __syncthreads();
}
__device__ __forceinline__ void b_mvtrans(const h16* __restrict__ kvm, h16* __restrict__ kvmVT, h16* __restrict__ kx, int item, h16* sl, int lt) {
    int id = item; const int kt = id & 3; id >>= 2; const int dtl = id & 3; id >>= 2; const int hh = id & 3; const int b = id >> 2;
    for (int i = lt; i < 64 * 64; i += 256) { const int k = i >> 6, d = i & 63; sl[k * 66 + d] = kvm[(size_t)(b * MEML + kt * 64 + k) * 2048 + 1024 + hh * 256 + dtl * 64 + d];
        kx[((size_t)(b * 4 + hh) * MEML + kt * 64 + k) * 256 + dtl * 64 + d] = kvm[(size_t)(b * MEML + kt * 64 + k) * 2048 + hh * 256 + dtl * 64 + d]; }
    __syncthreads();
    for (int i = lt; i < 64 * 64; i += 256) { const int d = i >> 6, k = i & 63; kvmVT[(size_t)((b * 4 + hh) * 256 + dtl * 64 + d) * MEML + kt * 64 + k] = sl[k * 66 + d]; }
    __syncthreads();
}

struct CmpSched {
    const char* hbase; const unsigned* cmpoff; const char* Wc1T; int c;
    __device__ bool next(int i, pg8::Unit& u) const {
        if (i > 0 || c >= 32) return false; const int kv = c >> 4, rt = c & 15;
        u.pm = kv * 16 + rt; u.pn = 0; u.A = hbase + (size_t)(kv ? C_NVC : C_NKC) * 2; u.gat = cmpoff + rt * 256; u.B = Wc1T + (size_t)kv * 256 * 2048 * 2; return true; }
};
__device__ __forceinline__ void b_cmp2(const Params& p, const h16* __restrict__ hid, h16* __restrict__ kcmp, h16* __restrict__ vcmpT) {
    const int lane = tidx() & 63;
    for (int r = blockIdx.x * 8 + (tidx() >> 6); r < 2 * 4096; r += gridDim.x * 8) {
        const int kv = r >> 12, rr = r & 4095, g = rr & 1, c = (rr >> 1) & 511, b = rr >> 10;
        const float* w2 = kv ? p.w2v : p.w2k; const h16* hr = hid + (size_t)r * 256; float acc = 0.f;
        for (int j = 0; j < 256; j += 8) { const h16x8 hv = *(const h16x8*)(hr + j);
#pragma unroll
            for (int x = 0; x < 8; ++x) acc += (float)hv[x] * w2[(j + x) * 64 + lane]; }
        if (c == 511) acc = 0.f;
        if (kv == 0) kcmp[((size_t)(b * 2 + g) * 512 + c) * 64 + lane] = (h16)acc;
        else vcmpT[(((size_t)(b * 2 + g) * 8 + (c >> 6)) * 64 + lane) * 64 + (c & 63)] = (h16)acc;
    }
}
__device__ __forceinline__ void b_vtrans(const h16* __restrict__ h, h16* __restrict__ vsT, h16* __restrict__ vwT, int item, h16* sl, int lt) {
    int id = item; const int tt = id & 127; id >>= 7; const int g = id & 1; id >>= 1; const int b = id & 3; const int which = id >> 2;
    const int col = (which ? C_NVW : C_NVS) + g * 64; h16* dst = (which ? vwT : vsT) + (size_t)((b * 2 + g) * 128 + tt) * 4096;
    for (int i = lt; i < 64 * 64; i += 256) { const int t = i >> 6, d = i & 63; sl[t * 66 + d] = h[(size_t)(b * T + tt * 64 + t) * INP + col + d]; }
    __syncthreads();
    for (int i = lt; i < 64 * 64; i += 256) { const int d = i >> 6, t = i & 63; dst[d * 64 + t] = sl[t * 66 + d]; }
    __syncthreads();
}

__device__ __forceinline__ void ret_kv_unit(const h16* __restrict__ rkzT, const h16* __restrict__ rvT, float* __restrict__ kvT, int chunk, int w, int lane) {
    const int i = lane & 15, kg = lane >> 4; const int bh = chunk >> 6, n = chunk & 63;
    h16x8 a[4];
#pragma unroll
    for (int ks = 0; ks < 4; ++ks) a[ks] = *(const h16x8*)(rkzT + ((size_t)chunk * 128 + 16 * w + i) * 128 + 32 * ks + 8 * kg);
#pragma unroll
    for (int et = 0; et < 8; ++et) { f32x4 acc = {0.f, 0.f, 0.f, 0.f};
#pragma unroll
        for (int ks = 0; ks < 4; ++ks) { const h16x8 bq = *(const h16x8*)(rvT + ((size_t)chunk * 128 + 16 * et + i) * 128 + 32 * ks + 8 * kg); acc = __builtin_amdgcn_mfma_f32_16x16x32_f16(a[ks], bq, acc, 0, 0, 0); }
        *(f32x4*)(kvT + ((size_t)chunk * 128 + 16 * et + i) * 128 + 16 * w + 4 * kg) = acc; }
}
__device__ __forceinline__ void b_ret_scan(const Params& p, const float* __restrict__ kvT, h16* __restrict__ prevT) {
    for (int gid = blockIdx.x * NTHR + tidx(); gid < 16 * 16384; gid += gridDim.x * NTHR) {
        const int de = gid & 16383, bh = gid >> 14; const float cd = __expf(p.lg[bh & 3] * 128.f);
        float st = 0.f;
        for (int n = 0; n < 64; ++n) { const size_t o = ((size_t)(bh * 64 + n) << 14) + de; prevT[o] = (h16)st; st = st * cd + kvT[o]; }
    }
}
__device__ __forceinline__ void ret_out_unit(const Params& p, const h16* __restrict__ h, const h16* __restrict__ rqr, const h16* __restrict__ rkr, const h16* __restrict__ rvT, const h16* __restrict__ prevT,
                                             h16* __restrict__ mix, int chunk, int w, int lane) {
    const int i = lane & 15, kg = lane >> 4; const int bh = chunk >> 6, n = chunk & 63, b = bh >> 2, hd = bh & 3; const float lg = p.lg[hd];
    const int qi = 16 * w + i; const size_t m = (size_t)b * T + n * 128 + qi;
    h16x8 qf[4];
#pragma unroll
    for (int ks = 0; ks < 4; ++ks) qf[ks] = *(const h16x8*)(rqr + ((size_t)bh * T + n * 128 + qi) * 128 + 32 * ks + 8 * kg);
    f32x4 inner[8], cross[8];
#pragma unroll
    for (int et = 0; et < 8; ++et) { inner[et] = (f32x4){0.f, 0.f, 0.f, 0.f}; cross[et] = (f32x4){0.f, 0.f, 0.f, 0.f}; }
    for (int gq = 0; gq < 2; ++gq) {
        if (64 * gq > 16 * w + 15) break;
        f32x4 s[4];
#pragma unroll
        for (int tl = 0; tl < 4; ++tl) { const int ko = 32 * (tl >> 1) + 8 * (i >> 2) + 4 * (tl & 1) + (i & 3); const h16* kp = rkr + ((size_t)bh * T + n * 128 + 64 * gq + ko) * 128 + 8 * kg;
            f32x4 acc = {0.f, 0.f, 0.f, 0.f};
#pragma unroll
            for (int ks = 0; ks < 4; ++ks) acc = __builtin_amdgcn_mfma_f32_16x16x32_f16(*(const h16x8*)(kp + 32 * ks), qf[ks], acc, 0, 0, 0);
            s[tl] = acc; }
        h16x8 pf[2];
#pragma unroll
        for (int tl = 0; tl < 4; ++tl)
#pragma unroll
            for (int r = 0; r < 4; ++r) { const int j = 64 * gq + 32 * (tl >> 1) + 8 * kg + 4 * (tl & 1) + r; const float v = (j <= qi) ? s[tl][r] * __expf(lg * (float)(qi - j)) : 0.f; pf[tl >> 1][4 * (tl & 1) + r] = (h16)v; }
#pragma unroll
        for (int et = 0; et < 8; ++et)
#pragma unroll
            for (int s2 = 0; s2 < 2; ++s2) { const h16x8 a = *(const h16x8*)(rvT + ((size_t)chunk * 128 + 16 * et + i) * 128 + 64 * gq + 32 * s2 + 8 * kg); inner[et] = __builtin_amdgcn_mfma_f32_16x16x32_f16(a, pf[s2], inner[et], 0, 0, 0); }
    }
#pragma unroll
    for (int et = 0; et < 8; ++et)
#pragma unroll
        for (int ks = 0; ks < 4; ++ks) { const h16x8 a = *(const h16x8*)(prevT + ((size_t)chunk * 128 + 16 * et + i) * 128 + 32 * ks + 8 * kg); cross[et] = __builtin_amdgcn_mfma_f32_16x16x32_f16(a, qf[ks], cross[et], 0, 0, 0); }
    const float xi = __expf(lg * (float)(qi + 1));
    float sm = 0.f;
#pragma unroll
    for (int et = 0; et < 8; ++et) { inner[et] = inner[et] + cross[et] * xi; sm += (inner[et][0] + inner[et][1]) + (inner[et][2] + inner[et][3]); }
    sm += __shfl_xor(sm, 16); sm += __shfl_xor(sm, 32);
    const float mu = sm * (1.f / 128.f); float sq = 0.f;
#pragma unroll
    for (int et = 0; et < 8; ++et) { inner[et] = inner[et] - mu; sq += (inner[et][0] * inner[et][0] + inner[et][1] * inner[et][1]) + (inner[et][2] * inner[et][2] + inner[et][3] * inner[et][3]); }
    sq += __shfl_xor(sq, 16); sq += __shfl_xor(sq, 32);
    const float rstd = rsqrtf(sq * (1.f / 128.f) + LN_EPS);
#pragma unroll
    for (int et = 0; et < 8; ++et) { const int e = 16 * et + 4 * kg; const h16x4 gv = *(const h16x4*)(h + m * INP + C_RG + hd * 128 + e);
        f32x4 o;
#pragma unroll
        for (int r = 0; r < 4; ++r) o[r] = siluf((float)gv[r]) * inner[et][r] * rstd;
        *(h16x4*)(mix + m * D + hd * 128 + e) = __builtin_convertvector(o, h16x4); }
}

struct AttSt { float m, l; f32x4 o[4]; };
struct KFrag { h16x8 a[4][2]; };
struct VFrag { h16x8 a[4][2]; };
__device__ __forceinline__ void ldk(KFrag& k, const h16* __restrict__ Kb, int pitchK, int i, int kg) {
#pragma unroll
    for (int tl = 0; tl < 4; ++tl) { const int ko = 32 * (tl >> 1) + 8 * (i >> 2) + 4 * (tl & 1) + (i & 3); const h16* kp = Kb + (size_t)ko * pitchK + 8 * kg;
        k.a[tl][0] = *(const h16x8*)kp; k.a[tl][1] = *(const h16x8*)(kp + 32); }
}
__device__ __forceinline__ void ldv(VFrag& v, const h16* __restrict__ VTb, int vstride, int i, int kg) {
#pragma unroll
    for (int dt = 0; dt < 4; ++dt)
#pragma unroll
        for (int s2 = 0; s2 < 2; ++s2) v.a[dt][s2] = *(const h16x8*)(VTb + (size_t)(16 * dt + i) * vstride + 32 * s2 + 8 * kg);
}
template <class MaskF>
__device__ __forceinline__ void att_scores(f32x4 (&s)[4], const KFrag& k, const h16x8 (&qf)[2], int kg, MaskF valid) {
#pragma unroll
    for (int tl = 0; tl < 4; ++tl) { f32x4 z = {0.f, 0.f, 0.f, 0.f}; z = __builtin_amdgcn_mfma_f32_16x16x32_f16(k.a[tl][0], qf[0], z, 0, 0, 0); s[tl] = __builtin_amdgcn_mfma_f32_16x16x32_f16(k.a[tl][1], qf[1], z, 0, 0, 0); }
#pragma unroll
    for (int tl = 0; tl < 4; ++tl)
#pragma unroll
        for (int r = 0; r < 4; ++r) { const int ko = 32 * (tl >> 1) + 8 * kg + 4 * (tl & 1) + r; s[tl][r] = valid(ko) ? s[tl][r] * 0.125f : -INFINITY; }
}
__device__ __forceinline__ void att_pv(f32x4 (&o)[4], const f32x4 (&pv)[4], const VFrag& v) {
    h16x8 pf[2];
#pragma unroll
    for (int s2 = 0; s2 < 2; ++s2)
#pragma unroll
        for (int j = 0; j < 8; ++j) pf[s2][j] = (h16)pv[2 * s2 + (j >> 2)][j & 3];
#pragma unroll
    for (int dt = 0; dt < 4; ++dt)
#pragma unroll
        for (int s2 = 0; s2 < 2; ++s2) o[dt] = __builtin_amdgcn_mfma_f32_16x16x32_f16(v.a[dt][s2], pf[s2], o[dt], 0, 0, 0);
}
template <class MaskF>
__device__ __forceinline__ void att_tile(AttSt& st, const KFrag& k, const VFrag& v, const h16x8 (&qf)[2], int kg, MaskF valid) {
    f32x4 s[4]; att_scores(s, k, qf, kg, valid);
    float mx = -INFINITY;
#pragma unroll
    for (int tl = 0; tl < 4; ++tl)
#pragma unroll
        for (int r = 0; r < 4; ++r) mx = fmaxf(mx, s[tl][r]);
    mx = fmaxf(mx, __shfl_xor(mx, 16)); mx = fmaxf(mx, __shfl_xor(mx, 32));
    const float mn = fmaxf(st.m, mx); const float alpha = __expf(st.m - mn); st.m = mn;
    float ps = 0.f;
#pragma unroll
    for (int tl = 0; tl < 4; ++tl)
#pragma unroll
        for (int r = 0; r < 4; ++r) { const float pe = __expf(s[tl][r] - mn); s[tl][r] = pe; ps += pe; }
    st.l = st.l * alpha + ps;
#pragma unroll
    for (int dt = 0; dt < 4; ++dt) st.o[dt] = st.o[dt] * alpha;
    att_pv(st.o, s, v);
}
constexpr int NSA_NSLOT = 5, NSA_RING = 0, NSA_IMP = NSA_NSLOT * 16384, NSA_MSK = NSA_IMP + 32768, NSA_LIST = NSA_MSK + 256;
__device__ __forceinline__ void ldk_lds(KFrag& k, LAS const unsigned char* slot, int ko0, int ko1) {
#pragma unroll
    for (int tl = 0; tl < 4; ++tl) { const int o = (32 * (tl >> 1) + 4 * (tl & 1)) * 128; k.a[tl][0] = *(LAS const h16x8*)(slot + o + ko0); k.a[tl][1] = *(LAS const h16x8*)(slot + o + ko1); }
}
__device__ __forceinline__ void ldv_lds(VFrag& v, LAS const unsigned char* slot, int vo0, int vo1) {
#pragma unroll
    for (int dt = 0; dt < 4; ++dt) { v.a[dt][0] = *(LAS const h16x8*)(slot + 8192 + dt * 2048 + vo0); v.a[dt][1] = *(LAS const h16x8*)(slot + 8192 + dt * 2048 + vo1); }
}
#define NSA_WAITV(n) asm volatile("s_waitcnt vmcnt(" #n ")" ::: "memory")
#define NSA_BAR() do { asm volatile("s_waitcnt lgkmcnt(0)" ::: "memory"); __builtin_amdgcn_s_barrier(); asm volatile("" ::: "memory"); } while (0)
template <int LPT, class IssueF, class CompF>
__device__ __forceinline__ void nsa_stream(int n, LAS unsigned char* dmaw, LAS unsigned char* ring, IssueF issue, CompF comp) {
#pragma unroll
    for (int j = 0; j < NSA_NSLOT - 1; ++j) if (j < n) issue(j, (LAS unsigned*)(dmaw + j * 16384));
    int st = 0, si = (NSA_NSLOT - 1) * 16384;
    for (int t = 0; t < n; ++t) {
        const int ahead = n - 1 - t;
        if (ahead >= 3) { if (LPT == 2) NSA_WAITV(6); else NSA_WAITV(3); }
        else if (ahead == 2) { if (LPT == 2) NSA_WAITV(4); else NSA_WAITV(2); }
        else if (ahead == 1) { if (LPT == 2) NSA_WAITV(2); else NSA_WAITV(1); }
        else NSA_WAITV(0);
        NSA_BAR();
        if (t + NSA_NSLOT - 1 < n) issue(t + NSA_NSLOT - 1, (LAS unsigned*)(dmaw + si));
        comp(t, (LAS const unsigned char*)(ring + st));
        st = (st == (NSA_NSLOT - 1) * 16384) ? 0 : st + 16384; si = (si == (NSA_NSLOT - 1) * 16384) ? 0 : si + 16384; }
    NSA_BAR();
}
__device__ __forceinline__ void nsa_block_unit(const h16* __restrict__ h, const h16* __restrict__ nqr, const h16* __restrict__ kcmp, const h16* __restrict__ vcmpT, const h16* __restrict__ vsT, const h16* __restrict__ vwT,
                                               const h16* __restrict__ ksR, const h16* __restrict__ kwR, h16* __restrict__ mix, int b, int g, int T0, LAS unsigned char* lds, int wv, int lane) {
    const int i = lane & 15, kg = lane >> 4, tt = i & 3, hh = i >> 2;
    const int t0 = T0 + 4 * wv, trow = t0 + tt; const size_t mrow = (size_t)b * T + trow;
    const int q = wv * 64 + lane, qrow = q >> 3, qch = q & 7;
    const int ksrc = qrow * 128 + ((qch ^ (((qrow >> 1) & 1) | (((qrow >> 3) & 3) << 1))) << 4), vsrc = qrow * 128 + ((qch ^ ((qrow >> 1) & 7)) << 4);
    const int gki = ((i >> 1) & 1) | ((i >> 2) << 1), gvi = (i >> 1) & 7;
    const int ko0 = (8 * (i >> 2) + (i & 3)) * 128 + ((kg ^ gki) << 4), ko1 = (8 * (i >> 2) + (i & 3)) * 128 + (((kg + 4) ^ gki) << 4);
    const int vo0 = i * 128 + ((kg ^ gvi) << 4), vo1 = i * 128 + (((kg + 4) ^ gvi) << 4);
    LAS unsigned char* ring = lds + NSA_RING; LAS unsigned char* dmaw = ring + wv * 1024;
    LAS float* impA = (LAS float*)(lds + NSA_IMP + wv * 4096); LAS float* impL = impA + 512;
    h16x8 qf[2], qrf[2];
    { const h16* qp = h + mrow * INP + C_NQ + (g * 4 + hh) * 64 + 8 * kg; qf[0] = *(const h16x8*)qp; qf[1] = *(const h16x8*)(qp + 32);
      const h16* qrp = nqr + mrow * 512 + (g * 4 + hh) * 64 + 8 * kg; qrf[0] = *(const h16x8*)qrp; qrf[1] = *(const h16x8*)(qrp + 32); }
    const h16* gp = h + mrow * INP + C_NG + (g * 4 + hh) * 3; const float gt0 = (float)gp[0], gt1 = (float)gp[1], gt2 = (float)gp[2];
    for (int x = lane; x < 1024; x += 64) impA[x] = 0.f;
    NSA_WAITV(0);
#define GLDS16(gsrc, ldst) __builtin_amdgcn_global_load_lds((const unsigned*)(gsrc), (ldst), 16, 0, 0)
    const int ncv_row = trow >= 31 ? ((trow - 31) >> 4) + 1 : 0;
    const int ncv_blk = (T0 + 31 >= 31) ? ((T0 + 31 - 31) >> 4) + 1 : 0;
    const int nct = (ncv_blk + 63) >> 6;
    const unsigned char* Kc = (const unsigned char*)(kcmp + (size_t)(b * 2 + g) * 512 * 64); const unsigned char* Vc = (const unsigned char*)(vcmpT + (size_t)(b * 2 + g) * 8 * 4096);
    float m = -1e30f, l = 0.f;
    f32x4 oc[4];
#pragma unroll
    for (int dt = 0; dt < 4; ++dt) oc[dt] = (f32x4){0.f, 0.f, 0.f, 0.f};
    nsa_stream<1>(nct, dmaw, ring, [&](int j, LAS unsigned* dk) { GLDS16(Kc + (size_t)j * 8192 + ksrc, dk); }, [&](int j, LAS const unsigned char* slot) {
        KFrag kf; ldk_lds(kf, slot, ko0, ko1);
        f32x4 s[4]; att_scores(s, kf, qf, kg, [&](int ko) { return j * 64 + ko < ncv_row; });
        float mx = -INFINITY;
        _Pragma("unroll") for (int tl = 0; tl < 4; ++tl) _Pragma("unroll") for (int r = 0; r < 4; ++r) mx = fmaxf(mx, s[tl][r]);
        mx = fmaxf(mx, __shfl_xor(mx, 16)); mx = fmaxf(mx, __shfl_xor(mx, 32));
        const float mn = fmaxf(m, mx); float ps = 0.f;
        _Pragma("unroll") for (int tl = 0; tl < 4; ++tl) _Pragma("unroll") for (int r = 0; r < 4; ++r) ps += __expf(s[tl][r] - mn);
        l = l * __expf(m - mn) + ps; m = mn; });
    l += __shfl_xor(l, 16); l += __shfl_xor(l, 32);
    const float linv = l > 0.f ? 1.f / l : 0.f;
    nsa_stream<2>(nct, dmaw, ring, [&](int j, LAS unsigned* dk) { GLDS16(Kc + (size_t)j * 8192 + ksrc, dk); GLDS16(Vc + (size_t)j * 8192 + vsrc, (LAS unsigned*)((LAS unsigned char*)dk + 8192)); }, [&](int j, LAS const unsigned char* slot) {
        KFrag kf; ldk_lds(kf, slot, ko0, ko1); VFrag vf; ldv_lds(vf, slot, vo0, vo1);
        f32x4 s[4]; att_scores(s, kf, qf, kg, [&](int ko) { return j * 64 + ko < ncv_row; });
        _Pragma("unroll") for (int tl = 0; tl < 4; ++tl) {
            _Pragma("unroll") for (int r = 0; r < 4; ++r) s[tl][r] = __expf(s[tl][r] - m) * linv;
            float A = (s[tl][0] + s[tl][1]) + (s[tl][2] + s[tl][3]), L = s[tl][3];
            A += __shfl_xor(A, 4); A += __shfl_xor(A, 8); L += __shfl_xor(L, 4); L += __shfl_xor(L, 8);
            if (hh == 0) { const int u = j * 16 + 8 * (tl >> 1) + 2 * kg + (tl & 1); impA[tt * 128 + u] = A; impL[tt * 128 + u] = L; } }
        att_pv(oc, s, vf); });
    const int cur = T0 >> 6;
    AttSt sw; sw.m = -1e30f; sw.l = 0.f;
#pragma unroll
    for (int dt = 0; dt < 4; ++dt) sw.o[dt] = (f32x4){0.f, 0.f, 0.f, 0.f};
    {
        const unsigned char* Kw = (const unsigned char*)(kwR + (size_t)((b * 2 + g) * 128) * 4096); const unsigned char* Vw = (const unsigned char*)(vwT + (size_t)((b * 2 + g) * 128) * 4096);
        const int s0w = (T0 >= 511 ? (T0 - 511) >> 6 : 0);
        nsa_stream<2>(cur - s0w + 1, dmaw, ring, [&](int j, LAS unsigned* dk) { GLDS16(Kw + (size_t)(s0w + j) * 8192 + ksrc, dk); GLDS16(Vw + (size_t)(s0w + j) * 8192 + vsrc, (LAS unsigned*)((LAS unsigned char*)dk + 8192)); }, [&](int j, LAS const unsigned char* slot) {
            KFrag kf; ldk_lds(kf, slot, ko0, ko1); VFrag vf; ldv_lds(vf, slot, vo0, vo1); const int s = s0w + j;
            att_tile(sw, kf, vf, qrf, kg, [&](int ko) { const int kp = 64 * s + ko; return kp <= trow && kp >= trow - 511; }); });
    }
    unsigned long long mylo, myhi, anylo, anyhi;
    if (cur <= 15) { mylo = anylo = (1ull << (cur + 1)) - 1ull; myhi = anyhi = 0ull; }
    else {
        mylo = myhi = anylo = anyhi = 0ull;
        const unsigned long long flo = 1ull | (cur < 64 ? (1ull << cur) : 0ull) | (cur - 1 < 64 ? (1ull << (cur - 1)) : 0ull);
        const unsigned long long fhi = (cur >= 64 ? (1ull << (cur - 64)) : 0ull) | (cur - 1 >= 64 ? (1ull << (cur - 65)) : 0ull);
        const unsigned long long lmask = (1ull << lane) - 1ull;
        for (int tk = 0; tk < 4; ++tk) {
            const int s0 = lane, s1 = lane + 64;
            const float v0 = impA[tk * 128 + s0] + (s0 > 0 ? impL[tk * 128 + s0 - 1] : 0.f), v1 = impA[tk * 128 + s1] + impL[tk * 128 + s1 - 1];
            const unsigned b0 = (s0 >= 1 && s0 <= cur - 2) ? __float_as_uint(v0) + 1u : 0u, b1 = (s1 <= cur - 2) ? __float_as_uint(v1) + 1u : 0u;
            unsigned Tq = 0u;
            for (int bit = 30; bit >= 0; --bit) { const unsigned T2 = Tq | (1u << bit);
                const int c = __popcll(__ballot(b0 >= T2)) + __popcll(__ballot(b1 >= T2)); if (c >= 13) Tq = T2; }
            const unsigned long long gtlo = __ballot(b0 > Tq), gthi = __ballot(b1 > Tq), eqlo = __ballot(b0 == Tq), eqhi = __ballot(b1 == Tq);
            const int need = 13 - (__popcll(gtlo) + __popcll(gthi));
            const bool t0q = (b0 == Tq) && (__popcll(eqlo & lmask) < need), t1q = (b1 == Tq) && (__popcll(eqlo) + __popcll(eqhi & lmask) < need);
            const unsigned long long lo = gtlo | __ballot(t0q) | flo, hi = gthi | __ballot(t1q) | fhi;
            anylo |= lo; anyhi |= hi; if (tt == tk) { mylo = lo; myhi = hi; }
        }
    }
    LAS unsigned long long* msk = (LAS unsigned long long*)(lds + NSA_MSK); LAS unsigned char* lst = lds + NSA_LIST; LAS int* nlst = (LAS int*)(lds + NSA_LIST + 128);
    if (lane == 0) { msk[2 * wv] = anylo; msk[2 * wv + 1] = anyhi; }
    NSA_BAR();
    if (wv == 0) {
        unsigned long long ulo = 0ull, uhi = 0ull;
#pragma unroll
        for (int w2 = 0; w2 < 8; ++w2) { ulo |= msk[2 * w2]; uhi |= msk[2 * w2 + 1]; }
        const unsigned long long lmask = (1ull << lane) - 1ull; const int nlo = __popcll(ulo);
        if ((ulo >> lane) & 1ull) lst[__popcll(ulo & lmask)] = (unsigned char)lane;
        if ((uhi >> lane) & 1ull) lst[nlo + __popcll(uhi & lmask)] = (unsigned char)(64 + lane);
        if (lane == 0) nlst[0] = nlo + __popcll(uhi);
    }
    NSA_BAR();
    const int nsel = nlst[0];
    AttSt ss; ss.m = -1e30f; ss.l = 0.f;
#pragma unroll
    for (int dt = 0; dt < 4; ++dt) ss.o[dt] = (f32x4){0.f, 0.f, 0.f, 0.f};
    {
        const unsigned char* Ks = (const unsigned char*)(ksR + (size_t)((b * 2 + g) * 128) * 4096); const unsigned char* Vs = (const unsigned char*)(vsT + (size_t)((b * 2 + g) * 128) * 4096);
        nsa_stream<2>(nsel, dmaw, ring, [&](int j, LAS unsigned* dk) { const int sj = lst[j]; GLDS16(Ks + (size_t)sj * 8192 + ksrc, dk); GLDS16(Vs + (size_t)sj * 8192 + vsrc, (LAS unsigned*)((LAS unsigned char*)dk + 8192)); }, [&](int j, LAS const unsigned char* slot) {
            const int s = lst[j];
            if ((((s < 64 ? anylo : anyhi) >> (s & 63)) & 1ull) != 0ull) {
                KFrag kf; ldk_lds(kf, slot, ko0, ko1); VFrag vf; ldv_lds(vf, slot, vo0, vo1);
                const bool mybit = (((s < 64 ? mylo : myhi) >> (s & 63)) & 1ull) != 0ull;
                att_tile(ss, kf, vf, qrf, kg, [&](int ko) { return mybit && (64 * s + ko <= trow); }); } });
    }
    float ls = ss.l; ls += __shfl_xor(ls, 16); ls += __shfl_xor(ls, 32); float lw = sw.l; lw += __shfl_xor(lw, 16); lw += __shfl_xor(lw, 32);
    const float g0 = sigmf(gt0), g1 = sigmf(gt1) / ls, g2 = sigmf(gt2) / lw;
#pragma unroll
    for (int dt = 0; dt < 4; ++dt) { const f32x4 o = oc[dt] * g0 + ss.o[dt] * g1 + sw.o[dt] * g2;
        *(h16x4*)(mix + mrow * D + 512 + (g * 4 + hh) * 64 + 16 * dt + 4 * kg) = __builtin_convertvector(o, h16x4); }
#undef GLDS16
}

__device__ __forceinline__ void b_ln(const float* __restrict__ in, const float* __restrict__ gam, const float* __restrict__ bet, float* __restrict__ o32, h16* __restrict__ o16) {
    const int lane = tidx() & 63;
    for (int row = blockIdx.x * 8 + (tidx() >> 6); row < M; row += gridDim.x * 8) {
        const f32x4* xr = (const f32x4*)(in + (size_t)row * D) + lane;
        f32x4 v[4]; float s = 0.f;
#pragma unroll
        for (int j = 0; j < 4; ++j) { v[j] = xr[64 * j]; s += (v[j][0] + v[j][1]) + (v[j][2] + v[j][3]); }
        const float mean = wave_sum(s) * (1.f / D); float s2 = 0.f;
#pragma unroll
        for (int j = 0; j < 4; ++j) { v[j] = v[j] - mean; s2 += (v[j][0] * v[j][0] + v[j][1] * v[j][1]) + (v[j][2] * v[j][2] + v[j][3] * v[j][3]); }
        const float rstd = rsqrtf(wave_sum(s2) * (1.f / D) + LN_EPS);
#pragma unroll
        for (int j = 0; j < 4; ++j) { const f32x4 gg = ((const f32x4*)gam)[lane + 64 * j], bb = ((const f32x4*)bet)[lane + 64 * j]; const f32x4 o = v[j] * rstd * gg + bb;
            ((f32x4*)(o32 + (size_t)row * D))[lane + 64 * j] = o;
            if (o16) ((h16x4*)(o16 + (size_t)row * D))[lane + 64 * j] = __builtin_convertvector(o, h16x4); }
    }
}

__device__ __forceinline__ void xattn_unit(const h16* __restrict__ qx, const h16* __restrict__ kx, const h16* __restrict__ kvmVT, h16* __restrict__ ox, int m0, int hh, int lane) {
    const int i = lane & 15, kg = lane >> 4; const int b = m0 >> 13; const size_t m = (size_t)m0 + i;
    h16x8 qf[8];
#pragma unroll
    for (int ks = 0; ks < 8; ++ks) qf[ks] = *(const h16x8*)(qx + m * D + hh * 256 + 32 * ks + 8 * kg);
    f32x4 o[16];
#pragma unroll
    for (int dt = 0; dt < 16; ++dt) o[dt] = (f32x4){0.f, 0.f, 0.f, 0.f};
    float mrun = -1e30f, l = 0.f;
    const h16* vb = kvmVT + (size_t)((b * 4 + hh) * 256) * MEML;
#pragma unroll 1
    for (int gq = 0; gq < 4; ++gq) {
        f32x4 s[4]; float mx = -INFINITY;
#pragma unroll
        for (int tl = 0; tl < 4; ++tl) { const int ko = 64 * gq + 32 * (tl >> 1) + 8 * (i >> 2) + 4 * (tl & 1) + (i & 3); const h16* kp = kx + ((size_t)(b * 4 + hh) * MEML + ko) * 256 + 8 * kg;
            f32x4 acc = {0.f, 0.f, 0.f, 0.f};
#pragma unroll
            for (int ks = 0; ks < 8; ++ks) acc = __builtin_amdgcn_mfma_f32_16x16x32_f16(*(const h16x8*)(kp + 32 * ks), qf[ks], acc, 0, 0, 0);
            s[tl] = acc * 0.0625f; mx = fmaxf(mx, fmaxf(fmaxf(s[tl][0], s[tl][1]), fmaxf(s[tl][2], s[tl][3]))); }
        mx = fmaxf(mx, __shfl_xor(mx, 16)); mx = fmaxf(mx, __shfl_xor(mx, 32));
        const float mn = fmaxf(mrun, mx); const float alpha = __expf(mrun - mn); mrun = mn;
        float ps = 0.f; h16x8 pf[2];
#pragma unroll
        for (int tl = 0; tl < 4; ++tl)
#pragma unroll
            for (int r = 0; r < 4; ++r) { const float pe = __expf(s[tl][r] - mn); ps += pe; pf[tl >> 1][4 * (tl & 1) + r] = (h16)pe; }
        l = l * alpha + ps;
#pragma unroll
        for (int dt = 0; dt < 16; ++dt) { f32x4 acc = o[dt] * alpha;
#pragma unroll
            for (int s2 = 0; s2 < 2; ++s2) acc = __builtin_amdgcn_mfma_f32_16x16x32_f16(*(const h16x8*)(vb + (size_t)(16 * dt + i) * MEML + 64 * gq + 32 * s2 + 8 * kg), pf[s2], acc, 0, 0, 0);
            o[dt] = acc; }
    }
    l += __shfl_xor(l, 16); l += __shfl_xor(l, 32); const float linv = 1.f / l;
#pragma unroll
    for (int dt = 0; dt < 16; ++dt) { const f32x4 acc = o[dt] * linv; *(h16x4*)(ox + m * D + hh * 256 + 16 * dt + 4 * kg) = __builtin_convertvector(acc, h16x4); }
}

__device__ __forceinline__ void route_token(float logit, int m, int lane, const float* __restrict__ rbias, int* __restrict__ tope, float* __restrict__ topw, int* __restrict__ hist) {
    const float score = 1.f / (1.f + expf(-logit)); const float biased = score + rbias[lane];
    float m1 = biased; m1 = fmaxf(m1, __shfl_xor(m1, 1)); m1 = fmaxf(m1, __shfl_xor(m1, 2)); m1 = fmaxf(m1, __shfl_xor(m1, 4));
    int am = (biased == m1) ? lane : 999; am = min(am, __shfl_xor(am, 1)); am = min(am, __shfl_xor(am, 2)); am = min(am, __shfl_xor(am, 4));
    float m2 = (lane == am) ? -INFINITY : biased; m2 = fmaxf(m2, __shfl_xor(m2, 1)); m2 = fmaxf(m2, __shfl_xor(m2, 2)); m2 = fmaxf(m2, __shfl_xor(m2, 4));
    const float gs = m1 + m2;
    int cnt = 0;
#pragma unroll
    for (int gq = 0; gq < 8; ++gq) { const float o = __shfl(gs, gq * 8); cnt += (o > gs) ? 1 : 0; }
    const float masked = (cnt <= 3) ? biased : NEGF;
    int rank = 0;
    for (int e2 = 0; e2 < 64; ++e2) { const float o = __shfl(masked, e2); rank += (o > masked || (o == masked && e2 < lane)) ? 1 : 0; }
    const bool selq = rank < 8;
    const float wsum = wave_sum(selq ? score : 0.f);
    if (selq) { tope[(size_t)m * 8 + rank] = lane; topw[(size_t)m * 8 + rank] = score / wsum * 2.5f; atomicAdd(hist + (m >> 13) * 65 + lane, 1); }
}
__device__ __forceinline__ void router_unit(const Params& p, const float* __restrict__ x2, const h16* __restrict__ WrTh, const h16* __restrict__ WrTl, int* __restrict__ tope, float* __restrict__ topw, int* __restrict__ hist,
                                            int m0, LAS float* lg, int lane) {
    const int i = lane & 15, kg = lane >> 4;
    f32x4 am_[4], ac_[4];
#pragma unroll
    for (int et = 0; et < 4; ++et) { am_[et] = (f32x4){0.f, 0.f, 0.f, 0.f}; ac_[et] = (f32x4){0.f, 0.f, 0.f, 0.f}; }
    const float* xr = x2 + (size_t)(m0 + i) * D + 8 * kg;
#pragma unroll 2
    for (int ks = 0; ks < 32; ++ks) {
        const f32x4 x0 = *(const f32x4*)(xr + 32 * ks), x1 = *(const f32x4*)(xr + 32 * ks + 4);
        h16x8 xh, xl;
#pragma unroll
        for (int j = 0; j < 4; ++j) { xh[j] = (h16)x0[j]; xl[j] = (h16)((x0[j] - (float)xh[j]) * 2048.f); xh[4 + j] = (h16)x1[j]; xl[4 + j] = (h16)((x1[j] - (float)xh[4 + j]) * 2048.f); }
#pragma unroll
        for (int et = 0; et < 4; ++et) { const h16x8 wh = *(const h16x8*)(WrTh + (size_t)(16 * et + i) * D + 32 * ks + 8 * kg), wl = *(const h16x8*)(WrTl + (size_t)(16 * et + i) * D + 32 * ks + 8 * kg);
            am_[et] = __builtin_amdgcn_mfma_f32_16x16x32_f16(wh, xh, am_[et], 0, 0, 0);
            ac_[et] = __builtin_amdgcn_mfma_f32_16x16x32_f16(wh, xl, ac_[et], 0, 0, 0);
            ac_[et] = __builtin_amdgcn_mfma_f32_16x16x32_f16(wl, xh, ac_[et], 0, 0, 0); }
    }
#pragma unroll
    for (int et = 0; et < 4; ++et)
#pragma unroll
        for (int r = 0; r < 4; ++r) lg[i * 64 + 16 * et + 4 * kg + r] = am_[et][r] + ac_[et][r] * (1.f / 2048.f);
    for (int tk = 0; tk < 16; ++tk) route_token(lg[tk * 64 + lane], m0 + tk, lane, p.rbias, tope, topw, hist);
}

__device__ __forceinline__ void b_moe(const Params& p, const float* __restrict__ x2, const int* __restrict__ tope, const float* __restrict__ topw, float* __restrict__ out, int m, float* sl, int tid) {
    float* xs = sl; float* hd = sl + 1024; float* red = sl + 1280;
    for (int i = tid; i < 1024; i += 256) xs[i] = x2[(size_t)m * D + i];
    __syncthreads();
    float acc[4] = {0.f, 0.f, 0.f, 0.f};
    for (int kx = 0; kx < 9; ++kx) {
        const float* G; const float* U; const float* Dn; float wt;
        if (kx < 8) { const int e = tope[(size_t)m * 8 + kx]; wt = topw[(size_t)m * 8 + kx]; G = p.w_gate + (size_t)e * D * EFF; U = p.w_up + (size_t)e * D * EFF; Dn = p.w_down + (size_t)e * EFF * D; }
        else { wt = 1.f; G = p.ws_gate; U = p.ws_up; Dn = p.ws_down; }
        float a = 0.f, u = 0.f;
        for (int k = 0; k < D; ++k) { const float xv = xs[k]; a += xv * G[(size_t)k * EFF + tid]; u += xv * U[(size_t)k * EFF + tid]; }
        hd[tid] = siluf(a) * u * wt;
        __syncthreads();
        for (int j = 0; j < EFF; ++j) { const float hv = hd[j]; const float* dr = Dn + (size_t)j * D + tid;
            acc[0] += hv * dr[0]; acc[1] += hv * dr[256]; acc[2] += hv * dr[512]; acc[3] += hv * dr[768]; }
        __syncthreads();
    }
    float v[4]; float s = 0.f;
#pragma unroll
    for (int i = 0; i < 4; ++i) { v[i] = DN_ALPHA * xs[tid + 256 * i] + acc[i]; s += v[i]; }
    s = wave_sum(s); if ((tid & 63) == 0) red[tid >> 6] = s; __syncthreads();
    const float mean = (red[0] + red[1] + red[2] + red[3]) * (1.f / D); float s2 = 0.f;
#pragma unroll
    for (int i = 0; i < 4; ++i) { v[i] -= mean; s2 += v[i] * v[i]; }
    s2 = wave_sum(s2); if ((tid & 63) == 0) red[4 + (tid >> 6)] = s2; __syncthreads();
    const float rstd = rsqrtf((red[4] + red[5] + red[6] + red[7]) * (1.f / D) + LN_EPS);
#pragma unroll
    for (int i = 0; i < 4; ++i) out[(size_t)m * D + tid + 256 * i] = v[i] * rstd * p.ln3g[tid + 256 * i] + p.ln3b[tid + 256 * i];
    __syncthreads();
}

struct G1Sched {
    const int* ctl; const char* x2h; const unsigned* rowoff; const char* WguT; int G, c;
    __device__ bool next(int i, pg8::Unit& u) const {
        const int ntile = ctl[CTL_TQS + NQ]; const long L = (long)i * G + c; if (L >= 2L * ntile) return false;
        const int tile = (int)(L >> 1), pn = (int)(L & 1); const int e = ctl[CTL_TVE + tile] % 65;
        u.pm = tile; u.pn = pn; u.A = x2h; u.gat = rowoff + (size_t)tile * 256; u.B = WguT + ((size_t)e * 512 + pn * 256) * (D * 2); return true; }
};
struct G2Sched {
    const int* ctl; const char* H; const char* WdT; int q, G, c;
    __device__ bool next(int i, pg8::Unit& u) const {
        const int t0 = ctl[CTL_TQS + q], t1 = ctl[CTL_TQS + q + 1]; const long L = (long)i * G + c; if (L >= 4L * (t1 - t0)) return false;
        const int tile = t0 + (int)(L >> 2), pn = (int)(L & 3); const int e = ctl[CTL_TVE + tile] % 65;
        u.pm = tile; u.pn = pn; u.A = H + (size_t)tile * 256 * (EFF * 2); u.gat = nullptr; u.B = WdT + ((size_t)e * D + pn * 256) * (EFF * 2); return true; }
};
__device__ __forceinline__ void b_scatter(int* __restrict__ ctl, const int* __restrict__ tope, const float* __restrict__ topw, unsigned* __restrict__ rowoff, u32x2* __restrict__ rowmeta, int* sl) {
    int* pst = sl;
    if (tidx() == 0) { int acc = 0; for (int v = 0; v < NVE; ++v) { pst[v] = acc; acc += (ctl[CTL_CNT + v] + 255) & ~255; } pst[NVE] = acc; }
    __syncthreads();
    if (blockIdx.x == 0) {
        for (int v = tidx(); v <= NVE; v += NTHR) ctl[CTL_PST + v] = pst[v];
        if (tidx() <= NQ) ctl[CTL_TQS + tidx()] = pst[tidx() * 65] >> 8;
        for (int v = tidx(); v < NVE; v += NTHR) for (int tl = pst[v] >> 8; tl < (pst[v + 1] >> 8); ++tl) ctl[CTL_TVE + tl] = v;
    }
    for (int idx = blockIdx.x * NTHR + tidx(); idx < M * 9; idx += gridDim.x * NTHR) {
        int m, k, pos; float w;
        if (idx < M * 8) { m = idx >> 3; k = idx & 7; const int ve = (m >> 13) * 65 + tope[idx]; w = topw[idx]; pos = pst[ve] + atomicAdd(ctl + CTL_CUR + ve, 1); }
        else { m = idx - M * 8; k = 8; w = 1.f; pos = pst[(m >> 13) * 65 + 64] + (m & (QT - 1)); }
        rowoff[pos] = (unsigned)m * (D * 2); rowmeta[pos] = (u32x2){(unsigned)((m & (QT - 1)) * 9 + k), __float_as_uint(w)};
    }
    __syncthreads();
}
__device__ __forceinline__ void b_combine(const Params& p, const h16* __restrict__ x2h, const h16* __restrict__ Y, int q) {
    const int lane = tidx() & 63;
    for (int r = blockIdx.x * 8 + (tidx() >> 6); r < QT; r += gridDim.x * 8) {
        const int m = q * QT + r;
        float v[16];
        { const h16x8 a = ((const h16x8*)(x2h + (size_t)m * D))[lane], b = ((const h16x8*)(x2h + (size_t)m * D))[lane + 64];
#pragma unroll
          for (int i = 0; i < 8; ++i) { v[i] = DN_ALPHA * (float)a[i]; v[8 + i] = DN_ALPHA * (float)b[i]; } }
#pragma unroll
        for (int k = 0; k < 9; ++k) { const h16x8* yr = (const h16x8*)(Y + ((size_t)r * 9 + k) * D); const h16x8 a = yr[lane], b = yr[lane + 64];
#pragma unroll
            for (int i = 0; i < 8; ++i) { v[i] += (float)a[i]; v[8 + i] += (float)b[i]; } }
        float s = 0.f;
#pragma unroll
        for (int i = 0; i < 16; ++i) s += v[i];
        const float mean = wave_sum(s) * (1.f / D); float s2 = 0.f;
#pragma unroll
        for (int i = 0; i < 16; ++i) { v[i] -= mean; s2 += v[i] * v[i]; }
        const float rstd = rsqrtf(wave_sum(s2) * (1.f / D) + LN_EPS);
#pragma unroll
        for (int hlf = 0; hlf < 2; ++hlf) { const int c0 = (lane + 64 * hlf) * 8;
            const f32x4 g0 = *(const f32x4*)(p.ln3g + c0), g1 = *(const f32x4*)(p.ln3g + c0 + 4), b0 = *(const f32x4*)(p.ln3b + c0), b1 = *(const f32x4*)(p.ln3b + c0 + 4);
            f32x4 o0, o1;
#pragma unroll
            for (int i = 0; i < 4; ++i) { o0[i] = v[8 * hlf + i] * rstd * g0[i] + b0[i]; o1[i] = v[8 * hlf + 4 + i] * rstd * g1[i] + b1[i]; }
            *(f32x4*)(p.out + (size_t)m * D + c0) = o0; *(f32x4*)(p.out + (size_t)m * D + c0 + 4) = o1; }
    }
}

#define XB_TMO      128
#define XB_XCNT(j)  (256  + 64 * (j))
#define XB_XSUB(j)  (1280 + 64 * (j))
#define XB_XGEN(j)  (2304 + 64 * (j))
#define XB_TOP      3328
#define XB_TOPGEN   3392
#define XCD_BAR_WORDS 3456
#define XB_SPIN_CAP (1u << 22)
__device__ __forceinline__ unsigned xb_ld(unsigned* p)              { return __hip_atomic_load(p, __ATOMIC_RELAXED, __HIP_MEMORY_SCOPE_AGENT); }
__device__ __forceinline__ unsigned xb_add(unsigned* p, unsigned v) { return __hip_atomic_fetch_add(p, v, __ATOMIC_RELAXED, __HIP_MEMORY_SCOPE_AGENT); }
__device__ __forceinline__ unsigned xb_xcc_id() { return (unsigned)__builtin_amdgcn_s_getreg((3 << 11) | 20) & 0xFu; }
#define XB_SPIN(cond, bar) do { unsigned _sp = 0; while (cond) { __builtin_amdgcn_s_sleep(1); \
    if ((++_sp & 255u) == 0u) { if (xb_ld(&(bar)[XB_TMO])) break; if (_sp > XB_SPIN_CAP) { atomicAdd(&(bar)[XB_TMO], 1u); break; } } } } while (0)
struct XcdBarrier { unsigned* bar; unsigned x; volatile LAS unsigned* st; };
__device__ __forceinline__ XcdBarrier xcd_barrier_post(unsigned* bar, volatile LAS unsigned* st) {
    XcdBarrier b; b.bar = bar; b.x = xb_xcc_id(); b.st = st;
    if (threadIdx.x == 0) (void)xb_add(&bar[XB_XCNT(b.x)], 1u);
    return b;
}
__device__ __forceinline__ void xcd_barrier_complete(unsigned* bar, unsigned x, unsigned& nloc, unsigned& nx) {
    const unsigned G = gridDim.x * gridDim.y * gridDim.z;
    unsigned sum, cnt, mine, sp = 0u;
    for (;;) {
        sum = 0u; cnt = 0u; mine = 0u;
#pragma unroll
        for (unsigned j = 0; j < 16; ++j) { const unsigned c = xb_ld(&bar[XB_XCNT(j)]); sum += c; cnt += (c > 0u) ? 1u : 0u; mine = (j == x) ? c : mine; }
        if (sum == G) break;
        __builtin_amdgcn_s_sleep(1);
        if ((++sp & 255u) == 0u) { if (xb_ld(&bar[XB_TMO])) break; if (sp > XB_SPIN_CAP) { atomicAdd(&bar[XB_TMO], 1u); break; } }
    }
    nloc = mine > 0u ? mine : 1u; nx = cnt > 0u ? cnt : 1u;
}
__device__ __forceinline__ void xcd_barrier(const XcdBarrier& b) {
    asm volatile("s_waitcnt vmcnt(0)" ::: "memory");
    __syncthreads();
    if (threadIdx.x == 0) {
        unsigned* bar = b.bar;
        __builtin_amdgcn_s_waitcnt(0);
        unsigned nloc = b.st[0], nx = b.st[1];
        if (nloc == 0u) { xcd_barrier_complete(bar, b.x, nloc, nx); b.st[0] = nloc; b.st[1] = nx; }
        const unsigned old = xb_add(&bar[XB_XSUB(b.x)], 1u);
        const unsigned gen = old / nloc;
        if (old + 1u == (gen + 1u) * nloc) {
            __builtin_amdgcn_fence(__ATOMIC_RELEASE, "agent");
            asm volatile("s_waitcnt vmcnt(0)" ::: "memory");
            const unsigned og = xb_add(&bar[XB_TOP], 1u);
            const unsigned tg = og / nx;
            if (og + 1u == (tg + 1u) * nx) xb_add(&bar[XB_TOPGEN], 1u);
            else XB_SPIN(xb_ld(&bar[XB_TOPGEN]) == tg, bar);
            __builtin_amdgcn_fence(__ATOMIC_ACQUIRE, "agent");
            xb_add(&bar[XB_XGEN(b.x)], 1u);
            asm volatile("s_waitcnt vmcnt(0)" ::: "memory");
        } else {
            XB_SPIN(xb_ld(&bar[XB_XGEN(b.x)]) == gen, bar);
            __builtin_amdgcn_fence(__ATOMIC_ACQUIRE, "agent");
            asm volatile("s_waitcnt vmcnt(0)" ::: "memory");
        }
    }
    __syncthreads();
}

constexpr int N_PHASES = 23;

__global__ void __launch_bounds__(NTHR, 2) mega_fwd(Params p) {
    extern __shared__ __attribute__((aligned(16))) unsigned char lds[];
    cg::grid_group grid = cg::this_grid();
    const int G = (int)gridDim.x, bid = (int)blockIdx.x;
#define tid tidx()
    unsigned char* ws = p.ws;
    h16* WinT = (h16*)(ws + WS_WIN); h16* WoutT = (h16*)(ws + WS_WOUT); h16* WxqT = (h16*)(ws + WS_WXQ); h16* WxoT = (h16*)(ws + WS_WXO); h16* WxkvT = (h16*)(ws + WS_WXKV);
    h16* memh = (h16*)(ws + WS_MEMH); h16* kvm = (h16*)(ws + WS_KVM); h16* kcmp = (h16*)(ws + WS_KCMP); h16* vcmpT = (h16*)(ws + WS_VCMP); h16* vsT = (h16*)(ws + WS_VST); h16* vwT = (h16*)(ws + WS_VWT);
    int* tope = (int*)(ws + WS_TOPE); float* topw = (float*)(ws + WS_TOPW);
    h16* xh = (h16*)(ws + WS_XH); h16* mix = (h16*)(ws + WS_MIX); h16* ox = (h16*)(ws + WS_OX); h16* hb = (h16*)(ws + WS_H); h16* nqr = (h16*)(ws + WS_NQR);
    float* kvb = (float*)(ws + WS_KVB); h16* prevT = (h16*)(ws + WS_PREVT);
    float* cosr = (float*)(ws + WS_COSR); float* sinr = (float*)(ws + WS_SINR); float* cosn = (float*)(ws + WS_COSN); float* sinn = (float*)(ws + WS_SINN); h16* kvmVT = (h16*)(ws + WS_KVMVT); h16* WrTh = (h16*)(ws + WS_WRTH); h16* WrTl = (h16*)(ws + WS_WRTL); h16* Wc1T = (h16*)(ws + WS_WC1T); h16* hid = (h16*)(ws + WS_HID); unsigned* cmpoff = (unsigned*)(ws + WS_CMPOFF); float* peb = (float*)(ws + WS_PEB); h16* ksR = (h16*)(ws + WS_KSR); h16* kwR = (h16*)(ws + WS_KWR); h16* kx = (h16*)(ws + WS_KX);
    h16* rqr = (h16*)((unsigned char*)p.out + DO_RQR); h16* rkr = (h16*)((unsigned char*)p.out + DO_RKR); h16* rkzT = (h16*)((unsigned char*)p.out + DO_RKZT); h16* rvT = (h16*)((unsigned char*)p.out + DO_RVT); float* pre = p.out; float* x1 = (float*)(ws + WS_X1); h16* x1h = (h16*)(ws + WS_X1H);
    h16* qx = (h16*)(ws + WS_QX); float* x2 = (float*)(ws + WS_X2); h16* x2h = (h16*)(ws + WS_X2H);
    int* ctl = (int*)ws; unsigned* rowoff = (unsigned*)(ws + WS_ROWOFF); u32x2* rowmeta = (u32x2*)(ws + WS_ROWMETA);
    h16* WguT = (h16*)(ws + WS_WGUT); h16* WdT = (h16*)(ws + WS_WDT); h16* Hm = (h16*)(ws + WS_HM); h16* Yq = (h16*)(ws + WS_Y);
    float* fl = (float*)lds;
    const int lo = p.ph_lo, hi = p.ph_hi;
#define IN(k) (lo <= (k) && (k) < hi)
    { volatile LAS unsigned* st = (volatile LAS unsigned*)((LAS unsigned char*)lds + 131072); if (threadIdx.x < 2) st[threadIdx.x] = 0u; }
    __syncthreads();
    XcdBarrier xbar = xcd_barrier_post((unsigned*)(ws + WS_BAR), (volatile LAS unsigned*)((LAS unsigned char*)lds + 131072));
#define SEAM(k) do { if (IN(k) && IN((k) + 1)) { if ((k) == 0) grid.sync(); else xcd_barrier(xbar); } } while (0)

    if (IN(0)) REPS(0) {
        { const int sub = tid >> 8, lt = tid & 255; float* tl = fl + sub * 1088;
          constexpr int T0 = (INP / 32) * (D / 32);
          for (int b0 = bid * 2; b0 < T0; b0 += G * 2) b_transpose_tile(p.w_in, D, INC, WinT, INP, b0 + sub, tl, lt); }
        { const int wv = __builtin_amdgcn_readfirstlane(tid >> 6), lane = tid & 63; LAS float* scr = (LAS float*)((LAS unsigned char*)lds + wv * 8704);
          constexpr int I1 = (D / 64) * (D / 32), I4 = (D / 64) * (2 * D / 32), I5 = (2048 / 64) * (256 / 32), IT = 3 * I1 + I4 + 2 * I5;
          for (int it0 = bid * 8 + wv; it0 < IT; it0 += G * 8) { int it = it0;
            if (it < I1) { w_transpose_item(p.w_out, D, D, WoutT, it, scr, lane); continue; } it -= I1;
            if (it < I1) { w_transpose_item(p.w_xq, D, D, WxqT, it, scr, lane); continue; } it -= I1;
            if (it < I1) { w_transpose_item(p.w_xo, D, D, WxoT, it, scr, lane); continue; } it -= I1;
            if (it < I4) { w_transpose_item(p.w_xkv, D, 2 * D, WxkvT, it, scr, lane); continue; } it -= I4;
            if (it < I5) { w_transpose_item(p.w1k, 2048, 256, Wc1T, it, scr, lane); continue; } it -= I5;
            w_transpose_item(p.w1v, 2048, 256, Wc1T + 256 * 2048, it, scr, lane); } }
        __syncthreads();
        b_cvt(p.x, xh, (size_t)M * D / 4);
        b_cvt(p.mem, memh, (size_t)NB * MEML * D / 4);
        if (bid == 0) for (int i = tid; i < 1024; i += NTHR) ctl[i] = 0;
        b_tables(p.positions, cosr, sinr, cosn, sinn);
        for (int idx = bid * NTHR + tid; idx < NE * D; idx += G * NTHR) { const int e = idx >> 10, k = idx & 1023; const float w = p.w_router[k * NE + e]; const h16 hi = (h16)w; WrTh[idx] = hi; WrTl[idx] = (h16)((w - (float)hi) * 2048.f); }
        for (int r = bid * NTHR + tid; r < 4096; r += G * NTHR) { const int g = r & 1, c = min((r >> 1) & 511, 510), b = r >> 10; cmpoff[r] = (unsigned)(((size_t)(b * T + 16 * c) * INP + g * 64) * 2); }
        { const int lane = tid & 63;
          for (int o = bid * 8 + (tid >> 6); o < 512; o += G * 8) { const int kv = o >> 8, j = o & 255; const float* pe = kv ? p.pe_v : p.pe_k; const float* w1 = kv ? p.w1v : p.w1k; float a = 0.f;
              for (int k = lane; k < 2048; k += 64) a += pe[k] * w1[(size_t)k * 256 + j];
              a = wave_sum(a); if (lane == 0) peb[o] = a; } }
    }
    SEAM(0);
    if (IN(1)) {
        REPS(1) { pg8::Gemm g{xh, WinT, M, INP, D}; pg8::StaticOrder S; S.init(g, G, bid); pg8::EpiF16 E{hb, INP};
          pg8::gemm_phase<pg8::EpiF16, pg8::StaticOrder>((PG8_LAS unsigned char*)lds, g.K, S, E); }
        { pg8::Gemm g{memh, WxkvT, NB * MEML, 2 * D, D}; pg8::StaticOrder S; S.init(g, G, bid); pg8::EpiF16 E{kvm, 2 * D};
          pg8::gemm_phase<pg8::EpiF16, pg8::StaticOrder>((PG8_LAS unsigned char*)lds, g.K, S, E); }
    }
    SEAM(1);
    if (IN(2)) REPS(2) {
        if (bid < 32) { CmpSched S{(const char*)hb, cmpoff, (const char*)Wc1T, bid}; pg8::EpiCmp1 E{hid, peb + (bid >> 4) * 256};
            pg8::gemm_phase<pg8::EpiCmp1, CmpSched>((PG8_LAS unsigned char*)lds, 2048, S, E, (size_t)INP * 2); }
        else { const int sub = tid >> 8, lt = tid & 255; const int b2 = bid - 32, G2 = G - 32;
        for (int b0 = b2 * 2; b0 < M; b0 += G2 * 2) b_rope(hb, rqr, rkr, nqr, ksR, kwR, cosr, sinr, cosn, sinn, b0 + sub, lt);
        for (int b0 = b2 * 2; b0 < 2 * NB * 2 * 128; b0 += G2 * 2) b_vtrans(hb, vsT, vwT, b0 + sub, (h16*)(fl + sub * 2304), lt);
        for (int b0 = b2 * 2; b0 < NB * 4 * 128; b0 += G2 * 2) b_rtrans(p, hb, rvT, rkzT, cosr, sinr, b0 + sub, (h16*)(fl + sub * 4224), lt);
        for (int b0 = b2 * 2; b0 < NB * 4 * 16; b0 += G2 * 2) b_mvtrans(kvm, kvmVT, kx, b0 + sub, (h16*)(fl + sub * 2304), lt); } }
    SEAM(2);
    if (IN(3)) {
        REPS(30) b_cmp2(p, hid, kcmp, vcmpT);
        const int wv = __builtin_amdgcn_readfirstlane(tid >> 6), lane = tid & 63;
        REPS(31) for (int ch = bid; ch < NB * 4 * 64; ch += G) ret_kv_unit(rkzT, rvT, kvb, ch, wv, lane); }
    SEAM(3);
    if (IN(4)) REPS(4) b_ret_scan(p, kvb, prevT);
    SEAM(4);
    if (IN(5)) {
        const int wv = __builtin_amdgcn_readfirstlane(tid >> 6), lane = tid & 63;
        REPS(50) { const int bg = bid & 7;
            for (int k = bid >> 3; k < T / 32; k += (G >> 3)) nsa_block_unit(hb, nqr, kcmp, vcmpT, vsT, vwT, ksR, kwR, mix, bg >> 1, bg & 1, (T / 32 - 1 - k) * 32, (LAS unsigned char*)lds, wv, lane); }
        __syncthreads();
        REPS(51) for (int ch = bid; ch < NB * 4 * 64; ch += G) ret_out_unit(p, hb, rqr, rkr, rvT, prevT, mix, ch, wv, lane);
    }
    SEAM(5);
    if (IN(6)) { pg8::Gemm g{mix, WoutT, M, D, D}; pg8::StaticOrder S; S.init(g, G, bid); pg8::EpiResF32 E{pre, p.x, D, DN_ALPHA};
        pg8::gemm_phase<pg8::EpiResF32, pg8::StaticOrder>((PG8_LAS unsigned char*)lds, g.K, S, E); }
    SEAM(6);
    if (IN(7)) REPS(7) b_ln(pre, p.ln1g, p.ln1b, x1, x1h);
    SEAM(7);
    if (IN(8)) { pg8::Gemm g{x1h, WxqT, M, D, D}; pg8::StaticOrder S; S.init(g, G, bid); pg8::EpiF16 E{qx, D};
        pg8::gemm_phase<pg8::EpiF16, pg8::StaticOrder>((PG8_LAS unsigned char*)lds, g.K, S, E); }
    SEAM(8);
    if (IN(9)) { const int wv = __builtin_amdgcn_readfirstlane(tid >> 6), lane = tid & 63;
        REPS(9) for (int u = bid; u < (M / 128) * 4; u += G) xattn_unit(qx, kx, kvmVT, ox, (u >> 2) * 128 + wv * 16, u & 3, lane); }
    SEAM(9);
    if (IN(10)) { pg8::Gemm g{ox, WxoT, M, D, D}; pg8::StaticOrder S; S.init(g, G, bid); pg8::EpiResF32 E{pre, x1, D, DN_ALPHA};
        pg8::gemm_phase<pg8::EpiResF32, pg8::StaticOrder>((PG8_LAS unsigned char*)lds, g.K, S, E); }
    SEAM(10);
    if (IN(11)) REPS(7) b_ln(pre, p.ln2g, p.ln2b, x2, x2h);
    SEAM(11);
    if (IN(12)) {
        { const int wv = __builtin_amdgcn_readfirstlane(tid >> 6), lane = tid & 63; LAS float* lg = (LAS float*)((LAS unsigned char*)lds + wv * 4096);
          for (int u = bid * 8 + wv; u < M / 16; u += G * 8) router_unit(p, x2, WrTh, WrTl, tope, topw, ctl + CTL_CNT, u * 16, lg, lane); }
        __syncthreads();
        if (bid == 0 && tid < NQ) ctl[CTL_CNT + tid * 65 + 64] = QT;
        for (int i = bid * NTHR + tid; i < CAP; i += G * NTHR) { rowoff[i] = 0u; rowmeta[i] = (u32x2){0xffffffffu, 0u}; }
        { const int wv = __builtin_amdgcn_readfirstlane(tid >> 6), lane = tid & 63; LAS float* scr = (LAS float*)((LAS unsigned char*)lds + wv * 8704);
          REPS(121) for (int it = bid * 8 + wv; it < 65 * 384; it += G * 8) { const int e = it / 384, r = it % 384;
            const float* wg = e < 64 ? p.w_gate + (size_t)e * D * EFF : p.ws_gate; const float* wu = e < 64 ? p.w_up + (size_t)e * D * EFF : p.ws_up; const float* wd = e < 64 ? p.w_down + (size_t)e * EFF * D : p.ws_down;
            if (r < 128) w_transpose_item(wg, D, EFF, WguT + (size_t)e * 512 * D, r, scr, lane, 2, 0);
            else if (r < 256) w_transpose_item(wu, D, EFF, WguT + (size_t)e * 512 * D, r - 128, scr, lane, 2, 1);
            else w_transpose_item(wd, EFF, D, WdT + (size_t)e * D * EFF, r - 256, scr, lane); } }
    }
    SEAM(12);
    if (IN(13)) b_scatter(ctl, tope, topw, rowoff, rowmeta, (int*)lds);
    SEAM(13);
    if (IN(14)) REPS(14) { G1Sched S{ctl, (const char*)x2h, rowoff, (const char*)WguT, G, bid}; pg8::EpiGateUp E{Hm};
        pg8::gemm_phase<pg8::EpiGateUp, G1Sched>((PG8_LAS unsigned char*)lds, D, S, E); }
    SEAM(14);
#pragma unroll 1
    for (int q = 0; q < NQ; ++q) {
        if (IN(15 + 2 * q)) REPS(15) { G2Sched S{ctl, (const char*)Hm, (const char*)WdT, q, G, bid}; pg8::EpiDown E{Yq, rowmeta};
            pg8::gemm_phase<pg8::EpiDown, G2Sched>((PG8_LAS unsigned char*)lds, EFF, S, E); }
        SEAM(15 + 2 * q);
        if (IN(16 + 2 * q)) REPS(16) b_combine(p, x2h, Yq, q);
        if (q < NQ - 1) SEAM(16 + 2 * q);
    }
#undef IN
#undef SEAM
#undef tid
}

#ifndef MK_PER_PHASE
#define MK_PER_PHASE 0
#endif
extern "C" void kernel_launch(void* const* d_in, const int* in_sizes, int n_in, void* d_out, int out_size, void* d_ws, size_t ws_size, hipStream_t stream) {
    static int grid = 0;
    if (grid == 0) {
        if (n_in != 28 || in_sizes[0] != M * D || out_size != M * D || ws_size < WS_NEED) { fprintf(stderr, "kernel_launch: unexpected shapes (n_in %d, in0 %d, out %d, ws %zu)\n", n_in, n_in > 0 ? in_sizes[0] : -1, out_size, ws_size); grid = -1; return; }
        if (hipFuncSetAttribute((const void*)mega_fwd, hipFuncAttributeMaxDynamicSharedMemorySize, LDS_BYTES) != hipSuccess) { fprintf(stderr, "kernel_launch: hipFuncSetAttribute failed\n"); grid = -1; return; }
        int dev = 0, cus = 0, per_cu = 0;
        hipGetDevice(&dev); hipDeviceGetAttribute(&cus, hipDeviceAttributeMultiprocessorCount, dev);
        if (hipOccupancyMaxActiveBlocksPerMultiprocessor(&per_cu, (const void*)mega_fwd, NTHR, LDS_BYTES) != hipSuccess || per_cu < 1) { fprintf(stderr, "kernel_launch: occupancy query failed (%d)\n", per_cu); grid = -1; return; }
        grid = cus;
    }
    if (grid < 0) return;
    Params p{};
    p.x = (const float*)d_in[0]; p.mem = (const float*)d_in[1]; p.positions = (const int*)d_in[2];
    p.w_in = (const float*)d_in[3]; p.pe_k = (const float*)d_in[4]; p.pe_v = (const float*)d_in[5];
    p.w1k = (const float*)d_in[6]; p.w2k = (const float*)d_in[7]; p.w1v = (const float*)d_in[8]; p.w2v = (const float*)d_in[9];
    p.w_out = (const float*)d_in[10]; p.ln1g = (const float*)d_in[11]; p.ln1b = (const float*)d_in[12];
    p.w_xq = (const float*)d_in[13]; p.w_xkv = (const float*)d_in[14]; p.w_xo = (const float*)d_in[15];
    p.ln2g = (const float*)d_in[16]; p.ln2b = (const float*)d_in[17]; p.w_router = (const float*)d_in[18]; p.rbias = (const float*)d_in[19];
    p.w_gate = (const float*)d_in[20]; p.w_up = (const float*)d_in[21]; p.w_down = (const float*)d_in[22];
    p.ws_gate = (const float*)d_in[23]; p.ws_up = (const float*)d_in[24]; p.ws_down = (const float*)d_in[25];
    p.ln3g = (const float*)d_in[26]; p.ln3b = (const float*)d_in[27];
    p.out = (float*)d_out; p.ws = (unsigned char*)d_ws;
    for (int i = 0; i < 4; ++i) p.lg[i] = (float)std::log(1.0 - std::pow(2.0, -5.0 - (double)i));
#if MK_PER_PHASE
    for (int ph = 0; ph < N_PHASES; ++ph) { p.ph_lo = ph; p.ph_hi = ph + 1; hipLaunchKernelGGL(mega_fwd, dim3(grid), dim3(NTHR), LDS_BYTES, stream, p); }
#else
    p.ph_lo = 0; p.ph_hi = N_PHASES;
    if (hipMemsetAsync((char*)d_ws + WS_BAR, 0, XCD_BAR_WORDS * 4, stream) != hipSuccess) { fprintf(stderr, "kernel_launch: memset failed\n"); return; }
    void* args[] = {&p};
    hipError_t e = hipLaunchCooperativeKernel((const void*)mega_fwd, dim3(grid), dim3(NTHR), args, LDS_BYTES, stream);
    if (e != hipSuccess) fprintf(stderr, "kernel_launch: cooperative launch failed: %s (grid %d)\n", hipGetErrorString(e), grid);
#endif
}
```

```cpp
#include <hip/hip_runtime.h>
#include <cstdio>
#include <cstdint>
#include <cmath>

typedef _Float16 h16;
typedef _Float16 h16x8 __attribute__((ext_vector_type(8)));
typedef _Float16 h16x2 __attribute__((ext_vector_type(2)));
typedef _Float16 h16x4 __attribute__((ext_vector_type(4)));
typedef float f32x2 __attribute__((ext_vector_type(2)));
typedef float f32x4 __attribute__((ext_vector_type(4)));
typedef unsigned u32x4 __attribute__((ext_vector_type(4)));
typedef unsigned u32x2 __attribute__((ext_vector_type(2)));

__device__ __forceinline__ int tidx() { int t = (int)threadIdx.x; asm volatile("" : "+v"(t)); return t; }

#ifndef PROBE_DBL
#define PROBE_DBL -1
#endif
#define REPS(k) for (int _rep = 0; _rep < ((PROBE_DBL) == (k) ? 2 : 1); ++_rep)

constexpr int NB = 4, T = 8192, D = 1024, M = NB * T;
constexpr int INC = 3352, INP = 3584;
constexpr int C_RQ = 0, C_RK = 512, C_RV = 1024, C_RG = 1536, C_NQ = 2048, C_NKC = 2560, C_NVC = 2688, C_NKS = 2816, C_NVS = 2944, C_NKW = 3072, C_NVW = 3200, C_NG = 3328;
constexpr int MEML = 256;
constexpr int NE = 64, EFF = 256;
constexpr float LN_EPS = 1e-5f;
constexpr float DN_ALPHA = 1.189207115002721f;
constexpr float NEGF = -1e30f;

constexpr size_t MiB = 1u << 20;
constexpr size_t WS_WIN = 1 * MiB, WS_WOUT = 8 * MiB, WS_WXQ = 10 * MiB, WS_WXO = 12 * MiB, WS_WXKV = 14 * MiB, WS_MEMH = 18 * MiB, WS_KVM = 20 * MiB;
constexpr size_t WS_KCMP = 24 * MiB, WS_VCMP = 25 * MiB, WS_TOPE = 26 * MiB, WS_TOPW = 27 * MiB;
constexpr size_t WS_XH = 32 * MiB, WS_MIX = 32 * MiB, WS_OX = 32 * MiB;
constexpr size_t WS_H = 96 * MiB, WS_NQR = 320 * MiB, WS_KVB = 352 * MiB, WS_PREV = 416 * MiB;
constexpr size_t WS_PRE = 96 * MiB, WS_X1 = 224 * MiB, WS_X1H = 352 * MiB, WS_QX = 416 * MiB, WS_X2 = 130 * MiB;
constexpr size_t WS_X2H = 32 * MiB, WS_WDT = 96 * MiB, WS_HM = 130 * MiB, WS_WGUT = 306 * MiB, WS_Y = 306 * MiB;
constexpr size_t WS_ROWOFF = 1 * MiB, WS_ROWMETA = 3 * MiB;
constexpr size_t WS_VST = 480 * MiB, WS_VWT = 488 * MiB, WS_COSR = 496 * MiB, WS_SINR = 504 * MiB, WS_COSN = 28 * MiB, WS_SINN = 29 * MiB, WS_KVMVT = 30 * MiB;
constexpr size_t WS_WRTH = 262144, WS_WRTL = 393216;
constexpr size_t WS_WC1T = 464 * MiB, WS_HID = 466 * MiB, WS_CMPOFF = 131072, WS_PEB = 131072 + 16384;
constexpr size_t WS_PREVT = 416 * MiB, WS_KSR = 448 * MiB, WS_KWR = 456 * MiB, WS_KX = 26 * MiB;
constexpr size_t DO_RQR = 0, DO_RKR = 32 * MiB, DO_RKZT = 64 * MiB, DO_RVT = 96 * MiB;
constexpr size_t WS_NEED = 512 * MiB;
constexpr int NQ = 4, QT = M / NQ, NVE = NQ * 65, CAP_TILES = 1412, CAP = CAP_TILES * 256;
constexpr size_t WS_BAR = 65536;
constexpr int CTL_CNT = 0, CTL_CUR = 512, CTL_PST = 1024, CTL_TQS = 1536, CTL_TVE = 2048;

namespace pg8 {
#define PG8_LAS __attribute__((address_space(3)))
typedef short s16x8 __attribute__((ext_vector_type(8)));
constexpr int BM = 256, BK = 64, HALF = 128, HTB = HALF * BK * 2, STAGE_BYTES = 8 * HTB, NXCD = 8, WGM = 8;
__host__ __device__ __forceinline__ int lds_byte(int r, int c) { const int st = (r >> 4) * 2 + (c >> 5), rr = r & 15, cc = c & 31, ob = rr * 64 + cc * 2; return st * 1024 + (ob ^ (((ob >> 9) & 1) << 5)); }
__host__ __device__ __forceinline__ void stage_rc(int b, int& R, int& C) { const int st = b / 1024, sb = b % 1024, swz = sb ^ (((sb >> 9) & 1) << 5); R = (st >> 1) * 16 + swz / 64; C = (st & 1) * 32 + (swz % 64) / 2; }
__host__ __device__ __forceinline__ int perm32(int rho) { const int n = rho >> 4, i = rho & 15; return 8 * (i >> 2) + 4 * n + (i & 3); }
struct Unit { int pm, pn; const char* A; const char* B; const unsigned* gat; };
struct Gemm { const h16* A; const h16* Bt; int M, N, K; };
struct StaticOrder {
    int nM, nN, nwg, G, c; const char* A; const char* B; size_t tstep;
    __device__ void init(const Gemm& g, int G_, int c_) { nM = g.M / BM; nN = g.N / BM; nwg = nM * nN; G = G_; c = c_; A = (const char*)g.A; B = (const char*)g.Bt; tstep = (size_t)BM * g.K * 2; }
    __device__ bool next(int i, Unit& u) const {
        const long L = (long)i * G + c; if (L >= nwg) return false;
        int wgid = (int)L; { const int q = nwg / NXCD, r = nwg % NXCD, xcd = wgid % NXCD, off = wgid / NXCD; wgid = (xcd < r ? xcd * (q + 1) : r * (q + 1) + (xcd - r) * q) + off; }
        const int nig = WGM * nN, gid = wgid / nig, fm = gid * WGM, gsz = (nM - fm) < WGM ? (nM - fm) : WGM;
        u.pm = fm + ((wgid % nig) % gsz); u.pn = (wgid % nig) / gsz; u.A = A + (size_t)u.pm * tstep; u.B = B + (size_t)u.pn * tstep; u.gat = nullptr; return true;
    }
};
__device__ __forceinline__ unsigned cvt_pk_f16(float lo, float hi) { f32x2 v = {lo, hi}; h16x2 h = __builtin_convertvector(v, h16x2); return __builtin_bit_cast(unsigned, h); }

struct EpiF16 {
    static constexpr bool PERM = true;
    h16* O; int ldc;
    __device__ __forceinline__ void operator()(const f32x4 (&acc)[2][2][4][2], const Unit& u, int wr, int wc, int fr, int fq) const {
        const int row0 = u.pm * BM + wr * 64 + fr; const int col0 = u.pn * BM + wc * 32 + 8 * fq;
#pragma unroll
        for (int ai = 0; ai < 2; ++ai)
#pragma unroll
            for (int m = 0; m < 4; ++m) { h16* rowp = O + (size_t)(row0 + ai * HALF + m * 16) * ldc + col0;
#pragma unroll
                for (int bj = 0; bj < 2; ++bj) { const f32x4 v0 = acc[ai][bj][m][0], v1 = acc[ai][bj][m][1];
                    *(h16x8*)(rowp + bj * HALF) = __builtin_convertvector(__builtin_shufflevector(v0, v1, 0, 1, 2, 3, 4, 5, 6, 7), h16x8); } }
    }
};
struct EpiResF32 {
    static constexpr bool PERM = false;
    float* C; const float* R; int ldc; float alpha;
    __device__ __forceinline__ void operator()(const f32x4 (&acc)[2][2][4][2], const Unit& u, int wr, int wc, int fr, int fq) const {
        const int row0 = u.pm * BM + wr * 64 + fr, col0 = u.pn * BM + wc * 32 + 4 * fq;
#pragma unroll
        for (int ai = 0; ai < 2; ++ai)
#pragma unroll
            for (int m = 0; m < 4; ++m) { const size_t off = (size_t)(row0 + ai * HALF + m * 16) * ldc + col0;
#pragma unroll
                for (int bj = 0; bj < 2; ++bj)
#pragma unroll
                    for (int n = 0; n < 2; ++n) { const f32x4 r = *(const f32x4*)(R + off + bj * HALF + n * 16); *(f32x4*)(C + off + bj * HALF + n * 16) = r * alpha + acc[ai][bj][m][n]; } }
    }
};
struct EpiCmp1 {
    static constexpr bool PERM = true;
    h16* O; const float* peb;
    __device__ __forceinline__ void operator()(const f32x4 (&acc)[2][2][4][2], const Unit& u, int wr, int wc, int fr, int fq) const {
        const int row0 = u.pm * BM + wr * 64 + fr; const int col0 = wc * 32 + 8 * fq;
#pragma unroll
        for (int bj = 0; bj < 2; ++bj) { const f32x4 b0 = *(const f32x4*)(peb + col0 + bj * HALF), b1 = *(const f32x4*)(peb + col0 + bj * HALF + 4);
#pragma unroll
            for (int ai = 0; ai < 2; ++ai)
#pragma unroll
                for (int m = 0; m < 4; ++m) { f32x4 v0 = acc[ai][bj][m][0] + b0, v1 = acc[ai][bj][m][1] + b1;
#pragma unroll
                    for (int r = 0; r < 4; ++r) { v0[r] = v0[r] / (1.f + __expf(-v0[r])); v1[r] = v1[r] / (1.f + __expf(-v1[r])); }
                    *(h16x8*)(O + (size_t)(row0 + ai * HALF + m * 16) * 256 + col0 + bj * HALF) = __builtin_convertvector(__builtin_shufflevector(v0, v1, 0, 1, 2, 3, 4, 5, 6, 7), h16x8); } }
    }
};
struct EpiGateUp {
    static constexpr bool PERM = true;
    h16* H;
    __device__ __forceinline__ void operator()(const f32x4 (&acc)[2][2][4][2], const Unit& u, int wr, int wc, int fr, int fq) const {
        const int row0 = u.pm * BM + wr * 64 + fr; const int col0 = u.pn * 128 + wc * 16 + 4 * fq;
#pragma unroll
        for (int ai = 0; ai < 2; ++ai)
#pragma unroll
            for (int m = 0; m < 4; ++m) { h16* rowp = H + (size_t)(row0 + ai * HALF + m * 16) * 256 + col0;
#pragma unroll
                for (int bj = 0; bj < 2; ++bj) { const f32x4 v0 = acc[ai][bj][m][0], v1 = acc[ai][bj][m][1];
                    const float h0 = v0[0] / (1.f + __expf(-v0[0])) * v0[1], h1 = v0[2] / (1.f + __expf(-v0[2])) * v0[3];
                    const float h2 = v1[0] / (1.f + __expf(-v1[0])) * v1[1], h3 = v1[2] / (1.f + __expf(-v1[2])) * v1[3];
                    *(h16x4*)(rowp + bj * 64) = __builtin_convertvector((f32x4){h0, h1, h2, h3}, h16x4); } }
    }
};
struct EpiDown {
    static constexpr bool PERM = true;
    h16* Y; const u32x2* rowmeta;
    __device__ __forceinline__ void operator()(const f32x4 (&acc)[2][2][4][2], const Unit& u, int wr, int wc, int fr, int fq) const {
        const int row0 = u.pm * BM + wr * 64 + fr; const int col0 = u.pn * BM + wc * 32 + 8 * fq;
#pragma unroll
        for (int ai = 0; ai < 2; ++ai)
#pragma unroll
            for (int m = 0; m < 4; ++m) { const u32x2 md = rowmeta[row0 + ai * HALF + m * 16]; const int slot = (int)md.x; const float w8 = __uint_as_float(md.y);
                if (slot >= 0) { h16* rowp = Y + (size_t)slot * 1024 + col0;
#pragma unroll
                    for (int bj = 0; bj < 2; ++bj) { const f32x4 v0 = acc[ai][bj][m][0] * w8, v1 = acc[ai][bj][m][1] * w8;
                        *(h16x8*)(rowp + bj * HALF) = __builtin_convertvector(__builtin_shufflevector(v0, v1, 0, 1, 2, 3, 4, 5, 6, 7), h16x8); } }
                asm volatile("" ::: "memory"); }
    }
};

template <class Epi, class Sched>
__device__ __forceinline__ void gemm_phase(PG8_LAS unsigned char* lds, const int K, const Sched& S, const Epi& E, const size_t kstepA = (size_t)(BK * 2)) {
    const int tid = tidx(), wid = __builtin_amdgcn_readfirstlane(tid >> 6), lane = tid & 63, wr = wid >> 2, wc = wid & 3, fr = lane & 15, fq = lane >> 4;
    const int nt = K / BK;
    int R0, C0; stage_rc(tid * 16, R0, C0);
    const unsigned cb2 = (unsigned)C0 * 2u;
    unsigned voffB[2];
#pragma unroll
    for (int i = 0; i < 2; ++i) { const int R = R0 + 64 * i; const int Rb = Epi::PERM ? ((R & ~31) + perm32(R & 31)) : R; voffB[i] = (unsigned)(Rb * K) * 2u + cb2; }
    const size_t kstep = (size_t)(BK * 2);
    const size_t hstep = (size_t)HALF * K * 2;
    const unsigned ldsw = (unsigned)wid * 1024u;
    const int aoff = lds_byte(wr * 64 + fr, fq * 8), boff = lds_byte(wc * 32 + fr, fq * 8);
#define PG8_MKVA(u, va) do { _Pragma("unroll") for (int _h = 0; _h < 2; ++_h) _Pragma("unroll") for (int _i = 0; _i < 2; ++_i) { const int _r = _h * HALF + R0 + 64 * _i; \
        (va)[_h][_i] = ((u).gat ? (u).gat[_r] : (unsigned)(_r * K) * 2u) + cb2; } } while (0)
#define PG8_SA(b, h) (((b) * 2 + (h)) * HTB)
#define PG8_SB(b, h) ((4 + (b) * 2 + (h)) * HTB)
#define PG8_STAGE(bufoff, gbase, voff) do { _Pragma("unroll") for (int _i = 0; _i < 2; ++_i) \
        __builtin_amdgcn_global_load_lds((const unsigned*)((const char*)(gbase) + (voff)[_i]), (PG8_LAS unsigned*)(lds + (bufoff) + ldsw + _i * 8192), 16, 0, 0); } while (0)
#define PG8_LDA(dst, b, h) do { _Pragma("unroll") for (int m = 0; m < 4; ++m) _Pragma("unroll") for (int k = 0; k < 2; ++k) dst[m][k] = *(const PG8_LAS s16x8*)(lds + PG8_SA(b, h) + aoff + m * 2048 + k * 1024); } while (0)
#define PG8_LDB(dst, b, h) do { _Pragma("unroll") for (int n = 0; n < 2; ++n) _Pragma("unroll") for (int k = 0; k < 2; ++k) dst[n][k] = *(const PG8_LAS s16x8*)(lds + PG8_SB(b, h) + boff + n * 2048 + k * 1024); } while (0)
#define PG8_MMA(ai, bj, At, Bt) do { __builtin_amdgcn_s_setprio(1); _Pragma("unroll") for (int m = 0; m < 4; ++m) _Pragma("unroll") for (int n = 0; n < 2; ++n) _Pragma("unroll") for (int k = 0; k < 2; ++k) \
        acc[ai][bj][m][n] = __builtin_amdgcn_mfma_f32_16x16x32_f16(__builtin_bit_cast(h16x8, Bt[n][k]), __builtin_bit_cast(h16x8, At[m][k]), acc[ai][bj][m][n], 0, 0, 0); __builtin_amdgcn_s_setprio(0); } while (0)
#define PG8_WAIT_V(n) asm volatile("s_waitcnt vmcnt(" #n ")" ::: "memory")
#define PG8_WAIT_L(n) asm volatile("s_waitcnt lgkmcnt(" #n ")" ::: "memory")
#define PG8_BAR __builtin_amdgcn_s_barrier()
#define PG8_SCHED __builtin_amdgcn_sched_barrier(0)
    Unit cur, nxt; int ui = 0;
    if (!S.next(0, cur)) return;
    unsigned va[2][2];
    PG8_MKVA(cur, va);
    f32x4 acc[2][2][4][2];
#pragma unroll
    for (int a = 0; a < 2; ++a)
#pragma unroll
        for (int b = 0; b < 2; ++b)
#pragma unroll
            for (int m = 0; m < 4; ++m)
#pragma unroll
                for (int n = 0; n < 2; ++n) acc[a][b][m][n] = (f32x4){0.f, 0.f, 0.f, 0.f};
    s16x8 At[4][2], B0[2][2], B1[2][2];
    const char* cA = cur.A; const char* cB = cur.B;
    {
        PG8_STAGE(PG8_SB(0, 0), cB, voffB); PG8_STAGE(PG8_SB(0, 1), cB + hstep, voffB); PG8_STAGE(PG8_SA(0, 0), cA, va[0]); PG8_STAGE(PG8_SA(0, 1), cA, va[1]);
        if (wr == 1) PG8_BAR;
        PG8_WAIT_V(2); PG8_BAR;
        PG8_STAGE(PG8_SB(1, 0), cB + kstep, voffB); PG8_STAGE(PG8_SA(1, 0), cA + kstepA, va[0]); PG8_STAGE(PG8_SB(1, 1), cB + hstep + kstep, voffB);
        PG8_WAIT_V(6); PG8_BAR;
    }
    for (;;) {
        const bool has_next = S.next(ui + 1, nxt);
        const char* nA = has_next ? nxt.A : cA; const char* nB = has_next ? nxt.B : cB;
#pragma unroll 1
        for (int t = 0; t < nt; t += 2) {
            const bool last = (t == nt - 2);
            const char* a1 = cA + (size_t)(t + 1) * kstepA;
            const char* a2 = last ? nA : cA + (size_t)(t + 2) * kstepA; const char* b2 = last ? nB : cB + (size_t)(t + 2) * kstep;
            const char* a3 = a2 + kstepA; const char* b3 = b2 + kstep;
            PG8_LDB(B0, 0, 0); PG8_LDB(B1, 0, 1); PG8_SCHED; PG8_LDA(At, 0, 0); PG8_STAGE(PG8_SA(1, 1), a1, va[1]);
            if (last && has_next) { PG8_MKVA(nxt, va); }
            PG8_WAIT_V(8); PG8_WAIT_L(0); PG8_BAR; PG8_MMA(0, 0, At, B0); PG8_MMA(0, 1, At, B1); PG8_BAR; PG8_SCHED;
            PG8_LDA(At, 0, 1); PG8_STAGE(PG8_SB(0, 0), b2, voffB); PG8_STAGE(PG8_SB(0, 1), b2 + hstep, voffB); PG8_STAGE(PG8_SA(0, 0), a2, va[0]);
            PG8_WAIT_V(8); PG8_WAIT_L(0); PG8_BAR; PG8_MMA(1, 0, At, B0); PG8_MMA(1, 1, At, B1); PG8_BAR; PG8_SCHED;
            PG8_LDB(B0, 1, 0); PG8_LDB(B1, 1, 1); PG8_SCHED; PG8_LDA(At, 1, 0); PG8_STAGE(PG8_SA(0, 1), a2, va[1]);
            PG8_WAIT_V(8); PG8_WAIT_L(0); PG8_BAR; PG8_MMA(0, 0, At, B0); PG8_MMA(0, 1, At, B1); PG8_BAR; PG8_SCHED;
            PG8_LDA(At, 1, 1); PG8_STAGE(PG8_SB(1, 0), b3, voffB); PG8_STAGE(PG8_SB(1, 1), b3 + hstep, voffB); PG8_STAGE(PG8_SA(1, 0), a3, va[0]);
            PG8_WAIT_V(8); PG8_WAIT_L(0); PG8_BAR; PG8_MMA(1, 0, At, B0); PG8_MMA(1, 1, At, B1); PG8_BAR; PG8_SCHED;
        }
        if (wr == 0) PG8_BAR;
        E(acc, cur, wr, wc, fr, fq);
        if (!has_next) break;
#pragma unroll
        for (int a = 0; a < 2; ++a)
#pragma unroll
            for (int b = 0; b < 2; ++b)
#pragma unroll
                for (int m = 0; m < 4; ++m)
#pragma unroll
                    for (int n = 0; n < 2; ++n) acc[a][b][m][n] = (f32x4){0.f, 0.f, 0.f, 0.f};
        cur = nxt; cA = nA; cB = nB; ++ui;
        if (wr == 1) PG8_BAR;
    }
    PG8_WAIT_V(0);
    PG8_BAR;
#undef PG8_MKVA
#undef PG8_SA
#undef PG8_SB
#undef PG8_STAGE
#undef PG8_LDA
#undef PG8_LDB
#undef PG8_MMA
#undef PG8_WAIT_V
#undef PG8_WAIT_L
#undef PG8_BAR
#undef PG8_SCHED
}
}


#include <hip/hip_cooperative_groups.h>
namespace cg = cooperative_groups;
constexpr int NTHR = 512;
constexpr int LDS_BYTES = 147456;
#define LAS __attribute__((address_space(3)))

struct Params {
    const float *x, *mem; const int* positions;
    const float *w_in, *pe_k, *pe_v, *w1k, *w2k, *w1v, *w2v, *w_out, *ln1g, *ln1b, *w_xq, *w_xkv, *w_xo, *ln2g, *ln2b, *w_router, *rbias, *w_gate, *w_up, *w_down, *ws_gate, *ws_up, *ws_down, *ln3g, *ln3b;
    float* out; unsigned char* ws;
    float lg[4];
    int ph_lo, ph_hi;
};

__device__ __forceinline__ float wave_sum(float v) {
#pragma unroll
    for (int o = 1; o < 64; o <<= 1) v += __shfl_xor(v, o);
    return v;
}
__device__ __forceinline__ float wave_max(float v) {
#pragma unroll
    for (int o = 1; o < 64; o <<= 1) v = fmaxf(v, __shfl_xor(v, o));
    return v;
}
__device__ __forceinline__ float siluf(float v) { return v / (1.f + __expf(-v)); }
__device__ __forceinline__ float sigmf(float v) { return 1.f / (1.f + __expf(-v)); }

__device__ __forceinline__ void b_transpose_tile(const float* __restrict__ W, int K, int N, h16* __restrict__ WT, int Npad, int tile, float* tl, int lt, int rs = 1, int ro = 0) {
    const int ntn = Npad / 32; const int n0 = (tile % ntn) * 32, k0 = (tile / ntn) * 32, tx = lt & 31, ty = lt >> 5;
    for (int i = ty; i < 32; i += 8) { const int k = k0 + i, n = n0 + tx; tl[i * 33 + tx] = (n < N) ? W[(size_t)k * N + n] : 0.f; }
    __syncthreads();
    for (int i = ty; i < 32; i += 8) { const int n = n0 + i, k = k0 + tx; WT[(size_t)(n * rs + ro) * K + k] = (h16)tl[tx * 33 + i]; }
    __syncthreads();
}
__device__ __forceinline__ void w_transpose_item(const float* __restrict__ W, int K, int N, h16* __restrict__ WT, int item, LAS float* scr, int lane, int rs = 1, int ro = 0) {
    const int nblk = N / 32, kb = item / nblk, nb = item % nblk, k0 = 64 * kb, n0 = 32 * nb;
#pragma unroll 8
    for (int i = 0; i < 32; ++i) { const int kk = 2 * i + (lane >> 5); scr[kk * 33 + (lane & 31)] = W[(size_t)(k0 + kk) * N + n0 + (lane & 31)]; }
    asm volatile("s_waitcnt lgkmcnt(0)" ::: "memory");
    const int c = lane & 7;
#pragma unroll
    for (int j = 0; j < 4; ++j) { const int n = (lane >> 3) + 8 * j; LAS const float* s = scr + (8 * c) * 33 + n; h16x8 o;
#pragma unroll
        for (int x = 0; x < 8; ++x) o[x] = (h16)s[x * 33];
        *(h16x8*)(WT + (size_t)((n0 + n) * rs + ro) * K + k0 + 8 * c) = o; }
    asm volatile("s_waitcnt lgkmcnt(0)" ::: "memory");
}
__device__ __forceinline__ void b_cvt(const float* __restrict__ x, h16* __restrict__ o, size_t n4) {
    for (size_t i = (size_t)blockIdx.x * NTHR + tidx(); i < n4; i += (size_t)gridDim.x * NTHR) {
        const f32x4 v = ((const f32x4*)x)[i]; ((h16x4*)o)[i] = __builtin_convertvector(v, h16x4); }
}

__device__ __forceinline__ void b_tables(const int* __restrict__ positions, float* __restrict__ cosr, float* __restrict__ sinr, float* __restrict__ cosn, float* __restrict__ sinn) {
    for (int idx = blockIdx.x * NTHR + tidx(); idx < M * 72; idx += gridDim.x * NTHR) {
        const int m = idx / 72, j = idx % 72; const float pos = (float)positions[m];
        const float inv = j < 64 ? (float)pow(10000.0, -(double)j / 64.0) : (float)pow(500000.0, -(double)(j - 64) / 8.0);
        const float ang = pos * inv; double sd, cd; sincos((double)ang, &sd, &cd);
        if (j < 64) { cosr[(size_t)m * 64 + j] = (float)cd; sinr[(size_t)m * 64 + j] = (float)sd; } else { cosn[(size_t)m * 8 + j - 64] = (float)cd; sinn[(size_t)m * 8 + j - 64] = (float)sd; }
    }
}
__device__ __forceinline__ void b_rope(const h16* __restrict__ h, h16* __restrict__ rqr, h16* __restrict__ rkr, h16* __restrict__ nqr, h16* __restrict__ ksR, h16* __restrict__ kwR, const float* __restrict__ cosr, const float* __restrict__ sinr,
                                       const float* __restrict__ cosn, const float* __restrict__ sinn, int m, int j) {
    const h16* hr = h + (size_t)m * INP; const int bb = m >> 13, t = m & (T - 1);
    {   const int hd = j >> 6, jj = j & 63; const float c = cosr[(size_t)m * 64 + jj], s = sinr[(size_t)m * 64 + jj]; const size_t ro = ((size_t)(bb * 4 + hd) * T + t) * 128;
        const int o1 = hd * 128 + jj, o2 = o1 + 64;
        const float q1 = (float)hr[C_RQ + o1], q2 = (float)hr[C_RQ + o2];
        rqr[ro + jj] = (h16)(q1 * c - q2 * s); rqr[ro + jj + 64] = (h16)(q2 * c + q1 * s);
        const float k1 = (float)hr[C_RK + o1], k2 = (float)hr[C_RK + o2]; const float sc = 0.08838834764831845f;
        rkr[ro + jj] = (h16)((k1 * c - k2 * s) * sc); rkr[ro + jj + 64] = (h16)((k2 * c + k1 * s) * sc);
    }
    if (j < 64 + 16 + 16) {
        const int jj = j & 7; const float c = cosn[(size_t)m * 8 + jj], s = sinn[(size_t)m * 8 + jj];
        if (j < 64) { const int hd = j >> 3; const int o1 = hd * 64 + jj, o2 = o1 + 8;
            const float q1 = (float)hr[C_NQ + o1], q2 = (float)hr[C_NQ + o2];
            nqr[(size_t)m * 512 + o1] = (h16)(q1 * c - q2 * s); nqr[(size_t)m * 512 + o2] = (h16)(q2 * c + q1 * s);
        } else { const int jx = j - 64; const int which = jx >> 4, g = (jx >> 3) & 1; const int base = (which ? C_NKW : C_NKS) + g * 64 + jj;
            const float k1 = (float)hr[base], k2 = (float)hr[base + 8];
            h16* dst = (which ? kwR : ksR) + (((size_t)((bb * 2 + g) * 128 + (t >> 6)) * 64 + (t & 63)) * 64); dst[jj] = (h16)(k1 * c - k2 * s); dst[jj + 8] = (h16)(k2 * c + k1 * s); }
    }
    if (j >= 128 && j < 128 + 96) { const int jx = j - 128; const int which = jx / 48, r = jx % 48, g = r / 24, d = 16 + 2 * (r % 24);
        const int base = (which ? C_NKW : C_NKS) + g * 64 + d; h16* dst = (which ? kwR : ksR) + (((size_t)((bb * 2 + g) * 128 + (t >> 6)) * 64 + (t & 63)) * 64);
        dst[d] = hr[base]; dst[d + 1] = hr[base + 1]; }
    for (int i = j; i < 8 * 48; i += 256) { const int hd = i / 48, d = 16 + i % 48; nqr[(size_t)m * 512 + hd * 64 + d] = hr[C_NQ + hd * 64 + d]; }
}
__device__ __forceinline__ void b_rtrans(const Params& p, const h16* __restrict__ h, h16* __restrict__ rvT, h16* __restrict__ rkzT, const float* __restrict__ cosr, const float* __restrict__ sinr, int item, h16* sl, int lt) {
    int id = item; const int tt = id & 127; id >>= 7; const int hd = id & 3; const int b = id >> 2; const int bh = b * 4 + hd; const float lg = p.lg[hd];
    for (int i = lt; i < 64 * 128; i += 256) { const int t = i >> 7, e = i & 127; sl[t * 130 + e] = h[(size_t)(b * T + tt * 64 + t) * INP + C_RV + hd * 128 + e]; }
    __syncthreads();
    for (int i = lt; i < 64 * 128; i += 256) { const int e = i >> 6, t = i & 63; rvT[((size_t)(bh * 64 + (tt >> 1)) * 128 + e) * 128 + (tt & 1) * 64 + t] = sl[t * 130 + e]; }
    __syncthreads();
    for (int i = lt; i < 64 * 64; i += 256) { const int t = i >> 6, jj = i & 63; const size_t m = (size_t)b * T + tt * 64 + t;
        const float c = cosr[m * 64 + jj], s = sinr[m * 64 + jj]; const float k1 = (float)h[m * INP + C_RK + hd * 128 + jj], k2 = (float)h[m * INP + C_RK + hd * 128 + jj + 64];
        const float z = 0.08838834764831845f * __expf(lg * (float)(127 - ((tt * 64 + t) & 127)));
        sl[t * 130 + jj] = (h16)((k1 * c - k2 * s) * z); sl[t * 130 + jj + 64] = (h16)((k2 * c + k1 * s) * z); }
    __syncthreads();
    for (int i = lt; i < 64 * 128; i += 256) { const int d = i >> 6, t = i & 63; rkzT[((size_t)(bh * 64 + (tt >> 1)) * 128 + d) * 128 + (tt & 1) * 64 + t] = sl[t * 130 + d]; }
    __syncthreads();
}
__device__ __forceinline__ void b_mvtrans(const h16* __restrict__ kvm, h16* __restrict__ kvmVT, h16* __restrict__ kx, int item, h16* sl, int lt) {
    int id = item; const int kt = id & 3; id >>= 2; const int dtl = id & 3; id >>= 2; const int hh = id & 3; const int b = id >> 2;
    for (int i = lt; i < 64 * 64; i += 256) { const int k = i >> 6, d = i & 63; sl[k * 66 + d] = kvm[(size_t)(b * MEML + kt * 64 + k) * 2048 + 1024 + hh * 256 + dtl * 64 + d];
        kx[((size_t)(b * 4 + hh) * MEML + kt * 64 + k) * 256 + dtl * 64 + d] = kvm[(size_t)(b * MEML + kt * 64 + k) * 2048 + hh * 256 + dtl * 64 + d]; }
    __syncthreads();
    for (int i = lt; i < 64 * 64; i += 256) { const int d = i >> 6, k = i & 63; kvmVT[(size_t)((b * 4 + hh) * 256 + dtl * 64 + d) * MEML + kt * 64 + k] = sl[k * 66 + d]; }
    __syncthreads();
}

struct CmpSched {
    const char* hbase; const unsigned* cmpoff; const char* Wc1T; int c;
    __device__ bool next(int i, pg8::Unit& u) const {
        if (i > 0 || c >= 32) return false; const int kv = c >> 4, rt = c & 15;
        u.pm = kv * 16 + rt; u.pn = 0; u.A = hbase + (size_t)(kv ? C_NVC : C_NKC) * 2; u.gat = cmpoff + rt * 256; u.B = Wc1T + (size_t)kv * 256 * 2048 * 2; return true; }
};
__device__ __forceinline__ void b_cmp2(const Params& p, const h16* __restrict__ hid, h16* __restrict__ kcmp, h16* __restrict__ vcmpT) {
    const int lane = tidx() & 63;
    for (int r = blockIdx.x * 8 + (tidx() >> 6); r < 2 * 4096; r += gridDim.x * 8) {
        const int kv = r >> 12, rr = r & 4095, g = rr & 1, c = (rr >> 1) & 511, b = rr >> 10;
        const float* w2 = kv ? p.w2v : p.w2k; const h16* hr = hid + (size_t)r * 256; float acc = 0.f;
        for (int j = 0; j < 256; j += 8) { const h16x8 hv = *(const h16x8*)(hr + j);
#pragma unroll
            for (int x = 0; x < 8; ++x) acc += (float)hv[x] * w2[(j + x) * 64 + lane]; }
        if (c == 511) acc = 0.f;
        if (kv == 0) kcmp[((size_t)(b * 2 + g) * 512 + c) * 64 + lane] = (h16)acc;
        else vcmpT[(((size_t)(b * 2 + g) * 8 + (c >> 6)) * 64 + lane) * 64 + (c & 63)] = (h16)acc;
    }
}
__device__ __forceinline__ void b_vtrans(const h16* __restrict__ h, h16* __restrict__ vsT, h16* __restrict__ vwT, int item, h16* sl, int lt) {
    int id = item; const int tt = id & 127; id >>= 7; const int g = id & 1; id >>= 1; const int b = id & 3; const int which = id >> 2;
    const int col = (which ? C_NVW : C_NVS) + g * 64; h16* dst = (which ? vwT : vsT) + (size_t)((b * 2 + g) * 128 + tt) * 4096;
    for (int i = lt; i < 64 * 64; i += 256) { const int t = i >> 6, d = i & 63; sl[t * 66 + d] = h[(size_t)(b * T + tt * 64 + t) * INP + col + d]; }
    __syncthreads();
    for (int i = lt; i < 64 * 64; i += 256) { const int d = i >> 6, t = i & 63; dst[d * 64 + t] = sl[t * 66 + d]; }
    __syncthreads();
}

__device__ __forceinline__ void ret_kv_unit(const h16* __restrict__ rkzT, const h16* __restrict__ rvT, float* __restrict__ kvT, int chunk, int w, int lane) {
    const int i = lane & 15, kg = lane >> 4; const int bh = chunk >> 6, n = chunk & 63;
    h16x8 a[4];
#pragma unroll
    for (int ks = 0; ks < 4; ++ks) a[ks] = *(const h16x8*)(rkzT + ((size_t)chunk * 128 + 16 * w + i) * 128 + 32 * ks + 8 * kg);
#pragma unroll
    for (int et = 0; et < 8; ++et) { f32x4 acc = {0.f, 0.f, 0.f, 0.f};
#pragma unroll
        for (int ks = 0; ks < 4; ++ks) { const h16x8 bq = *(const h16x8*)(rvT + ((size_t)chunk * 128 + 16 * et + i) * 128 + 32 * ks + 8 * kg); acc = __builtin_amdgcn_mfma_f32_16x16x32_f16(a[ks], bq, acc, 0, 0, 0); }
        *(f32x4*)(kvT + ((size_t)chunk * 128 + 16 * et + i) * 128 + 16 * w + 4 * kg) = acc; }
}
__device__ __forceinline__ void b_ret_scan(const Params& p, const float* __restrict__ kvT, h16* __restrict__ prevT) {
    for (int gid = blockIdx.x * NTHR + tidx(); gid < 16 * 16384; gid += gridDim.x * NTHR) {
        const int de = gid & 16383, bh = gid >> 14; const float cd = __expf(p.lg[bh & 3] * 128.f);
        float st = 0.f;
        for (int n = 0; n < 64; ++n) { const size_t o = ((size_t)(bh * 64 + n) << 14) + de; prevT[o] = (h16)st; st = st * cd + kvT[o]; }
    }
}
__device__ __forceinline__ void ret_out_unit(const Params& p, const h16* __restrict__ h, const h16* __restrict__ rqr, const h16* __restrict__ rkr, const h16* __restrict__ rvT, const h16* __restrict__ prevT,
                                             h16* __restrict__ mix, int chunk, int w, int lane) {
    const int i = lane & 15, kg = lane >> 4; const int bh = chunk >> 6, n = chunk & 63, b = bh >> 2, hd = bh & 3; const float lg = p.lg[hd];
    const int qi = 16 * w + i; const size_t m = (size_t)b * T + n * 128 + qi;
    h16x8 qf[4];
#pragma unroll
    for (int ks = 0; ks < 4; ++ks) qf[ks] = *(const h16x8*)(rqr + ((size_t)bh * T + n * 128 + qi) * 128 + 32 * ks + 8 * kg);
    f32x4 inner[8], cross[8];
#pragma unroll
    for (int et = 0; et < 8; ++et) { inner[et] = (f32x4){0.f, 0.f, 0.f, 0.f}; cross[et] = (f32x4){0.f, 0.f, 0.f, 0.f}; }
    for (int gq = 0; gq < 2; ++gq) {
        if (64 * gq > 16 * w + 15) break;
        f32x4 s[4];
#pragma unroll
        for (int tl = 0; tl < 4; ++tl) { const int ko = 32 * (tl >> 1) + 8 * (i >> 2) + 4 * (tl & 1) + (i & 3); const h16* kp = rkr + ((size_t)bh * T + n * 128 + 64 * gq + ko) * 128 + 8 * kg;
            f32x4 acc = {0.f, 0.f, 0.f, 0.f};
#pragma unroll
            for (int ks = 0; ks < 4; ++ks) acc = __builtin_amdgcn_mfma_f32_16x16x32_f16(*(const h16x8*)(kp + 32 * ks), qf[ks], acc, 0, 0, 0);
            s[tl] = acc; }
        h16x8 pf[2];
#pragma unroll
        for (int tl = 0; tl < 4; ++tl)
#pragma unroll
            for (int r = 0; r < 4; ++r) { const int j = 64 * gq + 32 * (tl >> 1) + 8 * kg + 4 * (tl & 1) + r; const float v = (j <= qi) ? s[tl][r] * __expf(lg * (float)(qi - j)) : 0.f; pf[tl >> 1][4 * (tl & 1) + r] = (h16)v; }
#pragma unroll
        for (int et = 0; et < 8; ++et)
#pragma unroll
            for (int s2 = 0; s2 < 2; ++s2) { const h16x8 a = *(const h16x8*)(rvT + ((size_t)chunk * 128 + 16 * et + i) * 128 + 64 * gq + 32 * s2 + 8 * kg); inner[et] = __builtin_amdgcn_mfma_f32_16x16x32_f16(a, pf[s2], inner[et], 0, 0, 0); }
    }
#pragma unroll
    for (int et = 0; et < 8; ++et)
#pragma unroll
        for (int ks = 0; ks < 4; ++ks) { const h16x8 a = *(const h16x8*)(prevT + ((size_t)chunk * 128 + 16 * et + i) * 128 + 32 * ks + 8 * kg); cross[et] = __builtin_amdgcn_mfma_f32_16x16x32_f16(a, qf[ks], cross[et], 0, 0, 0); }
    const float xi = __expf(lg * (float)(qi + 1));
    float sm = 0.f;
#pragma unroll
    for (int et = 0; et < 8; ++et) { inner[et] = inner[et] + cross[et] * xi; sm += (inner[et][0] + inner[et][1]) + (inner[et][2] + inner[et][3]); }
    sm += __shfl_xor(sm, 16); sm += __shfl_xor(sm, 32);
    const float mu = sm * (1.f / 128.f); float sq = 0.f;
#pragma unroll
    for (int et = 0; et < 8; ++et) { inner[et] = inner[et] - mu; sq += (inner[et][0] * inner[et][0] + inner[et][1] * inner[et][1]) + (inner[et][2] * inner[et][2] + inner[et][3] * inner[et][3]); }
    sq += __shfl_xor(sq, 16); sq += __shfl_xor(sq, 32);
    const float rstd = rsqrtf(sq * (1.f / 128.f) + LN_EPS);
#pragma unroll
    for (int et = 0; et < 8; ++et) { const int e = 16 * et + 4 * kg; const h16x4 gv = *(const h16x4*)(h + m * INP + C_RG + hd * 128 + e);
        f32x4 o;
#pragma unroll
        for (int r = 0; r < 4; ++r) o[r] = siluf((float)gv[r]) * inner[et][r] * rstd;
        *(h16x4*)(mix + m * D + hd * 128 + e) = __builtin_convertvector(o, h16x4); }
}

struct AttSt { float m, l; f32x4 o[4]; };
struct KFrag { h16x8 a[4][2]; };
struct VFrag { h16x8 a[4][2]; };
__device__ __forceinline__ void ldk(KFrag& k, const h16* __restrict__ Kb, int pitchK, int i, int kg) {
#pragma unroll
    for (int tl = 0; tl < 4; ++tl) { const int ko = 32 * (tl >> 1) + 8 * (i >> 2) + 4 * (tl & 1) + (i & 3); const h16* kp = Kb + (size_t)ko * pitchK + 8 * kg;
        k.a[tl][0] = *(const h16x8*)kp; k.a[tl][1] = *(const h16x8*)(kp + 32); }
}
__device__ __forceinline__ void ldv(VFrag& v, const h16* __restrict__ VTb, int vstride, int i, int kg) {
#pragma unroll
    for (int dt = 0; dt < 4; ++dt)
#pragma unroll
        for (int s2 = 0; s2 < 2; ++s2) v.a[dt][s2] = *(const h16x8*)(VTb + (size_t)(16 * dt + i) * vstride + 32 * s2 + 8 * kg);
}
__device__ __forceinline__ float xmax4(float v) {
    auto a = __builtin_amdgcn_permlane16_swap(__float_as_uint(v), __float_as_uint(v), false, false); v = fmaxf(__uint_as_float(a[0]), __uint_as_float(a[1]));
    auto c = __builtin_amdgcn_permlane32_swap(__float_as_uint(v), __float_as_uint(v), false, false); return fmaxf(__uint_as_float(c[0]), __uint_as_float(c[1])); }
__device__ __forceinline__ float xsum4(float v) {
    auto a = __builtin_amdgcn_permlane16_swap(__float_as_uint(v), __float_as_uint(v), false, false); v = __uint_as_float(a[0]) + __uint_as_float(a[1]);
    auto c = __builtin_amdgcn_permlane32_swap(__float_as_uint(v), __float_as_uint(v), false, false); return __uint_as_float(c[0]) + __uint_as_float(c[1]); }
constexpr float ATT_C2 = 0.125f * 1.4426950408889634f;
template <bool MASKED, class MaskF>
__device__ __forceinline__ void att_scores(f32x4 (&s)[4], const KFrag& k, const h16x8 (&qf)[2], int kg, MaskF valid) {
#pragma unroll
    for (int tl = 0; tl < 4; ++tl) { f32x4 z = {0.f, 0.f, 0.f, 0.f}; z = __builtin_amdgcn_mfma_f32_16x16x32_f16(k.a[tl][0], qf[0], z, 0, 0, 0); s[tl] = __builtin_amdgcn_mfma_f32_16x16x32_f16(k.a[tl][1], qf[1], z, 0, 0, 0); }
    if (MASKED) {
#pragma unroll
        for (int tl = 0; tl < 4; ++tl)
#pragma unroll
            for (int r = 0; r < 4; ++r) { const int ko = 32 * (tl >> 1) + 8 * kg + 4 * (tl & 1) + r; s[tl][r] = valid(ko) ? s[tl][r] : -INFINITY; }
    }
}
__device__ __forceinline__ float att_rowmax(const f32x4 (&s)[4]) {
    float mx = fmaxf(fmaxf(s[0][0], s[0][1]), fmaxf(s[0][2], s[0][3]));
#pragma unroll
    for (int tl = 1; tl < 4; ++tl) mx = fmaxf(mx, fmaxf(fmaxf(s[tl][0], s[tl][1]), fmaxf(s[tl][2], s[tl][3])));
    return xmax4(mx);
}
__device__ __forceinline__ void att_pv(f32x4 (&o)[4], const f32x4 (&pv)[4], const VFrag& v) {
    h16x8 pf[2];
#pragma unroll
    for (int s2 = 0; s2 < 2; ++s2)
#pragma unroll
        for (int j = 0; j < 8; ++j) pf[s2][j] = (h16)pv[2 * s2 + (j >> 2)][j & 3];
#pragma unroll
    for (int dt = 0; dt < 4; ++dt)
#pragma unroll
        for (int s2 = 0; s2 < 2; ++s2) o[dt] = __builtin_amdgcn_mfma_f32_16x16x32_f16(v.a[dt][s2], pf[s2], o[dt], 0, 0, 0);
}
template <bool MASKED, class MaskF>
__device__ __forceinline__ void att_tile(AttSt& st, const KFrag& k, const VFrag& v, const h16x8 (&qf)[2], int kg, bool rowok, MaskF valid) {
    f32x4 s[4]; att_scores<MASKED>(s, k, qf, kg, valid);
    const float mx = rowok ? att_rowmax(s) * ATT_C2 : -INFINITY;
    const float mn = fmaxf(st.m, mx);
    if (__any(mn > st.m)) { const float alpha = __builtin_amdgcn_exp2f(st.m - mn); st.m = mn; st.l *= alpha;
#pragma unroll
        for (int dt = 0; dt < 4; ++dt) st.o[dt] = st.o[dt] * alpha; }
    const float mneg = rowok ? -mn : -INFINITY;
    float ps0 = 0.f, ps1 = 0.f;
#pragma unroll
    for (int tl = 0; tl < 4; ++tl) {
#pragma unroll
        for (int r = 0; r < 4; ++r) s[tl][r] = __builtin_amdgcn_exp2f(__builtin_fmaf(s[tl][r], ATT_C2, mneg));
        ps0 += s[tl][0] + s[tl][1]; ps1 += s[tl][2] + s[tl][3]; }
    st.l += ps0 + ps1;
    att_pv(st.o, s, v);
}
constexpr int NSA_NSLOT = 5, NSA_RING = 0, NSA_IMP = NSA_NSLOT * 16384, NSA_MSK = NSA_IMP + 32768, NSA_LIST = NSA_MSK + 256;
__device__ __forceinline__ void ldk_lds(KFrag& k, LAS const unsigned char* slot, int ko0, int ko1) {
#pragma unroll
    for (int tl = 0; tl < 4; ++tl) { const int o = (32 * (tl >> 1) + 4 * (tl & 1)) * 128; k.a[tl][0] = *(LAS const h16x8*)(slot + o + ko0); k.a[tl][1] = *(LAS const h16x8*)(slot + o + ko1); }
}
__device__ __forceinline__ void ldv_lds(VFrag& v, LAS const unsigned char* slot, int vo0, int vo1) {
#pragma unroll
    for (int dt = 0; dt < 4; ++dt) { v.a[dt][0] = *(LAS const h16x8*)(slot + 8192 + dt * 2048 + vo0); v.a[dt][1] = *(LAS const h16x8*)(slot + 8192 + dt * 2048 + vo1); }
}
#define NSA_WAITV(n) asm volatile("s_waitcnt vmcnt(" #n ")" ::: "memory")
#define NSA_BAR() do { asm volatile("s_waitcnt lgkmcnt(0)" ::: "memory"); __builtin_amdgcn_s_barrier(); asm volatile("" ::: "memory"); } while (0)
template <int LPT, class IssueF, class CompF>
__device__ __forceinline__ void nsa_stream(int n, LAS unsigned char* dmaw, LAS unsigned char* ring, IssueF issue, CompF comp) {
#pragma unroll
    for (int j = 0; j < NSA_NSLOT - 1; ++j) if (j < n) issue(j, (LAS unsigned*)(dmaw + j * 16384));
    int st = 0, si = (NSA_NSLOT - 1) * 16384;
    for (int t = 0; t < n; ++t) {
        const int ahead = n - 1 - t;
        if (ahead >= 3) { if (LPT == 2) NSA_WAITV(6); else NSA_WAITV(3); }
        else if (ahead == 2) { if (LPT == 2) NSA_WAITV(4); else NSA_WAITV(2); }
        else if (ahead == 1) { if (LPT == 2) NSA_WAITV(2); else NSA_WAITV(1); }
        else NSA_WAITV(0);
        NSA_BAR();
        if (t + NSA_NSLOT - 1 < n) issue(t + NSA_NSLOT - 1, (LAS unsigned*)(dmaw + si));
        comp(t, (LAS const unsigned char*)(ring + st));
        st = (st == (NSA_NSLOT - 1) * 16384) ? 0 : st + 16384; si = (si == (NSA_NSLOT - 1) * 16384) ? 0 : si + 16384; }
    NSA_BAR();
}
__device__ __forceinline__ void nsa_block_unit(const h16* __restrict__ h, const h16* __restrict__ nqr, const h16* __restrict__ kcmp, const h16* __restrict__ vcmpT, const h16* __restrict__ vsT, const h16* __restrict__ vwT,
                                               const h16* __restrict__ ksR, const h16* __restrict__ kwR, h16* __restrict__ mix, int b, int g, int T0, LAS unsigned char* lds, int wv, int lane) {
    const int i = lane & 15, kg = lane >> 4, tt = i & 3, hh = i >> 2;
    const int t0 = T0 + 4 * wv, trow = t0 + tt; const size_t mrow = (size_t)b * T + trow;
    const int q = wv * 64 + lane, qrow = q >> 3, qch = q & 7;
    const int ksrc = qrow * 128 + ((qch ^ (((qrow >> 1) & 1) | (((qrow >> 3) & 3) << 1))) << 4), vsrc = qrow * 128 + ((qch ^ ((qrow >> 1) & 7)) << 4);
    const int gki = ((i >> 1) & 1) | ((i >> 2) << 1), gvi = (i >> 1) & 7;
    const int ko0 = (8 * (i >> 2) + (i & 3)) * 128 + ((kg ^ gki) << 4), ko1 = (8 * (i >> 2) + (i & 3)) * 128 + (((kg + 4) ^ gki) << 4);
    const int vo0 = i * 128 + ((kg ^ gvi) << 4), vo1 = i * 128 + (((kg + 4) ^ gvi) << 4);
    LAS unsigned char* ring = lds + NSA_RING; LAS unsigned char* dmaw = ring + wv * 1024;
    LAS float* impA = (LAS float*)(lds + NSA_IMP + wv * 4096); LAS float* impL = impA + 512;
    h16x8 qf[2], qrf[2];
    { const h16* qp = h + mrow * INP + C_NQ + (g * 4 + hh) * 64 + 8 * kg; qf[0] = *(const h16x8*)qp; qf[1] = *(const h16x8*)(qp + 32);
      const h16* qrp = nqr + mrow * 512 + (g * 4 + hh) * 64 + 8 * kg; qrf[0] = *(const h16x8*)qrp; qrf[1] = *(const h16x8*)(qrp + 32); }
    const h16* gp = h + mrow * INP + C_NG + (g * 4 + hh) * 3; const float gt0 = (float)gp[0], gt1 = (float)gp[1], gt2 = (float)gp[2];
    for (int x = lane; x < 1024; x += 64) impA[x] = 0.f;
    NSA_WAITV(0);
#define GLDS16(gsrc, ldst) __builtin_amdgcn_global_load_lds((const unsigned*)(gsrc), (ldst), 16, 0, 0)
    const int ncv_row = trow >= 31 ? ((trow - 31) >> 4) + 1 : 0;
    const int ncv_blk = (T0 + 31 >= 31) ? ((T0 + 31 - 31) >> 4) + 1 : 0;
    const int ncv_min = T0 >= 31 ? ((T0 - 31) >> 4) + 1 : 0;
    const int nct = (ncv_blk + 63) >> 6;
    const unsigned char* Kc = (const unsigned char*)(kcmp + (size_t)(b * 2 + g) * 512 * 64); const unsigned char* Vc = (const unsigned char*)(vcmpT + (size_t)(b * 2 + g) * 8 * 4096);
    float m = -1e30f, l = 0.f;
    f32x4 oc[4];
#pragma unroll
    for (int dt = 0; dt < 4; ++dt) oc[dt] = (f32x4){0.f, 0.f, 0.f, 0.f};
    nsa_stream<1>(nct, dmaw, ring, [&](int j, LAS unsigned* dk) { GLDS16(Kc + (size_t)j * 8192 + ksrc, dk); }, [&](int j, LAS const unsigned char* slot) {
        KFrag kf; ldk_lds(kf, slot, ko0, ko1);
        f32x4 s[4];
        if (64 * j + 63 < ncv_min) att_scores<false>(s, kf, qf, kg, [&](int) { return true; }); else att_scores<true>(s, kf, qf, kg, [&](int ko) { return j * 64 + ko < ncv_row; });
        const float mx = att_rowmax(s) * ATT_C2;
        const float mn = fmaxf(m, mx); float ps0 = 0.f, ps1 = 0.f;
        _Pragma("unroll") for (int tl = 0; tl < 4; ++tl) { ps0 += __builtin_amdgcn_exp2f(__builtin_fmaf(s[tl][0], ATT_C2, -mn)) + __builtin_amdgcn_exp2f(__builtin_fmaf(s[tl][1], ATT_C2, -mn));
                                                          ps1 += __builtin_amdgcn_exp2f(__builtin_fmaf(s[tl][2], ATT_C2, -mn)) + __builtin_amdgcn_exp2f(__builtin_fmaf(s[tl][3], ATT_C2, -mn)); }
        l = l * __builtin_amdgcn_exp2f(m - mn) + (ps0 + ps1); m = mn; });
    l = xsum4(l);
    const float linv = l > 0.f ? 1.f / l : 0.f;
    nsa_stream<2>(nct, dmaw, ring, [&](int j, LAS unsigned* dk) { GLDS16(Kc + (size_t)j * 8192 + ksrc, dk); GLDS16(Vc + (size_t)j * 8192 + vsrc, (LAS unsigned*)((LAS unsigned char*)dk + 8192)); }, [&](int j, LAS const unsigned char* slot) {
        KFrag kf; ldk_lds(kf, slot, ko0, ko1); VFrag vf; ldv_lds(vf, slot, vo0, vo1);
        f32x4 s[4];
        if (64 * j + 63 < ncv_min) att_scores<false>(s, kf, qf, kg, [&](int) { return true; }); else att_scores<true>(s, kf, qf, kg, [&](int ko) { return j * 64 + ko < ncv_row; });
        _Pragma("unroll") for (int tl = 0; tl < 4; ++tl) {
            _Pragma("unroll") for (int r = 0; r < 4; ++r) s[tl][r] = __builtin_amdgcn_exp2f(__builtin_fmaf(s[tl][r], ATT_C2, -m)) * linv;
            float A = (s[tl][0] + s[tl][1]) + (s[tl][2] + s[tl][3]), L = s[tl][3];
            A += __shfl_xor(A, 4); A += __shfl_xor(A, 8); L += __shfl_xor(L, 4); L += __shfl_xor(L, 8);
            if (hh == 0) { const int u = j * 16 + 8 * (tl >> 1) + 2 * kg + (tl & 1); impA[tt * 128 + u] = A; impL[tt * 128 + u] = L; } }
        att_pv(oc, s, vf); });
    const int cur = T0 >> 6;
    AttSt sw; sw.m = -1e30f; sw.l = 0.f;
#pragma unroll
    for (int dt = 0; dt < 4; ++dt) sw.o[dt] = (f32x4){0.f, 0.f, 0.f, 0.f};
    {
        const unsigned char* Kw = (const unsigned char*)(kwR + (size_t)((b * 2 + g) * 128) * 4096); const unsigned char* Vw = (const unsigned char*)(vwT + (size_t)((b * 2 + g) * 128) * 4096);
        const int s0w = (T0 >= 511 ? (T0 - 511) >> 6 : 0);
        nsa_stream<2>(cur - s0w + 1, dmaw, ring, [&](int j, LAS unsigned* dk) { GLDS16(Kw + (size_t)(s0w + j) * 8192 + ksrc, dk); GLDS16(Vw + (size_t)(s0w + j) * 8192 + vsrc, (LAS unsigned*)((LAS unsigned char*)dk + 8192)); }, [&](int j, LAS const unsigned char* slot) {
            KFrag kf; ldk_lds(kf, slot, ko0, ko1); VFrag vf; ldv_lds(vf, slot, vo0, vo1); const int s = s0w + j;
            if (s > s0w + 1 && s < cur) att_tile<false>(sw, kf, vf, qrf, kg, true, [&](int) { return true; });
            else att_tile<true>(sw, kf, vf, qrf, kg, true, [&](int ko) { const int kp = 64 * s + ko; return kp <= trow && kp >= trow - 511; }); });
    }
    unsigned long long mylo, myhi, anylo, anyhi;
    if (cur <= 15) { mylo = anylo = (1ull << (cur + 1)) - 1ull; myhi = anyhi = 0ull; }
    else {
        mylo = myhi = anylo = anyhi = 0ull;
        const unsigned long long flo = 1ull | (cur < 64 ? (1ull << cur) : 0ull) | (cur - 1 < 64 ? (1ull << (cur - 1)) : 0ull);
        const unsigned long long fhi = (cur >= 64 ? (1ull << (cur - 64)) : 0ull) | (cur - 1 >= 64 ? (1ull << (cur - 65)) : 0ull);
        const unsigned long long lmask = (1ull << lane) - 1ull;
        for (int tk = 0; tk < 4; ++tk) {
            const int s0 = lane, s1 = lane + 64;
            const float v0 = impA[tk * 128 + s0] + (s0 > 0 ? impL[tk * 128 + s0 - 1] : 0.f), v1 = impA[tk * 128 + s1] + impL[tk * 128 + s1 - 1];
            const unsigned b0 = (s0 >= 1 && s0 <= cur - 2) ? __float_as_uint(v0) + 1u : 0u, b1 = (s1 <= cur - 2) ? __float_as_uint(v1) + 1u : 0u;
            unsigned Tq = 0u;
            for (int bit = 30; bit >= 0; --bit) { const unsigned T2 = Tq | (1u << bit);
                const int c = __popcll(__ballot(b0 >= T2)) + __popcll(__ballot(b1 >= T2)); if (c >= 13) Tq = T2; }
            const unsigned long long gtlo = __ballot(b0 > Tq), gthi = __ballot(b1 > Tq), eqlo = __ballot(b0 == Tq), eqhi = __ballot(b1 == Tq);
            const int need = 13 - (__popcll(gtlo) + __popcll(gthi));
            const bool t0q = (b0 == Tq) && (__popcll(eqlo & lmask) < need), t1q = (b1 == Tq) && (__popcll(eqlo) + __popcll(eqhi & lmask) < need);
            const unsigned long long lo = gtlo | __ballot(t0q) | flo, hi = gthi | __ballot(t1q) | fhi;
            anylo |= lo; anyhi |= hi; if (tt == tk) { mylo = lo; myhi = hi; }
        }
    }
    LAS unsigned long long* msk = (LAS unsigned long long*)(lds + NSA_MSK); LAS unsigned char* lst = lds + NSA_LIST; LAS int* nlst = (LAS int*)(lds + NSA_LIST + 128);
    if (lane == 0) { msk[2 * wv] = anylo; msk[2 * wv + 1] = anyhi; }
    NSA_BAR();
    if (wv == 0) {
        unsigned long long ulo = 0ull, uhi = 0ull;
#pragma unroll
        for (int w2 = 0; w2 < 8; ++w2) { ulo |= msk[2 * w2]; uhi |= msk[2 * w2 + 1]; }
        const unsigned long long lmask = (1ull << lane) - 1ull; const int nlo = __popcll(ulo);
        if ((ulo >> lane) & 1ull) lst[__popcll(ulo & lmask)] = (unsigned char)lane;
        if ((uhi >> lane) & 1ull) lst[nlo + __popcll(uhi & lmask)] = (unsigned char)(64 + lane);
        if (lane == 0) nlst[0] = nlo + __popcll(uhi);
    }
    NSA_BAR();
    const int nsel = nlst[0];
    AttSt ss; ss.m = -1e30f; ss.l = 0.f;
#pragma unroll
    for (int dt = 0; dt < 4; ++dt) ss.o[dt] = (f32x4){0.f, 0.f, 0.f, 0.f};
    {
        const unsigned char* Ks = (const unsigned char*)(ksR + (size_t)((b * 2 + g) * 128) * 4096); const unsigned char* Vs = (const unsigned char*)(vsT + (size_t)((b * 2 + g) * 128) * 4096);
        nsa_stream<2>(nsel, dmaw, ring, [&](int j, LAS unsigned* dk) { const int sj = lst[j]; GLDS16(Ks + (size_t)sj * 8192 + ksrc, dk); GLDS16(Vs + (size_t)sj * 8192 + vsrc, (LAS unsigned*)((LAS unsigned char*)dk + 8192)); }, [&](int j, LAS const unsigned char* slot) {
            const int s = lst[j];
            if ((((s < 64 ? anylo : anyhi) >> (s & 63)) & 1ull) != 0ull) {
                KFrag kf; ldk_lds(kf, slot, ko0, ko1); VFrag vf; ldv_lds(vf, slot, vo0, vo1);
                const bool mybit = (((s < 64 ? mylo : myhi) >> (s & 63)) & 1ull) != 0ull;
                if (s < cur) att_tile<false>(ss, kf, vf, qrf, kg, mybit, [&](int) { return true; });
                else att_tile<true>(ss, kf, vf, qrf, kg, mybit, [&](int ko) { return 64 * s + ko <= trow; }); } });
    }
    const float ls = xsum4(ss.l), lw = xsum4(sw.l);
    const float g0 = sigmf(gt0), g1 = sigmf(gt1) / ls, g2 = sigmf(gt2) / lw;
#pragma unroll
    for (int dt = 0; dt < 4; ++dt) { const f32x4 o = oc[dt] * g0 + ss.o[dt] * g1 + sw.o[dt] * g2;
        *(h16x4*)(mix + mrow * D + 512 + (g * 4 + hh) * 64 + 16 * dt + 4 * kg) = __builtin_convertvector(o, h16x4); }
#undef GLDS16
}

__device__ __forceinline__ void b_ln(const float* __restrict__ in, const float* __restrict__ gam, const float* __restrict__ bet, float* __restrict__ o32, h16* __restrict__ o16) {
    const int lane = tidx() & 63;
    for (int row = blockIdx.x * 8 + (tidx() >> 6); row < M; row += gridDim.x * 8) {
        const f32x4* xr = (const f32x4*)(in + (size_t)row * D) + lane;
        f32x4 v[4]; float s = 0.f;
#pragma unroll
        for (int j = 0; j < 4; ++j) { v[j] = xr[64 * j]; s += (v[j][0] + v[j][1]) + (v[j][2] + v[j][3]); }
        const float mean = wave_sum(s) * (1.f / D); float s2 = 0.f;
#pragma unroll
        for (int j = 0; j < 4; ++j) { v[j] = v[j] - mean; s2 += (v[j][0] * v[j][0] + v[j][1] * v[j][1]) + (v[j][2] * v[j][2] + v[j][3] * v[j][3]); }
        const float rstd = rsqrtf(wave_sum(s2) * (1.f / D) + LN_EPS);
#pragma unroll
        for (int j = 0; j < 4; ++j) { const f32x4 gg = ((const f32x4*)gam)[lane + 64 * j], bb = ((const f32x4*)bet)[lane + 64 * j]; const f32x4 o = v[j] * rstd * gg + bb;
            ((f32x4*)(o32 + (size_t)row * D))[lane + 64 * j] = o;
            if (o16) ((h16x4*)(o16 + (size_t)row * D))[lane + 64 * j] = __builtin_convertvector(o, h16x4); }
    }
}

__device__ __forceinline__ void xattn_unit(const h16* __restrict__ qx, const h16* __restrict__ kx, const h16* __restrict__ kvmVT, h16* __restrict__ ox, int m0, int hh, int lane) {
    const int i = lane & 15, kg = lane >> 4; const int b = m0 >> 13; const size_t m = (size_t)m0 + i;
    h16x8 qf[8];
#pragma unroll
    for (int ks = 0; ks < 8; ++ks) qf[ks] = *(const h16x8*)(qx + m * D + hh * 256 + 32 * ks + 8 * kg);
    f32x4 o[16];
#pragma unroll
    for (int dt = 0; dt < 16; ++dt) o[dt] = (f32x4){0.f, 0.f, 0.f, 0.f};
    float mrun = -1e30f, l = 0.f;
    const h16* vb = kvmVT + (size_t)((b * 4 + hh) * 256) * MEML;
#pragma unroll 1
    for (int gq = 0; gq < 4; ++gq) {
        f32x4 s[4]; float mx = -INFINITY;
#pragma unroll
        for (int tl = 0; tl < 4; ++tl) { const int ko = 64 * gq + 32 * (tl >> 1) + 8 * (i >> 2) + 4 * (tl & 1) + (i & 3); const h16* kp = kx + ((size_t)(b * 4 + hh) * MEML + ko) * 256 + 8 * kg;
            f32x4 acc = {0.f, 0.f, 0.f, 0.f};
#pragma unroll
            for (int ks = 0; ks < 8; ++ks) acc = __builtin_amdgcn_mfma_f32_16x16x32_f16(*(const h16x8*)(kp + 32 * ks), qf[ks], acc, 0, 0, 0);
            s[tl] = acc * 0.0625f; mx = fmaxf(mx, fmaxf(fmaxf(s[tl][0], s[tl][1]), fmaxf(s[tl][2], s[tl][3]))); }
        mx = fmaxf(mx, __shfl_xor(mx, 16)); mx = fmaxf(mx, __shfl_xor(mx, 32));
        const float mn = fmaxf(mrun, mx); const float alpha = __expf(mrun - mn); mrun = mn;
        float ps = 0.f; h16x8 pf[2];
#pragma unroll
        for (int tl = 0; tl < 4; ++tl)
#pragma unroll
            for (int r = 0; r < 4; ++r) { const float pe = __expf(s[tl][r] - mn); ps += pe; pf[tl >> 1][4 * (tl & 1) + r] = (h16)pe; }
        l = l * alpha + ps;
#pragma unroll
        for (int dt = 0; dt < 16; ++dt) { f32x4 acc = o[dt] * alpha;
#pragma unroll
            for (int s2 = 0; s2 < 2; ++s2) acc = __builtin_amdgcn_mfma_f32_16x16x32_f16(*(const h16x8*)(vb + (size_t)(16 * dt + i) * MEML + 64 * gq + 32 * s2 + 8 * kg), pf[s2], acc, 0, 0, 0);
            o[dt] = acc; }
    }
    l += __shfl_xor(l, 16); l += __shfl_xor(l, 32); const float linv = 1.f / l;
#pragma unroll
    for (int dt = 0; dt < 16; ++dt) { const f32x4 acc = o[dt] * linv; *(h16x4*)(ox + m * D + hh * 256 + 16 * dt + 4 * kg) = __builtin_convertvector(acc, h16x4); }
}

__device__ __forceinline__ void route_token(float logit, int m, int lane, const float* __restrict__ rbias, int* __restrict__ tope, float* __restrict__ topw, int* __restrict__ hist) {
    const float score = 1.f / (1.f + expf(-logit)); const float biased = score + rbias[lane];
    float m1 = biased; m1 = fmaxf(m1, __shfl_xor(m1, 1)); m1 = fmaxf(m1, __shfl_xor(m1, 2)); m1 = fmaxf(m1, __shfl_xor(m1, 4));
    int am = (biased == m1) ? lane : 999; am = min(am, __shfl_xor(am, 1)); am = min(am, __shfl_xor(am, 2)); am = min(am, __shfl_xor(am, 4));
    float m2 = (lane == am) ? -INFINITY : biased; m2 = fmaxf(m2, __shfl_xor(m2, 1)); m2 = fmaxf(m2, __shfl_xor(m2, 2)); m2 = fmaxf(m2, __shfl_xor(m2, 4));
    const float gs = m1 + m2;
    int cnt = 0;
#pragma unroll
    for (int gq = 0; gq < 8; ++gq) { const float o = __shfl(gs, gq * 8); cnt += (o > gs) ? 1 : 0; }
    const float masked = (cnt <= 3) ? biased : NEGF;
    int rank = 0;
    for (int e2 = 0; e2 < 64; ++e2) { const float o = __shfl(masked, e2); rank += (o > masked || (o == masked && e2 < lane)) ? 1 : 0; }
    const bool selq = rank < 8;
    const float wsum = wave_sum(selq ? score : 0.f);
    if (selq) { tope[(size_t)m * 8 + rank] = lane; topw[(size_t)m * 8 + rank] = score / wsum * 2.5f; atomicAdd(hist + (m >> 13) * 65 + lane, 1); }
}
__device__ __forceinline__ void router_unit(const Params& p, const float* __restrict__ x2, const h16* __restrict__ WrTh, const h16* __restrict__ WrTl, int* __restrict__ tope, float* __restrict__ topw, int* __restrict__ hist,
                                            int m0, LAS float* lg, int lane) {
    const int i = lane & 15, kg = lane >> 4;
    f32x4 am_[4], ac_[4];
#pragma unroll
    for (int et = 0; et < 4; ++et) { am_[et] = (f32x4){0.f, 0.f, 0.f, 0.f}; ac_[et] = (f32x4){0.f, 0.f, 0.f, 0.f}; }
    const float* xr = x2 + (size_t)(m0 + i) * D + 8 * kg;
#pragma unroll 2
    for (int ks = 0; ks < 32; ++ks) {
        const f32x4 x0 = *(const f32x4*)(xr + 32 * ks), x1 = *(const f32x4*)(xr + 32 * ks + 4);
        h16x8 xh, xl;
#pragma unroll
        for (int j = 0; j < 4; ++j) { xh[j] = (h16)x0[j]; xl[j] = (h16)((x0[j] - (float)xh[j]) * 2048.f); xh[4 + j] = (h16)x1[j]; xl[4 + j] = (h16)((x1[j] - (float)xh[4 + j]) * 2048.f); }
#pragma unroll
        for (int et = 0; et < 4; ++et) { const h16x8 wh = *(const h16x8*)(WrTh + (size_t)(16 * et + i) * D + 32 * ks + 8 * kg), wl = *(const h16x8*)(WrTl + (size_t)(16 * et + i) * D + 32 * ks + 8 * kg);
            am_[et] = __builtin_amdgcn_mfma_f32_16x16x32_f16(wh, xh, am_[et], 0, 0, 0);
            ac_[et] = __builtin_amdgcn_mfma_f32_16x16x32_f16(wh, xl, ac_[et], 0, 0, 0);
            ac_[et] = __builtin_amdgcn_mfma_f32_16x16x32_f16(wl, xh, ac_[et], 0, 0, 0); }
    }
#pragma unroll
    for (int et = 0; et < 4; ++et)
#pragma unroll
        for (int r = 0; r < 4; ++r) lg[i * 64 + 16 * et + 4 * kg + r] = am_[et][r] + ac_[et][r] * (1.f / 2048.f);
    for (int tk = 0; tk < 16; ++tk) route_token(lg[tk * 64 + lane], m0 + tk, lane, p.rbias, tope, topw, hist);
}

__device__ __forceinline__ void b_moe(const Params& p, const float* __restrict__ x2, const int* __restrict__ tope, const float* __restrict__ topw, float* __restrict__ out, int m, float* sl, int tid) {
    float* xs = sl; float* hd = sl + 1024; float* red = sl + 1280;
    for (int i = tid; i < 1024; i += 256) xs[i] = x2[(size_t)m * D + i];
    __syncthreads();
    float acc[4] = {0.f, 0.f, 0.f, 0.f};
    for (int kx = 0; kx < 9; ++kx) {
        const float* G; const float* U; const float* Dn; float wt;
        if (kx < 8) { const int e = tope[(size_t)m * 8 + kx]; wt = topw[(size_t)m * 8 + kx]; G = p.w_gate + (size_t)e * D * EFF; U = p.w_up + (size_t)e * D * EFF; Dn = p.w_down + (size_t)e * EFF * D; }
        else { wt = 1.f; G = p.ws_gate; U = p.ws_up; Dn = p.ws_down; }
        float a = 0.f, u = 0.f;
        for (int k = 0; k < D; ++k) { const float xv = xs[k]; a += xv * G[(size_t)k * EFF + tid]; u += xv * U[(size_t)k * EFF + tid]; }
        hd[tid] = siluf(a) * u * wt;
        __syncthreads();
        for (int j = 0; j < EFF; ++j) { const float hv = hd[j]; const float* dr = Dn + (size_t)j * D + tid;
            acc[0] += hv * dr[0]; acc[1] += hv * dr[256]; acc[2] += hv * dr[512]; acc[3] += hv * dr[768]; }
        __syncthreads();
    }
    float v[4]; float s = 0.f;
#pragma unroll
    for (int i = 0; i < 4; ++i) { v[i] = DN_ALPHA * xs[tid + 256 * i] + acc[i]; s += v[i]; }
    s = wave_sum(s); if ((tid & 63) == 0) red[tid >> 6] = s; __syncthreads();
    const float mean = (red[0] + red[1] + red[2] + red[3]) * (1.f / D); float s2 = 0.f;
#pragma unroll
    for (int i = 0; i < 4; ++i) { v[i] -= mean; s2 += v[i] * v[i]; }
    s2 = wave_sum(s2); if ((tid & 63) == 0) red[4 + (tid >> 6)] = s2; __syncthreads();
    const float rstd = rsqrtf((red[4] + red[5] + red[6] + red[7]) * (1.f / D) + LN_EPS);
#pragma unroll
    for (int i = 0; i < 4; ++i) out[(size_t)m * D + tid + 256 * i] = v[i] * rstd * p.ln3g[tid + 256 * i] + p.ln3b[tid + 256 * i];
    __syncthreads();
}

struct G1Sched {
    const int* ctl; const char* x2h; const unsigned* rowoff; const char* WguT; int G, c;
    __device__ bool next(int i, pg8::Unit& u) const {
        const int ntile = ctl[CTL_TQS + NQ]; const long L = (long)i * G + c; if (L >= 2L * ntile) return false;
        const int tile = (int)(L >> 1), pn = (int)(L & 1); const int e = ctl[CTL_TVE + tile] % 65;
        u.pm = tile; u.pn = pn; u.A = x2h; u.gat = rowoff + (size_t)tile * 256; u.B = WguT + ((size_t)e * 512 + pn * 256) * (D * 2); return true; }
};
struct G2Sched {
    const int* ctl; const char* H; const char* WdT; int q, G, c;
    __device__ bool next(int i, pg8::Unit& u) const {
        const int t0 = ctl[CTL_TQS + q], t1 = ctl[CTL_TQS + q + 1]; const long L = (long)i * G + c; if (L >= 4L * (t1 - t0)) return false;
        const int tile = t0 + (int)(L >> 2), pn = (int)(L & 3); const int e = ctl[CTL_TVE + tile] % 65;
        u.pm = tile; u.pn = pn; u.A = H + (size_t)tile * 256 * (EFF * 2); u.gat = nullptr; u.B = WdT + ((size_t)e * D + pn * 256) * (EFF * 2); return true; }
};
__device__ __forceinline__ void b_scatter(int* __restrict__ ctl, const int* __restrict__ tope, const float* __restrict__ topw, unsigned* __restrict__ rowoff, u32x2* __restrict__ rowmeta, int* sl) {
    int* pst = sl;
    if (tidx() == 0) { int acc = 0; for (int v = 0; v < NVE; ++v) { pst[v] = acc; acc += (ctl[CTL_CNT + v] + 255) & ~255; } pst[NVE] = acc; }
    __syncthreads();
    if (blockIdx.x == 0) {
        for (int v = tidx(); v <= NVE; v += NTHR) ctl[CTL_PST + v] = pst[v];
        if (tidx() <= NQ) ctl[CTL_TQS + tidx()] = pst[tidx() * 65] >> 8;
        for (int v = tidx(); v < NVE; v += NTHR) for (int tl = pst[v] >> 8; tl < (pst[v + 1] >> 8); ++tl) ctl[CTL_TVE + tl] = v;
    }
    for (int idx = blockIdx.x * NTHR + tidx(); idx < M * 9; idx += gridDim.x * NTHR) {
        int m, k, pos; float w;
        if (idx < M * 8) { m = idx >> 3; k = idx & 7; const int ve = (m >> 13) * 65 + tope[idx]; w = topw[idx]; pos = pst[ve] + atomicAdd(ctl + CTL_CUR + ve, 1); }
        else { m = idx - M * 8; k = 8; w = 1.f; pos = pst[(m >> 13) * 65 + 64] + (m & (QT - 1)); }
        rowoff[pos] = (unsigned)m * (D * 2); rowmeta[pos] = (u32x2){(unsigned)((m & (QT - 1)) * 9 + k), __float_as_uint(w)};
    }
    __syncthreads();
}
__device__ __forceinline__ void b_combine(const Params& p, const h16* __restrict__ x2h, const h16* __restrict__ Y, int q) {
    const int lane = tidx() & 63;
    for (int r = blockIdx.x * 8 + (tidx() >> 6); r < QT; r += gridDim.x * 8) {
        const int m = q * QT + r;
        float v[16];
        { const h16x8 a = ((const h16x8*)(x2h + (size_t)m * D))[lane], b = ((const h16x8*)(x2h + (size_t)m * D))[lane + 64];
#pragma unroll
          for (int i = 0; i < 8; ++i) { v[i] = DN_ALPHA * (float)a[i]; v[8 + i] = DN_ALPHA * (float)b[i]; } }
#pragma unroll
        for (int k = 0; k < 9; ++k) { const h16x8* yr = (const h16x8*)(Y + ((size_t)r * 9 + k) * D); const h16x8 a = yr[lane], b = yr[lane + 64];
#pragma unroll
            for (int i = 0; i < 8; ++i) { v[i] += (float)a[i]; v[8 + i] += (float)b[i]; } }
        float s = 0.f;
#pragma unroll
        for (int i = 0; i < 16; ++i) s += v[i];
        const float mean = wave_sum(s) * (1.f / D); float s2 = 0.f;
#pragma unroll
        for (int i = 0; i < 16; ++i) { v[i] -= mean; s2 += v[i] * v[i]; }
        const float rstd = rsqrtf(wave_sum(s2) * (1.f / D) + LN_EPS);
#pragma unroll
        for (int hlf = 0; hlf < 2; ++hlf) { const int c0 = (lane + 64 * hlf) * 8;
            const f32x4 g0 = *(const f32x4*)(p.ln3g + c0), g1 = *(const f32x4*)(p.ln3g + c0 + 4), b0 = *(const f32x4*)(p.ln3b + c0), b1 = *(const f32x4*)(p.ln3b + c0 + 4);
            f32x4 o0, o1;
#pragma unroll
            for (int i = 0; i < 4; ++i) { o0[i] = v[8 * hlf + i] * rstd * g0[i] + b0[i]; o1[i] = v[8 * hlf + 4 + i] * rstd * g1[i] + b1[i]; }
            *(f32x4*)(p.out + (size_t)m * D + c0) = o0; *(f32x4*)(p.out + (size_t)m * D + c0 + 4) = o1; }
    }
}

#define XB_TMO      128
#define XB_XCNT(j)  (256  + 64 * (j))
#define XB_XSUB(j)  (1280 + 64 * (j))
#define XB_XGEN(j)  (2304 + 64 * (j))
#define XB_TOP      3328
#define XB_TOPGEN   3392
#define XCD_BAR_WORDS 3456
#define XB_SPIN_CAP (1u << 22)
__device__ __forceinline__ unsigned xb_ld(unsigned* p)              { return __hip_atomic_load(p, __ATOMIC_RELAXED, __HIP_MEMORY_SCOPE_AGENT); }
__device__ __forceinline__ unsigned xb_add(unsigned* p, unsigned v) { return __hip_atomic_fetch_add(p, v, __ATOMIC_RELAXED, __HIP_MEMORY_SCOPE_AGENT); }
__device__ __forceinline__ unsigned xb_xcc_id() { return (unsigned)__builtin_amdgcn_s_getreg((3 << 11) | 20) & 0xFu; }
#define XB_SPIN(cond, bar) do { unsigned _sp = 0; while (cond) { __builtin_amdgcn_s_sleep(1); \
    if ((++_sp & 255u) == 0u) { if (xb_ld(&(bar)[XB_TMO])) break; if (_sp > XB_SPIN_CAP) { atomicAdd(&(bar)[XB_TMO], 1u); break; } } } } while (0)
struct XcdBarrier { unsigned* bar; unsigned x; volatile LAS unsigned* st; };
__device__ __forceinline__ XcdBarrier xcd_barrier_post(unsigned* bar, volatile LAS unsigned* st) {
    XcdBarrier b; b.bar = bar; b.x = xb_xcc_id(); b.st = st;
    if (threadIdx.x == 0) (void)xb_add(&bar[XB_XCNT(b.x)], 1u);
    return b;
}
__device__ __forceinline__ void xcd_barrier_complete(unsigned* bar, unsigned x, unsigned& nloc, unsigned& nx) {
    const unsigned G = gridDim.x * gridDim.y * gridDim.z;
    unsigned sum, cnt, mine, sp = 0u;
    for (;;) {
        sum = 0u; cnt = 0u; mine = 0u;
#pragma unroll
        for (unsigned j = 0; j < 16; ++j) { const unsigned c = xb_ld(&bar[XB_XCNT(j)]); sum += c; cnt += (c > 0u) ? 1u : 0u; mine = (j == x) ? c : mine; }
        if (sum == G) break;
        __builtin_amdgcn_s_sleep(1);
        if ((++sp & 255u) == 0u) { if (xb_ld(&bar[XB_TMO])) break; if (sp > XB_SPIN_CAP) { atomicAdd(&bar[XB_TMO], 1u); break; } }
    }
    nloc = mine > 0u ? mine : 1u; nx = cnt > 0u ? cnt : 1u;
}
__device__ __forceinline__ void xcd_barrier(const XcdBarrier& b) {
    asm volatile("s_waitcnt vmcnt(0)" ::: "memory");
    __syncthreads();
    if (threadIdx.x == 0) {
        unsigned* bar = b.bar;
        __builtin_amdgcn_s_waitcnt(0);
        unsigned nloc = b.st[0], nx = b.st[1];
        if (nloc == 0u) { xcd_barrier_complete(bar, b.x, nloc, nx); b.st[0] = nloc; b.st[1] = nx; }
        const unsigned old = xb_add(&bar[XB_XSUB(b.x)], 1u);
        const unsigned gen = old / nloc;
        if (old + 1u == (gen + 1u) * nloc) {
            __builtin_amdgcn_fence(__ATOMIC_RELEASE, "agent");
            asm volatile("s_waitcnt vmcnt(0)" ::: "memory");
            const unsigned og = xb_add(&bar[XB_TOP], 1u);
            const unsigned tg = og / nx;
            if (og + 1u == (tg + 1u) * nx) xb_add(&bar[XB_TOPGEN], 1u);
            else XB_SPIN(xb_ld(&bar[XB_TOPGEN]) == tg, bar);
            __builtin_amdgcn_fence(__ATOMIC_ACQUIRE, "agent");
            xb_add(&bar[XB_XGEN(b.x)], 1u);
            asm volatile("s_waitcnt vmcnt(0)" ::: "memory");
        } else {
            XB_SPIN(xb_ld(&bar[XB_XGEN(b.x)]) == gen, bar);
            __builtin_amdgcn_fence(__ATOMIC_ACQUIRE, "agent");
            asm volatile("s_waitcnt vmcnt(0)" ::: "memory");
        }
    }
    __syncthreads();
}

constexpr int N_PHASES = 23;

__global__ void __launch_bounds__(NTHR, 2) mega_fwd(Params p) {
    extern __shared__ __attribute__((aligned(16))) unsigned char lds[];
    cg::grid_group grid = cg::this_grid();
    const int G = (int)gridDim.x, bid = (int)blockIdx.x;
#define tid tidx()
    unsigned char* ws = p.ws;
    h16* WinT = (h16*)(ws + WS_WIN); h16* WoutT = (h16*)(ws + WS_WOUT); h16* WxqT = (h16*)(ws + WS_WXQ); h16* WxoT = (h16*)(ws + WS_WXO); h16* WxkvT = (h16*)(ws + WS_WXKV);
    h16* memh = (h16*)(ws + WS_MEMH); h16* kvm = (h16*)(ws + WS_KVM); h16* kcmp = (h16*)(ws + WS_KCMP); h16* vcmpT = (h16*)(ws + WS_VCMP); h16* vsT = (h16*)(ws + WS_VST); h16* vwT = (h16*)(ws + WS_VWT);
    int* tope = (int*)(ws + WS_TOPE); float* topw = (float*)(ws + WS_TOPW);
    h16* xh = (h16*)(ws + WS_XH); h16* mix = (h16*)(ws + WS_MIX); h16* ox = (h16*)(ws + WS_OX); h16* hb = (h16*)(ws + WS_H); h16* nqr = (h16*)(ws + WS_NQR);
    float* kvb = (float*)(ws + WS_KVB); h16* prevT = (h16*)(ws + WS_PREVT);
    float* cosr = (float*)(ws + WS_COSR); float* sinr = (float*)(ws + WS_SINR); float* cosn = (float*)(ws + WS_COSN); float* sinn = (float*)(ws + WS_SINN); h16* kvmVT = (h16*)(ws + WS_KVMVT); h16* WrTh = (h16*)(ws + WS_WRTH); h16* WrTl = (h16*)(ws + WS_WRTL); h16* Wc1T = (h16*)(ws + WS_WC1T); h16* hid = (h16*)(ws + WS_HID); unsigned* cmpoff = (unsigned*)(ws + WS_CMPOFF); float* peb = (float*)(ws + WS_PEB); h16* ksR = (h16*)(ws + WS_KSR); h16* kwR = (h16*)(ws + WS_KWR); h16* kx = (h16*)(ws + WS_KX);
    h16* rqr = (h16*)((unsigned char*)p.out + DO_RQR); h16* rkr = (h16*)((unsigned char*)p.out + DO_RKR); h16* rkzT = (h16*)((unsigned char*)p.out + DO_RKZT); h16* rvT = (h16*)((unsigned char*)p.out + DO_RVT); float* pre = p.out; float* x1 = (float*)(ws + WS_X1); h16* x1h = (h16*)(ws + WS_X1H);
    h16* qx = (h16*)(ws + WS_QX); float* x2 = (float*)(ws + WS_X2); h16* x2h = (h16*)(ws + WS_X2H);
    int* ctl = (int*)ws; unsigned* rowoff = (unsigned*)(ws + WS_ROWOFF); u32x2* rowmeta = (u32x2*)(ws + WS_ROWMETA);
    h16* WguT = (h16*)(ws + WS_WGUT); h16* WdT = (h16*)(ws + WS_WDT); h16* Hm = (h16*)(ws + WS_HM); h16* Yq = (h16*)(ws + WS_Y);
    float* fl = (float*)lds;
    const int lo = p.ph_lo, hi = p.ph_hi;
#define IN(k) (lo <= (k) && (k) < hi)
    { volatile LAS unsigned* st = (volatile LAS unsigned*)((LAS unsigned char*)lds + 131072); if (threadIdx.x < 2) st[threadIdx.x] = 0u; }
    __syncthreads();
    XcdBarrier xbar = xcd_barrier_post((unsigned*)(ws + WS_BAR), (volatile LAS unsigned*)((LAS unsigned char*)lds + 131072));
#define SEAM(k) do { if (IN(k) && IN((k) + 1)) { if ((k) == 0) grid.sync(); else xcd_barrier(xbar); } } while (0)

    if (IN(0)) REPS(0) {
        { const int sub = tid >> 8, lt = tid & 255; float* tl = fl + sub * 1088;
          constexpr int T0 = (INP / 32) * (D / 32);
          for (int b0 = bid * 2; b0 < T0; b0 += G * 2) b_transpose_tile(p.w_in, D, INC, WinT, INP, b0 + sub, tl, lt); }
        { const int wv = __builtin_amdgcn_readfirstlane(tid >> 6), lane = tid & 63; LAS float* scr = (LAS float*)((LAS unsigned char*)lds + wv * 8704);
          constexpr int I1 = (D / 64) * (D / 32), I4 = (D / 64) * (2 * D / 32), I5 = (2048 / 64) * (256 / 32), IT = 3 * I1 + I4 + 2 * I5;
          for (int it0 = bid * 8 + wv; it0 < IT; it0 += G * 8) { int it = it0;
            if (it < I1) { w_transpose_item(p.w_out, D, D, WoutT, it, scr, lane); continue; } it -= I1;
            if (it < I1) { w_transpose_item(p.w_xq, D, D, WxqT, it, scr, lane); continue; } it -= I1;
            if (it < I1) { w_transpose_item(p.w_xo, D, D, WxoT, it, scr, lane); continue; } it -= I1;
            if (it < I4) { w_transpose_item(p.w_xkv, D, 2 * D, WxkvT, it, scr, lane); continue; } it -= I4;
            if (it < I5) { w_transpose_item(p.w1k, 2048, 256, Wc1T, it, scr, lane); continue; } it -= I5;
            w_transpose_item(p.w1v, 2048, 256, Wc1T + 256 * 2048, it, scr, lane); } }
        __syncthreads();
        b_cvt(p.x, xh, (size_t)M * D / 4);
        b_cvt(p.mem, memh, (size_t)NB * MEML * D / 4);
        if (bid == 0) for (int i = tid; i < 1024; i += NTHR) ctl[i] = 0;
        b_tables(p.positions, cosr, sinr, cosn, sinn);
        for (int idx = bid * NTHR + tid; idx < NE * D; idx += G * NTHR) { const int e = idx >> 10, k = idx & 1023; const float w = p.w_router[k * NE + e]; const h16 hi = (h16)w; WrTh[idx] = hi; WrTl[idx] = (h16)((w - (float)hi) * 2048.f); }
        for (int r = bid * NTHR + tid; r < 4096; r += G * NTHR) { const int g = r & 1, c = min((r >> 1) & 511, 510), b = r >> 10; cmpoff[r] = (unsigned)(((size_t)(b * T + 16 * c) * INP + g * 64) * 2); }
        { const int lane = tid & 63;
          for (int o = bid * 8 + (tid >> 6); o < 512; o += G * 8) { const int kv = o >> 8, j = o & 255; const float* pe = kv ? p.pe_v : p.pe_k; const float* w1 = kv ? p.w1v : p.w1k; float a = 0.f;
              for (int k = lane; k < 2048; k += 64) a += pe[k] * w1[(size_t)k * 256 + j];
              a = wave_sum(a); if (lane == 0) peb[o] = a; } }
    }
    SEAM(0);
    if (IN(1)) {
        REPS(1) { pg8::Gemm g{xh, WinT, M, INP, D}; pg8::StaticOrder S; S.init(g, G, bid); pg8::EpiF16 E{hb, INP};
          pg8::gemm_phase<pg8::EpiF16, pg8::StaticOrder>((PG8_LAS unsigned char*)lds, g.K, S, E); }
        { pg8::Gemm g{memh, WxkvT, NB * MEML, 2 * D, D}; pg8::StaticOrder S; S.init(g, G, bid); pg8::EpiF16 E{kvm, 2 * D};
          pg8::gemm_phase<pg8::EpiF16, pg8::StaticOrder>((PG8_LAS unsigned char*)lds, g.K, S, E); }
    }
    SEAM(1);
    if (IN(2)) REPS(2) {
        if (bid < 32) { CmpSched S{(const char*)hb, cmpoff, (const char*)Wc1T, bid}; pg8::EpiCmp1 E{hid, peb + (bid >> 4) * 256};
            pg8::gemm_phase<pg8::EpiCmp1, CmpSched>((PG8_LAS unsigned char*)lds, 2048, S, E, (size_t)INP * 2); }
        else { const int sub = tid >> 8, lt = tid & 255; const int b2 = bid - 32, G2 = G - 32;
        for (int b0 = b2 * 2; b0 < M; b0 += G2 * 2) b_rope(hb, rqr, rkr, nqr, ksR, kwR, cosr, sinr, cosn, sinn, b0 + sub, lt);
        for (int b0 = b2 * 2; b0 < 2 * NB * 2 * 128; b0 += G2 * 2) b_vtrans(hb, vsT, vwT, b0 + sub, (h16*)(fl + sub * 2304), lt);
        for (int b0 = b2 * 2; b0 < NB * 4 * 128; b0 += G2 * 2) b_rtrans(p, hb, rvT, rkzT, cosr, sinr, b0 + sub, (h16*)(fl + sub * 4224), lt);
        for (int b0 = b2 * 2; b0 < NB * 4 * 16; b0 += G2 * 2) b_mvtrans(kvm, kvmVT, kx, b0 + sub, (h16*)(fl + sub * 2304), lt); } }
    SEAM(2);
    if (IN(3)) {
        REPS(30) b_cmp2(p, hid, kcmp, vcmpT);
        const int wv = __builtin_amdgcn_readfirstlane(tid >> 6), lane = tid & 63;
        REPS(31) for (int ch = bid; ch < NB * 4 * 64; ch += G) ret_kv_unit(rkzT, rvT, kvb, ch, wv, lane); }
    SEAM(3);
    if (IN(4)) REPS(4) b_ret_scan(p, kvb, prevT);
    SEAM(4);
    if (IN(5)) {
        const int wv = __builtin_amdgcn_readfirstlane(tid >> 6), lane = tid & 63;
        REPS(50) { const int bg = bid & 7;
            for (int k = bid >> 3; k < T / 32; k += (G >> 3)) nsa_block_unit(hb, nqr, kcmp, vcmpT, vsT, vwT, ksR, kwR, mix, bg >> 1, bg & 1, (T / 32 - 1 - k) * 32, (LAS unsigned char*)lds, wv, lane); }
        __syncthreads();
        REPS(51) for (int ch = bid; ch < NB * 4 * 64; ch += G) ret_out_unit(p, hb, rqr, rkr, rvT, prevT, mix, ch, wv, lane);
    }
    SEAM(5);
    if (IN(6)) { pg8::Gemm g{mix, WoutT, M, D, D}; pg8::StaticOrder S; S.init(g, G, bid); pg8::EpiResF32 E{pre, p.x, D, DN_ALPHA};
        pg8::gemm_phase<pg8::EpiResF32, pg8::StaticOrder>((PG8_LAS unsigned char*)lds, g.K, S, E); }
    SEAM(6);
    if (PROBE_DBL == 900) { for (int k = 0; k < 20; ++k) xcd_barrier(xbar); }
    if (IN(7)) REPS(7) b_ln(pre, p.ln1g, p.ln1b, x1, x1h);
    SEAM(7);
    if (IN(8)) { pg8::Gemm g{x1h, WxqT, M, D, D}; pg8::StaticOrder S; S.init(g, G, bid); pg8::EpiF16 E{qx, D};
        pg8::gemm_phase<pg8::EpiF16, pg8::StaticOrder>((PG8_LAS unsigned char*)lds, g.K, S, E); }
    SEAM(8);
    if (IN(9)) { const int wv = __builtin_amdgcn_readfirstlane(tid >> 6), lane = tid & 63;
        REPS(9) for (int u = bid; u < (M / 128) * 4; u += G) xattn_unit(qx, kx, kvmVT, ox, (u >> 2) * 128 + wv * 16, u & 3, lane); }
    SEAM(9);
    if (IN(10)) { pg8::Gemm g{ox, WxoT, M, D, D}; pg8::StaticOrder S; S.init(g, G, bid); pg8::EpiResF32 E{pre, x1, D, DN_ALPHA};
        pg8::gemm_phase<pg8::EpiResF32, pg8::StaticOrder>((PG8_LAS unsigned char*)lds, g.K, S, E); }
    SEAM(10);
    if (IN(11)) REPS(7) b_ln(pre, p.ln2g, p.ln2b, x2, x2h);
    SEAM(11);
    if (IN(12)) {
        { const int wv = __builtin_amdgcn_readfirstlane(tid >> 6), lane = tid & 63; LAS float* lg = (LAS float*)((LAS unsigned char*)lds + wv * 4096);
          for (int u = bid * 8 + wv; u < M / 16; u += G * 8) router_unit(p, x2, WrTh, WrTl, tope, topw, ctl + CTL_CNT, u * 16, lg, lane); }
        __syncthreads();
        if (bid == 0 && tid < NQ) ctl[CTL_CNT + tid * 65 + 64] = QT;
        for (int i = bid * NTHR + tid; i < CAP; i += G * NTHR) { rowoff[i] = 0u; rowmeta[i] = (u32x2){0xffffffffu, 0u}; }
        { const int wv = __builtin_amdgcn_readfirstlane(tid >> 6), lane = tid & 63; LAS float* scr = (LAS float*)((LAS unsigned char*)lds + wv * 8704);
          REPS(121) for (int it = bid * 8 + wv; it < 65 * 384; it += G * 8) { const int e = it / 384, r = it % 384;
            const float* wg = e < 64 ? p.w_gate + (size_t)e * D * EFF : p.ws_gate; const float* wu = e < 64 ? p.w_up + (size_t)e * D * EFF : p.ws_up; const float* wd = e < 64 ? p.w_down + (size_t)e * EFF * D : p.ws_down;
            if (r < 128) w_transpose_item(wg, D, EFF, WguT + (size_t)e * 512 * D, r, scr, lane, 2, 0);
            else if (r < 256) w_transpose_item(wu, D, EFF, WguT + (size_t)e * 512 * D, r - 128, scr, lane, 2, 1);
            else w_transpose_item(wd, EFF, D, WdT + (size_t)e * D * EFF, r - 256, scr, lane); } }
    }
    SEAM(12);
    if (IN(13)) b_scatter(ctl, tope, topw, rowoff, rowmeta, (int*)lds);
    SEAM(13);
    if (IN(14)) REPS(14) { G1Sched S{ctl, (const char*)x2h, rowoff, (const char*)WguT, G, bid}; pg8::EpiGateUp E{Hm};
        pg8::gemm_phase<pg8::EpiGateUp, G1Sched>((PG8_LAS unsigned char*)lds, D, S, E); }
    SEAM(14);
#pragma unroll 1
    for (int q = 0; q < NQ; ++q) {
        if (IN(15 + 2 * q)) REPS(15) { G2Sched S{ctl, (const char*)Hm, (const char*)WdT, q, G, bid}; pg8::EpiDown E{Yq, rowmeta};
            pg8::gemm_phase<pg8::EpiDown, G2Sched>((PG8_LAS unsigned char*)lds, EFF, S, E); }
        SEAM(15 + 2 * q);
        if (IN(16 + 2 * q)) REPS(16) b_combine(p, x2h, Yq, q);
        if (q < NQ - 1) SEAM(16 + 2 * q);
    }
#undef IN
#undef SEAM
#undef tid
}

#ifndef MK_PER_PHASE
#define MK_PER_PHASE 0
#endif
extern "C" void kernel_launch(void* const* d_in, const int* in_sizes, int n_in, void* d_out, int out_size, void* d_ws, size_t ws_size, hipStream_t stream) {
    static int grid = 0;
    if (grid == 0) {
        if (n_in != 28 || in_sizes[0] != M * D || out_size != M * D || ws_size < WS_NEED) { fprintf(stderr, "kernel_launch: unexpected shapes (n_in %d, in0 %d, out %d, ws %zu)\n", n_in, n_in > 0 ? in_sizes[0] : -1, out_size, ws_size); grid = -1; return; }
        if (hipFuncSetAttribute((const void*)mega_fwd, hipFuncAttributeMaxDynamicSharedMemorySize, LDS_BYTES) != hipSuccess) { fprintf(stderr, "kernel_launch: hipFuncSetAttribute failed\n"); grid = -1; return; }
        int dev = 0, cus = 0, per_cu = 0;
        hipGetDevice(&dev); hipDeviceGetAttribute(&cus, hipDeviceAttributeMultiprocessorCount, dev);
        if (hipOccupancyMaxActiveBlocksPerMultiprocessor(&per_cu, (const void*)mega_fwd, NTHR, LDS_BYTES) != hipSuccess || per_cu < 1) { fprintf(stderr, "kernel_launch: occupancy query failed (%d)\n", per_cu); grid = -1; return; }
        grid = cus;
    }
    if (grid < 0) return;
    Params p{};
    p.x = (const float*)d_in[0]; p.mem = (const float*)d_in[1]; p.positions = (const int*)d_in[2];
    p.w_in = (const float*)d_in[3]; p.pe_k = (const float*)d_in[4]; p.pe_v = (const float*)d_in[5];
    p.w1k = (const float*)d_in[6]; p.w2k = (const float*)d_in[7]; p.w1v = (const float*)d_in[8]; p.w2v = (const float*)d_in[9];
    p.w_out = (const float*)d_in[10]; p.ln1g = (const float*)d_in[11]; p.ln1b = (const float*)d_in[12];
    p.w_xq = (const float*)d_in[13]; p.w_xkv = (const float*)d_in[14]; p.w_xo = (const float*)d_in[15];
    p.ln2g = (const float*)d_in[16]; p.ln2b = (const float*)d_in[17]; p.w_router = (const float*)d_in[18]; p.rbias = (const float*)d_in[19];
    p.w_gate = (const float*)d_in[20]; p.w_up = (const float*)d_in[21]; p.w_down = (const float*)d_in[22];
    p.ws_gate = (const float*)d_in[23]; p.ws_up = (const float*)d_in[24]; p.ws_down = (const float*)d_in[25];
    p.ln3g = (const float*)d_in[26]; p.ln3b = (const float*)d_in[27];
    p.out = (float*)d_out; p.ws = (unsigned char*)d_ws;
    for (int i = 0; i < 4; ++i) p.lg[i] = (float)std::log(1.0 - std::pow(2.0, -5.0 - (double)i));
#if MK_PER_PHASE
    for (int ph = 0; ph < N_PHASES; ++ph) { p.ph_lo = ph; p.ph_hi = ph + 1; hipLaunchKernelGGL(mega_fwd, dim3(grid), dim3(NTHR), LDS_BYTES, stream, p); }
#else
    p.ph_lo = 0; p.ph_hi = N_PHASES;
    if (hipMemsetAsync((char*)d_ws + WS_BAR, 0, XCD_BAR_WORDS * 4, stream) != hipSuccess) { fprintf(stderr, "kernel_launch: memset failed\n"); return; }
    void* args[] = {&p};
    hipError_t e = hipLaunchCooperativeKernel((const void*)mega_fwd, dim3(grid), dim3(NTHR), args, LDS_BYTES, stream);
    if (e != hipSuccess) fprintf(stderr, "kernel_launch: cooperative launch failed: %s (grid %d)\n", hipGetErrorString(e), grid);
#endif
}
```

```cpp
#include <hip/hip_runtime.h>
#include <cstdio>
#include <cstdint>
#include <cmath>

typedef _Float16 h16;
typedef _Float16 h16x8 __attribute__((ext_vector_type(8)));
typedef _Float16 h16x2 __attribute__((ext_vector_type(2)));
typedef _Float16 h16x4 __attribute__((ext_vector_type(4)));
typedef float f32x2 __attribute__((ext_vector_type(2)));
typedef float f32x4 __attribute__((ext_vector_type(4)));
typedef unsigned u32x4 __attribute__((ext_vector_type(4)));
typedef unsigned u32x2 __attribute__((ext_vector_type(2)));

__device__ __forceinline__ int tidx() { int t = (int)threadIdx.x; asm volatile("" : "+v"(t)); return t; }

#ifndef PROBE_DBL
#define PROBE_DBL -1
#endif
#define REPS(k) for (int _rep = 0; _rep < ((PROBE_DBL) == (k) ? 2 : 1); ++_rep)

constexpr int NB = 4, T = 8192, D = 1024, M = NB * T;
constexpr int INC = 3352, INP = 3584;
constexpr int C_RQ = 0, C_RK = 512, C_RV = 1024, C_RG = 1536, C_NQ = 2048, C_NKC = 2560, C_NVC = 2688, C_NKS = 2816, C_NVS = 2944, C_NKW = 3072, C_NVW = 3200, C_NG = 3328;
constexpr int MEML = 256;
constexpr int NE = 64, EFF = 256;
constexpr float LN_EPS = 1e-5f;
constexpr float DN_ALPHA = 1.189207115002721f;
constexpr float NEGF = -1e30f;

constexpr size_t MiB = 1u << 20;
constexpr size_t WS_WIN = 1 * MiB, WS_WOUT = 8 * MiB, WS_WXQ = 10 * MiB, WS_WXO = 12 * MiB, WS_WXKV = 14 * MiB, WS_MEMH = 18 * MiB, WS_KVM = 20 * MiB;
constexpr size_t WS_KCMP = 24 * MiB, WS_VCMP = 25 * MiB, WS_TOPE = 26 * MiB, WS_TOPW = 27 * MiB;
constexpr size_t WS_XH = 32 * MiB, WS_MIX = 32 * MiB, WS_OX = 32 * MiB;
constexpr size_t WS_H = 96 * MiB, WS_NQR = 320 * MiB, WS_KVB = 352 * MiB, WS_PREV = 416 * MiB;
constexpr size_t WS_PRE = 96 * MiB, WS_X1 = 224 * MiB, WS_X1H = 352 * MiB, WS_QX = 416 * MiB, WS_X2 = 130 * MiB;
constexpr size_t WS_X2H = 32 * MiB, WS_WDT = 96 * MiB, WS_HM = 130 * MiB, WS_WGUT = 306 * MiB, WS_Y = 306 * MiB;
constexpr size_t WS_ROWOFF = 1 * MiB, WS_ROWMETA = 3 * MiB;
constexpr size_t WS_VST = 480 * MiB, WS_VWT = 488 * MiB, WS_COSR = 496 * MiB, WS_SINR = 504 * MiB, WS_COSN = 28 * MiB, WS_SINN = 29 * MiB, WS_KVMVT = 30 * MiB;
constexpr size_t WS_WRTH = 262144, WS_WRTL = 393216;
constexpr size_t WS_WC1T = 464 * MiB, WS_HID = 466 * MiB, WS_CMPOFF = 131072, WS_PEB = 131072 + 16384;
constexpr size_t WS_PREVT = 416 * MiB, WS_KSR = 448 * MiB, WS_KWR = 456 * MiB, WS_KX = 26 * MiB;
constexpr size_t DO_RQR = 0, DO_RKR = 32 * MiB, DO_RKZT = 64 * MiB, DO_RVT = 96 * MiB;
constexpr size_t WS_NEED = 512 * MiB;
constexpr int NQ = 4, QT = M / NQ, NVE = NQ * 65, CAP_TILES = 1412, CAP = CAP_TILES * 256;
constexpr size_t WS_BAR = 65536;
constexpr int CTL_CNT = 0, CTL_CUR = 512, CTL_PST = 1024, CTL_TQS = 1536, CTL_TVE = 2048;

namespace pg8 {
#define PG8_LAS __attribute__((address_space(3)))
typedef short s16x8 __attribute__((ext_vector_type(8)));
constexpr int BM = 256, BK = 64, HALF = 128, HTB = HALF * BK * 2, STAGE_BYTES = 8 * HTB, NXCD = 8, WGM = 8;
__host__ __device__ __forceinline__ int lds_byte(int r, int c) { const int st = (r >> 4) * 2 + (c >> 5), rr = r & 15, cc = c & 31, ob = rr * 64 + cc * 2; return st * 1024 + (ob ^ (((ob >> 9) & 1) << 5)); }
__host__ __device__ __forceinline__ void stage_rc(int b, int& R, int& C) { const int st = b / 1024, sb = b % 1024, swz = sb ^ (((sb >> 9) & 1) << 5); R = (st >> 1) * 16 + swz / 64; C = (st & 1) * 32 + (swz % 64) / 2; }
__host__ __device__ __forceinline__ int perm32(int rho) { const int n = rho >> 4, i = rho & 15; return 8 * (i >> 2) + 4 * n + (i & 3); }
struct Unit { int pm, pn; const char* A; const char* B; const unsigned* gat; };
struct Gemm { const h16* A; const h16* Bt; int M, N, K; };
struct StaticOrder {
    int nM, nN, nwg, G, c; const char* A; const char* B; size_t tstep;
    __device__ void init(const Gemm& g, int G_, int c_) { nM = g.M / BM; nN = g.N / BM; nwg = nM * nN; G = G_; c = c_; A = (const char*)g.A; B = (const char*)g.Bt; tstep = (size_t)BM * g.K * 2; }
    __device__ bool next(int i, Unit& u) const {
        const long L = (long)i * G + c; if (L >= nwg) return false;
        int wgid = (int)L; { const int q = nwg / NXCD, r = nwg % NXCD, xcd = wgid % NXCD, off = wgid / NXCD; wgid = (xcd < r ? xcd * (q + 1) : r * (q + 1) + (xcd - r) * q) + off; }
        const int nig = WGM * nN, gid = wgid / nig, fm = gid * WGM, gsz = (nM - fm) < WGM ? (nM - fm) : WGM;
        u.pm = fm + ((wgid % nig) % gsz); u.pn = (wgid % nig) / gsz; u.A = A + (size_t)u.pm * tstep; u.B = B + (size_t)u.pn * tstep; u.gat = nullptr; return true;
    }
};
__device__ __forceinline__ unsigned cvt_pk_f16(float lo, float hi) { f32x2 v = {lo, hi}; h16x2 h = __builtin_convertvector(v, h16x2); return __builtin_bit_cast(unsigned, h); }

struct EpiF16 {
    static constexpr bool PERM = true;
    h16* O; int ldc;
    __device__ __forceinline__ void operator()(const f32x4 (&acc)[2][2][4][2], const Unit& u, int wr, int wc, int fr, int fq) const {
        const int row0 = u.pm * BM + wr * 64 + fr; const int col0 = u.pn * BM + wc * 32 + 8 * fq;
#pragma unroll
        for (int ai = 0; ai < 2; ++ai)
#pragma unroll
            for (int m = 0; m < 4; ++m) { h16* rowp = O + (size_t)(row0 + ai * HALF + m * 16) * ldc + col0;
#pragma unroll
                for (int bj = 0; bj < 2; ++bj) { const f32x4 v0 = acc[ai][bj][m][0], v1 = acc[ai][bj][m][1];
                    *(h16x8*)(rowp + bj * HALF) = __builtin_convertvector(__builtin_shufflevector(v0, v1, 0, 1, 2, 3, 4, 5, 6, 7), h16x8); } }
    }
};
struct EpiResF32 {
    static constexpr bool PERM = false;
    float* C; const float* R; int ldc; float alpha;
    __device__ __forceinline__ void operator()(const f32x4 (&acc)[2][2][4][2], const Unit& u, int wr, int wc, int fr, int fq) const {
        const int row0 = u.pm * BM + wr * 64 + fr, col0 = u.pn * BM + wc * 32 + 4 * fq;
#pragma unroll
        for (int ai = 0; ai < 2; ++ai)
#pragma unroll
            for (int m = 0; m < 4; ++m) { const size_t off = (size_t)(row0 + ai * HALF + m * 16) * ldc + col0;
#pragma unroll
                for (int bj = 0; bj < 2; ++bj)
#pragma unroll
                    for (int n = 0; n < 2; ++n) { const f32x4 r = *(const f32x4*)(R + off + bj * HALF + n * 16); *(f32x4*)(C + off + bj * HALF + n * 16) = r * alpha + acc[ai][bj][m][n]; } }
    }
};
struct EpiCmp1 {
    static constexpr bool PERM = true;
    h16* O; const float* peb;
    __device__ __forceinline__ void operator()(const f32x4 (&acc)[2][2][4][2], const Unit& u, int wr, int wc, int fr, int fq) const {
        const int row0 = u.pm * BM + wr * 64 + fr; const int col0 = wc * 32 + 8 * fq;
#pragma unroll
        for (int bj = 0; bj < 2; ++bj) { const f32x4 b0 = *(const f32x4*)(peb + col0 + bj * HALF), b1 = *(const f32x4*)(peb + col0 + bj * HALF + 4);
#pragma unroll
            for (int ai = 0; ai < 2; ++ai)
#pragma unroll
                for (int m = 0; m < 4; ++m) { f32x4 v0 = acc[ai][bj][m][0] + b0, v1 = acc[ai][bj][m][1] + b1;
#pragma unroll
                    for (int r = 0; r < 4; ++r) { v0[r] = v0[r] / (1.f + __expf(-v0[r])); v1[r] = v1[r] / (1.f + __expf(-v1[r])); }
                    *(h16x8*)(O + (size_t)(row0 + ai * HALF + m * 16) * 256 + col0 + bj * HALF) = __builtin_convertvector(__builtin_shufflevector(v0, v1, 0, 1, 2, 3, 4, 5, 6, 7), h16x8); } }
    }
};
struct EpiGateUp {
    static constexpr bool PERM = true;
    h16* H;
    __device__ __forceinline__ void operator()(const f32x4 (&acc)[2][2][4][2], const Unit& u, int wr, int wc, int fr, int fq) const {
        const int row0 = u.pm * BM + wr * 64 + fr; const int col0 = u.pn * 128 + wc * 16 + 4 * fq;
#pragma unroll
        for (int ai = 0; ai < 2; ++ai)
#pragma unroll
            for (int m = 0; m < 4; ++m) { h16* rowp = H + (size_t)(row0 + ai * HALF + m * 16) * 256 + col0;
#pragma unroll
                for (int bj = 0; bj < 2; ++bj) { const f32x4 v0 = acc[ai][bj][m][0], v1 = acc[ai][bj][m][1];
                    const float h0 = v0[0] / (1.f + __expf(-v0[0])) * v0[1], h1 = v0[2] / (1.f + __expf(-v0[2])) * v0[3];
                    const float h2 = v1[0] / (1.f + __expf(-v1[0])) * v1[1], h3 = v1[2] / (1.f + __expf(-v1[2])) * v1[3];
                    *(h16x4*)(rowp + bj * 64) = __builtin_convertvector((f32x4){h0, h1, h2, h3}, h16x4); } }
    }
};
struct EpiDown {
    static constexpr bool PERM = true;
    h16* Y; const u32x2* rowmeta;
    __device__ __forceinline__ void operator()(const f32x4 (&acc)[2][2][4][2], const Unit& u, int wr, int wc, int fr, int fq) const {
        const int row0 = u.pm * BM + wr * 64 + fr; const int col0 = u.pn * BM + wc * 32 + 8 * fq;
#pragma unroll
        for (int ai = 0; ai < 2; ++ai)
#pragma unroll
            for (int m = 0; m < 4; ++m) { const u32x2 md = rowmeta[row0 + ai * HALF + m * 16]; const int slot = (int)md.x; const float w8 = __uint_as_float(md.y);
                if (slot >= 0) { h16* rowp = Y + (size_t)slot * 1024 + col0;
#pragma unroll
                    for (int bj = 0; bj < 2; ++bj) { const f32x4 v0 = acc[ai][bj][m][0] * w8, v1 = acc[ai][bj][m][1] * w8;
                        *(h16x8*)(rowp + bj * HALF) = __builtin_convertvector(__builtin_shufflevector(v0, v1, 0, 1, 2, 3, 4, 5, 6, 7), h16x8); } }
                asm volatile("" ::: "memory"); }
    }
};

template <class Epi, class Sched>
__device__ __forceinline__ void gemm_phase(PG8_LAS unsigned char* lds, const int K, const Sched& S, const Epi& E, const size_t kstepA = (size_t)(BK * 2)) {
    const int tid = tidx(), wid = __builtin_amdgcn_readfirstlane(tid >> 6), lane = tid & 63, wr = wid >> 2, wc = wid & 3, fr = lane & 15, fq = lane >> 4;
    const int nt = K / BK;
    int R0, C0; stage_rc(tid * 16, R0, C0);
    const unsigned cb2 = (unsigned)C0 * 2u;
    unsigned voffB[2];
#pragma unroll
    for (int i = 0; i < 2; ++i) { const int R = R0 + 64 * i; const int Rb = Epi::PERM ? ((R & ~31) + perm32(R & 31)) : R; voffB[i] = (unsigned)(Rb * K) * 2u + cb2; }
    const size_t kstep = (size_t)(BK * 2);
    const size_t hstep = (size_t)HALF * K * 2;
    const unsigned ldsw = (unsigned)wid * 1024u;
    const int aoff = lds_byte(wr * 64 + fr, fq * 8), boff = lds_byte(wc * 32 + fr, fq * 8);
#define PG8_MKVA(u, va) do { _Pragma("unroll") for (int _h = 0; _h < 2; ++_h) _Pragma("unroll") for (int _i = 0; _i < 2; ++_i) { const int _r = _h * HALF + R0 + 64 * _i; \
        (va)[_h][_i] = ((u).gat ? (u).gat[_r] : (unsigned)(_r * K) * 2u) + cb2; } } while (0)
#define PG8_SA(b, h) (((b) * 2 + (h)) * HTB)
#define PG8_SB(b, h) ((4 + (b) * 2 + (h)) * HTB)
#define PG8_STAGE(bufoff, gbase, voff) do { _Pragma("unroll") for (int _i = 0; _i < 2; ++_i) \
        __builtin_amdgcn_global_load_lds((const unsigned*)((const char*)(gbase) + (voff)[_i]), (PG8_LAS unsigned*)(lds + (bufoff) + ldsw + _i * 8192), 16, 0, 0); } while (0)
#define PG8_LDA(dst, b, h) do { _Pragma("unroll") for (int m = 0; m < 4; ++m) _Pragma("unroll") for (int k = 0; k < 2; ++k) dst[m][k] = *(const PG8_LAS s16x8*)(lds + PG8_SA(b, h) + aoff + m * 2048 + k * 1024); } while (0)
#define PG8_LDB(dst, b, h) do { _Pragma("unroll") for (int n = 0; n < 2; ++n) _Pragma("unroll") for (int k = 0; k < 2; ++k) dst[n][k] = *(const PG8_LAS s16x8*)(lds + PG8_SB(b, h) + boff + n * 2048 + k * 1024); } while (0)
#define PG8_MMA(ai, bj, At, Bt) do { __builtin_amdgcn_s_setprio(1); _Pragma("unroll") for (int m = 0; m < 4; ++m) _Pragma("unroll") for (int n = 0; n < 2; ++n) _Pragma("unroll") for (int k = 0; k < 2; ++k) \
        acc[ai][bj][m][n] = __builtin_amdgcn_mfma_f32_16x16x32_f16(__builtin_bit_cast(h16x8, Bt[n][k]), __builtin_bit_cast(h16x8, At[m][k]), acc[ai][bj][m][n], 0, 0, 0); __builtin_amdgcn_s_setprio(0); } while (0)
#define PG8_WAIT_V(n) asm volatile("s_waitcnt vmcnt(" #n ")" ::: "memory")
#define PG8_WAIT_L(n) asm volatile("s_waitcnt lgkmcnt(" #n ")" ::: "memory")
#define PG8_BAR __builtin_amdgcn_s_barrier()
#define PG8_SCHED __builtin_amdgcn_sched_barrier(0)
    Unit cur, nxt; int ui = 0;
    if (!S.next(0, cur)) return;
    unsigned va[2][2];
    PG8_MKVA(cur, va);
    f32x4 acc[2][2][4][2];
#pragma unroll
    for (int a = 0; a < 2; ++a)
#pragma unroll
        for (int b = 0; b < 2; ++b)
#pragma unroll
            for (int m = 0; m < 4; ++m)
#pragma unroll
                for (int n = 0; n < 2; ++n) acc[a][b][m][n] = (f32x4){0.f, 0.f, 0.f, 0.f};
    s16x8 At[4][2], B0[2][2], B1[2][2];
    const char* cA = cur.A; const char* cB = cur.B;
    {
        PG8_STAGE(PG8_SB(0, 0), cB, voffB); PG8_STAGE(PG8_SB(0, 1), cB + hstep, voffB); PG8_STAGE(PG8_SA(0, 0), cA, va[0]); PG8_STAGE(PG8_SA(0, 1), cA, va[1]);
        if (wr == 1) PG8_BAR;
        PG8_WAIT_V(2); PG8_BAR;
        PG8_STAGE(PG8_SB(1, 0), cB + kstep, voffB); PG8_STAGE(PG8_SA(1, 0), cA + kstepA, va[0]); PG8_STAGE(PG8_SB(1, 1), cB + hstep + kstep, voffB);
        PG8_WAIT_V(6); PG8_BAR;
    }
    for (;;) {
        const bool has_next = S.next(ui + 1, nxt);
        const char* nA = has_next ? nxt.A : cA; const char* nB = has_next ? nxt.B : cB;
#pragma unroll 1
        for (int t = 0; t < nt; t += 2) {
            const bool last = (t == nt - 2);
            const char* a1 = cA + (size_t)(t + 1) * kstepA;
            const char* a2 = last ? nA : cA + (size_t)(t + 2) * kstepA; const char* b2 = last ? nB : cB + (size_t)(t + 2) * kstep;
            const char* a3 = a2 + kstepA; const char* b3 = b2 + kstep;
            PG8_LDB(B0, 0, 0); PG8_LDB(B1, 0, 1); PG8_SCHED; PG8_LDA(At, 0, 0); PG8_STAGE(PG8_SA(1, 1), a1, va[1]);
            if (last && has_next) { PG8_MKVA(nxt, va); }
            PG8_WAIT_V(8); PG8_WAIT_L(0); PG8_BAR; PG8_MMA(0, 0, At, B0); PG8_MMA(0, 1, At, B1); PG8_BAR; PG8_SCHED;
            PG8_LDA(At, 0, 1); PG8_STAGE(PG8_SB(0, 0), b2, voffB); PG8_STAGE(PG8_SB(0, 1), b2 + hstep, voffB); PG8_STAGE(PG8_SA(0, 0), a2, va[0]);
            PG8_WAIT_V(8); PG8_WAIT_L(0); PG8_BAR; PG8_MMA(1, 0, At, B0); PG8_MMA(1, 1, At, B1); PG8_BAR; PG8_SCHED;
            PG8_LDB(B0, 1, 0); PG8_LDB(B1, 1, 1); PG8_SCHED; PG8_LDA(At, 1, 0); PG8_STAGE(PG8_SA(0, 1), a2, va[1]);
            PG8_WAIT_V(8); PG8_WAIT_L(0); PG8_BAR; PG8_MMA(0, 0, At, B0); PG8_MMA(0, 1, At, B1); PG8_BAR; PG8_SCHED;
            PG8_LDA(At, 1, 1); PG8_STAGE(PG8_SB(1, 0), b3, voffB); PG8_STAGE(PG8_SB(1, 1), b3 + hstep, voffB); PG8_STAGE(PG8_SA(1, 0), a3, va[0]);
            PG8_WAIT_V(8); PG8_WAIT_L(0); PG8_BAR; PG8_MMA(1, 0, At, B0); PG8_MMA(1, 1, At, B1); PG8_BAR; PG8_SCHED;
        }
        if (wr == 0) PG8_BAR;
        E(acc, cur, wr, wc, fr, fq);
        if (!has_next) break;
#pragma unroll
        for (int a = 0; a < 2; ++a)
#pragma unroll
            for (int b = 0; b < 2; ++b)
#pragma unroll
                for (int m = 0; m < 4; ++m)
#pragma unroll
                    for (int n = 0; n < 2; ++n) acc[a][b][m][n] = (f32x4){0.f, 0.f, 0.f, 0.f};
        cur = nxt; cA = nA; cB = nB; ++ui;
        if (wr == 1) PG8_BAR;
    }
    PG8_WAIT_V(0);
    PG8_BAR;
#undef PG8_MKVA
#undef PG8_SA
#undef PG8_SB
#undef PG8_STAGE
#undef PG8_LDA
#undef PG8_LDB
#undef PG8_MMA
#undef PG8_WAIT_V
#undef PG8_WAIT_L
#undef PG8_BAR
#undef PG8_SCHED
}
}


#include <hip/hip_cooperative_groups.h>
namespace cg = cooperative_groups;
constexpr int NTHR = 512;
constexpr int LDS_BYTES = 147456;
#define LAS __attribute__((address_space(3)))

struct Params {
    const float *x, *mem; const int* positions;
    const float *w_in, *pe_k, *pe_v, *w1k, *w2k, *w1v, *w2v, *w_out, *ln1g, *ln1b, *w_xq, *w_xkv, *w_xo, *ln2g, *ln2b, *w_router, *rbias, *w_gate, *w_up, *w_down, *ws_gate, *ws_up, *ws_down, *ln3g, *ln3b;
    float* out; unsigned char* ws;
    float lg[4];
    int ph_lo, ph_hi;
};

__device__ __forceinline__ float wave_sum(float v) {
#pragma unroll
    for (int o = 1; o < 64; o <<= 1) v += __shfl_xor(v, o);
    return v;
}
__device__ __forceinline__ float wave_max(float v) {
#pragma unroll
    for (int o = 1; o < 64; o <<= 1) v = fmaxf(v, __shfl_xor(v, o));
    return v;
}
__device__ __forceinline__ float siluf(float v) { return v / (1.f + __expf(-v)); }
__device__ __forceinline__ float sigmf(float v) { return 1.f / (1.f + __expf(-v)); }

__device__ __forceinline__ void b_transpose_tile(const float* __restrict__ W, int K, int N, h16* __restrict__ WT, int Npad, int tile, float* tl, int lt, int rs = 1, int ro = 0) {
    const int ntn = Npad / 32; const int n0 = (tile % ntn) * 32, k0 = (tile / ntn) * 32, tx = lt & 31, ty = lt >> 5;
    for (int i = ty; i < 32; i += 8) { const int k = k0 + i, n = n0 + tx; tl[i * 33 + tx] = (n < N) ? W[(size_t)k * N + n] : 0.f; }
    __syncthreads();
    for (int i = ty; i < 32; i += 8) { const int n = n0 + i, k = k0 + tx; WT[(size_t)(n * rs + ro) * K + k] = (h16)tl[tx * 33 + i]; }
    __syncthreads();
}
__device__ __forceinline__ void w_transpose_item(const float* __restrict__ W, int K, int N, h16* __restrict__ WT, int item, LAS float* scr, int lane, int rs = 1, int ro = 0) {
    const int nblk = N / 32, kb = item / nblk, nb = item % nblk, k0 = 64 * kb, n0 = 32 * nb;
#pragma unroll 8
    for (int i = 0; i < 32; ++i) { const int kk = 2 * i + (lane >> 5); scr[kk * 33 + (lane & 31)] = W[(size_t)(k0 + kk) * N + n0 + (lane & 31)]; }
    asm volatile("s_waitcnt lgkmcnt(0)" ::: "memory");
    const int c = lane & 7;
#pragma unroll
    for (int j = 0; j < 4; ++j) { const int n = (lane >> 3) + 8 * j; LAS const float* s = scr + (8 * c) * 33 + n; h16x8 o;
#pragma unroll
        for (int x = 0; x < 8; ++x) o[x] = (h16)s[x * 33];
        *(h16x8*)(WT + (size_t)((n0 + n) * rs + ro) * K + k0 + 8 * c) = o; }
    asm volatile("s_waitcnt lgkmcnt(0)" ::: "memory");
}
__device__ __forceinline__ void b_cvt(const float* __restrict__ x, h16* __restrict__ o, size_t n4) {
    for (size_t i = (size_t)blockIdx.x * NTHR + tidx(); i < n4; i += (size_t)gridDim.x * NTHR) {
        const f32x4 v = ((const f32x4*)x)[i]; ((h16x4*)o)[i] = __builtin_convertvector(v, h16x4); }
}

__device__ __forceinline__ void b_tables(const int* __restrict__ positions, float* __restrict__ cosr, float* __restrict__ sinr, float* __restrict__ cosn, float* __restrict__ sinn) {
    for (int idx = blockIdx.x * NTHR + tidx(); idx < M * 72; idx += gridDim.x * NTHR) {
        const int m = idx / 72, j = idx % 72; const float pos = (float)positions[m];
        const float inv = j < 64 ? (float)pow(10000.0, -(double)j / 64.0) : (float)pow(500000.0, -(double)(j - 64) / 8.0);
        const float ang = pos * inv; double sd, cd; sincos((double)ang, &sd, &cd);
        if (j < 64) { cosr[(size_t)m * 64 + j] = (float)cd; sinr[(size_t)m * 64 + j] = (float)sd; } else { cosn[(size_t)m * 8 + j - 64] = (float)cd; sinn[(size_t)m * 8 + j - 64] = (float)sd; }
    }
}
__device__ __forceinline__ void b_rope(const h16* __restrict__ h, h16* __restrict__ rqr, h16* __restrict__ rkr, h16* __restrict__ nqr, h16* __restrict__ ksR, h16* __restrict__ kwR, const float* __restrict__ cosr, const float* __restrict__ sinr,
                                       const float* __restrict__ cosn, const float* __restrict__ sinn, int m, int j) {
    const h16* hr = h + (size_t)m * INP; const int bb = m >> 13, t = m & (T - 1);
    {   const int hd = j >> 6, jj = j & 63; const float c = cosr[(size_t)m * 64 + jj], s = sinr[(size_t)m * 64 + jj]; const size_t ro = ((size_t)(bb * 4 + hd) * T + t) * 128;
        const int o1 = hd * 128 + jj, o2 = o1 + 64;
        const float q1 = (float)hr[C_RQ + o1], q2 = (float)hr[C_RQ + o2];
        rqr[ro + jj] = (h16)(q1 * c - q2 * s); rqr[ro + jj + 64] = (h16)(q2 * c + q1 * s);
        const float k1 = (float)hr[C_RK + o1], k2 = (float)hr[C_RK + o2]; const float sc = 0.08838834764831845f;
        rkr[ro + jj] = (h16)((k1 * c - k2 * s) * sc); rkr[ro + jj + 64] = (h16)((k2 * c + k1 * s) * sc);
    }
    if (j < 64 + 16 + 16) {
        const int jj = j & 7; const float c = cosn[(size_t)m * 8 + jj], s = sinn[(size_t)m * 8 + jj];
        if (j < 64) { const int hd = j >> 3; const int o1 = hd * 64 + jj, o2 = o1 + 8;
            const float q1 = (float)hr[C_NQ + o1], q2 = (float)hr[C_NQ + o2];
            nqr[(size_t)m * 512 + o1] = (h16)(q1 * c - q2 * s); nqr[(size_t)m * 512 + o2] = (h16)(q2 * c + q1 * s);
        } else { const int jx = j - 64; const int which = jx >> 4, g = (jx >> 3) & 1; const int base = (which ? C_NKW : C_NKS) + g * 64 + jj;
            const float k1 = (float)hr[base], k2 = (float)hr[base + 8];
            h16* dst = (which ? kwR : ksR) + (((size_t)((bb * 2 + g) * 128 + (t >> 6)) * 64 + (t & 63)) * 64); dst[jj] = (h16)(k1 * c - k2 * s); dst[jj + 8] = (h16)(k2 * c + k1 * s); }
    }
    if (j >= 128 && j < 128 + 96) { const int jx = j - 128; const int which = jx / 48, r = jx % 48, g = r / 24, d = 16 + 2 * (r % 24);
        const int base = (which ? C_NKW : C_NKS) + g * 64 + d; h16* dst = (which ? kwR : ksR) + (((size_t)((bb * 2 + g) * 128 + (t >> 6)) * 64 + (t & 63)) * 64);
        dst[d] = hr[base]; dst[d + 1] = hr[base + 1]; }
    for (int i = j; i < 8 * 48; i += 256) { const int hd = i / 48, d = 16 + i % 48; nqr[(size_t)m * 512 + hd * 64 + d] = hr[C_NQ + hd * 64 + d]; }
}
__device__ __forceinline__ void b_rtrans(const Params& p, const h16* __restrict__ h, h16* __restrict__ rvT, h16* __restrict__ rkzT, const float* __restrict__ cosr, const float* __restrict__ sinr, int item, h16* sl, int lt) {
    int id = item; const int tt = id & 127; id >>= 7; const int hd = id & 3; const int b = id >> 2; const int bh = b * 4 + hd; const float lg = p.lg[hd];
    for (int i = lt; i < 64 * 128; i += 256) { const int t = i >> 7, e = i & 127; sl[t * 130 + e] = h[(size_t)(b * T + tt * 64 + t) * INP + C_RV + hd * 128 + e]; }
    __syncthreads();
    for (int i = lt; i < 64 * 128; i += 256) { const int e = i >> 6, t = i & 63; rvT[((size_t)(bh * 64 + (tt >> 1)) * 128 + e) * 128 + (tt & 1) * 64 + t] = sl[t * 130 + e]; }
    __syncthreads();
    for (int i = lt; i < 64 * 64; i += 256) { const int t = i >> 6, jj = i & 63; const size_t m = (size_t)b * T + tt * 64 + t;
        const float c = cosr[m * 64 + jj], s = sinr[m * 64 + jj]; const float k1 = (float)h[m * INP + C_RK + hd * 128 + jj], k2 = (float)h[m * INP + C_RK + hd * 128 + jj + 64];
        const float z = 0.08838834764831845f * __expf(lg * (float)(127 - ((tt * 64 + t) & 127)));
        sl[t * 130 + jj] = (h16)((k1 * c - k2 * s) * z); sl[t * 130 + jj + 64] = (h16)((k2 * c + k1 * s) * z); }
    __syncthreads();
    for (int i = lt; i < 64 * 128; i += 256) { const int d = i >> 6, t = i & 63; rkzT[((size_t)(bh * 64 + (tt >> 1)) * 128 + d) * 128 + (tt & 1) * 64 + t] = sl[t * 130 + d]; }
    __syncthreads();
}
__device__ __forceinline__ void b_mvtrans(const h16* __restrict__ kvm, h16* __restrict__ kvmVT, h16* __restrict__ kx, int item, h16* sl, int lt) {
    int id = item; const int kt = id & 3; id >>= 2; const int dtl = id & 3; id >>= 2; const int hh = id & 3; const int b = id >> 2;
    for (int i = lt; i < 64 * 64; i += 256) { const int k = i >> 6, d = i & 63; sl[k * 66 + d] = kvm[(size_t)(b * MEML + kt * 64 + k) * 2048 + 1024 + hh * 256 + dtl * 64 + d];
        kx[((size_t)(b * 4 + hh) * MEML + kt * 64 + k) * 256 + dtl * 64 + d] = kvm[(size_t)(b * MEML + kt * 64 + k) * 2048 + hh * 256 + dtl * 64 + d]; }
    __syncthreads();
    for (int i = lt; i < 64 * 64; i += 256) { const int d = i >> 6, k = i & 63; kvmVT[(size_t)((b * 4 + hh) * 256 + dtl * 64 + d) * MEML + kt * 64 + k] = sl[k * 66 + d]; }
    __syncthreads();
}

struct CmpSched {
    const char* hbase; const unsigned* cmpoff; const char* Wc1T; int c;
    __device__ bool next(int i, pg8::Unit& u) const {
        if (i > 0 || c >= 32) return false; const int kv = c >> 4, rt = c & 15;
        u.pm = kv * 16 + rt; u.pn = 0; u.A = hbase + (size_t)(kv ? C_NVC : C_NKC) * 2; u.gat = cmpoff + rt * 256; u.B = Wc1T + (size_t)kv * 256 * 2048 * 2; return true; }
};
__device__ __forceinline__ void b_cmp2(const Params& p, const h16* __restrict__ hid, h16* __restrict__ kcmp, h16* __restrict__ vcmpT) {
    const int lane = tidx() & 63;
    for (int r = blockIdx.x * 8 + (tidx() >> 6); r < 2 * 4096; r += gridDim.x * 8) {
        const int kv = r >> 12, rr = r & 4095, g = rr & 1, c = (rr >> 1) & 511, b = rr >> 10;
        const float* w2 = kv ? p.w2v : p.w2k; const h16* hr = hid + (size_t)r * 256; float acc = 0.f;
        for (int j = 0; j < 256; j += 8) { const h16x8 hv = *(const h16x8*)(hr + j);
#pragma unroll
            for (int x = 0; x < 8; ++x) acc += (float)hv[x] * w2[(j + x) * 64 + lane]; }
        if (c == 511) acc = 0.f;
        if (kv == 0) kcmp[((size_t)(b * 2 + g) * 512 + c) * 64 + lane] = (h16)acc;
        else vcmpT[(((size_t)(b * 2 + g) * 8 + (c >> 6)) * 64 + lane) * 64 + (c & 63)] = (h16)acc;
    }
}
__device__ __forceinline__ void b_vtrans(const h16* __restrict__ h, h16* __restrict__ vsT, h16* __restrict__ vwT, int item, h16* sl, int lt) {
    int id = item; const int tt = id & 127; id >>= 7; const int g = id & 1; id >>= 1; const int b = id & 3; const int which = id >> 2;
    const int col = (which ? C_NVW : C_NVS) + g * 64; h16* dst = (which ? vwT : vsT) + (size_t)((b * 2 + g) * 128 + tt) * 4096;
    for (int i = lt; i < 64 * 64; i += 256) { const int t = i >> 6, d = i & 63; sl[t * 66 + d] = h[(size_t)(b * T + tt * 64 + t) * INP + col + d]; }
    __syncthreads();
    for (int i = lt; i < 64 * 64; i += 256) { const int d = i >> 6, t = i & 63; dst[d * 64 + t] = sl[t * 66 + d]; }
    __syncthreads();
}

__device__ __forceinline__ void ret_kv_unit(const h16* __restrict__ rkzT, const h16* __restrict__ rvT, float* __restrict__ kvT, int chunk, int w, int lane) {
    const int i = lane & 15, kg = lane >> 4; const int bh = chunk >> 6, n = chunk & 63;
    h16x8 a[4];
#pragma unroll
    for (int ks = 0; ks < 4; ++ks) a[ks] = *(const h16x8*)(rkzT + ((size_t)chunk * 128 + 16 * w + i) * 128 + 32 * ks + 8 * kg);
#pragma unroll
    for (int et = 0; et < 8; ++et) { f32x4 acc = {0.f, 0.f, 0.f, 0.f};
#pragma unroll
        for (int ks = 0; ks < 4; ++ks) { const h16x8 bq = *(const h16x8*)(rvT + ((size_t)chunk * 128 + 16 * et + i) * 128 + 32 * ks + 8 * kg); acc = __builtin_amdgcn_mfma_f32_16x16x32_f16(a[ks], bq, acc, 0, 0, 0); }
        *(f32x4*)(kvT + ((size_t)chunk * 128 + 16 * et + i) * 128 + 16 * w + 4 * kg) = acc; }
}
__device__ __forceinline__ void b_ret_scan(const Params& p, const float* __restrict__ kvT, h16* __restrict__ prevT) {
    for (int gid = blockIdx.x * NTHR + tidx(); gid < 16 * 16384; gid += gridDim.x * NTHR) {
        const int de = gid & 16383, bh = gid >> 14; const float cd = __expf(p.lg[bh & 3] * 128.f);
        float st = 0.f;
        for (int n = 0; n < 64; ++n) { const size_t o = ((size_t)(bh * 64 + n) << 14) + de; prevT[o] = (h16)st; st = st * cd + kvT[o]; }
    }
}
__device__ __forceinline__ void ret_out_unit(const Params& p, const h16* __restrict__ h, const h16* __restrict__ rqr, const h16* __restrict__ rkr, const h16* __restrict__ rvT, const h16* __restrict__ prevT,
                                             h16* __restrict__ mix, int chunk, int w, int lane) {
    const int i = lane & 15, kg = lane >> 4; const int bh = chunk >> 6, n = chunk & 63, b = bh >> 2, hd = bh & 3; const float lg = p.lg[hd];
    const int qi = 16 * w + i; const size_t m = (size_t)b * T + n * 128 + qi;
    h16x8 qf[4];
#pragma unroll
    for (int ks = 0; ks < 4; ++ks) qf[ks] = *(const h16x8*)(rqr + ((size_t)bh * T + n * 128 + qi) * 128 + 32 * ks + 8 * kg);
    f32x4 inner[8], cross[8];
#pragma unroll
    for (int et = 0; et < 8; ++et) { inner[et] = (f32x4){0.f, 0.f, 0.f, 0.f}; cross[et] = (f32x4){0.f, 0.f, 0.f, 0.f}; }
    for (int gq = 0; gq < 2; ++gq) {
        if (64 * gq > 16 * w + 15) break;
        f32x4 s[4];
#pragma unroll
        for (int tl = 0; tl < 4; ++tl) { const int ko = 32 * (tl >> 1) + 8 * (i >> 2) + 4 * (tl & 1) + (i & 3); const h16* kp = rkr + ((size_t)bh * T + n * 128 + 64 * gq + ko) * 128 + 8 * kg;
            f32x4 acc = {0.f, 0.f, 0.f, 0.f};
#pragma unroll
            for (int ks = 0; ks < 4; ++ks) acc = __builtin_amdgcn_mfma_f32_16x16x32_f16(*(const h16x8*)(kp + 32 * ks), qf[ks], acc, 0, 0, 0);
            s[tl] = acc; }
        h16x8 pf[2];
#pragma unroll
        for (int tl = 0; tl < 4; ++tl)
#pragma unroll
            for (int r = 0; r < 4; ++r) { const int j = 64 * gq + 32 * (tl >> 1) + 8 * kg + 4 * (tl & 1) + r; const float v = (j <= qi) ? s[tl][r] * __expf(lg * (float)(qi - j)) : 0.f; pf[tl >> 1][4 * (tl & 1) + r] = (h16)v; }
#pragma unroll
        for (int et = 0; et < 8; ++et)
#pragma unroll
            for (int s2 = 0; s2 < 2; ++s2) { const h16x8 a = *(const h16x8*)(rvT + ((size_t)chunk * 128 + 16 * et + i) * 128 + 64 * gq + 32 * s2 + 8 * kg); inner[et] = __builtin_amdgcn_mfma_f32_16x16x32_f16(a, pf[s2], inner[et], 0, 0, 0); }
    }
#pragma unroll
    for (int et = 0; et < 8; ++et)
#pragma unroll
        for (int ks = 0; ks < 4; ++ks) { const h16x8 a = *(const h16x8*)(prevT + ((size_t)chunk * 128 + 16 * et + i) * 128 + 32 * ks + 8 * kg); cross[et] = __builtin_amdgcn_mfma_f32_16x16x32_f16(a, qf[ks], cross[et], 0, 0, 0); }
    const float xi = __expf(lg * (float)(qi + 1));
    float sm = 0.f;
#pragma unroll
    for (int et = 0; et < 8; ++et) { inner[et] = inner[et] + cross[et] * xi; sm += (inner[et][0] + inner[et][1]) + (inner[et][2] + inner[et][3]); }
    sm += __shfl_xor(sm, 16); sm += __shfl_xor(sm, 32);
    const float mu = sm * (1.f / 128.f); float sq = 0.f;
#pragma unroll
    for (int et = 0; et < 8; ++et) { inner[et] = inner[et] - mu; sq += (inner[et][0] * inner[et][0] + inner[et][1] * inner[et][1]) + (inner[et][2] * inner[et][2] + inner[et][3] * inner[et][3]); }
    sq += __shfl_xor(sq, 16); sq += __shfl_xor(sq, 32);
    const float rstd = rsqrtf(sq * (1.f / 128.f) + LN_EPS);
#pragma unroll
    for (int et = 0; et < 8; ++et) { const int e = 16 * et + 4 * kg; const h16x4 gv = *(const h16x4*)(h + m * INP + C_RG + hd * 128 + e);
        f32x4 o;
#pragma unroll
        for (int r = 0; r < 4; ++r) o[r] = siluf((float)gv[r]) * inner[et][r] * rstd;
        *(h16x4*)(mix + m * D + hd * 128 + e) = __builtin_convertvector(o, h16x4); }
}

struct AttSt { float m, l; f32x4 o[4]; };
struct KFrag { h16x8 a[4][2]; };
struct VFrag { h16x8 a[4][2]; };
__device__ __forceinline__ void ldk(KFrag& k, const h16* __restrict__ Kb, int pitchK, int i, int kg) {
#pragma unroll
    for (int tl = 0; tl < 4; ++tl) { const int ko = 32 * (tl >> 1) + 8 * (i >> 2) + 4 * (tl & 1) + (i & 3); const h16* kp = Kb + (size_t)ko * pitchK + 8 * kg;
        k.a[tl][0] = *(const h16x8*)kp; k.a[tl][1] = *(const h16x8*)(kp + 32); }
}
__device__ __forceinline__ void ldv(VFrag& v, const h16* __restrict__ VTb, int vstride, int i, int kg) {
#pragma unroll
    for (int dt = 0; dt < 4; ++dt)
#pragma unroll
        for (int s2 = 0; s2 < 2; ++s2) v.a[dt][s2] = *(const h16x8*)(VTb + (size_t)(16 * dt + i) * vstride + 32 * s2 + 8 * kg);
}
__device__ __forceinline__ float xmax4(float v) {
    auto a = __builtin_amdgcn_permlane16_swap(__float_as_uint(v), __float_as_uint(v), false, false); v = fmaxf(__uint_as_float(a[0]), __uint_as_float(a[1]));
    auto c = __builtin_amdgcn_permlane32_swap(__float_as_uint(v), __float_as_uint(v), false, false); return fmaxf(__uint_as_float(c[0]), __uint_as_float(c[1])); }
__device__ __forceinline__ float xsum4(float v) {
    auto a = __builtin_amdgcn_permlane16_swap(__float_as_uint(v), __float_as_uint(v), false, false); v = __uint_as_float(a[0]) + __uint_as_float(a[1]);
    auto c = __builtin_amdgcn_permlane32_swap(__float_as_uint(v), __float_as_uint(v), false, false); return __uint_as_float(c[0]) + __uint_as_float(c[1]); }
constexpr float ATT_C2 = 0.125f * 1.4426950408889634f;
template <bool MASKED, class MaskF>
__device__ __forceinline__ void att_scores(f32x4 (&s)[4], const KFrag& k, const h16x8 (&qf)[2], int kg, MaskF valid) {
#pragma unroll
    for (int tl = 0; tl < 4; ++tl) { f32x4 z = {0.f, 0.f, 0.f, 0.f}; z = __builtin_amdgcn_mfma_f32_16x16x32_f16(k.a[tl][0], qf[0], z, 0, 0, 0); s[tl] = __builtin_amdgcn_mfma_f32_16x16x32_f16(k.a[tl][1], qf[1], z, 0, 0, 0); }
    if (MASKED) {
#pragma unroll
        for (int tl = 0; tl < 4; ++tl)
#pragma unroll
            for (int r = 0; r < 4; ++r) { const int ko = 32 * (tl >> 1) + 8 * kg + 4 * (tl & 1) + r; s[tl][r] = valid(ko) ? s[tl][r] : -INFINITY; }
    }
}
__device__ __forceinline__ float att_rowmax(const f32x4 (&s)[4]) {
    float mx = fmaxf(fmaxf(s[0][0], s[0][1]), fmaxf(s[0][2], s[0][3]));
#pragma unroll
    for (int tl = 1; tl < 4; ++tl) mx = fmaxf(mx, fmaxf(fmaxf(s[tl][0], s[tl][1]), fmaxf(s[tl][2], s[tl][3])));
    return xmax4(mx);
}
__device__ __forceinline__ void att_pv(f32x4 (&o)[4], const f32x4 (&pv)[4], const VFrag& v) {
    h16x8 pf[2];
#pragma unroll
    for (int s2 = 0; s2 < 2; ++s2)
#pragma unroll
        for (int j = 0; j < 8; ++j) pf[s2][j] = (h16)pv[2 * s2 + (j >> 2)][j & 3];
#pragma unroll
    for (int dt = 0; dt < 4; ++dt)
#pragma unroll
        for (int s2 = 0; s2 < 2; ++s2) o[dt] = __builtin_amdgcn_mfma_f32_16x16x32_f16(v.a[dt][s2], pf[s2], o[dt], 0, 0, 0);
}
template <bool MASKED, class MaskF>
__device__ __forceinline__ void att_tile(AttSt& st, const KFrag& k, const VFrag& v, const h16x8 (&qf)[2], int kg, bool rowok, MaskF valid) {
    f32x4 s[4]; att_scores<MASKED>(s, k, qf, kg, valid);
    const float mx = rowok ? att_rowmax(s) * ATT_C2 : -INFINITY;
    const float mn = fmaxf(st.m, mx);
    if (__any(mn > st.m)) { const float alpha = __builtin_amdgcn_exp2f(st.m - mn); st.m = mn; st.l *= alpha;
#pragma unroll
        for (int dt = 0; dt < 4; ++dt) st.o[dt] = st.o[dt] * alpha; }
    const float mneg = rowok ? -mn : -INFINITY;
    float ps0 = 0.f, ps1 = 0.f;
#pragma unroll
    for (int tl = 0; tl < 4; ++tl) {
#pragma unroll
        for (int r = 0; r < 4; ++r) s[tl][r] = __builtin_amdgcn_exp2f(__builtin_fmaf(s[tl][r], ATT_C2, mneg));
        ps0 += s[tl][0] + s[tl][1]; ps1 += s[tl][2] + s[tl][3]; }
    st.l += ps0 + ps1;
    att_pv(st.o, s, v);
}
constexpr int NSA_NSLOT = 5, NSA_RING = 0, NSA_IMP = NSA_NSLOT * 16384, NSA_MSK = NSA_IMP + 32768, NSA_LIST = NSA_MSK + 256;
__device__ __forceinline__ void ldk_lds(KFrag& k, LAS const unsigned char* slot, int ko0, int ko1) {
#pragma unroll
    for (int tl = 0; tl < 4; ++tl) { const int o = (32 * (tl >> 1) + 4 * (tl & 1)) * 128; k.a[tl][0] = *(LAS const h16x8*)(slot + o + ko0); k.a[tl][1] = *(LAS const h16x8*)(slot + o + ko1); }
}
__device__ __forceinline__ void ldv_lds(VFrag& v, LAS const unsigned char* slot, int vo0, int vo1) {
#pragma unroll
    for (int dt = 0; dt < 4; ++dt) { v.a[dt][0] = *(LAS const h16x8*)(slot + 8192 + dt * 2048 + vo0); v.a[dt][1] = *(LAS const h16x8*)(slot + 8192 + dt * 2048 + vo1); }
}
#define NSA_WAITV(n) asm volatile("s_waitcnt vmcnt(" #n ")" ::: "memory")
#define NSA_BAR() do { asm volatile("s_waitcnt lgkmcnt(0)" ::: "memory"); __builtin_amdgcn_s_barrier(); asm volatile("" ::: "memory"); } while (0)
template <int LPT, class IssueF, class CompF>
__device__ __forceinline__ void nsa_stream(int n, LAS unsigned char* dmaw, LAS unsigned char* ring, IssueF issue, CompF comp) {
#pragma unroll
    for (int j = 0; j < NSA_NSLOT - 1; ++j) if (j < n) issue(j, (LAS unsigned*)(dmaw + j * 16384));
    int st = 0, si = (NSA_NSLOT - 1) * 16384;
    for (int t = 0; t < n; ++t) {
        const int ahead = n - 1 - t;
        if (ahead >= 3) { if (LPT == 2) NSA_WAITV(6); else NSA_WAITV(3); }
        else if (ahead == 2) { if (LPT == 2) NSA_WAITV(4); else NSA_WAITV(2); }
        else if (ahead == 1) { if (LPT == 2) NSA_WAITV(2); else NSA_WAITV(1); }
        else NSA_WAITV(0);
        NSA_BAR();
        if (t + NSA_NSLOT - 1 < n) issue(t + NSA_NSLOT - 1, (LAS unsigned*)(dmaw + si));
        comp(t, (LAS const unsigned char*)(ring + st));
        st = (st == (NSA_NSLOT - 1) * 16384) ? 0 : st + 16384; si = (si == (NSA_NSLOT - 1) * 16384) ? 0 : si + 16384; }
    NSA_BAR();
}
__device__ __forceinline__ void nsa_block_unit(const h16* __restrict__ h, const h16* __restrict__ nqr, const h16* __restrict__ kcmp, const h16* __restrict__ vcmpT, const h16* __restrict__ vsT, const h16* __restrict__ vwT,
                                               const h16* __restrict__ ksR, const h16* __restrict__ kwR, h16* __restrict__ mix, int b, int g, int T0, LAS unsigned char* lds, int wv, int lane) {
    const int i = lane & 15, kg = lane >> 4, tt = i & 3, hh = i >> 2;
    const int t0 = T0 + 4 * wv, trow = t0 + tt; const size_t mrow = (size_t)b * T + trow;
    const int q = wv * 64 + lane, qrow = q >> 3, qch = q & 7;
    const int ksrc = qrow * 128 + ((qch ^ (((qrow >> 1) & 1) | (((qrow >> 3) & 3) << 1))) << 4), vsrc = qrow * 128 + ((qch ^ ((qrow >> 1) & 7)) << 4);
    const int gki = ((i >> 1) & 1) | ((i >> 2) << 1), gvi = (i >> 1) & 7;
    const int ko0 = (8 * (i >> 2) + (i & 3)) * 128 + ((kg ^ gki) << 4), ko1 = (8 * (i >> 2) + (i & 3)) * 128 + (((kg + 4) ^ gki) << 4);
    const int vo0 = i * 128 + ((kg ^ gvi) << 4), vo1 = i * 128 + (((kg + 4) ^ gvi) << 4);
    LAS unsigned char* ring = lds + NSA_RING; LAS unsigned char* dmaw = ring + wv * 1024;
    LAS float* impA = (LAS float*)(lds + NSA_IMP + wv * 4096); LAS float* impL = impA + 512;
    h16x8 qf[2], qrf[2];
    { const h16* qp = h + mrow * INP + C_NQ + (g * 4 + hh) * 64 + 8 * kg; qf[0] = *(const h16x8*)qp; qf[1] = *(const h16x8*)(qp + 32);
      const h16* qrp = nqr + mrow * 512 + (g * 4 + hh) * 64 + 8 * kg; qrf[0] = *(const h16x8*)qrp; qrf[1] = *(const h16x8*)(qrp + 32); }
    const h16* gp = h + mrow * INP + C_NG + (g * 4 + hh) * 3; const float gt0 = (float)gp[0], gt1 = (float)gp[1], gt2 = (float)gp[2];
    for (int x = lane; x < 1024; x += 64) impA[x] = 0.f;
    NSA_WAITV(0);
#define GLDS16(gsrc, ldst) __builtin_amdgcn_global_load_lds((const unsigned*)(gsrc), (ldst), 16, 0, 0)
    const int ncv_row = trow >= 31 ? ((trow - 31) >> 4) + 1 : 0;
    const int ncv_blk = (T0 + 31 >= 31) ? ((T0 + 31 - 31) >> 4) + 1 : 0;
    const int ncv_min = T0 >= 31 ? ((T0 - 31) >> 4) + 1 : 0;
    const int nct = (ncv_blk + 63) >> 6;
    const unsigned char* Kc = (const unsigned char*)(kcmp + (size_t)(b * 2 + g) * 512 * 64); const unsigned char* Vc = (const unsigned char*)(vcmpT + (size_t)(b * 2 + g) * 8 * 4096);
    float m = -1e30f, l = 0.f;
    f32x4 oc[4];
    float linv = 0.f;
    REPS(501) {
    m = -1e30f; l = 0.f;
#pragma unroll
    for (int dt = 0; dt < 4; ++dt) oc[dt] = (f32x4){0.f, 0.f, 0.f, 0.f};
    nsa_stream<1>(nct, dmaw, ring, [&](int j, LAS unsigned* dk) { GLDS16(Kc + (size_t)j * 8192 + ksrc, dk); }, [&](int j, LAS const unsigned char* slot) {
        KFrag kf; ldk_lds(kf, slot, ko0, ko1);
        f32x4 s[4];
        if (64 * j + 63 < ncv_min) att_scores<false>(s, kf, qf, kg, [&](int) { return true; }); else att_scores<true>(s, kf, qf, kg, [&](int ko) { return j * 64 + ko < ncv_row; });
        const float mx = att_rowmax(s) * ATT_C2;
        const float mn = fmaxf(m, mx); float ps0 = 0.f, ps1 = 0.f;
        _Pragma("unroll") for (int tl = 0; tl < 4; ++tl) { ps0 += __builtin_amdgcn_exp2f(__builtin_fmaf(s[tl][0], ATT_C2, -mn)) + __builtin_amdgcn_exp2f(__builtin_fmaf(s[tl][1], ATT_C2, -mn));
                                                          ps1 += __builtin_amdgcn_exp2f(__builtin_fmaf(s[tl][2], ATT_C2, -mn)) + __builtin_amdgcn_exp2f(__builtin_fmaf(s[tl][3], ATT_C2, -mn)); }
        l = l * __builtin_amdgcn_exp2f(m - mn) + (ps0 + ps1); m = mn; });
    l = xsum4(l);
    linv = l > 0.f ? 1.f / l : 0.f;
    nsa_stream<2>(nct, dmaw, ring, [&](int j, LAS unsigned* dk) { GLDS16(Kc + (size_t)j * 8192 + ksrc, dk); GLDS16(Vc + (size_t)j * 8192 + vsrc, (LAS unsigned*)((LAS unsigned char*)dk + 8192)); }, [&](int j, LAS const unsigned char* slot) {
        KFrag kf; ldk_lds(kf, slot, ko0, ko1); VFrag vf; ldv_lds(vf, slot, vo0, vo1);
        f32x4 s[4];
        if (64 * j + 63 < ncv_min) att_scores<false>(s, kf, qf, kg, [&](int) { return true; }); else att_scores<true>(s, kf, qf, kg, [&](int ko) { return j * 64 + ko < ncv_row; });
        _Pragma("unroll") for (int tl = 0; tl < 4; ++tl) {
            _Pragma("unroll") for (int r = 0; r < 4; ++r) s[tl][r] = __builtin_amdgcn_exp2f(__builtin_fmaf(s[tl][r], ATT_C2, -m)) * linv;
            float A = (s[tl][0] + s[tl][1]) + (s[tl][2] + s[tl][3]), L = s[tl][3];
            A += __shfl_xor(A, 4); A += __shfl_xor(A, 8); L += __shfl_xor(L, 4); L += __shfl_xor(L, 8);
            if (hh == 0) { const int u = j * 16 + 8 * (tl >> 1) + 2 * kg + (tl & 1); impA[tt * 128 + u] = A; impL[tt * 128 + u] = L; } }
        att_pv(oc, s, vf); });
    }
    const int cur = T0 >> 6;
    AttSt sw;
    REPS(504) {
    sw.m = -1e30f; sw.l = 0.f;
#pragma unroll
    for (int dt = 0; dt < 4; ++dt) sw.o[dt] = (f32x4){0.f, 0.f, 0.f, 0.f};
    {
        const unsigned char* Kw = (const unsigned char*)(kwR + (size_t)((b * 2 + g) * 128) * 4096); const unsigned char* Vw = (const unsigned char*)(vwT + (size_t)((b * 2 + g) * 128) * 4096);
        const int s0w = (T0 >= 511 ? (T0 - 511) >> 6 : 0);
        nsa_stream<2>(cur - s0w + 1, dmaw, ring, [&](int j, LAS unsigned* dk) { GLDS16(Kw + (size_t)(s0w + j) * 8192 + ksrc, dk); GLDS16(Vw + (size_t)(s0w + j) * 8192 + vsrc, (LAS unsigned*)((LAS unsigned char*)dk + 8192)); }, [&](int j, LAS const unsigned char* slot) {
            KFrag kf; ldk_lds(kf, slot, ko0, ko1); VFrag vf; ldv_lds(vf, slot, vo0, vo1); const int s = s0w + j;
            if (s > s0w + 1 && s < cur) att_tile<false>(sw, kf, vf, qrf, kg, true, [&](int) { return true; });
            else att_tile<true>(sw, kf, vf, qrf, kg, true, [&](int ko) { const int kp = 64 * s + ko; return kp <= trow && kp >= trow - 511; }); });
    }
    }
    unsigned long long mylo, myhi, anylo, anyhi;
    if (cur <= 15) { mylo = anylo = (1ull << (cur + 1)) - 1ull; myhi = anyhi = 0ull; }
    else {
        mylo = myhi = anylo = anyhi = 0ull;
        const unsigned long long flo = 1ull | (cur < 64 ? (1ull << cur) : 0ull) | (cur - 1 < 64 ? (1ull << (cur - 1)) : 0ull);
        const unsigned long long fhi = (cur >= 64 ? (1ull << (cur - 64)) : 0ull) | (cur - 1 >= 64 ? (1ull << (cur - 65)) : 0ull);
        const unsigned long long lmask = (1ull << lane) - 1ull;
        for (int tk = 0; tk < 4; ++tk) {
            const int s0 = lane, s1 = lane + 64;
            const float v0 = impA[tk * 128 + s0] + (s0 > 0 ? impL[tk * 128 + s0 - 1] : 0.f), v1 = impA[tk * 128 + s1] + impL[tk * 128 + s1 - 1];
            const unsigned b0 = (s0 >= 1 && s0 <= cur - 2) ? __float_as_uint(v0) + 1u : 0u, b1 = (s1 <= cur - 2) ? __float_as_uint(v1) + 1u : 0u;
            unsigned Tq = 0u;
            for (int bit = 30; bit >= 0; --bit) { const unsigned T2 = Tq | (1u << bit);
                const int c = __popcll(__ballot(b0 >= T2)) + __popcll(__ballot(b1 >= T2)); if (c >= 13) Tq = T2; }
            const unsigned long long gtlo = __ballot(b0 > Tq), gthi = __ballot(b1 > Tq), eqlo = __ballot(b0 == Tq), eqhi = __ballot(b1 == Tq);
            const int need = 13 - (__popcll(gtlo) + __popcll(gthi));
            const bool t0q = (b0 == Tq) && (__popcll(eqlo & lmask) < need), t1q = (b1 == Tq) && (__popcll(eqlo) + __popcll(eqhi & lmask) < need);
            const unsigned long long lo = gtlo | __ballot(t0q) | flo, hi = gthi | __ballot(t1q) | fhi;
            anylo |= lo; anyhi |= hi; if (tt == tk) { mylo = lo; myhi = hi; }
        }
    }
    LAS unsigned long long* msk = (LAS unsigned long long*)(lds + NSA_MSK); LAS unsigned char* lst = lds + NSA_LIST; LAS int* nlst = (LAS int*)(lds + NSA_LIST + 128);
    if (lane == 0) { msk[2 * wv] = anylo; msk[2 * wv + 1] = anyhi; }
    NSA_BAR();
    if (wv == 0) {
        unsigned long long ulo = 0ull, uhi = 0ull;
#pragma unroll
        for (int w2 = 0; w2 < 8; ++w2) { ulo |= msk[2 * w2]; uhi |= msk[2 * w2 + 1]; }
        const unsigned long long lmask = (1ull << lane) - 1ull; const int nlo = __popcll(ulo);
        if ((ulo >> lane) & 1ull) lst[__popcll(ulo & lmask)] = (unsigned char)lane;
        if ((uhi >> lane) & 1ull) lst[nlo + __popcll(uhi & lmask)] = (unsigned char)(64 + lane);
        if (lane == 0) nlst[0] = nlo + __popcll(uhi);
    }
    NSA_BAR();
    const int nsel = nlst[0];
    AttSt ss;
    REPS(503) {
    ss.m = -1e30f; ss.l = 0.f;
#pragma unroll
    for (int dt = 0; dt < 4; ++dt) ss.o[dt] = (f32x4){0.f, 0.f, 0.f, 0.f};
    {
        const unsigned char* Ks = (const unsigned char*)(ksR + (size_t)((b * 2 + g) * 128) * 4096); const unsigned char* Vs = (const unsigned char*)(vsT + (size_t)((b * 2 + g) * 128) * 4096);
        nsa_stream<2>(nsel, dmaw, ring, [&](int j, LAS unsigned* dk) { const int sj = lst[j]; GLDS16(Ks + (size_t)sj * 8192 + ksrc, dk); GLDS16(Vs + (size_t)sj * 8192 + vsrc, (LAS unsigned*)((LAS unsigned char*)dk + 8192)); }, [&](int j, LAS const unsigned char* slot) {
            const int s = lst[j];
            if ((((s < 64 ? anylo : anyhi) >> (s & 63)) & 1ull) != 0ull) {
                KFrag kf; ldk_lds(kf, slot, ko0, ko1); VFrag vf; ldv_lds(vf, slot, vo0, vo1);
                const bool mybit = (((s < 64 ? mylo : myhi) >> (s & 63)) & 1ull) != 0ull;
                if (s < cur) att_tile<false>(ss, kf, vf, qrf, kg, mybit, [&](int) { return true; });
                else att_tile<true>(ss, kf, vf, qrf, kg, mybit, [&](int ko) { return 64 * s + ko <= trow; }); } });
    }
    }
    const float ls = xsum4(ss.l), lw = xsum4(sw.l);
    const float g0 = sigmf(gt0), g1 = sigmf(gt1) / ls, g2 = sigmf(gt2) / lw;
#pragma unroll
    for (int dt = 0; dt < 4; ++dt) { const f32x4 o = oc[dt] * g0 + ss.o[dt] * g1 + sw.o[dt] * g2;
        *(h16x4*)(mix + mrow * D + 512 + (g * 4 + hh) * 64 + 16 * dt + 4 * kg) = __builtin_convertvector(o, h16x4); }
#undef GLDS16
}

__device__ __forceinline__ void b_ln(const float* __restrict__ in, const float* __restrict__ gam, const float* __restrict__ bet, float* __restrict__ o32, h16* __restrict__ o16) {
    const int lane = tidx() & 63;
    for (int row = blockIdx.x * 8 + (tidx() >> 6); row < M; row += gridDim.x * 8) {
        const f32x4* xr = (const f32x4*)(in + (size_t)row * D) + lane;
        f32x4 v[4]; float s = 0.f;
#pragma unroll
        for (int j = 0; j < 4; ++j) { v[j] = xr[64 * j]; s += (v[j][0] + v[j][1]) + (v[j][2] + v[j][3]); }
        const float mean = wave_sum(s) * (1.f / D); float s2 = 0.f;
#pragma unroll
        for (int j = 0; j < 4; ++j) { v[j] = v[j] - mean; s2 += (v[j][0] * v[j][0] + v[j][1] * v[j][1]) + (v[j][2] * v[j][2] + v[j][3] * v[j][3]); }
        const float rstd = rsqrtf(wave_sum(s2) * (1.f / D) + LN_EPS);
#pragma unroll
        for (int j = 0; j < 4; ++j) { const f32x4 gg = ((const f32x4*)gam)[lane + 64 * j], bb = ((const f32x4*)bet)[lane + 64 * j]; const f32x4 o = v[j] * rstd * gg + bb;
            ((f32x4*)(o32 + (size_t)row * D))[lane + 64 * j] = o;
            if (o16) ((h16x4*)(o16 + (size_t)row * D))[lane + 64 * j] = __builtin_convertvector(o, h16x4); }
    }
}

__device__ __forceinline__ void xattn_unit(const h16* __restrict__ qx, const h16* __restrict__ kx, const h16* __restrict__ kvmVT, h16* __restrict__ ox, int m0, int hh, int lane) {
    const int i = lane & 15, kg = lane >> 4; const int b = m0 >> 13; const size_t m = (size_t)m0 + i;
    h16x8 qf[8];
#pragma unroll
    for (int ks = 0; ks < 8; ++ks) qf[ks] = *(const h16x8*)(qx + m * D + hh * 256 + 32 * ks + 8 * kg);
    f32x4 o[16];
#pragma unroll
    for (int dt = 0; dt < 16; ++dt) o[dt] = (f32x4){0.f, 0.f, 0.f, 0.f};
    float mrun = -1e30f, l = 0.f;
    const h16* vb = kvmVT + (size_t)((b * 4 + hh) * 256) * MEML;
#pragma unroll 1
    for (int gq = 0; gq < 4; ++gq) {
        f32x4 s[4]; float mx = -INFINITY;
#pragma unroll
        for (int tl = 0; tl < 4; ++tl) { const int ko = 64 * gq + 32 * (tl >> 1) + 8 * (i >> 2) + 4 * (tl & 1) + (i & 3); const h16* kp = kx + ((size_t)(b * 4 + hh) * MEML + ko) * 256 + 8 * kg;
            f32x4 acc = {0.f, 0.f, 0.f, 0.f};
#pragma unroll
            for (int ks = 0; ks < 8; ++ks) acc = __builtin_amdgcn_mfma_f32_16x16x32_f16(*(const h16x8*)(kp + 32 * ks), qf[ks], acc, 0, 0, 0);
            s[tl] = acc * 0.0625f; mx = fmaxf(mx, fmaxf(fmaxf(s[tl][0], s[tl][1]), fmaxf(s[tl][2], s[tl][3]))); }
        mx = fmaxf(mx, __shfl_xor(mx, 16)); mx = fmaxf(mx, __shfl_xor(mx, 32));
        const float mn = fmaxf(mrun, mx); const float alpha = __expf(mrun - mn); mrun = mn;
        float ps = 0.f; h16x8 pf[2];
#pragma unroll
        for (int tl = 0; tl < 4; ++tl)
#pragma unroll
            for (int r = 0; r < 4; ++r) { const float pe = __expf(s[tl][r] - mn); ps += pe; pf[tl >> 1][4 * (tl & 1) + r] = (h16)pe; }
        l = l * alpha + ps;
#pragma unroll
        for (int dt = 0; dt < 16; ++dt) { f32x4 acc = o[dt] * alpha;
#pragma unroll
            for (int s2 = 0; s2 < 2; ++s2) acc = __builtin_amdgcn_mfma_f32_16x16x32_f16(*(const h16x8*)(vb + (size_t)(16 * dt + i) * MEML + 64 * gq + 32 * s2 + 8 * kg), pf[s2], acc, 0, 0, 0);
            o[dt] = acc; }
    }
    l += __shfl_xor(l, 16); l += __shfl_xor(l, 32); const float linv = 1.f / l;
#pragma unroll
    for (int dt = 0; dt < 16; ++dt) { const f32x4 acc = o[dt] * linv; *(h16x4*)(ox + m * D + hh * 256 + 16 * dt + 4 * kg) = __builtin_convertvector(acc, h16x4); }
}

__device__ __forceinline__ void route_token(float logit, int m, int lane, const float* __restrict__ rbias, int* __restrict__ tope, float* __restrict__ topw, int* __restrict__ hist) {
    const float score = 1.f / (1.f + expf(-logit)); const float biased = score + rbias[lane];
    float m1 = biased; m1 = fmaxf(m1, __shfl_xor(m1, 1)); m1 = fmaxf(m1, __shfl_xor(m1, 2)); m1 = fmaxf(m1, __shfl_xor(m1, 4));
    int am = (biased == m1) ? lane : 999; am = min(am, __shfl_xor(am, 1)); am = min(am, __shfl_xor(am, 2)); am = min(am, __shfl_xor(am, 4));
    float m2 = (lane == am) ? -INFINITY : biased; m2 = fmaxf(m2, __shfl_xor(m2, 1)); m2 = fmaxf(m2, __shfl_xor(m2, 2)); m2 = fmaxf(m2, __shfl_xor(m2, 4));
    const float gs = m1 + m2;
    int cnt = 0;
#pragma unroll
    for (int gq = 0; gq < 8; ++gq) { const float o = __shfl(gs, gq * 8); cnt += (o > gs) ? 1 : 0; }
    const float masked = (cnt <= 3) ? biased : NEGF;
    int rank = 0;
    for (int e2 = 0; e2 < 64; ++e2) { const float o = __shfl(masked, e2); rank += (o > masked || (o == masked && e2 < lane)) ? 1 : 0; }
    const bool selq = rank < 8;
    const float wsum = wave_sum(selq ? score : 0.f);
    if (selq) { tope[(size_t)m * 8 + rank] = lane; topw[(size_t)m * 8 + rank] = score / wsum * 2.5f; atomicAdd(hist + (m >> 13) * 65 + lane, 1); }
}
__device__ __forceinline__ void router_unit(const Params& p, const float* __restrict__ pre, h16* __restrict__ x2h, const h16* __restrict__ WrTh, const h16* __restrict__ WrTl, int* __restrict__ tope, float* __restrict__ topw,
                                            int* __restrict__ hist, int m0, LAS float* lg, int lane) {
    const int i = lane & 15, kg = lane >> 4;
    const float* xr = pre + (size_t)(m0 + i) * D + 8 * kg;
    float s1 = 0.f, s2 = 0.f;
#pragma unroll 4
    for (int ks = 0; ks < 32; ++ks) { const f32x4 x0 = *(const f32x4*)(xr + 32 * ks), x1 = *(const f32x4*)(xr + 32 * ks + 4);
        s1 += (x0[0] + x0[1]) + (x0[2] + x0[3]) + (x1[0] + x1[1]) + (x1[2] + x1[3]);
        s2 += (x0[0] * x0[0] + x0[1] * x0[1]) + (x0[2] * x0[2] + x0[3] * x0[3]) + (x1[0] * x1[0] + x1[1] * x1[1]) + (x1[2] * x1[2] + x1[3] * x1[3]); }
    s1 = xsum4(s1); s2 = xsum4(s2);
    const float mean = s1 * (1.f / D); const float rstd = rsqrtf(fmaxf(s2 * (1.f / D) - mean * mean, 0.f) + LN_EPS);
    f32x4 am_[4], ac_[4];
#pragma unroll
    for (int et = 0; et < 4; ++et) { am_[et] = (f32x4){0.f, 0.f, 0.f, 0.f}; ac_[et] = (f32x4){0.f, 0.f, 0.f, 0.f}; }
    h16* xo = x2h + (size_t)(m0 + i) * D + 8 * kg;
#pragma unroll 2
    for (int ks = 0; ks < 32; ++ks) {
        f32x4 x0 = *(const f32x4*)(xr + 32 * ks), x1 = *(const f32x4*)(xr + 32 * ks + 4);
        const f32x4 g0 = *(const f32x4*)(p.ln2g + 32 * ks + 8 * kg), g1 = *(const f32x4*)(p.ln2g + 32 * ks + 8 * kg + 4), b0 = *(const f32x4*)(p.ln2b + 32 * ks + 8 * kg), b1 = *(const f32x4*)(p.ln2b + 32 * ks + 8 * kg + 4);
        x0 = (x0 - mean) * rstd * g0 + b0; x1 = (x1 - mean) * rstd * g1 + b1;
        h16x8 xh, xl;
#pragma unroll
        for (int j = 0; j < 4; ++j) { xh[j] = (h16)x0[j]; xl[j] = (h16)((x0[j] - (float)xh[j]) * 2048.f); xh[4 + j] = (h16)x1[j]; xl[4 + j] = (h16)((x1[j] - (float)xh[4 + j]) * 2048.f); }
        *(h16x8*)(xo + 32 * ks) = xh;
#pragma unroll
        for (int et = 0; et < 4; ++et) { const h16x8 wh = *(const h16x8*)(WrTh + (size_t)(16 * et + i) * D + 32 * ks + 8 * kg), wl = *(const h16x8*)(WrTl + (size_t)(16 * et + i) * D + 32 * ks + 8 * kg);
            am_[et] = __builtin_amdgcn_mfma_f32_16x16x32_f16(wh, xh, am_[et], 0, 0, 0);
            ac_[et] = __builtin_amdgcn_mfma_f32_16x16x32_f16(wh, xl, ac_[et], 0, 0, 0);
            ac_[et] = __builtin_amdgcn_mfma_f32_16x16x32_f16(wl, xh, ac_[et], 0, 0, 0); }
    }
#pragma unroll
    for (int et = 0; et < 4; ++et)
#pragma unroll
        for (int r = 0; r < 4; ++r) lg[i * 64 + 16 * et + 4 * kg + r] = am_[et][r] + ac_[et][r] * (1.f / 2048.f);
    for (int tk = 0; tk < 16; ++tk) route_token(lg[tk * 64 + lane], m0 + tk, lane, p.rbias, tope, topw, hist);
}

__device__ __forceinline__ void b_moe(const Params& p, const float* __restrict__ x2, const int* __restrict__ tope, const float* __restrict__ topw, float* __restrict__ out, int m, float* sl, int tid) {
    float* xs = sl; float* hd = sl + 1024; float* red = sl + 1280;
    for (int i = tid; i < 1024; i += 256) xs[i] = x2[(size_t)m * D + i];
    __syncthreads();
    float acc[4] = {0.f, 0.f, 0.f, 0.f};
    for (int kx = 0; kx < 9; ++kx) {
        const float* G; const float* U; const float* Dn; float wt;
        if (kx < 8) { const int e = tope[(size_t)m * 8 + kx]; wt = topw[(size_t)m * 8 + kx]; G = p.w_gate + (size_t)e * D * EFF; U = p.w_up + (size_t)e * D * EFF; Dn = p.w_down + (size_t)e * EFF * D; }
        else { wt = 1.f; G = p.ws_gate; U = p.ws_up; Dn = p.ws_down; }
        float a = 0.f, u = 0.f;
        for (int k = 0; k < D; ++k) { const float xv = xs[k]; a += xv * G[(size_t)k * EFF + tid]; u += xv * U[(size_t)k * EFF + tid]; }
        hd[tid] = siluf(a) * u * wt;
        __syncthreads();
        for (int j = 0; j < EFF; ++j) { const float hv = hd[j]; const float* dr = Dn + (size_t)j * D + tid;
            acc[0] += hv * dr[0]; acc[1] += hv * dr[256]; acc[2] += hv * dr[512]; acc[3] += hv * dr[768]; }
        __syncthreads();
    }
    float v[4]; float s = 0.f;
#pragma unroll
    for (int i = 0; i < 4; ++i) { v[i] = DN_ALPHA * xs[tid + 256 * i] + acc[i]; s += v[i]; }
    s = wave_sum(s); if ((tid & 63) == 0) red[tid >> 6] = s; __syncthreads();
    const float mean = (red[0] + red[1] + red[2] + red[3]) * (1.f / D); float s2 = 0.f;
#pragma unroll
    for (int i = 0; i < 4; ++i) { v[i] -= mean; s2 += v[i] * v[i]; }
    s2 = wave_sum(s2); if ((tid & 63) == 0) red[4 + (tid >> 6)] = s2; __syncthreads();
    const float rstd = rsqrtf((red[4] + red[5] + red[6] + red[7]) * (1.f / D) + LN_EPS);
#pragma unroll
    for (int i = 0; i < 4; ++i) out[(size_t)m * D + tid + 256 * i] = v[i] * rstd * p.ln3g[tid + 256 * i] + p.ln3b[tid + 256 * i];
    __syncthreads();
}

struct G1Sched {
    const int* ctl; const char* x2h; const unsigned* rowoff; const char* WguT; int G, c;
    __device__ bool next(int i, pg8::Unit& u) const {
        const int ntile = ctl[CTL_TQS + NQ]; const long L = (long)i * G + c; if (L >= 2L * ntile) return false;
        const int tile = (int)(L >> 1), pn = (int)(L & 1); const int e = ctl[CTL_TVE + tile] % 65;
        u.pm = tile; u.pn = pn; u.A = x2h; u.gat = rowoff + (size_t)tile * 256; u.B = WguT + ((size_t)e * 512 + pn * 256) * (D * 2); return true; }
};
struct G2Sched {
    const int* ctl; const char* H; const char* WdT; int q, G, c;
    __device__ bool next(int i, pg8::Unit& u) const {
        const int t0 = ctl[CTL_TQS + q], t1 = ctl[CTL_TQS + q + 1]; const long L = (long)i * G + c; if (L >= 4L * (t1 - t0)) return false;
        const int tile = t0 + (int)(L >> 2), pn = (int)(L & 3); const int e = ctl[CTL_TVE + tile] % 65;
        u.pm = tile; u.pn = pn; u.A = H + (size_t)tile * 256 * (EFF * 2); u.gat = nullptr; u.B = WdT + ((size_t)e * D + pn * 256) * (EFF * 2); return true; }
};
__device__ __forceinline__ void b_scatter(int* __restrict__ ctl, const int* __restrict__ tope, const float* __restrict__ topw, unsigned* __restrict__ rowoff, u32x2* __restrict__ rowmeta, int* sl) {
    int* pst = sl;
    if (tidx() == 0) { int acc = 0; for (int v = 0; v < NVE; ++v) { pst[v] = acc; acc += (ctl[CTL_CNT + v] + 255) & ~255; } pst[NVE] = acc; }
    __syncthreads();
    if (blockIdx.x == 0) {
        for (int v = tidx(); v <= NVE; v += NTHR) ctl[CTL_PST + v] = pst[v];
        if (tidx() <= NQ) ctl[CTL_TQS + tidx()] = pst[tidx() * 65] >> 8;
        for (int v = tidx(); v < NVE; v += NTHR) for (int tl = pst[v] >> 8; tl < (pst[v + 1] >> 8); ++tl) ctl[CTL_TVE + tl] = v;
    }
    for (int idx = blockIdx.x * NTHR + tidx(); idx < M * 9; idx += gridDim.x * NTHR) {
        int m, k, pos; float w;
        if (idx < M * 8) { m = idx >> 3; k = idx & 7; const int ve = (m >> 13) * 65 + tope[idx]; w = topw[idx]; pos = pst[ve] + atomicAdd(ctl + CTL_CUR + ve, 1); }
        else { m = idx - M * 8; k = 8; w = 1.f; pos = pst[(m >> 13) * 65 + 64] + (m & (QT - 1)); }
        rowoff[pos] = (unsigned)m * (D * 2); rowmeta[pos] = (u32x2){(unsigned)((m & (QT - 1)) * 9 + k), __float_as_uint(w)};
    }
    __syncthreads();
}
__device__ __forceinline__ void b_combine(const Params& p, const h16* __restrict__ x2h, const h16* __restrict__ Y, int q) {
    const int lane = tidx() & 63;
    for (int r = blockIdx.x * 8 + (tidx() >> 6); r < QT; r += gridDim.x * 8) {
        const int m = q * QT + r;
        float v[16];
        { const h16x8 a = ((const h16x8*)(x2h + (size_t)m * D))[lane], b = ((const h16x8*)(x2h + (size_t)m * D))[lane + 64];
#pragma unroll
          for (int i = 0; i < 8; ++i) { v[i] = DN_ALPHA * (float)a[i]; v[8 + i] = DN_ALPHA * (float)b[i]; } }
#pragma unroll
        for (int k = 0; k < 9; ++k) { const h16x8* yr = (const h16x8*)(Y + ((size_t)r * 9 + k) * D); const h16x8 a = yr[lane], b = yr[lane + 64];
#pragma unroll
            for (int i = 0; i < 8; ++i) { v[i] += (float)a[i]; v[8 + i] += (float)b[i]; } }
        float s = 0.f;
#pragma unroll
        for (int i = 0; i < 16; ++i) s += v[i];
        const float mean = wave_sum(s) * (1.f / D); float s2 = 0.f;
#pragma unroll
        for (int i = 0; i < 16; ++i) { v[i] -= mean; s2 += v[i] * v[i]; }
        const float rstd = rsqrtf(wave_sum(s2) * (1.f / D) + LN_EPS);
#pragma unroll
        for (int hlf = 0; hlf < 2; ++hlf) { const int c0 = (lane + 64 * hlf) * 8;
            const f32x4 g0 = *(const f32x4*)(p.ln3g + c0), g1 = *(const f32x4*)(p.ln3g + c0 + 4), b0 = *(const f32x4*)(p.ln3b + c0), b1 = *(const f32x4*)(p.ln3b + c0 + 4);
            f32x4 o0, o1;
#pragma unroll
            for (int i = 0; i < 4; ++i) { o0[i] = v[8 * hlf + i] * rstd * g0[i] + b0[i]; o1[i] = v[8 * hlf + 4 + i] * rstd * g1[i] + b1[i]; }
            *(f32x4*)(p.out + (size_t)m * D + c0) = o0; *(f32x4*)(p.out + (size_t)m * D + c0 + 4) = o1; }
    }
}

#define XB_TMO      128
#define XB_XCNT(j)  (256  + 64 * (j))
#define XB_XSUB(j)  (1280 + 64 * (j))
#define XB_XGEN(j)  (2304 + 64 * (j))
#define XB_TOP      3328
#define XB_TOPGEN   3392
#define XCD_BAR_WORDS 3456
#define XB_SPIN_CAP (1u << 22)
__device__ __forceinline__ unsigned xb_ld(unsigned* p)              { return __hip_atomic_load(p, __ATOMIC_RELAXED, __HIP_MEMORY_SCOPE_AGENT); }
__device__ __forceinline__ unsigned xb_add(unsigned* p, unsigned v) { return __hip_atomic_fetch_add(p, v, __ATOMIC_RELAXED, __HIP_MEMORY_SCOPE_AGENT); }
__device__ __forceinline__ unsigned xb_xcc_id() { return (unsigned)__builtin_amdgcn_s_getreg((3 << 11) | 20) & 0xFu; }
#define XB_SPIN(cond, bar) do { unsigned _sp = 0; while (cond) { __builtin_amdgcn_s_sleep(1); \
    if ((++_sp & 255u) == 0u) { if (xb_ld(&(bar)[XB_TMO])) break; if (_sp > XB_SPIN_CAP) { atomicAdd(&(bar)[XB_TMO], 1u); break; } } } } while (0)
struct XcdBarrier { unsigned* bar; unsigned x; volatile LAS unsigned* st; };
__device__ __forceinline__ XcdBarrier xcd_barrier_post(unsigned* bar, volatile LAS unsigned* st) {
    XcdBarrier b; b.bar = bar; b.x = xb_xcc_id(); b.st = st;
    if (threadIdx.x == 0) (void)xb_add(&bar[XB_XCNT(b.x)], 1u);
    return b;
}
__device__ __forceinline__ void xcd_barrier_complete(unsigned* bar, unsigned x, unsigned& nloc, unsigned& nx) {
    const unsigned G = gridDim.x * gridDim.y * gridDim.z;
    unsigned sum, cnt, mine, sp = 0u;
    for (;;) {
        sum = 0u; cnt = 0u; mine = 0u;
#pragma unroll
        for (unsigned j = 0; j < 16; ++j) { const unsigned c = xb_ld(&bar[XB_XCNT(j)]); sum += c; cnt += (c > 0u) ? 1u : 0u; mine = (j == x) ? c : mine; }
        if (sum == G) break;
        __builtin_amdgcn_s_sleep(1);
        if ((++sp & 255u) == 0u) { if (xb_ld(&bar[XB_TMO])) break; if (sp > XB_SPIN_CAP) { atomicAdd(&bar[XB_TMO], 1u); break; } }
    }
    nloc = mine > 0u ? mine : 1u; nx = cnt > 0u ? cnt : 1u;
}
__device__ __forceinline__ void xcd_barrier(const XcdBarrier& b) {
    asm volatile("s_waitcnt vmcnt(0)" ::: "memory");
    __syncthreads();
    if (threadIdx.x == 0) {
        unsigned* bar = b.bar;
        __builtin_amdgcn_s_waitcnt(0);
        unsigned nloc = b.st[0], nx = b.st[1];
        if (nloc == 0u) { xcd_barrier_complete(bar, b.x, nloc, nx); b.st[0] = nloc; b.st[1] = nx; }
        const unsigned old = xb_add(&bar[XB_XSUB(b.x)], 1u);
        const unsigned gen = old / nloc;
        if (old + 1u == (gen + 1u) * nloc) {
            __builtin_amdgcn_fence(__ATOMIC_RELEASE, "agent");
            asm volatile("s_waitcnt vmcnt(0)" ::: "memory");
            const unsigned og = xb_add(&bar[XB_TOP], 1u);
            const unsigned tg = og / nx;
            if (og + 1u == (tg + 1u) * nx) xb_add(&bar[XB_TOPGEN], 1u);
            else XB_SPIN(xb_ld(&bar[XB_TOPGEN]) == tg, bar);
            __builtin_amdgcn_fence(__ATOMIC_ACQUIRE, "agent");
            xb_add(&bar[XB_XGEN(b.x)], 1u);
            asm volatile("s_waitcnt vmcnt(0)" ::: "memory");
        } else {
            XB_SPIN(xb_ld(&bar[XB_XGEN(b.x)]) == gen, bar);
            __builtin_amdgcn_fence(__ATOMIC_ACQUIRE, "agent");
            asm volatile("s_waitcnt vmcnt(0)" ::: "memory");
        }
    }
    __syncthreads();
}

constexpr int N_PHASES = 23;

__global__ void __launch_bounds__(NTHR, 2) mega_fwd(Params p) {
    extern __shared__ __attribute__((aligned(16))) unsigned char lds[];
    cg::grid_group grid = cg::this_grid();
    const int G = (int)gridDim.x, bid = (int)blockIdx.x;
#define tid tidx()
    unsigned char* ws = p.ws;
    h16* WinT = (h16*)(ws + WS_WIN); h16* WoutT = (h16*)(ws + WS_WOUT); h16* WxqT = (h16*)(ws + WS_WXQ); h16* WxoT = (h16*)(ws + WS_WXO); h16* WxkvT = (h16*)(ws + WS_WXKV);
    h16* memh = (h16*)(ws + WS_MEMH); h16* kvm = (h16*)(ws + WS_KVM); h16* kcmp = (h16*)(ws + WS_KCMP); h16* vcmpT = (h16*)(ws + WS_VCMP); h16* vsT = (h16*)(ws + WS_VST); h16* vwT = (h16*)(ws + WS_VWT);
    int* tope = (int*)(ws + WS_TOPE); float* topw = (float*)(ws + WS_TOPW);
    h16* xh = (h16*)(ws + WS_XH); h16* mix = (h16*)(ws + WS_MIX); h16* ox = (h16*)(ws + WS_OX); h16* hb = (h16*)(ws + WS_H); h16* nqr = (h16*)(ws + WS_NQR);
    float* kvb = (float*)(ws + WS_KVB); h16* prevT = (h16*)(ws + WS_PREVT);
    float* cosr = (float*)(ws + WS_COSR); float* sinr = (float*)(ws + WS_SINR); float* cosn = (float*)(ws + WS_COSN); float* sinn = (float*)(ws + WS_SINN); h16* kvmVT = (h16*)(ws + WS_KVMVT); h16* WrTh = (h16*)(ws + WS_WRTH); h16* WrTl = (h16*)(ws + WS_WRTL); h16* Wc1T = (h16*)(ws + WS_WC1T); h16* hid = (h16*)(ws + WS_HID); unsigned* cmpoff = (unsigned*)(ws + WS_CMPOFF); float* peb = (float*)(ws + WS_PEB); h16* ksR = (h16*)(ws + WS_KSR); h16* kwR = (h16*)(ws + WS_KWR); h16* kx = (h16*)(ws + WS_KX);
    h16* rqr = (h16*)((unsigned char*)p.out + DO_RQR); h16* rkr = (h16*)((unsigned char*)p.out + DO_RKR); h16* rkzT = (h16*)((unsigned char*)p.out + DO_RKZT); h16* rvT = (h16*)((unsigned char*)p.out + DO_RVT); float* pre = p.out; float* x1 = (float*)(ws + WS_X1); h16* x1h = (h16*)(ws + WS_X1H);
    h16* qx = (h16*)(ws + WS_QX); float* x2 = (float*)(ws + WS_X2); h16* x2h = (h16*)(ws + WS_X2H);
    int* ctl = (int*)ws; unsigned* rowoff = (unsigned*)(ws + WS_ROWOFF); u32x2* rowmeta = (u32x2*)(ws + WS_ROWMETA);
    h16* WguT = (h16*)(ws + WS_WGUT); h16* WdT = (h16*)(ws + WS_WDT); h16* Hm = (h16*)(ws + WS_HM); h16* Yq = (h16*)(ws + WS_Y);
    float* fl = (float*)lds;
    const int lo = p.ph_lo, hi = p.ph_hi;
#define IN(k) (lo <= (k) && (k) < hi)
    { volatile LAS unsigned* st = (volatile LAS unsigned*)((LAS unsigned char*)lds + 131072); if (threadIdx.x < 2) st[threadIdx.x] = 0u; }
    __syncthreads();
    XcdBarrier xbar = xcd_barrier_post((unsigned*)(ws + WS_BAR), (volatile LAS unsigned*)((LAS unsigned char*)lds + 131072));
#define SEAM(k) do { if (IN(k) && IN((k) + 1)) { if ((k) == 0) grid.sync(); else xcd_barrier(xbar); } } while (0)

    if (IN(0)) REPS(0) {
        { const int sub = tid >> 8, lt = tid & 255; float* tl = fl + sub * 1088;
          constexpr int T0 = (INP / 32) * (D / 32);
          for (int b0 = bid * 2; b0 < T0; b0 += G * 2) b_transpose_tile(p.w_in, D, INC, WinT, INP, b0 + sub, tl, lt); }
        { const int wv = __builtin_amdgcn_readfirstlane(tid >> 6), lane = tid & 63; LAS float* scr = (LAS float*)((LAS unsigned char*)lds + wv * 8704);
          constexpr int I1 = (D / 64) * (D / 32), I4 = (D / 64) * (2 * D / 32), I5 = (2048 / 64) * (256 / 32), IT = 3 * I1 + I4 + 2 * I5;
          for (int it0 = bid * 8 + wv; it0 < IT; it0 += G * 8) { int it = it0;
            if (it < I1) { w_transpose_item(p.w_out, D, D, WoutT, it, scr, lane); continue; } it -= I1;
            if (it < I1) { w_transpose_item(p.w_xq, D, D, WxqT, it, scr, lane); continue; } it -= I1;
            if (it < I1) { w_transpose_item(p.w_xo, D, D, WxoT, it, scr, lane); continue; } it -= I1;
            if (it < I4) { w_transpose_item(p.w_xkv, D, 2 * D, WxkvT, it, scr, lane); continue; } it -= I4;
            if (it < I5) { w_transpose_item(p.w1k, 2048, 256, Wc1T, it, scr, lane); continue; } it -= I5;
            w_transpose_item(p.w1v, 2048, 256, Wc1T + 256 * 2048, it, scr, lane); } }
        __syncthreads();
        b_cvt(p.x, xh, (size_t)M * D / 4);
        b_cvt(p.mem, memh, (size_t)NB * MEML * D / 4);
        if (bid == 0) for (int i = tid; i < 1024; i += NTHR) ctl[i] = 0;
        b_tables(p.positions, cosr, sinr, cosn, sinn);
        for (int idx = bid * NTHR + tid; idx < NE * D; idx += G * NTHR) { const int e = idx >> 10, k = idx & 1023; const float w = p.w_router[k * NE + e]; const h16 hi = (h16)w; WrTh[idx] = hi; WrTl[idx] = (h16)((w - (float)hi) * 2048.f); }
        for (int r = bid * NTHR + tid; r < 4096; r += G * NTHR) { const int g = r & 1, c = min((r >> 1) & 511, 510), b = r >> 10; cmpoff[r] = (unsigned)(((size_t)(b * T + 16 * c) * INP + g * 64) * 2); }
        { const int lane = tid & 63;
          for (int o = bid * 8 + (tid >> 6); o < 512; o += G * 8) { const int kv = o >> 8, j = o & 255; const float* pe = kv ? p.pe_v : p.pe_k; const float* w1 = kv ? p.w1v : p.w1k; float a = 0.f;
              for (int k = lane; k < 2048; k += 64) a += pe[k] * w1[(size_t)k * 256 + j];
              a = wave_sum(a); if (lane == 0) peb[o] = a; } }
    }
    SEAM(0);
    if (IN(1)) {
        REPS(1) { pg8::Gemm g{xh, WinT, M, INP, D}; pg8::StaticOrder S; S.init(g, G, bid); pg8::EpiF16 E{hb, INP};
          pg8::gemm_phase<pg8::EpiF16, pg8::StaticOrder>((PG8_LAS unsigned char*)lds, g.K, S, E); }
        { pg8::Gemm g{memh, WxkvT, NB * MEML, 2 * D, D}; pg8::StaticOrder S; S.init(g, G, bid); pg8::EpiF16 E{kvm, 2 * D};
          pg8::gemm_phase<pg8::EpiF16, pg8::StaticOrder>((PG8_LAS unsigned char*)lds, g.K, S, E); }
    }
    SEAM(1);
    if (IN(2)) REPS(2) {
        if (bid < 32) { CmpSched S{(const char*)hb, cmpoff, (const char*)Wc1T, bid}; pg8::EpiCmp1 E{hid, peb + (bid >> 4) * 256};
            pg8::gemm_phase<pg8::EpiCmp1, CmpSched>((PG8_LAS unsigned char*)lds, 2048, S, E, (size_t)INP * 2); }
        else { const int sub = tid >> 8, lt = tid & 255; const int b2 = bid - 32, G2 = G - 32;
        for (int b0 = b2 * 2; b0 < M; b0 += G2 * 2) b_rope(hb, rqr, rkr, nqr, ksR, kwR, cosr, sinr, cosn, sinn, b0 + sub, lt);
        for (int b0 = b2 * 2; b0 < 2 * NB * 2 * 128; b0 += G2 * 2) b_vtrans(hb, vsT, vwT, b0 + sub, (h16*)(fl + sub * 2304), lt);
        for (int b0 = b2 * 2; b0 < NB * 4 * 128; b0 += G2 * 2) b_rtrans(p, hb, rvT, rkzT, cosr, sinr, b0 + sub, (h16*)(fl + sub * 4224), lt);
        for (int b0 = b2 * 2; b0 < NB * 4 * 16; b0 += G2 * 2) b_mvtrans(kvm, kvmVT, kx, b0 + sub, (h16*)(fl + sub * 2304), lt); } }
    SEAM(2);
    if (IN(3)) {
        REPS(30) b_cmp2(p, hid, kcmp, vcmpT);
        const int wv = __builtin_amdgcn_readfirstlane(tid >> 6), lane = tid & 63;
        REPS(31) for (int ch = bid; ch < NB * 4 * 64; ch += G) ret_kv_unit(rkzT, rvT, kvb, ch, wv, lane); }
    SEAM(3);
    if (IN(4)) {
        REPS(4) b_ret_scan(p, kvb, prevT);
        const int wv = __builtin_amdgcn_readfirstlane(tid >> 6), lane = tid & 63;
        __syncthreads();
        REPS(50) { const int bg = bid & 7;
            for (int k = bid >> 3; k < T / 32; k += (G >> 3)) nsa_block_unit(hb, nqr, kcmp, vcmpT, vsT, vwT, ksR, kwR, mix, bg >> 1, bg & 1, (T / 32 - 1 - k) * 32, (LAS unsigned char*)lds, wv, lane); }
    }
    SEAM(4);
    if (IN(5)) {
        const int wv = __builtin_amdgcn_readfirstlane(tid >> 6), lane = tid & 63;
        REPS(51) for (int ch = bid; ch < NB * 4 * 64; ch += G) ret_out_unit(p, hb, rqr, rkr, rvT, prevT, mix, ch, wv, lane);
    }
    SEAM(5);
    if (IN(6)) { pg8::Gemm g{mix, WoutT, M, D, D}; pg8::StaticOrder S; S.init(g, G, bid); pg8::EpiResF32 E{pre, p.x, D, DN_ALPHA};
        pg8::gemm_phase<pg8::EpiResF32, pg8::StaticOrder>((PG8_LAS unsigned char*)lds, g.K, S, E); }
    SEAM(6);
    if (PROBE_DBL == 900) { for (int k = 0; k < 20; ++k) xcd_barrier(xbar); }
    if (IN(7)) REPS(7) b_ln(pre, p.ln1g, p.ln1b, x1, x1h);
    SEAM(7);
    if (IN(8)) { pg8::Gemm g{x1h, WxqT, M, D, D}; pg8::StaticOrder S; S.init(g, G, bid); pg8::EpiF16 E{qx, D};
        pg8::gemm_phase<pg8::EpiF16, pg8::StaticOrder>((PG8_LAS unsigned char*)lds, g.K, S, E); }
    SEAM(8);
    if (IN(9)) { const int wv = __builtin_amdgcn_readfirstlane(tid >> 6), lane = tid & 63;
        REPS(9) for (int u = bid; u < (M / 128) * 4; u += G) xattn_unit(qx, kx, kvmVT, ox, (u >> 2) * 128 + wv * 16, u & 3, lane); }
    SEAM(9);
    if (IN(10)) { pg8::Gemm g{ox, WxoT, M, D, D}; pg8::StaticOrder S; S.init(g, G, bid); pg8::EpiResF32 E{pre, x1, D, DN_ALPHA};
        pg8::gemm_phase<pg8::EpiResF32, pg8::StaticOrder>((PG8_LAS unsigned char*)lds, g.K, S, E); }
    if (IN(10) && IN(12)) xcd_barrier(xbar);
    if (IN(12)) {
        { const int wv = __builtin_amdgcn_readfirstlane(tid >> 6), lane = tid & 63; LAS float* lg = (LAS float*)((LAS unsigned char*)lds + wv * 4096);
          for (int u = bid * 8 + wv; u < M / 16; u += G * 8) router_unit(p, pre, x2h, WrTh, WrTl, tope, topw, ctl + CTL_CNT, u * 16, lg, lane); }
        __syncthreads();
        if (bid == 0 && tid < NQ) ctl[CTL_CNT + tid * 65 + 64] = QT;
        for (int i = bid * NTHR + tid; i < CAP; i += G * NTHR) { rowoff[i] = 0u; rowmeta[i] = (u32x2){0xffffffffu, 0u}; }
        { const int wv = __builtin_amdgcn_readfirstlane(tid >> 6), lane = tid & 63; LAS float* scr = (LAS float*)((LAS unsigned char*)lds + wv * 8704);
          REPS(121) for (int it = bid * 8 + wv; it < 65 * 384; it += G * 8) { const int e = it / 384, r = it % 384;
            const float* wg = e < 64 ? p.w_gate + (size_t)e * D * EFF : p.ws_gate; const float* wu = e < 64 ? p.w_up + (size_t)e * D * EFF : p.ws_up; const float* wd = e < 64 ? p.w_down + (size_t)e * EFF * D : p.ws_down;
            if (r < 128) w_transpose_item(wg, D, EFF, WguT + (size_t)e * 512 * D, r, scr, lane, 2, 0);
            else if (r < 256) w_transpose_item(wu, D, EFF, WguT + (size_t)e * 512 * D, r - 128, scr, lane, 2, 1);
            else w_transpose_item(wd, EFF, D, WdT + (size_t)e * D * EFF, r - 256, scr, lane); } }
    }
    SEAM(12);
    if (IN(13)) b_scatter(ctl, tope, topw, rowoff, rowmeta, (int*)lds);
    SEAM(13);
    if (IN(14)) REPS(14) { G1Sched S{ctl, (const char*)x2h, rowoff, (const char*)WguT, G, bid}; pg8::EpiGateUp E{Hm};
        pg8::gemm_phase<pg8::EpiGateUp, G1Sched>((PG8_LAS unsigned char*)lds, D, S, E); }
    SEAM(14);
#pragma unroll 1
    for (int q = 0; q < NQ; ++q) {
        if (IN(15 + 2 * q)) REPS(15) { G2Sched S{ctl, (const char*)Hm, (const char*)WdT, q, G, bid}; pg8::EpiDown E{Yq, rowmeta};
            pg8::gemm_phase<pg8::EpiDown, G2Sched>((PG8_LAS unsigned char*)lds, EFF, S, E); }
        SEAM(15 + 2 * q);
        if (IN(16 + 2 * q)) REPS(16) b_combine(p, x2h, Yq, q);
        if (q < NQ - 1) SEAM(16 + 2 * q);
    }
#undef IN
#undef SEAM
#undef tid
}

#ifndef MK_PER_PHASE
#define MK_PER_PHASE 0
#endif
extern "C" void kernel_launch(void* const* d_in, const int* in_sizes, int n_in, void* d_out, int out_size, void* d_ws, size_t ws_size, hipStream_t stream) {
    static int grid = 0;
    if (grid == 0) {
        if (n_in != 28 || in_sizes[0] != M * D || out_size != M * D || ws_size < WS_NEED) { fprintf(stderr, "kernel_launch: unexpected shapes (n_in %d, in0 %d, out %d, ws %zu)\n", n_in, n_in > 0 ? in_sizes[0] : -1, out_size, ws_size); grid = -1; return; }
        if (hipFuncSetAttribute((const void*)mega_fwd, hipFuncAttributeMaxDynamicSharedMemorySize, LDS_BYTES) != hipSuccess) { fprintf(stderr, "kernel_launch: hipFuncSetAttribute failed\n"); grid = -1; return; }
        int dev = 0, cus = 0, per_cu = 0;
        hipGetDevice(&dev); hipDeviceGetAttribute(&cus, hipDeviceAttributeMultiprocessorCount, dev);
        if (hipOccupancyMaxActiveBlocksPerMultiprocessor(&per_cu, (const void*)mega_fwd, NTHR, LDS_BYTES) != hipSuccess || per_cu < 1) { fprintf(stderr, "kernel_launch: occupancy query failed (%d)\n", per_cu); grid = -1; return; }
        grid = cus;
    }
    if (grid < 0) return;
    Params p{};
    p.x = (const float*)d_in[0]; p.mem = (const float*)d_in[1]; p.positions = (const int*)d_in[2];
    p.w_in = (const float*)d_in[3]; p.pe_k = (const float*)d_in[4]; p.pe_v = (const float*)d_in[5];
    p.w1k = (const float*)d_in[6]; p.w2k = (const float*)d_in[7]; p.w1v = (const float*)d_in[8]; p.w2v = (const float*)d_in[9];
    p.w_out = (const float*)d_in[10]; p.ln1g = (const float*)d_in[11]; p.ln1b = (const float*)d_in[12];
    p.w_xq = (const float*)d_in[13]; p.w_xkv = (const float*)d_in[14]; p.w_xo = (const float*)d_in[15];
    p.ln2g = (const float*)d_in[16]; p.ln2b = (const float*)d_in[17]; p.w_router = (const float*)d_in[18]; p.rbias = (const float*)d_in[19];
    p.w_gate = (const float*)d_in[20]; p.w_up = (const float*)d_in[21]; p.w_down = (const float*)d_in[22];
    p.ws_gate = (const float*)d_in[23]; p.ws_up = (const float*)d_in[24]; p.ws_down = (const float*)d_in[25];
    p.ln3g = (const float*)d_in[26]; p.ln3b = (const float*)d_in[27];
    p.out = (float*)d_out; p.ws = (unsigned char*)d_ws;
    for (int i = 0; i < 4; ++i) p.lg[i] = (float)std::log(1.0 - std::pow(2.0, -5.0 - (double)i));
#if MK_PER_PHASE
    for (int ph = 0; ph < N_PHASES; ++ph) { p.ph_lo = ph; p.ph_hi = ph + 1; hipLaunchKernelGGL(mega_fwd, dim3(grid), dim3(NTHR), LDS_BYTES, stream, p); }
#else
    p.ph_lo = 0; p.ph_hi = N_PHASES;
    if (hipMemsetAsync((char*)d_ws + WS_BAR, 0, XCD_BAR_WORDS * 4, stream) != hipSuccess) { fprintf(stderr, "kernel_launch: memset failed\n"); return; }
    void* args[] = {&p};
    hipError_t e = hipLaunchCooperativeKernel((const void*)mega_fwd, dim3(grid), dim3(NTHR), args, LDS_BYTES, stream);
    if (e != hipSuccess) fprintf(stderr, "kernel_launch: cooperative launch failed: %s (grid %d)\n", hipGetErrorString(e), grid);
#endif
}
```

```cpp
#include <hip/hip_runtime.h>
#include <cstdio>
#include <cstdint>
#include <cmath>

typedef _Float16 h16;
typedef _Float16 h16x8 __attribute__((ext_vector_type(8)));
typedef _Float16 h16x2 __attribute__((ext_vector_type(2)));
typedef _Float16 h16x4 __attribute__((ext_vector_type(4)));
typedef float f32x2 __attribute__((ext_vector_type(2)));
typedef float f32x4 __attribute__((ext_vector_type(4)));
typedef unsigned u32x4 __attribute__((ext_vector_type(4)));
typedef unsigned u32x2 __attribute__((ext_vector_type(2)));

__device__ __forceinline__ int tidx() { int t = (int)threadIdx.x; asm volatile("" : "+v"(t)); return t; }

#ifndef PROBE_DBL
#define PROBE_DBL -1
#endif
#define REPS(k) for (int _rep = 0; _rep < ((PROBE_DBL) == (k) ? 2 : 1); ++_rep)

constexpr int NB = 4, T = 8192, D = 1024, M = NB * T;
constexpr int INC = 3352, INP = 3584;
constexpr int C_RQ = 0, C_RK = 512, C_RV = 1024, C_RG = 1536, C_NQ = 2048, C_NKC = 2560, C_NVC = 2688, C_NKS = 2816, C_NVS = 2944, C_NKW = 3072, C_NVW = 3200, C_NG = 3328;
constexpr int MEML = 256;
constexpr int NE = 64, EFF = 256;
constexpr float LN_EPS = 1e-5f;
constexpr float DN_ALPHA = 1.189207115002721f;
constexpr float NEGF = -1e30f;

constexpr size_t MiB = 1u << 20;
constexpr size_t WS_WIN = 1 * MiB, WS_WOUT = 8 * MiB, WS_WXQ = 10 * MiB, WS_WXO = 12 * MiB, WS_WXKV = 14 * MiB, WS_MEMH = 18 * MiB, WS_KVM = 20 * MiB;
constexpr size_t WS_KCMP = 24 * MiB, WS_VCMP = 25 * MiB, WS_TOPE = 26 * MiB, WS_TOPW = 27 * MiB;
constexpr size_t WS_XH = 32 * MiB, WS_MIX = 32 * MiB, WS_OX = 32 * MiB;
constexpr size_t WS_H = 96 * MiB, WS_NQR = 320 * MiB, WS_KVB = 352 * MiB, WS_PREV = 416 * MiB;
constexpr size_t WS_PRE = 96 * MiB, WS_X1 = 224 * MiB, WS_X1H = 352 * MiB, WS_QX = 416 * MiB, WS_X2 = 130 * MiB;
constexpr size_t WS_X2H = 32 * MiB, WS_WDT = 96 * MiB, WS_HM = 130 * MiB, WS_WGUT = 306 * MiB, WS_Y = 306 * MiB;
constexpr size_t WS_ROWOFF = 1 * MiB, WS_ROWMETA = 3 * MiB;
constexpr size_t WS_VST = 480 * MiB, WS_VWT = 488 * MiB, WS_COSR = 496 * MiB, WS_SINR = 504 * MiB, WS_COSN = 28 * MiB, WS_SINN = 29 * MiB, WS_KVMVT = 30 * MiB;
constexpr size_t WS_WRTH = 262144, WS_WRTL = 393216;
constexpr size_t WS_WC1T = 464 * MiB, WS_HID = 466 * MiB, WS_CMPOFF = 131072, WS_PEB = 131072 + 16384;
constexpr size_t WS_PREVT = 416 * MiB, WS_KSR = 448 * MiB, WS_KWR = 456 * MiB, WS_KX = 26 * MiB;
constexpr size_t DO_RQR = 0, DO_RKR = 32 * MiB, DO_RKZT = 64 * MiB, DO_RVT = 96 * MiB;
constexpr size_t WS_NEED = 512 * MiB;
constexpr int NQ = 4, QT = M / NQ, NVE = NQ * 65, CAP_TILES = 1412, CAP = CAP_TILES * 256;
constexpr size_t WS_BAR = 65536;
constexpr int CTL_CNT = 0, CTL_CUR = 512, CTL_PST = 1024, CTL_TQS = 1536, CTL_TVE = 2048;

namespace pg8 {
#define PG8_LAS __attribute__((address_space(3)))
typedef short s16x8 __attribute__((ext_vector_type(8)));
constexpr int BM = 256, BK = 64, HALF = 128, HTB = HALF * BK * 2, STAGE_BYTES = 8 * HTB, NXCD = 8, WGM = 8;
__host__ __device__ __forceinline__ int lds_byte(int r, int c) { const int st = (r >> 4) * 2 + (c >> 5), rr = r & 15, cc = c & 31, ob = rr * 64 + cc * 2; return st * 1024 + (ob ^ (((ob >> 9) & 1) << 5)); }
__host__ __device__ __forceinline__ void stage_rc(int b, int& R, int& C) { const int st = b / 1024, sb = b % 1024, swz = sb ^ (((sb >> 9) & 1) << 5); R = (st >> 1) * 16 + swz / 64; C = (st & 1) * 32 + (swz % 64) / 2; }
__host__ __device__ __forceinline__ int perm32(int rho) { const int n = rho >> 4, i = rho & 15; return 8 * (i >> 2) + 4 * n + (i & 3); }
struct Unit { int pm, pn; const char* A; const char* B; const unsigned* gat; };
struct Gemm { const h16* A; const h16* Bt; int M, N, K; };
struct StaticOrder {
    int nM, nN, nwg, G, c; const char* A; const char* B; size_t tstep;
    __device__ void init(const Gemm& g, int G_, int c_) { nM = g.M / BM; nN = g.N / BM; nwg = nM * nN; G = G_; c = c_; A = (const char*)g.A; B = (const char*)g.Bt; tstep = (size_t)BM * g.K * 2; }
    __device__ bool next(int i, Unit& u) const {
        const long L = (long)i * G + c; if (L >= nwg) return false;
        int wgid = (int)L; { const int q = nwg / NXCD, r = nwg % NXCD, xcd = wgid % NXCD, off = wgid / NXCD; wgid = (xcd < r ? xcd * (q + 1) : r * (q + 1) + (xcd - r) * q) + off; }
        const int nig = WGM * nN, gid = wgid / nig, fm = gid * WGM, gsz = (nM - fm) < WGM ? (nM - fm) : WGM;
        u.pm = fm + ((wgid % nig) % gsz); u.pn = (wgid % nig) / gsz; u.A = A + (size_t)u.pm * tstep; u.B = B + (size_t)u.pn * tstep; u.gat = nullptr; return true;
    }
};
__device__ __forceinline__ unsigned cvt_pk_f16(float lo, float hi) { f32x2 v = {lo, hi}; h16x2 h = __builtin_convertvector(v, h16x2); return __builtin_bit_cast(unsigned, h); }

struct EpiF16 {
    static constexpr bool PERM = true;
    h16* O; int ldc;
    __device__ __forceinline__ void operator()(const f32x4 (&acc)[2][2][4][2], const Unit& u, int wr, int wc, int fr, int fq) const {
        const int row0 = u.pm * BM + wr * 64 + fr; const int col0 = u.pn * BM + wc * 32 + 8 * fq;
#pragma unroll
        for (int ai = 0; ai < 2; ++ai)
#pragma unroll
            for (int m = 0; m < 4; ++m) { h16* rowp = O + (size_t)(row0 + ai * HALF + m * 16) * ldc + col0;
#pragma unroll
                for (int bj = 0; bj < 2; ++bj) { const f32x4 v0 = acc[ai][bj][m][0], v1 = acc[ai][bj][m][1];
                    *(h16x8*)(rowp + bj * HALF) = __builtin_convertvector(__builtin_shufflevector(v0, v1, 0, 1, 2, 3, 4, 5, 6, 7), h16x8); } }
    }
};
struct EpiResF32 {
    static constexpr bool PERM = false;
    float* C; const float* R; int ldc; float alpha;
    __device__ __forceinline__ void operator()(const f32x4 (&acc)[2][2][4][2], const Unit& u, int wr, int wc, int fr, int fq) const {
        const int row0 = u.pm * BM + wr * 64 + fr, col0 = u.pn * BM + wc * 32 + 4 * fq;
#pragma unroll
        for (int ai = 0; ai < 2; ++ai)
#pragma unroll
            for (int m = 0; m < 4; ++m) { const size_t off = (size_t)(row0 + ai * HALF + m * 16) * ldc + col0;
#pragma unroll
                for (int bj = 0; bj < 2; ++bj)
#pragma unroll
                    for (int n = 0; n < 2; ++n) { const f32x4 r = *(const f32x4*)(R + off + bj * HALF + n * 16); *(f32x4*)(C + off + bj * HALF + n * 16) = r * alpha + acc[ai][bj][m][n]; } }
    }
};
struct EpiCmp1 {
    static constexpr bool PERM = true;
    h16* O; const float* peb;
    __device__ __forceinline__ void operator()(const f32x4 (&acc)[2][2][4][2], const Unit& u, int wr, int wc, int fr, int fq) const {
        const int row0 = u.pm * BM + wr * 64 + fr; const int col0 = wc * 32 + 8 * fq;
#pragma unroll
        for (int bj = 0; bj < 2; ++bj) { const f32x4 b0 = *(const f32x4*)(peb + col0 + bj * HALF), b1 = *(const f32x4*)(peb + col0 + bj * HALF + 4);
#pragma unroll
            for (int ai = 0; ai < 2; ++ai)
#pragma unroll
                for (int m = 0; m < 4; ++m) { f32x4 v0 = acc[ai][bj][m][0] + b0, v1 = acc[ai][bj][m][1] + b1;
#pragma unroll
                    for (int r = 0; r < 4; ++r) { v0[r] = v0[r] / (1.f + __expf(-v0[r])); v1[r] = v1[r] / (1.f + __expf(-v1[r])); }
                    *(h16x8*)(O + (size_t)(row0 + ai * HALF + m * 16) * 256 + col0 + bj * HALF) = __builtin_convertvector(__builtin_shufflevector(v0, v1, 0, 1, 2, 3, 4, 5, 6, 7), h16x8); } }
    }
};
struct EpiGateUp {
    static constexpr bool PERM = true;
    h16* H;
    __device__ __forceinline__ void operator()(const f32x4 (&acc)[2][2][4][2], const Unit& u, int wr, int wc, int fr, int fq) const {
        const int row0 = u.pm * BM + wr * 64 + fr; const int col0 = u.pn * 128 + wc * 16 + 4 * fq;
#pragma unroll
        for (int ai = 0; ai < 2; ++ai)
#pragma unroll
            for (int m = 0; m < 4; ++m) { h16* rowp = H + (size_t)(row0 + ai * HALF + m * 16) * 256 + col0;
#pragma unroll
                for (int bj = 0; bj < 2; ++bj) { const f32x4 v0 = acc[ai][bj][m][0], v1 = acc[ai][bj][m][1];
                    const float h0 = v0[0] / (1.f + __expf(-v0[0])) * v0[1], h1 = v0[2] / (1.f + __expf(-v0[2])) * v0[3];
                    const float h2 = v1[0] / (1.f + __expf(-v1[0])) * v1[1], h3 = v1[2] / (1.f + __expf(-v1[2])) * v1[3];
                    *(h16x4*)(rowp + bj * 64) = __builtin_convertvector((f32x4){h0, h1, h2, h3}, h16x4); } }
    }
};
struct EpiDown {
    static constexpr bool PERM = true;
    h16* Y; const u32x2* rowmeta;
    __device__ __forceinline__ void operator()(const f32x4 (&acc)[2][2][4][2], const Unit& u, int wr, int wc, int fr, int fq) const {
        const int row0 = u.pm * BM + wr * 64 + fr; const int col0 = u.pn * BM + wc * 32 + 8 * fq;
#pragma unroll
        for (int ai = 0; ai < 2; ++ai)
#pragma unroll
            for (int m = 0; m < 4; ++m) { const u32x2 md = rowmeta[row0 + ai * HALF + m * 16]; const int slot = (int)md.x; const float w8 = __uint_as_float(md.y);
                if (slot >= 0) { h16* rowp = Y + (size_t)slot * 1024 + col0;
#pragma unroll
                    for (int bj = 0; bj < 2; ++bj) { const f32x4 v0 = acc[ai][bj][m][0] * w8, v1 = acc[ai][bj][m][1] * w8;
                        *(h16x8*)(rowp + bj * HALF) = __builtin_convertvector(__builtin_shufflevector(v0, v1, 0, 1, 2, 3, 4, 5, 6, 7), h16x8); } }
                asm volatile("" ::: "memory"); }
    }
};

template <class Epi, class Sched>
__device__ __forceinline__ void gemm_phase(PG8_LAS unsigned char* lds, const int K, const Sched& S, const Epi& E, const size_t kstepA = (size_t)(BK * 2)) {
    const int tid = tidx(), wid = __builtin_amdgcn_readfirstlane(tid >> 6), lane = tid & 63, wr = wid >> 2, wc = wid & 3, fr = lane & 15, fq = lane >> 4;
    const int nt = K / BK;
    int R0, C0; stage_rc(tid * 16, R0, C0);
    const unsigned cb2 = (unsigned)C0 * 2u;
    unsigned voffB[2];
#pragma unroll
    for (int i = 0; i < 2; ++i) { const int R = R0 + 64 * i; const int Rb = Epi::PERM ? ((R & ~31) + perm32(R & 31)) : R; voffB[i] = (unsigned)(Rb * K) * 2u + cb2; }
    const size_t kstep = (size_t)(BK * 2);
    const size_t hstep = (size_t)HALF * K * 2;
    const unsigned ldsw = (unsigned)wid * 1024u;
    const int aoff = lds_byte(wr * 64 + fr, fq * 8), boff = lds_byte(wc * 32 + fr, fq * 8);
#define PG8_MKVA(u, va) do { _Pragma("unroll") for (int _h = 0; _h < 2; ++_h) _Pragma("unroll") for (int _i = 0; _i < 2; ++_i) { const int _r = _h * HALF + R0 + 64 * _i; \
        (va)[_h][_i] = ((u).gat ? (u).gat[_r] : (unsigned)(_r * K) * 2u) + cb2; } } while (0)
#define PG8_SA(b, h) (((b) * 2 + (h)) * HTB)
#define PG8_SB(b, h) ((4 + (b) * 2 + (h)) * HTB)
#define PG8_STAGE(bufoff, gbase, voff) do { _Pragma("unroll") for (int _i = 0; _i < 2; ++_i) \
        __builtin_amdgcn_global_load_lds((const unsigned*)((const char*)(gbase) + (voff)[_i]), (PG8_LAS unsigned*)(lds + (bufoff) + ldsw + _i * 8192), 16, 0, 0); } while (0)
#define PG8_LDA(dst, b, h) do { _Pragma("unroll") for (int m = 0; m < 4; ++m) _Pragma("unroll") for (int k = 0; k < 2; ++k) dst[m][k] = *(const PG8_LAS s16x8*)(lds + PG8_SA(b, h) + aoff + m * 2048 + k * 1024); } while (0)
#define PG8_LDB(dst, b, h) do { _Pragma("unroll") for (int n = 0; n < 2; ++n) _Pragma("unroll") for (int k = 0; k < 2; ++k) dst[n][k] = *(const PG8_LAS s16x8*)(lds + PG8_SB(b, h) + boff + n * 2048 + k * 1024); } while (0)
#define PG8_MMA(ai, bj, At, Bt) do { __builtin_amdgcn_s_setprio(1); _Pragma("unroll") for (int m = 0; m < 4; ++m) _Pragma("unroll") for (int n = 0; n < 2; ++n) _Pragma("unroll") for (int k = 0; k < 2; ++k) \
        acc[ai][bj][m][n] = __builtin_amdgcn_mfma_f32_16x16x32_f16(__builtin_bit_cast(h16x8, Bt[n][k]), __builtin_bit_cast(h16x8, At[m][k]), acc[ai][bj][m][n], 0, 0, 0); __builtin_amdgcn_s_setprio(0); } while (0)
#define PG8_WAIT_V(n) asm volatile("s_waitcnt vmcnt(" #n ")" ::: "memory")
#define PG8_WAIT_L(n) asm volatile("s_waitcnt lgkmcnt(" #n ")" ::: "memory")
#define PG8_BAR __builtin_amdgcn_s_barrier()
#define PG8_SCHED __builtin_amdgcn_sched_barrier(0)
    Unit cur, nxt; int ui = 0;
    if (!S.next(0, cur)) return;
    unsigned va[2][2];
    PG8_MKVA(cur, va);
    f32x4 acc[2][2][4][2];
#pragma unroll
    for (int a = 0; a < 2; ++a)
#pragma unroll
        for (int b = 0; b < 2; ++b)
#pragma unroll
            for (int m = 0; m < 4; ++m)
#pragma unroll
                for (int n = 0; n < 2; ++n) acc[a][b][m][n] = (f32x4){0.f, 0.f, 0.f, 0.f};
    s16x8 At[4][2], B0[2][2], B1[2][2];
    const char* cA = cur.A; const char* cB = cur.B;
    {
        PG8_STAGE(PG8_SB(0, 0), cB, voffB); PG8_STAGE(PG8_SB(0, 1), cB + hstep, voffB); PG8_STAGE(PG8_SA(0, 0), cA, va[0]); PG8_STAGE(PG8_SA(0, 1), cA, va[1]);
        if (wr == 1) PG8_BAR;
        PG8_WAIT_V(2); PG8_BAR;
        PG8_STAGE(PG8_SB(1, 0), cB + kstep, voffB); PG8_STAGE(PG8_SA(1, 0), cA + kstepA, va[0]); PG8_STAGE(PG8_SB(1, 1), cB + hstep + kstep, voffB);
        PG8_WAIT_V(6); PG8_BAR;
    }
    for (;;) {
        const bool has_next = S.next(ui + 1, nxt);
        const char* nA = has_next ? nxt.A : cA; const char* nB = has_next ? nxt.B : cB;
#pragma unroll 1
        for (int t = 0; t < nt; t += 2) {
            const bool last = (t == nt - 2);
            const char* a1 = cA + (size_t)(t + 1) * kstepA;
            const char* a2 = last ? nA : cA + (size_t)(t + 2) * kstepA; const char* b2 = last ? nB : cB + (size_t)(t + 2) * kstep;
            const char* a3 = a2 + kstepA; const char* b3 = b2 + kstep;
            PG8_LDB(B0, 0, 0); PG8_LDB(B1, 0, 1); PG8_SCHED; PG8_LDA(At, 0, 0); PG8_STAGE(PG8_SA(1, 1), a1, va[1]);
            if (last && has_next) { PG8_MKVA(nxt, va); }
            PG8_WAIT_V(8); PG8_WAIT_L(0); PG8_BAR; PG8_MMA(0, 0, At, B0); PG8_MMA(0, 1, At, B1); PG8_BAR; PG8_SCHED;
            PG8_LDA(At, 0, 1); PG8_STAGE(PG8_SB(0, 0), b2, voffB); PG8_STAGE(PG8_SB(0, 1), b2 + hstep, voffB); PG8_STAGE(PG8_SA(0, 0), a2, va[0]);
            PG8_WAIT_V(8); PG8_WAIT_L(0); PG8_BAR; PG8_MMA(1, 0, At, B0); PG8_MMA(1, 1, At, B1); PG8_BAR; PG8_SCHED;
            PG8_LDB(B0, 1, 0); PG8_LDB(B1, 1, 1); PG8_SCHED; PG8_LDA(At, 1, 0); PG8_STAGE(PG8_SA(0, 1), a2, va[1]);
            PG8_WAIT_V(8); PG8_WAIT_L(0); PG8_BAR; PG8_MMA(0, 0, At, B0); PG8_MMA(0, 1, At, B1); PG8_BAR; PG8_SCHED;
            PG8_LDA(At, 1, 1); PG8_STAGE(PG8_SB(1, 0), b3, voffB); PG8_STAGE(PG8_SB(1, 1), b3 + hstep, voffB); PG8_STAGE(PG8_SA(1, 0), a3, va[0]);
            PG8_WAIT_V(8); PG8_WAIT_L(0); PG8_BAR; PG8_MMA(1, 0, At, B0); PG8_MMA(1, 1, At, B1); PG8_BAR; PG8_SCHED;
        }
        if (wr == 0) PG8_BAR;
        E(acc, cur, wr, wc, fr, fq);
        if (!has_next) break;
#pragma unroll
        for (int a = 0; a < 2; ++a)
#pragma unroll
            for (int b = 0; b < 2; ++b)
#pragma unroll
                for (int m = 0; m < 4; ++m)
#pragma unroll
                    for (int n = 0; n < 2; ++n) acc[a][b][m][n] = (f32x4){0.f, 0.f, 0.f, 0.f};
        cur = nxt; cA = nA; cB = nB; ++ui;
        if (wr == 1) PG8_BAR;
    }
    PG8_WAIT_V(0);
    PG8_BAR;
#undef PG8_MKVA
#undef PG8_SA
#undef PG8_SB
#undef PG8_STAGE
#undef PG8_LDA
#undef PG8_LDB
#undef PG8_MMA
#undef PG8_WAIT_V
#undef PG8_WAIT_L
#undef PG8_BAR
#undef PG8_SCHED
}
}


#include <hip/hip_cooperative_groups.h>
namespace cg = cooperative_groups;
constexpr int NTHR = 512;
constexpr int LDS_BYTES = 147456;
#define LAS __attribute__((address_space(3)))

struct Params {
    const float *x, *mem; const int* positions;
    const float *w_in, *pe_k, *pe_v, *w1k, *w2k, *w1v, *w2v, *w_out, *ln1g, *ln1b, *w_xq, *w_xkv, *w_xo, *ln2g, *ln2b, *w_router, *rbias, *w_gate, *w_up, *w_down, *ws_gate, *ws_up, *ws_down, *ln3g, *ln3b;
    float* out; unsigned char* ws;
    float lg[4];
    int ph_lo, ph_hi;
};

__device__ __forceinline__ float wave_sum(float v) {
#pragma unroll
    for (int o = 1; o < 64; o <<= 1) v += __shfl_xor(v, o);
    return v;
}
__device__ __forceinline__ float wave_max(float v) {
#pragma unroll
    for (int o = 1; o < 64; o <<= 1) v = fmaxf(v, __shfl_xor(v, o));
    return v;
}
__device__ __forceinline__ float siluf(float v) { return v / (1.f + __expf(-v)); }
__device__ __forceinline__ float sigmf(float v) { return 1.f / (1.f + __expf(-v)); }

__device__ __forceinline__ void b_transpose_tile(const float* __restrict__ W, int K, int N, h16* __restrict__ WT, int Npad, int tile, float* tl, int lt, int rs = 1, int ro = 0) {
    const int ntn = Npad / 32; const int n0 = (tile % ntn) * 32, k0 = (tile / ntn) * 32, tx = lt & 31, ty = lt >> 5;
    for (int i = ty; i < 32; i += 8) { const int k = k0 + i, n = n0 + tx; tl[i * 33 + tx] = (n < N) ? W[(size_t)k * N + n] : 0.f; }
    __syncthreads();
    for (int i = ty; i < 32; i += 8) { const int n = n0 + i, k = k0 + tx; WT[(size_t)(n * rs + ro) * K + k] = (h16)tl[tx * 33 + i]; }
    __syncthreads();
}
__device__ __forceinline__ void w_transpose_item(const float* __restrict__ W, int K, int N, h16* __restrict__ WT, int item, LAS float* scr, int lane, int rs = 1, int ro = 0) {
    const int nblk = N / 32, kb = item / nblk, nb = item % nblk, k0 = 64 * kb, n0 = 32 * nb;
#pragma unroll 8
    for (int i = 0; i < 32; ++i) { const int kk = 2 * i + (lane >> 5); scr[kk * 33 + (lane & 31)] = W[(size_t)(k0 + kk) * N + n0 + (lane & 31)]; }
    asm volatile("s_waitcnt lgkmcnt(0)" ::: "memory");
    const int c = lane & 7;
#pragma unroll
    for (int j = 0; j < 4; ++j) { const int n = (lane >> 3) + 8 * j; LAS const float* s = scr + (8 * c) * 33 + n; h16x8 o;
#pragma unroll
        for (int x = 0; x < 8; ++x) o[x] = (h16)s[x * 33];
        *(h16x8*)(WT + (size_t)((n0 + n) * rs + ro) * K + k0 + 8 * c) = o; }
    asm volatile("s_waitcnt lgkmcnt(0)" ::: "memory");
}
__device__ __forceinline__ void b_cvt(const float* __restrict__ x, h16* __restrict__ o, size_t n4) {
    for (size_t i = (size_t)blockIdx.x * NTHR + tidx(); i < n4; i += (size_t)gridDim.x * NTHR) {
        const f32x4 v = ((const f32x4*)x)[i]; ((h16x4*)o)[i] = __builtin_convertvector(v, h16x4); }
}

__device__ __forceinline__ void b_tables(const int* __restrict__ positions, float* __restrict__ cosr, float* __restrict__ sinr, float* __restrict__ cosn, float* __restrict__ sinn) {
    for (int idx = blockIdx.x * NTHR + tidx(); idx < M * 72; idx += gridDim.x * NTHR) {
        const int m = idx / 72, j = idx % 72; const float pos = (float)positions[m];
        const float inv = j < 64 ? (float)pow(10000.0, -(double)j / 64.0) : (float)pow(500000.0, -(double)(j - 64) / 8.0);
        const float ang = pos * inv; double sd, cd; sincos((double)ang, &sd, &cd);
        if (j < 64) { cosr[(size_t)m * 64 + j] = (float)cd; sinr[(size_t)m * 64 + j] = (float)sd; } else { cosn[(size_t)m * 8 + j - 64] = (float)cd; sinn[(size_t)m * 8 + j - 64] = (float)sd; }
    }
}
__device__ __forceinline__ void b_rope(const h16* __restrict__ h, h16* __restrict__ rqr, h16* __restrict__ rkr, h16* __restrict__ nqr, h16* __restrict__ ksR, h16* __restrict__ kwR, const float* __restrict__ cosr, const float* __restrict__ sinr,
                                       const float* __restrict__ cosn, const float* __restrict__ sinn, int m, int j) {
    const h16* hr = h + (size_t)m * INP; const int bb = m >> 13, t = m & (T - 1);
    {   const int hd = j >> 6, jj = j & 63; const float c = cosr[(size_t)m * 64 + jj], s = sinr[(size_t)m * 64 + jj]; const size_t ro = ((size_t)(bb * 4 + hd) * T + t) * 128;
        const int o1 = hd * 128 + jj, o2 = o1 + 64;
        const float q1 = (float)hr[C_RQ + o1], q2 = (float)hr[C_RQ + o2];
        rqr[ro + jj] = (h16)(q1 * c - q2 * s); rqr[ro + jj + 64] = (h16)(q2 * c + q1 * s);
        const float k1 = (float)hr[C_RK + o1], k2 = (float)hr[C_RK + o2]; const float sc = 0.08838834764831845f;
        rkr[ro + jj] = (h16)((k1 * c - k2 * s) * sc); rkr[ro + jj + 64] = (h16)((k2 * c + k1 * s) * sc);
    }
    if (j < 64 + 16 + 16) {
        const int jj = j & 7; const float c = cosn[(size_t)m * 8 + jj], s = sinn[(size_t)m * 8 + jj];
        if (j < 64) { const int hd = j >> 3; const int o1 = hd * 64 + jj, o2 = o1 + 8;
            const float q1 = (float)hr[C_NQ + o1], q2 = (float)hr[C_NQ + o2];
            nqr[(size_t)m * 512 + o1] = (h16)(q1 * c - q2 * s); nqr[(size_t)m * 512 + o2] = (h16)(q2 * c + q1 * s);
        } else { const int jx = j - 64; const int which = jx >> 4, g = (jx >> 3) & 1; const int base = (which ? C_NKW : C_NKS) + g * 64 + jj;
            const float k1 = (float)hr[base], k2 = (float)hr[base + 8];
            h16* dst = (which ? kwR : ksR) + (((size_t)((bb * 2 + g) * 128 + (t >> 6)) * 64 + (t & 63)) * 64); dst[jj] = (h16)(k1 * c - k2 * s); dst[jj + 8] = (h16)(k2 * c + k1 * s); }
    }
    if (j >= 128 && j < 128 + 96) { const int jx = j - 128; const int which = jx / 48, r = jx % 48, g = r / 24, d = 16 + 2 * (r % 24);
        const int base = (which ? C_NKW : C_NKS) + g * 64 + d; h16* dst = (which ? kwR : ksR) + (((size_t)((bb * 2 + g) * 128 + (t >> 6)) * 64 + (t & 63)) * 64);
        dst[d] = hr[base]; dst[d + 1] = hr[base + 1]; }
    for (int i = j; i < 8 * 48; i += 256) { const int hd = i / 48, d = 16 + i % 48; nqr[(size_t)m * 512 + hd * 64 + d] = hr[C_NQ + hd * 64 + d]; }
}
__device__ __forceinline__ void b_rtrans(const Params& p, const h16* __restrict__ h, h16* __restrict__ rvT, h16* __restrict__ rkzT, const float* __restrict__ cosr, const float* __restrict__ sinr, int item, h16* sl, int lt) {
    int id = item; const int tt = id & 127; id >>= 7; const int hd = id & 3; const int b = id >> 2; const int bh = b * 4 + hd; const float lg = p.lg[hd];
    for (int i = lt; i < 64 * 128; i += 256) { const int t = i >> 7, e = i & 127; sl[t * 130 + e] = h[(size_t)(b * T + tt * 64 + t) * INP + C_RV + hd * 128 + e]; }
    __syncthreads();
    for (int i = lt; i < 64 * 128; i += 256) { const int e = i >> 6, t = i & 63; rvT[((size_t)(bh * 64 + (tt >> 1)) * 128 + e) * 128 + (tt & 1) * 64 + t] = sl[t * 130 + e]; }
    __syncthreads();
    for (int i = lt; i < 64 * 64; i += 256) { const int t = i >> 6, jj = i & 63; const size_t m = (size_t)b * T + tt * 64 + t;
        const float c = cosr[m * 64 + jj], s = sinr[m * 64 + jj]; const float k1 = (float)h[m * INP + C_RK + hd * 128 + jj], k2 = (float)h[m * INP + C_RK + hd * 128 + jj + 64];
        const float z = 0.08838834764831845f * __expf(lg * (float)(127 - ((tt * 64 + t) & 127)));
        sl[t * 130 + jj] = (h16)((k1 * c - k2 * s) * z); sl[t * 130 + jj + 64] = (h16)((k2 * c + k1 * s) * z); }
    __syncthreads();
    for (int i = lt; i < 64 * 128; i += 256) { const int d = i >> 6, t = i & 63; rkzT[((size_t)(bh * 64 + (tt >> 1)) * 128 + d) * 128 + (tt & 1) * 64 + t] = sl[t * 130 + d]; }
    __syncthreads();
}
__device__ __forceinline__ void b_mvtrans(const h16* __restrict__ kvm, h16* __restrict__ kvmVT, h16* __restrict__ kx, int item, h16* sl, int lt) {
    int id = item; const int kt = id & 3; id >>= 2; const int dtl = id & 3; id >>= 2; const int hh = id & 3; const int b = id >> 2;
    for (int i = lt; i < 64 * 64; i += 256) { const int k = i >> 6, d = i & 63; sl[k * 66 + d] = kvm[(size_t)(b * MEML + kt * 64 + k) * 2048 + 1024 + hh * 256 + dtl * 64 + d];
        kx[((size_t)(b * 4 + hh) * MEML + kt * 64 + k) * 256 + dtl * 64 + d] = kvm[(size_t)(b * MEML + kt * 64 + k) * 2048 + hh * 256 + dtl * 64 + d]; }
    __syncthreads();
    for (int i = lt; i < 64 * 64; i += 256) { const int d = i >> 6, k = i & 63; kvmVT[(size_t)((b * 4 + hh) * 256 + dtl * 64 + d) * MEML + kt * 64 + k] = sl[k * 66 + d]; }
    __syncthreads();
}

struct CmpSched {
    const char* hbase; const unsigned* cmpoff; const char* Wc1T; int c;
    __device__ bool next(int i, pg8::Unit& u) const {
        if (i > 0 || c >= 32) return false; const int kv = c >> 4, rt = c & 15;
        u.pm = kv * 16 + rt; u.pn = 0; u.A = hbase + (size_t)(kv ? C_NVC : C_NKC) * 2; u.gat = cmpoff + rt * 256; u.B = Wc1T + (size_t)kv * 256 * 2048 * 2; return true; }
};
__device__ __forceinline__ void b_cmp2(const Params& p, const h16* __restrict__ hid, h16* __restrict__ kcmp, h16* __restrict__ vcmpT) {
    const int lane = tidx() & 63;
    for (int r = blockIdx.x * 8 + (tidx() >> 6); r < 2 * 4096; r += gridDim.x * 8) {
        const int kv = r >> 12, rr = r & 4095, g = rr & 1, c = (rr >> 1) & 511, b = rr >> 10;
        const float* w2 = kv ? p.w2v : p.w2k; const h16* hr = hid + (size_t)r * 256; float acc = 0.f;
        for (int j = 0; j < 256; j += 8) { const h16x8 hv = *(const h16x8*)(hr + j);
#pragma unroll
            for (int x = 0; x < 8; ++x) acc += (float)hv[x] * w2[(j + x) * 64 + lane]; }
        if (c == 511) acc = 0.f;
        if (kv == 0) kcmp[((size_t)(b * 2 + g) * 512 + c) * 64 + lane] = (h16)acc;
        else vcmpT[(((size_t)(b * 2 + g) * 8 + (c >> 6)) * 64 + lane) * 64 + (c & 63)] = (h16)acc;
    }
}
__device__ __forceinline__ void b_vtrans(const h16* __restrict__ h, h16* __restrict__ vsT, h16* __restrict__ vwT, int item, h16* sl, int lt) {
    int id = item; const int tt = id & 127; id >>= 7; const int g = id & 1; id >>= 1; const int b = id & 3; const int which = id >> 2;
    const int col = (which ? C_NVW : C_NVS) + g * 64; h16* dst = (which ? vwT : vsT) + (size_t)((b * 2 + g) * 128 + tt) * 4096;
    for (int i = lt; i < 64 * 64; i += 256) { const int t = i >> 6, d = i & 63; sl[t * 66 + d] = h[(size_t)(b * T + tt * 64 + t) * INP + col + d]; }
    __syncthreads();
    for (int i = lt; i < 64 * 64; i += 256) { const int d = i >> 6, t = i & 63; dst[d * 64 + t] = sl[t * 66 + d]; }
    __syncthreads();
}

__device__ __forceinline__ void ret_kv_unit(const h16* __restrict__ rkzT, const h16* __restrict__ rvT, float* __restrict__ kvT, int chunk, int w, int lane) {
    const int i = lane & 15, kg = lane >> 4; const int bh = chunk >> 6, n = chunk & 63;
    h16x8 a[4];
#pragma unroll
    for (int ks = 0; ks < 4; ++ks) a[ks] = *(const h16x8*)(rkzT + ((size_t)chunk * 128 + 16 * w + i) * 128 + 32 * ks + 8 * kg);
#pragma unroll
    for (int et = 0; et < 8; ++et) { f32x4 acc = {0.f, 0.f, 0.f, 0.f};
#pragma unroll
        for (int ks = 0; ks < 4; ++ks) { const h16x8 bq = *(const h16x8*)(rvT + ((size_t)chunk * 128 + 16 * et + i) * 128 + 32 * ks + 8 * kg); acc = __builtin_amdgcn_mfma_f32_16x16x32_f16(a[ks], bq, acc, 0, 0, 0); }
        *(f32x4*)(kvT + ((size_t)chunk * 128 + 16 * et + i) * 128 + 16 * w + 4 * kg) = acc; }
}
__device__ __forceinline__ void b_ret_scan(const Params& p, const float* __restrict__ kvT, h16* __restrict__ prevT) {
    for (int gid = blockIdx.x * NTHR + tidx(); gid < 16 * 16384; gid += gridDim.x * NTHR) {
        const int de = gid & 16383, bh = gid >> 14; const float cd = __expf(p.lg[bh & 3] * 128.f);
        float st = 0.f;
        for (int n = 0; n < 64; ++n) { const size_t o = ((size_t)(bh * 64 + n) << 14) + de; prevT[o] = (h16)st; st = st * cd + kvT[o]; }
    }
}
__device__ __forceinline__ void ret_out_unit(const Params& p, const h16* __restrict__ h, const h16* __restrict__ rqr, const h16* __restrict__ rkr, const h16* __restrict__ rvT, const h16* __restrict__ prevT,
                                             h16* __restrict__ mix, int chunk, int w, int lane) {
    const int i = lane & 15, kg = lane >> 4; const int bh = chunk >> 6, n = chunk & 63, b = bh >> 2, hd = bh & 3; const float lg = p.lg[hd];
    const int qi = 16 * w + i; const size_t m = (size_t)b * T + n * 128 + qi;
    h16x8 qf[4];
#pragma unroll
    for (int ks = 0; ks < 4; ++ks) qf[ks] = *(const h16x8*)(rqr + ((size_t)bh * T + n * 128 + qi) * 128 + 32 * ks + 8 * kg);
    f32x4 inner[8], cross[8];
#pragma unroll
    for (int et = 0; et < 8; ++et) { inner[et] = (f32x4){0.f, 0.f, 0.f, 0.f}; cross[et] = (f32x4){0.f, 0.f, 0.f, 0.f}; }
    for (int gq = 0; gq < 2; ++gq) {
        if (64 * gq > 16 * w + 15) break;
        f32x4 s[4];
#pragma unroll
        for (int tl = 0; tl < 4; ++tl) { const int ko = 32 * (tl >> 1) + 8 * (i >> 2) + 4 * (tl & 1) + (i & 3); const h16* kp = rkr + ((size_t)bh * T + n * 128 + 64 * gq + ko) * 128 + 8 * kg;
            f32x4 acc = {0.f, 0.f, 0.f, 0.f};
#pragma unroll
            for (int ks = 0; ks < 4; ++ks) acc = __builtin_amdgcn_mfma_f32_16x16x32_f16(*(const h16x8*)(kp + 32 * ks), qf[ks], acc, 0, 0, 0);
            s[tl] = acc; }
        h16x8 pf[2];
#pragma unroll
        for (int tl = 0; tl < 4; ++tl)
#pragma unroll
            for (int r = 0; r < 4; ++r) { const int j = 64 * gq + 32 * (tl >> 1) + 8 * kg + 4 * (tl & 1) + r; const float v = (j <= qi) ? s[tl][r] * __expf(lg * (float)(qi - j)) : 0.f; pf[tl >> 1][4 * (tl & 1) + r] = (h16)v; }
#pragma unroll
        for (int et = 0; et < 8; ++et)
#pragma unroll
            for (int s2 = 0; s2 < 2; ++s2) { const h16x8 a = *(const h16x8*)(rvT + ((size_t)chunk * 128 + 16 * et + i) * 128 + 64 * gq + 32 * s2 + 8 * kg); inner[et] = __builtin_amdgcn_mfma_f32_16x16x32_f16(a, pf[s2], inner[et], 0, 0, 0); }
    }
#pragma unroll
    for (int et = 0; et < 8; ++et)
#pragma unroll
        for (int ks = 0; ks < 4; ++ks) { const h16x8 a = *(const h16x8*)(prevT + ((size_t)chunk * 128 + 16 * et + i) * 128 + 32 * ks + 8 * kg); cross[et] = __builtin_amdgcn_mfma_f32_16x16x32_f16(a, qf[ks], cross[et], 0, 0, 0); }
    const float xi = __expf(lg * (float)(qi + 1));
    float sm = 0.f;
#pragma unroll
    for (int et = 0; et < 8; ++et) { inner[et] = inner[et] + cross[et] * xi; sm += (inner[et][0] + inner[et][1]) + (inner[et][2] + inner[et][3]); }
    sm += __shfl_xor(sm, 16); sm += __shfl_xor(sm, 32);
    const float mu = sm * (1.f / 128.f); float sq = 0.f;
#pragma unroll
    for (int et = 0; et < 8; ++et) { inner[et] = inner[et] - mu; sq += (inner[et][0] * inner[et][0] + inner[et][1] * inner[et][1]) + (inner[et][2] * inner[et][2] + inner[et][3] * inner[et][3]); }
    sq += __shfl_xor(sq, 16); sq += __shfl_xor(sq, 32);
    const float rstd = rsqrtf(sq * (1.f / 128.f) + LN_EPS);
#pragma unroll
    for (int et = 0; et < 8; ++et) { const int e = 16 * et + 4 * kg; const h16x4 gv = *(const h16x4*)(h + m * INP + C_RG + hd * 128 + e);
        f32x4 o;
#pragma unroll
        for (int r = 0; r < 4; ++r) o[r] = siluf((float)gv[r]) * inner[et][r] * rstd;
        *(h16x4*)(mix + m * D + hd * 128 + e) = __builtin_convertvector(o, h16x4); }
}

struct AttSt { float m, l; f32x4 o[4]; };
struct KFrag { h16x8 a[4][2]; };
struct VFrag { h16x8 a[4][2]; };
__device__ __forceinline__ void ldk(KFrag& k, const h16* __restrict__ Kb, int pitchK, int i, int kg) {
#pragma unroll
    for (int tl = 0; tl < 4; ++tl) { const int ko = 32 * (tl >> 1) + 8 * (i >> 2) + 4 * (tl & 1) + (i & 3); const h16* kp = Kb + (size_t)ko * pitchK + 8 * kg;
        k.a[tl][0] = *(const h16x8*)kp; k.a[tl][1] = *(const h16x8*)(kp + 32); }
}
__device__ __forceinline__ void ldv(VFrag& v, const h16* __restrict__ VTb, int vstride, int i, int kg) {
#pragma unroll
    for (int dt = 0; dt < 4; ++dt)
#pragma unroll
        for (int s2 = 0; s2 < 2; ++s2) v.a[dt][s2] = *(const h16x8*)(VTb + (size_t)(16 * dt + i) * vstride + 32 * s2 + 8 * kg);
}
__device__ __forceinline__ float xmax4(float v) {
    auto a = __builtin_amdgcn_permlane16_swap(__float_as_uint(v), __float_as_uint(v), false, false); v = fmaxf(__uint_as_float(a[0]), __uint_as_float(a[1]));
    auto c = __builtin_amdgcn_permlane32_swap(__float_as_uint(v), __float_as_uint(v), false, false); return fmaxf(__uint_as_float(c[0]), __uint_as_float(c[1])); }
__device__ __forceinline__ float xsum4(float v) {
    auto a = __builtin_amdgcn_permlane16_swap(__float_as_uint(v), __float_as_uint(v), false, false); v = __uint_as_float(a[0]) + __uint_as_float(a[1]);
    auto c = __builtin_amdgcn_permlane32_swap(__float_as_uint(v), __float_as_uint(v), false, false); return __uint_as_float(c[0]) + __uint_as_float(c[1]); }
constexpr float ATT_C2 = 0.125f * 1.4426950408889634f;
template <bool MASKED, class MaskF>
__device__ __forceinline__ void att_scores(f32x4 (&s)[4], const KFrag& k, const h16x8 (&qf)[2], int kg, MaskF valid) {
#pragma unroll
    for (int tl = 0; tl < 4; ++tl) { f32x4 z = {0.f, 0.f, 0.f, 0.f}; z = __builtin_amdgcn_mfma_f32_16x16x32_f16(k.a[tl][0], qf[0], z, 0, 0, 0); s[tl] = __builtin_amdgcn_mfma_f32_16x16x32_f16(k.a[tl][1], qf[1], z, 0, 0, 0); }
    if (MASKED) {
#pragma unroll
        for (int tl = 0; tl < 4; ++tl)
#pragma unroll
            for (int r = 0; r < 4; ++r) { const int ko = 32 * (tl >> 1) + 8 * kg + 4 * (tl & 1) + r; s[tl][r] = valid(ko) ? s[tl][r] : -INFINITY; }
    }
}
__device__ __forceinline__ float att_rowmax(const f32x4 (&s)[4]) {
    float mx = fmaxf(fmaxf(s[0][0], s[0][1]), fmaxf(s[0][2], s[0][3]));
#pragma unroll
    for (int tl = 1; tl < 4; ++tl) mx = fmaxf(mx, fmaxf(fmaxf(s[tl][0], s[tl][1]), fmaxf(s[tl][2], s[tl][3])));
    return xmax4(mx);
}
__device__ __forceinline__ void att_pv(f32x4 (&o)[4], const f32x4 (&pv)[4], const VFrag& v) {
    h16x8 pf[2];
#pragma unroll
    for (int s2 = 0; s2 < 2; ++s2)
#pragma unroll
        for (int j = 0; j < 8; ++j) pf[s2][j] = (h16)pv[2 * s2 + (j >> 2)][j & 3];
#pragma unroll
    for (int dt = 0; dt < 4; ++dt)
#pragma unroll
        for (int s2 = 0; s2 < 2; ++s2) o[dt] = __builtin_amdgcn_mfma_f32_16x16x32_f16(v.a[dt][s2], pf[s2], o[dt], 0, 0, 0);
}
template <bool MASKED, class MaskF>
__device__ __forceinline__ void att_tile(AttSt& st, const KFrag& k, const VFrag& v, const h16x8 (&qf)[2], int kg, bool rowok, MaskF valid) {
    f32x4 s[4]; att_scores<MASKED>(s, k, qf, kg, valid);
    const float mx = rowok ? att_rowmax(s) * ATT_C2 : -INFINITY;
    const float mn = fmaxf(st.m, mx);
    if (__any(mn > st.m)) { const float alpha = __builtin_amdgcn_exp2f(st.m - mn); st.m = mn; st.l *= alpha;
#pragma unroll
        for (int dt = 0; dt < 4; ++dt) st.o[dt] = st.o[dt] * alpha; }
    const float mneg = rowok ? -mn : -INFINITY;
    float ps0 = 0.f, ps1 = 0.f;
#pragma unroll
    for (int tl = 0; tl < 4; ++tl) {
#pragma unroll
        for (int r = 0; r < 4; ++r) s[tl][r] = __builtin_amdgcn_exp2f(__builtin_fmaf(s[tl][r], ATT_C2, mneg));
        ps0 += s[tl][0] + s[tl][1]; ps1 += s[tl][2] + s[tl][3]; }
    st.l += ps0 + ps1;
    att_pv(st.o, s, v);
}
constexpr int NSA_NSLOT = 5, NSA_RING = 0, NSA_IMP = NSA_NSLOT * 16384, NSA_MSK = NSA_IMP + 32768, NSA_LIST = NSA_MSK + 256;
__device__ __forceinline__ void ldk_lds(KFrag& k, LAS const unsigned char* slot, int ko0, int ko1) {
#pragma unroll
    for (int tl = 0; tl < 4; ++tl) { const int o = (32 * (tl >> 1) + 4 * (tl & 1)) * 128; k.a[tl][0] = *(LAS const h16x8*)(slot + o + ko0); k.a[tl][1] = *(LAS const h16x8*)(slot + o + ko1); }
}
__device__ __forceinline__ void ldv_lds(VFrag& v, LAS const unsigned char* slot, int vo0, int vo1) {
#pragma unroll
    for (int dt = 0; dt < 4; ++dt) { v.a[dt][0] = *(LAS const h16x8*)(slot + 8192 + dt * 2048 + vo0); v.a[dt][1] = *(LAS const h16x8*)(slot + 8192 + dt * 2048 + vo1); }
}
#define NSA_WAITV(n) asm volatile("s_waitcnt vmcnt(" #n ")" ::: "memory")
#define NSA_BAR() do { asm volatile("s_waitcnt lgkmcnt(0)" ::: "memory"); __builtin_amdgcn_s_barrier(); asm volatile("" ::: "memory"); } while (0)
template <int LPT, class IssueF, class CompF>
__device__ __forceinline__ void nsa_stream(int n, LAS unsigned char* dmaw, LAS unsigned char* ring, IssueF issue, CompF comp) {
#pragma unroll
    for (int j = 0; j < NSA_NSLOT - 1; ++j) if (j < n) issue(j, (LAS unsigned*)(dmaw + j * 16384));
    int st = 0, si = (NSA_NSLOT - 1) * 16384;
    for (int t = 0; t < n; ++t) {
        const int ahead = n - 1 - t;
        if (ahead >= 3) { if (LPT == 2) NSA_WAITV(6); else NSA_WAITV(3); }
        else if (ahead == 2) { if (LPT == 2) NSA_WAITV(4); else NSA_WAITV(2); }
        else if (ahead == 1) { if (LPT == 2) NSA_WAITV(2); else NSA_WAITV(1); }
        else NSA_WAITV(0);
        NSA_BAR();
        if (t + NSA_NSLOT - 1 < n) issue(t + NSA_NSLOT - 1, (LAS unsigned*)(dmaw + si));
        comp(t, (LAS const unsigned char*)(ring + st));
        st = (st == (NSA_NSLOT - 1) * 16384) ? 0 : st + 16384; si = (si == (NSA_NSLOT - 1) * 16384) ? 0 : si + 16384; }
    NSA_BAR();
}
__device__ __forceinline__ void nsa_block_unit(const h16* __restrict__ h, const h16* __restrict__ nqr, const h16* __restrict__ kcmp, const h16* __restrict__ vcmpT, const h16* __restrict__ vsT, const h16* __restrict__ vwT,
                                               const h16* __restrict__ ksR, const h16* __restrict__ kwR, h16* __restrict__ mix, int b, int g, int T0, LAS unsigned char* lds, int wv, int lane) {
    const int i = lane & 15, kg = lane >> 4, tt = i & 3, hh = i >> 2;
    const int t0 = T0 + 4 * wv, trow = t0 + tt; const size_t mrow = (size_t)b * T + trow;
    const int q = wv * 64 + lane, qrow = q >> 3, qch = q & 7;
    const int ksrc = qrow * 128 + ((qch ^ (((qrow >> 1) & 1) | (((qrow >> 3) & 3) << 1))) << 4), vsrc = qrow * 128 + ((qch ^ ((qrow >> 1) & 7)) << 4);
    const int gki = ((i >> 1) & 1) | ((i >> 2) << 1), gvi = (i >> 1) & 7;
    const int ko0 = (8 * (i >> 2) + (i & 3)) * 128 + ((kg ^ gki) << 4), ko1 = (8 * (i >> 2) + (i & 3)) * 128 + (((kg + 4) ^ gki) << 4);
    const int vo0 = i * 128 + ((kg ^ gvi) << 4), vo1 = i * 128 + (((kg + 4) ^ gvi) << 4);
    LAS unsigned char* ring = lds + NSA_RING; LAS unsigned char* dmaw = ring + wv * 1024;
    LAS float* impA = (LAS float*)(lds + NSA_IMP + wv * 4096); LAS float* impL = impA + 512;
    h16x8 qf[2], qrf[2];
    { const h16* qp = h + mrow * INP + C_NQ + (g * 4 + hh) * 64 + 8 * kg; qf[0] = *(const h16x8*)qp; qf[1] = *(const h16x8*)(qp + 32);
      const h16* qrp = nqr + mrow * 512 + (g * 4 + hh) * 64 + 8 * kg; qrf[0] = *(const h16x8*)qrp; qrf[1] = *(const h16x8*)(qrp + 32); }
    const h16* gp = h + mrow * INP + C_NG + (g * 4 + hh) * 3; const float gt0 = (float)gp[0], gt1 = (float)gp[1], gt2 = (float)gp[2];
    for (int x = lane; x < 1024; x += 64) impA[x] = 0.f;
    NSA_WAITV(0);
#define GLDS16(gsrc, ldst) __builtin_amdgcn_global_load_lds((const unsigned*)(gsrc), (ldst), 16, 0, 0)
    const int ncv_row = trow >= 31 ? ((trow - 31) >> 4) + 1 : 0;
    const int ncv_blk = (T0 + 31 >= 31) ? ((T0 + 31 - 31) >> 4) + 1 : 0;
    const int ncv_min = T0 >= 31 ? ((T0 - 31) >> 4) + 1 : 0;
    const int nct = (ncv_blk + 63) >> 6;
    const unsigned char* Kc = (const unsigned char*)(kcmp + (size_t)(b * 2 + g) * 512 * 64); const unsigned char* Vc = (const unsigned char*)(vcmpT + (size_t)(b * 2 + g) * 8 * 4096);
    float m = -1e30f, l = 0.f;
    f32x4 oc[4];
    float linv = 0.f;
    REPS(501) {
    m = -1e30f; l = 0.f;
#pragma unroll
    for (int dt = 0; dt < 4; ++dt) oc[dt] = (f32x4){0.f, 0.f, 0.f, 0.f};
    nsa_stream<1>(nct, dmaw, ring, [&](int j, LAS unsigned* dk) { GLDS16(Kc + (size_t)j * 8192 + ksrc, dk); }, [&](int j, LAS const unsigned char* slot) {
        KFrag kf; ldk_lds(kf, slot, ko0, ko1);
        f32x4 s[4];
        if (64 * j + 63 < ncv_min) att_scores<false>(s, kf, qf, kg, [&](int) { return true; }); else att_scores<true>(s, kf, qf, kg, [&](int ko) { return j * 64 + ko < ncv_row; });
        const float mx = att_rowmax(s) * ATT_C2;
        const float mn = fmaxf(m, mx); float ps0 = 0.f, ps1 = 0.f;
        _Pragma("unroll") for (int tl = 0; tl < 4; ++tl) { ps0 += __builtin_amdgcn_exp2f(__builtin_fmaf(s[tl][0], ATT_C2, -mn)) + __builtin_amdgcn_exp2f(__builtin_fmaf(s[tl][1], ATT_C2, -mn));
                                                          ps1 += __builtin_amdgcn_exp2f(__builtin_fmaf(s[tl][2], ATT_C2, -mn)) + __builtin_amdgcn_exp2f(__builtin_fmaf(s[tl][3], ATT_C2, -mn)); }
        l = l * __builtin_amdgcn_exp2f(m - mn) + (ps0 + ps1); m = mn; });
    l = xsum4(l);
    linv = l > 0.f ? 1.f / l : 0.f;
    nsa_stream<2>(nct, dmaw, ring, [&](int j, LAS unsigned* dk) { GLDS16(Kc + (size_t)j * 8192 + ksrc, dk); GLDS16(Vc + (size_t)j * 8192 + vsrc, (LAS unsigned*)((LAS unsigned char*)dk + 8192)); }, [&](int j, LAS const unsigned char* slot) {
        KFrag kf; ldk_lds(kf, slot, ko0, ko1); VFrag vf; ldv_lds(vf, slot, vo0, vo1);
        f32x4 s[4];
        if (64 * j + 63 < ncv_min) att_scores<false>(s, kf, qf, kg, [&](int) { return true; }); else att_scores<true>(s, kf, qf, kg, [&](int ko) { return j * 64 + ko < ncv_row; });
        _Pragma("unroll") for (int tl = 0; tl < 4; ++tl) {
            _Pragma("unroll") for (int r = 0; r < 4; ++r) s[tl][r] = __builtin_amdgcn_exp2f(__builtin_fmaf(s[tl][r], ATT_C2, -m)) * linv;
            float A = (s[tl][0] + s[tl][1]) + (s[tl][2] + s[tl][3]), L = s[tl][3];
            A += __shfl_xor(A, 4); A += __shfl_xor(A, 8); L += __shfl_xor(L, 4); L += __shfl_xor(L, 8);
            if (hh == 0) { const int u = j * 16 + 8 * (tl >> 1) + 2 * kg + (tl & 1); impA[tt * 128 + u] = A; impL[tt * 128 + u] = L; } }
        att_pv(oc, s, vf); });
    }
    const int cur = T0 >> 6;
    AttSt sw;
    REPS(504) {
    sw.m = -1e30f; sw.l = 0.f;
#pragma unroll
    for (int dt = 0; dt < 4; ++dt) sw.o[dt] = (f32x4){0.f, 0.f, 0.f, 0.f};
    {
        const unsigned char* Kw = (const unsigned char*)(kwR + (size_t)((b * 2 + g) * 128) * 4096); const unsigned char* Vw = (const unsigned char*)(vwT + (size_t)((b * 2 + g) * 128) * 4096);
        const int s0w = (T0 >= 511 ? (T0 - 511) >> 6 : 0);
        nsa_stream<2>(cur - s0w + 1, dmaw, ring, [&](int j, LAS unsigned* dk) { GLDS16(Kw + (size_t)(s0w + j) * 8192 + ksrc, dk); GLDS16(Vw + (size_t)(s0w + j) * 8192 + vsrc, (LAS unsigned*)((LAS unsigned char*)dk + 8192)); }, [&](int j, LAS const unsigned char* slot) {
            KFrag kf; ldk_lds(kf, slot, ko0, ko1); VFrag vf; ldv_lds(vf, slot, vo0, vo1); const int s = s0w + j;
            if (s > s0w + 1 && s < cur) att_tile<false>(sw, kf, vf, qrf, kg, true, [&](int) { return true; });
            else att_tile<true>(sw, kf, vf, qrf, kg, true, [&](int ko) { const int kp = 64 * s + ko; return kp <= trow && kp >= trow - 511; }); });
    }
    }
    unsigned long long mylo, myhi, anylo, anyhi;
    if (cur <= 15) { mylo = anylo = (1ull << (cur + 1)) - 1ull; myhi = anyhi = 0ull; }
    else {
        mylo = myhi = anylo = anyhi = 0ull;
        const unsigned long long flo = 1ull | (cur < 64 ? (1ull << cur) : 0ull) | (cur - 1 < 64 ? (1ull << (cur - 1)) : 0ull);
        const unsigned long long fhi = (cur >= 64 ? (1ull << (cur - 64)) : 0ull) | (cur - 1 >= 64 ? (1ull << (cur - 65)) : 0ull);
        const unsigned long long lmask = (1ull << lane) - 1ull;
        for (int tk = 0; tk < 4; ++tk) {
            const int s0 = lane, s1 = lane + 64;
            const float v0 = impA[tk * 128 + s0] + (s0 > 0 ? impL[tk * 128 + s0 - 1] : 0.f), v1 = impA[tk * 128 + s1] + impL[tk * 128 + s1 - 1];
            const unsigned b0 = (s0 >= 1 && s0 <= cur - 2) ? __float_as_uint(v0) + 1u : 0u, b1 = (s1 <= cur - 2) ? __float_as_uint(v1) + 1u : 0u;
            unsigned Tq = 0u;
            for (int bit = 30; bit >= 0; --bit) { const unsigned T2 = Tq | (1u << bit);
                const int c = __popcll(__ballot(b0 >= T2)) + __popcll(__ballot(b1 >= T2)); if (c >= 13) Tq = T2; }
            const unsigned long long gtlo = __ballot(b0 > Tq), gthi = __ballot(b1 > Tq), eqlo = __ballot(b0 == Tq), eqhi = __ballot(b1 == Tq);
            const int need = 13 - (__popcll(gtlo) + __popcll(gthi));
            const bool t0q = (b0 == Tq) && (__popcll(eqlo & lmask) < need), t1q = (b1 == Tq) && (__popcll(eqlo) + __popcll(eqhi & lmask) < need);
            const unsigned long long lo = gtlo | __ballot(t0q) | flo, hi = gthi | __ballot(t1q) | fhi;
            anylo |= lo; anyhi |= hi; if (tt == tk) { mylo = lo; myhi = hi; }
        }
    }
    LAS unsigned long long* msk = (LAS unsigned long long*)(lds + NSA_MSK); LAS unsigned char* lst = lds + NSA_LIST; LAS int* nlst = (LAS int*)(lds + NSA_LIST + 128);
    if (lane == 0) { msk[2 * wv] = anylo; msk[2 * wv + 1] = anyhi; }
    NSA_BAR();
    if (wv == 0) {
        unsigned long long ulo = 0ull, uhi = 0ull;
#pragma unroll
        for (int w2 = 0; w2 < 8; ++w2) { ulo |= msk[2 * w2]; uhi |= msk[2 * w2 + 1]; }
        const unsigned long long lmask = (1ull << lane) - 1ull; const int nlo = __popcll(ulo);
        if ((ulo >> lane) & 1ull) lst[__popcll(ulo & lmask)] = (unsigned char)lane;
        if ((uhi >> lane) & 1ull) lst[nlo + __popcll(uhi & lmask)] = (unsigned char)(64 + lane);
        if (lane == 0) nlst[0] = nlo + __popcll(uhi);
    }
    NSA_BAR();
    const int nsel = nlst[0];
    AttSt ss;
    REPS(503) {
    ss.m = -1e30f; ss.l = 0.f;
#pragma unroll
    for (int dt = 0; dt < 4; ++dt) ss.o[dt] = (f32x4){0.f, 0.f, 0.f, 0.f};
    {
        const unsigned char* Ks = (const unsigned char*)(ksR + (size_t)((b * 2 + g) * 128) * 4096); const unsigned char* Vs = (const unsigned char*)(vsT + (size_t)((b * 2 + g) * 128) * 4096);
        nsa_stream<2>(nsel, dmaw, ring, [&](int j, LAS unsigned* dk) { const int sj = lst[j]; GLDS16(Ks + (size_t)sj * 8192 + ksrc, dk); GLDS16(Vs + (size_t)sj * 8192 + vsrc, (LAS unsigned*)((LAS unsigned char*)dk + 8192)); }, [&](int j, LAS const unsigned char* slot) {
            const int s = lst[j];
            if ((((s < 64 ? anylo : anyhi) >> (s & 63)) & 1ull) != 0ull) {
                KFrag kf; ldk_lds(kf, slot, ko0, ko1); VFrag vf; ldv_lds(vf, slot, vo0, vo1);
                const bool mybit = (((s < 64 ? mylo : myhi) >> (s & 63)) & 1ull) != 0ull;
                if (s < cur) att_tile<false>(ss, kf, vf, qrf, kg, mybit, [&](int) { return true; });
                else att_tile<true>(ss, kf, vf, qrf, kg, mybit, [&](int ko) { return 64 * s + ko <= trow; }); } });
    }
    }
    const float ls = xsum4(ss.l), lw = xsum4(sw.l);
    const float g0 = sigmf(gt0), g1 = sigmf(gt1) / ls, g2 = sigmf(gt2) / lw;
#pragma unroll
    for (int dt = 0; dt < 4; ++dt) { const f32x4 o = oc[dt] * g0 + ss.o[dt] * g1 + sw.o[dt] * g2;
        *(h16x4*)(mix + mrow * D + 512 + (g * 4 + hh) * 64 + 16 * dt + 4 * kg) = __builtin_convertvector(o, h16x4); }
#undef GLDS16
}

__device__ __forceinline__ void b_ln(const float* __restrict__ in, const float* __restrict__ gam, const float* __restrict__ bet, float* __restrict__ o32, h16* __restrict__ o16) {
    const int lane = tidx() & 63;
    for (int row = blockIdx.x * 8 + (tidx() >> 6); row < M; row += gridDim.x * 8) {
        const f32x4* xr = (const f32x4*)(in + (size_t)row * D) + lane;
        f32x4 v[4]; float s = 0.f;
#pragma unroll
        for (int j = 0; j < 4; ++j) { v[j] = xr[64 * j]; s += (v[j][0] + v[j][1]) + (v[j][2] + v[j][3]); }
        const float mean = wave_sum(s) * (1.f / D); float s2 = 0.f;
#pragma unroll
        for (int j = 0; j < 4; ++j) { v[j] = v[j] - mean; s2 += (v[j][0] * v[j][0] + v[j][1] * v[j][1]) + (v[j][2] * v[j][2] + v[j][3] * v[j][3]); }
        const float rstd = rsqrtf(wave_sum(s2) * (1.f / D) + LN_EPS);
#pragma unroll
        for (int j = 0; j < 4; ++j) { const f32x4 gg = ((const f32x4*)gam)[lane + 64 * j], bb = ((const f32x4*)bet)[lane + 64 * j]; const f32x4 o = v[j] * rstd * gg + bb;
            ((f32x4*)(o32 + (size_t)row * D))[lane + 64 * j] = o;
            if (o16) ((h16x4*)(o16 + (size_t)row * D))[lane + 64 * j] = __builtin_convertvector(o, h16x4); }
    }
}

__device__ __forceinline__ void xattn_block(const h16* __restrict__ qx, const h16* __restrict__ kx, const h16* __restrict__ kvmVT, h16* __restrict__ ox, int G, int bid, LAS unsigned char* lds, int wv, int lane) {
    const int i = lane & 15, kg = lane >> 4;
    const int gki = ((i >> 1) & 1) | ((i >> 2) << 1), gvi = (i >> 1) & 7;
    const int ko0 = (8 * (i >> 2) + (i & 3)) * 512 + ((kg ^ gki) << 4), ko1 = (8 * (i >> 2) + (i & 3)) * 512 + (((kg + 4) ^ gki) << 4);
    const int vo0 = i * 128 + ((kg ^ gvi) << 4), vo1 = i * 128 + (((kg + 4) ^ gvi) << 4);
    const int t = wv * 64 + lane;
    int ksrc[4], vsrc[4];
#pragma unroll
    for (int pz = 0; pz < 4; ++pz) { const int q = pz * 512 + t;
        { const int row = q >> 5, cp = q & 31; const int gk = ((row >> 1) & 1) | (((row >> 3) & 3) << 1); ksrc[pz] = row * 512 + ((cp ^ gk) << 4); }
        { const int row = q >> 3, cp = q & 7; vsrc[pz] = row * 512 + ((cp ^ ((row >> 1) & 7)) << 4); } }
    const int nun = ((M / 128) * 4 - bid + G - 1) / G;
    const int ntile = nun * 4;
    auto issue = [&](int tix, int slot) { const int u = bid + G * (tix >> 2), grp = tix & 3; const int m0 = (u >> 2) * 128, hh = u & 3, b = m0 >> 13;
        const unsigned char* Kb = (const unsigned char*)(kx + ((size_t)(b * 4 + hh) * MEML + 64 * grp) * 256); const unsigned char* Vb = (const unsigned char*)(kvmVT + (size_t)((b * 4 + hh) * 256) * MEML + 64 * grp);
        LAS unsigned char* base = lds + slot * 65536 + wv * 1024;
#pragma unroll
        for (int pz = 0; pz < 4; ++pz) { __builtin_amdgcn_global_load_lds((const unsigned*)(Kb + ksrc[pz]), (LAS unsigned*)(base + pz * 8192), 16, 0, 0);
                                        __builtin_amdgcn_global_load_lds((const unsigned*)(Vb + vsrc[pz]), (LAS unsigned*)(base + 32768 + pz * 8192), 16, 0, 0); } };
    NSA_WAITV(0);
    if (ntile > 0) issue(0, 0);
    h16x8 qf[8]; f32x4 o[16]; float mrun = -1e30f, l = 0.f; size_t mrow = 0; int hh = 0;
    for (int tix = 0; tix < ntile; ++tix) {
        const int grp = tix & 3, slot = tix & 1;
        if (grp == 0) {
            const int u = bid + G * (tix >> 2); mrow = (size_t)((u >> 2) * 128 + wv * 16 + i); hh = u & 3;
#pragma unroll
            for (int ks = 0; ks < 8; ++ks) qf[ks] = *(const h16x8*)(qx + mrow * D + hh * 256 + 32 * ks + 8 * kg);
#pragma unroll
            for (int dt = 0; dt < 16; ++dt) o[dt] = (f32x4){0.f, 0.f, 0.f, 0.f};
            mrun = -1e30f; l = 0.f;
        }
        NSA_WAITV(0);
        NSA_BAR();
        if (tix + 1 < ntile) issue(tix + 1, slot ^ 1);
        LAS const unsigned char* sk = lds + slot * 65536; LAS const unsigned char* sv = sk + 32768;
        f32x4 s[4];
#pragma unroll
        for (int tl = 0; tl < 4; ++tl) { const int ro = (32 * (tl >> 1) + 4 * (tl & 1)) * 512; f32x4 acc = {0.f, 0.f, 0.f, 0.f};
#pragma unroll
            for (int ks = 0; ks < 8; ++ks) acc = __builtin_amdgcn_mfma_f32_16x16x32_f16(*(LAS const h16x8*)(sk + ro + 128 * (ks >> 1) + ((ks & 1) ? ko1 : ko0)), qf[ks], acc, 0, 0, 0);
            s[tl] = acc; }
        const float mx = att_rowmax(s) * (0.0625f * 1.4426950408889634f);
        const float mn = fmaxf(mrun, mx); const float alpha = __builtin_amdgcn_exp2f(mrun - mn); mrun = mn;
        float ps = 0.f; h16x8 pf[2];
#pragma unroll
        for (int tl = 0; tl < 4; ++tl)
#pragma unroll
            for (int r = 0; r < 4; ++r) { const float pe = __builtin_amdgcn_exp2f(__builtin_fmaf(s[tl][r], 0.0625f * 1.4426950408889634f, -mn)); ps += pe; pf[tl >> 1][4 * (tl & 1) + r] = (h16)pe; }
        l = l * alpha + ps;
#pragma unroll
        for (int dt = 0; dt < 16; ++dt) { f32x4 acc = o[dt] * alpha;
            acc = __builtin_amdgcn_mfma_f32_16x16x32_f16(*(LAS const h16x8*)(sv + dt * 2048 + vo0), pf[0], acc, 0, 0, 0);
            acc = __builtin_amdgcn_mfma_f32_16x16x32_f16(*(LAS const h16x8*)(sv + dt * 2048 + vo1), pf[1], acc, 0, 0, 0);
            o[dt] = acc; }
        if (grp == 3) { const float linv = 1.f / xsum4(l);
#pragma unroll
            for (int dt = 0; dt < 16; ++dt) { const f32x4 acc = o[dt] * linv; *(h16x4*)(ox + mrow * D + hh * 256 + 16 * dt + 4 * kg) = __builtin_convertvector(acc, h16x4); } }
    }
    NSA_WAITV(0);
    NSA_BAR();
}

__device__ __forceinline__ void route_token(float logit, int m, int lane, const float* __restrict__ rbias, int* __restrict__ tope, float* __restrict__ topw, int* __restrict__ hist) {
    const float score = 1.f / (1.f + expf(-logit)); const float biased = score + rbias[lane];
    float m1 = biased; m1 = fmaxf(m1, __shfl_xor(m1, 1)); m1 = fmaxf(m1, __shfl_xor(m1, 2)); m1 = fmaxf(m1, __shfl_xor(m1, 4));
    int am = (biased == m1) ? lane : 999; am = min(am, __shfl_xor(am, 1)); am = min(am, __shfl_xor(am, 2)); am = min(am, __shfl_xor(am, 4));
    float m2 = (lane == am) ? -INFINITY : biased; m2 = fmaxf(m2, __shfl_xor(m2, 1)); m2 = fmaxf(m2, __shfl_xor(m2, 2)); m2 = fmaxf(m2, __shfl_xor(m2, 4));
    const float gs = m1 + m2;
    int cnt = 0;
#pragma unroll
    for (int gq = 0; gq < 8; ++gq) { const float o = __shfl(gs, gq * 8); cnt += (o > gs) ? 1 : 0; }
    const float masked = (cnt <= 3) ? biased : NEGF;
    int rank = 0;
    for (int e2 = 0; e2 < 64; ++e2) { const float o = __shfl(masked, e2); rank += (o > masked || (o == masked && e2 < lane)) ? 1 : 0; }
    const bool selq = rank < 8;
    const float wsum = wave_sum(selq ? score : 0.f);
    if (selq) { tope[(size_t)m * 8 + rank] = lane; topw[(size_t)m * 8 + rank] = score / wsum * 2.5f; atomicAdd(hist + (m >> 13) * 65 + lane, 1); }
}
__device__ __forceinline__ void router_unit(const Params& p, const float* __restrict__ pre, h16* __restrict__ x2h, const h16* __restrict__ WrTh, const h16* __restrict__ WrTl, int* __restrict__ tope, float* __restrict__ topw,
                                            int* __restrict__ hist, int m0, LAS float* lg, int lane) {
    const int i = lane & 15, kg = lane >> 4;
    const float* xr = pre + (size_t)(m0 + i) * D + 8 * kg;
    float s1 = 0.f, s2 = 0.f;
#pragma unroll 4
    for (int ks = 0; ks < 32; ++ks) { const f32x4 x0 = *(const f32x4*)(xr + 32 * ks), x1 = *(const f32x4*)(xr + 32 * ks + 4);
        s1 += (x0[0] + x0[1]) + (x0[2] + x0[3]) + (x1[0] + x1[1]) + (x1[2] + x1[3]);
        s2 += (x0[0] * x0[0] + x0[1] * x0[1]) + (x0[2] * x0[2] + x0[3] * x0[3]) + (x1[0] * x1[0] + x1[1] * x1[1]) + (x1[2] * x1[2] + x1[3] * x1[3]); }
    s1 = xsum4(s1); s2 = xsum4(s2);
    const float mean = s1 * (1.f / D); const float rstd = rsqrtf(fmaxf(s2 * (1.f / D) - mean * mean, 0.f) + LN_EPS);
    f32x4 am_[4], ac_[4];
#pragma unroll
    for (int et = 0; et < 4; ++et) { am_[et] = (f32x4){0.f, 0.f, 0.f, 0.f}; ac_[et] = (f32x4){0.f, 0.f, 0.f, 0.f}; }
    h16* xo = x2h + (size_t)(m0 + i) * D + 8 * kg;
#pragma unroll 2
    for (int ks = 0; ks < 32; ++ks) {
        f32x4 x0 = *(const f32x4*)(xr + 32 * ks), x1 = *(const f32x4*)(xr + 32 * ks + 4);
        const f32x4 g0 = *(const f32x4*)(p.ln2g + 32 * ks + 8 * kg), g1 = *(const f32x4*)(p.ln2g + 32 * ks + 8 * kg + 4), b0 = *(const f32x4*)(p.ln2b + 32 * ks + 8 * kg), b1 = *(const f32x4*)(p.ln2b + 32 * ks + 8 * kg + 4);
        x0 = (x0 - mean) * rstd * g0 + b0; x1 = (x1 - mean) * rstd * g1 + b1;
        h16x8 xh, xl;
#pragma unroll
        for (int j = 0; j < 4; ++j) { xh[j] = (h16)x0[j]; xl[j] = (h16)((x0[j] - (float)xh[j]) * 2048.f); xh[4 + j] = (h16)x1[j]; xl[4 + j] = (h16)((x1[j] - (float)xh[4 + j]) * 2048.f); }
        *(h16x8*)(xo + 32 * ks) = xh;
#pragma unroll
        for (int et = 0; et < 4; ++et) { const h16x8 wh = *(const h16x8*)(WrTh + (size_t)(16 * et + i) * D + 32 * ks + 8 * kg), wl = *(const h16x8*)(WrTl + (size_t)(16 * et + i) * D + 32 * ks + 8 * kg);
            am_[et] = __builtin_amdgcn_mfma_f32_16x16x32_f16(wh, xh, am_[et], 0, 0, 0);
            ac_[et] = __builtin_amdgcn_mfma_f32_16x16x32_f16(wh, xl, ac_[et], 0, 0, 0);
            ac_[et] = __builtin_amdgcn_mfma_f32_16x16x32_f16(wl, xh, ac_[et], 0, 0, 0); }
    }
#pragma unroll
    for (int et = 0; et < 4; ++et)
#pragma unroll
        for (int r = 0; r < 4; ++r) lg[i * 64 + 16 * et + 4 * kg + r] = am_[et][r] + ac_[et][r] * (1.f / 2048.f);
    for (int tk = 0; tk < 16; ++tk) route_token(lg[tk * 64 + lane], m0 + tk, lane, p.rbias, tope, topw, hist);
}

__device__ __forceinline__ void b_moe(const Params& p, const float* __restrict__ x2, const int* __restrict__ tope, const float* __restrict__ topw, float* __restrict__ out, int m, float* sl, int tid) {
    float* xs = sl; float* hd = sl + 1024; float* red = sl + 1280;
    for (int i = tid; i < 1024; i += 256) xs[i] = x2[(size_t)m * D + i];
    __syncthreads();
    float acc[4] = {0.f, 0.f, 0.f, 0.f};
    for (int kx = 0; kx < 9; ++kx) {
        const float* G; const float* U; const float* Dn; float wt;
        if (kx < 8) { const int e = tope[(size_t)m * 8 + kx]; wt = topw[(size_t)m * 8 + kx]; G = p.w_gate + (size_t)e * D * EFF; U = p.w_up + (size_t)e * D * EFF; Dn = p.w_down + (size_t)e * EFF * D; }
        else { wt = 1.f; G = p.ws_gate; U = p.ws_up; Dn = p.ws_down; }
        float a = 0.f, u = 0.f;
        for (int k = 0; k < D; ++k) { const float xv = xs[k]; a += xv * G[(size_t)k * EFF + tid]; u += xv * U[(size_t)k * EFF + tid]; }
        hd[tid] = siluf(a) * u * wt;
        __syncthreads();
        for (int j = 0; j < EFF; ++j) { const float hv = hd[j]; const float* dr = Dn + (size_t)j * D + tid;
            acc[0] += hv * dr[0]; acc[1] += hv * dr[256]; acc[2] += hv * dr[512]; acc[3] += hv * dr[768]; }
        __syncthreads();
    }
    float v[4]; float s = 0.f;
#pragma unroll
    for (int i = 0; i < 4; ++i) { v[i] = DN_ALPHA * xs[tid + 256 * i] + acc[i]; s += v[i]; }
    s = wave_sum(s); if ((tid & 63) == 0) red[tid >> 6] = s; __syncthreads();
    const float mean = (red[0] + red[1] + red[2] + red[3]) * (1.f / D); float s2 = 0.f;
#pragma unroll
    for (int i = 0; i < 4; ++i) { v[i] -= mean; s2 += v[i] * v[i]; }
    s2 = wave_sum(s2); if ((tid & 63) == 0) red[4 + (tid >> 6)] = s2; __syncthreads();
    const float rstd = rsqrtf((red[4] + red[5] + red[6] + red[7]) * (1.f / D) + LN_EPS);
#pragma unroll
    for (int i = 0; i < 4; ++i) out[(size_t)m * D + tid + 256 * i] = v[i] * rstd * p.ln3g[tid + 256 * i] + p.ln3b[tid + 256 * i];
    __syncthreads();
}

struct G1Sched {
    const int* ctl; const char* x2h; const unsigned* rowoff; const char* WguT; int G, c;
    __device__ bool next(int i, pg8::Unit& u) const {
        const int ntile = ctl[CTL_TQS + NQ]; const long L = (long)i * G + c; if (L >= 2L * ntile) return false;
        const int tile = (int)(L >> 1), pn = (int)(L & 1); const int e = ctl[CTL_TVE + tile] % 65;
        u.pm = tile; u.pn = pn; u.A = x2h; u.gat = rowoff + (size_t)tile * 256; u.B = WguT + ((size_t)e * 512 + pn * 256) * (D * 2); return true; }
};
struct G2Sched {
    const int* ctl; const char* H; const char* WdT; int q, G, c;
    __device__ bool next(int i, pg8::Unit& u) const {
        const int t0 = ctl[CTL_TQS + q], t1 = ctl[CTL_TQS + q + 1]; const long L = (long)i * G + c; if (L >= 4L * (t1 - t0)) return false;
        const int tile = t0 + (int)(L >> 2), pn = (int)(L & 3); const int e = ctl[CTL_TVE + tile] % 65;
        u.pm = tile; u.pn = pn; u.A = H + (size_t)tile * 256 * (EFF * 2); u.gat = nullptr; u.B = WdT + ((size_t)e * D + pn * 256) * (EFF * 2); return true; }
};
__device__ __forceinline__ void b_scatter(int* __restrict__ ctl, const int* __restrict__ tope, const float* __restrict__ topw, unsigned* __restrict__ rowoff, u32x2* __restrict__ rowmeta, int* sl) {
    int* pst = sl;
    if (tidx() == 0) { int acc = 0; for (int v = 0; v < NVE; ++v) { pst[v] = acc; acc += (ctl[CTL_CNT + v] + 255) & ~255; } pst[NVE] = acc; }
    __syncthreads();
    if (blockIdx.x == 0) {
        for (int v = tidx(); v <= NVE; v += NTHR) ctl[CTL_PST + v] = pst[v];
        if (tidx() <= NQ) ctl[CTL_TQS + tidx()] = pst[tidx() * 65] >> 8;
        for (int v = tidx(); v < NVE; v += NTHR) for (int tl = pst[v] >> 8; tl < (pst[v + 1] >> 8); ++tl) ctl[CTL_TVE + tl] = v;
    }
    for (int idx = blockIdx.x * NTHR + tidx(); idx < M * 9; idx += gridDim.x * NTHR) {
        int m, k, pos; float w;
        if (idx < M * 8) { m = idx >> 3; k = idx & 7; const int ve = (m >> 13) * 65 + tope[idx]; w = topw[idx]; pos = pst[ve] + atomicAdd(ctl + CTL_CUR + ve, 1); }
        else { m = idx - M * 8; k = 8; w = 1.f; pos = pst[(m >> 13) * 65 + 64] + (m & (QT - 1)); }
        rowoff[pos] = (unsigned)m * (D * 2); rowmeta[pos] = (u32x2){(unsigned)((m & (QT - 1)) * 9 + k), __float_as_uint(w)};
    }
    __syncthreads();
}
__device__ __forceinline__ void b_combine(const Params& p, const h16* __restrict__ x2h, const h16* __restrict__ Y, int q) {
    const int lane = tidx() & 63;
    for (int r = blockIdx.x * 8 + (tidx() >> 6); r < QT; r += gridDim.x * 8) {
        const int m = q * QT + r;
        float v[16];
        { const h16x8 a = ((const h16x8*)(x2h + (size_t)m * D))[lane], b = ((const h16x8*)(x2h + (size_t)m * D))[lane + 64];
#pragma unroll
          for (int i = 0; i < 8; ++i) { v[i] = DN_ALPHA * (float)a[i]; v[8 + i] = DN_ALPHA * (float)b[i]; } }
#pragma unroll
        for (int k = 0; k < 9; ++k) { const h16x8* yr = (const h16x8*)(Y + ((size_t)r * 9 + k) * D); const h16x8 a = yr[lane], b = yr[lane + 64];
#pragma unroll
            for (int i = 0; i < 8; ++i) { v[i] += (float)a[i]; v[8 + i] += (float)b[i]; } }
        float s = 0.f;
#pragma unroll
        for (int i = 0; i < 16; ++i) s += v[i];
        const float mean = wave_sum(s) * (1.f / D); float s2 = 0.f;
#pragma unroll
        for (int i = 0; i < 16; ++i) { v[i] -= mean; s2 += v[i] * v[i]; }
        const float rstd = rsqrtf(wave_sum(s2) * (1.f / D) + LN_EPS);
#pragma unroll
        for (int hlf = 0; hlf < 2; ++hlf) { const int c0 = (lane + 64 * hlf) * 8;
            const f32x4 g0 = *(const f32x4*)(p.ln3g + c0), g1 = *(const f32x4*)(p.ln3g + c0 + 4), b0 = *(const f32x4*)(p.ln3b + c0), b1 = *(const f32x4*)(p.ln3b + c0 + 4);
            f32x4 o0, o1;
#pragma unroll
            for (int i = 0; i < 4; ++i) { o0[i] = v[8 * hlf + i] * rstd * g0[i] + b0[i]; o1[i] = v[8 * hlf + 4 + i] * rstd * g1[i] + b1[i]; }
            *(f32x4*)(p.out + (size_t)m * D + c0) = o0; *(f32x4*)(p.out + (size_t)m * D + c0 + 4) = o1; }
    }
}

#define XB_TMO      128
#define XB_XCNT(j)  (256  + 64 * (j))
#define XB_XSUB(j)  (1280 + 64 * (j))
#define XB_XGEN(j)  (2304 + 64 * (j))
#define XB_TOP      3328
#define XB_TOPGEN   3392
#define XCD_BAR_WORDS 3456
#define XB_SPIN_CAP (1u << 22)
__device__ __forceinline__ unsigned xb_ld(unsigned* p)              { return __hip_atomic_load(p, __ATOMIC_RELAXED, __HIP_MEMORY_SCOPE_AGENT); }
__device__ __forceinline__ unsigned xb_add(unsigned* p, unsigned v) { return __hip_atomic_fetch_add(p, v, __ATOMIC_RELAXED, __HIP_MEMORY_SCOPE_AGENT); }
__device__ __forceinline__ unsigned xb_xcc_id() { return (unsigned)__builtin_amdgcn_s_getreg((3 << 11) | 20) & 0xFu; }
#define XB_SPIN(cond, bar) do { unsigned _sp = 0; while (cond) { __builtin_amdgcn_s_sleep(1); \
    if ((++_sp & 255u) == 0u) { if (xb_ld(&(bar)[XB_TMO])) break; if (_sp > XB_SPIN_CAP) { atomicAdd(&(bar)[XB_TMO], 1u); break; } } } } while (0)
struct XcdBarrier { unsigned* bar; unsigned x; volatile LAS unsigned* st; };
__device__ __forceinline__ XcdBarrier xcd_barrier_post(unsigned* bar, volatile LAS unsigned* st) {
    XcdBarrier b; b.bar = bar; b.x = xb_xcc_id(); b.st = st;
    if (threadIdx.x == 0) (void)xb_add(&bar[XB_XCNT(b.x)], 1u);
    return b;
}
__device__ __forceinline__ void xcd_barrier_complete(unsigned* bar, unsigned x, unsigned& nloc, unsigned& nx) {
    const unsigned G = gridDim.x * gridDim.y * gridDim.z;
    unsigned sum, cnt, mine, sp = 0u;
    for (;;) {
        sum = 0u; cnt = 0u; mine = 0u;
#pragma unroll
        for (unsigned j = 0; j < 16; ++j) { const unsigned c = xb_ld(&bar[XB_XCNT(j)]); sum += c; cnt += (c > 0u) ? 1u : 0u; mine = (j == x) ? c : mine; }
        if (sum == G) break;
        __builtin_amdgcn_s_sleep(1);
        if ((++sp & 255u) == 0u) { if (xb_ld(&bar[XB_TMO])) break; if (sp > XB_SPIN_CAP) { atomicAdd(&bar[XB_TMO], 1u); break; } }
    }
    nloc = mine > 0u ? mine : 1u; nx = cnt > 0u ? cnt : 1u;
}
__device__ __forceinline__ void xcd_barrier(const XcdBarrier& b) {
    asm volatile("s_waitcnt vmcnt(0)" ::: "memory");
    __syncthreads();
    if (threadIdx.x == 0) {
        unsigned* bar = b.bar;
        __builtin_amdgcn_s_waitcnt(0);
        unsigned nloc = b.st[0], nx = b.st[1];
        if (nloc == 0u) { xcd_barrier_complete(bar, b.x, nloc, nx); b.st[0] = nloc; b.st[1] = nx; }
        const unsigned old = xb_add(&bar[XB_XSUB(b.x)], 1u);
        const unsigned gen = old / nloc;
        if (old + 1u == (gen + 1u) * nloc) {
            __builtin_amdgcn_fence(__ATOMIC_RELEASE, "agent");
            asm volatile("s_waitcnt vmcnt(0)" ::: "memory");
            const unsigned og = xb_add(&bar[XB_TOP], 1u);
            const unsigned tg = og / nx;
            if (og + 1u == (tg + 1u) * nx) xb_add(&bar[XB_TOPGEN], 1u);
            else XB_SPIN(xb_ld(&bar[XB_TOPGEN]) == tg, bar);
            __builtin_amdgcn_fence(__ATOMIC_ACQUIRE, "agent");
            xb_add(&bar[XB_XGEN(b.x)], 1u);
            asm volatile("s_waitcnt vmcnt(0)" ::: "memory");
        } else {
            XB_SPIN(xb_ld(&bar[XB_XGEN(b.x)]) == gen, bar);
            __builtin_amdgcn_fence(__ATOMIC_ACQUIRE, "agent");
            asm volatile("s_waitcnt vmcnt(0)" ::: "memory");
        }
    }
    __syncthreads();
}

constexpr int N_PHASES = 23;

__global__ void __launch_bounds__(NTHR, 2) mega_fwd(Params p) {
    extern __shared__ __attribute__((aligned(16))) unsigned char lds[];
    cg::grid_group grid = cg::this_grid();
    const int G = (int)gridDim.x, bid = (int)blockIdx.x;
#define tid tidx()
    unsigned char* ws = p.ws;
    h16* WinT = (h16*)(ws + WS_WIN); h16* WoutT = (h16*)(ws + WS_WOUT); h16* WxqT = (h16*)(ws + WS_WXQ); h16* WxoT = (h16*)(ws + WS_WXO); h16* WxkvT = (h16*)(ws + WS_WXKV);
    h16* memh = (h16*)(ws + WS_MEMH); h16* kvm = (h16*)(ws + WS_KVM); h16* kcmp = (h16*)(ws + WS_KCMP); h16* vcmpT = (h16*)(ws + WS_VCMP); h16* vsT = (h16*)(ws + WS_VST); h16* vwT = (h16*)(ws + WS_VWT);
    int* tope = (int*)(ws + WS_TOPE); float* topw = (float*)(ws + WS_TOPW);
    h16* xh = (h16*)(ws + WS_XH); h16* mix = (h16*)(ws + WS_MIX); h16* ox = (h16*)(ws + WS_OX); h16* hb = (h16*)(ws + WS_H); h16* nqr = (h16*)(ws + WS_NQR);
    float* kvb = (float*)(ws + WS_KVB); h16* prevT = (h16*)(ws + WS_PREVT);
    float* cosr = (float*)(ws + WS_COSR); float* sinr = (float*)(ws + WS_SINR); float* cosn = (float*)(ws + WS_COSN); float* sinn = (float*)(ws + WS_SINN); h16* kvmVT = (h16*)(ws + WS_KVMVT); h16* WrTh = (h16*)(ws + WS_WRTH); h16* WrTl = (h16*)(ws + WS_WRTL); h16* Wc1T = (h16*)(ws + WS_WC1T); h16* hid = (h16*)(ws + WS_HID); unsigned* cmpoff = (unsigned*)(ws + WS_CMPOFF); float* peb = (float*)(ws + WS_PEB); h16* ksR = (h16*)(ws + WS_KSR); h16* kwR = (h16*)(ws + WS_KWR); h16* kx = (h16*)(ws + WS_KX);
    h16* rqr = (h16*)((unsigned char*)p.out + DO_RQR); h16* rkr = (h16*)((unsigned char*)p.out + DO_RKR); h16* rkzT = (h16*)((unsigned char*)p.out + DO_RKZT); h16* rvT = (h16*)((unsigned char*)p.out + DO_RVT); float* pre = p.out; float* x1 = (float*)(ws + WS_X1); h16* x1h = (h16*)(ws + WS_X1H);
    h16* qx = (h16*)(ws + WS_QX); float* x2 = (float*)(ws + WS_X2); h16* x2h = (h16*)(ws + WS_X2H);
    int* ctl = (int*)ws; unsigned* rowoff = (unsigned*)(ws + WS_ROWOFF); u32x2* rowmeta = (u32x2*)(ws + WS_ROWMETA);
    h16* WguT = (h16*)(ws + WS_WGUT); h16* WdT = (h16*)(ws + WS_WDT); h16* Hm = (h16*)(ws + WS_HM); h16* Yq = (h16*)(ws + WS_Y);
    float* fl = (float*)lds;
    const int lo = p.ph_lo, hi = p.ph_hi;
#define IN(k) (lo <= (k) && (k) < hi)
    { volatile LAS unsigned* st = (volatile LAS unsigned*)((LAS unsigned char*)lds + 131072); if (threadIdx.x < 2) st[threadIdx.x] = 0u; }
    __syncthreads();
    XcdBarrier xbar = xcd_barrier_post((unsigned*)(ws + WS_BAR), (volatile LAS unsigned*)((LAS unsigned char*)lds + 131072));
#define SEAM(k) do { if (IN(k) && IN((k) + 1)) { if ((k) == 0) grid.sync(); else xcd_barrier(xbar); } } while (0)

    if (IN(0)) REPS(0) {
        { const int sub = tid >> 8, lt = tid & 255; float* tl = fl + sub * 1088;
          constexpr int T0 = (INP / 32) * (D / 32);
          for (int b0 = bid * 2; b0 < T0; b0 += G * 2) b_transpose_tile(p.w_in, D, INC, WinT, INP, b0 + sub, tl, lt); }
        { const int wv = __builtin_amdgcn_readfirstlane(tid >> 6), lane = tid & 63; LAS float* scr = (LAS float*)((LAS unsigned char*)lds + wv * 8704);
          constexpr int I1 = (D / 64) * (D / 32), I4 = (D / 64) * (2 * D / 32), I5 = (2048 / 64) * (256 / 32), IT = 3 * I1 + I4 + 2 * I5;
          for (int it0 = bid * 8 + wv; it0 < IT; it0 += G * 8) { int it = it0;
            if (it < I1) { w_transpose_item(p.w_out, D, D, WoutT, it, scr, lane); continue; } it -= I1;
            if (it < I1) { w_transpose_item(p.w_xq, D, D, WxqT, it, scr, lane); continue; } it -= I1;
            if (it < I1) { w_transpose_item(p.w_xo, D, D, WxoT, it, scr, lane); continue; } it -= I1;
            if (it < I4) { w_transpose_item(p.w_xkv, D, 2 * D, WxkvT, it, scr, lane); continue; } it -= I4;
            if (it < I5) { w_transpose_item(p.w1k, 2048, 256, Wc1T, it, scr, lane); continue; } it -= I5;
            w_transpose_item(p.w1v, 2048, 256, Wc1T + 256 * 2048, it, scr, lane); } }
        __syncthreads();
        b_cvt(p.x, xh, (size_t)M * D / 4);
        b_cvt(p.mem, memh, (size_t)NB * MEML * D / 4);
        if (bid == 0) for (int i = tid; i < 1024; i += NTHR) ctl[i] = 0;
        b_tables(p.positions, cosr, sinr, cosn, sinn);
        for (int idx = bid * NTHR + tid; idx < NE * D; idx += G * NTHR) { const int e = idx >> 10, k = idx & 1023; const float w = p.w_router[k * NE + e]; const h16 hi = (h16)w; WrTh[idx] = hi; WrTl[idx] = (h16)((w - (float)hi) * 2048.f); }
        for (int r = bid * NTHR + tid; r < 4096; r += G * NTHR) { const int g = r & 1, c = min((r >> 1) & 511, 510), b = r >> 10; cmpoff[r] = (unsigned)(((size_t)(b * T + 16 * c) * INP + g * 64) * 2); }
        { const int lane = tid & 63;
          for (int o = bid * 8 + (tid >> 6); o < 512; o += G * 8) { const int kv = o >> 8, j = o & 255; const float* pe = kv ? p.pe_v : p.pe_k; const float* w1 = kv ? p.w1v : p.w1k; float a = 0.f;
              for (int k = lane; k < 2048; k += 64) a += pe[k] * w1[(size_t)k * 256 + j];
              a = wave_sum(a); if (lane == 0) peb[o] = a; } }
    }
    SEAM(0);
    if (IN(1)) {
        REPS(1) { pg8::Gemm g{xh, WinT, M, INP, D}; pg8::StaticOrder S; S.init(g, G, bid); pg8::EpiF16 E{hb, INP};
          pg8::gemm_phase<pg8::EpiF16, pg8::StaticOrder>((PG8_LAS unsigned char*)lds, g.K, S, E); }
        { pg8::Gemm g{memh, WxkvT, NB * MEML, 2 * D, D}; pg8::StaticOrder S; S.init(g, G, bid); pg8::EpiF16 E{kvm, 2 * D};
          pg8::gemm_phase<pg8::EpiF16, pg8::StaticOrder>((PG8_LAS unsigned char*)lds, g.K, S, E); }
    }
    SEAM(1);
    if (IN(2)) REPS(2) {
        if (bid < 32) { CmpSched S{(const char*)hb, cmpoff, (const char*)Wc1T, bid}; pg8::EpiCmp1 E{hid, peb + (bid >> 4) * 256};
            pg8::gemm_phase<pg8::EpiCmp1, CmpSched>((PG8_LAS unsigned char*)lds, 2048, S, E, (size_t)INP * 2); }
        else { const int sub = tid >> 8, lt = tid & 255; const int b2 = bid - 32, G2 = G - 32;
        for (int b0 = b2 * 2; b0 < M; b0 += G2 * 2) b_rope(hb, rqr, rkr, nqr, ksR, kwR, cosr, sinr, cosn, sinn, b0 + sub, lt);
        for (int b0 = b2 * 2; b0 < 2 * NB * 2 * 128; b0 += G2 * 2) b_vtrans(hb, vsT, vwT, b0 + sub, (h16*)(fl + sub * 2304), lt);
        for (int b0 = b2 * 2; b0 < NB * 4 * 128; b0 += G2 * 2) b_rtrans(p, hb, rvT, rkzT, cosr, sinr, b0 + sub, (h16*)(fl + sub * 4224), lt);
        for (int b0 = b2 * 2; b0 < NB * 4 * 16; b0 += G2 * 2) b_mvtrans(kvm, kvmVT, kx, b0 + sub, (h16*)(fl + sub * 2304), lt); } }
    SEAM(2);
    if (IN(3)) {
        REPS(30) b_cmp2(p, hid, kcmp, vcmpT);
        const int wv = __builtin_amdgcn_readfirstlane(tid >> 6), lane = tid & 63;
        REPS(31) for (int ch = bid; ch < NB * 4 * 64; ch += G) ret_kv_unit(rkzT, rvT, kvb, ch, wv, lane); }
    SEAM(3);
    if (IN(4)) {
        REPS(4) b_ret_scan(p, kvb, prevT);
        const int wv = __builtin_amdgcn_readfirstlane(tid >> 6), lane = tid & 63;
        __syncthreads();
        REPS(50) { const int bg = bid & 7;
            for (int k = bid >> 3; k < T / 32; k += (G >> 3)) nsa_block_unit(hb, nqr, kcmp, vcmpT, vsT, vwT, ksR, kwR, mix, bg >> 1, bg & 1, (T / 32 - 1 - k) * 32, (LAS unsigned char*)lds, wv, lane); }
    }
    SEAM(4);
    if (IN(5)) {
        const int wv = __builtin_amdgcn_readfirstlane(tid >> 6), lane = tid & 63;
        REPS(51) for (int ch = bid; ch < NB * 4 * 64; ch += G) ret_out_unit(p, hb, rqr, rkr, rvT, prevT, mix, ch, wv, lane);
    }
    SEAM(5);
    if (IN(6)) { pg8::Gemm g{mix, WoutT, M, D, D}; pg8::StaticOrder S; S.init(g, G, bid); pg8::EpiResF32 E{pre, p.x, D, DN_ALPHA};
        pg8::gemm_phase<pg8::EpiResF32, pg8::StaticOrder>((PG8_LAS unsigned char*)lds, g.K, S, E); }
    SEAM(6);
    if (PROBE_DBL == 900) { for (int k = 0; k < 20; ++k) xcd_barrier(xbar); }
    if (IN(7)) REPS(7) b_ln(pre, p.ln1g, p.ln1b, x1, x1h);
    SEAM(7);
    if (IN(8)) { pg8::Gemm g{x1h, WxqT, M, D, D}; pg8::StaticOrder S; S.init(g, G, bid); pg8::EpiF16 E{qx, D};
        pg8::gemm_phase<pg8::EpiF16, pg8::StaticOrder>((PG8_LAS unsigned char*)lds, g.K, S, E); }
    SEAM(8);
    if (IN(9)) { const int wv = __builtin_amdgcn_readfirstlane(tid >> 6), lane = tid & 63;
        REPS(9) xattn_block(qx, kx, kvmVT, ox, G, bid, (LAS unsigned char*)lds, wv, lane); }
    SEAM(9);
    if (IN(10)) { pg8::Gemm g{ox, WxoT, M, D, D}; pg8::StaticOrder S; S.init(g, G, bid); pg8::EpiResF32 E{pre, x1, D, DN_ALPHA};
        pg8::gemm_phase<pg8::EpiResF32, pg8::StaticOrder>((PG8_LAS unsigned char*)lds, g.K, S, E); }
    if (IN(10) && IN(12)) xcd_barrier(xbar);
    if (IN(12)) {
        { const int wv = __builtin_amdgcn_readfirstlane(tid >> 6), lane = tid & 63; LAS float* lg = (LAS float*)((LAS unsigned char*)lds + wv * 4096);
          for (int u = bid * 8 + wv; u < M / 16; u += G * 8) router_unit(p, pre, x2h, WrTh, WrTl, tope, topw, ctl + CTL_CNT, u * 16, lg, lane); }
        __syncthreads();
        if (bid == 0 && tid < NQ) ctl[CTL_CNT + tid * 65 + 64] = QT;
        for (int i = bid * NTHR + tid; i < CAP; i += G * NTHR) { rowoff[i] = 0u; rowmeta[i] = (u32x2){0xffffffffu, 0u}; }
        { const int wv = __builtin_amdgcn_readfirstlane(tid >> 6), lane = tid & 63; LAS float* scr = (LAS float*)((LAS unsigned char*)lds + wv * 8704);
          REPS(121) for (int it = bid * 8 + wv; it < 65 * 384; it += G * 8) { const int e = it / 384, r = it % 384;
            const float* wg = e < 64 ? p.w_gate + (size_t)e * D * EFF : p.ws_gate; const float* wu = e < 64 ? p.w_up + (size_t)e * D * EFF : p.ws_up; const float* wd = e < 64 ? p.w_down + (size_t)e * EFF * D : p.ws_down;
            if (r < 128) w_transpose_item(wg, D, EFF, WguT + (size_t)e * 512 * D, r, scr, lane, 2, 0);
            else if (r < 256) w_transpose_item(wu, D, EFF, WguT + (size_t)e * 512 * D, r - 128, scr, lane, 2, 1);
            else w_transpose_item(wd, EFF, D, WdT + (size_t)e * D * EFF, r - 256, scr, lane); } }
    }
    SEAM(12);
    if (IN(13)) b_scatter(ctl, tope, topw, rowoff, rowmeta, (int*)lds);
    SEAM(13);
    if (IN(14)) REPS(14) { G1Sched S{ctl, (const char*)x2h, rowoff, (const char*)WguT, G, bid}; pg8::EpiGateUp E{Hm};
        pg8::gemm_phase<pg8::EpiGateUp, G1Sched>((PG8_LAS unsigned char*)lds, D, S, E); }
    SEAM(14);
#pragma unroll 1
    for (int q = 0; q < NQ; ++q) {
        if (IN(15 + 2 * q)) REPS(15) { G2Sched S{ctl, (const char*)Hm, (const char*)WdT, q, G, bid}; pg8::EpiDown E{Yq, rowmeta};
            pg8::gemm_phase<pg8::EpiDown, G2Sched>((PG8_LAS unsigned char*)lds, EFF, S, E); }
        SEAM(15 + 2 * q);
        if (IN(16 + 2 * q)) REPS(16) b_combine(p, x2h, Yq, q);
        if (q < NQ - 1) SEAM(16 + 2 * q);
    }
#undef IN
#undef SEAM
#undef tid
}

#ifndef MK_PER_PHASE
#define MK_PER_PHASE 0
#endif
extern "C" void kernel_launch(void* const* d_in, const int* in_sizes, int n_in, void* d_out, int out_size, void* d_ws, size_t ws_size, hipStream_t stream) {
    static int grid = 0;
    if (grid == 0) {
        if (n_in != 28 || in_sizes[0] != M * D || out_size != M * D || ws_size < WS_NEED) { fprintf(stderr, "kernel_launch: unexpected shapes (n_in %d, in0 %d, out %d, ws %zu)\n", n_in, n_in > 0 ? in_sizes[0] : -1, out_size, ws_size); grid = -1; return; }
        if (hipFuncSetAttribute((const void*)mega_fwd, hipFuncAttributeMaxDynamicSharedMemorySize, LDS_BYTES) != hipSuccess) { fprintf(stderr, "kernel_launch: hipFuncSetAttribute failed\n"); grid = -1; return; }
        int dev = 0, cus = 0, per_cu = 0;
        hipGetDevice(&dev); hipDeviceGetAttribute(&cus, hipDeviceAttributeMultiprocessorCount, dev);
        if (hipOccupancyMaxActiveBlocksPerMultiprocessor(&per_cu, (const void*)mega_fwd, NTHR, LDS_BYTES) != hipSuccess || per_cu < 1) { fprintf(stderr, "kernel_launch: occupancy query failed (%d)\n", per_cu); grid = -1; return; }
        grid = cus;
    }
    if (grid < 0) return;
    Params p{};
    p.x = (const float*)d_in[0]; p.mem = (const float*)d_in[1]; p.positions = (const int*)d_in[2];
    p.w_in = (const float*)d_in[3]; p.pe_k = (const float*)d_in[4]; p.pe_v = (const float*)d_in[5];
    p.w1k = (const float*)d_in[6]; p.w2k = (const float*)d_in[7]; p.w1v = (const float*)d_in[8]; p.w2v = (const float*)d_in[9];
    p.w_out = (const float*)d_in[10]; p.ln1g = (const float*)d_in[11]; p.ln1b = (const float*)d_in[12];
    p.w_xq = (const float*)d_in[13]; p.w_xkv = (const float*)d_in[14]; p.w_xo = (const float*)d_in[15];
    p.ln2g = (const float*)d_in[16]; p.ln2b = (const float*)d_in[17]; p.w_router = (const float*)d_in[18]; p.rbias = (const float*)d_in[19];
    p.w_gate = (const float*)d_in[20]; p.w_up = (const float*)d_in[21]; p.w_down = (const float*)d_in[22];
    p.ws_gate = (const float*)d_in[23]; p.ws_up = (const float*)d_in[24]; p.ws_down = (const float*)d_in[25];
    p.ln3g = (const float*)d_in[26]; p.ln3b = (const float*)d_in[27];
    p.out = (float*)d_out; p.ws = (unsigned char*)d_ws;
    for (int i = 0; i < 4; ++i) p.lg[i] = (float)std::log(1.0 - std::pow(2.0, -5.0 - (double)i));
#if MK_PER_PHASE
    for (int ph = 0; ph < N_PHASES; ++ph) { p.ph_lo = ph; p.ph_hi = ph + 1; hipLaunchKernelGGL(mega_fwd, dim3(grid), dim3(NTHR), LDS_BYTES, stream, p); }
#else
    p.ph_lo = 0; p.ph_hi = N_PHASES;
    if (hipMemsetAsync((char*)d_ws + WS_BAR, 0, XCD_BAR_WORDS * 4, stream) != hipSuccess) { fprintf(stderr, "kernel_launch: memset failed\n"); return; }
    void* args[] = {&p};
    hipError_t e = hipLaunchCooperativeKernel((const void*)mega_fwd, dim3(grid), dim3(NTHR), args, LDS_BYTES, stream);
    if (e != hipSuccess) fprintf(stderr, "kernel_launch: cooperative launch failed: %s (grid %d)\n", hipGetErrorString(e), grid);
#endif
}
```

```cpp
#include <hip/hip_runtime.h>
#include <cstdio>
#include <cstdint>
#include <cmath>

typedef _Float16 h16;
typedef _Float16 h16x8 __attribute__((ext_vector_type(8)));
typedef _Float16 h16x2 __attribute__((ext_vector_type(2)));
typedef _Float16 h16x4 __attribute__((ext_vector_type(4)));
typedef float f32x2 __attribute__((ext_vector_type(2)));
typedef float f32x4 __attribute__((ext_vector_type(4)));
typedef unsigned u32x4 __attribute__((ext_vector_type(4)));
typedef unsigned u32x2 __attribute__((ext_vector_type(2)));

__device__ __forceinline__ int tidx() { int t = (int)threadIdx.x; asm volatile("" : "+v"(t)); return t; }

#ifndef PROBE_DBL
#define PROBE_DBL -1
#endif
#define REPS(k) for (int _rep = 0; _rep < ((PROBE_DBL) == (k) ? 2 : 1); ++_rep)

constexpr int NB = 4, T = 8192, D = 1024, M = NB * T;
constexpr int INC = 3352, INP = 3584;
constexpr int C_RQ = 0, C_RK = 512, C_RV = 1024, C_RG = 1536, C_NQ = 2048, C_NKC = 2560, C_NVC = 2688, C_NKS = 2816, C_NVS = 2944, C_NKW = 3072, C_NVW = 3200, C_NG = 3328;
constexpr int MEML = 256;
constexpr int NE = 64, EFF = 256;
constexpr float LN_EPS = 1e-5f;
constexpr float DN_ALPHA = 1.189207115002721f;
constexpr float NEGF = -1e30f;

constexpr size_t MiB = 1u << 20;
constexpr size_t WS_WIN = 1 * MiB, WS_WOUT = 8 * MiB, WS_WXQ = 10 * MiB, WS_WXO = 12 * MiB, WS_WXKV = 14 * MiB, WS_MEMH = 18 * MiB, WS_KVM = 20 * MiB;
constexpr size_t WS_KCMP = 24 * MiB, WS_VCMP = 25 * MiB, WS_TOPE = 26 * MiB, WS_TOPW = 27 * MiB;
constexpr size_t WS_XH = 32 * MiB, WS_MIX = 32 * MiB, WS_OX = 32 * MiB;
constexpr size_t WS_H = 96 * MiB, WS_NQR = 320 * MiB, WS_KVB = 352 * MiB, WS_PREV = 416 * MiB;
constexpr size_t WS_PRE = 96 * MiB, WS_X1 = 224 * MiB, WS_X1H = 352 * MiB, WS_QX = 416 * MiB, WS_X2 = 130 * MiB;
constexpr size_t WS_X2H = 32 * MiB, WS_WDT = 96 * MiB, WS_HM = 130 * MiB, WS_WGUT = 306 * MiB, WS_Y = 306 * MiB;
constexpr size_t WS_ROWOFF = 1 * MiB, WS_ROWMETA = 3 * MiB;
constexpr size_t WS_VST = 480 * MiB, WS_VWT = 488 * MiB, WS_COSR = 496 * MiB, WS_SINR = 504 * MiB, WS_COSN = 28 * MiB, WS_SINN = 29 * MiB, WS_KVMVT = 30 * MiB;
constexpr size_t WS_WRTH = 262144, WS_WRTL = 393216;
constexpr size_t WS_WC1T = 464 * MiB, WS_HID = 466 * MiB, WS_CMPOFF = 131072, WS_PEB = 131072 + 16384;
constexpr size_t WS_PREVT = 416 * MiB, WS_KSR = 448 * MiB, WS_KWR = 456 * MiB, WS_KX = 26 * MiB;
constexpr size_t DO_RQR = 0, DO_RKR = 32 * MiB, DO_RKZT = 64 * MiB, DO_RVT = 96 * MiB;
constexpr size_t WS_NEED = 512 * MiB;
constexpr int NQ = 4, QT = M / NQ, NVE = NQ * 65, CAP_TILES = 1412, CAP = CAP_TILES * 256;
constexpr size_t WS_BAR = 65536;
constexpr int CTL_CNT = 0, CTL_CUR = 512, CTL_PST = 1024, CTL_TQS = 1536, CTL_TVE = 2048;

namespace pg8 {
#define PG8_LAS __attribute__((address_space(3)))
typedef short s16x8 __attribute__((ext_vector_type(8)));
constexpr int BM = 256, BK = 64, HALF = 128, HTB = HALF * BK * 2, STAGE_BYTES = 8 * HTB, NXCD = 8, WGM = 8;
__host__ __device__ __forceinline__ int lds_byte(int r, int c) { const int st = (r >> 4) * 2 + (c >> 5), rr = r & 15, cc = c & 31, ob = rr * 64 + cc * 2; return st * 1024 + (ob ^ (((ob >> 9) & 1) << 5)); }
__host__ __device__ __forceinline__ void stage_rc(int b, int& R, int& C) { const int st = b / 1024, sb = b % 1024, swz = sb ^ (((sb >> 9) & 1) << 5); R = (st >> 1) * 16 + swz / 64; C = (st & 1) * 32 + (swz % 64) / 2; }
__host__ __device__ __forceinline__ int perm32(int rho) { const int n = rho >> 4, i = rho & 15; return 8 * (i >> 2) + 4 * n + (i & 3); }
struct Unit { int pm, pn; const char* A; const char* B; const unsigned* gat; };
struct Gemm { const h16* A; const h16* Bt; int M, N, K; };
struct StaticOrder {
    int nM, nN, nwg, G, c; const char* A; const char* B; size_t tstep;
    __device__ void init(const Gemm& g, int G_, int c_) { nM = g.M / BM; nN = g.N / BM; nwg = nM * nN; G = G_; c = c_; A = (const char*)g.A; B = (const char*)g.Bt; tstep = (size_t)BM * g.K * 2; }
    __device__ bool next(int i, Unit& u) const {
        const long L = (long)i * G + c; if (L >= nwg) return false;
        int wgid = (int)L; { const int q = nwg / NXCD, r = nwg % NXCD, xcd = wgid % NXCD, off = wgid / NXCD; wgid = (xcd < r ? xcd * (q + 1) : r * (q + 1) + (xcd - r) * q) + off; }
        const int nig = WGM * nN, gid = wgid / nig, fm = gid * WGM, gsz = (nM - fm) < WGM ? (nM - fm) : WGM;
        u.pm = fm + ((wgid % nig) % gsz); u.pn = (wgid % nig) / gsz; u.A = A + (size_t)u.pm * tstep; u.B = B + (size_t)u.pn * tstep; u.gat = nullptr; return true;
    }
};
__device__ __forceinline__ unsigned cvt_pk_f16(float lo, float hi) { f32x2 v = {lo, hi}; h16x2 h = __builtin_convertvector(v, h16x2); return __builtin_bit_cast(unsigned, h); }

struct EpiF16 {
    static constexpr bool PERM = true;
    h16* O; int ldc;
    __device__ __forceinline__ void operator()(const f32x4 (&acc)[2][2][4][2], const Unit& u, int wr, int wc, int fr, int fq) const {
        const int row0 = u.pm * BM + wr * 64 + fr; const int col0 = u.pn * BM + wc * 32 + 8 * fq;
#pragma unroll
        for (int ai = 0; ai < 2; ++ai)
#pragma unroll
            for (int m = 0; m < 4; ++m) { h16* rowp = O + (size_t)(row0 + ai * HALF + m * 16) * ldc + col0;
#pragma unroll
                for (int bj = 0; bj < 2; ++bj) { const f32x4 v0 = acc[ai][bj][m][0], v1 = acc[ai][bj][m][1];
                    *(h16x8*)(rowp + bj * HALF) = __builtin_convertvector(__builtin_shufflevector(v0, v1, 0, 1, 2, 3, 4, 5, 6, 7), h16x8); } }
    }
};
struct EpiResF32 {
    static constexpr bool PERM = false;
    float* C; const float* R; int ldc; float alpha;
    __device__ __forceinline__ void operator()(const f32x4 (&acc)[2][2][4][2], const Unit& u, int wr, int wc, int fr, int fq) const {
        const int row0 = u.pm * BM + wr * 64 + fr, col0 = u.pn * BM + wc * 32 + 4 * fq;
#pragma unroll
        for (int ai = 0; ai < 2; ++ai)
#pragma unroll
            for (int m = 0; m < 4; ++m) { const size_t off = (size_t)(row0 + ai * HALF + m * 16) * ldc + col0;
#pragma unroll
                for (int bj = 0; bj < 2; ++bj)
#pragma unroll
                    for (int n = 0; n < 2; ++n) { const f32x4 r = *(const f32x4*)(R + off + bj * HALF + n * 16); *(f32x4*)(C + off + bj * HALF + n * 16) = r * alpha + acc[ai][bj][m][n]; } }
    }
};
struct EpiCmp1 {
    static constexpr bool PERM = true;
    h16* O; const float* peb;
    __device__ __forceinline__ void operator()(const f32x4 (&acc)[2][2][4][2], const Unit& u, int wr, int wc, int fr, int fq) const {
        const int row0 = u.pm * BM + wr * 64 + fr; const int col0 = wc * 32 + 8 * fq;
#pragma unroll
        for (int bj = 0; bj < 2; ++bj) { const f32x4 b0 = *(const f32x4*)(peb + col0 + bj * HALF), b1 = *(const f32x4*)(peb + col0 + bj * HALF + 4);
#pragma unroll
            for (int ai = 0; ai < 2; ++ai)
#pragma unroll
                for (int m = 0; m < 4; ++m) { f32x4 v0 = acc[ai][bj][m][0] + b0, v1 = acc[ai][bj][m][1] + b1;
#pragma unroll
                    for (int r = 0; r < 4; ++r) { v0[r] = v0[r] / (1.f + __expf(-v0[r])); v1[r] = v1[r] / (1.f + __expf(-v1[r])); }
                    *(h16x8*)(O + (size_t)(row0 + ai * HALF + m * 16) * 256 + col0 + bj * HALF) = __builtin_convertvector(__builtin_shufflevector(v0, v1, 0, 1, 2, 3, 4, 5, 6, 7), h16x8); } }
    }
};
struct EpiGateUp {
    static constexpr bool PERM = true;
    h16* H;
    __device__ __forceinline__ void operator()(const f32x4 (&acc)[2][2][4][2], const Unit& u, int wr, int wc, int fr, int fq) const {
        const int row0 = u.pm * BM + wr * 64 + fr; const int col0 = u.pn * 128 + wc * 16 + 4 * fq;
#pragma unroll
        for (int ai = 0; ai < 2; ++ai)
#pragma unroll
            for (int m = 0; m < 4; ++m) { h16* rowp = H + (size_t)(row0 + ai * HALF + m * 16) * 256 + col0;
#pragma unroll
                for (int bj = 0; bj < 2; ++bj) { const f32x4 v0 = acc[ai][bj][m][0], v1 = acc[ai][bj][m][1];
                    const float h0 = v0[0] / (1.f + __expf(-v0[0])) * v0[1], h1 = v0[2] / (1.f + __expf(-v0[2])) * v0[3];
                    const float h2 = v1[0] / (1.f + __expf(-v1[0])) * v1[1], h3 = v1[2] / (1.f + __expf(-v1[2])) * v1[3];
                    *(h16x4*)(rowp + bj * 64) = __builtin_convertvector((f32x4){h0, h1, h2, h3}, h16x4); } }
    }
};
struct EpiDown {
    static constexpr bool PERM = true;
    h16* Y; const u32x2* rowmeta;
    __device__ __forceinline__ void operator()(const f32x4 (&acc)[2][2][4][2], const Unit& u, int wr, int wc, int fr, int fq) const {
        const int row0 = u.pm * BM + wr * 64 + fr; const int col0 = u.pn * BM + wc * 32 + 8 * fq;
#pragma unroll
        for (int ai = 0; ai < 2; ++ai)
#pragma unroll
            for (int m = 0; m < 4; ++m) { const u32x2 md = rowmeta[row0 + ai * HALF + m * 16]; const int slot = (int)md.x; const float w8 = __uint_as_float(md.y);
                if (slot >= 0) { h16* rowp = Y + (size_t)slot * 1024 + col0;
#pragma unroll
                    for (int bj = 0; bj < 2; ++bj) { const f32x4 v0 = acc[ai][bj][m][0] * w8, v1 = acc[ai][bj][m][1] * w8;
                        *(h16x8*)(rowp + bj * HALF) = __builtin_convertvector(__builtin_shufflevector(v0, v1, 0, 1, 2, 3, 4, 5, 6, 7), h16x8); } }
                asm volatile("" ::: "memory"); }
    }
};

template <class Epi, class Sched>
__device__ __forceinline__ void gemm_phase(PG8_LAS unsigned char* lds, const int K, const Sched& S, const Epi& E, const size_t kstepA = (size_t)(BK * 2)) {
    const int tid = tidx(), wid = __builtin_amdgcn_readfirstlane(tid >> 6), lane = tid & 63, wr = wid >> 2, wc = wid & 3, fr = lane & 15, fq = lane >> 4;
    const int nt = K / BK;
    int R0, C0; stage_rc(tid * 16, R0, C0);
    const unsigned cb2 = (unsigned)C0 * 2u;
    unsigned voffB[2];
#pragma unroll
    for (int i = 0; i < 2; ++i) { const int R = R0 + 64 * i; const int Rb = Epi::PERM ? ((R & ~31) + perm32(R & 31)) : R; voffB[i] = (unsigned)(Rb * K) * 2u + cb2; }
    const size_t kstep = (size_t)(BK * 2);
    const size_t hstep = (size_t)HALF * K * 2;
    const unsigned ldsw = (unsigned)wid * 1024u;
    const int aoff = lds_byte(wr * 64 + fr, fq * 8), boff = lds_byte(wc * 32 + fr, fq * 8);
#define PG8_MKVA(u, va) do { _Pragma("unroll") for (int _h = 0; _h < 2; ++_h) _Pragma("unroll") for (int _i = 0; _i < 2; ++_i) { const int _r = _h * HALF + R0 + 64 * _i; \
        (va)[_h][_i] = ((u).gat ? (u).gat[_r] : (unsigned)(_r * K) * 2u) + cb2; } } while (0)
#define PG8_SA(b, h) (((b) * 2 + (h)) * HTB)
#define PG8_SB(b, h) ((4 + (b) * 2 + (h)) * HTB)
#define PG8_STAGE(bufoff, gbase, voff) do { _Pragma("unroll") for (int _i = 0; _i < 2; ++_i) \
        __builtin_amdgcn_global_load_lds((const unsigned*)((const char*)(gbase) + (voff)[_i]), (PG8_LAS unsigned*)(lds + (bufoff) + ldsw + _i * 8192), 16, 0, 0); } while (0)
#define PG8_LDA(dst, b, h) do { _Pragma("unroll") for (int m = 0; m < 4; ++m) _Pragma("unroll") for (int k = 0; k < 2; ++k) dst[m][k] = *(const PG8_LAS s16x8*)(lds + PG8_SA(b, h) + aoff + m * 2048 + k * 1024); } while (0)
#define PG8_LDB(dst, b, h) do { _Pragma("unroll") for (int n = 0; n < 2; ++n) _Pragma("unroll") for (int k = 0; k < 2; ++k) dst[n][k] = *(const PG8_LAS s16x8*)(lds + PG8_SB(b, h) + boff + n * 2048 + k * 1024); } while (0)
#define PG8_MMA(ai, bj, At, Bt) do { __builtin_amdgcn_s_setprio(1); _Pragma("unroll") for (int m = 0; m < 4; ++m) _Pragma("unroll") for (int n = 0; n < 2; ++n) _Pragma("unroll") for (int k = 0; k < 2; ++k) \
        acc[ai][bj][m][n] = __builtin_amdgcn_mfma_f32_16x16x32_f16(__builtin_bit_cast(h16x8, Bt[n][k]), __builtin_bit_cast(h16x8, At[m][k]), acc[ai][bj][m][n], 0, 0, 0); __builtin_amdgcn_s_setprio(0); } while (0)
#define PG8_WAIT_V(n) asm volatile("s_waitcnt vmcnt(" #n ")" ::: "memory")
#define PG8_WAIT_L(n) asm volatile("s_waitcnt lgkmcnt(" #n ")" ::: "memory")
#define PG8_BAR __builtin_amdgcn_s_barrier()
#define PG8_SCHED __builtin_amdgcn_sched_barrier(0)
    Unit cur, nxt; int ui = 0;
    if (!S.next(0, cur)) return;
    unsigned va[2][2];
    PG8_MKVA(cur, va);
    f32x4 acc[2][2][4][2];
#pragma unroll
    for (int a = 0; a < 2; ++a)
#pragma unroll
        for (int b = 0; b < 2; ++b)
#pragma unroll
            for (int m = 0; m < 4; ++m)
#pragma unroll
                for (int n = 0; n < 2; ++n) acc[a][b][m][n] = (f32x4){0.f, 0.f, 0.f, 0.f};
    s16x8 At[4][2], B0[2][2], B1[2][2];
    const char* cA = cur.A; const char* cB = cur.B;
    {
        PG8_STAGE(PG8_SB(0, 0), cB, voffB); PG8_STAGE(PG8_SB(0, 1), cB + hstep, voffB); PG8_STAGE(PG8_SA(0, 0), cA, va[0]); PG8_STAGE(PG8_SA(0, 1), cA, va[1]);
        if (wr == 1) PG8_BAR;
        PG8_WAIT_V(2); PG8_BAR;
        PG8_STAGE(PG8_SB(1, 0), cB + kstep, voffB); PG8_STAGE(PG8_SA(1, 0), cA + kstepA, va[0]); PG8_STAGE(PG8_SB(1, 1), cB + hstep + kstep, voffB);
        PG8_WAIT_V(6); PG8_BAR;
    }
    for (;;) {
        const bool has_next = S.next(ui + 1, nxt);
        const char* nA = has_next ? nxt.A : cA; const char* nB = has_next ? nxt.B : cB;
#pragma unroll 1
        for (int t = 0; t < nt; t += 2) {
            const bool last = (t == nt - 2);
            const char* a1 = cA + (size_t)(t + 1) * kstepA;
            const char* a2 = last ? nA : cA + (size_t)(t + 2) * kstepA; const char* b2 = last ? nB : cB + (size_t)(t + 2) * kstep;
            const char* a3 = a2 + kstepA; const char* b3 = b2 + kstep;
            PG8_LDB(B0, 0, 0); PG8_LDB(B1, 0, 1); PG8_SCHED; PG8_LDA(At, 0, 0); PG8_STAGE(PG8_SA(1, 1), a1, va[1]);
            if (last && has_next) { PG8_MKVA(nxt, va); }
            PG8_WAIT_V(8); PG8_WAIT_L(0); PG8_BAR; PG8_MMA(0, 0, At, B0); PG8_MMA(0, 1, At, B1); PG8_BAR; PG8_SCHED;
            PG8_LDA(At, 0, 1); PG8_STAGE(PG8_SB(0, 0), b2, voffB); PG8_STAGE(PG8_SB(0, 1), b2 + hstep, voffB); PG8_STAGE(PG8_SA(0, 0), a2, va[0]);
            PG8_WAIT_V(8); PG8_WAIT_L(0); PG8_BAR; PG8_MMA(1, 0, At, B0); PG8_MMA(1, 1, At, B1); PG8_BAR; PG8_SCHED;
            PG8_LDB(B0, 1, 0); PG8_LDB(B1, 1, 1); PG8_SCHED; PG8_LDA(At, 1, 0); PG8_STAGE(PG8_SA(0, 1), a2, va[1]);
            PG8_WAIT_V(8); PG8_WAIT_L(0); PG8_BAR; PG8_MMA(0, 0, At, B0); PG8_MMA(0, 1, At, B1); PG8_BAR; PG8_SCHED;
            PG8_LDA(At, 1, 1); PG8_STAGE(PG8_SB(1, 0), b3, voffB); PG8_STAGE(PG8_SB(1, 1), b3 + hstep, voffB); PG8_STAGE(PG8_SA(1, 0), a3, va[0]);
            PG8_WAIT_V(8); PG8_WAIT_L(0); PG8_BAR; PG8_MMA(1, 0, At, B0); PG8_MMA(1, 1, At, B1); PG8_BAR; PG8_SCHED;
        }
        if (wr == 0) PG8_BAR;
        E(acc, cur, wr, wc, fr, fq);
        if (!has_next) break;
#pragma unroll
        for (int a = 0; a < 2; ++a)
#pragma unroll
            for (int b = 0; b < 2; ++b)
#pragma unroll
                for (int m = 0; m < 4; ++m)
#pragma unroll
                    for (int n = 0; n < 2; ++n) acc[a][b][m][n] = (f32x4){0.f, 0.f, 0.f, 0.f};
        cur = nxt; cA = nA; cB = nB; ++ui;
        if (wr == 1) PG8_BAR;
    }
    PG8_WAIT_V(0);
    PG8_BAR;
#undef PG8_MKVA
#undef PG8_SA
#undef PG8_SB
#undef PG8_STAGE
#undef PG8_LDA
#undef PG8_LDB
#undef PG8_MMA
#undef PG8_WAIT_V
#undef PG8_WAIT_L
#undef PG8_BAR
#undef PG8_SCHED
}
}


#include <hip/hip_cooperative_groups.h>
namespace cg = cooperative_groups;
constexpr int NTHR = 512;
constexpr int LDS_BYTES = 147456;
#define LAS __attribute__((address_space(3)))

struct Params {
    const float *x, *mem; const int* positions;
    const float *w_in, *pe_k, *pe_v, *w1k, *w2k, *w1v, *w2v, *w_out, *ln1g, *ln1b, *w_xq, *w_xkv, *w_xo, *ln2g, *ln2b, *w_router, *rbias, *w_gate, *w_up, *w_down, *ws_gate, *ws_up, *ws_down, *ln3g, *ln3b;
    float* out; unsigned char* ws;
    float lg[4];
    int ph_lo, ph_hi;
};

__device__ __forceinline__ float wave_sum(float v) {
#pragma unroll
    for (int o = 1; o < 64; o <<= 1) v += __shfl_xor(v, o);
    return v;
}
__device__ __forceinline__ float wave_max(float v) {
#pragma unroll
    for (int o = 1; o < 64; o <<= 1) v = fmaxf(v, __shfl_xor(v, o));
    return v;
}
__device__ __forceinline__ float siluf(float v) { return v / (1.f + __expf(-v)); }
__device__ __forceinline__ float sigmf(float v) { return 1.f / (1.f + __expf(-v)); }

__device__ __forceinline__ void b_transpose_tile(const float* __restrict__ W, int K, int N, h16* __restrict__ WT, int Npad, int tile, float* tl, int lt, int rs = 1, int ro = 0) {
    const int ntn = Npad / 32; const int n0 = (tile % ntn) * 32, k0 = (tile / ntn) * 32, tx = lt & 31, ty = lt >> 5;
    for (int i = ty; i < 32; i += 8) { const int k = k0 + i, n = n0 + tx; tl[i * 33 + tx] = (n < N) ? W[(size_t)k * N + n] : 0.f; }
    __syncthreads();
    for (int i = ty; i < 32; i += 8) { const int n = n0 + i, k = k0 + tx; WT[(size_t)(n * rs + ro) * K + k] = (h16)tl[tx * 33 + i]; }
    __syncthreads();
}
__device__ __forceinline__ void w_transpose_item(const float* __restrict__ W, int K, int N, h16* __restrict__ WT, int item, LAS float* scr, int lane, int rs = 1, int ro = 0) {
    const int nblk = N / 32, kb = item / nblk, nb = item % nblk, k0 = 64 * kb, n0 = 32 * nb;
#pragma unroll 8
    for (int i = 0; i < 32; ++i) { const int kk = 2 * i + (lane >> 5); scr[kk * 33 + (lane & 31)] = W[(size_t)(k0 + kk) * N + n0 + (lane & 31)]; }
    asm volatile("s_waitcnt lgkmcnt(0)" ::: "memory");
    const int c = lane & 7;
#pragma unroll
    for (int j = 0; j < 4; ++j) { const int n = (lane >> 3) + 8 * j; LAS const float* s = scr + (8 * c) * 33 + n; h16x8 o;
#pragma unroll
        for (int x = 0; x < 8; ++x) o[x] = (h16)s[x * 33];
        *(h16x8*)(WT + (size_t)((n0 + n) * rs + ro) * K + k0 + 8 * c) = o; }
    asm volatile("s_waitcnt lgkmcnt(0)" ::: "memory");
}
__device__ __forceinline__ void b_cvt(const float* __restrict__ x, h16* __restrict__ o, size_t n4) {
    for (size_t i = (size_t)blockIdx.x * NTHR + tidx(); i < n4; i += (size_t)gridDim.x * NTHR) {
        const f32x4 v = ((const f32x4*)x)[i]; ((h16x4*)o)[i] = __builtin_convertvector(v, h16x4); }
}

__device__ __forceinline__ void b_tables(const int* __restrict__ positions, float* __restrict__ cosr, float* __restrict__ sinr, float* __restrict__ cosn, float* __restrict__ sinn) {
    for (int idx = blockIdx.x * NTHR + tidx(); idx < M * 72; idx += gridDim.x * NTHR) {
        const int m = idx / 72, j = idx % 72; const float pos = (float)positions[m];
        const float inv = j < 64 ? (float)pow(10000.0, -(double)j / 64.0) : (float)pow(500000.0, -(double)(j - 64) / 8.0);
        const float ang = pos * inv; double sd, cd; sincos((double)ang, &sd, &cd);
        if (j < 64) { cosr[(size_t)m * 64 + j] = (float)cd; sinr[(size_t)m * 64 + j] = (float)sd; } else { cosn[(size_t)m * 8 + j - 64] = (float)cd; sinn[(size_t)m * 8 + j - 64] = (float)sd; }
    }
}
__device__ __forceinline__ void b_rope(const h16* __restrict__ h, h16* __restrict__ rqr, h16* __restrict__ rkr, h16* __restrict__ nqr, h16* __restrict__ ksR, h16* __restrict__ kwR, const float* __restrict__ cosr, const float* __restrict__ sinr,
                                       const float* __restrict__ cosn, const float* __restrict__ sinn, int m, int j) {
    const h16* hr = h + (size_t)m * INP; const int bb = m >> 13, t = m & (T - 1);
    {   const int hd = j >> 6, jj = j & 63; const float c = cosr[(size_t)m * 64 + jj], s = sinr[(size_t)m * 64 + jj]; const size_t ro = ((size_t)(bb * 4 + hd) * T + t) * 128;
        const int o1 = hd * 128 + jj, o2 = o1 + 64;
        const float q1 = (float)hr[C_RQ + o1], q2 = (float)hr[C_RQ + o2];
        rqr[ro + jj] = (h16)(q1 * c - q2 * s); rqr[ro + jj + 64] = (h16)(q2 * c + q1 * s);
        const float k1 = (float)hr[C_RK + o1], k2 = (float)hr[C_RK + o2]; const float sc = 0.08838834764831845f;
        rkr[ro + jj] = (h16)((k1 * c - k2 * s) * sc); rkr[ro + jj + 64] = (h16)((k2 * c + k1 * s) * sc);
    }
    if (j < 64 + 16 + 16) {
        const int jj = j & 7; const float c = cosn[(size_t)m * 8 + jj], s = sinn[(size_t)m * 8 + jj];
        if (j < 64) { const int hd = j >> 3; const int o1 = hd * 64 + jj, o2 = o1 + 8;
            const float q1 = (float)hr[C_NQ + o1], q2 = (float)hr[C_NQ + o2];
            nqr[(size_t)m * 512 + o1] = (h16)(q1 * c - q2 * s); nqr[(size_t)m * 512 + o2] = (h16)(q2 * c + q1 * s);
        } else { const int jx = j - 64; const int which = jx >> 4, g = (jx >> 3) & 1; const int base = (which ? C_NKW : C_NKS) + g * 64 + jj;
            const float k1 = (float)hr[base], k2 = (float)hr[base + 8];
            h16* dst = (which ? kwR : ksR) + (((size_t)((bb * 2 + g) * 128 + (t >> 6)) * 64 + (t & 63)) * 64); dst[jj] = (h16)(k1 * c - k2 * s); dst[jj + 8] = (h16)(k2 * c + k1 * s); }
    }
    if (j >= 128 && j < 128 + 96) { const int jx = j - 128; const int which = jx / 48, r = jx % 48, g = r / 24, d = 16 + 2 * (r % 24);
        const int base = (which ? C_NKW : C_NKS) + g * 64 + d; h16* dst = (which ? kwR : ksR) + (((size_t)((bb * 2 + g) * 128 + (t >> 6)) * 64 + (t & 63)) * 64);
        dst[d] = hr[base]; dst[d + 1] = hr[base + 1]; }
    for (int i = j; i < 8 * 48; i += 256) { const int hd = i / 48, d = 16 + i % 48; nqr[(size_t)m * 512 + hd * 64 + d] = hr[C_NQ + hd * 64 + d]; }
}
__device__ __forceinline__ void b_rtrans(const Params& p, const h16* __restrict__ h, h16* __restrict__ rvT, h16* __restrict__ rkzT, const float* __restrict__ cosr, const float* __restrict__ sinr, int item, h16* sl, int lt) {
    int id = item; const int tt = id & 127; id >>= 7; const int hd = id & 3; const int b = id >> 2; const int bh = b * 4 + hd; const float lg = p.lg[hd];
    for (int i = lt; i < 64 * 128; i += 256) { const int t = i >> 7, e = i & 127; sl[t * 130 + e] = h[(size_t)(b * T + tt * 64 + t) * INP + C_RV + hd * 128 + e]; }
    __syncthreads();
    for (int i = lt; i < 64 * 128; i += 256) { const int e = i >> 6, t = i & 63; rvT[((size_t)(bh * 64 + (tt >> 1)) * 128 + e) * 128 + (tt & 1) * 64 + t] = sl[t * 130 + e]; }
    __syncthreads();
    for (int i = lt; i < 64 * 64; i += 256) { const int t = i >> 6, jj = i & 63; const size_t m = (size_t)b * T + tt * 64 + t;
        const float c = cosr[m * 64 + jj], s = sinr[m * 64 + jj]; const float k1 = (float)h[m * INP + C_RK + hd * 128 + jj], k2 = (float)h[m * INP + C_RK + hd * 128 + jj + 64];
        const float z = 0.08838834764831845f * __expf(lg * (float)(127 - ((tt * 64 + t) & 127)));
        sl[t * 130 + jj] = (h16)((k1 * c - k2 * s) * z); sl[t * 130 + jj + 64] = (h16)((k2 * c + k1 * s) * z); }
    __syncthreads();
    for (int i = lt; i < 64 * 128; i += 256) { const int d = i >> 6, t = i & 63; rkzT[((size_t)(bh * 64 + (tt >> 1)) * 128 + d) * 128 + (tt & 1) * 64 + t] = sl[t * 130 + d]; }
    __syncthreads();
}
__device__ __forceinline__ void b_mvtrans(const h16* __restrict__ kvm, h16* __restrict__ kvmVT, h16* __restrict__ kx, int item, h16* sl, int lt) {
    int id = item; const int kt = id & 3; id >>= 2; const int dtl = id & 3; id >>= 2; const int hh = id & 3; const int b = id >> 2;
    for (int i = lt; i < 64 * 64; i += 256) { const int k = i >> 6, d = i & 63; sl[k * 66 + d] = kvm[(size_t)(b * MEML + kt * 64 + k) * 2048 + 1024 + hh * 256 + dtl * 64 + d];
        kx[((size_t)(b * 4 + hh) * MEML + kt * 64 + k) * 256 + dtl * 64 + d] = kvm[(size_t)(b * MEML + kt * 64 + k) * 2048 + hh * 256 + dtl * 64 + d]; }
    __syncthreads();
    for (int i = lt; i < 64 * 64; i += 256) { const int d = i >> 6, k = i & 63; kvmVT[(size_t)((b * 4 + hh) * 256 + dtl * 64 + d) * MEML + kt * 64 + k] = sl[k * 66 + d]; }
    __syncthreads();
}

struct CmpSched {
    const char* hbase; const unsigned* cmpoff; const char* Wc1T; int c;
    __device__ bool next(int i, pg8::Unit& u) const {
        if (i > 0 || c >= 32) return false; const int kv = c >> 4, rt = c & 15;
        u.pm = kv * 16 + rt; u.pn = 0; u.A = hbase + (size_t)(kv ? C_NVC : C_NKC) * 2; u.gat = cmpoff + rt * 256; u.B = Wc1T + (size_t)kv * 256 * 2048 * 2; return true; }
};
__device__ __forceinline__ void b_cmp2(const Params& p, const h16* __restrict__ hid, h16* __restrict__ kcmp, h16* __restrict__ vcmpT) {
    const int lane = tidx() & 63;
    for (int r = blockIdx.x * 8 + (tidx() >> 6); r < 2 * 4096; r += gridDim.x * 8) {
        const int kv = r >> 12, rr = r & 4095, g = rr & 1, c = (rr >> 1) & 511, b = rr >> 10;
        const float* w2 = kv ? p.w2v : p.w2k; const h16* hr = hid + (size_t)r * 256; float acc = 0.f;
        for (int j = 0; j < 256; j += 8) { const h16x8 hv = *(const h16x8*)(hr + j);
#pragma unroll
            for (int x = 0; x < 8; ++x) acc += (float)hv[x] * w2[(j + x) * 64 + lane]; }
        if (c == 511) acc = 0.f;
        if (kv == 0) kcmp[((size_t)(b * 2 + g) * 512 + c) * 64 + lane] = (h16)acc;
        else vcmpT[(((size_t)(b * 2 + g) * 8 + (c >> 6)) * 64 + lane) * 64 + (c & 63)] = (h16)acc;
    }
}
__device__ __forceinline__ void b_vtrans(const h16* __restrict__ h, h16* __restrict__ vsT, h16* __restrict__ vwT, int item, h16* sl, int lt) {
    int id = item; const int tt = id & 127; id >>= 7; const int g = id & 1; id >>= 1; const int b = id & 3; const int which = id >> 2;
    const int col = (which ? C_NVW : C_NVS) + g * 64; h16* dst = (which ? vwT : vsT) + (size_t)((b * 2 + g) * 128 + tt) * 4096;
    for (int i = lt; i < 64 * 64; i += 256) { const int t = i >> 6, d = i & 63; sl[t * 66 + d] = h[(size_t)(b * T + tt * 64 + t) * INP + col + d]; }
    __syncthreads();
    for (int i = lt; i < 64 * 64; i += 256) { const int d = i >> 6, t = i & 63; dst[d * 64 + t] = sl[t * 66 + d]; }
    __syncthreads();
}

__device__ __forceinline__ void ret_kv_unit(const h16* __restrict__ rkzT, const h16* __restrict__ rvT, float* __restrict__ kvT, int chunk, int w, int lane) {
    const int i = lane & 15, kg = lane >> 4; const int bh = chunk >> 6, n = chunk & 63;
    h16x8 a[4];
#pragma unroll
    for (int ks = 0; ks < 4; ++ks) a[ks] = *(const h16x8*)(rkzT + ((size_t)chunk * 128 + 16 * w + i) * 128 + 32 * ks + 8 * kg);
#pragma unroll
    for (int et = 0; et < 8; ++et) { f32x4 acc = {0.f, 0.f, 0.f, 0.f};
#pragma unroll
        for (int ks = 0; ks < 4; ++ks) { const h16x8 bq = *(const h16x8*)(rvT + ((size_t)chunk * 128 + 16 * et + i) * 128 + 32 * ks + 8 * kg); acc = __builtin_amdgcn_mfma_f32_16x16x32_f16(a[ks], bq, acc, 0, 0, 0); }
        *(f32x4*)(kvT + ((size_t)chunk * 128 + 16 * et + i) * 128 + 16 * w + 4 * kg) = acc; }
}
__device__ __forceinline__ void b_ret_scan(const Params& p, const float* __restrict__ kvT, h16* __restrict__ prevT) {
    for (int gid = blockIdx.x * NTHR + tidx(); gid < 16 * 16384; gid += gridDim.x * NTHR) {
        const int de = gid & 16383, bh = gid >> 14; const float cd = __expf(p.lg[bh & 3] * 128.f);
        float st = 0.f;
        for (int n = 0; n < 64; ++n) { const size_t o = ((size_t)(bh * 64 + n) << 14) + de; prevT[o] = (h16)st; st = st * cd + kvT[o]; }
    }
}
__device__ __forceinline__ void ret_out_unit(const Params& p, const h16* __restrict__ h, const h16* __restrict__ rqr, const h16* __restrict__ rkr, const h16* __restrict__ rvT, const h16* __restrict__ prevT,
                                             h16* __restrict__ mix, int chunk, int w, int lane) {
    const int i = lane & 15, kg = lane >> 4; const int bh = chunk >> 6, n = chunk & 63, b = bh >> 2, hd = bh & 3; const float lg = p.lg[hd];
    const int qi = 16 * w + i; const size_t m = (size_t)b * T + n * 128 + qi;
    h16x8 qf[4];
#pragma unroll
    for (int ks = 0; ks < 4; ++ks) qf[ks] = *(const h16x8*)(rqr + ((size_t)bh * T + n * 128 + qi) * 128 + 32 * ks + 8 * kg);
    f32x4 inner[8], cross[8];
#pragma unroll
    for (int et = 0; et < 8; ++et) { inner[et] = (f32x4){0.f, 0.f, 0.f, 0.f}; cross[et] = (f32x4){0.f, 0.f, 0.f, 0.f}; }
    for (int gq = 0; gq < 2; ++gq) {
        if (64 * gq > 16 * w + 15) break;
        f32x4 s[4];
#pragma unroll
        for (int tl = 0; tl < 4; ++tl) { const int ko = 32 * (tl >> 1) + 8 * (i >> 2) + 4 * (tl & 1) + (i & 3); const h16* kp = rkr + ((size_t)bh * T + n * 128 + 64 * gq + ko) * 128 + 8 * kg;
            f32x4 acc = {0.f, 0.f, 0.f, 0.f};
#pragma unroll
            for (int ks = 0; ks < 4; ++ks) acc = __builtin_amdgcn_mfma_f32_16x16x32_f16(*(const h16x8*)(kp + 32 * ks), qf[ks], acc, 0, 0, 0);
            s[tl] = acc; }
        h16x8 pf[2];
#pragma unroll
        for (int tl = 0; tl < 4; ++tl)
#pragma unroll
            for (int r = 0; r < 4; ++r) { const int j = 64 * gq + 32 * (tl >> 1) + 8 * kg + 4 * (tl & 1) + r; const float v = (j <= qi) ? s[tl][r] * __expf(lg * (float)(qi - j)) : 0.f; pf[tl >> 1][4 * (tl & 1) + r] = (h16)v; }
#pragma unroll
        for (int et = 0; et < 8; ++et)
#pragma unroll
            for (int s2 = 0; s2 < 2; ++s2) { const h16x8 a = *(const h16x8*)(rvT + ((size_t)chunk * 128 + 16 * et + i) * 128 + 64 * gq + 32 * s2 + 8 * kg); inner[et] = __builtin_amdgcn_mfma_f32_16x16x32_f16(a, pf[s2], inner[et], 0, 0, 0); }
    }
#pragma unroll
    for (int et = 0; et < 8; ++et)
#pragma unroll
        for (int ks = 0; ks < 4; ++ks) { const h16x8 a = *(const h16x8*)(prevT + ((size_t)chunk * 128 + 16 * et + i) * 128 + 32 * ks + 8 * kg); cross[et] = __builtin_amdgcn_mfma_f32_16x16x32_f16(a, qf[ks], cross[et], 0, 0, 0); }
    const float xi = __expf(lg * (float)(qi + 1));
    float sm = 0.f;
#pragma unroll
    for (int et = 0; et < 8; ++et) { inner[et] = inner[et] + cross[et] * xi; sm += (inner[et][0] + inner[et][1]) + (inner[et][2] + inner[et][3]); }
    sm += __shfl_xor(sm, 16); sm += __shfl_xor(sm, 32);
    const float mu = sm * (1.f / 128.f); float sq = 0.f;
#pragma unroll
    for (int et = 0; et < 8; ++et) { inner[et] = inner[et] - mu; sq += (inner[et][0] * inner[et][0] + inner[et][1] * inner[et][1]) + (inner[et][2] * inner[et][2] + inner[et][3] * inner[et][3]); }
    sq += __shfl_xor(sq, 16); sq += __shfl_xor(sq, 32);
    const float rstd = rsqrtf(sq * (1.f / 128.f) + LN_EPS);
#pragma unroll
    for (int et = 0; et < 8; ++et) { const int e = 16 * et + 4 * kg; const h16x4 gv = *(const h16x4*)(h + m * INP + C_RG + hd * 128 + e);
        f32x4 o;
#pragma unroll
        for (int r = 0; r < 4; ++r) o[r] = siluf((float)gv[r]) * inner[et][r] * rstd;
        *(h16x4*)(mix + m * D + hd * 128 + e) = __builtin_convertvector(o, h16x4); }
}

struct AttSt { float m, l; f32x4 o[4]; };
struct KFrag { h16x8 a[4][2]; };
struct VFrag { h16x8 a[4][2]; };
__device__ __forceinline__ void ldk(KFrag& k, const h16* __restrict__ Kb, int pitchK, int i, int kg) {
#pragma unroll
    for (int tl = 0; tl < 4; ++tl) { const int ko = 32 * (tl >> 1) + 8 * (i >> 2) + 4 * (tl & 1) + (i & 3); const h16* kp = Kb + (size_t)ko * pitchK + 8 * kg;
        k.a[tl][0] = *(const h16x8*)kp; k.a[tl][1] = *(const h16x8*)(kp + 32); }
}
__device__ __forceinline__ void ldv(VFrag& v, const h16* __restrict__ VTb, int vstride, int i, int kg) {
#pragma unroll
    for (int dt = 0; dt < 4; ++dt)
#pragma unroll
        for (int s2 = 0; s2 < 2; ++s2) v.a[dt][s2] = *(const h16x8*)(VTb + (size_t)(16 * dt + i) * vstride + 32 * s2 + 8 * kg);
}
__device__ __forceinline__ float xmax4(float v) {
    auto a = __builtin_amdgcn_permlane16_swap(__float_as_uint(v), __float_as_uint(v), false, false); v = fmaxf(__uint_as_float(a[0]), __uint_as_float(a[1]));
    auto c = __builtin_amdgcn_permlane32_swap(__float_as_uint(v), __float_as_uint(v), false, false); return fmaxf(__uint_as_float(c[0]), __uint_as_float(c[1])); }
__device__ __forceinline__ float xsum4(float v) {
    auto a = __builtin_amdgcn_permlane16_swap(__float_as_uint(v), __float_as_uint(v), false, false); v = __uint_as_float(a[0]) + __uint_as_float(a[1]);
    auto c = __builtin_amdgcn_permlane32_swap(__float_as_uint(v), __float_as_uint(v), false, false); return __uint_as_float(c[0]) + __uint_as_float(c[1]); }
constexpr float ATT_C2 = 0.125f * 1.4426950408889634f;
template <bool MASKED, class MaskF>
__device__ __forceinline__ void att_scores(f32x4 (&s)[4], const KFrag& k, const h16x8 (&qf)[2], int kg, MaskF valid) {
#pragma unroll
    for (int tl = 0; tl < 4; ++tl) { f32x4 z = {0.f, 0.f, 0.f, 0.f}; z = __builtin_amdgcn_mfma_f32_16x16x32_f16(k.a[tl][0], qf[0], z, 0, 0, 0); s[tl] = __builtin_amdgcn_mfma_f32_16x16x32_f16(k.a[tl][1], qf[1], z, 0, 0, 0); }
    if (MASKED) {
#pragma unroll
        for (int tl = 0; tl < 4; ++tl)
#pragma unroll
            for (int r = 0; r < 4; ++r) { const int ko = 32 * (tl >> 1) + 8 * kg + 4 * (tl & 1) + r; s[tl][r] = valid(ko) ? s[tl][r] : -INFINITY; }
    }
}
__device__ __forceinline__ float att_rowmax(const f32x4 (&s)[4]) {
    float mx = fmaxf(fmaxf(s[0][0], s[0][1]), fmaxf(s[0][2], s[0][3]));
#pragma unroll
    for (int tl = 1; tl < 4; ++tl) mx = fmaxf(mx, fmaxf(fmaxf(s[tl][0], s[tl][1]), fmaxf(s[tl][2], s[tl][3])));
    return xmax4(mx);
}
__device__ __forceinline__ void att_pv(f32x4 (&o)[4], const f32x4 (&pv)[4], const VFrag& v) {
    h16x8 pf[2];
#pragma unroll
    for (int s2 = 0; s2 < 2; ++s2)
#pragma unroll
        for (int j = 0; j < 8; ++j) pf[s2][j] = (h16)pv[2 * s2 + (j >> 2)][j & 3];
#pragma unroll
    for (int dt = 0; dt < 4; ++dt)
#pragma unroll
        for (int s2 = 0; s2 < 2; ++s2) o[dt] = __builtin_amdgcn_mfma_f32_16x16x32_f16(v.a[dt][s2], pf[s2], o[dt], 0, 0, 0);
}
template <bool MASKED, class MaskF>
__device__ __forceinline__ void att_tile(AttSt& st, const KFrag& k, const VFrag& v, const h16x8 (&qf)[2], int kg, bool rowok, MaskF valid) {
    f32x4 s[4]; att_scores<MASKED>(s, k, qf, kg, valid);
    const float mx = rowok ? att_rowmax(s) * ATT_C2 : -INFINITY;
    const float mn = fmaxf(st.m, mx);
    if (__any(mn > st.m)) { const float alpha = __builtin_amdgcn_exp2f(st.m - mn); st.m = mn; st.l *= alpha;
#pragma unroll
        for (int dt = 0; dt < 4; ++dt) st.o[dt] = st.o[dt] * alpha; }
    const float mneg = rowok ? -mn : -INFINITY;
    float ps0 = 0.f, ps1 = 0.f;
#pragma unroll
    for (int tl = 0; tl < 4; ++tl) {
#pragma unroll
        for (int r = 0; r < 4; ++r) s[tl][r] = __builtin_amdgcn_exp2f(__builtin_fmaf(s[tl][r], ATT_C2, mneg));
        ps0 += s[tl][0] + s[tl][1]; ps1 += s[tl][2] + s[tl][3]; }
    st.l += ps0 + ps1;
    att_pv(st.o, s, v);
}
constexpr int NSA_NSLOT = 5, NSA_RING = 0, NSA_IMP = NSA_NSLOT * 16384, NSA_MSK = NSA_IMP + 32768, NSA_LIST = NSA_MSK + 256;
__device__ __forceinline__ void ldk_lds(KFrag& k, LAS const unsigned char* slot, int ko0, int ko1) {
#pragma unroll
    for (int tl = 0; tl < 4; ++tl) { const int o = (32 * (tl >> 1) + 4 * (tl & 1)) * 128; k.a[tl][0] = *(LAS const h16x8*)(slot + o + ko0); k.a[tl][1] = *(LAS const h16x8*)(slot + o + ko1); }
}
__device__ __forceinline__ void ldv_lds(VFrag& v, LAS const unsigned char* slot, int vo0, int vo1) {
#pragma unroll
    for (int dt = 0; dt < 4; ++dt) { v.a[dt][0] = *(LAS const h16x8*)(slot + 8192 + dt * 2048 + vo0); v.a[dt][1] = *(LAS const h16x8*)(slot + 8192 + dt * 2048 + vo1); }
}
#define NSA_WAITV(n) asm volatile("s_waitcnt vmcnt(" #n ")" ::: "memory")
#define NSA_BAR() do { asm volatile("s_waitcnt lgkmcnt(0)" ::: "memory"); __builtin_amdgcn_s_barrier(); asm volatile("" ::: "memory"); } while (0)
template <int LPT, class IssueF, class CompF>
__device__ __forceinline__ void nsa_stream(int n, LAS unsigned char* dmaw, LAS unsigned char* ring, IssueF issue, CompF comp) {
#pragma unroll
    for (int j = 0; j < NSA_NSLOT - 1; ++j) if (j < n) issue(j, (LAS unsigned*)(dmaw + j * 16384));
    int st = 0, si = (NSA_NSLOT - 1) * 16384;
    for (int t = 0; t < n; ++t) {
        const int ahead = n - 1 - t;
        if (ahead >= 3) { if (LPT == 2) NSA_WAITV(6); else NSA_WAITV(3); }
        else if (ahead == 2) { if (LPT == 2) NSA_WAITV(4); else NSA_WAITV(2); }
        else if (ahead == 1) { if (LPT == 2) NSA_WAITV(2); else NSA_WAITV(1); }
        else NSA_WAITV(0);
        NSA_BAR();
        if (t + NSA_NSLOT - 1 < n) issue(t + NSA_NSLOT - 1, (LAS unsigned*)(dmaw + si));
        comp(t, (LAS const unsigned char*)(ring + st));
        st = (st == (NSA_NSLOT - 1) * 16384) ? 0 : st + 16384; si = (si == (NSA_NSLOT - 1) * 16384) ? 0 : si + 16384; }
    NSA_BAR();
}
__device__ __forceinline__ void nsa_block_unit(const h16* __restrict__ h, const h16* __restrict__ nqr, const h16* __restrict__ kcmp, const h16* __restrict__ vcmpT, const h16* __restrict__ vsT, const h16* __restrict__ vwT,
                                               const h16* __restrict__ ksR, const h16* __restrict__ kwR, h16* __restrict__ mix, int b, int g, int T0, LAS unsigned char* lds, int wv, int lane) {
    const int i = lane & 15, kg = lane >> 4, tt = i & 3, hh = i >> 2;
    const int t0 = T0 + 4 * wv, trow = t0 + tt; const size_t mrow = (size_t)b * T + trow;
    const int q = wv * 64 + lane, qrow = q >> 3, qch = q & 7;
    const int ksrc = qrow * 128 + ((qch ^ (((qrow >> 1) & 1) | (((qrow >> 3) & 3) << 1))) << 4), vsrc = qrow * 128 + ((qch ^ ((qrow >> 1) & 7)) << 4);
    const int gki = ((i >> 1) & 1) | ((i >> 2) << 1), gvi = (i >> 1) & 7;
    const int ko0 = (8 * (i >> 2) + (i & 3)) * 128 + ((kg ^ gki) << 4), ko1 = (8 * (i >> 2) + (i & 3)) * 128 + (((kg + 4) ^ gki) << 4);
    const int vo0 = i * 128 + ((kg ^ gvi) << 4), vo1 = i * 128 + (((kg + 4) ^ gvi) << 4);
    LAS unsigned char* ring = lds + NSA_RING; LAS unsigned char* dmaw = ring + wv * 1024;
    LAS float* impA = (LAS float*)(lds + NSA_IMP + wv * 4096); LAS float* impL = impA + 512;
    h16x8 qf[2], qrf[2];
    { const h16* qp = h + mrow * INP + C_NQ + (g * 4 + hh) * 64 + 8 * kg; qf[0] = *(const h16x8*)qp; qf[1] = *(const h16x8*)(qp + 32);
      const h16* qrp = nqr + mrow * 512 + (g * 4 + hh) * 64 + 8 * kg; qrf[0] = *(const h16x8*)qrp; qrf[1] = *(const h16x8*)(qrp + 32); }
    const h16* gp = h + mrow * INP + C_NG + (g * 4 + hh) * 3; const float gt0 = (float)gp[0], gt1 = (float)gp[1], gt2 = (float)gp[2];
    for (int x = lane; x < 1024; x += 64) impA[x] = 0.f;
    NSA_WAITV(0);
#define GLDS16(gsrc, ldst) __builtin_amdgcn_global_load_lds((const unsigned*)(gsrc), (ldst), 16, 0, 0)
    const int ncv_row = trow >= 31 ? ((trow - 31) >> 4) + 1 : 0;
    const int ncv_blk = (T0 + 31 >= 31) ? ((T0 + 31 - 31) >> 4) + 1 : 0;
    const int ncv_min = T0 >= 31 ? ((T0 - 31) >> 4) + 1 : 0;
    const int nct = (ncv_blk + 63) >> 6;
    const unsigned char* Kc = (const unsigned char*)(kcmp + (size_t)(b * 2 + g) * 512 * 64); const unsigned char* Vc = (const unsigned char*)(vcmpT + (size_t)(b * 2 + g) * 8 * 4096);
    float m = -1e30f, l = 0.f;
    f32x4 oc[4];
    float linv = 0.f;
    REPS(501) {
    m = -1e30f; l = 0.f;
#pragma unroll
    for (int dt = 0; dt < 4; ++dt) oc[dt] = (f32x4){0.f, 0.f, 0.f, 0.f};
    nsa_stream<1>(nct, dmaw, ring, [&](int j, LAS unsigned* dk) { GLDS16(Kc + (size_t)j * 8192 + ksrc, dk); }, [&](int j, LAS const unsigned char* slot) {
        KFrag kf; ldk_lds(kf, slot, ko0, ko1);
        f32x4 s[4];
        if (64 * j + 63 < ncv_min) att_scores<false>(s, kf, qf, kg, [&](int) { return true; }); else att_scores<true>(s, kf, qf, kg, [&](int ko) { return j * 64 + ko < ncv_row; });
        const float mx = att_rowmax(s) * ATT_C2;
        const float mn = fmaxf(m, mx); float ps0 = 0.f, ps1 = 0.f;
        _Pragma("unroll") for (int tl = 0; tl < 4; ++tl) { ps0 += __builtin_amdgcn_exp2f(__builtin_fmaf(s[tl][0], ATT_C2, -mn)) + __builtin_amdgcn_exp2f(__builtin_fmaf(s[tl][1], ATT_C2, -mn));
                                                          ps1 += __builtin_amdgcn_exp2f(__builtin_fmaf(s[tl][2], ATT_C2, -mn)) + __builtin_amdgcn_exp2f(__builtin_fmaf(s[tl][3], ATT_C2, -mn)); }
        l = l * __builtin_amdgcn_exp2f(m - mn) + (ps0 + ps1); m = mn; });
    l = xsum4(l);
    linv = l > 0.f ? 1.f / l : 0.f;
    nsa_stream<2>(nct, dmaw, ring, [&](int j, LAS unsigned* dk) { GLDS16(Kc + (size_t)j * 8192 + ksrc, dk); GLDS16(Vc + (size_t)j * 8192 + vsrc, (LAS unsigned*)((LAS unsigned char*)dk + 8192)); }, [&](int j, LAS const unsigned char* slot) {
        KFrag kf; ldk_lds(kf, slot, ko0, ko1); VFrag vf; ldv_lds(vf, slot, vo0, vo1);
        f32x4 s[4];
        if (64 * j + 63 < ncv_min) att_scores<false>(s, kf, qf, kg, [&](int) { return true; }); else att_scores<true>(s, kf, qf, kg, [&](int ko) { return j * 64 + ko < ncv_row; });
        _Pragma("unroll") for (int tl = 0; tl < 4; ++tl) {
            _Pragma("unroll") for (int r = 0; r < 4; ++r) s[tl][r] = __builtin_amdgcn_exp2f(__builtin_fmaf(s[tl][r], ATT_C2, -m)) * linv;
            float A = (s[tl][0] + s[tl][1]) + (s[tl][2] + s[tl][3]), L = s[tl][3];
            A += __shfl_xor(A, 4); A += __shfl_xor(A, 8); L += __shfl_xor(L, 4); L += __shfl_xor(L, 8);
            if (hh == 0) { const int u = j * 16 + 8 * (tl >> 1) + 2 * kg + (tl & 1); impA[tt * 128 + u] = A; impL[tt * 128 + u] = L; } }
        att_pv(oc, s, vf); });
    }
    const int cur = T0 >> 6;
    AttSt sw;
    REPS(504) {
    sw.m = -1e30f; sw.l = 0.f;
#pragma unroll
    for (int dt = 0; dt < 4; ++dt) sw.o[dt] = (f32x4){0.f, 0.f, 0.f, 0.f};
    {
        const unsigned char* Kw = (const unsigned char*)(kwR + (size_t)((b * 2 + g) * 128) * 4096); const unsigned char* Vw = (const unsigned char*)(vwT + (size_t)((b * 2 + g) * 128) * 4096);
        const int s0w = (T0 >= 511 ? (T0 - 511) >> 6 : 0);
        nsa_stream<2>(cur - s0w + 1, dmaw, ring, [&](int j, LAS unsigned* dk) { GLDS16(Kw + (size_t)(s0w + j) * 8192 + ksrc, dk); GLDS16(Vw + (size_t)(s0w + j) * 8192 + vsrc, (LAS unsigned*)((LAS unsigned char*)dk + 8192)); }, [&](int j, LAS const unsigned char* slot) {
            KFrag kf; ldk_lds(kf, slot, ko0, ko1); VFrag vf; ldv_lds(vf, slot, vo0, vo1); const int s = s0w + j;
            if (s > s0w + 1 && s < cur) att_tile<false>(sw, kf, vf, qrf, kg, true, [&](int) { return true; });
            else att_tile<true>(sw, kf, vf, qrf, kg, true, [&](int ko) { const int kp = 64 * s + ko; return kp <= trow && kp >= trow - 511; }); });
    }
    }
    unsigned long long mylo, myhi, anylo, anyhi;
    if (cur <= 15) { mylo = anylo = (1ull << (cur + 1)) - 1ull; myhi = anyhi = 0ull; }
    else {
        mylo = myhi = anylo = anyhi = 0ull;
        const unsigned long long flo = 1ull | (cur < 64 ? (1ull << cur) : 0ull) | (cur - 1 < 64 ? (1ull << (cur - 1)) : 0ull);
        const unsigned long long fhi = (cur >= 64 ? (1ull << (cur - 64)) : 0ull) | (cur - 1 >= 64 ? (1ull << (cur - 65)) : 0ull);
        const unsigned long long lmask = (1ull << lane) - 1ull;
        for (int tk = 0; tk < 4; ++tk) {
            const int s0 = lane, s1 = lane + 64;
            const float v0 = impA[tk * 128 + s0] + (s0 > 0 ? impL[tk * 128 + s0 - 1] : 0.f), v1 = impA[tk * 128 + s1] + impL[tk * 128 + s1 - 1];
            const unsigned b0 = (s0 >= 1 && s0 <= cur - 2) ? __float_as_uint(v0) + 1u : 0u, b1 = (s1 <= cur - 2) ? __float_as_uint(v1) + 1u : 0u;
            unsigned Tq = 0u;
            for (int bit = 30; bit >= 0; --bit) { const unsigned T2 = Tq | (1u << bit);
                const int c = __popcll(__ballot(b0 >= T2)) + __popcll(__ballot(b1 >= T2)); if (c >= 13) Tq = T2; }
            const unsigned long long gtlo = __ballot(b0 > Tq), gthi = __ballot(b1 > Tq), eqlo = __ballot(b0 == Tq), eqhi = __ballot(b1 == Tq);
            const int need = 13 - (__popcll(gtlo) + __popcll(gthi));
            const bool t0q = (b0 == Tq) && (__popcll(eqlo & lmask) < need), t1q = (b1 == Tq) && (__popcll(eqlo) + __popcll(eqhi & lmask) < need);
            const unsigned long long lo = gtlo | __ballot(t0q) | flo, hi = gthi | __ballot(t1q) | fhi;
            anylo |= lo; anyhi |= hi; if (tt == tk) { mylo = lo; myhi = hi; }
        }
    }
    LAS unsigned long long* msk = (LAS unsigned long long*)(lds + NSA_MSK); LAS unsigned char* lst = lds + NSA_LIST; LAS int* nlst = (LAS int*)(lds + NSA_LIST + 128);
    if (lane == 0) { msk[2 * wv] = anylo; msk[2 * wv + 1] = anyhi; }
    NSA_BAR();
    if (wv == 0) {
        unsigned long long ulo = 0ull, uhi = 0ull;
#pragma unroll
        for (int w2 = 0; w2 < 8; ++w2) { ulo |= msk[2 * w2]; uhi |= msk[2 * w2 + 1]; }
        const unsigned long long lmask = (1ull << lane) - 1ull; const int nlo = __popcll(ulo);
        if ((ulo >> lane) & 1ull) lst[__popcll(ulo & lmask)] = (unsigned char)lane;
        if ((uhi >> lane) & 1ull) lst[nlo + __popcll(uhi & lmask)] = (unsigned char)(64 + lane);
        if (lane == 0) nlst[0] = nlo + __popcll(uhi);
    }
    NSA_BAR();
    const int nsel = nlst[0];
    AttSt ss;
    REPS(503) {
    ss.m = -1e30f; ss.l = 0.f;
#pragma unroll
    for (int dt = 0; dt < 4; ++dt) ss.o[dt] = (f32x4){0.f, 0.f, 0.f, 0.f};
    {
        const unsigned char* Ks = (const unsigned char*)(ksR + (size_t)((b * 2 + g) * 128) * 4096); const unsigned char* Vs = (const unsigned char*)(vsT + (size_t)((b * 2 + g) * 128) * 4096);
        nsa_stream<2>(nsel, dmaw, ring, [&](int j, LAS unsigned* dk) { const int sj = lst[j]; GLDS16(Ks + (size_t)sj * 8192 + ksrc, dk); GLDS16(Vs + (size_t)sj * 8192 + vsrc, (LAS unsigned*)((LAS unsigned char*)dk + 8192)); }, [&](int j, LAS const unsigned char* slot) {
            const int s = lst[j];
            if ((((s < 64 ? anylo : anyhi) >> (s & 63)) & 1ull) != 0ull) {
                KFrag kf; ldk_lds(kf, slot, ko0, ko1); VFrag vf; ldv_lds(vf, slot, vo0, vo1);
                const bool mybit = (((s < 64 ? mylo : myhi) >> (s & 63)) & 1ull) != 0ull;
                if (s < cur) att_tile<false>(ss, kf, vf, qrf, kg, mybit, [&](int) { return true; });
                else att_tile<true>(ss, kf, vf, qrf, kg, mybit, [&](int ko) { return 64 * s + ko <= trow; }); } });
    }
    }
    const float ls = xsum4(ss.l), lw = xsum4(sw.l);
    const float g0 = sigmf(gt0), g1 = sigmf(gt1) / ls, g2 = sigmf(gt2) / lw;
#pragma unroll
    for (int dt = 0; dt < 4; ++dt) { const f32x4 o = oc[dt] * g0 + ss.o[dt] * g1 + sw.o[dt] * g2;
        *(h16x4*)(mix + mrow * D + 512 + (g * 4 + hh) * 64 + 16 * dt + 4 * kg) = __builtin_convertvector(o, h16x4); }
#undef GLDS16
}

__device__ __forceinline__ void b_ln(const float* __restrict__ in, const float* __restrict__ gam, const float* __restrict__ bet, float* __restrict__ o32, h16* __restrict__ o16) {
    const int lane = tidx() & 63;
    for (int row = blockIdx.x * 8 + (tidx() >> 6); row < M; row += gridDim.x * 8) {
        const f32x4* xr = (const f32x4*)(in + (size_t)row * D) + lane;
        f32x4 v[4]; float s = 0.f;
#pragma unroll
        for (int j = 0; j < 4; ++j) { v[j] = xr[64 * j]; s += (v[j][0] + v[j][1]) + (v[j][2] + v[j][3]); }
        const float mean = wave_sum(s) * (1.f / D); float s2 = 0.f;
#pragma unroll
        for (int j = 0; j < 4; ++j) { v[j] = v[j] - mean; s2 += (v[j][0] * v[j][0] + v[j][1] * v[j][1]) + (v[j][2] * v[j][2] + v[j][3] * v[j][3]); }
        const float rstd = rsqrtf(wave_sum(s2) * (1.f / D) + LN_EPS);
#pragma unroll
        for (int j = 0; j < 4; ++j) { const f32x4 gg = ((const f32x4*)gam)[lane + 64 * j], bb = ((const f32x4*)bet)[lane + 64 * j]; const f32x4 o = v[j] * rstd * gg + bb;
            ((f32x4*)(o32 + (size_t)row * D))[lane + 64 * j] = o;
            if (o16) ((h16x4*)(o16 + (size_t)row * D))[lane + 64 * j] = __builtin_convertvector(o, h16x4); }
    }
}

__device__ __forceinline__ void xattn_block(const h16* __restrict__ qx, const h16* __restrict__ kx, const h16* __restrict__ kvmVT, h16* __restrict__ ox, int G, int bid, LAS unsigned char* lds, int wv, int lane) {
    const int i = lane & 15, kg = lane >> 4;
    const int gki = ((i >> 1) & 1) | ((i >> 2) << 1), gvi = (i >> 1) & 7;
    const int ko0 = (8 * (i >> 2) + (i & 3)) * 512 + ((kg ^ gki) << 4), ko1 = (8 * (i >> 2) + (i & 3)) * 512 + (((kg + 4) ^ gki) << 4);
    const int vo0 = i * 128 + ((kg ^ gvi) << 4), vo1 = i * 128 + (((kg + 4) ^ gvi) << 4);
    const int t = wv * 64 + lane;
    int ksrc[4], vsrc[4];
#pragma unroll
    for (int pz = 0; pz < 4; ++pz) { const int q = pz * 512 + t;
        { const int row = q >> 5, cp = q & 31; const int gk = ((row >> 1) & 1) | (((row >> 3) & 3) << 1); ksrc[pz] = row * 512 + ((cp ^ gk) << 4); }
        { const int row = q >> 3, cp = q & 7; vsrc[pz] = row * 512 + ((cp ^ ((row >> 1) & 7)) << 4); } }
    const int nun = ((M / 128) * 4 - bid + G - 1) / G;
    const int ntile = nun * 4;
    auto issue = [&](int tix, int slot) { const int u = bid + G * (tix >> 2), grp = tix & 3; const int m0 = (u >> 2) * 128, hh = u & 3, b = m0 >> 13;
        const unsigned char* Kb = (const unsigned char*)(kx + ((size_t)(b * 4 + hh) * MEML + 64 * grp) * 256); const unsigned char* Vb = (const unsigned char*)(kvmVT + (size_t)((b * 4 + hh) * 256) * MEML + 64 * grp);
        LAS unsigned char* base = lds + slot * 65536 + wv * 1024;
#pragma unroll
        for (int pz = 0; pz < 4; ++pz) { __builtin_amdgcn_global_load_lds((const unsigned*)(Kb + ksrc[pz]), (LAS unsigned*)(base + pz * 8192), 16, 0, 0);
                                        __builtin_amdgcn_global_load_lds((const unsigned*)(Vb + vsrc[pz]), (LAS unsigned*)(base + 32768 + pz * 8192), 16, 0, 0); } };
    NSA_WAITV(0);
    if (ntile > 0) issue(0, 0);
    h16x8 qf[8]; f32x4 o[16]; float mrun = -1e30f, l = 0.f; size_t mrow = 0; int hh = 0;
    for (int tix = 0; tix < ntile; ++tix) {
        const int grp = tix & 3, slot = tix & 1;
        if (grp == 0) {
            const int u = bid + G * (tix >> 2); mrow = (size_t)((u >> 2) * 128 + wv * 16 + i); hh = u & 3;
#pragma unroll
            for (int ks = 0; ks < 8; ++ks) qf[ks] = *(const h16x8*)(qx + mrow * D + hh * 256 + 32 * ks + 8 * kg);
#pragma unroll
            for (int dt = 0; dt < 16; ++dt) o[dt] = (f32x4){0.f, 0.f, 0.f, 0.f};
            mrun = -1e30f; l = 0.f;
        }
        NSA_WAITV(0);
        NSA_BAR();
        if (tix + 1 < ntile) issue(tix + 1, slot ^ 1);
        LAS const unsigned char* sk = lds + slot * 65536; LAS const unsigned char* sv = sk + 32768;
        f32x4 s[4];
#pragma unroll
        for (int tl = 0; tl < 4; ++tl) { const int ro = (32 * (tl >> 1) + 4 * (tl & 1)) * 512; f32x4 acc = {0.f, 0.f, 0.f, 0.f};
#pragma unroll
            for (int ks = 0; ks < 8; ++ks) acc = __builtin_amdgcn_mfma_f32_16x16x32_f16(*(LAS const h16x8*)(sk + ro + 128 * (ks >> 1) + ((ks & 1) ? ko1 : ko0)), qf[ks], acc, 0, 0, 0);
            s[tl] = acc; }
        const float mx = att_rowmax(s) * (0.0625f * 1.4426950408889634f);
        const float mn = fmaxf(mrun, mx); const float alpha = __builtin_amdgcn_exp2f(mrun - mn); mrun = mn;
        float ps = 0.f; h16x8 pf[2];
#pragma unroll
        for (int tl = 0; tl < 4; ++tl)
#pragma unroll
            for (int r = 0; r < 4; ++r) { const float pe = __builtin_amdgcn_exp2f(__builtin_fmaf(s[tl][r], 0.0625f * 1.4426950408889634f, -mn)); ps += pe; pf[tl >> 1][4 * (tl & 1) + r] = (h16)pe; }
        l = l * alpha + ps;
#pragma unroll
        for (int dt = 0; dt < 16; ++dt) { f32x4 acc = o[dt] * alpha;
            acc = __builtin_amdgcn_mfma_f32_16x16x32_f16(*(LAS const h16x8*)(sv + dt * 2048 + vo0), pf[0], acc, 0, 0, 0);
            acc = __builtin_amdgcn_mfma_f32_16x16x32_f16(*(LAS const h16x8*)(sv + dt * 2048 + vo1), pf[1], acc, 0, 0, 0);
            o[dt] = acc; }
        if (grp == 3) { const float linv = 1.f / xsum4(l);
#pragma unroll
            for (int dt = 0; dt < 16; ++dt) { const f32x4 acc = o[dt] * linv; *(h16x4*)(ox + mrow * D + hh * 256 + 16 * dt + 4 * kg) = __builtin_convertvector(acc, h16x4); } }
    }
    NSA_WAITV(0);
    NSA_BAR();
}

__device__ __forceinline__ void route_token(float logit, int m, int lane, const float* __restrict__ rbias, int* __restrict__ tope, float* __restrict__ topw, int* __restrict__ hist) {
    const float score = 1.f / (1.f + expf(-logit)); const float biased = score + rbias[lane];
    float m1 = biased; m1 = fmaxf(m1, __shfl_xor(m1, 1)); m1 = fmaxf(m1, __shfl_xor(m1, 2)); m1 = fmaxf(m1, __shfl_xor(m1, 4));
    int am = (biased == m1) ? lane : 999; am = min(am, __shfl_xor(am, 1)); am = min(am, __shfl_xor(am, 2)); am = min(am, __shfl_xor(am, 4));
    float m2 = (lane == am) ? -INFINITY : biased; m2 = fmaxf(m2, __shfl_xor(m2, 1)); m2 = fmaxf(m2, __shfl_xor(m2, 2)); m2 = fmaxf(m2, __shfl_xor(m2, 4));
    const float gs = m1 + m2;
    int cnt = 0;
#pragma unroll
    for (int gq = 0; gq < 8; ++gq) { const float o = __shfl(gs, gq * 8); cnt += (o > gs) ? 1 : 0; }
    const float masked = (cnt <= 3) ? biased : NEGF;
    int rank = 0;
    for (int e2 = 0; e2 < 64; ++e2) { const float o = __shfl(masked, e2); rank += (o > masked || (o == masked && e2 < lane)) ? 1 : 0; }
    const bool selq = rank < 8;
    const float wsum = wave_sum(selq ? score : 0.f);
    if (selq) { tope[(size_t)m * 8 + rank] = lane; topw[(size_t)m * 8 + rank] = score / wsum * 2.5f; atomicAdd(hist + (m >> 13) * 65 + lane, 1); }
}
__device__ __forceinline__ void router_unit(const Params& p, const float* __restrict__ pre, h16* __restrict__ x2h, const h16* __restrict__ WrTh, const h16* __restrict__ WrTl, int* __restrict__ tope, float* __restrict__ topw,
                                            int* __restrict__ hist, int m0, LAS float* lg, int lane) {
    const int i = lane & 15, kg = lane >> 4;
    const float* xr = pre + (size_t)(m0 + i) * D + 8 * kg;
    float s1 = 0.f, s2 = 0.f;
#pragma unroll 4
    for (int ks = 0; ks < 32; ++ks) { const f32x4 x0 = *(const f32x4*)(xr + 32 * ks), x1 = *(const f32x4*)(xr + 32 * ks + 4);
        s1 += (x0[0] + x0[1]) + (x0[2] + x0[3]) + (x1[0] + x1[1]) + (x1[2] + x1[3]);
        s2 += (x0[0] * x0[0] + x0[1] * x0[1]) + (x0[2] * x0[2] + x0[3] * x0[3]) + (x1[0] * x1[0] + x1[1] * x1[1]) + (x1[2] * x1[2] + x1[3] * x1[3]); }
    s1 = xsum4(s1); s2 = xsum4(s2);
    const float mean = s1 * (1.f / D); const float rstd = rsqrtf(fmaxf(s2 * (1.f / D) - mean * mean, 0.f) + LN_EPS);
    f32x4 am_[4], ac_[4];
#pragma unroll
    for (int et = 0; et < 4; ++et) { am_[et] = (f32x4){0.f, 0.f, 0.f, 0.f}; ac_[et] = (f32x4){0.f, 0.f, 0.f, 0.f}; }
    h16* xo = x2h + (size_t)(m0 + i) * D + 8 * kg;
#pragma unroll 2
    for (int ks = 0; ks < 32; ++ks) {
        f32x4 x0 = *(const f32x4*)(xr + 32 * ks), x1 = *(const f32x4*)(xr + 32 * ks + 4);
        const f32x4 g0 = *(const f32x4*)(p.ln2g + 32 * ks + 8 * kg), g1 = *(const f32x4*)(p.ln2g + 32 * ks + 8 * kg + 4), b0 = *(const f32x4*)(p.ln2b + 32 * ks + 8 * kg), b1 = *(const f32x4*)(p.ln2b + 32 * ks + 8 * kg + 4);
        x0 = (x0 - mean) * rstd * g0 + b0; x1 = (x1 - mean) * rstd * g1 + b1;
        h16x8 xh, xl;
#pragma unroll
        for (int j = 0; j < 4; ++j) { xh[j] = (h16)x0[j]; xl[j] = (h16)((x0[j] - (float)xh[j]) * 2048.f); xh[4 + j] = (h16)x1[j]; xl[4 + j] = (h16)((x1[j] - (float)xh[4 + j]) * 2048.f); }
        *(h16x8*)(xo + 32 * ks) = xh;
#pragma unroll
        for (int et = 0; et < 4; ++et) { const h16x8 wh = *(const h16x8*)(WrTh + (size_t)(16 * et + i) * D + 32 * ks + 8 * kg), wl = *(const h16x8*)(WrTl + (size_t)(16 * et + i) * D + 32 * ks + 8 * kg);
            am_[et] = __builtin_amdgcn_mfma_f32_16x16x32_f16(wh, xh, am_[et], 0, 0, 0);
            ac_[et] = __builtin_amdgcn_mfma_f32_16x16x32_f16(wh, xl, ac_[et], 0, 0, 0);
            ac_[et] = __builtin_amdgcn_mfma_f32_16x16x32_f16(wl, xh, ac_[et], 0, 0, 0); }
    }
#pragma unroll
    for (int et = 0; et < 4; ++et)
#pragma unroll
        for (int r = 0; r < 4; ++r) lg[i * 64 + 16 * et + 4 * kg + r] = am_[et][r] + ac_[et][r] * (1.f / 2048.f);
    for (int tk = 0; tk < 16; ++tk) route_token(lg[tk * 64 + lane], m0 + tk, lane, p.rbias, tope, topw, hist);
}

__device__ __forceinline__ void b_moe(const Params& p, const float* __restrict__ x2, const int* __restrict__ tope, const float* __restrict__ topw, float* __restrict__ out, int m, float* sl, int tid) {
    float* xs = sl; float* hd = sl + 1024; float* red = sl + 1280;
    for (int i = tid; i < 1024; i += 256) xs[i] = x2[(size_t)m * D + i];
    __syncthreads();
    float acc[4] = {0.f, 0.f, 0.f, 0.f};
    for (int kx = 0; kx < 9; ++kx) {
        const float* G; const float* U; const float* Dn; float wt;
        if (kx < 8) { const int e = tope[(size_t)m * 8 + kx]; wt = topw[(size_t)m * 8 + kx]; G = p.w_gate + (size_t)e * D * EFF; U = p.w_up + (size_t)e * D * EFF; Dn = p.w_down + (size_t)e * EFF * D; }
        else { wt = 1.f; G = p.ws_gate; U = p.ws_up; Dn = p.ws_down; }
        float a = 0.f, u = 0.f;
        for (int k = 0; k < D; ++k) { const float xv = xs[k]; a += xv * G[(size_t)k * EFF + tid]; u += xv * U[(size_t)k * EFF + tid]; }
        hd[tid] = siluf(a) * u * wt;
        __syncthreads();
        for (int j = 0; j < EFF; ++j) { const float hv = hd[j]; const float* dr = Dn + (size_t)j * D + tid;
            acc[0] += hv * dr[0]; acc[1] += hv * dr[256]; acc[2] += hv * dr[512]; acc[3] += hv * dr[768]; }
        __syncthreads();
    }
    float v[4]; float s = 0.f;
#pragma unroll
    for (int i = 0; i < 4; ++i) { v[i] = DN_ALPHA * xs[tid + 256 * i] + acc[i]; s += v[i]; }
    s = wave_sum(s); if ((tid & 63) == 0) red[tid >> 6] = s; __syncthreads();
    const float mean = (red[0] + red[1] + red[2] + red[3]) * (1.f / D); float s2 = 0.f;
#pragma unroll
    for (int i = 0; i < 4; ++i) { v[i] -= mean; s2 += v[i] * v[i]; }
    s2 = wave_sum(s2); if ((tid & 63) == 0) red[4 + (tid >> 6)] = s2; __syncthreads();
    const float rstd = rsqrtf((red[4] + red[5] + red[6] + red[7]) * (1.f / D) + LN_EPS);
#pragma unroll
    for (int i = 0; i < 4; ++i) out[(size_t)m * D + tid + 256 * i] = v[i] * rstd * p.ln3g[tid + 256 * i] + p.ln3b[tid + 256 * i];
    __syncthreads();
}

struct G1Sched {
    const int* ctl; const char* x2h; const unsigned* rowoff; const char* WguT; int G, c;
    __device__ bool next(int i, pg8::Unit& u) const {
        const int ntile = ctl[CTL_TQS + NQ]; const long L = (long)i * G + c; if (L >= 2L * ntile) return false;
        const int tile = (int)(L >> 1), pn = (int)(L & 1); const int e = ctl[CTL_TVE + tile] % 65;
        u.pm = tile; u.pn = pn; u.A = x2h; u.gat = rowoff + (size_t)tile * 256; u.B = WguT + ((size_t)e * 512 + pn * 256) * (D * 2); return true; }
};
struct G2Sched {
    const int* ctl; const char* H; const char* WdT; int q, G, c;
    __device__ bool next(int i, pg8::Unit& u) const {
        const int t0 = ctl[CTL_TQS + q], t1 = ctl[CTL_TQS + q + 1]; const long L = (long)i * G + c; if (L >= 4L * (t1 - t0)) return false;
        const int tile = t0 + (int)(L >> 2), pn = (int)(L & 3); const int e = ctl[CTL_TVE + tile] % 65;
        u.pm = tile; u.pn = pn; u.A = H + (size_t)tile * 256 * (EFF * 2); u.gat = nullptr; u.B = WdT + ((size_t)e * D + pn * 256) * (EFF * 2); return true; }
};
__device__ __forceinline__ void b_scatter(int* __restrict__ ctl, const int* __restrict__ tope, const float* __restrict__ topw, unsigned* __restrict__ rowoff, u32x2* __restrict__ rowmeta, int* sl) {
    int* pst = sl;
    int* pc = sl + 512;
    for (int v = tidx(); v < NVE; v += NTHR) pc[v] = (ctl[CTL_CNT + v] + 255) & ~255;
    __syncthreads();
    for (int v = tidx(); v <= NVE; v += NTHR) { int acc = 0; for (int u = 0; u < v; ++u) acc += pc[u]; pst[v] = acc; }
    __syncthreads();
    if (blockIdx.x == 0) {
        for (int v = tidx(); v <= NVE; v += NTHR) ctl[CTL_PST + v] = pst[v];
        if (tidx() <= NQ) ctl[CTL_TQS + tidx()] = pst[tidx() * 65] >> 8;
        for (int v = tidx(); v < NVE; v += NTHR) for (int tl = pst[v] >> 8; tl < (pst[v + 1] >> 8); ++tl) ctl[CTL_TVE + tl] = v;
    }
    for (int idx = blockIdx.x * NTHR + tidx(); idx < M * 9; idx += gridDim.x * NTHR) {
        int m, k, pos; float w;
        if (idx < M * 8) { m = idx >> 3; k = idx & 7; const int ve = (m >> 13) * 65 + tope[idx]; w = topw[idx]; pos = pst[ve] + atomicAdd(ctl + CTL_CUR + ve, 1); }
        else { m = idx - M * 8; k = 8; w = 1.f; pos = pst[(m >> 13) * 65 + 64] + (m & (QT - 1)); }
        rowoff[pos] = (unsigned)m * (D * 2); rowmeta[pos] = (u32x2){(unsigned)((m & (QT - 1)) * 9 + k), __float_as_uint(w)};
    }
    __syncthreads();
}
__device__ __forceinline__ void b_combine(const Params& p, const h16* __restrict__ x2h, const h16* __restrict__ Y, int q) {
    const int lane = tidx() & 63;
    for (int r = blockIdx.x * 8 + (tidx() >> 6); r < QT; r += gridDim.x * 8) {
        const int m = q * QT + r;
        float v[16];
        { const h16x8 a = ((const h16x8*)(x2h + (size_t)m * D))[lane], b = ((const h16x8*)(x2h + (size_t)m * D))[lane + 64];
#pragma unroll
          for (int i = 0; i < 8; ++i) { v[i] = DN_ALPHA * (float)a[i]; v[8 + i] = DN_ALPHA * (float)b[i]; } }
#pragma unroll
        for (int k = 0; k < 9; ++k) { const h16x8* yr = (const h16x8*)(Y + ((size_t)r * 9 + k) * D); const h16x8 a = yr[lane], b = yr[lane + 64];
#pragma unroll
            for (int i = 0; i < 8; ++i) { v[i] += (float)a[i]; v[8 + i] += (float)b[i]; } }
        float s = 0.f;
#pragma unroll
        for (int i = 0; i < 16; ++i) s += v[i];
        const float mean = wave_sum(s) * (1.f / D); float s2 = 0.f;
#pragma unroll
        for (int i = 0; i < 16; ++i) { v[i] -= mean; s2 += v[i] * v[i]; }
        const float rstd = rsqrtf(wave_sum(s2) * (1.f / D) + LN_EPS);
#pragma unroll
        for (int hlf = 0; hlf < 2; ++hlf) { const int c0 = (lane + 64 * hlf) * 8;
            const f32x4 g0 = *(const f32x4*)(p.ln3g + c0), g1 = *(const f32x4*)(p.ln3g + c0 + 4), b0 = *(const f32x4*)(p.ln3b + c0), b1 = *(const f32x4*)(p.ln3b + c0 + 4);
            f32x4 o0, o1;
#pragma unroll
            for (int i = 0; i < 4; ++i) { o0[i] = v[8 * hlf + i] * rstd * g0[i] + b0[i]; o1[i] = v[8 * hlf + 4 + i] * rstd * g1[i] + b1[i]; }
            *(f32x4*)(p.out + (size_t)m * D + c0) = o0; *(f32x4*)(p.out + (size_t)m * D + c0 + 4) = o1; }
    }
}

#define XB_TMO      128
#define XB_XCNT(j)  (256  + 64 * (j))
#define XB_XSUB(j)  (1280 + 64 * (j))
#define XB_XGEN(j)  (2304 + 64 * (j))
#define XB_TOP      3328
#define XB_TOPGEN   3392
#define XCD_BAR_WORDS 3456
#define XB_SPIN_CAP (1u << 22)
__device__ __forceinline__ unsigned xb_ld(unsigned* p)              { return __hip_atomic_load(p, __ATOMIC_RELAXED, __HIP_MEMORY_SCOPE_AGENT); }
__device__ __forceinline__ unsigned xb_add(unsigned* p, unsigned v) { return __hip_atomic_fetch_add(p, v, __ATOMIC_RELAXED, __HIP_MEMORY_SCOPE_AGENT); }
__device__ __forceinline__ unsigned xb_xcc_id() { return (unsigned)__builtin_amdgcn_s_getreg((3 << 11) | 20) & 0xFu; }
#define XB_SPIN(cond, bar) do { unsigned _sp = 0; while (cond) { __builtin_amdgcn_s_sleep(1); \
    if ((++_sp & 255u) == 0u) { if (xb_ld(&(bar)[XB_TMO])) break; if (_sp > XB_SPIN_CAP) { atomicAdd(&(bar)[XB_TMO], 1u); break; } } } } while (0)
struct XcdBarrier { unsigned* bar; unsigned x; volatile LAS unsigned* st; };
__device__ __forceinline__ XcdBarrier xcd_barrier_post(unsigned* bar, volatile LAS unsigned* st) {
    XcdBarrier b; b.bar = bar; b.x = xb_xcc_id(); b.st = st;
    if (threadIdx.x == 0) (void)xb_add(&bar[XB_XCNT(b.x)], 1u);
    return b;
}
__device__ __forceinline__ void xcd_barrier_complete(unsigned* bar, unsigned x, unsigned& nloc, unsigned& nx) {
    const unsigned G = gridDim.x * gridDim.y * gridDim.z;
    unsigned sum, cnt, mine, sp = 0u;
    for (;;) {
        sum = 0u; cnt = 0u; mine = 0u;
#pragma unroll
        for (unsigned j = 0; j < 16; ++j) { const unsigned c = xb_ld(&bar[XB_XCNT(j)]); sum += c; cnt += (c > 0u) ? 1u : 0u; mine = (j == x) ? c : mine; }
        if (sum == G) break;
        __builtin_amdgcn_s_sleep(1);
        if ((++sp & 255u) == 0u) { if (xb_ld(&bar[XB_TMO])) break; if (sp > XB_SPIN_CAP) { atomicAdd(&bar[XB_TMO], 1u); break; } }
    }
    nloc = mine > 0u ? mine : 1u; nx = cnt > 0u ? cnt : 1u;
}
__device__ __forceinline__ void xcd_barrier(const XcdBarrier& b) {
    asm volatile("s_waitcnt vmcnt(0)" ::: "memory");
    __syncthreads();
    if (threadIdx.x == 0) {
        unsigned* bar = b.bar;
        __builtin_amdgcn_s_waitcnt(0);
        unsigned nloc = b.st[0], nx = b.st[1];
        if (nloc == 0u) { xcd_barrier_complete(bar, b.x, nloc, nx); b.st[0] = nloc; b.st[1] = nx; }
        const unsigned old = xb_add(&bar[XB_XSUB(b.x)], 1u);
        const unsigned gen = old / nloc;
        if (old + 1u == (gen + 1u) * nloc) {
            __builtin_amdgcn_fence(__ATOMIC_RELEASE, "agent");
            asm volatile("s_waitcnt vmcnt(0)" ::: "memory");
            const unsigned og = xb_add(&bar[XB_TOP], 1u);
            const unsigned tg = og / nx;
            if (og + 1u == (tg + 1u) * nx) xb_add(&bar[XB_TOPGEN], 1u);
            else XB_SPIN(xb_ld(&bar[XB_TOPGEN]) == tg, bar);
            __builtin_amdgcn_fence(__ATOMIC_ACQUIRE, "agent");
            xb_add(&bar[XB_XGEN(b.x)], 1u);
            asm volatile("s_waitcnt vmcnt(0)" ::: "memory");
        } else {
            XB_SPIN(xb_ld(&bar[XB_XGEN(b.x)]) == gen, bar);
            __builtin_amdgcn_fence(__ATOMIC_ACQUIRE, "agent");
            asm volatile("s_waitcnt vmcnt(0)" ::: "memory");
        }
    }
    __syncthreads();
}

constexpr int N_PHASES = 23;

__global__ void __launch_bounds__(NTHR, 2) mega_fwd(Params p) {
    extern __shared__ __attribute__((aligned(16))) unsigned char lds[];
    cg::grid_group grid = cg::this_grid();
    const int G = (int)gridDim.x, bid = (int)blockIdx.x;
#define tid tidx()
    unsigned char* ws = p.ws;
    h16* WinT = (h16*)(ws + WS_WIN); h16* WoutT = (h16*)(ws + WS_WOUT); h16* WxqT = (h16*)(ws + WS_WXQ); h16* WxoT = (h16*)(ws + WS_WXO); h16* WxkvT = (h16*)(ws + WS_WXKV);
    h16* memh = (h16*)(ws + WS_MEMH); h16* kvm = (h16*)(ws + WS_KVM); h16* kcmp = (h16*)(ws + WS_KCMP); h16* vcmpT = (h16*)(ws + WS_VCMP); h16* vsT = (h16*)(ws + WS_VST); h16* vwT = (h16*)(ws + WS_VWT);
    int* tope = (int*)(ws + WS_TOPE); float* topw = (float*)(ws + WS_TOPW);
    h16* xh = (h16*)(ws + WS_XH); h16* mix = (h16*)(ws + WS_MIX); h16* ox = (h16*)(ws + WS_OX); h16* hb = (h16*)(ws + WS_H); h16* nqr = (h16*)(ws + WS_NQR);
    float* kvb = (float*)(ws + WS_KVB); h16* prevT = (h16*)(ws + WS_PREVT);
    float* cosr = (float*)(ws + WS_COSR); float* sinr = (float*)(ws + WS_SINR); float* cosn = (float*)(ws + WS_COSN); float* sinn = (float*)(ws + WS_SINN); h16* kvmVT = (h16*)(ws + WS_KVMVT); h16* WrTh = (h16*)(ws + WS_WRTH); h16* WrTl = (h16*)(ws + WS_WRTL); h16* Wc1T = (h16*)(ws + WS_WC1T); h16* hid = (h16*)(ws + WS_HID); unsigned* cmpoff = (unsigned*)(ws + WS_CMPOFF); float* peb = (float*)(ws + WS_PEB); h16* ksR = (h16*)(ws + WS_KSR); h16* kwR = (h16*)(ws + WS_KWR); h16* kx = (h16*)(ws + WS_KX);
    h16* rqr = (h16*)((unsigned char*)p.out + DO_RQR); h16* rkr = (h16*)((unsigned char*)p.out + DO_RKR); h16* rkzT = (h16*)((unsigned char*)p.out + DO_RKZT); h16* rvT = (h16*)((unsigned char*)p.out + DO_RVT); float* pre = p.out; float* x1 = (float*)(ws + WS_X1); h16* x1h = (h16*)(ws + WS_X1H);
    h16* qx = (h16*)(ws + WS_QX); float* x2 = (float*)(ws + WS_X2); h16* x2h = (h16*)(ws + WS_X2H);
    int* ctl = (int*)ws; unsigned* rowoff = (unsigned*)(ws + WS_ROWOFF); u32x2* rowmeta = (u32x2*)(ws + WS_ROWMETA);
    h16* WguT = (h16*)(ws + WS_WGUT); h16* WdT = (h16*)(ws + WS_WDT); h16* Hm = (h16*)(ws + WS_HM); h16* Yq = (h16*)(ws + WS_Y);
    float* fl = (float*)lds;
    const int lo = p.ph_lo, hi = p.ph_hi;
#define IN(k) (lo <= (k) && (k) < hi)
    { volatile LAS unsigned* st = (volatile LAS unsigned*)((LAS unsigned char*)lds + 131072); if (threadIdx.x < 2) st[threadIdx.x] = 0u; }
    __syncthreads();
    XcdBarrier xbar = xcd_barrier_post((unsigned*)(ws + WS_BAR), (volatile LAS unsigned*)((LAS unsigned char*)lds + 131072));
#define SEAM(k) do { if (IN(k) && IN((k) + 1)) { if ((k) == 0) grid.sync(); else xcd_barrier(xbar); } } while (0)

    if (IN(0)) REPS(0) {
        { const int sub = tid >> 8, lt = tid & 255; float* tl = fl + sub * 1088;
          constexpr int T0 = (INP / 32) * (D / 32);
          for (int b0 = bid * 2; b0 < T0; b0 += G * 2) b_transpose_tile(p.w_in, D, INC, WinT, INP, b0 + sub, tl, lt); }
        { const int wv = __builtin_amdgcn_readfirstlane(tid >> 6), lane = tid & 63; LAS float* scr = (LAS float*)((LAS unsigned char*)lds + wv * 8704);
          constexpr int I1 = (D / 64) * (D / 32), I4 = (D / 64) * (2 * D / 32), I5 = (2048 / 64) * (256 / 32), IT = 3 * I1 + I4 + 2 * I5;
          for (int it0 = bid * 8 + wv; it0 < IT; it0 += G * 8) { int it = it0;
            if (it < I1) { w_transpose_item(p.w_out, D, D, WoutT, it, scr, lane); continue; } it -= I1;
            if (it < I1) { w_transpose_item(p.w_xq, D, D, WxqT, it, scr, lane); continue; } it -= I1;
            if (it < I1) { w_transpose_item(p.w_xo, D, D, WxoT, it, scr, lane); continue; } it -= I1;
            if (it < I4) { w_transpose_item(p.w_xkv, D, 2 * D, WxkvT, it, scr, lane); continue; } it -= I4;
            if (it < I5) { w_transpose_item(p.w1k, 2048, 256, Wc1T, it, scr, lane); continue; } it -= I5;
            w_transpose_item(p.w1v, 2048, 256, Wc1T + 256 * 2048, it, scr, lane); } }
        __syncthreads();
        b_cvt(p.x, xh, (size_t)M * D / 4);
        b_cvt(p.mem, memh, (size_t)NB * MEML * D / 4);
        if (bid == 0) for (int i = tid; i < 1024; i += NTHR) ctl[i] = 0;
        b_tables(p.positions, cosr, sinr, cosn, sinn);
        for (int idx = bid * NTHR + tid; idx < NE * D; idx += G * NTHR) { const int e = idx >> 10, k = idx & 1023; const float w = p.w_router[k * NE + e]; const h16 hi = (h16)w; WrTh[idx] = hi; WrTl[idx] = (h16)((w - (float)hi) * 2048.f); }
        for (int r = bid * NTHR + tid; r < 4096; r += G * NTHR) { const int g = r & 1, c = min((r >> 1) & 511, 510), b = r >> 10; cmpoff[r] = (unsigned)(((size_t)(b * T + 16 * c) * INP + g * 64) * 2); }
        { const int lane = tid & 63;
          for (int o = bid * 8 + (tid >> 6); o < 512; o += G * 8) { const int kv = o >> 8, j = o & 255; const float* pe = kv ? p.pe_v : p.pe_k; const float* w1 = kv ? p.w1v : p.w1k; float a = 0.f;
              for (int k = lane; k < 2048; k += 64) a += pe[k] * w1[(size_t)k * 256 + j];
              a = wave_sum(a); if (lane == 0) peb[o] = a; } }
    }
    SEAM(0);
    if (IN(1)) {
        REPS(1) { pg8::Gemm g{xh, WinT, M, INP, D}; pg8::StaticOrder S; S.init(g, G, bid); pg8::EpiF16 E{hb, INP};
          pg8::gemm_phase<pg8::EpiF16, pg8::StaticOrder>((PG8_LAS unsigned char*)lds, g.K, S, E); }
    }
    SEAM(1);
    if (IN(2)) REPS(2) {
        if (bid < 32) { CmpSched S{(const char*)hb, cmpoff, (const char*)Wc1T, bid}; pg8::EpiCmp1 E{hid, peb + (bid >> 4) * 256};
            pg8::gemm_phase<pg8::EpiCmp1, CmpSched>((PG8_LAS unsigned char*)lds, 2048, S, E, (size_t)INP * 2);
            pg8::Gemm g{memh, WxkvT, NB * MEML, 2 * D, D}; pg8::StaticOrder S2; S2.init(g, 32, bid); pg8::EpiF16 E2{kvm, 2 * D};
            pg8::gemm_phase<pg8::EpiF16, pg8::StaticOrder>((PG8_LAS unsigned char*)lds, g.K, S2, E2); }
        else { const int sub = tid >> 8, lt = tid & 255; const int b2 = bid - 32, G2 = G - 32;
        for (int b0 = b2 * 8; b0 < M; b0 += G2 * 8) {
#pragma unroll
            for (int r4 = 0; r4 < 4; ++r4) b_rope(hb, rqr, rkr, nqr, ksR, kwR, cosr, sinr, cosn, sinn, b0 + sub * 4 + r4, lt); }
        for (int b0 = b2 * 2; b0 < 2 * NB * 2 * 128; b0 += G2 * 2) b_vtrans(hb, vsT, vwT, b0 + sub, (h16*)(fl + sub * 2304), lt);
        for (int b0 = b2 * 2; b0 < NB * 4 * 128; b0 += G2 * 2) b_rtrans(p, hb, rvT, rkzT, cosr, sinr, b0 + sub, (h16*)(fl + sub * 4224), lt);
        } }
    SEAM(2);
    if (IN(3)) {
        REPS(30) b_cmp2(p, hid, kcmp, vcmpT);
        { const int sub = tid >> 8, lt = tid & 255;
          for (int b0 = bid * 2; b0 < NB * 4 * 16; b0 += G * 2) b_mvtrans(kvm, kvmVT, kx, b0 + sub, (h16*)(fl + sub * 2304), lt); }
        const int wv = __builtin_amdgcn_readfirstlane(tid >> 6), lane = tid & 63;
        REPS(31) for (int ch = bid; ch < NB * 4 * 64; ch += G) ret_kv_unit(rkzT, rvT, kvb, ch, wv, lane); }
    SEAM(3);
    if (IN(4)) {
        REPS(4) b_ret_scan(p, kvb, prevT);
        const int wv = __builtin_amdgcn_readfirstlane(tid >> 6), lane = tid & 63;
        __syncthreads();
        REPS(50) { const int bg = bid & 7;
            for (int k = bid >> 3; k < T / 32; k += (G >> 3)) nsa_block_unit(hb, nqr, kcmp, vcmpT, vsT, vwT, ksR, kwR, mix, bg >> 1, bg & 1, (T / 32 - 1 - k) * 32, (LAS unsigned char*)lds, wv, lane); }
    }
    SEAM(4);
    if (IN(5)) {
        const int wv = __builtin_amdgcn_readfirstlane(tid >> 6), lane = tid & 63;
        REPS(51) for (int ch = bid; ch < NB * 4 * 64; ch += G) ret_out_unit(p, hb, rqr, rkr, rvT, prevT, mix, ch, wv, lane);
    }
    SEAM(5);
    if (IN(6)) { pg8::Gemm g{mix, WoutT, M, D, D}; pg8::StaticOrder S; S.init(g, G, bid); pg8::EpiResF32 E{pre, p.x, D, DN_ALPHA};
        pg8::gemm_phase<pg8::EpiResF32, pg8::StaticOrder>((PG8_LAS unsigned char*)lds, g.K, S, E); }
    SEAM(6);
    if (PROBE_DBL == 900) { for (int k = 0; k < 20; ++k) xcd_barrier(xbar); }
    if (IN(7)) REPS(7) b_ln(pre, p.ln1g, p.ln1b, x1, x1h);
    SEAM(7);
    if (IN(8)) { pg8::Gemm g{x1h, WxqT, M, D, D}; pg8::StaticOrder S; S.init(g, G, bid); pg8::EpiF16 E{qx, D};
        pg8::gemm_phase<pg8::EpiF16, pg8::StaticOrder>((PG8_LAS unsigned char*)lds, g.K, S, E); }
    SEAM(8);
    if (IN(9)) { const int wv = __builtin_amdgcn_readfirstlane(tid >> 6), lane = tid & 63;
        REPS(9) xattn_block(qx, kx, kvmVT, ox, G, bid, (LAS unsigned char*)lds, wv, lane); }
    SEAM(9);
    if (IN(10)) { pg8::Gemm g{ox, WxoT, M, D, D}; pg8::StaticOrder S; S.init(g, G, bid); pg8::EpiResF32 E{pre, x1, D, DN_ALPHA};
        pg8::gemm_phase<pg8::EpiResF32, pg8::StaticOrder>((PG8_LAS unsigned char*)lds, g.K, S, E); }
    if (IN(10) && IN(12)) xcd_barrier(xbar);
    if (IN(12)) {
        { const int wv = __builtin_amdgcn_readfirstlane(tid >> 6), lane = tid & 63; LAS float* lg = (LAS float*)((LAS unsigned char*)lds + wv * 4096);
          for (int u = bid * 8 + wv; u < M / 16; u += G * 8) router_unit(p, pre, x2h, WrTh, WrTl, tope, topw, ctl + CTL_CNT, u * 16, lg, lane); }
        __syncthreads();
        if (bid == 0 && tid < NQ) ctl[CTL_CNT + tid * 65 + 64] = QT;
        for (int i = bid * NTHR + tid; i < CAP; i += G * NTHR) { rowoff[i] = 0u; rowmeta[i] = (u32x2){0xffffffffu, 0u}; }
        { const int wv = __builtin_amdgcn_readfirstlane(tid >> 6), lane = tid & 63; LAS float* scr = (LAS float*)((LAS unsigned char*)lds + wv * 8704);
          REPS(121) for (int it = bid * 8 + wv; it < 65 * 384; it += G * 8) { const int e = it / 384, r = it % 384;
            const float* wg = e < 64 ? p.w_gate + (size_t)e * D * EFF : p.ws_gate; const float* wu = e < 64 ? p.w_up + (size_t)e * D * EFF : p.ws_up; const float* wd = e < 64 ? p.w_down + (size_t)e * EFF * D : p.ws_down;
            if (r < 128) w_transpose_item(wg, D, EFF, WguT + (size_t)e * 512 * D, r, scr, lane, 2, 0);
            else if (r < 256) w_transpose_item(wu, D, EFF, WguT + (size_t)e * 512 * D, r - 128, scr, lane, 2, 1);
            else w_transpose_item(wd, EFF, D, WdT + (size_t)e * D * EFF, r - 256, scr, lane); } }
    }
    SEAM(12);
    if (IN(13)) b_scatter(ctl, tope, topw, rowoff, rowmeta, (int*)lds);
    SEAM(13);
    if (IN(14)) REPS(14) { G1Sched S{ctl, (const char*)x2h, rowoff, (const char*)WguT, G, bid}; pg8::EpiGateUp E{Hm};
        pg8::gemm_phase<pg8::EpiGateUp, G1Sched>((PG8_LAS unsigned char*)lds, D, S, E); }
    SEAM(14);
#pragma unroll 1
    for (int q = 0; q < NQ; ++q) {
        if (IN(15 + 2 * q)) REPS(15) { G2Sched S{ctl, (const char*)Hm, (const char*)WdT, q, G, bid}; pg8::EpiDown E{Yq, rowmeta};
            pg8::gemm_phase<pg8::EpiDown, G2Sched>((PG8_LAS unsigned char*)lds, EFF, S, E); }
        SEAM(15 + 2 * q);
        if (IN(16 + 2 * q)) REPS(16) b_combine(p, x2h, Yq, q);
        if (q < NQ - 1) SEAM(16 + 2 * q);
    }
#undef IN
#undef SEAM
#undef tid
}

#ifndef MK_PER_PHASE
#define MK_PER_PHASE 0
#endif
extern "C" void kernel_launch(void* const* d_in, const int* in_sizes, int n_in, void* d_out, int out_size, void* d_ws, size_t ws_size, hipStream_t stream) {
    static int grid = 0;
    if (grid == 0) {
        if (n_in != 28 || in_sizes[0] != M * D || out_size != M * D || ws_size < WS_NEED) { fprintf(stderr, "kernel_launch: unexpected shapes (n_in %d, in0 %d, out %d, ws %zu)\n", n_in, n_in > 0 ? in_sizes[0] : -1, out_size, ws_size); grid = -1; return; }
        if (hipFuncSetAttribute((const void*)mega_fwd, hipFuncAttributeMaxDynamicSharedMemorySize, LDS_BYTES) != hipSuccess) { fprintf(stderr, "kernel_launch: hipFuncSetAttribute failed\n"); grid = -1; return; }
        int dev = 0, cus = 0, per_cu = 0;
        hipGetDevice(&dev); hipDeviceGetAttribute(&cus, hipDeviceAttributeMultiprocessorCount, dev);
        if (hipOccupancyMaxActiveBlocksPerMultiprocessor(&per_cu, (const void*)mega_fwd, NTHR, LDS_BYTES) != hipSuccess || per_cu < 1) { fprintf(stderr, "kernel_launch: occupancy query failed (%d)\n", per_cu); grid = -1; return; }
        grid = cus;
    }
    if (grid < 0) return;
    Params p{};
    p.x = (const float*)d_in[0]; p.mem = (const float*)d_in[1]; p.positions = (const int*)d_in[2];
    p.w_in = (const float*)d_in[3]; p.pe_k = (const float*)d_in[4]; p.pe_v = (const float*)d_in[5];
    p.w1k = (const float*)d_in[6]; p.w2k = (const float*)d_in[7]; p.w1v = (const float*)d_in[8]; p.w2v = (const float*)d_in[9];
    p.w_out = (const float*)d_in[10]; p.ln1g = (const float*)d_in[11]; p.ln1b = (const float*)d_in[12];
    p.w_xq = (const float*)d_in[13]; p.w_xkv = (const float*)d_in[14]; p.w_xo = (const float*)d_in[15];
    p.ln2g = (const float*)d_in[16]; p.ln2b = (const float*)d_in[17]; p.w_router = (const float*)d_in[18]; p.rbias = (const float*)d_in[19];
    p.w_gate = (const float*)d_in[20]; p.w_up = (const float*)d_in[21]; p.w_down = (const float*)d_in[22];
    p.ws_gate = (const float*)d_in[23]; p.ws_up = (const float*)d_in[24]; p.ws_down = (const float*)d_in[25];
    p.ln3g = (const float*)d_in[26]; p.ln3b = (const float*)d_in[27];
    p.out = (float*)d_out; p.ws = (unsigned char*)d_ws;
    for (int i = 0; i < 4; ++i) p.lg[i] = (float)std::log(1.0 - std::pow(2.0, -5.0 - (double)i));
#if MK_PER_PHASE
    for (int ph = 0; ph < N_PHASES; ++ph) { p.ph_lo = ph; p.ph_hi = ph + 1; hipLaunchKernelGGL(mega_fwd, dim3(grid), dim3(NTHR), LDS_BYTES, stream, p); }
#else
    p.ph_lo = 0; p.ph_hi = N_PHASES;
    if (hipMemsetAsync((char*)d_ws + WS_BAR, 0, XCD_BAR_WORDS * 4, stream) != hipSuccess) { fprintf(stderr, "kernel_launch: memset failed\n"); return; }
    void* args[] = {&p};
    hipError_t e = hipLaunchCooperativeKernel((const void*)mega_fwd, dim3(grid), dim3(NTHR), args, LDS_BYTES, stream);
    if (e != hipSuccess) fprintf(stderr, "kernel_launch: cooperative launch failed: %s (grid %d)\n", hipGetErrorString(e), grid);
#endif
}
```

```cpp
#include <hip/hip_runtime.h>
#include <cstdio>
#include <cstdint>
#include <cmath>

typedef _Float16 h16;
typedef _Float16 h16x8 __attribute__((ext_vector_type(8)));
typedef _Float16 h16x2 __attribute__((ext_vector_type(2)));
typedef _Float16 h16x4 __attribute__((ext_vector_type(4)));
typedef float f32x2 __attribute__((ext_vector_type(2)));
typedef float f32x4 __attribute__((ext_vector_type(4)));
typedef unsigned u32x4 __attribute__((ext_vector_type(4)));
typedef unsigned u32x2 __attribute__((ext_vector_type(2)));

__device__ __forceinline__ int tidx() { int t = (int)threadIdx.x; asm volatile("" : "+v"(t)); return t; }

#ifndef PROBE_DBL
#define PROBE_DBL -1
#endif
#define REPS(k) for (int _rep = 0; _rep < ((PROBE_DBL) == (k) ? 2 : 1); ++_rep)

constexpr int NB = 4, T = 8192, D = 1024, M = NB * T;
constexpr int INC = 3352, INP = 3584;
constexpr int C_RQ = 0, C_RK = 512, C_RV = 1024, C_RG = 1536, C_NQ = 2048, C_NKC = 2560, C_NVC = 2688, C_NKS = 2816, C_NVS = 2944, C_NKW = 3072, C_NVW = 3200, C_NG = 3328;
constexpr int MEML = 256;
constexpr int NE = 64, EFF = 256;
constexpr float LN_EPS = 1e-5f;
constexpr float DN_ALPHA = 1.189207115002721f;
constexpr float NEGF = -1e30f;

constexpr size_t MiB = 1u << 20;
constexpr size_t WS_WIN = 1 * MiB, WS_WOUT = 8 * MiB, WS_WXQ = 10 * MiB, WS_WXO = 12 * MiB, WS_WXKV = 14 * MiB, WS_MEMH = 18 * MiB, WS_KVM = 20 * MiB;
constexpr size_t WS_KCMP = 24 * MiB, WS_VCMP = 25 * MiB, WS_TOPE = 26 * MiB, WS_TOPW = 27 * MiB;
constexpr size_t WS_XH = 32 * MiB, WS_MIX = 32 * MiB, WS_OX = 32 * MiB;
constexpr size_t WS_H = 96 * MiB, WS_NQR = 320 * MiB, WS_KVB = 352 * MiB, WS_PREV = 416 * MiB;
constexpr size_t WS_PRE = 96 * MiB, WS_X1 = 224 * MiB, WS_X1H = 352 * MiB, WS_QX = 416 * MiB, WS_X2 = 130 * MiB;
constexpr size_t WS_X2H = 32 * MiB, WS_WDT = 96 * MiB, WS_HM = 130 * MiB, WS_WGUT = 306 * MiB, WS_Y = 306 * MiB;
constexpr size_t WS_ROWOFF = 1 * MiB, WS_ROWMETA = 3 * MiB;
constexpr size_t WS_VST = 480 * MiB, WS_VWT = 488 * MiB, WS_COSR = 496 * MiB, WS_SINR = 504 * MiB, WS_COSN = 28 * MiB, WS_SINN = 29 * MiB, WS_KVMVT = 30 * MiB;
constexpr size_t WS_WRTH = 262144, WS_WRTL = 393216;
constexpr size_t WS_WC1T = 464 * MiB, WS_HID = 466 * MiB, WS_CMPOFF = 131072, WS_PEB = 131072 + 16384;
constexpr size_t WS_PREVT = 416 * MiB, WS_KSR = 448 * MiB, WS_KWR = 456 * MiB, WS_KX = 26 * MiB;
constexpr size_t DO_RQR = 0, DO_RKR = 32 * MiB, DO_RKZT = 64 * MiB, DO_RVT = 96 * MiB;
constexpr size_t WS_NEED = 512 * MiB;
constexpr int NQ = 4, QT = M / NQ, NVE = NQ * 65, CAP_TILES = 1412, CAP = CAP_TILES * 256;
constexpr size_t WS_BAR = 65536;
constexpr int CTL_CNT = 0, CTL_CUR = 512, CTL_PST = 1024, CTL_TQS = 1536, CTL_TVE = 2048;

namespace pg8 {
#define PG8_LAS __attribute__((address_space(3)))
typedef short s16x8 __attribute__((ext_vector_type(8)));
constexpr int BM = 256, BK = 64, HALF = 128, HTB = HALF * BK * 2, STAGE_BYTES = 8 * HTB, NXCD = 8, WGM = 8;
__host__ __device__ __forceinline__ int lds_byte(int r, int c) { const int st = (r >> 4) * 2 + (c >> 5), rr = r & 15, cc = c & 31, ob = rr * 64 + cc * 2; return st * 1024 + (ob ^ (((ob >> 9) & 1) << 5)); }
__host__ __device__ __forceinline__ void stage_rc(int b, int& R, int& C) { const int st = b / 1024, sb = b % 1024, swz = sb ^ (((sb >> 9) & 1) << 5); R = (st >> 1) * 16 + swz / 64; C = (st & 1) * 32 + (swz % 64) / 2; }
__host__ __device__ __forceinline__ int perm32(int rho) { const int n = rho >> 4, i = rho & 15; return 8 * (i >> 2) + 4 * n + (i & 3); }
struct Unit { int pm, pn; const char* A; const char* B; const unsigned* gat; };
struct Gemm { const h16* A; const h16* Bt; int M, N, K; };
struct StaticOrder {
    int nM, nN, nwg, G, c; const char* A; const char* B; size_t tstep;
    __device__ void init(const Gemm& g, int G_, int c_) { nM = g.M / BM; nN = g.N / BM; nwg = nM * nN; G = G_; c = c_; A = (const char*)g.A; B = (const char*)g.Bt; tstep = (size_t)BM * g.K * 2; }
    __device__ bool next(int i, Unit& u) const {
        const long L = (long)i * G + c; if (L >= nwg) return false;
        int wgid = (int)L; { const int q = nwg / NXCD, r = nwg % NXCD, xcd = wgid % NXCD, off = wgid / NXCD; wgid = (xcd < r ? xcd * (q + 1) : r * (q + 1) + (xcd - r) * q) + off; }
        const int nig = WGM * nN, gid = wgid / nig, fm = gid * WGM, gsz = (nM - fm) < WGM ? (nM - fm) : WGM;
        u.pm = fm + ((wgid % nig) % gsz); u.pn = (wgid % nig) / gsz; u.A = A + (size_t)u.pm * tstep; u.B = B + (size_t)u.pn * tstep; u.gat = nullptr; return true;
    }
};
__device__ __forceinline__ unsigned cvt_pk_f16(float lo, float hi) { f32x2 v = {lo, hi}; h16x2 h = __builtin_convertvector(v, h16x2); return __builtin_bit_cast(unsigned, h); }

struct EpiF16 {
    static constexpr bool PERM = true;
    h16* O; int ldc;
    __device__ __forceinline__ void operator()(const f32x4 (&acc)[2][2][4][2], const Unit& u, int wr, int wc, int fr, int fq) const {
        const int row0 = u.pm * BM + wr * 64 + fr; const int col0 = u.pn * BM + wc * 32 + 8 * fq;
#pragma unroll
        for (int ai = 0; ai < 2; ++ai)
#pragma unroll
            for (int m = 0; m < 4; ++m) { h16* rowp = O + (size_t)(row0 + ai * HALF + m * 16) * ldc + col0;
#pragma unroll
                for (int bj = 0; bj < 2; ++bj) { const f32x4 v0 = acc[ai][bj][m][0], v1 = acc[ai][bj][m][1];
                    *(h16x8*)(rowp + bj * HALF) = __builtin_convertvector(__builtin_shufflevector(v0, v1, 0, 1, 2, 3, 4, 5, 6, 7), h16x8); } }
    }
};
struct EpiResF32 {
    static constexpr bool PERM = false;
    float* C; const float* R; int ldc; float alpha;
    __device__ __forceinline__ void operator()(const f32x4 (&acc)[2][2][4][2], const Unit& u, int wr, int wc, int fr, int fq) const {
        const int row0 = u.pm * BM + wr * 64 + fr, col0 = u.pn * BM + wc * 32 + 4 * fq;
#pragma unroll
        for (int ai = 0; ai < 2; ++ai)
#pragma unroll
            for (int m = 0; m < 4; ++m) { const size_t off = (size_t)(row0 + ai * HALF + m * 16) * ldc + col0;
#pragma unroll
                for (int bj = 0; bj < 2; ++bj)
#pragma unroll
                    for (int n = 0; n < 2; ++n) { const f32x4 r = *(const f32x4*)(R + off + bj * HALF + n * 16); *(f32x4*)(C + off + bj * HALF + n * 16) = r * alpha + acc[ai][bj][m][n]; } }
    }
};
struct EpiCmp1 {
    static constexpr bool PERM = true;
    h16* O; const float* peb;
    __device__ __forceinline__ void operator()(const f32x4 (&acc)[2][2][4][2], const Unit& u, int wr, int wc, int fr, int fq) const {
        const int row0 = u.pm * BM + wr * 64 + fr; const int col0 = wc * 32 + 8 * fq;
#pragma unroll
        for (int bj = 0; bj < 2; ++bj) { const f32x4 b0 = *(const f32x4*)(peb + col0 + bj * HALF), b1 = *(const f32x4*)(peb + col0 + bj * HALF + 4);
#pragma unroll
            for (int ai = 0; ai < 2; ++ai)
#pragma unroll
                for (int m = 0; m < 4; ++m) { f32x4 v0 = acc[ai][bj][m][0] + b0, v1 = acc[ai][bj][m][1] + b1;
#pragma unroll
                    for (int r = 0; r < 4; ++r) { v0[r] = v0[r] / (1.f + __expf(-v0[r])); v1[r] = v1[r] / (1.f + __expf(-v1[r])); }
                    *(h16x8*)(O + (size_t)(row0 + ai * HALF + m * 16) * 256 + col0 + bj * HALF) = __builtin_convertvector(__builtin_shufflevector(v0, v1, 0, 1, 2, 3, 4, 5, 6, 7), h16x8); } }
    }
};
struct EpiGateUp {
    static constexpr bool PERM = true;
    h16* H;
    __device__ __forceinline__ void operator()(const f32x4 (&acc)[2][2][4][2], const Unit& u, int wr, int wc, int fr, int fq) const {
        const int row0 = u.pm * BM + wr * 64 + fr; const int col0 = u.pn * 128 + wc * 16 + 4 * fq;
#pragma unroll
        for (int ai = 0; ai < 2; ++ai)
#pragma unroll
            for (int m = 0; m < 4; ++m) { h16* rowp = H + (size_t)(row0 + ai * HALF + m * 16) * 256 + col0;
#pragma unroll
                for (int bj = 0; bj < 2; ++bj) { const f32x4 v0 = acc[ai][bj][m][0], v1 = acc[ai][bj][m][1];
                    const float h0 = v0[0] / (1.f + __expf(-v0[0])) * v0[1], h1 = v0[2] / (1.f + __expf(-v0[2])) * v0[3];
                    const float h2 = v1[0] / (1.f + __expf(-v1[0])) * v1[1], h3 = v1[2] / (1.f + __expf(-v1[2])) * v1[3];
                    *(h16x4*)(rowp + bj * 64) = __builtin_convertvector((f32x4){h0, h1, h2, h3}, h16x4); } }
    }
};
struct EpiDown {
    static constexpr bool PERM = true;
    h16* Y; const u32x2* rowmeta;
    __device__ __forceinline__ void operator()(const f32x4 (&acc)[2][2][4][2], const Unit& u, int wr, int wc, int fr, int fq) const {
        const int row0 = u.pm * BM + wr * 64 + fr; const int col0 = u.pn * BM + wc * 32 + 8 * fq;
#pragma unroll
        for (int ai = 0; ai < 2; ++ai)
#pragma unroll
            for (int m = 0; m < 4; ++m) { const u32x2 md = rowmeta[row0 + ai * HALF + m * 16]; const int slot = (int)md.x; const float w8 = __uint_as_float(md.y);
                if (slot >= 0) { h16* rowp = Y + (size_t)slot * 1024 + col0;
#pragma unroll
                    for (int bj = 0; bj < 2; ++bj) { const f32x4 v0 = acc[ai][bj][m][0] * w8, v1 = acc[ai][bj][m][1] * w8;
                        *(h16x8*)(rowp + bj * HALF) = __builtin_convertvector(__builtin_shufflevector(v0, v1, 0, 1, 2, 3, 4, 5, 6, 7), h16x8); } }
                asm volatile("" ::: "memory"); }
    }
};

template <class Epi, class Sched>
__device__ __forceinline__ void gemm_phase(PG8_LAS unsigned char* lds, const int K, const Sched& S, const Epi& E, const size_t kstepA = (size_t)(BK * 2)) {
    const int tid = tidx(), wid = __builtin_amdgcn_readfirstlane(tid >> 6), lane = tid & 63, wr = wid >> 2, wc = wid & 3, fr = lane & 15, fq = lane >> 4;
    const int nt = K / BK;
    int R0, C0; stage_rc(tid * 16, R0, C0);
    const unsigned cb2 = (unsigned)C0 * 2u;
    unsigned voffB[2];
#pragma unroll
    for (int i = 0; i < 2; ++i) { const int R = R0 + 64 * i; const int Rb = Epi::PERM ? ((R & ~31) + perm32(R & 31)) : R; voffB[i] = (unsigned)(Rb * K) * 2u + cb2; }
    const size_t kstep = (size_t)(BK * 2);
    const size_t hstep = (size_t)HALF * K * 2;
    const unsigned ldsw = (unsigned)wid * 1024u;
    const int aoff = lds_byte(wr * 64 + fr, fq * 8), boff = lds_byte(wc * 32 + fr, fq * 8);
#define PG8_MKVA(u, va) do { _Pragma("unroll") for (int _h = 0; _h < 2; ++_h) _Pragma("unroll") for (int _i = 0; _i < 2; ++_i) { const int _r = _h * HALF + R0 + 64 * _i; \
        (va)[_h][_i] = ((u).gat ? (u).gat[_r] : (unsigned)(_r * K) * 2u) + cb2; } } while (0)
#define PG8_SA(b, h) (((b) * 2 + (h)) * HTB)
#define PG8_SB(b, h) ((4 + (b) * 2 + (h)) * HTB)
#define PG8_STAGE(bufoff, gbase, voff) do { _Pragma("unroll") for (int _i = 0; _i < 2; ++_i) \
        __builtin_amdgcn_global_load_lds((const unsigned*)((const char*)(gbase) + (voff)[_i]), (PG8_LAS unsigned*)(lds + (bufoff) + ldsw + _i * 8192), 16, 0, 0); } while (0)
#define PG8_LDA(dst, b, h) do { _Pragma("unroll") for (int m = 0; m < 4; ++m) _Pragma("unroll") for (int k = 0; k < 2; ++k) dst[m][k] = *(const PG8_LAS s16x8*)(lds + PG8_SA(b, h) + aoff + m * 2048 + k * 1024); } while (0)
#define PG8_LDB(dst, b, h) do { _Pragma("unroll") for (int n = 0; n < 2; ++n) _Pragma("unroll") for (int k = 0; k < 2; ++k) dst[n][k] = *(const PG8_LAS s16x8*)(lds + PG8_SB(b, h) + boff + n * 2048 + k * 1024); } while (0)
#define PG8_MMA(ai, bj, At, Bt) do { __builtin_amdgcn_s_setprio(1); _Pragma("unroll") for (int m = 0; m < 4; ++m) _Pragma("unroll") for (int n = 0; n < 2; ++n) _Pragma("unroll") for (int k = 0; k < 2; ++k) \
        acc[ai][bj][m][n] = __builtin_amdgcn_mfma_f32_16x16x32_f16(__builtin_bit_cast(h16x8, Bt[n][k]), __builtin_bit_cast(h16x8, At[m][k]), acc[ai][bj][m][n], 0, 0, 0); __builtin_amdgcn_s_setprio(0); } while (0)
#define PG8_WAIT_V(n) asm volatile("s_waitcnt vmcnt(" #n ")" ::: "memory")
#define PG8_WAIT_L(n) asm volatile("s_waitcnt lgkmcnt(" #n ")" ::: "memory")
#define PG8_BAR __builtin_amdgcn_s_barrier()
#define PG8_SCHED __builtin_amdgcn_sched_barrier(0)
    Unit cur, nxt; int ui = 0;
    if (!S.next(0, cur)) return;
    unsigned va[2][2];
    PG8_MKVA(cur, va);
    f32x4 acc[2][2][4][2];
#pragma unroll
    for (int a = 0; a < 2; ++a)
#pragma unroll
        for (int b = 0; b < 2; ++b)
#pragma unroll
            for (int m = 0; m < 4; ++m)
#pragma unroll
                for (int n = 0; n < 2; ++n) acc[a][b][m][n] = (f32x4){0.f, 0.f, 0.f, 0.f};
    s16x8 At[4][2], B0[2][2], B1[2][2];
    const char* cA = cur.A; const char* cB = cur.B;
    {
        PG8_STAGE(PG8_SB(0, 0), cB, voffB); PG8_STAGE(PG8_SB(0, 1), cB + hstep, voffB); PG8_STAGE(PG8_SA(0, 0), cA, va[0]); PG8_STAGE(PG8_SA(0, 1), cA, va[1]);
        if (wr == 1) PG8_BAR;
        PG8_WAIT_V(2); PG8_BAR;
        PG8_STAGE(PG8_SB(1, 0), cB + kstep, voffB); PG8_STAGE(PG8_SA(1, 0), cA + kstepA, va[0]); PG8_STAGE(PG8_SB(1, 1), cB + hstep + kstep, voffB);
        PG8_WAIT_V(6); PG8_BAR;
    }
    for (;;) {
        const bool has_next = S.next(ui + 1, nxt);
        const char* nA = has_next ? nxt.A : cA; const char* nB = has_next ? nxt.B : cB;
#pragma unroll 1
        for (int t = 0; t < nt; t += 2) {
            const bool last = (t == nt - 2);
            const char* a1 = cA + (size_t)(t + 1) * kstepA;
            const char* a2 = last ? nA : cA + (size_t)(t + 2) * kstepA; const char* b2 = last ? nB : cB + (size_t)(t + 2) * kstep;
            const char* a3 = a2 + kstepA; const char* b3 = b2 + kstep;
            PG8_LDB(B0, 0, 0); PG8_LDB(B1, 0, 1); PG8_SCHED; PG8_LDA(At, 0, 0); PG8_STAGE(PG8_SA(1, 1), a1, va[1]);
            if (last && has_next) { PG8_MKVA(nxt, va); }
            PG8_WAIT_V(8); PG8_WAIT_L(0); PG8_BAR; PG8_MMA(0, 0, At, B0); PG8_MMA(0, 1, At, B1); PG8_BAR; PG8_SCHED;
            PG8_LDA(At, 0, 1); PG8_STAGE(PG8_SB(0, 0), b2, voffB); PG8_STAGE(PG8_SB(0, 1), b2 + hstep, voffB); PG8_STAGE(PG8_SA(0, 0), a2, va[0]);
            PG8_WAIT_V(8); PG8_WAIT_L(0); PG8_BAR; PG8_MMA(1, 0, At, B0); PG8_MMA(1, 1, At, B1); PG8_BAR; PG8_SCHED;
            PG8_LDB(B0, 1, 0); PG8_LDB(B1, 1, 1); PG8_SCHED; PG8_LDA(At, 1, 0); PG8_STAGE(PG8_SA(0, 1), a2, va[1]);
            PG8_WAIT_V(8); PG8_WAIT_L(0); PG8_BAR; PG8_MMA(0, 0, At, B0); PG8_MMA(0, 1, At, B1); PG8_BAR; PG8_SCHED;
            PG8_LDA(At, 1, 1); PG8_STAGE(PG8_SB(1, 0), b3, voffB); PG8_STAGE(PG8_SB(1, 1), b3 + hstep, voffB); PG8_STAGE(PG8_SA(1, 0), a3, va[0]);
            PG8_WAIT_V(8); PG8_WAIT_L(0); PG8_BAR; PG8_MMA(1, 0, At, B0); PG8_MMA(1, 1, At, B1); PG8_BAR; PG8_SCHED;
        }
        if (wr == 0) PG8_BAR;
        E(acc, cur, wr, wc, fr, fq);
        if (!has_next) break;
#pragma unroll
        for (int a = 0; a < 2; ++a)
#pragma unroll
            for (int b = 0; b < 2; ++b)
#pragma unroll
                for (int m = 0; m < 4; ++m)
#pragma unroll
                    for (int n = 0; n < 2; ++n) acc[a][b][m][n] = (f32x4){0.f, 0.f, 0.f, 0.f};
        cur = nxt; cA = nA; cB = nB; ++ui;
        if (wr == 1) PG8_BAR;
    }
    PG8_WAIT_V(0);
    PG8_BAR;
#undef PG8_MKVA
#undef PG8_SA
#undef PG8_SB
#undef PG8_STAGE
#undef PG8_LDA
#undef PG8_LDB
#undef PG8_MMA
#undef PG8_WAIT_V
#undef PG8_WAIT_L
#undef PG8_BAR
#undef PG8_SCHED
}
}


#include <hip/hip_cooperative_groups.h>
namespace cg = cooperative_groups;
constexpr int NTHR = 512;
constexpr int LDS_BYTES = 147456;
#define LAS __attribute__((address_space(3)))

struct Params {
    const float *x, *mem; const int* positions;
    const float *w_in, *pe_k, *pe_v, *w1k, *w2k, *w1v, *w2v, *w_out, *ln1g, *ln1b, *w_xq, *w_xkv, *w_xo, *ln2g, *ln2b, *w_router, *rbias, *w_gate, *w_up, *w_down, *ws_gate, *ws_up, *ws_down, *ln3g, *ln3b;
    float* out; unsigned char* ws;
    float lg[4];
    int ph_lo, ph_hi;
};

__device__ __forceinline__ float wave_sum(float v) {
#pragma unroll
    for (int o = 1; o < 64; o <<= 1) v += __shfl_xor(v, o);
    return v;
}
__device__ __forceinline__ float wave_max(float v) {
#pragma unroll
    for (int o = 1; o < 64; o <<= 1) v = fmaxf(v, __shfl_xor(v, o));
    return v;
}
__device__ __forceinline__ float siluf(float v) { return v / (1.f + __expf(-v)); }
__device__ __forceinline__ float sigmf(float v) { return 1.f / (1.f + __expf(-v)); }

__device__ __forceinline__ void b_transpose_tile(const float* __restrict__ W, int K, int N, h16* __restrict__ WT, int Npad, int tile, float* tl, int lt, int rs = 1, int ro = 0) {
    const int ntn = Npad / 32; const int n0 = (tile % ntn) * 32, k0 = (tile / ntn) * 32, tx = lt & 31, ty = lt >> 5;
    for (int i = ty; i < 32; i += 8) { const int k = k0 + i, n = n0 + tx; tl[i * 33 + tx] = (n < N) ? W[(size_t)k * N + n] : 0.f; }
    __syncthreads();
    for (int i = ty; i < 32; i += 8) { const int n = n0 + i, k = k0 + tx; WT[(size_t)(n * rs + ro) * K + k] = (h16)tl[tx * 33 + i]; }
    __syncthreads();
}
__device__ __forceinline__ void w_transpose_item(const float* __restrict__ W, int K, int N, h16* __restrict__ WT, int item, LAS float* scr, int lane, int rs = 1, int ro = 0) {
    const int nblk = N / 32, kb = item / nblk, nb = item % nblk, k0 = 64 * kb, n0 = 32 * nb;
#pragma unroll 8
    for (int i = 0; i < 32; ++i) { const int kk = 2 * i + (lane >> 5); scr[kk * 33 + (lane & 31)] = W[(size_t)(k0 + kk) * N + n0 + (lane & 31)]; }
    asm volatile("s_waitcnt lgkmcnt(0)" ::: "memory");
    const int c = lane & 7;
#pragma unroll
    for (int j = 0; j < 4; ++j) { const int n = (lane >> 3) + 8 * j; LAS const float* s = scr + (8 * c) * 33 + n; h16x8 o;
#pragma unroll
        for (int x = 0; x < 8; ++x) o[x] = (h16)s[x * 33];
        *(h16x8*)(WT + (size_t)((n0 + n) * rs + ro) * K + k0 + 8 * c) = o; }
    asm volatile("s_waitcnt lgkmcnt(0)" ::: "memory");
}
__device__ __forceinline__ void b_cvt(const float* __restrict__ x, h16* __restrict__ o, size_t n4) {
    for (size_t i = (size_t)blockIdx.x * NTHR + tidx(); i < n4; i += (size_t)gridDim.x * NTHR) {
        const f32x4 v = ((const f32x4*)x)[i]; ((h16x4*)o)[i] = __builtin_convertvector(v, h16x4); }
}

__device__ __forceinline__ void b_tables(const int* __restrict__ positions, float* __restrict__ cosr, float* __restrict__ sinr, float* __restrict__ cosn, float* __restrict__ sinn) {
    for (int idx = blockIdx.x * NTHR + tidx(); idx < M * 72; idx += gridDim.x * NTHR) {
        const int m = idx / 72, j = idx % 72; const float pos = (float)positions[m];
        const float inv = j < 64 ? (float)pow(10000.0, -(double)j / 64.0) : (float)pow(500000.0, -(double)(j - 64) / 8.0);
        const float ang = pos * inv; double sd, cd; sincos((double)ang, &sd, &cd);
        if (j < 64) { cosr[(size_t)m * 64 + j] = (float)cd; sinr[(size_t)m * 64 + j] = (float)sd; } else { cosn[(size_t)m * 8 + j - 64] = (float)cd; sinn[(size_t)m * 8 + j - 64] = (float)sd; }
    }
}
__device__ __forceinline__ void b_rope(const h16* __restrict__ h, h16* __restrict__ rqr, h16* __restrict__ rkr, h16* __restrict__ nqr, h16* __restrict__ ksR, h16* __restrict__ kwR, const float* __restrict__ cosr, const float* __restrict__ sinr,
                                       const float* __restrict__ cosn, const float* __restrict__ sinn, int m, int j) {
    const h16* hr = h + (size_t)m * INP; const int bb = m >> 13, t = m & (T - 1);
    {   const int hd = j >> 6, jj = j & 63; const float c = cosr[(size_t)m * 64 + jj], s = sinr[(size_t)m * 64 + jj]; const size_t ro = ((size_t)(bb * 4 + hd) * T + t) * 128;
        const int o1 = hd * 128 + jj, o2 = o1 + 64;
        const float q1 = (float)hr[C_RQ + o1], q2 = (float)hr[C_RQ + o2];
        rqr[ro + jj] = (h16)(q1 * c - q2 * s); rqr[ro + jj + 64] = (h16)(q2 * c + q1 * s);
        const float k1 = (float)hr[C_RK + o1], k2 = (float)hr[C_RK + o2]; const float sc = 0.08838834764831845f;
        rkr[ro + jj] = (h16)((k1 * c - k2 * s) * sc); rkr[ro + jj + 64] = (h16)((k2 * c + k1 * s) * sc);
    }
    if (j < 64 + 16 + 16) {
        const int jj = j & 7; const float c = cosn[(size_t)m * 8 + jj], s = sinn[(size_t)m * 8 + jj];
        if (j < 64) { const int hd = j >> 3; const int o1 = hd * 64 + jj, o2 = o1 + 8;
            const float q1 = (float)hr[C_NQ + o1], q2 = (float)hr[C_NQ + o2];
            nqr[(size_t)m * 512 + o1] = (h16)(q1 * c - q2 * s); nqr[(size_t)m * 512 + o2] = (h16)(q2 * c + q1 * s);
        } else { const int jx = j - 64; const int which = jx >> 4, g = (jx >> 3) & 1; const int base = (which ? C_NKW : C_NKS) + g * 64 + jj;
            const float k1 = (float)hr[base], k2 = (float)hr[base + 8];
            h16* dst = (which ? kwR : ksR) + (((size_t)((bb * 2 + g) * 128 + (t >> 6)) * 64 + (t & 63)) * 64); dst[jj] = (h16)(k1 * c - k2 * s); dst[jj + 8] = (h16)(k2 * c + k1 * s); }
    }
    if (j >= 128 && j < 128 + 96) { const int jx = j - 128; const int which = jx / 48, r = jx % 48, g = r / 24, d = 16 + 2 * (r % 24);
        const int base = (which ? C_NKW : C_NKS) + g * 64 + d; h16* dst = (which ? kwR : ksR) + (((size_t)((bb * 2 + g) * 128 + (t >> 6)) * 64 + (t & 63)) * 64);
        dst[d] = hr[base]; dst[d + 1] = hr[base + 1]; }
    for (int i = j; i < 8 * 48; i += 256) { const int hd = i / 48, d = 16 + i % 48; nqr[(size_t)m * 512 + hd * 64 + d] = hr[C_NQ + hd * 64 + d]; }
}
__device__ __forceinline__ void b_rtrans(const Params& p, const h16* __restrict__ h, h16* __restrict__ rvT, h16* __restrict__ rkzT, const float* __restrict__ cosr, const float* __restrict__ sinr, int item, h16* sl, int lt) {
    int id = item; const int tt = id & 127; id >>= 7; const int hd = id & 3; const int b = id >> 2; const int bh = b * 4 + hd; const float lg = p.lg[hd];
    for (int i = lt; i < 64 * 128; i += 256) { const int t = i >> 7, e = i & 127; sl[t * 130 + e] = h[(size_t)(b * T + tt * 64 + t) * INP + C_RV + hd * 128 + e]; }
    __syncthreads();
    for (int i = lt; i < 64 * 128; i += 256) { const int e = i >> 6, t = i & 63; rvT[((size_t)(bh * 64 + (tt >> 1)) * 128 + e) * 128 + (tt & 1) * 64 + t] = sl[t * 130 + e]; }
    __syncthreads();
    for (int i = lt; i < 64 * 64; i += 256) { const int t = i >> 6, jj = i & 63; const size_t m = (size_t)b * T + tt * 64 + t;
        const float c = cosr[m * 64 + jj], s = sinr[m * 64 + jj]; const float k1 = (float)h[m * INP + C_RK + hd * 128 + jj], k2 = (float)h[m * INP + C_RK + hd * 128 + jj + 64];
        const float z = 0.08838834764831845f * __expf(lg * (float)(127 - ((tt * 64 + t) & 127)));
        sl[t * 130 + jj] = (h16)((k1 * c - k2 * s) * z); sl[t * 130 + jj + 64] = (h16)((k2 * c + k1 * s) * z); }
    __syncthreads();
    for (int i = lt; i < 64 * 128; i += 256) { const int d = i >> 6, t = i & 63; rkzT[((size_t)(bh * 64 + (tt >> 1)) * 128 + d) * 128 + (tt & 1) * 64 + t] = sl[t * 130 + d]; }
    __syncthreads();
}
__device__ __forceinline__ void b_mvtrans(const h16* __restrict__ kvm, h16* __restrict__ kvmVT, h16* __restrict__ kx, int item, h16* sl, int lt) {
    int id = item; const int kt = id & 3; id >>= 2; const int dtl = id & 3; id >>= 2; const int hh = id & 3; const int b = id >> 2;
    for (int i = lt; i < 64 * 64; i += 256) { const int k = i >> 6, d = i & 63; sl[k * 66 + d] = kvm[(size_t)(b * MEML + kt * 64 + k) * 2048 + 1024 + hh * 256 + dtl * 64 + d];
        kx[((size_t)(b * 4 + hh) * MEML + kt * 64 + k) * 256 + dtl * 64 + d] = kvm[(size_t)(b * MEML + kt * 64 + k) * 2048 + hh * 256 + dtl * 64 + d]; }
    __syncthreads();
    for (int i = lt; i < 64 * 64; i += 256) { const int d = i >> 6, k = i & 63; kvmVT[(size_t)((b * 4 + hh) * 256 + dtl * 64 + d) * MEML + kt * 64 + k] = sl[k * 66 + d]; }
    __syncthreads();
}

struct CmpSched {
    const char* hbase; const unsigned* cmpoff; const char* Wc1T; int c;
    __device__ bool next(int i, pg8::Unit& u) const {
        if (i > 0 || c >= 32) return false; const int kv = c >> 4, rt = c & 15;
        u.pm = kv * 16 + rt; u.pn = 0; u.A = hbase + (size_t)(kv ? C_NVC : C_NKC) * 2; u.gat = cmpoff + rt * 256; u.B = Wc1T + (size_t)kv * 256 * 2048 * 2; return true; }
};
__device__ __forceinline__ void b_cmp2(const Params& p, const h16* __restrict__ hid, h16* __restrict__ kcmp, h16* __restrict__ vcmpT) {
    const int lane = tidx() & 63;
    for (int r = blockIdx.x * 8 + (tidx() >> 6); r < 2 * 4096; r += gridDim.x * 8) {
        const int kv = r >> 12, rr = r & 4095, g = rr & 1, c = (rr >> 1) & 511, b = rr >> 10;
        const float* w2 = kv ? p.w2v : p.w2k; const h16* hr = hid + (size_t)r * 256; float acc = 0.f;
        for (int j = 0; j < 256; j += 8) { const h16x8 hv = *(const h16x8*)(hr + j);
#pragma unroll
            for (int x = 0; x < 8; ++x) acc += (float)hv[x] * w2[(j + x) * 64 + lane]; }
        if (c == 511) acc = 0.f;
        if (kv == 0) kcmp[((size_t)(b * 2 + g) * 512 + c) * 64 + lane] = (h16)acc;
        else vcmpT[(((size_t)(b * 2 + g) * 8 + (c >> 6)) * 64 + lane) * 64 + (c & 63)] = (h16)acc;
    }
}
__device__ __forceinline__ void b_vtrans(const h16* __restrict__ h, h16* __restrict__ vsT, h16* __restrict__ vwT, int item, h16* sl, int lt) {
    int id = item; const int tt = id & 127; id >>= 7; const int g = id & 1; id >>= 1; const int b = id & 3; const int which = id >> 2;
    const int col = (which ? C_NVW : C_NVS) + g * 64; h16* dst = (which ? vwT : vsT) + (size_t)((b * 2 + g) * 128 + tt) * 4096;
    for (int i = lt; i < 64 * 64; i += 256) { const int t = i >> 6, d = i & 63; sl[t * 66 + d] = h[(size_t)(b * T + tt * 64 + t) * INP + col + d]; }
    __syncthreads();
    for (int i = lt; i < 64 * 64; i += 256) { const int d = i >> 6, t = i & 63; dst[d * 64 + t] = sl[t * 66 + d]; }
    __syncthreads();
}

__device__ __forceinline__ void ret_kv_unit(const h16* __restrict__ rkzT, const h16* __restrict__ rvT, float* __restrict__ kvT, int chunk, int w, int lane) {
    const int i = lane & 15, kg = lane >> 4; const int bh = chunk >> 6, n = chunk & 63;
    h16x8 a[4];
#pragma unroll
    for (int ks = 0; ks < 4; ++ks) a[ks] = *(const h16x8*)(rkzT + ((size_t)chunk * 128 + 16 * w + i) * 128 + 32 * ks + 8 * kg);
#pragma unroll
    for (int et = 0; et < 8; ++et) { f32x4 acc = {0.f, 0.f, 0.f, 0.f};
#pragma unroll
        for (int ks = 0; ks < 4; ++ks) { const h16x8 bq = *(const h16x8*)(rvT + ((size_t)chunk * 128 + 16 * et + i) * 128 + 32 * ks + 8 * kg); acc = __builtin_amdgcn_mfma_f32_16x16x32_f16(a[ks], bq, acc, 0, 0, 0); }
        *(f32x4*)(kvT + ((size_t)chunk * 128 + 16 * et + i) * 128 + 16 * w + 4 * kg) = acc; }
}
__device__ __forceinline__ void b_ret_scan(const Params& p, const float* __restrict__ kvT, h16* __restrict__ prevT) {
    for (int gid = blockIdx.x * NTHR + tidx(); gid < 16 * 16384; gid += gridDim.x * NTHR) {
        const int de = gid & 16383, bh = gid >> 14; const float cd = __expf(p.lg[bh & 3] * 128.f);
        float st = 0.f;
        for (int n = 0; n < 64; ++n) { const size_t o = ((size_t)(bh * 64 + n) << 14) + de; prevT[o] = (h16)st; st = st * cd + kvT[o]; }
    }
}
__device__ __forceinline__ void ret_out_unit(const Params& p, const h16* __restrict__ h, const h16* __restrict__ rqr, const h16* __restrict__ rkr, const h16* __restrict__ rvT, const h16* __restrict__ prevT,
                                             h16* __restrict__ mix, int chunk, int w, int lane) {
    const int i = lane & 15, kg = lane >> 4; const int bh = chunk >> 6, n = chunk & 63, b = bh >> 2, hd = bh & 3; const float lg = p.lg[hd];
    const int qi = 16 * w + i; const size_t m = (size_t)b * T + n * 128 + qi;
    h16x8 qf[4];
#pragma unroll
    for (int ks = 0; ks < 4; ++ks) qf[ks] = *(const h16x8*)(rqr + ((size_t)bh * T + n * 128 + qi) * 128 + 32 * ks + 8 * kg);
    f32x4 inner[8], cross[8];
#pragma unroll
    for (int et = 0; et < 8; ++et) { inner[et] = (f32x4){0.f, 0.f, 0.f, 0.f}; cross[et] = (f32x4){0.f, 0.f, 0.f, 0.f}; }
    for (int gq = 0; gq < 2; ++gq) {
        if (64 * gq > 16 * w + 15) break;
        f32x4 s[4];
#pragma unroll
        for (int tl = 0; tl < 4; ++tl) { const int ko = 32 * (tl >> 1) + 8 * (i >> 2) + 4 * (tl & 1) + (i & 3); const h16* kp = rkr + ((size_t)bh * T + n * 128 + 64 * gq + ko) * 128 + 8 * kg;
            f32x4 acc = {0.f, 0.f, 0.f, 0.f};
#pragma unroll
            for (int ks = 0; ks < 4; ++ks) acc = __builtin_amdgcn_mfma_f32_16x16x32_f16(*(const h16x8*)(kp + 32 * ks), qf[ks], acc, 0, 0, 0);
            s[tl] = acc; }
        h16x8 pf[2];
#pragma unroll
        for (int tl = 0; tl < 4; ++tl)
#pragma unroll
            for (int r = 0; r < 4; ++r) { const int j = 64 * gq + 32 * (tl >> 1) + 8 * kg + 4 * (tl & 1) + r; const float v = (j <= qi) ? s[tl][r] * __expf(lg * (float)(qi - j)) : 0.f; pf[tl >> 1][4 * (tl & 1) + r] = (h16)v; }
#pragma unroll
        for (int et = 0; et < 8; ++et)
#pragma unroll
            for (int s2 = 0; s2 < 2; ++s2) { const h16x8 a = *(const h16x8*)(rvT + ((size_t)chunk * 128 + 16 * et + i) * 128 + 64 * gq + 32 * s2 + 8 * kg); inner[et] = __builtin_amdgcn_mfma_f32_16x16x32_f16(a, pf[s2], inner[et], 0, 0, 0); }
    }
#pragma unroll
    for (int et = 0; et < 8; ++et)
#pragma unroll
        for (int ks = 0; ks < 4; ++ks) { const h16x8 a = *(const h16x8*)(prevT + ((size_t)chunk * 128 + 16 * et + i) * 128 + 32 * ks + 8 * kg); cross[et] = __builtin_amdgcn_mfma_f32_16x16x32_f16(a, qf[ks], cross[et], 0, 0, 0); }
    const float xi = __expf(lg * (float)(qi + 1));
    float sm = 0.f;
#pragma unroll
    for (int et = 0; et < 8; ++et) { inner[et] = inner[et] + cross[et] * xi; sm += (inner[et][0] + inner[et][1]) + (inner[et][2] + inner[et][3]); }
    sm += __shfl_xor(sm, 16); sm += __shfl_xor(sm, 32);
    const float mu = sm * (1.f / 128.f); float sq = 0.f;
#pragma unroll
    for (int et = 0; et < 8; ++et) { inner[et] = inner[et] - mu; sq += (inner[et][0] * inner[et][0] + inner[et][1] * inner[et][1]) + (inner[et][2] * inner[et][2] + inner[et][3] * inner[et][3]); }
    sq += __shfl_xor(sq, 16); sq += __shfl_xor(sq, 32);
    const float rstd = rsqrtf(sq * (1.f / 128.f) + LN_EPS);
#pragma unroll
    for (int et = 0; et < 8; ++et) { const int e = 16 * et + 4 * kg; const h16x4 gv = *(const h16x4*)(h + m * INP + C_RG + hd * 128 + e);
        f32x4 o;
#pragma unroll
        for (int r = 0; r < 4; ++r) o[r] = siluf((float)gv[r]) * inner[et][r] * rstd;
        *(h16x4*)(mix + m * D + hd * 128 + e) = __builtin_convertvector(o, h16x4); }
}

struct AttSt { float m, l; f32x4 o[4]; };
struct KFrag { h16x8 a[4][2]; };
struct VFrag { h16x8 a[4][2]; };
__device__ __forceinline__ void ldk(KFrag& k, const h16* __restrict__ Kb, int pitchK, int i, int kg) {
#pragma unroll
    for (int tl = 0; tl < 4; ++tl) { const int ko = 32 * (tl >> 1) + 8 * (i >> 2) + 4 * (tl & 1) + (i & 3); const h16* kp = Kb + (size_t)ko * pitchK + 8 * kg;
        k.a[tl][0] = *(const h16x8*)kp; k.a[tl][1] = *(const h16x8*)(kp + 32); }
}
__device__ __forceinline__ void ldv(VFrag& v, const h16* __restrict__ VTb, int vstride, int i, int kg) {
#pragma unroll
    for (int dt = 0; dt < 4; ++dt)
#pragma unroll
        for (int s2 = 0; s2 < 2; ++s2) v.a[dt][s2] = *(const h16x8*)(VTb + (size_t)(16 * dt + i) * vstride + 32 * s2 + 8 * kg);
}
__device__ __forceinline__ float xmax4(float v) {
    auto a = __builtin_amdgcn_permlane16_swap(__float_as_uint(v), __float_as_uint(v), false, false); v = fmaxf(__uint_as_float(a[0]), __uint_as_float(a[1]));
    auto c = __builtin_amdgcn_permlane32_swap(__float_as_uint(v), __float_as_uint(v), false, false); return fmaxf(__uint_as_float(c[0]), __uint_as_float(c[1])); }
__device__ __forceinline__ float xsum4(float v) {
    auto a = __builtin_amdgcn_permlane16_swap(__float_as_uint(v), __float_as_uint(v), false, false); v = __uint_as_float(a[0]) + __uint_as_float(a[1]);
    auto c = __builtin_amdgcn_permlane32_swap(__float_as_uint(v), __float_as_uint(v), false, false); return __uint_as_float(c[0]) + __uint_as_float(c[1]); }
constexpr float ATT_C2 = 0.125f * 1.4426950408889634f;
template <bool MASKED, class MaskF>
__device__ __forceinline__ void att_scores(f32x4 (&s)[4], const KFrag& k, const h16x8 (&qf)[2], int kg, MaskF valid) {
#pragma unroll
    for (int tl = 0; tl < 4; ++tl) { f32x4 z = {0.f, 0.f, 0.f, 0.f}; z = __builtin_amdgcn_mfma_f32_16x16x32_f16(k.a[tl][0], qf[0], z, 0, 0, 0); s[tl] = __builtin_amdgcn_mfma_f32_16x16x32_f16(k.a[tl][1], qf[1], z, 0, 0, 0); }
    if (MASKED) {
#pragma unroll
        for (int tl = 0; tl < 4; ++tl)
#pragma unroll
            for (int r = 0; r < 4; ++r) { const int ko = 32 * (tl >> 1) + 8 * kg + 4 * (tl & 1) + r; s[tl][r] = valid(ko) ? s[tl][r] : -INFINITY; }
    }
}
__device__ __forceinline__ float att_rowmax(const f32x4 (&s)[4]) {
    float mx = fmaxf(fmaxf(s[0][0], s[0][1]), fmaxf(s[0][2], s[0][3]));
#pragma unroll
    for (int tl = 1; tl < 4; ++tl) mx = fmaxf(mx, fmaxf(fmaxf(s[tl][0], s[tl][1]), fmaxf(s[tl][2], s[tl][3])));
    return xmax4(mx);
}
__device__ __forceinline__ void att_pv(f32x4 (&o)[4], const f32x4 (&pv)[4], const VFrag& v) {
    h16x8 pf[2];
#pragma unroll
    for (int s2 = 0; s2 < 2; ++s2)
#pragma unroll
        for (int j = 0; j < 8; ++j) pf[s2][j] = (h16)pv[2 * s2 + (j >> 2)][j & 3];
#pragma unroll
    for (int dt = 0; dt < 4; ++dt)
#pragma unroll
        for (int s2 = 0; s2 < 2; ++s2) o[dt] = __builtin_amdgcn_mfma_f32_16x16x32_f16(v.a[dt][s2], pf[s2], o[dt], 0, 0, 0);
}
__device__ __forceinline__ void att_softmax_pv(AttSt& st, f32x4 (&s)[4], const VFrag& v, bool rowok) {
    const float mx = rowok ? att_rowmax(s) * ATT_C2 : -INFINITY;
    const float mn = fmaxf(st.m, mx);
    if (__any(mn > st.m)) { const float alpha = __builtin_amdgcn_exp2f(st.m - mn); st.m = mn; st.l *= alpha;
#pragma unroll
        for (int dt = 0; dt < 4; ++dt) st.o[dt] = st.o[dt] * alpha; }
    const float mneg = rowok ? -mn : -INFINITY;
    float ps0 = 0.f, ps1 = 0.f;
#pragma unroll
    for (int tl = 0; tl < 4; ++tl) {
#pragma unroll
        for (int r = 0; r < 4; ++r) s[tl][r] = __builtin_amdgcn_exp2f(__builtin_fmaf(s[tl][r], ATT_C2, mneg));
        ps0 += s[tl][0] + s[tl][1]; ps1 += s[tl][2] + s[tl][3]; }
    st.l += ps0 + ps1;
    att_pv(st.o, s, v);
}
template <bool MASKED, class MaskF>
__device__ __forceinline__ void att_tile(AttSt& st, const KFrag& k, const VFrag& v, const h16x8 (&qf)[2], int kg, bool rowok, MaskF valid) {
    f32x4 s[4]; att_scores<MASKED>(s, k, qf, kg, valid);
    att_softmax_pv(st, s, v, rowok);
}
constexpr int NSA_NSLOT = 6, NSA_RING = 0, NSA_IMP = NSA_NSLOT * 16384, NSA_MSK = 131072 + 256, NSA_LIST = NSA_MSK + 256;
__device__ __forceinline__ void ldk_lds(KFrag& k, LAS const unsigned char* slot, int ko0, int ko1) {
#pragma unroll
    for (int tl = 0; tl < 4; ++tl) { const int o = (32 * (tl >> 1) + 4 * (tl & 1)) * 128; k.a[tl][0] = *(LAS const h16x8*)(slot + o + ko0); k.a[tl][1] = *(LAS const h16x8*)(slot + o + ko1); }
}
__device__ __forceinline__ void ldv_lds(VFrag& v, LAS const unsigned char* slot, int vo0, int vo1) {
#pragma unroll
    for (int dt = 0; dt < 4; ++dt) { v.a[dt][0] = *(LAS const h16x8*)(slot + 8192 + dt * 2048 + vo0); v.a[dt][1] = *(LAS const h16x8*)(slot + 8192 + dt * 2048 + vo1); }
}
#define NSA_WAITV(n) asm volatile("s_waitcnt vmcnt(" #n ")" ::: "memory")
#define NSA_BAR() do { asm volatile("s_waitcnt lgkmcnt(0)" ::: "memory"); __builtin_amdgcn_s_barrier(); asm volatile("" ::: "memory"); } while (0)
template <int LPT, class IssueF, class CompF>
__device__ __forceinline__ void nsa_stream2(int n, LAS unsigned char* dmaw, LAS unsigned char* ring, IssueF issue, CompF comp2) {
#pragma unroll
    for (int j = 0; j < 4; ++j) if (j < n) issue(j, (LAS unsigned*)(dmaw + j * 16384));
    int sa = 0, si = 4 * 16384;
    for (int t2 = 0; t2 < n; t2 += 2) {
        const int rem = n - t2 - 2;
        if (rem >= 2) { if (LPT == 2) NSA_WAITV(4); else NSA_WAITV(2); } else if (rem == 1) { if (LPT == 2) NSA_WAITV(2); else NSA_WAITV(1); } else NSA_WAITV(0);
        NSA_BAR();
        if (t2 + 4 < n) issue(t2 + 4, (LAS unsigned*)(dmaw + si));
        if (t2 + 5 < n) issue(t2 + 5, (LAS unsigned*)(dmaw + si + 16384));
        comp2(t2, (LAS const unsigned char*)(ring + sa), t2 + 1 < n, (LAS const unsigned char*)(ring + sa + 16384));
        sa = (sa == 4 * 16384) ? 0 : sa + 2 * 16384; si = (si == 4 * 16384) ? 0 : si + 2 * 16384; }
    NSA_BAR();
}
__device__ __forceinline__ void att_merge(AttSt& a, const AttSt& b2) {
    const float mn = fmaxf(a.m, b2.m); const float fa = __builtin_amdgcn_exp2f(a.m - mn), fb = __builtin_amdgcn_exp2f(b2.m - mn);
    a.m = mn; a.l = a.l * fa + b2.l * fb;
#pragma unroll
    for (int dt = 0; dt < 4; ++dt) a.o[dt] = a.o[dt] * fa + b2.o[dt] * fb;
}
__device__ __forceinline__ void nsa_block_unit(const h16* __restrict__ h, const h16* __restrict__ nqr, const h16* __restrict__ kcmp, const h16* __restrict__ vcmpT, const h16* __restrict__ vsT, const h16* __restrict__ vwT,
                                               const h16* __restrict__ ksR, const h16* __restrict__ kwR, h16* __restrict__ mix, int b, int g, int T0, LAS unsigned char* lds, int wv, int lane) {
    const int i = lane & 15, kg = lane >> 4, tt = i & 3, hh = i >> 2;
    const int t0 = T0 + 4 * wv, trow = t0 + tt; const size_t mrow = (size_t)b * T + trow;
    const int q = wv * 64 + lane, qrow = q >> 3, qch = q & 7;
    const int ksrc = qrow * 128 + ((qch ^ (((qrow >> 1) & 1) | (((qrow >> 3) & 3) << 1))) << 4), vsrc = qrow * 128 + ((qch ^ ((qrow >> 1) & 7)) << 4);
    const int gki = ((i >> 1) & 1) | ((i >> 2) << 1), gvi = (i >> 1) & 7;
    const int ko0 = (8 * (i >> 2) + (i & 3)) * 128 + ((kg ^ gki) << 4), ko1 = (8 * (i >> 2) + (i & 3)) * 128 + (((kg + 4) ^ gki) << 4);
    const int vo0 = i * 128 + ((kg ^ gvi) << 4), vo1 = i * 128 + (((kg + 4) ^ gvi) << 4);
    LAS unsigned char* ring = lds + NSA_RING; LAS unsigned char* dmaw = ring + wv * 1024;
    LAS float* impA = (LAS float*)(lds + NSA_IMP + wv * 4096); LAS float* impL = impA + 512;
    h16x8 qf[2], qrf[2];
    { const h16* qp = h + mrow * INP + C_NQ + (g * 4 + hh) * 64 + 8 * kg; qf[0] = *(const h16x8*)qp; qf[1] = *(const h16x8*)(qp + 32);
      const h16* qrp = nqr + mrow * 512 + (g * 4 + hh) * 64 + 8 * kg; qrf[0] = *(const h16x8*)qrp; qrf[1] = *(const h16x8*)(qrp + 32); }
    const h16* gp = h + mrow * INP + C_NG + (g * 4 + hh) * 3; const float gt0 = (float)gp[0], gt1 = (float)gp[1], gt2 = (float)gp[2];
    for (int x = lane; x < 1024; x += 64) impA[x] = 0.f;
    NSA_WAITV(0);
#define GLDS16(gsrc, ldst) __builtin_amdgcn_global_load_lds((const unsigned*)(gsrc), (ldst), 16, 0, 0)
    const int ncv_row = trow >= 31 ? ((trow - 31) >> 4) + 1 : 0;
    const int ncv_blk = (T0 + 31 >= 31) ? ((T0 + 31 - 31) >> 4) + 1 : 0;
    const int ncv_min = T0 >= 31 ? ((T0 - 31) >> 4) + 1 : 0;
    const int nct = (ncv_blk + 63) >> 6;
    const unsigned char* Kc = (const unsigned char*)(kcmp + (size_t)(b * 2 + g) * 512 * 64); const unsigned char* Vc = (const unsigned char*)(vcmpT + (size_t)(b * 2 + g) * 8 * 4096);
    float m = -1e30f, l = 0.f;
    f32x4 oc[4];
    float linv = 0.f;
    REPS(501) {
    m = -1e30f; l = 0.f;
#pragma unroll
    for (int dt = 0; dt < 4; ++dt) oc[dt] = (f32x4){0.f, 0.f, 0.f, 0.f};
    float mB = -1e30f, lB = 0.f;
    auto cmp1 = [&](int j, LAS const unsigned char* slot, float& mm, float& ll) {
        KFrag kf; ldk_lds(kf, slot, ko0, ko1);
        f32x4 s[4];
        if (64 * j + 63 < ncv_min) att_scores<false>(s, kf, qf, kg, [&](int) { return true; }); else att_scores<true>(s, kf, qf, kg, [&](int ko) { return j * 64 + ko < ncv_row; });
        const float mx = att_rowmax(s) * ATT_C2;
        const float mn = fmaxf(mm, mx); float ps0 = 0.f, ps1 = 0.f;
        _Pragma("unroll") for (int tl = 0; tl < 4; ++tl) { ps0 += __builtin_amdgcn_exp2f(__builtin_fmaf(s[tl][0], ATT_C2, -mn)) + __builtin_amdgcn_exp2f(__builtin_fmaf(s[tl][1], ATT_C2, -mn));
                                                          ps1 += __builtin_amdgcn_exp2f(__builtin_fmaf(s[tl][2], ATT_C2, -mn)) + __builtin_amdgcn_exp2f(__builtin_fmaf(s[tl][3], ATT_C2, -mn)); }
        ll = ll * __builtin_amdgcn_exp2f(mm - mn) + (ps0 + ps1); mm = mn; };
    nsa_stream2<1>(nct, dmaw, ring, [&](int j, LAS unsigned* dk) { GLDS16(Kc + (size_t)j * 8192 + ksrc, dk); }, [&](int j, LAS const unsigned char* sA, bool hasB, LAS const unsigned char* sB) {
        cmp1(j, sA, m, l); __builtin_amdgcn_sched_barrier(0); if (hasB) cmp1(j + 1, sB, mB, lB); });
    { const float mn = fmaxf(m, mB); l = l * __builtin_amdgcn_exp2f(m - mn) + lB * __builtin_amdgcn_exp2f(mB - mn); m = mn; }
    l = xsum4(l);
    linv = l > 0.f ? 1.f / l : 0.f;
    auto cmp2 = [&](int j, LAS const unsigned char* slot) {
        KFrag kf; ldk_lds(kf, slot, ko0, ko1); VFrag vf; ldv_lds(vf, slot, vo0, vo1);
        f32x4 s[4];
        if (64 * j + 63 < ncv_min) att_scores<false>(s, kf, qf, kg, [&](int) { return true; }); else att_scores<true>(s, kf, qf, kg, [&](int ko) { return j * 64 + ko < ncv_row; });
        _Pragma("unroll") for (int tl = 0; tl < 4; ++tl) {
            _Pragma("unroll") for (int r = 0; r < 4; ++r) s[tl][r] = __builtin_amdgcn_exp2f(__builtin_fmaf(s[tl][r], ATT_C2, -m)) * linv;
            float A = (s[tl][0] + s[tl][1]) + (s[tl][2] + s[tl][3]), L = s[tl][3];
            A += __shfl_xor(A, 4); A += __shfl_xor(A, 8); L += __shfl_xor(L, 4); L += __shfl_xor(L, 8);
            if (hh == 0) { const int u = j * 16 + 8 * (tl >> 1) + 2 * kg + (tl & 1); impA[tt * 128 + u] = A; impL[tt * 128 + u] = L; } }
        att_pv(oc, s, vf); };
    nsa_stream2<2>(nct, dmaw, ring, [&](int j, LAS unsigned* dk) { GLDS16(Kc + (size_t)j * 8192 + ksrc, dk); GLDS16(Vc + (size_t)j * 8192 + vsrc, (LAS unsigned*)((LAS unsigned char*)dk + 8192)); },
        [&](int j, LAS const unsigned char* sA, bool hasB, LAS const unsigned char* sB) { cmp2(j, sA); if (hasB) cmp2(j + 1, sB); });
    }
    const int cur = T0 >> 6;
    AttSt sw;
    REPS(504) {
    sw.m = -1e30f; sw.l = 0.f;
#pragma unroll
    for (int dt = 0; dt < 4; ++dt) sw.o[dt] = (f32x4){0.f, 0.f, 0.f, 0.f};
    {
        const unsigned char* Kw = (const unsigned char*)(kwR + (size_t)((b * 2 + g) * 128) * 4096); const unsigned char* Vw = (const unsigned char*)(vwT + (size_t)((b * 2 + g) * 128) * 4096);
        const int s0w = (T0 >= 511 ? (T0 - 511) >> 6 : 0);
        AttSt swB; swB.m = -1e30f; swB.l = 0.f;
#pragma unroll
        for (int dt = 0; dt < 4; ++dt) swB.o[dt] = (f32x4){0.f, 0.f, 0.f, 0.f};
        auto wsc = [&](f32x4 (&s)[4], int j, LAS const unsigned char* slot) { KFrag kf; ldk_lds(kf, slot, ko0, ko1); const int sx = s0w + j;
            if (sx > s0w + 1 && sx < cur) att_scores<false>(s, kf, qrf, kg, [&](int) { return true; });
            else att_scores<true>(s, kf, qrf, kg, [&](int ko) { const int kp = 64 * sx + ko; return kp <= trow && kp >= trow - 511; }); };
        nsa_stream2<2>(cur - s0w + 1, dmaw, ring, [&](int j, LAS unsigned* dk) { GLDS16(Kw + (size_t)(s0w + j) * 8192 + ksrc, dk); GLDS16(Vw + (size_t)(s0w + j) * 8192 + vsrc, (LAS unsigned*)((LAS unsigned char*)dk + 8192)); },
            [&](int j, LAS const unsigned char* sA, bool hasB, LAS const unsigned char* sB) {
                if (hasB) { f32x4 s0[4], s1[4]; wsc(s0, j, sA); wsc(s1, j + 1, sB); __builtin_amdgcn_sched_barrier(0);
                    { VFrag vf; ldv_lds(vf, sA, vo0, vo1); att_softmax_pv(sw, s0, vf, true); } { VFrag vf; ldv_lds(vf, sB, vo0, vo1); att_softmax_pv(swB, s1, vf, true); } }
                else { f32x4 s0[4]; wsc(s0, j, sA); VFrag vf; ldv_lds(vf, sA, vo0, vo1); att_softmax_pv(sw, s0, vf, true); } });
        att_merge(sw, swB);
    }
    }
    unsigned long long mylo, myhi, anylo, anyhi;
    if (cur <= 15) { mylo = anylo = (1ull << (cur + 1)) - 1ull; myhi = anyhi = 0ull; }
    else {
        mylo = myhi = anylo = anyhi = 0ull;
        const unsigned long long flo = 1ull | (cur < 64 ? (1ull << cur) : 0ull) | (cur - 1 < 64 ? (1ull << (cur - 1)) : 0ull);
        const unsigned long long fhi = (cur >= 64 ? (1ull << (cur - 64)) : 0ull) | (cur - 1 >= 64 ? (1ull << (cur - 65)) : 0ull);
        const unsigned long long lmask = (1ull << lane) - 1ull;
        for (int tk = 0; tk < 4; ++tk) {
            const int s0 = lane, s1 = lane + 64;
            const float v0 = impA[tk * 128 + s0] + (s0 > 0 ? impL[tk * 128 + s0 - 1] : 0.f), v1 = impA[tk * 128 + s1] + impL[tk * 128 + s1 - 1];
            const unsigned b0 = (s0 >= 1 && s0 <= cur - 2) ? __float_as_uint(v0) + 1u : 0u, b1 = (s1 <= cur - 2) ? __float_as_uint(v1) + 1u : 0u;
            unsigned Tq = 0u;
            for (int bit = 30; bit >= 0; --bit) { const unsigned T2 = Tq | (1u << bit);
                const int c = __popcll(__ballot(b0 >= T2)) + __popcll(__ballot(b1 >= T2)); if (c >= 13) Tq = T2; }
            const unsigned long long gtlo = __ballot(b0 > Tq), gthi = __ballot(b1 > Tq), eqlo = __ballot(b0 == Tq), eqhi = __ballot(b1 == Tq);
            const int need = 13 - (__popcll(gtlo) + __popcll(gthi));
            const bool t0q = (b0 == Tq) && (__popcll(eqlo & lmask) < need), t1q = (b1 == Tq) && (__popcll(eqlo) + __popcll(eqhi & lmask) < need);
            const unsigned long long lo = gtlo | __ballot(t0q) | flo, hi = gthi | __ballot(t1q) | fhi;
            anylo |= lo; anyhi |= hi; if (tt == tk) { mylo = lo; myhi = hi; }
        }
    }
    LAS unsigned long long* msk = (LAS unsigned long long*)(lds + NSA_MSK); LAS unsigned char* lst = lds + NSA_LIST; LAS int* nlst = (LAS int*)(lds + NSA_LIST + 128);
    if (lane == 0) { msk[2 * wv] = anylo; msk[2 * wv + 1] = anyhi; }
    NSA_BAR();
    if (wv == 0) {
        unsigned long long ulo = 0ull, uhi = 0ull;
#pragma unroll
        for (int w2 = 0; w2 < 8; ++w2) { ulo |= msk[2 * w2]; uhi |= msk[2 * w2 + 1]; }
        const unsigned long long lmask = (1ull << lane) - 1ull; const int nlo = __popcll(ulo);
        if ((ulo >> lane) & 1ull) lst[__popcll(ulo & lmask)] = (unsigned char)lane;
        if ((uhi >> lane) & 1ull) lst[nlo + __popcll(uhi & lmask)] = (unsigned char)(64 + lane);
        if (lane == 0) nlst[0] = nlo + __popcll(uhi);
    }
    NSA_BAR();
    const int nsel = nlst[0];
    AttSt ss;
    REPS(503) {
    ss.m = -1e30f; ss.l = 0.f;
#pragma unroll
    for (int dt = 0; dt < 4; ++dt) ss.o[dt] = (f32x4){0.f, 0.f, 0.f, 0.f};
    {
        const unsigned char* Ks = (const unsigned char*)(ksR + (size_t)((b * 2 + g) * 128) * 4096); const unsigned char* Vs = (const unsigned char*)(vsT + (size_t)((b * 2 + g) * 128) * 4096);
        auto sel1 = [&](int s, LAS const unsigned char* slot, AttSt& st) {
            KFrag kf; ldk_lds(kf, slot, ko0, ko1); VFrag vf; ldv_lds(vf, slot, vo0, vo1);
            const bool mybit = (((s < 64 ? mylo : myhi) >> (s & 63)) & 1ull) != 0ull;
            if (s < cur) att_tile<false>(st, kf, vf, qrf, kg, mybit, [&](int) { return true; });
            else att_tile<true>(st, kf, vf, qrf, kg, mybit, [&](int ko) { return 64 * s + ko <= trow; }); };
        nsa_stream2<2>(nsel, dmaw, ring, [&](int j, LAS unsigned* dk) { const int sj = lst[j]; GLDS16(Ks + (size_t)sj * 8192 + ksrc, dk); GLDS16(Vs + (size_t)sj * 8192 + vsrc, (LAS unsigned*)((LAS unsigned char*)dk + 8192)); },
            [&](int j, LAS const unsigned char* sA, bool hasB, LAS const unsigned char* sB) {
                const int s0 = lst[j]; const int s1 = hasB ? (int)lst[j + 1] : 0;
                const bool nA = (((s0 < 64 ? anylo : anyhi) >> (s0 & 63)) & 1ull) != 0ull, nB = hasB && ((((s1 < 64 ? anylo : anyhi) >> (s1 & 63)) & 1ull) != 0ull);
                if (nA) sel1(s0, sA, ss);
                if (nB) sel1(s1, sB, ss); });
    }
    }
    const float ls = xsum4(ss.l), lw = xsum4(sw.l);
    const float g0 = sigmf(gt0), g1 = sigmf(gt1) / ls, g2 = sigmf(gt2) / lw;
#pragma unroll
    for (int dt = 0; dt < 4; ++dt) { const f32x4 o = oc[dt] * g0 + ss.o[dt] * g1 + sw.o[dt] * g2;
        *(h16x4*)(mix + mrow * D + 512 + (g * 4 + hh) * 64 + 16 * dt + 4 * kg) = __builtin_convertvector(o, h16x4); }
#undef GLDS16
}

__device__ __forceinline__ void b_ln(const float* __restrict__ in, const float* __restrict__ gam, const float* __restrict__ bet, float* __restrict__ o32, h16* __restrict__ o16) {
    const int lane = tidx() & 63;
    for (int row = blockIdx.x * 8 + (tidx() >> 6); row < M; row += gridDim.x * 8) {
        const f32x4* xr = (const f32x4*)(in + (size_t)row * D) + lane;
        f32x4 v[4]; float s = 0.f;
#pragma unroll
        for (int j = 0; j < 4; ++j) { v[j] = xr[64 * j]; s += (v[j][0] + v[j][1]) + (v[j][2] + v[j][3]); }
        const float mean = wave_sum(s) * (1.f / D); float s2 = 0.f;
#pragma unroll
        for (int j = 0; j < 4; ++j) { v[j] = v[j] - mean; s2 += (v[j][0] * v[j][0] + v[j][1] * v[j][1]) + (v[j][2] * v[j][2] + v[j][3] * v[j][3]); }
        const float rstd = rsqrtf(wave_sum(s2) * (1.f / D) + LN_EPS);
#pragma unroll
        for (int j = 0; j < 4; ++j) { const f32x4 gg = ((const f32x4*)gam)[lane + 64 * j], bb = ((const f32x4*)bet)[lane + 64 * j]; const f32x4 o = v[j] * rstd * gg + bb;
            ((f32x4*)(o32 + (size_t)row * D))[lane + 64 * j] = o;
            if (o16) ((h16x4*)(o16 + (size_t)row * D))[lane + 64 * j] = __builtin_convertvector(o, h16x4); }
    }
}

__device__ __forceinline__ void xattn_block(const h16* __restrict__ qx, const h16* __restrict__ kx, const h16* __restrict__ kvmVT, h16* __restrict__ ox, int G, int bid, LAS unsigned char* lds, int wv, int lane) {
    const int i = lane & 15, kg = lane >> 4;
    const int gki = ((i >> 1) & 1) | ((i >> 2) << 1), gvi = (i >> 1) & 7;
    const int ko0 = (8 * (i >> 2) + (i & 3)) * 512 + ((kg ^ gki) << 4), ko1 = (8 * (i >> 2) + (i & 3)) * 512 + (((kg + 4) ^ gki) << 4);
    const int vo0 = i * 128 + ((kg ^ gvi) << 4), vo1 = i * 128 + (((kg + 4) ^ gvi) << 4);
    const int t = wv * 64 + lane;
    int ksrc[4], vsrc[4];
#pragma unroll
    for (int pz = 0; pz < 4; ++pz) { const int q = pz * 512 + t;
        { const int row = q >> 5, cp = q & 31; const int gk = ((row >> 1) & 1) | (((row >> 3) & 3) << 1); ksrc[pz] = row * 512 + ((cp ^ gk) << 4); }
        { const int row = q >> 3, cp = q & 7; vsrc[pz] = row * 512 + ((cp ^ ((row >> 1) & 7)) << 4); } }
    const int nun = ((M / 128) * 4 - bid + G - 1) / G;
    const int ntile = nun * 4;
    auto issue = [&](int tix, int slot) { const int u = bid + G * (tix >> 2), grp = tix & 3; const int m0 = (u >> 2) * 128, hh = u & 3, b = m0 >> 13;
        const unsigned char* Kb = (const unsigned char*)(kx + ((size_t)(b * 4 + hh) * MEML + 64 * grp) * 256); const unsigned char* Vb = (const unsigned char*)(kvmVT + (size_t)((b * 4 + hh) * 256) * MEML + 64 * grp);
        LAS unsigned char* base = lds + slot * 65536 + wv * 1024;
#pragma unroll
        for (int pz = 0; pz < 4; ++pz) { __builtin_amdgcn_global_load_lds((const unsigned*)(Kb + ksrc[pz]), (LAS unsigned*)(base + pz * 8192), 16, 0, 0);
                                        __builtin_amdgcn_global_load_lds((const unsigned*)(Vb + vsrc[pz]), (LAS unsigned*)(base + 32768 + pz * 8192), 16, 0, 0); } };
    NSA_WAITV(0);
    if (ntile > 0) issue(0, 0);
    h16x8 qf[8]; f32x4 o[16]; float mrun = -1e30f, l = 0.f; size_t mrow = 0; int hh = 0;
    for (int tix = 0; tix < ntile; ++tix) {
        const int grp = tix & 3, slot = tix & 1;
        if (grp == 0) {
            const int u = bid + G * (tix >> 2); mrow = (size_t)((u >> 2) * 128 + wv * 16 + i); hh = u & 3;
#pragma unroll
            for (int ks = 0; ks < 8; ++ks) qf[ks] = *(const h16x8*)(qx + mrow * D + hh * 256 + 32 * ks + 8 * kg);
#pragma unroll
            for (int dt = 0; dt < 16; ++dt) o[dt] = (f32x4){0.f, 0.f, 0.f, 0.f};
            mrun = -1e30f; l = 0.f;
        }
        NSA_WAITV(0);
        NSA_BAR();
        if (tix + 1 < ntile) issue(tix + 1, slot ^ 1);
        LAS const unsigned char* sk = lds + slot * 65536; LAS const unsigned char* sv = sk + 32768;
        f32x4 s[4];
#pragma unroll
        for (int tl = 0; tl < 4; ++tl) { const int ro = (32 * (tl >> 1) + 4 * (tl & 1)) * 512; f32x4 acc = {0.f, 0.f, 0.f, 0.f};
#pragma unroll
            for (int ks = 0; ks < 8; ++ks) acc = __builtin_amdgcn_mfma_f32_16x16x32_f16(*(LAS const h16x8*)(sk + ro + 128 * (ks >> 1) + ((ks & 1) ? ko1 : ko0)), qf[ks], acc, 0, 0, 0);
            s[tl] = acc; }
        const float mx = att_rowmax(s) * (0.0625f * 1.4426950408889634f);
        const float mn = fmaxf(mrun, mx); const float alpha = __builtin_amdgcn_exp2f(mrun - mn); mrun = mn;
        float ps = 0.f; h16x8 pf[2];
#pragma unroll
        for (int tl = 0; tl < 4; ++tl)
#pragma unroll
            for (int r = 0; r < 4; ++r) { const float pe = __builtin_amdgcn_exp2f(__builtin_fmaf(s[tl][r], 0.0625f * 1.4426950408889634f, -mn)); ps += pe; pf[tl >> 1][4 * (tl & 1) + r] = (h16)pe; }
        l = l * alpha + ps;
#pragma unroll
        for (int dt = 0; dt < 16; ++dt) { f32x4 acc = o[dt] * alpha;
            acc = __builtin_amdgcn_mfma_f32_16x16x32_f16(*(LAS const h16x8*)(sv + dt * 2048 + vo0), pf[0], acc, 0, 0, 0);
            acc = __builtin_amdgcn_mfma_f32_16x16x32_f16(*(LAS const h16x8*)(sv + dt * 2048 + vo1), pf[1], acc, 0, 0, 0);
            o[dt] = acc; }
        if (grp == 3) { const float linv = 1.f / xsum4(l);
#pragma unroll
            for (int dt = 0; dt < 16; ++dt) { const f32x4 acc = o[dt] * linv; *(h16x4*)(ox + mrow * D + hh * 256 + 16 * dt + 4 * kg) = __builtin_convertvector(acc, h16x4); } }
    }
    NSA_WAITV(0);
    NSA_BAR();
}

__device__ __forceinline__ void route_token(float logit, int m, int lane, const float* __restrict__ rbias, int* __restrict__ tope, float* __restrict__ topw, int* __restrict__ hist) {
    const float score = 1.f / (1.f + expf(-logit)); const float biased = score + rbias[lane];
    float m1 = biased; m1 = fmaxf(m1, __shfl_xor(m1, 1)); m1 = fmaxf(m1, __shfl_xor(m1, 2)); m1 = fmaxf(m1, __shfl_xor(m1, 4));
    int am = (biased == m1) ? lane : 999; am = min(am, __shfl_xor(am, 1)); am = min(am, __shfl_xor(am, 2)); am = min(am, __shfl_xor(am, 4));
    float m2 = (lane == am) ? -INFINITY : biased; m2 = fmaxf(m2, __shfl_xor(m2, 1)); m2 = fmaxf(m2, __shfl_xor(m2, 2)); m2 = fmaxf(m2, __shfl_xor(m2, 4));
    const float gs = m1 + m2;
    int cnt = 0;
#pragma unroll
    for (int gq = 0; gq < 8; ++gq) { const float o = __shfl(gs, gq * 8); cnt += (o > gs) ? 1 : 0; }
    const float masked = (cnt <= 3) ? biased : NEGF;
    int rank = 0;
    for (int e2 = 0; e2 < 64; ++e2) { const float o = __shfl(masked, e2); rank += (o > masked || (o == masked && e2 < lane)) ? 1 : 0; }
    const bool selq = rank < 8;
    const float wsum = wave_sum(selq ? score : 0.f);
    if (selq) { tope[(size_t)m * 8 + rank] = lane; topw[(size_t)m * 8 + rank] = score / wsum * 2.5f; atomicAdd(hist + (m >> 13) * 65 + lane, 1); }
}
__device__ __forceinline__ void router_unit(const Params& p, const float* __restrict__ pre, h16* __restrict__ x2h, const h16* __restrict__ WrTh, const h16* __restrict__ WrTl, int* __restrict__ tope, float* __restrict__ topw,
                                            int* __restrict__ hist, int m0, LAS float* lg, int lane) {
    const int i = lane & 15, kg = lane >> 4;
    const float* xr = pre + (size_t)(m0 + i) * D + 8 * kg;
    float s1 = 0.f, s2 = 0.f;
#pragma unroll 4
    for (int ks = 0; ks < 32; ++ks) { const f32x4 x0 = *(const f32x4*)(xr + 32 * ks), x1 = *(const f32x4*)(xr + 32 * ks + 4);
        s1 += (x0[0] + x0[1]) + (x0[2] + x0[3]) + (x1[0] + x1[1]) + (x1[2] + x1[3]);
        s2 += (x0[0] * x0[0] + x0[1] * x0[1]) + (x0[2] * x0[2] + x0[3] * x0[3]) + (x1[0] * x1[0] + x1[1] * x1[1]) + (x1[2] * x1[2] + x1[3] * x1[3]); }
    s1 = xsum4(s1); s2 = xsum4(s2);
    const float mean = s1 * (1.f / D); const float rstd = rsqrtf(fmaxf(s2 * (1.f / D) - mean * mean, 0.f) + LN_EPS);
    f32x4 am_[4], ac_[4];
#pragma unroll
    for (int et = 0; et < 4; ++et) { am_[et] = (f32x4){0.f, 0.f, 0.f, 0.f}; ac_[et] = (f32x4){0.f, 0.f, 0.f, 0.f}; }
    h16* xo = x2h + (size_t)(m0 + i) * D + 8 * kg;
#pragma unroll 2
    for (int ks = 0; ks < 32; ++ks) {
        f32x4 x0 = *(const f32x4*)(xr + 32 * ks), x1 = *(const f32x4*)(xr + 32 * ks + 4);
        const f32x4 g0 = *(const f32x4*)(p.ln2g + 32 * ks + 8 * kg), g1 = *(const f32x4*)(p.ln2g + 32 * ks + 8 * kg + 4), b0 = *(const f32x4*)(p.ln2b + 32 * ks + 8 * kg), b1 = *(const f32x4*)(p.ln2b + 32 * ks + 8 * kg + 4);
        x0 = (x0 - mean) * rstd * g0 + b0; x1 = (x1 - mean) * rstd * g1 + b1;
        h16x8 xh, xl;
#pragma unroll
        for (int j = 0; j < 4; ++j) { xh[j] = (h16)x0[j]; xl[j] = (h16)((x0[j] - (float)xh[j]) * 2048.f); xh[4 + j] = (h16)x1[j]; xl[4 + j] = (h16)((x1[j] - (float)xh[4 + j]) * 2048.f); }
        *(h16x8*)(xo + 32 * ks) = xh;
#pragma unroll
        for (int et = 0; et < 4; ++et) { const h16x8 wh = *(const h16x8*)(WrTh + (size_t)(16 * et + i) * D + 32 * ks + 8 * kg), wl = *(const h16x8*)(WrTl + (size_t)(16 * et + i) * D + 32 * ks + 8 * kg);
            am_[et] = __builtin_amdgcn_mfma_f32_16x16x32_f16(wh, xh, am_[et], 0, 0, 0);
            ac_[et] = __builtin_amdgcn_mfma_f32_16x16x32_f16(wh, xl, ac_[et], 0, 0, 0);
            ac_[et] = __builtin_amdgcn_mfma_f32_16x16x32_f16(wl, xh, ac_[et], 0, 0, 0); }
    }
#pragma unroll
    for (int et = 0; et < 4; ++et)
#pragma unroll
        for (int r = 0; r < 4; ++r) lg[i * 64 + 16 * et + 4 * kg + r] = am_[et][r] + ac_[et][r] * (1.f / 2048.f);
    for (int tk = 0; tk < 16; ++tk) route_token(lg[tk * 64 + lane], m0 + tk, lane, p.rbias, tope, topw, hist);
}

__device__ __forceinline__ void b_moe(const Params& p, const float* __restrict__ x2, const int* __restrict__ tope, const float* __restrict__ topw, float* __restrict__ out, int m, float* sl, int tid) {
    float* xs = sl; float* hd = sl + 1024; float* red = sl + 1280;
    for (int i = tid; i < 1024; i += 256) xs[i] = x2[(size_t)m * D + i];
    __syncthreads();
    float acc[4] = {0.f, 0.f, 0.f, 0.f};
    for (int kx = 0; kx < 9; ++kx) {
        const float* G; const float* U; const float* Dn; float wt;
        if (kx < 8) { const int e = tope[(size_t)m * 8 + kx]; wt = topw[(size_t)m * 8 + kx]; G = p.w_gate + (size_t)e * D * EFF; U = p.w_up + (size_t)e * D * EFF; Dn = p.w_down + (size_t)e * EFF * D; }
        else { wt = 1.f; G = p.ws_gate; U = p.ws_up; Dn = p.ws_down; }
        float a = 0.f, u = 0.f;
        for (int k = 0; k < D; ++k) { const float xv = xs[k]; a += xv * G[(size_t)k * EFF + tid]; u += xv * U[(size_t)k * EFF + tid]; }
        hd[tid] = siluf(a) * u * wt;
        __syncthreads();
        for (int j = 0; j < EFF; ++j) { const float hv = hd[j]; const float* dr = Dn + (size_t)j * D + tid;
            acc[0] += hv * dr[0]; acc[1] += hv * dr[256]; acc[2] += hv * dr[512]; acc[3] += hv * dr[768]; }
        __syncthreads();
    }
    float v[4]; float s = 0.f;
#pragma unroll
    for (int i = 0; i < 4; ++i) { v[i] = DN_ALPHA * xs[tid + 256 * i] + acc[i]; s += v[i]; }
    s = wave_sum(s); if ((tid & 63) == 0) red[tid >> 6] = s; __syncthreads();
    const float mean = (red[0] + red[1] + red[2] + red[3]) * (1.f / D); float s2 = 0.f;
#pragma unroll
    for (int i = 0; i < 4; ++i) { v[i] -= mean; s2 += v[i] * v[i]; }
    s2 = wave_sum(s2); if ((tid & 63) == 0) red[4 + (tid >> 6)] = s2; __syncthreads();
    const float rstd = rsqrtf((red[4] + red[5] + red[6] + red[7]) * (1.f / D) + LN_EPS);
#pragma unroll
    for (int i = 0; i < 4; ++i) out[(size_t)m * D + tid + 256 * i] = v[i] * rstd * p.ln3g[tid + 256 * i] + p.ln3b[tid + 256 * i];
    __syncthreads();
}

struct G1Sched {
    const int* ctl; const char* x2h; const unsigned* rowoff; const char* WguT; int G, c;
    __device__ bool next(int i, pg8::Unit& u) const {
        const int ntile = ctl[CTL_TQS + NQ]; const long L = (long)i * G + c; if (L >= 2L * ntile) return false;
        const int tile = (int)(L >> 1), pn = (int)(L & 1); const int e = ctl[CTL_TVE + tile] % 65;
        u.pm = tile; u.pn = pn; u.A = x2h; u.gat = rowoff + (size_t)tile * 256; u.B = WguT + ((size_t)e * 512 + pn * 256) * (D * 2); return true; }
};
struct G2Sched {
    const int* ctl; const char* H; const char* WdT; int q, G, c;
    __device__ bool next(int i, pg8::Unit& u) const {
        const int t0 = ctl[CTL_TQS + q], t1 = ctl[CTL_TQS + q + 1]; const long L = (long)i * G + c; if (L >= 4L * (t1 - t0)) return false;
        const int tile = t0 + (int)(L >> 2), pn = (int)(L & 3); const int e = ctl[CTL_TVE + tile] % 65;
        u.pm = tile; u.pn = pn; u.A = H + (size_t)tile * 256 * (EFF * 2); u.gat = nullptr; u.B = WdT + ((size_t)e * D + pn * 256) * (EFF * 2); return true; }
};
__device__ __forceinline__ void b_scatter(int* __restrict__ ctl, const int* __restrict__ tope, const float* __restrict__ topw, unsigned* __restrict__ rowoff, u32x2* __restrict__ rowmeta, int* sl) {
    int* pst = sl;
    int* pc = sl + 512;
    for (int v = tidx(); v < NVE; v += NTHR) pc[v] = (ctl[CTL_CNT + v] + 255) & ~255;
    __syncthreads();
    for (int v = tidx(); v <= NVE; v += NTHR) { int acc = 0; for (int u = 0; u < v; ++u) acc += pc[u]; pst[v] = acc; }
    __syncthreads();
    if (blockIdx.x == 0) {
        for (int v = tidx(); v <= NVE; v += NTHR) ctl[CTL_PST + v] = pst[v];
        if (tidx() <= NQ) ctl[CTL_TQS + tidx()] = pst[tidx() * 65] >> 8;
        for (int v = tidx(); v < NVE; v += NTHR) for (int tl = pst[v] >> 8; tl < (pst[v + 1] >> 8); ++tl) ctl[CTL_TVE + tl] = v;
    }
    for (int idx = blockIdx.x * NTHR + tidx(); idx < M * 9; idx += gridDim.x * NTHR) {
        int m, k, pos; float w;
        if (idx < M * 8) { m = idx >> 3; k = idx & 7; const int ve = (m >> 13) * 65 + tope[idx]; w = topw[idx]; pos = pst[ve] + atomicAdd(ctl + CTL_CUR + ve, 1); }
        else { m = idx - M * 8; k = 8; w = 1.f; pos = pst[(m >> 13) * 65 + 64] + (m & (QT - 1)); }
        rowoff[pos] = (unsigned)m * (D * 2); rowmeta[pos] = (u32x2){(unsigned)((m & (QT - 1)) * 9 + k), __float_as_uint(w)};
    }
    __syncthreads();
}
__device__ __forceinline__ void b_combine(const Params& p, const h16* __restrict__ x2h, const h16* __restrict__ Y, int q) {
    const int lane = tidx() & 63;
    for (int r = blockIdx.x * 8 + (tidx() >> 6); r < QT; r += gridDim.x * 8) {
        const int m = q * QT + r;
        float v[16];
        { const h16x8 a = ((const h16x8*)(x2h + (size_t)m * D))[lane], b = ((const h16x8*)(x2h + (size_t)m * D))[lane + 64];
#pragma unroll
          for (int i = 0; i < 8; ++i) { v[i] = DN_ALPHA * (float)a[i]; v[8 + i] = DN_ALPHA * (float)b[i]; } }
#pragma unroll
        for (int k = 0; k < 9; ++k) { const h16x8* yr = (const h16x8*)(Y + ((size_t)r * 9 + k) * D); const h16x8 a = yr[lane], b = yr[lane + 64];
#pragma unroll
            for (int i = 0; i < 8; ++i) { v[i] += (float)a[i]; v[8 + i] += (float)b[i]; } }
        float s = 0.f;
#pragma unroll
        for (int i = 0; i < 16; ++i) s += v[i];
        const float mean = wave_sum(s) * (1.f / D); float s2 = 0.f;
#pragma unroll
        for (int i = 0; i < 16; ++i) { v[i] -= mean; s2 += v[i] * v[i]; }
        const float rstd = rsqrtf(wave_sum(s2) * (1.f / D) + LN_EPS);
#pragma unroll
        for (int hlf = 0; hlf < 2; ++hlf) { const int c0 = (lane + 64 * hlf) * 8;
            const f32x4 g0 = *(const f32x4*)(p.ln3g + c0), g1 = *(const f32x4*)(p.ln3g + c0 + 4), b0 = *(const f32x4*)(p.ln3b + c0), b1 = *(const f32x4*)(p.ln3b + c0 + 4);
            f32x4 o0, o1;
#pragma unroll
            for (int i = 0; i < 4; ++i) { o0[i] = v[8 * hlf + i] * rstd * g0[i] + b0[i]; o1[i] = v[8 * hlf + 4 + i] * rstd * g1[i] + b1[i]; }
            *(f32x4*)(p.out + (size_t)m * D + c0) = o0; *(f32x4*)(p.out + (size_t)m * D + c0 + 4) = o1; }
    }
}

#define XB_TMO      128
#define XB_XCNT(j)  (256  + 64 * (j))
#define XB_XSUB(j)  (1280 + 64 * (j))
#define XB_XGEN(j)  (2304 + 64 * (j))
#define XB_TOP      3328
#define XB_TOPGEN   3392
#define XCD_BAR_WORDS 3456
#define XB_SPIN_CAP (1u << 22)
__device__ __forceinline__ unsigned xb_ld(unsigned* p)              { return __hip_atomic_load(p, __ATOMIC_RELAXED, __HIP_MEMORY_SCOPE_AGENT); }
__device__ __forceinline__ unsigned xb_add(unsigned* p, unsigned v) { return __hip_atomic_fetch_add(p, v, __ATOMIC_RELAXED, __HIP_MEMORY_SCOPE_AGENT); }
__device__ __forceinline__ unsigned xb_xcc_id() { return (unsigned)__builtin_amdgcn_s_getreg((3 << 11) | 20) & 0xFu; }
#define XB_SPIN(cond, bar) do { unsigned _sp = 0; while (cond) { __builtin_amdgcn_s_sleep(1); \
    if ((++_sp & 255u) == 0u) { if (xb_ld(&(bar)[XB_TMO])) break; if (_sp > XB_SPIN_CAP) { atomicAdd(&(bar)[XB_TMO], 1u); break; } } } } while (0)
struct XcdBarrier { unsigned* bar; unsigned x; volatile LAS unsigned* st; };
__device__ __forceinline__ XcdBarrier xcd_barrier_post(unsigned* bar, volatile LAS unsigned* st) {
    XcdBarrier b; b.bar = bar; b.x = xb_xcc_id(); b.st = st;
    if (threadIdx.x == 0) (void)xb_add(&bar[XB_XCNT(b.x)], 1u);
    return b;
}
__device__ __forceinline__ void xcd_barrier_complete(unsigned* bar, unsigned x, unsigned& nloc, unsigned& nx) {
    const unsigned G = gridDim.x * gridDim.y * gridDim.z;
    unsigned sum, cnt, mine, sp = 0u;
    for (;;) {
        sum = 0u; cnt = 0u; mine = 0u;
#pragma unroll
        for (unsigned j = 0; j < 16; ++j) { const unsigned c = xb_ld(&bar[XB_XCNT(j)]); sum += c; cnt += (c > 0u) ? 1u : 0u; mine = (j == x) ? c : mine; }
        if (sum == G) break;
        __builtin_amdgcn_s_sleep(1);
        if ((++sp & 255u) == 0u) { if (xb_ld(&bar[XB_TMO])) break; if (sp > XB_SPIN_CAP) { atomicAdd(&bar[XB_TMO], 1u); break; } }
    }
    nloc = mine > 0u ? mine : 1u; nx = cnt > 0u ? cnt : 1u;
}
__device__ __forceinline__ void xcd_barrier(const XcdBarrier& b) {
    asm volatile("s_waitcnt vmcnt(0)" ::: "memory");
    __syncthreads();
    if (threadIdx.x == 0) {
        unsigned* bar = b.bar;
        __builtin_amdgcn_s_waitcnt(0);
        unsigned nloc = b.st[0], nx = b.st[1];
        if (nloc == 0u) { xcd_barrier_complete(bar, b.x, nloc, nx); b.st[0] = nloc; b.st[1] = nx; }
        const unsigned old = xb_add(&bar[XB_XSUB(b.x)], 1u);
        const unsigned gen = old / nloc;
        if (old + 1u == (gen + 1u) * nloc) {
            __builtin_amdgcn_fence(__ATOMIC_RELEASE, "agent");
            asm volatile("s_waitcnt vmcnt(0)" ::: "memory");
            const unsigned og = xb_add(&bar[XB_TOP], 1u);
            const unsigned tg = og / nx;
            if (og + 1u == (tg + 1u) * nx) xb_add(&bar[XB_TOPGEN], 1u);
            else XB_SPIN(xb_ld(&bar[XB_TOPGEN]) == tg, bar);
            __builtin_amdgcn_fence(__ATOMIC_ACQUIRE, "agent");
            xb_add(&bar[XB_XGEN(b.x)], 1u);
            asm volatile("s_waitcnt vmcnt(0)" ::: "memory");
        } else {
            XB_SPIN(xb_ld(&bar[XB_XGEN(b.x)]) == gen, bar);
            __builtin_amdgcn_fence(__ATOMIC_ACQUIRE, "agent");
            asm volatile("s_waitcnt vmcnt(0)" ::: "memory");
        }
    }
    __syncthreads();
}

constexpr int N_PHASES = 23;

__global__ void __launch_bounds__(NTHR, 2) mega_fwd(Params p) {
    extern __shared__ __attribute__((aligned(16))) unsigned char lds[];
    cg::grid_group grid = cg::this_grid();
    const int G = (int)gridDim.x, bid = (int)blockIdx.x;
#define tid tidx()
    unsigned char* ws = p.ws;
    h16* WinT = (h16*)(ws + WS_WIN); h16* WoutT = (h16*)(ws + WS_WOUT); h16* WxqT = (h16*)(ws + WS_WXQ); h16* WxoT = (h16*)(ws + WS_WXO); h16* WxkvT = (h16*)(ws + WS_WXKV);
    h16* memh = (h16*)(ws + WS_MEMH); h16* kvm = (h16*)(ws + WS_KVM); h16* kcmp = (h16*)(ws + WS_KCMP); h16* vcmpT = (h16*)(ws + WS_VCMP); h16* vsT = (h16*)(ws + WS_VST); h16* vwT = (h16*)(ws + WS_VWT);
    int* tope = (int*)(ws + WS_TOPE); float* topw = (float*)(ws + WS_TOPW);
    h16* xh = (h16*)(ws + WS_XH); h16* mix = (h16*)(ws + WS_MIX); h16* ox = (h16*)(ws + WS_OX); h16* hb = (h16*)(ws + WS_H); h16* nqr = (h16*)(ws + WS_NQR);
    float* kvb = (float*)(ws + WS_KVB); h16* prevT = (h16*)(ws + WS_PREVT);
    float* cosr = (float*)(ws + WS_COSR); float* sinr = (float*)(ws + WS_SINR); float* cosn = (float*)(ws + WS_COSN); float* sinn = (float*)(ws + WS_SINN); h16* kvmVT = (h16*)(ws + WS_KVMVT); h16* WrTh = (h16*)(ws + WS_WRTH); h16* WrTl = (h16*)(ws + WS_WRTL); h16* Wc1T = (h16*)(ws + WS_WC1T); h16* hid = (h16*)(ws + WS_HID); unsigned* cmpoff = (unsigned*)(ws + WS_CMPOFF); float* peb = (float*)(ws + WS_PEB); h16* ksR = (h16*)(ws + WS_KSR); h16* kwR = (h16*)(ws + WS_KWR); h16* kx = (h16*)(ws + WS_KX);
    h16* rqr = (h16*)((unsigned char*)p.out + DO_RQR); h16* rkr = (h16*)((unsigned char*)p.out + DO_RKR); h16* rkzT = (h16*)((unsigned char*)p.out + DO_RKZT); h16* rvT = (h16*)((unsigned char*)p.out + DO_RVT); float* pre = p.out; float* x1 = (float*)(ws + WS_X1); h16* x1h = (h16*)(ws + WS_X1H);
    h16* qx = (h16*)(ws + WS_QX); float* x2 = (float*)(ws + WS_X2); h16* x2h = (h16*)(ws + WS_X2H);
    int* ctl = (int*)ws; unsigned* rowoff = (unsigned*)(ws + WS_ROWOFF); u32x2* rowmeta = (u32x2*)(ws + WS_ROWMETA);
    h16* WguT = (h16*)(ws + WS_WGUT); h16* WdT = (h16*)(ws + WS_WDT); h16* Hm = (h16*)(ws + WS_HM); h16* Yq = (h16*)(ws + WS_Y);
    float* fl = (float*)lds;
    const int lo = p.ph_lo, hi = p.ph_hi;
#define IN(k) (lo <= (k) && (k) < hi)
    { volatile LAS unsigned* st = (volatile LAS unsigned*)((LAS unsigned char*)lds + 131072); if (threadIdx.x < 2) st[threadIdx.x] = 0u; }
    __syncthreads();
    XcdBarrier xbar = xcd_barrier_post((unsigned*)(ws + WS_BAR), (volatile LAS unsigned*)((LAS unsigned char*)lds + 131072));
#define SEAM(k) do { if (IN(k) && IN((k) + 1)) { if ((k) == 0) grid.sync(); else xcd_barrier(xbar); } } while (0)

    if (IN(0)) REPS(0) {
        { const int sub = tid >> 8, lt = tid & 255; float* tl = fl + sub * 1088;
          constexpr int T0 = (INP / 32) * (D / 32);
          for (int b0 = bid * 2; b0 < T0; b0 += G * 2) b_transpose_tile(p.w_in, D, INC, WinT, INP, b0 + sub, tl, lt); }
        { const int wv = __builtin_amdgcn_readfirstlane(tid >> 6), lane = tid & 63; LAS float* scr = (LAS float*)((LAS unsigned char*)lds + wv * 8704);
          constexpr int I1 = (D / 64) * (D / 32), I4 = (D / 64) * (2 * D / 32), I5 = (2048 / 64) * (256 / 32), IT = 3 * I1 + I4 + 2 * I5;
          for (int it0 = bid * 8 + wv; it0 < IT; it0 += G * 8) { int it = it0;
            if (it < I1) { w_transpose_item(p.w_out, D, D, WoutT, it, scr, lane); continue; } it -= I1;
            if (it < I1) { w_transpose_item(p.w_xq, D, D, WxqT, it, scr, lane); continue; } it -= I1;
            if (it < I1) { w_transpose_item(p.w_xo, D, D, WxoT, it, scr, lane); continue; } it -= I1;
            if (it < I4) { w_transpose_item(p.w_xkv, D, 2 * D, WxkvT, it, scr, lane); continue; } it -= I4;
            if (it < I5) { w_transpose_item(p.w1k, 2048, 256, Wc1T, it, scr, lane); continue; } it -= I5;
            w_transpose_item(p.w1v, 2048, 256, Wc1T + 256 * 2048, it, scr, lane); } }
        __syncthreads();
        b_cvt(p.x, xh, (size_t)M * D / 4);
        b_cvt(p.mem, memh, (size_t)NB * MEML * D / 4);
        if (bid == 0) for (int i = tid; i < 1024; i += NTHR) ctl[i] = 0;
        b_tables(p.positions, cosr, sinr, cosn, sinn);
        for (int idx = bid * NTHR + tid; idx < NE * D; idx += G * NTHR) { const int e = idx >> 10, k = idx & 1023; const float w = p.w_router[k * NE + e]; const h16 hi = (h16)w; WrTh[idx] = hi; WrTl[idx] = (h16)((w - (float)hi) * 2048.f); }
        for (int r = bid * NTHR + tid; r < 4096; r += G * NTHR) { const int g = r & 1, c = min((r >> 1) & 511, 510), b = r >> 10; cmpoff[r] = (unsigned)(((size_t)(b * T + 16 * c) * INP + g * 64) * 2); }
        { const int lane = tid & 63;
          for (int o = bid * 8 + (tid >> 6); o < 512; o += G * 8) { const int kv = o >> 8, j = o & 255; const float* pe = kv ? p.pe_v : p.pe_k; const float* w1 = kv ? p.w1v : p.w1k; float a = 0.f;
              for (int k = lane; k < 2048; k += 64) a += pe[k] * w1[(size_t)k * 256 + j];
              a = wave_sum(a); if (lane == 0) peb[o] = a; } }
    }
    SEAM(0);
    if (IN(1)) {
        REPS(1) { pg8::Gemm g{xh, WinT, M, INP, D}; pg8::StaticOrder S; S.init(g, G, bid); pg8::EpiF16 E{hb, INP};
          pg8::gemm_phase<pg8::EpiF16, pg8::StaticOrder>((PG8_LAS unsigned char*)lds, g.K, S, E); }
    }
    SEAM(1);
    if (IN(2)) REPS(2) {
        if (bid < 32) { CmpSched S{(const char*)hb, cmpoff, (const char*)Wc1T, bid}; pg8::EpiCmp1 E{hid, peb + (bid >> 4) * 256};
            pg8::gemm_phase<pg8::EpiCmp1, CmpSched>((PG8_LAS unsigned char*)lds, 2048, S, E, (size_t)INP * 2);
            pg8::Gemm g{memh, WxkvT, NB * MEML, 2 * D, D}; pg8::StaticOrder S2; S2.init(g, 32, bid); pg8::EpiF16 E2{kvm, 2 * D};
            pg8::gemm_phase<pg8::EpiF16, pg8::StaticOrder>((PG8_LAS unsigned char*)lds, g.K, S2, E2); }
        else { const int sub = tid >> 8, lt = tid & 255; const int b2 = bid - 32, G2 = G - 32;
        for (int b0 = b2 * 8; b0 < M; b0 += G2 * 8) {
#pragma unroll
            for (int r4 = 0; r4 < 4; ++r4) b_rope(hb, rqr, rkr, nqr, ksR, kwR, cosr, sinr, cosn, sinn, b0 + sub * 4 + r4, lt); }
        for (int b0 = b2 * 2; b0 < 2 * NB * 2 * 128; b0 += G2 * 2) b_vtrans(hb, vsT, vwT, b0 + sub, (h16*)(fl + sub * 2304), lt);
        for (int b0 = b2 * 2; b0 < NB * 4 * 128; b0 += G2 * 2) b_rtrans(p, hb, rvT, rkzT, cosr, sinr, b0 + sub, (h16*)(fl + sub * 4224), lt);
        } }
    SEAM(2);
    if (IN(3)) {
        REPS(30) b_cmp2(p, hid, kcmp, vcmpT);
        { const int sub = tid >> 8, lt = tid & 255;
          for (int b0 = bid * 2; b0 < NB * 4 * 16; b0 += G * 2) b_mvtrans(kvm, kvmVT, kx, b0 + sub, (h16*)(fl + sub * 2304), lt); }
        const int wv = __builtin_amdgcn_readfirstlane(tid >> 6), lane = tid & 63;
        REPS(31) for (int ch = bid; ch < NB * 4 * 64; ch += G) ret_kv_unit(rkzT, rvT, kvb, ch, wv, lane); }
    SEAM(3);
    if (IN(4)) {
        REPS(4) b_ret_scan(p, kvb, prevT);
        const int wv = __builtin_amdgcn_readfirstlane(tid >> 6), lane = tid & 63;
        __syncthreads();
        REPS(50) { const int bg = bid & 7;
            for (int k = bid >> 3; k < T / 32; k += (G >> 3)) nsa_block_unit(hb, nqr, kcmp, vcmpT, vsT, vwT, ksR, kwR, mix, bg >> 1, bg & 1, (T / 32 - 1 - k) * 32, (LAS unsigned char*)lds, wv, lane); }
    }
    SEAM(4);
    if (IN(5)) {
        const int wv = __builtin_amdgcn_readfirstlane(tid >> 6), lane = tid & 63;
        REPS(51) for (int ch = bid; ch < NB * 4 * 64; ch += G) ret_out_unit(p, hb, rqr, rkr, rvT, prevT, mix, ch, wv, lane);
    }
    SEAM(5);
    if (IN(6)) { pg8::Gemm g{mix, WoutT, M, D, D}; pg8::StaticOrder S; S.init(g, G, bid); pg8::EpiResF32 E{pre, p.x, D, DN_ALPHA};
        pg8::gemm_phase<pg8::EpiResF32, pg8::StaticOrder>((PG8_LAS unsigned char*)lds, g.K, S, E); }
    SEAM(6);
    if (PROBE_DBL == 900) { for (int k = 0; k < 20; ++k) xcd_barrier(xbar); }
    if (IN(7)) REPS(7) b_ln(pre, p.ln1g, p.ln1b, x1, x1h);
    SEAM(7);
    if (IN(8)) { pg8::Gemm g{x1h, WxqT, M, D, D}; pg8::StaticOrder S; S.init(g, G, bid); pg8::EpiF16 E{qx, D};
        pg8::gemm_phase<pg8::EpiF16, pg8::StaticOrder>((PG8_LAS unsigned char*)lds, g.K, S, E); }
    SEAM(8);
    if (IN(9)) { const int wv = __builtin_amdgcn_readfirstlane(tid >> 6), lane = tid & 63;
        REPS(9) xattn_block(qx, kx, kvmVT, ox, G, bid, (LAS unsigned char*)lds, wv, lane); }
    SEAM(9);
    if (IN(10)) { pg8::Gemm g{ox, WxoT, M, D, D}; pg8::StaticOrder S; S.init(g, G, bid); pg8::EpiResF32 E{pre, x1, D, DN_ALPHA};
        pg8::gemm_phase<pg8::EpiResF32, pg8::StaticOrder>((PG8_LAS unsigned char*)lds, g.K, S, E); }
    if (IN(10) && IN(12)) xcd_barrier(xbar);
    if (IN(12)) {
        { const int wv = __builtin_amdgcn_readfirstlane(tid >> 6), lane = tid & 63; LAS float* lg = (LAS float*)((LAS unsigned char*)lds + wv * 4096);
          for (int u = bid * 8 + wv; u < M / 16; u += G * 8) router_unit(p, pre, x2h, WrTh, WrTl, tope, topw, ctl + CTL_CNT, u * 16, lg, lane); }
        __syncthreads();
        if (bid == 0 && tid < NQ) ctl[CTL_CNT + tid * 65 + 64] = QT;
        for (int i = bid * NTHR + tid; i < CAP; i += G * NTHR) { rowoff[i] = 0u; rowmeta[i] = (u32x2){0xffffffffu, 0u}; }
        { const int wv = __builtin_amdgcn_readfirstlane(tid >> 6), lane = tid & 63; LAS float* scr = (LAS float*)((LAS unsigned char*)lds + wv * 8704);
          REPS(121) for (int it = bid * 8 + wv; it < 65 * 384; it += G * 8) { const int e = it / 384, r = it % 384;
            const float* wg = e < 64 ? p.w_gate + (size_t)e * D * EFF : p.ws_gate; const float* wu = e < 64 ? p.w_up + (size_t)e * D * EFF : p.ws_up; const float* wd = e < 64 ? p.w_down + (size_t)e * EFF * D : p.ws_down;
            if (r < 128) w_transpose_item(wg, D, EFF, WguT + (size_t)e * 512 * D, r, scr, lane, 2, 0);
            else if (r < 256) w_transpose_item(wu, D, EFF, WguT + (size_t)e * 512 * D, r - 128, scr, lane, 2, 1);
            else w_transpose_item(wd, EFF, D, WdT + (size_t)e * D * EFF, r - 256, scr, lane); } }
    }
    SEAM(12);
    if (IN(13)) b_scatter(ctl, tope, topw, rowoff, rowmeta, (int*)lds);
    SEAM(13);
    if (IN(14)) REPS(14) { G1Sched S{ctl, (const char*)x2h, rowoff, (const char*)WguT, G, bid}; pg8::EpiGateUp E{Hm};
        pg8::gemm_phase<pg8::EpiGateUp, G1Sched>((PG8_LAS unsigned char*)lds, D, S, E); }
    SEAM(14);
#pragma unroll 1
    for (int q = 0; q < NQ; ++q) {
        if (IN(15 + 2 * q)) REPS(15) { G2Sched S{ctl, (const char*)Hm, (const char*)WdT, q, G, bid}; pg8::EpiDown E{Yq, rowmeta};
            pg8::gemm_phase<pg8::EpiDown, G2Sched>((PG8_LAS unsigned char*)lds, EFF, S, E); }
        SEAM(15 + 2 * q);
        if (IN(16 + 2 * q)) REPS(16) b_combine(p, x2h, Yq, q);
        if (q < NQ - 1) SEAM(16 + 2 * q);
    }
#undef IN
#undef SEAM
#undef tid
}

#ifndef MK_PER_PHASE
#define MK_PER_PHASE 0
#endif
extern "C" void kernel_launch(void* const* d_in, const int* in_sizes, int n_in, void* d_out, int out_size, void* d_ws, size_t ws_size, hipStream_t stream) {
    static int grid = 0;
    if (grid == 0) {
        if (n_in != 28 || in_sizes[0] != M * D || out_size != M * D || ws_size < WS_NEED) { fprintf(stderr, "kernel_launch: unexpected shapes (n_in %d, in0 %d, out %d, ws %zu)\n", n_in, n_in > 0 ? in_sizes[0] : -1, out_size, ws_size); grid = -1; return; }
        if (hipFuncSetAttribute((const void*)mega_fwd, hipFuncAttributeMaxDynamicSharedMemorySize, LDS_BYTES) != hipSuccess) { fprintf(stderr, "kernel_launch: hipFuncSetAttribute failed\n"); grid = -1; return; }
        int dev = 0, cus = 0, per_cu = 0;
        hipGetDevice(&dev); hipDeviceGetAttribute(&cus, hipDeviceAttributeMultiprocessorCount, dev);
        if (hipOccupancyMaxActiveBlocksPerMultiprocessor(&per_cu, (const void*)mega_fwd, NTHR, LDS_BYTES) != hipSuccess || per_cu < 1) { fprintf(stderr, "kernel_launch: occupancy query failed (%d)\n", per_cu); grid = -1; return; }
        grid = cus;
    }
    if (grid < 0) return;
    Params p{};
    p.x = (const float*)d_in[0]; p.mem = (const float*)d_in[1]; p.positions = (const int*)d_in[2];
    p.w_in = (const float*)d_in[3]; p.pe_k = (const float*)d_in[4]; p.pe_v = (const float*)d_in[5];
    p.w1k = (const float*)d_in[6]; p.w2k = (const float*)d_in[7]; p.w1v = (const float*)d_in[8]; p.w2v = (const float*)d_in[9];
    p.w_out = (const float*)d_in[10]; p.ln1g = (const float*)d_in[11]; p.ln1b = (const float*)d_in[12];
    p.w_xq = (const float*)d_in[13]; p.w_xkv = (const float*)d_in[14]; p.w_xo = (const float*)d_in[15];
    p.ln2g = (const float*)d_in[16]; p.ln2b = (const float*)d_in[17]; p.w_router = (const float*)d_in[18]; p.rbias = (const float*)d_in[19];
    p.w_gate = (const float*)d_in[20]; p.w_up = (const float*)d_in[21]; p.w_down = (const float*)d_in[22];
    p.ws_gate = (const float*)d_in[23]; p.ws_up = (const float*)d_in[24]; p.ws_down = (const float*)d_in[25];
    p.ln3g = (const float*)d_in[26]; p.ln3b = (const float*)d_in[27];
    p.out = (float*)d_out; p.ws = (unsigned char*)d_ws;
    for (int i = 0; i < 4; ++i) p.lg[i] = (float)std::log(1.0 - std::pow(2.0, -5.0 - (double)i));
#if MK_PER_PHASE
    for (int ph = 0; ph < N_PHASES; ++ph) { p.ph_lo = ph; p.ph_hi = ph + 1; hipLaunchKernelGGL(mega_fwd, dim3(grid), dim3(NTHR), LDS_BYTES, stream, p); }
#else
    p.ph_lo = 0; p.ph_hi = N_PHASES;
    if (hipMemsetAsync((char*)d_ws + WS_BAR, 0, XCD_BAR_WORDS * 4, stream) != hipSuccess) { fprintf(stderr, "kernel_launch: memset failed\n"); return; }
    void* args[] = {&p};
    hipError_t e = hipLaunchCooperativeKernel((const void*)mega_fwd, dim3(grid), dim3(NTHR), args, LDS_BYTES, stream);
    if (e != hipSuccess) fprintf(stderr, "kernel_launch: cooperative launch failed: %s (grid %d)\n", hipGetErrorString(e), grid);
#endif
}
```

```cpp
#include <hip/hip_runtime.h>
#include <cstdio>
#include <cstdint>
#include <cmath>

typedef _Float16 h16;
typedef _Float16 h16x8 __attribute__((ext_vector_type(8)));
typedef _Float16 h16x2 __attribute__((ext_vector_type(2)));
typedef _Float16 h16x4 __attribute__((ext_vector_type(4)));
typedef float f32x2 __attribute__((ext_vector_type(2)));
typedef float f32x4 __attribute__((ext_vector_type(4)));
typedef unsigned u32x4 __attribute__((ext_vector_type(4)));
typedef unsigned u32x2 __attribute__((ext_vector_type(2)));

__device__ __forceinline__ int tidx() { int t = (int)threadIdx.x; asm volatile("" : "+v"(t)); return t; }

#ifndef PROBE_DBL
#define PROBE_DBL -1
#endif
#define REPS(k) for (int _rep = 0; _rep < ((PROBE_DBL) == (k) ? 2 : 1); ++_rep)

constexpr int NB = 4, T = 8192, D = 1024, M = NB * T;
constexpr int INC = 3352, INP = 3584;
constexpr int C_RQ = 0, C_RK = 512, C_RV = 1024, C_RG = 1536, C_NQ = 2048, C_NKC = 2560, C_NVC = 2688, C_NKS = 2816, C_NVS = 2944, C_NKW = 3072, C_NVW = 3200, C_NG = 3328;
constexpr int MEML = 256;
constexpr int NE = 64, EFF = 256;
constexpr float LN_EPS = 1e-5f;
constexpr float DN_ALPHA = 1.189207115002721f;
constexpr float NEGF = -1e30f;

constexpr size_t MiB = 1u << 20;
constexpr size_t WS_WIN = 1 * MiB, WS_WOUT = 8 * MiB, WS_WXQ = 10 * MiB, WS_WXO = 12 * MiB, WS_WXKV = 14 * MiB, WS_MEMH = 18 * MiB, WS_KVM = 20 * MiB;
constexpr size_t WS_KCMP = 24 * MiB, WS_VCMP = 25 * MiB, WS_TOPE = 26 * MiB, WS_TOPW = 27 * MiB;
constexpr size_t WS_XH = 32 * MiB, WS_MIX = 32 * MiB, WS_OX = 32 * MiB;
constexpr size_t WS_H = 96 * MiB, WS_NQR = 320 * MiB, WS_KVB = 352 * MiB, WS_PREV = 416 * MiB;
constexpr size_t WS_PRE = 96 * MiB, WS_X1 = 224 * MiB, WS_X1H = 352 * MiB, WS_QX = 416 * MiB, WS_X2 = 130 * MiB;
constexpr size_t WS_X2H = 32 * MiB, WS_WDT = 96 * MiB, WS_HM = 130 * MiB, WS_WGUT = 306 * MiB, WS_Y = 306 * MiB;
constexpr size_t WS_ROWOFF = 1 * MiB, WS_ROWMETA = 3 * MiB;
constexpr size_t WS_VST = 480 * MiB, WS_VWT = 488 * MiB, WS_COSR = 496 * MiB, WS_SINR = 504 * MiB, WS_COSN = 28 * MiB, WS_SINN = 29 * MiB, WS_KVMVT = 30 * MiB;
constexpr size_t WS_WRTH = 262144, WS_WRTL = 393216;
constexpr size_t WS_WC1T = 464 * MiB, WS_HID = 466 * MiB, WS_CMPOFF = 131072, WS_PEB = 131072 + 16384;
constexpr size_t WS_PREVT = 416 * MiB, WS_KSR = 448 * MiB, WS_KWR = 456 * MiB, WS_KX = 26 * MiB;
constexpr size_t DO_RQR = 0, DO_RKR = 32 * MiB, DO_RKZT = 64 * MiB, DO_RVT = 96 * MiB;
constexpr size_t WS_NEED = 512 * MiB;
constexpr int NQ = 4, QT = M / NQ, NVE = NQ * 65, CAP_TILES = 1412, CAP = CAP_TILES * 256;
constexpr size_t WS_BAR = 65536;
constexpr int CTL_CNT = 0, CTL_CUR = 512, CTL_PST = 1024, CTL_TQS = 1536, CTL_TVE = 2048;

namespace pg8 {
#define PG8_LAS __attribute__((address_space(3)))
typedef short s16x8 __attribute__((ext_vector_type(8)));
constexpr int BM = 256, BK = 64, HALF = 128, HTB = HALF * BK * 2, STAGE_BYTES = 8 * HTB, NXCD = 8, WGM = 8;
__host__ __device__ __forceinline__ int lds_byte(int r, int c) { const int st = (r >> 4) * 2 + (c >> 5), rr = r & 15, cc = c & 31, ob = rr * 64 + cc * 2; return st * 1024 + (ob ^ (((ob >> 9) & 1) << 5)); }
__host__ __device__ __forceinline__ void stage_rc(int b, int& R, int& C) { const int st = b / 1024, sb = b % 1024, swz = sb ^ (((sb >> 9) & 1) << 5); R = (st >> 1) * 16 + swz / 64; C = (st & 1) * 32 + (swz % 64) / 2; }
__host__ __device__ __forceinline__ int perm32(int rho) { const int n = rho >> 4, i = rho & 15; return 8 * (i >> 2) + 4 * n + (i & 3); }
struct Unit { int pm, pn; const char* A; const char* B; const unsigned* gat; };
struct Gemm { const h16* A; const h16* Bt; int M, N, K; };
struct StaticOrder {
    int nM, nN, nwg, G, c; const char* A; const char* B; size_t tstep;
    __device__ void init(const Gemm& g, int G_, int c_) { nM = g.M / BM; nN = g.N / BM; nwg = nM * nN; G = G_; c = c_; A = (const char*)g.A; B = (const char*)g.Bt; tstep = (size_t)BM * g.K * 2; }
    __device__ bool next(int i, Unit& u) const {
        const long L = (long)i * G + c; if (L >= nwg) return false;
        int wgid = (int)L; { const int q = nwg / NXCD, r = nwg % NXCD, xcd = wgid % NXCD, off = wgid / NXCD; wgid = (xcd < r ? xcd * (q + 1) : r * (q + 1) + (xcd - r) * q) + off; }
        const int nig = WGM * nN, gid = wgid / nig, fm = gid * WGM, gsz = (nM - fm) < WGM ? (nM - fm) : WGM;
        u.pm = fm + ((wgid % nig) % gsz); u.pn = (wgid % nig) / gsz; u.A = A + (size_t)u.pm * tstep; u.B = B + (size_t)u.pn * tstep; u.gat = nullptr; return true;
    }
};
__device__ __forceinline__ unsigned cvt_pk_f16(float lo, float hi) { f32x2 v = {lo, hi}; h16x2 h = __builtin_convertvector(v, h16x2); return __builtin_bit_cast(unsigned, h); }

struct EpiF16 {
    static constexpr bool PERM = true;
    h16* O; int ldc;
    __device__ __forceinline__ void operator()(const f32x4 (&acc)[2][2][4][2], const Unit& u, int wr, int wc, int fr, int fq) const {
        const int row0 = u.pm * BM + wr * 64 + fr; const int col0 = u.pn * BM + wc * 32 + 8 * fq;
#pragma unroll
        for (int ai = 0; ai < 2; ++ai)
#pragma unroll
            for (int m = 0; m < 4; ++m) { h16* rowp = O + (size_t)(row0 + ai * HALF + m * 16) * ldc + col0;
#pragma unroll
                for (int bj = 0; bj < 2; ++bj) { const f32x4 v0 = acc[ai][bj][m][0], v1 = acc[ai][bj][m][1];
                    *(h16x8*)(rowp + bj * HALF) = __builtin_convertvector(__builtin_shufflevector(v0, v1, 0, 1, 2, 3, 4, 5, 6, 7), h16x8); } }
    }
};
struct EpiResF32 {
    static constexpr bool PERM = false;
    float* C; const float* R; int ldc; float alpha;
    __device__ __forceinline__ void operator()(const f32x4 (&acc)[2][2][4][2], const Unit& u, int wr, int wc, int fr, int fq) const {
        const int row0 = u.pm * BM + wr * 64 + fr, col0 = u.pn * BM + wc * 32 + 4 * fq;
#pragma unroll
        for (int ai = 0; ai < 2; ++ai)
#pragma unroll
            for (int m = 0; m < 4; ++m) { const size_t off = (size_t)(row0 + ai * HALF + m * 16) * ldc + col0;
#pragma unroll
                for (int bj = 0; bj < 2; ++bj)
#pragma unroll
                    for (int n = 0; n < 2; ++n) { const f32x4 r = *(const f32x4*)(R + off + bj * HALF + n * 16); *(f32x4*)(C + off + bj * HALF + n * 16) = r * alpha + acc[ai][bj][m][n]; } }
    }
};
struct EpiCmp1 {
    static constexpr bool PERM = true;
    h16* O; const float* peb;
    __device__ __forceinline__ void operator()(const f32x4 (&acc)[2][2][4][2], const Unit& u, int wr, int wc, int fr, int fq) const {
        const int row0 = u.pm * BM + wr * 64 + fr; const int col0 = wc * 32 + 8 * fq;
#pragma unroll
        for (int bj = 0; bj < 2; ++bj) { const f32x4 b0 = *(const f32x4*)(peb + col0 + bj * HALF), b1 = *(const f32x4*)(peb + col0 + bj * HALF + 4);
#pragma unroll
            for (int ai = 0; ai < 2; ++ai)
#pragma unroll
                for (int m = 0; m < 4; ++m) { f32x4 v0 = acc[ai][bj][m][0] + b0, v1 = acc[ai][bj][m][1] + b1;
#pragma unroll
                    for (int r = 0; r < 4; ++r) { v0[r] = v0[r] / (1.f + __expf(-v0[r])); v1[r] = v1[r] / (1.f + __expf(-v1[r])); }
                    *(h16x8*)(O + (size_t)(row0 + ai * HALF + m * 16) * 256 + col0 + bj * HALF) = __builtin_convertvector(__builtin_shufflevector(v0, v1, 0, 1, 2, 3, 4, 5, 6, 7), h16x8); } }
    }
};
struct EpiGateUp {
    static constexpr bool PERM = true;
    h16* H;
    __device__ __forceinline__ void operator()(const f32x4 (&acc)[2][2][4][2], const Unit& u, int wr, int wc, int fr, int fq) const {
        const int row0 = u.pm * BM + wr * 64 + fr; const int col0 = u.pn * 128 + wc * 16 + 4 * fq;
#pragma unroll
        for (int ai = 0; ai < 2; ++ai)
#pragma unroll
            for (int m = 0; m < 4; ++m) { h16* rowp = H + (size_t)(row0 + ai * HALF + m * 16) * 256 + col0;
#pragma unroll
                for (int bj = 0; bj < 2; ++bj) { const f32x4 v0 = acc[ai][bj][m][0], v1 = acc[ai][bj][m][1];
                    const float h0 = v0[0] / (1.f + __expf(-v0[0])) * v0[1], h1 = v0[2] / (1.f + __expf(-v0[2])) * v0[3];
                    const float h2 = v1[0] / (1.f + __expf(-v1[0])) * v1[1], h3 = v1[2] / (1.f + __expf(-v1[2])) * v1[3];
                    *(h16x4*)(rowp + bj * 64) = __builtin_convertvector((f32x4){h0, h1, h2, h3}, h16x4); } }
    }
};
struct EpiDown {
    static constexpr bool PERM = true;
    h16* Y; const u32x2* rowmeta;
    __device__ __forceinline__ void operator()(const f32x4 (&acc)[2][2][4][2], const Unit& u, int wr, int wc, int fr, int fq) const {
        const int row0 = u.pm * BM + wr * 64 + fr; const int col0 = u.pn * BM + wc * 32 + 8 * fq;
#pragma unroll
        for (int ai = 0; ai < 2; ++ai)
#pragma unroll
            for (int m = 0; m < 4; ++m) { const u32x2 md = rowmeta[row0 + ai * HALF + m * 16]; const int slot = (int)md.x; const float w8 = __uint_as_float(md.y);
                if (slot >= 0) { h16* rowp = Y + (size_t)slot * 1024 + col0;
#pragma unroll
                    for (int bj = 0; bj < 2; ++bj) { const f32x4 v0 = acc[ai][bj][m][0] * w8, v1 = acc[ai][bj][m][1] * w8;
                        *(h16x8*)(rowp + bj * HALF) = __builtin_convertvector(__builtin_shufflevector(v0, v1, 0, 1, 2, 3, 4, 5, 6, 7), h16x8); } }
                asm volatile("" ::: "memory"); }
    }
};

template <class Epi, class Sched>
__device__ __forceinline__ void gemm_phase(PG8_LAS unsigned char* lds, const int K, const Sched& S, const Epi& E, const size_t kstepA = (size_t)(BK * 2)) {
    const int tid = tidx(), wid = __builtin_amdgcn_readfirstlane(tid >> 6), lane = tid & 63, wr = wid >> 2, wc = wid & 3, fr = lane & 15, fq = lane >> 4;
    const int nt = K / BK;
    int R0, C0; stage_rc(tid * 16, R0, C0);
    const unsigned cb2 = (unsigned)C0 * 2u;
    unsigned voffB[2];
#pragma unroll
    for (int i = 0; i < 2; ++i) { const int R = R0 + 64 * i; const int Rb = Epi::PERM ? ((R & ~31) + perm32(R & 31)) : R; voffB[i] = (unsigned)(Rb * K) * 2u + cb2; }
    const size_t kstep = (size_t)(BK * 2);
    const size_t hstep = (size_t)HALF * K * 2;
    const unsigned ldsw = (unsigned)wid * 1024u;
    const int aoff = lds_byte(wr * 64 + fr, fq * 8), boff = lds_byte(wc * 32 + fr, fq * 8);
#define PG8_MKVA(u, va) do { _Pragma("unroll") for (int _h = 0; _h < 2; ++_h) _Pragma("unroll") for (int _i = 0; _i < 2; ++_i) { const int _r = _h * HALF + R0 + 64 * _i; \
        (va)[_h][_i] = ((u).gat ? (u).gat[_r] : (unsigned)(_r * K) * 2u) + cb2; } } while (0)
#define PG8_SA(b, h) (((b) * 2 + (h)) * HTB)
#define PG8_SB(b, h) ((4 + (b) * 2 + (h)) * HTB)
#define PG8_STAGE(bufoff, gbase, voff) do { _Pragma("unroll") for (int _i = 0; _i < 2; ++_i) \
        __builtin_amdgcn_global_load_lds((const unsigned*)((const char*)(gbase) + (voff)[_i]), (PG8_LAS unsigned*)(lds + (bufoff) + ldsw + _i * 8192), 16, 0, 0); } while (0)
#define PG8_LDA(dst, b, h) do { _Pragma("unroll") for (int m = 0; m < 4; ++m) _Pragma("unroll") for (int k = 0; k < 2; ++k) dst[m][k] = *(const PG8_LAS s16x8*)(lds + PG8_SA(b, h) + aoff + m * 2048 + k * 1024); } while (0)
#define PG8_LDB(dst, b, h) do { _Pragma("unroll") for (int n = 0; n < 2; ++n) _Pragma("unroll") for (int k = 0; k < 2; ++k) dst[n][k] = *(const PG8_LAS s16x8*)(lds + PG8_SB(b, h) + boff + n * 2048 + k * 1024); } while (0)
#define PG8_MMA(ai, bj, At, Bt) do { __builtin_amdgcn_s_setprio(1); _Pragma("unroll") for (int m = 0; m < 4; ++m) _Pragma("unroll") for (int n = 0; n < 2; ++n) _Pragma("unroll") for (int k = 0; k < 2; ++k) \
        acc[ai][bj][m][n] = __builtin_amdgcn_mfma_f32_16x16x32_f16(__builtin_bit_cast(h16x8, Bt[n][k]), __builtin_bit_cast(h16x8, At[m][k]), acc[ai][bj][m][n], 0, 0, 0); __builtin_amdgcn_s_setprio(0); } while (0)
#define PG8_WAIT_V(n) asm volatile("s_waitcnt vmcnt(" #n ")" ::: "memory")
#define PG8_WAIT_L(n) asm volatile("s_waitcnt lgkmcnt(" #n ")" ::: "memory")
#define PG8_BAR __builtin_amdgcn_s_barrier()
#define PG8_SCHED __builtin_amdgcn_sched_barrier(0)
    Unit cur, nxt; int ui = 0;
    if (!S.next(0, cur)) return;
    unsigned va[2][2];
    PG8_MKVA(cur, va);
    f32x4 acc[2][2][4][2];
#pragma unroll
    for (int a = 0; a < 2; ++a)
#pragma unroll
        for (int b = 0; b < 2; ++b)
#pragma unroll
            for (int m = 0; m < 4; ++m)
#pragma unroll
                for (int n = 0; n < 2; ++n) acc[a][b][m][n] = (f32x4){0.f, 0.f, 0.f, 0.f};
    s16x8 At[4][2], B0[2][2], B1[2][2];
    const char* cA = cur.A; const char* cB = cur.B;
    {
        PG8_STAGE(PG8_SB(0, 0), cB, voffB); PG8_STAGE(PG8_SB(0, 1), cB + hstep, voffB); PG8_STAGE(PG8_SA(0, 0), cA, va[0]); PG8_STAGE(PG8_SA(0, 1), cA, va[1]);
        if (wr == 1) PG8_BAR;
        PG8_WAIT_V(2); PG8_BAR;
        PG8_STAGE(PG8_SB(1, 0), cB + kstep, voffB); PG8_STAGE(PG8_SA(1, 0), cA + kstepA, va[0]); PG8_STAGE(PG8_SB(1, 1), cB + hstep + kstep, voffB);
        PG8_WAIT_V(6); PG8_BAR;
    }
    for (;;) {
        const bool has_next = S.next(ui + 1, nxt);
        const char* nA = has_next ? nxt.A : cA; const char* nB = has_next ? nxt.B : cB;
#pragma unroll 1
        for (int t = 0; t < nt; t += 2) {
            const bool last = (t == nt - 2);
            const char* a1 = cA + (size_t)(t + 1) * kstepA;
            const char* a2 = last ? nA : cA + (size_t)(t + 2) * kstepA; const char* b2 = last ? nB : cB + (size_t)(t + 2) * kstep;
            const char* a3 = a2 + kstepA; const char* b3 = b2 + kstep;
            PG8_LDB(B0, 0, 0); PG8_LDB(B1, 0, 1); PG8_SCHED; PG8_LDA(At, 0, 0); PG8_STAGE(PG8_SA(1, 1), a1, va[1]);
            if (last && has_next) { PG8_MKVA(nxt, va); }
            PG8_WAIT_V(8); PG8_WAIT_L(0); PG8_BAR; PG8_MMA(0, 0, At, B0); PG8_MMA(0, 1, At, B1); PG8_BAR; PG8_SCHED;
            PG8_LDA(At, 0, 1); PG8_STAGE(PG8_SB(0, 0), b2, voffB); PG8_STAGE(PG8_SB(0, 1), b2 + hstep, voffB); PG8_STAGE(PG8_SA(0, 0), a2, va[0]);
            PG8_WAIT_V(8); PG8_WAIT_L(0); PG8_BAR; PG8_MMA(1, 0, At, B0); PG8_MMA(1, 1, At, B1); PG8_BAR; PG8_SCHED;
            PG8_LDB(B0, 1, 0); PG8_LDB(B1, 1, 1); PG8_SCHED; PG8_LDA(At, 1, 0); PG8_STAGE(PG8_SA(0, 1), a2, va[1]);
            PG8_WAIT_V(8); PG8_WAIT_L(0); PG8_BAR; PG8_MMA(0, 0, At, B0); PG8_MMA(0, 1, At, B1); PG8_BAR; PG8_SCHED;
            PG8_LDA(At, 1, 1); PG8_STAGE(PG8_SB(1, 0), b3, voffB); PG8_STAGE(PG8_SB(1, 1), b3 + hstep, voffB); PG8_STAGE(PG8_SA(1, 0), a3, va[0]);
            PG8_WAIT_V(8); PG8_WAIT_L(0); PG8_BAR; PG8_MMA(1, 0, At, B0); PG8_MMA(1, 1, At, B1); PG8_BAR; PG8_SCHED;
        }
        if (wr == 0) PG8_BAR;
        E(acc, cur, wr, wc, fr, fq);
        if (!has_next) break;
#pragma unroll
        for (int a = 0; a < 2; ++a)
#pragma unroll
            for (int b = 0; b < 2; ++b)
#pragma unroll
                for (int m = 0; m < 4; ++m)
#pragma unroll
                    for (int n = 0; n < 2; ++n) acc[a][b][m][n] = (f32x4){0.f, 0.f, 0.f, 0.f};
        cur = nxt; cA = nA; cB = nB; ++ui;
        if (wr == 1) PG8_BAR;
    }
    PG8_WAIT_V(0);
    PG8_BAR;
#undef PG8_MKVA
#undef PG8_SA
#undef PG8_SB
#undef PG8_STAGE
#undef PG8_LDA
#undef PG8_LDB
#undef PG8_MMA
#undef PG8_WAIT_V
#undef PG8_WAIT_L
#undef PG8_BAR
#undef PG8_SCHED
}
}


#include <hip/hip_cooperative_groups.h>
namespace cg = cooperative_groups;
constexpr int NTHR = 512;
constexpr int LDS_BYTES = 147456;
#define LAS __attribute__((address_space(3)))

struct Params {
    const float *x, *mem; const int* positions;
    const float *w_in, *pe_k, *pe_v, *w1k, *w2k, *w1v, *w2v, *w_out, *ln1g, *ln1b, *w_xq, *w_xkv, *w_xo, *ln2g, *ln2b, *w_router, *rbias, *w_gate, *w_up, *w_down, *ws_gate, *ws_up, *ws_down, *ln3g, *ln3b;
    float* out; unsigned char* ws;
    float lg[4];
    int ph_lo, ph_hi;
};

__device__ __forceinline__ float wave_sum(float v) {
#pragma unroll
    for (int o = 1; o < 64; o <<= 1) v += __shfl_xor(v, o);
    return v;
}
__device__ __forceinline__ float wave_max(float v) {
#pragma unroll
    for (int o = 1; o < 64; o <<= 1) v = fmaxf(v, __shfl_xor(v, o));
    return v;
}
__device__ __forceinline__ float siluf(float v) { return v / (1.f + __expf(-v)); }
__device__ __forceinline__ float sigmf(float v) { return 1.f / (1.f + __expf(-v)); }

__device__ __forceinline__ void b_transpose_tile(const float* __restrict__ W, int K, int N, h16* __restrict__ WT, int Npad, int tile, float* tl, int lt, int rs = 1, int ro = 0) {
    const int ntn = Npad / 32; const int n0 = (tile % ntn) * 32, k0 = (tile / ntn) * 32, tx = lt & 31, ty = lt >> 5;
    for (int i = ty; i < 32; i += 8) { const int k = k0 + i, n = n0 + tx; tl[i * 33 + tx] = (n < N) ? W[(size_t)k * N + n] : 0.f; }
    __syncthreads();
    for (int i = ty; i < 32; i += 8) { const int n = n0 + i, k = k0 + tx; WT[(size_t)(n * rs + ro) * K + k] = (h16)tl[tx * 33 + i]; }
    __syncthreads();
}
__device__ __forceinline__ void w_transpose_item(const float* __restrict__ W, int K, int N, h16* __restrict__ WT, int item, LAS float* scr, int lane, int rs = 1, int ro = 0) {
    const int nblk = N / 32, kb = item / nblk, nb = item % nblk, k0 = 64 * kb, n0 = 32 * nb;
#pragma unroll 8
    for (int i = 0; i < 32; ++i) { const int kk = 2 * i + (lane >> 5); scr[kk * 33 + (lane & 31)] = W[(size_t)(k0 + kk) * N + n0 + (lane & 31)]; }
    asm volatile("s_waitcnt lgkmcnt(0)" ::: "memory");
    const int c = lane & 7;
#pragma unroll
    for (int j = 0; j < 4; ++j) { const int n = (lane >> 3) + 8 * j; LAS const float* s = scr + (8 * c) * 33 + n; h16x8 o;
#pragma unroll
        for (int x = 0; x < 8; ++x) o[x] = (h16)s[x * 33];
        *(h16x8*)(WT + (size_t)((n0 + n) * rs + ro) * K + k0 + 8 * c) = o; }
    asm volatile("s_waitcnt lgkmcnt(0)" ::: "memory");
}
__device__ __forceinline__ void b_cvt(const float* __restrict__ x, h16* __restrict__ o, size_t n4) {
    for (size_t i = (size_t)blockIdx.x * NTHR + tidx(); i < n4; i += (size_t)gridDim.x * NTHR) {
        const f32x4 v = ((const f32x4*)x)[i]; ((h16x4*)o)[i] = __builtin_convertvector(v, h16x4); }
}

__device__ __forceinline__ void b_tables(const int* __restrict__ positions, float* __restrict__ cosr, float* __restrict__ sinr, float* __restrict__ cosn, float* __restrict__ sinn) {
    for (int idx = blockIdx.x * NTHR + tidx(); idx < M * 72; idx += gridDim.x * NTHR) {
        const int m = idx / 72, j = idx % 72; const float pos = (float)positions[m];
        const float inv = j < 64 ? (float)pow(10000.0, -(double)j / 64.0) : (float)pow(500000.0, -(double)(j - 64) / 8.0);
        const float ang = pos * inv; double sd, cd; sincos((double)ang, &sd, &cd);
        if (j < 64) { cosr[(size_t)m * 64 + j] = (float)cd; sinr[(size_t)m * 64 + j] = (float)sd; } else { cosn[(size_t)m * 8 + j - 64] = (float)cd; sinn[(size_t)m * 8 + j - 64] = (float)sd; }
    }
}
__device__ __forceinline__ void b_rope(const h16* __restrict__ h, h16* __restrict__ rqr, h16* __restrict__ rkr, h16* __restrict__ nqr, h16* __restrict__ ksR, h16* __restrict__ kwR, const float* __restrict__ cosr, const float* __restrict__ sinr,
                                       const float* __restrict__ cosn, const float* __restrict__ sinn, int m, int j) {
    const h16* hr = h + (size_t)m * INP; const int bb = m >> 13, t = m & (T - 1);
    {   const int hd = j >> 6, jj = j & 63; const float c = cosr[(size_t)m * 64 + jj], s = sinr[(size_t)m * 64 + jj]; const size_t ro = ((size_t)(bb * 4 + hd) * T + t) * 128;
        const int o1 = hd * 128 + jj, o2 = o1 + 64;
        const float q1 = (float)hr[C_RQ + o1], q2 = (float)hr[C_RQ + o2];
        rqr[ro + jj] = (h16)(q1 * c - q2 * s); rqr[ro + jj + 64] = (h16)(q2 * c + q1 * s);
        const float k1 = (float)hr[C_RK + o1], k2 = (float)hr[C_RK + o2]; const float sc = 0.08838834764831845f;
        rkr[ro + jj] = (h16)((k1 * c - k2 * s) * sc); rkr[ro + jj + 64] = (h16)((k2 * c + k1 * s) * sc);
    }
    if (j < 64 + 16 + 16) {
        const int jj = j & 7; const float c = cosn[(size_t)m * 8 + jj], s = sinn[(size_t)m * 8 + jj];
        if (j < 64) { const int hd = j >> 3; const int o1 = hd * 64 + jj, o2 = o1 + 8;
            const float q1 = (float)hr[C_NQ + o1], q2 = (float)hr[C_NQ + o2];
            nqr[(size_t)m * 512 + o1] = (h16)(q1 * c - q2 * s); nqr[(size_t)m * 512 + o2] = (h16)(q2 * c + q1 * s);
        } else { const int jx = j - 64; const int which = jx >> 4, g = (jx >> 3) & 1; const int base = (which ? C_NKW : C_NKS) + g * 64 + jj;
            const float k1 = (float)hr[base], k2 = (float)hr[base + 8];
            h16* dst = (which ? kwR : ksR) + (((size_t)((bb * 2 + g) * 128 + (t >> 6)) * 64 + (t & 63)) * 64); dst[jj] = (h16)(k1 * c - k2 * s); dst[jj + 8] = (h16)(k2 * c + k1 * s); }
    }
    if (j >= 128 && j < 128 + 96) { const int jx = j - 128; const int which = jx / 48, r = jx % 48, g = r / 24, d = 16 + 2 * (r % 24);
        const int base = (which ? C_NKW : C_NKS) + g * 64 + d; h16* dst = (which ? kwR : ksR) + (((size_t)((bb * 2 + g) * 128 + (t >> 6)) * 64 + (t & 63)) * 64);
        dst[d] = hr[base]; dst[d + 1] = hr[base + 1]; }
    for (int i = j; i < 8 * 48; i += 256) { const int hd = i / 48, d = 16 + i % 48; nqr[(size_t)m * 512 + hd * 64 + d] = hr[C_NQ + hd * 64 + d]; }
}
__device__ __forceinline__ void b_rtrans(const Params& p, const h16* __restrict__ h, h16* __restrict__ rvT, h16* __restrict__ rkzT, const float* __restrict__ cosr, const float* __restrict__ sinr, int item, LAS h16* sl, int lane) {
    int id = item; const int tt = id & 255; id >>= 8; const int hd = id & 3; const int b = id >> 2; const int bh = b * 4 + hd; const float lg = p.lg[hd];
    const int chunk = bh * 64 + (tt >> 2), koff = (tt & 3) * 32;
#pragma unroll 4
    for (int i = lane; i < 32 * 16; i += 64) { const int t = i >> 4, e8 = (i & 15) * 8; const h16x8 v = *(const h16x8*)(h + (size_t)(b * T + tt * 32 + t) * INP + C_RV + hd * 128 + e8);
#pragma unroll
        for (int x = 0; x < 8; ++x) sl[t * 130 + e8 + x] = v[x]; }
    asm volatile("s_waitcnt lgkmcnt(0)" ::: "memory");
#pragma unroll 4
    for (int i = lane; i < 128 * 4; i += 64) { const int e = i >> 2, t8 = (i & 3) * 8; h16x8 o;
#pragma unroll
        for (int x = 0; x < 8; ++x) o[x] = sl[(t8 + x) * 130 + e];
        *(h16x8*)(rvT + ((size_t)chunk * 128 + e) * 128 + koff + t8) = o; }
    asm volatile("s_waitcnt lgkmcnt(0)" ::: "memory");
#pragma unroll 4
    for (int i = lane; i < 32 * 8; i += 64) { const int t = i >> 3, j8 = (i & 7) * 8; const size_t m = (size_t)b * T + tt * 32 + t;
        const h16x8 k1 = *(const h16x8*)(h + m * INP + C_RK + hd * 128 + j8), k2 = *(const h16x8*)(h + m * INP + C_RK + hd * 128 + 64 + j8);
        const f32x4 c0 = *(const f32x4*)(cosr + m * 64 + j8), c1 = *(const f32x4*)(cosr + m * 64 + j8 + 4), s0 = *(const f32x4*)(sinr + m * 64 + j8), s1 = *(const f32x4*)(sinr + m * 64 + j8 + 4);
        const float z = 0.08838834764831845f * __expf(lg * (float)(127 - (koff + t)));
#pragma unroll
        for (int x = 0; x < 8; ++x) { const float c = x < 4 ? c0[x & 3] : c1[x & 3], s = x < 4 ? s0[x & 3] : s1[x & 3]; const float a1 = (float)k1[x], a2 = (float)k2[x];
            sl[t * 130 + j8 + x] = (h16)((a1 * c - a2 * s) * z); sl[t * 130 + 64 + j8 + x] = (h16)((a2 * c + a1 * s) * z); } }
    asm volatile("s_waitcnt lgkmcnt(0)" ::: "memory");
#pragma unroll 4
    for (int i = lane; i < 128 * 4; i += 64) { const int d = i >> 2, t8 = (i & 3) * 8; h16x8 o;
#pragma unroll
        for (int x = 0; x < 8; ++x) o[x] = sl[(t8 + x) * 130 + d];
        *(h16x8*)(rkzT + ((size_t)chunk * 128 + d) * 128 + koff + t8) = o; }
    asm volatile("s_waitcnt lgkmcnt(0)" ::: "memory");
}
__device__ __forceinline__ void b_mvtrans(const h16* __restrict__ kvm, h16* __restrict__ kvmVT, h16* __restrict__ kx, int item, h16* sl, int lt) {
    int id = item; const int kt = id & 3; id >>= 2; const int dtl = id & 3; id >>= 2; const int hh = id & 3; const int b = id >> 2;
    for (int i = lt; i < 64 * 64; i += 256) { const int k = i >> 6, d = i & 63; sl[k * 66 + d] = kvm[(size_t)(b * MEML + kt * 64 + k) * 2048 + 1024 + hh * 256 + dtl * 64 + d];
        kx[((size_t)(b * 4 + hh) * MEML + kt * 64 + k) * 256 + dtl * 64 + d] = kvm[(size_t)(b * MEML + kt * 64 + k) * 2048 + hh * 256 + dtl * 64 + d]; }
    __syncthreads();
    for (int i = lt; i < 64 * 64; i += 256) { const int d = i >> 6, k = i & 63; kvmVT[(size_t)((b * 4 + hh) * 256 + dtl * 64 + d) * MEML + kt * 64 + k] = sl[k * 66 + d]; }
    __syncthreads();
}

struct CmpSched {
    const char* hbase; const unsigned* cmpoff; const char* Wc1T; int c;
    __device__ bool next(int i, pg8::Unit& u) const {
        if (i > 0 || c >= 32) return false; const int kv = c >> 4, rt = c & 15;
        u.pm = kv * 16 + rt; u.pn = 0; u.A = hbase + (size_t)(kv ? C_NVC : C_NKC) * 2; u.gat = cmpoff + rt * 256; u.B = Wc1T + (size_t)kv * 256 * 2048 * 2; return true; }
};
__device__ __forceinline__ void b_cmp2(const Params& p, const h16* __restrict__ hid, h16* __restrict__ kcmp, h16* __restrict__ vcmpT) {
    const int lane = tidx() & 63;
    for (int r = blockIdx.x * 8 + (tidx() >> 6); r < 2 * 4096; r += gridDim.x * 8) {
        const int kv = r >> 12, rr = r & 4095, g = rr & 1, c = (rr >> 1) & 511, b = rr >> 10;
        const float* w2 = kv ? p.w2v : p.w2k; const h16* hr = hid + (size_t)r * 256; float acc = 0.f;
        for (int j = 0; j < 256; j += 8) { const h16x8 hv = *(const h16x8*)(hr + j);
#pragma unroll
            for (int x = 0; x < 8; ++x) acc += (float)hv[x] * w2[(j + x) * 64 + lane]; }
        if (c == 511) acc = 0.f;
        if (kv == 0) kcmp[((size_t)(b * 2 + g) * 512 + c) * 64 + lane] = (h16)acc;
        else vcmpT[(((size_t)(b * 2 + g) * 8 + (c >> 6)) * 64 + lane) * 64 + (c & 63)] = (h16)acc;
    }
}
__device__ __forceinline__ void b_vtrans(const h16* __restrict__ h, h16* __restrict__ vsT, h16* __restrict__ vwT, int item, LAS h16* sl, int lane) {
    int id = item; const int tt = id & 127; id >>= 7; const int g = id & 1; id >>= 1; const int b = id & 3; const int which = id >> 2;
    const int col = (which ? C_NVW : C_NVS) + g * 64; h16* dst = (which ? vwT : vsT) + (size_t)((b * 2 + g) * 128 + tt) * 4096;
#pragma unroll 4
    for (int i = lane; i < 64 * 8; i += 64) { const int t = i >> 3, d8 = (i & 7) * 8; const h16x8 v = *(const h16x8*)(h + (size_t)(b * T + tt * 64 + t) * INP + col + d8);
#pragma unroll
        for (int x = 0; x < 8; ++x) sl[t * 66 + d8 + x] = v[x]; }
    asm volatile("s_waitcnt lgkmcnt(0)" ::: "memory");
#pragma unroll 4
    for (int i = lane; i < 64 * 8; i += 64) { const int d = i >> 3, t8 = (i & 7) * 8; h16x8 o;
#pragma unroll
        for (int x = 0; x < 8; ++x) o[x] = sl[(t8 + x) * 66 + d];
        *(h16x8*)(dst + d * 64 + t8) = o; }
    asm volatile("s_waitcnt lgkmcnt(0)" ::: "memory");
}

__device__ __forceinline__ void ret_kv_unit(const h16* __restrict__ rkzT, const h16* __restrict__ rvT, float* __restrict__ kvT, int chunk, int w, int lane) {
    const int i = lane & 15, kg = lane >> 4; const int bh = chunk >> 6, n = chunk & 63;
    h16x8 a[4];
#pragma unroll
    for (int ks = 0; ks < 4; ++ks) a[ks] = *(const h16x8*)(rkzT + ((size_t)chunk * 128 + 16 * w + i) * 128 + 32 * ks + 8 * kg);
#pragma unroll
    for (int et = 0; et < 8; ++et) { f32x4 acc = {0.f, 0.f, 0.f, 0.f};
#pragma unroll
        for (int ks = 0; ks < 4; ++ks) { const h16x8 bq = *(const h16x8*)(rvT + ((size_t)chunk * 128 + 16 * et + i) * 128 + 32 * ks + 8 * kg); acc = __builtin_amdgcn_mfma_f32_16x16x32_f16(a[ks], bq, acc, 0, 0, 0); }
        *(f32x4*)(kvT + ((size_t)chunk * 128 + 16 * et + i) * 128 + 16 * w + 4 * kg) = acc; }
}
__device__ __forceinline__ void b_ret_scan(const Params& p, const float* __restrict__ kvT, h16* __restrict__ prevT) {
    for (int gid = blockIdx.x * NTHR + tidx(); gid < 16 * 16384; gid += gridDim.x * NTHR) {
        const int de = gid & 16383, bh = gid >> 14; const float cd = __expf(p.lg[bh & 3] * 128.f);
        float st = 0.f;
        for (int n = 0; n < 64; ++n) { const size_t o = ((size_t)(bh * 64 + n) << 14) + de; prevT[o] = (h16)st; st = st * cd + kvT[o]; }
    }
}
__device__ __forceinline__ void ret_out_unit(const Params& p, const h16* __restrict__ h, const h16* __restrict__ rqr, const h16* __restrict__ rkr, const h16* __restrict__ rvT, const h16* __restrict__ prevT,
                                             h16* __restrict__ mix, int chunk, int w, int lane) {
    const int i = lane & 15, kg = lane >> 4; const int bh = chunk >> 6, n = chunk & 63, b = bh >> 2, hd = bh & 3; const float lg = p.lg[hd];
    const int qi = 16 * w + i; const size_t m = (size_t)b * T + n * 128 + qi;
    h16x8 qf[4];
#pragma unroll
    for (int ks = 0; ks < 4; ++ks) qf[ks] = *(const h16x8*)(rqr + ((size_t)bh * T + n * 128 + qi) * 128 + 32 * ks + 8 * kg);
    f32x4 inner[8], cross[8];
#pragma unroll
    for (int et = 0; et < 8; ++et) { inner[et] = (f32x4){0.f, 0.f, 0.f, 0.f}; cross[et] = (f32x4){0.f, 0.f, 0.f, 0.f}; }
    for (int gq = 0; gq < 2; ++gq) {
        if (64 * gq > 16 * w + 15) break;
        f32x4 s[4];
#pragma unroll
        for (int tl = 0; tl < 4; ++tl) { const int ko = 32 * (tl >> 1) + 8 * (i >> 2) + 4 * (tl & 1) + (i & 3); const h16* kp = rkr + ((size_t)bh * T + n * 128 + 64 * gq + ko) * 128 + 8 * kg;
            f32x4 acc = {0.f, 0.f, 0.f, 0.f};
#pragma unroll
            for (int ks = 0; ks < 4; ++ks) acc = __builtin_amdgcn_mfma_f32_16x16x32_f16(*(const h16x8*)(kp + 32 * ks), qf[ks], acc, 0, 0, 0);
            s[tl] = acc; }
        h16x8 pf[2];
#pragma unroll
        for (int tl = 0; tl < 4; ++tl)
#pragma unroll
            for (int r = 0; r < 4; ++r) { const int j = 64 * gq + 32 * (tl >> 1) + 8 * kg + 4 * (tl & 1) + r; const float v = (j <= qi) ? s[tl][r] * __expf(lg * (float)(qi - j)) : 0.f; pf[tl >> 1][4 * (tl & 1) + r] = (h16)v; }
#pragma unroll
        for (int et = 0; et < 8; ++et)
#pragma unroll
            for (int s2 = 0; s2 < 2; ++s2) { const h16x8 a = *(const h16x8*)(rvT + ((size_t)chunk * 128 + 16 * et + i) * 128 + 64 * gq + 32 * s2 + 8 * kg); inner[et] = __builtin_amdgcn_mfma_f32_16x16x32_f16(a, pf[s2], inner[et], 0, 0, 0); }
    }
#pragma unroll
    for (int et = 0; et < 8; ++et)
#pragma unroll
        for (int ks = 0; ks < 4; ++ks) { const h16x8 a = *(const h16x8*)(prevT + ((size_t)chunk * 128 + 16 * et + i) * 128 + 32 * ks + 8 * kg); cross[et] = __builtin_amdgcn_mfma_f32_16x16x32_f16(a, qf[ks], cross[et], 0, 0, 0); }
    const float xi = __expf(lg * (float)(qi + 1));
    float sm = 0.f;
#pragma unroll
    for (int et = 0; et < 8; ++et) { inner[et] = inner[et] + cross[et] * xi; sm += (inner[et][0] + inner[et][1]) + (inner[et][2] + inner[et][3]); }
    sm += __shfl_xor(sm, 16); sm += __shfl_xor(sm, 32);
    const float mu = sm * (1.f / 128.f); float sq = 0.f;
#pragma unroll
    for (int et = 0; et < 8; ++et) { inner[et] = inner[et] - mu; sq += (inner[et][0] * inner[et][0] + inner[et][1] * inner[et][1]) + (inner[et][2] * inner[et][2] + inner[et][3] * inner[et][3]); }
    sq += __shfl_xor(sq, 16); sq += __shfl_xor(sq, 32);
    const float rstd = rsqrtf(sq * (1.f / 128.f) + LN_EPS);
#pragma unroll
    for (int et = 0; et < 8; ++et) { const int e = 16 * et + 4 * kg; const h16x4 gv = *(const h16x4*)(h + m * INP + C_RG + hd * 128 + e);
        f32x4 o;
#pragma unroll
        for (int r = 0; r < 4; ++r) o[r] = siluf((float)gv[r]) * inner[et][r] * rstd;
        *(h16x4*)(mix + m * D + hd * 128 + e) = __builtin_convertvector(o, h16x4); }
}

struct AttSt { float m, l; f32x4 o[4]; };
struct KFrag { h16x8 a[4][2]; };
struct VFrag { h16x8 a[4][2]; };
__device__ __forceinline__ void ldk(KFrag& k, const h16* __restrict__ Kb, int pitchK, int i, int kg) {
#pragma unroll
    for (int tl = 0; tl < 4; ++tl) { const int ko = 32 * (tl >> 1) + 8 * (i >> 2) + 4 * (tl & 1) + (i & 3); const h16* kp = Kb + (size_t)ko * pitchK + 8 * kg;
        k.a[tl][0] = *(const h16x8*)kp; k.a[tl][1] = *(const h16x8*)(kp + 32); }
}
__device__ __forceinline__ void ldv(VFrag& v, const h16* __restrict__ VTb, int vstride, int i, int kg) {
#pragma unroll
    for (int dt = 0; dt < 4; ++dt)
#pragma unroll
        for (int s2 = 0; s2 < 2; ++s2) v.a[dt][s2] = *(const h16x8*)(VTb + (size_t)(16 * dt + i) * vstride + 32 * s2 + 8 * kg);
}
__device__ __forceinline__ float xmax4(float v) {
    auto a = __builtin_amdgcn_permlane16_swap(__float_as_uint(v), __float_as_uint(v), false, false); v = fmaxf(__uint_as_float(a[0]), __uint_as_float(a[1]));
    auto c = __builtin_amdgcn_permlane32_swap(__float_as_uint(v), __float_as_uint(v), false, false); return fmaxf(__uint_as_float(c[0]), __uint_as_float(c[1])); }
__device__ __forceinline__ float xsum4(float v) {
    auto a = __builtin_amdgcn_permlane16_swap(__float_as_uint(v), __float_as_uint(v), false, false); v = __uint_as_float(a[0]) + __uint_as_float(a[1]);
    auto c = __builtin_amdgcn_permlane32_swap(__float_as_uint(v), __float_as_uint(v), false, false); return __uint_as_float(c[0]) + __uint_as_float(c[1]); }
constexpr float ATT_C2 = 0.125f * 1.4426950408889634f;
template <bool MASKED, class MaskF>
__device__ __forceinline__ void att_scores(f32x4 (&s)[4], const KFrag& k, const h16x8 (&qf)[2], int kg, MaskF valid) {
#pragma unroll
    for (int tl = 0; tl < 4; ++tl) { f32x4 z = {0.f, 0.f, 0.f, 0.f}; z = __builtin_amdgcn_mfma_f32_16x16x32_f16(k.a[tl][0], qf[0], z, 0, 0, 0); s[tl] = __builtin_amdgcn_mfma_f32_16x16x32_f16(k.a[tl][1], qf[1], z, 0, 0, 0); }
    if (MASKED) {
#pragma unroll
        for (int tl = 0; tl < 4; ++tl)
#pragma unroll
            for (int r = 0; r < 4; ++r) { const int ko = 32 * (tl >> 1) + 8 * kg + 4 * (tl & 1) + r; s[tl][r] = valid(ko) ? s[tl][r] : -INFINITY; }
    }
}
__device__ __forceinline__ float att_rowmax(const f32x4 (&s)[4]) {
    float mx = fmaxf(fmaxf(s[0][0], s[0][1]), fmaxf(s[0][2], s[0][3]));
#pragma unroll
    for (int tl = 1; tl < 4; ++tl) mx = fmaxf(mx, fmaxf(fmaxf(s[tl][0], s[tl][1]), fmaxf(s[tl][2], s[tl][3])));
    return xmax4(mx);
}
__device__ __forceinline__ void att_pv(f32x4 (&o)[4], const f32x4 (&pv)[4], const VFrag& v) {
    h16x8 pf[2];
#pragma unroll
    for (int s2 = 0; s2 < 2; ++s2)
#pragma unroll
        for (int j = 0; j < 8; ++j) pf[s2][j] = (h16)pv[2 * s2 + (j >> 2)][j & 3];
#pragma unroll
    for (int dt = 0; dt < 4; ++dt)
#pragma unroll
        for (int s2 = 0; s2 < 2; ++s2) o[dt] = __builtin_amdgcn_mfma_f32_16x16x32_f16(v.a[dt][s2], pf[s2], o[dt], 0, 0, 0);
}
__device__ __forceinline__ void att_softmax_pv(AttSt& st, f32x4 (&s)[4], const VFrag& v, bool rowok) {
    const float mx = rowok ? att_rowmax(s) * ATT_C2 : -INFINITY;
    const float mn = fmaxf(st.m, mx);
    if (__any(mn > st.m)) { const float alpha = __builtin_amdgcn_exp2f(st.m - mn); st.m = mn; st.l *= alpha;
#pragma unroll
        for (int dt = 0; dt < 4; ++dt) st.o[dt] = st.o[dt] * alpha; }
    const float mneg = rowok ? -mn : -INFINITY;
    float ps0 = 0.f, ps1 = 0.f;
#pragma unroll
    for (int tl = 0; tl < 4; ++tl) {
#pragma unroll
        for (int r = 0; r < 4; ++r) s[tl][r] = __builtin_amdgcn_exp2f(__builtin_fmaf(s[tl][r], ATT_C2, mneg));
        ps0 += s[tl][0] + s[tl][1]; ps1 += s[tl][2] + s[tl][3]; }
    st.l += ps0 + ps1;
    att_pv(st.o, s, v);
}
template <bool MASKED, class MaskF>
__device__ __forceinline__ void att_tile(AttSt& st, const KFrag& k, const VFrag& v, const h16x8 (&qf)[2], int kg, bool rowok, MaskF valid) {
    f32x4 s[4]; att_scores<MASKED>(s, k, qf, kg, valid);
    att_softmax_pv(st, s, v, rowok);
}
constexpr int NSA_NSLOT = 6, NSA_RING = 0, NSA_IMP = NSA_NSLOT * 16384, NSA_MSK = 131072 + 256, NSA_LIST = NSA_MSK + 256;
__device__ __forceinline__ void ldk_lds(KFrag& k, LAS const unsigned char* slot, int ko0, int ko1) {
#pragma unroll
    for (int tl = 0; tl < 4; ++tl) { const int o = (32 * (tl >> 1) + 4 * (tl & 1)) * 128; k.a[tl][0] = *(LAS const h16x8*)(slot + o + ko0); k.a[tl][1] = *(LAS const h16x8*)(slot + o + ko1); }
}
__device__ __forceinline__ void ldv_lds(VFrag& v, LAS const unsigned char* slot, int vo0, int vo1) {
#pragma unroll
    for (int dt = 0; dt < 4; ++dt) { v.a[dt][0] = *(LAS const h16x8*)(slot + 8192 + dt * 2048 + vo0); v.a[dt][1] = *(LAS const h16x8*)(slot + 8192 + dt * 2048 + vo1); }
}
#define NSA_WAITV(n) asm volatile("s_waitcnt vmcnt(" #n ")" ::: "memory")
#define NSA_BAR() do { asm volatile("s_waitcnt lgkmcnt(0)" ::: "memory"); __builtin_amdgcn_s_barrier(); asm volatile("" ::: "memory"); } while (0)
template <int LPT, class IssueF, class CompF>
__device__ __forceinline__ void nsa_stream2(int n, LAS unsigned char* dmaw, LAS unsigned char* ring, IssueF issue, CompF comp2) {
#pragma unroll
    for (int j = 0; j < 4; ++j) if (j < n) issue(j, (LAS unsigned*)(dmaw + j * 16384));
    int sa = 0, si = 4 * 16384;
    for (int t2 = 0; t2 < n; t2 += 2) {
        const int rem = n - t2 - 2;
        if (rem >= 2) { if (LPT == 2) NSA_WAITV(4); else NSA_WAITV(2); } else if (rem == 1) { if (LPT == 2) NSA_WAITV(2); else NSA_WAITV(1); } else NSA_WAITV(0);
        NSA_BAR();
        if (t2 + 4 < n) issue(t2 + 4, (LAS unsigned*)(dmaw + si));
        if (t2 + 5 < n) issue(t2 + 5, (LAS unsigned*)(dmaw + si + 16384));
        comp2(t2, (LAS const unsigned char*)(ring + sa), t2 + 1 < n, (LAS const unsigned char*)(ring + sa + 16384));
        sa = (sa == 4 * 16384) ? 0 : sa + 2 * 16384; si = (si == 4 * 16384) ? 0 : si + 2 * 16384; }
    NSA_BAR();
}
__device__ __forceinline__ void att_merge(AttSt& a, const AttSt& b2) {
    const float mn = fmaxf(a.m, b2.m); const float fa = __builtin_amdgcn_exp2f(a.m - mn), fb = __builtin_amdgcn_exp2f(b2.m - mn);
    a.m = mn; a.l = a.l * fa + b2.l * fb;
#pragma unroll
    for (int dt = 0; dt < 4; ++dt) a.o[dt] = a.o[dt] * fa + b2.o[dt] * fb;
}
__device__ __forceinline__ void nsa_block_unit(const h16* __restrict__ h, const h16* __restrict__ nqr, const h16* __restrict__ kcmp, const h16* __restrict__ vcmpT, const h16* __restrict__ vsT, const h16* __restrict__ vwT,
                                               const h16* __restrict__ ksR, const h16* __restrict__ kwR, h16* __restrict__ mix, int b, int g, int T0, LAS unsigned char* lds, int wv, int lane) {
    const int i = lane & 15, kg = lane >> 4, tt = i & 3, hh = i >> 2;
    const int t0 = T0 + 4 * wv, trow = t0 + tt; const size_t mrow = (size_t)b * T + trow;
    const int q = wv * 64 + lane, qrow = q >> 3, qch = q & 7;
    const int ksrc = qrow * 128 + ((qch ^ (((qrow >> 1) & 1) | (((qrow >> 3) & 3) << 1))) << 4), vsrc = qrow * 128 + ((qch ^ ((qrow >> 1) & 7)) << 4);
    const int gki = ((i >> 1) & 1) | ((i >> 2) << 1), gvi = (i >> 1) & 7;
    const int ko0 = (8 * (i >> 2) + (i & 3)) * 128 + ((kg ^ gki) << 4), ko1 = (8 * (i >> 2) + (i & 3)) * 128 + (((kg + 4) ^ gki) << 4);
    const int vo0 = i * 128 + ((kg ^ gvi) << 4), vo1 = i * 128 + (((kg + 4) ^ gvi) << 4);
    LAS unsigned char* ring = lds + NSA_RING; LAS unsigned char* dmaw = ring + wv * 1024;
    LAS float* impA = (LAS float*)(lds + NSA_IMP + wv * 4096); LAS float* impL = impA + 512;
    h16x8 qf[2], qrf[2];
    { const h16* qp = h + mrow * INP + C_NQ + (g * 4 + hh) * 64 + 8 * kg; qf[0] = *(const h16x8*)qp; qf[1] = *(const h16x8*)(qp + 32);
      const h16* qrp = nqr + mrow * 512 + (g * 4 + hh) * 64 + 8 * kg; qrf[0] = *(const h16x8*)qrp; qrf[1] = *(const h16x8*)(qrp + 32); }
    const h16* gp = h + mrow * INP + C_NG + (g * 4 + hh) * 3; const float gt0 = (float)gp[0], gt1 = (float)gp[1], gt2 = (float)gp[2];
    for (int x = lane; x < 1024; x += 64) impA[x] = 0.f;
    NSA_WAITV(0);
#define GLDS16(gsrc, ldst) __builtin_amdgcn_global_load_lds((const unsigned*)(gsrc), (ldst), 16, 0, 0)
    const int ncv_row = trow >= 31 ? ((trow - 31) >> 4) + 1 : 0;
    const int ncv_blk = (T0 + 31 >= 31) ? ((T0 + 31 - 31) >> 4) + 1 : 0;
    const int ncv_min = T0 >= 31 ? ((T0 - 31) >> 4) + 1 : 0;
    const int nct = (ncv_blk + 63) >> 6;
    const unsigned char* Kc = (const unsigned char*)(kcmp + (size_t)(b * 2 + g) * 512 * 64); const unsigned char* Vc = (const unsigned char*)(vcmpT + (size_t)(b * 2 + g) * 8 * 4096);
    float m = -1e30f, l = 0.f;
    f32x4 oc[4];
    float linv = 0.f;
    REPS(501) {
    m = -1e30f; l = 0.f;
#pragma unroll
    for (int dt = 0; dt < 4; ++dt) oc[dt] = (f32x4){0.f, 0.f, 0.f, 0.f};
    float mB = -1e30f, lB = 0.f;
    auto cmp1 = [&](int j, LAS const unsigned char* slot, float& mm, float& ll) {
        KFrag kf; ldk_lds(kf, slot, ko0, ko1);
        f32x4 s[4];
        if (64 * j + 63 < ncv_min) att_scores<false>(s, kf, qf, kg, [&](int) { return true; }); else att_scores<true>(s, kf, qf, kg, [&](int ko) { return j * 64 + ko < ncv_row; });
        const float mx = att_rowmax(s) * ATT_C2;
        const float mn = fmaxf(mm, mx); float ps0 = 0.f, ps1 = 0.f;
        _Pragma("unroll") for (int tl = 0; tl < 4; ++tl) { ps0 += __builtin_amdgcn_exp2f(__builtin_fmaf(s[tl][0], ATT_C2, -mn)) + __builtin_amdgcn_exp2f(__builtin_fmaf(s[tl][1], ATT_C2, -mn));
                                                          ps1 += __builtin_amdgcn_exp2f(__builtin_fmaf(s[tl][2], ATT_C2, -mn)) + __builtin_amdgcn_exp2f(__builtin_fmaf(s[tl][3], ATT_C2, -mn)); }
        ll = ll * __builtin_amdgcn_exp2f(mm - mn) + (ps0 + ps1); mm = mn; };
    nsa_stream2<1>(nct, dmaw, ring, [&](int j, LAS unsigned* dk) { GLDS16(Kc + (size_t)j * 8192 + ksrc, dk); }, [&](int j, LAS const unsigned char* sA, bool hasB, LAS const unsigned char* sB) {
        cmp1(j, sA, m, l); __builtin_amdgcn_sched_barrier(0); if (hasB) cmp1(j + 1, sB, mB, lB); });
    { const float mn = fmaxf(m, mB); l = l * __builtin_amdgcn_exp2f(m - mn) + lB * __builtin_amdgcn_exp2f(mB - mn); m = mn; }
    l = xsum4(l);
    linv = l > 0.f ? 1.f / l : 0.f;
    auto cmp2 = [&](int j, LAS const unsigned char* slot) {
        KFrag kf; ldk_lds(kf, slot, ko0, ko1); VFrag vf; ldv_lds(vf, slot, vo0, vo1);
        f32x4 s[4];
        if (64 * j + 63 < ncv_min) att_scores<false>(s, kf, qf, kg, [&](int) { return true; }); else att_scores<true>(s, kf, qf, kg, [&](int ko) { return j * 64 + ko < ncv_row; });
        _Pragma("unroll") for (int tl = 0; tl < 4; ++tl) {
            _Pragma("unroll") for (int r = 0; r < 4; ++r) s[tl][r] = __builtin_amdgcn_exp2f(__builtin_fmaf(s[tl][r], ATT_C2, -m)) * linv;
            float A = (s[tl][0] + s[tl][1]) + (s[tl][2] + s[tl][3]), L = s[tl][3];
            A += __shfl_xor(A, 4); A += __shfl_xor(A, 8); L += __shfl_xor(L, 4); L += __shfl_xor(L, 8);
            if (hh == 0) { const int u = j * 16 + 8 * (tl >> 1) + 2 * kg + (tl & 1); impA[tt * 128 + u] = A; impL[tt * 128 + u] = L; } }
        att_pv(oc, s, vf); };
    nsa_stream2<2>(nct, dmaw, ring, [&](int j, LAS unsigned* dk) { GLDS16(Kc + (size_t)j * 8192 + ksrc, dk); GLDS16(Vc + (size_t)j * 8192 + vsrc, (LAS unsigned*)((LAS unsigned char*)dk + 8192)); },
        [&](int j, LAS const unsigned char* sA, bool hasB, LAS const unsigned char* sB) { cmp2(j, sA); if (hasB) cmp2(j + 1, sB); });
    }
    const int cur = T0 >> 6;
    AttSt sw;
    REPS(504) {
    sw.m = -1e30f; sw.l = 0.f;
#pragma unroll
    for (int dt = 0; dt < 4; ++dt) sw.o[dt] = (f32x4){0.f, 0.f, 0.f, 0.f};
    {
        const unsigned char* Kw = (const unsigned char*)(kwR + (size_t)((b * 2 + g) * 128) * 4096); const unsigned char* Vw = (const unsigned char*)(vwT + (size_t)((b * 2 + g) * 128) * 4096);
        const int s0w = (T0 >= 511 ? (T0 - 511) >> 6 : 0);
        AttSt swB; swB.m = -1e30f; swB.l = 0.f;
#pragma unroll
        for (int dt = 0; dt < 4; ++dt) swB.o[dt] = (f32x4){0.f, 0.f, 0.f, 0.f};
        auto wsc = [&](f32x4 (&s)[4], int j, LAS const unsigned char* slot) { KFrag kf; ldk_lds(kf, slot, ko0, ko1); const int sx = s0w + j;
            if (sx > s0w + 1 && sx < cur) att_scores<false>(s, kf, qrf, kg, [&](int) { return true; });
            else att_scores<true>(s, kf, qrf, kg, [&](int ko) { const int kp = 64 * sx + ko; return kp <= trow && kp >= trow - 511; }); };
        nsa_stream2<2>(cur - s0w + 1, dmaw, ring, [&](int j, LAS unsigned* dk) { GLDS16(Kw + (size_t)(s0w + j) * 8192 + ksrc, dk); GLDS16(Vw + (size_t)(s0w + j) * 8192 + vsrc, (LAS unsigned*)((LAS unsigned char*)dk + 8192)); },
            [&](int j, LAS const unsigned char* sA, bool hasB, LAS const unsigned char* sB) {
                if (hasB) { f32x4 s0[4], s1[4]; wsc(s0, j, sA); wsc(s1, j + 1, sB); __builtin_amdgcn_sched_barrier(0);
                    { VFrag vf; ldv_lds(vf, sA, vo0, vo1); att_softmax_pv(sw, s0, vf, true); } { VFrag vf; ldv_lds(vf, sB, vo0, vo1); att_softmax_pv(swB, s1, vf, true); } }
                else { f32x4 s0[4]; wsc(s0, j, sA); VFrag vf; ldv_lds(vf, sA, vo0, vo1); att_softmax_pv(sw, s0, vf, true); } });
        att_merge(sw, swB);
    }
    }
    unsigned long long mylo, myhi, anylo, anyhi;
    if (cur <= 15) { mylo = anylo = (1ull << (cur + 1)) - 1ull; myhi = anyhi = 0ull; }
    else {
        mylo = myhi = anylo = anyhi = 0ull;
        const unsigned long long flo = 1ull | (cur < 64 ? (1ull << cur) : 0ull) | (cur - 1 < 64 ? (1ull << (cur - 1)) : 0ull);
        const unsigned long long fhi = (cur >= 64 ? (1ull << (cur - 64)) : 0ull) | (cur - 1 >= 64 ? (1ull << (cur - 65)) : 0ull);
        const unsigned long long lmask = (1ull << lane) - 1ull;
        for (int tk = 0; tk < 4; ++tk) {
            const int s0 = lane, s1 = lane + 64;
            const float v0 = impA[tk * 128 + s0] + (s0 > 0 ? impL[tk * 128 + s0 - 1] : 0.f), v1 = impA[tk * 128 + s1] + impL[tk * 128 + s1 - 1];
            const unsigned b0 = (s0 >= 1 && s0 <= cur - 2) ? __float_as_uint(v0) + 1u : 0u, b1 = (s1 <= cur - 2) ? __float_as_uint(v1) + 1u : 0u;
            unsigned Tq = 0u;
            for (int bit = 30; bit >= 0; --bit) { const unsigned T2 = Tq | (1u << bit);
                const int c = __popcll(__ballot(b0 >= T2)) + __popcll(__ballot(b1 >= T2)); if (c >= 13) Tq = T2; }
            const unsigned long long gtlo = __ballot(b0 > Tq), gthi = __ballot(b1 > Tq), eqlo = __ballot(b0 == Tq), eqhi = __ballot(b1 == Tq);
            const int need = 13 - (__popcll(gtlo) + __popcll(gthi));
            const bool t0q = (b0 == Tq) && (__popcll(eqlo & lmask) < need), t1q = (b1 == Tq) && (__popcll(eqlo) + __popcll(eqhi & lmask) < need);
            const unsigned long long lo = gtlo | __ballot(t0q) | flo, hi = gthi | __ballot(t1q) | fhi;
            anylo |= lo; anyhi |= hi; if (tt == tk) { mylo = lo; myhi = hi; }
        }
    }
    LAS unsigned long long* msk = (LAS unsigned long long*)(lds + NSA_MSK); LAS unsigned char* lst = lds + NSA_LIST; LAS int* nlst = (LAS int*)(lds + NSA_LIST + 128);
    if (lane == 0) { msk[2 * wv] = anylo; msk[2 * wv + 1] = anyhi; }
    NSA_BAR();
    if (wv == 0) {
        unsigned long long ulo = 0ull, uhi = 0ull;
#pragma unroll
        for (int w2 = 0; w2 < 8; ++w2) { ulo |= msk[2 * w2]; uhi |= msk[2 * w2 + 1]; }
        const unsigned long long lmask = (1ull << lane) - 1ull; const int nlo = __popcll(ulo);
        if ((ulo >> lane) & 1ull) lst[__popcll(ulo & lmask)] = (unsigned char)lane;
        if ((uhi >> lane) & 1ull) lst[nlo + __popcll(uhi & lmask)] = (unsigned char)(64 + lane);
        if (lane == 0) nlst[0] = nlo + __popcll(uhi);
    }
    NSA_BAR();
    const int nsel = nlst[0];
    AttSt ss;
    REPS(503) {
    ss.m = -1e30f; ss.l = 0.f;
#pragma unroll
    for (int dt = 0; dt < 4; ++dt) ss.o[dt] = (f32x4){0.f, 0.f, 0.f, 0.f};
    {
        const unsigned char* Ks = (const unsigned char*)(ksR + (size_t)((b * 2 + g) * 128) * 4096); const unsigned char* Vs = (const unsigned char*)(vsT + (size_t)((b * 2 + g) * 128) * 4096);
        auto sel1 = [&](int s, LAS const unsigned char* slot, AttSt& st) {
            KFrag kf; ldk_lds(kf, slot, ko0, ko1); VFrag vf; ldv_lds(vf, slot, vo0, vo1);
            const bool mybit = (((s < 64 ? mylo : myhi) >> (s & 63)) & 1ull) != 0ull;
            if (s < cur) att_tile<false>(st, kf, vf, qrf, kg, mybit, [&](int) { return true; });
            else att_tile<true>(st, kf, vf, qrf, kg, mybit, [&](int ko) { return 64 * s + ko <= trow; }); };
        nsa_stream2<2>(nsel, dmaw, ring, [&](int j, LAS unsigned* dk) { const int sj = lst[j]; GLDS16(Ks + (size_t)sj * 8192 + ksrc, dk); GLDS16(Vs + (size_t)sj * 8192 + vsrc, (LAS unsigned*)((LAS unsigned char*)dk + 8192)); },
            [&](int j, LAS const unsigned char* sA, bool hasB, LAS const unsigned char* sB) {
                const int s0 = lst[j]; const int s1 = hasB ? (int)lst[j + 1] : 0;
                const bool nA = (((s0 < 64 ? anylo : anyhi) >> (s0 & 63)) & 1ull) != 0ull, nB = hasB && ((((s1 < 64 ? anylo : anyhi) >> (s1 & 63)) & 1ull) != 0ull);
                if (nA) sel1(s0, sA, ss);
                if (nB) sel1(s1, sB, ss); });
    }
    }
    const float ls = xsum4(ss.l), lw = xsum4(sw.l);
    const float g0 = sigmf(gt0), g1 = sigmf(gt1) / ls, g2 = sigmf(gt2) / lw;
#pragma unroll
    for (int dt = 0; dt < 4; ++dt) { const f32x4 o = oc[dt] * g0 + ss.o[dt] * g1 + sw.o[dt] * g2;
        *(h16x4*)(mix + mrow * D + 512 + (g * 4 + hh) * 64 + 16 * dt + 4 * kg) = __builtin_convertvector(o, h16x4); }
#undef GLDS16
}

__device__ __forceinline__ void b_ln(const float* __restrict__ in, const float* __restrict__ gam, const float* __restrict__ bet, float* __restrict__ o32, h16* __restrict__ o16) {
    const int lane = tidx() & 63;
    for (int row = blockIdx.x * 8 + (tidx() >> 6); row < M; row += gridDim.x * 8) {
        const f32x4* xr = (const f32x4*)(in + (size_t)row * D) + lane;
        f32x4 v[4]; float s = 0.f;
#pragma unroll
        for (int j = 0; j < 4; ++j) { v[j] = xr[64 * j]; s += (v[j][0] + v[j][1]) + (v[j][2] + v[j][3]); }
        const float mean = wave_sum(s) * (1.f / D); float s2 = 0.f;
#pragma unroll
        for (int j = 0; j < 4; ++j) { v[j] = v[j] - mean; s2 += (v[j][0] * v[j][0] + v[j][1] * v[j][1]) + (v[j][2] * v[j][2] + v[j][3] * v[j][3]); }
        const float rstd = rsqrtf(wave_sum(s2) * (1.f / D) + LN_EPS);
#pragma unroll
        for (int j = 0; j < 4; ++j) { const f32x4 gg = ((const f32x4*)gam)[lane + 64 * j], bb = ((const f32x4*)bet)[lane + 64 * j]; const f32x4 o = v[j] * rstd * gg + bb;
            ((f32x4*)(o32 + (size_t)row * D))[lane + 64 * j] = o;
            if (o16) ((h16x4*)(o16 + (size_t)row * D))[lane + 64 * j] = __builtin_convertvector(o, h16x4); }
    }
}

__device__ __forceinline__ void xattn_block(const h16* __restrict__ qx, const h16* __restrict__ kx, const h16* __restrict__ kvmVT, h16* __restrict__ ox, int G, int bid, LAS unsigned char* lds, int wv, int lane) {
    const int i = lane & 15, kg = lane >> 4;
    const int gki = ((i >> 1) & 1) | ((i >> 2) << 1), gvi = (i >> 1) & 7;
    const int ko0 = (8 * (i >> 2) + (i & 3)) * 512 + ((kg ^ gki) << 4), ko1 = (8 * (i >> 2) + (i & 3)) * 512 + (((kg + 4) ^ gki) << 4);
    const int vo0 = i * 128 + ((kg ^ gvi) << 4), vo1 = i * 128 + (((kg + 4) ^ gvi) << 4);
    const int t = wv * 64 + lane;
    int ksrc[4], vsrc[4];
#pragma unroll
    for (int pz = 0; pz < 4; ++pz) { const int q = pz * 512 + t;
        { const int row = q >> 5, cp = q & 31; const int gk = ((row >> 1) & 1) | (((row >> 3) & 3) << 1); ksrc[pz] = row * 512 + ((cp ^ gk) << 4); }
        { const int row = q >> 3, cp = q & 7; vsrc[pz] = row * 512 + ((cp ^ ((row >> 1) & 7)) << 4); } }
    const int nun = ((M / 128) * 4 - bid + G - 1) / G;
    const int ntile = nun * 4;
    auto issue = [&](int tix, int slot) { const int u = bid + G * (tix >> 2), grp = tix & 3; const int m0 = (u >> 2) * 128, hh = u & 3, b = m0 >> 13;
        const unsigned char* Kb = (const unsigned char*)(kx + ((size_t)(b * 4 + hh) * MEML + 64 * grp) * 256); const unsigned char* Vb = (const unsigned char*)(kvmVT + (size_t)((b * 4 + hh) * 256) * MEML + 64 * grp);
        LAS unsigned char* base = lds + slot * 65536 + wv * 1024;
#pragma unroll
        for (int pz = 0; pz < 4; ++pz) { __builtin_amdgcn_global_load_lds((const unsigned*)(Kb + ksrc[pz]), (LAS unsigned*)(base + pz * 8192), 16, 0, 0);
                                        __builtin_amdgcn_global_load_lds((const unsigned*)(Vb + vsrc[pz]), (LAS unsigned*)(base + 32768 + pz * 8192), 16, 0, 0); } };
    NSA_WAITV(0);
    if (ntile > 0) issue(0, 0);
    h16x8 qf[8]; f32x4 o[16]; float mrun = -1e30f, l = 0.f; size_t mrow = 0; int hh = 0;
    for (int tix = 0; tix < ntile; ++tix) {
        const int grp = tix & 3, slot = tix & 1;
        if (grp == 0) {
            const int u = bid + G * (tix >> 2); mrow = (size_t)((u >> 2) * 128 + wv * 16 + i); hh = u & 3;
#pragma unroll
            for (int ks = 0; ks < 8; ++ks) qf[ks] = *(const h16x8*)(qx + mrow * D + hh * 256 + 32 * ks + 8 * kg);
#pragma unroll
            for (int dt = 0; dt < 16; ++dt) o[dt] = (f32x4){0.f, 0.f, 0.f, 0.f};
            mrun = -1e30f; l = 0.f;
        }
        NSA_WAITV(0);
        NSA_BAR();
        if (tix + 1 < ntile) issue(tix + 1, slot ^ 1);
        LAS const unsigned char* sk = lds + slot * 65536; LAS const unsigned char* sv = sk + 32768;
        f32x4 s[4];
#pragma unroll
        for (int tl = 0; tl < 4; ++tl) { const int ro = (32 * (tl >> 1) + 4 * (tl & 1)) * 512; f32x4 acc = {0.f, 0.f, 0.f, 0.f};
#pragma unroll
            for (int ks = 0; ks < 8; ++ks) acc = __builtin_amdgcn_mfma_f32_16x16x32_f16(*(LAS const h16x8*)(sk + ro + 128 * (ks >> 1) + ((ks & 1) ? ko1 : ko0)), qf[ks], acc, 0, 0, 0);
            s[tl] = acc; }
        const float mx = att_rowmax(s) * (0.0625f * 1.4426950408889634f);
        const float mn = fmaxf(mrun, mx); const float alpha = __builtin_amdgcn_exp2f(mrun - mn); mrun = mn;
        float ps = 0.f; h16x8 pf[2];
#pragma unroll
        for (int tl = 0; tl < 4; ++tl)
#pragma unroll
            for (int r = 0; r < 4; ++r) { const float pe = __builtin_amdgcn_exp2f(__builtin_fmaf(s[tl][r], 0.0625f * 1.4426950408889634f, -mn)); ps += pe; pf[tl >> 1][4 * (tl & 1) + r] = (h16)pe; }
        l = l * alpha + ps;
#pragma unroll
        for (int dt = 0; dt < 16; ++dt) { f32x4 acc = o[dt] * alpha;
            acc = __builtin_amdgcn_mfma_f32_16x16x32_f16(*(LAS const h16x8*)(sv + dt * 2048 + vo0), pf[0], acc, 0, 0, 0);
            acc = __builtin_amdgcn_mfma_f32_16x16x32_f16(*(LAS const h16x8*)(sv + dt * 2048 + vo1), pf[1], acc, 0, 0, 0);
            o[dt] = acc; }
        if (grp == 3) { const float linv = 1.f / xsum4(l);
#pragma unroll
            for (int dt = 0; dt < 16; ++dt) { const f32x4 acc = o[dt] * linv; *(h16x4*)(ox + mrow * D + hh * 256 + 16 * dt + 4 * kg) = __builtin_convertvector(acc, h16x4); } }
    }
    NSA_WAITV(0);
    NSA_BAR();
}

__device__ __forceinline__ void route_token(float logit, int m, int lane, const float* __restrict__ rbias, int* __restrict__ tope, float* __restrict__ topw, int* __restrict__ hist) {
    const float score = 1.f / (1.f + expf(-logit)); const float biased = score + rbias[lane];
    float m1 = biased; m1 = fmaxf(m1, __shfl_xor(m1, 1)); m1 = fmaxf(m1, __shfl_xor(m1, 2)); m1 = fmaxf(m1, __shfl_xor(m1, 4));
    int am = (biased == m1) ? lane : 999; am = min(am, __shfl_xor(am, 1)); am = min(am, __shfl_xor(am, 2)); am = min(am, __shfl_xor(am, 4));
    float m2 = (lane == am) ? -INFINITY : biased; m2 = fmaxf(m2, __shfl_xor(m2, 1)); m2 = fmaxf(m2, __shfl_xor(m2, 2)); m2 = fmaxf(m2, __shfl_xor(m2, 4));
    const float gs = m1 + m2;
    int cnt = 0;
#pragma unroll
    for (int gq = 0; gq < 8; ++gq) { const float o = __shfl(gs, gq * 8); cnt += (o > gs) ? 1 : 0; }
    const float masked = (cnt <= 3) ? biased : NEGF;
    int rank = 0;
    for (int e2 = 0; e2 < 64; ++e2) { const float o = __shfl(masked, e2); rank += (o > masked || (o == masked && e2 < lane)) ? 1 : 0; }
    const bool selq = rank < 8;
    const float wsum = wave_sum(selq ? score : 0.f);
    if (selq) { tope[(size_t)m * 8 + rank] = lane; topw[(size_t)m * 8 + rank] = score / wsum * 2.5f; atomicAdd(hist + (m >> 13) * 65 + lane, 1); }
}
__device__ __forceinline__ void router_unit(const Params& p, const float* __restrict__ pre, h16* __restrict__ x2h, const h16* __restrict__ WrTh, const h16* __restrict__ WrTl, int* __restrict__ tope, float* __restrict__ topw,
                                            int* __restrict__ hist, int m0, LAS float* lg, int lane) {
    const int i = lane & 15, kg = lane >> 4;
    const float* xr = pre + (size_t)(m0 + i) * D + 8 * kg;
    float s1 = 0.f, s2 = 0.f;
#pragma unroll 4
    for (int ks = 0; ks < 32; ++ks) { const f32x4 x0 = *(const f32x4*)(xr + 32 * ks), x1 = *(const f32x4*)(xr + 32 * ks + 4);
        s1 += (x0[0] + x0[1]) + (x0[2] + x0[3]) + (x1[0] + x1[1]) + (x1[2] + x1[3]);
        s2 += (x0[0] * x0[0] + x0[1] * x0[1]) + (x0[2] * x0[2] + x0[3] * x0[3]) + (x1[0] * x1[0] + x1[1] * x1[1]) + (x1[2] * x1[2] + x1[3] * x1[3]); }
    s1 = xsum4(s1); s2 = xsum4(s2);
    const float mean = s1 * (1.f / D); const float rstd = rsqrtf(fmaxf(s2 * (1.f / D) - mean * mean, 0.f) + LN_EPS);
    f32x4 am_[4], ac_[4];
#pragma unroll
    for (int et = 0; et < 4; ++et) { am_[et] = (f32x4){0.f, 0.f, 0.f, 0.f}; ac_[et] = (f32x4){0.f, 0.f, 0.f, 0.f}; }
    h16* xo = x2h + (size_t)(m0 + i) * D + 8 * kg;
#pragma unroll 2
    for (int ks = 0; ks < 32; ++ks) {
        f32x4 x0 = *(const f32x4*)(xr + 32 * ks), x1 = *(const f32x4*)(xr + 32 * ks + 4);
        const f32x4 g0 = *(const f32x4*)(p.ln2g + 32 * ks + 8 * kg), g1 = *(const f32x4*)(p.ln2g + 32 * ks + 8 * kg + 4), b0 = *(const f32x4*)(p.ln2b + 32 * ks + 8 * kg), b1 = *(const f32x4*)(p.ln2b + 32 * ks + 8 * kg + 4);
        x0 = (x0 - mean) * rstd * g0 + b0; x1 = (x1 - mean) * rstd * g1 + b1;
        h16x8 xh, xl;
#pragma unroll
        for (int j = 0; j < 4; ++j) { xh[j] = (h16)x0[j]; xl[j] = (h16)((x0[j] - (float)xh[j]) * 2048.f); xh[4 + j] = (h16)x1[j]; xl[4 + j] = (h16)((x1[j] - (float)xh[4 + j]) * 2048.f); }
        *(h16x8*)(xo + 32 * ks) = xh;
#pragma unroll
        for (int et = 0; et < 4; ++et) { const h16x8 wh = *(const h16x8*)(WrTh + (size_t)(16 * et + i) * D + 32 * ks + 8 * kg), wl = *(const h16x8*)(WrTl + (size_t)(16 * et + i) * D + 32 * ks + 8 * kg);
            am_[et] = __builtin_amdgcn_mfma_f32_16x16x32_f16(wh, xh, am_[et], 0, 0, 0);
            ac_[et] = __builtin_amdgcn_mfma_f32_16x16x32_f16(wh, xl, ac_[et], 0, 0, 0);
            ac_[et] = __builtin_amdgcn_mfma_f32_16x16x32_f16(wl, xh, ac_[et], 0, 0, 0); }
    }
#pragma unroll
    for (int et = 0; et < 4; ++et)
#pragma unroll
        for (int r = 0; r < 4; ++r) lg[i * 64 + 16 * et + 4 * kg + r] = am_[et][r] + ac_[et][r] * (1.f / 2048.f);
    for (int tk = 0; tk < 16; ++tk) route_token(lg[tk * 64 + lane], m0 + tk, lane, p.rbias, tope, topw, hist);
}

__device__ __forceinline__ void b_moe(const Params& p, const float* __restrict__ x2, const int* __restrict__ tope, const float* __restrict__ topw, float* __restrict__ out, int m, float* sl, int tid) {
    float* xs = sl; float* hd = sl + 1024; float* red = sl + 1280;
    for (int i = tid; i < 1024; i += 256) xs[i] = x2[(size_t)m * D + i];
    __syncthreads();
    float acc[4] = {0.f, 0.f, 0.f, 0.f};
    for (int kx = 0; kx < 9; ++kx) {
        const float* G; const float* U; const float* Dn; float wt;
        if (kx < 8) { const int e = tope[(size_t)m * 8 + kx]; wt = topw[(size_t)m * 8 + kx]; G = p.w_gate + (size_t)e * D * EFF; U = p.w_up + (size_t)e * D * EFF; Dn = p.w_down + (size_t)e * EFF * D; }
        else { wt = 1.f; G = p.ws_gate; U = p.ws_up; Dn = p.ws_down; }
        float a = 0.f, u = 0.f;
        for (int k = 0; k < D; ++k) { const float xv = xs[k]; a += xv * G[(size_t)k * EFF + tid]; u += xv * U[(size_t)k * EFF + tid]; }
        hd[tid] = siluf(a) * u * wt;
        __syncthreads();
        for (int j = 0; j < EFF; ++j) { const float hv = hd[j]; const float* dr = Dn + (size_t)j * D + tid;
            acc[0] += hv * dr[0]; acc[1] += hv * dr[256]; acc[2] += hv * dr[512]; acc[3] += hv * dr[768]; }
        __syncthreads();
    }
    float v[4]; float s = 0.f;
#pragma unroll
    for (int i = 0; i < 4; ++i) { v[i] = DN_ALPHA * xs[tid + 256 * i] + acc[i]; s += v[i]; }
    s = wave_sum(s); if ((tid & 63) == 0) red[tid >> 6] = s; __syncthreads();
    const float mean = (red[0] + red[1] + red[2] + red[3]) * (1.f / D); float s2 = 0.f;
#pragma unroll
    for (int i = 0; i < 4; ++i) { v[i] -= mean; s2 += v[i] * v[i]; }
    s2 = wave_sum(s2); if ((tid & 63) == 0) red[4 + (tid >> 6)] = s2; __syncthreads();
    const float rstd = rsqrtf((red[4] + red[5] + red[6] + red[7]) * (1.f / D) + LN_EPS);
#pragma unroll
    for (int i = 0; i < 4; ++i) out[(size_t)m * D + tid + 256 * i] = v[i] * rstd * p.ln3g[tid + 256 * i] + p.ln3b[tid + 256 * i];
    __syncthreads();
}

struct G1Sched {
    const int* ctl; const char* x2h; const unsigned* rowoff; const char* WguT; int G, c;
    __device__ bool next(int i, pg8::Unit& u) const {
        const int ntile = ctl[CTL_TQS + NQ]; const long L = (long)i * G + c; if (L >= 2L * ntile) return false;
        const int tile = (int)(L >> 1), pn = (int)(L & 1); const int e = ctl[CTL_TVE + tile] % 65;
        u.pm = tile; u.pn = pn; u.A = x2h; u.gat = rowoff + (size_t)tile * 256; u.B = WguT + ((size_t)e * 512 + pn * 256) * (D * 2); return true; }
};
struct G2Sched {
    const int* ctl; const char* H; const char* WdT; int q, G, c;
    __device__ bool next(int i, pg8::Unit& u) const {
        const int t0 = ctl[CTL_TQS + q], t1 = ctl[CTL_TQS + q + 1]; const long L = (long)i * G + c; if (L >= 4L * (t1 - t0)) return false;
        const int tile = t0 + (int)(L >> 2), pn = (int)(L & 3); const int e = ctl[CTL_TVE + tile] % 65;
        u.pm = tile; u.pn = pn; u.A = H + (size_t)tile * 256 * (EFF * 2); u.gat = nullptr; u.B = WdT + ((size_t)e * D + pn * 256) * (EFF * 2); return true; }
};
__device__ __forceinline__ void b_scatter(int* __restrict__ ctl, const int* __restrict__ tope, const float* __restrict__ topw, unsigned* __restrict__ rowoff, u32x2* __restrict__ rowmeta, int* sl) {
    int* pst = sl;
    int* pc = sl + 512;
    for (int v = tidx(); v < NVE; v += NTHR) pc[v] = (ctl[CTL_CNT + v] + 255) & ~255;
    __syncthreads();
    for (int v = tidx(); v <= NVE; v += NTHR) { int acc = 0; for (int u = 0; u < v; ++u) acc += pc[u]; pst[v] = acc; }
    __syncthreads();
    if (blockIdx.x == 0) {
        for (int v = tidx(); v <= NVE; v += NTHR) ctl[CTL_PST + v] = pst[v];
        if (tidx() <= NQ) ctl[CTL_TQS + tidx()] = pst[tidx() * 65] >> 8;
        for (int v = tidx(); v < NVE; v += NTHR) for (int tl = pst[v] >> 8; tl < (pst[v + 1] >> 8); ++tl) ctl[CTL_TVE + tl] = v;
    }
    for (int idx = blockIdx.x * NTHR + tidx(); idx < M * 9; idx += gridDim.x * NTHR) {
        int m, k, pos; float w;
        if (idx < M * 8) { m = idx >> 3; k = idx & 7; const int ve = (m >> 13) * 65 + tope[idx]; w = topw[idx]; pos = pst[ve] + atomicAdd(ctl + CTL_CUR + ve, 1); }
        else { m = idx - M * 8; k = 8; w = 1.f; pos = pst[(m >> 13) * 65 + 64] + (m & (QT - 1)); }
        rowoff[pos] = (unsigned)m * (D * 2); rowmeta[pos] = (u32x2){(unsigned)((m & (QT - 1)) * 9 + k), __float_as_uint(w)};
    }
    __syncthreads();
}
__device__ __forceinline__ void b_combine(const Params& p, const h16* __restrict__ x2h, const h16* __restrict__ Y, int q) {
    const int lane = tidx() & 63;
    for (int r = blockIdx.x * 8 + (tidx() >> 6); r < QT; r += gridDim.x * 8) {
        const int m = q * QT + r;
        float v[16];
        { const h16x8 a = ((const h16x8*)(x2h + (size_t)m * D))[lane], b = ((const h16x8*)(x2h + (size_t)m * D))[lane + 64];
#pragma unroll
          for (int i = 0; i < 8; ++i) { v[i] = DN_ALPHA * (float)a[i]; v[8 + i] = DN_ALPHA * (float)b[i]; } }
#pragma unroll
        for (int k = 0; k < 9; ++k) { const h16x8* yr = (const h16x8*)(Y + ((size_t)r * 9 + k) * D); const h16x8 a = yr[lane], b = yr[lane + 64];
#pragma unroll
            for (int i = 0; i < 8; ++i) { v[i] += (float)a[i]; v[8 + i] += (float)b[i]; } }
        float s = 0.f;
#pragma unroll
        for (int i = 0; i < 16; ++i) s += v[i];
        const float mean = wave_sum(s) * (1.f / D); float s2 = 0.f;
#pragma unroll
        for (int i = 0; i < 16; ++i) { v[i] -= mean; s2 += v[i] * v[i]; }
        const float rstd = rsqrtf(wave_sum(s2) * (1.f / D) + LN_EPS);
#pragma unroll
        for (int hlf = 0; hlf < 2; ++hlf) { const int c0 = (lane + 64 * hlf) * 8;
            const f32x4 g0 = *(const f32x4*)(p.ln3g + c0), g1 = *(const f32x4*)(p.ln3g + c0 + 4), b0 = *(const f32x4*)(p.ln3b + c0), b1 = *(const f32x4*)(p.ln3b + c0 + 4);
            f32x4 o0, o1;
#pragma unroll
            for (int i = 0; i < 4; ++i) { o0[i] = v[8 * hlf + i] * rstd * g0[i] + b0[i]; o1[i] = v[8 * hlf + 4 + i] * rstd * g1[i] + b1[i]; }
            *(f32x4*)(p.out + (size_t)m * D + c0) = o0; *(f32x4*)(p.out + (size_t)m * D + c0 + 4) = o1; }
    }
}

#define XB_TMO      128
#define XB_XCNT(j)  (256  + 64 * (j))
#define XB_XSUB(j)  (1280 + 64 * (j))
#define XB_XGEN(j)  (2304 + 64 * (j))
#define XB_TOP      3328
#define XB_TOPGEN   3392
#define XCD_BAR_WORDS 3456
#define XB_SPIN_CAP (1u << 22)
__device__ __forceinline__ unsigned xb_ld(unsigned* p)              { return __hip_atomic_load(p, __ATOMIC_RELAXED, __HIP_MEMORY_SCOPE_AGENT); }
__device__ __forceinline__ unsigned xb_add(unsigned* p, unsigned v) { return __hip_atomic_fetch_add(p, v, __ATOMIC_RELAXED, __HIP_MEMORY_SCOPE_AGENT); }
__device__ __forceinline__ unsigned xb_xcc_id() { return (unsigned)__builtin_amdgcn_s_getreg((3 << 11) | 20) & 0xFu; }
#define XB_SPIN(cond, bar) do { unsigned _sp = 0; while (cond) { __builtin_amdgcn_s_sleep(1); \
    if ((++_sp & 255u) == 0u) { if (xb_ld(&(bar)[XB_TMO])) break; if (_sp > XB_SPIN_CAP) { atomicAdd(&(bar)[XB_TMO], 1u); break; } } } } while (0)
struct XcdBarrier { unsigned* bar; unsigned x; volatile LAS unsigned* st; };
__device__ __forceinline__ XcdBarrier xcd_barrier_post(unsigned* bar, volatile LAS unsigned* st) {
    XcdBarrier b; b.bar = bar; b.x = xb_xcc_id(); b.st = st;
    if (threadIdx.x == 0) (void)xb_add(&bar[XB_XCNT(b.x)], 1u);
    return b;
}
__device__ __forceinline__ void xcd_barrier_complete(unsigned* bar, unsigned x, unsigned& nloc, unsigned& nx) {
    const unsigned G = gridDim.x * gridDim.y * gridDim.z;
    unsigned sum, cnt, mine, sp = 0u;
    for (;;) {
        sum = 0u; cnt = 0u; mine = 0u;
#pragma unroll
        for (unsigned j = 0; j < 16; ++j) { const unsigned c = xb_ld(&bar[XB_XCNT(j)]); sum += c; cnt += (c > 0u) ? 1u : 0u; mine = (j == x) ? c : mine; }
        if (sum == G) break;
        __builtin_amdgcn_s_sleep(1);
        if ((++sp & 255u) == 0u) { if (xb_ld(&bar[XB_TMO])) break; if (sp > XB_SPIN_CAP) { atomicAdd(&bar[XB_TMO], 1u); break; } }
    }
    nloc = mine > 0u ? mine : 1u; nx = cnt > 0u ? cnt : 1u;
}
__device__ __forceinline__ void xcd_barrier(const XcdBarrier& b) {
    asm volatile("s_waitcnt vmcnt(0)" ::: "memory");
    __syncthreads();
    if (threadIdx.x == 0) {
        unsigned* bar = b.bar;
        __builtin_amdgcn_s_waitcnt(0);
        unsigned nloc = b.st[0], nx = b.st[1];
        if (nloc == 0u) { xcd_barrier_complete(bar, b.x, nloc, nx); b.st[0] = nloc; b.st[1] = nx; }
        const unsigned old = xb_add(&bar[XB_XSUB(b.x)], 1u);
        const unsigned gen = old / nloc;
        if (old + 1u == (gen + 1u) * nloc) {
            __builtin_amdgcn_fence(__ATOMIC_RELEASE, "agent");
            asm volatile("s_waitcnt vmcnt(0)" ::: "memory");
            const unsigned og = xb_add(&bar[XB_TOP], 1u);
            const unsigned tg = og / nx;
            if (og + 1u == (tg + 1u) * nx) xb_add(&bar[XB_TOPGEN], 1u);
            else XB_SPIN(xb_ld(&bar[XB_TOPGEN]) == tg, bar);
            __builtin_amdgcn_fence(__ATOMIC_ACQUIRE, "agent");
            xb_add(&bar[XB_XGEN(b.x)], 1u);
            asm volatile("s_waitcnt vmcnt(0)" ::: "memory");
        } else {
            XB_SPIN(xb_ld(&bar[XB_XGEN(b.x)]) == gen, bar);
            __builtin_amdgcn_fence(__ATOMIC_ACQUIRE, "agent");
            asm volatile("s_waitcnt vmcnt(0)" ::: "memory");
        }
    }
    __syncthreads();
}

constexpr int N_PHASES = 23;

__global__ void __launch_bounds__(NTHR, 2) mega_fwd(Params p) {
    extern __shared__ __attribute__((aligned(16))) unsigned char lds[];
    cg::grid_group grid = cg::this_grid();
    const int G = (int)gridDim.x, bid = (int)blockIdx.x;
#define tid tidx()
    unsigned char* ws = p.ws;
    h16* WinT = (h16*)(ws + WS_WIN); h16* WoutT = (h16*)(ws + WS_WOUT); h16* WxqT = (h16*)(ws + WS_WXQ); h16* WxoT = (h16*)(ws + WS_WXO); h16* WxkvT = (h16*)(ws + WS_WXKV);
    h16* memh = (h16*)(ws + WS_MEMH); h16* kvm = (h16*)(ws + WS_KVM); h16* kcmp = (h16*)(ws + WS_KCMP); h16* vcmpT = (h16*)(ws + WS_VCMP); h16* vsT = (h16*)(ws + WS_VST); h16* vwT = (h16*)(ws + WS_VWT);
    int* tope = (int*)(ws + WS_TOPE); float* topw = (float*)(ws + WS_TOPW);
    h16* xh = (h16*)(ws + WS_XH); h16* mix = (h16*)(ws + WS_MIX); h16* ox = (h16*)(ws + WS_OX); h16* hb = (h16*)(ws + WS_H); h16* nqr = (h16*)(ws + WS_NQR);
    float* kvb = (float*)(ws + WS_KVB); h16* prevT = (h16*)(ws + WS_PREVT);
    float* cosr = (float*)(ws + WS_COSR); float* sinr = (float*)(ws + WS_SINR); float* cosn = (float*)(ws + WS_COSN); float* sinn = (float*)(ws + WS_SINN); h16* kvmVT = (h16*)(ws + WS_KVMVT); h16* WrTh = (h16*)(ws + WS_WRTH); h16* WrTl = (h16*)(ws + WS_WRTL); h16* Wc1T = (h16*)(ws + WS_WC1T); h16* hid = (h16*)(ws + WS_HID); unsigned* cmpoff = (unsigned*)(ws + WS_CMPOFF); float* peb = (float*)(ws + WS_PEB); h16* ksR = (h16*)(ws + WS_KSR); h16* kwR = (h16*)(ws + WS_KWR); h16* kx = (h16*)(ws + WS_KX);
    h16* rqr = (h16*)((unsigned char*)p.out + DO_RQR); h16* rkr = (h16*)((unsigned char*)p.out + DO_RKR); h16* rkzT = (h16*)((unsigned char*)p.out + DO_RKZT); h16* rvT = (h16*)((unsigned char*)p.out + DO_RVT); float* pre = p.out; float* x1 = (float*)(ws + WS_X1); h16* x1h = (h16*)(ws + WS_X1H);
    h16* qx = (h16*)(ws + WS_QX); float* x2 = (float*)(ws + WS_X2); h16* x2h = (h16*)(ws + WS_X2H);
    int* ctl = (int*)ws; unsigned* rowoff = (unsigned*)(ws + WS_ROWOFF); u32x2* rowmeta = (u32x2*)(ws + WS_ROWMETA);
    h16* WguT = (h16*)(ws + WS_WGUT); h16* WdT = (h16*)(ws + WS_WDT); h16* Hm = (h16*)(ws + WS_HM); h16* Yq = (h16*)(ws + WS_Y);
    float* fl = (float*)lds;
    const int lo = p.ph_lo, hi = p.ph_hi;
#define IN(k) (lo <= (k) && (k) < hi)
    { volatile LAS unsigned* st = (volatile LAS unsigned*)((LAS unsigned char*)lds + 131072); if (threadIdx.x < 2) st[threadIdx.x] = 0u; }
    __syncthreads();
    XcdBarrier xbar = xcd_barrier_post((unsigned*)(ws + WS_BAR), (volatile LAS unsigned*)((LAS unsigned char*)lds + 131072));
#define SEAM(k) do { if (IN(k) && IN((k) + 1)) { if ((k) == 0) grid.sync(); else xcd_barrier(xbar); } } while (0)

    if (IN(0)) REPS(0) {
        { const int sub = tid >> 8, lt = tid & 255; float* tl = fl + sub * 1088;
          constexpr int T0 = (INP / 32) * (D / 32);
          for (int b0 = bid * 2; b0 < T0; b0 += G * 2) b_transpose_tile(p.w_in, D, INC, WinT, INP, b0 + sub, tl, lt); }
        { const int wv = __builtin_amdgcn_readfirstlane(tid >> 6), lane = tid & 63; LAS float* scr = (LAS float*)((LAS unsigned char*)lds + wv * 8704);
          constexpr int I1 = (D / 64) * (D / 32), I4 = (D / 64) * (2 * D / 32), I5 = (2048 / 64) * (256 / 32), IT = 3 * I1 + I4 + 2 * I5;
          for (int it0 = bid * 8 + wv; it0 < IT; it0 += G * 8) { int it = it0;
            if (it < I1) { w_transpose_item(p.w_out, D, D, WoutT, it, scr, lane); continue; } it -= I1;
            if (it < I1) { w_transpose_item(p.w_xq, D, D, WxqT, it, scr, lane); continue; } it -= I1;
            if (it < I1) { w_transpose_item(p.w_xo, D, D, WxoT, it, scr, lane); continue; } it -= I1;
            if (it < I4) { w_transpose_item(p.w_xkv, D, 2 * D, WxkvT, it, scr, lane); continue; } it -= I4;
            if (it < I5) { w_transpose_item(p.w1k, 2048, 256, Wc1T, it, scr, lane); continue; } it -= I5;
            w_transpose_item(p.w1v, 2048, 256, Wc1T + 256 * 2048, it, scr, lane); } }
        __syncthreads();
        b_cvt(p.x, xh, (size_t)M * D / 4);
        b_cvt(p.mem, memh, (size_t)NB * MEML * D / 4);
        if (bid == 0) for (int i = tid; i < 1024; i += NTHR) ctl[i] = 0;
        b_tables(p.positions, cosr, sinr, cosn, sinn);
        for (int idx = bid * NTHR + tid; idx < NE * D; idx += G * NTHR) { const int e = idx >> 10, k = idx & 1023; const float w = p.w_router[k * NE + e]; const h16 hi = (h16)w; WrTh[idx] = hi; WrTl[idx] = (h16)((w - (float)hi) * 2048.f); }
        for (int r = bid * NTHR + tid; r < 4096; r += G * NTHR) { const int g = r & 1, c = min((r >> 1) & 511, 510), b = r >> 10; cmpoff[r] = (unsigned)(((size_t)(b * T + 16 * c) * INP + g * 64) * 2); }
        { const int lane = tid & 63;
          for (int o = bid * 8 + (tid >> 6); o < 512; o += G * 8) { const int kv = o >> 8, j = o & 255; const float* pe = kv ? p.pe_v : p.pe_k; const float* w1 = kv ? p.w1v : p.w1k; float a = 0.f;
              for (int k = lane; k < 2048; k += 64) a += pe[k] * w1[(size_t)k * 256 + j];
              a = wave_sum(a); if (lane == 0) peb[o] = a; } }
    }
    SEAM(0);
    if (IN(1)) {
        REPS(1) { pg8::Gemm g{xh, WinT, M, INP, D}; pg8::StaticOrder S; S.init(g, G, bid); pg8::EpiF16 E{hb, INP};
          pg8::gemm_phase<pg8::EpiF16, pg8::StaticOrder>((PG8_LAS unsigned char*)lds, g.K, S, E); }
    }
    SEAM(1);
    if (IN(2)) REPS(2) {
        if (bid < 32) { CmpSched S{(const char*)hb, cmpoff, (const char*)Wc1T, bid}; pg8::EpiCmp1 E{hid, peb + (bid >> 4) * 256};
            pg8::gemm_phase<pg8::EpiCmp1, CmpSched>((PG8_LAS unsigned char*)lds, 2048, S, E, (size_t)INP * 2);
            pg8::Gemm g{memh, WxkvT, NB * MEML, 2 * D, D}; pg8::StaticOrder S2; S2.init(g, 32, bid); pg8::EpiF16 E2{kvm, 2 * D};
            pg8::gemm_phase<pg8::EpiF16, pg8::StaticOrder>((PG8_LAS unsigned char*)lds, g.K, S2, E2); }
        else { const int sub = tid >> 8, lt = tid & 255; const int b2 = bid - 32, G2 = G - 32;
        for (int b0 = b2 * 8; b0 < M; b0 += G2 * 8) {
#pragma unroll
            for (int r4 = 0; r4 < 4; ++r4) b_rope(hb, rqr, rkr, nqr, ksR, kwR, cosr, sinr, cosn, sinn, b0 + sub * 4 + r4, lt); }
        { const int wv = __builtin_amdgcn_readfirstlane(tid >> 6), lane = tid & 63; LAS h16* wsl = (LAS h16*)((LAS unsigned char*)lds + wv * 8704);
          for (int it = b2 * 8 + wv; it < 2 * NB * 2 * 128; it += G2 * 8) b_vtrans(hb, vsT, vwT, it, wsl, lane);
          for (int it = b2 * 8 + wv; it < NB * 4 * 256; it += G2 * 8) b_rtrans(p, hb, rvT, rkzT, cosr, sinr, it, wsl, lane); }
        } }
    SEAM(2);
    if (IN(3)) {
        REPS(30) b_cmp2(p, hid, kcmp, vcmpT);
        { const int sub = tid >> 8, lt = tid & 255;
          for (int b0 = bid * 2; b0 < NB * 4 * 16; b0 += G * 2) b_mvtrans(kvm, kvmVT, kx, b0 + sub, (h16*)(fl + sub * 2304), lt); }
        const int wv = __builtin_amdgcn_readfirstlane(tid >> 6), lane = tid & 63;
        REPS(31) for (int ch = bid; ch < NB * 4 * 64; ch += G) ret_kv_unit(rkzT, rvT, kvb, ch, wv, lane); }
    SEAM(3);
    if (IN(4)) {
        REPS(4) b_ret_scan(p, kvb, prevT);
        const int wv = __builtin_amdgcn_readfirstlane(tid >> 6), lane = tid & 63;
        __syncthreads();
        REPS(50) { const int bg = bid & 7;
            for (int k = bid >> 3; k < T / 32; k += (G >> 3)) nsa_block_unit(hb, nqr, kcmp, vcmpT, vsT, vwT, ksR, kwR, mix, bg >> 1, bg & 1, (T / 32 - 1 - k) * 32, (LAS unsigned char*)lds, wv, lane); }
    }
    SEAM(4);
    if (IN(5)) {
        const int wv = __builtin_amdgcn_readfirstlane(tid >> 6), lane = tid & 63;
        REPS(51) for (int ch = bid; ch < NB * 4 * 64; ch += G) ret_out_unit(p, hb, rqr, rkr, rvT, prevT, mix, ch, wv, lane);
    }
    SEAM(5);
    if (IN(6)) { pg8::Gemm g{mix, WoutT, M, D, D}; pg8::StaticOrder S; S.init(g, G, bid); pg8::EpiResF32 E{pre, p.x, D, DN_ALPHA};
        pg8::gemm_phase<pg8::EpiResF32, pg8::StaticOrder>((PG8_LAS unsigned char*)lds, g.K, S, E); }
    SEAM(6);
    if (PROBE_DBL == 900) { for (int k = 0; k < 20; ++k) xcd_barrier(xbar); }
    if (IN(7)) REPS(7) b_ln(pre, p.ln1g, p.ln1b, x1, x1h);
    SEAM(7);
    if (IN(8)) { pg8::Gemm g{x1h, WxqT, M, D, D}; pg8::StaticOrder S; S.init(g, G, bid); pg8::EpiF16 E{qx, D};
        pg8::gemm_phase<pg8::EpiF16, pg8::StaticOrder>((PG8_LAS unsigned char*)lds, g.K, S, E); }
    SEAM(8);
    if (IN(9)) { const int wv = __builtin_amdgcn_readfirstlane(tid >> 6), lane = tid & 63;
        REPS(9) xattn_block(qx, kx, kvmVT, ox, G, bid, (LAS unsigned char*)lds, wv, lane); }
    SEAM(9);
    if (IN(10)) { pg8::Gemm g{ox, WxoT, M, D, D}; pg8::StaticOrder S; S.init(g, G, bid); pg8::EpiResF32 E{pre, x1, D, DN_ALPHA};
        pg8::gemm_phase<pg8::EpiResF32, pg8::StaticOrder>((PG8_LAS unsigned char*)lds, g.K, S, E); }
    if (IN(10) && IN(12)) xcd_barrier(xbar);
    if (IN(12)) {
        { const int wv = __builtin_amdgcn_readfirstlane(tid >> 6), lane = tid & 63; LAS float* lg = (LAS float*)((LAS unsigned char*)lds + wv * 4096);
          for (int u = bid * 8 + wv; u < M / 16; u += G * 8) router_unit(p, pre, x2h, WrTh, WrTl, tope, topw, ctl + CTL_CNT, u * 16, lg, lane); }
        __syncthreads();
        if (bid == 0 && tid < NQ) ctl[CTL_CNT + tid * 65 + 64] = QT;
        for (int i = bid * NTHR + tid; i < CAP; i += G * NTHR) { rowoff[i] = 0u; rowmeta[i] = (u32x2){0xffffffffu, 0u}; }
        { const int wv = __builtin_amdgcn_readfirstlane(tid >> 6), lane = tid & 63; LAS float* scr = (LAS float*)((LAS unsigned char*)lds + wv * 8704);
          REPS(121) for (int it = bid * 8 + wv; it < 65 * 384; it += G * 8) { const int e = it / 384, r = it % 384;
            const float* wg = e < 64 ? p.w_gate + (size_t)e * D * EFF : p.ws_gate; const float* wu = e < 64 ? p.w_up + (size_t)e * D * EFF : p.ws_up; const float* wd = e < 64 ? p.w_down + (size_t)e * EFF * D : p.ws_down;
            if (r < 128) w_transpose_item(wg, D, EFF, WguT + (size_t)e * 512 * D, r, scr, lane, 2, 0);
            else if (r < 256) w_transpose_item(wu, D, EFF, WguT + (size_t)e * 512 * D, r - 128, scr, lane, 2, 1);
            else w_transpose_item(wd, EFF, D, WdT + (size_t)e * D * EFF, r - 256, scr, lane); } }
    }
    SEAM(12);
    if (IN(13)) b_scatter(ctl, tope, topw, rowoff, rowmeta, (int*)lds);
    SEAM(13);
    if (IN(14)) REPS(14) { G1Sched S{ctl, (const char*)x2h, rowoff, (const char*)WguT, G, bid}; pg8::EpiGateUp E{Hm};
        pg8::gemm_phase<pg8::EpiGateUp, G1Sched>((PG8_LAS unsigned char*)lds, D, S, E); }
    SEAM(14);
#pragma unroll 1
    for (int q = 0; q < NQ; ++q) {
        if (IN(15 + 2 * q)) REPS(15) { G2Sched S{ctl, (const char*)Hm, (const char*)WdT, q, G, bid}; pg8::EpiDown E{Yq, rowmeta};
            pg8::gemm_phase<pg8::EpiDown, G2Sched>((PG8_LAS unsigned char*)lds, EFF, S, E); }
        SEAM(15 + 2 * q);
        if (IN(16 + 2 * q)) REPS(16) b_combine(p, x2h, Yq, q);
        if (q < NQ - 1) SEAM(16 + 2 * q);
    }
#undef IN
#undef SEAM
#undef tid
}

#ifndef MK_PER_PHASE
#define MK_PER_PHASE 0
#endif
extern "C" void kernel_launch(void* const* d_in, const int* in_sizes, int n_in, void* d_out, int out_size, void* d_ws, size_t ws_size, hipStream_t stream) {
    static int grid = 0;
    if (grid == 0) {
        if (n_in != 28 || in_sizes[0] != M * D || out_size != M * D || ws_size < WS_NEED) { fprintf(stderr, "kernel_launch: unexpected shapes (n_in %d, in0 %d, out %d, ws %zu)\n", n_in, n_in > 0 ? in_sizes[0] : -1, out_size, ws_size); grid = -1; return; }
        if (hipFuncSetAttribute((const void*)mega_fwd, hipFuncAttributeMaxDynamicSharedMemorySize, LDS_BYTES) != hipSuccess) { fprintf(stderr, "kernel_launch: hipFuncSetAttribute failed\n"); grid = -1; return; }
        int dev = 0, cus = 0, per_cu = 0;
        hipGetDevice(&dev); hipDeviceGetAttribute(&cus, hipDeviceAttributeMultiprocessorCount, dev);
        if (hipOccupancyMaxActiveBlocksPerMultiprocessor(&per_cu, (const void*)mega_fwd, NTHR, LDS_BYTES) != hipSuccess || per_cu < 1) { fprintf(stderr, "kernel_launch: occupancy query failed (%d)\n", per_cu); grid = -1; return; }
        grid = cus;
    }
    if (grid < 0) return;
    Params p{};
    p.x = (const float*)d_in[0]; p.mem = (const float*)d_in[1]; p.positions = (const int*)d_in[2];
    p.w_in = (const float*)d_in[3]; p.pe_k = (const float*)d_in[4]; p.pe_v = (const float*)d_in[5];
    p.w1k = (const float*)d_in[6]; p.w2k = (const float*)d_in[7]; p.w1v = (const float*)d_in[8]; p.w2v = (const float*)d_in[9];
    p.w_out = (const float*)d_in[10]; p.ln1g = (const float*)d_in[11]; p.ln1b = (const float*)d_in[12];
    p.w_xq = (const float*)d_in[13]; p.w_xkv = (const float*)d_in[14]; p.w_xo = (const float*)d_in[15];
    p.ln2g = (const float*)d_in[16]; p.ln2b = (const float*)d_in[17]; p.w_router = (const float*)d_in[18]; p.rbias = (const float*)d_in[19];
    p.w_gate = (const float*)d_in[20]; p.w_up = (const float*)d_in[21]; p.w_down = (const float*)d_in[22];
    p.ws_gate = (const float*)d_in[23]; p.ws_up = (const float*)d_in[24]; p.ws_down = (const float*)d_in[25];
    p.ln3g = (const float*)d_in[26]; p.ln3b = (const float*)d_in[27];
    p.out = (float*)d_out; p.ws = (unsigned char*)d_ws;
    for (int i = 0; i < 4; ++i) p.lg[i] = (float)std::log(1.0 - std::pow(2.0, -5.0 - (double)i));
#if MK_PER_PHASE
    for (int ph = 0; ph < N_PHASES; ++ph) { p.ph_lo = ph; p.ph_hi = ph + 1; hipLaunchKernelGGL(mega_fwd, dim3(grid), dim3(NTHR), LDS_BYTES, stream, p); }
#else
    p.ph_lo = 0; p.ph_hi = N_PHASES;
    if (hipMemsetAsync((char*)d_ws + WS_BAR, 0, XCD_BAR_WORDS * 4, stream) != hipSuccess) { fprintf(stderr, "kernel_launch: memset failed\n"); return; }
    void* args[] = {&p};
    hipError_t e = hipLaunchCooperativeKernel((const void*)mega_fwd, dim3(grid), dim3(NTHR), args, LDS_BYTES, stream);
    if (e != hipSuccess) fprintf(stderr, "kernel_launch: cooperative launch failed: %s (grid %d)\n", hipGetErrorString(e), grid);
#endif
}
```

```cpp
#include <hip/hip_runtime.h>
#include <cstdio>
#include <cstdint>
#include <cmath>

typedef _Float16 h16;
typedef _Float16 h16x8 __attribute__((ext_vector_type(8)));
typedef _Float16 h16x2 __attribute__((ext_vector_type(2)));
typedef _Float16 h16x4 __attribute__((ext_vector_type(4)));
typedef float f32x2 __attribute__((ext_vector_type(2)));
typedef float f32x4 __attribute__((ext_vector_type(4)));
typedef unsigned u32x4 __attribute__((ext_vector_type(4)));
typedef unsigned u32x2 __attribute__((ext_vector_type(2)));

__device__ __forceinline__ int tidx() { int t = (int)threadIdx.x; asm volatile("" : "+v"(t)); return t; }

#ifndef PROBE_DBL
#define PROBE_DBL -1
#endif
#define REPS(k) for (int _rep = 0; _rep < ((PROBE_DBL) == (k) ? 2 : 1); ++_rep)

constexpr int NB = 4, T = 8192, D = 1024, M = NB * T;
constexpr int INC = 3352, INP = 3584;
constexpr int C_RQ = 0, C_RK = 512, C_RV = 1024, C_RG = 1536, C_NQ = 2048, C_NKC = 2560, C_NVC = 2688, C_NKS = 2816, C_NVS = 2944, C_NKW = 3072, C_NVW = 3200, C_NG = 3328;
constexpr int MEML = 256;
constexpr int NE = 64, EFF = 256;
constexpr float LN_EPS = 1e-5f;
constexpr float DN_ALPHA = 1.189207115002721f;
constexpr float NEGF = -1e30f;

constexpr size_t MiB = 1u << 20;
constexpr size_t WS_WIN = 1 * MiB, WS_WOUT = 8 * MiB, WS_WXQ = 10 * MiB, WS_WXO = 12 * MiB, WS_WXKV = 14 * MiB, WS_MEMH = 18 * MiB, WS_KVM = 20 * MiB;
constexpr size_t WS_KCMP = 24 * MiB, WS_VCMP = 25 * MiB, WS_TOPE = 26 * MiB, WS_TOPW = 27 * MiB;
constexpr size_t WS_XH = 32 * MiB, WS_MIX = 32 * MiB, WS_OX = 32 * MiB;
constexpr size_t WS_H = 96 * MiB, WS_NQR = 320 * MiB, WS_KVB = 352 * MiB, WS_PREV = 416 * MiB;
constexpr size_t WS_PRE = 96 * MiB, WS_X1 = 224 * MiB, WS_X1H = 352 * MiB, WS_QX = 416 * MiB, WS_X2 = 130 * MiB;
constexpr size_t WS_X2H = 32 * MiB, WS_WDT = 96 * MiB, WS_HM = 130 * MiB, WS_WGUT = 306 * MiB, WS_Y = 306 * MiB;
constexpr size_t WS_ROWOFF = 1 * MiB, WS_ROWMETA = 3 * MiB;
constexpr size_t WS_VST = 480 * MiB, WS_VWT = 488 * MiB, WS_COSR = 496 * MiB, WS_SINR = 504 * MiB, WS_COSN = 28 * MiB, WS_SINN = 29 * MiB, WS_KVMVT = 30 * MiB;
constexpr size_t WS_WRTH = 262144, WS_WRTL = 393216;
constexpr size_t WS_WC1T = 464 * MiB, WS_HID = 466 * MiB, WS_CMPOFF = 131072, WS_PEB = 131072 + 16384;
constexpr size_t WS_PREVT = 416 * MiB, WS_KSR = 448 * MiB, WS_KWR = 456 * MiB, WS_KX = 26 * MiB;
constexpr size_t DO_RQR = 0, DO_RKR = 32 * MiB, DO_RKZT = 64 * MiB, DO_RVT = 96 * MiB;
constexpr size_t WS_NEED = 512 * MiB;
constexpr int NQ = 4, QT = M / NQ, NVE = NQ * 65, CAP_TILES = 1412, CAP = CAP_TILES * 256;
constexpr size_t WS_BAR = 65536;
constexpr int CTL_CNT = 0, CTL_CUR = 512, CTL_PST = 1024, CTL_TQS = 1536, CTL_TVE = 2048;

namespace pg8 {
#define PG8_LAS __attribute__((address_space(3)))
typedef short s16x8 __attribute__((ext_vector_type(8)));
constexpr int BM = 256, BK = 64, HALF = 128, HTB = HALF * BK * 2, STAGE_BYTES = 8 * HTB, NXCD = 8, WGM = 8;
__host__ __device__ __forceinline__ int lds_byte(int r, int c) { const int st = (r >> 4) * 2 + (c >> 5), rr = r & 15, cc = c & 31, ob = rr * 64 + cc * 2; return st * 1024 + (ob ^ (((ob >> 9) & 1) << 5)); }
__host__ __device__ __forceinline__ void stage_rc(int b, int& R, int& C) { const int st = b / 1024, sb = b % 1024, swz = sb ^ (((sb >> 9) & 1) << 5); R = (st >> 1) * 16 + swz / 64; C = (st & 1) * 32 + (swz % 64) / 2; }
__host__ __device__ __forceinline__ int perm32(int rho) { const int n = rho >> 4, i = rho & 15; return 8 * (i >> 2) + 4 * n + (i & 3); }
struct Unit { int pm, pn; const char* A; const char* B; const unsigned* gat; };
struct Gemm { const h16* A; const h16* Bt; int M, N, K; };
struct StaticOrder {
    int nM, nN, nwg, G, c; const char* A; const char* B; size_t tstep;
    __device__ void init(const Gemm& g, int G_, int c_) { nM = g.M / BM; nN = g.N / BM; nwg = nM * nN; G = G_; c = c_; A = (const char*)g.A; B = (const char*)g.Bt; tstep = (size_t)BM * g.K * 2; }
    __device__ bool next(int i, Unit& u) const {
        const long L = (long)i * G + c; if (L >= nwg) return false;
        int wgid = (int)L; { const int q = nwg / NXCD, r = nwg % NXCD, xcd = wgid % NXCD, off = wgid / NXCD; wgid = (xcd < r ? xcd * (q + 1) : r * (q + 1) + (xcd - r) * q) + off; }
        const int nig = WGM * nN, gid = wgid / nig, fm = gid * WGM, gsz = (nM - fm) < WGM ? (nM - fm) : WGM;
        u.pm = fm + ((wgid % nig) % gsz); u.pn = (wgid % nig) / gsz; u.A = A + (size_t)u.pm * tstep; u.B = B + (size_t)u.pn * tstep; u.gat = nullptr; return true;
    }
};
__device__ __forceinline__ unsigned cvt_pk_f16(float lo, float hi) { f32x2 v = {lo, hi}; h16x2 h = __builtin_convertvector(v, h16x2); return __builtin_bit_cast(unsigned, h); }

struct EpiF16 {
    static constexpr bool PERM = true;
    h16* O; int ldc;
    __device__ __forceinline__ void operator()(const f32x4 (&acc)[2][2][4][2], const Unit& u, int wr, int wc, int fr, int fq) const {
        const int row0 = u.pm * BM + wr * 64 + fr; const int col0 = u.pn * BM + wc * 32 + 8 * fq;
#pragma unroll
        for (int ai = 0; ai < 2; ++ai)
#pragma unroll
            for (int m = 0; m < 4; ++m) { h16* rowp = O + (size_t)(row0 + ai * HALF + m * 16) * ldc + col0;
#pragma unroll
                for (int bj = 0; bj < 2; ++bj) { const f32x4 v0 = acc[ai][bj][m][0], v1 = acc[ai][bj][m][1];
                    *(h16x8*)(rowp + bj * HALF) = __builtin_convertvector(__builtin_shufflevector(v0, v1, 0, 1, 2, 3, 4, 5, 6, 7), h16x8); } }
    }
};
struct EpiResF32 {
    static constexpr bool PERM = false;
    float* C; const float* R; int ldc; float alpha;
    __device__ __forceinline__ void operator()(const f32x4 (&acc)[2][2][4][2], const Unit& u, int wr, int wc, int fr, int fq) const {
        const int row0 = u.pm * BM + wr * 64 + fr, col0 = u.pn * BM + wc * 32 + 4 * fq;
#pragma unroll
        for (int ai = 0; ai < 2; ++ai)
#pragma unroll
            for (int m = 0; m < 4; ++m) { const size_t off = (size_t)(row0 + ai * HALF + m * 16) * ldc + col0;
#pragma unroll
                for (int bj = 0; bj < 2; ++bj)
#pragma unroll
                    for (int n = 0; n < 2; ++n) { const f32x4 r = *(const f32x4*)(R + off + bj * HALF + n * 16); *(f32x4*)(C + off + bj * HALF + n * 16) = r * alpha + acc[ai][bj][m][n]; } }
    }
};
struct EpiCmp1 {
    static constexpr bool PERM = true;
    h16* O; const float* peb;
    __device__ __forceinline__ void operator()(const f32x4 (&acc)[2][2][4][2], const Unit& u, int wr, int wc, int fr, int fq) const {
        const int row0 = u.pm * BM + wr * 64 + fr; const int col0 = wc * 32 + 8 * fq;
#pragma unroll
        for (int bj = 0; bj < 2; ++bj) { const f32x4 b0 = *(const f32x4*)(peb + col0 + bj * HALF), b1 = *(const f32x4*)(peb + col0 + bj * HALF + 4);
#pragma unroll
            for (int ai = 0; ai < 2; ++ai)
#pragma unroll
                for (int m = 0; m < 4; ++m) { f32x4 v0 = acc[ai][bj][m][0] + b0, v1 = acc[ai][bj][m][1] + b1;
#pragma unroll
                    for (int r = 0; r < 4; ++r) { v0[r] = v0[r] / (1.f + __expf(-v0[r])); v1[r] = v1[r] / (1.f + __expf(-v1[r])); }
                    *(h16x8*)(O + (size_t)(row0 + ai * HALF + m * 16) * 256 + col0 + bj * HALF) = __builtin_convertvector(__builtin_shufflevector(v0, v1, 0, 1, 2, 3, 4, 5, 6, 7), h16x8); } }
    }
};
struct EpiGateUp {
    static constexpr bool PERM = true;
    h16* H;
    __device__ __forceinline__ void operator()(const f32x4 (&acc)[2][2][4][2], const Unit& u, int wr, int wc, int fr, int fq) const {
        const int row0 = u.pm * BM + wr * 64 + fr; const int col0 = u.pn * 128 + wc * 16 + 4 * fq;
#pragma unroll
        for (int ai = 0; ai < 2; ++ai)
#pragma unroll
            for (int m = 0; m < 4; ++m) { h16* rowp = H + (size_t)(row0 + ai * HALF + m * 16) * 256 + col0;
#pragma unroll
                for (int bj = 0; bj < 2; ++bj) { const f32x4 v0 = acc[ai][bj][m][0], v1 = acc[ai][bj][m][1];
                    const float h0 = v0[0] / (1.f + __expf(-v0[0])) * v0[1], h1 = v0[2] / (1.f + __expf(-v0[2])) * v0[3];
                    const float h2 = v1[0] / (1.f + __expf(-v1[0])) * v1[1], h3 = v1[2] / (1.f + __expf(-v1[2])) * v1[3];
                    *(h16x4*)(rowp + bj * 64) = __builtin_convertvector((f32x4){h0, h1, h2, h3}, h16x4); } }
    }
};
struct EpiDown {
    static constexpr bool PERM = true;
    h16* Y; const u32x2* rowmeta;
    __device__ __forceinline__ void operator()(const f32x4 (&acc)[2][2][4][2], const Unit& u, int wr, int wc, int fr, int fq) const {
        const int row0 = u.pm * BM + wr * 64 + fr; const int col0 = u.pn * BM + wc * 32 + 8 * fq;
#pragma unroll
        for (int ai = 0; ai < 2; ++ai)
#pragma unroll
            for (int m = 0; m < 4; ++m) { const u32x2 md = rowmeta[row0 + ai * HALF + m * 16]; const int slot = (int)md.x; const float w8 = __uint_as_float(md.y);
                if (slot >= 0) { h16* rowp = Y + (size_t)slot * 1024 + col0;
#pragma unroll
                    for (int bj = 0; bj < 2; ++bj) { const f32x4 v0 = acc[ai][bj][m][0] * w8, v1 = acc[ai][bj][m][1] * w8;
                        *(h16x8*)(rowp + bj * HALF) = __builtin_convertvector(__builtin_shufflevector(v0, v1, 0, 1, 2, 3, 4, 5, 6, 7), h16x8); } }
                asm volatile("" ::: "memory"); }
    }
};

template <class Epi, class Sched>
__device__ __forceinline__ void gemm_phase(PG8_LAS unsigned char* lds, const int K, const Sched& S, const Epi& E, const size_t kstepA = (size_t)(BK * 2)) {
    const int tid = tidx(), wid = __builtin_amdgcn_readfirstlane(tid >> 6), lane = tid & 63, wr = wid >> 2, wc = wid & 3, fr = lane & 15, fq = lane >> 4;
    const int nt = K / BK;
    int R0, C0; stage_rc(tid * 16, R0, C0);
    const unsigned cb2 = (unsigned)C0 * 2u;
    unsigned voffB[2];
#pragma unroll
    for (int i = 0; i < 2; ++i) { const int R = R0 + 64 * i; const int Rb = Epi::PERM ? ((R & ~31) + perm32(R & 31)) : R; voffB[i] = (unsigned)(Rb * K) * 2u + cb2; }
    const size_t kstep = (size_t)(BK * 2);
    const size_t hstep = (size_t)HALF * K * 2;
    const unsigned ldsw = (unsigned)wid * 1024u;
    const int aoff = lds_byte(wr * 64 + fr, fq * 8), boff = lds_byte(wc * 32 + fr, fq * 8);
#define PG8_MKVA(u, va) do { _Pragma("unroll") for (int _h = 0; _h < 2; ++_h) _Pragma("unroll") for (int _i = 0; _i < 2; ++_i) { const int _r = _h * HALF + R0 + 64 * _i; \
        (va)[_h][_i] = ((u).gat ? (u).gat[_r] : (unsigned)(_r * K) * 2u) + cb2; } } while (0)
#define PG8_SA(b, h) (((b) * 2 + (h)) * HTB)
#define PG8_SB(b, h) ((4 + (b) * 2 + (h)) * HTB)
#define PG8_STAGE(bufoff, gbase, voff) do { _Pragma("unroll") for (int _i = 0; _i < 2; ++_i) \
        __builtin_amdgcn_global_load_lds((const unsigned*)((const char*)(gbase) + (voff)[_i]), (PG8_LAS unsigned*)(lds + (bufoff) + ldsw + _i * 8192), 16, 0, 0); } while (0)
#define PG8_LDA(dst, b, h) do { _Pragma("unroll") for (int m = 0; m < 4; ++m) _Pragma("unroll") for (int k = 0; k < 2; ++k) dst[m][k] = *(const PG8_LAS s16x8*)(lds + PG8_SA(b, h) + aoff + m * 2048 + k * 1024); } while (0)
#define PG8_LDB(dst, b, h) do { _Pragma("unroll") for (int n = 0; n < 2; ++n) _Pragma("unroll") for (int k = 0; k < 2; ++k) dst[n][k] = *(const PG8_LAS s16x8*)(lds + PG8_SB(b, h) + boff + n * 2048 + k * 1024); } while (0)
#define PG8_MMA(ai, bj, At, Bt) do { __builtin_amdgcn_s_setprio(1); _Pragma("unroll") for (int m = 0; m < 4; ++m) _Pragma("unroll") for (int n = 0; n < 2; ++n) _Pragma("unroll") for (int k = 0; k < 2; ++k) \
        acc[ai][bj][m][n] = __builtin_amdgcn_mfma_f32_16x16x32_f16(__builtin_bit_cast(h16x8, Bt[n][k]), __builtin_bit_cast(h16x8, At[m][k]), acc[ai][bj][m][n], 0, 0, 0); __builtin_amdgcn_s_setprio(0); } while (0)
#define PG8_WAIT_V(n) asm volatile("s_waitcnt vmcnt(" #n ")" ::: "memory")
#define PG8_WAIT_L(n) asm volatile("s_waitcnt lgkmcnt(" #n ")" ::: "memory")
#define PG8_BAR __builtin_amdgcn_s_barrier()
#define PG8_SCHED __builtin_amdgcn_sched_barrier(0)
    Unit cur, nxt; int ui = 0;
    if (!S.next(0, cur)) return;
    unsigned va[2][2];
    PG8_MKVA(cur, va);
    f32x4 acc[2][2][4][2];
#pragma unroll
    for (int a = 0; a < 2; ++a)
#pragma unroll
        for (int b = 0; b < 2; ++b)
#pragma unroll
            for (int m = 0; m < 4; ++m)
#pragma unroll
                for (int n = 0; n < 2; ++n) acc[a][b][m][n] = (f32x4){0.f, 0.f, 0.f, 0.f};
    s16x8 At[4][2], B0[2][2], B1[2][2];
    const char* cA = cur.A; const char* cB = cur.B;
    {
        PG8_STAGE(PG8_SB(0, 0), cB, voffB); PG8_STAGE(PG8_SB(0, 1), cB + hstep, voffB); PG8_STAGE(PG8_SA(0, 0), cA, va[0]); PG8_STAGE(PG8_SA(0, 1), cA, va[1]);
        if (wr == 1) PG8_BAR;
        PG8_WAIT_V(2); PG8_BAR;
        PG8_STAGE(PG8_SB(1, 0), cB + kstep, voffB); PG8_STAGE(PG8_SA(1, 0), cA + kstepA, va[0]); PG8_STAGE(PG8_SB(1, 1), cB + hstep + kstep, voffB);
        PG8_WAIT_V(6); PG8_BAR;
    }
    for (;;) {
        const bool has_next = S.next(ui + 1, nxt);
        const char* nA = has_next ? nxt.A : cA; const char* nB = has_next ? nxt.B : cB;
#pragma unroll 1
        for (int t = 0; t < nt; t += 2) {
            const bool last = (t == nt - 2);
            const char* a1 = cA + (size_t)(t + 1) * kstepA;
            const char* a2 = last ? nA : cA + (size_t)(t + 2) * kstepA; const char* b2 = last ? nB : cB + (size_t)(t + 2) * kstep;
            const char* a3 = a2 + kstepA; const char* b3 = b2 + kstep;
            PG8_LDB(B0, 0, 0); PG8_LDB(B1, 0, 1); PG8_SCHED; PG8_LDA(At, 0, 0); PG8_STAGE(PG8_SA(1, 1), a1, va[1]);
            if (last && has_next) { PG8_MKVA(nxt, va); }
            PG8_WAIT_V(8); PG8_WAIT_L(0); PG8_BAR; PG8_MMA(0, 0, At, B0); PG8_MMA(0, 1, At, B1); PG8_BAR; PG8_SCHED;
            PG8_LDA(At, 0, 1); PG8_STAGE(PG8_SB(0, 0), b2, voffB); PG8_STAGE(PG8_SB(0, 1), b2 + hstep, voffB); PG8_STAGE(PG8_SA(0, 0), a2, va[0]);
            PG8_WAIT_V(8); PG8_WAIT_L(0); PG8_BAR; PG8_MMA(1, 0, At, B0); PG8_MMA(1, 1, At, B1); PG8_BAR; PG8_SCHED;
            PG8_LDB(B0, 1, 0); PG8_LDB(B1, 1, 1); PG8_SCHED; PG8_LDA(At, 1, 0); PG8_STAGE(PG8_SA(0, 1), a2, va[1]);
            PG8_WAIT_V(8); PG8_WAIT_L(0); PG8_BAR; PG8_MMA(0, 0, At, B0); PG8_MMA(0, 1, At, B1); PG8_BAR; PG8_SCHED;
            PG8_LDA(At, 1, 1); PG8_STAGE(PG8_SB(1, 0), b3, voffB); PG8_STAGE(PG8_SB(1, 1), b3 + hstep, voffB); PG8_STAGE(PG8_SA(1, 0), a3, va[0]);
            PG8_WAIT_V(8); PG8_WAIT_L(0); PG8_BAR; PG8_MMA(1, 0, At, B0); PG8_MMA(1, 1, At, B1); PG8_BAR; PG8_SCHED;
        }
        if (wr == 0) PG8_BAR;
        E(acc, cur, wr, wc, fr, fq);
        if (!has_next) break;
#pragma unroll
        for (int a = 0; a < 2; ++a)
#pragma unroll
            for (int b = 0; b < 2; ++b)
#pragma unroll
                for (int m = 0; m < 4; ++m)
#pragma unroll
                    for (int n = 0; n < 2; ++n) acc[a][b][m][n] = (f32x4){0.f, 0.f, 0.f, 0.f};
        cur = nxt; cA = nA; cB = nB; ++ui;
        if (wr == 1) PG8_BAR;
    }
    PG8_WAIT_V(0);
    PG8_BAR;
#undef PG8_MKVA
#undef PG8_SA
#undef PG8_SB
#undef PG8_STAGE
#undef PG8_LDA
#undef PG8_LDB
#undef PG8_MMA
#undef PG8_WAIT_V
#undef PG8_WAIT_L
#undef PG8_BAR
#undef PG8_SCHED
}
}


#include <hip/hip_cooperative_groups.h>
namespace cg = cooperative_groups;
constexpr int NTHR = 512;
constexpr int LDS_BYTES = 147456;
#define LAS __attribute__((address_space(3)))

struct Params {
    const float *x, *mem; const int* positions;
    const float *w_in, *pe_k, *pe_v, *w1k, *w2k, *w1v, *w2v, *w_out, *ln1g, *ln1b, *w_xq, *w_xkv, *w_xo, *ln2g, *ln2b, *w_router, *rbias, *w_gate, *w_up, *w_down, *ws_gate, *ws_up, *ws_down, *ln3g, *ln3b;
    float* out; unsigned char* ws;
    float lg[4];
    int ph_lo, ph_hi;
};

__device__ __forceinline__ float wave_sum(float v) {
#pragma unroll
    for (int o = 1; o < 64; o <<= 1) v += __shfl_xor(v, o);
    return v;
}
__device__ __forceinline__ float wave_max(float v) {
#pragma unroll
    for (int o = 1; o < 64; o <<= 1) v = fmaxf(v, __shfl_xor(v, o));
    return v;
}
__device__ __forceinline__ float siluf(float v) { return v / (1.f + __expf(-v)); }
__device__ __forceinline__ float sigmf(float v) { return 1.f / (1.f + __expf(-v)); }

__device__ __forceinline__ void b_transpose_tile(const float* __restrict__ W, int K, int N, h16* __restrict__ WT, int Npad, int tile, float* tl, int lt, int rs = 1, int ro = 0) {
    const int ntn = Npad / 32; const int n0 = (tile % ntn) * 32, k0 = (tile / ntn) * 32, tx = lt & 31, ty = lt >> 5;
    for (int i = ty; i < 32; i += 8) { const int k = k0 + i, n = n0 + tx; tl[i * 33 + tx] = (n < N) ? W[(size_t)k * N + n] : 0.f; }
    __syncthreads();
    for (int i = ty; i < 32; i += 8) { const int n = n0 + i, k = k0 + tx; WT[(size_t)(n * rs + ro) * K + k] = (h16)tl[tx * 33 + i]; }
    __syncthreads();
}
__device__ __forceinline__ void w_transpose_item(const float* __restrict__ W, int K, int N, h16* __restrict__ WT, int item, LAS float* scr, int lane, int rs = 1, int ro = 0) {
    const int nblk = N / 32, kb = item / nblk, nb = item % nblk, k0 = 64 * kb, n0 = 32 * nb;
#pragma unroll 8
    for (int i = 0; i < 32; ++i) { const int kk = 2 * i + (lane >> 5); scr[kk * 33 + (lane & 31)] = W[(size_t)(k0 + kk) * N + n0 + (lane & 31)]; }
    asm volatile("s_waitcnt lgkmcnt(0)" ::: "memory");
    const int c = lane & 7;
#pragma unroll
    for (int j = 0; j < 4; ++j) { const int n = (lane >> 3) + 8 * j; LAS const float* s = scr + (8 * c) * 33 + n; h16x8 o;
#pragma unroll
        for (int x = 0; x < 8; ++x) o[x] = (h16)s[x * 33];
        *(h16x8*)(WT + (size_t)((n0 + n) * rs + ro) * K + k0 + 8 * c) = o; }
    asm volatile("s_waitcnt lgkmcnt(0)" ::: "memory");
}
__device__ __forceinline__ void b_cvt(const float* __restrict__ x, h16* __restrict__ o, size_t n4) {
    for (size_t i = (size_t)blockIdx.x * NTHR + tidx(); i < n4; i += (size_t)gridDim.x * NTHR) {
        const f32x4 v = ((const f32x4*)x)[i]; ((h16x4*)o)[i] = __builtin_convertvector(v, h16x4); }
}

__device__ __forceinline__ void b_tables(const int* __restrict__ positions, float* __restrict__ cosr, float* __restrict__ sinr, float* __restrict__ cosn, float* __restrict__ sinn) {
    for (int idx = blockIdx.x * NTHR + tidx(); idx < M * 72; idx += gridDim.x * NTHR) {
        const int m = idx / 72, j = idx % 72; const float pos = (float)positions[m];
        const float inv = j < 64 ? (float)pow(10000.0, -(double)j / 64.0) : (float)pow(500000.0, -(double)(j - 64) / 8.0);
        const float ang = pos * inv; double sd, cd; sincos((double)ang, &sd, &cd);
        if (j < 64) { cosr[(size_t)m * 64 + j] = (float)cd; sinr[(size_t)m * 64 + j] = (float)sd; } else { cosn[(size_t)m * 8 + j - 64] = (float)cd; sinn[(size_t)m * 8 + j - 64] = (float)sd; }
    }
}
__device__ __forceinline__ void w_rope(const h16* __restrict__ h, h16* __restrict__ rqr, h16* __restrict__ rkr, h16* __restrict__ nqr, h16* __restrict__ ksR, h16* __restrict__ kwR, const float* __restrict__ cosr, const float* __restrict__ sinr,
                                       const float* __restrict__ cosn, const float* __restrict__ sinn, int m, int lane) {
    const h16* hr = h + (size_t)m * INP; const int bb = m >> 13, t = m & (T - 1);
    {
        const int isk = lane >> 5, hd = (lane >> 3) & 3, j8 = (lane & 7) * 8; const int col = (isk ? C_RK : C_RQ) + hd * 128 + j8;
        const h16x8 a1 = *(const h16x8*)(hr + col), a2 = *(const h16x8*)(hr + col + 64);
        const f32x4 c0 = *(const f32x4*)(cosr + (size_t)m * 64 + j8), c1 = *(const f32x4*)(cosr + (size_t)m * 64 + j8 + 4), s0 = *(const f32x4*)(sinr + (size_t)m * 64 + j8), s1 = *(const f32x4*)(sinr + (size_t)m * 64 + j8 + 4);
        const float sc = isk ? 0.08838834764831845f : 1.f; h16x8 o1, o2;
#pragma unroll
        for (int x = 0; x < 8; ++x) { const float c = x < 4 ? c0[x & 3] : c1[x & 3], s = x < 4 ? s0[x & 3] : s1[x & 3]; const float v1 = (float)a1[x], v2 = (float)a2[x];
            o1[x] = (h16)((v1 * c - v2 * s) * sc); o2[x] = (h16)((v2 * c + v1 * s) * sc); }
        h16* dst = (isk ? rkr : rqr) + ((size_t)(bb * 4 + hd) * T + t) * 128 + j8; *(h16x8*)dst = o1; *(h16x8*)(dst + 64) = o2; }
    const f32x4 cn0 = *(const f32x4*)(cosn + (size_t)m * 8), cn1 = *(const f32x4*)(cosn + (size_t)m * 8 + 4), sn0 = *(const f32x4*)(sinn + (size_t)m * 8), sn1 = *(const f32x4*)(sinn + (size_t)m * 8 + 4);
    if (lane < 8 || (lane >= 56 && lane < 60)) {
        const bool isq = lane < 8; const int idx = lane - 56, which = idx >> 1, g = idx & 1;
        const h16* src = isq ? hr + C_NQ + lane * 64 : hr + (which ? C_NKW : C_NKS) + g * 64;
        h16* dst = isq ? nqr + (size_t)m * 512 + lane * 64 : (which ? kwR : ksR) + (((size_t)((bb * 2 + g) * 128 + (t >> 6)) * 64 + (t & 63)) * 64);
        const h16x8 a1 = *(const h16x8*)src, a2 = *(const h16x8*)(src + 8); h16x8 o1, o2;
#pragma unroll
        for (int x = 0; x < 8; ++x) { const float c = x < 4 ? cn0[x & 3] : cn1[x & 3], s = x < 4 ? sn0[x & 3] : sn1[x & 3]; const float v1 = (float)a1[x], v2 = (float)a2[x];
            o1[x] = (h16)(v1 * c - v2 * s); o2[x] = (h16)(v2 * c + v1 * s); }
        *(h16x8*)dst = o1; *(h16x8*)(dst + 8) = o2;
    } else if (lane < 56) {
        const int idx = lane - 8, hd = idx / 6, d = 16 + 8 * (idx % 6); *(h16x8*)(nqr + (size_t)m * 512 + hd * 64 + d) = *(const h16x8*)(hr + C_NQ + hd * 64 + d); }
    if (lane < 24) {
        const int which = lane / 12, r = lane % 12, g = r / 6, d = 16 + 8 * (r % 6);
        h16* dst = (which ? kwR : ksR) + (((size_t)((bb * 2 + g) * 128 + (t >> 6)) * 64 + (t & 63)) * 64);
        *(h16x8*)(dst + d) = *(const h16x8*)(hr + (which ? C_NKW : C_NKS) + g * 64 + d); }
}
__device__ __forceinline__ void b_rope(const h16* __restrict__ h, h16* __restrict__ rqr, h16* __restrict__ rkr, h16* __restrict__ nqr, h16* __restrict__ ksR, h16* __restrict__ kwR, const float* __restrict__ cosr, const float* __restrict__ sinr,
                                       const float* __restrict__ cosn, const float* __restrict__ sinn, int m, int j) {
    const h16* hr = h + (size_t)m * INP; const int bb = m >> 13, t = m & (T - 1);
    {   const int hd = j >> 6, jj = j & 63; const float c = cosr[(size_t)m * 64 + jj], s = sinr[(size_t)m * 64 + jj]; const size_t ro = ((size_t)(bb * 4 + hd) * T + t) * 128;
        const int o1 = hd * 128 + jj, o2 = o1 + 64;
        const float q1 = (float)hr[C_RQ + o1], q2 = (float)hr[C_RQ + o2];
        rqr[ro + jj] = (h16)(q1 * c - q2 * s); rqr[ro + jj + 64] = (h16)(q2 * c + q1 * s);
        const float k1 = (float)hr[C_RK + o1], k2 = (float)hr[C_RK + o2]; const float sc = 0.08838834764831845f;
        rkr[ro + jj] = (h16)((k1 * c - k2 * s) * sc); rkr[ro + jj + 64] = (h16)((k2 * c + k1 * s) * sc);
    }
    if (j < 64 + 16 + 16) {
        const int jj = j & 7; const float c = cosn[(size_t)m * 8 + jj], s = sinn[(size_t)m * 8 + jj];
        if (j < 64) { const int hd = j >> 3; const int o1 = hd * 64 + jj, o2 = o1 + 8;
            const float q1 = (float)hr[C_NQ + o1], q2 = (float)hr[C_NQ + o2];
            nqr[(size_t)m * 512 + o1] = (h16)(q1 * c - q2 * s); nqr[(size_t)m * 512 + o2] = (h16)(q2 * c + q1 * s);
        } else { const int jx = j - 64; const int which = jx >> 4, g = (jx >> 3) & 1; const int base = (which ? C_NKW : C_NKS) + g * 64 + jj;
            const float k1 = (float)hr[base], k2 = (float)hr[base + 8];
            h16* dst = (which ? kwR : ksR) + (((size_t)((bb * 2 + g) * 128 + (t >> 6)) * 64 + (t & 63)) * 64); dst[jj] = (h16)(k1 * c - k2 * s); dst[jj + 8] = (h16)(k2 * c + k1 * s); }
    }
    if (j >= 128 && j < 128 + 96) { const int jx = j - 128; const int which = jx / 48, r = jx % 48, g = r / 24, d = 16 + 2 * (r % 24);
        const int base = (which ? C_NKW : C_NKS) + g * 64 + d; h16* dst = (which ? kwR : ksR) + (((size_t)((bb * 2 + g) * 128 + (t >> 6)) * 64 + (t & 63)) * 64);
        dst[d] = hr[base]; dst[d + 1] = hr[base + 1]; }
    for (int i = j; i < 8 * 48; i += 256) { const int hd = i / 48, d = 16 + i % 48; nqr[(size_t)m * 512 + hd * 64 + d] = hr[C_NQ + hd * 64 + d]; }
}
__device__ __forceinline__ void b_rtrans(const Params& p, const h16* __restrict__ h, h16* __restrict__ rvT, h16* __restrict__ rkzT, const float* __restrict__ cosr, const float* __restrict__ sinr, int item, LAS h16* sl, int lane) {
    int id = item; const int tt = id & 255; id >>= 8; const int hd = id & 3; const int b = id >> 2; const int bh = b * 4 + hd; const float lg = p.lg[hd];
    const int chunk = bh * 64 + (tt >> 2), koff = (tt & 3) * 32;
#pragma unroll 4
    for (int i = lane; i < 32 * 16; i += 64) { const int t = i >> 4, e8 = (i & 15) * 8; const h16x8 v = *(const h16x8*)(h + (size_t)(b * T + tt * 32 + t) * INP + C_RV + hd * 128 + e8);
#pragma unroll
        for (int x = 0; x < 8; ++x) sl[t * 130 + e8 + x] = v[x]; }
    asm volatile("s_waitcnt lgkmcnt(0)" ::: "memory");
#pragma unroll 4
    for (int i = lane; i < 128 * 4; i += 64) { const int e = i >> 2, t8 = (i & 3) * 8; h16x8 o;
#pragma unroll
        for (int x = 0; x < 8; ++x) o[x] = sl[(t8 + x) * 130 + e];
        *(h16x8*)(rvT + ((size_t)chunk * 128 + e) * 128 + koff + t8) = o; }
    asm volatile("s_waitcnt lgkmcnt(0)" ::: "memory");
#pragma unroll 4
    for (int i = lane; i < 32 * 8; i += 64) { const int t = i >> 3, j8 = (i & 7) * 8; const size_t m = (size_t)b * T + tt * 32 + t;
        const h16x8 k1 = *(const h16x8*)(h + m * INP + C_RK + hd * 128 + j8), k2 = *(const h16x8*)(h + m * INP + C_RK + hd * 128 + 64 + j8);
        const f32x4 c0 = *(const f32x4*)(cosr + m * 64 + j8), c1 = *(const f32x4*)(cosr + m * 64 + j8 + 4), s0 = *(const f32x4*)(sinr + m * 64 + j8), s1 = *(const f32x4*)(sinr + m * 64 + j8 + 4);
        const float z = 0.08838834764831845f * __expf(lg * (float)(127 - (koff + t)));
#pragma unroll
        for (int x = 0; x < 8; ++x) { const float c = x < 4 ? c0[x & 3] : c1[x & 3], s = x < 4 ? s0[x & 3] : s1[x & 3]; const float a1 = (float)k1[x], a2 = (float)k2[x];
            sl[t * 130 + j8 + x] = (h16)((a1 * c - a2 * s) * z); sl[t * 130 + 64 + j8 + x] = (h16)((a2 * c + a1 * s) * z); } }
    asm volatile("s_waitcnt lgkmcnt(0)" ::: "memory");
#pragma unroll 4
    for (int i = lane; i < 128 * 4; i += 64) { const int d = i >> 2, t8 = (i & 3) * 8; h16x8 o;
#pragma unroll
        for (int x = 0; x < 8; ++x) o[x] = sl[(t8 + x) * 130 + d];
        *(h16x8*)(rkzT + ((size_t)chunk * 128 + d) * 128 + koff + t8) = o; }
    asm volatile("s_waitcnt lgkmcnt(0)" ::: "memory");
}
__device__ __forceinline__ void b_mvtrans(const h16* __restrict__ kvm, h16* __restrict__ kvmVT, h16* __restrict__ kx, int item, h16* sl, int lt) {
    int id = item; const int kt = id & 3; id >>= 2; const int dtl = id & 3; id >>= 2; const int hh = id & 3; const int b = id >> 2;
    for (int i = lt; i < 64 * 64; i += 256) { const int k = i >> 6, d = i & 63; sl[k * 66 + d] = kvm[(size_t)(b * MEML + kt * 64 + k) * 2048 + 1024 + hh * 256 + dtl * 64 + d];
        kx[((size_t)(b * 4 + hh) * MEML + kt * 64 + k) * 256 + dtl * 64 + d] = kvm[(size_t)(b * MEML + kt * 64 + k) * 2048 + hh * 256 + dtl * 64 + d]; }
    __syncthreads();
    for (int i = lt; i < 64 * 64; i += 256) { const int d = i >> 6, k = i & 63; kvmVT[(size_t)((b * 4 + hh) * 256 + dtl * 64 + d) * MEML + kt * 64 + k] = sl[k * 66 + d]; }
    __syncthreads();
}

struct CmpSched {
    const char* hbase; const unsigned* cmpoff; const char* Wc1T; int c;
    __device__ bool next(int i, pg8::Unit& u) const {
        if (i > 0 || c >= 32) return false; const int kv = c >> 4, rt = c & 15;
        u.pm = kv * 16 + rt; u.pn = 0; u.A = hbase + (size_t)(kv ? C_NVC : C_NKC) * 2; u.gat = cmpoff + rt * 256; u.B = Wc1T + (size_t)kv * 256 * 2048 * 2; return true; }
};
__device__ __forceinline__ void b_cmp2(const Params& p, const h16* __restrict__ hid, h16* __restrict__ kcmp, h16* __restrict__ vcmpT) {
    const int lane = tidx() & 63;
    for (int r = blockIdx.x * 8 + (tidx() >> 6); r < 2 * 4096; r += gridDim.x * 8) {
        const int kv = r >> 12, rr = r & 4095, g = rr & 1, c = (rr >> 1) & 511, b = rr >> 10;
        const float* w2 = kv ? p.w2v : p.w2k; const h16* hr = hid + (size_t)r * 256; float acc = 0.f;
        for (int j = 0; j < 256; j += 8) { const h16x8 hv = *(const h16x8*)(hr + j);
#pragma unroll
            for (int x = 0; x < 8; ++x) acc += (float)hv[x] * w2[(j + x) * 64 + lane]; }
        if (c == 511) acc = 0.f;
        if (kv == 0) kcmp[((size_t)(b * 2 + g) * 512 + c) * 64 + lane] = (h16)acc;
        else vcmpT[(((size_t)(b * 2 + g) * 8 + (c >> 6)) * 64 + lane) * 64 + (c & 63)] = (h16)acc;
    }
}
__device__ __forceinline__ void b_vtrans(const h16* __restrict__ h, h16* __restrict__ vsT, h16* __restrict__ vwT, int item, LAS h16* sl, int lane) {
    int id = item; const int tt = id & 127; id >>= 7; const int g = id & 1; id >>= 1; const int b = id & 3; const int which = id >> 2;
    const int col = (which ? C_NVW : C_NVS) + g * 64; h16* dst = (which ? vwT : vsT) + (size_t)((b * 2 + g) * 128 + tt) * 4096;
#pragma unroll 4
    for (int i = lane; i < 64 * 8; i += 64) { const int t = i >> 3, d8 = (i & 7) * 8; const h16x8 v = *(const h16x8*)(h + (size_t)(b * T + tt * 64 + t) * INP + col + d8);
#pragma unroll
        for (int x = 0; x < 8; ++x) sl[t * 66 + d8 + x] = v[x]; }
    asm volatile("s_waitcnt lgkmcnt(0)" ::: "memory");
#pragma unroll 4
    for (int i = lane; i < 64 * 8; i += 64) { const int d = i >> 3, t8 = (i & 7) * 8; h16x8 o;
#pragma unroll
        for (int x = 0; x < 8; ++x) o[x] = sl[(t8 + x) * 66 + d];
        *(h16x8*)(dst + d * 64 + t8) = o; }
    asm volatile("s_waitcnt lgkmcnt(0)" ::: "memory");
}

__device__ __forceinline__ void ret_kv_unit(const h16* __restrict__ rkzT, const h16* __restrict__ rvT, float* __restrict__ kvT, int chunk, int w, int lane) {
    const int i = lane & 15, kg = lane >> 4; const int bh = chunk >> 6, n = chunk & 63;
    h16x8 a[4];
#pragma unroll
    for (int ks = 0; ks < 4; ++ks) a[ks] = *(const h16x8*)(rkzT + ((size_t)chunk * 128 + 16 * w + i) * 128 + 32 * ks + 8 * kg);
#pragma unroll
    for (int et = 0; et < 8; ++et) { f32x4 acc = {0.f, 0.f, 0.f, 0.f};
#pragma unroll
        for (int ks = 0; ks < 4; ++ks) { const h16x8 bq = *(const h16x8*)(rvT + ((size_t)chunk * 128 + 16 * et + i) * 128 + 32 * ks + 8 * kg); acc = __builtin_amdgcn_mfma_f32_16x16x32_f16(a[ks], bq, acc, 0, 0, 0); }
        *(f32x4*)(kvT + ((size_t)chunk * 128 + 16 * et + i) * 128 + 16 * w + 4 * kg) = acc; }
}
__device__ __forceinline__ void b_ret_scan(const Params& p, const float* __restrict__ kvT, h16* __restrict__ prevT) {
    for (int gid = blockIdx.x * NTHR + tidx(); gid < 16 * 16384; gid += gridDim.x * NTHR) {
        const int de = gid & 16383, bh = gid >> 14; const float cd = __expf(p.lg[bh & 3] * 128.f);
        float st = 0.f;
        for (int n = 0; n < 64; ++n) { const size_t o = ((size_t)(bh * 64 + n) << 14) + de; prevT[o] = (h16)st; st = st * cd + kvT[o]; }
    }
}
__device__ __forceinline__ void ret_out_unit(const Params& p, const h16* __restrict__ h, const h16* __restrict__ rqr, const h16* __restrict__ rkr, const h16* __restrict__ rvT, const h16* __restrict__ prevT,
                                             h16* __restrict__ mix, int chunk, int w, int lane) {
    const int i = lane & 15, kg = lane >> 4; const int bh = chunk >> 6, n = chunk & 63, b = bh >> 2, hd = bh & 3; const float lg = p.lg[hd];
    const int qi = 16 * w + i; const size_t m = (size_t)b * T + n * 128 + qi;
    h16x8 qf[4];
#pragma unroll
    for (int ks = 0; ks < 4; ++ks) qf[ks] = *(const h16x8*)(rqr + ((size_t)bh * T + n * 128 + qi) * 128 + 32 * ks + 8 * kg);
    f32x4 inner[8], cross[8];
#pragma unroll
    for (int et = 0; et < 8; ++et) { inner[et] = (f32x4){0.f, 0.f, 0.f, 0.f}; cross[et] = (f32x4){0.f, 0.f, 0.f, 0.f}; }
    for (int gq = 0; gq < 2; ++gq) {
        if (64 * gq > 16 * w + 15) break;
        f32x4 s[4];
#pragma unroll
        for (int tl = 0; tl < 4; ++tl) { const int ko = 32 * (tl >> 1) + 8 * (i >> 2) + 4 * (tl & 1) + (i & 3); const h16* kp = rkr + ((size_t)bh * T + n * 128 + 64 * gq + ko) * 128 + 8 * kg;
            f32x4 acc = {0.f, 0.f, 0.f, 0.f};
#pragma unroll
            for (int ks = 0; ks < 4; ++ks) acc = __builtin_amdgcn_mfma_f32_16x16x32_f16(*(const h16x8*)(kp + 32 * ks), qf[ks], acc, 0, 0, 0);
            s[tl] = acc; }
        h16x8 pf[2];
#pragma unroll
        for (int tl = 0; tl < 4; ++tl)
#pragma unroll
            for (int r = 0; r < 4; ++r) { const int j = 64 * gq + 32 * (tl >> 1) + 8 * kg + 4 * (tl & 1) + r; const float v = (j <= qi) ? s[tl][r] * __expf(lg * (float)(qi - j)) : 0.f; pf[tl >> 1][4 * (tl & 1) + r] = (h16)v; }
#pragma unroll
        for (int et = 0; et < 8; ++et)
#pragma unroll
            for (int s2 = 0; s2 < 2; ++s2) { const h16x8 a = *(const h16x8*)(rvT + ((size_t)chunk * 128 + 16 * et + i) * 128 + 64 * gq + 32 * s2 + 8 * kg); inner[et] = __builtin_amdgcn_mfma_f32_16x16x32_f16(a, pf[s2], inner[et], 0, 0, 0); }
    }
#pragma unroll
    for (int et = 0; et < 8; ++et)
#pragma unroll
        for (int ks = 0; ks < 4; ++ks) { const h16x8 a = *(const h16x8*)(prevT + ((size_t)chunk * 128 + 16 * et + i) * 128 + 32 * ks + 8 * kg); cross[et] = __builtin_amdgcn_mfma_f32_16x16x32_f16(a, qf[ks], cross[et], 0, 0, 0); }
    const float xi = __expf(lg * (float)(qi + 1));
    float sm = 0.f;
#pragma unroll
    for (int et = 0; et < 8; ++et) { inner[et] = inner[et] + cross[et] * xi; sm += (inner[et][0] + inner[et][1]) + (inner[et][2] + inner[et][3]); }
    sm += __shfl_xor(sm, 16); sm += __shfl_xor(sm, 32);
    const float mu = sm * (1.f / 128.f); float sq = 0.f;
#pragma unroll
    for (int et = 0; et < 8; ++et) { inner[et] = inner[et] - mu; sq += (inner[et][0] * inner[et][0] + inner[et][1] * inner[et][1]) + (inner[et][2] * inner[et][2] + inner[et][3] * inner[et][3]); }
    sq += __shfl_xor(sq, 16); sq += __shfl_xor(sq, 32);
    const float rstd = rsqrtf(sq * (1.f / 128.f) + LN_EPS);
#pragma unroll
    for (int et = 0; et < 8; ++et) { const int e = 16 * et + 4 * kg; const h16x4 gv = *(const h16x4*)(h + m * INP + C_RG + hd * 128 + e);
        f32x4 o;
#pragma unroll
        for (int r = 0; r < 4; ++r) o[r] = siluf((float)gv[r]) * inner[et][r] * rstd;
        *(h16x4*)(mix + m * D + hd * 128 + e) = __builtin_convertvector(o, h16x4); }
}

struct AttSt { float m, l; f32x4 o[4]; };
struct KFrag { h16x8 a[4][2]; };
struct VFrag { h16x8 a[4][2]; };
__device__ __forceinline__ void ldk(KFrag& k, const h16* __restrict__ Kb, int pitchK, int i, int kg) {
#pragma unroll
    for (int tl = 0; tl < 4; ++tl) { const int ko = 32 * (tl >> 1) + 8 * (i >> 2) + 4 * (tl & 1) + (i & 3); const h16* kp = Kb + (size_t)ko * pitchK + 8 * kg;
        k.a[tl][0] = *(const h16x8*)kp; k.a[tl][1] = *(const h16x8*)(kp + 32); }
}
__device__ __forceinline__ void ldv(VFrag& v, const h16* __restrict__ VTb, int vstride, int i, int kg) {
#pragma unroll
    for (int dt = 0; dt < 4; ++dt)
#pragma unroll
        for (int s2 = 0; s2 < 2; ++s2) v.a[dt][s2] = *(const h16x8*)(VTb + (size_t)(16 * dt + i) * vstride + 32 * s2 + 8 * kg);
}
__device__ __forceinline__ float xmax4(float v) {
    auto a = __builtin_amdgcn_permlane16_swap(__float_as_uint(v), __float_as_uint(v), false, false); v = fmaxf(__uint_as_float(a[0]), __uint_as_float(a[1]));
    auto c = __builtin_amdgcn_permlane32_swap(__float_as_uint(v), __float_as_uint(v), false, false); return fmaxf(__uint_as_float(c[0]), __uint_as_float(c[1])); }
__device__ __forceinline__ float xsum4(float v) {
    auto a = __builtin_amdgcn_permlane16_swap(__float_as_uint(v), __float_as_uint(v), false, false); v = __uint_as_float(a[0]) + __uint_as_float(a[1]);
    auto c = __builtin_amdgcn_permlane32_swap(__float_as_uint(v), __float_as_uint(v), false, false); return __uint_as_float(c[0]) + __uint_as_float(c[1]); }
constexpr float ATT_C2 = 0.125f * 1.4426950408889634f;
template <bool MASKED, class MaskF>
__device__ __forceinline__ void att_scores(f32x4 (&s)[4], const KFrag& k, const h16x8 (&qf)[2], int kg, MaskF valid) {
#pragma unroll
    for (int tl = 0; tl < 4; ++tl) { f32x4 z = {0.f, 0.f, 0.f, 0.f}; z = __builtin_amdgcn_mfma_f32_16x16x32_f16(k.a[tl][0], qf[0], z, 0, 0, 0); s[tl] = __builtin_amdgcn_mfma_f32_16x16x32_f16(k.a[tl][1], qf[1], z, 0, 0, 0); }
    if (MASKED) {
#pragma unroll
        for (int tl = 0; tl < 4; ++tl)
#pragma unroll
            for (int r = 0; r < 4; ++r) { const int ko = 32 * (tl >> 1) + 8 * kg + 4 * (tl & 1) + r; s[tl][r] = valid(ko) ? s[tl][r] : -INFINITY; }
    }
}
__device__ __forceinline__ float att_rowmax(const f32x4 (&s)[4]) {
    float mx = fmaxf(fmaxf(s[0][0], s[0][1]), fmaxf(s[0][2], s[0][3]));
#pragma unroll
    for (int tl = 1; tl < 4; ++tl) mx = fmaxf(mx, fmaxf(fmaxf(s[tl][0], s[tl][1]), fmaxf(s[tl][2], s[tl][3])));
    return xmax4(mx);
}
__device__ __forceinline__ void att_pv(f32x4 (&o)[4], const f32x4 (&pv)[4], const VFrag& v) {
    h16x8 pf[2];
#pragma unroll
    for (int s2 = 0; s2 < 2; ++s2)
#pragma unroll
        for (int j = 0; j < 8; ++j) pf[s2][j] = (h16)pv[2 * s2 + (j >> 2)][j & 3];
#pragma unroll
    for (int dt = 0; dt < 4; ++dt)
#pragma unroll
        for (int s2 = 0; s2 < 2; ++s2) o[dt] = __builtin_amdgcn_mfma_f32_16x16x32_f16(v.a[dt][s2], pf[s2], o[dt], 0, 0, 0);
}
__device__ __forceinline__ void att_softmax_pv(AttSt& st, f32x4 (&s)[4], const VFrag& v, bool rowok) {
    const float mx = rowok ? att_rowmax(s) * ATT_C2 : -INFINITY;
    const float mn = fmaxf(st.m, mx);
    if (__any(mn > st.m)) { const float alpha = __builtin_amdgcn_exp2f(st.m - mn); st.m = mn; st.l *= alpha;
#pragma unroll
        for (int dt = 0; dt < 4; ++dt) st.o[dt] = st.o[dt] * alpha; }
    const float mneg = rowok ? -mn : -INFINITY;
    float ps0 = 0.f, ps1 = 0.f;
#pragma unroll
    for (int tl = 0; tl < 4; ++tl) {
#pragma unroll
        for (int r = 0; r < 4; ++r) s[tl][r] = __builtin_amdgcn_exp2f(__builtin_fmaf(s[tl][r], ATT_C2, mneg));
        ps0 += s[tl][0] + s[tl][1]; ps1 += s[tl][2] + s[tl][3]; }
    st.l += ps0 + ps1;
    att_pv(st.o, s, v);
}
template <bool MASKED, class MaskF>
__device__ __forceinline__ void att_tile(AttSt& st, const KFrag& k, const VFrag& v, const h16x8 (&qf)[2], int kg, bool rowok, MaskF valid) {
    f32x4 s[4]; att_scores<MASKED>(s, k, qf, kg, valid);
    att_softmax_pv(st, s, v, rowok);
}
constexpr int NSA_NSLOT = 6, NSA_RING = 0, NSA_IMP = NSA_NSLOT * 16384, NSA_MSK = 131072 + 256, NSA_LIST = NSA_MSK + 256;
__device__ __forceinline__ void ldk_lds(KFrag& k, LAS const unsigned char* slot, int ko0, int ko1) {
#pragma unroll
    for (int tl = 0; tl < 4; ++tl) { const int o = (32 * (tl >> 1) + 4 * (tl & 1)) * 128; k.a[tl][0] = *(LAS const h16x8*)(slot + o + ko0); k.a[tl][1] = *(LAS const h16x8*)(slot + o + ko1); }
}
__device__ __forceinline__ void ldv_lds(VFrag& v, LAS const unsigned char* slot, int vo0, int vo1) {
#pragma unroll
    for (int dt = 0; dt < 4; ++dt) { v.a[dt][0] = *(LAS const h16x8*)(slot + 8192 + dt * 2048 + vo0); v.a[dt][1] = *(LAS const h16x8*)(slot + 8192 + dt * 2048 + vo1); }
}
#define NSA_WAITV(n) asm volatile("s_waitcnt vmcnt(" #n ")" ::: "memory")
#define NSA_BAR() do { asm volatile("s_waitcnt lgkmcnt(0)" ::: "memory"); __builtin_amdgcn_s_barrier(); asm volatile("" ::: "memory"); } while (0)
template <int LPT, class IssueF, class CompF>
__device__ __forceinline__ void nsa_stream2(int n, LAS unsigned char* dmaw, LAS unsigned char* ring, IssueF issue, CompF comp2) {
#pragma unroll
    for (int j = 0; j < 4; ++j) if (j < n) issue(j, (LAS unsigned*)(dmaw + j * 16384));
    int sa = 0, si = 4 * 16384;
    for (int t2 = 0; t2 < n; t2 += 2) {
        const int rem = n - t2 - 2;
        if (rem >= 2) { if (LPT == 2) NSA_WAITV(4); else NSA_WAITV(2); } else if (rem == 1) { if (LPT == 2) NSA_WAITV(2); else NSA_WAITV(1); } else NSA_WAITV(0);
        NSA_BAR();
        if (t2 + 4 < n) issue(t2 + 4, (LAS unsigned*)(dmaw + si));
        if (t2 + 5 < n) issue(t2 + 5, (LAS unsigned*)(dmaw + si + 16384));
        comp2(t2, (LAS const unsigned char*)(ring + sa), t2 + 1 < n, (LAS const unsigned char*)(ring + sa + 16384));
        sa = (sa == 4 * 16384) ? 0 : sa + 2 * 16384; si = (si == 4 * 16384) ? 0 : si + 2 * 16384; }
    NSA_BAR();
}
__device__ __forceinline__ void att_merge(AttSt& a, const AttSt& b2) {
    const float mn = fmaxf(a.m, b2.m); const float fa = __builtin_amdgcn_exp2f(a.m - mn), fb = __builtin_amdgcn_exp2f(b2.m - mn);
    a.m = mn; a.l = a.l * fa + b2.l * fb;
#pragma unroll
    for (int dt = 0; dt < 4; ++dt) a.o[dt] = a.o[dt] * fa + b2.o[dt] * fb;
}
__device__ __forceinline__ void nsa_block_unit(const h16* __restrict__ h, const h16* __restrict__ nqr, const h16* __restrict__ kcmp, const h16* __restrict__ vcmpT, const h16* __restrict__ vsT, const h16* __restrict__ vwT,
                                               const h16* __restrict__ ksR, const h16* __restrict__ kwR, h16* __restrict__ mix, int b, int g, int T0, LAS unsigned char* lds, int wv, int lane) {
    const int i = lane & 15, kg = lane >> 4, tt = i & 3, hh = i >> 2;
    const int t0 = T0 + 4 * wv, trow = t0 + tt; const size_t mrow = (size_t)b * T + trow;
    const int q = wv * 64 + lane, qrow = q >> 3, qch = q & 7;
    const int ksrc = qrow * 128 + ((qch ^ (((qrow >> 1) & 1) | (((qrow >> 3) & 3) << 1))) << 4), vsrc = qrow * 128 + ((qch ^ ((qrow >> 1) & 7)) << 4);
    const int gki = ((i >> 1) & 1) | ((i >> 2) << 1), gvi = (i >> 1) & 7;
    const int ko0 = (8 * (i >> 2) + (i & 3)) * 128 + ((kg ^ gki) << 4), ko1 = (8 * (i >> 2) + (i & 3)) * 128 + (((kg + 4) ^ gki) << 4);
    const int vo0 = i * 128 + ((kg ^ gvi) << 4), vo1 = i * 128 + (((kg + 4) ^ gvi) << 4);
    LAS unsigned char* ring = lds + NSA_RING; LAS unsigned char* dmaw = ring + wv * 1024;
    LAS float* impA = (LAS float*)(lds + NSA_IMP + wv * 4096); LAS float* impL = impA + 512;
    h16x8 qf[2], qrf[2];
    { const h16* qp = h + mrow * INP + C_NQ + (g * 4 + hh) * 64 + 8 * kg; qf[0] = *(const h16x8*)qp; qf[1] = *(const h16x8*)(qp + 32);
      const h16* qrp = nqr + mrow * 512 + (g * 4 + hh) * 64 + 8 * kg; qrf[0] = *(const h16x8*)qrp; qrf[1] = *(const h16x8*)(qrp + 32); }
    const h16* gp = h + mrow * INP + C_NG + (g * 4 + hh) * 3; const float gt0 = (float)gp[0], gt1 = (float)gp[1], gt2 = (float)gp[2];
    for (int x = lane; x < 1024; x += 64) impA[x] = 0.f;
    NSA_WAITV(0);
#define GLDS16(gsrc, ldst) __builtin_amdgcn_global_load_lds((const unsigned*)(gsrc), (ldst), 16, 0, 0)
    const int ncv_row = trow >= 31 ? ((trow - 31) >> 4) + 1 : 0;
    const int ncv_blk = (T0 + 31 >= 31) ? ((T0 + 31 - 31) >> 4) + 1 : 0;
    const int ncv_min = T0 >= 31 ? ((T0 - 31) >> 4) + 1 : 0;
    const int nct = (ncv_blk + 63) >> 6;
    const unsigned char* Kc = (const unsigned char*)(kcmp + (size_t)(b * 2 + g) * 512 * 64); const unsigned char* Vc = (const unsigned char*)(vcmpT + (size_t)(b * 2 + g) * 8 * 4096);
    float m = -1e30f, l = 0.f;
    f32x4 oc[4];
    float linv = 0.f;
    REPS(501) {
    m = -1e30f; l = 0.f;
#pragma unroll
    for (int dt = 0; dt < 4; ++dt) oc[dt] = (f32x4){0.f, 0.f, 0.f, 0.f};
    float mB = -1e30f, lB = 0.f;
    auto cmp1 = [&](int j, LAS const unsigned char* slot, float& mm, float& ll) {
        KFrag kf; ldk_lds(kf, slot, ko0, ko1);
        f32x4 s[4];
        if (64 * j + 63 < ncv_min) att_scores<false>(s, kf, qf, kg, [&](int) { return true; }); else att_scores<true>(s, kf, qf, kg, [&](int ko) { return j * 64 + ko < ncv_row; });
        const float mx = att_rowmax(s) * ATT_C2;
        const float mn = fmaxf(mm, mx); float ps0 = 0.f, ps1 = 0.f;
        _Pragma("unroll") for (int tl = 0; tl < 4; ++tl) { ps0 += __builtin_amdgcn_exp2f(__builtin_fmaf(s[tl][0], ATT_C2, -mn)) + __builtin_amdgcn_exp2f(__builtin_fmaf(s[tl][1], ATT_C2, -mn));
                                                          ps1 += __builtin_amdgcn_exp2f(__builtin_fmaf(s[tl][2], ATT_C2, -mn)) + __builtin_amdgcn_exp2f(__builtin_fmaf(s[tl][3], ATT_C2, -mn)); }
        ll = ll * __builtin_amdgcn_exp2f(mm - mn) + (ps0 + ps1); mm = mn; };
    nsa_stream2<1>(nct, dmaw, ring, [&](int j, LAS unsigned* dk) { GLDS16(Kc + (size_t)j * 8192 + ksrc, dk); }, [&](int j, LAS const unsigned char* sA, bool hasB, LAS const unsigned char* sB) {
        cmp1(j, sA, m, l); __builtin_amdgcn_sched_barrier(0); if (hasB) cmp1(j + 1, sB, mB, lB); });
    { const float mn = fmaxf(m, mB); l = l * __builtin_amdgcn_exp2f(m - mn) + lB * __builtin_amdgcn_exp2f(mB - mn); m = mn; }
    l = xsum4(l);
    linv = l > 0.f ? 1.f / l : 0.f;
    auto cmp2 = [&](int j, LAS const unsigned char* slot) {
        KFrag kf; ldk_lds(kf, slot, ko0, ko1); VFrag vf; ldv_lds(vf, slot, vo0, vo1);
        f32x4 s[4];
        if (64 * j + 63 < ncv_min) att_scores<false>(s, kf, qf, kg, [&](int) { return true; }); else att_scores<true>(s, kf, qf, kg, [&](int ko) { return j * 64 + ko < ncv_row; });
        _Pragma("unroll") for (int tl = 0; tl < 4; ++tl) {
            _Pragma("unroll") for (int r = 0; r < 4; ++r) s[tl][r] = __builtin_amdgcn_exp2f(__builtin_fmaf(s[tl][r], ATT_C2, -m)) * linv;
            float A = (s[tl][0] + s[tl][1]) + (s[tl][2] + s[tl][3]), L = s[tl][3];
            A += __shfl_xor(A, 4); A += __shfl_xor(A, 8); L += __shfl_xor(L, 4); L += __shfl_xor(L, 8);
            if (hh == 0) { const int u = j * 16 + 8 * (tl >> 1) + 2 * kg + (tl & 1); impA[tt * 128 + u] = A; impL[tt * 128 + u] = L; } }
        att_pv(oc, s, vf); };
    nsa_stream2<2>(nct, dmaw, ring, [&](int j, LAS unsigned* dk) { GLDS16(Kc + (size_t)j * 8192 + ksrc, dk); GLDS16(Vc + (size_t)j * 8192 + vsrc, (LAS unsigned*)((LAS unsigned char*)dk + 8192)); },
        [&](int j, LAS const unsigned char* sA, bool hasB, LAS const unsigned char* sB) { cmp2(j, sA); if (hasB) cmp2(j + 1, sB); });
    }
    const int cur = T0 >> 6;
    AttSt sw;
    REPS(504) {
    sw.m = -1e30f; sw.l = 0.f;
#pragma unroll
    for (int dt = 0; dt < 4; ++dt) sw.o[dt] = (f32x4){0.f, 0.f, 0.f, 0.f};
    {
        const unsigned char* Kw = (const unsigned char*)(kwR + (size_t)((b * 2 + g) * 128) * 4096); const unsigned char* Vw = (const unsigned char*)(vwT + (size_t)((b * 2 + g) * 128) * 4096);
        const int s0w = (T0 >= 511 ? (T0 - 511) >> 6 : 0);
        AttSt swB; swB.m = -1e30f; swB.l = 0.f;
#pragma unroll
        for (int dt = 0; dt < 4; ++dt) swB.o[dt] = (f32x4){0.f, 0.f, 0.f, 0.f};
        auto wsc = [&](f32x4 (&s)[4], int j, LAS const unsigned char* slot) { KFrag kf; ldk_lds(kf, slot, ko0, ko1); const int sx = s0w + j;
            if (sx > s0w + 1 && sx < cur) att_scores<false>(s, kf, qrf, kg, [&](int) { return true; });
            else att_scores<true>(s, kf, qrf, kg, [&](int ko) { const int kp = 64 * sx + ko; return kp <= trow && kp >= trow - 511; }); };
        nsa_stream2<2>(cur - s0w + 1, dmaw, ring, [&](int j, LAS unsigned* dk) { GLDS16(Kw + (size_t)(s0w + j) * 8192 + ksrc, dk); GLDS16(Vw + (size_t)(s0w + j) * 8192 + vsrc, (LAS unsigned*)((LAS unsigned char*)dk + 8192)); },
            [&](int j, LAS const unsigned char* sA, bool hasB, LAS const unsigned char* sB) {
                if (hasB) { f32x4 s0[4], s1[4]; wsc(s0, j, sA); wsc(s1, j + 1, sB); __builtin_amdgcn_sched_barrier(0);
                    { VFrag vf; ldv_lds(vf, sA, vo0, vo1); att_softmax_pv(sw, s0, vf, true); } { VFrag vf; ldv_lds(vf, sB, vo0, vo1); att_softmax_pv(swB, s1, vf, true); } }
                else { f32x4 s0[4]; wsc(s0, j, sA); VFrag vf; ldv_lds(vf, sA, vo0, vo1); att_softmax_pv(sw, s0, vf, true); } });
        att_merge(sw, swB);
    }
    }
    unsigned long long mylo, myhi, anylo, anyhi;
    if (cur <= 15) { mylo = anylo = (1ull << (cur + 1)) - 1ull; myhi = anyhi = 0ull; }
    else {
        mylo = myhi = anylo = anyhi = 0ull;
        const unsigned long long flo = 1ull | (cur < 64 ? (1ull << cur) : 0ull) | (cur - 1 < 64 ? (1ull << (cur - 1)) : 0ull);
        const unsigned long long fhi = (cur >= 64 ? (1ull << (cur - 64)) : 0ull) | (cur - 1 >= 64 ? (1ull << (cur - 65)) : 0ull);
        const unsigned long long lmask = (1ull << lane) - 1ull;
        for (int tk = 0; tk < 4; ++tk) {
            const int s0 = lane, s1 = lane + 64;
            const float v0 = impA[tk * 128 + s0] + (s0 > 0 ? impL[tk * 128 + s0 - 1] : 0.f), v1 = impA[tk * 128 + s1] + impL[tk * 128 + s1 - 1];
            const unsigned b0 = (s0 >= 1 && s0 <= cur - 2) ? __float_as_uint(v0) + 1u : 0u, b1 = (s1 <= cur - 2) ? __float_as_uint(v1) + 1u : 0u;
            unsigned Tq = 0u;
            for (int bit = 30; bit >= 0; --bit) { const unsigned T2 = Tq | (1u << bit);
                const int c = __popcll(__ballot(b0 >= T2)) + __popcll(__ballot(b1 >= T2)); if (c >= 13) Tq = T2; }
            const unsigned long long gtlo = __ballot(b0 > Tq), gthi = __ballot(b1 > Tq), eqlo = __ballot(b0 == Tq), eqhi = __ballot(b1 == Tq);
            const int need = 13 - (__popcll(gtlo) + __popcll(gthi));
            const bool t0q = (b0 == Tq) && (__popcll(eqlo & lmask) < need), t1q = (b1 == Tq) && (__popcll(eqlo) + __popcll(eqhi & lmask) < need);
            const unsigned long long lo = gtlo | __ballot(t0q) | flo, hi = gthi | __ballot(t1q) | fhi;
            anylo |= lo; anyhi |= hi; if (tt == tk) { mylo = lo; myhi = hi; }
        }
    }
    LAS unsigned long long* msk = (LAS unsigned long long*)(lds + NSA_MSK); LAS unsigned char* lst = lds + NSA_LIST; LAS int* nlst = (LAS int*)(lds + NSA_LIST + 128);
    if (lane == 0) { msk[2 * wv] = anylo; msk[2 * wv + 1] = anyhi; }
    NSA_BAR();
    if (wv == 0) {
        unsigned long long ulo = 0ull, uhi = 0ull;
#pragma unroll
        for (int w2 = 0; w2 < 8; ++w2) { ulo |= msk[2 * w2]; uhi |= msk[2 * w2 + 1]; }
        const unsigned long long lmask = (1ull << lane) - 1ull; const int nlo = __popcll(ulo);
        if ((ulo >> lane) & 1ull) lst[__popcll(ulo & lmask)] = (unsigned char)lane;
        if ((uhi >> lane) & 1ull) lst[nlo + __popcll(uhi & lmask)] = (unsigned char)(64 + lane);
        if (lane == 0) nlst[0] = nlo + __popcll(uhi);
    }
    NSA_BAR();
    const int nsel = nlst[0];
    AttSt ss;
    REPS(503) {
    ss.m = -1e30f; ss.l = 0.f;
#pragma unroll
    for (int dt = 0; dt < 4; ++dt) ss.o[dt] = (f32x4){0.f, 0.f, 0.f, 0.f};
    {
        const unsigned char* Ks = (const unsigned char*)(ksR + (size_t)((b * 2 + g) * 128) * 4096); const unsigned char* Vs = (const unsigned char*)(vsT + (size_t)((b * 2 + g) * 128) * 4096);
        auto sel1 = [&](int s, LAS const unsigned char* slot, AttSt& st) {
            KFrag kf; ldk_lds(kf, slot, ko0, ko1); VFrag vf; ldv_lds(vf, slot, vo0, vo1);
            const bool mybit = (((s < 64 ? mylo : myhi) >> (s & 63)) & 1ull) != 0ull;
            if (s < cur) att_tile<false>(st, kf, vf, qrf, kg, mybit, [&](int) { return true; });
            else att_tile<true>(st, kf, vf, qrf, kg, mybit, [&](int ko) { return 64 * s + ko <= trow; }); };
        nsa_stream2<2>(nsel, dmaw, ring, [&](int j, LAS unsigned* dk) { const int sj = lst[j]; GLDS16(Ks + (size_t)sj * 8192 + ksrc, dk); GLDS16(Vs + (size_t)sj * 8192 + vsrc, (LAS unsigned*)((LAS unsigned char*)dk + 8192)); },
            [&](int j, LAS const unsigned char* sA, bool hasB, LAS const unsigned char* sB) {
                const int s0 = lst[j]; const int s1 = hasB ? (int)lst[j + 1] : 0;
                const bool nA = (((s0 < 64 ? anylo : anyhi) >> (s0 & 63)) & 1ull) != 0ull, nB = hasB && ((((s1 < 64 ? anylo : anyhi) >> (s1 & 63)) & 1ull) != 0ull);
                if (nA) sel1(s0, sA, ss);
                if (nB) sel1(s1, sB, ss); });
    }
    }
    const float ls = xsum4(ss.l), lw = xsum4(sw.l);
    const float g0 = sigmf(gt0), g1 = sigmf(gt1) / ls, g2 = sigmf(gt2) / lw;
#pragma unroll
    for (int dt = 0; dt < 4; ++dt) { const f32x4 o = oc[dt] * g0 + ss.o[dt] * g1 + sw.o[dt] * g2;
        *(h16x4*)(mix + mrow * D + 512 + (g * 4 + hh) * 64 + 16 * dt + 4 * kg) = __builtin_convertvector(o, h16x4); }
#undef GLDS16
}

__device__ __forceinline__ void b_ln(const float* __restrict__ in, const float* __restrict__ gam, const float* __restrict__ bet, float* __restrict__ o32, h16* __restrict__ o16) {
    const int lane = tidx() & 63;
    for (int row = blockIdx.x * 8 + (tidx() >> 6); row < M; row += gridDim.x * 8) {
        const f32x4* xr = (const f32x4*)(in + (size_t)row * D) + lane;
        f32x4 v[4]; float s = 0.f;
#pragma unroll
        for (int j = 0; j < 4; ++j) { v[j] = xr[64 * j]; s += (v[j][0] + v[j][1]) + (v[j][2] + v[j][3]); }
        const float mean = wave_sum(s) * (1.f / D); float s2 = 0.f;
#pragma unroll
        for (int j = 0; j < 4; ++j) { v[j] = v[j] - mean; s2 += (v[j][0] * v[j][0] + v[j][1] * v[j][1]) + (v[j][2] * v[j][2] + v[j][3] * v[j][3]); }
        const float rstd = rsqrtf(wave_sum(s2) * (1.f / D) + LN_EPS);
#pragma unroll
        for (int j = 0; j < 4; ++j) { const f32x4 gg = ((const f32x4*)gam)[lane + 64 * j], bb = ((const f32x4*)bet)[lane + 64 * j]; const f32x4 o = v[j] * rstd * gg + bb;
            ((f32x4*)(o32 + (size_t)row * D))[lane + 64 * j] = o;
            if (o16) ((h16x4*)(o16 + (size_t)row * D))[lane + 64 * j] = __builtin_convertvector(o, h16x4); }
    }
}

__device__ __forceinline__ void xattn_block(const h16* __restrict__ qx, const h16* __restrict__ kx, const h16* __restrict__ kvmVT, h16* __restrict__ ox, int G, int bid, LAS unsigned char* lds, int wv, int lane) {
    const int i = lane & 15, kg = lane >> 4;
    const int gki = ((i >> 1) & 1) | ((i >> 2) << 1), gvi = (i >> 1) & 7;
    const int ko0 = (8 * (i >> 2) + (i & 3)) * 512 + ((kg ^ gki) << 4), ko1 = (8 * (i >> 2) + (i & 3)) * 512 + (((kg + 4) ^ gki) << 4);
    const int vo0 = i * 128 + ((kg ^ gvi) << 4), vo1 = i * 128 + (((kg + 4) ^ gvi) << 4);
    const int t = wv * 64 + lane;
    int ksrc[4], vsrc[4];
#pragma unroll
    for (int pz = 0; pz < 4; ++pz) { const int q = pz * 512 + t;
        { const int row = q >> 5, cp = q & 31; const int gk = ((row >> 1) & 1) | (((row >> 3) & 3) << 1); ksrc[pz] = row * 512 + ((cp ^ gk) << 4); }
        { const int row = q >> 3, cp = q & 7; vsrc[pz] = row * 512 + ((cp ^ ((row >> 1) & 7)) << 4); } }
    const int nun = ((M / 128) * 4 - bid + G - 1) / G;
    const int ntile = nun * 4;
    auto issue = [&](int tix, int slot) { const int u = bid + G * (tix >> 2), grp = tix & 3; const int m0 = (u >> 2) * 128, hh = u & 3, b = m0 >> 13;
        const unsigned char* Kb = (const unsigned char*)(kx + ((size_t)(b * 4 + hh) * MEML + 64 * grp) * 256); const unsigned char* Vb = (const unsigned char*)(kvmVT + (size_t)((b * 4 + hh) * 256) * MEML + 64 * grp);
        LAS unsigned char* base = lds + slot * 65536 + wv * 1024;
#pragma unroll
        for (int pz = 0; pz < 4; ++pz) { __builtin_amdgcn_global_load_lds((const unsigned*)(Kb + ksrc[pz]), (LAS unsigned*)(base + pz * 8192), 16, 0, 0);
                                        __builtin_amdgcn_global_load_lds((const unsigned*)(Vb + vsrc[pz]), (LAS unsigned*)(base + 32768 + pz * 8192), 16, 0, 0); } };
    NSA_WAITV(0);
    if (ntile > 0) issue(0, 0);
    h16x8 qf[8]; f32x4 o[16]; float mrun = -1e30f, l = 0.f; size_t mrow = 0; int hh = 0;
    for (int tix = 0; tix < ntile; ++tix) {
        const int grp = tix & 3, slot = tix & 1;
        if (grp == 0) {
            const int u = bid + G * (tix >> 2); mrow = (size_t)((u >> 2) * 128 + wv * 16 + i); hh = u & 3;
#pragma unroll
            for (int ks = 0; ks < 8; ++ks) qf[ks] = *(const h16x8*)(qx + mrow * D + hh * 256 + 32 * ks + 8 * kg);
#pragma unroll
            for (int dt = 0; dt < 16; ++dt) o[dt] = (f32x4){0.f, 0.f, 0.f, 0.f};
            mrun = -1e30f; l = 0.f;
        }
        NSA_WAITV(0);
        NSA_BAR();
        if (tix + 1 < ntile) issue(tix + 1, slot ^ 1);
        LAS const unsigned char* sk = lds + slot * 65536; LAS const unsigned char* sv = sk + 32768;
        f32x4 s[4];
#pragma unroll
        for (int tl = 0; tl < 4; ++tl) { const int ro = (32 * (tl >> 1) + 4 * (tl & 1)) * 512; f32x4 acc = {0.f, 0.f, 0.f, 0.f};
#pragma unroll
            for (int ks = 0; ks < 8; ++ks) acc = __builtin_amdgcn_mfma_f32_16x16x32_f16(*(LAS const h16x8*)(sk + ro + 128 * (ks >> 1) + ((ks & 1) ? ko1 : ko0)), qf[ks], acc, 0, 0, 0);
            s[tl] = acc; }
        const float mx = att_rowmax(s) * (0.0625f * 1.4426950408889634f);
        const float mn = fmaxf(mrun, mx); const float alpha = __builtin_amdgcn_exp2f(mrun - mn); mrun = mn;
        float ps = 0.f; h16x8 pf[2];
#pragma unroll
        for (int tl = 0; tl < 4; ++tl)
#pragma unroll
            for (int r = 0; r < 4; ++r) { const float pe = __builtin_amdgcn_exp2f(__builtin_fmaf(s[tl][r], 0.0625f * 1.4426950408889634f, -mn)); ps += pe; pf[tl >> 1][4 * (tl & 1) + r] = (h16)pe; }
        l = l * alpha + ps;
#pragma unroll
        for (int dt = 0; dt < 16; ++dt) { f32x4 acc = o[dt] * alpha;
            acc = __builtin_amdgcn_mfma_f32_16x16x32_f16(*(LAS const h16x8*)(sv + dt * 2048 + vo0), pf[0], acc, 0, 0, 0);
            acc = __builtin_amdgcn_mfma_f32_16x16x32_f16(*(LAS const h16x8*)(sv + dt * 2048 + vo1), pf[1], acc, 0, 0, 0);
            o[dt] = acc; }
        if (grp == 3) { const float linv = 1.f / xsum4(l);
#pragma unroll
            for (int dt = 0; dt < 16; ++dt) { const f32x4 acc = o[dt] * linv; *(h16x4*)(ox + mrow * D + hh * 256 + 16 * dt + 4 * kg) = __builtin_convertvector(acc, h16x4); } }
    }
    NSA_WAITV(0);
    NSA_BAR();
}

__device__ __forceinline__ void route_token(float logit, int m, int lane, const float* __restrict__ rbias, int* __restrict__ tope, float* __restrict__ topw, int* __restrict__ hist) {
    const float score = 1.f / (1.f + expf(-logit)); const float biased = score + rbias[lane];
    float m1 = biased; m1 = fmaxf(m1, __shfl_xor(m1, 1)); m1 = fmaxf(m1, __shfl_xor(m1, 2)); m1 = fmaxf(m1, __shfl_xor(m1, 4));
    int am = (biased == m1) ? lane : 999; am = min(am, __shfl_xor(am, 1)); am = min(am, __shfl_xor(am, 2)); am = min(am, __shfl_xor(am, 4));
    float m2 = (lane == am) ? -INFINITY : biased; m2 = fmaxf(m2, __shfl_xor(m2, 1)); m2 = fmaxf(m2, __shfl_xor(m2, 2)); m2 = fmaxf(m2, __shfl_xor(m2, 4));
    const float gs = m1 + m2;
    int cnt = 0;
#pragma unroll
    for (int gq = 0; gq < 8; ++gq) { const float o = __shfl(gs, gq * 8); cnt += (o > gs) ? 1 : 0; }
    const float masked = (cnt <= 3) ? biased : NEGF;
    int rank = 0;
    for (int e2 = 0; e2 < 64; ++e2) { const float o = __shfl(masked, e2); rank += (o > masked || (o == masked && e2 < lane)) ? 1 : 0; }
    const bool selq = rank < 8;
    const float wsum = wave_sum(selq ? score : 0.f);
    if (selq) { tope[(size_t)m * 8 + rank] = lane; topw[(size_t)m * 8 + rank] = score / wsum * 2.5f; atomicAdd(hist + (m >> 13) * 65 + lane, 1); }
}
__device__ __forceinline__ void router_unit(const Params& p, const float* __restrict__ pre, h16* __restrict__ x2h, const h16* __restrict__ WrTh, const h16* __restrict__ WrTl, int* __restrict__ tope, float* __restrict__ topw,
                                            int* __restrict__ hist, int m0, LAS float* lg, int lane) {
    const int i = lane & 15, kg = lane >> 4;
    const float* xr = pre + (size_t)(m0 + i) * D + 8 * kg;
    float s1 = 0.f, s2 = 0.f;
#pragma unroll 4
    for (int ks = 0; ks < 32; ++ks) { const f32x4 x0 = *(const f32x4*)(xr + 32 * ks), x1 = *(const f32x4*)(xr + 32 * ks + 4);
        s1 += (x0[0] + x0[1]) + (x0[2] + x0[3]) + (x1[0] + x1[1]) + (x1[2] + x1[3]);
        s2 += (x0[0] * x0[0] + x0[1] * x0[1]) + (x0[2] * x0[2] + x0[3] * x0[3]) + (x1[0] * x1[0] + x1[1] * x1[1]) + (x1[2] * x1[2] + x1[3] * x1[3]); }
    s1 = xsum4(s1); s2 = xsum4(s2);
    const float mean = s1 * (1.f / D); const float rstd = rsqrtf(fmaxf(s2 * (1.f / D) - mean * mean, 0.f) + LN_EPS);
    f32x4 am_[4], ac_[4];
#pragma unroll
    for (int et = 0; et < 4; ++et) { am_[et] = (f32x4){0.f, 0.f, 0.f, 0.f}; ac_[et] = (f32x4){0.f, 0.f, 0.f, 0.f}; }
    h16* xo = x2h + (size_t)(m0 + i) * D + 8 * kg;
#pragma unroll 2
    for (int ks = 0; ks < 32; ++ks) {
        f32x4 x0 = *(const f32x4*)(xr + 32 * ks), x1 = *(const f32x4*)(xr + 32 * ks + 4);
        const f32x4 g0 = *(const f32x4*)(p.ln2g + 32 * ks + 8 * kg), g1 = *(const f32x4*)(p.ln2g + 32 * ks + 8 * kg + 4), b0 = *(const f32x4*)(p.ln2b + 32 * ks + 8 * kg), b1 = *(const f32x4*)(p.ln2b + 32 * ks + 8 * kg + 4);
        x0 = (x0 - mean) * rstd * g0 + b0; x1 = (x1 - mean) * rstd * g1 + b1;
        h16x8 xh, xl;
#pragma unroll
        for (int j = 0; j < 4; ++j) { xh[j] = (h16)x0[j]; xl[j] = (h16)((x0[j] - (float)xh[j]) * 2048.f); xh[4 + j] = (h16)x1[j]; xl[4 + j] = (h16)((x1[j] - (float)xh[4 + j]) * 2048.f); }
        *(h16x8*)(xo + 32 * ks) = xh;
#pragma unroll
        for (int et = 0; et < 4; ++et) { const h16x8 wh = *(const h16x8*)(WrTh + (size_t)(16 * et + i) * D + 32 * ks + 8 * kg), wl = *(const h16x8*)(WrTl + (size_t)(16 * et + i) * D + 32 * ks + 8 * kg);
            am_[et] = __builtin_amdgcn_mfma_f32_16x16x32_f16(wh, xh, am_[et], 0, 0, 0);
            ac_[et] = __builtin_amdgcn_mfma_f32_16x16x32_f16(wh, xl, ac_[et], 0, 0, 0);
            ac_[et] = __builtin_amdgcn_mfma_f32_16x16x32_f16(wl, xh, ac_[et], 0, 0, 0); }
    }
#pragma unroll
    for (int et = 0; et < 4; ++et)
#pragma unroll
        for (int r = 0; r < 4; ++r) lg[i * 64 + 16 * et + 4 * kg + r] = am_[et][r] + ac_[et][r] * (1.f / 2048.f);
    for (int tk = 0; tk < 16; ++tk) route_token(lg[tk * 64 + lane], m0 + tk, lane, p.rbias, tope, topw, hist);
}

__device__ __forceinline__ void b_moe(const Params& p, const float* __restrict__ x2, const int* __restrict__ tope, const float* __restrict__ topw, float* __restrict__ out, int m, float* sl, int tid) {
    float* xs = sl; float* hd = sl + 1024; float* red = sl + 1280;
    for (int i = tid; i < 1024; i += 256) xs[i] = x2[(size_t)m * D + i];
    __syncthreads();
    float acc[4] = {0.f, 0.f, 0.f, 0.f};
    for (int kx = 0; kx < 9; ++kx) {
        const float* G; const float* U; const float* Dn; float wt;
        if (kx < 8) { const int e = tope[(size_t)m * 8 + kx]; wt = topw[(size_t)m * 8 + kx]; G = p.w_gate + (size_t)e * D * EFF; U = p.w_up + (size_t)e * D * EFF; Dn = p.w_down + (size_t)e * EFF * D; }
        else { wt = 1.f; G = p.ws_gate; U = p.ws_up; Dn = p.ws_down; }
        float a = 0.f, u = 0.f;
        for (int k = 0; k < D; ++k) { const float xv = xs[k]; a += xv * G[(size_t)k * EFF + tid]; u += xv * U[(size_t)k * EFF + tid]; }
        hd[tid] = siluf(a) * u * wt;
        __syncthreads();
        for (int j = 0; j < EFF; ++j) { const float hv = hd[j]; const float* dr = Dn + (size_t)j * D + tid;
            acc[0] += hv * dr[0]; acc[1] += hv * dr[256]; acc[2] += hv * dr[512]; acc[3] += hv * dr[768]; }
        __syncthreads();
    }
    float v[4]; float s = 0.f;
#pragma unroll
    for (int i = 0; i < 4; ++i) { v[i] = DN_ALPHA * xs[tid + 256 * i] + acc[i]; s += v[i]; }
    s = wave_sum(s); if ((tid & 63) == 0) red[tid >> 6] = s; __syncthreads();
    const float mean = (red[0] + red[1] + red[2] + red[3]) * (1.f / D); float s2 = 0.f;
#pragma unroll
    for (int i = 0; i < 4; ++i) { v[i] -= mean; s2 += v[i] * v[i]; }
    s2 = wave_sum(s2); if ((tid & 63) == 0) red[4 + (tid >> 6)] = s2; __syncthreads();
    const float rstd = rsqrtf((red[4] + red[5] + red[6] + red[7]) * (1.f / D) + LN_EPS);
#pragma unroll
    for (int i = 0; i < 4; ++i) out[(size_t)m * D + tid + 256 * i] = v[i] * rstd * p.ln3g[tid + 256 * i] + p.ln3b[tid + 256 * i];
    __syncthreads();
}

struct G1Sched {
    const int* ctl; const char* x2h; const unsigned* rowoff; const char* WguT; int G, c;
    __device__ bool next(int i, pg8::Unit& u) const {
        const int ntile = ctl[CTL_TQS + NQ]; const long L = (long)i * G + c; if (L >= 2L * ntile) return false;
        const int tile = (int)(L >> 1), pn = (int)(L & 1); const int e = ctl[CTL_TVE + tile] % 65;
        u.pm = tile; u.pn = pn; u.A = x2h; u.gat = rowoff + (size_t)tile * 256; u.B = WguT + ((size_t)e * 512 + pn * 256) * (D * 2); return true; }
};
struct G2Sched {
    const int* ctl; const char* H; const char* WdT; int q, G, c;
    __device__ bool next(int i, pg8::Unit& u) const {
        const int t0 = ctl[CTL_TQS + q], t1 = ctl[CTL_TQS + q + 1]; const long L = (long)i * G + c; if (L >= 4L * (t1 - t0)) return false;
        const int tile = t0 + (int)(L >> 2), pn = (int)(L & 3); const int e = ctl[CTL_TVE + tile] % 65;
        u.pm = tile; u.pn = pn; u.A = H + (size_t)tile * 256 * (EFF * 2); u.gat = nullptr; u.B = WdT + ((size_t)e * D + pn * 256) * (EFF * 2); return true; }
};
__device__ __forceinline__ void b_scatter(int* __restrict__ ctl, const int* __restrict__ tope, const float* __restrict__ topw, unsigned* __restrict__ rowoff, u32x2* __restrict__ rowmeta, int* sl) {
    int* pst = sl;
    int* pc = sl + 512;
    for (int v = tidx(); v < NVE; v += NTHR) pc[v] = (ctl[CTL_CNT + v] + 255) & ~255;
    __syncthreads();
    for (int v = tidx(); v <= NVE; v += NTHR) { int acc = 0; for (int u = 0; u < v; ++u) acc += pc[u]; pst[v] = acc; }
    __syncthreads();
    if (blockIdx.x == 0) {
        for (int v = tidx(); v <= NVE; v += NTHR) ctl[CTL_PST + v] = pst[v];
        if (tidx() <= NQ) ctl[CTL_TQS + tidx()] = pst[tidx() * 65] >> 8;
        for (int v = tidx(); v < NVE; v += NTHR) for (int tl = pst[v] >> 8; tl < (pst[v + 1] >> 8); ++tl) ctl[CTL_TVE + tl] = v;
    }
    for (int idx = blockIdx.x * NTHR + tidx(); idx < M * 9; idx += gridDim.x * NTHR) {
        int m, k, pos; float w;
        if (idx < M * 8) { m = idx >> 3; k = idx & 7; const int ve = (m >> 13) * 65 + tope[idx]; w = topw[idx]; pos = pst[ve] + atomicAdd(ctl + CTL_CUR + ve, 1); }
        else { m = idx - M * 8; k = 8; w = 1.f; pos = pst[(m >> 13) * 65 + 64] + (m & (QT - 1)); }
        rowoff[pos] = (unsigned)m * (D * 2); rowmeta[pos] = (u32x2){(unsigned)((m & (QT - 1)) * 9 + k), __float_as_uint(w)};
    }
    __syncthreads();
}
__device__ __forceinline__ void b_combine(const Params& p, const h16* __restrict__ x2h, const h16* __restrict__ Y, int q) {
    const int lane = tidx() & 63;
    for (int r = blockIdx.x * 8 + (tidx() >> 6); r < QT; r += gridDim.x * 8) {
        const int m = q * QT + r;
        float v[16];
        { const h16x8 a = ((const h16x8*)(x2h + (size_t)m * D))[lane], b = ((const h16x8*)(x2h + (size_t)m * D))[lane + 64];
#pragma unroll
          for (int i = 0; i < 8; ++i) { v[i] = DN_ALPHA * (float)a[i]; v[8 + i] = DN_ALPHA * (float)b[i]; } }
#pragma unroll
        for (int k = 0; k < 9; ++k) { const h16x8* yr = (const h16x8*)(Y + ((size_t)r * 9 + k) * D); const h16x8 a = yr[lane], b = yr[lane + 64];
#pragma unroll
            for (int i = 0; i < 8; ++i) { v[i] += (float)a[i]; v[8 + i] += (float)b[i]; } }
        float s = 0.f;
#pragma unroll
        for (int i = 0; i < 16; ++i) s += v[i];
        const float mean = wave_sum(s) * (1.f / D); float s2 = 0.f;
#pragma unroll
        for (int i = 0; i < 16; ++i) { v[i] -= mean; s2 += v[i] * v[i]; }
        const float rstd = rsqrtf(wave_sum(s2) * (1.f / D) + LN_EPS);
#pragma unroll
        for (int hlf = 0; hlf < 2; ++hlf) { const int c0 = (lane + 64 * hlf) * 8;
            const f32x4 g0 = *(const f32x4*)(p.ln3g + c0), g1 = *(const f32x4*)(p.ln3g + c0 + 4), b0 = *(const f32x4*)(p.ln3b + c0), b1 = *(const f32x4*)(p.ln3b + c0 + 4);
            f32x4 o0, o1;
#pragma unroll
            for (int i = 0; i < 4; ++i) { o0[i] = v[8 * hlf + i] * rstd * g0[i] + b0[i]; o1[i] = v[8 * hlf + 4 + i] * rstd * g1[i] + b1[i]; }
            *(f32x4*)(p.out + (size_t)m * D + c0) = o0; *(f32x4*)(p.out + (size_t)m * D + c0 + 4) = o1; }
    }
}

#define XB_TMO      128
#define XB_XCNT(j)  (256  + 64 * (j))
#define XB_XSUB(j)  (1280 + 64 * (j))
#define XB_XGEN(j)  (2304 + 64 * (j))
#define XB_TOP      3328
#define XB_TOPGEN   3392
#define XCD_BAR_WORDS 3456
#define XB_SPIN_CAP (1u << 22)
__device__ __forceinline__ unsigned xb_ld(unsigned* p)              { return __hip_atomic_load(p, __ATOMIC_RELAXED, __HIP_MEMORY_SCOPE_AGENT); }
__device__ __forceinline__ unsigned xb_add(unsigned* p, unsigned v) { return __hip_atomic_fetch_add(p, v, __ATOMIC_RELAXED, __HIP_MEMORY_SCOPE_AGENT); }
__device__ __forceinline__ unsigned xb_xcc_id() { return (unsigned)__builtin_amdgcn_s_getreg((3 << 11) | 20) & 0xFu; }
#define XB_SPIN(cond, bar) do { unsigned _sp = 0; while (cond) { __builtin_amdgcn_s_sleep(1); \
    if ((++_sp & 255u) == 0u) { if (xb_ld(&(bar)[XB_TMO])) break; if (_sp > XB_SPIN_CAP) { atomicAdd(&(bar)[XB_TMO], 1u); break; } } } } while (0)
struct XcdBarrier { unsigned* bar; unsigned x; volatile LAS unsigned* st; };
__device__ __forceinline__ XcdBarrier xcd_barrier_post(unsigned* bar, volatile LAS unsigned* st) {
    XcdBarrier b; b.bar = bar; b.x = xb_xcc_id(); b.st = st;
    if (threadIdx.x == 0) (void)xb_add(&bar[XB_XCNT(b.x)], 1u);
    return b;
}
__device__ __forceinline__ void xcd_barrier_complete(unsigned* bar, unsigned x, unsigned& nloc, unsigned& nx) {
    const unsigned G = gridDim.x * gridDim.y * gridDim.z;
    unsigned sum, cnt, mine, sp = 0u;
    for (;;) {
        sum = 0u; cnt = 0u; mine = 0u;
#pragma unroll
        for (unsigned j = 0; j < 16; ++j) { const unsigned c = xb_ld(&bar[XB_XCNT(j)]); sum += c; cnt += (c > 0u) ? 1u : 0u; mine = (j == x) ? c : mine; }
        if (sum == G) break;
        __builtin_amdgcn_s_sleep(1);
        if ((++sp & 255u) == 0u) { if (xb_ld(&bar[XB_TMO])) break; if (sp > XB_SPIN_CAP) { atomicAdd(&bar[XB_TMO], 1u); break; } }
    }
    nloc = mine > 0u ? mine : 1u; nx = cnt > 0u ? cnt : 1u;
}
__device__ __forceinline__ void xcd_barrier(const XcdBarrier& b) {
    asm volatile("s_waitcnt vmcnt(0)" ::: "memory");
    __syncthreads();
    if (threadIdx.x == 0) {
        unsigned* bar = b.bar;
        __builtin_amdgcn_s_waitcnt(0);
        unsigned nloc = b.st[0], nx = b.st[1];
        if (nloc == 0u) { xcd_barrier_complete(bar, b.x, nloc, nx); b.st[0] = nloc; b.st[1] = nx; }
        const unsigned old = xb_add(&bar[XB_XSUB(b.x)], 1u);
        const unsigned gen = old / nloc;
        if (old + 1u == (gen + 1u) * nloc) {
            __builtin_amdgcn_fence(__ATOMIC_RELEASE, "agent");
            asm volatile("s_waitcnt vmcnt(0)" ::: "memory");
            const unsigned og = xb_add(&bar[XB_TOP], 1u);
            const unsigned tg = og / nx;
            if (og + 1u == (tg + 1u) * nx) xb_add(&bar[XB_TOPGEN], 1u);
            else XB_SPIN(xb_ld(&bar[XB_TOPGEN]) == tg, bar);
            __builtin_amdgcn_fence(__ATOMIC_ACQUIRE, "agent");
            xb_add(&bar[XB_XGEN(b.x)], 1u);
            asm volatile("s_waitcnt vmcnt(0)" ::: "memory");
        } else {
            XB_SPIN(xb_ld(&bar[XB_XGEN(b.x)]) == gen, bar);
            __builtin_amdgcn_fence(__ATOMIC_ACQUIRE, "agent");
            asm volatile("s_waitcnt vmcnt(0)" ::: "memory");
        }
    }
    __syncthreads();
}

constexpr int N_PHASES = 23;

__global__ void __launch_bounds__(NTHR, 2) mega_fwd(Params p) {
    extern __shared__ __attribute__((aligned(16))) unsigned char lds[];
    cg::grid_group grid = cg::this_grid();
    const int G = (int)gridDim.x, bid = (int)blockIdx.x;
#define tid tidx()
    unsigned char* ws = p.ws;
    h16* WinT = (h16*)(ws + WS_WIN); h16* WoutT = (h16*)(ws + WS_WOUT); h16* WxqT = (h16*)(ws + WS_WXQ); h16* WxoT = (h16*)(ws + WS_WXO); h16* WxkvT = (h16*)(ws + WS_WXKV);
    h16* memh = (h16*)(ws + WS_MEMH); h16* kvm = (h16*)(ws + WS_KVM); h16* kcmp = (h16*)(ws + WS_KCMP); h16* vcmpT = (h16*)(ws + WS_VCMP); h16* vsT = (h16*)(ws + WS_VST); h16* vwT = (h16*)(ws + WS_VWT);
    int* tope = (int*)(ws + WS_TOPE); float* topw = (float*)(ws + WS_TOPW);
    h16* xh = (h16*)(ws + WS_XH); h16* mix = (h16*)(ws + WS_MIX); h16* ox = (h16*)(ws + WS_OX); h16* hb = (h16*)(ws + WS_H); h16* nqr = (h16*)(ws + WS_NQR);
    float* kvb = (float*)(ws + WS_KVB); h16* prevT = (h16*)(ws + WS_PREVT);
    float* cosr = (float*)(ws + WS_COSR); float* sinr = (float*)(ws + WS_SINR); float* cosn = (float*)(ws + WS_COSN); float* sinn = (float*)(ws + WS_SINN); h16* kvmVT = (h16*)(ws + WS_KVMVT); h16* WrTh = (h16*)(ws + WS_WRTH); h16* WrTl = (h16*)(ws + WS_WRTL); h16* Wc1T = (h16*)(ws + WS_WC1T); h16* hid = (h16*)(ws + WS_HID); unsigned* cmpoff = (unsigned*)(ws + WS_CMPOFF); float* peb = (float*)(ws + WS_PEB); h16* ksR = (h16*)(ws + WS_KSR); h16* kwR = (h16*)(ws + WS_KWR); h16* kx = (h16*)(ws + WS_KX);
    h16* rqr = (h16*)((unsigned char*)p.out + DO_RQR); h16* rkr = (h16*)((unsigned char*)p.out + DO_RKR); h16* rkzT = (h16*)((unsigned char*)p.out + DO_RKZT); h16* rvT = (h16*)((unsigned char*)p.out + DO_RVT); float* pre = p.out; float* x1 = (float*)(ws + WS_X1); h16* x1h = (h16*)(ws + WS_X1H);
    h16* qx = (h16*)(ws + WS_QX); float* x2 = (float*)(ws + WS_X2); h16* x2h = (h16*)(ws + WS_X2H);
    int* ctl = (int*)ws; unsigned* rowoff = (unsigned*)(ws + WS_ROWOFF); u32x2* rowmeta = (u32x2*)(ws + WS_ROWMETA);
    h16* WguT = (h16*)(ws + WS_WGUT); h16* WdT = (h16*)(ws + WS_WDT); h16* Hm = (h16*)(ws + WS_HM); h16* Yq = (h16*)(ws + WS_Y);
    float* fl = (float*)lds;
    const int lo = p.ph_lo, hi = p.ph_hi;
#define IN(k) (lo <= (k) && (k) < hi)
    { volatile LAS unsigned* st = (volatile LAS unsigned*)((LAS unsigned char*)lds + 131072); if (threadIdx.x < 2) st[threadIdx.x] = 0u; }
    __syncthreads();
    XcdBarrier xbar = xcd_barrier_post((unsigned*)(ws + WS_BAR), (volatile LAS unsigned*)((LAS unsigned char*)lds + 131072));
#define SEAM(k) do { if (IN(k) && IN((k) + 1)) { if ((k) == 0) grid.sync(); else xcd_barrier(xbar); } } while (0)

    if (IN(0)) REPS(0) {
        { const int sub = tid >> 8, lt = tid & 255; float* tl = fl + sub * 1088;
          constexpr int T0 = (INP / 32) * (D / 32);
          for (int b0 = bid * 2; b0 < T0; b0 += G * 2) b_transpose_tile(p.w_in, D, INC, WinT, INP, b0 + sub, tl, lt); }
        { const int wv = __builtin_amdgcn_readfirstlane(tid >> 6), lane = tid & 63; LAS float* scr = (LAS float*)((LAS unsigned char*)lds + wv * 8704);
          constexpr int I1 = (D / 64) * (D / 32), I4 = (D / 64) * (2 * D / 32), I5 = (2048 / 64) * (256 / 32), IT = 3 * I1 + I4 + 2 * I5;
          for (int it0 = bid * 8 + wv; it0 < IT; it0 += G * 8) { int it = it0;
            if (it < I1) { w_transpose_item(p.w_out, D, D, WoutT, it, scr, lane); continue; } it -= I1;
            if (it < I1) { w_transpose_item(p.w_xq, D, D, WxqT, it, scr, lane); continue; } it -= I1;
            if (it < I1) { w_transpose_item(p.w_xo, D, D, WxoT, it, scr, lane); continue; } it -= I1;
            if (it < I4) { w_transpose_item(p.w_xkv, D, 2 * D, WxkvT, it, scr, lane); continue; } it -= I4;
            if (it < I5) { w_transpose_item(p.w1k, 2048, 256, Wc1T, it, scr, lane); continue; } it -= I5;
            w_transpose_item(p.w1v, 2048, 256, Wc1T + 256 * 2048, it, scr, lane); } }
        __syncthreads();
        b_cvt(p.x, xh, (size_t)M * D / 4);
        b_cvt(p.mem, memh, (size_t)NB * MEML * D / 4);
        if (bid == 0) for (int i = tid; i < 1024; i += NTHR) ctl[i] = 0;
        b_tables(p.positions, cosr, sinr, cosn, sinn);
        for (int idx = bid * NTHR + tid; idx < NE * D; idx += G * NTHR) { const int e = idx >> 10, k = idx & 1023; const float w = p.w_router[k * NE + e]; const h16 hi = (h16)w; WrTh[idx] = hi; WrTl[idx] = (h16)((w - (float)hi) * 2048.f); }
        for (int r = bid * NTHR + tid; r < 4096; r += G * NTHR) { const int g = r & 1, c = min((r >> 1) & 511, 510), b = r >> 10; cmpoff[r] = (unsigned)(((size_t)(b * T + 16 * c) * INP + g * 64) * 2); }
        { const int lane = tid & 63;
          for (int o = bid * 8 + (tid >> 6); o < 512; o += G * 8) { const int kv = o >> 8, j = o & 255; const float* pe = kv ? p.pe_v : p.pe_k; const float* w1 = kv ? p.w1v : p.w1k; float a = 0.f;
              for (int k = lane; k < 2048; k += 64) a += pe[k] * w1[(size_t)k * 256 + j];
              a = wave_sum(a); if (lane == 0) peb[o] = a; } }
    }
    SEAM(0);
    if (IN(1)) {
        REPS(1) { pg8::Gemm g{xh, WinT, M, INP, D}; pg8::StaticOrder S; S.init(g, G, bid); pg8::EpiF16 E{hb, INP};
          pg8::gemm_phase<pg8::EpiF16, pg8::StaticOrder>((PG8_LAS unsigned char*)lds, g.K, S, E); }
    }
    SEAM(1);
    if (IN(2)) REPS(2) {
        if (bid < 32) { CmpSched S{(const char*)hb, cmpoff, (const char*)Wc1T, bid}; pg8::EpiCmp1 E{hid, peb + (bid >> 4) * 256};
            pg8::gemm_phase<pg8::EpiCmp1, CmpSched>((PG8_LAS unsigned char*)lds, 2048, S, E, (size_t)INP * 2);
            pg8::Gemm g{memh, WxkvT, NB * MEML, 2 * D, D}; pg8::StaticOrder S2; S2.init(g, 32, bid); pg8::EpiF16 E2{kvm, 2 * D};
            pg8::gemm_phase<pg8::EpiF16, pg8::StaticOrder>((PG8_LAS unsigned char*)lds, g.K, S2, E2); }
        else { const int sub = tid >> 8, lt = tid & 255; const int b2 = bid - 32, G2 = G - 32;
        { const int wv = __builtin_amdgcn_readfirstlane(tid >> 6), lane = tid & 63; LAS h16* wsl = (LAS h16*)((LAS unsigned char*)lds + wv * 8704);
          for (int m0 = (b2 * 8 + wv) * 2; m0 < M; m0 += G2 * 16) { w_rope(hb, rqr, rkr, nqr, ksR, kwR, cosr, sinr, cosn, sinn, m0, lane); w_rope(hb, rqr, rkr, nqr, ksR, kwR, cosr, sinr, cosn, sinn, m0 + 1, lane); }
          for (int it = b2 * 8 + wv; it < 2 * NB * 2 * 128; it += G2 * 8) b_vtrans(hb, vsT, vwT, it, wsl, lane);
          for (int it = b2 * 8 + wv; it < NB * 4 * 256; it += G2 * 8) b_rtrans(p, hb, rvT, rkzT, cosr, sinr, it, wsl, lane); }
        } }
    SEAM(2);
    if (IN(3)) {
        REPS(30) b_cmp2(p, hid, kcmp, vcmpT);
        { const int sub = tid >> 8, lt = tid & 255;
          for (int b0 = bid * 2; b0 < NB * 4 * 16; b0 += G * 2) b_mvtrans(kvm, kvmVT, kx, b0 + sub, (h16*)(fl + sub * 2304), lt); }
        const int wv = __builtin_amdgcn_readfirstlane(tid >> 6), lane = tid & 63;
        REPS(31) for (int ch = bid; ch < NB * 4 * 64; ch += G) ret_kv_unit(rkzT, rvT, kvb, ch, wv, lane); }
    SEAM(3);
    if (IN(4)) {
        REPS(4) b_ret_scan(p, kvb, prevT);
        const int wv = __builtin_amdgcn_readfirstlane(tid >> 6), lane = tid & 63;
        __syncthreads();
        REPS(50) { const int bg = bid & 7;
            for (int k = bid >> 3; k < T / 32; k += (G >> 3)) nsa_block_unit(hb, nqr, kcmp, vcmpT, vsT, vwT, ksR, kwR, mix, bg >> 1, bg & 1, (T / 32 - 1 - k) * 32, (LAS unsigned char*)lds, wv, lane); }
    }
    SEAM(4);
    if (IN(5)) {
        const int wv = __builtin_amdgcn_readfirstlane(tid >> 6), lane = tid & 63;
        REPS(51) for (int ch = bid; ch < NB * 4 * 64; ch += G) ret_out_unit(p, hb, rqr, rkr, rvT, prevT, mix, ch, wv, lane);
    }
    SEAM(5);
    if (IN(6)) { pg8::Gemm g{mix, WoutT, M, D, D}; pg8::StaticOrder S; S.init(g, G, bid); pg8::EpiResF32 E{pre, p.x, D, DN_ALPHA};
        pg8::gemm_phase<pg8::EpiResF32, pg8::StaticOrder>((PG8_LAS unsigned char*)lds, g.K, S, E); }
    SEAM(6);
    if (PROBE_DBL == 900) { for (int k = 0; k < 20; ++k) xcd_barrier(xbar); }
    if (IN(7)) REPS(7) b_ln(pre, p.ln1g, p.ln1b, x1, x1h);
    SEAM(7);
    if (IN(8)) { pg8::Gemm g{x1h, WxqT, M, D, D}; pg8::StaticOrder S; S.init(g, G, bid); pg8::EpiF16 E{qx, D};
        pg8::gemm_phase<pg8::EpiF16, pg8::StaticOrder>((PG8_LAS unsigned char*)lds, g.K, S, E); }
    SEAM(8);
    if (IN(9)) { const int wv = __builtin_amdgcn_readfirstlane(tid >> 6), lane = tid & 63;
        REPS(9) xattn_block(qx, kx, kvmVT, ox, G, bid, (LAS unsigned char*)lds, wv, lane); }
    SEAM(9);
    if (IN(10)) { pg8::Gemm g{ox, WxoT, M, D, D}; pg8::StaticOrder S; S.init(g, G, bid); pg8::EpiResF32 E{pre, x1, D, DN_ALPHA};
        pg8::gemm_phase<pg8::EpiResF32, pg8::StaticOrder>((PG8_LAS unsigned char*)lds, g.K, S, E); }
    if (IN(10) && IN(12)) xcd_barrier(xbar);
    if (IN(12)) {
        { const int wv = __builtin_amdgcn_readfirstlane(tid >> 6), lane = tid & 63; LAS float* lg = (LAS float*)((LAS unsigned char*)lds + wv * 4096);
          for (int u = bid * 8 + wv; u < M / 16; u += G * 8) router_unit(p, pre, x2h, WrTh, WrTl, tope, topw, ctl + CTL_CNT, u * 16, lg, lane); }
        __syncthreads();
        if (bid == 0 && tid < NQ) ctl[CTL_CNT + tid * 65 + 64] = QT;
        for (int i = bid * NTHR + tid; i < CAP; i += G * NTHR) { rowoff[i] = 0u; rowmeta[i] = (u32x2){0xffffffffu, 0u}; }
        { const int wv = __builtin_amdgcn_readfirstlane(tid >> 6), lane = tid & 63; LAS float* scr = (LAS float*)((LAS unsigned char*)lds + wv * 8704);
          REPS(121) for (int it = bid * 8 + wv; it < 65 * 384; it += G * 8) { const int e = it / 384, r = it % 384;
            const float* wg = e < 64 ? p.w_gate + (size_t)e * D * EFF : p.ws_gate; const float* wu = e < 64 ? p.w_up + (size_t)e * D * EFF : p.ws_up; const float* wd = e < 64 ? p.w_down + (size_t)e * EFF * D : p.ws_down;
            if (r < 128) w_transpose_item(wg, D, EFF, WguT + (size_t)e * 512 * D, r, scr, lane, 2, 0);
            else if (r < 256) w_transpose_item(wu, D, EFF, WguT + (size_t)e * 512 * D, r - 128, scr, lane, 2, 1);
            else w_transpose_item(wd, EFF, D, WdT + (size_t)e * D * EFF, r - 256, scr, lane); } }
    }
    SEAM(12);
    if (IN(13)) b_scatter(ctl, tope, topw, rowoff, rowmeta, (int*)lds);
    SEAM(13);
    if (IN(14)) REPS(14) { G1Sched S{ctl, (const char*)x2h, rowoff, (const char*)WguT, G, bid}; pg8::EpiGateUp E{Hm};
        pg8::gemm_phase<pg8::EpiGateUp, G1Sched>((PG8_LAS unsigned char*)lds, D, S, E); }
    SEAM(14);
#pragma unroll 1
    for (int q = 0; q < NQ; ++q) {
        if (IN(15 + 2 * q)) REPS(15) { G2Sched S{ctl, (const char*)Hm, (const char*)WdT, q, G, bid}; pg8::EpiDown E{Yq, rowmeta};
            pg8::gemm_phase<pg8::EpiDown, G2Sched>((PG8_LAS unsigned char*)lds, EFF, S, E); }
        SEAM(15 + 2 * q);
        if (IN(16 + 2 * q)) REPS(16) b_combine(p, x2h, Yq, q);
        if (q < NQ - 1) SEAM(16 + 2 * q);
    }
#undef IN
#undef SEAM
#undef tid
}

#ifndef MK_PER_PHASE
#define MK_PER_PHASE 0
#endif
extern "C" void kernel_launch(void* const* d_in, const int* in_sizes, int n_in, void* d_out, int out_size, void* d_ws, size_t ws_size, hipStream_t stream) {
    static int grid = 0;
    if (grid == 0) {
        if (n_in != 28 || in_sizes[0] != M * D || out_size != M * D || ws_size < WS_NEED) { fprintf(stderr, "kernel_launch: unexpected shapes (n_in %d, in0 %d, out %d, ws %zu)\n", n_in, n_in > 0 ? in_sizes[0] : -1, out_size, ws_size); grid = -1; return; }
        if (hipFuncSetAttribute((const void*)mega_fwd, hipFuncAttributeMaxDynamicSharedMemorySize, LDS_BYTES) != hipSuccess) { fprintf(stderr, "kernel_launch: hipFuncSetAttribute failed\n"); grid = -1; return; }
        int dev = 0, cus = 0, per_cu = 0;
        hipGetDevice(&dev); hipDeviceGetAttribute(&cus, hipDeviceAttributeMultiprocessorCount, dev);
        if (hipOccupancyMaxActiveBlocksPerMultiprocessor(&per_cu, (const void*)mega_fwd, NTHR, LDS_BYTES) != hipSuccess || per_cu < 1) { fprintf(stderr, "kernel_launch: occupancy query failed (%d)\n", per_cu); grid = -1; return; }
        grid = cus;
    }
    if (grid < 0) return;
    Params p{};
    p.x = (const float*)d_in[0]; p.mem = (const float*)d_in[1]; p.positions = (const int*)d_in[2];
    p.w_in = (const float*)d_in[3]; p.pe_k = (const float*)d_in[4]; p.pe_v = (const float*)d_in[5];
    p.w1k = (const float*)d_in[6]; p.w2k = (const float*)d_in[7]; p.w1v = (const float*)d_in[8]; p.w2v = (const float*)d_in[9];
    p.w_out = (const float*)d_in[10]; p.ln1g = (const float*)d_in[11]; p.ln1b = (const float*)d_in[12];
    p.w_xq = (const float*)d_in[13]; p.w_xkv = (const float*)d_in[14]; p.w_xo = (const float*)d_in[15];
    p.ln2g = (const float*)d_in[16]; p.ln2b = (const float*)d_in[17]; p.w_router = (const float*)d_in[18]; p.rbias = (const float*)d_in[19];
    p.w_gate = (const float*)d_in[20]; p.w_up = (const float*)d_in[21]; p.w_down = (const float*)d_in[22];
    p.ws_gate = (const float*)d_in[23]; p.ws_up = (const float*)d_in[24]; p.ws_down = (const float*)d_in[25];
    p.ln3g = (const float*)d_in[26]; p.ln3b = (const float*)d_in[27];
    p.out = (float*)d_out; p.ws = (unsigned char*)d_ws;
    for (int i = 0; i < 4; ++i) p.lg[i] = (float)std::log(1.0 - std::pow(2.0, -5.0 - (double)i));
#if MK_PER_PHASE
    for (int ph = 0; ph < N_PHASES; ++ph) { p.ph_lo = ph; p.ph_hi = ph + 1; hipLaunchKernelGGL(mega_fwd, dim3(grid), dim3(NTHR), LDS_BYTES, stream, p); }
#else
    p.ph_lo = 0; p.ph_hi = N_PHASES;
    if (hipMemsetAsync((char*)d_ws + WS_BAR, 0, XCD_BAR_WORDS * 4, stream) != hipSuccess) { fprintf(stderr, "kernel_launch: memset failed\n"); return; }
    void* args[] = {&p};
    hipError_t e = hipLaunchCooperativeKernel((const void*)mega_fwd, dim3(grid), dim3(NTHR), args, LDS_BYTES, stream);
    if (e != hipSuccess) fprintf(stderr, "kernel_launch: cooperative launch failed: %s (grid %d)\n", hipGetErrorString(e), grid);
#endif
}
```

```cpp
#include <hip/hip_runtime.h>
#include <cstdio>
#include <cstdint>
#include <cmath>

typedef _Float16 h16;
typedef _Float16 h16x8 __attribute__((ext_vector_type(8)));
typedef _Float16 h16x2 __attribute__((ext_vector_type(2)));
typedef _Float16 h16x4 __attribute__((ext_vector_type(4)));
typedef float f32x2 __attribute__((ext_vector_type(2)));
typedef float f32x4 __attribute__((ext_vector_type(4)));
typedef unsigned u32x4 __attribute__((ext_vector_type(4)));
typedef unsigned u32x2 __attribute__((ext_vector_type(2)));

__device__ __forceinline__ int tidx() { int t = (int)threadIdx.x; asm volatile("" : "+v"(t)); return t; }

#ifndef PROBE_DBL
#define PROBE_DBL -1
#endif
#define REPS(k) for (int _rep = 0; _rep < ((PROBE_DBL) == (k) ? 2 : 1); ++_rep)

constexpr int NB = 4, T = 8192, D = 1024, M = NB * T;
constexpr int INC = 3352, INP = 3584;
constexpr int C_RQ = 0, C_RK = 512, C_RV = 1024, C_RG = 1536, C_NQ = 2048, C_NKC = 2560, C_NVC = 2688, C_NKS = 2816, C_NVS = 2944, C_NKW = 3072, C_NVW = 3200, C_NG = 3328;
constexpr int MEML = 256;
constexpr int NE = 64, EFF = 256;
constexpr float LN_EPS = 1e-5f;
constexpr float DN_ALPHA = 1.189207115002721f;
constexpr float NEGF = -1e30f;

constexpr size_t MiB = 1u << 20;
constexpr size_t WS_WIN = 1 * MiB, WS_WOUT = 8 * MiB, WS_WXQ = 10 * MiB, WS_WXO = 12 * MiB, WS_WXKV = 14 * MiB, WS_MEMH = 18 * MiB, WS_KVM = 20 * MiB;
constexpr size_t WS_KCMP = 24 * MiB, WS_VCMP = 25 * MiB, WS_TOPE = 26 * MiB, WS_TOPW = 27 * MiB;
constexpr size_t WS_XH = 32 * MiB, WS_MIX = 32 * MiB, WS_OX = 32 * MiB;
constexpr size_t WS_H = 96 * MiB, WS_NQR = 320 * MiB, WS_KVB = 352 * MiB, WS_PREV = 416 * MiB;
constexpr size_t WS_PRE = 96 * MiB, WS_X1 = 224 * MiB, WS_X1H = 352 * MiB, WS_QX = 416 * MiB, WS_X2 = 130 * MiB;
constexpr size_t WS_X2H = 32 * MiB, WS_WDT = 96 * MiB, WS_HM = 130 * MiB, WS_WGUT = 306 * MiB, WS_Y = 306 * MiB;
constexpr size_t WS_ROWOFF = 1 * MiB, WS_ROWMETA = 3 * MiB;
constexpr size_t WS_VST = 480 * MiB, WS_VWT = 488 * MiB, WS_COSR = 496 * MiB, WS_SINR = 504 * MiB, WS_COSN = 28 * MiB, WS_SINN = 29 * MiB, WS_KVMVT = 30 * MiB;
constexpr size_t WS_WRTH = 262144, WS_WRTL = 393216;
constexpr size_t WS_WC1T = 464 * MiB, WS_HID = 466 * MiB, WS_CMPOFF = 131072, WS_PEB = 131072 + 16384;
constexpr size_t WS_PREVT = 416 * MiB, WS_KSR = 448 * MiB, WS_KWR = 456 * MiB, WS_KX = 26 * MiB;
constexpr size_t DO_RQR = 0, DO_RKR = 32 * MiB, DO_RKZT = 64 * MiB, DO_RVT = 96 * MiB;
constexpr size_t WS_NEED = 512 * MiB;
constexpr int NQ = 4, QT = M / NQ, NVE = NQ * 65, CAP_TILES = 1412, CAP = CAP_TILES * 256;
constexpr size_t WS_BAR = 65536;
constexpr int CTL_CNT = 0, CTL_CUR = 512, CTL_PST = 1024, CTL_TQS = 1536, CTL_TVE = 2048;

namespace pg8 {
#define PG8_LAS __attribute__((address_space(3)))
typedef short s16x8 __attribute__((ext_vector_type(8)));
constexpr int BM = 256, BK = 64, HALF = 128, HTB = HALF * BK * 2, STAGE_BYTES = 8 * HTB, NXCD = 8, WGM = 8;
__host__ __device__ __forceinline__ int lds_byte(int r, int c) { const int st = (r >> 4) * 2 + (c >> 5), rr = r & 15, cc = c & 31, ob = rr * 64 + cc * 2; return st * 1024 + (ob ^ (((ob >> 9) & 1) << 5)); }
__host__ __device__ __forceinline__ void stage_rc(int b, int& R, int& C) { const int st = b / 1024, sb = b % 1024, swz = sb ^ (((sb >> 9) & 1) << 5); R = (st >> 1) * 16 + swz / 64; C = (st & 1) * 32 + (swz % 64) / 2; }
__host__ __device__ __forceinline__ int perm32(int rho) { const int n = rho >> 4, i = rho & 15; return 8 * (i >> 2) + 4 * n + (i & 3); }
struct Unit { int pm, pn; const char* A; const char* B; const unsigned* gat; };
struct Gemm { const h16* A; const h16* Bt; int M, N, K; };
struct StaticOrder {
    int nM, nN, nwg, G, c; const char* A; const char* B; size_t tstep;
    __device__ void init(const Gemm& g, int G_, int c_) { nM = g.M / BM; nN = g.N / BM; nwg = nM * nN; G = G_; c = c_; A = (const char*)g.A; B = (const char*)g.Bt; tstep = (size_t)BM * g.K * 2; }
    __device__ bool next(int i, Unit& u) const {
        const long L = (long)i * G + c; if (L >= nwg) return false;
        int wgid = (int)L; { const int q = nwg / NXCD, r = nwg % NXCD, xcd = wgid % NXCD, off = wgid / NXCD; wgid = (xcd < r ? xcd * (q + 1) : r * (q + 1) + (xcd - r) * q) + off; }
        const int nig = WGM * nN, gid = wgid / nig, fm = gid * WGM, gsz = (nM - fm) < WGM ? (nM - fm) : WGM;
        u.pm = fm + ((wgid % nig) % gsz); u.pn = (wgid % nig) / gsz; u.A = A + (size_t)u.pm * tstep; u.B = B + (size_t)u.pn * tstep; u.gat = nullptr; return true;
    }
};
__device__ __forceinline__ unsigned cvt_pk_f16(float lo, float hi) { f32x2 v = {lo, hi}; h16x2 h = __builtin_convertvector(v, h16x2); return __builtin_bit_cast(unsigned, h); }

struct EpiF16 {
    static constexpr bool PERM = true;
    h16* O; int ldc;
    __device__ __forceinline__ void operator()(const f32x4 (&acc)[2][2][4][2], const Unit& u, int wr, int wc, int fr, int fq) const {
        const int row0 = u.pm * BM + wr * 64 + fr; const int col0 = u.pn * BM + wc * 32 + 8 * fq;
#pragma unroll
        for (int ai = 0; ai < 2; ++ai)
#pragma unroll
            for (int m = 0; m < 4; ++m) { h16* rowp = O + (size_t)(row0 + ai * HALF + m * 16) * ldc + col0;
#pragma unroll
                for (int bj = 0; bj < 2; ++bj) { const f32x4 v0 = acc[ai][bj][m][0], v1 = acc[ai][bj][m][1];
                    *(h16x8*)(rowp + bj * HALF) = __builtin_convertvector(__builtin_shufflevector(v0, v1, 0, 1, 2, 3, 4, 5, 6, 7), h16x8); } }
    }
};
struct EpiResF32 {
    static constexpr bool PERM = false;
    float* C; const float* R; int ldc; float alpha;
    __device__ __forceinline__ void operator()(const f32x4 (&acc)[2][2][4][2], const Unit& u, int wr, int wc, int fr, int fq) const {
        const int row0 = u.pm * BM + wr * 64 + fr, col0 = u.pn * BM + wc * 32 + 4 * fq;
#pragma unroll
        for (int ai = 0; ai < 2; ++ai)
#pragma unroll
            for (int m = 0; m < 4; ++m) { const size_t off = (size_t)(row0 + ai * HALF + m * 16) * ldc + col0;
#pragma unroll
                for (int bj = 0; bj < 2; ++bj)
#pragma unroll
                    for (int n = 0; n < 2; ++n) { const f32x4 r = *(const f32x4*)(R + off + bj * HALF + n * 16); *(f32x4*)(C + off + bj * HALF + n * 16) = r * alpha + acc[ai][bj][m][n]; } }
    }
};
struct EpiCmp1 {
    static constexpr bool PERM = true;
    h16* O; const float* peb;
    __device__ __forceinline__ void operator()(const f32x4 (&acc)[2][2][4][2], const Unit& u, int wr, int wc, int fr, int fq) const {
        const int row0 = u.pm * BM + wr * 64 + fr; const int col0 = wc * 32 + 8 * fq;
#pragma unroll
        for (int bj = 0; bj < 2; ++bj) { const f32x4 b0 = *(const f32x4*)(peb + col0 + bj * HALF), b1 = *(const f32x4*)(peb + col0 + bj * HALF + 4);
#pragma unroll
            for (int ai = 0; ai < 2; ++ai)
#pragma unroll
                for (int m = 0; m < 4; ++m) { f32x4 v0 = acc[ai][bj][m][0] + b0, v1 = acc[ai][bj][m][1] + b1;
#pragma unroll
                    for (int r = 0; r < 4; ++r) { v0[r] = v0[r] / (1.f + __expf(-v0[r])); v1[r] = v1[r] / (1.f + __expf(-v1[r])); }
                    *(h16x8*)(O + (size_t)(row0 + ai * HALF + m * 16) * 256 + col0 + bj * HALF) = __builtin_convertvector(__builtin_shufflevector(v0, v1, 0, 1, 2, 3, 4, 5, 6, 7), h16x8); } }
    }
};
struct EpiGateUp {
    static constexpr bool PERM = true;
    h16* H;
    __device__ __forceinline__ void operator()(const f32x4 (&acc)[2][2][4][2], const Unit& u, int wr, int wc, int fr, int fq) const {
        const int row0 = u.pm * BM + wr * 64 + fr; const int col0 = u.pn * 128 + wc * 16 + 4 * fq;
#pragma unroll
        for (int ai = 0; ai < 2; ++ai)
#pragma unroll
            for (int m = 0; m < 4; ++m) { h16* rowp = H + (size_t)(row0 + ai * HALF + m * 16) * 256 + col0;
#pragma unroll
                for (int bj = 0; bj < 2; ++bj) { const f32x4 v0 = acc[ai][bj][m][0], v1 = acc[ai][bj][m][1];
                    const float h0 = v0[0] / (1.f + __expf(-v0[0])) * v0[1], h1 = v0[2] / (1.f + __expf(-v0[2])) * v0[3];
                    const float h2 = v1[0] / (1.f + __expf(-v1[0])) * v1[1], h3 = v1[2] / (1.f + __expf(-v1[2])) * v1[3];
                    *(h16x4*)(rowp + bj * 64) = __builtin_convertvector((f32x4){h0, h1, h2, h3}, h16x4); } }
    }
};
struct EpiDown {
    static constexpr bool PERM = true;
    h16* Y; const u32x2* rowmeta;
    __device__ __forceinline__ void operator()(const f32x4 (&acc)[2][2][4][2], const Unit& u, int wr, int wc, int fr, int fq) const {
        const int row0 = u.pm * BM + wr * 64 + fr; const int col0 = u.pn * BM + wc * 32 + 8 * fq;
#pragma unroll
        for (int ai = 0; ai < 2; ++ai)
#pragma unroll
            for (int m = 0; m < 4; ++m) { const u32x2 md = rowmeta[row0 + ai * HALF + m * 16]; const int slot = (int)md.x; const float w8 = __uint_as_float(md.y);
                if (slot >= 0) { h16* rowp = Y + (size_t)slot * 1024 + col0;
#pragma unroll
                    for (int bj = 0; bj < 2; ++bj) { const f32x4 v0 = acc[ai][bj][m][0] * w8, v1 = acc[ai][bj][m][1] * w8;
                        *(h16x8*)(rowp + bj * HALF) = __builtin_convertvector(__builtin_shufflevector(v0, v1, 0, 1, 2, 3, 4, 5, 6, 7), h16x8); } }
                asm volatile("" ::: "memory"); }
    }
};

template <class Epi, class Sched>
__device__ __forceinline__ void gemm_phase(PG8_LAS unsigned char* lds, const int K, const Sched& S, const Epi& E, const size_t kstepA = (size_t)(BK * 2)) {
    const int tid = tidx(), wid = __builtin_amdgcn_readfirstlane(tid >> 6), lane = tid & 63, wr = wid >> 2, wc = wid & 3, fr = lane & 15, fq = lane >> 4;
    const int nt = K / BK;
    int R0, C0; stage_rc(tid * 16, R0, C0);
    const unsigned cb2 = (unsigned)C0 * 2u;
    unsigned voffB[2];
#pragma unroll
    for (int i = 0; i < 2; ++i) { const int R = R0 + 64 * i; const int Rb = Epi::PERM ? ((R & ~31) + perm32(R & 31)) : R; voffB[i] = (unsigned)(Rb * K) * 2u + cb2; }
    const size_t kstep = (size_t)(BK * 2);
    const size_t hstep = (size_t)HALF * K * 2;
    const unsigned ldsw = (unsigned)wid * 1024u;
    const int aoff = lds_byte(wr * 64 + fr, fq * 8), boff = lds_byte(wc * 32 + fr, fq * 8);
#define PG8_MKVA(u, va) do { _Pragma("unroll") for (int _h = 0; _h < 2; ++_h) _Pragma("unroll") for (int _i = 0; _i < 2; ++_i) { const int _r = _h * HALF + R0 + 64 * _i; \
        (va)[_h][_i] = ((u).gat ? (u).gat[_r] : (unsigned)(_r * K) * 2u) + cb2; } } while (0)
#define PG8_SA(b, h) (((b) * 2 + (h)) * HTB)
#define PG8_SB(b, h) ((4 + (b) * 2 + (h)) * HTB)
#define PG8_STAGE(bufoff, gbase, voff) do { _Pragma("unroll") for (int _i = 0; _i < 2; ++_i) \
        __builtin_amdgcn_global_load_lds((const unsigned*)((const char*)(gbase) + (voff)[_i]), (PG8_LAS unsigned*)(lds + (bufoff) + ldsw + _i * 8192), 16, 0, 0); } while (0)
#define PG8_LDA(dst, b, h) do { _Pragma("unroll") for (int m = 0; m < 4; ++m) _Pragma("unroll") for (int k = 0; k < 2; ++k) dst[m][k] = *(const PG8_LAS s16x8*)(lds + PG8_SA(b, h) + aoff + m * 2048 + k * 1024); } while (0)
#define PG8_LDB(dst, b, h) do { _Pragma("unroll") for (int n = 0; n < 2; ++n) _Pragma("unroll") for (int k = 0; k < 2; ++k) dst[n][k] = *(const PG8_LAS s16x8*)(lds + PG8_SB(b, h) + boff + n * 2048 + k * 1024); } while (0)
#define PG8_MMA(ai, bj, At, Bt) do { __builtin_amdgcn_s_setprio(1); _Pragma("unroll") for (int m = 0; m < 4; ++m) _Pragma("unroll") for (int n = 0; n < 2; ++n) _Pragma("unroll") for (int k = 0; k < 2; ++k) \
        acc[ai][bj][m][n] = __builtin_amdgcn_mfma_f32_16x16x32_f16(__builtin_bit_cast(h16x8, Bt[n][k]), __builtin_bit_cast(h16x8, At[m][k]), acc[ai][bj][m][n], 0, 0, 0); __builtin_amdgcn_s_setprio(0); } while (0)
#define PG8_WAIT_V(n) asm volatile("s_waitcnt vmcnt(" #n ")" ::: "memory")
#define PG8_WAIT_L(n) asm volatile("s_waitcnt lgkmcnt(" #n ")" ::: "memory")
#define PG8_BAR __builtin_amdgcn_s_barrier()
#define PG8_SCHED __builtin_amdgcn_sched_barrier(0)
    Unit cur, nxt; int ui = 0;
    if (!S.next(0, cur)) return;
    unsigned va[2][2];
    PG8_MKVA(cur, va);
    f32x4 acc[2][2][4][2];
#pragma unroll
    for (int a = 0; a < 2; ++a)
#pragma unroll
        for (int b = 0; b < 2; ++b)
#pragma unroll
            for (int m = 0; m < 4; ++m)
#pragma unroll
                for (int n = 0; n < 2; ++n) acc[a][b][m][n] = (f32x4){0.f, 0.f, 0.f, 0.f};
    s16x8 At[4][2], B0[2][2], B1[2][2];
    const char* cA = cur.A; const char* cB = cur.B;
    {
        PG8_STAGE(PG8_SB(0, 0), cB, voffB); PG8_STAGE(PG8_SB(0, 1), cB + hstep, voffB); PG8_STAGE(PG8_SA(0, 0), cA, va[0]); PG8_STAGE(PG8_SA(0, 1), cA, va[1]);
        if (wr == 1) PG8_BAR;
        PG8_WAIT_V(2); PG8_BAR;
        PG8_STAGE(PG8_SB(1, 0), cB + kstep, voffB); PG8_STAGE(PG8_SA(1, 0), cA + kstepA, va[0]); PG8_STAGE(PG8_SB(1, 1), cB + hstep + kstep, voffB);
        PG8_WAIT_V(6); PG8_BAR;
    }
    for (;;) {
        const bool has_next = S.next(ui + 1, nxt);
        const char* nA = has_next ? nxt.A : cA; const char* nB = has_next ? nxt.B : cB;
#pragma unroll 1
        for (int t = 0; t < nt; t += 2) {
            const bool last = (t == nt - 2);
            const char* a1 = cA + (size_t)(t + 1) * kstepA;
            const char* a2 = last ? nA : cA + (size_t)(t + 2) * kstepA; const char* b2 = last ? nB : cB + (size_t)(t + 2) * kstep;
            const char* a3 = a2 + kstepA; const char* b3 = b2 + kstep;
            PG8_LDB(B0, 0, 0); PG8_LDB(B1, 0, 1); PG8_SCHED; PG8_LDA(At, 0, 0); PG8_STAGE(PG8_SA(1, 1), a1, va[1]);
            if (last && has_next) { PG8_MKVA(nxt, va); }
            PG8_WAIT_V(8); PG8_WAIT_L(0); PG8_BAR; PG8_MMA(0, 0, At, B0); PG8_MMA(0, 1, At, B1); PG8_BAR; PG8_SCHED;
            PG8_LDA(At, 0, 1); PG8_STAGE(PG8_SB(0, 0), b2, voffB); PG8_STAGE(PG8_SB(0, 1), b2 + hstep, voffB); PG8_STAGE(PG8_SA(0, 0), a2, va[0]);
            PG8_WAIT_V(8); PG8_WAIT_L(0); PG8_BAR; PG8_MMA(1, 0, At, B0); PG8_MMA(1, 1, At, B1); PG8_BAR; PG8_SCHED;
            PG8_LDB(B0, 1, 0); PG8_LDB(B1, 1, 1); PG8_SCHED; PG8_LDA(At, 1, 0); PG8_STAGE(PG8_SA(0, 1), a2, va[1]);
            PG8_WAIT_V(8); PG8_WAIT_L(0); PG8_BAR; PG8_MMA(0, 0, At, B0); PG8_MMA(0, 1, At, B1); PG8_BAR; PG8_SCHED;
            PG8_LDA(At, 1, 1); PG8_STAGE(PG8_SB(1, 0), b3, voffB); PG8_STAGE(PG8_SB(1, 1), b3 + hstep, voffB); PG8_STAGE(PG8_SA(1, 0), a3, va[0]);
            PG8_WAIT_V(8); PG8_WAIT_L(0); PG8_BAR; PG8_MMA(1, 0, At, B0); PG8_MMA(1, 1, At, B1); PG8_BAR; PG8_SCHED;
        }
        if (wr == 0) PG8_BAR;
        E(acc, cur, wr, wc, fr, fq);
        if (!has_next) break;
#pragma unroll
        for (int a = 0; a < 2; ++a)
#pragma unroll
            for (int b = 0; b < 2; ++b)
#pragma unroll
                for (int m = 0; m < 4; ++m)
#pragma unroll
                    for (int n = 0; n < 2; ++n) acc[a][b][m][n] = (f32x4){0.f, 0.f, 0.f, 0.f};
        cur = nxt; cA = nA; cB = nB; ++ui;
        if (wr == 1) PG8_BAR;
    }
    PG8_WAIT_V(0);
    PG8_BAR;
#undef PG8_MKVA
#undef PG8_SA
#undef PG8_SB
#undef PG8_STAGE
#undef PG8_LDA
#undef PG8_LDB
#undef PG8_MMA
#undef PG8_WAIT_V
#undef PG8_WAIT_L
#undef PG8_BAR
#undef PG8_SCHED
}
}


#include <hip/hip_cooperative_groups.h>
namespace cg = cooperative_groups;
constexpr int NTHR = 512;
constexpr int LDS_BYTES = 147456;
#define LAS __attribute__((address_space(3)))

struct Params {
    const float *x, *mem; const int* positions;
    const float *w_in, *pe_k, *pe_v, *w1k, *w2k, *w1v, *w2v, *w_out, *ln1g, *ln1b, *w_xq, *w_xkv, *w_xo, *ln2g, *ln2b, *w_router, *rbias, *w_gate, *w_up, *w_down, *ws_gate, *ws_up, *ws_down, *ln3g, *ln3b;
    float* out; unsigned char* ws;
    float lg[4];
    int ph_lo, ph_hi;
};

__device__ __forceinline__ float wave_sum(float v) {
#pragma unroll
    for (int o = 1; o < 64; o <<= 1) v += __shfl_xor(v, o);
    return v;
}
__device__ __forceinline__ float wave_max(float v) {
#pragma unroll
    for (int o = 1; o < 64; o <<= 1) v = fmaxf(v, __shfl_xor(v, o));
    return v;
}
__device__ __forceinline__ float siluf(float v) { return v / (1.f + __expf(-v)); }
__device__ __forceinline__ float sigmf(float v) { return 1.f / (1.f + __expf(-v)); }

__device__ __forceinline__ void b_transpose_tile(const float* __restrict__ W, int K, int N, h16* __restrict__ WT, int Npad, int tile, float* tl, int lt, int rs = 1, int ro = 0) {
    const int ntn = Npad / 32; const int n0 = (tile % ntn) * 32, k0 = (tile / ntn) * 32, tx = lt & 31, ty = lt >> 5;
    for (int i = ty; i < 32; i += 8) { const int k = k0 + i, n = n0 + tx; tl[i * 33 + tx] = (n < N) ? W[(size_t)k * N + n] : 0.f; }
    __syncthreads();
    for (int i = ty; i < 32; i += 8) { const int n = n0 + i, k = k0 + tx; WT[(size_t)(n * rs + ro) * K + k] = (h16)tl[tx * 33 + i]; }
    __syncthreads();
}
__device__ __forceinline__ void w_transpose_item(const float* __restrict__ W, int K, int N, h16* __restrict__ WT, int item, LAS float* scr, int lane, int rs = 1, int ro = 0) {
    const int nblk = N / 32, kb = item / nblk, nb = item % nblk, k0 = 64 * kb, n0 = 32 * nb;
#pragma unroll 8
    for (int i = 0; i < 32; ++i) { const int kk = 2 * i + (lane >> 5); scr[kk * 33 + (lane & 31)] = W[(size_t)(k0 + kk) * N + n0 + (lane & 31)]; }
    asm volatile("s_waitcnt lgkmcnt(0)" ::: "memory");
    const int c = lane & 7;
#pragma unroll
    for (int j = 0; j < 4; ++j) { const int n = (lane >> 3) + 8 * j; LAS const float* s = scr + (8 * c) * 33 + n; h16x8 o;
#pragma unroll
        for (int x = 0; x < 8; ++x) o[x] = (h16)s[x * 33];
        *(h16x8*)(WT + (size_t)((n0 + n) * rs + ro) * K + k0 + 8 * c) = o; }
    asm volatile("s_waitcnt lgkmcnt(0)" ::: "memory");
}
__device__ __forceinline__ void b_cvt(const float* __restrict__ x, h16* __restrict__ o, size_t n4) {
    for (size_t i = (size_t)blockIdx.x * NTHR + tidx(); i < n4; i += (size_t)gridDim.x * NTHR) {
        const f32x4 v = ((const f32x4*)x)[i]; ((h16x4*)o)[i] = __builtin_convertvector(v, h16x4); }
}

__device__ __forceinline__ void b_tables(const int* __restrict__ positions, float* __restrict__ cosr, float* __restrict__ sinr, float* __restrict__ cosn, float* __restrict__ sinn, LAS float* inv) {
    if (tidx() < 72) { const int j = tidx(); inv[j] = j < 64 ? (float)pow(10000.0, -(double)j / 64.0) : (float)pow(500000.0, -(double)(j - 64) / 8.0); }
    __syncthreads();
    for (int idx = blockIdx.x * NTHR + tidx(); idx < M * 72; idx += gridDim.x * NTHR) {
        const int m = idx / 72, j = idx % 72; const float pos = (float)positions[m];
        const float ang = pos * inv[j]; double sd, cd; sincos((double)ang, &sd, &cd);
        if (j < 64) { cosr[(size_t)m * 64 + j] = (float)cd; sinr[(size_t)m * 64 + j] = (float)sd; } else { cosn[(size_t)m * 8 + j - 64] = (float)cd; sinn[(size_t)m * 8 + j - 64] = (float)sd; }
    }
    __syncthreads();
}
__device__ __forceinline__ void w_rope(const h16* __restrict__ h, h16* __restrict__ rqr, h16* __restrict__ rkr, h16* __restrict__ nqr, h16* __restrict__ ksR, h16* __restrict__ kwR, const float* __restrict__ cosr, const float* __restrict__ sinr,
                                       const float* __restrict__ cosn, const float* __restrict__ sinn, int m, int lane) {
    const h16* hr = h + (size_t)m * INP; const int bb = m >> 13, t = m & (T - 1);
    {
        const int isk = lane >> 5, hd = (lane >> 3) & 3, j8 = (lane & 7) * 8; const int col = (isk ? C_RK : C_RQ) + hd * 128 + j8;
        const h16x8 a1 = *(const h16x8*)(hr + col), a2 = *(const h16x8*)(hr + col + 64);
        const f32x4 c0 = *(const f32x4*)(cosr + (size_t)m * 64 + j8), c1 = *(const f32x4*)(cosr + (size_t)m * 64 + j8 + 4), s0 = *(const f32x4*)(sinr + (size_t)m * 64 + j8), s1 = *(const f32x4*)(sinr + (size_t)m * 64 + j8 + 4);
        const float sc = isk ? 0.08838834764831845f : 1.f; h16x8 o1, o2;
#pragma unroll
        for (int x = 0; x < 8; ++x) { const float c = x < 4 ? c0[x & 3] : c1[x & 3], s = x < 4 ? s0[x & 3] : s1[x & 3]; const float v1 = (float)a1[x], v2 = (float)a2[x];
            o1[x] = (h16)((v1 * c - v2 * s) * sc); o2[x] = (h16)((v2 * c + v1 * s) * sc); }
        h16* dst = (isk ? rkr : rqr) + ((size_t)(bb * 4 + hd) * T + t) * 128 + j8; *(h16x8*)dst = o1; *(h16x8*)(dst + 64) = o2; }
    const f32x4 cn0 = *(const f32x4*)(cosn + (size_t)m * 8), cn1 = *(const f32x4*)(cosn + (size_t)m * 8 + 4), sn0 = *(const f32x4*)(sinn + (size_t)m * 8), sn1 = *(const f32x4*)(sinn + (size_t)m * 8 + 4);
    if (lane < 8 || (lane >= 56 && lane < 60)) {
        const bool isq = lane < 8; const int idx = lane - 56, which = idx >> 1, g = idx & 1;
        const h16* src = isq ? hr + C_NQ + lane * 64 : hr + (which ? C_NKW : C_NKS) + g * 64;
        h16* dst = isq ? nqr + (size_t)m * 512 + lane * 64 : (which ? kwR : ksR) + (((size_t)((bb * 2 + g) * 128 + (t >> 6)) * 64 + (t & 63)) * 64);
        const h16x8 a1 = *(const h16x8*)src, a2 = *(const h16x8*)(src + 8); h16x8 o1, o2;
#pragma unroll
        for (int x = 0; x < 8; ++x) { const float c = x < 4 ? cn0[x & 3] : cn1[x & 3], s = x < 4 ? sn0[x & 3] : sn1[x & 3]; const float v1 = (float)a1[x], v2 = (float)a2[x];
            o1[x] = (h16)(v1 * c - v2 * s); o2[x] = (h16)(v2 * c + v1 * s); }
        *(h16x8*)dst = o1; *(h16x8*)(dst + 8) = o2;
    } else if (lane < 56) {
        const int idx = lane - 8, hd = idx / 6, d = 16 + 8 * (idx % 6); *(h16x8*)(nqr + (size_t)m * 512 + hd * 64 + d) = *(const h16x8*)(hr + C_NQ + hd * 64 + d); }
    if (lane < 24) {
        const int which = lane / 12, r = lane % 12, g = r / 6, d = 16 + 8 * (r % 6);
        h16* dst = (which ? kwR : ksR) + (((size_t)((bb * 2 + g) * 128 + (t >> 6)) * 64 + (t & 63)) * 64);
        *(h16x8*)(dst + d) = *(const h16x8*)(hr + (which ? C_NKW : C_NKS) + g * 64 + d); }
}
__device__ __forceinline__ void b_rope(const h16* __restrict__ h, h16* __restrict__ rqr, h16* __restrict__ rkr, h16* __restrict__ nqr, h16* __restrict__ ksR, h16* __restrict__ kwR, const float* __restrict__ cosr, const float* __restrict__ sinr,
                                       const float* __restrict__ cosn, const float* __restrict__ sinn, int m, int j) {
    const h16* hr = h + (size_t)m * INP; const int bb = m >> 13, t = m & (T - 1);
    {   const int hd = j >> 6, jj = j & 63; const float c = cosr[(size_t)m * 64 + jj], s = sinr[(size_t)m * 64 + jj]; const size_t ro = ((size_t)(bb * 4 + hd) * T + t) * 128;
        const int o1 = hd * 128 + jj, o2 = o1 + 64;
        const float q1 = (float)hr[C_RQ + o1], q2 = (float)hr[C_RQ + o2];
        rqr[ro + jj] = (h16)(q1 * c - q2 * s); rqr[ro + jj + 64] = (h16)(q2 * c + q1 * s);
        const float k1 = (float)hr[C_RK + o1], k2 = (float)hr[C_RK + o2]; const float sc = 0.08838834764831845f;
        rkr[ro + jj] = (h16)((k1 * c - k2 * s) * sc); rkr[ro + jj + 64] = (h16)((k2 * c + k1 * s) * sc);
    }
    if (j < 64 + 16 + 16) {
        const int jj = j & 7; const float c = cosn[(size_t)m * 8 + jj], s = sinn[(size_t)m * 8 + jj];
        if (j < 64) { const int hd = j >> 3; const int o1 = hd * 64 + jj, o2 = o1 + 8;
            const float q1 = (float)hr[C_NQ + o1], q2 = (float)hr[C_NQ + o2];
            nqr[(size_t)m * 512 + o1] = (h16)(q1 * c - q2 * s); nqr[(size_t)m * 512 + o2] = (h16)(q2 * c + q1 * s);
        } else { const int jx = j - 64; const int which = jx >> 4, g = (jx >> 3) & 1; const int base = (which ? C_NKW : C_NKS) + g * 64 + jj;
            const float k1 = (float)hr[base], k2 = (float)hr[base + 8];
            h16* dst = (which ? kwR : ksR) + (((size_t)((bb * 2 + g) * 128 + (t >> 6)) * 64 + (t & 63)) * 64); dst[jj] = (h16)(k1 * c - k2 * s); dst[jj + 8] = (h16)(k2 * c + k1 * s); }
    }
    if (j >= 128 && j < 128 + 96) { const int jx = j - 128; const int which = jx / 48, r = jx % 48, g = r / 24, d = 16 + 2 * (r % 24);
        const int base = (which ? C_NKW : C_NKS) + g * 64 + d; h16* dst = (which ? kwR : ksR) + (((size_t)((bb * 2 + g) * 128 + (t >> 6)) * 64 + (t & 63)) * 64);
        dst[d] = hr[base]; dst[d + 1] = hr[base + 1]; }
    for (int i = j; i < 8 * 48; i += 256) { const int hd = i / 48, d = 16 + i % 48; nqr[(size_t)m * 512 + hd * 64 + d] = hr[C_NQ + hd * 64 + d]; }
}
__device__ __forceinline__ void b_rtrans(const Params& p, const h16* __restrict__ h, h16* __restrict__ rvT, h16* __restrict__ rkzT, const float* __restrict__ cosr, const float* __restrict__ sinr, int item, LAS h16* sl, int lane) {
    int id = item; const int tt = id & 255; id >>= 8; const int hd = id & 3; const int b = id >> 2; const int bh = b * 4 + hd; const float lg = p.lg[hd];
    const int chunk = bh * 64 + (tt >> 2), koff = (tt & 3) * 32;
#pragma unroll 4
    for (int i = lane; i < 32 * 16; i += 64) { const int t = i >> 4, e8 = (i & 15) * 8; const h16x8 v = *(const h16x8*)(h + (size_t)(b * T + tt * 32 + t) * INP + C_RV + hd * 128 + e8);
#pragma unroll
        for (int x = 0; x < 8; ++x) sl[t * 130 + e8 + x] = v[x]; }
    asm volatile("s_waitcnt lgkmcnt(0)" ::: "memory");
#pragma unroll 4
    for (int i = lane; i < 128 * 4; i += 64) { const int e = i >> 2, t8 = (i & 3) * 8; h16x8 o;
#pragma unroll
        for (int x = 0; x < 8; ++x) o[x] = sl[(t8 + x) * 130 + e];
        *(h16x8*)(rvT + ((size_t)chunk * 128 + e) * 128 + koff + t8) = o; }
    asm volatile("s_waitcnt lgkmcnt(0)" ::: "memory");
#pragma unroll 4
    for (int i = lane; i < 32 * 8; i += 64) { const int t = i >> 3, j8 = (i & 7) * 8; const size_t m = (size_t)b * T + tt * 32 + t;
        const h16x8 k1 = *(const h16x8*)(h + m * INP + C_RK + hd * 128 + j8), k2 = *(const h16x8*)(h + m * INP + C_RK + hd * 128 + 64 + j8);
        const f32x4 c0 = *(const f32x4*)(cosr + m * 64 + j8), c1 = *(const f32x4*)(cosr + m * 64 + j8 + 4), s0 = *(const f32x4*)(sinr + m * 64 + j8), s1 = *(const f32x4*)(sinr + m * 64 + j8 + 4);
        const float z = 0.08838834764831845f * __expf(lg * (float)(127 - (koff + t)));
#pragma unroll
        for (int x = 0; x < 8; ++x) { const float c = x < 4 ? c0[x & 3] : c1[x & 3], s = x < 4 ? s0[x & 3] : s1[x & 3]; const float a1 = (float)k1[x], a2 = (float)k2[x];
            sl[t * 130 + j8 + x] = (h16)((a1 * c - a2 * s) * z); sl[t * 130 + 64 + j8 + x] = (h16)((a2 * c + a1 * s) * z); } }
    asm volatile("s_waitcnt lgkmcnt(0)" ::: "memory");
#pragma unroll 4
    for (int i = lane; i < 128 * 4; i += 64) { const int d = i >> 2, t8 = (i & 3) * 8; h16x8 o;
#pragma unroll
        for (int x = 0; x < 8; ++x) o[x] = sl[(t8 + x) * 130 + d];
        *(h16x8*)(rkzT + ((size_t)chunk * 128 + d) * 128 + koff + t8) = o; }
    asm volatile("s_waitcnt lgkmcnt(0)" ::: "memory");
}
__device__ __forceinline__ void b_mvtrans(const h16* __restrict__ kvm, h16* __restrict__ kvmVT, h16* __restrict__ kx, int item, h16* sl, int lt) {
    int id = item; const int kt = id & 3; id >>= 2; const int dtl = id & 3; id >>= 2; const int hh = id & 3; const int b = id >> 2;
    for (int i = lt; i < 64 * 64; i += 256) { const int k = i >> 6, d = i & 63; sl[k * 66 + d] = kvm[(size_t)(b * MEML + kt * 64 + k) * 2048 + 1024 + hh * 256 + dtl * 64 + d];
        kx[((size_t)(b * 4 + hh) * MEML + kt * 64 + k) * 256 + dtl * 64 + d] = kvm[(size_t)(b * MEML + kt * 64 + k) * 2048 + hh * 256 + dtl * 64 + d]; }
    __syncthreads();
    for (int i = lt; i < 64 * 64; i += 256) { const int d = i >> 6, k = i & 63; kvmVT[(size_t)((b * 4 + hh) * 256 + dtl * 64 + d) * MEML + kt * 64 + k] = sl[k * 66 + d]; }
    __syncthreads();
}

struct CmpSched {
    const char* hbase; const unsigned* cmpoff; const char* Wc1T; int c;
    __device__ bool next(int i, pg8::Unit& u) const {
        if (i > 0 || c >= 32) return false; const int kv = c >> 4, rt = c & 15;
        u.pm = kv * 16 + rt; u.pn = 0; u.A = hbase + (size_t)(kv ? C_NVC : C_NKC) * 2; u.gat = cmpoff + rt * 256; u.B = Wc1T + (size_t)kv * 256 * 2048 * 2; return true; }
};
__device__ __forceinline__ void b_cmp2(const Params& p, const h16* __restrict__ hid, h16* __restrict__ kcmp, h16* __restrict__ vcmpT) {
    const int lane = tidx() & 63;
    for (int r = blockIdx.x * 8 + (tidx() >> 6); r < 2 * 4096; r += gridDim.x * 8) {
        const int kv = r >> 12, rr = r & 4095, g = rr & 1, c = (rr >> 1) & 511, b = rr >> 10;
        const float* w2 = kv ? p.w2v : p.w2k; const h16* hr = hid + (size_t)r * 256; float acc = 0.f;
        for (int j = 0; j < 256; j += 8) { const h16x8 hv = *(const h16x8*)(hr + j);
#pragma unroll
            for (int x = 0; x < 8; ++x) acc += (float)hv[x] * w2[(j + x) * 64 + lane]; }
        if (c == 511) acc = 0.f;
        if (kv == 0) kcmp[((size_t)(b * 2 + g) * 512 + c) * 64 + lane] = (h16)acc;
        else vcmpT[(((size_t)(b * 2 + g) * 8 + (c >> 6)) * 64 + lane) * 64 + (c & 63)] = (h16)acc;
    }
}
__device__ __forceinline__ void b_vtrans(const h16* __restrict__ h, h16* __restrict__ vsT, h16* __restrict__ vwT, int item, LAS h16* sl, int lane) {
    int id = item; const int tt = id & 127; id >>= 7; const int g = id & 1; id >>= 1; const int b = id & 3; const int which = id >> 2;
    const int col = (which ? C_NVW : C_NVS) + g * 64; h16* dst = (which ? vwT : vsT) + (size_t)((b * 2 + g) * 128 + tt) * 4096;
#pragma unroll 4
    for (int i = lane; i < 64 * 8; i += 64) { const int t = i >> 3, d8 = (i & 7) * 8; const h16x8 v = *(const h16x8*)(h + (size_t)(b * T + tt * 64 + t) * INP + col + d8);
#pragma unroll
        for (int x = 0; x < 8; ++x) sl[t * 66 + d8 + x] = v[x]; }
    asm volatile("s_waitcnt lgkmcnt(0)" ::: "memory");
#pragma unroll 4
    for (int i = lane; i < 64 * 8; i += 64) { const int d = i >> 3, t8 = (i & 7) * 8; h16x8 o;
#pragma unroll
        for (int x = 0; x < 8; ++x) o[x] = sl[(t8 + x) * 66 + d];
        *(h16x8*)(dst + d * 64 + t8) = o; }
    asm volatile("s_waitcnt lgkmcnt(0)" ::: "memory");
}

__device__ __forceinline__ void ret_kv_unit(const h16* __restrict__ rkzT, const h16* __restrict__ rvT, float* __restrict__ kvT, int chunk, int w, int lane) {
    const int i = lane & 15, kg = lane >> 4; const int bh = chunk >> 6, n = chunk & 63;
    h16x8 a[4];
#pragma unroll
    for (int ks = 0; ks < 4; ++ks) a[ks] = *(const h16x8*)(rkzT + ((size_t)chunk * 128 + 16 * w + i) * 128 + 32 * ks + 8 * kg);
#pragma unroll
    for (int et = 0; et < 8; ++et) { f32x4 acc = {0.f, 0.f, 0.f, 0.f};
#pragma unroll
        for (int ks = 0; ks < 4; ++ks) { const h16x8 bq = *(const h16x8*)(rvT + ((size_t)chunk * 128 + 16 * et + i) * 128 + 32 * ks + 8 * kg); acc = __builtin_amdgcn_mfma_f32_16x16x32_f16(a[ks], bq, acc, 0, 0, 0); }
        *(f32x4*)(kvT + ((size_t)chunk * 128 + 16 * et + i) * 128 + 16 * w + 4 * kg) = acc; }
}
__device__ __forceinline__ void b_ret_scan(const Params& p, const float* __restrict__ kvT, h16* __restrict__ prevT) {
    for (int gid = blockIdx.x * NTHR + tidx(); gid < 16 * 16384; gid += gridDim.x * NTHR) {
        const int de = gid & 16383, bh = gid >> 14; const float cd = __expf(p.lg[bh & 3] * 128.f);
        float st = 0.f;
        for (int n = 0; n < 64; ++n) { const size_t o = ((size_t)(bh * 64 + n) << 14) + de; prevT[o] = (h16)st; st = st * cd + kvT[o]; }
    }
}
__device__ __forceinline__ void ret_out_unit(const Params& p, const h16* __restrict__ h, const h16* __restrict__ rqr, const h16* __restrict__ rkr, const h16* __restrict__ rvT, const h16* __restrict__ prevT,
                                             h16* __restrict__ mix, int chunk, int w, int lane) {
    const int i = lane & 15, kg = lane >> 4; const int bh = chunk >> 6, n = chunk & 63, b = bh >> 2, hd = bh & 3; const float lg = p.lg[hd];
    const int qi = 16 * w + i; const size_t m = (size_t)b * T + n * 128 + qi;
    h16x8 qf[4];
#pragma unroll
    for (int ks = 0; ks < 4; ++ks) qf[ks] = *(const h16x8*)(rqr + ((size_t)bh * T + n * 128 + qi) * 128 + 32 * ks + 8 * kg);
    f32x4 inner[8], cross[8];
#pragma unroll
    for (int et = 0; et < 8; ++et) { inner[et] = (f32x4){0.f, 0.f, 0.f, 0.f}; cross[et] = (f32x4){0.f, 0.f, 0.f, 0.f}; }
    for (int gq = 0; gq < 2; ++gq) {
        if (64 * gq > 16 * w + 15) break;
        f32x4 s[4];
#pragma unroll
        for (int tl = 0; tl < 4; ++tl) { const int ko = 32 * (tl >> 1) + 8 * (i >> 2) + 4 * (tl & 1) + (i & 3); const h16* kp = rkr + ((size_t)bh * T + n * 128 + 64 * gq + ko) * 128 + 8 * kg;
            f32x4 acc = {0.f, 0.f, 0.f, 0.f};
#pragma unroll
            for (int ks = 0; ks < 4; ++ks) acc = __builtin_amdgcn_mfma_f32_16x16x32_f16(*(const h16x8*)(kp + 32 * ks), qf[ks], acc, 0, 0, 0);
            s[tl] = acc; }
        h16x8 pf[2];
#pragma unroll
        for (int tl = 0; tl < 4; ++tl)
#pragma unroll
            for (int r = 0; r < 4; ++r) { const int j = 64 * gq + 32 * (tl >> 1) + 8 * kg + 4 * (tl & 1) + r; const float v = (j <= qi) ? s[tl][r] * __expf(lg * (float)(qi - j)) : 0.f; pf[tl >> 1][4 * (tl & 1) + r] = (h16)v; }
#pragma unroll
        for (int et = 0; et < 8; ++et)
#pragma unroll
            for (int s2 = 0; s2 < 2; ++s2) { const h16x8 a = *(const h16x8*)(rvT + ((size_t)chunk * 128 + 16 * et + i) * 128 + 64 * gq + 32 * s2 + 8 * kg); inner[et] = __builtin_amdgcn_mfma_f32_16x16x32_f16(a, pf[s2], inner[et], 0, 0, 0); }
    }
#pragma unroll
    for (int et = 0; et < 8; ++et)
#pragma unroll
        for (int ks = 0; ks < 4; ++ks) { const h16x8 a = *(const h16x8*)(prevT + ((size_t)chunk * 128 + 16 * et + i) * 128 + 32 * ks + 8 * kg); cross[et] = __builtin_amdgcn_mfma_f32_16x16x32_f16(a, qf[ks], cross[et], 0, 0, 0); }
    const float xi = __expf(lg * (float)(qi + 1));
    float sm = 0.f;
#pragma unroll
    for (int et = 0; et < 8; ++et) { inner[et] = inner[et] + cross[et] * xi; sm += (inner[et][0] + inner[et][1]) + (inner[et][2] + inner[et][3]); }
    sm += __shfl_xor(sm, 16); sm += __shfl_xor(sm, 32);
    const float mu = sm * (1.f / 128.f); float sq = 0.f;
#pragma unroll
    for (int et = 0; et < 8; ++et) { inner[et] = inner[et] - mu; sq += (inner[et][0] * inner[et][0] + inner[et][1] * inner[et][1]) + (inner[et][2] * inner[et][2] + inner[et][3] * inner[et][3]); }
    sq += __shfl_xor(sq, 16); sq += __shfl_xor(sq, 32);
    const float rstd = rsqrtf(sq * (1.f / 128.f) + LN_EPS);
#pragma unroll
    for (int et = 0; et < 8; ++et) { const int e = 16 * et + 4 * kg; const h16x4 gv = *(const h16x4*)(h + m * INP + C_RG + hd * 128 + e);
        f32x4 o;
#pragma unroll
        for (int r = 0; r < 4; ++r) o[r] = siluf((float)gv[r]) * inner[et][r] * rstd;
        *(h16x4*)(mix + m * D + hd * 128 + e) = __builtin_convertvector(o, h16x4); }
}

struct AttSt { float m, l; f32x4 o[4]; };
struct KFrag { h16x8 a[4][2]; };
struct VFrag { h16x8 a[4][2]; };
__device__ __forceinline__ void ldk(KFrag& k, const h16* __restrict__ Kb, int pitchK, int i, int kg) {
#pragma unroll
    for (int tl = 0; tl < 4; ++tl) { const int ko = 32 * (tl >> 1) + 8 * (i >> 2) + 4 * (tl & 1) + (i & 3); const h16* kp = Kb + (size_t)ko * pitchK + 8 * kg;
        k.a[tl][0] = *(const h16x8*)kp; k.a[tl][1] = *(const h16x8*)(kp + 32); }
}
__device__ __forceinline__ void ldv(VFrag& v, const h16* __restrict__ VTb, int vstride, int i, int kg) {
#pragma unroll
    for (int dt = 0; dt < 4; ++dt)
#pragma unroll
        for (int s2 = 0; s2 < 2; ++s2) v.a[dt][s2] = *(const h16x8*)(VTb + (size_t)(16 * dt + i) * vstride + 32 * s2 + 8 * kg);
}
__device__ __forceinline__ float xmax4(float v) {
    auto a = __builtin_amdgcn_permlane16_swap(__float_as_uint(v), __float_as_uint(v), false, false); v = fmaxf(__uint_as_float(a[0]), __uint_as_float(a[1]));
    auto c = __builtin_amdgcn_permlane32_swap(__float_as_uint(v), __float_as_uint(v), false, false); return fmaxf(__uint_as_float(c[0]), __uint_as_float(c[1])); }
__device__ __forceinline__ float xsum4(float v) {
    auto a = __builtin_amdgcn_permlane16_swap(__float_as_uint(v), __float_as_uint(v), false, false); v = __uint_as_float(a[0]) + __uint_as_float(a[1]);
    auto c = __builtin_amdgcn_permlane32_swap(__float_as_uint(v), __float_as_uint(v), false, false); return __uint_as_float(c[0]) + __uint_as_float(c[1]); }
constexpr float ATT_C2 = 0.125f * 1.4426950408889634f;
template <bool MASKED, class MaskF>
__device__ __forceinline__ void att_scores(f32x4 (&s)[4], const KFrag& k, const h16x8 (&qf)[2], int kg, MaskF valid) {
#pragma unroll
    for (int tl = 0; tl < 4; ++tl) { f32x4 z = {0.f, 0.f, 0.f, 0.f}; z = __builtin_amdgcn_mfma_f32_16x16x32_f16(k.a[tl][0], qf[0], z, 0, 0, 0); s[tl] = __builtin_amdgcn_mfma_f32_16x16x32_f16(k.a[tl][1], qf[1], z, 0, 0, 0); }
    if (MASKED) {
#pragma unroll
        for (int tl = 0; tl < 4; ++tl)
#pragma unroll
            for (int r = 0; r < 4; ++r) { const int ko = 32 * (tl >> 1) + 8 * kg + 4 * (tl & 1) + r; s[tl][r] = valid(ko) ? s[tl][r] : -INFINITY; }
    }
}
__device__ __forceinline__ float att_rowmax(const f32x4 (&s)[4]) {
    float mx = fmaxf(fmaxf(s[0][0], s[0][1]), fmaxf(s[0][2], s[0][3]));
#pragma unroll
    for (int tl = 1; tl < 4; ++tl) mx = fmaxf(mx, fmaxf(fmaxf(s[tl][0], s[tl][1]), fmaxf(s[tl][2], s[tl][3])));
    return xmax4(mx);
}
__device__ __forceinline__ void att_pv(f32x4 (&o)[4], const f32x4 (&pv)[4], const VFrag& v) {
    h16x8 pf[2];
#pragma unroll
    for (int s2 = 0; s2 < 2; ++s2)
#pragma unroll
        for (int j = 0; j < 8; ++j) pf[s2][j] = (h16)pv[2 * s2 + (j >> 2)][j & 3];
#pragma unroll
    for (int dt = 0; dt < 4; ++dt)
#pragma unroll
        for (int s2 = 0; s2 < 2; ++s2) o[dt] = __builtin_amdgcn_mfma_f32_16x16x32_f16(v.a[dt][s2], pf[s2], o[dt], 0, 0, 0);
}
__device__ __forceinline__ void att_softmax_pv(AttSt& st, f32x4 (&s)[4], const VFrag& v, bool rowok) {
    const float mx = rowok ? att_rowmax(s) * ATT_C2 : -INFINITY;
    const float mn = fmaxf(st.m, mx);
    if (__any(mn > st.m)) { const float alpha = __builtin_amdgcn_exp2f(st.m - mn); st.m = mn; st.l *= alpha;
#pragma unroll
        for (int dt = 0; dt < 4; ++dt) st.o[dt] = st.o[dt] * alpha; }
    const float mneg = rowok ? -mn : -INFINITY;
    float ps0 = 0.f, ps1 = 0.f;
#pragma unroll
    for (int tl = 0; tl < 4; ++tl) {
#pragma unroll
        for (int r = 0; r < 4; ++r) s[tl][r] = __builtin_amdgcn_exp2f(__builtin_fmaf(s[tl][r], ATT_C2, mneg));
        ps0 += s[tl][0] + s[tl][1]; ps1 += s[tl][2] + s[tl][3]; }
    st.l += ps0 + ps1;
    att_pv(st.o, s, v);
}
template <bool MASKED, class MaskF>
__device__ __forceinline__ void att_tile(AttSt& st, const KFrag& k, const VFrag& v, const h16x8 (&qf)[2], int kg, bool rowok, MaskF valid) {
    f32x4 s[4]; att_scores<MASKED>(s, k, qf, kg, valid);
    att_softmax_pv(st, s, v, rowok);
}
constexpr int NSA_NSLOT = 6, NSA_RING = 0, NSA_IMP = NSA_NSLOT * 16384, NSA_MSK = 131072 + 256, NSA_LIST = NSA_MSK + 256;
__device__ __forceinline__ void ldk_lds(KFrag& k, LAS const unsigned char* slot, int ko0, int ko1) {
#pragma unroll
    for (int tl = 0; tl < 4; ++tl) { const int o = (32 * (tl >> 1) + 4 * (tl & 1)) * 128; k.a[tl][0] = *(LAS const h16x8*)(slot + o + ko0); k.a[tl][1] = *(LAS const h16x8*)(slot + o + ko1); }
}
__device__ __forceinline__ void ldv_lds(VFrag& v, LAS const unsigned char* slot, int vo0, int vo1) {
#pragma unroll
    for (int dt = 0; dt < 4; ++dt) { v.a[dt][0] = *(LAS const h16x8*)(slot + 8192 + dt * 2048 + vo0); v.a[dt][1] = *(LAS const h16x8*)(slot + 8192 + dt * 2048 + vo1); }
}
#define NSA_WAITV(n) asm volatile("s_waitcnt vmcnt(" #n ")" ::: "memory")
#define NSA_BAR() do { asm volatile("s_waitcnt lgkmcnt(0)" ::: "memory"); __builtin_amdgcn_s_barrier(); asm volatile("" ::: "memory"); } while (0)
template <int LPT, class IssueF, class CompF>
__device__ __forceinline__ void nsa_stream2(int n, LAS unsigned char* dmaw, LAS unsigned char* ring, IssueF issue, CompF comp2) {
#pragma unroll
    for (int j = 0; j < 4; ++j) if (j < n) issue(j, (LAS unsigned*)(dmaw + j * 16384));
    int sa = 0, si = 4 * 16384;
    for (int t2 = 0; t2 < n; t2 += 2) {
        const int rem = n - t2 - 2;
        if (rem >= 2) { if (LPT == 2) NSA_WAITV(4); else NSA_WAITV(2); } else if (rem == 1) { if (LPT == 2) NSA_WAITV(2); else NSA_WAITV(1); } else NSA_WAITV(0);
        NSA_BAR();
        if (t2 + 4 < n) issue(t2 + 4, (LAS unsigned*)(dmaw + si));
        if (t2 + 5 < n) issue(t2 + 5, (LAS unsigned*)(dmaw + si + 16384));
        comp2(t2, (LAS const unsigned char*)(ring + sa), t2 + 1 < n, (LAS const unsigned char*)(ring + sa + 16384));
        sa = (sa == 4 * 16384) ? 0 : sa + 2 * 16384; si = (si == 4 * 16384) ? 0 : si + 2 * 16384; }
    NSA_BAR();
}
__device__ __forceinline__ void att_merge(AttSt& a, const AttSt& b2) {
    const float mn = fmaxf(a.m, b2.m); const float fa = __builtin_amdgcn_exp2f(a.m - mn), fb = __builtin_amdgcn_exp2f(b2.m - mn);
    a.m = mn; a.l = a.l * fa + b2.l * fb;
#pragma unroll
    for (int dt = 0; dt < 4; ++dt) a.o[dt] = a.o[dt] * fa + b2.o[dt] * fb;
}
__device__ __forceinline__ void nsa_block_unit(const h16* __restrict__ h, const h16* __restrict__ nqr, const h16* __restrict__ kcmp, const h16* __restrict__ vcmpT, const h16* __restrict__ vsT, const h16* __restrict__ vwT,
                                               const h16* __restrict__ ksR, const h16* __restrict__ kwR, h16* __restrict__ mix, int b, int g, int T0, LAS unsigned char* lds, int wv, int lane) {
    const int i = lane & 15, kg = lane >> 4, tt = i & 3, hh = i >> 2;
    const int t0 = T0 + 4 * wv, trow = t0 + tt; const size_t mrow = (size_t)b * T + trow;
    const int q = wv * 64 + lane, qrow = q >> 3, qch = q & 7;
    const int ksrc = qrow * 128 + ((qch ^ (((qrow >> 1) & 1) | (((qrow >> 3) & 3) << 1))) << 4), vsrc = qrow * 128 + ((qch ^ ((qrow >> 1) & 7)) << 4);
    const int gki = ((i >> 1) & 1) | ((i >> 2) << 1), gvi = (i >> 1) & 7;
    const int ko0 = (8 * (i >> 2) + (i & 3)) * 128 + ((kg ^ gki) << 4), ko1 = (8 * (i >> 2) + (i & 3)) * 128 + (((kg + 4) ^ gki) << 4);
    const int vo0 = i * 128 + ((kg ^ gvi) << 4), vo1 = i * 128 + (((kg + 4) ^ gvi) << 4);
    LAS unsigned char* ring = lds + NSA_RING; LAS unsigned char* dmaw = ring + wv * 1024;
    LAS float* impA = (LAS float*)(lds + NSA_IMP + wv * 4096); LAS float* impL = impA + 512;
    h16x8 qf[2], qrf[2];
    { const h16* qp = h + mrow * INP + C_NQ + (g * 4 + hh) * 64 + 8 * kg; qf[0] = *(const h16x8*)qp; qf[1] = *(const h16x8*)(qp + 32);
      const h16* qrp = nqr + mrow * 512 + (g * 4 + hh) * 64 + 8 * kg; qrf[0] = *(const h16x8*)qrp; qrf[1] = *(const h16x8*)(qrp + 32); }
    const h16* gp = h + mrow * INP + C_NG + (g * 4 + hh) * 3; const float gt0 = (float)gp[0], gt1 = (float)gp[1], gt2 = (float)gp[2];
    for (int x = lane; x < 1024; x += 64) impA[x] = 0.f;
    NSA_WAITV(0);
#define GLDS16(gsrc, ldst) __builtin_amdgcn_global_load_lds((const unsigned*)(gsrc), (ldst), 16, 0, 0)
    const int ncv_row = trow >= 31 ? ((trow - 31) >> 4) + 1 : 0;
    const int ncv_blk = (T0 + 31 >= 31) ? ((T0 + 31 - 31) >> 4) + 1 : 0;
    const int ncv_min = T0 >= 31 ? ((T0 - 31) >> 4) + 1 : 0;
    const int nct = (ncv_blk + 63) >> 6;
    const unsigned char* Kc = (const unsigned char*)(kcmp + (size_t)(b * 2 + g) * 512 * 64); const unsigned char* Vc = (const unsigned char*)(vcmpT + (size_t)(b * 2 + g) * 8 * 4096);
    float m = -1e30f, l = 0.f;
    f32x4 oc[4];
    float linv = 0.f;
    REPS(501) {
    m = -1e30f; l = 0.f;
#pragma unroll
    for (int dt = 0; dt < 4; ++dt) oc[dt] = (f32x4){0.f, 0.f, 0.f, 0.f};
    float mB = -1e30f, lB = 0.f;
    auto cmp1 = [&](int j, LAS const unsigned char* slot, float& mm, float& ll) {
        KFrag kf; ldk_lds(kf, slot, ko0, ko1);
        f32x4 s[4];
        if (64 * j + 63 < ncv_min) att_scores<false>(s, kf, qf, kg, [&](int) { return true; }); else att_scores<true>(s, kf, qf, kg, [&](int ko) { return j * 64 + ko < ncv_row; });
        const float mx = att_rowmax(s) * ATT_C2;
        const float mn = fmaxf(mm, mx); float ps0 = 0.f, ps1 = 0.f;
        _Pragma("unroll") for (int tl = 0; tl < 4; ++tl) { ps0 += __builtin_amdgcn_exp2f(__builtin_fmaf(s[tl][0], ATT_C2, -mn)) + __builtin_amdgcn_exp2f(__builtin_fmaf(s[tl][1], ATT_C2, -mn));
                                                          ps1 += __builtin_amdgcn_exp2f(__builtin_fmaf(s[tl][2], ATT_C2, -mn)) + __builtin_amdgcn_exp2f(__builtin_fmaf(s[tl][3], ATT_C2, -mn)); }
        ll = ll * __builtin_amdgcn_exp2f(mm - mn) + (ps0 + ps1); mm = mn; };
    nsa_stream2<1>(nct, dmaw, ring, [&](int j, LAS unsigned* dk) { GLDS16(Kc + (size_t)j * 8192 + ksrc, dk); }, [&](int j, LAS const unsigned char* sA, bool hasB, LAS const unsigned char* sB) {
        cmp1(j, sA, m, l); __builtin_amdgcn_sched_barrier(0); if (hasB) cmp1(j + 1, sB, mB, lB); });
    { const float mn = fmaxf(m, mB); l = l * __builtin_amdgcn_exp2f(m - mn) + lB * __builtin_amdgcn_exp2f(mB - mn); m = mn; }
    l = xsum4(l);
    linv = l > 0.f ? 1.f / l : 0.f;
    auto cmp2 = [&](int j, LAS const unsigned char* slot) {
        KFrag kf; ldk_lds(kf, slot, ko0, ko1); VFrag vf; ldv_lds(vf, slot, vo0, vo1);
        f32x4 s[4];
        if (64 * j + 63 < ncv_min) att_scores<false>(s, kf, qf, kg, [&](int) { return true; }); else att_scores<true>(s, kf, qf, kg, [&](int ko) { return j * 64 + ko < ncv_row; });
        _Pragma("unroll") for (int tl = 0; tl < 4; ++tl) {
            _Pragma("unroll") for (int r = 0; r < 4; ++r) s[tl][r] = __builtin_amdgcn_exp2f(__builtin_fmaf(s[tl][r], ATT_C2, -m)) * linv;
            float A = (s[tl][0] + s[tl][1]) + (s[tl][2] + s[tl][3]), L = s[tl][3];
            A += __shfl_xor(A, 4); A += __shfl_xor(A, 8); L += __shfl_xor(L, 4); L += __shfl_xor(L, 8);
            if (hh == 0) { const int u = j * 16 + 8 * (tl >> 1) + 2 * kg + (tl & 1); impA[tt * 128 + u] = A; impL[tt * 128 + u] = L; } }
        att_pv(oc, s, vf); };
    nsa_stream2<2>(nct, dmaw, ring, [&](int j, LAS unsigned* dk) { GLDS16(Kc + (size_t)j * 8192 + ksrc, dk); GLDS16(Vc + (size_t)j * 8192 + vsrc, (LAS unsigned*)((LAS unsigned char*)dk + 8192)); },
        [&](int j, LAS const unsigned char* sA, bool hasB, LAS const unsigned char* sB) { cmp2(j, sA); if (hasB) cmp2(j + 1, sB); });
    }
    const int cur = T0 >> 6;
    AttSt sw;
    REPS(504) {
    sw.m = -1e30f; sw.l = 0.f;
#pragma unroll
    for (int dt = 0; dt < 4; ++dt) sw.o[dt] = (f32x4){0.f, 0.f, 0.f, 0.f};
    {
        const unsigned char* Kw = (const unsigned char*)(kwR + (size_t)((b * 2 + g) * 128) * 4096); const unsigned char* Vw = (const unsigned char*)(vwT + (size_t)((b * 2 + g) * 128) * 4096);
        const int s0w = (T0 >= 511 ? (T0 - 511) >> 6 : 0);
        AttSt swB; swB.m = -1e30f; swB.l = 0.f;
#pragma unroll
        for (int dt = 0; dt < 4; ++dt) swB.o[dt] = (f32x4){0.f, 0.f, 0.f, 0.f};
        auto wsc = [&](f32x4 (&s)[4], int j, LAS const unsigned char* slot) { KFrag kf; ldk_lds(kf, slot, ko0, ko1); const int sx = s0w + j;
            if (sx > s0w + 1 && sx < cur) att_scores<false>(s, kf, qrf, kg, [&](int) { return true; });
            else att_scores<true>(s, kf, qrf, kg, [&](int ko) { const int kp = 64 * sx + ko; return kp <= trow && kp >= trow - 511; }); };
        nsa_stream2<2>(cur - s0w + 1, dmaw, ring, [&](int j, LAS unsigned* dk) { GLDS16(Kw + (size_t)(s0w + j) * 8192 + ksrc, dk); GLDS16(Vw + (size_t)(s0w + j) * 8192 + vsrc, (LAS unsigned*)((LAS unsigned char*)dk + 8192)); },
            [&](int j, LAS const unsigned char* sA, bool hasB, LAS const unsigned char* sB) {
                if (hasB) { f32x4 s0[4], s1[4]; wsc(s0, j, sA); wsc(s1, j + 1, sB); __builtin_amdgcn_sched_barrier(0);
                    { VFrag vf; ldv_lds(vf, sA, vo0, vo1); att_softmax_pv(sw, s0, vf, true); } { VFrag vf; ldv_lds(vf, sB, vo0, vo1); att_softmax_pv(swB, s1, vf, true); } }
                else { f32x4 s0[4]; wsc(s0, j, sA); VFrag vf; ldv_lds(vf, sA, vo0, vo1); att_softmax_pv(sw, s0, vf, true); } });
        att_merge(sw, swB);
    }
    }
    unsigned long long mylo, myhi, anylo, anyhi;
    if (cur <= 15) { mylo = anylo = (1ull << (cur + 1)) - 1ull; myhi = anyhi = 0ull; }
    else {
        mylo = myhi = anylo = anyhi = 0ull;
        const unsigned long long flo = 1ull | (cur < 64 ? (1ull << cur) : 0ull) | (cur - 1 < 64 ? (1ull << (cur - 1)) : 0ull);
        const unsigned long long fhi = (cur >= 64 ? (1ull << (cur - 64)) : 0ull) | (cur - 1 >= 64 ? (1ull << (cur - 65)) : 0ull);
        const unsigned long long lmask = (1ull << lane) - 1ull;
        for (int tk = 0; tk < 4; ++tk) {
            const int s0 = lane, s1 = lane + 64;
            const float v0 = impA[tk * 128 + s0] + (s0 > 0 ? impL[tk * 128 + s0 - 1] : 0.f), v1 = impA[tk * 128 + s1] + impL[tk * 128 + s1 - 1];
            const unsigned b0 = (s0 >= 1 && s0 <= cur - 2) ? __float_as_uint(v0) + 1u : 0u, b1 = (s1 <= cur - 2) ? __float_as_uint(v1) + 1u : 0u;
            unsigned Tq = 0u;
            for (int bit = 30; bit >= 0; --bit) { const unsigned T2 = Tq | (1u << bit);
                const int c = __popcll(__ballot(b0 >= T2)) + __popcll(__ballot(b1 >= T2)); if (c >= 13) Tq = T2; }
            const unsigned long long gtlo = __ballot(b0 > Tq), gthi = __ballot(b1 > Tq), eqlo = __ballot(b0 == Tq), eqhi = __ballot(b1 == Tq);
            const int need = 13 - (__popcll(gtlo) + __popcll(gthi));
            const bool t0q = (b0 == Tq) && (__popcll(eqlo & lmask) < need), t1q = (b1 == Tq) && (__popcll(eqlo) + __popcll(eqhi & lmask) < need);
            const unsigned long long lo = gtlo | __ballot(t0q) | flo, hi = gthi | __ballot(t1q) | fhi;
            anylo |= lo; anyhi |= hi; if (tt == tk) { mylo = lo; myhi = hi; }
        }
    }
    LAS unsigned long long* msk = (LAS unsigned long long*)(lds + NSA_MSK); LAS unsigned char* lst = lds + NSA_LIST; LAS int* nlst = (LAS int*)(lds + NSA_LIST + 128);
    if (lane == 0) { msk[2 * wv] = anylo; msk[2 * wv + 1] = anyhi; }
    NSA_BAR();
    if (wv == 0) {
        unsigned long long ulo = 0ull, uhi = 0ull;
#pragma unroll
        for (int w2 = 0; w2 < 8; ++w2) { ulo |= msk[2 * w2]; uhi |= msk[2 * w2 + 1]; }
        const unsigned long long lmask = (1ull << lane) - 1ull; const int nlo = __popcll(ulo);
        if ((ulo >> lane) & 1ull) lst[__popcll(ulo & lmask)] = (unsigned char)lane;
        if ((uhi >> lane) & 1ull) lst[nlo + __popcll(uhi & lmask)] = (unsigned char)(64 + lane);
        if (lane == 0) nlst[0] = nlo + __popcll(uhi);
    }
    NSA_BAR();
    const int nsel = nlst[0];
    AttSt ss;
    REPS(503) {
    ss.m = -1e30f; ss.l = 0.f;
#pragma unroll
    for (int dt = 0; dt < 4; ++dt) ss.o[dt] = (f32x4){0.f, 0.f, 0.f, 0.f};
    {
        const unsigned char* Ks = (const unsigned char*)(ksR + (size_t)((b * 2 + g) * 128) * 4096); const unsigned char* Vs = (const unsigned char*)(vsT + (size_t)((b * 2 + g) * 128) * 4096);
        auto sel1 = [&](int s, LAS const unsigned char* slot, AttSt& st) {
            KFrag kf; ldk_lds(kf, slot, ko0, ko1); VFrag vf; ldv_lds(vf, slot, vo0, vo1);
            const bool mybit = (((s < 64 ? mylo : myhi) >> (s & 63)) & 1ull) != 0ull;
            if (s < cur) att_tile<false>(st, kf, vf, qrf, kg, mybit, [&](int) { return true; });
            else att_tile<true>(st, kf, vf, qrf, kg, mybit, [&](int ko) { return 64 * s + ko <= trow; }); };
        nsa_stream2<2>(nsel, dmaw, ring, [&](int j, LAS unsigned* dk) { const int sj = lst[j]; GLDS16(Ks + (size_t)sj * 8192 + ksrc, dk); GLDS16(Vs + (size_t)sj * 8192 + vsrc, (LAS unsigned*)((LAS unsigned char*)dk + 8192)); },
            [&](int j, LAS const unsigned char* sA, bool hasB, LAS const unsigned char* sB) {
                const int s0 = lst[j]; const int s1 = hasB ? (int)lst[j + 1] : 0;
                const bool nA = (((s0 < 64 ? anylo : anyhi) >> (s0 & 63)) & 1ull) != 0ull, nB = hasB && ((((s1 < 64 ? anylo : anyhi) >> (s1 & 63)) & 1ull) != 0ull);
                if (nA) sel1(s0, sA, ss);
                if (nB) sel1(s1, sB, ss); });
    }
    }
    const float ls = xsum4(ss.l), lw = xsum4(sw.l);
    const float g0 = sigmf(gt0), g1 = sigmf(gt1) / ls, g2 = sigmf(gt2) / lw;
#pragma unroll
    for (int dt = 0; dt < 4; ++dt) { const f32x4 o = oc[dt] * g0 + ss.o[dt] * g1 + sw.o[dt] * g2;
        *(h16x4*)(mix + mrow * D + 512 + (g * 4 + hh) * 64 + 16 * dt + 4 * kg) = __builtin_convertvector(o, h16x4); }
#undef GLDS16
}

__device__ __forceinline__ void b_ln(const float* __restrict__ in, const float* __restrict__ gam, const float* __restrict__ bet, float* __restrict__ o32, h16* __restrict__ o16) {
    const int lane = tidx() & 63;
    for (int row = blockIdx.x * 8 + (tidx() >> 6); row < M; row += gridDim.x * 8) {
        const f32x4* xr = (const f32x4*)(in + (size_t)row * D) + lane;
        f32x4 v[4]; float s = 0.f;
#pragma unroll
        for (int j = 0; j < 4; ++j) { v[j] = xr[64 * j]; s += (v[j][0] + v[j][1]) + (v[j][2] + v[j][3]); }
        const float mean = wave_sum(s) * (1.f / D); float s2 = 0.f;
#pragma unroll
        for (int j = 0; j < 4; ++j) { v[j] = v[j] - mean; s2 += (v[j][0] * v[j][0] + v[j][1] * v[j][1]) + (v[j][2] * v[j][2] + v[j][3] * v[j][3]); }
        const float rstd = rsqrtf(wave_sum(s2) * (1.f / D) + LN_EPS);
#pragma unroll
        for (int j = 0; j < 4; ++j) { const f32x4 gg = ((const f32x4*)gam)[lane + 64 * j], bb = ((const f32x4*)bet)[lane + 64 * j]; const f32x4 o = v[j] * rstd * gg + bb;
            ((f32x4*)(o32 + (size_t)row * D))[lane + 64 * j] = o;
            if (o16) ((h16x4*)(o16 + (size_t)row * D))[lane + 64 * j] = __builtin_convertvector(o, h16x4); }
    }
}

__device__ __forceinline__ void xattn_block(const h16* __restrict__ qx, const h16* __restrict__ kx, const h16* __restrict__ kvmVT, h16* __restrict__ ox, int G, int bid, LAS unsigned char* lds, int wv, int lane) {
    const int i = lane & 15, kg = lane >> 4;
    const int gki = ((i >> 1) & 1) | ((i >> 2) << 1), gvi = (i >> 1) & 7;
    const int ko0 = (8 * (i >> 2) + (i & 3)) * 512 + ((kg ^ gki) << 4), ko1 = (8 * (i >> 2) + (i & 3)) * 512 + (((kg + 4) ^ gki) << 4);
    const int vo0 = i * 128 + ((kg ^ gvi) << 4), vo1 = i * 128 + (((kg + 4) ^ gvi) << 4);
    const int t = wv * 64 + lane;
    int ksrc[4], vsrc[4];
#pragma unroll
    for (int pz = 0; pz < 4; ++pz) { const int q = pz * 512 + t;
        { const int row = q >> 5, cp = q & 31; const int gk = ((row >> 1) & 1) | (((row >> 3) & 3) << 1); ksrc[pz] = row * 512 + ((cp ^ gk) << 4); }
        { const int row = q >> 3, cp = q & 7; vsrc[pz] = row * 512 + ((cp ^ ((row >> 1) & 7)) << 4); } }
    const int nun = ((M / 128) * 4 - bid + G - 1) / G;
    const int ntile = nun * 4;
    auto issue = [&](int tix, int slot) { const int u = bid + G * (tix >> 2), grp = tix & 3; const int m0 = (u >> 2) * 128, hh = u & 3, b = m0 >> 13;
        const unsigned char* Kb = (const unsigned char*)(kx + ((size_t)(b * 4 + hh) * MEML + 64 * grp) * 256); const unsigned char* Vb = (const unsigned char*)(kvmVT + (size_t)((b * 4 + hh) * 256) * MEML + 64 * grp);
        LAS unsigned char* base = lds + slot * 65536 + wv * 1024;
#pragma unroll
        for (int pz = 0; pz < 4; ++pz) { __builtin_amdgcn_global_load_lds((const unsigned*)(Kb + ksrc[pz]), (LAS unsigned*)(base + pz * 8192), 16, 0, 0);
                                        __builtin_amdgcn_global_load_lds((const unsigned*)(Vb + vsrc[pz]), (LAS unsigned*)(base + 32768 + pz * 8192), 16, 0, 0); } };
    NSA_WAITV(0);
    if (ntile > 0) issue(0, 0);
    h16x8 qf[8]; f32x4 o[16]; float mrun = -1e30f, l = 0.f; size_t mrow = 0; int hh = 0;
    for (int tix = 0; tix < ntile; ++tix) {
        const int grp = tix & 3, slot = tix & 1;
        if (grp == 0) {
            const int u = bid + G * (tix >> 2); mrow = (size_t)((u >> 2) * 128 + wv * 16 + i); hh = u & 3;
#pragma unroll
            for (int ks = 0; ks < 8; ++ks) qf[ks] = *(const h16x8*)(qx + mrow * D + hh * 256 + 32 * ks + 8 * kg);
#pragma unroll
            for (int dt = 0; dt < 16; ++dt) o[dt] = (f32x4){0.f, 0.f, 0.f, 0.f};
            mrun = -1e30f; l = 0.f;
        }
        NSA_WAITV(0);
        NSA_BAR();
        if (tix + 1 < ntile) issue(tix + 1, slot ^ 1);
        LAS const unsigned char* sk = lds + slot * 65536; LAS const unsigned char* sv = sk + 32768;
        f32x4 s[4];
#pragma unroll
        for (int tl = 0; tl < 4; ++tl) { const int ro = (32 * (tl >> 1) + 4 * (tl & 1)) * 512; f32x4 acc = {0.f, 0.f, 0.f, 0.f};
#pragma unroll
            for (int ks = 0; ks < 8; ++ks) acc = __builtin_amdgcn_mfma_f32_16x16x32_f16(*(LAS const h16x8*)(sk + ro + 128 * (ks >> 1) + ((ks & 1) ? ko1 : ko0)), qf[ks], acc, 0, 0, 0);
            s[tl] = acc; }
        const float mx = att_rowmax(s) * (0.0625f * 1.4426950408889634f);
        const float mn = fmaxf(mrun, mx); const float alpha = __builtin_amdgcn_exp2f(mrun - mn); mrun = mn;
        float ps = 0.f; h16x8 pf[2];
#pragma unroll
        for (int tl = 0; tl < 4; ++tl)
#pragma unroll
            for (int r = 0; r < 4; ++r) { const float pe = __builtin_amdgcn_exp2f(__builtin_fmaf(s[tl][r], 0.0625f * 1.4426950408889634f, -mn)); ps += pe; pf[tl >> 1][4 * (tl & 1) + r] = (h16)pe; }
        l = l * alpha + ps;
#pragma unroll
        for (int dt = 0; dt < 16; ++dt) { f32x4 acc = o[dt] * alpha;
            acc = __builtin_amdgcn_mfma_f32_16x16x32_f16(*(LAS const h16x8*)(sv + dt * 2048 + vo0), pf[0], acc, 0, 0, 0);
            acc = __builtin_amdgcn_mfma_f32_16x16x32_f16(*(LAS const h16x8*)(sv + dt * 2048 + vo1), pf[1], acc, 0, 0, 0);
            o[dt] = acc; }
        if (grp == 3) { const float linv = 1.f / xsum4(l);
#pragma unroll
            for (int dt = 0; dt < 16; ++dt) { const f32x4 acc = o[dt] * linv; *(h16x4*)(ox + mrow * D + hh * 256 + 16 * dt + 4 * kg) = __builtin_convertvector(acc, h16x4); } }
    }
    NSA_WAITV(0);
    NSA_BAR();
}

__device__ __forceinline__ void route_token(float logit, int m, int lane, const float* __restrict__ rbias, int* __restrict__ tope, float* __restrict__ topw, int* __restrict__ hist) {
    const float score = 1.f / (1.f + expf(-logit)); const float biased = score + rbias[lane];
    float m1 = biased; m1 = fmaxf(m1, __shfl_xor(m1, 1)); m1 = fmaxf(m1, __shfl_xor(m1, 2)); m1 = fmaxf(m1, __shfl_xor(m1, 4));
    int am = (biased == m1) ? lane : 999; am = min(am, __shfl_xor(am, 1)); am = min(am, __shfl_xor(am, 2)); am = min(am, __shfl_xor(am, 4));
    float m2 = (lane == am) ? -INFINITY : biased; m2 = fmaxf(m2, __shfl_xor(m2, 1)); m2 = fmaxf(m2, __shfl_xor(m2, 2)); m2 = fmaxf(m2, __shfl_xor(m2, 4));
    const float gs = m1 + m2;
    int cnt = 0;
#pragma unroll
    for (int gq = 0; gq < 8; ++gq) { const float o = __shfl(gs, gq * 8); cnt += (o > gs) ? 1 : 0; }
    const float masked = (cnt <= 3) ? biased : NEGF;
    int rank = 0;
    for (int e2 = 0; e2 < 64; ++e2) { const float o = __shfl(masked, e2); rank += (o > masked || (o == masked && e2 < lane)) ? 1 : 0; }
    const bool selq = rank < 8;
    const float wsum = wave_sum(selq ? score : 0.f);
    if (selq) { tope[(size_t)m * 8 + rank] = lane; topw[(size_t)m * 8 + rank] = score / wsum * 2.5f; atomicAdd(hist + (m >> 13) * 65 + lane, 1); }
}
__device__ __forceinline__ void router_unit(const Params& p, const float* __restrict__ pre, h16* __restrict__ x2h, const h16* __restrict__ WrTh, const h16* __restrict__ WrTl, int* __restrict__ tope, float* __restrict__ topw,
                                            int* __restrict__ hist, int m0, LAS float* lg, int lane) {
    const int i = lane & 15, kg = lane >> 4;
    const float* xr = pre + (size_t)(m0 + i) * D + 8 * kg;
    float s1 = 0.f, s2 = 0.f;
#pragma unroll 4
    for (int ks = 0; ks < 32; ++ks) { const f32x4 x0 = *(const f32x4*)(xr + 32 * ks), x1 = *(const f32x4*)(xr + 32 * ks + 4);
        s1 += (x0[0] + x0[1]) + (x0[2] + x0[3]) + (x1[0] + x1[1]) + (x1[2] + x1[3]);
        s2 += (x0[0] * x0[0] + x0[1] * x0[1]) + (x0[2] * x0[2] + x0[3] * x0[3]) + (x1[0] * x1[0] + x1[1] * x1[1]) + (x1[2] * x1[2] + x1[3] * x1[3]); }
    s1 = xsum4(s1); s2 = xsum4(s2);
    const float mean = s1 * (1.f / D); const float rstd = rsqrtf(fmaxf(s2 * (1.f / D) - mean * mean, 0.f) + LN_EPS);
    f32x4 am_[4], ac_[4];
#pragma unroll
    for (int et = 0; et < 4; ++et) { am_[et] = (f32x4){0.f, 0.f, 0.f, 0.f}; ac_[et] = (f32x4){0.f, 0.f, 0.f, 0.f}; }
    h16* xo = x2h + (size_t)(m0 + i) * D + 8 * kg;
#pragma unroll 2
    for (int ks = 0; ks < 32; ++ks) {
        f32x4 x0 = *(const f32x4*)(xr + 32 * ks), x1 = *(const f32x4*)(xr + 32 * ks + 4);
        const f32x4 g0 = *(const f32x4*)(p.ln2g + 32 * ks + 8 * kg), g1 = *(const f32x4*)(p.ln2g + 32 * ks + 8 * kg + 4), b0 = *(const f32x4*)(p.ln2b + 32 * ks + 8 * kg), b1 = *(const f32x4*)(p.ln2b + 32 * ks + 8 * kg + 4);
        x0 = (x0 - mean) * rstd * g0 + b0; x1 = (x1 - mean) * rstd * g1 + b1;
        h16x8 xh, xl;
#pragma unroll
        for (int j = 0; j < 4; ++j) { xh[j] = (h16)x0[j]; xl[j] = (h16)((x0[j] - (float)xh[j]) * 2048.f); xh[4 + j] = (h16)x1[j]; xl[4 + j] = (h16)((x1[j] - (float)xh[4 + j]) * 2048.f); }
        *(h16x8*)(xo + 32 * ks) = xh;
#pragma unroll
        for (int et = 0; et < 4; ++et) { const h16x8 wh = *(const h16x8*)(WrTh + (size_t)(16 * et + i) * D + 32 * ks + 8 * kg), wl = *(const h16x8*)(WrTl + (size_t)(16 * et + i) * D + 32 * ks + 8 * kg);
            am_[et] = __builtin_amdgcn_mfma_f32_16x16x32_f16(wh, xh, am_[et], 0, 0, 0);
            ac_[et] = __builtin_amdgcn_mfma_f32_16x16x32_f16(wh, xl, ac_[et], 0, 0, 0);
            ac_[et] = __builtin_amdgcn_mfma_f32_16x16x32_f16(wl, xh, ac_[et], 0, 0, 0); }
    }
#pragma unroll
    for (int et = 0; et < 4; ++et)
#pragma unroll
        for (int r = 0; r < 4; ++r) lg[i * 64 + 16 * et + 4 * kg + r] = am_[et][r] + ac_[et][r] * (1.f / 2048.f);
    for (int tk = 0; tk < 16; ++tk) route_token(lg[tk * 64 + lane], m0 + tk, lane, p.rbias, tope, topw, hist);
}

__device__ __forceinline__ void b_moe(const Params& p, const float* __restrict__ x2, const int* __restrict__ tope, const float* __restrict__ topw, float* __restrict__ out, int m, float* sl, int tid) {
    float* xs = sl; float* hd = sl + 1024; float* red = sl + 1280;
    for (int i = tid; i < 1024; i += 256) xs[i] = x2[(size_t)m * D + i];
    __syncthreads();
    float acc[4] = {0.f, 0.f, 0.f, 0.f};
    for (int kx = 0; kx < 9; ++kx) {
        const float* G; const float* U; const float* Dn; float wt;
        if (kx < 8) { const int e = tope[(size_t)m * 8 + kx]; wt = topw[(size_t)m * 8 + kx]; G = p.w_gate + (size_t)e * D * EFF; U = p.w_up + (size_t)e * D * EFF; Dn = p.w_down + (size_t)e * EFF * D; }
        else { wt = 1.f; G = p.ws_gate; U = p.ws_up; Dn = p.ws_down; }
        float a = 0.f, u = 0.f;
        for (int k = 0; k < D; ++k) { const float xv = xs[k]; a += xv * G[(size_t)k * EFF + tid]; u += xv * U[(size_t)k * EFF + tid]; }
        hd[tid] = siluf(a) * u * wt;
        __syncthreads();
        for (int j = 0; j < EFF; ++j) { const float hv = hd[j]; const float* dr = Dn + (size_t)j * D + tid;
            acc[0] += hv * dr[0]; acc[1] += hv * dr[256]; acc[2] += hv * dr[512]; acc[3] += hv * dr[768]; }
        __syncthreads();
    }
    float v[4]; float s = 0.f;
#pragma unroll
    for (int i = 0; i < 4; ++i) { v[i] = DN_ALPHA * xs[tid + 256 * i] + acc[i]; s += v[i]; }
    s = wave_sum(s); if ((tid & 63) == 0) red[tid >> 6] = s; __syncthreads();
    const float mean = (red[0] + red[1] + red[2] + red[3]) * (1.f / D); float s2 = 0.f;
#pragma unroll
    for (int i = 0; i < 4; ++i) { v[i] -= mean; s2 += v[i] * v[i]; }
    s2 = wave_sum(s2); if ((tid & 63) == 0) red[4 + (tid >> 6)] = s2; __syncthreads();
    const float rstd = rsqrtf((red[4] + red[5] + red[6] + red[7]) * (1.f / D) + LN_EPS);
#pragma unroll
    for (int i = 0; i < 4; ++i) out[(size_t)m * D + tid + 256 * i] = v[i] * rstd * p.ln3g[tid + 256 * i] + p.ln3b[tid + 256 * i];
    __syncthreads();
}

struct G1Sched {
    const int* ctl; const char* x2h; const unsigned* rowoff; const char* WguT; int G, c;
    __device__ bool next(int i, pg8::Unit& u) const {
        const int ntile = ctl[CTL_TQS + NQ]; const long L = (long)i * G + c; if (L >= 2L * ntile) return false;
        const int tile = (int)(L >> 1), pn = (int)(L & 1); const int e = ctl[CTL_TVE + tile] % 65;
        u.pm = tile; u.pn = pn; u.A = x2h; u.gat = rowoff + (size_t)tile * 256; u.B = WguT + ((size_t)e * 512 + pn * 256) * (D * 2); return true; }
};
struct G2Sched {
    const int* ctl; const char* H; const char* WdT; int q, G, c;
    __device__ bool next(int i, pg8::Unit& u) const {
        const int t0 = ctl[CTL_TQS + q], t1 = ctl[CTL_TQS + q + 1]; const long L = (long)i * G + c; if (L >= 4L * (t1 - t0)) return false;
        const int tile = t0 + (int)(L >> 2), pn = (int)(L & 3); const int e = ctl[CTL_TVE + tile] % 65;
        u.pm = tile; u.pn = pn; u.A = H + (size_t)tile * 256 * (EFF * 2); u.gat = nullptr; u.B = WdT + ((size_t)e * D + pn * 256) * (EFF * 2); return true; }
};
__device__ __forceinline__ void b_scatter(int* __restrict__ ctl, const int* __restrict__ tope, const float* __restrict__ topw, unsigned* __restrict__ rowoff, u32x2* __restrict__ rowmeta, int* sl) {
    int* pst = sl;
    int* pc = sl + 512;
    for (int v = tidx(); v < NVE; v += NTHR) pc[v] = (ctl[CTL_CNT + v] + 255) & ~255;
    __syncthreads();
    for (int v = tidx(); v <= NVE; v += NTHR) { int acc = 0; for (int u = 0; u < v; ++u) acc += pc[u]; pst[v] = acc; }
    __syncthreads();
    if (blockIdx.x == 0) {
        for (int v = tidx(); v <= NVE; v += NTHR) ctl[CTL_PST + v] = pst[v];
        if (tidx() <= NQ) ctl[CTL_TQS + tidx()] = pst[tidx() * 65] >> 8;
        for (int v = tidx(); v < NVE; v += NTHR) for (int tl = pst[v] >> 8; tl < (pst[v + 1] >> 8); ++tl) ctl[CTL_TVE + tl] = v;
    }
    for (int idx = blockIdx.x * NTHR + tidx(); idx < M * 9; idx += gridDim.x * NTHR) {
        int m, k, pos; float w;
        if (idx < M * 8) { m = idx >> 3; k = idx & 7; const int ve = (m >> 13) * 65 + tope[idx]; w = topw[idx]; pos = pst[ve] + atomicAdd(ctl + CTL_CUR + ve, 1); }
        else { m = idx - M * 8; k = 8; w = 1.f; pos = pst[(m >> 13) * 65 + 64] + (m & (QT - 1)); }
        rowoff[pos] = (unsigned)m * (D * 2); rowmeta[pos] = (u32x2){(unsigned)((m & (QT - 1)) * 9 + k), __float_as_uint(w)};
    }
    __syncthreads();
}
__device__ __forceinline__ void b_combine(const Params& p, const h16* __restrict__ x2h, const h16* __restrict__ Y, int q) {
    const int lane = tidx() & 63;
    for (int r = blockIdx.x * 8 + (tidx() >> 6); r < QT; r += gridDim.x * 8) {
        const int m = q * QT + r;
        float v[16];
        { const h16x8 a = ((const h16x8*)(x2h + (size_t)m * D))[lane], b = ((const h16x8*)(x2h + (size_t)m * D))[lane + 64];
#pragma unroll
          for (int i = 0; i < 8; ++i) { v[i] = DN_ALPHA * (float)a[i]; v[8 + i] = DN_ALPHA * (float)b[i]; } }
#pragma unroll
        for (int k = 0; k < 9; ++k) { const h16x8* yr = (const h16x8*)(Y + ((size_t)r * 9 + k) * D); const h16x8 a = yr[lane], b = yr[lane + 64];
#pragma unroll
            for (int i = 0; i < 8; ++i) { v[i] += (float)a[i]; v[8 + i] += (float)b[i]; } }
        float s = 0.f;
#pragma unroll
        for (int i = 0; i < 16; ++i) s += v[i];
        const float mean = wave_sum(s) * (1.f / D); float s2 = 0.f;
#pragma unroll
        for (int i = 0; i < 16; ++i) { v[i] -= mean; s2 += v[i] * v[i]; }
        const float rstd = rsqrtf(wave_sum(s2) * (1.f / D) + LN_EPS);
#pragma unroll
        for (int hlf = 0; hlf < 2; ++hlf) { const int c0 = (lane + 64 * hlf) * 8;
            const f32x4 g0 = *(const f32x4*)(p.ln3g + c0), g1 = *(const f32x4*)(p.ln3g + c0 + 4), b0 = *(const f32x4*)(p.ln3b + c0), b1 = *(const f32x4*)(p.ln3b + c0 + 4);
            f32x4 o0, o1;
#pragma unroll
            for (int i = 0; i < 4; ++i) { o0[i] = v[8 * hlf + i] * rstd * g0[i] + b0[i]; o1[i] = v[8 * hlf + 4 + i] * rstd * g1[i] + b1[i]; }
            *(f32x4*)(p.out + (size_t)m * D + c0) = o0; *(f32x4*)(p.out + (size_t)m * D + c0 + 4) = o1; }
    }
}

#define XB_TMO      128
#define XB_XCNT(j)  (256  + 64 * (j))
#define XB_XSUB(j)  (1280 + 64 * (j))
#define XB_XGEN(j)  (2304 + 64 * (j))
#define XB_TOP      3328
#define XB_TOPGEN   3392
#define XCD_BAR_WORDS 3456
#define XB_SPIN_CAP (1u << 22)
__device__ __forceinline__ unsigned xb_ld(unsigned* p)              { return __hip_atomic_load(p, __ATOMIC_RELAXED, __HIP_MEMORY_SCOPE_AGENT); }
__device__ __forceinline__ unsigned xb_add(unsigned* p, unsigned v) { return __hip_atomic_fetch_add(p, v, __ATOMIC_RELAXED, __HIP_MEMORY_SCOPE_AGENT); }
__device__ __forceinline__ unsigned xb_xcc_id() { return (unsigned)__builtin_amdgcn_s_getreg((3 << 11) | 20) & 0xFu; }
#define XB_SPIN(cond, bar) do { unsigned _sp = 0; while (cond) { __builtin_amdgcn_s_sleep(1); \
    if ((++_sp & 255u) == 0u) { if (xb_ld(&(bar)[XB_TMO])) break; if (_sp > XB_SPIN_CAP) { atomicAdd(&(bar)[XB_TMO], 1u); break; } } } } while (0)
struct XcdBarrier { unsigned* bar; unsigned x; volatile LAS unsigned* st; };
__device__ __forceinline__ XcdBarrier xcd_barrier_post(unsigned* bar, volatile LAS unsigned* st) {
    XcdBarrier b; b.bar = bar; b.x = xb_xcc_id(); b.st = st;
    if (threadIdx.x == 0) (void)xb_add(&bar[XB_XCNT(b.x)], 1u);
    return b;
}
__device__ __forceinline__ void xcd_barrier_complete(unsigned* bar, unsigned x, unsigned& nloc, unsigned& nx) {
    const unsigned G = gridDim.x * gridDim.y * gridDim.z;
    unsigned sum, cnt, mine, sp = 0u;
    for (;;) {
        sum = 0u; cnt = 0u; mine = 0u;
#pragma unroll
        for (unsigned j = 0; j < 16; ++j) { const unsigned c = xb_ld(&bar[XB_XCNT(j)]); sum += c; cnt += (c > 0u) ? 1u : 0u; mine = (j == x) ? c : mine; }
        if (sum == G) break;
        __builtin_amdgcn_s_sleep(1);
        if ((++sp & 255u) == 0u) { if (xb_ld(&bar[XB_TMO])) break; if (sp > XB_SPIN_CAP) { atomicAdd(&bar[XB_TMO], 1u); break; } }
    }
    nloc = mine > 0u ? mine : 1u; nx = cnt > 0u ? cnt : 1u;
}
__device__ __forceinline__ void xcd_barrier(const XcdBarrier& b) {
    asm volatile("s_waitcnt vmcnt(0)" ::: "memory");
    __syncthreads();
    if (threadIdx.x == 0) {
        unsigned* bar = b.bar;
        __builtin_amdgcn_s_waitcnt(0);
        unsigned nloc = b.st[0], nx = b.st[1];
        if (nloc == 0u) { xcd_barrier_complete(bar, b.x, nloc, nx); b.st[0] = nloc; b.st[1] = nx; }
        const unsigned old = xb_add(&bar[XB_XSUB(b.x)], 1u);
        const unsigned gen = old / nloc;
        if (old + 1u == (gen + 1u) * nloc) {
            __builtin_amdgcn_fence(__ATOMIC_RELEASE, "agent");
            asm volatile("s_waitcnt vmcnt(0)" ::: "memory");
            const unsigned og = xb_add(&bar[XB_TOP], 1u);
            const unsigned tg = og / nx;
            if (og + 1u == (tg + 1u) * nx) xb_add(&bar[XB_TOPGEN], 1u);
            else XB_SPIN(xb_ld(&bar[XB_TOPGEN]) == tg, bar);
            __builtin_amdgcn_fence(__ATOMIC_ACQUIRE, "agent");
            xb_add(&bar[XB_XGEN(b.x)], 1u);
            asm volatile("s_waitcnt vmcnt(0)" ::: "memory");
        } else {
            XB_SPIN(xb_ld(&bar[XB_XGEN(b.x)]) == gen, bar);
            __builtin_amdgcn_fence(__ATOMIC_ACQUIRE, "agent");
            asm volatile("s_waitcnt vmcnt(0)" ::: "memory");
        }
    }
    __syncthreads();
}

constexpr int N_PHASES = 23;

__global__ void __launch_bounds__(NTHR, 2) mega_fwd(Params p) {
    extern __shared__ __attribute__((aligned(16))) unsigned char lds[];
    cg::grid_group grid = cg::this_grid();
    const int G = (int)gridDim.x, bid = (int)blockIdx.x;
#define tid tidx()
    unsigned char* ws = p.ws;
    h16* WinT = (h16*)(ws + WS_WIN); h16* WoutT = (h16*)(ws + WS_WOUT); h16* WxqT = (h16*)(ws + WS_WXQ); h16* WxoT = (h16*)(ws + WS_WXO); h16* WxkvT = (h16*)(ws + WS_WXKV);
    h16* memh = (h16*)(ws + WS_MEMH); h16* kvm = (h16*)(ws + WS_KVM); h16* kcmp = (h16*)(ws + WS_KCMP); h16* vcmpT = (h16*)(ws + WS_VCMP); h16* vsT = (h16*)(ws + WS_VST); h16* vwT = (h16*)(ws + WS_VWT);
    int* tope = (int*)(ws + WS_TOPE); float* topw = (float*)(ws + WS_TOPW);
    h16* xh = (h16*)(ws + WS_XH); h16* mix = (h16*)(ws + WS_MIX); h16* ox = (h16*)(ws + WS_OX); h16* hb = (h16*)(ws + WS_H); h16* nqr = (h16*)(ws + WS_NQR);
    float* kvb = (float*)(ws + WS_KVB); h16* prevT = (h16*)(ws + WS_PREVT);
    float* cosr = (float*)(ws + WS_COSR); float* sinr = (float*)(ws + WS_SINR); float* cosn = (float*)(ws + WS_COSN); float* sinn = (float*)(ws + WS_SINN); h16* kvmVT = (h16*)(ws + WS_KVMVT); h16* WrTh = (h16*)(ws + WS_WRTH); h16* WrTl = (h16*)(ws + WS_WRTL); h16* Wc1T = (h16*)(ws + WS_WC1T); h16* hid = (h16*)(ws + WS_HID); unsigned* cmpoff = (unsigned*)(ws + WS_CMPOFF); float* peb = (float*)(ws + WS_PEB); h16* ksR = (h16*)(ws + WS_KSR); h16* kwR = (h16*)(ws + WS_KWR); h16* kx = (h16*)(ws + WS_KX);
    h16* rqr = (h16*)((unsigned char*)p.out + DO_RQR); h16* rkr = (h16*)((unsigned char*)p.out + DO_RKR); h16* rkzT = (h16*)((unsigned char*)p.out + DO_RKZT); h16* rvT = (h16*)((unsigned char*)p.out + DO_RVT); float* pre = p.out; float* x1 = (float*)(ws + WS_X1); h16* x1h = (h16*)(ws + WS_X1H);
    h16* qx = (h16*)(ws + WS_QX); float* x2 = (float*)(ws + WS_X2); h16* x2h = (h16*)(ws + WS_X2H);
    int* ctl = (int*)ws; unsigned* rowoff = (unsigned*)(ws + WS_ROWOFF); u32x2* rowmeta = (u32x2*)(ws + WS_ROWMETA);
    h16* WguT = (h16*)(ws + WS_WGUT); h16* WdT = (h16*)(ws + WS_WDT); h16* Hm = (h16*)(ws + WS_HM); h16* Yq = (h16*)(ws + WS_Y);
    float* fl = (float*)lds;
    const int lo = p.ph_lo, hi = p.ph_hi;
#define IN(k) (lo <= (k) && (k) < hi)
    { volatile LAS unsigned* st = (volatile LAS unsigned*)((LAS unsigned char*)lds + 131072); if (threadIdx.x < 2) st[threadIdx.x] = 0u; }
    __syncthreads();
    XcdBarrier xbar = xcd_barrier_post((unsigned*)(ws + WS_BAR), (volatile LAS unsigned*)((LAS unsigned char*)lds + 131072));
#define SEAM(k) do { if (IN(k) && IN((k) + 1)) { if ((k) == 0) grid.sync(); else xcd_barrier(xbar); } } while (0)

    if (IN(0)) REPS(0) {
        { const int sub = tid >> 8, lt = tid & 255; float* tl = fl + sub * 1088;
          constexpr int T0 = (INP / 32) * (D / 32);
          for (int b0 = bid * 2; b0 < T0; b0 += G * 2) b_transpose_tile(p.w_in, D, INC, WinT, INP, b0 + sub, tl, lt); }
        { const int wv = __builtin_amdgcn_readfirstlane(tid >> 6), lane = tid & 63; LAS float* scr = (LAS float*)((LAS unsigned char*)lds + wv * 8704);
          constexpr int I1 = (D / 64) * (D / 32), I4 = (D / 64) * (2 * D / 32), I5 = (2048 / 64) * (256 / 32), IT = 3 * I1 + I4 + 2 * I5;
          for (int it0 = bid * 8 + wv; it0 < IT; it0 += G * 8) { int it = it0;
            if (it < I1) { w_transpose_item(p.w_out, D, D, WoutT, it, scr, lane); continue; } it -= I1;
            if (it < I1) { w_transpose_item(p.w_xq, D, D, WxqT, it, scr, lane); continue; } it -= I1;
            if (it < I1) { w_transpose_item(p.w_xo, D, D, WxoT, it, scr, lane); continue; } it -= I1;
            if (it < I4) { w_transpose_item(p.w_xkv, D, 2 * D, WxkvT, it, scr, lane); continue; } it -= I4;
            if (it < I5) { w_transpose_item(p.w1k, 2048, 256, Wc1T, it, scr, lane); continue; } it -= I5;
            w_transpose_item(p.w1v, 2048, 256, Wc1T + 256 * 2048, it, scr, lane); } }
        __syncthreads();
        b_cvt(p.x, xh, (size_t)M * D / 4);
        b_cvt(p.mem, memh, (size_t)NB * MEML * D / 4);
        if (bid == 0) for (int i = tid; i < 1024; i += NTHR) ctl[i] = 0;
        b_tables(p.positions, cosr, sinr, cosn, sinn, (LAS float*)((LAS unsigned char*)lds));
        for (int idx = bid * NTHR + tid; idx < NE * D; idx += G * NTHR) { const int e = idx >> 10, k = idx & 1023; const float w = p.w_router[k * NE + e]; const h16 hi = (h16)w; WrTh[idx] = hi; WrTl[idx] = (h16)((w - (float)hi) * 2048.f); }
        for (int r = bid * NTHR + tid; r < 4096; r += G * NTHR) { const int g = r & 1, c = min((r >> 1) & 511, 510), b = r >> 10; cmpoff[r] = (unsigned)(((size_t)(b * T + 16 * c) * INP + g * 64) * 2); }
        { const int lane = tid & 63;
          for (int o = bid * 8 + (tid >> 6); o < 512; o += G * 8) { const int kv = o >> 8, j = o & 255; const float* pe = kv ? p.pe_v : p.pe_k; const float* w1 = kv ? p.w1v : p.w1k; float a = 0.f;
              for (int k = lane; k < 2048; k += 64) a += pe[k] * w1[(size_t)k * 256 + j];
              a = wave_sum(a); if (lane == 0) peb[o] = a; } }
    }
    SEAM(0);
    if (IN(1)) {
        REPS(1) { pg8::Gemm g{xh, WinT, M, INP, D}; pg8::StaticOrder S; S.init(g, G, bid); pg8::EpiF16 E{hb, INP};
          pg8::gemm_phase<pg8::EpiF16, pg8::StaticOrder>((PG8_LAS unsigned char*)lds, g.K, S, E); }
    }
    SEAM(1);
    if (IN(2)) REPS(2) {
        if (bid < 32) { CmpSched S{(const char*)hb, cmpoff, (const char*)Wc1T, bid}; pg8::EpiCmp1 E{hid, peb + (bid >> 4) * 256};
            pg8::gemm_phase<pg8::EpiCmp1, CmpSched>((PG8_LAS unsigned char*)lds, 2048, S, E, (size_t)INP * 2);
            pg8::Gemm g{memh, WxkvT, NB * MEML, 2 * D, D}; pg8::StaticOrder S2; S2.init(g, 32, bid); pg8::EpiF16 E2{kvm, 2 * D};
            pg8::gemm_phase<pg8::EpiF16, pg8::StaticOrder>((PG8_LAS unsigned char*)lds, g.K, S2, E2); }
        else { const int sub = tid >> 8, lt = tid & 255; const int b2 = bid - 32, G2 = G - 32;
        { const int wv = __builtin_amdgcn_readfirstlane(tid >> 6), lane = tid & 63; LAS h16* wsl = (LAS h16*)((LAS unsigned char*)lds + wv * 8704);
          for (int m0 = (b2 * 8 + wv) * 2; m0 < M; m0 += G2 * 16) { w_rope(hb, rqr, rkr, nqr, ksR, kwR, cosr, sinr, cosn, sinn, m0, lane); w_rope(hb, rqr, rkr, nqr, ksR, kwR, cosr, sinr, cosn, sinn, m0 + 1, lane); }
          for (int it = b2 * 8 + wv; it < 2 * NB * 2 * 128; it += G2 * 8) b_vtrans(hb, vsT, vwT, it, wsl, lane);
          for (int it = b2 * 8 + wv; it < NB * 4 * 256; it += G2 * 8) b_rtrans(p, hb, rvT, rkzT, cosr, sinr, it, wsl, lane); }
        } }
    SEAM(2);
    if (IN(3)) {
        REPS(30) b_cmp2(p, hid, kcmp, vcmpT);
        { const int sub = tid >> 8, lt = tid & 255;
          for (int b0 = bid * 2; b0 < NB * 4 * 16; b0 += G * 2) b_mvtrans(kvm, kvmVT, kx, b0 + sub, (h16*)(fl + sub * 2304), lt); }
        const int wv = __builtin_amdgcn_readfirstlane(tid >> 6), lane = tid & 63;
        REPS(31) for (int ch = bid; ch < NB * 4 * 64; ch += G) ret_kv_unit(rkzT, rvT, kvb, ch, wv, lane); }
    SEAM(3);
    if (IN(4)) {
        REPS(4) b_ret_scan(p, kvb, prevT);
        const int wv = __builtin_amdgcn_readfirstlane(tid >> 6), lane = tid & 63;
        __syncthreads();
        REPS(50) { const int bg = bid & 7;
            for (int k = bid >> 3; k < T / 32; k += (G >> 3)) nsa_block_unit(hb, nqr, kcmp, vcmpT, vsT, vwT, ksR, kwR, mix, bg >> 1, bg & 1, (T / 32 - 1 - k) * 32, (LAS unsigned char*)lds, wv, lane); }
    }
    SEAM(4);
    if (IN(5)) {
        const int wv = __builtin_amdgcn_readfirstlane(tid >> 6), lane = tid & 63;
        REPS(51) for (int ch = bid; ch < NB * 4 * 64; ch += G) ret_out_unit(p, hb, rqr, rkr, rvT, prevT, mix, ch, wv, lane);
    }
    SEAM(5);
    if (IN(6)) { pg8::Gemm g{mix, WoutT, M, D, D}; pg8::StaticOrder S; S.init(g, G, bid); pg8::EpiResF32 E{pre, p.x, D, DN_ALPHA};
        pg8::gemm_phase<pg8::EpiResF32, pg8::StaticOrder>((PG8_LAS unsigned char*)lds, g.K, S, E); }
    SEAM(6);
    if (PROBE_DBL == 900) { for (int k = 0; k < 20; ++k) xcd_barrier(xbar); }
    if (IN(7)) REPS(7) b_ln(pre, p.ln1g, p.ln1b, x1, x1h);
    SEAM(7);
    if (IN(8)) { pg8::Gemm g{x1h, WxqT, M, D, D}; pg8::StaticOrder S; S.init(g, G, bid); pg8::EpiF16 E{qx, D};
        pg8::gemm_phase<pg8::EpiF16, pg8::StaticOrder>((PG8_LAS unsigned char*)lds, g.K, S, E); }
    SEAM(8);
    if (IN(9)) { const int wv = __builtin_amdgcn_readfirstlane(tid >> 6), lane = tid & 63;
        REPS(9) xattn_block(qx, kx, kvmVT, ox, G, bid, (LAS unsigned char*)lds, wv, lane); }
    SEAM(9);
    if (IN(10)) { pg8::Gemm g{ox, WxoT, M, D, D}; pg8::StaticOrder S; S.init(g, G, bid); pg8::EpiResF32 E{pre, x1, D, DN_ALPHA};
        pg8::gemm_phase<pg8::EpiResF32, pg8::StaticOrder>((PG8_LAS unsigned char*)lds, g.K, S, E); }
    if (IN(10) && IN(12)) xcd_barrier(xbar);
    if (IN(12)) {
        { const int wv = __builtin_amdgcn_readfirstlane(tid >> 6), lane = tid & 63; LAS float* lg = (LAS float*)((LAS unsigned char*)lds + wv * 4096);
          for (int u = bid * 8 + wv; u < M / 16; u += G * 8) router_unit(p, pre, x2h, WrTh, WrTl, tope, topw, ctl + CTL_CNT, u * 16, lg, lane); }
        __syncthreads();
        if (bid == 0 && tid < NQ) ctl[CTL_CNT + tid * 65 + 64] = QT;
        for (int i = bid * NTHR + tid; i < CAP; i += G * NTHR) { rowoff[i] = 0u; rowmeta[i] = (u32x2){0xffffffffu, 0u}; }
        { const int wv = __builtin_amdgcn_readfirstlane(tid >> 6), lane = tid & 63; LAS float* scr = (LAS float*)((LAS unsigned char*)lds + wv * 8704);
          REPS(121) for (int it = bid * 8 + wv; it < 65 * 384; it += G * 8) { const int e = it / 384, r = it % 384;
            const float* wg = e < 64 ? p.w_gate + (size_t)e * D * EFF : p.ws_gate; const float* wu = e < 64 ? p.w_up + (size_t)e * D * EFF : p.ws_up; const float* wd = e < 64 ? p.w_down + (size_t)e * EFF * D : p.ws_down;
            if (r < 128) w_transpose_item(wg, D, EFF, WguT + (size_t)e * 512 * D, r, scr, lane, 2, 0);
            else if (r < 256) w_transpose_item(wu, D, EFF, WguT + (size_t)e * 512 * D, r - 128, scr, lane, 2, 1);
            else w_transpose_item(wd, EFF, D, WdT + (size_t)e * D * EFF, r - 256, scr, lane); } }
    }
    SEAM(12);
    if (IN(13)) b_scatter(ctl, tope, topw, rowoff, rowmeta, (int*)lds);
    SEAM(13);
    if (IN(14)) REPS(14) { G1Sched S{ctl, (const char*)x2h, rowoff, (const char*)WguT, G, bid}; pg8::EpiGateUp E{Hm};
        pg8::gemm_phase<pg8::EpiGateUp, G1Sched>((PG8_LAS unsigned char*)lds, D, S, E); }
    SEAM(14);
#pragma unroll 1
    for (int q = 0; q < NQ; ++q) {
        if (IN(15 + 2 * q)) REPS(15) { G2Sched S{ctl, (const char*)Hm, (const char*)WdT, q, G, bid}; pg8::EpiDown E{Yq, rowmeta};
            pg8::gemm_phase<pg8::EpiDown, G2Sched>((PG8_LAS unsigned char*)lds, EFF, S, E); }
        SEAM(15 + 2 * q);
        if (IN(16 + 2 * q)) REPS(16) b_combine(p, x2h, Yq, q);
        if (q < NQ - 1) SEAM(16 + 2 * q);
    }
#undef IN
#undef SEAM
#undef tid
}

#ifndef MK_PER_PHASE
#define MK_PER_PHASE 0
#endif
extern "C" void kernel_launch(void* const* d_in, const int* in_sizes, int n_in, void* d_out, int out_size, void* d_ws, size_t ws_size, hipStream_t stream) {
    static int grid = 0;
    if (grid == 0) {
        if (n_in != 28 || in_sizes[0] != M * D || out_size != M * D || ws_size < WS_NEED) { fprintf(stderr, "kernel_launch: unexpected shapes (n_in %d, in0 %d, out %d, ws %zu)\n", n_in, n_in > 0 ? in_sizes[0] : -1, out_size, ws_size); grid = -1; return; }
        if (hipFuncSetAttribute((const void*)mega_fwd, hipFuncAttributeMaxDynamicSharedMemorySize, LDS_BYTES) != hipSuccess) { fprintf(stderr, "kernel_launch: hipFuncSetAttribute failed\n"); grid = -1; return; }
        int dev = 0, cus = 0, per_cu = 0;
        hipGetDevice(&dev); hipDeviceGetAttribute(&cus, hipDeviceAttributeMultiprocessorCount, dev);
        if (hipOccupancyMaxActiveBlocksPerMultiprocessor(&per_cu, (const void*)mega_fwd, NTHR, LDS_BYTES) != hipSuccess || per_cu < 1) { fprintf(stderr, "kernel_launch: occupancy query failed (%d)\n", per_cu); grid = -1; return; }
        grid = cus;
    }
    if (grid < 0) return;
    Params p{};
    p.x = (const float*)d_in[0]; p.mem = (const float*)d_in[1]; p.positions = (const int*)d_in[2];
    p.w_in = (const float*)d_in[3]; p.pe_k = (const float*)d_in[4]; p.pe_v = (const float*)d_in[5];
    p.w1k = (const float*)d_in[6]; p.w2k = (const float*)d_in[7]; p.w1v = (const float*)d_in[8]; p.w2v = (const float*)d_in[9];
    p.w_out = (const float*)d_in[10]; p.ln1g = (const float*)d_in[11]; p.ln1b = (const float*)d_in[12];
    p.w_xq = (const float*)d_in[13]; p.w_xkv = (const float*)d_in[14]; p.w_xo = (const float*)d_in[15];
    p.ln2g = (const float*)d_in[16]; p.ln2b = (const float*)d_in[17]; p.w_router = (const float*)d_in[18]; p.rbias = (const float*)d_in[19];
    p.w_gate = (const float*)d_in[20]; p.w_up = (const float*)d_in[21]; p.w_down = (const float*)d_in[22];
    p.ws_gate = (const float*)d_in[23]; p.ws_up = (const float*)d_in[24]; p.ws_down = (const float*)d_in[25];
    p.ln3g = (const float*)d_in[26]; p.ln3b = (const float*)d_in[27];
    p.out = (float*)d_out; p.ws = (unsigned char*)d_ws;
    for (int i = 0; i < 4; ++i) p.lg[i] = (float)std::log(1.0 - std::pow(2.0, -5.0 - (double)i));
#if MK_PER_PHASE
    for (int ph = 0; ph < N_PHASES; ++ph) { p.ph_lo = ph; p.ph_hi = ph + 1; hipLaunchKernelGGL(mega_fwd, dim3(grid), dim3(NTHR), LDS_BYTES, stream, p); }
#else
    p.ph_lo = 0; p.ph_hi = N_PHASES;
    if (hipMemsetAsync((char*)d_ws + WS_BAR, 0, XCD_BAR_WORDS * 4, stream) != hipSuccess) { fprintf(stderr, "kernel_launch: memset failed\n"); return; }
    void* args[] = {&p};
    hipError_t e = hipLaunchCooperativeKernel((const void*)mega_fwd, dim3(grid), dim3(NTHR), args, LDS_BYTES, stream);
    if (e != hipSuccess) fprintf(stderr, "kernel_launch: cooperative launch failed: %s (grid %d)\n", hipGetErrorString(e), grid);
#endif
}
```

```cpp
#include <hip/hip_runtime.h>
#include <cstdio>
#include <cstdint>
#include <cmath>

typedef _Float16 h16;
typedef _Float16 h16x8 __attribute__((ext_vector_type(8)));
typedef _Float16 h16x2 __attribute__((ext_vector_type(2)));
typedef _Float16 h16x4 __attribute__((ext_vector_type(4)));
typedef float f32x2 __attribute__((ext_vector_type(2)));
typedef float f32x4 __attribute__((ext_vector_type(4)));
typedef unsigned u32x4 __attribute__((ext_vector_type(4)));
typedef unsigned u32x2 __attribute__((ext_vector_type(2)));

__device__ __forceinline__ int tidx() { int t = (int)threadIdx.x; asm volatile("" : "+v"(t)); return t; }

#ifndef PROBE_DBL
#define PROBE_DBL -1
#endif
#define REPS(k) for (int _rep = 0; _rep < ((PROBE_DBL) == (k) ? 2 : 1); ++_rep)

constexpr int NB = 4, T = 8192, D = 1024, M = NB * T;
constexpr int INC = 3352, INP = 3584;
constexpr int C_RQ = 0, C_RK = 512, C_RV = 1024, C_RG = 1536, C_NQ = 2048, C_NKC = 2560, C_NVC = 2688, C_NKS = 2816, C_NVS = 2944, C_NKW = 3072, C_NVW = 3200, C_NG = 3328;
constexpr int MEML = 256;
constexpr int NE = 64, EFF = 256;
constexpr float LN_EPS = 1e-5f;
constexpr float DN_ALPHA = 1.189207115002721f;
constexpr float NEGF = -1e30f;

constexpr size_t MiB = 1u << 20;
constexpr size_t WS_WIN = 1 * MiB, WS_WOUT = 8 * MiB, WS_WXQ = 10 * MiB, WS_WXO = 12 * MiB, WS_WXKV = 14 * MiB, WS_MEMH = 18 * MiB, WS_KVM = 20 * MiB;
constexpr size_t WS_KCMP = 24 * MiB, WS_VCMP = 25 * MiB, WS_TOPE = 26 * MiB, WS_TOPW = 27 * MiB;
constexpr size_t WS_XH = 32 * MiB, WS_MIX = 32 * MiB, WS_OX = 32 * MiB;
constexpr size_t WS_H = 96 * MiB, WS_NQR = 320 * MiB, WS_KVB = 352 * MiB, WS_PREV = 416 * MiB;
constexpr size_t WS_PRE = 96 * MiB, WS_X1 = 224 * MiB, WS_X1H = 352 * MiB, WS_QX = 416 * MiB, WS_X2 = 130 * MiB;
constexpr size_t WS_X2H = 32 * MiB, WS_WDT = 96 * MiB, WS_HM = 130 * MiB, WS_WGUT = 306 * MiB, WS_Y = 306 * MiB;
constexpr size_t WS_ROWOFF = 1 * MiB, WS_ROWMETA = 3 * MiB;
constexpr size_t WS_VST = 480 * MiB, WS_VWT = 488 * MiB, WS_COSR = 496 * MiB, WS_SINR = 504 * MiB, WS_COSN = 28 * MiB, WS_SINN = 29 * MiB, WS_KVMVT = 30 * MiB;
constexpr size_t WS_WRTH = 262144, WS_WRTL = 393216;
constexpr size_t WS_WC1T = 464 * MiB, WS_HID = 466 * MiB, WS_CMPOFF = 131072, WS_PEB = 131072 + 16384;
constexpr size_t WS_PREVT = 416 * MiB, WS_KSR = 448 * MiB, WS_KWR = 456 * MiB, WS_KX = 26 * MiB;
constexpr size_t DO_RQR = 0, DO_RKR = 32 * MiB, DO_RKZT = 64 * MiB, DO_RVT = 96 * MiB;
constexpr size_t WS_NEED = 512 * MiB;
constexpr int NQ = 4, QT = M / NQ, NVE = NQ * 65, CAP_TILES = 1412, CAP = CAP_TILES * 256;
constexpr size_t WS_BAR = 65536;
constexpr int CTL_CNT = 0, CTL_CUR = 512, CTL_PST = 1024, CTL_TQS = 1536, CTL_TVE = 2048;

namespace pg8 {
#define PG8_LAS __attribute__((address_space(3)))
typedef short s16x8 __attribute__((ext_vector_type(8)));
constexpr int BM = 256, BK = 64, HALF = 128, HTB = HALF * BK * 2, STAGE_BYTES = 8 * HTB, NXCD = 8, WGM = 8;
__host__ __device__ __forceinline__ int lds_byte(int r, int c) { const int st = (r >> 4) * 2 + (c >> 5), rr = r & 15, cc = c & 31, ob = rr * 64 + cc * 2; return st * 1024 + (ob ^ (((ob >> 9) & 1) << 5)); }
__host__ __device__ __forceinline__ void stage_rc(int b, int& R, int& C) { const int st = b / 1024, sb = b % 1024, swz = sb ^ (((sb >> 9) & 1) << 5); R = (st >> 1) * 16 + swz / 64; C = (st & 1) * 32 + (swz % 64) / 2; }
__host__ __device__ __forceinline__ int perm32(int rho) { const int n = rho >> 4, i = rho & 15; return 8 * (i >> 2) + 4 * n + (i & 3); }
struct Unit { int pm, pn; const char* A; const char* B; const unsigned* gat; };
struct Gemm { const h16* A; const h16* Bt; int M, N, K; };
struct StaticOrder {
    int nM, nN, nwg, G, c; const char* A; const char* B; size_t tstep;
    __device__ void init(const Gemm& g, int G_, int c_) { nM = g.M / BM; nN = g.N / BM; nwg = nM * nN; G = G_; c = c_; A = (const char*)g.A; B = (const char*)g.Bt; tstep = (size_t)BM * g.K * 2; }
    __device__ bool next(int i, Unit& u) const {
        const long L = (long)i * G + c; if (L >= nwg) return false;
        int wgid = (int)L; { const int q = nwg / NXCD, r = nwg % NXCD, xcd = wgid % NXCD, off = wgid / NXCD; wgid = (xcd < r ? xcd * (q + 1) : r * (q + 1) + (xcd - r) * q) + off; }
        const int nig = WGM * nN, gid = wgid / nig, fm = gid * WGM, gsz = (nM - fm) < WGM ? (nM - fm) : WGM;
        u.pm = fm + ((wgid % nig) % gsz); u.pn = (wgid % nig) / gsz; u.A = A + (size_t)u.pm * tstep; u.B = B + (size_t)u.pn * tstep; u.gat = nullptr; return true;
    }
};
__device__ __forceinline__ unsigned cvt_pk_f16(float lo, float hi) { f32x2 v = {lo, hi}; h16x2 h = __builtin_convertvector(v, h16x2); return __builtin_bit_cast(unsigned, h); }

struct EpiF16 {
    static constexpr bool PERM = true;
    h16* O; int ldc;
    __device__ __forceinline__ void operator()(const f32x4 (&acc)[2][2][4][2], const Unit& u, int wr, int wc, int fr, int fq) const {
        const int row0 = u.pm * BM + wr * 64 + fr; const int col0 = u.pn * BM + wc * 32 + 8 * fq;
#pragma unroll
        for (int ai = 0; ai < 2; ++ai)
#pragma unroll
            for (int m = 0; m < 4; ++m) { h16* rowp = O + (size_t)(row0 + ai * HALF + m * 16) * ldc + col0;
#pragma unroll
                for (int bj = 0; bj < 2; ++bj) { const f32x4 v0 = acc[ai][bj][m][0], v1 = acc[ai][bj][m][1];
                    *(h16x8*)(rowp + bj * HALF) = __builtin_convertvector(__builtin_shufflevector(v0, v1, 0, 1, 2, 3, 4, 5, 6, 7), h16x8); } }
    }
};
struct EpiResF32 {
    static constexpr bool PERM = false;
    float* C; const float* R; int ldc; float alpha;
    __device__ __forceinline__ void operator()(const f32x4 (&acc)[2][2][4][2], const Unit& u, int wr, int wc, int fr, int fq) const {
        const int row0 = u.pm * BM + wr * 64 + fr, col0 = u.pn * BM + wc * 32 + 4 * fq;
#pragma unroll
        for (int ai = 0; ai < 2; ++ai)
#pragma unroll
            for (int m = 0; m < 4; ++m) { const size_t off = (size_t)(row0 + ai * HALF + m * 16) * ldc + col0;
#pragma unroll
                for (int bj = 0; bj < 2; ++bj)
#pragma unroll
                    for (int n = 0; n < 2; ++n) { const f32x4 r = *(const f32x4*)(R + off + bj * HALF + n * 16); *(f32x4*)(C + off + bj * HALF + n * 16) = r * alpha + acc[ai][bj][m][n]; } }
    }
};
struct EpiCmp1 {
    static constexpr bool PERM = true;
    h16* O; const float* peb;
    __device__ __forceinline__ void operator()(const f32x4 (&acc)[2][2][4][2], const Unit& u, int wr, int wc, int fr, int fq) const {
        const int row0 = u.pm * BM + wr * 64 + fr; const int col0 = wc * 32 + 8 * fq;
#pragma unroll
        for (int bj = 0; bj < 2; ++bj) { const f32x4 b0 = *(const f32x4*)(peb + col0 + bj * HALF), b1 = *(const f32x4*)(peb + col0 + bj * HALF + 4);
#pragma unroll
            for (int ai = 0; ai < 2; ++ai)
#pragma unroll
                for (int m = 0; m < 4; ++m) { f32x4 v0 = acc[ai][bj][m][0] + b0, v1 = acc[ai][bj][m][1] + b1;
#pragma unroll
                    for (int r = 0; r < 4; ++r) { v0[r] = v0[r] / (1.f + __expf(-v0[r])); v1[r] = v1[r] / (1.f + __expf(-v1[r])); }
                    *(h16x8*)(O + (size_t)(row0 + ai * HALF + m * 16) * 256 + col0 + bj * HALF) = __builtin_convertvector(__builtin_shufflevector(v0, v1, 0, 1, 2, 3, 4, 5, 6, 7), h16x8); } }
    }
};
struct EpiGateUp {
    static constexpr bool PERM = true;
    h16* H;
    __device__ __forceinline__ void operator()(const f32x4 (&acc)[2][2][4][2], const Unit& u, int wr, int wc, int fr, int fq) const {
        const int row0 = u.pm * BM + wr * 64 + fr; const int col0 = u.pn * 128 + wc * 16 + 4 * fq;
#pragma unroll
        for (int ai = 0; ai < 2; ++ai)
#pragma unroll
            for (int m = 0; m < 4; ++m) { h16* rowp = H + (size_t)(row0 + ai * HALF + m * 16) * 256 + col0;
#pragma unroll
                for (int bj = 0; bj < 2; ++bj) { const f32x4 v0 = acc[ai][bj][m][0], v1 = acc[ai][bj][m][1];
                    const float h0 = v0[0] / (1.f + __expf(-v0[0])) * v0[1], h1 = v0[2] / (1.f + __expf(-v0[2])) * v0[3];
                    const float h2 = v1[0] / (1.f + __expf(-v1[0])) * v1[1], h3 = v1[2] / (1.f + __expf(-v1[2])) * v1[3];
                    *(h16x4*)(rowp + bj * 64) = __builtin_convertvector((f32x4){h0, h1, h2, h3}, h16x4); } }
    }
};
struct EpiDown {
    static constexpr bool PERM = true;
    h16* Y; const u32x2* rowmeta;
    __device__ __forceinline__ void operator()(const f32x4 (&acc)[2][2][4][2], const Unit& u, int wr, int wc, int fr, int fq) const {
        const int row0 = u.pm * BM + wr * 64 + fr; const int col0 = u.pn * BM + wc * 32 + 8 * fq;
#pragma unroll
        for (int ai = 0; ai < 2; ++ai)
#pragma unroll
            for (int m = 0; m < 4; ++m) { const u32x2 md = rowmeta[row0 + ai * HALF + m * 16]; const int slot = (int)md.x; const float w8 = __uint_as_float(md.y);
                if (slot >= 0) { h16* rowp = Y + (size_t)slot * 1024 + col0;
#pragma unroll
                    for (int bj = 0; bj < 2; ++bj) { const f32x4 v0 = acc[ai][bj][m][0] * w8, v1 = acc[ai][bj][m][1] * w8;
                        *(h16x8*)(rowp + bj * HALF) = __builtin_convertvector(__builtin_shufflevector(v0, v1, 0, 1, 2, 3, 4, 5, 6, 7), h16x8); } }
                asm volatile("" ::: "memory"); }
    }
};

template <class Epi, class Sched>
__device__ __forceinline__ void gemm_phase(PG8_LAS unsigned char* lds, const int K, const Sched& S, const Epi& E, const size_t kstepA = (size_t)(BK * 2)) {
    const int tid = tidx(), wid = __builtin_amdgcn_readfirstlane(tid >> 6), lane = tid & 63, wr = wid >> 2, wc = wid & 3, fr = lane & 15, fq = lane >> 4;
    const int nt = K / BK;
    int R0, C0; stage_rc(tid * 16, R0, C0);
    const unsigned cb2 = (unsigned)C0 * 2u;
    unsigned voffB[2];
#pragma unroll
    for (int i = 0; i < 2; ++i) { const int R = R0 + 64 * i; const int Rb = Epi::PERM ? ((R & ~31) + perm32(R & 31)) : R; voffB[i] = (unsigned)(Rb * K) * 2u + cb2; }
    const size_t kstep = (size_t)(BK * 2);
    const size_t hstep = (size_t)HALF * K * 2;
    const unsigned ldsw = (unsigned)wid * 1024u;
    const int aoff = lds_byte(wr * 64 + fr, fq * 8), boff = lds_byte(wc * 32 + fr, fq * 8);
#define PG8_MKVA(u, va) do { _Pragma("unroll") for (int _h = 0; _h < 2; ++_h) _Pragma("unroll") for (int _i = 0; _i < 2; ++_i) { const int _r = _h * HALF + R0 + 64 * _i; \
        (va)[_h][_i] = ((u).gat ? (u).gat[_r] : (unsigned)(_r * K) * 2u) + cb2; } } while (0)
#define PG8_SA(b, h) (((b) * 2 + (h)) * HTB)
#define PG8_SB(b, h) ((4 + (b) * 2 + (h)) * HTB)
#define PG8_STAGE(bufoff, gbase, voff) do { _Pragma("unroll") for (int _i = 0; _i < 2; ++_i) \
        __builtin_amdgcn_global_load_lds((const unsigned*)((const char*)(gbase) + (voff)[_i]), (PG8_LAS unsigned*)(lds + (bufoff) + ldsw + _i * 8192), 16, 0, 0); } while (0)
#define PG8_LDA(dst, b, h) do { _Pragma("unroll") for (int m = 0; m < 4; ++m) _Pragma("unroll") for (int k = 0; k < 2; ++k) dst[m][k] = *(const PG8_LAS s16x8*)(lds + PG8_SA(b, h) + aoff + m * 2048 + k * 1024); } while (0)
#define PG8_LDB(dst, b, h) do { _Pragma("unroll") for (int n = 0; n < 2; ++n) _Pragma("unroll") for (int k = 0; k < 2; ++k) dst[n][k] = *(const PG8_LAS s16x8*)(lds + PG8_SB(b, h) + boff + n * 2048 + k * 1024); } while (0)
#define PG8_MMA(ai, bj, At, Bt) do { __builtin_amdgcn_s_setprio(1); _Pragma("unroll") for (int m = 0; m < 4; ++m) _Pragma("unroll") for (int n = 0; n < 2; ++n) _Pragma("unroll") for (int k = 0; k < 2; ++k) \
        acc[ai][bj][m][n] = __builtin_amdgcn_mfma_f32_16x16x32_f16(__builtin_bit_cast(h16x8, Bt[n][k]), __builtin_bit_cast(h16x8, At[m][k]), acc[ai][bj][m][n], 0, 0, 0); __builtin_amdgcn_s_setprio(0); } while (0)
#define PG8_WAIT_V(n) asm volatile("s_waitcnt vmcnt(" #n ")" ::: "memory")
#define PG8_WAIT_L(n) asm volatile("s_waitcnt lgkmcnt(" #n ")" ::: "memory")
#define PG8_BAR __builtin_amdgcn_s_barrier()
#define PG8_SCHED __builtin_amdgcn_sched_barrier(0)
    Unit cur, nxt; int ui = 0;
    if (!S.next(0, cur)) return;
    unsigned va[2][2];
    PG8_MKVA(cur, va);
    f32x4 acc[2][2][4][2];
#pragma unroll
    for (int a = 0; a < 2; ++a)
#pragma unroll
        for (int b = 0; b < 2; ++b)
#pragma unroll
            for (int m = 0; m < 4; ++m)
#pragma unroll
                for (int n = 0; n < 2; ++n) acc[a][b][m][n] = (f32x4){0.f, 0.f, 0.f, 0.f};
    s16x8 At[4][2], B0[2][2], B1[2][2];
    const char* cA = cur.A; const char* cB = cur.B;
    {
        PG8_STAGE(PG8_SB(0, 0), cB, voffB); PG8_STAGE(PG8_SB(0, 1), cB + hstep, voffB); PG8_STAGE(PG8_SA(0, 0), cA, va[0]); PG8_STAGE(PG8_SA(0, 1), cA, va[1]);
        if (wr == 1) PG8_BAR;
        PG8_WAIT_V(2); PG8_BAR;
        PG8_STAGE(PG8_SB(1, 0), cB + kstep, voffB); PG8_STAGE(PG8_SA(1, 0), cA + kstepA, va[0]); PG8_STAGE(PG8_SB(1, 1), cB + hstep + kstep, voffB);
        PG8_WAIT_V(6); PG8_BAR;
    }
    for (;;) {
        const bool has_next = S.next(ui + 1, nxt);
        const char* nA = has_next ? nxt.A : cA; const char* nB = has_next ? nxt.B : cB;
#pragma unroll 1
        for (int t = 0; t < nt; t += 2) {
            const bool last = (t == nt - 2);
            const char* a1 = cA + (size_t)(t + 1) * kstepA;
            const char* a2 = last ? nA : cA + (size_t)(t + 2) * kstepA; const char* b2 = last ? nB : cB + (size_t)(t + 2) * kstep;
            const char* a3 = a2 + kstepA; const char* b3 = b2 + kstep;
            PG8_LDB(B0, 0, 0); PG8_LDB(B1, 0, 1); PG8_SCHED; PG8_LDA(At, 0, 0); PG8_STAGE(PG8_SA(1, 1), a1, va[1]);
            if (last && has_next) { PG8_MKVA(nxt, va); }
            PG8_WAIT_V(8); PG8_WAIT_L(0); PG8_BAR; PG8_MMA(0, 0, At, B0); PG8_MMA(0, 1, At, B1); PG8_BAR; PG8_SCHED;
            PG8_LDA(At, 0, 1); PG8_STAGE(PG8_SB(0, 0), b2, voffB); PG8_STAGE(PG8_SB(0, 1), b2 + hstep, voffB); PG8_STAGE(PG8_SA(0, 0), a2, va[0]);
            PG8_WAIT_V(8); PG8_WAIT_L(0); PG8_BAR; PG8_MMA(1, 0, At, B0); PG8_MMA(1, 1, At, B1); PG8_BAR; PG8_SCHED;
            PG8_LDB(B0, 1, 0); PG8_LDB(B1, 1, 1); PG8_SCHED; PG8_LDA(At, 1, 0); PG8_STAGE(PG8_SA(0, 1), a2, va[1]);
            PG8_WAIT_V(8); PG8_WAIT_L(0); PG8_BAR; PG8_MMA(0, 0, At, B0); PG8_MMA(0, 1, At, B1); PG8_BAR; PG8_SCHED;
            PG8_LDA(At, 1, 1); PG8_STAGE(PG8_SB(1, 0), b3, voffB); PG8_STAGE(PG8_SB(1, 1), b3 + hstep, voffB); PG8_STAGE(PG8_SA(1, 0), a3, va[0]);
            PG8_WAIT_V(8); PG8_WAIT_L(0); PG8_BAR; PG8_MMA(1, 0, At, B0); PG8_MMA(1, 1, At, B1); PG8_BAR; PG8_SCHED;
        }
        if (wr == 0) PG8_BAR;
        E(acc, cur, wr, wc, fr, fq);
        if (!has_next) break;
#pragma unroll
        for (int a = 0; a < 2; ++a)
#pragma unroll
            for (int b = 0; b < 2; ++b)
#pragma unroll
                for (int m = 0; m < 4; ++m)
#pragma unroll
                    for (int n = 0; n < 2; ++n) acc[a][b][m][n] = (f32x4){0.f, 0.f, 0.f, 0.f};
        cur = nxt; cA = nA; cB = nB; ++ui;
        if (wr == 1) PG8_BAR;
    }
    PG8_WAIT_V(0);
    PG8_BAR;
#undef PG8_MKVA
#undef PG8_SA
#undef PG8_SB
#undef PG8_STAGE
#undef PG8_LDA
#undef PG8_LDB
#undef PG8_MMA
#undef PG8_WAIT_V
#undef PG8_WAIT_L
#undef PG8_BAR
#undef PG8_SCHED
}
}


#include <hip/hip_cooperative_groups.h>
namespace cg = cooperative_groups;
constexpr int NTHR = 512;
constexpr int LDS_BYTES = 147456;
#define LAS __attribute__((address_space(3)))

struct Params {
    const float *x, *mem; const int* positions;
    const float *w_in, *pe_k, *pe_v, *w1k, *w2k, *w1v, *w2v, *w_out, *ln1g, *ln1b, *w_xq, *w_xkv, *w_xo, *ln2g, *ln2b, *w_router, *rbias, *w_gate, *w_up, *w_down, *ws_gate, *ws_up, *ws_down, *ln3g, *ln3b;
    float* out; unsigned char* ws;
    float lg[4];
    int ph_lo, ph_hi;
};

__device__ __forceinline__ float wave_sum(float v) {
#pragma unroll
    for (int o = 1; o < 64; o <<= 1) v += __shfl_xor(v, o);
    return v;
}
__device__ __forceinline__ float wave_max(float v) {
#pragma unroll
    for (int o = 1; o < 64; o <<= 1) v = fmaxf(v, __shfl_xor(v, o));
    return v;
}
__device__ __forceinline__ float siluf(float v) { return v / (1.f + __expf(-v)); }
__device__ __forceinline__ float sigmf(float v) { return 1.f / (1.f + __expf(-v)); }

__device__ __forceinline__ void b_transpose_tile(const float* __restrict__ W, int K, int N, h16* __restrict__ WT, int Npad, int tile, float* tl, int lt, int rs = 1, int ro = 0) {
    const int ntn = Npad / 32; const int n0 = (tile % ntn) * 32, k0 = (tile / ntn) * 32, tx = lt & 31, ty = lt >> 5;
    for (int i = ty; i < 32; i += 8) { const int k = k0 + i, n = n0 + tx; tl[i * 33 + tx] = (n < N) ? W[(size_t)k * N + n] : 0.f; }
    __syncthreads();
    for (int i = ty; i < 32; i += 8) { const int n = n0 + i, k = k0 + tx; WT[(size_t)(n * rs + ro) * K + k] = (h16)tl[tx * 33 + i]; }
    __syncthreads();
}
__device__ __forceinline__ void w_transpose_item(const float* __restrict__ W, int K, int N, h16* __restrict__ WT, int item, LAS float* scr, int lane, int rs = 1, int ro = 0) {
    const int nblk = N / 32, kb = item / nblk, nb = item % nblk, k0 = 64 * kb, n0 = 32 * nb;
#pragma unroll 8
    for (int i = 0; i < 32; ++i) { const int kk = 2 * i + (lane >> 5); scr[kk * 33 + (lane & 31)] = W[(size_t)(k0 + kk) * N + n0 + (lane & 31)]; }
    asm volatile("s_waitcnt lgkmcnt(0)" ::: "memory");
    const int c = lane & 7;
#pragma unroll
    for (int j = 0; j < 4; ++j) { const int n = (lane >> 3) + 8 * j; LAS const float* s = scr + (8 * c) * 33 + n; h16x8 o;
#pragma unroll
        for (int x = 0; x < 8; ++x) o[x] = (h16)s[x * 33];
        *(h16x8*)(WT + (size_t)((n0 + n) * rs + ro) * K + k0 + 8 * c) = o; }
    asm volatile("s_waitcnt lgkmcnt(0)" ::: "memory");
}
__device__ __forceinline__ void b_cvt(const float* __restrict__ x, h16* __restrict__ o, size_t n4) {
    for (size_t i = (size_t)blockIdx.x * NTHR + tidx(); i < n4; i += (size_t)gridDim.x * NTHR) {
        const f32x4 v = ((const f32x4*)x)[i]; ((h16x4*)o)[i] = __builtin_convertvector(v, h16x4); }
}

__device__ __forceinline__ void b_tables(const int* __restrict__ positions, float* __restrict__ cosr, float* __restrict__ sinr, float* __restrict__ cosn, float* __restrict__ sinn, LAS float* inv) {
    if (tidx() < 72) { const int j = tidx(); inv[j] = j < 64 ? (float)pow(10000.0, -(double)j / 64.0) : (float)pow(500000.0, -(double)(j - 64) / 8.0); }
    __syncthreads();
    for (int idx = blockIdx.x * NTHR + tidx(); idx < M * 72; idx += gridDim.x * NTHR) {
        const int m = idx / 72, j = idx % 72; const float pos = (float)positions[m];
        const float ang = pos * inv[j]; double sd, cd; sincos((double)ang, &sd, &cd);
        if (j < 64) { cosr[(size_t)m * 64 + j] = (float)cd; sinr[(size_t)m * 64 + j] = (float)sd; } else { cosn[(size_t)m * 8 + j - 64] = (float)cd; sinn[(size_t)m * 8 + j - 64] = (float)sd; }
    }
    __syncthreads();
}
__device__ __forceinline__ void w_rope(const h16* __restrict__ h, h16* __restrict__ rqr, h16* __restrict__ rkr, h16* __restrict__ nqr, h16* __restrict__ ksR, h16* __restrict__ kwR, const float* __restrict__ cosr, const float* __restrict__ sinr,
                                       const float* __restrict__ cosn, const float* __restrict__ sinn, int m, int lane) {
    const h16* hr = h + (size_t)m * INP; const int bb = m >> 13, t = m & (T - 1);
    {
        const int isk = lane >> 5, hd = (lane >> 3) & 3, j8 = (lane & 7) * 8; const int col = (isk ? C_RK : C_RQ) + hd * 128 + j8;
        const h16x8 a1 = *(const h16x8*)(hr + col), a2 = *(const h16x8*)(hr + col + 64);
        const f32x4 c0 = *(const f32x4*)(cosr + (size_t)m * 64 + j8), c1 = *(const f32x4*)(cosr + (size_t)m * 64 + j8 + 4), s0 = *(const f32x4*)(sinr + (size_t)m * 64 + j8), s1 = *(const f32x4*)(sinr + (size_t)m * 64 + j8 + 4);
        const float sc = isk ? 0.08838834764831845f : 1.f; h16x8 o1, o2;
#pragma unroll
        for (int x = 0; x < 8; ++x) { const float c = x < 4 ? c0[x & 3] : c1[x & 3], s = x < 4 ? s0[x & 3] : s1[x & 3]; const float v1 = (float)a1[x], v2 = (float)a2[x];
            o1[x] = (h16)((v1 * c - v2 * s) * sc); o2[x] = (h16)((v2 * c + v1 * s) * sc); }
        h16* dst = (isk ? rkr : rqr) + ((size_t)(bb * 4 + hd) * T + t) * 128 + j8; *(h16x8*)dst = o1; *(h16x8*)(dst + 64) = o2; }
    const f32x4 cn0 = *(const f32x4*)(cosn + (size_t)m * 8), cn1 = *(const f32x4*)(cosn + (size_t)m * 8 + 4), sn0 = *(const f32x4*)(sinn + (size_t)m * 8), sn1 = *(const f32x4*)(sinn + (size_t)m * 8 + 4);
    if (lane < 8 || (lane >= 56 && lane < 60)) {
        const bool isq = lane < 8; const int idx = lane - 56, which = idx >> 1, g = idx & 1;
        const h16* src = isq ? hr + C_NQ + lane * 64 : hr + (which ? C_NKW : C_NKS) + g * 64;
        h16* dst = isq ? nqr + (size_t)m * 512 + lane * 64 : (which ? kwR : ksR) + (((size_t)((bb * 2 + g) * 128 + (t >> 6)) * 64 + (t & 63)) * 64);
        const h16x8 a1 = *(const h16x8*)src, a2 = *(const h16x8*)(src + 8); h16x8 o1, o2;
#pragma unroll
        for (int x = 0; x < 8; ++x) { const float c = x < 4 ? cn0[x & 3] : cn1[x & 3], s = x < 4 ? sn0[x & 3] : sn1[x & 3]; const float v1 = (float)a1[x], v2 = (float)a2[x];
            o1[x] = (h16)(v1 * c - v2 * s); o2[x] = (h16)(v2 * c + v1 * s); }
        *(h16x8*)dst = o1; *(h16x8*)(dst + 8) = o2;
    } else if (lane < 56) {
        const int idx = lane - 8, hd = idx / 6, d = 16 + 8 * (idx % 6); *(h16x8*)(nqr + (size_t)m * 512 + hd * 64 + d) = *(const h16x8*)(hr + C_NQ + hd * 64 + d); }
    if (lane < 24) {
        const int which = lane / 12, r = lane % 12, g = r / 6, d = 16 + 8 * (r % 6);
        h16* dst = (which ? kwR : ksR) + (((size_t)((bb * 2 + g) * 128 + (t >> 6)) * 64 + (t & 63)) * 64);
        *(h16x8*)(dst + d) = *(const h16x8*)(hr + (which ? C_NKW : C_NKS) + g * 64 + d); }
}
__device__ __forceinline__ void b_rope(const h16* __restrict__ h, h16* __restrict__ rqr, h16* __restrict__ rkr, h16* __restrict__ nqr, h16* __restrict__ ksR, h16* __restrict__ kwR, const float* __restrict__ cosr, const float* __restrict__ sinr,
                                       const float* __restrict__ cosn, const float* __restrict__ sinn, int m, int j) {
    const h16* hr = h + (size_t)m * INP; const int bb = m >> 13, t = m & (T - 1);
    {   const int hd = j >> 6, jj = j & 63; const float c = cosr[(size_t)m * 64 + jj], s = sinr[(size_t)m * 64 + jj]; const size_t ro = ((size_t)(bb * 4 + hd) * T + t) * 128;
        const int o1 = hd * 128 + jj, o2 = o1 + 64;
        const float q1 = (float)hr[C_RQ + o1], q2 = (float)hr[C_RQ + o2];
        rqr[ro + jj] = (h16)(q1 * c - q2 * s); rqr[ro + jj + 64] = (h16)(q2 * c + q1 * s);
        const float k1 = (float)hr[C_RK + o1], k2 = (float)hr[C_RK + o2]; const float sc = 0.08838834764831845f;
        rkr[ro + jj] = (h16)((k1 * c - k2 * s) * sc); rkr[ro + jj + 64] = (h16)((k2 * c + k1 * s) * sc);
    }
    if (j < 64 + 16 + 16) {
        const int jj = j & 7; const float c = cosn[(size_t)m * 8 + jj], s = sinn[(size_t)m * 8 + jj];
        if (j < 64) { const int hd = j >> 3; const int o1 = hd * 64 + jj, o2 = o1 + 8;
            const float q1 = (float)hr[C_NQ + o1], q2 = (float)hr[C_NQ + o2];
            nqr[(size_t)m * 512 + o1] = (h16)(q1 * c - q2 * s); nqr[(size_t)m * 512 + o2] = (h16)(q2 * c + q1 * s);
        } else { const int jx = j - 64; const int which = jx >> 4, g = (jx >> 3) & 1; const int base = (which ? C_NKW : C_NKS) + g * 64 + jj;
            const float k1 = (float)hr[base], k2 = (float)hr[base + 8];
            h16* dst = (which ? kwR : ksR) + (((size_t)((bb * 2 + g) * 128 + (t >> 6)) * 64 + (t & 63)) * 64); dst[jj] = (h16)(k1 * c - k2 * s); dst[jj + 8] = (h16)(k2 * c + k1 * s); }
    }
    if (j >= 128 && j < 128 + 96) { const int jx = j - 128; const int which = jx / 48, r = jx % 48, g = r / 24, d = 16 + 2 * (r % 24);
        const int base = (which ? C_NKW : C_NKS) + g * 64 + d; h16* dst = (which ? kwR : ksR) + (((size_t)((bb * 2 + g) * 128 + (t >> 6)) * 64 + (t & 63)) * 64);
        dst[d] = hr[base]; dst[d + 1] = hr[base + 1]; }
    for (int i = j; i < 8 * 48; i += 256) { const int hd = i / 48, d = 16 + i % 48; nqr[(size_t)m * 512 + hd * 64 + d] = hr[C_NQ + hd * 64 + d]; }
}
__device__ __forceinline__ void b_rtrans(const Params& p, const h16* __restrict__ h, h16* __restrict__ rvT, h16* __restrict__ rkzT, const float* __restrict__ cosr, const float* __restrict__ sinr, int item, LAS h16* sl, int lane) {
    int id = item; const int tt = id & 255; id >>= 8; const int hd = id & 3; const int b = id >> 2; const int bh = b * 4 + hd; const float lg = p.lg[hd];
    const int chunk = bh * 64 + (tt >> 2), koff = (tt & 3) * 32;
#pragma unroll 4
    for (int i = lane; i < 32 * 16; i += 64) { const int t = i >> 4, e8 = (i & 15) * 8; const h16x8 v = *(const h16x8*)(h + (size_t)(b * T + tt * 32 + t) * INP + C_RV + hd * 128 + e8);
#pragma unroll
        for (int x = 0; x < 8; ++x) sl[t * 130 + e8 + x] = v[x]; }
    asm volatile("s_waitcnt lgkmcnt(0)" ::: "memory");
#pragma unroll 4
    for (int i = lane; i < 128 * 4; i += 64) { const int e = i >> 2, t8 = (i & 3) * 8; h16x8 o;
#pragma unroll
        for (int x = 0; x < 8; ++x) o[x] = sl[(t8 + x) * 130 + e];
        *(h16x8*)(rvT + ((size_t)chunk * 128 + e) * 128 + koff + t8) = o; }
    asm volatile("s_waitcnt lgkmcnt(0)" ::: "memory");
#pragma unroll 4
    for (int i = lane; i < 32 * 8; i += 64) { const int t = i >> 3, j8 = (i & 7) * 8; const size_t m = (size_t)b * T + tt * 32 + t;
        const h16x8 k1 = *(const h16x8*)(h + m * INP + C_RK + hd * 128 + j8), k2 = *(const h16x8*)(h + m * INP + C_RK + hd * 128 + 64 + j8);
        const f32x4 c0 = *(const f32x4*)(cosr + m * 64 + j8), c1 = *(const f32x4*)(cosr + m * 64 + j8 + 4), s0 = *(const f32x4*)(sinr + m * 64 + j8), s1 = *(const f32x4*)(sinr + m * 64 + j8 + 4);
        const float z = 0.08838834764831845f * __expf(lg * (float)(127 - (koff + t)));
#pragma unroll
        for (int x = 0; x < 8; ++x) { const float c = x < 4 ? c0[x & 3] : c1[x & 3], s = x < 4 ? s0[x & 3] : s1[x & 3]; const float a1 = (float)k1[x], a2 = (float)k2[x];
            sl[t * 130 + j8 + x] = (h16)((a1 * c - a2 * s) * z); sl[t * 130 + 64 + j8 + x] = (h16)((a2 * c + a1 * s) * z); } }
    asm volatile("s_waitcnt lgkmcnt(0)" ::: "memory");
#pragma unroll 4
    for (int i = lane; i < 128 * 4; i += 64) { const int d = i >> 2, t8 = (i & 3) * 8; h16x8 o;
#pragma unroll
        for (int x = 0; x < 8; ++x) o[x] = sl[(t8 + x) * 130 + d];
        *(h16x8*)(rkzT + ((size_t)chunk * 128 + d) * 128 + koff + t8) = o; }
    asm volatile("s_waitcnt lgkmcnt(0)" ::: "memory");
}
__device__ __forceinline__ void b_mvtrans(const h16* __restrict__ kvm, h16* __restrict__ kvmVT, h16* __restrict__ kx, int item, h16* sl, int lt) {
    int id = item; const int kt = id & 3; id >>= 2; const int dtl = id & 3; id >>= 2; const int hh = id & 3; const int b = id >> 2;
    for (int i = lt; i < 64 * 64; i += 256) { const int k = i >> 6, d = i & 63; sl[k * 66 + d] = kvm[(size_t)(b * MEML + kt * 64 + k) * 2048 + 1024 + hh * 256 + dtl * 64 + d];
        kx[((size_t)(b * 4 + hh) * MEML + kt * 64 + k) * 256 + dtl * 64 + d] = kvm[(size_t)(b * MEML + kt * 64 + k) * 2048 + hh * 256 + dtl * 64 + d]; }
    __syncthreads();
    for (int i = lt; i < 64 * 64; i += 256) { const int d = i >> 6, k = i & 63; kvmVT[(size_t)((b * 4 + hh) * 256 + dtl * 64 + d) * MEML + kt * 64 + k] = sl[k * 66 + d]; }
    __syncthreads();
}

struct CmpSched {
    const char* hbase; const unsigned* cmpoff; const char* Wc1T; int c;
    __device__ bool next(int i, pg8::Unit& u) const {
        if (i > 0 || c >= 32) return false; const int kv = c >> 4, rt = c & 15;
        u.pm = kv * 16 + rt; u.pn = 0; u.A = hbase + (size_t)(kv ? C_NVC : C_NKC) * 2; u.gat = cmpoff + rt * 256; u.B = Wc1T + (size_t)kv * 256 * 2048 * 2; return true; }
};
__device__ __forceinline__ void b_cmp2(const Params& p, const h16* __restrict__ hid, h16* __restrict__ kcmp, h16* __restrict__ vcmpT) {
    const int lane = tidx() & 63;
    for (int r = blockIdx.x * 8 + (tidx() >> 6); r < 2 * 4096; r += gridDim.x * 8) {
        const int kv = r >> 12, rr = r & 4095, g = rr & 1, c = (rr >> 1) & 511, b = rr >> 10;
        const float* w2 = kv ? p.w2v : p.w2k; const h16* hr = hid + (size_t)r * 256; float acc = 0.f;
        for (int j = 0; j < 256; j += 8) { const h16x8 hv = *(const h16x8*)(hr + j);
#pragma unroll
            for (int x = 0; x < 8; ++x) acc += (float)hv[x] * w2[(j + x) * 64 + lane]; }
        if (c == 511) acc = 0.f;
        if (kv == 0) kcmp[((size_t)(b * 2 + g) * 512 + c) * 64 + lane] = (h16)acc;
        else vcmpT[(((size_t)(b * 2 + g) * 8 + (c >> 6)) * 64 + lane) * 64 + (c & 63)] = (h16)acc;
    }
}
__device__ __forceinline__ void b_vtrans(const h16* __restrict__ h, h16* __restrict__ vsT, h16* __restrict__ vwT, int item, LAS h16* sl, int lane) {
    int id = item; const int tt = id & 127; id >>= 7; const int g = id & 1; id >>= 1; const int b = id & 3; const int which = id >> 2;
    const int col = (which ? C_NVW : C_NVS) + g * 64; h16* dst = (which ? vwT : vsT) + (size_t)((b * 2 + g) * 128 + tt) * 4096;
#pragma unroll 4
    for (int i = lane; i < 64 * 8; i += 64) { const int t = i >> 3, d8 = (i & 7) * 8; const h16x8 v = *(const h16x8*)(h + (size_t)(b * T + tt * 64 + t) * INP + col + d8);
#pragma unroll
        for (int x = 0; x < 8; ++x) sl[t * 66 + d8 + x] = v[x]; }
    asm volatile("s_waitcnt lgkmcnt(0)" ::: "memory");
#pragma unroll 4
    for (int i = lane; i < 64 * 8; i += 64) { const int d = i >> 3, t8 = (i & 7) * 8; h16x8 o;
#pragma unroll
        for (int x = 0; x < 8; ++x) o[x] = sl[(t8 + x) * 66 + d];
        *(h16x8*)(dst + d * 64 + t8) = o; }
    asm volatile("s_waitcnt lgkmcnt(0)" ::: "memory");
}

__device__ __forceinline__ void ret_kv_unit(const h16* __restrict__ rkzT, const h16* __restrict__ rvT, float* __restrict__ kvT, int chunk, int w, int lane) {
    const int i = lane & 15, kg = lane >> 4; const int bh = chunk >> 6, n = chunk & 63;
    h16x8 a[4];
#pragma unroll
    for (int ks = 0; ks < 4; ++ks) a[ks] = *(const h16x8*)(rkzT + ((size_t)chunk * 128 + 16 * w + i) * 128 + 32 * ks + 8 * kg);
#pragma unroll
    for (int et = 0; et < 8; ++et) { f32x4 acc = {0.f, 0.f, 0.f, 0.f};
#pragma unroll
        for (int ks = 0; ks < 4; ++ks) { const h16x8 bq = *(const h16x8*)(rvT + ((size_t)chunk * 128 + 16 * et + i) * 128 + 32 * ks + 8 * kg); acc = __builtin_amdgcn_mfma_f32_16x16x32_f16(a[ks], bq, acc, 0, 0, 0); }
        *(f32x4*)(kvT + ((size_t)chunk * 128 + 16 * et + i) * 128 + 16 * w + 4 * kg) = acc; }
}
__device__ __forceinline__ void b_ret_scan(const Params& p, const float* __restrict__ kvT, h16* __restrict__ prevT) {
    for (int gid = blockIdx.x * NTHR + tidx(); gid < 16 * 16384; gid += gridDim.x * NTHR) {
        const int de = gid & 16383, bh = gid >> 14; const float cd = __expf(p.lg[bh & 3] * 128.f);
        float st = 0.f;
        for (int n = 0; n < 64; ++n) { const size_t o = ((size_t)(bh * 64 + n) << 14) + de; prevT[o] = (h16)st; st = st * cd + kvT[o]; }
    }
}
__device__ __forceinline__ void ret_out_unit(const Params& p, const h16* __restrict__ h, const h16* __restrict__ rqr, const h16* __restrict__ rkr, const h16* __restrict__ rvT, const h16* __restrict__ prevT,
                                             h16* __restrict__ mix, int chunk, int w, int lane) {
    const int i = lane & 15, kg = lane >> 4; const int bh = chunk >> 6, n = chunk & 63, b = bh >> 2, hd = bh & 3; const float lg = p.lg[hd];
    const int qi = 16 * w + i; const size_t m = (size_t)b * T + n * 128 + qi;
    h16x8 qf[4];
#pragma unroll
    for (int ks = 0; ks < 4; ++ks) qf[ks] = *(const h16x8*)(rqr + ((size_t)bh * T + n * 128 + qi) * 128 + 32 * ks + 8 * kg);
    f32x4 inner[8], cross[8];
#pragma unroll
    for (int et = 0; et < 8; ++et) { inner[et] = (f32x4){0.f, 0.f, 0.f, 0.f}; cross[et] = (f32x4){0.f, 0.f, 0.f, 0.f}; }
    for (int gq = 0; gq < 2; ++gq) {
        if (64 * gq > 16 * w + 15) break;
        f32x4 s[4];
#pragma unroll
        for (int tl = 0; tl < 4; ++tl) { const int ko = 32 * (tl >> 1) + 8 * (i >> 2) + 4 * (tl & 1) + (i & 3); const h16* kp = rkr + ((size_t)bh * T + n * 128 + 64 * gq + ko) * 128 + 8 * kg;
            f32x4 acc = {0.f, 0.f, 0.f, 0.f};
#pragma unroll
            for (int ks = 0; ks < 4; ++ks) acc = __builtin_amdgcn_mfma_f32_16x16x32_f16(*(const h16x8*)(kp + 32 * ks), qf[ks], acc, 0, 0, 0);
            s[tl] = acc; }
        h16x8 pf[2];
#pragma unroll
        for (int tl = 0; tl < 4; ++tl)
#pragma unroll
            for (int r = 0; r < 4; ++r) { const int j = 64 * gq + 32 * (tl >> 1) + 8 * kg + 4 * (tl & 1) + r; const float v = (j <= qi) ? s[tl][r] * __expf(lg * (float)(qi - j)) : 0.f; pf[tl >> 1][4 * (tl & 1) + r] = (h16)v; }
#pragma unroll
        for (int et = 0; et < 8; ++et)
#pragma unroll
            for (int s2 = 0; s2 < 2; ++s2) { const h16x8 a = *(const h16x8*)(rvT + ((size_t)chunk * 128 + 16 * et + i) * 128 + 64 * gq + 32 * s2 + 8 * kg); inner[et] = __builtin_amdgcn_mfma_f32_16x16x32_f16(a, pf[s2], inner[et], 0, 0, 0); }
    }
#pragma unroll
    for (int et = 0; et < 8; ++et)
#pragma unroll
        for (int ks = 0; ks < 4; ++ks) { const h16x8 a = *(const h16x8*)(prevT + ((size_t)chunk * 128 + 16 * et + i) * 128 + 32 * ks + 8 * kg); cross[et] = __builtin_amdgcn_mfma_f32_16x16x32_f16(a, qf[ks], cross[et], 0, 0, 0); }
    const float xi = __expf(lg * (float)(qi + 1));
    float sm = 0.f;
#pragma unroll
    for (int et = 0; et < 8; ++et) { inner[et] = inner[et] + cross[et] * xi; sm += (inner[et][0] + inner[et][1]) + (inner[et][2] + inner[et][3]); }
    sm += __shfl_xor(sm, 16); sm += __shfl_xor(sm, 32);
    const float mu = sm * (1.f / 128.f); float sq = 0.f;
#pragma unroll
    for (int et = 0; et < 8; ++et) { inner[et] = inner[et] - mu; sq += (inner[et][0] * inner[et][0] + inner[et][1] * inner[et][1]) + (inner[et][2] * inner[et][2] + inner[et][3] * inner[et][3]); }
    sq += __shfl_xor(sq, 16); sq += __shfl_xor(sq, 32);
    const float rstd = rsqrtf(sq * (1.f / 128.f) + LN_EPS);
#pragma unroll
    for (int et = 0; et < 8; ++et) { const int e = 16 * et + 4 * kg; const h16x4 gv = *(const h16x4*)(h + m * INP + C_RG + hd * 128 + e);
        f32x4 o;
#pragma unroll
        for (int r = 0; r < 4; ++r) o[r] = siluf((float)gv[r]) * inner[et][r] * rstd;
        *(h16x4*)(mix + m * D + hd * 128 + e) = __builtin_convertvector(o, h16x4); }
}

struct AttSt { float m, l; f32x4 o[4]; };
struct KFrag { h16x8 a[4][2]; };
struct VFrag { h16x8 a[4][2]; };
__device__ __forceinline__ void ldk(KFrag& k, const h16* __restrict__ Kb, int pitchK, int i, int kg) {
#pragma unroll
    for (int tl = 0; tl < 4; ++tl) { const int ko = 32 * (tl >> 1) + 8 * (i >> 2) + 4 * (tl & 1) + (i & 3); const h16* kp = Kb + (size_t)ko * pitchK + 8 * kg;
        k.a[tl][0] = *(const h16x8*)kp; k.a[tl][1] = *(const h16x8*)(kp + 32); }
}
__device__ __forceinline__ void ldv(VFrag& v, const h16* __restrict__ VTb, int vstride, int i, int kg) {
#pragma unroll
    for (int dt = 0; dt < 4; ++dt)
#pragma unroll
        for (int s2 = 0; s2 < 2; ++s2) v.a[dt][s2] = *(const h16x8*)(VTb + (size_t)(16 * dt + i) * vstride + 32 * s2 + 8 * kg);
}
__device__ __forceinline__ float xmax4(float v) {
    auto a = __builtin_amdgcn_permlane16_swap(__float_as_uint(v), __float_as_uint(v), false, false); v = fmaxf(__uint_as_float(a[0]), __uint_as_float(a[1]));
    auto c = __builtin_amdgcn_permlane32_swap(__float_as_uint(v), __float_as_uint(v), false, false); return fmaxf(__uint_as_float(c[0]), __uint_as_float(c[1])); }
__device__ __forceinline__ float xsum4(float v) {
    auto a = __builtin_amdgcn_permlane16_swap(__float_as_uint(v), __float_as_uint(v), false, false); v = __uint_as_float(a[0]) + __uint_as_float(a[1]);
    auto c = __builtin_amdgcn_permlane32_swap(__float_as_uint(v), __float_as_uint(v), false, false); return __uint_as_float(c[0]) + __uint_as_float(c[1]); }
constexpr float ATT_C2 = 0.125f * 1.4426950408889634f;
template <bool MASKED, class MaskF>
__device__ __forceinline__ void att_scores(f32x4 (&s)[4], const KFrag& k, const h16x8 (&qf)[2], int kg, MaskF valid) {
#pragma unroll
    for (int tl = 0; tl < 4; ++tl) { f32x4 z = {0.f, 0.f, 0.f, 0.f}; z = __builtin_amdgcn_mfma_f32_16x16x32_f16(k.a[tl][0], qf[0], z, 0, 0, 0); s[tl] = __builtin_amdgcn_mfma_f32_16x16x32_f16(k.a[tl][1], qf[1], z, 0, 0, 0); }
    if (MASKED) {
#pragma unroll
        for (int tl = 0; tl < 4; ++tl)
#pragma unroll
            for (int r = 0; r < 4; ++r) { const int ko = 32 * (tl >> 1) + 8 * kg + 4 * (tl & 1) + r; s[tl][r] = valid(ko) ? s[tl][r] : -INFINITY; }
    }
}
__device__ __forceinline__ float att_rowmax(const f32x4 (&s)[4]) {
    float mx = fmaxf(fmaxf(s[0][0], s[0][1]), fmaxf(s[0][2], s[0][3]));
#pragma unroll
    for (int tl = 1; tl < 4; ++tl) mx = fmaxf(mx, fmaxf(fmaxf(s[tl][0], s[tl][1]), fmaxf(s[tl][2], s[tl][3])));
    return xmax4(mx);
}
__device__ __forceinline__ void att_pv(f32x4 (&o)[4], const f32x4 (&pv)[4], const VFrag& v) {
    h16x8 pf[2];
#pragma unroll
    for (int s2 = 0; s2 < 2; ++s2)
#pragma unroll
        for (int j = 0; j < 8; ++j) pf[s2][j] = (h16)pv[2 * s2 + (j >> 2)][j & 3];
#pragma unroll
    for (int dt = 0; dt < 4; ++dt)
#pragma unroll
        for (int s2 = 0; s2 < 2; ++s2) o[dt] = __builtin_amdgcn_mfma_f32_16x16x32_f16(v.a[dt][s2], pf[s2], o[dt], 0, 0, 0);
}
__device__ __forceinline__ void att_softmax_pv(AttSt& st, f32x4 (&s)[4], const VFrag& v, bool rowok) {
    const float mx = rowok ? att_rowmax(s) * ATT_C2 : -INFINITY;
    const float mn = fmaxf(st.m, mx);
    if (__any(mn > st.m)) { const float alpha = __builtin_amdgcn_exp2f(st.m - mn); st.m = mn; st.l *= alpha;
#pragma unroll
        for (int dt = 0; dt < 4; ++dt) st.o[dt] = st.o[dt] * alpha; }
    const float mneg = rowok ? -mn : -INFINITY;
    float ps0 = 0.f, ps1 = 0.f;
#pragma unroll
    for (int tl = 0; tl < 4; ++tl) {
#pragma unroll
        for (int r = 0; r < 4; ++r) s[tl][r] = __builtin_amdgcn_exp2f(__builtin_fmaf(s[tl][r], ATT_C2, mneg));
        ps0 += s[tl][0] + s[tl][1]; ps1 += s[tl][2] + s[tl][3]; }
    st.l += ps0 + ps1;
    att_pv(st.o, s, v);
}
template <bool MASKED, class MaskF>
__device__ __forceinline__ void att_tile(AttSt& st, const KFrag& k, const VFrag& v, const h16x8 (&qf)[2], int kg, bool rowok, MaskF valid) {
    f32x4 s[4]; att_scores<MASKED>(s, k, qf, kg, valid);
    att_softmax_pv(st, s, v, rowok);
}
constexpr int NSA_NSLOT = 6, NSA_RING = 0, NSA_IMP = NSA_NSLOT * 16384, NSA_MSK = 131072 + 256, NSA_LIST = NSA_MSK + 256;
__device__ __forceinline__ void ldk_lds(KFrag& k, LAS const unsigned char* slot, int ko0, int ko1) {
#pragma unroll
    for (int tl = 0; tl < 4; ++tl) { const int o = (32 * (tl >> 1) + 4 * (tl & 1)) * 128; k.a[tl][0] = *(LAS const h16x8*)(slot + o + ko0); k.a[tl][1] = *(LAS const h16x8*)(slot + o + ko1); }
}
__device__ __forceinline__ void ldv_lds(VFrag& v, LAS const unsigned char* slot, int vo0, int vo1) {
#pragma unroll
    for (int dt = 0; dt < 4; ++dt) { v.a[dt][0] = *(LAS const h16x8*)(slot + 8192 + dt * 2048 + vo0); v.a[dt][1] = *(LAS const h16x8*)(slot + 8192 + dt * 2048 + vo1); }
}
#define NSA_WAITV(n) asm volatile("s_waitcnt vmcnt(" #n ")" ::: "memory")
#define NSA_BAR() do { asm volatile("s_waitcnt lgkmcnt(0)" ::: "memory"); __builtin_amdgcn_s_barrier(); asm volatile("" ::: "memory"); } while (0)
template <int LPT, class IssueF, class CompF>
__device__ __forceinline__ void nsa_stream2(int n, LAS unsigned char* dmaw, LAS unsigned char* ring, IssueF issue, CompF comp2) {
#pragma unroll
    for (int j = 0; j < 4; ++j) if (j < n) issue(j, (LAS unsigned*)(dmaw + j * 16384));
    int sa = 0, si = 4 * 16384;
    for (int t2 = 0; t2 < n; t2 += 2) {
        const int rem = n - t2 - 2;
        if (rem >= 2) { if (LPT == 2) NSA_WAITV(4); else NSA_WAITV(2); } else if (rem == 1) { if (LPT == 2) NSA_WAITV(2); else NSA_WAITV(1); } else NSA_WAITV(0);
        NSA_BAR();
        if (t2 + 4 < n) issue(t2 + 4, (LAS unsigned*)(dmaw + si));
        if (t2 + 5 < n) issue(t2 + 5, (LAS unsigned*)(dmaw + si + 16384));
        comp2(t2, (LAS const unsigned char*)(ring + sa), t2 + 1 < n, (LAS const unsigned char*)(ring + sa + 16384));
        sa = (sa == 4 * 16384) ? 0 : sa + 2 * 16384; si = (si == 4 * 16384) ? 0 : si + 2 * 16384; }
    NSA_BAR();
}
__device__ __forceinline__ void att_merge(AttSt& a, const AttSt& b2) {
    const float mn = fmaxf(a.m, b2.m); const float fa = __builtin_amdgcn_exp2f(a.m - mn), fb = __builtin_amdgcn_exp2f(b2.m - mn);
    a.m = mn; a.l = a.l * fa + b2.l * fb;
#pragma unroll
    for (int dt = 0; dt < 4; ++dt) a.o[dt] = a.o[dt] * fa + b2.o[dt] * fb;
}
__device__ __forceinline__ void nsa_block_unit(const h16* __restrict__ h, const h16* __restrict__ nqr, const h16* __restrict__ kcmp, const h16* __restrict__ vcmpT, const h16* __restrict__ vsT, const h16* __restrict__ vwT,
                                               const h16* __restrict__ ksR, const h16* __restrict__ kwR, h16* __restrict__ mix, int b, int g, int T0, LAS unsigned char* lds, int wv, int lane) {
    const int i = lane & 15, kg = lane >> 4, tt = i & 3, hh = i >> 2;
    const int t0 = T0 + 4 * wv, trow = t0 + tt; const size_t mrow = (size_t)b * T + trow;
    const int q = wv * 64 + lane, qrow = q >> 3, qch = q & 7;
    const int ksrc = qrow * 128 + ((qch ^ (((qrow >> 1) & 1) | (((qrow >> 3) & 3) << 1))) << 4), vsrc = qrow * 128 + ((qch ^ ((qrow >> 1) & 7)) << 4);
    const int gki = ((i >> 1) & 1) | ((i >> 2) << 1), gvi = (i >> 1) & 7;
    const int ko0 = (8 * (i >> 2) + (i & 3)) * 128 + ((kg ^ gki) << 4), ko1 = (8 * (i >> 2) + (i & 3)) * 128 + (((kg + 4) ^ gki) << 4);
    const int vo0 = i * 128 + ((kg ^ gvi) << 4), vo1 = i * 128 + (((kg + 4) ^ gvi) << 4);
    LAS unsigned char* ring = lds + NSA_RING; LAS unsigned char* dmaw = ring + wv * 1024;
    LAS float* impA = (LAS float*)(lds + NSA_IMP + wv * 4096); LAS float* impL = impA + 512;
    h16x8 qf[2], qrf[2];
    { const h16* qp = h + mrow * INP + C_NQ + (g * 4 + hh) * 64 + 8 * kg; qf[0] = *(const h16x8*)qp; qf[1] = *(const h16x8*)(qp + 32);
      const h16* qrp = nqr + mrow * 512 + (g * 4 + hh) * 64 + 8 * kg; qrf[0] = *(const h16x8*)qrp; qrf[1] = *(const h16x8*)(qrp + 32); }
    const h16* gp = h + mrow * INP + C_NG + (g * 4 + hh) * 3; const float gt0 = (float)gp[0], gt1 = (float)gp[1], gt2 = (float)gp[2];
    for (int x = lane; x < 1024; x += 64) impA[x] = 0.f;
    NSA_WAITV(0);
#define GLDS16(gsrc, ldst) __builtin_amdgcn_global_load_lds((const unsigned*)(gsrc), (ldst), 16, 0, 0)
    const int ncv_row = trow >= 31 ? ((trow - 31) >> 4) + 1 : 0;
    const int ncv_blk = (T0 + 31 >= 31) ? ((T0 + 31 - 31) >> 4) + 1 : 0;
    const int ncv_min = T0 >= 31 ? ((T0 - 31) >> 4) + 1 : 0;
    const int nct = (ncv_blk + 63) >> 6;
    const unsigned char* Kc = (const unsigned char*)(kcmp + (size_t)(b * 2 + g) * 512 * 64); const unsigned char* Vc = (const unsigned char*)(vcmpT + (size_t)(b * 2 + g) * 8 * 4096);
    float m = -1e30f, l = 0.f;
    f32x4 oc[4];
    float linv = 0.f;
    REPS(501) {
    m = -1e30f; l = 0.f;
#pragma unroll
    for (int dt = 0; dt < 4; ++dt) oc[dt] = (f32x4){0.f, 0.f, 0.f, 0.f};
    float mB = -1e30f, lB = 0.f;
    auto cmp1 = [&](int j, LAS const unsigned char* slot, float& mm, float& ll) {
        KFrag kf; ldk_lds(kf, slot, ko0, ko1);
        f32x4 s[4];
        if (64 * j + 63 < ncv_min) att_scores<false>(s, kf, qf, kg, [&](int) { return true; }); else att_scores<true>(s, kf, qf, kg, [&](int ko) { return j * 64 + ko < ncv_row; });
        const float mx = att_rowmax(s) * ATT_C2;
        const float mn = fmaxf(mm, mx); float ps0 = 0.f, ps1 = 0.f;
        _Pragma("unroll") for (int tl = 0; tl < 4; ++tl) { ps0 += __builtin_amdgcn_exp2f(__builtin_fmaf(s[tl][0], ATT_C2, -mn)) + __builtin_amdgcn_exp2f(__builtin_fmaf(s[tl][1], ATT_C2, -mn));
                                                          ps1 += __builtin_amdgcn_exp2f(__builtin_fmaf(s[tl][2], ATT_C2, -mn)) + __builtin_amdgcn_exp2f(__builtin_fmaf(s[tl][3], ATT_C2, -mn)); }
        ll = ll * __builtin_amdgcn_exp2f(mm - mn) + (ps0 + ps1); mm = mn; };
    nsa_stream2<1>(nct, dmaw, ring, [&](int j, LAS unsigned* dk) { GLDS16(Kc + (size_t)j * 8192 + ksrc, dk); }, [&](int j, LAS const unsigned char* sA, bool hasB, LAS const unsigned char* sB) {
        cmp1(j, sA, m, l); __builtin_amdgcn_sched_barrier(0); if (hasB) cmp1(j + 1, sB, mB, lB); });
    { const float mn = fmaxf(m, mB); l = l * __builtin_amdgcn_exp2f(m - mn) + lB * __builtin_amdgcn_exp2f(mB - mn); m = mn; }
    l = xsum4(l);
    linv = l > 0.f ? 1.f / l : 0.f;
    auto cmp2 = [&](int j, LAS const unsigned char* slot) {
        KFrag kf; ldk_lds(kf, slot, ko0, ko1); VFrag vf; ldv_lds(vf, slot, vo0, vo1);
        f32x4 s[4];
        if (64 * j + 63 < ncv_min) att_scores<false>(s, kf, qf, kg, [&](int) { return true; }); else att_scores<true>(s, kf, qf, kg, [&](int ko) { return j * 64 + ko < ncv_row; });
        _Pragma("unroll") for (int tl = 0; tl < 4; ++tl) {
            _Pragma("unroll") for (int r = 0; r < 4; ++r) s[tl][r] = __builtin_amdgcn_exp2f(__builtin_fmaf(s[tl][r], ATT_C2, -m)) * linv;
            float A = (s[tl][0] + s[tl][1]) + (s[tl][2] + s[tl][3]), L = s[tl][3];
            A += __shfl_xor(A, 4); A += __shfl_xor(A, 8); L += __shfl_xor(L, 4); L += __shfl_xor(L, 8);
            if (hh == 0) { const int u = j * 16 + 8 * (tl >> 1) + 2 * kg + (tl & 1); impA[tt * 128 + u] = A; impL[tt * 128 + u] = L; } }
        att_pv(oc, s, vf); };
    nsa_stream2<2>(nct, dmaw, ring, [&](int j, LAS unsigned* dk) { GLDS16(Kc + (size_t)j * 8192 + ksrc, dk); GLDS16(Vc + (size_t)j * 8192 + vsrc, (LAS unsigned*)((LAS unsigned char*)dk + 8192)); },
        [&](int j, LAS const unsigned char* sA, bool hasB, LAS const unsigned char* sB) { cmp2(j, sA); if (hasB) cmp2(j + 1, sB); });
    }
    const int cur = T0 >> 6;
    AttSt sw;
    REPS(504) {
    sw.m = -1e30f; sw.l = 0.f;
#pragma unroll
    for (int dt = 0; dt < 4; ++dt) sw.o[dt] = (f32x4){0.f, 0.f, 0.f, 0.f};
    {
        const unsigned char* Kw = (const unsigned char*)(kwR + (size_t)((b * 2 + g) * 128) * 4096); const unsigned char* Vw = (const unsigned char*)(vwT + (size_t)((b * 2 + g) * 128) * 4096);
        const int s0w = (T0 >= 511 ? (T0 - 511) >> 6 : 0);
        AttSt swB; swB.m = -1e30f; swB.l = 0.f;
#pragma unroll
        for (int dt = 0; dt < 4; ++dt) swB.o[dt] = (f32x4){0.f, 0.f, 0.f, 0.f};
        auto wsc = [&](f32x4 (&s)[4], int j, LAS const unsigned char* slot) { KFrag kf; ldk_lds(kf, slot, ko0, ko1); const int sx = s0w + j;
            if (sx > s0w + 1 && sx < cur) att_scores<false>(s, kf, qrf, kg, [&](int) { return true; });
            else att_scores<true>(s, kf, qrf, kg, [&](int ko) { const int kp = 64 * sx + ko; return kp <= trow && kp >= trow - 511; }); };
        nsa_stream2<2>(cur - s0w + 1, dmaw, ring, [&](int j, LAS unsigned* dk) { GLDS16(Kw + (size_t)(s0w + j) * 8192 + ksrc, dk); GLDS16(Vw + (size_t)(s0w + j) * 8192 + vsrc, (LAS unsigned*)((LAS unsigned char*)dk + 8192)); },
            [&](int j, LAS const unsigned char* sA, bool hasB, LAS const unsigned char* sB) {
                if (hasB) { f32x4 s0[4], s1[4]; wsc(s0, j, sA); wsc(s1, j + 1, sB); __builtin_amdgcn_sched_barrier(0);
                    { VFrag vf; ldv_lds(vf, sA, vo0, vo1); att_softmax_pv(sw, s0, vf, true); } { VFrag vf; ldv_lds(vf, sB, vo0, vo1); att_softmax_pv(swB, s1, vf, true); } }
                else { f32x4 s0[4]; wsc(s0, j, sA); VFrag vf; ldv_lds(vf, sA, vo0, vo1); att_softmax_pv(sw, s0, vf, true); } });
        att_merge(sw, swB);
    }
    }
    unsigned long long mylo, myhi, anylo, anyhi;
    if (cur <= 15) { mylo = anylo = (1ull << (cur + 1)) - 1ull; myhi = anyhi = 0ull; }
    else {
        mylo = myhi = anylo = anyhi = 0ull;
        const unsigned long long flo = 1ull | (cur < 64 ? (1ull << cur) : 0ull) | (cur - 1 < 64 ? (1ull << (cur - 1)) : 0ull);
        const unsigned long long fhi = (cur >= 64 ? (1ull << (cur - 64)) : 0ull) | (cur - 1 >= 64 ? (1ull << (cur - 65)) : 0ull);
        const unsigned long long lmask = (1ull << lane) - 1ull;
        for (int tk = 0; tk < 4; ++tk) {
            const int s0 = lane, s1 = lane + 64;
            const float v0 = impA[tk * 128 + s0] + (s0 > 0 ? impL[tk * 128 + s0 - 1] : 0.f), v1 = impA[tk * 128 + s1] + impL[tk * 128 + s1 - 1];
            const unsigned b0 = (s0 >= 1 && s0 <= cur - 2) ? __float_as_uint(v0) + 1u : 0u, b1 = (s1 <= cur - 2) ? __float_as_uint(v1) + 1u : 0u;
            unsigned Tq = 0u;
            for (int bit = 30; bit >= 0; --bit) { const unsigned T2 = Tq | (1u << bit);
                const int c = __popcll(__ballot(b0 >= T2)) + __popcll(__ballot(b1 >= T2)); if (c >= 13) Tq = T2; }
            const unsigned long long gtlo = __ballot(b0 > Tq), gthi = __ballot(b1 > Tq), eqlo = __ballot(b0 == Tq), eqhi = __ballot(b1 == Tq);
            const int need = 13 - (__popcll(gtlo) + __popcll(gthi));
            const bool t0q = (b0 == Tq) && (__popcll(eqlo & lmask) < need), t1q = (b1 == Tq) && (__popcll(eqlo) + __popcll(eqhi & lmask) < need);
            const unsigned long long lo = gtlo | __ballot(t0q) | flo, hi = gthi | __ballot(t1q) | fhi;
            anylo |= lo; anyhi |= hi; if (tt == tk) { mylo = lo; myhi = hi; }
        }
    }
    LAS unsigned long long* msk = (LAS unsigned long long*)(lds + NSA_MSK); LAS unsigned char* lst = lds + NSA_LIST; LAS int* nlst = (LAS int*)(lds + NSA_LIST + 128);
    if (lane == 0) { msk[2 * wv] = anylo; msk[2 * wv + 1] = anyhi; }
    NSA_BAR();
    if (wv == 0) {
        unsigned long long ulo = 0ull, uhi = 0ull;
#pragma unroll
        for (int w2 = 0; w2 < 8; ++w2) { ulo |= msk[2 * w2]; uhi |= msk[2 * w2 + 1]; }
        const unsigned long long lmask = (1ull << lane) - 1ull; const int nlo = __popcll(ulo);
        if ((ulo >> lane) & 1ull) lst[__popcll(ulo & lmask)] = (unsigned char)lane;
        if ((uhi >> lane) & 1ull) lst[nlo + __popcll(uhi & lmask)] = (unsigned char)(64 + lane);
        if (lane == 0) nlst[0] = nlo + __popcll(uhi);
    }
    NSA_BAR();
    const int nsel = nlst[0];
    AttSt ss;
    REPS(503) {
    ss.m = -1e30f; ss.l = 0.f;
#pragma unroll
    for (int dt = 0; dt < 4; ++dt) ss.o[dt] = (f32x4){0.f, 0.f, 0.f, 0.f};
    {
        const unsigned char* Ks = (const unsigned char*)(ksR + (size_t)((b * 2 + g) * 128) * 4096); const unsigned char* Vs = (const unsigned char*)(vsT + (size_t)((b * 2 + g) * 128) * 4096);
        auto sel1 = [&](int s, LAS const unsigned char* slot, AttSt& st) {
            KFrag kf; ldk_lds(kf, slot, ko0, ko1); VFrag vf; ldv_lds(vf, slot, vo0, vo1);
            const bool mybit = (((s < 64 ? mylo : myhi) >> (s & 63)) & 1ull) != 0ull;
            if (s < cur) att_tile<false>(st, kf, vf, qrf, kg, mybit, [&](int) { return true; });
            else att_tile<true>(st, kf, vf, qrf, kg, mybit, [&](int ko) { return 64 * s + ko <= trow; }); };
        nsa_stream2<2>(nsel, dmaw, ring, [&](int j, LAS unsigned* dk) { const int sj = lst[j]; GLDS16(Ks + (size_t)sj * 8192 + ksrc, dk); GLDS16(Vs + (size_t)sj * 8192 + vsrc, (LAS unsigned*)((LAS unsigned char*)dk + 8192)); },
            [&](int j, LAS const unsigned char* sA, bool hasB, LAS const unsigned char* sB) {
                const int s0 = lst[j]; const int s1 = hasB ? (int)lst[j + 1] : 0;
                const bool nA = (((s0 < 64 ? anylo : anyhi) >> (s0 & 63)) & 1ull) != 0ull, nB = hasB && ((((s1 < 64 ? anylo : anyhi) >> (s1 & 63)) & 1ull) != 0ull);
                if (nA) sel1(s0, sA, ss);
                if (nB) sel1(s1, sB, ss); });
    }
    }
    const float ls = xsum4(ss.l), lw = xsum4(sw.l);
    const float g0 = sigmf(gt0), g1 = sigmf(gt1) / ls, g2 = sigmf(gt2) / lw;
#pragma unroll
    for (int dt = 0; dt < 4; ++dt) { const f32x4 o = oc[dt] * g0 + ss.o[dt] * g1 + sw.o[dt] * g2;
        *(h16x4*)(mix + mrow * D + 512 + (g * 4 + hh) * 64 + 16 * dt + 4 * kg) = __builtin_convertvector(o, h16x4); }
#undef GLDS16
}

__device__ __forceinline__ void b_ln(const float* __restrict__ in, const float* __restrict__ gam, const float* __restrict__ bet, float* __restrict__ o32, h16* __restrict__ o16) {
    const int lane = tidx() & 63;
    for (int row = blockIdx.x * 8 + (tidx() >> 6); row < M; row += gridDim.x * 8) {
        const f32x4* xr = (const f32x4*)(in + (size_t)row * D) + lane;
        f32x4 v[4]; float s = 0.f;
#pragma unroll
        for (int j = 0; j < 4; ++j) { v[j] = xr[64 * j]; s += (v[j][0] + v[j][1]) + (v[j][2] + v[j][3]); }
        const float mean = wave_sum(s) * (1.f / D); float s2 = 0.f;
#pragma unroll
        for (int j = 0; j < 4; ++j) { v[j] = v[j] - mean; s2 += (v[j][0] * v[j][0] + v[j][1] * v[j][1]) + (v[j][2] * v[j][2] + v[j][3] * v[j][3]); }
        const float rstd = rsqrtf(wave_sum(s2) * (1.f / D) + LN_EPS);
#pragma unroll
        for (int j = 0; j < 4; ++j) { const f32x4 gg = ((const f32x4*)gam)[lane + 64 * j], bb = ((const f32x4*)bet)[lane + 64 * j]; const f32x4 o = v[j] * rstd * gg + bb;
            ((f32x4*)(o32 + (size_t)row * D))[lane + 64 * j] = o;
            if (o16) ((h16x4*)(o16 + (size_t)row * D))[lane + 64 * j] = __builtin_convertvector(o, h16x4); }
    }
}

__device__ __forceinline__ void xattn_block(const h16* __restrict__ qx, const h16* __restrict__ kx, const h16* __restrict__ kvmVT, h16* __restrict__ ox, int G, int bid, LAS unsigned char* lds, int wv, int lane) {
    const int i = lane & 15, kg = lane >> 4;
    const int gki = ((i >> 1) & 1) | ((i >> 2) << 1), gvi = (i >> 1) & 7;
    const int ko0 = (8 * (i >> 2) + (i & 3)) * 512 + ((kg ^ gki) << 4), ko1 = (8 * (i >> 2) + (i & 3)) * 512 + (((kg + 4) ^ gki) << 4);
    const int vo0 = i * 128 + ((kg ^ gvi) << 4), vo1 = i * 128 + (((kg + 4) ^ gvi) << 4);
    const int t = wv * 64 + lane;
    int ksrc[4], vsrc[4];
#pragma unroll
    for (int pz = 0; pz < 4; ++pz) { const int q = pz * 512 + t;
        { const int row = q >> 5, cp = q & 31; const int gk = ((row >> 1) & 1) | (((row >> 3) & 3) << 1); ksrc[pz] = row * 512 + ((cp ^ gk) << 4); }
        { const int row = q >> 3, cp = q & 7; vsrc[pz] = row * 512 + ((cp ^ ((row >> 1) & 7)) << 4); } }
    const int nun = ((M / 128) * 4 - bid + G - 1) / G;
    const int ntile = nun * 4;
    auto issue = [&](int tix, int slot) { const int u = bid + G * (tix >> 2), grp = tix & 3; const int m0 = (u >> 2) * 128, hh = u & 3, b = m0 >> 13;
        const unsigned char* Kb = (const unsigned char*)(kx + ((size_t)(b * 4 + hh) * MEML + 64 * grp) * 256); const unsigned char* Vb = (const unsigned char*)(kvmVT + (size_t)((b * 4 + hh) * 256) * MEML + 64 * grp);
        LAS unsigned char* base = lds + slot * 65536 + wv * 1024;
#pragma unroll
        for (int pz = 0; pz < 4; ++pz) { __builtin_amdgcn_global_load_lds((const unsigned*)(Kb + ksrc[pz]), (LAS unsigned*)(base + pz * 8192), 16, 0, 0);
                                        __builtin_amdgcn_global_load_lds((const unsigned*)(Vb + vsrc[pz]), (LAS unsigned*)(base + 32768 + pz * 8192), 16, 0, 0); } };
    NSA_WAITV(0);
    if (ntile > 0) issue(0, 0);
    h16x8 qf[8]; f32x4 o[16]; float mrun = -1e30f, l = 0.f; size_t mrow = 0; int hh = 0;
    for (int tix = 0; tix < ntile; ++tix) {
        const int grp = tix & 3, slot = tix & 1;
        if (grp == 0) {
            const int u = bid + G * (tix >> 2); mrow = (size_t)((u >> 2) * 128 + wv * 16 + i); hh = u & 3;
#pragma unroll
            for (int ks = 0; ks < 8; ++ks) qf[ks] = *(const h16x8*)(qx + mrow * D + hh * 256 + 32 * ks + 8 * kg);
#pragma unroll
            for (int dt = 0; dt < 16; ++dt) o[dt] = (f32x4){0.f, 0.f, 0.f, 0.f};
            mrun = -1e30f; l = 0.f;
        }
        NSA_WAITV(0);
        NSA_BAR();
        if (tix + 1 < ntile) issue(tix + 1, slot ^ 1);
        LAS const unsigned char* sk = lds + slot * 65536; LAS const unsigned char* sv = sk + 32768;
        f32x4 s[4];
#pragma unroll
        for (int tl = 0; tl < 4; ++tl) { const int ro = (32 * (tl >> 1) + 4 * (tl & 1)) * 512; f32x4 acc = {0.f, 0.f, 0.f, 0.f};
#pragma unroll
            for (int ks = 0; ks < 8; ++ks) acc = __builtin_amdgcn_mfma_f32_16x16x32_f16(*(LAS const h16x8*)(sk + ro + 128 * (ks >> 1) + ((ks & 1) ? ko1 : ko0)), qf[ks], acc, 0, 0, 0);
            s[tl] = acc; }
        const float mx = att_rowmax(s) * (0.0625f * 1.4426950408889634f);
        const float mn = fmaxf(mrun, mx); const float alpha = __builtin_amdgcn_exp2f(mrun - mn); mrun = mn;
        float ps = 0.f; h16x8 pf[2];
#pragma unroll
        for (int tl = 0; tl < 4; ++tl)
#pragma unroll
            for (int r = 0; r < 4; ++r) { const float pe = __builtin_amdgcn_exp2f(__builtin_fmaf(s[tl][r], 0.0625f * 1.4426950408889634f, -mn)); ps += pe; pf[tl >> 1][4 * (tl & 1) + r] = (h16)pe; }
        l = l * alpha + ps;
#pragma unroll
        for (int dt = 0; dt < 16; ++dt) { f32x4 acc = o[dt] * alpha;
            acc = __builtin_amdgcn_mfma_f32_16x16x32_f16(*(LAS const h16x8*)(sv + dt * 2048 + vo0), pf[0], acc, 0, 0, 0);
            acc = __builtin_amdgcn_mfma_f32_16x16x32_f16(*(LAS const h16x8*)(sv + dt * 2048 + vo1), pf[1], acc, 0, 0, 0);
            o[dt] = acc; }
        if (grp == 3) { const float linv = 1.f / xsum4(l);
#pragma unroll
            for (int dt = 0; dt < 16; ++dt) { const f32x4 acc = o[dt] * linv; *(h16x4*)(ox + mrow * D + hh * 256 + 16 * dt + 4 * kg) = __builtin_convertvector(acc, h16x4); } }
    }
    NSA_WAITV(0);
    NSA_BAR();
}

__device__ __forceinline__ void route_token(float logit, int m, int lane, const float* __restrict__ rbias, int* __restrict__ tope, float* __restrict__ topw, int* __restrict__ hist) {
    const float score = 1.f / (1.f + expf(-logit)); const float biased = score + rbias[lane];
    float m1 = biased; m1 = fmaxf(m1, __shfl_xor(m1, 1)); m1 = fmaxf(m1, __shfl_xor(m1, 2)); m1 = fmaxf(m1, __shfl_xor(m1, 4));
    int am = (biased == m1) ? lane : 999; am = min(am, __shfl_xor(am, 1)); am = min(am, __shfl_xor(am, 2)); am = min(am, __shfl_xor(am, 4));
    float m2 = (lane == am) ? -INFINITY : biased; m2 = fmaxf(m2, __shfl_xor(m2, 1)); m2 = fmaxf(m2, __shfl_xor(m2, 2)); m2 = fmaxf(m2, __shfl_xor(m2, 4));
    const float gs = m1 + m2;
    int cnt = 0;
#pragma unroll
    for (int gq = 0; gq < 8; ++gq) { const float o = __shfl(gs, gq * 8); cnt += (o > gs) ? 1 : 0; }
    const float masked = (cnt <= 3) ? biased : NEGF;
    int rank = 0;
    for (int e2 = 0; e2 < 64; ++e2) { const float o = __shfl(masked, e2); rank += (o > masked || (o == masked && e2 < lane)) ? 1 : 0; }
    const bool selq = rank < 8;
    const float wsum = wave_sum(selq ? score : 0.f);
    if (selq) { tope[(size_t)m * 8 + rank] = lane; topw[(size_t)m * 8 + rank] = score / wsum * 2.5f; atomicAdd(hist + (m >> 13) * 65 + lane, 1); }
}
__device__ __forceinline__ void router_unit(const Params& p, const float* __restrict__ pre, h16* __restrict__ x2h, const h16* __restrict__ WrTh, const h16* __restrict__ WrTl, int* __restrict__ tope, float* __restrict__ topw,
                                            int* __restrict__ hist, int m0, LAS float* lg, int lane) {
    const int i = lane & 15, kg = lane >> 4;
    const float* xr = pre + (size_t)(m0 + i) * D + 8 * kg;
    float s1 = 0.f, s2 = 0.f;
#pragma unroll 4
    for (int ks = 0; ks < 32; ++ks) { const f32x4 x0 = *(const f32x4*)(xr + 32 * ks), x1 = *(const f32x4*)(xr + 32 * ks + 4);
        s1 += (x0[0] + x0[1]) + (x0[2] + x0[3]) + (x1[0] + x1[1]) + (x1[2] + x1[3]);
        s2 += (x0[0] * x0[0] + x0[1] * x0[1]) + (x0[2] * x0[2] + x0[3] * x0[3]) + (x1[0] * x1[0] + x1[1] * x1[1]) + (x1[2] * x1[2] + x1[3] * x1[3]); }
    s1 = xsum4(s1); s2 = xsum4(s2);
    const float mean = s1 * (1.f / D); const float rstd = rsqrtf(fmaxf(s2 * (1.f / D) - mean * mean, 0.f) + LN_EPS);
    f32x4 am_[4], ac_[4];
#pragma unroll
    for (int et = 0; et < 4; ++et) { am_[et] = (f32x4){0.f, 0.f, 0.f, 0.f}; ac_[et] = (f32x4){0.f, 0.f, 0.f, 0.f}; }
    h16* xo = x2h + (size_t)(m0 + i) * D + 8 * kg;
#pragma unroll 2
    for (int ks = 0; ks < 32; ++ks) {
        f32x4 x0 = *(const f32x4*)(xr + 32 * ks), x1 = *(const f32x4*)(xr + 32 * ks + 4);
        const f32x4 g0 = *(const f32x4*)(p.ln2g + 32 * ks + 8 * kg), g1 = *(const f32x4*)(p.ln2g + 32 * ks + 8 * kg + 4), b0 = *(const f32x4*)(p.ln2b + 32 * ks + 8 * kg), b1 = *(const f32x4*)(p.ln2b + 32 * ks + 8 * kg + 4);
        x0 = (x0 - mean) * rstd * g0 + b0; x1 = (x1 - mean) * rstd * g1 + b1;
        h16x8 xh, xl;
#pragma unroll
        for (int j = 0; j < 4; ++j) { xh[j] = (h16)x0[j]; xl[j] = (h16)((x0[j] - (float)xh[j]) * 2048.f); xh[4 + j] = (h16)x1[j]; xl[4 + j] = (h16)((x1[j] - (float)xh[4 + j]) * 2048.f); }
        *(h16x8*)(xo + 32 * ks) = xh;
#pragma unroll
        for (int et = 0; et < 4; ++et) { const h16x8 wh = *(const h16x8*)(WrTh + (size_t)(16 * et + i) * D + 32 * ks + 8 * kg), wl = *(const h16x8*)(WrTl + (size_t)(16 * et + i) * D + 32 * ks + 8 * kg);
            am_[et] = __builtin_amdgcn_mfma_f32_16x16x32_f16(wh, xh, am_[et], 0, 0, 0);
            ac_[et] = __builtin_amdgcn_mfma_f32_16x16x32_f16(wh, xl, ac_[et], 0, 0, 0);
            ac_[et] = __builtin_amdgcn_mfma_f32_16x16x32_f16(wl, xh, ac_[et], 0, 0, 0); }
    }
#pragma unroll
    for (int et = 0; et < 4; ++et)
#pragma unroll
        for (int r = 0; r < 4; ++r) lg[i * 64 + 16 * et + 4 * kg + r] = am_[et][r] + ac_[et][r] * (1.f / 2048.f);
    for (int tk = 0; tk < 16; ++tk) route_token(lg[tk * 64 + lane], m0 + tk, lane, p.rbias, tope, topw, hist);
}

__device__ __forceinline__ void b_moe(const Params& p, const float* __restrict__ x2, const int* __restrict__ tope, const float* __restrict__ topw, float* __restrict__ out, int m, float* sl, int tid) {
    float* xs = sl; float* hd = sl + 1024; float* red = sl + 1280;
    for (int i = tid; i < 1024; i += 256) xs[i] = x2[(size_t)m * D + i];
    __syncthreads();
    float acc[4] = {0.f, 0.f, 0.f, 0.f};
    for (int kx = 0; kx < 9; ++kx) {
        const float* G; const float* U; const float* Dn; float wt;
        if (kx < 8) { const int e = tope[(size_t)m * 8 + kx]; wt = topw[(size_t)m * 8 + kx]; G = p.w_gate + (size_t)e * D * EFF; U = p.w_up + (size_t)e * D * EFF; Dn = p.w_down + (size_t)e * EFF * D; }
        else { wt = 1.f; G = p.ws_gate; U = p.ws_up; Dn = p.ws_down; }
        float a = 0.f, u = 0.f;
        for (int k = 0; k < D; ++k) { const float xv = xs[k]; a += xv * G[(size_t)k * EFF + tid]; u += xv * U[(size_t)k * EFF + tid]; }
        hd[tid] = siluf(a) * u * wt;
        __syncthreads();
        for (int j = 0; j < EFF; ++j) { const float hv = hd[j]; const float* dr = Dn + (size_t)j * D + tid;
            acc[0] += hv * dr[0]; acc[1] += hv * dr[256]; acc[2] += hv * dr[512]; acc[3] += hv * dr[768]; }
        __syncthreads();
    }
    float v[4]; float s = 0.f;
#pragma unroll
    for (int i = 0; i < 4; ++i) { v[i] = DN_ALPHA * xs[tid + 256 * i] + acc[i]; s += v[i]; }
    s = wave_sum(s); if ((tid & 63) == 0) red[tid >> 6] = s; __syncthreads();
    const float mean = (red[0] + red[1] + red[2] + red[3]) * (1.f / D); float s2 = 0.f;
#pragma unroll
    for (int i = 0; i < 4; ++i) { v[i] -= mean; s2 += v[i] * v[i]; }
    s2 = wave_sum(s2); if ((tid & 63) == 0) red[4 + (tid >> 6)] = s2; __syncthreads();
    const float rstd = rsqrtf((red[4] + red[5] + red[6] + red[7]) * (1.f / D) + LN_EPS);
#pragma unroll
    for (int i = 0; i < 4; ++i) out[(size_t)m * D + tid + 256 * i] = v[i] * rstd * p.ln3g[tid + 256 * i] + p.ln3b[tid + 256 * i];
    __syncthreads();
}

struct G1Sched {
    const int* ctl; const char* x2h; const unsigned* rowoff; const char* WguT; int G, c;
    __device__ bool next(int i, pg8::Unit& u) const {
        const int ntile = ctl[CTL_TQS + NQ]; const long L = (long)i * G + c; if (L >= 2L * ntile) return false;
        const int tile = (int)(L >> 1), pn = (int)(L & 1); const int e = ctl[CTL_TVE + tile] % 65;
        u.pm = tile; u.pn = pn; u.A = x2h; u.gat = rowoff + (size_t)tile * 256; u.B = WguT + ((size_t)e * 512 + pn * 256) * (D * 2); return true; }
};
struct G2Sched {
    const int* ctl; const char* H; const char* WdT; int q, G, c;
    __device__ bool next(int i, pg8::Unit& u) const {
        const int t0 = ctl[CTL_TQS + q], t1 = ctl[CTL_TQS + q + 1]; const long L = (long)i * G + c; if (L >= 4L * (t1 - t0)) return false;
        const int tile = t0 + (int)(L >> 2), pn = (int)(L & 3); const int e = ctl[CTL_TVE + tile] % 65;
        u.pm = tile; u.pn = pn; u.A = H + (size_t)tile * 256 * (EFF * 2); u.gat = nullptr; u.B = WdT + ((size_t)e * D + pn * 256) * (EFF * 2); return true; }
};
__device__ __forceinline__ void b_scatter(int* __restrict__ ctl, const int* __restrict__ tope, const float* __restrict__ topw, unsigned* __restrict__ rowoff, u32x2* __restrict__ rowmeta, int* sl) {
    int* pst = sl;
    int* pc = sl + 512;
    for (int v = tidx(); v < NVE; v += NTHR) pc[v] = (ctl[CTL_CNT + v] + 255) & ~255;
    __syncthreads();
    for (int v = tidx(); v <= NVE; v += NTHR) { int acc = 0; for (int u = 0; u < v; ++u) acc += pc[u]; pst[v] = acc; }
    __syncthreads();
    if (blockIdx.x == 0) {
        for (int v = tidx(); v <= NVE; v += NTHR) ctl[CTL_PST + v] = pst[v];
        if (tidx() <= NQ) ctl[CTL_TQS + tidx()] = pst[tidx() * 65] >> 8;
        for (int v = tidx(); v < NVE; v += NTHR) for (int tl = pst[v] >> 8; tl < (pst[v + 1] >> 8); ++tl) ctl[CTL_TVE + tl] = v;
    }
    for (int idx = blockIdx.x * NTHR + tidx(); idx < M * 9; idx += gridDim.x * NTHR) {
        int m, k, pos; float w;
        if (idx < M * 8) { m = idx >> 3; k = idx & 7; const int ve = (m >> 13) * 65 + tope[idx]; w = topw[idx]; pos = pst[ve] + atomicAdd(ctl + CTL_CUR + ve, 1); }
        else { m = idx - M * 8; k = 8; w = 1.f; pos = pst[(m >> 13) * 65 + 64] + (m & (QT - 1)); }
        rowoff[pos] = (unsigned)m * (D * 2); rowmeta[pos] = (u32x2){(unsigned)((m & (QT - 1)) * 9 + k), __float_as_uint(w)};
    }
    __syncthreads();
}
__device__ __forceinline__ void b_combine(const Params& p, const h16* __restrict__ x2h, const h16* __restrict__ Y, int q) {
    const int lane = tidx() & 63;
    for (int r = blockIdx.x * 8 + (tidx() >> 6); r < QT; r += gridDim.x * 8) {
        const int m = q * QT + r;
        float v[16];
        { const h16x8 a = ((const h16x8*)(x2h + (size_t)m * D))[lane], b = ((const h16x8*)(x2h + (size_t)m * D))[lane + 64];
#pragma unroll
          for (int i = 0; i < 8; ++i) { v[i] = DN_ALPHA * (float)a[i]; v[8 + i] = DN_ALPHA * (float)b[i]; } }
#pragma unroll
        for (int k = 0; k < 9; ++k) { const h16x8* yr = (const h16x8*)(Y + ((size_t)r * 9 + k) * D); const h16x8 a = yr[lane], b = yr[lane + 64];
#pragma unroll
            for (int i = 0; i < 8; ++i) { v[i] += (float)a[i]; v[8 + i] += (float)b[i]; } }
        float s = 0.f;
#pragma unroll
        for (int i = 0; i < 16; ++i) s += v[i];
        const float mean = wave_sum(s) * (1.f / D); float s2 = 0.f;
#pragma unroll
        for (int i = 0; i < 16; ++i) { v[i] -= mean; s2 += v[i] * v[i]; }
        const float rstd = rsqrtf(wave_sum(s2) * (1.f / D) + LN_EPS);
#pragma unroll
        for (int hlf = 0; hlf < 2; ++hlf) { const int c0 = (lane + 64 * hlf) * 8;
            const f32x4 g0 = *(const f32x4*)(p.ln3g + c0), g1 = *(const f32x4*)(p.ln3g + c0 + 4), b0 = *(const f32x4*)(p.ln3b + c0), b1 = *(const f32x4*)(p.ln3b + c0 + 4);
            f32x4 o0, o1;
#pragma unroll
            for (int i = 0; i < 4; ++i) { o0[i] = v[8 * hlf + i] * rstd * g0[i] + b0[i]; o1[i] = v[8 * hlf + 4 + i] * rstd * g1[i] + b1[i]; }
            *(f32x4*)(p.out + (size_t)m * D + c0) = o0; *(f32x4*)(p.out + (size_t)m * D + c0 + 4) = o1; }
    }
}

#define XB_TMO      128
#define XB_XCNT(j)  (256  + 64 * (j))
#define XB_XSUB(j)  (1280 + 64 * (j))
#define XB_XGEN(j)  (2304 + 64 * (j))
#define XB_TOP      3328
#define XB_TOPGEN   3392
#define XCD_BAR_WORDS 3456
#define XB_SPIN_CAP (1u << 22)
__device__ __forceinline__ unsigned xb_ld(unsigned* p)              { return __hip_atomic_load(p, __ATOMIC_RELAXED, __HIP_MEMORY_SCOPE_AGENT); }
__device__ __forceinline__ unsigned xb_add(unsigned* p, unsigned v) { return __hip_atomic_fetch_add(p, v, __ATOMIC_RELAXED, __HIP_MEMORY_SCOPE_AGENT); }
__device__ __forceinline__ unsigned xb_xcc_id() { return (unsigned)__builtin_amdgcn_s_getreg((3 << 11) | 20) & 0xFu; }
#define XB_SPIN(cond, bar) do { unsigned _sp = 0; while (cond) { __builtin_amdgcn_s_sleep(1); \
    if ((++_sp & 255u) == 0u) { if (xb_ld(&(bar)[XB_TMO])) break; if (_sp > XB_SPIN_CAP) { atomicAdd(&(bar)[XB_TMO], 1u); break; } } } } while (0)
struct XcdBarrier { unsigned* bar; unsigned x; volatile LAS unsigned* st; };
__device__ __forceinline__ XcdBarrier xcd_barrier_post(unsigned* bar, volatile LAS unsigned* st) {
    XcdBarrier b; b.bar = bar; b.x = xb_xcc_id(); b.st = st;
    if (threadIdx.x == 0) (void)xb_add(&bar[XB_XCNT(b.x)], 1u);
    return b;
}
__device__ __forceinline__ void xcd_barrier_complete(unsigned* bar, unsigned x, unsigned& nloc, unsigned& nx) {
    const unsigned G = gridDim.x * gridDim.y * gridDim.z;
    unsigned sum, cnt, mine, sp = 0u;
    for (;;) {
        sum = 0u; cnt = 0u; mine = 0u;
#pragma unroll
        for (unsigned j = 0; j < 16; ++j) { const unsigned c = xb_ld(&bar[XB_XCNT(j)]); sum += c; cnt += (c > 0u) ? 1u : 0u; mine = (j == x) ? c : mine; }
        if (sum == G) break;
        __builtin_amdgcn_s_sleep(1);
        if ((++sp & 255u) == 0u) { if (xb_ld(&bar[XB_TMO])) break; if (sp > XB_SPIN_CAP) { atomicAdd(&bar[XB_TMO], 1u); break; } }
    }
    nloc = mine > 0u ? mine : 1u; nx = cnt > 0u ? cnt : 1u;
}
__device__ __forceinline__ void xcd_barrier(const XcdBarrier& b) {
    asm volatile("s_waitcnt vmcnt(0)" ::: "memory");
    __syncthreads();
    if (threadIdx.x == 0) {
        unsigned* bar = b.bar;
        __builtin_amdgcn_s_waitcnt(0);
        unsigned nloc = b.st[0], nx = b.st[1];
        if (nloc == 0u) { xcd_barrier_complete(bar, b.x, nloc, nx); b.st[0] = nloc; b.st[1] = nx; }
        const unsigned old = xb_add(&bar[XB_XSUB(b.x)], 1u);
        const unsigned gen = old / nloc;
        if (old + 1u == (gen + 1u) * nloc) {
            __builtin_amdgcn_fence(__ATOMIC_RELEASE, "agent");
            asm volatile("s_waitcnt vmcnt(0)" ::: "memory");
            const unsigned og = xb_add(&bar[XB_TOP], 1u);
            const unsigned tg = og / nx;
            if (og + 1u == (tg + 1u) * nx) xb_add(&bar[XB_TOPGEN], 1u);
            else XB_SPIN(xb_ld(&bar[XB_TOPGEN]) == tg, bar);
            __builtin_amdgcn_fence(__ATOMIC_ACQUIRE, "agent");
            xb_add(&bar[XB_XGEN(b.x)], 1u);
            asm volatile("s_waitcnt vmcnt(0)" ::: "memory");
        } else {
            XB_SPIN(xb_ld(&bar[XB_XGEN(b.x)]) == gen, bar);
            __builtin_amdgcn_fence(__ATOMIC_ACQUIRE, "agent");
            asm volatile("s_waitcnt vmcnt(0)" ::: "memory");
        }
    }
    __syncthreads();
}

constexpr int N_PHASES = 23;

__global__ void __launch_bounds__(NTHR, 2) mega_fwd(Params p) {
    extern __shared__ __attribute__((aligned(16))) unsigned char lds[];
    const int G = (int)gridDim.x, bid = (int)blockIdx.x;
#define tid tidx()
    unsigned char* ws = p.ws;
    h16* WinT = (h16*)(ws + WS_WIN); h16* WoutT = (h16*)(ws + WS_WOUT); h16* WxqT = (h16*)(ws + WS_WXQ); h16* WxoT = (h16*)(ws + WS_WXO); h16* WxkvT = (h16*)(ws + WS_WXKV);
    h16* memh = (h16*)(ws + WS_MEMH); h16* kvm = (h16*)(ws + WS_KVM); h16* kcmp = (h16*)(ws + WS_KCMP); h16* vcmpT = (h16*)(ws + WS_VCMP); h16* vsT = (h16*)(ws + WS_VST); h16* vwT = (h16*)(ws + WS_VWT);
    int* tope = (int*)(ws + WS_TOPE); float* topw = (float*)(ws + WS_TOPW);
    h16* xh = (h16*)(ws + WS_XH); h16* mix = (h16*)(ws + WS_MIX); h16* ox = (h16*)(ws + WS_OX); h16* hb = (h16*)(ws + WS_H); h16* nqr = (h16*)(ws + WS_NQR);
    float* kvb = (float*)(ws + WS_KVB); h16* prevT = (h16*)(ws + WS_PREVT);
    float* cosr = (float*)(ws + WS_COSR); float* sinr = (float*)(ws + WS_SINR); float* cosn = (float*)(ws + WS_COSN); float* sinn = (float*)(ws + WS_SINN); h16* kvmVT = (h16*)(ws + WS_KVMVT); h16* WrTh = (h16*)(ws + WS_WRTH); h16* WrTl = (h16*)(ws + WS_WRTL); h16* Wc1T = (h16*)(ws + WS_WC1T); h16* hid = (h16*)(ws + WS_HID); unsigned* cmpoff = (unsigned*)(ws + WS_CMPOFF); float* peb = (float*)(ws + WS_PEB); h16* ksR = (h16*)(ws + WS_KSR); h16* kwR = (h16*)(ws + WS_KWR); h16* kx = (h16*)(ws + WS_KX);
    h16* rqr = (h16*)((unsigned char*)p.out + DO_RQR); h16* rkr = (h16*)((unsigned char*)p.out + DO_RKR); h16* rkzT = (h16*)((unsigned char*)p.out + DO_RKZT); h16* rvT = (h16*)((unsigned char*)p.out + DO_RVT); float* pre = p.out; float* x1 = (float*)(ws + WS_X1); h16* x1h = (h16*)(ws + WS_X1H);
    h16* qx = (h16*)(ws + WS_QX); float* x2 = (float*)(ws + WS_X2); h16* x2h = (h16*)(ws + WS_X2H);
    int* ctl = (int*)ws; unsigned* rowoff = (unsigned*)(ws + WS_ROWOFF); u32x2* rowmeta = (u32x2*)(ws + WS_ROWMETA);
    h16* WguT = (h16*)(ws + WS_WGUT); h16* WdT = (h16*)(ws + WS_WDT); h16* Hm = (h16*)(ws + WS_HM); h16* Yq = (h16*)(ws + WS_Y);
    float* fl = (float*)lds;
    const int lo = p.ph_lo, hi = p.ph_hi;
#define IN(k) (lo <= (k) && (k) < hi)
    { volatile LAS unsigned* st = (volatile LAS unsigned*)((LAS unsigned char*)lds + 131072); if (threadIdx.x < 2) st[threadIdx.x] = 0u; }
    __syncthreads();
    XcdBarrier xbar = xcd_barrier_post((unsigned*)(ws + WS_BAR), (volatile LAS unsigned*)((LAS unsigned char*)lds + 131072));
#define SEAM(k) do { if (IN(k) && IN((k) + 1)) xcd_barrier(xbar); } while (0)

    if (IN(0)) REPS(0) {
        { const int sub = tid >> 8, lt = tid & 255; float* tl = fl + sub * 1088;
          constexpr int T0 = (INP / 32) * (D / 32);
          for (int b0 = bid * 2; b0 < T0; b0 += G * 2) b_transpose_tile(p.w_in, D, INC, WinT, INP, b0 + sub, tl, lt); }
        { const int wv = __builtin_amdgcn_readfirstlane(tid >> 6), lane = tid & 63; LAS float* scr = (LAS float*)((LAS unsigned char*)lds + wv * 8704);
          constexpr int I1 = (D / 64) * (D / 32), I4 = (D / 64) * (2 * D / 32), I5 = (2048 / 64) * (256 / 32), IT = 3 * I1 + I4 + 2 * I5;
          for (int it0 = bid * 8 + wv; it0 < IT; it0 += G * 8) { int it = it0;
            if (it < I1) { w_transpose_item(p.w_out, D, D, WoutT, it, scr, lane); continue; } it -= I1;
            if (it < I1) { w_transpose_item(p.w_xq, D, D, WxqT, it, scr, lane); continue; } it -= I1;
            if (it < I1) { w_transpose_item(p.w_xo, D, D, WxoT, it, scr, lane); continue; } it -= I1;
            if (it < I4) { w_transpose_item(p.w_xkv, D, 2 * D, WxkvT, it, scr, lane); continue; } it -= I4;
            if (it < I5) { w_transpose_item(p.w1k, 2048, 256, Wc1T, it, scr, lane); continue; } it -= I5;
            w_transpose_item(p.w1v, 2048, 256, Wc1T + 256 * 2048, it, scr, lane); } }
        __syncthreads();
        b_cvt(p.x, xh, (size_t)M * D / 4);
        b_cvt(p.mem, memh, (size_t)NB * MEML * D / 4);
        if (bid == 0) for (int i = tid; i < 1024; i += NTHR) ctl[i] = 0;
        b_tables(p.positions, cosr, sinr, cosn, sinn, (LAS float*)((LAS unsigned char*)lds));
        for (int idx = bid * NTHR + tid; idx < NE * D; idx += G * NTHR) { const int e = idx >> 10, k = idx & 1023; const float w = p.w_router[k * NE + e]; const h16 hi = (h16)w; WrTh[idx] = hi; WrTl[idx] = (h16)((w - (float)hi) * 2048.f); }
        for (int r = bid * NTHR + tid; r < 4096; r += G * NTHR) { const int g = r & 1, c = min((r >> 1) & 511, 510), b = r >> 10; cmpoff[r] = (unsigned)(((size_t)(b * T + 16 * c) * INP + g * 64) * 2); }
        { const int lane = tid & 63;
          for (int o = bid * 8 + (tid >> 6); o < 512; o += G * 8) { const int kv = o >> 8, j = o & 255; const float* pe = kv ? p.pe_v : p.pe_k; const float* w1 = kv ? p.w1v : p.w1k; float a = 0.f;
              for (int k = lane; k < 2048; k += 64) a += pe[k] * w1[(size_t)k * 256 + j];
              a = wave_sum(a); if (lane == 0) peb[o] = a; } }
    }
    SEAM(0);
    if (IN(1)) {
        REPS(1) { pg8::Gemm g{xh, WinT, M, INP, D}; pg8::StaticOrder S; S.init(g, G, bid); pg8::EpiF16 E{hb, INP};
          pg8::gemm_phase<pg8::EpiF16, pg8::StaticOrder>((PG8_LAS unsigned char*)lds, g.K, S, E); }
    }
    SEAM(1);
    if (IN(2)) REPS(2) {
        if (bid < 32) { CmpSched S{(const char*)hb, cmpoff, (const char*)Wc1T, bid}; pg8::EpiCmp1 E{hid, peb + (bid >> 4) * 256};
            pg8::gemm_phase<pg8::EpiCmp1, CmpSched>((PG8_LAS unsigned char*)lds, 2048, S, E, (size_t)INP * 2);
            pg8::Gemm g{memh, WxkvT, NB * MEML, 2 * D, D}; pg8::StaticOrder S2; S2.init(g, 32, bid); pg8::EpiF16 E2{kvm, 2 * D};
            pg8::gemm_phase<pg8::EpiF16, pg8::StaticOrder>((PG8_LAS unsigned char*)lds, g.K, S2, E2); }
        else { const int sub = tid >> 8, lt = tid & 255; const int b2 = bid - 32, G2 = G - 32;
        { const int wv = __builtin_amdgcn_readfirstlane(tid >> 6), lane = tid & 63; LAS h16* wsl = (LAS h16*)((LAS unsigned char*)lds + wv * 8704);
          for (int m0 = (b2 * 8 + wv) * 2; m0 < M; m0 += G2 * 16) { w_rope(hb, rqr, rkr, nqr, ksR, kwR, cosr, sinr, cosn, sinn, m0, lane); w_rope(hb, rqr, rkr, nqr, ksR, kwR, cosr, sinr, cosn, sinn, m0 + 1, lane); }
          for (int it = b2 * 8 + wv; it < 2 * NB * 2 * 128; it += G2 * 8) b_vtrans(hb, vsT, vwT, it, wsl, lane);
          for (int it = b2 * 8 + wv; it < NB * 4 * 256; it += G2 * 8) b_rtrans(p, hb, rvT, rkzT, cosr, sinr, it, wsl, lane); }
        } }
    SEAM(2);
    if (IN(3)) {
        REPS(30) b_cmp2(p, hid, kcmp, vcmpT);
        { const int sub = tid >> 8, lt = tid & 255;
          for (int b0 = bid * 2; b0 < NB * 4 * 16; b0 += G * 2) b_mvtrans(kvm, kvmVT, kx, b0 + sub, (h16*)(fl + sub * 2304), lt); }
        const int wv = __builtin_amdgcn_readfirstlane(tid >> 6), lane = tid & 63;
        REPS(31) for (int ch = bid; ch < NB * 4 * 64; ch += G) ret_kv_unit(rkzT, rvT, kvb, ch, wv, lane); }
    SEAM(3);
    if (IN(4)) {
        REPS(4) b_ret_scan(p, kvb, prevT);
        const int wv = __builtin_amdgcn_readfirstlane(tid >> 6), lane = tid & 63;
        __syncthreads();
        REPS(50) { const int bg = bid & 7;
            for (int k = bid >> 3; k < T / 32; k += (G >> 3)) nsa_block_unit(hb, nqr, kcmp, vcmpT, vsT, vwT, ksR, kwR, mix, bg >> 1, bg & 1, (T / 32 - 1 - k) * 32, (LAS unsigned char*)lds, wv, lane); }
    }
    SEAM(4);
    if (IN(5)) {
        const int wv = __builtin_amdgcn_readfirstlane(tid >> 6), lane = tid & 63;
        REPS(51) for (int ch = bid; ch < NB * 4 * 64; ch += G) ret_out_unit(p, hb, rqr, rkr, rvT, prevT, mix, ch, wv, lane);
    }
    SEAM(5);
    if (IN(6)) { pg8::Gemm g{mix, WoutT, M, D, D}; pg8::StaticOrder S; S.init(g, G, bid); pg8::EpiResF32 E{pre, p.x, D, DN_ALPHA};
        pg8::gemm_phase<pg8::EpiResF32, pg8::StaticOrder>((PG8_LAS unsigned char*)lds, g.K, S, E); }
    SEAM(6);
    if (PROBE_DBL == 900) { for (int k = 0; k < 20; ++k) xcd_barrier(xbar); }
    if (IN(7)) REPS(7) b_ln(pre, p.ln1g, p.ln1b, x1, x1h);
    SEAM(7);
    if (IN(8)) { pg8::Gemm g{x1h, WxqT, M, D, D}; pg8::StaticOrder S; S.init(g, G, bid); pg8::EpiF16 E{qx, D};
        pg8::gemm_phase<pg8::EpiF16, pg8::StaticOrder>((PG8_LAS unsigned char*)lds, g.K, S, E); }
    SEAM(8);
    if (IN(9)) { const int wv = __builtin_amdgcn_readfirstlane(tid >> 6), lane = tid & 63;
        REPS(9) xattn_block(qx, kx, kvmVT, ox, G, bid, (LAS unsigned char*)lds, wv, lane); }
    SEAM(9);
    if (IN(10)) { pg8::Gemm g{ox, WxoT, M, D, D}; pg8::StaticOrder S; S.init(g, G, bid); pg8::EpiResF32 E{pre, x1, D, DN_ALPHA};
        pg8::gemm_phase<pg8::EpiResF32, pg8::StaticOrder>((PG8_LAS unsigned char*)lds, g.K, S, E); }
    if (IN(10) && IN(12)) xcd_barrier(xbar);
    if (IN(12)) {
        { const int wv = __builtin_amdgcn_readfirstlane(tid >> 6), lane = tid & 63; LAS float* lg = (LAS float*)((LAS unsigned char*)lds + wv * 4096);
          for (int u = bid * 8 + wv; u < M / 16; u += G * 8) router_unit(p, pre, x2h, WrTh, WrTl, tope, topw, ctl + CTL_CNT, u * 16, lg, lane); }
        __syncthreads();
        if (bid == 0 && tid < NQ) ctl[CTL_CNT + tid * 65 + 64] = QT;
        for (int i = bid * NTHR + tid; i < CAP; i += G * NTHR) { rowoff[i] = 0u; rowmeta[i] = (u32x2){0xffffffffu, 0u}; }
        { const int wv = __builtin_amdgcn_readfirstlane(tid >> 6), lane = tid & 63; LAS float* scr = (LAS float*)((LAS unsigned char*)lds + wv * 8704);
          REPS(121) for (int it = bid * 8 + wv; it < 65 * 384; it += G * 8) { const int e = it / 384, r = it % 384;
            const float* wg = e < 64 ? p.w_gate + (size_t)e * D * EFF : p.ws_gate; const float* wu = e < 64 ? p.w_up + (size_t)e * D * EFF : p.ws_up; const float* wd = e < 64 ? p.w_down + (size_t)e * EFF * D : p.ws_down;
            if (r < 128) w_transpose_item(wg, D, EFF, WguT + (size_t)e * 512 * D, r, scr, lane, 2, 0);
            else if (r < 256) w_transpose_item(wu, D, EFF, WguT + (size_t)e * 512 * D, r - 128, scr, lane, 2, 1);
            else w_transpose_item(wd, EFF, D, WdT + (size_t)e * D * EFF, r - 256, scr, lane); } }
    }
    SEAM(12);
    if (IN(13)) b_scatter(ctl, tope, topw, rowoff, rowmeta, (int*)lds);
    SEAM(13);
    if (IN(14)) REPS(14) { G1Sched S{ctl, (const char*)x2h, rowoff, (const char*)WguT, G, bid}; pg8::EpiGateUp E{Hm};
        pg8::gemm_phase<pg8::EpiGateUp, G1Sched>((PG8_LAS unsigned char*)lds, D, S, E); }
    SEAM(14);
#pragma unroll 1
    for (int q = 0; q < NQ; ++q) {
        if (IN(15 + 2 * q)) REPS(15) { G2Sched S{ctl, (const char*)Hm, (const char*)WdT, q, G, bid}; pg8::EpiDown E{Yq, rowmeta};
            pg8::gemm_phase<pg8::EpiDown, G2Sched>((PG8_LAS unsigned char*)lds, EFF, S, E); }
        SEAM(15 + 2 * q);
        if (IN(16 + 2 * q)) REPS(16) b_combine(p, x2h, Yq, q);
        if (q < NQ - 1) SEAM(16 + 2 * q);
    }
#undef IN
#undef SEAM
#undef tid
}

#ifndef MK_PER_PHASE
#define MK_PER_PHASE 0
#endif
extern "C" void kernel_launch(void* const* d_in, const int* in_sizes, int n_in, void* d_out, int out_size, void* d_ws, size_t ws_size, hipStream_t stream) {
    static int grid = 0;
    if (grid == 0) {
        if (n_in != 28 || in_sizes[0] != M * D || out_size != M * D || ws_size < WS_NEED) { fprintf(stderr, "kernel_launch: unexpected shapes (n_in %d, in0 %d, out %d, ws %zu)\n", n_in, n_in > 0 ? in_sizes[0] : -1, out_size, ws_size); grid = -1; return; }
        if (hipFuncSetAttribute((const void*)mega_fwd, hipFuncAttributeMaxDynamicSharedMemorySize, LDS_BYTES) != hipSuccess) { fprintf(stderr, "kernel_launch: hipFuncSetAttribute failed\n"); grid = -1; return; }
        int dev = 0, cus = 0, per_cu = 0;
        hipGetDevice(&dev); hipDeviceGetAttribute(&cus, hipDeviceAttributeMultiprocessorCount, dev);
        if (hipOccupancyMaxActiveBlocksPerMultiprocessor(&per_cu, (const void*)mega_fwd, NTHR, LDS_BYTES) != hipSuccess || per_cu < 1) { fprintf(stderr, "kernel_launch: occupancy query failed (%d)\n", per_cu); grid = -1; return; }
        grid = cus;
    }
    if (grid < 0) return;
    Params p{};
    p.x = (const float*)d_in[0]; p.mem = (const float*)d_in[1]; p.positions = (const int*)d_in[2];
    p.w_in = (const float*)d_in[3]; p.pe_k = (const float*)d_in[4]; p.pe_v = (const float*)d_in[5];
    p.w1k = (const float*)d_in[6]; p.w2k = (const float*)d_in[7]; p.w1v = (const float*)d_in[8]; p.w2v = (const float*)d_in[9];
    p.w_out = (const float*)d_in[10]; p.ln1g = (const float*)d_in[11]; p.ln1b = (const float*)d_in[12];
    p.w_xq = (const float*)d_in[13]; p.w_xkv = (const float*)d_in[14]; p.w_xo = (const float*)d_in[15];
    p.ln2g = (const float*)d_in[16]; p.ln2b = (const float*)d_in[17]; p.w_router = (const float*)d_in[18]; p.rbias = (const float*)d_in[19];
    p.w_gate = (const float*)d_in[20]; p.w_up = (const float*)d_in[21]; p.w_down = (const float*)d_in[22];
    p.ws_gate = (const float*)d_in[23]; p.ws_up = (const float*)d_in[24]; p.ws_down = (const float*)d_in[25];
    p.ln3g = (const float*)d_in[26]; p.ln3b = (const float*)d_in[27];
    p.out = (float*)d_out; p.ws = (unsigned char*)d_ws;
    for (int i = 0; i < 4; ++i) p.lg[i] = (float)std::log(1.0 - std::pow(2.0, -5.0 - (double)i));
#if MK_PER_PHASE
    for (int ph = 0; ph < N_PHASES; ++ph) { p.ph_lo = ph; p.ph_hi = ph + 1; hipLaunchKernelGGL(mega_fwd, dim3(grid), dim3(NTHR), LDS_BYTES, stream, p); }
#else
    p.ph_lo = 0; p.ph_hi = N_PHASES;
    if (hipMemsetAsync((char*)d_ws + WS_BAR, 0, XCD_BAR_WORDS * 4, stream) != hipSuccess) { fprintf(stderr, "kernel_launch: memset failed\n"); return; }
    hipLaunchKernelGGL(mega_fwd, dim3(grid), dim3(NTHR), LDS_BYTES, stream, p);
#endif
}
```

```cpp
#include <hip/hip_runtime.h>
#include <cstdio>
#include <cstdint>
#include <cmath>

typedef _Float16 h16;
typedef _Float16 h16x8 __attribute__((ext_vector_type(8)));
typedef _Float16 h16x2 __attribute__((ext_vector_type(2)));
typedef _Float16 h16x4 __attribute__((ext_vector_type(4)));
typedef float f32x2 __attribute__((ext_vector_type(2)));
typedef float f32x4 __attribute__((ext_vector_type(4)));
typedef unsigned u32x4 __attribute__((ext_vector_type(4)));
typedef unsigned u32x2 __attribute__((ext_vector_type(2)));

__device__ __forceinline__ int tidx() { int t = (int)threadIdx.x; asm volatile("" : "+v"(t)); return t; }

#ifndef PROBE_DBL
#define PROBE_DBL -1
#endif
#define REPS(k) for (int _rep = 0; _rep < ((PROBE_DBL) == (k) ? 2 : 1); ++_rep)

constexpr int NB = 4, T = 8192, D = 1024, M = NB * T;
constexpr int INC = 3352, INP = 3584;
constexpr int C_RQ = 0, C_RK = 512, C_RV = 1024, C_RG = 1536, C_NQ = 2048, C_NKC = 2560, C_NVC = 2688, C_NKS = 2816, C_NVS = 2944, C_NKW = 3072, C_NVW = 3200, C_NG = 3328;
constexpr int MEML = 256;
constexpr int NE = 64, EFF = 256;
constexpr float LN_EPS = 1e-5f;
constexpr float DN_ALPHA = 1.189207115002721f;
constexpr float NEGF = -1e30f;

constexpr size_t MiB = 1u << 20;
constexpr size_t WS_WIN = 1 * MiB, WS_WOUT = 8 * MiB, WS_WXQ = 10 * MiB, WS_WXO = 12 * MiB, WS_WXKV = 14 * MiB, WS_MEMH = 18 * MiB, WS_KVM = 20 * MiB;
constexpr size_t WS_KCMP = 24 * MiB, WS_VCMP = 25 * MiB, WS_TOPE = 26 * MiB, WS_TOPW = 27 * MiB;
constexpr size_t WS_XH = 32 * MiB, WS_MIX = 32 * MiB, WS_OX = 32 * MiB;
constexpr size_t WS_H = 96 * MiB, WS_NQR = 320 * MiB, WS_KVB = 352 * MiB, WS_PREV = 416 * MiB;
constexpr size_t WS_PRE = 96 * MiB, WS_X1 = 224 * MiB, WS_X1H = 352 * MiB, WS_QX = 416 * MiB, WS_X2 = 130 * MiB;
constexpr size_t WS_X2H = 32 * MiB, WS_WDT = 96 * MiB, WS_HM = 130 * MiB, WS_WGUT = 306 * MiB, WS_Y = 306 * MiB;
constexpr size_t WS_ROWOFF = 1 * MiB, WS_ROWMETA = 3 * MiB;
constexpr size_t WS_VST = 480 * MiB, WS_VWT = 488 * MiB, WS_COSR = 496 * MiB, WS_SINR = 504 * MiB, WS_COSN = 28 * MiB, WS_SINN = 29 * MiB, WS_KVMVT = 30 * MiB;
constexpr size_t WS_SC = 131072 + 32768, WS_TC = 131072 + 32768 + 4096, WS_GB1 = 131072 + 32768 + 8192;
constexpr size_t WS_WRTH = 262144, WS_WRTL = 393216;
constexpr size_t WS_WC1T = 464 * MiB, WS_HID = 466 * MiB, WS_CMPOFF = 131072, WS_PEB = 131072 + 16384;
constexpr size_t WS_PREVT = 416 * MiB, WS_KSR = 448 * MiB, WS_KWR = 456 * MiB, WS_KX = 26 * MiB;
constexpr size_t DO_RQR = 0, DO_RKR = 32 * MiB, DO_RKZT = 64 * MiB, DO_RVT = 96 * MiB;
constexpr size_t WS_NEED = 512 * MiB;
constexpr int NQ = 4, QT = M / NQ, NVE = NQ * 65, CAP_TILES = 1412, CAP = CAP_TILES * 256;
constexpr size_t WS_BAR = 65536;
constexpr int CTL_CNT = 0, CTL_CUR = 512, CTL_PST = 1024, CTL_TQS = 1536, CTL_TVE = 2048;

__device__ __forceinline__ float fsilu(float v) { return v * __builtin_amdgcn_rcpf(1.f + __expf(-v)); }
namespace pg8 {
#define PG8_LAS __attribute__((address_space(3)))
typedef short s16x8 __attribute__((ext_vector_type(8)));
constexpr int BM = 256, BK = 64, HALF = 128, HTB = HALF * BK * 2, STAGE_BYTES = 8 * HTB, NXCD = 8, WGM = 8;
__host__ __device__ __forceinline__ int lds_byte(int r, int c) { const int st = (r >> 4) * 2 + (c >> 5), rr = r & 15, cc = c & 31, ob = rr * 64 + cc * 2; return st * 1024 + (ob ^ (((ob >> 9) & 1) << 5)); }
__host__ __device__ __forceinline__ void stage_rc(int b, int& R, int& C) { const int st = b / 1024, sb = b % 1024, swz = sb ^ (((sb >> 9) & 1) << 5); R = (st >> 1) * 16 + swz / 64; C = (st & 1) * 32 + (swz % 64) / 2; }
__host__ __device__ __forceinline__ int perm32(int rho) { const int n = rho >> 4, i = rho & 15; return 8 * (i >> 2) + 4 * n + (i & 3); }
struct Unit { int pm, pn; const char* A; const char* B; const unsigned* gat; };
struct Gemm { const h16* A; const h16* Bt; int M, N, K; };
struct StaticOrder {
    int nM, nN, nwg, G, c; const char* A; const char* B; size_t tstep;
    __device__ void init(const Gemm& g, int G_, int c_) { nM = g.M / BM; nN = g.N / BM; nwg = nM * nN; G = G_; c = c_; A = (const char*)g.A; B = (const char*)g.Bt; tstep = (size_t)BM * g.K * 2; }
    __device__ bool next(int i, Unit& u) const {
        const long L = (long)i * G + c; if (L >= nwg) return false;
        int wgid = (int)L; { const int q = nwg / NXCD, r = nwg % NXCD, xcd = wgid % NXCD, off = wgid / NXCD; wgid = (xcd < r ? xcd * (q + 1) : r * (q + 1) + (xcd - r) * q) + off; }
        const int nig = WGM * nN, gid = wgid / nig, fm = gid * WGM, gsz = (nM - fm) < WGM ? (nM - fm) : WGM;
        u.pm = fm + ((wgid % nig) % gsz); u.pn = (wgid % nig) / gsz; u.A = A + (size_t)u.pm * tstep; u.B = B + (size_t)u.pn * tstep; u.gat = nullptr; return true;
    }
};
__device__ __forceinline__ unsigned cvt_pk_f16(float lo, float hi) { f32x2 v = {lo, hi}; h16x2 h = __builtin_convertvector(v, h16x2); return __builtin_bit_cast(unsigned, h); }

struct EpiF16 {
    static constexpr bool PERM = true;
    h16* O; int ldc;
    __device__ __forceinline__ void operator()(const f32x4 (&acc)[2][2][4][2], const Unit& u, int wr, int wc, int fr, int fq) const {
        const int row0 = u.pm * BM + wr * 64 + fr; const int col0 = u.pn * BM + wc * 32 + 8 * fq;
#pragma unroll
        for (int ai = 0; ai < 2; ++ai)
#pragma unroll
            for (int m = 0; m < 4; ++m) { h16* rowp = O + (size_t)(row0 + ai * HALF + m * 16) * ldc + col0;
#pragma unroll
                for (int bj = 0; bj < 2; ++bj) { const f32x4 v0 = acc[ai][bj][m][0], v1 = acc[ai][bj][m][1];
                    *(h16x8*)(rowp + bj * HALF) = __builtin_convertvector(__builtin_shufflevector(v0, v1, 0, 1, 2, 3, 4, 5, 6, 7), h16x8); } }
    }
};
__device__ __forceinline__ float rsum4(float v) {
    auto a = __builtin_amdgcn_permlane16_swap(__float_as_uint(v), __float_as_uint(v), false, false); v = __uint_as_float(a[0]) + __uint_as_float(a[1]);
    auto c = __builtin_amdgcn_permlane32_swap(__float_as_uint(v), __float_as_uint(v), false, false); return __uint_as_float(c[0]) + __uint_as_float(c[1]); }
struct EpiResStats {
    static constexpr bool PERM = false;
    h16* Vh; const float* R; int ldc; float alpha; f32x2* st;
    __device__ __forceinline__ void operator()(const f32x4 (&acc)[2][2][4][2], const Unit& u, int wr, int wc, int fr, int fq) const {
        const int row0 = u.pm * BM + wr * 64 + fr, col0 = u.pn * BM + wc * 32 + 4 * fq;
#pragma unroll
        for (int ai = 0; ai < 2; ++ai)
#pragma unroll
            for (int m = 0; m < 4; ++m) { const int row = row0 + ai * HALF + m * 16; const size_t off = (size_t)row * ldc + col0; float s = 0.f, q = 0.f;
#pragma unroll
                for (int bj = 0; bj < 2; ++bj)
#pragma unroll
                    for (int n = 0; n < 2; ++n) { const f32x4 r = *(const f32x4*)(R + off + bj * HALF + n * 16); const f32x4 v = r * alpha + acc[ai][bj][m][n];
                        *(h16x4*)(Vh + off + bj * HALF + n * 16) = __builtin_convertvector(v, h16x4);
                        s += (v[0] + v[1]) + (v[2] + v[3]); q += (v[0] * v[0] + v[1] * v[1]) + (v[2] * v[2] + v[3] * v[3]); }
                s = rsum4(s); q = rsum4(q);
                if (fq == 0) st[(size_t)row * 16 + u.pn * 4 + wc] = (f32x2){s, q}; }
    }
};
__device__ __forceinline__ void row_stats(const f32x2* st, int row, int fq, float& mean, float& rstd) {
    float s = 0.f, q = 0.f;
#pragma unroll
    for (int k = 0; k < 4; ++k) { const f32x2 pz = st[(size_t)row * 16 + 4 * fq + k]; s += pz[0]; q += pz[1]; }
    s = rsum4(s); q = rsum4(q);
    mean = s * (1.f / 1024.f); rstd = rsqrtf(fmaxf(q * (1.f / 1024.f) - mean * mean, 0.f) + 1e-5f);
}
struct EpiQLn {
    static constexpr bool PERM = true;
    h16* O; int ldc; const f32x2* st; const float* sc; const float* tc; f32x2* stf;
    __device__ __forceinline__ void operator()(const f32x4 (&acc)[2][2][4][2], const Unit& u, int wr, int wc, int fr, int fq) const {
        const int row0 = u.pm * BM + wr * 64 + fr; const int col0 = u.pn * BM + wc * 32 + 8 * fq;
        float mean8[2][4], rstd8[2][4];
#pragma unroll
        for (int ai = 0; ai < 2; ++ai)
#pragma unroll
            for (int m = 0; m < 4; ++m) { const int row = row0 + ai * HALF + m * 16; row_stats(st, row, fq, mean8[ai][m], rstd8[ai][m]);
                if (u.pn == 0 && wc == 0 && fq == 0) stf[row] = (f32x2){mean8[ai][m], rstd8[ai][m]}; }
#pragma unroll
        for (int bj = 0; bj < 2; ++bj) { const int c = col0 + bj * HALF;
            const f32x4 sc0 = *(const f32x4*)(sc + c), sc1 = *(const f32x4*)(sc + c + 4), tc0 = *(const f32x4*)(tc + c), tc1 = *(const f32x4*)(tc + c + 4);
#pragma unroll
            for (int ai = 0; ai < 2; ++ai)
#pragma unroll
                for (int m = 0; m < 4; ++m) { const int row = row0 + ai * HALF + m * 16; const float mean = mean8[ai][m], rstd = rstd8[ai][m];
                    const f32x4 v0 = (acc[ai][bj][m][0] - sc0 * mean) * rstd + tc0, v1 = (acc[ai][bj][m][1] - sc1 * mean) * rstd + tc1;
                    *(h16x8*)(O + (size_t)row * ldc + c) = __builtin_convertvector(__builtin_shufflevector(v0, v1, 0, 1, 2, 3, 4, 5, 6, 7), h16x8); } }
    }
};
struct EpiResLn {
    static constexpr bool PERM = false;
    float* C; const h16* Vh; const f32x2* stf; const float* gb;
    static constexpr int ldc = 1024; static constexpr float alpha = 1.189207115002721f;
    __device__ __forceinline__ void operator()(const f32x4 (&acc)[2][2][4][2], const Unit& u, int wr, int wc, int fr, int fq) const {
        const int row0 = u.pm * BM + wr * 64 + fr, col0 = u.pn * BM + wc * 32 + 4 * fq;
        f32x2 ms8[2][4];
#pragma unroll
        for (int ai = 0; ai < 2; ++ai)
#pragma unroll
            for (int m = 0; m < 4; ++m) ms8[ai][m] = stf[row0 + ai * HALF + m * 16];
#pragma unroll
        for (int ai = 0; ai < 2; ++ai)
#pragma unroll
            for (int m = 0; m < 4; ++m) { const int row = row0 + ai * HALF + m * 16; const size_t off = (size_t)row * ldc + col0; const float mean = ms8[ai][m][0], rstd = ms8[ai][m][1];
#pragma unroll
                for (int bj = 0; bj < 2; ++bj)
#pragma unroll
                    for (int n = 0; n < 2; ++n) { const int c = col0 + bj * HALF + n * 16; const f32x4 v = __builtin_convertvector(*(const h16x4*)(Vh + off + bj * HALF + n * 16), f32x4);
                        const f32x4 x1 = (v - mean) * rstd * *(const f32x4*)(gb + c) + *(const f32x4*)(gb + 1024 + c);
                        *(f32x4*)(C + off + bj * HALF + n * 16) = x1 * alpha + acc[ai][bj][m][n]; } }
    }
};
struct EpiCmp1 {
    static constexpr bool PERM = true;
    h16* O; const float* peb;
    __device__ __forceinline__ void operator()(const f32x4 (&acc)[2][2][4][2], const Unit& u, int wr, int wc, int fr, int fq) const {
        const int row0 = u.pm * BM + wr * 64 + fr; const int col0 = wc * 32 + 8 * fq;
#pragma unroll
        for (int bj = 0; bj < 2; ++bj) { const f32x4 b0 = *(const f32x4*)(peb + col0 + bj * HALF), b1 = *(const f32x4*)(peb + col0 + bj * HALF + 4);
#pragma unroll
            for (int ai = 0; ai < 2; ++ai)
#pragma unroll
                for (int m = 0; m < 4; ++m) { f32x4 v0 = acc[ai][bj][m][0] + b0, v1 = acc[ai][bj][m][1] + b1;
#pragma unroll
                    for (int r = 0; r < 4; ++r) { v0[r] = fsilu(v0[r]); v1[r] = fsilu(v1[r]); }
                    *(h16x8*)(O + (size_t)(row0 + ai * HALF + m * 16) * 256 + col0 + bj * HALF) = __builtin_convertvector(__builtin_shufflevector(v0, v1, 0, 1, 2, 3, 4, 5, 6, 7), h16x8); } }
    }
};
struct EpiGateUp {
    static constexpr bool PERM = true;
    h16* H;
    __device__ __forceinline__ void operator()(const f32x4 (&acc)[2][2][4][2], const Unit& u, int wr, int wc, int fr, int fq) const {
        const int row0 = u.pm * BM + wr * 64 + fr; const int col0 = u.pn * 128 + wc * 16 + 4 * fq;
#pragma unroll
        for (int ai = 0; ai < 2; ++ai)
#pragma unroll
            for (int m = 0; m < 4; ++m) { h16* rowp = H + (size_t)(row0 + ai * HALF + m * 16) * 256 + col0;
#pragma unroll
                for (int bj = 0; bj < 2; ++bj) { const f32x4 v0 = acc[ai][bj][m][0], v1 = acc[ai][bj][m][1];
                    const float h0 = fsilu(v0[0]) * v0[1], h1 = fsilu(v0[2]) * v0[3];
                    const float h2 = fsilu(v1[0]) * v1[1], h3 = fsilu(v1[2]) * v1[3];
                    *(h16x4*)(rowp + bj * 64) = __builtin_convertvector((f32x4){h0, h1, h2, h3}, h16x4); } }
    }
};
struct EpiDown {
    static constexpr bool PERM = true;
    h16* Y; const u32x2* rowmeta;
    __device__ __forceinline__ void operator()(const f32x4 (&acc)[2][2][4][2], const Unit& u, int wr, int wc, int fr, int fq) const {
        const int row0 = u.pm * BM + wr * 64 + fr; const int col0 = u.pn * BM + wc * 32 + 8 * fq;
        u32x2 md8[2][4];
#pragma unroll
        for (int ai = 0; ai < 2; ++ai)
#pragma unroll
            for (int m = 0; m < 4; ++m) md8[ai][m] = rowmeta[row0 + ai * HALF + m * 16];
#pragma unroll
        for (int ai = 0; ai < 2; ++ai)
#pragma unroll
            for (int m = 0; m < 4; ++m) { const int slot = (int)md8[ai][m].x; const float w8 = __uint_as_float(md8[ai][m].y);
                if (slot >= 0) { h16* rowp = Y + (size_t)slot * 1024 + col0;
#pragma unroll
                    for (int bj = 0; bj < 2; ++bj) { const f32x4 v0 = acc[ai][bj][m][0] * w8, v1 = acc[ai][bj][m][1] * w8;
                        *(h16x8*)(rowp + bj * HALF) = __builtin_convertvector(__builtin_shufflevector(v0, v1, 0, 1, 2, 3, 4, 5, 6, 7), h16x8); } } }
    }
};

template <class T> struct erp { static constexpr int v = 1; };
template <class T> struct krp { static constexpr int v = 1; };
#define PROBE_EPI(T, x) template <> struct erp<T> { static constexpr int v = (PROBE_DBL == 602 || PROBE_DBL == 602 + 10 * (x)) ? 2 : 1; }; template <> struct krp<T> { static constexpr int v = (PROBE_DBL == 601 || PROBE_DBL == 601 + 10 * (x)) ? 2 : 1; };
PROBE_EPI(EpiF16, 1) PROBE_EPI(EpiGateUp, 2) PROBE_EPI(EpiDown, 3)
#undef PROBE_EPI
template <class Epi, class Sched>
__device__ __forceinline__ void gemm_phase(PG8_LAS unsigned char* lds, const int K, const Sched S, const Epi E, const size_t kstepA = (size_t)(BK * 2)) {
    const int tid = tidx(), wid = __builtin_amdgcn_readfirstlane(tid >> 6), lane = tid & 63, wr = wid >> 2, wc = wid & 3, fr = lane & 15, fq = lane >> 4;
    const int nt = K / BK;
    int R0, C0; stage_rc(tid * 16, R0, C0);
    const unsigned cb2 = (unsigned)C0 * 2u;
    unsigned voffB[2];
#pragma unroll
    for (int i = 0; i < 2; ++i) { const int R = R0 + 64 * i; const int Rb = Epi::PERM ? ((R & ~31) + perm32(R & 31)) : R; voffB[i] = (unsigned)(Rb * K) * 2u + cb2; }
    const size_t kstep = (size_t)(BK * 2);
    const size_t hstep = (size_t)HALF * K * 2;
    const unsigned ldsw = (unsigned)wid * 1024u;
    const int aoff = lds_byte(wr * 64 + fr, fq * 8), boff = lds_byte(wc * 32 + fr, fq * 8);
#define PG8_MKVA(u, va) do { _Pragma("unroll") for (int _h = 0; _h < 2; ++_h) _Pragma("unroll") for (int _i = 0; _i < 2; ++_i) { const int _r = _h * HALF + R0 + 64 * _i; \
        (va)[_h][_i] = ((u).gat ? (u).gat[_r] : (unsigned)(_r * K) * 2u) + cb2; } } while (0)
#define PG8_SA(b, h) (((b) * 2 + (h)) * HTB)
#define PG8_SB(b, h) ((4 + (b) * 2 + (h)) * HTB)
#define PG8_STAGE(bufoff, gbase, voff) do { _Pragma("unroll") for (int _i = 0; _i < 2; ++_i) \
        __builtin_amdgcn_global_load_lds((const unsigned*)((const char*)(gbase) + (voff)[_i]), (PG8_LAS unsigned*)(lds + (bufoff) + ldsw + _i * 8192), 16, 0, 0); } while (0)
#define PG8_LDA(dst, b, h) do { _Pragma("unroll") for (int m = 0; m < 4; ++m) _Pragma("unroll") for (int k = 0; k < 2; ++k) dst[m][k] = *(const PG8_LAS s16x8*)(lds + PG8_SA(b, h) + aoff + m * 2048 + k * 1024); } while (0)
#define PG8_LDB(dst, b, h) do { _Pragma("unroll") for (int n = 0; n < 2; ++n) _Pragma("unroll") for (int k = 0; k < 2; ++k) dst[n][k] = *(const PG8_LAS s16x8*)(lds + PG8_SB(b, h) + boff + n * 2048 + k * 1024); } while (0)
#define PG8_MMA(ai, bj, At, Bt) do { __builtin_amdgcn_s_setprio(1); _Pragma("unroll") for (int m = 0; m < 4; ++m) _Pragma("unroll") for (int n = 0; n < 2; ++n) _Pragma("unroll") for (int k = 0; k < 2; ++k) \
        acc[ai][bj][m][n] = __builtin_amdgcn_mfma_f32_16x16x32_f16(__builtin_bit_cast(h16x8, Bt[n][k]), __builtin_bit_cast(h16x8, At[m][k]), acc[ai][bj][m][n], 0, 0, 0); __builtin_amdgcn_s_setprio(0); } while (0)
#define PG8_WAIT_V(n) asm volatile("s_waitcnt vmcnt(" #n ")" ::: "memory")
#define PG8_WAIT_L(n) asm volatile("s_waitcnt lgkmcnt(" #n ")" ::: "memory")
#define PG8_BAR __builtin_amdgcn_s_barrier()
#define PG8_SCHED __builtin_amdgcn_sched_barrier(0)
    Unit cur, nxt; int ui = 0;
    if (!S.next(0, cur)) return;
    unsigned va[2][2];
    PG8_MKVA(cur, va);
    f32x4 acc[2][2][4][2];
#pragma unroll
    for (int a = 0; a < 2; ++a)
#pragma unroll
        for (int b = 0; b < 2; ++b)
#pragma unroll
            for (int m = 0; m < 4; ++m)
#pragma unroll
                for (int n = 0; n < 2; ++n) acc[a][b][m][n] = (f32x4){0.f, 0.f, 0.f, 0.f};
    s16x8 At[4][2], B0[2][2], B1[2][2];
    const char* cA = cur.A; const char* cB = cur.B;
    {
        PG8_STAGE(PG8_SB(0, 0), cB, voffB); PG8_STAGE(PG8_SB(0, 1), cB + hstep, voffB); PG8_STAGE(PG8_SA(0, 0), cA, va[0]); PG8_STAGE(PG8_SA(0, 1), cA, va[1]);
        if (wr == 1) PG8_BAR;
        PG8_WAIT_V(2); PG8_BAR;
        PG8_STAGE(PG8_SB(1, 0), cB + kstep, voffB); PG8_STAGE(PG8_SA(1, 0), cA + kstepA, va[0]); PG8_STAGE(PG8_SB(1, 1), cB + hstep + kstep, voffB);
        PG8_WAIT_V(6); PG8_BAR;
    }
    for (;;) {
        const bool has_next = S.next(ui + 1, nxt);
        const char* nA = has_next ? nxt.A : cA; const char* nB = has_next ? nxt.B : cB;
#if PROBE_DBL >= 600 && PROBE_DBL < 640
        if (krp<Epi>::v == 2) {
#pragma unroll 1
        for (int t = 0; t < nt; t += 2) {
            const bool last = (t == nt - 2);
            const char* a1 = cA + (size_t)(t + 1) * kstepA;
            const char* a2 = last ? cA : cA + (size_t)(t + 2) * kstepA; const char* b2 = last ? cB : cB + (size_t)(t + 2) * kstep;
            const char* a3 = a2 + kstepA; const char* b3 = b2 + kstep;
            PG8_LDB(B0, 0, 0); PG8_LDB(B1, 0, 1); PG8_SCHED; PG8_LDA(At, 0, 0); PG8_STAGE(PG8_SA(1, 1), a1, va[1]);
            PG8_WAIT_V(8); PG8_WAIT_L(0); PG8_BAR; PG8_MMA(0, 0, At, B0); PG8_MMA(0, 1, At, B1); PG8_BAR; PG8_SCHED;
            PG8_LDA(At, 0, 1); PG8_STAGE(PG8_SB(0, 0), b2, voffB); PG8_STAGE(PG8_SB(0, 1), b2 + hstep, voffB); PG8_STAGE(PG8_SA(0, 0), a2, va[0]);
            PG8_WAIT_V(8); PG8_WAIT_L(0); PG8_BAR; PG8_MMA(1, 0, At, B0); PG8_MMA(1, 1, At, B1); PG8_BAR; PG8_SCHED;
            PG8_LDB(B0, 1, 0); PG8_LDB(B1, 1, 1); PG8_SCHED; PG8_LDA(At, 1, 0); PG8_STAGE(PG8_SA(0, 1), a2, va[1]);
            PG8_WAIT_V(8); PG8_WAIT_L(0); PG8_BAR; PG8_MMA(0, 0, At, B0); PG8_MMA(0, 1, At, B1); PG8_BAR; PG8_SCHED;
            PG8_LDA(At, 1, 1); PG8_STAGE(PG8_SB(1, 0), b3, voffB); PG8_STAGE(PG8_SB(1, 1), b3 + hstep, voffB); PG8_STAGE(PG8_SA(1, 0), a3, va[0]);
            PG8_WAIT_V(8); PG8_WAIT_L(0); PG8_BAR; PG8_MMA(1, 0, At, B0); PG8_MMA(1, 1, At, B1); PG8_BAR; PG8_SCHED;
        }
#pragma unroll
        for (int a = 0; a < 2; ++a)
#pragma unroll
            for (int b = 0; b < 2; ++b)
#pragma unroll
                for (int m = 0; m < 4; ++m)
#pragma unroll
                    for (int n = 0; n < 2; ++n) acc[a][b][m][n] = (f32x4){0.f, 0.f, 0.f, 0.f};
        }
#endif
#pragma unroll 1
        for (int t = 0; t < nt; t += 2) {
            const bool last = (t == nt - 2);
            const char* a1 = cA + (size_t)(t + 1) * kstepA;
            const char* a2 = last ? nA : cA + (size_t)(t + 2) * kstepA; const char* b2 = last ? nB : cB + (size_t)(t + 2) * kstep;
            const char* a3 = a2 + kstepA; const char* b3 = b2 + kstep;
            PG8_LDB(B0, 0, 0); PG8_LDB(B1, 0, 1); PG8_SCHED; PG8_LDA(At, 0, 0); PG8_STAGE(PG8_SA(1, 1), a1, va[1]);
            if (last && has_next) { PG8_MKVA(nxt, va); }
            PG8_WAIT_V(8); PG8_WAIT_L(0); PG8_BAR; PG8_MMA(0, 0, At, B0); PG8_MMA(0, 1, At, B1); PG8_BAR; PG8_SCHED;
            PG8_LDA(At, 0, 1); PG8_STAGE(PG8_SB(0, 0), b2, voffB); PG8_STAGE(PG8_SB(0, 1), b2 + hstep, voffB); PG8_STAGE(PG8_SA(0, 0), a2, va[0]);
            PG8_WAIT_V(8); PG8_WAIT_L(0); PG8_BAR; PG8_MMA(1, 0, At, B0); PG8_MMA(1, 1, At, B1); PG8_BAR; PG8_SCHED;
            PG8_LDB(B0, 1, 0); PG8_LDB(B1, 1, 1); PG8_SCHED; PG8_LDA(At, 1, 0); PG8_STAGE(PG8_SA(0, 1), a2, va[1]);
            PG8_WAIT_V(8); PG8_WAIT_L(0); PG8_BAR; PG8_MMA(0, 0, At, B0); PG8_MMA(0, 1, At, B1); PG8_BAR; PG8_SCHED;
            PG8_LDA(At, 1, 1); PG8_STAGE(PG8_SB(1, 0), b3, voffB); PG8_STAGE(PG8_SB(1, 1), b3 + hstep, voffB); PG8_STAGE(PG8_SA(1, 0), a3, va[0]);
            PG8_WAIT_V(8); PG8_WAIT_L(0); PG8_BAR; PG8_MMA(1, 0, At, B0); PG8_MMA(1, 1, At, B1); PG8_BAR; PG8_SCHED;
        }
        if (wr == 0) PG8_BAR;
#if PROBE_DBL >= 600 && PROBE_DBL < 640
#pragma unroll 1
        for (int erep = 0; erep < erp<Epi>::v; ++erep) { E(acc, cur, wr, wc, fr, fq); asm volatile("" ::: "memory"); }
#else
        E(acc, cur, wr, wc, fr, fq);
#endif
        if (!has_next) break;
#pragma unroll
        for (int a = 0; a < 2; ++a)
#pragma unroll
            for (int b = 0; b < 2; ++b)
#pragma unroll
                for (int m = 0; m < 4; ++m)
#pragma unroll
                    for (int n = 0; n < 2; ++n) acc[a][b][m][n] = (f32x4){0.f, 0.f, 0.f, 0.f};
        cur = nxt; cA = nA; cB = nB; ++ui;
        if (wr == 1) PG8_BAR;
    }
    PG8_WAIT_V(0);
    PG8_BAR;
#undef PG8_MKVA
#undef PG8_SA
#undef PG8_SB
#undef PG8_STAGE
#undef PG8_LDA
#undef PG8_LDB
#undef PG8_MMA
#undef PG8_WAIT_V
#undef PG8_WAIT_L
#undef PG8_BAR
#undef PG8_SCHED
}
}


#include <hip/hip_cooperative_groups.h>
namespace cg = cooperative_groups;
constexpr int NTHR = 512;
constexpr int LDS_BYTES = 147456;
#define LAS __attribute__((address_space(3)))

struct Params {
    const float *x, *mem; const int* positions;
    const float *w_in, *pe_k, *pe_v, *w1k, *w2k, *w1v, *w2v, *w_out, *ln1g, *ln1b, *w_xq, *w_xkv, *w_xo, *ln2g, *ln2b, *w_router, *rbias, *w_gate, *w_up, *w_down, *ws_gate, *ws_up, *ws_down, *ln3g, *ln3b;
    float* out; unsigned char* ws;
    float lg[4];
    int ph_lo, ph_hi;
};

template <int CTRL> __device__ __forceinline__ float dppf(float v) { return __builtin_bit_cast(float, __builtin_amdgcn_update_dpp(0, __builtin_bit_cast(int, v), CTRL, 0xf, 0xf, true)); }
template <int CTRL> __device__ __forceinline__ int dppi(int v) { return __builtin_amdgcn_update_dpp(0, v, CTRL, 0xf, 0xf, true); }
__device__ __forceinline__ float rlanef(float v, int l) { return __builtin_bit_cast(float, __builtin_amdgcn_readlane(__builtin_bit_cast(int, v), l)); }
__device__ __forceinline__ float wsum64(float v) { v += dppf<0xB1>(v); v += dppf<0x4E>(v); v += dppf<0x141>(v); v += dppf<0x140>(v);
    return (rlanef(v, 0) + rlanef(v, 16)) + (rlanef(v, 32) + rlanef(v, 48)); }
__device__ __forceinline__ float wave_sum(float v) { return wsum64(v); }
__device__ __forceinline__ float wave_max(float v) {
#pragma unroll
    for (int o = 1; o < 64; o <<= 1) v = fmaxf(v, __shfl_xor(v, o));
    return v;
}
__device__ __forceinline__ float siluf(float v) { return fsilu(v); }
__device__ __forceinline__ float sigmf(float v) { return __builtin_amdgcn_rcpf(1.f + __expf(-v)); }

__device__ __forceinline__ void b_transpose_tile(const float* __restrict__ W, int K, int N, h16* __restrict__ WT, int Npad, int tile, float* tl, int lt, int rs = 1, int ro = 0) {
    const int ntn = Npad / 32; const int n0 = (tile % ntn) * 32, k0 = (tile / ntn) * 32, tx = lt & 31, ty = lt >> 5;
    for (int i = ty; i < 32; i += 8) { const int k = k0 + i, n = n0 + tx; tl[i * 33 + tx] = (n < N) ? W[(size_t)k * N + n] : 0.f; }
    __syncthreads();
    for (int i = ty; i < 32; i += 8) { const int n = n0 + i, k = k0 + tx; WT[(size_t)(n * rs + ro) * K + k] = (h16)tl[tx * 33 + i]; }
    __syncthreads();
}
__device__ __forceinline__ void w_transpose_item(const float* __restrict__ W, int K, int N, h16* __restrict__ WT, int item, LAS float* scr, int lane, int rs = 1, int ro = 0, const float* __restrict__ kscale = nullptr) {
    const int nblk = N / 32, kb = item / nblk, nb = item % nblk, k0 = 64 * kb, n0 = 32 * nb;
#pragma unroll 8
    for (int i = 0; i < 32; ++i) { const int kk = 2 * i + (lane >> 5); scr[kk * 33 + (lane & 31)] = W[(size_t)(k0 + kk) * N + n0 + (lane & 31)]; }
    asm volatile("s_waitcnt lgkmcnt(0)" ::: "memory");
    const int c = lane & 7;
#pragma unroll
    for (int j = 0; j < 4; ++j) { const int n = (lane >> 3) + 8 * j; LAS const float* s = scr + (8 * c) * 33 + n; h16x8 o;
#pragma unroll
        for (int x = 0; x < 8; ++x) o[x] = (h16)(kscale ? s[x * 33] * kscale[k0 + 8 * c + x] : s[x * 33]);
        *(h16x8*)(WT + (size_t)((n0 + n) * rs + ro) * K + k0 + 8 * c) = o; }
    asm volatile("s_waitcnt lgkmcnt(0)" ::: "memory");
}
__device__ __forceinline__ void b_cvt(const float* __restrict__ x, h16* __restrict__ o, size_t n4) {
    for (size_t i = (size_t)blockIdx.x * NTHR + tidx(); i < n4; i += (size_t)gridDim.x * NTHR) {
        const f32x4 v = ((const f32x4*)x)[i]; ((h16x4*)o)[i] = __builtin_convertvector(v, h16x4); }
}

__device__ __forceinline__ void b_tables(const int* __restrict__ positions, float* __restrict__ cosr, float* __restrict__ sinr, float* __restrict__ cosn, float* __restrict__ sinn, LAS float* inv) {
    if (tidx() < 72) { const int j = tidx(); inv[j] = j < 64 ? (float)pow(10000.0, -(double)j / 64.0) : (float)pow(500000.0, -(double)(j - 64) / 8.0); }
    __syncthreads();
    for (int idx = blockIdx.x * NTHR + tidx(); idx < M * 72; idx += gridDim.x * NTHR) {
        const int m = idx / 72, j = idx % 72; const float pos = (float)positions[m];
        const float ang = pos * inv[j]; double sd, cd; sincos((double)ang, &sd, &cd);
        if (j < 64) { cosr[(size_t)m * 64 + j] = (float)cd; sinr[(size_t)m * 64 + j] = (float)sd; } else { cosn[(size_t)m * 8 + j - 64] = (float)cd; sinn[(size_t)m * 8 + j - 64] = (float)sd; }
    }
    __syncthreads();
}
__device__ __forceinline__ void w_rope(const h16* __restrict__ h, h16* __restrict__ rqr, h16* __restrict__ rkr, h16* __restrict__ nqr, h16* __restrict__ ksR, h16* __restrict__ kwR, const float* __restrict__ cosr, const float* __restrict__ sinr,
                                       const float* __restrict__ cosn, const float* __restrict__ sinn, int m, int lane) {
    const h16* hr = h + (size_t)m * INP; const int bb = m >> 13, t = m & (T - 1);
    {
        const int isk = lane >> 5, hd = (lane >> 3) & 3, j8 = (lane & 7) * 8; const int col = (isk ? C_RK : C_RQ) + hd * 128 + j8;
        const h16x8 a1 = *(const h16x8*)(hr + col), a2 = *(const h16x8*)(hr + col + 64);
        const f32x4 c0 = *(const f32x4*)(cosr + (size_t)m * 64 + j8), c1 = *(const f32x4*)(cosr + (size_t)m * 64 + j8 + 4), s0 = *(const f32x4*)(sinr + (size_t)m * 64 + j8), s1 = *(const f32x4*)(sinr + (size_t)m * 64 + j8 + 4);
        const float sc = isk ? 0.08838834764831845f : 1.f; h16x8 o1, o2;
#pragma unroll
        for (int x = 0; x < 8; ++x) { const float c = x < 4 ? c0[x & 3] : c1[x & 3], s = x < 4 ? s0[x & 3] : s1[x & 3]; const float v1 = (float)a1[x], v2 = (float)a2[x];
            o1[x] = (h16)((v1 * c - v2 * s) * sc); o2[x] = (h16)((v2 * c + v1 * s) * sc); }
        h16* dst = (isk ? rkr : rqr) + ((size_t)(bb * 4 + hd) * T + t) * 128 + j8; *(h16x8*)dst = o1; *(h16x8*)(dst + 64) = o2; }
    const f32x4 cn0 = *(const f32x4*)(cosn + (size_t)m * 8), cn1 = *(const f32x4*)(cosn + (size_t)m * 8 + 4), sn0 = *(const f32x4*)(sinn + (size_t)m * 8), sn1 = *(const f32x4*)(sinn + (size_t)m * 8 + 4);
    if (lane < 8 || (lane >= 56 && lane < 60)) {
        const bool isq = lane < 8; const int idx = lane - 56, which = idx >> 1, g = idx & 1;
        const h16* src = isq ? hr + C_NQ + lane * 64 : hr + (which ? C_NKW : C_NKS) + g * 64;
        h16* dst = isq ? nqr + (size_t)m * 512 + lane * 64 : (which ? kwR : ksR) + (((size_t)((bb * 2 + g) * 128 + (t >> 6)) * 64 + (t & 63)) * 64);
        const h16x8 a1 = *(const h16x8*)src, a2 = *(const h16x8*)(src + 8); h16x8 o1, o2;
#pragma unroll
        for (int x = 0; x < 8; ++x) { const float c = x < 4 ? cn0[x & 3] : cn1[x & 3], s = x < 4 ? sn0[x & 3] : sn1[x & 3]; const float v1 = (float)a1[x], v2 = (float)a2[x];
            o1[x] = (h16)(v1 * c - v2 * s); o2[x] = (h16)(v2 * c + v1 * s); }
        *(h16x8*)dst = o1; *(h16x8*)(dst + 8) = o2;
    } else if (lane < 56) {
        const int idx = lane - 8, hd = idx / 6, d = 16 + 8 * (idx % 6); *(h16x8*)(nqr + (size_t)m * 512 + hd * 64 + d) = *(const h16x8*)(hr + C_NQ + hd * 64 + d); }
    if (lane < 24) {
        const int which = lane / 12, r = lane % 12, g = r / 6, d = 16 + 8 * (r % 6);
        h16* dst = (which ? kwR : ksR) + (((size_t)((bb * 2 + g) * 128 + (t >> 6)) * 64 + (t & 63)) * 64);
        *(h16x8*)(dst + d) = *(const h16x8*)(hr + (which ? C_NKW : C_NKS) + g * 64 + d); }
}
__device__ __forceinline__ void b_rtrans(const Params& p, const h16* __restrict__ h, h16* __restrict__ rvT, h16* __restrict__ rkzT, const float* __restrict__ cosr, const float* __restrict__ sinr, int item, LAS h16* sl, int lane) {
    int id = item; const int tt = id & 255; id >>= 8; const int hd = id & 3; const int b = id >> 2; const int bh = b * 4 + hd; const float lg = p.lg[hd];
    const int chunk = bh * 64 + (tt >> 2), koff = (tt & 3) * 32;
#pragma unroll
    for (int i = lane; i < 32 * 16; i += 64) { const int t = i >> 4, e8 = (i & 15) * 8; const h16x8 v = *(const h16x8*)(h + (size_t)(b * T + tt * 32 + t) * INP + C_RV + hd * 128 + e8);
#pragma unroll
        for (int x = 0; x < 8; ++x) sl[t * 130 + e8 + x] = v[x]; }
    asm volatile("s_waitcnt lgkmcnt(0)" ::: "memory");
#pragma unroll 4
    for (int i = lane; i < 128 * 4; i += 64) { const int e = i >> 2, t8 = (i & 3) * 8; h16x8 o;
#pragma unroll
        for (int x = 0; x < 8; ++x) o[x] = sl[(t8 + x) * 130 + e];
        *(h16x8*)(rvT + ((size_t)chunk * 128 + e) * 128 + koff + t8) = o; }
    asm volatile("s_waitcnt lgkmcnt(0)" ::: "memory");
#pragma unroll 4
    for (int i = lane; i < 32 * 8; i += 64) { const int t = i >> 3, j8 = (i & 7) * 8; const size_t m = (size_t)b * T + tt * 32 + t;
        const h16x8 k1 = *(const h16x8*)(h + m * INP + C_RK + hd * 128 + j8), k2 = *(const h16x8*)(h + m * INP + C_RK + hd * 128 + 64 + j8);
        const f32x4 c0 = *(const f32x4*)(cosr + m * 64 + j8), c1 = *(const f32x4*)(cosr + m * 64 + j8 + 4), s0 = *(const f32x4*)(sinr + m * 64 + j8), s1 = *(const f32x4*)(sinr + m * 64 + j8 + 4);
        const float z = 0.08838834764831845f * __expf(lg * (float)(127 - (koff + t)));
#pragma unroll
        for (int x = 0; x < 8; ++x) { const float c = x < 4 ? c0[x & 3] : c1[x & 3], s = x < 4 ? s0[x & 3] : s1[x & 3]; const float a1 = (float)k1[x], a2 = (float)k2[x];
            sl[t * 130 + j8 + x] = (h16)((a1 * c - a2 * s) * z); sl[t * 130 + 64 + j8 + x] = (h16)((a2 * c + a1 * s) * z); } }
    asm volatile("s_waitcnt lgkmcnt(0)" ::: "memory");
#pragma unroll 4
    for (int i = lane; i < 128 * 4; i += 64) { const int d = i >> 2, t8 = (i & 3) * 8; h16x8 o;
#pragma unroll
        for (int x = 0; x < 8; ++x) o[x] = sl[(t8 + x) * 130 + d];
        *(h16x8*)(rkzT + ((size_t)chunk * 128 + d) * 128 + koff + t8) = o; }
    asm volatile("s_waitcnt lgkmcnt(0)" ::: "memory");
}
__device__ __forceinline__ void b_mvtrans(const h16* __restrict__ kvm, h16* __restrict__ kvmVT, h16* __restrict__ kx, int item, h16* sl, int lt) {
    int id = item; const int kt = id & 3; id >>= 2; const int dtl = id & 3; id >>= 2; const int hh = id & 3; const int b = id >> 2;
    for (int i = lt; i < 64 * 64; i += 256) { const int k = i >> 6, d = i & 63; sl[k * 66 + d] = kvm[(size_t)(b * MEML + kt * 64 + k) * 2048 + 1024 + hh * 256 + dtl * 64 + d];
        kx[((size_t)(b * 4 + hh) * MEML + kt * 64 + k) * 256 + dtl * 64 + d] = kvm[(size_t)(b * MEML + kt * 64 + k) * 2048 + hh * 256 + dtl * 64 + d]; }
    __syncthreads();
    for (int i = lt; i < 64 * 64; i += 256) { const int d = i >> 6, k = i & 63; kvmVT[(size_t)((b * 4 + hh) * 256 + dtl * 64 + d) * MEML + kt * 64 + k] = sl[k * 66 + d]; }
    __syncthreads();
}

struct CmpSched {
    const char* hbase; const unsigned* cmpoff; const char* Wc1T; int c;
    __device__ bool next(int i, pg8::Unit& u) const {
        if (i > 0 || c >= 32) return false; const int kv = c >> 4, rt = c & 15;
        u.pm = kv * 16 + rt; u.pn = 0; u.A = hbase + (size_t)(kv ? C_NVC : C_NKC) * 2; u.gat = cmpoff + rt * 256; u.B = Wc1T + (size_t)kv * 256 * 2048 * 2; return true; }
};
__device__ __forceinline__ void b_cmp2(const Params& p, const h16* __restrict__ hid, h16* __restrict__ kcmp, h16* __restrict__ vcmpT) {
    const int lane = tidx() & 63;
    for (int r = blockIdx.x * 8 + (tidx() >> 6); r < 2 * 4096; r += gridDim.x * 8) {
        const int kv = r >> 12, rr = r & 4095, g = rr & 1, c = (rr >> 1) & 511, b = rr >> 10;
        const float* w2 = kv ? p.w2v : p.w2k; const h16* hr = hid + (size_t)r * 256; float acc = 0.f;
        for (int j = 0; j < 256; j += 8) { const h16x8 hv = *(const h16x8*)(hr + j);
#pragma unroll
            for (int x = 0; x < 8; ++x) acc += (float)hv[x] * w2[(j + x) * 64 + lane]; }
        if (c == 511) acc = 0.f;
        if (kv == 0) kcmp[((size_t)(b * 2 + g) * 512 + c) * 64 + lane] = (h16)acc;
        else vcmpT[(((size_t)(b * 2 + g) * 8 + (c >> 6)) * 64 + lane) * 64 + (c & 63)] = (h16)acc;
    }
}
__device__ __forceinline__ void b_vtrans(const h16* __restrict__ h, h16* __restrict__ vsT, h16* __restrict__ vwT, int item, LAS h16* sl, int lane) {
    int id = item; const int tt = id & 127; id >>= 7; const int g = id & 1; id >>= 1; const int b = id & 3; const int which = id >> 2;
    const int col = (which ? C_NVW : C_NVS) + g * 64; h16* dst = (which ? vwT : vsT) + (size_t)((b * 2 + g) * 128 + tt) * 4096;
#pragma unroll
    for (int i = lane; i < 64 * 8; i += 64) { const int t = i >> 3, d8 = (i & 7) * 8; const h16x8 v = *(const h16x8*)(h + (size_t)(b * T + tt * 64 + t) * INP + col + d8);
#pragma unroll
        for (int x = 0; x < 8; ++x) sl[t * 66 + d8 + x] = v[x]; }
    asm volatile("s_waitcnt lgkmcnt(0)" ::: "memory");
#pragma unroll 4
    for (int i = lane; i < 64 * 8; i += 64) { const int d = i >> 3, t8 = (i & 7) * 8; h16x8 o;
#pragma unroll
        for (int x = 0; x < 8; ++x) o[x] = sl[(t8 + x) * 66 + d];
        *(h16x8*)(dst + d * 64 + t8) = o; }
    asm volatile("s_waitcnt lgkmcnt(0)" ::: "memory");
}

__device__ __forceinline__ void ret_kv_unit(const h16* __restrict__ rkzT, const h16* __restrict__ rvT, float* __restrict__ kvT, int chunk, int w, int lane) {
    const int i = lane & 15, kg = lane >> 4; const int bh = chunk >> 6, n = chunk & 63;
    h16x8 a[4];
#pragma unroll
    for (int ks = 0; ks < 4; ++ks) a[ks] = *(const h16x8*)(rkzT + ((size_t)chunk * 128 + 16 * w + i) * 128 + 32 * ks + 8 * kg);
    f32x4 acc[8];
#pragma unroll
    for (int et = 0; et < 8; ++et) acc[et] = (f32x4){0.f, 0.f, 0.f, 0.f};
#pragma unroll
    for (int ks = 0; ks < 4; ++ks) { h16x8 bq[8];
#pragma unroll
        for (int et = 0; et < 8; ++et) bq[et] = *(const h16x8*)(rvT + ((size_t)chunk * 128 + 16 * et + i) * 128 + 32 * ks + 8 * kg);
#pragma unroll
        for (int et = 0; et < 8; ++et) acc[et] = __builtin_amdgcn_mfma_f32_16x16x32_f16(a[ks], bq[et], acc[et], 0, 0, 0); }
#pragma unroll
    for (int et = 0; et < 8; ++et) *(f32x4*)(kvT + ((size_t)chunk * 128 + 16 * et + i) * 128 + 16 * w + 4 * kg) = acc[et];
}
__device__ __forceinline__ void b_ret_scan(const Params& p, const float* __restrict__ kvT, h16* __restrict__ prevT) {
    for (int gid = blockIdx.x * NTHR + tidx(); gid < 16 * 16384; gid += gridDim.x * NTHR) {
        const int de = gid & 16383, bh = gid >> 14; const float cd = __expf(p.lg[bh & 3] * 128.f);
        float st = 0.f;
        for (int n = 0; n < 64; ++n) { const size_t o = ((size_t)(bh * 64 + n) << 14) + de; prevT[o] = (h16)st; st = st * cd + kvT[o]; }
    }
}
__device__ __forceinline__ void ret_out_unit(const Params& p, const h16* __restrict__ h, const h16* __restrict__ rqr, const h16* __restrict__ rkr, const h16* __restrict__ rvT, const h16* __restrict__ prevT,
                                             h16* __restrict__ mix, int chunk, int w, int lane) {
    const int i = lane & 15, kg = lane >> 4; const int bh = chunk >> 6, n = chunk & 63, b = bh >> 2, hd = bh & 3; const float lg = p.lg[hd];
    const int qi = 16 * w + i; const size_t m = (size_t)b * T + n * 128 + qi;
    h16x8 qf[4];
#pragma unroll
    for (int ks = 0; ks < 4; ++ks) qf[ks] = *(const h16x8*)(rqr + ((size_t)bh * T + n * 128 + qi) * 128 + 32 * ks + 8 * kg);
    f32x4 inner[8], cross[8];
#pragma unroll
    for (int et = 0; et < 8; ++et) { inner[et] = (f32x4){0.f, 0.f, 0.f, 0.f}; cross[et] = (f32x4){0.f, 0.f, 0.f, 0.f}; }
    for (int gq = 0; gq < 2; ++gq) {
        if (64 * gq > 16 * w + 15) break;
        f32x4 s[4];
#pragma unroll
        for (int tl = 0; tl < 4; ++tl) s[tl] = (f32x4){0.f, 0.f, 0.f, 0.f};
#pragma unroll
        for (int ks = 0; ks < 4; ++ks) { h16x8 kf[4];
#pragma unroll
            for (int tl = 0; tl < 4; ++tl) { const int ko = 32 * (tl >> 1) + 8 * (i >> 2) + 4 * (tl & 1) + (i & 3); kf[tl] = *(const h16x8*)(rkr + ((size_t)bh * T + n * 128 + 64 * gq + ko) * 128 + 8 * kg + 32 * ks); }
#pragma unroll
            for (int tl = 0; tl < 4; ++tl) s[tl] = __builtin_amdgcn_mfma_f32_16x16x32_f16(kf[tl], qf[ks], s[tl], 0, 0, 0); }
        h16x8 pf[2];
#pragma unroll
        for (int tl = 0; tl < 4; ++tl)
#pragma unroll
            for (int r = 0; r < 4; ++r) { const int j = 64 * gq + 32 * (tl >> 1) + 8 * kg + 4 * (tl & 1) + r; const float v = (j <= qi) ? s[tl][r] * __expf(lg * (float)(qi - j)) : 0.f; pf[tl >> 1][4 * (tl & 1) + r] = (h16)v; }
#pragma unroll
        for (int s2 = 0; s2 < 2; ++s2) { h16x8 a[8];
#pragma unroll
            for (int et = 0; et < 8; ++et) a[et] = *(const h16x8*)(rvT + ((size_t)chunk * 128 + 16 * et + i) * 128 + 64 * gq + 32 * s2 + 8 * kg);
#pragma unroll
            for (int et = 0; et < 8; ++et) inner[et] = __builtin_amdgcn_mfma_f32_16x16x32_f16(a[et], pf[s2], inner[et], 0, 0, 0); }
    }
#pragma unroll
    for (int ks = 0; ks < 4; ++ks) { h16x8 a[8];
#pragma unroll
        for (int et = 0; et < 8; ++et) a[et] = *(const h16x8*)(prevT + ((size_t)chunk * 128 + 16 * et + i) * 128 + 32 * ks + 8 * kg);
#pragma unroll
        for (int et = 0; et < 8; ++et) cross[et] = __builtin_amdgcn_mfma_f32_16x16x32_f16(a[et], qf[ks], cross[et], 0, 0, 0); }
    const float xi = __expf(lg * (float)(qi + 1));
    float sm = 0.f;
#pragma unroll
    for (int et = 0; et < 8; ++et) { inner[et] = inner[et] + cross[et] * xi; sm += (inner[et][0] + inner[et][1]) + (inner[et][2] + inner[et][3]); }
    sm = pg8::rsum4(sm);
    const float mu = sm * (1.f / 128.f); float sq = 0.f;
#pragma unroll
    for (int et = 0; et < 8; ++et) { inner[et] = inner[et] - mu; sq += (inner[et][0] * inner[et][0] + inner[et][1] * inner[et][1]) + (inner[et][2] * inner[et][2] + inner[et][3] * inner[et][3]); }
    sq = pg8::rsum4(sq);
    const float rstd = rsqrtf(sq * (1.f / 128.f) + LN_EPS);
#pragma unroll
    for (int et = 0; et < 8; ++et) { const int e = 16 * et + 4 * kg; const h16x4 gv = *(const h16x4*)(h + m * INP + C_RG + hd * 128 + e);
        f32x4 o;
#pragma unroll
        for (int r = 0; r < 4; ++r) o[r] = siluf((float)gv[r]) * inner[et][r] * rstd;
        *(h16x4*)(mix + m * D + hd * 128 + e) = __builtin_convertvector(o, h16x4); }
}

struct AttSt { float m; f32x4 lo; f32x4 o[4]; };
struct KFrag { h16x8 a[4][2]; };
struct VFrag { h16x8 a[4][2]; };
__device__ __forceinline__ float fmx(float a, float b) { return __builtin_elementwise_maximum(a, b); }
__device__ __forceinline__ float xmax4(float v) {
    auto a = __builtin_amdgcn_permlane16_swap(__float_as_uint(v), __float_as_uint(v), false, false); v = fmx(__uint_as_float(a[0]), __uint_as_float(a[1]));
    auto c = __builtin_amdgcn_permlane32_swap(__float_as_uint(v), __float_as_uint(v), false, false); return fmx(__uint_as_float(c[0]), __uint_as_float(c[1])); }
__device__ __forceinline__ float xsum4(float v) {
    auto a = __builtin_amdgcn_permlane16_swap(__float_as_uint(v), __float_as_uint(v), false, false); v = __uint_as_float(a[0]) + __uint_as_float(a[1]);
    auto c = __builtin_amdgcn_permlane32_swap(__float_as_uint(v), __float_as_uint(v), false, false); return __uint_as_float(c[0]) + __uint_as_float(c[1]); }
constexpr float ATT_C2 = 0.125f * 1.4426950408889634f;
template <bool MASKED, class MaskF>
__device__ __forceinline__ void att_scores(f32x4 (&s)[4], const KFrag& k, const h16x8 (&qf)[2], int kg, MaskF valid) {
#pragma unroll
    for (int tl = 0; tl < 4; ++tl) s[tl] = __builtin_amdgcn_mfma_f32_16x16x32_f16(k.a[tl][0], qf[0], (f32x4){0.f, 0.f, 0.f, 0.f}, 0, 0, 0);
#pragma unroll
    for (int tl = 0; tl < 4; ++tl) s[tl] = __builtin_amdgcn_mfma_f32_16x16x32_f16(k.a[tl][1], qf[1], s[tl], 0, 0, 0);
    if (MASKED) {
#pragma unroll
        for (int tl = 0; tl < 4; ++tl)
#pragma unroll
            for (int r = 0; r < 4; ++r) { const int ko = 32 * (tl >> 1) + 8 * kg + 4 * (tl & 1) + r; s[tl][r] = valid(ko) ? s[tl][r] : -INFINITY; }
    }
}
__device__ __forceinline__ float att_rowmax(const f32x4 (&s)[4]) {
    float mx = fmx(fmx(s[0][0], s[0][1]), fmx(s[0][2], s[0][3]));
#pragma unroll
    for (int tl = 1; tl < 4; ++tl) mx = fmx(mx, fmx(fmx(s[tl][0], s[tl][1]), fmx(s[tl][2], s[tl][3])));
    return xmax4(mx);
}
__device__ __forceinline__ void att_pv(f32x4 (&o)[4], const f32x4 (&pv)[4], const VFrag& v) {
    h16x8 pf[2];
#pragma unroll
    for (int s2 = 0; s2 < 2; ++s2)
#pragma unroll
        for (int j = 0; j < 8; ++j) pf[s2][j] = (h16)pv[2 * s2 + (j >> 2)][j & 3];
#pragma unroll
    for (int dt = 0; dt < 4; ++dt)
#pragma unroll
        for (int s2 = 0; s2 < 2; ++s2) o[dt] = __builtin_amdgcn_mfma_f32_16x16x32_f16(v.a[dt][s2], pf[s2], o[dt], 0, 0, 0);
}
__device__ __forceinline__ void att_pvl(f32x4 (&o)[4], f32x4& lo, const f32x4 (&pv)[4], const VFrag& v) {
    h16x8 pf[2];
#pragma unroll
    for (int s2 = 0; s2 < 2; ++s2)
#pragma unroll
        for (int j = 0; j < 8; ++j) pf[s2][j] = (h16)pv[2 * s2 + (j >> 2)][j & 3];
    const h16x8 ones = {(h16)1.f, (h16)1.f, (h16)1.f, (h16)1.f, (h16)1.f, (h16)1.f, (h16)1.f, (h16)1.f};
#pragma unroll
    for (int dt = 0; dt < 4; ++dt)
#pragma unroll
        for (int s2 = 0; s2 < 2; ++s2) o[dt] = __builtin_amdgcn_mfma_f32_16x16x32_f16(v.a[dt][s2], pf[s2], o[dt], 0, 0, 0);
    lo = __builtin_amdgcn_mfma_f32_16x16x32_f16(ones, pf[0], lo, 0, 0, 0); lo = __builtin_amdgcn_mfma_f32_16x16x32_f16(ones, pf[1], lo, 0, 0, 0);
}
__device__ __forceinline__ void att_softmax_pv(AttSt& st, f32x4 (&s)[4], const VFrag& v, bool rowok) {
    const float mx = rowok ? att_rowmax(s) * ATT_C2 : -INFINITY;
    const float mn = fmx(st.m, mx);
    if (__any(mn > st.m)) { const float alpha = __builtin_amdgcn_exp2f(st.m - mn); st.m = mn; st.lo[0] *= alpha;
#pragma unroll
        for (int dt = 0; dt < 4; ++dt) st.o[dt] = st.o[dt] * alpha; }
    const float mneg = rowok ? -mn : -INFINITY;
#pragma unroll
    for (int tl = 0; tl < 4; ++tl)
#pragma unroll
        for (int r = 0; r < 4; ++r) s[tl][r] = __builtin_amdgcn_exp2f(__builtin_fmaf(s[tl][r], ATT_C2, mneg));
    att_pvl(st.o, st.lo, s, v);
}
template <bool MASKED, class MaskF>
__device__ __forceinline__ void att_tile(AttSt& st, const KFrag& k, const VFrag& v, const h16x8 (&qf)[2], int kg, bool rowok, MaskF valid) {
    f32x4 s[4]; att_scores<MASKED>(s, k, qf, kg, valid);
    att_softmax_pv(st, s, v, rowok);
}
constexpr int NSA_NSLOT = 6, NSA_RING = 0, NSA_IMP = NSA_NSLOT * 16384, NSA_MSK = 131072 + 256, NSA_LIST = NSA_MSK + 256;
__device__ __forceinline__ void ldk_lds(KFrag& k, LAS const unsigned char* slot, int ko0, int ko1) {
#pragma unroll
    for (int tl = 0; tl < 4; ++tl) { const int o = (32 * (tl >> 1) + 4 * (tl & 1)) * 128; k.a[tl][0] = *(LAS const h16x8*)(slot + o + ko0); k.a[tl][1] = *(LAS const h16x8*)(slot + o + ko1); }
}
__device__ __forceinline__ void ldv_lds(VFrag& v, LAS const unsigned char* slot, int vo0, int vo1) {
#pragma unroll
    for (int dt = 0; dt < 4; ++dt) { v.a[dt][0] = *(LAS const h16x8*)(slot + 8192 + dt * 2048 + vo0); v.a[dt][1] = *(LAS const h16x8*)(slot + 8192 + dt * 2048 + vo1); }
}
__device__ __forceinline__ float att_lmax(const f32x4 (&s)[4]) {
    float mx = fmx(fmx(s[0][0], s[0][1]), fmx(s[0][2], s[0][3]));
#pragma unroll
    for (int tl = 1; tl < 4; ++tl) mx = fmx(mx, fmx(fmx(s[tl][0], s[tl][1]), fmx(s[tl][2], s[tl][3])));
    return mx;
}
template <class FA, class FB>
__device__ __forceinline__ void att_pair(AttSt& st, LAS const unsigned char* sA, LAS const unsigned char* sB, int ko0, int ko1, int vo0, int vo1, const h16x8 (&qf)[2], int kg,
                                         bool okA, bool okB, bool mA, bool mB, FA validA, FB validB) {
    f32x4 a[4], c[4];
    { KFrag kA, kB; ldk_lds(kA, sA, ko0, ko1); ldk_lds(kB, sB, ko0, ko1);
      att_scores<false>(a, kA, qf, kg, [&](int) { return true; }); att_scores<false>(c, kB, qf, kg, [&](int) { return true; }); }
    VFrag vA, vB; ldv_lds(vA, sA, vo0, vo1); ldv_lds(vB, sB, vo0, vo1);
    if (mA) {
#pragma unroll
        for (int tl = 0; tl < 4; ++tl)
#pragma unroll
            for (int r = 0; r < 4; ++r) { const int ko = 32 * (tl >> 1) + 8 * kg + 4 * (tl & 1) + r; a[tl][r] = validA(ko) ? a[tl][r] : -INFINITY; } }
    if (mB) {
#pragma unroll
        for (int tl = 0; tl < 4; ++tl)
#pragma unroll
            for (int r = 0; r < 4; ++r) { const int ko = 32 * (tl >> 1) + 8 * kg + 4 * (tl & 1) + r; c[tl][r] = validB(ko) ? c[tl][r] : -INFINITY; } }
    const float mx = xmax4(fmx(okA ? att_lmax(a) : -INFINITY, okB ? att_lmax(c) : -INFINITY)) * ATT_C2;
    const float mn = fmx(st.m, mx);
    if (__any(mn > st.m)) { const float alpha = __builtin_amdgcn_exp2f(st.m - mn); st.m = mn; st.lo[0] *= alpha;
#pragma unroll
        for (int dt = 0; dt < 4; ++dt) st.o[dt] = st.o[dt] * alpha; }
    const float mnA = okA ? -mn : -INFINITY, mnB = okB ? -mn : -INFINITY;
#pragma unroll
    for (int tl = 0; tl < 4; ++tl)
#pragma unroll
        for (int r = 0; r < 4; ++r) { a[tl][r] = __builtin_amdgcn_exp2f(__builtin_fmaf(a[tl][r], ATT_C2, mnA)); c[tl][r] = __builtin_amdgcn_exp2f(__builtin_fmaf(c[tl][r], ATT_C2, mnB)); }
    att_pvl(st.o, st.lo, a, vA); att_pvl(st.o, st.lo, c, vB);
}
#define NSA_WAITV(n) asm volatile("s_waitcnt vmcnt(" #n ")" ::: "memory")
#define NSA_BAR() do { asm volatile("s_waitcnt lgkmcnt(0)" ::: "memory"); __builtin_amdgcn_s_barrier(); asm volatile("" ::: "memory"); } while (0)
template <int LPT, class IssueF, class CompF>
__device__ __forceinline__ void nsa_stream2(int n, LAS unsigned char* dmaw, LAS unsigned char* ring, IssueF issue, CompF comp2) {
#pragma unroll
    for (int j = 0; j < 4; ++j) if (j < n) issue(j, (LAS unsigned*)(dmaw + j * 16384));
    int sa = 0, si = 4 * 16384;
    for (int t2 = 0; t2 < n; t2 += 2) {
        const int rem = n - t2 - 2;
        if (rem >= 2) { if (LPT == 2) NSA_WAITV(4); else NSA_WAITV(2); } else if (rem == 1) { if (LPT == 2) NSA_WAITV(2); else NSA_WAITV(1); } else NSA_WAITV(0);
        NSA_BAR();
        if (t2 + 4 < n) issue(t2 + 4, (LAS unsigned*)(dmaw + si));
        if (t2 + 5 < n) issue(t2 + 5, (LAS unsigned*)(dmaw + si + 16384));
        comp2(t2, (LAS const unsigned char*)(ring + sa), t2 + 1 < n, (LAS const unsigned char*)(ring + sa + 16384));
        sa = (sa == 4 * 16384) ? 0 : sa + 2 * 16384; si = (si == 4 * 16384) ? 0 : si + 2 * 16384; }
    NSA_BAR();
}
__device__ __forceinline__ void att_merge(AttSt& a, const AttSt& b2) {
    const float mn = fmx(a.m, b2.m); const float fa = __builtin_amdgcn_exp2f(a.m - mn), fb = __builtin_amdgcn_exp2f(b2.m - mn);
    a.m = mn; a.lo[0] = a.lo[0] * fa + b2.lo[0] * fb;
#pragma unroll
    for (int dt = 0; dt < 4; ++dt) a.o[dt] = a.o[dt] * fa + b2.o[dt] * fb;
}
__device__ __forceinline__ void nsa_block_unit(const h16* __restrict__ h, const h16* __restrict__ nqr, const h16* __restrict__ kcmp, const h16* __restrict__ vcmpT, const h16* __restrict__ vsT, const h16* __restrict__ vwT,
                                               const h16* __restrict__ ksR, const h16* __restrict__ kwR, h16* __restrict__ mix, int b, int g, int T0, LAS unsigned char* lds, int wv, int lane) {
    const int i = lane & 15, kg = lane >> 4, tt = i & 3, hh = i >> 2;
    const int t0 = T0 + 4 * wv, trow = t0 + tt; const size_t mrow = (size_t)b * T + trow;
    const int q = wv * 64 + lane, qrow = q >> 3, qch = q & 7;
    const int ksrc = qrow * 128 + ((qch ^ (((qrow >> 1) & 1) | (((qrow >> 3) & 3) << 1))) << 4), vsrc = qrow * 128 + ((qch ^ ((qrow >> 1) & 7)) << 4);
    const int gki = ((i >> 1) & 1) | ((i >> 2) << 1), gvi = (i >> 1) & 7;
    const int ko0 = (8 * (i >> 2) + (i & 3)) * 128 + ((kg ^ gki) << 4), ko1 = (8 * (i >> 2) + (i & 3)) * 128 + (((kg + 4) ^ gki) << 4);
    const int vo0 = i * 128 + ((kg ^ gvi) << 4), vo1 = i * 128 + (((kg + 4) ^ gvi) << 4);
    LAS unsigned char* ring = lds + NSA_RING; LAS unsigned char* dmaw = ring + wv * 1024;
    LAS float* impA = (LAS float*)(lds + NSA_IMP + wv * 4096); LAS float* impL = impA + 512;
    h16x8 qf[2], qrf[2];
    { const h16* qp = h + mrow * INP + C_NQ + (g * 4 + hh) * 64 + 8 * kg; qf[0] = *(const h16x8*)qp; qf[1] = *(const h16x8*)(qp + 32);
      const h16* qrp = nqr + mrow * 512 + (g * 4 + hh) * 64 + 8 * kg; qrf[0] = *(const h16x8*)qrp; qrf[1] = *(const h16x8*)(qrp + 32); }
    const h16* gp = h + mrow * INP + C_NG + (g * 4 + hh) * 3; const float gt0 = (float)gp[0], gt1 = (float)gp[1], gt2 = (float)gp[2];
    for (int x = lane; x < 1024; x += 64) impA[x] = 0.f;
    NSA_WAITV(0);
#define GLDS16(gsrc, ldst) __builtin_amdgcn_global_load_lds((const unsigned*)(gsrc), (ldst), 16, 0, 0)
    const int ncv_row = trow >= 31 ? ((trow - 31) >> 4) + 1 : 0;
    const int ncv_blk = (T0 + 31 >= 31) ? ((T0 + 31 - 31) >> 4) + 1 : 0;
    const int ncv_min = T0 >= 31 ? ((T0 - 31) >> 4) + 1 : 0;
    const int nct = (ncv_blk + 63) >> 6;
    const unsigned char* Kc = (const unsigned char*)(kcmp + (size_t)(b * 2 + g) * 512 * 64); const unsigned char* Vc = (const unsigned char*)(vcmpT + (size_t)(b * 2 + g) * 8 * 4096);
    float m = -1e30f, l = 0.f;
    f32x4 oc[4];
    float linv = 0.f;
    REPS(501) {
    m = -1e30f; l = 0.f;
#pragma unroll
    for (int dt = 0; dt < 4; ++dt) oc[dt] = (f32x4){0.f, 0.f, 0.f, 0.f};
    float mB = -1e30f, lB = 0.f;
    auto cmp1 = [&](int j, LAS const unsigned char* slot, float& mm, float& ll) {
        KFrag kf; ldk_lds(kf, slot, ko0, ko1);
        f32x4 s[4];
        if (64 * j + 63 < ncv_min) att_scores<false>(s, kf, qf, kg, [&](int) { return true; }); else att_scores<true>(s, kf, qf, kg, [&](int ko) { return j * 64 + ko < ncv_row; });
        const float mx = att_rowmax(s) * ATT_C2;
        const float mn = fmx(mm, mx); float ps0 = 0.f, ps1 = 0.f;
        _Pragma("unroll") for (int tl = 0; tl < 4; ++tl) { ps0 += __builtin_amdgcn_exp2f(__builtin_fmaf(s[tl][0], ATT_C2, -mn)) + __builtin_amdgcn_exp2f(__builtin_fmaf(s[tl][1], ATT_C2, -mn));
                                                          ps1 += __builtin_amdgcn_exp2f(__builtin_fmaf(s[tl][2], ATT_C2, -mn)) + __builtin_amdgcn_exp2f(__builtin_fmaf(s[tl][3], ATT_C2, -mn)); }
        ll = ll * __builtin_amdgcn_exp2f(mm - mn) + (ps0 + ps1); mm = mn; };
    nsa_stream2<1>(nct, dmaw, ring, [&](int j, LAS unsigned* dk) { GLDS16(Kc + (size_t)j * 8192 + ksrc, dk); }, [&](int j, LAS const unsigned char* sA, bool hasB, LAS const unsigned char* sB) {
        cmp1(j, sA, m, l); __builtin_amdgcn_sched_barrier(0); if (hasB) cmp1(j + 1, sB, mB, lB); });
    { const float mn = fmx(m, mB); l = l * __builtin_amdgcn_exp2f(m - mn) + lB * __builtin_amdgcn_exp2f(mB - mn); m = mn; }
    l = xsum4(l);
    linv = l > 0.f ? 1.f / l : 0.f;
    auto cmp2 = [&](int j, LAS const unsigned char* slot) {
        KFrag kf; ldk_lds(kf, slot, ko0, ko1); VFrag vf; ldv_lds(vf, slot, vo0, vo1);
        f32x4 s[4];
        if (64 * j + 63 < ncv_min) att_scores<false>(s, kf, qf, kg, [&](int) { return true; }); else att_scores<true>(s, kf, qf, kg, [&](int ko) { return j * 64 + ko < ncv_row; });
        _Pragma("unroll") for (int tl = 0; tl < 4; ++tl) {
            _Pragma("unroll") for (int r = 0; r < 4; ++r) s[tl][r] = __builtin_amdgcn_exp2f(__builtin_fmaf(s[tl][r], ATT_C2, -m)) * linv;
            float A = (s[tl][0] + s[tl][1]) + (s[tl][2] + s[tl][3]), L = s[tl][3];
            A += dppf<0x128>(A); A += dppf<0x124>(A); L += dppf<0x128>(L); L += dppf<0x124>(L);
            if (hh == 0) { const int u = j * 16 + 8 * (tl >> 1) + 2 * kg + (tl & 1); impA[tt * 128 + u] = A; impL[tt * 128 + u] = L; } }
        att_pv(oc, s, vf); };
    nsa_stream2<2>(nct, dmaw, ring, [&](int j, LAS unsigned* dk) { GLDS16(Kc + (size_t)j * 8192 + ksrc, dk); GLDS16(Vc + (size_t)j * 8192 + vsrc, (LAS unsigned*)((LAS unsigned char*)dk + 8192)); },
        [&](int j, LAS const unsigned char* sA, bool hasB, LAS const unsigned char* sB) { cmp2(j, sA); if (hasB) cmp2(j + 1, sB); });
    }
    const int cur = T0 >> 6;
    AttSt sw;
    REPS(504) {
    sw.m = -1e30f; sw.lo = (f32x4){0.f, 0.f, 0.f, 0.f};
#pragma unroll
    for (int dt = 0; dt < 4; ++dt) sw.o[dt] = (f32x4){0.f, 0.f, 0.f, 0.f};
    {
        const unsigned char* Kw = (const unsigned char*)(kwR + (size_t)((b * 2 + g) * 128) * 4096); const unsigned char* Vw = (const unsigned char*)(vwT + (size_t)((b * 2 + g) * 128) * 4096);
        const int s0w = (T0 >= 511 ? (T0 - 511) >> 6 : 0);
        auto wmk = [&](int j) { const int sx = s0w + j; return !(sx > s0w + 1 && sx < cur); };
        nsa_stream2<2>(cur - s0w + 1, dmaw, ring, [&](int j, LAS unsigned* dk) { GLDS16(Kw + (size_t)(s0w + j) * 8192 + ksrc, dk); GLDS16(Vw + (size_t)(s0w + j) * 8192 + vsrc, (LAS unsigned*)((LAS unsigned char*)dk + 8192)); },
            [&](int j, LAS const unsigned char* sA, bool hasB, LAS const unsigned char* sB) {
                const int kA0 = 64 * (s0w + j), kB0 = kA0 + 64;
                if (hasB) att_pair(sw, sA, sB, ko0, ko1, vo0, vo1, qrf, kg, true, true, wmk(j), wmk(j + 1),
                                   [&](int ko) { const int kp = kA0 + ko; return kp <= trow && kp >= trow - 511; }, [&](int ko) { const int kp = kB0 + ko; return kp <= trow && kp >= trow - 511; });
                else { KFrag kf; ldk_lds(kf, sA, ko0, ko1); VFrag vf; ldv_lds(vf, sA, vo0, vo1);
                       att_tile<true>(sw, kf, vf, qrf, kg, true, [&](int ko) { const int kp = kA0 + ko; return kp <= trow && kp >= trow - 511; }); } });
    }
    }
    unsigned long long mylo, myhi, anylo, anyhi;
    if (cur <= 15) { mylo = anylo = (1ull << (cur + 1)) - 1ull; myhi = anyhi = 0ull; }
    else {
        mylo = myhi = anylo = anyhi = 0ull;
        const unsigned long long flo = 1ull | (cur < 64 ? (1ull << cur) : 0ull) | (cur - 1 < 64 ? (1ull << (cur - 1)) : 0ull);
        const unsigned long long fhi = (cur >= 64 ? (1ull << (cur - 64)) : 0ull) | (cur - 1 >= 64 ? (1ull << (cur - 65)) : 0ull);
        const unsigned long long lmask = (1ull << lane) - 1ull;
        unsigned b0[4], b1[4], Tq[4];
#pragma unroll
        for (int tk = 0; tk < 4; ++tk) { const int s0 = lane, s1 = lane + 64;
            const float v0 = impA[tk * 128 + s0] + (s0 > 0 ? impL[tk * 128 + s0 - 1] : 0.f), v1 = impA[tk * 128 + s1] + impL[tk * 128 + s1 - 1];
            b0[tk] = (s0 >= 1 && s0 <= cur - 2) ? __float_as_uint(v0) + 1u : 0u; b1[tk] = (s1 <= cur - 2) ? __float_as_uint(v1) + 1u : 0u; Tq[tk] = 0u; }
        for (int bit = 30; bit >= 0; --bit) {
#pragma unroll
            for (int tk = 0; tk < 4; ++tk) { const unsigned T2 = Tq[tk] | (1u << bit);
                const int c = __popcll(__ballot(b0[tk] >= T2)) + __popcll(__ballot(b1[tk] >= T2)); if (c >= 13) Tq[tk] = T2; } }
#pragma unroll
        for (int tk = 0; tk < 4; ++tk) {
            const unsigned long long gtlo = __ballot(b0[tk] > Tq[tk]), gthi = __ballot(b1[tk] > Tq[tk]), eqlo = __ballot(b0[tk] == Tq[tk]), eqhi = __ballot(b1[tk] == Tq[tk]);
            const int need = 13 - (__popcll(gtlo) + __popcll(gthi));
            const bool t0q = (b0[tk] == Tq[tk]) && (__popcll(eqlo & lmask) < need), t1q = (b1[tk] == Tq[tk]) && (__popcll(eqlo) + __popcll(eqhi & lmask) < need);
            const unsigned long long lo = gtlo | __ballot(t0q) | flo, hi = gthi | __ballot(t1q) | fhi;
            anylo |= lo; anyhi |= hi; if (tt == tk) { mylo = lo; myhi = hi; }
        }
    }
    LAS unsigned long long* msk = (LAS unsigned long long*)(lds + NSA_MSK); LAS unsigned char* lst = lds + NSA_LIST; LAS int* nlst = (LAS int*)(lds + NSA_LIST + 128);
    if (lane == 0) { msk[2 * wv] = anylo; msk[2 * wv + 1] = anyhi; }
    NSA_BAR();
    if (wv == 0) {
        unsigned long long ulo = 0ull, uhi = 0ull;
#pragma unroll
        for (int w2 = 0; w2 < 8; ++w2) { ulo |= msk[2 * w2]; uhi |= msk[2 * w2 + 1]; }
        const unsigned long long lmask = (1ull << lane) - 1ull; const int nlo = __popcll(ulo);
        if ((ulo >> lane) & 1ull) lst[__popcll(ulo & lmask)] = (unsigned char)lane;
        if ((uhi >> lane) & 1ull) lst[nlo + __popcll(uhi & lmask)] = (unsigned char)(64 + lane);
        if (lane == 0) nlst[0] = nlo + __popcll(uhi);
    }
    NSA_BAR();
    const int nsel = nlst[0];
    const int lv0 = lst[lane], lv1 = lst[64 + lane];
    auto lget = [&](int j) { return j < 64 ? __builtin_amdgcn_readlane(lv0, j) : __builtin_amdgcn_readlane(lv1, j - 64); };
    AttSt ss;
    REPS(503) {
    ss.m = -1e30f; ss.lo = (f32x4){0.f, 0.f, 0.f, 0.f};
#pragma unroll
    for (int dt = 0; dt < 4; ++dt) ss.o[dt] = (f32x4){0.f, 0.f, 0.f, 0.f};
    {
        const unsigned char* Ks = (const unsigned char*)(ksR + (size_t)((b * 2 + g) * 128) * 4096); const unsigned char* Vs = (const unsigned char*)(vsT + (size_t)((b * 2 + g) * 128) * 4096);
        auto sel1 = [&](int s, LAS const unsigned char* slot, AttSt& st) {
            KFrag kf; ldk_lds(kf, slot, ko0, ko1); VFrag vf; ldv_lds(vf, slot, vo0, vo1);
            const bool mybit = (((s < 64 ? mylo : myhi) >> (s & 63)) & 1ull) != 0ull;
            if (s < cur) att_tile<false>(st, kf, vf, qrf, kg, mybit, [&](int) { return true; });
            else att_tile<true>(st, kf, vf, qrf, kg, mybit, [&](int ko) { return 64 * s + ko <= trow; }); };
        nsa_stream2<2>(nsel, dmaw, ring, [&](int j, LAS unsigned* dk) { const int sj = lget(j); GLDS16(Ks + (size_t)sj * 8192 + ksrc, dk); GLDS16(Vs + (size_t)sj * 8192 + vsrc, (LAS unsigned*)((LAS unsigned char*)dk + 8192)); },
            [&](int j, LAS const unsigned char* sA, bool hasB, LAS const unsigned char* sB) {
                const int s0 = lget(j); const int s1 = hasB ? lget(j + 1) : 0;
                const bool nA = (((s0 < 64 ? anylo : anyhi) >> (s0 & 63)) & 1ull) != 0ull, nB = hasB && ((((s1 < 64 ? anylo : anyhi) >> (s1 & 63)) & 1ull) != 0ull);
                if (nA && nB) { const bool bA = (((s0 < 64 ? mylo : myhi) >> (s0 & 63)) & 1ull) != 0ull, bB = (((s1 < 64 ? mylo : myhi) >> (s1 & 63)) & 1ull) != 0ull;
                    att_pair(ss, sA, sB, ko0, ko1, vo0, vo1, qrf, kg, bA, bB, false, s1 >= cur, [&](int) { return true; }, [&](int ko) { return 64 * s1 + ko <= trow; }); }
                else if (nA) sel1(s0, sA, ss);
                else if (nB) sel1(s1, sB, ss); });
    }
    }
    const float ls = ss.lo[0], lw = sw.lo[0];
    const float g0 = sigmf(gt0), g1 = sigmf(gt1) / ls, g2 = sigmf(gt2) / lw;
#pragma unroll
    for (int dt = 0; dt < 4; ++dt) { const f32x4 o = oc[dt] * g0 + ss.o[dt] * g1 + sw.o[dt] * g2;
        *(h16x4*)(mix + mrow * D + 512 + (g * 4 + hh) * 64 + 16 * dt + 4 * kg) = __builtin_convertvector(o, h16x4); }
#undef GLDS16
}

template <class Sched>
__device__ __forceinline__ void xattn_block(const h16* __restrict__ qx, const h16* __restrict__ kx, const h16* __restrict__ kvmVT, h16* __restrict__ ox, const Sched& S, LAS unsigned char* lds, int wv, int lane) {
    const int i = lane & 15, kg = lane >> 4;
    const int gki = ((i >> 1) & 1) | ((i >> 2) << 1), gvi = (i >> 1) & 7;
    const int ko0 = (8 * (i >> 2) + (i & 3)) * 512 + ((kg ^ gki) << 4), ko1 = (8 * (i >> 2) + (i & 3)) * 512 + (((kg + 4) ^ gki) << 4);
    const int vo0 = i * 128 + ((kg ^ gvi) << 4), vo1 = i * 128 + (((kg + 4) ^ gvi) << 4);
    const int t = wv * 64 + lane;
    int ksrc[4], vsrc[4];
#pragma unroll
    for (int pz = 0; pz < 4; ++pz) { const int q = pz * 512 + t;
        { const int row = q >> 5, cp = q & 31; const int gk = ((row >> 1) & 1) | (((row >> 3) & 3) << 1); ksrc[pz] = row * 512 + ((cp ^ gk) << 4); }
        { const int row = q >> 3, cp = q & 7; vsrc[pz] = row * 512 + ((cp ^ ((row >> 1) & 7)) << 4); } }
    int ngu = 0; { pg8::Unit uu; while (S.next(ngu, uu)) ++ngu; }
    const int ntile = ngu * 2 * 4;
    auto unit_of = [&](int j, int& m0, int& hh) { pg8::Unit uu; S.next(j >> 1, uu); m0 = uu.pm * 256 + (j & 1) * 128; hh = uu.pn; };
    auto issue = [&](int tix, int slot) { const int grp = tix & 3; int m0, hh; unit_of(tix >> 2, m0, hh); const int b = m0 >> 13;
        const unsigned char* Kb = (const unsigned char*)(kx + ((size_t)(b * 4 + hh) * MEML + 64 * grp) * 256); const unsigned char* Vb = (const unsigned char*)(kvmVT + (size_t)((b * 4 + hh) * 256) * MEML + 64 * grp);
        LAS unsigned char* base = lds + slot * 65536 + wv * 1024;
#pragma unroll
        for (int pz = 0; pz < 4; ++pz) { __builtin_amdgcn_global_load_lds((const unsigned*)(Kb + ksrc[pz]), (LAS unsigned*)(base + pz * 8192), 16, 0, 0);
                                        __builtin_amdgcn_global_load_lds((const unsigned*)(Vb + vsrc[pz]), (LAS unsigned*)(base + 32768 + pz * 8192), 16, 0, 0); } };
    NSA_WAITV(0);
    if (ntile > 0) issue(0, 0);
    h16x8 qf[8]; f32x4 o[16]; float mrun = -1e30f, l = 0.f; size_t mrow = 0; int hh = 0;
    for (int tix = 0; tix < ntile; ++tix) {
        const int grp = tix & 3, slot = tix & 1;
        if (grp == 0) {
            int m0u; unit_of(tix >> 2, m0u, hh); mrow = (size_t)(m0u + wv * 16 + i);
#pragma unroll
            for (int ks = 0; ks < 8; ++ks) qf[ks] = *(const h16x8*)(qx + mrow * D + hh * 256 + 32 * ks + 8 * kg);
#pragma unroll
            for (int dt = 0; dt < 16; ++dt) o[dt] = (f32x4){0.f, 0.f, 0.f, 0.f};
            mrun = -1e30f; l = 0.f;
        }
        NSA_WAITV(0);
        NSA_BAR();
        if (tix + 1 < ntile) issue(tix + 1, slot ^ 1);
        LAS const unsigned char* sk = lds + slot * 65536; LAS const unsigned char* sv = sk + 32768;
        f32x4 s[4];
#pragma unroll
        for (int tl = 0; tl < 4; ++tl) s[tl] = (f32x4){0.f, 0.f, 0.f, 0.f};
#pragma unroll
        for (int ks = 0; ks < 8; ++ks) { h16x8 kf[4];
#pragma unroll
            for (int tl = 0; tl < 4; ++tl) kf[tl] = *(LAS const h16x8*)(sk + (32 * (tl >> 1) + 4 * (tl & 1)) * 512 + 128 * (ks >> 1) + ((ks & 1) ? ko1 : ko0));
#pragma unroll
            for (int tl = 0; tl < 4; ++tl) s[tl] = __builtin_amdgcn_mfma_f32_16x16x32_f16(kf[tl], qf[ks], s[tl], 0, 0, 0); }
        const float mx = att_rowmax(s) * (0.0625f * 1.4426950408889634f);
        const float mn = fmx(mrun, mx); const float alpha = __builtin_amdgcn_exp2f(mrun - mn); mrun = mn;
        float ps = 0.f; h16x8 pf[2];
#pragma unroll
        for (int tl = 0; tl < 4; ++tl)
#pragma unroll
            for (int r = 0; r < 4; ++r) { const float pe = __builtin_amdgcn_exp2f(__builtin_fmaf(s[tl][r], 0.0625f * 1.4426950408889634f, -mn)); ps += pe; pf[tl >> 1][4 * (tl & 1) + r] = (h16)pe; }
        l = l * alpha + ps;
#pragma unroll
        for (int dt = 0; dt < 16; ++dt) { f32x4 acc = o[dt] * alpha;
            acc = __builtin_amdgcn_mfma_f32_16x16x32_f16(*(LAS const h16x8*)(sv + dt * 2048 + vo0), pf[0], acc, 0, 0, 0);
            acc = __builtin_amdgcn_mfma_f32_16x16x32_f16(*(LAS const h16x8*)(sv + dt * 2048 + vo1), pf[1], acc, 0, 0, 0);
            o[dt] = acc; }
        if (grp == 3) { const float linv = 1.f / xsum4(l);
#pragma unroll
            for (int dt = 0; dt < 16; ++dt) { const f32x4 acc = o[dt] * linv; *(h16x4*)(ox + mrow * D + hh * 256 + 16 * dt + 4 * kg) = __builtin_convertvector(acc, h16x4); } }
    }
    NSA_WAITV(0);
    NSA_BAR();
}

__device__ __forceinline__ float gmax8(float v) { v = fmx(v, dppf<0xB1>(v)); v = fmx(v, dppf<0x4E>(v)); return fmx(v, dppf<0x141>(v)); }
__device__ __forceinline__ int gmin8(int v) { v = min(v, dppi<0xB1>(v)); v = min(v, dppi<0x4E>(v)); return min(v, dppi<0x141>(v)); }
__device__ __forceinline__ void route16(LAS const float* lg, int m0, int lane, const float* __restrict__ rbias, int* __restrict__ tope, float* __restrict__ topw, int* __restrict__ hist) {
    const float rb = rbias[lane];
    const unsigned long long ltm = (1ull << lane) - 1ull;
    float score[16]; unsigned key[16], Tq[16];
#pragma unroll
    for (int tk = 0; tk < 16; ++tk) {
        const float logit = lg[tk * 64 + lane];
        score[tk] = 1.f / (1.f + expf(-logit)); const float biased = score[tk] + rb;
        const float m1 = gmax8(biased);
        const int am = gmin8((biased == m1) ? lane : 999);
        const float m2 = gmax8((lane == am) ? -INFINITY : biased);
        const float gs = m1 + m2;
        int cnt = 0;
#pragma unroll
        for (int gq = 0; gq < 8; ++gq) cnt += (rlanef(gs, gq * 8) > gs) ? 1 : 0;
        const float masked = (cnt <= 3) ? biased : NEGF;
        const unsigned bb = __float_as_uint(masked); key[tk] = bb ^ ((bb >> 31) ? 0xffffffffu : 0x80000000u); Tq[tk] = 0u;
    }
    for (int bit = 31; bit >= 0; --bit) {
#pragma unroll
        for (int tk = 0; tk < 16; ++tk) { const unsigned T2 = Tq[tk] | (1u << bit); if (__popcll(__ballot(key[tk] >= T2)) >= 8) Tq[tk] = T2; } }
#pragma unroll
    for (int tk = 0; tk < 16; ++tk) {
        const unsigned long long gt = __ballot(key[tk] > Tq[tk]), eq = __ballot(key[tk] == Tq[tk]);
        const int need = 8 - __popcll(gt);
        const bool selq = key[tk] > Tq[tk] || (key[tk] == Tq[tk] && __popcll(eq & ltm) < need);
        const unsigned long long sm = __ballot(selq);
        const float wsum = wsum64(selq ? score[tk] : 0.f);
        if (selq) { const int rank = __popcll(sm & ltm); const int m = m0 + tk;
            tope[(size_t)m * 8 + rank] = lane; topw[(size_t)m * 8 + rank] = score[tk] / wsum * 2.5f; atomicAdd(hist + (m >> 13) * 65 + lane, 1); }
    }
}
__device__ __forceinline__ void router_unit(const Params& p, const float* __restrict__ pre, h16* __restrict__ x2h, const h16* __restrict__ WrTh, const h16* __restrict__ WrTl, int* __restrict__ tope, float* __restrict__ topw,
                                            int* __restrict__ hist, int m0, LAS float* lg, int lane) {
    const int i = lane & 15, kg = lane >> 4;
    const float* xr = pre + (size_t)(m0 + i) * D + 8 * kg;
    float s1 = 0.f, s2 = 0.f;
#pragma unroll 8
    for (int ks = 0; ks < 32; ++ks) { const f32x4 x0 = *(const f32x4*)(xr + 32 * ks), x1 = *(const f32x4*)(xr + 32 * ks + 4);
        s1 += (x0[0] + x0[1]) + (x0[2] + x0[3]) + (x1[0] + x1[1]) + (x1[2] + x1[3]);
        s2 += (x0[0] * x0[0] + x0[1] * x0[1]) + (x0[2] * x0[2] + x0[3] * x0[3]) + (x1[0] * x1[0] + x1[1] * x1[1]) + (x1[2] * x1[2] + x1[3] * x1[3]); }
    s1 = xsum4(s1); s2 = xsum4(s2);
    const float mean = s1 * (1.f / D); const float rstd = rsqrtf(fmaxf(s2 * (1.f / D) - mean * mean, 0.f) + LN_EPS);
    f32x4 am_[4], ac_[4];
#pragma unroll
    for (int et = 0; et < 4; ++et) { am_[et] = (f32x4){0.f, 0.f, 0.f, 0.f}; ac_[et] = (f32x4){0.f, 0.f, 0.f, 0.f}; }
    h16* xo = x2h + (size_t)(m0 + i) * D + 8 * kg;
#pragma unroll 4
    for (int ks = 0; ks < 32; ++ks) {
        f32x4 x0 = *(const f32x4*)(xr + 32 * ks), x1 = *(const f32x4*)(xr + 32 * ks + 4);
        const f32x4 g0 = *(const f32x4*)(p.ln2g + 32 * ks + 8 * kg), g1 = *(const f32x4*)(p.ln2g + 32 * ks + 8 * kg + 4), b0 = *(const f32x4*)(p.ln2b + 32 * ks + 8 * kg), b1 = *(const f32x4*)(p.ln2b + 32 * ks + 8 * kg + 4);
        x0 = (x0 - mean) * rstd * g0 + b0; x1 = (x1 - mean) * rstd * g1 + b1;
        h16x8 xh, xl;
#pragma unroll
        for (int j = 0; j < 4; ++j) { xh[j] = (h16)x0[j]; xl[j] = (h16)((x0[j] - (float)xh[j]) * 2048.f); xh[4 + j] = (h16)x1[j]; xl[4 + j] = (h16)((x1[j] - (float)xh[4 + j]) * 2048.f); }
        *(h16x8*)(xo + 32 * ks) = xh;
        h16x8 wh[4], wl[4];
#pragma unroll
        for (int et = 0; et < 4; ++et) { wh[et] = *(const h16x8*)(WrTh + (size_t)(16 * et + i) * D + 32 * ks + 8 * kg); wl[et] = *(const h16x8*)(WrTl + (size_t)(16 * et + i) * D + 32 * ks + 8 * kg); }
#pragma unroll
        for (int et = 0; et < 4; ++et) am_[et] = __builtin_amdgcn_mfma_f32_16x16x32_f16(wh[et], xh, am_[et], 0, 0, 0);
#pragma unroll
        for (int et = 0; et < 4; ++et) ac_[et] = __builtin_amdgcn_mfma_f32_16x16x32_f16(wh[et], xl, ac_[et], 0, 0, 0);
#pragma unroll
        for (int et = 0; et < 4; ++et) ac_[et] = __builtin_amdgcn_mfma_f32_16x16x32_f16(wl[et], xh, ac_[et], 0, 0, 0);
    }
#pragma unroll
    for (int et = 0; et < 4; ++et)
#pragma unroll
        for (int r = 0; r < 4; ++r) lg[i * 64 + 16 * et + 4 * kg + r] = am_[et][r] + ac_[et][r] * (1.f / 2048.f);
    route16(lg, m0, lane, p.rbias, tope, topw, hist);
}

struct G1Sched {
    const int* ctl; const char* x2h; const unsigned* rowoff; const char* WguT; int G, c;
    __device__ bool next(int i, pg8::Unit& u) const {
        const int ntile = ctl[CTL_TQS + NQ]; const long L = (long)i * G + c; if (L >= 2L * ntile) return false;
        const int tile = (int)(L >> 1), pn = (int)(L & 1); const int e = ctl[CTL_TVE + tile] % 65;
        u.pm = tile; u.pn = pn; u.A = x2h; u.gat = rowoff + (size_t)tile * 256; u.B = WguT + ((size_t)e * 512 + pn * 256) * (D * 2); return true; }
};
struct G2Sched {
    const int* ctl; const char* H; const char* WdT; int q, G, c;
    __device__ bool next(int i, pg8::Unit& u) const {
        const int t0 = ctl[CTL_TQS + q], t1 = ctl[CTL_TQS + q + 1]; const long L = (long)i * G + c; if (L >= 4L * (t1 - t0)) return false;
        const int tile = t0 + (int)(L >> 2), pn = (int)(L & 3); const int e = ctl[CTL_TVE + tile] % 65;
        u.pm = tile; u.pn = pn; u.A = H + (size_t)tile * 256 * (EFF * 2); u.gat = nullptr; u.B = WdT + ((size_t)e * D + pn * 256) * (EFF * 2); return true; }
};
__device__ __forceinline__ void b_scatter(int* __restrict__ ctl, const int* __restrict__ tope, const float* __restrict__ topw, unsigned* __restrict__ rowoff, u32x2* __restrict__ rowmeta, int* sl) {
    int* pst = sl;
    int* pc = sl + 512;
    for (int v = tidx(); v < NVE; v += NTHR) pc[v] = (ctl[CTL_CNT + v] + 255) & ~255;
    __syncthreads();
    for (int v = tidx(); v <= NVE; v += NTHR) { int acc = 0; for (int u = 0; u < v; ++u) acc += pc[u]; pst[v] = acc; }
    __syncthreads();
    if (blockIdx.x == 0) {
        for (int v = tidx(); v <= NVE; v += NTHR) ctl[CTL_PST + v] = pst[v];
        if (tidx() <= NQ) ctl[CTL_TQS + tidx()] = pst[tidx() * 65] >> 8;
        for (int v = tidx(); v < NVE; v += NTHR) for (int tl = pst[v] >> 8; tl < (pst[v + 1] >> 8); ++tl) ctl[CTL_TVE + tl] = v;
    }
    for (int idx = blockIdx.x * NTHR + tidx(); idx < M * 9; idx += gridDim.x * NTHR) {
        int m, k, pos; float w;
        if (idx < M * 8) { m = idx >> 3; k = idx & 7; const int ve = (m >> 13) * 65 + tope[idx]; w = topw[idx]; pos = pst[ve] + atomicAdd(ctl + CTL_CUR + ve, 1); }
        else { m = idx - M * 8; k = 8; w = 1.f; pos = pst[(m >> 13) * 65 + 64] + (m & (QT - 1)); }
        rowoff[pos] = (unsigned)m * (D * 2); rowmeta[pos] = (u32x2){(unsigned)((m & (QT - 1)) * 9 + k), __float_as_uint(w)};
    }
    __syncthreads();
}
__device__ __forceinline__ void b_combine(const Params& p, const h16* __restrict__ x2h, const h16* __restrict__ Y, int q) {
    const int lane = tidx() & 63;
    for (int r = blockIdx.x * 8 + (tidx() >> 6); r < QT; r += gridDim.x * 8) {
        const int m = q * QT + r;
        float v[16];
        { const h16x8 a = ((const h16x8*)(x2h + (size_t)m * D))[lane], b = ((const h16x8*)(x2h + (size_t)m * D))[lane + 64];
#pragma unroll
          for (int i = 0; i < 8; ++i) { v[i] = DN_ALPHA * (float)a[i]; v[8 + i] = DN_ALPHA * (float)b[i]; } }
#pragma unroll
        for (int k = 0; k < 9; ++k) { const h16x8* yr = (const h16x8*)(Y + ((size_t)r * 9 + k) * D); const h16x8 a = yr[lane], b = yr[lane + 64];
#pragma unroll
            for (int i = 0; i < 8; ++i) { v[i] += (float)a[i]; v[8 + i] += (float)b[i]; } }
        float s = 0.f;
#pragma unroll
        for (int i = 0; i < 16; ++i) s += v[i];
        const float mean = wave_sum(s) * (1.f / D); float s2 = 0.f;
#pragma unroll
        for (int i = 0; i < 16; ++i) { v[i] -= mean; s2 += v[i] * v[i]; }
        const float rstd = rsqrtf(wave_sum(s2) * (1.f / D) + LN_EPS);
#pragma unroll
        for (int hlf = 0; hlf < 2; ++hlf) { const int c0 = (lane + 64 * hlf) * 8;
            const f32x4 g0 = *(const f32x4*)(p.ln3g + c0), g1 = *(const f32x4*)(p.ln3g + c0 + 4), b0 = *(const f32x4*)(p.ln3b + c0), b1 = *(const f32x4*)(p.ln3b + c0 + 4);
            f32x4 o0, o1;
#pragma unroll
            for (int i = 0; i < 4; ++i) { o0[i] = v[8 * hlf + i] * rstd * g0[i] + b0[i]; o1[i] = v[8 * hlf + 4 + i] * rstd * g1[i] + b1[i]; }
            *(f32x4*)(p.out + (size_t)m * D + c0) = o0; *(f32x4*)(p.out + (size_t)m * D + c0 + 4) = o1; }
    }
}

#define XB_TMO      128
#define XB_XCNT(j)  (256  + 64 * (j))
#define XB_XSUB(j)  (1280 + 64 * (j))
#define XB_XGEN(j)  (2304 + 64 * (j))
#define XB_TOP      3328
#define XB_TOPGEN   3392
#define XCD_BAR_WORDS 3456
#define XB_SPIN_CAP (1u << 22)
__device__ __forceinline__ unsigned xb_ld(unsigned* p)              { return __hip_atomic_load(p, __ATOMIC_RELAXED, __HIP_MEMORY_SCOPE_AGENT); }
__device__ __forceinline__ unsigned xb_add(unsigned* p, unsigned v) { return __hip_atomic_fetch_add(p, v, __ATOMIC_RELAXED, __HIP_MEMORY_SCOPE_AGENT); }
__device__ __forceinline__ unsigned xb_xcc_id() { return (unsigned)__builtin_amdgcn_s_getreg((3 << 11) | 20) & 0xFu; }
#define XB_SPIN(cond, bar) do { unsigned _sp = 0; while (cond) { __builtin_amdgcn_s_sleep(1); \
    if ((++_sp & 255u) == 0u) { if (xb_ld(&(bar)[XB_TMO])) break; if (_sp > XB_SPIN_CAP) { atomicAdd(&(bar)[XB_TMO], 1u); break; } } } } while (0)
struct XcdBarrier { unsigned* bar; unsigned x; volatile LAS unsigned* st; };
__device__ __forceinline__ XcdBarrier xcd_barrier_post(unsigned* bar, volatile LAS unsigned* st) {
    XcdBarrier b; b.bar = bar; b.x = xb_xcc_id(); b.st = st;
    if (threadIdx.x == 0) (void)xb_add(&bar[XB_XCNT(b.x)], 1u);
    return b;
}
__device__ __forceinline__ void xcd_barrier_complete(unsigned* bar, unsigned x, unsigned& nloc, unsigned& nx) {
    const unsigned G = gridDim.x * gridDim.y * gridDim.z;
    unsigned sum, cnt, mine, sp = 0u;
    for (;;) {
        sum = 0u; cnt = 0u; mine = 0u;
#pragma unroll
        for (unsigned j = 0; j < 16; ++j) { const unsigned c = xb_ld(&bar[XB_XCNT(j)]); sum += c; cnt += (c > 0u) ? 1u : 0u; mine = (j == x) ? c : mine; }
        if (sum == G) break;
        __builtin_amdgcn_s_sleep(1);
        if ((++sp & 255u) == 0u) { if (xb_ld(&bar[XB_TMO])) break; if (sp > XB_SPIN_CAP) { atomicAdd(&bar[XB_TMO], 1u); break; } }
    }
    nloc = mine > 0u ? mine : 1u; nx = cnt > 0u ? cnt : 1u;
}
__device__ __forceinline__ void xcd_barrier(const XcdBarrier& b) {
    asm volatile("s_waitcnt vmcnt(0)" ::: "memory");
    __syncthreads();
    if (threadIdx.x == 0) {
        unsigned* bar = b.bar;
        __builtin_amdgcn_s_waitcnt(0);
        unsigned nloc = b.st[0], nx = b.st[1];
        if (nloc == 0u) { xcd_barrier_complete(bar, b.x, nloc, nx); b.st[0] = nloc; b.st[1] = nx; }
        const unsigned old = xb_add(&bar[XB_XSUB(b.x)], 1u);
        const unsigned gen = old / nloc;
        if (old + 1u == (gen + 1u) * nloc) {
            __builtin_amdgcn_fence(__ATOMIC_RELEASE, "agent");
            asm volatile("s_waitcnt vmcnt(0)" ::: "memory");
            const unsigned og = xb_add(&bar[XB_TOP], 1u);
            const unsigned tg = og / nx;
            if (og + 1u == (tg + 1u) * nx) xb_add(&bar[XB_TOPGEN], 1u);
            else XB_SPIN(xb_ld(&bar[XB_TOPGEN]) == tg, bar);
            __builtin_amdgcn_fence(__ATOMIC_ACQUIRE, "agent");
            xb_add(&bar[XB_XGEN(b.x)], 1u);
            asm volatile("s_waitcnt vmcnt(0)" ::: "memory");
        } else {
            XB_SPIN(xb_ld(&bar[XB_XGEN(b.x)]) == gen, bar);
            __builtin_amdgcn_fence(__ATOMIC_ACQUIRE, "agent");
            asm volatile("s_waitcnt vmcnt(0)" ::: "memory");
        }
    }
    __syncthreads();
}

constexpr int N_PHASES = 23;

__global__ void __launch_bounds__(NTHR, 2) mega_fwd(Params p) {
    extern __shared__ __attribute__((aligned(16))) unsigned char lds[];
    const int G = (int)gridDim.x, bid = (int)blockIdx.x;
#define tid tidx()
    unsigned char* ws = p.ws;
    h16* WinT = (h16*)(ws + WS_WIN); h16* WoutT = (h16*)(ws + WS_WOUT); h16* WxqT = (h16*)(ws + WS_WXQ); h16* WxoT = (h16*)(ws + WS_WXO); h16* WxkvT = (h16*)(ws + WS_WXKV);
    h16* memh = (h16*)(ws + WS_MEMH); h16* kvm = (h16*)(ws + WS_KVM); h16* kcmp = (h16*)(ws + WS_KCMP); h16* vcmpT = (h16*)(ws + WS_VCMP); h16* vsT = (h16*)(ws + WS_VST); h16* vwT = (h16*)(ws + WS_VWT);
    int* tope = (int*)(ws + WS_TOPE); float* topw = (float*)(ws + WS_TOPW);
    h16* xh = (h16*)(ws + WS_XH); h16* mix = (h16*)(ws + WS_MIX); h16* ox = (h16*)(ws + WS_OX); h16* hb = (h16*)(ws + WS_H); h16* nqr = (h16*)(ws + WS_NQR);
    float* kvb = (float*)(ws + WS_KVB); h16* prevT = (h16*)(ws + WS_PREVT);
    float* cosr = (float*)(ws + WS_COSR); float* sinr = (float*)(ws + WS_SINR); float* cosn = (float*)(ws + WS_COSN); float* sinn = (float*)(ws + WS_SINN); h16* kvmVT = (h16*)(ws + WS_KVMVT); f32x2* st1 = (f32x2*)(ws + WS_X1); h16* vh = (h16*)(ws + WS_X1H); float* scv = (float*)(ws + WS_SC); float* tcv = (float*)(ws + WS_TC); float* gb1 = (float*)(ws + WS_GB1); h16* WrTh = (h16*)(ws + WS_WRTH); h16* WrTl = (h16*)(ws + WS_WRTL); h16* Wc1T = (h16*)(ws + WS_WC1T); h16* hid = (h16*)(ws + WS_HID); unsigned* cmpoff = (unsigned*)(ws + WS_CMPOFF); float* peb = (float*)(ws + WS_PEB); h16* ksR = (h16*)(ws + WS_KSR); h16* kwR = (h16*)(ws + WS_KWR); h16* kx = (h16*)(ws + WS_KX);
    h16* rqr = (h16*)((unsigned char*)p.out + DO_RQR); h16* rkr = (h16*)((unsigned char*)p.out + DO_RKR); h16* rkzT = (h16*)((unsigned char*)p.out + DO_RKZT); h16* rvT = (h16*)((unsigned char*)p.out + DO_RVT); float* pre = p.out; float* x1 = (float*)(ws + WS_X1); h16* x1h = (h16*)(ws + WS_X1H);
    h16* qx = (h16*)(ws + WS_QX); float* x2 = (float*)(ws + WS_X2); h16* x2h = (h16*)(ws + WS_X2H);
    int* ctl = (int*)ws; unsigned* rowoff = (unsigned*)(ws + WS_ROWOFF); u32x2* rowmeta = (u32x2*)(ws + WS_ROWMETA);
    h16* WguT = (h16*)(ws + WS_WGUT); h16* WdT = (h16*)(ws + WS_WDT); h16* Hm = (h16*)(ws + WS_HM); h16* Yq = (h16*)(ws + WS_Y);
    float* fl = (float*)lds;
    const int lo = p.ph_lo, hi = p.ph_hi;
#define IN(k) (lo <= (k) && (k) < hi)
    { volatile LAS unsigned* st = (volatile LAS unsigned*)((LAS unsigned char*)lds + 131072); if (threadIdx.x < 2) st[threadIdx.x] = 0u; }
    __syncthreads();
    XcdBarrier xbar = xcd_barrier_post((unsigned*)(ws + WS_BAR), (volatile LAS unsigned*)((LAS unsigned char*)lds + 131072));
#define SEAM(k) do { if (IN(k) && IN((k) + 1)) xcd_barrier(xbar); } while (0)

    if (IN(0)) REPS(0) {
        { const int sub = tid >> 8, lt = tid & 255; float* tl = fl + sub * 1088;
          constexpr int T0 = (INP / 32) * (D / 32);
          for (int b0 = bid * 2; b0 < T0; b0 += G * 2) b_transpose_tile(p.w_in, D, INC, WinT, INP, b0 + sub, tl, lt); }
        { const int wv = __builtin_amdgcn_readfirstlane(tid >> 6), lane = tid & 63; LAS float* scr = (LAS float*)((LAS unsigned char*)lds + wv * 8704);
          constexpr int I1 = (D / 64) * (D / 32), I4 = (D / 64) * (2 * D / 32), I5 = (2048 / 64) * (256 / 32), IT = 3 * I1 + I4 + 2 * I5;
          for (int it0 = bid * 8 + wv; it0 < IT; it0 += G * 8) { int it = it0;
            if (it < I1) { w_transpose_item(p.w_out, D, D, WoutT, it, scr, lane); continue; } it -= I1;
            if (it < I1) { w_transpose_item(p.w_xq, D, D, WxqT, it, scr, lane, 1, 0, p.ln1g); continue; } it -= I1;
            if (it < I1) { w_transpose_item(p.w_xo, D, D, WxoT, it, scr, lane); continue; } it -= I1;
            if (it < I4) { w_transpose_item(p.w_xkv, D, 2 * D, WxkvT, it, scr, lane); continue; } it -= I4;
            if (it < I5) { w_transpose_item(p.w1k, 2048, 256, Wc1T, it, scr, lane); continue; } it -= I5;
            w_transpose_item(p.w1v, 2048, 256, Wc1T + 256 * 2048, it, scr, lane); } }
        __syncthreads();
        b_cvt(p.x, xh, (size_t)M * D / 4);
        b_cvt(p.mem, memh, (size_t)NB * MEML * D / 4);
        if (bid == 0) for (int i = tid; i < 1024; i += NTHR) ctl[i] = 0;
        b_tables(p.positions, cosr, sinr, cosn, sinn, (LAS float*)((LAS unsigned char*)lds));
        if (bid == 1) for (int i = tid; i < 2 * D; i += NTHR) gb1[i] = i < D ? p.ln1g[i] : p.ln1b[i - D];
        for (int cb = bid; cb < D / 4; cb += G) { const int ci = tid & 3, kk = tid >> 2; const int c = cb * 4 + ci; float sa = 0.f, ta = 0.f;
            for (int k = kk; k < D; k += 128) { const float w = p.w_xq[(size_t)k * D + c]; sa += p.ln1g[k] * w; ta += p.ln1b[k] * w; }
            fl[tid * 2] = sa; fl[tid * 2 + 1] = ta; __syncthreads();
            if (tid < 4) { float s = 0.f, t2 = 0.f; for (int k2 = 0; k2 < 128; ++k2) { s += fl[(k2 * 4 + tid) * 2]; t2 += fl[(k2 * 4 + tid) * 2 + 1]; } scv[cb * 4 + tid] = s; tcv[cb * 4 + tid] = t2; }
            __syncthreads(); }
        for (int idx = bid * NTHR + tid; idx < NE * D; idx += G * NTHR) { const int e = idx >> 10, k = idx & 1023; const float w = p.w_router[k * NE + e]; const h16 hi = (h16)w; WrTh[idx] = hi; WrTl[idx] = (h16)((w - (float)hi) * 2048.f); }
        for (int r = bid * NTHR + tid; r < 4096; r += G * NTHR) { const int g = r & 1, c = min((r >> 1) & 511, 510), b = r >> 10; cmpoff[r] = (unsigned)(((size_t)(b * T + 16 * c) * INP + g * 64) * 2); }
        { const int lane = tid & 63;
          for (int o = bid * 8 + (tid >> 6); o < 512; o += G * 8) { const int kv = o >> 8, j = o & 255; const float* pe = kv ? p.pe_v : p.pe_k; const float* w1 = kv ? p.w1v : p.w1k; float a = 0.f;
              for (int k = lane; k < 2048; k += 64) a += pe[k] * w1[(size_t)k * 256 + j];
              a = wave_sum(a); if (lane == 0) peb[o] = a; } }
    }
    SEAM(0);
    if (IN(1)) {
        REPS(1) { pg8::Gemm g{xh, WinT, M, INP, D}; pg8::StaticOrder S; S.init(g, G, bid); pg8::EpiF16 E{hb, INP};
          pg8::gemm_phase<pg8::EpiF16, pg8::StaticOrder>((PG8_LAS unsigned char*)lds, g.K, S, E); }
    }
    SEAM(1);
    if (IN(2)) REPS(2) {
        if (bid < 32) { CmpSched S{(const char*)hb, cmpoff, (const char*)Wc1T, bid}; pg8::EpiCmp1 E{hid, peb + (bid >> 4) * 256};
            pg8::gemm_phase<pg8::EpiCmp1, CmpSched>((PG8_LAS unsigned char*)lds, 2048, S, E, (size_t)INP * 2);
            pg8::Gemm g{memh, WxkvT, NB * MEML, 2 * D, D}; pg8::StaticOrder S2; S2.init(g, 32, bid); pg8::EpiF16 E2{kvm, 2 * D};
            pg8::gemm_phase<pg8::EpiF16, pg8::StaticOrder>((PG8_LAS unsigned char*)lds, g.K, S2, E2); }
        else { const int sub = tid >> 8, lt = tid & 255; const int b2 = bid - 32, G2 = G - 32;
        { const int wv = __builtin_amdgcn_readfirstlane(tid >> 6), lane = tid & 63; LAS h16* wsl = (LAS h16*)((LAS unsigned char*)lds + wv * 8704);
          for (int m0 = (b2 * 8 + wv) * 2; m0 < M; m0 += G2 * 16) { w_rope(hb, rqr, rkr, nqr, ksR, kwR, cosr, sinr, cosn, sinn, m0, lane); w_rope(hb, rqr, rkr, nqr, ksR, kwR, cosr, sinr, cosn, sinn, m0 + 1, lane); }
          for (int it = b2 * 8 + wv; it < 2 * NB * 2 * 128; it += G2 * 8) b_vtrans(hb, vsT, vwT, it, wsl, lane);
          for (int it = b2 * 8 + wv; it < NB * 4 * 256; it += G2 * 8) b_rtrans(p, hb, rvT, rkzT, cosr, sinr, it, wsl, lane); }
        } }
    SEAM(2);
    if (IN(3)) {
        REPS(30) b_cmp2(p, hid, kcmp, vcmpT);
        { const int sub = tid >> 8, lt = tid & 255;
          for (int b0 = bid * 2; b0 < NB * 4 * 16; b0 += G * 2) b_mvtrans(kvm, kvmVT, kx, b0 + sub, (h16*)(fl + sub * 2304), lt); }
        const int wv = __builtin_amdgcn_readfirstlane(tid >> 6), lane = tid & 63;
        REPS(31) for (int ch = bid; ch < NB * 4 * 64; ch += G) ret_kv_unit(rkzT, rvT, kvb, ch, wv, lane); }
    SEAM(3);
    if (IN(4)) {
        REPS(4) b_ret_scan(p, kvb, prevT);
        const int wv = __builtin_amdgcn_readfirstlane(tid >> 6), lane = tid & 63;
        __syncthreads();
        REPS(50) { const int bg = bid & 7;
            const int nper = G >> 3, jb = bid >> 3;
            for (int r = 0; r * nper < T / 32; ++r) { const int k = r * nper + ((r & 1) ? nper - 1 - jb : jb);
                if (k < T / 32) nsa_block_unit(hb, nqr, kcmp, vcmpT, vsT, vwT, ksR, kwR, mix, bg >> 1, bg & 1, (T / 32 - 1 - k) * 32, (LAS unsigned char*)lds, wv, lane); } }
    }
    SEAM(4);
    if (IN(5)) {
        const int wv = __builtin_amdgcn_readfirstlane(tid >> 6), lane = tid & 63;
        REPS(51) for (int ch = bid; ch < NB * 4 * 64; ch += G) ret_out_unit(p, hb, rqr, rkr, rvT, prevT, mix, ch, wv, lane);
    }
    SEAM(5);
    if (IN(6)) { pg8::Gemm g{mix, WoutT, M, D, D}; pg8::StaticOrder S; S.init(g, G, bid); pg8::EpiResStats E{vh, p.x, D, DN_ALPHA, st1};
        pg8::gemm_phase<pg8::EpiResStats, pg8::StaticOrder>((PG8_LAS unsigned char*)lds, g.K, S, E); }
    if (IN(6) && IN(8)) xcd_barrier(xbar);
    if (PROBE_DBL == 900) { for (int k = 0; k < 20; ++k) xcd_barrier(xbar); }
    if (IN(8)) { pg8::Gemm g{vh, WxqT, M, D, D}; pg8::StaticOrder S; S.init(g, G, bid); pg8::EpiQLn E{qx, D, st1, scv, tcv, st1 + (size_t)M * 16};
        pg8::gemm_phase<pg8::EpiQLn, pg8::StaticOrder>((PG8_LAS unsigned char*)lds, g.K, S, E);
        __builtin_amdgcn_fence(__ATOMIC_ACQUIRE, "agent"); asm volatile("s_waitcnt vmcnt(0)" ::: "memory"); __syncthreads();
        const int wv = __builtin_amdgcn_readfirstlane(tid >> 6), lane = tid & 63;
        xattn_block(qx, kx, kvmVT, ox, S, (LAS unsigned char*)lds, wv, lane); }
    if (IN(8) && IN(10)) xcd_barrier(xbar);
    if (IN(10)) { pg8::Gemm g{ox, WxoT, M, D, D}; pg8::StaticOrder S; S.init(g, G, bid); pg8::EpiResLn E{pre, vh, st1 + (size_t)M * 16, gb1};
        pg8::gemm_phase<pg8::EpiResLn, pg8::StaticOrder>((PG8_LAS unsigned char*)lds, g.K, S, E); }
    if (IN(10) && IN(12)) xcd_barrier(xbar);
    if (IN(12)) {
        { const int wv = __builtin_amdgcn_readfirstlane(tid >> 6), lane = tid & 63; LAS float* lg = (LAS float*)((LAS unsigned char*)lds + wv * 4096);
          for (int u = bid * 8 + wv; u < M / 16; u += G * 8) router_unit(p, pre, x2h, WrTh, WrTl, tope, topw, ctl + CTL_CNT, u * 16, lg, lane); }
        __syncthreads();
        if (bid == 0 && tid < NQ) ctl[CTL_CNT + tid * 65 + 64] = QT;
        for (int i = bid * NTHR + tid; i < CAP; i += G * NTHR) { rowoff[i] = 0u; rowmeta[i] = (u32x2){0xffffffffu, 0u}; }
        { const int wv = __builtin_amdgcn_readfirstlane(tid >> 6), lane = tid & 63; LAS float* scr = (LAS float*)((LAS unsigned char*)lds + wv * 8704);
          REPS(121) for (int it = bid * 8 + wv; it < 65 * 384; it += G * 8) { const int e = it / 384, r = it % 384;
            const float* wg = e < 64 ? p.w_gate + (size_t)e * D * EFF : p.ws_gate; const float* wu = e < 64 ? p.w_up + (size_t)e * D * EFF : p.ws_up; const float* wd = e < 64 ? p.w_down + (size_t)e * EFF * D : p.ws_down;
            if (r < 128) w_transpose_item(wg, D, EFF, WguT + (size_t)e * 512 * D, r, scr, lane, 2, 0);
            else if (r < 256) w_transpose_item(wu, D, EFF, WguT + (size_t)e * 512 * D, r - 128, scr, lane, 2, 1);
            else w_transpose_item(wd, EFF, D, WdT + (size_t)e * D * EFF, r - 256, scr, lane); } }
    }
    SEAM(12);
    if (IN(13)) b_scatter(ctl, tope, topw, rowoff, rowmeta, (int*)lds);
    SEAM(13);
    if (IN(14)) REPS(14) { G1Sched S{ctl, (const char*)x2h, rowoff, (const char*)WguT, G, bid}; pg8::EpiGateUp E{Hm};
        pg8::gemm_phase<pg8::EpiGateUp, G1Sched>((PG8_LAS unsigned char*)lds, D, S, E); }
    SEAM(14);
#pragma unroll 1
    for (int q = 0; q < NQ; ++q) {
        if (IN(15 + 2 * q)) REPS(15) { G2Sched S{ctl, (const char*)Hm, (const char*)WdT, q, G, bid}; pg8::EpiDown E{Yq, rowmeta};
            pg8::gemm_phase<pg8::EpiDown, G2Sched>((PG8_LAS unsigned char*)lds, EFF, S, E); }
        SEAM(15 + 2 * q);
        if (IN(16 + 2 * q)) REPS(16) b_combine(p, x2h, Yq, q);
        if (q < NQ - 1) SEAM(16 + 2 * q);
    }
#undef IN
#undef SEAM
#undef tid
}

#ifndef MK_PER_PHASE
#define MK_PER_PHASE 0
#endif
extern "C" void kernel_launch(void* const* d_in, const int* in_sizes, int n_in, void* d_out, int out_size, void* d_ws, size_t ws_size, hipStream_t stream) {
    static int grid = 0;
    if (grid == 0) {
        if (n_in != 28 || in_sizes[0] != M * D || out_size != M * D || ws_size < WS_NEED) { fprintf(stderr, "kernel_launch: unexpected shapes (n_in %d, in0 %d, out %d, ws %zu)\n", n_in, n_in > 0 ? in_sizes[0] : -1, out_size, ws_size); grid = -1; return; }
        if (hipFuncSetAttribute((const void*)mega_fwd, hipFuncAttributeMaxDynamicSharedMemorySize, LDS_BYTES) != hipSuccess) { fprintf(stderr, "kernel_launch: hipFuncSetAttribute failed\n"); grid = -1; return; }
        int dev = 0, cus = 0, per_cu = 0;
        hipGetDevice(&dev); hipDeviceGetAttribute(&cus, hipDeviceAttributeMultiprocessorCount, dev);
        if (hipOccupancyMaxActiveBlocksPerMultiprocessor(&per_cu, (const void*)mega_fwd, NTHR, LDS_BYTES) != hipSuccess || per_cu < 1) { fprintf(stderr, "kernel_launch: occupancy query failed (%d)\n", per_cu); grid = -1; return; }
        grid = cus;
    }
    if (grid < 0) return;
    Params p{};
    p.x = (const float*)d_in[0]; p.mem = (const float*)d_in[1]; p.positions = (const int*)d_in[2];
    p.w_in = (const float*)d_in[3]; p.pe_k = (const float*)d_in[4]; p.pe_v = (const float*)d_in[5];
    p.w1k = (const float*)d_in[6]; p.w2k = (const float*)d_in[7]; p.w1v = (const float*)d_in[8]; p.w2v = (const float*)d_in[9];
    p.w_out = (const float*)d_in[10]; p.ln1g = (const float*)d_in[11]; p.ln1b = (const float*)d_in[12];
    p.w_xq = (const float*)d_in[13]; p.w_xkv = (const float*)d_in[14]; p.w_xo = (const float*)d_in[15];
    p.ln2g = (const float*)d_in[16]; p.ln2b = (const float*)d_in[17]; p.w_router = (const float*)d_in[18]; p.rbias = (const float*)d_in[19];
    p.w_gate = (const float*)d_in[20]; p.w_up = (const float*)d_in[21]; p.w_down = (const float*)d_in[22];
    p.ws_gate = (const float*)d_in[23]; p.ws_up = (const float*)d_in[24]; p.ws_down = (const float*)d_in[25];
    p.ln3g = (const float*)d_in[26]; p.ln3b = (const float*)d_in[27];
    p.out = (float*)d_out; p.ws = (unsigned char*)d_ws;
    for (int i = 0; i < 4; ++i) p.lg[i] = (float)std::log(1.0 - std::pow(2.0, -5.0 - (double)i));
#if MK_PER_PHASE
    for (int ph = 0; ph < N_PHASES; ++ph) { p.ph_lo = ph; p.ph_hi = ph + 1; hipLaunchKernelGGL(mega_fwd, dim3(grid), dim3(NTHR), LDS_BYTES, stream, p); }
#else
    p.ph_lo = 0; p.ph_hi = N_PHASES;
    if (hipMemsetAsync((char*)d_ws + WS_BAR, 0, XCD_BAR_WORDS * 4, stream) != hipSuccess) { fprintf(stderr, "kernel_launch: memset failed\n"); return; }
    hipLaunchKernelGGL(mega_fwd, dim3(grid), dim3(NTHR), LDS_BYTES, stream, p);
#endif
}
```

```cpp
#include <hip/hip_runtime.h>
#include <cstdio>
#include <cstdint>
#include <cmath>

typedef _Float16 h16;
typedef _Float16 h16x8 __attribute__((ext_vector_type(8)));
typedef _Float16 h16x2 __attribute__((ext_vector_type(2)));
typedef _Float16 h16x4 __attribute__((ext_vector_type(4)));
typedef float f32x2 __attribute__((ext_vector_type(2)));
typedef float f32x4 __attribute__((ext_vector_type(4)));
typedef unsigned u32x4 __attribute__((ext_vector_type(4)));
typedef unsigned u32x2 __attribute__((ext_vector_type(2)));

__device__ __forceinline__ int tidx() { int t = (int)threadIdx.x; asm volatile("" : "+v"(t)); return t; }

#ifndef PROBE_DBL
#define PROBE_DBL -1
#endif
#define REPS(k) for (int _rep = 0; _rep < ((PROBE_DBL) == (k) ? 2 : 1); ++_rep)

constexpr int NB = 4, T = 8192, D = 1024, M = NB * T;
constexpr int INC = 3352, INP = 3584;
constexpr int C_RQ = 0, C_RK = 512, C_RV = 1024, C_RG = 1536, C_NQ = 2048, C_NKC = 2560, C_NVC = 2688, C_NKS = 2816, C_NVS = 2944, C_NKW = 3072, C_NVW = 3200, C_NG = 3328;
constexpr int MEML = 256;
constexpr int NE = 64, EFF = 256;
constexpr float LN_EPS = 1e-5f;
constexpr float DN_ALPHA = 1.189207115002721f;
constexpr float NEGF = -1e30f;

constexpr size_t MiB = 1u << 20;
constexpr size_t WS_WIN = 1 * MiB, WS_WOUT = 8 * MiB, WS_WXQ = 10 * MiB, WS_WXO = 12 * MiB, WS_WXKV = 14 * MiB, WS_MEMH = 18 * MiB, WS_KVM = 20 * MiB;
constexpr size_t WS_KCMP = 24 * MiB, WS_VCMP = 25 * MiB, WS_TOPE = 26 * MiB, WS_TOPW = 27 * MiB;
constexpr size_t WS_XH = 32 * MiB, WS_MIX = 32 * MiB, WS_OX = 32 * MiB;
constexpr size_t WS_H = 96 * MiB, WS_NQR = 320 * MiB, WS_KVB = 352 * MiB, WS_PREV = 416 * MiB;
constexpr size_t WS_PRE = 96 * MiB, WS_X1 = 224 * MiB, WS_X1H = 352 * MiB, WS_QX = 416 * MiB, WS_X2 = 130 * MiB;
constexpr size_t WS_X2H = 32 * MiB, WS_WDT = 96 * MiB, WS_HM = 129 * MiB, WS_WGUT = 306 * MiB, WS_Y = 306 * MiB;
constexpr size_t WS_ROWOFF = 1 * MiB, WS_ROWMETA = 3 * MiB;
constexpr size_t WS_VST = 480 * MiB, WS_VWT = 488 * MiB, WS_COSR = 496 * MiB, WS_SINR = 504 * MiB, WS_COSN = 28 * MiB, WS_SINN = 29 * MiB, WS_KVMVT = 30 * MiB;
constexpr size_t WS_SC = 131072 + 32768, WS_TC = 131072 + 32768 + 4096, WS_GB1 = 131072 + 32768 + 8192;
constexpr size_t WS_WRTH = 262144, WS_WRTL = 393216;
constexpr size_t WS_WC1T = 464 * MiB, WS_HID = 466 * MiB, WS_CMPOFF = 131072, WS_PEB = 131072 + 16384;
constexpr size_t WS_PREVT = 416 * MiB, WS_KSR = 448 * MiB, WS_KWR = 456 * MiB, WS_KX = 26 * MiB;
constexpr size_t DO_RQR = 0, DO_RKR = 32 * MiB, DO_RKZT = 64 * MiB, DO_RVT = 96 * MiB;
constexpr size_t WS_NEED = 512 * MiB;
constexpr int NQ = 4, QT = M / NQ, NVE = NQ * 65, CAP_TILES = 1412, CAP = CAP_TILES * 256;
constexpr size_t WS_BAR = 65536;
constexpr int CTL_CNT = 0, CTL_CUR = 512, CTL_PST = 1024, CTL_TQS = 1536, CTL_NT1 = 1600, CTL_TVE = 2048, CTL_T2 = 4096;

__device__ __forceinline__ float fsilu(float v) { return v * __builtin_amdgcn_rcpf(1.f + __expf(-v)); }
namespace pg8 {
#define PG8_LAS __attribute__((address_space(3)))
typedef short s16x8 __attribute__((ext_vector_type(8)));
constexpr int BM = 256, BK = 64, HALF = 128, HTB = HALF * BK * 2, STAGE_BYTES = 8 * HTB, NXCD = 8, WGM = 8;
__host__ __device__ __forceinline__ int lds_byte(int r, int c) { const int st = (r >> 4) * 2 + (c >> 5), rr = r & 15, cc = c & 31, ob = rr * 64 + cc * 2; return st * 1024 + (ob ^ (((ob >> 9) & 1) << 5)); }
__host__ __device__ __forceinline__ void stage_rc(int b, int& R, int& C) { const int st = b / 1024, sb = b % 1024, swz = sb ^ (((sb >> 9) & 1) << 5); R = (st >> 1) * 16 + swz / 64; C = (st & 1) * 32 + (swz % 64) / 2; }
__host__ __device__ __forceinline__ int perm32(int rho) { const int n = rho >> 4, i = rho & 15; return 8 * (i >> 2) + 4 * n + (i & 3); }
struct Unit { int pm, pn; const char* A; const char* B; const unsigned* gat; };
struct Gemm { const h16* A; const h16* Bt; int M, N, K; };
struct StaticOrder {
    int nM, nN, nwg, G, c; const char* A; const char* B; size_t tstep;
    __device__ void init(const Gemm& g, int G_, int c_) { nM = g.M / BM; nN = g.N / BM; nwg = nM * nN; G = G_; c = c_; A = (const char*)g.A; B = (const char*)g.Bt; tstep = (size_t)BM * g.K * 2; }
    __device__ bool next(int i, Unit& u) const {
        const long L = (long)i * G + c; if (L >= nwg) return false;
        int wgid = (int)L; { const int q = nwg / NXCD, r = nwg % NXCD, xcd = wgid % NXCD, off = wgid / NXCD; wgid = (xcd < r ? xcd * (q + 1) : r * (q + 1) + (xcd - r) * q) + off; }
        const int nig = WGM * nN, gid = wgid / nig, fm = gid * WGM, gsz = (nM - fm) < WGM ? (nM - fm) : WGM;
        u.pm = fm + ((wgid % nig) % gsz); u.pn = (wgid % nig) / gsz; u.A = A + (size_t)u.pm * tstep; u.B = B + (size_t)u.pn * tstep; u.gat = nullptr; return true;
    }
};
__device__ __forceinline__ unsigned cvt_pk_f16(float lo, float hi) { f32x2 v = {lo, hi}; h16x2 h = __builtin_convertvector(v, h16x2); return __builtin_bit_cast(unsigned, h); }

struct EpiF16 {
    static constexpr bool PERM = true;
    h16* O; int ldc;
    __device__ __forceinline__ void operator()(const f32x4 (&acc)[2][2][4][2], const Unit& u, int wr, int wc, int fr, int fq) const {
        const bool odd = fr & 1; const int row0 = u.pm * BM + wr * 64 + fr; const int col0 = u.pn * BM + wc * 64 + 8 * fq + (odd ? 32 : 0);
#pragma unroll
        for (int ai = 0; ai < 2; ++ai)
#pragma unroll
            for (int m = 0; m < 4; ++m) { const int r = row0 + ai * HALF + m * 16;
                const u32x4 P0 = __builtin_bit_cast(u32x4, __builtin_convertvector(__builtin_shufflevector(acc[ai][0][m][0], acc[ai][0][m][1], 0, 1, 2, 3, 4, 5, 6, 7), h16x8));
                const u32x4 P1 = __builtin_bit_cast(u32x4, __builtin_convertvector(__builtin_shufflevector(acc[ai][1][m][0], acc[ai][1][m][1], 0, 1, 2, 3, 4, 5, 6, 7), h16x8));
                const u32x4 snd = odd ? P0 : P1; u32x4 rcv;
#pragma unroll
                for (int d = 0; d < 4; ++d) rcv[d] = (unsigned)__builtin_amdgcn_update_dpp(0, (int)snd[d], 0xB1, 0xf, 0xf, true);
                *(u32x4*)(O + (size_t)(r & ~1) * ldc + col0) = odd ? rcv : P0;
                *(u32x4*)(O + (size_t)(r | 1) * ldc + col0) = odd ? P1 : rcv; }
    }
};
__device__ __forceinline__ float rsum4(float v) {
    auto a = __builtin_amdgcn_permlane16_swap(__float_as_uint(v), __float_as_uint(v), false, false); v = __uint_as_float(a[0]) + __uint_as_float(a[1]);
    auto c = __builtin_amdgcn_permlane32_swap(__float_as_uint(v), __float_as_uint(v), false, false); return __uint_as_float(c[0]) + __uint_as_float(c[1]); }
struct EpiResStats {
    static constexpr bool PERM = true;
    h16* Vh; const float* R; int ldc; float alpha; f32x2* st;
    __device__ __forceinline__ void operator()(const f32x4 (&acc)[2][2][4][2], const Unit& u, int wr, int wc, int fr, int fq) const {
        const bool odd = fr & 1; const int row0 = u.pm * BM + wr * 64 + fr, col0 = u.pn * BM + wc * 64 + 8 * fq;
#pragma unroll
        for (int ai = 0; ai < 2; ++ai)
#pragma unroll
            for (int m = 0; m < 4; ++m) { const int row = row0 + ai * HALF + m * 16; const size_t off = (size_t)row * ldc + col0; float s = 0.f, q = 0.f; u32x4 P[2];
#pragma unroll
                for (int bj = 0; bj < 2; ++bj) { const f32x4 r0 = *(const f32x4*)(R + off + bj * 32), r1 = *(const f32x4*)(R + off + bj * 32 + 4);
                    const f32x4 v0 = r0 * alpha + acc[ai][bj][m][0], v1 = r1 * alpha + acc[ai][bj][m][1];
                    P[bj] = __builtin_bit_cast(u32x4, __builtin_convertvector(__builtin_shufflevector(v0, v1, 0, 1, 2, 3, 4, 5, 6, 7), h16x8));
                    s += ((v0[0] + v0[1]) + (v0[2] + v0[3])) + ((v1[0] + v1[1]) + (v1[2] + v1[3]));
                    q += ((v0[0] * v0[0] + v0[1] * v0[1]) + (v0[2] * v0[2] + v0[3] * v0[3])) + ((v1[0] * v1[0] + v1[1] * v1[1]) + (v1[2] * v1[2] + v1[3] * v1[3])); }
                const u32x4 snd = odd ? P[0] : P[1]; u32x4 rcv;
#pragma unroll
                for (int d = 0; d < 4; ++d) rcv[d] = (unsigned)__builtin_amdgcn_update_dpp(0, (int)snd[d], 0xB1, 0xf, 0xf, true);
                h16* const vb = Vh + col0 + (odd ? 32 : 0);
                *(u32x4*)(vb + (size_t)(row & ~1) * ldc) = odd ? rcv : P[0];
                *(u32x4*)(vb + (size_t)(row | 1) * ldc) = odd ? P[1] : rcv;
                s = rsum4(s); q = rsum4(q);
                if (fq == 0) st[(size_t)row * 16 + u.pn * 4 + wc] = (f32x2){s, q}; }
    }
};
__device__ __forceinline__ void row_stats(const f32x2* st, int row, int fq, float& mean, float& rstd) {
    float s = 0.f, q = 0.f;
#pragma unroll
    for (int k = 0; k < 4; ++k) { const f32x2 pz = st[(size_t)row * 16 + 4 * fq + k]; s += pz[0]; q += pz[1]; }
    s = rsum4(s); q = rsum4(q);
    mean = s * (1.f / 1024.f); rstd = rsqrtf(fmaxf(q * (1.f / 1024.f) - mean * mean, 0.f) + 1e-5f);
}
struct EpiQLn {
    static constexpr bool PERM = true;
    h16* O; int ldc; const f32x2* st; const float* sc; const float* tc; f32x2* stf;
    __device__ __forceinline__ void operator()(const f32x4 (&acc)[2][2][4][2], const Unit& u, int wr, int wc, int fr, int fq) const {
        const bool odd = fr & 1; const int row0 = u.pm * BM + wr * 64 + fr; const int col0 = u.pn * BM + wc * 64 + 8 * fq;
        float mean8[2][4], rstd8[2][4];
#pragma unroll
        for (int ai = 0; ai < 2; ++ai)
#pragma unroll
            for (int m = 0; m < 4; ++m) { const int row = row0 + ai * HALF + m * 16; row_stats(st, row, fq, mean8[ai][m], rstd8[ai][m]);
                if (u.pn == 0 && wc == 0 && fq == 0) stf[row] = (f32x2){mean8[ai][m], rstd8[ai][m]}; }
        f32x4 sc0[2], sc1[2], tc0[2], tc1[2];
#pragma unroll
        for (int bj = 0; bj < 2; ++bj) { const int c = col0 + bj * 32; sc0[bj] = *(const f32x4*)(sc + c); sc1[bj] = *(const f32x4*)(sc + c + 4); tc0[bj] = *(const f32x4*)(tc + c); tc1[bj] = *(const f32x4*)(tc + c + 4); }
        h16* const ob = O + col0 + (odd ? 32 : 0);
#pragma unroll
        for (int ai = 0; ai < 2; ++ai)
#pragma unroll
            for (int m = 0; m < 4; ++m) { const int row = row0 + ai * HALF + m * 16; const float mean = mean8[ai][m], rstd = rstd8[ai][m]; u32x4 P[2];
#pragma unroll
                for (int bj = 0; bj < 2; ++bj) { const f32x4 v0 = (acc[ai][bj][m][0] - sc0[bj] * mean) * rstd + tc0[bj], v1 = (acc[ai][bj][m][1] - sc1[bj] * mean) * rstd + tc1[bj];
                    P[bj] = __builtin_bit_cast(u32x4, __builtin_convertvector(__builtin_shufflevector(v0, v1, 0, 1, 2, 3, 4, 5, 6, 7), h16x8)); }
                const u32x4 snd = odd ? P[0] : P[1]; u32x4 rcv;
#pragma unroll
                for (int d = 0; d < 4; ++d) rcv[d] = (unsigned)__builtin_amdgcn_update_dpp(0, (int)snd[d], 0xB1, 0xf, 0xf, true);
                *(u32x4*)(ob + (size_t)(row & ~1) * ldc) = odd ? rcv : P[0];
                *(u32x4*)(ob + (size_t)(row | 1) * ldc) = odd ? P[1] : rcv; }
    }
};
struct EpiResLn {
    static constexpr bool PERM = true;
    float* C; const h16* Vh; const f32x2* stf; const float* gb; f32x2* st2;
    static constexpr int ldc = 1024; static constexpr float alpha = 1.189207115002721f;
    __device__ __forceinline__ void operator()(const f32x4 (&acc)[2][2][4][2], const Unit& u, int wr, int wc, int fr, int fq) const {
        const bool odd = fr & 1; const int row0 = u.pm * BM + wr * 64 + fr, col0 = u.pn * BM + wc * 64 + 8 * fq;
        float* const cb = C + col0 + (odd ? 4 : 0);
        f32x2 ms8[2][4];
#pragma unroll
        for (int ai = 0; ai < 2; ++ai)
#pragma unroll
            for (int m = 0; m < 4; ++m) ms8[ai][m] = stf[row0 + ai * HALF + m * 16];
#pragma unroll
        for (int ai = 0; ai < 2; ++ai)
#pragma unroll
            for (int m = 0; m < 4; ++m) { const int row = row0 + ai * HALF + m * 16; const size_t off = (size_t)row * ldc + col0; const float mean = ms8[ai][m][0], rstd = ms8[ai][m][1]; float s = 0.f, q = 0.f;
#pragma unroll
                for (int bj = 0; bj < 2; ++bj) { const int c = col0 + bj * 32; const h16x8 vh8 = *(const h16x8*)(Vh + off + bj * 32);
                    const f32x4 va = __builtin_convertvector(__builtin_shufflevector(vh8, vh8, 0, 1, 2, 3), f32x4), vb = __builtin_convertvector(__builtin_shufflevector(vh8, vh8, 4, 5, 6, 7), f32x4);
                    const f32x4 o0 = ((va - mean) * rstd * *(const f32x4*)(gb + c) + *(const f32x4*)(gb + 1024 + c)) * alpha + acc[ai][bj][m][0];
                    const f32x4 o1 = ((vb - mean) * rstd * *(const f32x4*)(gb + c + 4) + *(const f32x4*)(gb + 1024 + c + 4)) * alpha + acc[ai][bj][m][1];
                    s += ((o0[0] + o0[1]) + (o0[2] + o0[3])) + ((o1[0] + o1[1]) + (o1[2] + o1[3]));
                    q += ((o0[0] * o0[0] + o0[1] * o0[1]) + (o0[2] * o0[2] + o0[3] * o0[3])) + ((o1[0] * o1[0] + o1[1] * o1[1]) + (o1[2] * o1[2] + o1[3] * o1[3]));
                    const u32x4 snd = __builtin_bit_cast(u32x4, odd ? o0 : o1), own = __builtin_bit_cast(u32x4, odd ? o1 : o0); u32x4 rcv;
#pragma unroll
                    for (int d = 0; d < 4; ++d) rcv[d] = (unsigned)__builtin_amdgcn_update_dpp(0, (int)snd[d], 0xB1, 0xf, 0xf, true);
                    *(u32x4*)(cb + (size_t)(row & ~1) * ldc + bj * 32) = odd ? rcv : own;
                    *(u32x4*)(cb + (size_t)(row | 1) * ldc + bj * 32) = odd ? own : rcv; }
                s = rsum4(s); q = rsum4(q);
                if (fq == 0) st2[(size_t)row * 16 + u.pn * 4 + wc] = (f32x2){s, q}; }
    }
};
struct EpiCmp1 {
    static constexpr bool PERM = true;
    h16* O; const float* peb;
    __device__ __forceinline__ void operator()(const f32x4 (&acc)[2][2][4][2], const Unit& u, int wr, int wc, int fr, int fq) const {
        const int row0 = u.pm * BM + wr * 64 + fr; const int col0 = wc * 32 + 8 * fq;
#pragma unroll
        for (int bj = 0; bj < 2; ++bj) { const f32x4 b0 = *(const f32x4*)(peb + col0 + bj * HALF), b1 = *(const f32x4*)(peb + col0 + bj * HALF + 4);
#pragma unroll
            for (int ai = 0; ai < 2; ++ai)
#pragma unroll
                for (int m = 0; m < 4; ++m) { f32x4 v0 = acc[ai][bj][m][0] + b0, v1 = acc[ai][bj][m][1] + b1;
#pragma unroll
                    for (int r = 0; r < 4; ++r) { v0[r] = fsilu(v0[r]); v1[r] = fsilu(v1[r]); }
                    *(h16x8*)(O + (size_t)(row0 + ai * HALF + m * 16) * 256 + col0 + bj * HALF) = __builtin_convertvector(__builtin_shufflevector(v0, v1, 0, 1, 2, 3, 4, 5, 6, 7), h16x8); } }
    }
};
struct EpiGateUp {
    static constexpr bool PERM = true;
    h16* H;
    __device__ __forceinline__ void operator()(const f32x4 (&acc)[2][2][4][2], const Unit& u, int wr, int wc, int fr, int fq) const {
        const int row0 = u.pm * BM + wr * 64 + fr; const int col0 = u.pn * 128 + wc * 32 + 8 * fq;
#pragma unroll
        for (int ai = 0; ai < 2; ++ai)
#pragma unroll
            for (int m = 0; m < 4; ++m) { h16* rowp = H + (size_t)(row0 + ai * HALF + m * 16) * 256 + col0; h16x8 o;
#pragma unroll
                for (int bj = 0; bj < 2; ++bj) { const f32x4 v0 = acc[ai][bj][m][0], v1 = acc[ai][bj][m][1];
                    o[4 * bj] = (h16)(fsilu(v0[0]) * v0[1]); o[4 * bj + 1] = (h16)(fsilu(v0[2]) * v0[3]); o[4 * bj + 2] = (h16)(fsilu(v1[0]) * v1[1]); o[4 * bj + 3] = (h16)(fsilu(v1[2]) * v1[3]); }
                *(h16x8*)rowp = o; }
    }
};
struct EpiDown {
    static constexpr bool PERM = true;
    h16* Y; const u32x2* rowmeta; const int* t2;
    __device__ __forceinline__ void operator()(const f32x4 (&acc)[2][2][4][2], const Unit& u, int wr, int wc, int fr, int fq) const {
        const int lr0 = wr * 64 + fr, nv = t2[3 * u.pm + 2]; const int row0 = t2[3 * u.pm] + lr0; const int col0 = u.pn * BM + wc * 64 + 8 * fq;
        u32x2 md8[2][4];
#pragma unroll
        for (int ai = 0; ai < 2; ++ai)
#pragma unroll
            for (int m = 0; m < 4; ++m) md8[ai][m] = rowmeta[row0 + ai * HALF + m * 16];
        const bool odd = fr & 1; h16* const yb = Y + col0 + (odd ? 32 : 0);
#pragma unroll
        for (int ai = 0; ai < 2; ++ai)
#pragma unroll
            for (int m = 0; m < 4; ++m) { const int slot = (int)md8[ai][m].x; const float w8 = __uint_as_float(md8[ai][m].y); const int lr = lr0 + ai * HALF + m * 16;
                const int slotn = __builtin_amdgcn_update_dpp(0, slot, 0xB1, 0xf, 0xf, true);
                const bool okown = slot >= 0 && lr < nv, oknb = slotn >= 0 && (lr ^ 1) < nv;
                const u32x4 P0 = __builtin_bit_cast(u32x4, __builtin_convertvector(__builtin_shufflevector(acc[ai][0][m][0] * w8, acc[ai][0][m][1] * w8, 0, 1, 2, 3, 4, 5, 6, 7), h16x8));
                const u32x4 P1 = __builtin_bit_cast(u32x4, __builtin_convertvector(__builtin_shufflevector(acc[ai][1][m][0] * w8, acc[ai][1][m][1] * w8, 0, 1, 2, 3, 4, 5, 6, 7), h16x8));
                const u32x4 snd = odd ? P0 : P1; u32x4 rcv;
#pragma unroll
                for (int d = 0; d < 4; ++d) rcv[d] = (unsigned)__builtin_amdgcn_update_dpp(0, (int)snd[d], 0xB1, 0xf, 0xf, true);
                if (odd ? oknb : okown) *(u32x4*)(yb + (size_t)(odd ? slotn : slot) * 1024) = odd ? rcv : P0;
                if (odd ? okown : oknb) *(u32x4*)(yb + (size_t)(odd ? slot : slotn) * 1024) = odd ? P1 : rcv; }
    }
};

template <class T> struct adjb { static constexpr bool v = false; };
template <> struct adjb<EpiDown> { static constexpr bool v = true; };
template <> struct adjb<EpiF16> { static constexpr bool v = true; };
template <> struct adjb<EpiResStats> { static constexpr bool v = true; };
template <> struct adjb<EpiQLn> { static constexpr bool v = true; };
template <> struct adjb<EpiResLn> { static constexpr bool v = true; };
template <class T> struct adjg { static constexpr bool v = false; };
template <> struct adjg<EpiGateUp> { static constexpr bool v = true; };
template <class T> struct erp { static constexpr int v = 1; };
template <class T> struct krp { static constexpr int v = 1; };
#define PROBE_EPI(T, x) template <> struct erp<T> { static constexpr int v = (PROBE_DBL == 602 || PROBE_DBL == 602 + 10 * (x)) ? 2 : 1; }; template <> struct krp<T> { static constexpr int v = (PROBE_DBL == 601 || PROBE_DBL == 601 + 10 * (x)) ? 2 : 1; };
PROBE_EPI(EpiF16, 1) PROBE_EPI(EpiGateUp, 2) PROBE_EPI(EpiDown, 3)
#undef PROBE_EPI
template <class Epi, class Sched>
__device__ __forceinline__ void gemm_phase(PG8_LAS unsigned char* lds, const int K, const Sched S, const Epi E, const size_t kstepA = (size_t)(BK * 2)) {
    const int tid = tidx(), wid = __builtin_amdgcn_readfirstlane(tid >> 6), lane = tid & 63, wr = wid >> 2, wc = wid & 3, fr = lane & 15, fq = lane >> 4;
    const int nt = K / BK;
    int R0, C0; stage_rc(tid * 16, R0, C0);
    const unsigned cb2 = (unsigned)C0 * 2u;
    unsigned voffB[2];
#pragma unroll
    for (int i = 0; i < 2; ++i) { const int R = R0 + 64 * i; const int Rb = Epi::PERM ? ((R & ~31) + perm32(R & 31)) : R; const int Rg = adjg<Epi>::v ? (Rb >> 5) * 64 + 2 * (Rb & 24) + (Rb & 7) : adjb<Epi>::v ? (Rb >> 5) * 64 + (Rb & 31) : Rb; voffB[i] = (unsigned)(Rg * K) * 2u + cb2; }
    const size_t kstep = (size_t)(BK * 2);
    const size_t hstep = (size_t)(adjg<Epi>::v ? 8 : adjb<Epi>::v ? 32 : HALF) * K * 2;
    const unsigned ldsw = (unsigned)wid * 1024u;
    const int aoff = lds_byte(wr * 64 + fr, fq * 8), boff = lds_byte(wc * 32 + fr, fq * 8);
#define PG8_MKVA(u, va) do { _Pragma("unroll") for (int _h = 0; _h < 2; ++_h) _Pragma("unroll") for (int _i = 0; _i < 2; ++_i) { const int _r = _h * HALF + R0 + 64 * _i; \
        (va)[_h][_i] = ((u).gat ? (u).gat[_r] : (unsigned)(_r * K) * 2u) + cb2; } } while (0)
#define PG8_SA(b, h) (((b) * 2 + (h)) * HTB)
#define PG8_SB(b, h) ((4 + (b) * 2 + (h)) * HTB)
#define PG8_STAGE(bufoff, gbase, voff) do { _Pragma("unroll") for (int _i = 0; _i < 2; ++_i) \
        __builtin_amdgcn_global_load_lds((const unsigned*)((const char*)(gbase) + (voff)[_i]), (PG8_LAS unsigned*)(lds + (bufoff) + ldsw + _i * 8192), 16, 0, 0); } while (0)
#define PG8_LDA(dst, b, h) do { _Pragma("unroll") for (int m = 0; m < 4; ++m) _Pragma("unroll") for (int k = 0; k < 2; ++k) dst[m][k] = *(const PG8_LAS s16x8*)(lds + PG8_SA(b, h) + aoff + m * 2048 + k * 1024); } while (0)
#define PG8_LDB(dst, b, h) do { _Pragma("unroll") for (int n = 0; n < 2; ++n) _Pragma("unroll") for (int k = 0; k < 2; ++k) dst[n][k] = *(const PG8_LAS s16x8*)(lds + PG8_SB(b, h) + boff + n * 2048 + k * 1024); } while (0)
#define PG8_MMA(ai, bj, At, Bt) do { __builtin_amdgcn_s_setprio(1); _Pragma("unroll") for (int m = 0; m < 4; ++m) _Pragma("unroll") for (int n = 0; n < 2; ++n) _Pragma("unroll") for (int k = 0; k < 2; ++k) \
        acc[ai][bj][m][n] = __builtin_amdgcn_mfma_f32_16x16x32_f16(__builtin_bit_cast(h16x8, Bt[n][k]), __builtin_bit_cast(h16x8, At[m][k]), acc[ai][bj][m][n], 0, 0, 0); __builtin_amdgcn_s_setprio(0); } while (0)
#define PG8_WAIT_V(n) asm volatile("s_waitcnt vmcnt(" #n ")" ::: "memory")
#define PG8_WAIT_L(n) asm volatile("s_waitcnt lgkmcnt(" #n ")" ::: "memory")
#define PG8_BAR __builtin_amdgcn_s_barrier()
#define PG8_SCHED __builtin_amdgcn_sched_barrier(0)
    Unit cur, nxt; int ui = 0;
    if (!S.next(0, cur)) return;
    unsigned va[2][2];
    PG8_MKVA(cur, va);
    f32x4 acc[2][2][4][2];
#pragma unroll
    for (int a = 0; a < 2; ++a)
#pragma unroll
        for (int b = 0; b < 2; ++b)
#pragma unroll
            for (int m = 0; m < 4; ++m)
#pragma unroll
                for (int n = 0; n < 2; ++n) acc[a][b][m][n] = (f32x4){0.f, 0.f, 0.f, 0.f};
    s16x8 At[4][2], B0[2][2], B1[2][2];
    const char* cA = cur.A; const char* cB = cur.B;
    {
        PG8_STAGE(PG8_SB(0, 0), cB, voffB); PG8_STAGE(PG8_SB(0, 1), cB + hstep, voffB); PG8_STAGE(PG8_SA(0, 0), cA, va[0]); PG8_STAGE(PG8_SA(0, 1), cA, va[1]);
        if (wr == 1) PG8_BAR;
        PG8_WAIT_V(2); PG8_BAR;
        PG8_STAGE(PG8_SB(1, 0), cB + kstep, voffB); PG8_STAGE(PG8_SA(1, 0), cA + kstepA, va[0]); PG8_STAGE(PG8_SB(1, 1), cB + hstep + kstep, voffB);
        PG8_WAIT_V(6); PG8_BAR;
    }
    for (;;) {
        const bool has_next = S.next(ui + 1, nxt);
        const char* nA = has_next ? nxt.A : cA; const char* nB = has_next ? nxt.B : cB;
#if PROBE_DBL >= 600 && PROBE_DBL < 640
        if (krp<Epi>::v == 2) {
#pragma unroll 1
        for (int t = 0; t < nt; t += 2) {
            const bool last = (t == nt - 2);
            const char* a1 = cA + (size_t)(t + 1) * kstepA;
            const char* a2 = last ? cA : cA + (size_t)(t + 2) * kstepA; const char* b2 = last ? cB : cB + (size_t)(t + 2) * kstep;
            const char* a3 = a2 + kstepA; const char* b3 = b2 + kstep;
            PG8_LDB(B0, 0, 0); PG8_LDB(B1, 0, 1); PG8_SCHED; PG8_LDA(At, 0, 0); PG8_STAGE(PG8_SA(1, 1), a1, va[1]);
            PG8_WAIT_V(8); PG8_WAIT_L(0); PG8_BAR; PG8_MMA(0, 0, At, B0); PG8_MMA(0, 1, At, B1); PG8_BAR; PG8_SCHED;
            PG8_LDA(At, 0, 1); PG8_STAGE(PG8_SB(0, 0), b2, voffB); PG8_STAGE(PG8_SB(0, 1), b2 + hstep, voffB); PG8_STAGE(PG8_SA(0, 0), a2, va[0]);
            PG8_WAIT_V(8); PG8_WAIT_L(0); PG8_BAR; PG8_MMA(1, 0, At, B0); PG8_MMA(1, 1, At, B1); PG8_BAR; PG8_SCHED;
            PG8_LDB(B0, 1, 0); PG8_LDB(B1, 1, 1); PG8_SCHED; PG8_LDA(At, 1, 0); PG8_STAGE(PG8_SA(0, 1), a2, va[1]);
            PG8_WAIT_V(8); PG8_WAIT_L(0); PG8_BAR; PG8_MMA(0, 0, At, B0); PG8_MMA(0, 1, At, B1); PG8_BAR; PG8_SCHED;
            PG8_LDA(At, 1, 1); PG8_STAGE(PG8_SB(1, 0), b3, voffB); PG8_STAGE(PG8_SB(1, 1), b3 + hstep, voffB); PG8_STAGE(PG8_SA(1, 0), a3, va[0]);
            PG8_WAIT_V(8); PG8_WAIT_L(0); PG8_BAR; PG8_MMA(1, 0, At, B0); PG8_MMA(1, 1, At, B1); PG8_BAR; PG8_SCHED;
        }
#pragma unroll
        for (int a = 0; a < 2; ++a)
#pragma unroll
            for (int b = 0; b < 2; ++b)
#pragma unroll
                for (int m = 0; m < 4; ++m)
#pragma unroll
                    for (int n = 0; n < 2; ++n) acc[a][b][m][n] = (f32x4){0.f, 0.f, 0.f, 0.f};
        }
#endif
#pragma unroll 1
        for (int t = 0; t < nt; t += 2) {
            const bool last = (t == nt - 2);
            const char* a1 = cA + (size_t)(t + 1) * kstepA;
            const char* a2 = last ? nA : cA + (size_t)(t + 2) * kstepA; const char* b2 = last ? nB : cB + (size_t)(t + 2) * kstep;
            const char* a3 = a2 + kstepA; const char* b3 = b2 + kstep;
            PG8_LDB(B0, 0, 0); PG8_LDB(B1, 0, 1); PG8_SCHED; PG8_LDA(At, 0, 0); PG8_STAGE(PG8_SA(1, 1), a1, va[1]);
            if (last && has_next) { PG8_MKVA(nxt, va); }
            PG8_WAIT_V(8); PG8_WAIT_L(0); PG8_BAR; PG8_MMA(0, 0, At, B0); PG8_MMA(0, 1, At, B1); PG8_BAR; PG8_SCHED;
            PG8_LDA(At, 0, 1); PG8_STAGE(PG8_SB(0, 0), b2, voffB); PG8_STAGE(PG8_SB(0, 1), b2 + hstep, voffB); PG8_STAGE(PG8_SA(0, 0), a2, va[0]);
            PG8_WAIT_V(8); PG8_WAIT_L(0); PG8_BAR; PG8_MMA(1, 0, At, B0); PG8_MMA(1, 1, At, B1); PG8_BAR; PG8_SCHED;
            PG8_LDB(B0, 1, 0); PG8_LDB(B1, 1, 1); PG8_SCHED; PG8_LDA(At, 1, 0); PG8_STAGE(PG8_SA(0, 1), a2, va[1]);
            PG8_WAIT_V(8); PG8_WAIT_L(0); PG8_BAR; PG8_MMA(0, 0, At, B0); PG8_MMA(0, 1, At, B1); PG8_BAR; PG8_SCHED;
            PG8_LDA(At, 1, 1); PG8_STAGE(PG8_SB(1, 0), b3, voffB); PG8_STAGE(PG8_SB(1, 1), b3 + hstep, voffB); PG8_STAGE(PG8_SA(1, 0), a3, va[0]);
            PG8_WAIT_V(8); PG8_WAIT_L(0); PG8_BAR; PG8_MMA(1, 0, At, B0); PG8_MMA(1, 1, At, B1); PG8_BAR; PG8_SCHED;
        }
        if (wr == 0) PG8_BAR;
#if PROBE_DBL >= 600 && PROBE_DBL < 640
#pragma unroll 1
        for (int erep = 0; erep < erp<Epi>::v; ++erep) { E(acc, cur, wr, wc, fr, fq); asm volatile("" ::: "memory"); }
#else
        E(acc, cur, wr, wc, fr, fq);
#endif
        if (!has_next) break;
#pragma unroll
        for (int a = 0; a < 2; ++a)
#pragma unroll
            for (int b = 0; b < 2; ++b)
#pragma unroll
                for (int m = 0; m < 4; ++m)
#pragma unroll
                    for (int n = 0; n < 2; ++n) acc[a][b][m][n] = (f32x4){0.f, 0.f, 0.f, 0.f};
        cur = nxt; cA = nA; cB = nB; ++ui;
        if (wr == 1) PG8_BAR;
    }
    PG8_WAIT_V(0);
    PG8_BAR;
#undef PG8_MKVA
#undef PG8_SA
#undef PG8_SB
#undef PG8_STAGE
#undef PG8_LDA
#undef PG8_LDB
#undef PG8_MMA
#undef PG8_WAIT_V
#undef PG8_WAIT_L
#undef PG8_BAR
#undef PG8_SCHED
}
}


#include <hip/hip_cooperative_groups.h>
namespace cg = cooperative_groups;
constexpr int NTHR = 512;
constexpr int LDS_BYTES = 147456;
#define LAS __attribute__((address_space(3)))

struct Params {
    const float *x, *mem; const int* positions;
    const float *w_in, *pe_k, *pe_v, *w1k, *w2k, *w1v, *w2v, *w_out, *ln1g, *ln1b, *w_xq, *w_xkv, *w_xo, *ln2g, *ln2b, *w_router, *rbias, *w_gate, *w_up, *w_down, *ws_gate, *ws_up, *ws_down, *ln3g, *ln3b;
    float* out; unsigned char* ws;
    float lg[4];
    int ph_lo, ph_hi;
};

template <int CTRL> __device__ __forceinline__ float dppf(float v) { return __builtin_bit_cast(float, __builtin_amdgcn_update_dpp(0, __builtin_bit_cast(int, v), CTRL, 0xf, 0xf, true)); }
template <int CTRL> __device__ __forceinline__ int dppi(int v) { return __builtin_amdgcn_update_dpp(0, v, CTRL, 0xf, 0xf, true); }
__device__ __forceinline__ float rlanef(float v, int l) { return __builtin_bit_cast(float, __builtin_amdgcn_readlane(__builtin_bit_cast(int, v), l)); }
__device__ __forceinline__ float wsum64(float v) { v += dppf<0xB1>(v); v += dppf<0x4E>(v); v += dppf<0x141>(v); v += dppf<0x140>(v);
    return (rlanef(v, 0) + rlanef(v, 16)) + (rlanef(v, 32) + rlanef(v, 48)); }
__device__ __forceinline__ float wave_sum(float v) { return wsum64(v); }
__device__ __forceinline__ float wave_max(float v) {
#pragma unroll
    for (int o = 1; o < 64; o <<= 1) v = fmaxf(v, __shfl_xor(v, o));
    return v;
}
__device__ __forceinline__ float siluf(float v) { return fsilu(v); }
__device__ __forceinline__ float sigmf(float v) { return __builtin_amdgcn_rcpf(1.f + __expf(-v)); }

__device__ __forceinline__ void b_transpose_tile(const float* __restrict__ W, int K, int N, h16* __restrict__ WT, int Npad, int tile, float* tl, int lt, int rs = 1, int ro = 0) {
    const int ntn = Npad / 32; const int n0 = (tile % ntn) * 32, k0 = (tile / ntn) * 32, tx = lt & 31, ty = lt >> 5;
    for (int i = ty; i < 32; i += 8) { const int k = k0 + i, n = n0 + tx; tl[i * 33 + tx] = (n < N) ? W[(size_t)k * N + n] : 0.f; }
    __syncthreads();
    for (int i = ty; i < 32; i += 8) { const int n = n0 + i, k = k0 + tx; WT[(size_t)(n * rs + ro) * K + k] = (h16)tl[tx * 33 + i]; }
    __syncthreads();
}
__device__ __forceinline__ void w_transpose_item(const float* __restrict__ W, int K, int N, h16* __restrict__ WT, int item, LAS float* scr, int lane, int rs = 1, int ro = 0, const float* __restrict__ kscale = nullptr) {
    const int nblk = N / 32, kb = item / nblk, nb = item % nblk, k0 = 64 * kb, n0 = 32 * nb;
#pragma unroll 8
    for (int i = 0; i < 32; ++i) { const int kk = 2 * i + (lane >> 5); scr[kk * 33 + (lane & 31)] = W[(size_t)(k0 + kk) * N + n0 + (lane & 31)]; }
    asm volatile("s_waitcnt lgkmcnt(0)" ::: "memory");
    const int c = lane & 7;
#pragma unroll
    for (int j = 0; j < 4; ++j) { const int n = (lane >> 3) + 8 * j; LAS const float* s = scr + (8 * c) * 33 + n; h16x8 o;
#pragma unroll
        for (int x = 0; x < 8; ++x) o[x] = (h16)(kscale ? s[x * 33] * kscale[k0 + 8 * c + x] : s[x * 33]);
        *(h16x8*)(WT + (size_t)((n0 + n) * rs + ro) * K + k0 + 8 * c) = o; }
    asm volatile("s_waitcnt lgkmcnt(0)" ::: "memory");
}
__device__ __forceinline__ void b_cvt(const float* __restrict__ x, h16* __restrict__ o, size_t n4) {
    for (size_t i = (size_t)blockIdx.x * NTHR + tidx(); i < n4; i += (size_t)gridDim.x * NTHR) {
        const f32x4 v = ((const f32x4*)x)[i]; ((h16x4*)o)[i] = __builtin_convertvector(v, h16x4); }
}

__device__ __forceinline__ void b_tables(const int* __restrict__ positions, float* __restrict__ cosr, float* __restrict__ sinr, float* __restrict__ cosn, float* __restrict__ sinn, LAS float* inv) {
    if (tidx() < 72) { const int j = tidx(); inv[j] = j < 64 ? (float)pow(10000.0, -(double)j / 64.0) : (float)pow(500000.0, -(double)(j - 64) / 8.0); }
    __syncthreads();
    for (int idx = blockIdx.x * NTHR + tidx(); idx < M * 72; idx += gridDim.x * NTHR) {
        const int m = idx / 72, j = idx % 72; const float pos = (float)positions[m];
        const float ang = pos * inv[j]; double sd, cd; sincos((double)ang, &sd, &cd);
        if (j < 64) { cosr[(size_t)m * 64 + j] = (float)cd; sinr[(size_t)m * 64 + j] = (float)sd; } else { cosn[(size_t)m * 8 + j - 64] = (float)cd; sinn[(size_t)m * 8 + j - 64] = (float)sd; }
    }
    __syncthreads();
}
__device__ __forceinline__ void w_rope(const h16* __restrict__ h, h16* __restrict__ rqr, h16* __restrict__ rkr, h16* __restrict__ nqr, h16* __restrict__ ksR, h16* __restrict__ kwR, const float* __restrict__ cosr, const float* __restrict__ sinr,
                                       const float* __restrict__ cosn, const float* __restrict__ sinn, int m, int lane) {
    const h16* hr = h + (size_t)m * INP; const int bb = m >> 13, t = m & (T - 1);
    {
        const int isk = lane >> 5, hd = (lane >> 3) & 3, j8 = (lane & 7) * 8; const int col = (isk ? C_RK : C_RQ) + hd * 128 + j8;
        const h16x8 a1 = *(const h16x8*)(hr + col), a2 = *(const h16x8*)(hr + col + 64);
        const f32x4 c0 = *(const f32x4*)(cosr + (size_t)m * 64 + j8), c1 = *(const f32x4*)(cosr + (size_t)m * 64 + j8 + 4), s0 = *(const f32x4*)(sinr + (size_t)m * 64 + j8), s1 = *(const f32x4*)(sinr + (size_t)m * 64 + j8 + 4);
        const float sc = isk ? 0.08838834764831845f : 1.f; h16x8 o1, o2;
#pragma unroll
        for (int x = 0; x < 8; ++x) { const float c = x < 4 ? c0[x & 3] : c1[x & 3], s = x < 4 ? s0[x & 3] : s1[x & 3]; const float v1 = (float)a1[x], v2 = (float)a2[x];
            o1[x] = (h16)((v1 * c - v2 * s) * sc); o2[x] = (h16)((v2 * c + v1 * s) * sc); }
        h16* dst = (isk ? rkr : rqr) + ((size_t)(bb * 4 + hd) * T + t) * 128 + j8; *(h16x8*)dst = o1; *(h16x8*)(dst + 64) = o2; }
    const f32x4 cn0 = *(const f32x4*)(cosn + (size_t)m * 8), cn1 = *(const f32x4*)(cosn + (size_t)m * 8 + 4), sn0 = *(const f32x4*)(sinn + (size_t)m * 8), sn1 = *(const f32x4*)(sinn + (size_t)m * 8 + 4);
    if (lane < 8 || (lane >= 56 && lane < 60)) {
        const bool isq = lane < 8; const int idx = lane - 56, which = idx >> 1, g = idx & 1;
        const h16* src = isq ? hr + C_NQ + lane * 64 : hr + (which ? C_NKW : C_NKS) + g * 64;
        h16* dst = isq ? nqr + (size_t)m * 512 + lane * 64 : (which ? kwR : ksR) + (((size_t)((bb * 2 + g) * 128 + (t >> 6)) * 64 + (t & 63)) * 64);
        const h16x8 a1 = *(const h16x8*)src, a2 = *(const h16x8*)(src + 8); h16x8 o1, o2;
#pragma unroll
        for (int x = 0; x < 8; ++x) { const float c = x < 4 ? cn0[x & 3] : cn1[x & 3], s = x < 4 ? sn0[x & 3] : sn1[x & 3]; const float v1 = (float)a1[x], v2 = (float)a2[x];
            o1[x] = (h16)(v1 * c - v2 * s); o2[x] = (h16)(v2 * c + v1 * s); }
        *(h16x8*)dst = o1; *(h16x8*)(dst + 8) = o2;
    } else if (lane < 56) {
        const int idx = lane - 8, hd = idx / 6, d = 16 + 8 * (idx % 6); *(h16x8*)(nqr + (size_t)m * 512 + hd * 64 + d) = *(const h16x8*)(hr + C_NQ + hd * 64 + d); }
    if (lane < 24) {
        const int which = lane / 12, r = lane % 12, g = r / 6, d = 16 + 8 * (r % 6);
        h16* dst = (which ? kwR : ksR) + (((size_t)((bb * 2 + g) * 128 + (t >> 6)) * 64 + (t & 63)) * 64);
        *(h16x8*)(dst + d) = *(const h16x8*)(hr + (which ? C_NKW : C_NKS) + g * 64 + d); }
}
__device__ __forceinline__ void b_rtrans(const Params& p, const h16* __restrict__ h, h16* __restrict__ rvT, h16* __restrict__ rkzT, const float* __restrict__ cosr, const float* __restrict__ sinr, int item, LAS h16* sl, int lane) {
    int id = item; const int tt = id & 255; id >>= 8; const int hd = id & 3; const int b = id >> 2; const int bh = b * 4 + hd; const float lg = p.lg[hd];
    const int chunk = bh * 64 + (tt >> 2), koff = (tt & 3) * 32;
#pragma unroll
    for (int i = lane; i < 32 * 16; i += 64) { const int t = i >> 4, e8 = (i & 15) * 8; const h16x8 v = *(const h16x8*)(h + (size_t)(b * T + tt * 32 + t) * INP + C_RV + hd * 128 + e8);
#pragma unroll
        for (int x = 0; x < 8; ++x) sl[t * 130 + e8 + x] = v[x]; }
    asm volatile("s_waitcnt lgkmcnt(0)" ::: "memory");
#pragma unroll 4
    for (int i = lane; i < 128 * 4; i += 64) { const int e = i >> 2, t8 = (i & 3) * 8; h16x8 o;
#pragma unroll
        for (int x = 0; x < 8; ++x) o[x] = sl[(t8 + x) * 130 + e];
        *(h16x8*)(rvT + ((size_t)chunk * 128 + e) * 128 + koff + t8) = o; }
    asm volatile("s_waitcnt lgkmcnt(0)" ::: "memory");
#pragma unroll 4
    for (int i = lane; i < 32 * 8; i += 64) { const int t = i >> 3, j8 = (i & 7) * 8; const size_t m = (size_t)b * T + tt * 32 + t;
        const h16x8 k1 = *(const h16x8*)(h + m * INP + C_RK + hd * 128 + j8), k2 = *(const h16x8*)(h + m * INP + C_RK + hd * 128 + 64 + j8);
        const f32x4 c0 = *(const f32x4*)(cosr + m * 64 + j8), c1 = *(const f32x4*)(cosr + m * 64 + j8 + 4), s0 = *(const f32x4*)(sinr + m * 64 + j8), s1 = *(const f32x4*)(sinr + m * 64 + j8 + 4);
        const float z = 0.08838834764831845f * __expf(lg * (float)(127 - (koff + t)));
#pragma unroll
        for (int x = 0; x < 8; ++x) { const float c = x < 4 ? c0[x & 3] : c1[x & 3], s = x < 4 ? s0[x & 3] : s1[x & 3]; const float a1 = (float)k1[x], a2 = (float)k2[x];
            sl[t * 130 + j8 + x] = (h16)((a1 * c - a2 * s) * z); sl[t * 130 + 64 + j8 + x] = (h16)((a2 * c + a1 * s) * z); } }
    asm volatile("s_waitcnt lgkmcnt(0)" ::: "memory");
#pragma unroll 4
    for (int i = lane; i < 128 * 4; i += 64) { const int d = i >> 2, t8 = (i & 3) * 8; h16x8 o;
#pragma unroll
        for (int x = 0; x < 8; ++x) o[x] = sl[(t8 + x) * 130 + d];
        *(h16x8*)(rkzT + ((size_t)chunk * 128 + d) * 128 + koff + t8) = o; }
    asm volatile("s_waitcnt lgkmcnt(0)" ::: "memory");
}
__device__ __forceinline__ void b_mvtrans(const h16* __restrict__ kvm, h16* __restrict__ kvmVT, h16* __restrict__ kx, int item, h16* sl, int lt) {
    int id = item; const int kt = id & 3; id >>= 2; const int dtl = id & 3; id >>= 2; const int hh = id & 3; const int b = id >> 2;
    for (int i = lt; i < 64 * 64; i += 256) { const int k = i >> 6, d = i & 63; sl[k * 66 + d] = kvm[(size_t)(b * MEML + kt * 64 + k) * 2048 + 1024 + hh * 256 + dtl * 64 + d];
        kx[((size_t)(b * 4 + hh) * MEML + kt * 64 + k) * 256 + dtl * 64 + d] = kvm[(size_t)(b * MEML + kt * 64 + k) * 2048 + hh * 256 + dtl * 64 + d]; }
    __syncthreads();
    for (int i = lt; i < 64 * 64; i += 256) { const int d = i >> 6, k = i & 63; kvmVT[(size_t)((b * 4 + hh) * 256 + dtl * 64 + d) * MEML + kt * 64 + k] = sl[k * 66 + d]; }
    __syncthreads();
}

struct CmpSched {
    const char* hbase; const unsigned* cmpoff; const char* Wc1T; int c;
    __device__ bool next(int i, pg8::Unit& u) const {
        if (i > 0 || c >= 32) return false; const int kv = c >> 4, rt = c & 15;
        u.pm = kv * 16 + rt; u.pn = 0; u.A = hbase + (size_t)(kv ? C_NVC : C_NKC) * 2; u.gat = cmpoff + rt * 256; u.B = Wc1T + (size_t)kv * 256 * 2048 * 2; return true; }
};
__device__ __forceinline__ void b_cmp2(const Params& p, const h16* __restrict__ hid, h16* __restrict__ kcmp, h16* __restrict__ vcmpT) {
    const int lane = tidx() & 63;
    for (int r = blockIdx.x * 8 + (tidx() >> 6); r < 2 * 4096; r += gridDim.x * 8) {
        const int kv = r >> 12, rr = r & 4095, g = rr & 1, c = (rr >> 1) & 511, b = rr >> 10;
        const float* w2 = kv ? p.w2v : p.w2k; const h16* hr = hid + (size_t)r * 256; float acc = 0.f;
        for (int j = 0; j < 256; j += 8) { const h16x8 hv = *(const h16x8*)(hr + j);
#pragma unroll
            for (int x = 0; x < 8; ++x) acc += (float)hv[x] * w2[(j + x) * 64 + lane]; }
        if (c == 511) acc = 0.f;
        if (kv == 0) kcmp[((size_t)(b * 2 + g) * 512 + c) * 64 + lane] = (h16)acc;
        else vcmpT[(((size_t)(b * 2 + g) * 8 + (c >> 6)) * 64 + lane) * 64 + (c & 63)] = (h16)acc;
    }
}
__device__ __forceinline__ void b_vtrans(const h16* __restrict__ h, h16* __restrict__ vsT, h16* __restrict__ vwT, int item, LAS h16* sl, int lane) {
    int id = item; const int tt = id & 127; id >>= 7; const int g = id & 1; id >>= 1; const int b = id & 3; const int which = id >> 2;
    const int col = (which ? C_NVW : C_NVS) + g * 64; h16* dst = (which ? vwT : vsT) + (size_t)((b * 2 + g) * 128 + tt) * 4096;
#pragma unroll
    for (int i = lane; i < 64 * 8; i += 64) { const int t = i >> 3, d8 = (i & 7) * 8; const h16x8 v = *(const h16x8*)(h + (size_t)(b * T + tt * 64 + t) * INP + col + d8);
#pragma unroll
        for (int x = 0; x < 8; ++x) sl[t * 66 + d8 + x] = v[x]; }
    asm volatile("s_waitcnt lgkmcnt(0)" ::: "memory");
#pragma unroll 4
    for (int i = lane; i < 64 * 8; i += 64) { const int d = i >> 3, t8 = (i & 7) * 8; h16x8 o;
#pragma unroll
        for (int x = 0; x < 8; ++x) o[x] = sl[(t8 + x) * 66 + d];
        *(h16x8*)(dst + d * 64 + t8) = o; }
    asm volatile("s_waitcnt lgkmcnt(0)" ::: "memory");
}

__device__ __forceinline__ void ret_kv_unit(const h16* __restrict__ rkzT, const h16* __restrict__ rvT, float* __restrict__ kvT, int chunk, int w, int lane) {
    const int i = lane & 15, kg = lane >> 4; const int bh = chunk >> 6, n = chunk & 63;
    h16x8 a[4];
#pragma unroll
    for (int ks = 0; ks < 4; ++ks) a[ks] = *(const h16x8*)(rkzT + ((size_t)chunk * 128 + 16 * w + i) * 128 + 32 * ks + 8 * kg);
#pragma unroll
    for (int et = 0; et < 8; ++et) { f32x4 acc = {0.f, 0.f, 0.f, 0.f};
#pragma unroll
        for (int ks = 0; ks < 4; ++ks) { const h16x8 bq = *(const h16x8*)(rvT + ((size_t)chunk * 128 + 16 * et + i) * 128 + 32 * ks + 8 * kg); acc = __builtin_amdgcn_mfma_f32_16x16x32_f16(a[ks], bq, acc, 0, 0, 0); }
        *(f32x4*)(kvT + ((size_t)chunk * 128 + 16 * et + i) * 128 + 16 * w + 4 * kg) = acc; }
}
__device__ __forceinline__ void b_ret_scan(const Params& p, const float* __restrict__ kvT, h16* __restrict__ prevT) {
    for (int gid = blockIdx.x * NTHR + tidx(); gid < 16 * 16384; gid += gridDim.x * NTHR) {
        const int de = gid & 16383, bh = gid >> 14; const float cd = __expf(p.lg[bh & 3] * 128.f);
        float st = 0.f;
        for (int n = 0; n < 64; ++n) { const size_t o = ((size_t)(bh * 64 + n) << 14) + de; prevT[o] = (h16)st; st = st * cd + kvT[o]; }
    }
}
__device__ __forceinline__ void ret_out_unit(const Params& p, const h16* __restrict__ h, const h16* __restrict__ rqr, const h16* __restrict__ rkr, const h16* __restrict__ rvT, const h16* __restrict__ prevT,
                                             h16* __restrict__ mix, int chunk, int w, int lane) {
    const int i = lane & 15, kg = lane >> 4; const int bh = chunk >> 6, n = chunk & 63, b = bh >> 2, hd = bh & 3; const float lg = p.lg[hd];
    const int qi = 16 * w + i; const size_t m = (size_t)b * T + n * 128 + qi;
    h16x8 qf[4];
#pragma unroll
    for (int ks = 0; ks < 4; ++ks) qf[ks] = *(const h16x8*)(rqr + ((size_t)bh * T + n * 128 + qi) * 128 + 32 * ks + 8 * kg);
    f32x4 inner[8], cross[8];
#pragma unroll
    for (int et = 0; et < 8; ++et) { inner[et] = (f32x4){0.f, 0.f, 0.f, 0.f}; cross[et] = (f32x4){0.f, 0.f, 0.f, 0.f}; }
    for (int gq = 0; gq < 2; ++gq) {
        if (64 * gq > 16 * w + 15) break;
        h16x8 kf[4][4];
#pragma unroll
        for (int ks = 0; ks < 4; ++ks)
#pragma unroll
            for (int tl = 0; tl < 4; ++tl) { const int ko = 32 * (tl >> 1) + 8 * (i >> 2) + 4 * (tl & 1) + (i & 3); kf[ks][tl] = *(const h16x8*)(rkr + ((size_t)bh * T + n * 128 + 64 * gq + ko) * 128 + 8 * kg + 32 * ks); }
        f32x4 s[4];
#pragma unroll
        for (int tl = 0; tl < 4; ++tl) s[tl] = (f32x4){0.f, 0.f, 0.f, 0.f};
#pragma unroll
        for (int ks = 0; ks < 4; ++ks)
#pragma unroll
            for (int tl = 0; tl < 4; ++tl) s[tl] = __builtin_amdgcn_mfma_f32_16x16x32_f16(kf[ks][tl], qf[ks], s[tl], 0, 0, 0);
        h16x8 va[2][8];
#pragma unroll
        for (int s2 = 0; s2 < 2; ++s2)
#pragma unroll
            for (int et = 0; et < 8; ++et) va[s2][et] = *(const h16x8*)(rvT + ((size_t)chunk * 128 + 16 * et + i) * 128 + 64 * gq + 32 * s2 + 8 * kg);
        h16x8 pf[2];
#pragma unroll
        for (int tl = 0; tl < 4; ++tl)
#pragma unroll
            for (int r = 0; r < 4; ++r) { const int j = 64 * gq + 32 * (tl >> 1) + 8 * kg + 4 * (tl & 1) + r; const float v = (j <= qi) ? s[tl][r] * __expf(lg * (float)(qi - j)) : 0.f; pf[tl >> 1][4 * (tl & 1) + r] = (h16)v; }
#pragma unroll
        for (int s2 = 0; s2 < 2; ++s2)
#pragma unroll
            for (int et = 0; et < 8; ++et) inner[et] = __builtin_amdgcn_mfma_f32_16x16x32_f16(va[s2][et], pf[s2], inner[et], 0, 0, 0);
    }
    {
        h16x8 ca[2][8];
#pragma unroll
        for (int ks = 0; ks < 2; ++ks)
#pragma unroll
            for (int et = 0; et < 8; ++et) ca[ks][et] = *(const h16x8*)(prevT + ((size_t)chunk * 128 + 16 * et + i) * 128 + 32 * ks + 8 * kg);
#pragma unroll
        for (int ks = 0; ks < 4; ++ks) {
#pragma unroll
            for (int et = 0; et < 8; ++et) cross[et] = __builtin_amdgcn_mfma_f32_16x16x32_f16(ca[ks & 1][et], qf[ks], cross[et], 0, 0, 0);
            if (ks + 2 < 4) {
#pragma unroll
                for (int et = 0; et < 8; ++et) ca[ks & 1][et] = *(const h16x8*)(prevT + ((size_t)chunk * 128 + 16 * et + i) * 128 + 32 * (ks + 2) + 8 * kg); } }
    }
    const float xi = __expf(lg * (float)(qi + 1));
    float sm = 0.f;
#pragma unroll
    for (int et = 0; et < 8; ++et) { inner[et] = inner[et] + cross[et] * xi; sm += (inner[et][0] + inner[et][1]) + (inner[et][2] + inner[et][3]); }
    sm = pg8::rsum4(sm);
    const float mu = sm * (1.f / 128.f); float sq = 0.f;
#pragma unroll
    for (int et = 0; et < 8; ++et) { inner[et] = inner[et] - mu; sq += (inner[et][0] * inner[et][0] + inner[et][1] * inner[et][1]) + (inner[et][2] * inner[et][2] + inner[et][3] * inner[et][3]); }
    sq = pg8::rsum4(sq);
    const float rstd = rsqrtf(sq * (1.f / 128.f) + LN_EPS);
#pragma unroll
    for (int et = 0; et < 8; ++et) { const int e = 16 * et + 4 * kg; const h16x4 gv = *(const h16x4*)(h + m * INP + C_RG + hd * 128 + e);
        f32x4 o;
#pragma unroll
        for (int r = 0; r < 4; ++r) o[r] = siluf((float)gv[r]) * inner[et][r] * rstd;
        *(h16x4*)(mix + m * D + hd * 128 + e) = __builtin_convertvector(o, h16x4); }
}

struct AttSt { float m; f32x4 lo; f32x4 o[4]; };
struct KFrag { h16x8 a[4][2]; };
struct VFrag { h16x8 a[4][2]; };
__device__ __forceinline__ float fmx(float a, float b) { return __builtin_elementwise_maximum(a, b); }
__device__ __forceinline__ float xmax4(float v) {
    auto a = __builtin_amdgcn_permlane16_swap(__float_as_uint(v), __float_as_uint(v), false, false); v = fmx(__uint_as_float(a[0]), __uint_as_float(a[1]));
    auto c = __builtin_amdgcn_permlane32_swap(__float_as_uint(v), __float_as_uint(v), false, false); return fmx(__uint_as_float(c[0]), __uint_as_float(c[1])); }
__device__ __forceinline__ float xsum4(float v) {
    auto a = __builtin_amdgcn_permlane16_swap(__float_as_uint(v), __float_as_uint(v), false, false); v = __uint_as_float(a[0]) + __uint_as_float(a[1]);
    auto c = __builtin_amdgcn_permlane32_swap(__float_as_uint(v), __float_as_uint(v), false, false); return __uint_as_float(c[0]) + __uint_as_float(c[1]); }
constexpr float ATT_THR = 8.f;
constexpr float ATT_C2 = 0.125f * 1.4426950408889634f;
template <bool MASKED, class MaskF>
__device__ __forceinline__ void att_scores(f32x4 (&s)[4], const KFrag& k, const h16x8 (&qf)[2], int kg, MaskF valid, float c0 = 0.f) {
#pragma unroll
    for (int tl = 0; tl < 4; ++tl) s[tl] = __builtin_amdgcn_mfma_f32_16x16x32_f16(k.a[tl][0], qf[0], (f32x4){c0, c0, c0, c0}, 0, 0, 0);
#pragma unroll
    for (int tl = 0; tl < 4; ++tl) s[tl] = __builtin_amdgcn_mfma_f32_16x16x32_f16(k.a[tl][1], qf[1], s[tl], 0, 0, 0);
    if (MASKED) {
#pragma unroll
        for (int tl = 0; tl < 4; ++tl)
#pragma unroll
            for (int r = 0; r < 4; ++r) { const int ko = 32 * (tl >> 1) + 8 * kg + 4 * (tl & 1) + r; s[tl][r] = valid(ko) ? s[tl][r] : -INFINITY; }
    }
}
__device__ __forceinline__ float att_lmax(const f32x4 (&s)[4]) {
    float mx = fmx(fmx(s[0][0], s[0][1]), fmx(s[0][2], s[0][3]));
#pragma unroll
    for (int tl = 1; tl < 4; ++tl) mx = fmx(mx, fmx(fmx(s[tl][0], s[tl][1]), fmx(s[tl][2], s[tl][3])));
    return mx;
}
__device__ __forceinline__ float att_rowmax(const f32x4 (&s)[4]) {
    float mx = fmx(fmx(s[0][0], s[0][1]), fmx(s[0][2], s[0][3]));
#pragma unroll
    for (int tl = 1; tl < 4; ++tl) mx = fmx(mx, fmx(fmx(s[tl][0], s[tl][1]), fmx(s[tl][2], s[tl][3])));
    return xmax4(mx);
}
__device__ __forceinline__ void att_pv(f32x4 (&o)[4], const f32x4 (&pv)[4], const VFrag& v) {
    h16x8 pf[2];
#pragma unroll
    for (int s2 = 0; s2 < 2; ++s2)
#pragma unroll
        for (int j = 0; j < 8; ++j) pf[s2][j] = (h16)pv[2 * s2 + (j >> 2)][j & 3];
#pragma unroll
    for (int dt = 0; dt < 4; ++dt)
#pragma unroll
        for (int s2 = 0; s2 < 2; ++s2) o[dt] = __builtin_amdgcn_mfma_f32_16x16x32_f16(v.a[dt][s2], pf[s2], o[dt], 0, 0, 0);
}
__device__ __forceinline__ void att_pvl(f32x4 (&o)[4], f32x4& lo, const f32x4 (&pv)[4], const VFrag& v) {
    h16x8 pf[2];
#pragma unroll
    for (int s2 = 0; s2 < 2; ++s2)
#pragma unroll
        for (int j = 0; j < 8; ++j) pf[s2][j] = (h16)pv[2 * s2 + (j >> 2)][j & 3];
    const h16x8 ones = {(h16)1.f, (h16)1.f, (h16)1.f, (h16)1.f, (h16)1.f, (h16)1.f, (h16)1.f, (h16)1.f};
#pragma unroll
    for (int dt = 0; dt < 4; ++dt)
#pragma unroll
        for (int s2 = 0; s2 < 2; ++s2) o[dt] = __builtin_amdgcn_mfma_f32_16x16x32_f16(v.a[dt][s2], pf[s2], o[dt], 0, 0, 0);
    lo = __builtin_amdgcn_mfma_f32_16x16x32_f16(ones, pf[0], lo, 0, 0, 0); lo = __builtin_amdgcn_mfma_f32_16x16x32_f16(ones, pf[1], lo, 0, 0, 0);
}
__device__ __forceinline__ void att_softmax_pv(AttSt& st, f32x4 (&s)[4], const VFrag& v, bool rowok) {
    const float mx = rowok ? att_rowmax(s) * ATT_C2 : -INFINITY;
    if (__any(mx > st.m + ATT_THR)) { const float mn = fmx(st.m, mx); const float alpha = __builtin_amdgcn_exp2f(st.m - mn); st.m = mn; st.lo[0] *= alpha;
#pragma unroll
        for (int dt = 0; dt < 4; ++dt) st.o[dt] = st.o[dt] * alpha; }
    const float mneg = rowok ? -st.m : -INFINITY;
#pragma unroll
    for (int tl = 0; tl < 4; ++tl)
#pragma unroll
        for (int r = 0; r < 4; ++r) s[tl][r] = __builtin_amdgcn_exp2f(__builtin_fmaf(s[tl][r], ATT_C2, mneg));
    att_pvl(st.o, st.lo, s, v);
}
struct AttShift { bool un; float base; };
__device__ __forceinline__ AttShift att_shift(const AttSt& st) { AttShift h; h.un = st.m == -1e30f; h.base = h.un ? 0.f : st.m; return h; }
__device__ __forceinline__ float att_rebase(AttSt& st, const AttShift& h, float lmx, bool& took) {
    float dd = 0.f; took = false;
    if (__any(lmx > ATT_THR || (h.un && lmx > -INFINITY))) { took = true;
        const float d = xmax4(lmx); const bool part = d > -INFINITY;
        dd = part ? (h.un ? d : fmx(d, 0.f)) : 0.f;
        const float alpha = (part && !h.un) ? __builtin_amdgcn_exp2f(-dd) : 1.f;
        st.m = part ? h.base + dd : st.m; st.lo[0] *= alpha;
#pragma unroll
        for (int dt = 0; dt < 4; ++dt) st.o[dt] = st.o[dt] * alpha; }
    return dd;
}
template <bool MASKED, class MaskF>
__device__ __forceinline__ void att_tile(AttSt& st, const KFrag& k, const VFrag& v, const h16x8 (&qf)[2], int kg, bool rowok, MaskF valid) {
    const AttShift h = att_shift(st);
    f32x4 s[4]; att_scores<MASKED>(s, k, qf, kg, valid, rowok ? -h.base : -INFINITY);
    bool took; const float dd = att_rebase(st, h, att_lmax(s), took);
    if (took) {
#pragma unroll
        for (int tl = 0; tl < 4; ++tl) s[tl] = s[tl] - dd; }
#pragma unroll
    for (int tl = 0; tl < 4; ++tl)
#pragma unroll
        for (int r = 0; r < 4; ++r) s[tl][r] = __builtin_amdgcn_exp2f(s[tl][r]);
    att_pvl(st.o, st.lo, s, v);
}
constexpr int NSA_NSLOT = 6, NSA_RING = 0, NSA_IMP = NSA_NSLOT * 16384, NSA_MSK = 131072 + 256, NSA_LIST = NSA_MSK + 256;
__device__ __forceinline__ void ldk_lds(KFrag& k, LAS const unsigned char* slot, int ko0, int ko1) {
#pragma unroll
    for (int tl = 0; tl < 4; ++tl) { const int o = (32 * (tl >> 1) + 4 * (tl & 1)) * 128; k.a[tl][0] = *(LAS const h16x8*)(slot + o + ko0); k.a[tl][1] = *(LAS const h16x8*)(slot + o + ko1); }
}
__device__ __forceinline__ void ldv_lds(VFrag& v, LAS const unsigned char* slot, int vo0, int vo1) {
#pragma unroll
    for (int dt = 0; dt < 4; ++dt) { v.a[dt][0] = *(LAS const h16x8*)(slot + 8192 + dt * 2048 + vo0); v.a[dt][1] = *(LAS const h16x8*)(slot + 8192 + dt * 2048 + vo1); }
}
template <class FA, class FB>
__device__ __forceinline__ void att_pair(AttSt& st, LAS const unsigned char* sA, LAS const unsigned char* sB, int ko0, int ko1, int vo0, int vo1, const h16x8 (&qf)[2], int kg,
                                         bool okA, bool okB, bool mA, bool mB, FA validA, FB validB) {
    const AttShift h = att_shift(st);
    f32x4 a[4], c[4];
    { KFrag kA, kB; ldk_lds(kA, sA, ko0, ko1); ldk_lds(kB, sB, ko0, ko1);
      att_scores<false>(a, kA, qf, kg, [&](int) { return true; }, okA ? -h.base : -INFINITY); att_scores<false>(c, kB, qf, kg, [&](int) { return true; }, okB ? -h.base : -INFINITY); }
    VFrag vA, vB; ldv_lds(vA, sA, vo0, vo1); ldv_lds(vB, sB, vo0, vo1);
    if (mA) {
#pragma unroll
        for (int tl = 0; tl < 4; ++tl)
#pragma unroll
            for (int r = 0; r < 4; ++r) { const int ko = 32 * (tl >> 1) + 8 * kg + 4 * (tl & 1) + r; a[tl][r] = validA(ko) ? a[tl][r] : -INFINITY; } }
    if (mB) {
#pragma unroll
        for (int tl = 0; tl < 4; ++tl)
#pragma unroll
            for (int r = 0; r < 4; ++r) { const int ko = 32 * (tl >> 1) + 8 * kg + 4 * (tl & 1) + r; c[tl][r] = validB(ko) ? c[tl][r] : -INFINITY; } }
    bool took; const float dd = att_rebase(st, h, fmx(att_lmax(a), att_lmax(c)), took);
    if (took) {
#pragma unroll
        for (int tl = 0; tl < 4; ++tl) { a[tl] = a[tl] - dd; c[tl] = c[tl] - dd; } }
#pragma unroll
    for (int tl = 0; tl < 4; ++tl)
#pragma unroll
        for (int r = 0; r < 4; ++r) { a[tl][r] = __builtin_amdgcn_exp2f(a[tl][r]); c[tl][r] = __builtin_amdgcn_exp2f(c[tl][r]); }
    att_pvl(st.o, st.lo, a, vA); att_pvl(st.o, st.lo, c, vB);
}
#define NSA_WAITV(n) asm volatile("s_waitcnt vmcnt(" #n ")" ::: "memory")
#define NSA_BAR() do { asm volatile("s_waitcnt lgkmcnt(0)" ::: "memory"); __builtin_amdgcn_s_barrier(); asm volatile("" ::: "memory"); } while (0)
template <int LPT, class IssueF, class CompF>
__device__ __forceinline__ void nsa_stream2(int n, LAS unsigned char* dmaw, LAS unsigned char* ring, IssueF issue, CompF comp2) {
#pragma unroll
    for (int j = 0; j < 4; ++j) if (j < n) issue(j, (LAS unsigned*)(dmaw + j * 16384));
    int sa = 0, si = 4 * 16384;
    for (int t2 = 0; t2 < n; t2 += 2) {
        const int rem = n - t2 - 2;
        if (rem >= 2) { if (LPT == 2) NSA_WAITV(4); else NSA_WAITV(2); } else if (rem == 1) { if (LPT == 2) NSA_WAITV(2); else NSA_WAITV(1); } else NSA_WAITV(0);
        NSA_BAR();
        if (t2 + 4 < n) issue(t2 + 4, (LAS unsigned*)(dmaw + si));
        if (t2 + 5 < n) issue(t2 + 5, (LAS unsigned*)(dmaw + si + 16384));
        comp2(t2, (LAS const unsigned char*)(ring + sa), t2 + 1 < n, (LAS const unsigned char*)(ring + sa + 16384));
        sa = (sa == 4 * 16384) ? 0 : sa + 2 * 16384; si = (si == 4 * 16384) ? 0 : si + 2 * 16384; }
    NSA_BAR();
}
__device__ __forceinline__ void att_merge(AttSt& a, const AttSt& b2) {
    const float mn = fmx(a.m, b2.m); const float fa = __builtin_amdgcn_exp2f(a.m - mn), fb = __builtin_amdgcn_exp2f(b2.m - mn);
    a.m = mn; a.lo[0] = a.lo[0] * fa + b2.lo[0] * fb;
#pragma unroll
    for (int dt = 0; dt < 4; ++dt) a.o[dt] = a.o[dt] * fa + b2.o[dt] * fb;
}
__device__ __forceinline__ void nsa_block_unit(const h16* __restrict__ h, const h16* __restrict__ nqr, const h16* __restrict__ kcmp, const h16* __restrict__ vcmpT, const h16* __restrict__ vsT, const h16* __restrict__ vwT,
                                               const h16* __restrict__ ksR, const h16* __restrict__ kwR, h16* __restrict__ mix, int b, int g, int T0, LAS unsigned char* lds, int wv, int lane) {
    const int i = lane & 15, kg = lane >> 4, tt = i & 3, hh = i >> 2;
    const int t0 = T0 + 4 * wv, trow = t0 + tt; const size_t mrow = (size_t)b * T + trow;
    const int q = wv * 64 + lane, qrow = q >> 3, qch = q & 7;
    const int ksrc = qrow * 128 + ((qch ^ (((qrow >> 1) & 1) | (((qrow >> 3) & 3) << 1))) << 4), vsrc = qrow * 128 + ((qch ^ ((qrow >> 1) & 7)) << 4);
    const int gki = ((i >> 1) & 1) | ((i >> 2) << 1), gvi = (i >> 1) & 7;
    const int ko0 = (8 * (i >> 2) + (i & 3)) * 128 + ((kg ^ gki) << 4), ko1 = (8 * (i >> 2) + (i & 3)) * 128 + (((kg + 4) ^ gki) << 4);
    const int vo0 = i * 128 + ((kg ^ gvi) << 4), vo1 = i * 128 + (((kg + 4) ^ gvi) << 4);
    LAS unsigned char* ring = lds + NSA_RING; LAS unsigned char* dmaw = ring + wv * 1024;
    LAS float* impA = (LAS float*)(lds + NSA_IMP + wv * 4096); LAS float* impL = impA + 512;
    h16x8 qf[2], qrf[2];
    { const h16* qp = h + mrow * INP + C_NQ + (g * 4 + hh) * 64 + 8 * kg; qf[0] = *(const h16x8*)qp; qf[1] = *(const h16x8*)(qp + 32);
      const h16* qrp = nqr + mrow * 512 + (g * 4 + hh) * 64 + 8 * kg; qrf[0] = *(const h16x8*)qrp; qrf[1] = *(const h16x8*)(qrp + 32);
#pragma unroll
      for (int s2 = 0; s2 < 2; ++s2)
#pragma unroll
          for (int x = 0; x < 8; ++x) qrf[s2][x] = (h16)((float)qrf[s2][x] * ATT_C2); }
    const h16* gp = h + mrow * INP + C_NG + (g * 4 + hh) * 3; const float gt0 = (float)gp[0], gt1 = (float)gp[1], gt2 = (float)gp[2];
    for (int x = lane; x < 1024; x += 64) impA[x] = 0.f;
    NSA_WAITV(0);
#define GLDS16(gsrc, ldst) __builtin_amdgcn_global_load_lds((const unsigned*)(gsrc), (ldst), 16, 0, 0)
    const int ncv_row = trow >= 31 ? ((trow - 31) >> 4) + 1 : 0;
    const int ncv_blk = (T0 + 31 >= 31) ? ((T0 + 31 - 31) >> 4) + 1 : 0;
    const int ncv_min = T0 >= 31 ? ((T0 - 31) >> 4) + 1 : 0;
    const int nct = (ncv_blk + 63) >> 6;
    const unsigned char* Kc = (const unsigned char*)(kcmp + (size_t)(b * 2 + g) * 512 * 64); const unsigned char* Vc = (const unsigned char*)(vcmpT + (size_t)(b * 2 + g) * 8 * 4096);
    float m = -1e30f, l = 0.f;
    f32x4 oc[4];
    float linv = 0.f;
    REPS(501) {
    m = -1e30f; l = 0.f;
#pragma unroll
    for (int dt = 0; dt < 4; ++dt) oc[dt] = (f32x4){0.f, 0.f, 0.f, 0.f};
    float mB = -1e30f, lB = 0.f;
    auto cmp1 = [&](int j, LAS const unsigned char* slot, float& mm, float& ll) {
        KFrag kf; ldk_lds(kf, slot, ko0, ko1);
        f32x4 s[4];
        if (64 * j + 63 < ncv_min) att_scores<false>(s, kf, qf, kg, [&](int) { return true; }); else att_scores<true>(s, kf, qf, kg, [&](int ko) { return j * 64 + ko < ncv_row; });
        const float mx = att_rowmax(s) * ATT_C2;
        const float mn = fmx(mm, mx); float ps0 = 0.f, ps1 = 0.f;
        _Pragma("unroll") for (int tl = 0; tl < 4; ++tl) { ps0 += __builtin_amdgcn_exp2f(__builtin_fmaf(s[tl][0], ATT_C2, -mn)) + __builtin_amdgcn_exp2f(__builtin_fmaf(s[tl][1], ATT_C2, -mn));
                                                          ps1 += __builtin_amdgcn_exp2f(__builtin_fmaf(s[tl][2], ATT_C2, -mn)) + __builtin_amdgcn_exp2f(__builtin_fmaf(s[tl][3], ATT_C2, -mn)); }
        ll = ll * __builtin_amdgcn_exp2f(mm - mn) + (ps0 + ps1); mm = mn; };
    nsa_stream2<1>(nct, dmaw, ring, [&](int j, LAS unsigned* dk) { GLDS16(Kc + (size_t)j * 8192 + ksrc, dk); }, [&](int j, LAS const unsigned char* sA, bool hasB, LAS const unsigned char* sB) {
        cmp1(j, sA, m, l); __builtin_amdgcn_sched_barrier(0); if (hasB) cmp1(j + 1, sB, mB, lB); });
    { const float mn = fmx(m, mB); l = l * __builtin_amdgcn_exp2f(m - mn) + lB * __builtin_amdgcn_exp2f(mB - mn); m = mn; }
    l = xsum4(l);
    linv = l > 0.f ? 1.f / l : 0.f;
    auto cmp2 = [&](int j, LAS const unsigned char* slot) {
        KFrag kf; ldk_lds(kf, slot, ko0, ko1); VFrag vf; ldv_lds(vf, slot, vo0, vo1);
        f32x4 s[4];
        if (64 * j + 63 < ncv_min) att_scores<false>(s, kf, qf, kg, [&](int) { return true; }); else att_scores<true>(s, kf, qf, kg, [&](int ko) { return j * 64 + ko < ncv_row; });
        _Pragma("unroll") for (int tl = 0; tl < 4; ++tl) {
            _Pragma("unroll") for (int r = 0; r < 4; ++r) s[tl][r] = __builtin_amdgcn_exp2f(__builtin_fmaf(s[tl][r], ATT_C2, -m)) * linv;
            float A = (s[tl][0] + s[tl][1]) + (s[tl][2] + s[tl][3]), L = s[tl][3];
            A += dppf<0x128>(A); A += dppf<0x124>(A); L += dppf<0x128>(L); L += dppf<0x124>(L);
            if (hh == 0) { const int u = j * 16 + 8 * (tl >> 1) + 2 * kg + (tl & 1); impA[tt * 128 + u] = A; impL[tt * 128 + u] = L; } }
        att_pv(oc, s, vf); };
    nsa_stream2<2>(nct, dmaw, ring, [&](int j, LAS unsigned* dk) { GLDS16(Kc + (size_t)j * 8192 + ksrc, dk); GLDS16(Vc + (size_t)j * 8192 + vsrc, (LAS unsigned*)((LAS unsigned char*)dk + 8192)); },
        [&](int j, LAS const unsigned char* sA, bool hasB, LAS const unsigned char* sB) { cmp2(j, sA); if (hasB) cmp2(j + 1, sB); });
    }
    const int cur = T0 >> 6;
    AttSt sw;
    REPS(504) {
    sw.m = -1e30f; sw.lo = (f32x4){0.f, 0.f, 0.f, 0.f};
#pragma unroll
    for (int dt = 0; dt < 4; ++dt) sw.o[dt] = (f32x4){0.f, 0.f, 0.f, 0.f};
    {
        const unsigned char* Kw = (const unsigned char*)(kwR + (size_t)((b * 2 + g) * 128) * 4096); const unsigned char* Vw = (const unsigned char*)(vwT + (size_t)((b * 2 + g) * 128) * 4096);
        const int s0w = (T0 >= 511 ? (T0 - 511) >> 6 : 0);
        auto wmk = [&](int j) { const int sx = s0w + j; return !(sx > s0w + 1 && sx < cur); };
        nsa_stream2<2>(cur - s0w + 1, dmaw, ring, [&](int j, LAS unsigned* dk) { GLDS16(Kw + (size_t)(s0w + j) * 8192 + ksrc, dk); GLDS16(Vw + (size_t)(s0w + j) * 8192 + vsrc, (LAS unsigned*)((LAS unsigned char*)dk + 8192)); },
            [&](int j, LAS const unsigned char* sA, bool hasB, LAS const unsigned char* sB) {
                const int kA0 = 64 * (s0w + j), kB0 = kA0 + 64;
                if (hasB) att_pair(sw, sA, sB, ko0, ko1, vo0, vo1, qrf, kg, true, true, wmk(j), wmk(j + 1),
                                   [&](int ko) { const int kp = kA0 + ko; return kp <= trow && kp >= trow - 511; }, [&](int ko) { const int kp = kB0 + ko; return kp <= trow && kp >= trow - 511; });
                else { KFrag kf; ldk_lds(kf, sA, ko0, ko1); VFrag vf; ldv_lds(vf, sA, vo0, vo1);
                       att_tile<true>(sw, kf, vf, qrf, kg, true, [&](int ko) { const int kp = kA0 + ko; return kp <= trow && kp >= trow - 511; }); } });
    }
    }
    unsigned long long mylo, myhi, anylo, anyhi;
    if (cur <= 15) { mylo = anylo = (1ull << (cur + 1)) - 1ull; myhi = anyhi = 0ull; }
    else {
        mylo = myhi = anylo = anyhi = 0ull;
        const unsigned long long flo = 1ull | (cur < 64 ? (1ull << cur) : 0ull) | (cur - 1 < 64 ? (1ull << (cur - 1)) : 0ull);
        const unsigned long long fhi = (cur >= 64 ? (1ull << (cur - 64)) : 0ull) | (cur - 1 >= 64 ? (1ull << (cur - 65)) : 0ull);
        const unsigned long long lmask = (1ull << lane) - 1ull;
        unsigned b0[4], b1[4], Tq[4];
#pragma unroll
        for (int tk = 0; tk < 4; ++tk) { const int s0 = lane, s1 = lane + 64;
            const float v0 = impA[tk * 128 + s0] + (s0 > 0 ? impL[tk * 128 + s0 - 1] : 0.f), v1 = impA[tk * 128 + s1] + impL[tk * 128 + s1 - 1];
            b0[tk] = (s0 >= 1 && s0 <= cur - 2) ? __float_as_uint(v0) + 1u : 0u; b1[tk] = (s1 <= cur - 2) ? __float_as_uint(v1) + 1u : 0u; Tq[tk] = 0u; }
        for (int bit = 30; bit >= 0; --bit) {
#pragma unroll
            for (int tk = 0; tk < 4; ++tk) { const unsigned T2 = Tq[tk] | (1u << bit);
                const int c = __popcll(__ballot(b0[tk] >= T2)) + __popcll(__ballot(b1[tk] >= T2)); if (c >= 13) Tq[tk] = T2; } }
#pragma unroll
        for (int tk = 0; tk < 4; ++tk) {
            const unsigned long long gtlo = __ballot(b0[tk] > Tq[tk]), gthi = __ballot(b1[tk] > Tq[tk]), eqlo = __ballot(b0[tk] == Tq[tk]), eqhi = __ballot(b1[tk] == Tq[tk]);
            const int need = 13 - (__popcll(gtlo) + __popcll(gthi));
            const bool t0q = (b0[tk] == Tq[tk]) && (__popcll(eqlo & lmask) < need), t1q = (b1[tk] == Tq[tk]) && (__popcll(eqlo) + __popcll(eqhi & lmask) < need);
            const unsigned long long lo = gtlo | __ballot(t0q) | flo, hi = gthi | __ballot(t1q) | fhi;
            anylo |= lo; anyhi |= hi; if (tt == tk) { mylo = lo; myhi = hi; }
        }
    }
    LAS unsigned long long* msk = (LAS unsigned long long*)(lds + NSA_MSK); LAS unsigned char* lst = lds + NSA_LIST; LAS int* nlst = (LAS int*)(lds + NSA_LIST + 128);
    if (lane == 0) { msk[2 * wv] = anylo; msk[2 * wv + 1] = anyhi; }
    NSA_BAR();
    if (wv == 0) {
        unsigned long long ulo = 0ull, uhi = 0ull;
#pragma unroll
        for (int w2 = 0; w2 < 8; ++w2) { ulo |= msk[2 * w2]; uhi |= msk[2 * w2 + 1]; }
        const unsigned long long lmask = (1ull << lane) - 1ull; const int nlo = __popcll(ulo);
        if ((ulo >> lane) & 1ull) lst[__popcll(ulo & lmask)] = (unsigned char)lane;
        if ((uhi >> lane) & 1ull) lst[nlo + __popcll(uhi & lmask)] = (unsigned char)(64 + lane);
        if (lane == 0) nlst[0] = nlo + __popcll(uhi);
    }
    NSA_BAR();
    const int nsel = nlst[0];
    const int lv0 = lst[lane], lv1 = lst[64 + lane];
    auto lget = [&](int j) { return j < 64 ? __builtin_amdgcn_readlane(lv0, j) : __builtin_amdgcn_readlane(lv1, j - 64); };
    AttSt ss;
    REPS(503) {
    ss.m = -1e30f; ss.lo = (f32x4){0.f, 0.f, 0.f, 0.f};
#pragma unroll
    for (int dt = 0; dt < 4; ++dt) ss.o[dt] = (f32x4){0.f, 0.f, 0.f, 0.f};
    {
        const unsigned char* Ks = (const unsigned char*)(ksR + (size_t)((b * 2 + g) * 128) * 4096); const unsigned char* Vs = (const unsigned char*)(vsT + (size_t)((b * 2 + g) * 128) * 4096);
        auto sel1 = [&](int s, LAS const unsigned char* slot, AttSt& st) {
            KFrag kf; ldk_lds(kf, slot, ko0, ko1); VFrag vf; ldv_lds(vf, slot, vo0, vo1);
            const bool mybit = (((s < 64 ? mylo : myhi) >> (s & 63)) & 1ull) != 0ull;
            if (s < cur) att_tile<false>(st, kf, vf, qrf, kg, mybit, [&](int) { return true; });
            else att_tile<true>(st, kf, vf, qrf, kg, mybit, [&](int ko) { return 64 * s + ko <= trow; }); };
        nsa_stream2<2>(nsel, dmaw, ring, [&](int j, LAS unsigned* dk) { const int sj = lget(j); GLDS16(Ks + (size_t)sj * 8192 + ksrc, dk); GLDS16(Vs + (size_t)sj * 8192 + vsrc, (LAS unsigned*)((LAS unsigned char*)dk + 8192)); },
            [&](int j, LAS const unsigned char* sA, bool hasB, LAS const unsigned char* sB) {
                const int s0 = lget(j); const int s1 = hasB ? lget(j + 1) : 0;
                const bool nA = (((s0 < 64 ? anylo : anyhi) >> (s0 & 63)) & 1ull) != 0ull, nB = hasB && ((((s1 < 64 ? anylo : anyhi) >> (s1 & 63)) & 1ull) != 0ull);
                if (nA && nB) { const bool bA = (((s0 < 64 ? mylo : myhi) >> (s0 & 63)) & 1ull) != 0ull, bB = (((s1 < 64 ? mylo : myhi) >> (s1 & 63)) & 1ull) != 0ull;
                    att_pair(ss, sA, sB, ko0, ko1, vo0, vo1, qrf, kg, bA, bB, false, s1 >= cur, [&](int) { return true; }, [&](int ko) { return 64 * s1 + ko <= trow; }); }
                else if (nA) sel1(s0, sA, ss);
                else if (nB) sel1(s1, sB, ss); });
    }
    }
    const float ls = ss.lo[0], lw = sw.lo[0];
    const float g0 = sigmf(gt0), g1 = sigmf(gt1) / ls, g2 = sigmf(gt2) / lw;
#pragma unroll
    for (int dt = 0; dt < 4; ++dt) { const f32x4 o = oc[dt] * g0 + ss.o[dt] * g1 + sw.o[dt] * g2;
        *(h16x4*)(mix + mrow * D + 512 + (g * 4 + hh) * 64 + 16 * dt + 4 * kg) = __builtin_convertvector(o, h16x4); }
#undef GLDS16
}

template <class Sched>
__device__ __forceinline__ void xattn_block(const h16* __restrict__ qx, const h16* __restrict__ kx, const h16* __restrict__ kvmVT, h16* __restrict__ ox, const Sched& S, LAS unsigned char* lds, int wv, int lane) {
    const int i = lane & 15, kg = lane >> 4;
    const int gki = ((i >> 1) & 1) | ((i >> 2) << 1), gvi = (i >> 1) & 7;
    const int ko0 = (8 * (i >> 2) + (i & 3)) * 512 + ((kg ^ gki) << 4), ko1 = (8 * (i >> 2) + (i & 3)) * 512 + (((kg + 4) ^ gki) << 4);
    const int gve = 4 * ((i >> 2) & 1) + ((i >> 1) & 1), vbe = (8 * (i >> 2) + (i & 3)) * 128;
    const int voe0 = vbe + ((kg ^ gve) << 4), voe1 = vbe + (((kg + 4) ^ gve) << 4), voo0 = vbe + 512 + ((kg ^ (gve | 2)) << 4), voo1 = vbe + 512 + (((kg + 4) ^ (gve | 2)) << 4);
    const int t = wv * 64 + lane;
    int ksrc[4], vsrc[4];
#pragma unroll
    for (int pz = 0; pz < 4; ++pz) { const int q = pz * 512 + t;
        { const int row = q >> 5, cp = q & 31; const int gk = ((row >> 1) & 1) | (((row >> 3) & 3) << 1); ksrc[pz] = row * 512 + ((cp ^ gk) << 4); }
        { const int row = q >> 3, cp = q & 7; vsrc[pz] = row * 512 + ((cp ^ ((row >> 1) & 7)) << 4); } }
    int ngu = 0; { pg8::Unit uu; while (S.next(ngu, uu)) ++ngu; }
    const int ntile = ngu * 2 * 4;
    auto unit_of = [&](int j, int& m0, int& hh) { pg8::Unit uu; S.next(j >> 1, uu); m0 = uu.pm * 256 + (j & 1) * 128; hh = uu.pn; };
    auto issue = [&](int tix, int slot) { const int grp = tix & 3; int m0, hh; unit_of(tix >> 2, m0, hh); const int b = m0 >> 13;
        const unsigned char* Kb = (const unsigned char*)(kx + ((size_t)(b * 4 + hh) * MEML + 64 * grp) * 256); const unsigned char* Vb = (const unsigned char*)(kvmVT + (size_t)((b * 4 + hh) * 256) * MEML + 64 * grp);
        LAS unsigned char* base = lds + slot * 65536 + wv * 1024;
#pragma unroll
        for (int pz = 0; pz < 4; ++pz) { __builtin_amdgcn_global_load_lds((const unsigned*)(Kb + ksrc[pz]), (LAS unsigned*)(base + pz * 8192), 16, 0, 0);
                                        __builtin_amdgcn_global_load_lds((const unsigned*)(Vb + vsrc[pz]), (LAS unsigned*)(base + 32768 + pz * 8192), 16, 0, 0); } };
    NSA_WAITV(0);
    if (ntile > 0) issue(0, 0);
    h16x8 qf[8]; f32x4 o[16]; float mrun = -1e30f, l = 0.f; size_t mrow = 0; int hh = 0;
    for (int tix = 0; tix < ntile; ++tix) {
        const int grp = tix & 3, slot = tix & 1;
        if (grp == 0) {
            int m0u; unit_of(tix >> 2, m0u, hh); mrow = (size_t)(m0u + wv * 16 + i);
#pragma unroll
            for (int ks = 0; ks < 8; ++ks) qf[ks] = *(const h16x8*)(qx + mrow * D + hh * 256 + 32 * ks + 8 * kg);
#pragma unroll
            for (int dt = 0; dt < 16; ++dt) o[dt] = (f32x4){0.f, 0.f, 0.f, 0.f};
            mrun = -1e30f; l = 0.f;
        }
        NSA_WAITV(0);
        NSA_BAR();
        if (tix + 1 < ntile) issue(tix + 1, slot ^ 1);
        LAS const unsigned char* sk = lds + slot * 65536; LAS const unsigned char* sv = sk + 32768;
        f32x4 s[4];
#pragma unroll
        for (int tl = 0; tl < 4; ++tl) s[tl] = (f32x4){0.f, 0.f, 0.f, 0.f};
#pragma unroll
        for (int ks = 0; ks < 8; ++ks) { h16x8 kf[4];
#pragma unroll
            for (int tl = 0; tl < 4; ++tl) kf[tl] = *(LAS const h16x8*)(sk + (32 * (tl >> 1) + 4 * (tl & 1)) * 512 + 128 * (ks >> 1) + ((ks & 1) ? ko1 : ko0));
#pragma unroll
            for (int tl = 0; tl < 4; ++tl) s[tl] = __builtin_amdgcn_mfma_f32_16x16x32_f16(kf[tl], qf[ks], s[tl], 0, 0, 0); }
        const float mx = att_rowmax(s) * (0.0625f * 1.4426950408889634f);
        if (__any(mx > mrun + ATT_THR)) {
            const float mn2 = fmx(mrun, mx); const float alpha = __builtin_amdgcn_exp2f(mrun - mn2); mrun = mn2; l *= alpha;
#pragma unroll
            for (int dt = 0; dt < 16; ++dt) o[dt] = o[dt] * alpha; }
        const float mn = mrun;
        float ps = 0.f; h16x8 pf[2];
#pragma unroll
        for (int tl = 0; tl < 4; ++tl)
#pragma unroll
            for (int r = 0; r < 4; ++r) { const float pe = __builtin_amdgcn_exp2f(__builtin_fmaf(s[tl][r], 0.0625f * 1.4426950408889634f, -mn)); ps += pe; pf[tl >> 1][4 * (tl & 1) + r] = (h16)pe; }
        l += ps;
#pragma unroll
        for (int dt = 0; dt < 16; ++dt) { f32x4 acc = o[dt];
            acc = __builtin_amdgcn_mfma_f32_16x16x32_f16(*(LAS const h16x8*)(sv + (dt >> 1) * 4096 + ((dt & 1) ? voo0 : voe0)), pf[0], acc, 0, 0, 0);
            acc = __builtin_amdgcn_mfma_f32_16x16x32_f16(*(LAS const h16x8*)(sv + (dt >> 1) * 4096 + ((dt & 1) ? voo1 : voe1)), pf[1], acc, 0, 0, 0);
            o[dt] = acc; }
        if (grp == 3) { const float linv = 1.f / xsum4(l); const bool odd = i & 1;
            h16* const ob = ox + hh * 256 + 8 * kg + (odd ? 32 : 0); const size_t re = (mrow & ~(size_t)1) * D, ro = (mrow | 1) * D;
#pragma unroll
            for (int sx = 0; sx < 4; ++sx) {
                const u32x4 P0 = __builtin_bit_cast(u32x4, __builtin_convertvector(__builtin_shufflevector(o[4 * sx] * linv, o[4 * sx + 1] * linv, 0, 1, 2, 3, 4, 5, 6, 7), h16x8));
                const u32x4 P1 = __builtin_bit_cast(u32x4, __builtin_convertvector(__builtin_shufflevector(o[4 * sx + 2] * linv, o[4 * sx + 3] * linv, 0, 1, 2, 3, 4, 5, 6, 7), h16x8));
                const u32x4 snd = odd ? P0 : P1; u32x4 rcv;
#pragma unroll
                for (int d = 0; d < 4; ++d) rcv[d] = (unsigned)__builtin_amdgcn_update_dpp(0, (int)snd[d], 0xB1, 0xf, 0xf, true);
                *(u32x4*)(ob + re + 64 * sx) = odd ? rcv : P0;
                *(u32x4*)(ob + ro + 64 * sx) = odd ? P1 : rcv; } }
    }
    NSA_WAITV(0);
    NSA_BAR();
}

__device__ __forceinline__ float gmax8(float v) { v = fmx(v, dppf<0xB1>(v)); v = fmx(v, dppf<0x4E>(v)); return fmx(v, dppf<0x141>(v)); }
__device__ __forceinline__ int gmin8(int v) { v = min(v, dppi<0xB1>(v)); v = min(v, dppi<0x4E>(v)); return min(v, dppi<0x141>(v)); }
__device__ __forceinline__ void route16(LAS const float* lg, int m0, int lane, const float* __restrict__ rbias, int* __restrict__ tope, float* __restrict__ topw, LAS int* hist) {
    const float rb = rbias[lane];
    const unsigned long long ltm = (1ull << lane) - 1ull;
    float score[16]; unsigned key[16], Tq[16];
#pragma unroll
    for (int tk = 0; tk < 16; ++tk) {
        const float logit = lg[tk * 64 + lane];
        score[tk] = 1.f / (1.f + expf(-logit)); const float biased = score[tk] + rb;
        const float m1 = gmax8(biased);
        const int am = gmin8((biased == m1) ? lane : 999);
        const float m2 = gmax8((lane == am) ? -INFINITY : biased);
        const float gs = m1 + m2;
        int cnt = 0;
#pragma unroll
        for (int gq = 0; gq < 8; ++gq) cnt += (rlanef(gs, gq * 8) > gs) ? 1 : 0;
        const float masked = (cnt <= 3) ? biased : NEGF;
        const unsigned bb = __float_as_uint(masked); key[tk] = bb ^ ((bb >> 31) ? 0xffffffffu : 0x80000000u); Tq[tk] = 0u;
    }
    for (int bit = 31; bit >= 0; --bit) {
#pragma unroll
        for (int tk = 0; tk < 16; ++tk) { const unsigned T2 = Tq[tk] | (1u << bit); if (__popcll(__ballot(key[tk] >= T2)) >= 8) Tq[tk] = T2; } }
#pragma unroll
    for (int tk = 0; tk < 16; ++tk) {
        const unsigned long long gt = __ballot(key[tk] > Tq[tk]), eq = __ballot(key[tk] == Tq[tk]);
        const int need = 8 - __popcll(gt);
        const bool selq = key[tk] > Tq[tk] || (key[tk] == Tq[tk] && __popcll(eq & ltm) < need);
        const unsigned long long sm = __ballot(selq);
        const float wsum = wsum64(selq ? score[tk] : 0.f);
        if (selq) { const int rank = __popcll(sm & ltm); const int m = m0 + tk;
            tope[(size_t)m * 8 + rank] = lane; topw[(size_t)m * 8 + rank] = score[tk] / wsum * 2.5f; __hip_atomic_fetch_add(hist + (m >> 13) * 65 + lane, 1, __ATOMIC_RELAXED, __HIP_MEMORY_SCOPE_WORKGROUP); }
    }
}
__device__ __forceinline__ void router_round(const Params& p, const float* __restrict__ pre, const f32x2* __restrict__ st2, h16* __restrict__ x2h, const h16* __restrict__ WrT, int* __restrict__ tope, float* __restrict__ topw,
                                             LAS int* hist, int m0, bool act, LAS unsigned char* lds, LAS float* lg, int wv, int lane) {
    const int i = lane & 15, kg = lane >> 4;
    const int mrow = act ? m0 + i : 0;
    const float* xr = pre + (size_t)mrow * D + 8 * kg;
    float s1 = 0.f, s2 = 0.f;
#pragma unroll
    for (int k = 0; k < 4; ++k) { const f32x2 pz = st2[(size_t)mrow * 16 + 4 * kg + k]; s1 += pz[0]; s2 += pz[1]; }
    s1 = xsum4(s1); s2 = xsum4(s2);
    const float mean = s1 * (1.f / D); const float rstd = rsqrtf(fmaxf(s2 * (1.f / D) - mean * mean, 0.f) + LN_EPS);
    f32x4 am_[4], ac_[4];
#pragma unroll
    for (int et = 0; et < 4; ++et) { am_[et] = (f32x4){0.f, 0.f, 0.f, 0.f}; ac_[et] = (f32x4){0.f, 0.f, 0.f, 0.f}; }
    h16* xo = x2h + (size_t)mrow * D + 8 * kg;
    const int q = wv * 64 + lane, qrow = q >> 3, qch = q & 7;
    const int ksrc = qrow * 128 + ((qch ^ (((qrow >> 1) & 1) | (((qrow >> 3) & 3) << 1))) << 4);
    const int gki = ((i >> 1) & 1) | ((i >> 2) << 1);
    const int ko0 = (8 * (i >> 2) + (i & 3)) * 128 + ((kg ^ gki) << 4), ko1 = (8 * (i >> 2) + (i & 3)) * 128 + (((kg + 4) ^ gki) << 4);
    LAS unsigned char* ring = lds + NSA_RING; LAS unsigned char* dmaw = ring + wv * 1024;
    const unsigned char* Wt = (const unsigned char*)WrT;
    LAS const float* gb = (LAS const float*)(lds + 131072 + 4096);
    auto tile = [&](int j, LAS const unsigned char* slot) {
        KFrag wh, wl; ldk_lds(wh, slot, ko0, ko1); ldk_lds(wl, slot + 8192, ko0, ko1);
#pragma unroll
        for (int k2 = 0; k2 < 2; ++k2) { const int ks = 2 * j + k2;
            f32x4 x0 = *(const f32x4*)(xr + 32 * ks), x1 = *(const f32x4*)(xr + 32 * ks + 4);
            const f32x4 g0 = *(LAS const f32x4*)(gb + 32 * ks + 8 * kg), g1 = *(LAS const f32x4*)(gb + 32 * ks + 8 * kg + 4), b0 = *(LAS const f32x4*)(gb + 1024 + 32 * ks + 8 * kg), b1 = *(LAS const f32x4*)(gb + 1024 + 32 * ks + 8 * kg + 4);
            x0 = (x0 - mean) * rstd * g0 + b0; x1 = (x1 - mean) * rstd * g1 + b1;
            h16x8 xh, xl;
#pragma unroll
            for (int jj = 0; jj < 4; ++jj) { xh[jj] = (h16)x0[jj]; xl[jj] = (h16)((x0[jj] - (float)xh[jj]) * 2048.f); xh[4 + jj] = (h16)x1[jj]; xl[4 + jj] = (h16)((x1[jj] - (float)xh[4 + jj]) * 2048.f); }
            if (act) *(h16x8*)(xo + 32 * ks) = xh;
#pragma unroll
            for (int et = 0; et < 4; ++et) am_[et] = __builtin_amdgcn_mfma_f32_16x16x32_f16(wh.a[et][k2], xh, am_[et], 0, 0, 0);
#pragma unroll
            for (int et = 0; et < 4; ++et) ac_[et] = __builtin_amdgcn_mfma_f32_16x16x32_f16(wh.a[et][k2], xl, ac_[et], 0, 0, 0);
#pragma unroll
            for (int et = 0; et < 4; ++et) ac_[et] = __builtin_amdgcn_mfma_f32_16x16x32_f16(wl.a[et][k2], xh, ac_[et], 0, 0, 0); } };
    NSA_WAITV(0);
    nsa_stream2<2>(16, dmaw, ring, [&](int j, LAS unsigned* dk) { __builtin_amdgcn_global_load_lds((const unsigned*)(Wt + (size_t)j * 16384 + ksrc), dk, 16, 0, 0);
                                                                    __builtin_amdgcn_global_load_lds((const unsigned*)(Wt + (size_t)j * 16384 + 8192 + ksrc), (LAS unsigned*)((LAS unsigned char*)dk + 8192), 16, 0, 0); },
        [&](int j, LAS const unsigned char* sA, bool hasB, LAS const unsigned char* sB) { tile(j, sA); if (hasB) tile(j + 1, sB); });
    if (act) {
#pragma unroll
        for (int et = 0; et < 4; ++et)
#pragma unroll
            for (int r = 0; r < 4; ++r) lg[i * 64 + 16 * et + 4 * kg + r] = am_[et][r] + ac_[et][r] * (1.f / 2048.f);
        route16(lg, m0, lane, p.rbias, tope, topw, hist); }
}

struct G1Sched {
    const int* ctl; const char* x2h; const unsigned* rowoff; const char* WguT; int G, c;
    __device__ bool next(int i, pg8::Unit& u) const {
        const int ntile = ctl[CTL_NT1]; const long L = (long)i * G + c; if (L >= 2L * ntile) return false;
        const int tile = (int)(L >> 1), pn = (int)(L & 1); const int e = ctl[CTL_TVE + tile];
        u.pm = tile; u.pn = pn; u.A = x2h; u.gat = rowoff + (size_t)tile * 256; u.B = WguT + ((size_t)e * 512 + pn * 256) * (D * 2); return true; }
};
struct G2Sched {
    const int* ctl; const char* H; const char* WdT; int q, G, c;
    __device__ bool next(int i, pg8::Unit& u) const {
        const int t0 = ctl[CTL_TQS + q], t1 = ctl[CTL_TQS + q + 1]; const long L = (long)i * G + c; if (L >= 4L * (t1 - t0)) return false;
        const int tile = t0 + (int)(L >> 2), pn = (int)(L & 3); const int start = ctl[CTL_T2 + 3 * tile], e = ctl[CTL_T2 + 3 * tile + 1];
        u.pm = tile; u.pn = pn; u.A = H + (size_t)start * (EFF * 2); u.gat = nullptr; u.B = WdT + ((size_t)e * D + pn * 256) * (EFF * 2); return true; }
};
__device__ __forceinline__ void b_scatter(int* __restrict__ ctl, const int* __restrict__ tope, const float* __restrict__ topw, unsigned* __restrict__ rowoff, u32x2* __restrict__ rowmeta, int* sl) {
    int* pst = sl;
    int* pc = sl + 512;
    int* est = sl + 2048;
    int* t2s = sl + 2176;
    for (int v = tidx(); v < NVE; v += NTHR) pc[v] = ctl[CTL_CNT + v];
    __syncthreads();
    if (tidx() == 0) { int acc = 0; for (int e = 0; e < 65; ++e) { est[e] = acc; int t = 0; for (int qq = 0; qq < NQ; ++qq) t += pc[qq * 65 + e]; acc += (t + 255) & ~255; } est[65] = acc; }
    if (tidx() == 64) { int acc = 0; for (int v = 0; v < NVE; ++v) { t2s[v] = acc; acc += (pc[v] + 255) >> 8; } t2s[NVE] = acc; }
    __syncthreads();
    for (int v = tidx(); v < NVE; v += NTHR) { const int qq = v / 65, e = v % 65; int a = est[e]; for (int q2 = 0; q2 < qq; ++q2) a += pc[q2 * 65 + e]; pst[v] = a; }
    __syncthreads();
    if (blockIdx.x == 0) {
        if (tidx() <= NQ) ctl[CTL_TQS + tidx()] = t2s[tidx() * 65];
        if (tidx() == 0) ctl[CTL_NT1] = est[65] >> 8;
        for (int e = tidx(); e < 65; e += NTHR) for (int tl = est[e] >> 8; tl < (est[e + 1] >> 8); ++tl) ctl[CTL_TVE + tl] = e;
        for (int v = tidx(); v < NVE; v += NTHR) { const int nt = (pc[v] + 255) >> 8;
            for (int k = 0; k < nt; ++k) { int* tp = ctl + CTL_T2 + 3 * (t2s[v] + k); tp[0] = pst[v] + 256 * k; tp[1] = v % 65; tp[2] = min(256, pc[v] - 256 * k); } }
    }
    int* lh = sl + 1024; int* lb = sl + 1536;
    const int chunk = (M + (int)gridDim.x - 1) / (int)gridDim.x, tend = min(M, ((int)blockIdx.x + 1) * chunk);
    for (int t0 = (int)blockIdx.x * chunk; t0 < tend; t0 += 64) {
        const int ntok = min(64, tend - t0);
        for (int v = tidx(); v < NVE; v += NTHR) lh[v] = 0;
        __syncthreads();
        const int it = tidx(); const bool val = it < ntok * 8; int ve = 0, lp = 0, m = 0;
        if (val) { m = t0 + (it >> 3); ve = (m >> 13) * 65 + tope[(size_t)m * 8 + (it & 7)]; lp = __hip_atomic_fetch_add(lh + ve, 1, __ATOMIC_RELAXED, __HIP_MEMORY_SCOPE_WORKGROUP); }
        __syncthreads();
        for (int v = tidx(); v < NVE; v += NTHR) { const int c = lh[v]; lb[v] = c ? atomicAdd(ctl + CTL_CUR + v, c) : 0; }
        __syncthreads();
        if (val) { const int pos = pst[ve] + lb[ve] + lp; rowoff[pos] = (unsigned)m * (D * 2); rowmeta[pos] = (u32x2){(unsigned)((m & (QT - 1)) * 9 + (it & 7)), __float_as_uint(topw[(size_t)m * 8 + (it & 7)])}; }
        if (it < ntok) { const int ms = t0 + it; const int pos = pst[(ms >> 13) * 65 + 64] + (ms & (QT - 1)); rowoff[pos] = (unsigned)ms * (D * 2); rowmeta[pos] = (u32x2){(unsigned)((ms & (QT - 1)) * 9 + 8), __float_as_uint(1.f)}; }
        __syncthreads();
    }
    __syncthreads();
}
__device__ __forceinline__ void b_combine(const Params& p, const h16* __restrict__ x2h, const h16* __restrict__ Y, int q) {
    const int lane = tidx() & 63;
    for (int r = blockIdx.x * 8 + (tidx() >> 6); r < QT; r += gridDim.x * 8) {
        const int m = q * QT + r;
        float v[16];
        { const h16x8 a = ((const h16x8*)(x2h + (size_t)m * D))[lane], b = ((const h16x8*)(x2h + (size_t)m * D))[lane + 64];
#pragma unroll
          for (int i = 0; i < 8; ++i) { v[i] = DN_ALPHA * (float)a[i]; v[8 + i] = DN_ALPHA * (float)b[i]; } }
#pragma unroll
        for (int k = 0; k < 9; ++k) { const h16x8* yr = (const h16x8*)(Y + ((size_t)r * 9 + k) * D); const h16x8 a = yr[lane], b = yr[lane + 64];
#pragma unroll
            for (int i = 0; i < 8; ++i) { v[i] += (float)a[i]; v[8 + i] += (float)b[i]; } }
        float s = 0.f;
#pragma unroll
        for (int i = 0; i < 16; ++i) s += v[i];
        const float mean = wave_sum(s) * (1.f / D); float s2 = 0.f;
#pragma unroll
        for (int i = 0; i < 16; ++i) { v[i] -= mean; s2 += v[i] * v[i]; }
        const float rstd = rsqrtf(wave_sum(s2) * (1.f / D) + LN_EPS);
#pragma unroll
        for (int hlf = 0; hlf < 2; ++hlf) { const int c0 = (lane + 64 * hlf) * 8;
            const f32x4 g0 = *(const f32x4*)(p.ln3g + c0), g1 = *(const f32x4*)(p.ln3g + c0 + 4), b0 = *(const f32x4*)(p.ln3b + c0), b1 = *(const f32x4*)(p.ln3b + c0 + 4);
            f32x4 o0, o1;
#pragma unroll
            for (int i = 0; i < 4; ++i) { o0[i] = v[8 * hlf + i] * rstd * g0[i] + b0[i]; o1[i] = v[8 * hlf + 4 + i] * rstd * g1[i] + b1[i]; }
            const bool odd = lane & 1; const u32x4 snd = __builtin_bit_cast(u32x4, odd ? o0 : o1), own = __builtin_bit_cast(u32x4, odd ? o1 : o0); u32x4 rcv;
#pragma unroll
            for (int d = 0; d < 4; ++d) rcv[d] = (unsigned)__builtin_amdgcn_update_dpp(0, (int)snd[d], 0xB1, 0xf, 0xf, true);
            float* const op = p.out + (size_t)m * D + c0;
            *(u32x4*)(op + (odd ? -4 : 0)) = odd ? rcv : own; *(u32x4*)(op + (odd ? 4 : 8)) = odd ? own : rcv; }
    }
}

#define XB_TMO      128
#define XB_XCNT(j)  (256  + 64 * (j))
#define XB_XSUB(j)  (1280 + 64 * (j))
#define XB_XGEN(j)  (2304 + 64 * (j))
#define XB_TOP      3328
#define XB_TOPGEN   3392
#define XCD_BAR_WORDS 3456
#define XB_SPIN_CAP (1u << 22)
__device__ __forceinline__ unsigned xb_ld(unsigned* p)              { return __hip_atomic_load(p, __ATOMIC_RELAXED, __HIP_MEMORY_SCOPE_AGENT); }
__device__ __forceinline__ unsigned xb_add(unsigned* p, unsigned v) { return __hip_atomic_fetch_add(p, v, __ATOMIC_RELAXED, __HIP_MEMORY_SCOPE_AGENT); }
__device__ __forceinline__ unsigned xb_xcc_id() { return (unsigned)__builtin_amdgcn_s_getreg((3 << 11) | 20) & 0xFu; }
#define XB_SPIN(cond, bar) do { unsigned _sp = 0; while (cond) { __builtin_amdgcn_s_sleep(1); \
    if ((++_sp & 255u) == 0u) { if (xb_ld(&(bar)[XB_TMO])) break; if (_sp > XB_SPIN_CAP) { atomicAdd(&(bar)[XB_TMO], 1u); break; } } } } while (0)
struct XcdBarrier { unsigned* bar; unsigned x; volatile LAS unsigned* st; };
__device__ __forceinline__ XcdBarrier xcd_barrier_post(unsigned* bar, volatile LAS unsigned* st) {
    XcdBarrier b; b.bar = bar; b.x = xb_xcc_id(); b.st = st;
    if (threadIdx.x == 0) (void)xb_add(&bar[XB_XCNT(b.x)], 1u);
    return b;
}
__device__ __forceinline__ void xcd_barrier_complete(unsigned* bar, unsigned x, unsigned& nloc, unsigned& nx) {
    const unsigned G = gridDim.x * gridDim.y * gridDim.z;
    unsigned sum, cnt, mine, sp = 0u;
    for (;;) {
        sum = 0u; cnt = 0u; mine = 0u;
#pragma unroll
        for (unsigned j = 0; j < 16; ++j) { const unsigned c = xb_ld(&bar[XB_XCNT(j)]); sum += c; cnt += (c > 0u) ? 1u : 0u; mine = (j == x) ? c : mine; }
        if (sum == G) break;
        __builtin_amdgcn_s_sleep(1);
        if ((++sp & 255u) == 0u) { if (xb_ld(&bar[XB_TMO])) break; if (sp > XB_SPIN_CAP) { atomicAdd(&bar[XB_TMO], 1u); break; } }
    }
    nloc = mine > 0u ? mine : 1u; nx = cnt > 0u ? cnt : 1u;
}
template <bool FENCE = true>
__device__ __forceinline__ void xcd_barrier(const XcdBarrier& b) {
    asm volatile("s_waitcnt vmcnt(0)" ::: "memory");
    __syncthreads();
    if (threadIdx.x == 0) {
        unsigned* bar = b.bar;
        __builtin_amdgcn_s_waitcnt(0);
        unsigned nloc = b.st[0], nx = b.st[1];
        if (nloc == 0u) { xcd_barrier_complete(bar, b.x, nloc, nx); b.st[0] = nloc; b.st[1] = nx; }
        const unsigned old = xb_add(&bar[XB_XSUB(b.x)], 1u);
        const unsigned gen = old / nloc;
        if (old + 1u == (gen + 1u) * nloc) {
            if (FENCE) __builtin_amdgcn_fence(__ATOMIC_RELEASE, "agent");
            asm volatile("s_waitcnt vmcnt(0)" ::: "memory");
            (void)xb_add(&bar[XB_TOP], 1u);
            XB_SPIN(xb_ld(&bar[XB_TOP]) < (gen + 1u) * nx, bar);
            if (FENCE) __builtin_amdgcn_fence(__ATOMIC_ACQUIRE, "agent");
            xb_add(&bar[XB_XGEN(b.x)], 1u);
            asm volatile("s_waitcnt vmcnt(0)" ::: "memory");
        } else {
            if (FENCE) __builtin_amdgcn_fence(__ATOMIC_ACQUIRE, "agent");
            asm volatile("s_waitcnt vmcnt(0)" ::: "memory");
            XB_SPIN(xb_ld(&bar[XB_XGEN(b.x)]) == gen, bar);
            asm volatile("s_waitcnt vmcnt(0)" ::: "memory");
        }
    }
    __syncthreads();
}

constexpr int N_PHASES = 23;

__global__ void __launch_bounds__(NTHR, 2) mega_fwd(Params p) {
    extern __shared__ __attribute__((aligned(16))) unsigned char lds[];
    const int G = (int)gridDim.x, bid = (int)blockIdx.x;
#define tid tidx()
    unsigned char* ws = p.ws;
    h16* WinT = (h16*)(ws + WS_WIN); h16* WoutT = (h16*)(ws + WS_WOUT); h16* WxqT = (h16*)(ws + WS_WXQ); h16* WxoT = (h16*)(ws + WS_WXO); h16* WxkvT = (h16*)(ws + WS_WXKV);
    h16* memh = (h16*)(ws + WS_MEMH); h16* kvm = (h16*)(ws + WS_KVM); h16* kcmp = (h16*)(ws + WS_KCMP); h16* vcmpT = (h16*)(ws + WS_VCMP); h16* vsT = (h16*)(ws + WS_VST); h16* vwT = (h16*)(ws + WS_VWT);
    int* tope = (int*)(ws + WS_TOPE); float* topw = (float*)(ws + WS_TOPW);
    h16* xh = (h16*)(ws + WS_XH); h16* mix = (h16*)(ws + WS_MIX); h16* ox = (h16*)(ws + WS_OX); h16* hb = (h16*)(ws + WS_H); h16* nqr = (h16*)(ws + WS_NQR);
    float* kvb = (float*)(ws + WS_KVB); h16* prevT = (h16*)(ws + WS_PREVT);
    float* cosr = (float*)(ws + WS_COSR); float* sinr = (float*)(ws + WS_SINR); float* cosn = (float*)(ws + WS_COSN); float* sinn = (float*)(ws + WS_SINN); h16* kvmVT = (h16*)(ws + WS_KVMVT); f32x2* st1 = (f32x2*)(ws + WS_X1); h16* vh = (h16*)(ws + WS_X1H); float* scv = (float*)(ws + WS_SC); float* tcv = (float*)(ws + WS_TC); float* gb1 = (float*)(ws + WS_GB1); h16* WrTh = (h16*)(ws + WS_WRTH); h16* WrTl = (h16*)(ws + WS_WRTL); h16* Wc1T = (h16*)(ws + WS_WC1T); h16* hid = (h16*)(ws + WS_HID); unsigned* cmpoff = (unsigned*)(ws + WS_CMPOFF); float* peb = (float*)(ws + WS_PEB); h16* ksR = (h16*)(ws + WS_KSR); h16* kwR = (h16*)(ws + WS_KWR); h16* kx = (h16*)(ws + WS_KX);
    h16* rqr = (h16*)((unsigned char*)p.out + DO_RQR); h16* rkr = (h16*)((unsigned char*)p.out + DO_RKR); h16* rkzT = (h16*)((unsigned char*)p.out + DO_RKZT); h16* rvT = (h16*)((unsigned char*)p.out + DO_RVT); float* pre = p.out; float* x1 = (float*)(ws + WS_X1); h16* x1h = (h16*)(ws + WS_X1H);
    h16* qx = (h16*)(ws + WS_QX); float* x2 = (float*)(ws + WS_X2); h16* x2h = (h16*)(ws + WS_X2H);
    int* ctl = (int*)ws; unsigned* rowoff = (unsigned*)(ws + WS_ROWOFF); u32x2* rowmeta = (u32x2*)(ws + WS_ROWMETA);
    h16* WguT = (h16*)(ws + WS_WGUT); h16* WdT = (h16*)(ws + WS_WDT); h16* Hm = (h16*)(ws + WS_HM); h16* Yq = (h16*)(ws + WS_Y);
    float* fl = (float*)lds;
    const int lo = p.ph_lo, hi = p.ph_hi;
#define IN(k) (lo <= (k) && (k) < hi)
    { volatile LAS unsigned* st = (volatile LAS unsigned*)((LAS unsigned char*)lds + 131072); if (threadIdx.x < 2) st[threadIdx.x] = 0u; }
    __syncthreads();
    XcdBarrier xbar = xcd_barrier_post((unsigned*)(ws + WS_BAR), (volatile LAS unsigned*)((LAS unsigned char*)lds + 131072));
#define SEAM(k) do { if (IN(k) && IN((k) + 1)) xcd_barrier(xbar); } while (0)

    if (IN(0)) REPS(0) {
        { const int sub = tid >> 8, lt = tid & 255; float* tl = fl + sub * 1088;
          constexpr int T0 = (INP / 32) * (D / 32);
          for (int b0 = bid * 2; b0 < T0; b0 += G * 2) b_transpose_tile(p.w_in, D, INC, WinT, INP, b0 + sub, tl, lt); }
        { const int wv = __builtin_amdgcn_readfirstlane(tid >> 6), lane = tid & 63; LAS float* scr = (LAS float*)((LAS unsigned char*)lds + wv * 8704);
          constexpr int I1 = (D / 64) * (D / 32), I4 = (D / 64) * (2 * D / 32), I5 = (2048 / 64) * (256 / 32), IT = 3 * I1 + I4 + 2 * I5;
          for (int it0 = bid * 8 + wv; it0 < IT; it0 += G * 8) { int it = it0;
            if (it < I1) { w_transpose_item(p.w_out, D, D, WoutT, it, scr, lane); continue; } it -= I1;
            if (it < I1) { w_transpose_item(p.w_xq, D, D, WxqT, it, scr, lane, 1, 0, p.ln1g); continue; } it -= I1;
            if (it < I1) { w_transpose_item(p.w_xo, D, D, WxoT, it, scr, lane); continue; } it -= I1;
            if (it < I4) { w_transpose_item(p.w_xkv, D, 2 * D, WxkvT, it, scr, lane); continue; } it -= I4;
            if (it < I5) { w_transpose_item(p.w1k, 2048, 256, Wc1T, it, scr, lane); continue; } it -= I5;
            w_transpose_item(p.w1v, 2048, 256, Wc1T + 256 * 2048, it, scr, lane); } }
        __syncthreads();
        b_cvt(p.x, xh, (size_t)M * D / 4);
        b_cvt(p.mem, memh, (size_t)NB * MEML * D / 4);
        if (bid == 0) for (int i = tid; i < 1024; i += NTHR) ctl[i] = 0;
        b_tables(p.positions, cosr, sinr, cosn, sinn, (LAS float*)((LAS unsigned char*)lds));
        if (bid == 1) for (int i = tid; i < 2 * D; i += NTHR) gb1[i] = i < D ? p.ln1g[i] : p.ln1b[i - D];
        for (int cb = bid; cb < D / 4; cb += G) { const int ci = tid & 3, kk = tid >> 2; const int c = cb * 4 + ci; float sa = 0.f, ta = 0.f;
            for (int k = kk; k < D; k += 128) { const float w = p.w_xq[(size_t)k * D + c]; sa += p.ln1g[k] * w; ta += p.ln1b[k] * w; }
            fl[tid * 2] = sa; fl[tid * 2 + 1] = ta; __syncthreads();
            if (tid < 4) { float s = 0.f, t2 = 0.f; for (int k2 = 0; k2 < 128; ++k2) { s += fl[(k2 * 4 + tid) * 2]; t2 += fl[(k2 * 4 + tid) * 2 + 1]; } scv[cb * 4 + tid] = s; tcv[cb * 4 + tid] = t2; }
            __syncthreads(); }
        for (int idx = bid * NTHR + tid; idx < NE * D; idx += G * NTHR) { const int e = idx >> 10, k = idx & 1023; const float w = p.w_router[k * NE + e]; const h16 hi = (h16)w;
            const int tl = e >> 4, ii = e & 15, rho = 32 * (tl >> 1) + 8 * (ii >> 2) + 4 * (tl & 1) + (ii & 3); const size_t dst = (size_t)(k >> 6) * 8192 + rho * 64 + (k & 63);
            WrTh[dst] = hi; WrTh[dst + 4096] = (h16)((w - (float)hi) * 2048.f); }
        for (int r = bid * NTHR + tid; r < 4096; r += G * NTHR) { const int g = r & 1, c = min((r >> 1) & 511, 510), b = r >> 10; cmpoff[r] = (unsigned)(((size_t)(b * T + 16 * c) * INP + g * 64) * 2); }
        { const int lane = tid & 63;
          for (int o = bid * 8 + (tid >> 6); o < 512; o += G * 8) { const int kv = o >> 8, j = o & 255; const float* pe = kv ? p.pe_v : p.pe_k; const float* w1 = kv ? p.w1v : p.w1k; float a = 0.f;
              for (int k = lane; k < 2048; k += 64) a += pe[k] * w1[(size_t)k * 256 + j];
              a = wave_sum(a); if (lane == 0) peb[o] = a; } }
    }
    SEAM(0);
    if (IN(1)) {
        REPS(1) { pg8::Gemm g{xh, WinT, M, INP, D}; pg8::StaticOrder S; S.init(g, G, bid); pg8::EpiF16 E{hb, INP};
          pg8::gemm_phase<pg8::EpiF16, pg8::StaticOrder>((PG8_LAS unsigned char*)lds, g.K, S, E); }
    }
    SEAM(1);
    if (IN(2)) REPS(2) {
        if (bid < 32) { CmpSched S{(const char*)hb, cmpoff, (const char*)Wc1T, bid}; pg8::EpiCmp1 E{hid, peb + (bid >> 4) * 256};
            pg8::gemm_phase<pg8::EpiCmp1, CmpSched>((PG8_LAS unsigned char*)lds, 2048, S, E, (size_t)INP * 2);
            pg8::Gemm g{memh, WxkvT, NB * MEML, 2 * D, D}; pg8::StaticOrder S2; S2.init(g, 32, bid); pg8::EpiF16 E2{kvm, 2 * D};
            pg8::gemm_phase<pg8::EpiF16, pg8::StaticOrder>((PG8_LAS unsigned char*)lds, g.K, S2, E2); }
        else { const int sub = tid >> 8, lt = tid & 255; const int b2 = bid - 32, G2 = G - 32;
        { const int wv = __builtin_amdgcn_readfirstlane(tid >> 6), lane = tid & 63; LAS h16* wsl = (LAS h16*)((LAS unsigned char*)lds + wv * 8704);
          for (int m0 = (b2 * 8 + wv) * 2; m0 < M; m0 += G2 * 16) { w_rope(hb, rqr, rkr, nqr, ksR, kwR, cosr, sinr, cosn, sinn, m0, lane); w_rope(hb, rqr, rkr, nqr, ksR, kwR, cosr, sinr, cosn, sinn, m0 + 1, lane); }
          for (int it = b2 * 8 + wv; it < 2 * NB * 2 * 128; it += G2 * 8) b_vtrans(hb, vsT, vwT, it, wsl, lane);
          for (int it = b2 * 8 + wv; it < NB * 4 * 256; it += G2 * 8) b_rtrans(p, hb, rvT, rkzT, cosr, sinr, it, wsl, lane); }
        } }
    SEAM(2);
    if (IN(3)) {
        REPS(30) b_cmp2(p, hid, kcmp, vcmpT);
        { const int sub = tid >> 8, lt = tid & 255;
          for (int b0 = bid * 2; b0 < NB * 4 * 16; b0 += G * 2) b_mvtrans(kvm, kvmVT, kx, b0 + sub, (h16*)(fl + sub * 2304), lt); }
        const int wv = __builtin_amdgcn_readfirstlane(tid >> 6), lane = tid & 63;
        REPS(31) for (int ch = bid; ch < NB * 4 * 64; ch += G) ret_kv_unit(rkzT, rvT, kvb, ch, wv, lane); }
    SEAM(3);
    if (IN(4)) {
        REPS(4) b_ret_scan(p, kvb, prevT);
        const int wv = __builtin_amdgcn_readfirstlane(tid >> 6), lane = tid & 63;
        __syncthreads();
        REPS(50) { const int bg = bid & 7;
            const int nper = G >> 3, jb = bid >> 3;
            for (int r = 0; r * nper < T / 32; ++r) { const int k = r * nper + ((r & 1) ? nper - 1 - jb : jb);
                if (k < T / 32) nsa_block_unit(hb, nqr, kcmp, vcmpT, vsT, vwT, ksR, kwR, mix, bg >> 1, bg & 1, (T / 32 - 1 - k) * 32, (LAS unsigned char*)lds, wv, lane); } }
    }
    SEAM(4);
    if (IN(5)) {
        const int wv = __builtin_amdgcn_readfirstlane(tid >> 6), lane = tid & 63;
        REPS(51) for (int ch = bid; ch < NB * 4 * 64; ch += G) ret_out_unit(p, hb, rqr, rkr, rvT, prevT, mix, ch, wv, lane);
    }
    SEAM(5);
    if (IN(6)) { pg8::Gemm g{mix, WoutT, M, D, D}; pg8::StaticOrder S; S.init(g, G, bid); pg8::EpiResStats E{vh, p.x, D, DN_ALPHA, st1};
        pg8::gemm_phase<pg8::EpiResStats, pg8::StaticOrder>((PG8_LAS unsigned char*)lds, g.K, S, E); }
    if (IN(6) && IN(8)) xcd_barrier(xbar);
    if (PROBE_DBL == 900) { for (int k = 0; k < 20; ++k) xcd_barrier(xbar); }
    if (IN(8)) { pg8::Gemm g{vh, WxqT, M, D, D}; pg8::StaticOrder S; S.init(g, G, bid); pg8::EpiQLn E{qx, D, st1, scv, tcv, st1 + (size_t)M * 16};
        pg8::gemm_phase<pg8::EpiQLn, pg8::StaticOrder>((PG8_LAS unsigned char*)lds, g.K, S, E);
        __builtin_amdgcn_fence(__ATOMIC_ACQUIRE, "agent"); asm volatile("s_waitcnt vmcnt(0)" ::: "memory"); __syncthreads();
        const int wv = __builtin_amdgcn_readfirstlane(tid >> 6), lane = tid & 63;
        xattn_block(qx, kx, kvmVT, ox, S, (LAS unsigned char*)lds, wv, lane); }
    if (IN(8) && IN(10)) xcd_barrier(xbar);
    if (IN(10)) { pg8::Gemm g{ox, WxoT, M, D, D}; pg8::StaticOrder S; S.init(g, G, bid); pg8::EpiResLn E{pre, vh, st1 + (size_t)M * 16, gb1, st1 + (size_t)M * 17};
        pg8::gemm_phase<pg8::EpiResLn, pg8::StaticOrder>((PG8_LAS unsigned char*)lds, g.K, S, E); }
    if (IN(10) && IN(12)) xcd_barrier(xbar);
    if (IN(12)) {
        { const int wv = __builtin_amdgcn_readfirstlane(tid >> 6), lane = tid & 63; LAS float* lg = (LAS float*)((LAS unsigned char*)lds + NSA_IMP + wv * 4096);
          LAS int* lhist = (LAS int*)((LAS unsigned char*)lds + 131072 + 2048);
          for (int i = tid; i < NVE; i += NTHR) lhist[i] = 0;
          __syncthreads();
          { LAS float* gbl = (LAS float*)((LAS unsigned char*)lds + 131072 + 4096); for (int i = tid; i < 2 * D; i += NTHR) gbl[i] = i < D ? p.ln2g[i] : p.ln2b[i - D]; }
          __syncthreads();
          for (int u0 = bid * 8; u0 < M / 16; u0 += G * 8) router_round(p, pre, st1 + (size_t)M * 17, x2h, WrTh, tope, topw, lhist, (u0 + wv) * 16, u0 + wv < M / 16, (LAS unsigned char*)lds, lg, wv, lane);
          __syncthreads();
          for (int i = tid; i < NVE; i += NTHR) { const int c = lhist[i]; if (c) atomicAdd(ctl + CTL_CNT + i, c); } }
        __syncthreads();
        if (bid == 0 && tid < NQ) ctl[CTL_CNT + tid * 65 + 64] = QT;
        for (int i = bid * NTHR + tid; i < CAP; i += G * NTHR) { rowoff[i] = 0u; rowmeta[i] = (u32x2){0xffffffffu, 0u}; }
        { const int wv = __builtin_amdgcn_readfirstlane(tid >> 6), lane = tid & 63; LAS float* scr = (LAS float*)((LAS unsigned char*)lds + wv * 8704);
          REPS(121) for (int it = bid * 8 + wv; it < 65 * 384; it += G * 8) { const int e = it / 384, r = it % 384;
            const float* wg = e < 64 ? p.w_gate + (size_t)e * D * EFF : p.ws_gate; const float* wu = e < 64 ? p.w_up + (size_t)e * D * EFF : p.ws_up; const float* wd = e < 64 ? p.w_down + (size_t)e * EFF * D : p.ws_down;
            if (r < 128) w_transpose_item(wg, D, EFF, WguT + (size_t)e * 512 * D, r, scr, lane, 2, 0);
            else if (r < 256) w_transpose_item(wu, D, EFF, WguT + (size_t)e * 512 * D, r - 128, scr, lane, 2, 1);
            else w_transpose_item(wd, EFF, D, WdT + (size_t)e * D * EFF, r - 256, scr, lane); } }
    }
    SEAM(12);
    if (IN(13)) b_scatter(ctl, tope, topw, rowoff, rowmeta, (int*)lds);
    SEAM(13);
    const int cx = (G & 7) == 0 ? (bid & 7) * (G >> 3) + (bid >> 3) : bid;
    if (IN(14)) REPS(14) { G1Sched S{ctl, (const char*)x2h, rowoff, (const char*)WguT, G, cx}; pg8::EpiGateUp E{Hm};
        pg8::gemm_phase<pg8::EpiGateUp, G1Sched>((PG8_LAS unsigned char*)lds, D, S, E); }
    SEAM(14);
#pragma unroll 1
    for (int q = 0; q < NQ; ++q) {
        if (IN(15 + 2 * q)) REPS(15) { G2Sched S{ctl, (const char*)Hm, (const char*)WdT, q, G, cx}; pg8::EpiDown E{Yq, rowmeta, ctl + CTL_T2};
            pg8::gemm_phase<pg8::EpiDown, G2Sched>((PG8_LAS unsigned char*)lds, EFF, S, E); }
        SEAM(15 + 2 * q);
        if (IN(16 + 2 * q)) REPS(16) b_combine(p, x2h, Yq, q);
        if (q < NQ - 1 && IN(16 + 2 * q) && IN(17 + 2 * q)) xcd_barrier<false>(xbar);
    }
#undef IN
#undef SEAM
#undef tid
}

#ifndef MK_PER_PHASE
#define MK_PER_PHASE 0
#endif
extern "C" void kernel_launch(void* const* d_in, const int* in_sizes, int n_in, void* d_out, int out_size, void* d_ws, size_t ws_size, hipStream_t stream) {
    static int grid = 0;
    if (grid == 0) {
        if (n_in != 28 || in_sizes[0] != M * D || out_size != M * D || ws_size < WS_NEED) { fprintf(stderr, "kernel_launch: unexpected shapes (n_in %d, in0 %d, out %d, ws %zu)\n", n_in, n_in > 0 ? in_sizes[0] : -1, out_size, ws_size); grid = -1; return; }
        if (hipFuncSetAttribute((const void*)mega_fwd, hipFuncAttributeMaxDynamicSharedMemorySize, LDS_BYTES) != hipSuccess) { fprintf(stderr, "kernel_launch: hipFuncSetAttribute failed\n"); grid = -1; return; }
        int dev = 0, cus = 0, per_cu = 0;
        hipGetDevice(&dev); hipDeviceGetAttribute(&cus, hipDeviceAttributeMultiprocessorCount, dev);
        if (hipOccupancyMaxActiveBlocksPerMultiprocessor(&per_cu, (const void*)mega_fwd, NTHR, LDS_BYTES) != hipSuccess || per_cu < 1) { fprintf(stderr, "kernel_launch: occupancy query failed (%d)\n", per_cu); grid = -1; return; }
        grid = cus;
    }
    if (grid < 0) return;
    Params p{};
    p.x = (const float*)d_in[0]; p.mem = (const float*)d_in[1]; p.positions = (const int*)d_in[2];
    p.w_in = (const float*)d_in[3]; p.pe_k = (const float*)d_in[4]; p.pe_v = (const float*)d_in[5];
    p.w1k = (const float*)d_in[6]; p.w2k = (const float*)d_in[7]; p.w1v = (const float*)d_in[8]; p.w2v = (const float*)d_in[9];
    p.w_out = (const float*)d_in[10]; p.ln1g = (const float*)d_in[11]; p.ln1b = (const float*)d_in[12];
    p.w_xq = (const float*)d_in[13]; p.w_xkv = (const float*)d_in[14]; p.w_xo = (const float*)d_in[15];
    p.ln2g = (const float*)d_in[16]; p.ln2b = (const float*)d_in[17]; p.w_router = (const float*)d_in[18]; p.rbias = (const float*)d_in[19];
    p.w_gate = (const float*)d_in[20]; p.w_up = (const float*)d_in[21]; p.w_down = (const float*)d_in[22];
    p.ws_gate = (const float*)d_in[23]; p.ws_up = (const float*)d_in[24]; p.ws_down = (const float*)d_in[25];
    p.ln3g = (const float*)d_in[26]; p.ln3b = (const float*)d_in[27];
    p.out = (float*)d_out; p.ws = (unsigned char*)d_ws;
    for (int i = 0; i < 4; ++i) p.lg[i] = (float)std::log(1.0 - std::pow(2.0, -5.0 - (double)i));
#if MK_PER_PHASE
    for (int ph = 0; ph < N_PHASES; ++ph) { p.ph_lo = ph; p.ph_hi = ph + 1; hipLaunchKernelGGL(mega_fwd, dim3(grid), dim3(NTHR), LDS_BYTES, stream, p); }
#else
    p.ph_lo = 0; p.ph_hi = N_PHASES;
    if (hipMemsetAsync((char*)d_ws + WS_BAR, 0, XCD_BAR_WORDS * 4, stream) != hipSuccess) { fprintf(stderr, "kernel_launch: memset failed\n"); return; }
    hipLaunchKernelGGL(mega_fwd, dim3(grid), dim3(NTHR), LDS_BYTES, stream, p);
#endif
}
```
